# Optimizing an MI355X kernel written in HIP

```python
import jax
import jax.numpy as jnp
from jax import lax
import numpy as np

D_MODEL = 1024
BATCH = 8
SEQ = 4096
DEPTH = 4

GRID_W = 64
CTX_LEN = 256
N_MIXERS = 2
N_ATTN_LAYERS = (DEPTH + N_MIXERS - 1) // N_MIXERS
N_GLA_LAYERS = DEPTH // N_MIXERS
N_MOD = 6
RMS_EPS = 1e-6

ATTN_HEAD_DIM = 64
N_Q_HEADS = D_MODEL // ATTN_HEAD_DIM
N_KV_HEADS = N_Q_HEADS // 4
GQA_GROUP = N_Q_HEADS // N_KV_HEADS
QKV_DIM = (N_Q_HEADS + 2 * N_KV_HEADS) * ATTN_HEAD_DIM
ROPE_THETA = 10000.0
Q_BLOCK = 128

GLA_HEADS = 4
GLA_DK = D_MODEL // 2
GLA_DV = D_MODEL
GLA_DK_HEAD = GLA_DK // GLA_HEADS
GLA_DV_HEAD = GLA_DV // GLA_HEADS
GLA_GATE_RANK = 16
GLA_GATE_NORM = 16.0
GLA_CHUNK = 64
GLA_IN_DIM = 2 * GLA_DK + 2 * GLA_DV + 2 * GLA_GATE_RANK

N_EXPERTS = 32
TOP_K = 4
D_EXPERT = D_MODEL
SWIGLU_LIMIT = 7.0
SWIGLU_ALPHA = 1.702

kernel_name = 'hybrid_gqa_gla_moe_dit'


def rms_norm(x, g):
    xf = x.astype(jnp.float32)
    y = xf * lax.rsqrt(jnp.mean(xf * xf, axis=-1, keepdims=True) + RMS_EPS)
    return (y * g.astype(jnp.float32)).astype(x.dtype)


def ada_modulation(cond, w_mod, b_mod):
    m = jax.nn.silu(cond) @ w_mod + b_mod
    return jnp.split(m, N_MOD, axis=-1)


def modulate(x, g, shift, scale):
    return rms_norm(x, g) * (1.0 + scale) + shift


def axial_rope_tables(rows):
    row_ids = jnp.repeat(jnp.arange(rows), GRID_W).astype(jnp.float32)
    col_ids = jnp.tile(jnp.arange(GRID_W), rows).astype(jnp.float32)
    axis_dim = ATTN_HEAD_DIM // 2
    inv_freq = 1.0 / (ROPE_THETA ** (jnp.arange(0, axis_dim, 2, dtype=jnp.float32) / axis_dim))
    ang = jnp.concatenate([row_ids[:, None] * inv_freq, col_ids[:, None] * inv_freq], axis=-1)
    return jnp.cos(ang), jnp.sin(ang)


def apply_rope(x, cos, sin):
    extra = x.ndim - 3
    c = cos.reshape((cos.shape[0],) + (1,) * extra + (cos.shape[1],))
    s = sin.reshape((sin.shape[0],) + (1,) * extra + (sin.shape[1],))
    x1 = x[..., 0::2]
    x2 = x[..., 1::2]
    y = jnp.stack([x1 * c - x2 * s, x1 * s + x2 * c], axis=-1)
    return y.reshape(x.shape).astype(x.dtype)


def gqa_attend(q, k, v):
    s = jnp.einsum('bqhgd,bkhd->bhgqk', q, k).astype(jnp.float32) * (ATTN_HEAD_DIM ** -0.5)
    p = jax.nn.softmax(s, axis=-1).astype(v.dtype)
    return jnp.einsum('bhgqk,bkhd->bqhgd', p, v)


def qkv_heads(h, w_qkv, q_gain, k_gain):
    B, T, _ = h.shape
    q, k, v = jnp.split(h @ w_qkv, [N_Q_HEADS * ATTN_HEAD_DIM, (N_Q_HEADS + N_KV_HEADS) * ATTN_HEAD_DIM], axis=-1)
    q = rms_norm(q.reshape(B, T, N_KV_HEADS, GQA_GROUP, ATTN_HEAD_DIM), q_gain)
    k = rms_norm(k.reshape(B, T, N_KV_HEADS, ATTN_HEAD_DIM), k_gain)
    v = v.reshape(B, T, N_KV_HEADS, ATTN_HEAD_DIM)
    return q, k, v


def attention_mixer(h_ctx, h_lat, cos, sin, w_qkv, q_gain, k_gain, w_o, ctx_out):
    B, S, _ = h_lat.shape
    L = h_ctx.shape[1]
    q_c, k_c, v_c = qkv_heads(h_ctx, w_qkv, q_gain, k_gain)
    q_l, k_l, v_l = qkv_heads(h_lat, w_qkv, q_gain, k_gain)
    q_l = apply_rope(q_l, cos, sin)
    k_l = apply_rope(k_l, cos, sin)
    k_all = jnp.concatenate([k_c, k_l], axis=1)
    v_all = jnp.concatenate([v_c, v_l], axis=1)
    n_blk = S // Q_BLOCK
    q_blocks = q_l.reshape(B, n_blk, Q_BLOCK, N_KV_HEADS, GQA_GROUP, ATTN_HEAD_DIM).swapaxes(0, 1)
    o_blocks = lax.map(lambda qb: gqa_attend(qb, k_all, v_all), q_blocks)
    o_lat = o_blocks.swapaxes(0, 1).reshape(B, S, D_MODEL) @ w_o
    o_ctx = None
    if ctx_out:
        o_ctx = gqa_attend(q_c, k_c, v_c).reshape(B, L, D_MODEL) @ w_o
    return o_ctx, o_lat


def gla_chunk_scan(q, k, v, g, s0):
    B, H, T, dk = q.shape
    dv = v.shape[-1]
    n = T // GLA_CHUNK

    def to_chunks(a):
        return a.reshape(B, H, n, GLA_CHUNK, a.shape[-1]).transpose(2, 0, 1, 3, 4)

    mask = jnp.tril(jnp.ones((GLA_CHUNK, GLA_CHUNK), dtype=bool))[:, :, None]

    def step(state, inp):
        qc, kc, vc, gc = inp
        b = jnp.cumsum(gc, axis=2)
        o_inter = jnp.einsum('bhcd,bhde->bhce', qc * jnp.exp(b), state)
        diff = b[:, :, :, None, :] - b[:, :, None, :, :]
        decay = jnp.exp(jnp.where(mask, diff, -jnp.inf))
        A = jnp.einsum('bhid,bhjd,bhijd->bhij', qc, kc, decay)
        o_intra = jnp.einsum('bhij,bhje->bhie', A, vc)
        b_last = b[:, :, -1:, :]
        k_dec = kc * jnp.exp(b_last - b)
        new_state = jnp.exp(b_last[:, :, 0, :])[..., None] * state + jnp.einsum('bhcd,bhce->bhde', k_dec, vc)
        return new_state, o_inter + o_intra

    s_fin, o = lax.scan(step, s0, (to_chunks(q), to_chunks(k), to_chunks(v), to_chunks(g)))
    o = o.transpose(1, 2, 0, 3, 4).reshape(B, H, T, dv)
    return o, s_fin


def gla_mixer(h_ctx, h_lat, w_in, w_gk2_f, b_gk_f, w_gk2_b, b_gk_b, o_gain, w_o, ctx_out):
    splits = [GLA_DK, 2 * GLA_DK, 2 * GLA_DK + GLA_DV, 2 * GLA_DK + 2 * GLA_DV,
              2 * GLA_DK + 2 * GLA_DV + GLA_GATE_RANK]

    def project(h):
        B, T, _ = h.shape
        q, k, v, r, lf, lb = jnp.split(h @ w_in, splits, axis=-1)
        gf = jax.nn.log_sigmoid((lf @ w_gk2_f + b_gk_f).astype(jnp.float32)) / GLA_GATE_NORM
        gb = jax.nn.log_sigmoid((lb @ w_gk2_b + b_gk_b).astype(jnp.float32)) / GLA_GATE_NORM

        def heads(a, dh):
            return a.reshape(B, T, GLA_HEADS, dh).transpose(0, 2, 1, 3).astype(jnp.float32)

        qkvg = (heads(q, GLA_DK_HEAD) * (GLA_DK_HEAD ** -0.5), heads(k, GLA_DK_HEAD),
                heads(v, GLA_DV_HEAD), heads(gf, GLA_DK_HEAD), heads(gb, GLA_DK_HEAD))
        return qkvg, r

    def bidir(qkvg, sf0, sb0):
        q, k, v, gf, gb = qkvg
        flip = lambda a: jnp.flip(a, axis=2)
        o_f, s_f = gla_chunk_scan(q, k, v, gf, sf0)
        o_b, s_b = gla_chunk_scan(flip(q), flip(k), flip(v), flip(gb), sb0)
        return o_f + flip(o_b), s_f, s_b

    def readout(o, r):
        B, H, T, _ = o.shape
        o = rms_norm(o.transpose(0, 2, 1, 3), o_gain).reshape(B, T, GLA_DV)
        return (o.astype(r.dtype) * jax.nn.silu(r)) @ w_o

    qkvg_c, r_c = project(h_ctx)
    qkvg_l, r_l = project(h_lat)
    B = h_lat.shape[0]
    zero = jnp.zeros((B, GLA_HEADS, GLA_DK_HEAD, GLA_DV_HEAD), jnp.float32)
    o_c, s_f, s_b = bidir(qkvg_c, zero, zero)
    o_l, _, _ = bidir(qkvg_l, s_f, s_b)
    o_ctx = readout(o_c, r_c) if ctx_out else None
    return o_ctx, readout(o_l, r_l)


def moe_ffn(h, w_router, b_router, w_gu, b_gu, w_down, b_down):
    shape = h.shape
    hf = h.reshape(-1, shape[-1])
    logits = (hf @ w_router + b_router).astype(jnp.float32)
    top_v, top_i = lax.top_k(logits, TOP_K)
    top_w = jax.nn.softmax(top_v, axis=-1)
    gates = jnp.einsum('nk,nke->ne', top_w, jax.nn.one_hot(top_i, N_EXPERTS, dtype=jnp.float32))
    out = jnp.zeros(hf.shape, jnp.float32)
    for e in range(N_EXPERTS):
        gu = hf @ w_gu[e] + b_gu[e]
        gate = jnp.minimum(gu[:, :D_EXPERT], SWIGLU_LIMIT)
        up = jnp.clip(gu[:, D_EXPERT:], -SWIGLU_LIMIT, SWIGLU_LIMIT)
        act = (up + 1.0) * (gate * jax.nn.sigmoid(SWIGLU_ALPHA * gate))
        out = out + gates[:, e:e + 1] * (act @ w_down[e] + b_down[e]).astype(jnp.float32)
    return out.astype(h.dtype).reshape(shape)


def setup_inputs(seed: int = 0) -> dict:
    key = jax.random.key(seed)
    ks = iter(jax.random.split(key, 32))

    def nrm(shape, scale):
        return jax.random.normal(next(ks), shape, jnp.float32) * scale

    def gain(shape):
        return 1.0 + nrm(shape, 0.02)

    D = D_MODEL
    return {
        'x': nrm((BATCH, SEQ, D), 1.0),
        'c': nrm((BATCH, D), 1.0),
        'ctx': nrm((BATCH, CTX_LEN, D), 1.0),
        'c_ctx': nrm((D,), 1.0),
        'ada_w': nrm((DEPTH, D, N_MOD * D), 0.5 * D ** -0.5),
        'ada_b': nrm((DEPTH, N_MOD * D), 0.02),
        'norm1_g': gain((DEPTH, D)),
        'norm2_g': gain((DEPTH, D)),
        'attn_w_qkv': nrm((N_ATTN_LAYERS, D, QKV_DIM), D ** -0.5),
        'attn_q_gain': gain((N_ATTN_LAYERS, ATTN_HEAD_DIM)),
        'attn_k_gain': gain((N_ATTN_LAYERS, ATTN_HEAD_DIM)),
        'attn_w_o': nrm((N_ATTN_LAYERS, D, D), D ** -0.5),
        'gla_w_in': nrm((N_GLA_LAYERS, D, GLA_IN_DIM), D ** -0.5),
        'gla_w_gk2_f': nrm((N_GLA_LAYERS, GLA_GATE_RANK, GLA_DK), GLA_GATE_RANK ** -0.5),
        'gla_b_gk_f': nrm((N_GLA_LAYERS, GLA_DK), 0.1),
        'gla_w_gk2_b': nrm((N_GLA_LAYERS, GLA_GATE_RANK, GLA_DK), GLA_GATE_RANK ** -0.5),
        'gla_b_gk_b': nrm((N_GLA_LAYERS, GLA_DK), 0.1),
        'gla_o_gain': gain((N_GLA_LAYERS, GLA_DV_HEAD)),
        'gla_w_o': nrm((N_GLA_LAYERS, D, D), D ** -0.5),
        'moe_w_router': nrm((DEPTH, D, N_EXPERTS), D ** -0.5),
        'moe_b_router': nrm((DEPTH, N_EXPERTS), 0.01),
        'moe_w_gu': nrm((DEPTH, N_EXPERTS, D, 2 * D_EXPERT), D ** -0.5),
        'moe_b_gu': nrm((DEPTH, N_EXPERTS, 2 * D_EXPERT), 0.02),
        'moe_w_down': nrm((DEPTH, N_EXPERTS, D_EXPERT, D), D_EXPERT ** -0.5),
        'moe_b_down': nrm((DEPTH, N_EXPERTS, D), 0.02),
    }


def reference(x, c, ctx, c_ctx, ada_w, ada_b, norm1_g, norm2_g,
              attn_w_qkv, attn_q_gain, attn_k_gain, attn_w_o,
              gla_w_in, gla_w_gk2_f, gla_b_gk_f, gla_w_gk2_b, gla_b_gk_b, gla_o_gain, gla_w_o,
              moe_w_router, moe_b_router, moe_w_gu, moe_b_gu, moe_w_down, moe_b_down):
    n_lat = x.shape[1]
    n_ctx = ctx.shape[1]
    rows = n_lat // GRID_W
    cos, sin = axial_rope_tables(rows)
    for i in range(DEPTH):
        last = i == DEPTH - 1
        sh1_l, sc1_l, g1_l, sh2_l, sc2_l, g2_l = ada_modulation(c[:, None, :], ada_w[i], ada_b[i])
        sh1_c, sc1_c, g1_c, sh2_c, sc2_c, g2_c = ada_modulation(c_ctx, ada_w[i], ada_b[i])
        h_lat = modulate(x, norm1_g[i], sh1_l, sc1_l)
        h_ctx = modulate(ctx, norm1_g[i], sh1_c, sc1_c)
        j = i // N_MIXERS
        if i % N_MIXERS == 0:
            o_ctx, o_lat = attention_mixer(h_ctx, h_lat, cos, sin, attn_w_qkv[j], attn_q_gain[j],
                                           attn_k_gain[j], attn_w_o[j], not last)
        else:
            o_ctx, o_lat = gla_mixer(h_ctx, h_lat, gla_w_in[j], gla_w_gk2_f[j], gla_b_gk_f[j],
                                     gla_w_gk2_b[j], gla_b_gk_b[j], gla_o_gain[j], gla_w_o[j], not last)
        x = x + g1_l * o_lat
        if last:
            f = moe_ffn(modulate(x, norm2_g[i], sh2_l, sc2_l), moe_w_router[i], moe_b_router[i],
                        moe_w_gu[i], moe_b_gu[i], moe_w_down[i], moe_b_down[i])
            x = x + g2_l * f
        else:
            ctx = ctx + g1_c * o_ctx
            h2 = jnp.concatenate([modulate(ctx, norm2_g[i], sh2_c, sc2_c),
                                  modulate(x, norm2_g[i], sh2_l, sc2_l)], axis=1)
            f = moe_ffn(h2, moe_w_router[i], moe_b_router[i], moe_w_gu[i], moe_b_gu[i],
                        moe_w_down[i], moe_b_down[i])
            ctx = ctx + g2_c * f[:, :n_ctx]
            x = x + g2_l * f[:, n_ctx:]
    return x
```

```cpp
#include <hip/hip_runtime.h>
#include <hip/hip_bf16.h>
#include <cstdio>
#include <cstdint>
#include <cmath>

#ifndef MK_ONE_LAUNCH
#define MK_ONE_LAUNCH 1
#endif

namespace pg8 {
#define PG8_LAS __attribute__((address_space(3)))
typedef unsigned short bf16_t;
typedef short bf16x8 __attribute__((ext_vector_type(8)));
typedef float f32x4 __attribute__((ext_vector_type(4)));
typedef unsigned u32x4 __attribute__((ext_vector_type(4)));
constexpr int BM = 256, BK = 64, HALF = 128, HTB = HALF * BK * 2  , STAGE_BYTES = 8 * HTB, NXCD = 8, WGM = 8;

__host__ __device__ __forceinline__ int lds_byte(int r, int c) { const int st = (r >> 4) * 2 + (c >> 5), rr = r & 15, cc = c & 31, ob = rr * 64 + cc * 2; return st * 1024 + (ob ^ (((ob >> 9) & 1) << 5)); }
__host__ __device__ __forceinline__ void stage_rc(int b, int& R, int& C) { const int st = b / 1024, sb = b % 1024, swz = sb ^ (((sb >> 9) & 1) << 5); R = (st >> 1) * 16 + swz / 64; C = (st & 1) * 32 + (swz % 64) / 2; }
__host__ __device__ __forceinline__ int perm32(int rho) { const int n = rho >> 4, i = rho & 15; return 8 * (i >> 2) + 4 * n + (i & 3); }

struct Unit { int pm, pn, e; };
struct Gemm { const bf16_t* A; const bf16_t* Bt; int M, N, K; size_t bstride; };

struct StaticOrder {
    int nM, nN, nwg, G, c;
    __host__ __device__ __forceinline__ void init(int M, int N, int G_, int c_) { nM = M / BM; nN = N / BM; nwg = nM * nN; G = G_; c = c_; }
    __host__ __device__ __forceinline__ bool next(int i, Unit& u) const {
        const long L = (long)i * G + c; if (L >= nwg) return false;
        int wgid = (int)L; { const int q = nwg / NXCD, r = nwg % NXCD, xcd = wgid % NXCD, off = wgid / NXCD; wgid = (xcd < r ? xcd * (q + 1) : r * (q + 1) + (xcd - r) * q) + off; }
        const int nig = WGM * nN, gid = wgid / nig, fm = gid * WGM, gsz = (nM - fm) < WGM ? (nM - fm) : WGM;
        u.pm = fm + ((wgid % nig) % gsz); u.pn = (wgid % nig) / gsz; u.e = 0; return true;
    }
    __device__ __forceinline__ void a_ready(const Unit&) const {}
    __device__ __forceinline__ void done(const Unit&) const {}
};
struct MoeOrder {
    int nT, nN, G, c; const PG8_LAS int* t2e;
    __device__ __forceinline__ bool next(int i, Unit& u) const {
        const int L = i * G + c, mt = L / nN; if (mt >= nT) return false;
        u.pm = mt; u.pn = L - mt * nN; u.e = __builtin_amdgcn_readfirstlane(t2e[mt]); return true;
    }
    __device__ __forceinline__ void a_ready(const Unit&) const {}
    __device__ __forceinline__ void done(const Unit&) const {}
};

__device__ __forceinline__ unsigned cvt_pk_bf16(float lo, float hi) { unsigned r; asm volatile("v_cvt_pk_bf16_f32 %0, %1, %2" : "=v"(r) : "v"(lo), "v"(hi)); return r; }

struct EpiBf16 {
    static constexpr bool PERM = true, AFTER_DRAIN = false;
    bf16_t* O; int ldc;
    __device__ __forceinline__ void operator()(const f32x4 (&acc)[2][2][4][2], const Unit& u, int wr, int wc, int fr, int fq) const {
        const int row0 = u.pm * BM + wr * 64 + fr; const int col0 = u.pn * BM + wc * 32 + 8 * fq;
#pragma unroll
        for (int ai = 0; ai < 2; ++ai)
#pragma unroll
            for (int m = 0; m < 4; ++m) { bf16_t* rowp = O + (size_t)(row0 + ai * HALF + m * 16) * ldc + col0;
#pragma unroll
                for (int bj = 0; bj < 2; ++bj) { const f32x4 v0 = acc[ai][bj][m][0], v1 = acc[ai][bj][m][1];
                    u32x4 w; w.x = cvt_pk_bf16(v0[0], v0[1]); w.y = cvt_pk_bf16(v0[2], v0[3]); w.z = cvt_pk_bf16(v1[0], v1[1]); w.w = cvt_pk_bf16(v1[2], v1[3]);
                    *(u32x4*)(rowp + bj * HALF) = w; } }
    }
};
struct EpiQKV {
    static constexpr bool PERM = true, AFTER_DRAIN = false;
    unsigned char* wsb; size_t offQ, dK, dV;
    __device__ __forceinline__ void operator()(const f32x4 (&acc)[2][2][4][2], const Unit& u, int wr, int wc, int fr, int fq) const {
        const int row0 = u.pm * BM + wr * 64 + fr;
        const int isk = (u.pn >= 4) ? 1 : 0, isv = (u.pn >= 5) ? 1 : 0;
        bf16_t* base = (bf16_t*)(wsb + offQ + (size_t)isk * dK + (size_t)isv * dV); const int ldc = isk ? 256 : 1024, colt = isk ? 0 : u.pn * BM;
        const int col0 = colt + wc * 32 + 8 * fq;
#pragma unroll
        for (int ai = 0; ai < 2; ++ai)
#pragma unroll
            for (int m = 0; m < 4; ++m) { bf16_t* rowp = base + (size_t)(row0 + ai * HALF + m * 16) * ldc + col0;
#pragma unroll
                for (int bj = 0; bj < 2; ++bj) { const f32x4 v0 = acc[ai][bj][m][0], v1 = acc[ai][bj][m][1];
                    u32x4 w; w.x = cvt_pk_bf16(v0[0], v0[1]); w.y = cvt_pk_bf16(v0[2], v0[3]); w.z = cvt_pk_bf16(v1[0], v1[1]); w.w = cvt_pk_bf16(v1[2], v1[3]);
                    *(u32x4*)(rowp + bj * HALF) = w; } }
    }
};
struct EpiResGate {
    static constexpr bool PERM = false, AFTER_DRAIN = false;
    float* X; const float* gate;
    __device__ __forceinline__ void operator()(const f32x4 (&acc)[2][2][4][2], const Unit& u, int wr, int wc, int fr, int fq) const {
        const int row0 = u.pm * BM + wr * 64 + fr; const int col0 = u.pn * BM + wc * 32 + 4 * fq;
        const int bb = u.pm / 17, mr = (u.pm - bb * 17 == 0) ? 8 : bb;
        const float* gp = gate + (size_t)mr * 6144 + col0;
        f32x4 gv[2][2];
#pragma unroll
        for (int bj = 0; bj < 2; ++bj)
#pragma unroll
            for (int n = 0; n < 2; ++n) gv[bj][n] = *(const f32x4*)(gp + bj * HALF + n * 16);
#pragma unroll
        for (int ai = 0; ai < 2; ++ai)
#pragma unroll
            for (int m = 0; m < 4; ++m) { float* rowp = X + (size_t)(row0 + ai * HALF + m * 16) * 1024 + col0;
#pragma unroll
                for (int bj = 0; bj < 2; ++bj)
#pragma unroll
                    for (int n = 0; n < 2; ++n) { f32x4* p = (f32x4*)(rowp + bj * HALF + n * 16); f32x4 x = *p; x = x + gv[bj][n] * acc[ai][bj][m][n]; *p = x; } }
    }
};
struct EpiSwiGLU {
    static constexpr bool PERM = true, AFTER_DRAIN = false;
    bf16_t* O; const float* bias;
    __device__ __forceinline__ void operator()(const f32x4 (&acc)[2][2][4][2], const Unit& u, int wr, int wc, int fr, int fq) const {
        const int row0 = u.pm * BM + wr * 64 + fr; const int col0 = u.pn * HALF + wc * 32 + 8 * fq;
        const float* bp = bias + (size_t)u.e * 2048 + col0;
        f32x4 bg[2], bu[2];
#pragma unroll
        for (int n = 0; n < 2; ++n) { bg[n] = *(const f32x4*)(bp + 4 * n); bu[n] = *(const f32x4*)(bp + 1024 + 4 * n); }
#pragma unroll
        for (int ai = 0; ai < 2; ++ai)
#pragma unroll
            for (int m = 0; m < 4; ++m) { bf16_t* rowp = O + (size_t)(row0 + ai * HALF + m * 16) * 1024 + col0;
                float r[8];
#pragma unroll
                for (int n = 0; n < 2; ++n) { const f32x4 gt = acc[ai][0][m][n] + bg[n], up = acc[ai][1][m][n] + bu[n];
#pragma unroll
                    for (int i = 0; i < 4; ++i) { const float g = fminf(gt[i], 7.0f), uu = fminf(fmaxf(up[i], -7.0f), 7.0f);
                        const float sg = __builtin_amdgcn_rcpf(1.0f + __builtin_amdgcn_exp2f(-1.702f * 1.4426950408889634f * g));
                        r[4 * n + i] = (uu + 1.0f) * (g * sg); } }
                u32x4 w; w.x = cvt_pk_bf16(r[0], r[1]); w.y = cvt_pk_bf16(r[2], r[3]); w.z = cvt_pk_bf16(r[4], r[5]); w.w = cvt_pk_bf16(r[6], r[7]);
                *(u32x4*)rowp = w; }
    }
};
struct EpiBiasBf16 {
    static constexpr bool PERM = true, AFTER_DRAIN = false;
    bf16_t* O; const float* bias;
    __device__ __forceinline__ void operator()(const f32x4 (&acc)[2][2][4][2], const Unit& u, int wr, int wc, int fr, int fq) const {
        const int row0 = u.pm * BM + wr * 64 + fr; const int col0 = u.pn * BM + wc * 32 + 8 * fq;
        const float* bp = bias + (size_t)u.e * 1024 + col0;
        f32x4 bv[2][2];
#pragma unroll
        for (int bj = 0; bj < 2; ++bj)
#pragma unroll
            for (int n = 0; n < 2; ++n) bv[bj][n] = *(const f32x4*)(bp + bj * HALF + 4 * n);
#pragma unroll
        for (int ai = 0; ai < 2; ++ai)
#pragma unroll
            for (int m = 0; m < 4; ++m) { bf16_t* rowp = O + (size_t)(row0 + ai * HALF + m * 16) * 1024 + col0;
#pragma unroll
                for (int bj = 0; bj < 2; ++bj) { const f32x4 v0 = acc[ai][bj][m][0] + bv[bj][0], v1 = acc[ai][bj][m][1] + bv[bj][1];
                    u32x4 w; w.x = cvt_pk_bf16(v0[0], v0[1]); w.y = cvt_pk_bf16(v0[2], v0[3]); w.z = cvt_pk_bf16(v1[0], v1[1]); w.w = cvt_pk_bf16(v1[2], v1[3]);
                    *(u32x4*)(rowp + bj * HALF) = w; } }
    }
};

template <class Epi, class Sched, bool ALIGN_EPI = false, bool SP2 = false>
__device__ __forceinline__ void gemm_phase(PG8_LAS unsigned char* lds, const Gemm g, const Sched& S, const Epi& E) {
    int tid_l = threadIdx.x; asm volatile("" : "+v"(tid_l));
    const int tid = tid_l, wid = __builtin_amdgcn_readfirstlane(tid >> 6), lane = tid & 63, wr = wid >> 2, wc = wid & 3, fr = lane & 15, fq = lane >> 4;
    const int K = g.K, nt = K / BK;
    unsigned voffA[2], voffB[2];
#pragma unroll
    for (int i = 0; i < 2; ++i) { int R, C; stage_rc(tid * 16 + i * 8192, R, C); const int Rb = Epi::PERM ? ((R & ~31) + perm32(R & 31)) : R;
        voffA[i] = (unsigned)(R * K + C) * 2u; voffB[i] = (unsigned)(Rb * K + C) * 2u; }
    const size_t kstep = (size_t)(BK * 2);
    const size_t hstep = (size_t)HALF * K * 2;
    const size_t tstep = 2 * hstep;
    const unsigned ldsw = (unsigned)wid * 1024u;
    const int aoff = lds_byte(wr * 64 + fr, fq * 8), boff = lds_byte(wc * 32 + fr, fq * 8);
#define PG8_SA(b, h) (((b) * 2 + (h)) * HTB)
#define PG8_SB(b, h) ((4 + (b) * 2 + (h)) * HTB)
#define PG8_STAGE(bufoff, gbase, voff) do { _Pragma("unroll") for (int _i = 0; _i < 2; ++_i) \
        __builtin_amdgcn_global_load_lds((const unsigned*)((const char*)(gbase) + (voff)[_i]), (PG8_LAS unsigned*)(lds + (bufoff) + ldsw + _i * 8192), 16, 0, 0); } while (0)
#define PG8_LDA(dst, b, h) do { _Pragma("unroll") for (int m = 0; m < 4; ++m) _Pragma("unroll") for (int k = 0; k < 2; ++k) dst[m][k] = *(const PG8_LAS bf16x8*)(lds + PG8_SA(b, h) + aoff + m * 2048 + k * 1024); } while (0)
#define PG8_LDB(dst, b, h) do { _Pragma("unroll") for (int n = 0; n < 2; ++n) _Pragma("unroll") for (int k = 0; k < 2; ++k) dst[n][k] = *(const PG8_LAS bf16x8*)(lds + PG8_SB(b, h) + boff + n * 2048 + k * 1024); } while (0)
#define PG8_MMA(ai, bj, At, Bt) do { __builtin_amdgcn_s_setprio(1); _Pragma("unroll") for (int m = 0; m < 4; ++m) _Pragma("unroll") for (int n = 0; n < 2; ++n) _Pragma("unroll") for (int k = 0; k < 2; ++k) \
        acc[ai][bj][m][n] = __builtin_amdgcn_mfma_f32_16x16x32_bf16(Bt[n][k], At[m][k], acc[ai][bj][m][n], 0, 0, 0); __builtin_amdgcn_s_setprio(0); } while (0)
#define PG8_WAIT_V(n) asm volatile("s_waitcnt vmcnt(" #n ")" ::: "memory")
#define PG8_WAIT_L(n) asm volatile("s_waitcnt lgkmcnt(" #n ")" ::: "memory")
#define PG8_BAR __builtin_amdgcn_s_barrier()
#define PG8_SCHED __builtin_amdgcn_sched_barrier(0)
    Unit cur, nxt; int ui = 0;
    if (!S.next(0, cur)) return;
    f32x4 acc[2][2][4][2];
#pragma unroll
    for (int a = 0; a < 2; ++a)
#pragma unroll
        for (int b = 0; b < 2; ++b)
#pragma unroll
            for (int m = 0; m < 4; ++m)
#pragma unroll
                for (int n = 0; n < 2; ++n) acc[a][b][m][n] = (f32x4){0.f, 0.f, 0.f, 0.f};
    bf16x8 At[4][2], B0[2][2], B1[2][2];
    const char* cA = (const char*)g.A + (size_t)cur.pm * tstep; const char* cB = (const char*)g.Bt + (size_t)cur.e * g.bstride + (size_t)cur.pn * tstep;
    S.a_ready(cur);
    if constexpr (SP2) {
        PG8_STAGE(PG8_SB(0, 0), cB, voffB); PG8_STAGE(PG8_SB(0, 1), cB + hstep, voffB); PG8_STAGE(PG8_SA(0, 0), cA, voffA); PG8_STAGE(PG8_SA(0, 1), cA + hstep, voffA);
        if (wr == 1) PG8_BAR;
        PG8_WAIT_V(2); PG8_BAR;
        PG8_STAGE(PG8_SB(1, 0), cB + kstep, voffB); PG8_STAGE(PG8_SA(1, 0), cA + kstep, voffA); PG8_STAGE(PG8_SB(1, 1), cB + hstep + kstep, voffB);
        PG8_WAIT_V(6); PG8_BAR;
    } else {
        PG8_STAGE(PG8_SB(0, 0), cB, voffB); PG8_STAGE(PG8_SA(0, 0), cA, voffA); PG8_STAGE(PG8_SB(0, 1), cB + hstep, voffB); PG8_STAGE(PG8_SA(0, 1), cA + hstep, voffA);
        if (wr == 1) PG8_BAR;
        PG8_WAIT_V(4); PG8_BAR;
        PG8_STAGE(PG8_SB(1, 0), cB + kstep, voffB); PG8_STAGE(PG8_SA(1, 0), cA + kstep, voffA); PG8_STAGE(PG8_SB(1, 1), cB + hstep + kstep, voffB);
        PG8_WAIT_V(6); PG8_BAR;
    }
    for (;;) {
        const bool has_next = S.next(ui + 1, nxt);
        const char* nA = has_next ? (const char*)g.A + (size_t)nxt.pm * tstep : cA; const char* nB = has_next ? (const char*)g.Bt + (size_t)nxt.e * g.bstride + (size_t)nxt.pn * tstep : cB;
        for (int t = 0; t < nt; t += 2) {
            const bool last = (t == nt - 2);
            const char* a1 = cA + (size_t)(t + 1) * kstep;
            const char* a2 = last ? nA : cA + (size_t)(t + 2) * kstep; const char* b2 = last ? nB : cB + (size_t)(t + 2) * kstep;
            const char* a3 = a2 + kstep; const char* b3 = b2 + kstep;
            if (last && has_next) S.a_ready(nxt);
            if constexpr (SP2) {
            PG8_LDB(B0, 0, 0); PG8_LDB(B1, 0, 1); PG8_SCHED; PG8_LDA(At, 0, 0); PG8_STAGE(PG8_SA(1, 1), a1 + hstep, voffA);
            PG8_WAIT_V(8); PG8_WAIT_L(0); PG8_BAR; PG8_MMA(0, 0, At, B0); PG8_MMA(0, 1, At, B1); PG8_BAR; PG8_SCHED;
            PG8_LDA(At, 0, 1); PG8_STAGE(PG8_SB(0, 0), b2, voffB); PG8_STAGE(PG8_SB(0, 1), b2 + hstep, voffB); PG8_STAGE(PG8_SA(0, 0), a2, voffA);
            PG8_WAIT_V(8); PG8_WAIT_L(0); PG8_BAR; PG8_MMA(1, 0, At, B0); PG8_MMA(1, 1, At, B1); PG8_BAR; PG8_SCHED;
            PG8_LDB(B0, 1, 0); PG8_LDB(B1, 1, 1); PG8_SCHED; PG8_LDA(At, 1, 0); PG8_STAGE(PG8_SA(0, 1), a2 + hstep, voffA);
            PG8_WAIT_V(8); PG8_WAIT_L(0); PG8_BAR; PG8_MMA(0, 0, At, B0); PG8_MMA(0, 1, At, B1); PG8_BAR; PG8_SCHED;
            PG8_LDA(At, 1, 1); PG8_STAGE(PG8_SB(1, 0), b3, voffB); PG8_STAGE(PG8_SB(1, 1), b3 + hstep, voffB); PG8_STAGE(PG8_SA(1, 0), a3, voffA);
            PG8_WAIT_V(8); PG8_WAIT_L(0); PG8_BAR; PG8_MMA(1, 0, At, B0); PG8_MMA(1, 1, At, B1); PG8_BAR; PG8_SCHED;
            } else {
            PG8_LDB(B0, 0, 0); PG8_SCHED; PG8_LDA(At, 0, 0); PG8_STAGE(PG8_SA(1, 1), a1 + hstep, voffA);
            PG8_WAIT_L(8); PG8_BAR; PG8_WAIT_L(0); PG8_MMA(0, 0, At, B0); PG8_BAR; PG8_SCHED;
            PG8_LDB(B1, 0, 1); PG8_STAGE(PG8_SB(0, 0), b2, voffB);
            PG8_BAR; PG8_WAIT_L(0); PG8_MMA(0, 1, At, B1); PG8_BAR;
            PG8_LDA(At, 0, 1); PG8_STAGE(PG8_SA(0, 0), a2, voffA);
            PG8_BAR; PG8_WAIT_L(0); PG8_MMA(1, 0, At, B0); PG8_BAR; PG8_SCHED;
            PG8_STAGE(PG8_SB(0, 1), b2 + hstep, voffB);
            PG8_WAIT_V(6); PG8_BAR; PG8_MMA(1, 1, At, B1); PG8_BAR;
            PG8_LDB(B0, 1, 0); PG8_SCHED; PG8_LDA(At, 1, 0); PG8_STAGE(PG8_SA(0, 1), a2 + hstep, voffA);
            PG8_WAIT_L(8); PG8_BAR; PG8_WAIT_L(0); PG8_MMA(0, 0, At, B0); PG8_BAR; PG8_SCHED;
            PG8_LDB(B1, 1, 1); PG8_STAGE(PG8_SB(1, 0), b3, voffB);
            PG8_BAR; PG8_WAIT_L(0); PG8_MMA(0, 1, At, B1); PG8_BAR;
            PG8_LDA(At, 1, 1); PG8_STAGE(PG8_SA(1, 0), a3, voffA);
            PG8_BAR; PG8_WAIT_L(0); PG8_MMA(1, 0, At, B0); PG8_BAR; PG8_SCHED;
            PG8_STAGE(PG8_SB(1, 1), b3 + hstep, voffB);
            PG8_WAIT_V(6); PG8_BAR; PG8_MMA(1, 1, At, B1); PG8_BAR;
            }
        }
        if constexpr (ALIGN_EPI) { if (wr == 0) PG8_BAR; }
        if constexpr (!Epi::AFTER_DRAIN) { E(acc, cur, wr, wc, fr, fq); S.done(cur); }
        if (!has_next) break;
#pragma unroll
        for (int a = 0; a < 2; ++a)
#pragma unroll
            for (int b = 0; b < 2; ++b)
#pragma unroll
                for (int m = 0; m < 4; ++m)
#pragma unroll
                    for (int n = 0; n < 2; ++n) acc[a][b][m][n] = (f32x4){0.f, 0.f, 0.f, 0.f};
        cur = nxt; cA = nA; cB = nB; ++ui;
        if constexpr (ALIGN_EPI) { if (wr == 1) PG8_BAR; }
    }
    PG8_WAIT_V(0);
    if constexpr (!ALIGN_EPI) { if (wr == 0) PG8_BAR; }
    PG8_BAR;
    if constexpr (Epi::AFTER_DRAIN) { E.fused(acc, cur, wr, wc, fr, fq, lds, wid, lane); S.done(cur); }
#undef PG8_SA
#undef PG8_SB
#undef PG8_STAGE
#undef PG8_LDA
#undef PG8_LDB
#undef PG8_MMA
#undef PG8_WAIT_V
#undef PG8_WAIT_L
#undef PG8_BAR
#undef PG8_SCHED
}
}
#include <hip/hip_bf16.h>
#include <cmath>
namespace attn_body {
using bf16=__hip_bfloat16;
using bf16x8=__attribute__((ext_vector_type(8)))short;
using s16x4=__attribute__((ext_vector_type(4)))short;
using f32x16=__attribute__((ext_vector_type(16)))float;
using u32x4=__attribute__((ext_vector_type(4)))unsigned;
constexpr int D=64,DM=1024,KVP=256;
constexpr int NW=8,QBLK=32,QB=QBLK*NW,KVBLK=64;
__device__ __forceinline__ int crow(int r,int hi){return (r&3)+8*(r>>2)+4*hi;}
#define SBAR() __builtin_amdgcn_sched_barrier(0)
__device__ __forceinline__ void cmask(f32x16&p0,f32x16&p1,int jb,int qrel,int hi){
  const float NEG=-INFINITY; int kb=64*jb+4*hi;
  #pragma unroll
  for(int r=0;r<16;++r){int kv=kb+(r&3)+8*(r>>2); if(kv>qrel)p0[r]=NEG; if(kv+32>qrel)p1[r]=NEG;}
}

constexpr int NSLOT=3, SLOTB=8192;
constexpr int LDS_K=0, LDS_V=NSLOT*SLOTB, LDS_WS=2*NSLOT*SLOTB, LDS_OST=LDS_WS+NW*64*4, LDS_BYTES=LDS_OST+NW*4096;
constexpr float C2=0.125f*1.4426950408889634f;
__device__ __forceinline__ void glds16(const void*gsrc,unsigned lds_dst){unsigned keep;
  asm volatile("s_mov_b32 %0, m0\n\ts_mov_b32 m0, %2\n\ts_nop 0\n\tglobal_load_lds_dwordx4 %1, off\n\ts_mov_b32 m0, %0":"=&s"(keep):"v"(gsrc),"s"(lds_dst):"memory");}
__device__ __forceinline__ float max3f(float a,float b,float c){float r;asm("v_max3_f32 %0, %1, %2, %3":"=v"(r):"v"(a),"v"(b),"v"(c));return r;}
__device__ __forceinline__ float max2f(float a,float b){float r;asm("v_max_f32_e32 %0, %1, %2":"=v"(r):"v"(a),"v"(b));return r;}
__device__ __forceinline__ float fadd_s(float a,float b){float r;asm("v_add_f32_e32 %0, %1, %2":"=v"(r):"v"(a),"v"(b));return r;}
__device__ __forceinline__ float fsub_s(float a,float b){float r;asm("v_sub_f32_e32 %0, %1, %2":"=v"(r):"v"(a),"v"(b));return r;}
typedef float f32x2_t __attribute__((ext_vector_type(2))); typedef __bf16 bf16x2_t __attribute__((ext_vector_type(2)));
__device__ __forceinline__ unsigned cvtpk_s(float lo,float hi){f32x2_t v={lo,hi};bf16x2_t b=__builtin_convertvector(v,bf16x2_t);return __builtin_bit_cast(unsigned,b);}
#define WAIT_BAR(N) asm volatile("s_waitcnt vmcnt(" #N ") lgkmcnt(0)\n\ts_barrier":::"memory")

__device__ __forceinline__ void qkt(f32x16&p0,f32x16&p1,const char*Kslot,const bf16x8*qr,const f32x16&negm,int r32,int hi){
  const char*kb=Kslot+hi*1024+r32*16;
  #pragma unroll
  for(int d0=0;d0<4;++d0){
    const bf16x8 b0=*reinterpret_cast<const bf16x8*>(kb+d0*2048);
    const bf16x8 b1=*reinterpret_cast<const bf16x8*>(kb+d0*2048+512);
    if(d0==0){p0=__builtin_amdgcn_mfma_f32_32x32x16_bf16(b0,qr[0],negm,0,0,0);p1=__builtin_amdgcn_mfma_f32_32x32x16_bf16(b1,qr[0],negm,0,0,0);}
    else{p0=__builtin_amdgcn_mfma_f32_32x32x16_bf16(b0,qr[d0],p0,0,0,0);p1=__builtin_amdgcn_mfma_f32_32x32x16_bf16(b1,qr[d0],p1,0,0,0);}}
}
typedef __attribute__((address_space(3))) const char* lds_cptr;
typedef short v4i16_t __attribute__((ext_vector_type(4)));
__device__ __forceinline__ void kload8(bf16x8*kf,lds_cptr kp){
  kf[0]=*(const __attribute__((address_space(3))) bf16x8*)(kp);      kf[1]=*(const __attribute__((address_space(3))) bf16x8*)(kp+512);
  kf[2]=*(const __attribute__((address_space(3))) bf16x8*)(kp+2048); kf[3]=*(const __attribute__((address_space(3))) bf16x8*)(kp+2560);
  kf[4]=*(const __attribute__((address_space(3))) bf16x8*)(kp+4096); kf[5]=*(const __attribute__((address_space(3))) bf16x8*)(kp+4608);
  kf[6]=*(const __attribute__((address_space(3))) bf16x8*)(kp+6144); kf[7]=*(const __attribute__((address_space(3))) bf16x8*)(kp+6656);
}
__device__ __forceinline__ void kload2(bf16x8*kf,lds_cptr kp,int j){ kf[2*j]=*(const __attribute__((address_space(3))) bf16x8*)(kp+j*2048); kf[2*j+1]=*(const __attribute__((address_space(3))) bf16x8*)(kp+j*2048+512); }
__device__ __forceinline__ s16x4 vtr(lds_cptr p){ return __builtin_bit_cast(s16x4,__builtin_amdgcn_ds_read_tr16_b64_v4i16((__attribute__((address_space(3))) v4i16_t*)p)); }
__device__ __forceinline__ float rowmax(const f32x16&p0,const f32x16&p1){
  float a=max3f(p0[0],p0[1],p1[0]),b=max3f(p0[2],p0[3],p1[1]);a=max3f(a,p1[2],p1[3]);
  #pragma unroll
  for(int r=4;r<16;r+=4){a=max3f(a,p0[r],p0[r+1]);b=max3f(b,p0[r+2],p0[r+3]);a=max3f(a,p1[r],p1[r+1]);b=max3f(b,p1[r+2],p1[r+3]);}
  const float m=max2f(a,b);
  auto rr=__builtin_amdgcn_permlane32_swap(__float_as_uint(m),__float_as_uint(m),false,false);
  return max2f(__uint_as_float(rr[0]),__uint_as_float(rr[1]));
}
__device__ __forceinline__ void pv(f32x16*o,int vb,bf16x8 pa0,bf16x8 pa1,bf16x8 pa2,bf16x8 pa3){
  #pragma unroll
  for(int d0=0;d0<2;++d0){s16x4 lo[4],hi[4];
    #pragma unroll
    for(int ks=0;ks<4;++ks){
      asm volatile("ds_read_b64_tr_b16 %0,%1 offset:%c2":"=&v"(lo[ks]):"v"(vb),"i"(d0*4096+ks*1024):"memory");
      asm volatile("ds_read_b64_tr_b16 %0,%1 offset:%c2":"=&v"(hi[ks]):"v"(vb),"i"(d0*4096+ks*1024+512):"memory");}
    asm volatile("s_waitcnt lgkmcnt(0)":::"memory");SBAR();
    #define PK(k) (bf16x8){lo[k][0],lo[k][1],lo[k][2],lo[k][3],hi[k][0],hi[k][1],hi[k][2],hi[k][3]}
    o[d0]=__builtin_amdgcn_mfma_f32_32x32x16_bf16(pa0,PK(0),o[d0],0,0,0);
    o[d0]=__builtin_amdgcn_mfma_f32_32x32x16_bf16(pa1,PK(1),o[d0],0,0,0);
    o[d0]=__builtin_amdgcn_mfma_f32_32x32x16_bf16(pa2,PK(2),o[d0],0,0,0);
    o[d0]=__builtin_amdgcn_mfma_f32_32x32x16_bf16(pa3,PK(3),o[d0],0,0,0);
    #undef PK
  }
}

#ifndef ATTN_STORE16
#define ATTN_STORE16(p,v) (*(u32x4*)(p)=(v))
#endif
template<int THRL> __device__ __forceinline__ void attn_unit(long qrow0,long kvrow0,int NT,int h,const bf16*Q,const bf16*__restrict__ K,const bf16*__restrict__ V,bf16*O,char*shm){
  int tid_l=threadIdx.x; asm volatile("":"+v"(tid_l)); const int tid=tid_l,lane=tid&63,r32=lane&31,hi=lane>>5; const int wid=__builtin_amdgcn_readfirstlane(tid>>6);
  const bf16*Qw=Q+(qrow0+wid*QBLK)*DM+h*D;
  const bf16*Kh=K+kvrow0*KVP+(h>>2)*D,*Vh=V+kvrow0*KVP+(h>>2)*D;
  const unsigned lds0=(unsigned)(uintptr_t)shm;
  float*wsf=(float*)(shm+LDS_WS)+wid*64;
  const bf16*ksrc=Kh+(long)lane*KVP+wid*8;
  const bf16*vsrc=Vh+(long)(16*(wid&3)+(lane>>2))*KVP+(wid>>2)*32+(lane&3)*8;
  const unsigned kdst=lds0+LDS_K+wid*1024, vdst=lds0+LDS_V+wid*1024;
  #define DMA_K(t,slot) glds16(ksrc+(long)(t)*KVBLK*KVP,(unsigned)__builtin_amdgcn_readfirstlane(kdst+(slot)))
  #define DMA_V(t,slot) glds16(vsrc+(long)(t)*KVBLK*KVP,(unsigned)__builtin_amdgcn_readfirstlane(vdst+(slot)))
  const int vb0=(int)(lds0+LDS_V)+((lane>>4)&1)*32+(lane&3)*8+(4*hi+((lane&15)>>2))*64;
  const char*Kbase=shm+LDS_K; bf16x8 kf[8];
  const lds_cptr shm3=(lds_cptr)shm; const lds_cptr kp0=shm3+LDS_K+hi*1024+r32*16; const lds_cptr vp0=shm3+LDS_V+((lane>>4)&1)*32+(lane&3)*8+(4*hi+((lane&15)>>2))*64;
  DMA_K(0,0);DMA_V(0,0);DMA_K(1,SLOTB);
  bf16x8 qr[4];
  #pragma unroll
  for(int d0=0;d0<4;++d0)qr[d0]=*reinterpret_cast<const bf16x8*>(&Qw[(long)r32*DM+d0*16+hi*8]);
  float mhat=0.f,l_reg=0.f;f32x16 o[2];o[0]=f32x16{};o[1]=f32x16{};f32x16 negm=f32x16{};asm volatile("":"+v"(negm));
  #define CMASK(P0,P1,t) do{}while(0)
  bool resc=false;
  #define START(P0,P1) do{ const float rm=rowmax(P0,P1); resc=false; \
    { const float dl=rm; mhat=fadd_s(mhat,dl); \
      _Pragma("unroll") for(int r=0;r<16;++r){P0[r]=fsub_s(P0[r],dl);P1[r]=fsub_s(P1[r],dl);} \
      _Pragma("unroll") for(int r=0;r<16;++r)negm[r]=-mhat; asm volatile("":"+v"(negm)); } \
    _Pragma("unroll") for(int r=0;r<16;++r)P0[r]=__builtin_amdgcn_exp2f(P0[r]); }while(0)
  #define RESC() do{ if(resc){ asm volatile("s_waitcnt lgkmcnt(0)":::"memory"); \
      _Pragma("unroll") for(int d_=0;d_<2;++d_) _Pragma("unroll") for(int r=0;r<16;++r)o[d_][r]*=wsf[crow(r,hi)]; } }while(0)
  f32x16 pA0,pA1,pB0,pB1;
  int sl_prev=0,sl_cur=0,sl_next=SLOTB;
  #define ROT() do{sl_prev=sl_cur;sl_cur=sl_next;sl_next=(sl_next==(NSLOT-1)*SLOTB)?0:sl_next+SLOTB;}while(0)
  DMA_K(2,2*SLOTB);
  WAIT_BAR(3);
  qkt(pA0,pA1,Kbase,qr,negm,r32,hi);asm volatile("s_nop 15\n\ts_nop 7":"+v"(pA0),"+v"(pA1));CMASK(pA0,pA1,0);
  START(pA0,pA1);
  _Pragma("unroll") for(int r=0;r<16;++r)pA1[r]=__builtin_amdgcn_exp2f(pA1[r]);
  WAIT_BAR(0);
  DMA_K(3,0);DMA_V(1,SLOTB);
  ROT();
  kload8(kf,kp0+sl_cur);
  WAIT_BAR(2);
  s16x4 vlo[8],vhi[8]; u32x4 pw0,pw1,pw2,pw3;
  #define PKW(P,B) cvtpk_s(P[B],P[B+1])
  #define PAF(k) __builtin_bit_cast(bf16x8,pw##k)
  #define VFR(i) (bf16x8){vlo[i][0],vlo[i][1],vlo[i][2],vlo[i][3],vhi[i][0],vhi[i][1],vhi[i][2],vhi[i][3]}
  #define PIN(x) asm volatile("":"+v"(x))
  #define MX3(a,b,c) __builtin_fmaxf(__builtin_fmaxf((a),(b)),(c))
  #define GAPA(MF,A0,A1,A2,A3,W0,W1,PW) do{ MF; sacc+=A0; sacc+=A1; sacc+=A2; sacc+=A3; PIN(sacc); W0; W1; PIN(PW); SBAR(); }while(0)
  #define EX(v) __builtin_amdgcn_exp2f(v)
  #define GAPB(MF,X,B) do{ MF; X[B]=EX(X[B]); X[B+1]=EX(X[B+1]); X[B+2]=EX(X[B+2]); X[B+3]=EX(X[B+3]); PIN(X); SBAR(); }while(0)
  #define VRD(i) do{ vlo[i]=vtr(vp_+(((i)>>2)*4096+((i)&3)*1024)); vhi[i]=vtr(vp_+(((i)>>2)*4096+((i)&3)*1024+512)); }while(0)
  #define KRD(G,j) do{ if(G){ kload2(kf,kp0+sl_next,j); SBAR(); } }while(0)
  #define STEP(C0,C1,P0,P1,t,GK,GV,GL) do{ SBAR(); \
    const lds_cptr vp_=vp0+sl_prev; \
    VRD(0); SBAR(); float sacc=(P0[0]+P0[1]); \
    GAPA(C0=__builtin_amdgcn_mfma_f32_32x32x16_bf16(kf[0],qr[0],negm,0,0,0), P0[2],P0[3],P0[4],P0[5],     pw0[0]=PKW(P0,0), pw0[1]=PKW(P0,2), pw0); \
    VRD(4); SBAR(); GAPA(C1=__builtin_amdgcn_mfma_f32_32x32x16_bf16(kf[1],qr[0],negm,0,0,0), P0[6],P0[7],P0[8],P0[9],     pw0[2]=PKW(P0,4), pw0[3]=PKW(P0,6), pw0); \
    VRD(1); SBAR(); GAPA(C0=__builtin_amdgcn_mfma_f32_32x32x16_bf16(kf[2],qr[1],C0,0,0,0),   P0[10],P0[11],P0[12],P0[13], pw1[0]=PKW(P0,8), pw1[1]=PKW(P0,10), pw1); \
    VRD(5); SBAR(); GAPA(C1=__builtin_amdgcn_mfma_f32_32x32x16_bf16(kf[3],qr[1],C1,0,0,0),   P0[14],P0[15],P1[0],P1[1],   pw1[2]=PKW(P0,12),pw1[3]=PKW(P0,14), pw1); \
    VRD(2); SBAR(); GAPA(C0=__builtin_amdgcn_mfma_f32_32x32x16_bf16(kf[4],qr[2],C0,0,0,0),   P1[2],P1[3],P1[4],P1[5],     pw2[0]=PKW(P1,0), pw2[1]=PKW(P1,2), pw2); \
    VRD(6); SBAR(); GAPA(C1=__builtin_amdgcn_mfma_f32_32x32x16_bf16(kf[5],qr[2],C1,0,0,0),   P1[6],P1[7],P1[8],P1[9],     pw2[2]=PKW(P1,4), pw2[3]=PKW(P1,6), pw2); \
    VRD(3); SBAR(); GAPA(C0=__builtin_amdgcn_mfma_f32_32x32x16_bf16(kf[6],qr[3],C0,0,0,0),   P1[10],P1[11],P1[12],P1[13], pw3[0]=PKW(P1,8), pw3[1]=PKW(P1,10), pw3); \
    VRD(7); SBAR(); GAPA(C1=__builtin_amdgcn_mfma_f32_32x32x16_bf16(kf[7],qr[3],C1,0,0,0),   P1[14],P1[15],0.f,0.f,       pw3[2]=PKW(P1,12),pw3[3]=PKW(P1,14), pw3); \
    l_reg+=sacc; \
    if(GK){DMA_K((t)+3,sl_cur);} if(GV){DMA_V((t)+1,sl_next);} \
    CMASK(C0,C1,t); \
    { float a=MX3(C0[0],C0[1],C1[0]),b=MX3(C0[2],C0[3],C1[1]); a=MX3(a,C1[2],C1[3]); \
      _Pragma("unroll") for(int r=4;r<16;r+=4){a=MX3(a,C0[r],C0[r+1]);b=MX3(b,C0[r+2],C0[r+3]);a=MX3(a,C1[r],C1[r+1]);b=MX3(b,C1[r+2],C1[r+3]);} \
      float rm=__builtin_fmaxf(a,b); { auto rr=__builtin_amdgcn_permlane32_swap(__float_as_uint(rm),__float_as_uint(rm),false,false); rm=__builtin_fmaxf(__uint_as_float(rr[0]),__uint_as_float(rr[1])); } \
      resc=false; \
      if(__builtin_expect(__any(rm>(float)THRL),0)){ const float dl=__builtin_fmaxf(rm,0.f); mhat+=dl; \
        _Pragma("unroll") for(int r=0;r<16;++r){C0[r]-=dl;C1[r]-=dl;} \
        _Pragma("unroll") for(int r=0;r<16;++r)negm[r]=-mhat; asm volatile("":"+v"(negm)); \
        const float f=__builtin_amdgcn_exp2f(-dl); l_reg*=f; if(hi==0)wsf[r32]=f; resc=true; } } \
    SBAR(); \
    GAPB(o[0]=__builtin_amdgcn_mfma_f32_32x32x16_bf16(PAF(0),VFR(0),o[0],0,0,0), C0,0); \
    GAPB(o[1]=__builtin_amdgcn_mfma_f32_32x32x16_bf16(PAF(0),VFR(4),o[1],0,0,0), C0,4); \
    KRD(GL,0); GAPB(o[0]=__builtin_amdgcn_mfma_f32_32x32x16_bf16(PAF(1),VFR(1),o[0],0,0,0), C0,8); \
    KRD(GL,1); GAPB(o[1]=__builtin_amdgcn_mfma_f32_32x32x16_bf16(PAF(1),VFR(5),o[1],0,0,0), C0,12); \
    KRD(GL,2); GAPB(o[0]=__builtin_amdgcn_mfma_f32_32x32x16_bf16(PAF(2),VFR(2),o[0],0,0,0), C1,0); \
    KRD(GL,3); GAPB(o[1]=__builtin_amdgcn_mfma_f32_32x32x16_bf16(PAF(2),VFR(6),o[1],0,0,0), C1,4); \
    GAPB(o[0]=__builtin_amdgcn_mfma_f32_32x32x16_bf16(PAF(3),VFR(3),o[0],0,0,0), C1,8); \
    GAPB(o[1]=__builtin_amdgcn_mfma_f32_32x32x16_bf16(PAF(3),VFR(7),o[1],0,0,0), C1,12); \
    }while(0)
  int t=1;
  #undef CMASK
  #define CMASK(P0,P1,t) do{}while(0)
  for(;t+5<NT;t+=2){
    STEP(pB0,pB1,pA0,pA1,t,true,true,true);     WAIT_BAR(2); RESC(); ROT();
    STEP(pA0,pA1,pB0,pB1,t+1,true,true,true);   WAIT_BAR(2); RESC(); ROT();
  }
  #undef CMASK
  #define CMASK(P0,P1,t) do{}while(0)
  #define ENDW(tt) do{ if((tt)+3<NT){WAIT_BAR(2);} else if((tt)+2<NT){WAIT_BAR(1);} else {WAIT_BAR(0);} }while(0)
  for(;t+1<NT;t+=2){
    STEP(pB0,pB1,pA0,pA1,t,(t+3<NT),(t+1<NT),(t+1<NT));       ENDW(t);   RESC(); ROT();
    STEP(pA0,pA1,pB0,pB1,t+1,(t+4<NT),(t+2<NT),(t+2<NT));     ENDW(t+1); RESC(); ROT();
  }
  STEP(pB0,pB1,pA0,pA1,NT-1,false,false,false); RESC();
  { float sacc=pB0[0]+pB0[1]; _Pragma("unroll") for(int r=2;r<16;++r)sacc+=pB0[r]; _Pragma("unroll") for(int r=0;r<16;++r)sacc+=pB1[r]; l_reg+=sacc;
    pw0=(u32x4){PKW(pB0,0),PKW(pB0,2),PKW(pB0,4),PKW(pB0,6)};pw1=(u32x4){PKW(pB0,8),PKW(pB0,10),PKW(pB0,12),PKW(pB0,14)};pw2=(u32x4){PKW(pB1,0),PKW(pB1,2),PKW(pB1,4),PKW(pB1,6)};pw3=(u32x4){PKW(pB1,8),PKW(pB1,10),PKW(pB1,12),PKW(pB1,14)};
    SBAR(); pv(o,vb0+sl_cur,PAF(0),PAF(1),PAF(2),PAF(3)); }
  #undef PKW
  #undef PAF
  #undef VFR
  #undef PIN
  #undef MX3
  #undef GAPA
  #undef GAPB
  #undef EX
  #undef VRD
  #undef KRD
  #undef STEP
  #undef ENDW
  {auto rr=__builtin_amdgcn_permlane32_swap(__float_as_uint(l_reg),__float_as_uint(l_reg),false,false);l_reg=__uint_as_float(rr[0])+__uint_as_float(rr[1]);}
  if(hi==0)wsf[32+r32]=l_reg;asm volatile("s_waitcnt lgkmcnt(0)":::"memory");
  float rli[16];
  #pragma unroll
  for(int r=0;r<16;++r)rli[r]=__builtin_amdgcn_rcpf(wsf[32+crow(r,hi)]);
  bf16*Ow=O+(qrow0+wid*QBLK)*DM+h*D;
  { bf16*stg=(bf16*)(shm+LDS_OST)+wid*2048;
    #pragma unroll
    for(int r=0;r<16;++r){const int orow=crow(r,hi);
      #pragma unroll
      for(int d0=0;d0<2;++d0)stg[orow*64+d0*32+r32]=__float2bfloat16(o[d0][r]*rli[r]);}
    asm volatile("s_waitcnt lgkmcnt(0)":::"memory");
    #pragma unroll
    for(int i=0;i<4;++i){const int row=i*8+(lane>>3),ch=lane&7; const u32x4 v=*(const u32x4*)(stg+row*64+ch*8); ATTN_STORE16(Ow+(long)row*DM+ch*8,v);} }
  asm volatile("s_waitcnt lgkmcnt(0)\n\ts_barrier":::"memory");
  #undef DMA_K
  #undef DMA_V
  #undef CMASK
  #undef START
  #undef RESC
  #undef ROT
}
constexpr int ATTN_LDS_BYTES=LDS_BYTES;
#undef SBAR
#undef WAIT_BAR
}

constexpr int NWAVES = 8;
constexpr int NB = 8, SEQ = 4096, CTXL = 256, TB = SEQ + CTXL  , MT = NB * TB  , DMODEL = 1024;
constexpr int NMODC = 6 * DMODEL, MODROWS = 9;
constexpr int QKVN = 1536, WINN = 3104, WINP = 3328;
constexpr int NEXP = 32, TOPK = 4, MPAD = MT * TOPK + NEXP * 256;
constexpr int NLAYER = 4;
constexpr float RMS_EPS = 1e-6f;
constexpr float ATT_C2 = 0.125f * 1.4426950408889634f;

constexpr size_t MiB = 1u << 20;
constexpr size_t WS_CTL = 0, CTL_ZERO_BYTES = 1 * MiB;
constexpr size_t WS_MOD = 1 * MiB, WS_ROPE = 2 * MiB, WS_MODP = 3 * MiB;
constexpr size_t WS_SLOT = 17 * MiB, WS_GATEW = 18 * MiB, WS_SLOTPOS = 19 * MiB;
constexpr size_t WS_WQKV = 20 * MiB, WS_WOA = 26 * MiB, WS_WIN = 30 * MiB, WS_WOG = 43 * MiB, WS_WGU = 48 * MiB, WS_WDN = 560 * MiB;
constexpr size_t WS_X = 816 * MiB, WS_XN = 952 * MiB, WS_Q = 1020 * MiB, WS_K = 1088 * MiB, WS_V = 1105 * MiB, WS_G = 1122 * MiB;
constexpr size_t WS_OF = 1343 * MiB, WS_OB = 1479 * MiB, WS_XG = 1615 * MiB, WS_ACT = 1903 * MiB, WS_Y = 2191 * MiB, WS_PAR = 2479 * MiB, WS_END = 2483 * MiB;
static_assert(WS_MODP + (size_t)16 * NLAYER * MODROWS * NMODC * 4 <= WS_SLOT && WS_WIN + (size_t)2 * WINP * 1024 * 2 <= WS_WOG && WS_G + (size_t)MT * WINP * 2 <= WS_OF && WS_XG + (size_t)MPAD * 1024 * 2 <= WS_ACT, "ws map");
constexpr int CW_TMO = 0, CW_BAR = 4096, CW_CNT = 16384;

constexpr int RING_OFF = 0, RING_BYTES = 131072;
constexpr int WR_STRIDE = 1028;
constexpr int LDS_AUX = 131584;
constexpr int AUX_LCNT = LDS_AUX, AUX_GB = LDS_AUX + 128, AUX_T2E = LDS_AUX + 256  , AUX_BASE = AUX_T2E + 2560  , AUX_NT = AUX_BASE + 128, AUX_ENT = AUX_NT + 64  ;
constexpr int MISC_OFF = 154624;
constexpr int LDS_BYTES = 155648;
static_assert(AUX_ENT + 4352 <= MISC_OFF && 32 * WR_STRIDE * 4 <= LDS_AUX, "LDS map");

#define GAS __attribute__((address_space(1)))
#define LAS __attribute__((address_space(3)))
typedef unsigned short bf16;
typedef unsigned v4u __attribute__((ext_vector_type(4)));
typedef float f32x4 __attribute__((ext_vector_type(4)));
typedef short bf16x8 __attribute__((ext_vector_type(8)));
typedef GAS unsigned gu32;
typedef GAS unsigned long long gu64;
#define RLX_AGENT __ATOMIC_RELAXED, __HIP_MEMORY_SCOPE_AGENT
#define LDS_WAIT() asm volatile("s_waitcnt lgkmcnt(0)" ::: "memory")
#define VM_WAIT() asm volatile("s_waitcnt vmcnt(0)" ::: "memory")
__device__ __forceinline__ unsigned long long rt() { return __builtin_amdgcn_s_memrealtime(); }
__device__ __forceinline__ unsigned f2bf(float f) { unsigned u = __builtin_bit_cast(unsigned, f); return (u + 0x7fffu + ((u >> 16) & 1u)) >> 16; }
__device__ __forceinline__ unsigned pk2(float lo, float hi) { return f2bf(lo) | (f2bf(hi) << 16); }

#define XB_TMO      128
#define XB_XCNT(j)  (256  + 64 * (j))
#define XB_XSUB(j)  (1280 + 64 * (j))
#define XB_XGEN(j)  (2304 + 64 * (j))
#define XB_TOP      3328
#define XB_TOPGEN   3392
#define XCD_BAR_WORDS 3456
#define XB_SPIN_CAP (1u << 18)

__device__ __forceinline__ unsigned xb_ld(unsigned* p)              { return __hip_atomic_load(p, __ATOMIC_RELAXED, __HIP_MEMORY_SCOPE_AGENT); }
__device__ __forceinline__ unsigned xb_add(unsigned* p, unsigned v) { return __hip_atomic_fetch_add(p, v, __ATOMIC_RELAXED, __HIP_MEMORY_SCOPE_AGENT); }
__device__ __forceinline__ unsigned xb_xcc_id() { return (unsigned)__builtin_amdgcn_s_getreg((3 << 11) | 20) & 0xFu; }
#define XB_SPIN(cond, bar) do { unsigned _sp = 0; while (cond) { __builtin_amdgcn_s_sleep(1); \
    if ((++_sp & 255u) == 0u) { if (xb_ld(&(bar)[XB_TMO])) break; if (_sp > XB_SPIN_CAP) { atomicAdd(&(bar)[XB_TMO], 1u); break; } } } } while (0)

struct XcdBarrier {
    unsigned* bar; unsigned x;
    volatile LAS unsigned* st;
};

__device__ __forceinline__ XcdBarrier xcd_barrier_post(unsigned* bar, volatile LAS unsigned* st) {
    XcdBarrier b; b.bar = bar; b.x = xb_xcc_id(); b.st = st;
    if (threadIdx.x == 0) (void)xb_add(&bar[XB_XCNT(b.x)], 1u);
    return b;
}
__device__ __forceinline__ void xcd_barrier_complete(unsigned* bar, unsigned x, unsigned& nloc, unsigned& nx) {
    const unsigned G = gridDim.x * gridDim.y * gridDim.z;
    unsigned sum, cnt, mine, sp = 0u;
    for (;;) {
        sum = 0u; cnt = 0u; mine = 0u;
#pragma unroll
        for (unsigned j = 0; j < 16; ++j) { const unsigned c = xb_ld(&bar[XB_XCNT(j)]); sum += c; cnt += (c > 0u) ? 1u : 0u; mine = (j == x) ? c : mine; }
        if (sum == G) break;
        __builtin_amdgcn_s_sleep(1);
        if ((++sp & 255u) == 0u) { if (xb_ld(&bar[XB_TMO])) break; if (sp > XB_SPIN_CAP) { atomicAdd(&bar[XB_TMO], 1u); break; } }
    }
    nloc = mine > 0u ? mine : 1u; nx = cnt > 0u ? cnt : 1u;
}

__device__ __forceinline__ void xcd_barrier(const XcdBarrier& b) {
    asm volatile("s_waitcnt vmcnt(0)" ::: "memory");
    __syncthreads();
    if (threadIdx.x == 0) {
        unsigned* bar = b.bar;
        __builtin_amdgcn_s_waitcnt(0);
        unsigned nloc = b.st[0], nx = b.st[1];
        if (nloc == 0u) { xcd_barrier_complete(bar, b.x, nloc, nx); b.st[0] = nloc; b.st[1] = nx; }
        const unsigned old = xb_add(&bar[XB_XSUB(b.x)], 1u);
        const unsigned gen = old / nloc;
        if (old + 1u == (gen + 1u) * nloc) {
            __builtin_amdgcn_fence(__ATOMIC_RELEASE, "agent");
            asm volatile("s_waitcnt vmcnt(0)" ::: "memory");
            const unsigned og = xb_add(&bar[XB_TOP], 1u);
            const unsigned tg = og / nx;
            if (og + 1u == (tg + 1u) * nx) xb_add(&bar[XB_TOPGEN], 1u);
            else XB_SPIN(xb_ld(&bar[XB_TOPGEN]) == tg, bar);
            __builtin_amdgcn_fence(__ATOMIC_ACQUIRE, "agent");
            xb_add(&bar[XB_XGEN(b.x)], 1u);
            asm volatile("s_waitcnt vmcnt(0)" ::: "memory");
        } else {
            XB_SPIN(xb_ld(&bar[XB_XGEN(b.x)]) == gen, bar);
            __builtin_amdgcn_fence(__ATOMIC_ACQUIRE, "agent");
            asm volatile("s_waitcnt vmcnt(0)" ::: "memory");
        }
    }
    __syncthreads();
}

typedef float f32x2 __attribute__((ext_vector_type(2)));
__device__ __forceinline__ float wave_sum(float v) {
#pragma unroll
    for (int o = 1; o < 64; o <<= 1) v += __shfl_xor(v, o);
    return v;
}
__device__ __forceinline__ float wave_max(float v) {
#pragma unroll
    for (int o = 1; o < 64; o <<= 1) v = fmaxf(v, __shfl_xor(v, o));
    return v;
}
__device__ __forceinline__ float bf2f(unsigned short h) { return __uint_as_float((unsigned)h << 16); }
__device__ __forceinline__ float silu_f(float x) { return x / (1.0f + __expf(-x)); }
__device__ __forceinline__ int mod_row(int m) { const int b = m / TB; return (m - b * TB < CTXL) ? 8 : b; }

__device__ __forceinline__ void transpose_item(const float* W, int K, int N, bf16* WT, int k0, int n0, int dst_row0, LAS float* scr, int lane) {
#pragma unroll 8
    for (int i = 0; i < 32; ++i) { const int kk = 2 * i + (lane >> 5); scr[kk * 33 + (lane & 31)] = W[(size_t)(k0 + kk) * N + n0 + (lane & 31)]; }
    LDS_WAIT(); asm volatile("" ::: "memory");
    const int c = lane & 7;
#pragma unroll
    for (int j = 0; j < 4; ++j) { const int n = (lane >> 3) + 8 * j; const LAS float* s = scr + (8 * c) * 33 + n;
        v4u o; o.x = pk2(s[0 * 33], s[1 * 33]); o.y = pk2(s[2 * 33], s[3 * 33]); o.z = pk2(s[4 * 33], s[5 * 33]); o.w = pk2(s[6 * 33], s[7 * 33]);
        *(GAS v4u*)(WT + (size_t)(dst_row0 + n) * K + k0 + 8 * c) = o; }
    LDS_WAIT(); asm volatile("" ::: "memory");
}

struct Args { const float* in[25]; float* out; unsigned char* ws; int ph_lo, ph_hi; };
constexpr int P_N1G = 0, P_N2G = 4096, P_QG = 8192, P_KG = 8320, P_GKF = 8448, P_GKB = 24832, P_BGF = 41216, P_BGB = 42240, P_OG = 43264, P_WR = 43776, P_BR = 174848, P_BGU = 174976, P_BDN = 437120, P_END = 568192;
#define LAUNDER_S(p) asm volatile("" : "+s"(p))
#define LAUNDER_V(p) asm volatile("" : "+v"(p))
#define PARF(ws) ((const float*)((ws) + WS_PAR))

__device__ __forceinline__ void p0_prologue(const Args& A, LAS unsigned char* lds, int gw, int NGW, int wave, int lane) {
    unsigned char* ws = A.ws;
    LAS float* scr = (LAS float*)(lds + RING_OFF + wave * 16384);
    constexpr int I_QKV = 2 * 16 * (QKVN / 32), I_WO = 2 * 16 * 32, I_WIN = 2 * 16 * (WINN / 32), I_GU = 128 * 16 * 64, I_DN = 128 * 16 * 32;
    constexpr int NITEMS = I_GU + I_DN + I_QKV + I_WO + I_WIN + I_WO;
    for (int it = gw; it < NITEMS; it += NGW) {
        int r = it;
        if (r < I_GU) { const int mat = r / (16 * 64), q = r - mat * (16 * 64), kb = q / 64, nb = q - kb * 64, n0 = nb * 32;
            const int dst = ((n0 & 1023) >> 7) * 256 + (n0 >> 10) * 128 + (n0 & 127);
            transpose_item(A.in[21] + (size_t)mat * 1024 * 2048, 1024, 2048, (bf16*)(ws + WS_WGU) + (size_t)mat * 2048 * 1024, kb * 64, n0, dst, scr, lane); continue; } r -= I_GU;
        if (r < I_DN) { const int mat = r / (16 * 32), q = r - mat * (16 * 32), kb = q / 32, nb = q - kb * 32;
            transpose_item(A.in[23] + (size_t)mat * 1024 * 1024, 1024, 1024, (bf16*)(ws + WS_WDN) + (size_t)mat * 1024 * 1024, kb * 64, nb * 32, nb * 32, scr, lane); continue; } r -= I_DN;
        if (r < I_QKV) { const int per = 16 * (QKVN / 32), mat = r / per, q = r - mat * per, kb = q / (QKVN / 32), nb = q - kb * (QKVN / 32);
            transpose_item(A.in[8] + (size_t)mat * 1024 * QKVN, 1024, QKVN, (bf16*)(ws + WS_WQKV) + (size_t)mat * QKVN * 1024, kb * 64, nb * 32, nb * 32, scr, lane); continue; } r -= I_QKV;
        if (r < I_WO) { const int mat = r / 512, q = r - mat * 512, kb = q / 32, nb = q - kb * 32;
            transpose_item(A.in[11] + (size_t)mat * 1024 * 1024, 1024, 1024, (bf16*)(ws + WS_WOA) + (size_t)mat * 1024 * 1024, kb * 64, nb * 32, nb * 32, scr, lane); continue; } r -= I_WO;
        if (r < I_WIN) { const int per = 16 * (WINN / 32), mat = r / per, q = r - mat * per, kb = q / (WINN / 32), nb = q - kb * (WINN / 32);
            transpose_item(A.in[12] + (size_t)mat * 1024 * WINN, 1024, WINN, (bf16*)(ws + WS_WIN) + (size_t)mat * WINP * 1024, kb * 64, nb * 32, nb * 32, scr, lane); continue; } r -= I_WIN;
        { const int mat = r / 512, q = r - mat * 512, kb = q / 32, nb = q - kb * 32;
            transpose_item(A.in[18] + (size_t)mat * 1024 * 1024, 1024, 1024, (bf16*)(ws + WS_WOG) + (size_t)mat * 1024 * 1024, kb * 64, nb * 32, nb * 32, scr, lane); }
    }
    for (int it = gw; it < 2 * (WINP - WINN); it += NGW) { const int mat = it / (WINP - WINN), rr = WINN + it - mat * (WINP - WINN);
        GAS v4u* p = (GAS v4u*)((bf16*)(ws + WS_WIN) + ((size_t)mat * WINP + rr) * 1024) + lane; p[0] = (v4u){0u, 0u, 0u, 0u}; p[64] = (v4u){0u, 0u, 0u, 0u}; }
    for (int it = gw; it < NLAYER * 24 * 16; it += NGW) {
        const int l = it / (24 * 16), q = it - l * (24 * 16), cg = q / 16, kc = q - cg * 16;
        float s[MODROWS];
#pragma unroll
        for (int r = 0; r < MODROWS; ++r) { const float cv = (r < 8) ? A.in[1][r * 1024 + kc * 64 + lane] : A.in[3][kc * 64 + lane]; s[r] = silu_f(cv); }
        f32x4 acc[MODROWS];
#pragma unroll
        for (int r = 0; r < MODROWS; ++r) acc[r] = (f32x4){0.f, 0.f, 0.f, 0.f};
        const float* wp = A.in[4] + ((size_t)l * 1024 + kc * 64) * NMODC + cg * 256 + 4 * lane;
#pragma unroll 4
        for (int kk = 0; kk < 64; ++kk) { const f32x4 w = *(const f32x4*)(wp + (size_t)kk * NMODC);
#pragma unroll
            for (int r = 0; r < MODROWS; ++r) { const float sv = __shfl(s[r], kk); acc[r] = acc[r] + w * sv; } }
        float* op = (float*)(ws + WS_MODP) + (size_t)kc * (NLAYER * MODROWS * NMODC) + (size_t)l * MODROWS * NMODC + cg * 256 + 4 * lane;
#pragma unroll
        for (int r = 0; r < MODROWS; ++r) *(f32x4*)(op + (size_t)r * NMODC) = acc[r];
    }
    for (int m = gw; m < MT; m += NGW) { const int b = m / TB, w = m - b * TB;
        const float* src = (w < CTXL) ? A.in[2] + ((size_t)b * CTXL + w) * 1024 : A.in[0] + ((size_t)b * SEQ + (w - CTXL)) * 1024;
        const GAS f32x4* sp = (const GAS f32x4*)src + lane; GAS f32x4* dp = (GAS f32x4*)((float*)(ws + WS_X) + (size_t)m * 1024) + lane;
#pragma unroll
        for (int j = 0; j < 4; ++j) dp[64 * j] = sp[64 * j]; }
    { float* par = (float*)(ws + WS_PAR); const int gt = gw * 64 + lane, NGT = NGW * 64;
#define CPY(src, n, off) for (int i = gt; i < (n); i += NGT) par[(off) + i] = A.in[src][i];
      CPY(6, 4096, P_N1G) CPY(7, 4096, P_N2G) CPY(9, 128, P_QG) CPY(10, 128, P_KG) CPY(13, 16384, P_GKF) CPY(15, 16384, P_GKB) CPY(14, 1024, P_BGF) CPY(16, 1024, P_BGB)
      CPY(17, 512, P_OG) CPY(19, 131072, P_WR) CPY(20, 128, P_BR) CPY(22, 262144, P_BGU) CPY(24, 131072, P_BDN)
#undef CPY
    }
    for (int idx = gw * 64 + lane; idx < SEQ * 32; idx += NGW * 64) { const int s = idx >> 5, i = idx & 31;
        const float invf = 1.0f / powf(10000.0f, (float)(i & 15) * (1.0f / 16.0f));
        const float ang = (float)((i < 16) ? (s >> 6) : (s & 63)) * invf;
        ((float*)(ws + WS_ROPE))[idx] = cosf(ang); ((float*)(ws + WS_ROPE))[SEQ * 32 + idx] = sinf(ang); }
}
__device__ __forceinline__ void p1_mod_reduce(const Args& A, int gtid, int NGT) {
    const float* P = (const float*)(A.ws + WS_MODP); float* Mo = (float*)(A.ws + WS_MOD);
    constexpr int N = NLAYER * MODROWS * NMODC;
    for (int i = gtid; i < N; i += NGT) { const int l = i / (MODROWS * NMODC), c = i % NMODC; float s = A.in[5][l * NMODC + c];
#pragma unroll
        for (int k = 0; k < 16; ++k) s += P[(size_t)k * N + i];
        Mo[i] = s; }
}
__device__ __forceinline__ void modulate_row(const float* xrow, const float* ng, const float* shp, const float* scp, bf16* orow, int lane, f32x4 (&y)[4]) {
    const GAS f32x4* xr = (const GAS f32x4*)xrow + lane;
    float ss = 0.f;
#pragma unroll
    for (int j = 0; j < 4; ++j) { y[j] = xr[64 * j]; ss += (y[j].x * y[j].x + y[j].y * y[j].y) + (y[j].z * y[j].z + y[j].w * y[j].w); }
    const float rs = 1.0f / sqrtf(wave_sum(ss) * (1.0f / 1024.0f) + RMS_EPS);
    GAS unsigned long long* o8 = (GAS unsigned long long*)orow + lane;
#pragma unroll
    for (int j = 0; j < 4; ++j) { const f32x4 g = ((const GAS f32x4*)ng)[64 * j + lane], sh = ((const GAS f32x4*)shp)[64 * j + lane], sc = ((const GAS f32x4*)scp)[64 * j + lane];
        y[j] = (y[j] * rs) * g * (sc + 1.0f) + sh;
        o8[64 * j] = (unsigned long long)pk2(y[j].x, y[j].y) | ((unsigned long long)pk2(y[j].z, y[j].w) << 32); }
}
__device__ __forceinline__ void phase_modulate1(unsigned char* ws, int layer, int gw, int NGW, int lane) {
    const float* X = (const float*)(ws + WS_X); bf16* XN = (bf16*)(ws + WS_XN);
    const float* ng = PARF(ws) + P_N1G + layer * 1024; const float* Mo = (const float*)(ws + WS_MOD) + (size_t)layer * MODROWS * NMODC;
    for (int m = gw; m < MT; m += NGW) { const int mr = mod_row(m); f32x4 y[4];
        modulate_row(X + (size_t)m * 1024, ng, Mo + (size_t)mr * NMODC + 0 * 1024, Mo + (size_t)mr * NMODC + 1 * 1024, XN + (size_t)m * 1024, lane, y); }
}
__device__ __forceinline__ void phase_qknorm_rope(unsigned char* ws, int la, int gw, int NGW, int lane) {
    bf16* Qb = (bf16*)(ws + WS_Q); bf16* Kb = (bf16*)(ws + WS_K);
    const float* qg = PARF(ws) + P_QG + la * 64; const float* kg = PARF(ws) + P_KG + la * 64; const float* ropec = (const float*)(ws + WS_ROPE); const float* ropes = ropec + SEQ * 32;
    const int i = lane & 31, hs = lane >> 5;
    for (int m = gw; m < MT; m += NGW) { const int b = m / TB, w = m - b * TB; const bool lat = w >= CTXL;
        float cs = 1.f, sn = 0.f; if (lat) { cs = ropec[(w - CTXL) * 32 + i]; sn = ropes[(w - CTXL) * 32 + i]; }
#pragma unroll 2
        for (int hh = 0; hh < 20; hh += 2) { const int hd = hh + hs;
            unsigned* p = (hd < 16) ? (unsigned*)(Qb + (size_t)m * 1024 + hd * 64) + i : (unsigned*)(Kb + (size_t)m * 256 + (hd - 16) * 64) + i;
            const float* gp = (hd < 16) ? qg : kg; const float scl = (hd < 16) ? ATT_C2 : 1.0f;
            const unsigned v = *p; const float x1 = __uint_as_float(v << 16), x2 = __uint_as_float(v & 0xffff0000u);
            float ss = x1 * x1 + x2 * x2;
#pragma unroll
            for (int o = 1; o < 32; o <<= 1) ss += __shfl_xor(ss, o);
            const float rs = 1.0f / sqrtf(ss * (1.0f / 64.0f) + RMS_EPS);
            const float y1 = x1 * rs * gp[2 * i], y2 = x2 * rs * gp[2 * i + 1];
            const float r1 = (y1 * cs - y2 * sn) * scl, r2 = (y1 * sn + y2 * cs) * scl;
            *p = pk2(r1, r2); }
    }
}
__device__ __forceinline__ void phase_gla_recurrent(unsigned char* ws, int lg, LAS unsigned char* lds, int tid) {
    const int unit = blockIdx.x; if (unit >= 128) return;
    const int half = unit & 1, dir = (unit >> 1) & 1, h = (unit >> 2) & 3, b = unit >> 4;
    const bf16* G = (const bf16*)(ws + WS_G);
    float* Oo = (float*)(ws + (dir ? WS_OB : WS_OF));
    const float* wg = PARF(ws) + (dir ? P_GKB : P_GKF) + (size_t)lg * 16 * 512; const float* bg = PARF(ws) + (dir ? P_BGB : P_BGF) + lg * 512;
    LAS float* qq = (LAS float*)(lds + RING_OFF); LAS float* kk = qq + 64 * 128; LAS float* dd = kk + 64 * 128; LAS float* vv = dd + 64 * 128;
    const int sd = tid & 127, st0 = tid >> 7;
    float wcol[16];
#pragma unroll
    for (int r = 0; r < 16; ++r) wcol[r] = wg[r * 512 + h * 128 + sd];
    const float bcol = bg[h * 128 + sd];
    const int c = tid >> 2, dq = tid & 3;
    float s[32];
#pragma unroll
    for (int j = 0; j < 32; ++j) s[j] = 0.f;
    const float qscale = 0.08838834764831845f;
    for (int ch = 0; ch < TB / 64; ++ch) {
        __syncthreads();
#pragma unroll 4
        for (int i = 0; i < 16; ++i) { const int tt = st0 + 4 * i, n = 64 * ch + tt;
            const int w = dir ? (n < CTXL ? (CTXL - 1 - n) : (TB + CTXL - 1 - n)) : n;
            const bf16* gr = G + ((size_t)b * TB + w) * WINP;
            const float qv = bf2f(gr[h * 128 + sd]) * qscale, kv = bf2f(gr[512 + h * 128 + sd]);
            const bf16* lp = gr + 3072 + dir * 16; float z = bcol;
#pragma unroll
            for (int r = 0; r < 16; ++r) z += bf2f(lp[r]) * wcol[r];
            const float ls = fminf(z, 0.f) - log1pf(__expf(-fabsf(z)));
            qq[tt * 128 + sd] = qv; kk[tt * 128 + sd] = kv; dd[tt * 128 + sd] = __expf(ls * (1.0f / 16.0f));
            vv[tt * 128 + sd] = bf2f(gr[1024 + h * 256 + half * 128 + sd]); }
        __syncthreads();
        for (int tt = 0; tt < 64; ++tt) { const int n = 64 * ch + tt; const int w = dir ? (n < CTXL ? (CTXL - 1 - n) : (TB + CTXL - 1 - n)) : n;
            const float v = vv[tt * 128 + c]; float acc = 0.f;
            const LAS f32x4* q4 = (const LAS f32x4*)(qq + tt * 128 + dq * 32); const LAS f32x4* k4 = (const LAS f32x4*)(kk + tt * 128 + dq * 32); const LAS f32x4* d4 = (const LAS f32x4*)(dd + tt * 128 + dq * 32);
#pragma unroll
            for (int j = 0; j < 8; ++j) { const f32x4 qv = q4[j], kv = k4[j], dv = d4[j];
                s[4 * j + 0] = s[4 * j + 0] * dv.x + kv.x * v; acc += qv.x * s[4 * j + 0];
                s[4 * j + 1] = s[4 * j + 1] * dv.y + kv.y * v; acc += qv.y * s[4 * j + 1];
                s[4 * j + 2] = s[4 * j + 2] * dv.z + kv.z * v; acc += qv.z * s[4 * j + 2];
                s[4 * j + 3] = s[4 * j + 3] * dv.w + kv.w * v; acc += qv.w * s[4 * j + 3]; }
            acc += __shfl_xor(acc, 1); acc += __shfl_xor(acc, 2);
            if (dq == 0) Oo[((size_t)b * TB + w) * 1024 + h * 256 + half * 128 + c] = acc; }
    }
}
__device__ __forceinline__ void phase_gla_readout(unsigned char* ws, int lg, int gw, int NGW, int lane) {
    const float* OF = (const float*)(ws + WS_OF); const float* OB = (const float*)(ws + WS_OB); const bf16* G = (const bf16*)(ws + WS_G); bf16* OG = (bf16*)(ws + WS_Q);
    const f32x4 og = ((const GAS f32x4*)(PARF(ws) + P_OG + lg * 256))[lane];
    for (int m = gw; m < MT; m += NGW) {
#pragma unroll
        for (int hh = 0; hh < 4; ++hh) { const size_t off = (size_t)m * 1024 + hh * 256 + 4 * lane;
            f32x4 o = *(const GAS f32x4*)(OF + off) + *(const GAS f32x4*)(OB + off);
            const float ss = wave_sum((o.x * o.x + o.y * o.y) + (o.z * o.z + o.w * o.w));
            const float rs = 1.0f / sqrtf(ss * (1.0f / 256.0f) + RMS_EPS);
            const unsigned long long rv = *(const GAS unsigned long long*)(G + (size_t)m * WINP + 2048 + hh * 256 + 4 * lane);
            const float r0 = __uint_as_float((unsigned)(rv & 0xffffu) << 16), r1 = __uint_as_float((unsigned)(rv >> 16) << 16), r2 = __uint_as_float((unsigned)((rv >> 32) & 0xffffu) << 16), r3 = __uint_as_float((unsigned)(rv >> 48) << 16);
            o = o * rs * og;
            o.x *= silu_f(r0); o.y *= silu_f(r1); o.z *= silu_f(r2); o.w *= silu_f(r3);
            *(GAS unsigned long long*)(OG + off) = (unsigned long long)pk2(o.x, o.y) | ((unsigned long long)pk2(o.z, o.w) << 32); }
    }
}
__device__ __forceinline__ void phase_modulate2_route(unsigned char* ws, int layer, LAS unsigned char* lds, int gw, int NGW, int wave, int lane, int tid) {
    const float* X = (const float*)(ws + WS_X); bf16* XN = (bf16*)(ws + WS_XN);
    const float* ng = PARF(ws) + P_N2G + layer * 1024; const float* Mo = (const float*)(ws + WS_MOD) + (size_t)layer * MODROWS * NMODC;
    LAS float* wr = (LAS float*)(lds + RING_OFF);
    LAS unsigned* lcnt = (LAS unsigned*)(lds + AUX_LCNT); LAS unsigned* gb = (LAS unsigned*)(lds + AUX_GB); LAS unsigned* ent = (LAS unsigned*)(lds + AUX_ENT) + wave * (17 * 4 * 2);
    { const float* wsrc = PARF(ws) + P_WR + (size_t)layer * 1024 * 32;
      for (int idx = tid; idx < 1024 * 32; idx += NWAVES * 64) { const int k = idx >> 5, e = idx & 31; wr[e * WR_STRIDE + k] = wsrc[idx]; }
      if (tid < 32) lcnt[tid] = 0u; }
    __syncthreads();
    const float brt = (PARF(ws) + P_BR)[layer * 32 + (lane >> 1)];
    gu32* cnt = (gu32*)(ws + WS_CTL) + CW_CNT + layer * 32 * 16;
    int ri = 0;
    for (int m = gw; m < MT; m += NGW, ++ri) { const int mr = mod_row(m); f32x4 y[4];
        modulate_row(X + (size_t)m * 1024, ng, Mo + (size_t)mr * NMODC + 3 * 1024, Mo + (size_t)mr * NMODC + 4 * 1024, XN + (size_t)m * 1024, lane, y);
        float p[32];
#pragma unroll
        for (int e = 0; e < 32; ++e) { float a = 0.f;
#pragma unroll
            for (int j = 0; j < 4; ++j) { const f32x4 w = *(const LAS f32x4*)(wr + e * WR_STRIDE + 256 * j + 4 * lane); a += (y[j].x * w.x + y[j].y * w.y) + (y[j].z * w.z + y[j].w * w.w); }
            p[e] = a; }
#define RED_STEP(H, BIT) _Pragma("unroll") for (int e = 0; e < H; ++e) { const bool up = (lane & BIT) != 0; const float keep = up ? p[e + H] : p[e], send = up ? p[e] : p[e + H]; p[e] = keep + __shfl_xor(send, BIT); }
        RED_STEP(16, 32) RED_STEP(8, 16) RED_STEP(4, 8) RED_STEP(2, 4) RED_STEP(1, 2)
#undef RED_STEP
        float lg = p[0] + __shfl_xor(p[0], 1) + brt;
        const int myexp = lane >> 1;
        float tv[4]; int te[4];
#pragma unroll
        for (int k = 0; k < 4; ++k) { const float mx = wave_max(lg); const unsigned long long bm = __ballot(lg == mx); const int first = __ffsll((long long)bm) - 1; te[k] = first >> 1; tv[k] = mx; if (myexp == te[k]) lg = -INFINITY; }
        const float e1 = __expf(tv[1] - tv[0]), e2 = __expf(tv[2] - tv[0]), e3 = __expf(tv[3] - tv[0]); const float inv = 1.0f / (1.0f + e1 + e2 + e3);
        if (lane < 4) { const int e = (lane == 0) ? te[0] : (lane == 1) ? te[1] : (lane == 2) ? te[2] : te[3]; const float w = ((lane == 0) ? 1.0f : (lane == 1) ? e1 : (lane == 2) ? e2 : e3) * inv;
            const unsigned lp = atomicAdd((unsigned*)&lcnt[e], 1u);
            ent[(ri * 4 + lane) * 2 + 0] = ((unsigned)e << 24) | lp; ent[(ri * 4 + lane) * 2 + 1] = __float_as_uint(w); }
    }
    __syncthreads();
    if (tid < 32) gb[tid] = __hip_atomic_fetch_add(cnt + tid * 16, lcnt[tid], __ATOMIC_RELAXED, __HIP_MEMORY_SCOPE_AGENT);
    __syncthreads();
    ri = 0;
    for (int m = gw; m < MT; m += NGW, ++ri) {
        if (lane < 4) { const unsigned pe = ent[(ri * 4 + lane) * 2 + 0]; const unsigned e = pe >> 24, lp = pe & 0xffffffu;
            ((unsigned*)(ws + WS_SLOT))[m * 4 + lane] = (e << 24) | (gb[e] + lp); ((unsigned*)(ws + WS_GATEW))[m * 4 + lane] = ent[(ri * 4 + lane) * 2 + 1]; }
    }
}
__device__ __forceinline__ void build_expert_tables(unsigned char* ws, int layer, LAS unsigned char* lds, int tid) {
    LAS int* t2e = (LAS int*)(lds + AUX_T2E); LAS int* base = (LAS int*)(lds + AUX_BASE); LAS int* ntp = (LAS int*)(lds + AUX_NT);
    gu32* cnt = (gu32*)(ws + WS_CTL) + CW_CNT + layer * 32 * 16;
    __syncthreads();
    if (tid < 64) { const unsigned cval = (tid < 32) ? __hip_atomic_load(cnt + tid * 16, RLX_AGENT) : 0u; const int tiles = (int)((cval + 255u) >> 8);
        int pre = tiles;
#pragma unroll
        for (int o = 1; o < 32; o <<= 1) { const int t = __shfl_up(pre, o); if ((tid & 63) >= o) pre += t; }
        const int start = pre - tiles;
        if (tid < 32) { base[tid] = start * 256; for (int t = 0; t < tiles; ++t) t2e[start + t] = tid; if (tid == 31) ntp[0] = pre; } }
    __syncthreads();
}
__device__ __forceinline__ void phase_moe_gather(unsigned char* ws, int layer, LAS unsigned char* lds, int gw, int NGW, int lane, int tid) {
    build_expert_tables(ws, layer, lds, tid);
    const LAS int* base = (const LAS int*)(lds + AUX_BASE);
    const bf16* XN = (const bf16*)(ws + WS_XN); bf16* XG = (bf16*)(ws + WS_XG);
    const unsigned* slot = (const unsigned*)(ws + WS_SLOT); unsigned* spos = (unsigned*)(ws + WS_SLOTPOS);
    for (int m = gw; m < MT; m += NGW) {
        const GAS v4u* src = (const GAS v4u*)(XN + (size_t)m * 1024) + lane; const v4u a = src[0], b = src[64];
#pragma unroll
        for (int k = 0; k < 4; ++k) { const unsigned pe = slot[m * 4 + k]; const int dst = base[pe >> 24] + (int)(pe & 0xffffffu);
            GAS v4u* dp = (GAS v4u*)(XG + (size_t)dst * 1024) + lane; dp[0] = a; dp[64] = b;
            if (lane == 0) spos[m * 4 + k] = (unsigned)dst; }
    }
}
__device__ __forceinline__ void phase_moe_combine(unsigned char* ws, float* out, int layer, int gw, int NGW, int lane) {
    float* X = (float*)(ws + WS_X); const bf16* Y = (const bf16*)(ws + WS_Y);
    const float* Mo = (const float*)(ws + WS_MOD) + (size_t)layer * MODROWS * NMODC;
    const unsigned* spos = (const unsigned*)(ws + WS_SLOTPOS); const float* gw4 = (const float*)(ws + WS_GATEW);
    for (int m = gw; m < MT; m += NGW) { const int b = m / TB, w = m - b * TB; const int mr = (w < CTXL) ? 8 : b;
        if (layer == NLAYER - 1 && w < CTXL) continue;
        f32x4 f[4];
#pragma unroll
        for (int j = 0; j < 4; ++j) f[j] = (f32x4){0.f, 0.f, 0.f, 0.f};
#pragma unroll
        for (int k = 0; k < 4; ++k) { const unsigned sp = spos[m * 4 + k]; const float wk = gw4[m * 4 + k];
            const GAS unsigned long long* yp = (const GAS unsigned long long*)(Y + (size_t)sp * 1024) + lane;
#pragma unroll
            for (int j = 0; j < 4; ++j) { const unsigned long long v = yp[64 * j];
                f[j].x += wk * __uint_as_float((unsigned)(v & 0xffffu) << 16); f[j].y += wk * __uint_as_float((unsigned)(v >> 16) << 16);
                f[j].z += wk * __uint_as_float((unsigned)((v >> 32) & 0xffffu) << 16); f[j].w += wk * __uint_as_float((unsigned)(v >> 48) << 16); } }
        GAS f32x4* xp = (GAS f32x4*)(X + (size_t)m * 1024) + lane; const GAS f32x4* gp = (const GAS f32x4*)(Mo + (size_t)mr * NMODC + 5 * 1024) + lane;
        GAS f32x4* op = (layer == NLAYER - 1) ? (GAS f32x4*)(out + ((size_t)b * SEQ + (w - CTXL)) * 1024) + lane : xp;
#pragma unroll
        for (int j = 0; j < 4; ++j) op[64 * j] = xp[64 * j] + gp[64 * j] * f[j];
    }
}

constexpr int NPHASE = 2 + 10 * NLAYER;
#ifndef PHMASK
#define PHMASK 0x7fff
#endif
#define EN(b) ((PHMASK >> (b)) & 1)
__global__ void __launch_bounds__(NWAVES * 64, 2) dit_fwd(Args args) {
    extern __shared__ __attribute__((aligned(16))) unsigned char lds_raw[];
    LAS unsigned char* lds = (LAS unsigned char*)lds_raw;
    volatile LAS unsigned* MISC = (volatile LAS unsigned*)(lds + MISC_OFF);
    const int G = gridDim.x, bx = blockIdx.x;
    const int vcu = (G % 8 == 0) ? (bx % 8) * (G / 8) + bx / 8 : bx;
    { const int t0 = threadIdx.x; for (int u = t0; u < (LDS_BYTES - MISC_OFF) / 4; u += NWAVES * 64) ((LAS unsigned*)(lds + MISC_OFF))[u] = 0u; }
    __syncthreads();
    const int lo = args.ph_lo, hi = args.ph_hi;
    XcdBarrier bar; bar.bar = (unsigned*)(args.ws + WS_CTL) + CW_BAR; bar.x = 0; bar.st = nullptr;
    if (hi - lo > 1) bar = xcd_barrier_post((unsigned*)(args.ws + WS_CTL) + CW_BAR, MISC + 8);
#define IN(k) (lo <= (k) && (k) < hi)
#define SEAM(k) do { if (IN(k) && IN((k) + 1)) xcd_barrier(bar); } while (0)
#define PHASE_IDS() int tid = threadIdx.x; LAUNDER_V(tid); const int lane = tid & 63, wave = __builtin_amdgcn_readfirstlane(tid >> 6); const int gw = vcu * NWAVES + wave, NGW = G * NWAVES; \
    unsigned zoff_ = 0u; LAUNDER_S(zoff_); unsigned char* ws = args.ws + zoff_; (void)lane; (void)gw; (void)NGW;

    if (EN(0) && IN(0)) { PHASE_IDS(); p0_prologue(args, lds, gw, NGW, wave, lane); } SEAM(0);
    if (EN(1) && IN(1)) { PHASE_IDS(); p1_mod_reduce(args, gw * 64 + lane, NGW * 64); } SEAM(1);

    for (int layer = 0; layer < NLAYER; ++layer) {
        const int pb = 2 + 10 * layer, lh = layer >> 1;
        if (EN(2) && IN(pb + 0)) { PHASE_IDS(); phase_modulate1(ws, layer, gw, NGW, lane); } SEAM(pb + 0);
        if ((layer & 1) == 0) {
            if (EN(3) && IN(pb + 1)) {
                PHASE_IDS();
                pg8::Gemm g{(const pg8::bf16_t*)(ws + WS_XN), (const pg8::bf16_t*)(ws + WS_WQKV) + (size_t)lh * QKVN * 1024, MT, QKVN, 1024, 0};
                pg8::StaticOrder S; S.init(MT, QKVN, G, bx);
                pg8::EpiQKV E{ws, WS_Q, WS_K - WS_Q, WS_V - WS_K};
                pg8::gemm_phase<pg8::EpiQKV, pg8::StaticOrder, true, true>(lds + RING_OFF, g, S, E);
            } SEAM(pb + 1);
            if (EN(4) && IN(pb + 2)) { PHASE_IDS(); phase_qknorm_rope(ws, lh, gw, NGW, lane); } SEAM(pb + 2);
            if (EN(5) && IN(pb + 3)) {
                PHASE_IDS();
                const attn_body::bf16* Qp = (const attn_body::bf16*)(ws + WS_Q); const attn_body::bf16* Kp = (const attn_body::bf16*)(ws + WS_K); const attn_body::bf16* Vp = (const attn_body::bf16*)(ws + WS_V);
                attn_body::bf16* Op = (attn_body::bf16*)(ws + WS_Q);
                if (G == 256) {
                    for (int i = 0; i < 9; ++i) {
                        long qrow0, kvrow0; int NT, h;
                        if (i < 8) { const int x = vcu >> 5, j = vcu & 31, pair = 4 * x + (i >> 1), wi = (i & 1) * 32 + j, hq = wi >> 4, qb = wi & 15, b = pair >> 2, hk = pair & 3;
                            h = hk * 4 + hq; qrow0 = (long)b * TB + CTXL + qb * 256; kvrow0 = (long)b * TB; NT = TB / 64; }
                        else { if (vcu >= 128) break; const int b = vcu >> 4; h = vcu & 15; qrow0 = (long)b * TB; kvrow0 = qrow0; NT = CTXL / 64; }
                        attn_body::attn_unit<8>(qrow0, kvrow0, NT, h, Qp, Kp, Vp, Op, (char*)lds_raw + RING_OFF);
                    }
                } else {
                    for (int U = bx; U < 2048 + 128; U += G) {
                        long qrow0, kvrow0; int NT, h;
                        if (U < 2048) { const int pair = U >> 6, wi = U & 63, hq = wi >> 4, qb = wi & 15, b = pair >> 2, hk = pair & 3; h = hk * 4 + hq; qrow0 = (long)b * TB + CTXL + qb * 256; kvrow0 = (long)b * TB; NT = TB / 64; }
                        else { const int v = U - 2048, b = v >> 4; h = v & 15; qrow0 = (long)b * TB; kvrow0 = qrow0; NT = CTXL / 64; }
                        attn_body::attn_unit<8>(qrow0, kvrow0, NT, h, Qp, Kp, Vp, Op, (char*)lds_raw + RING_OFF);
                    }
                }
            } SEAM(pb + 3);
        } else {
            if (EN(6) && IN(pb + 1)) {
                PHASE_IDS();
                pg8::Gemm g{(const pg8::bf16_t*)(ws + WS_XN), (const pg8::bf16_t*)(ws + WS_WIN) + (size_t)lh * WINP * 1024, MT, WINP, 1024, 0};
                pg8::StaticOrder S; S.init(MT, WINP, G, bx);
                pg8::EpiBf16 E{(pg8::bf16_t*)(ws + WS_G), WINP};
                pg8::gemm_phase<pg8::EpiBf16, pg8::StaticOrder, true, true>(lds + RING_OFF, g, S, E);
            } SEAM(pb + 1);
            if (EN(7) && IN(pb + 2)) { PHASE_IDS(); phase_gla_recurrent(ws, lh, lds, tid); } SEAM(pb + 2);
            if (EN(8) && IN(pb + 3)) { PHASE_IDS(); phase_gla_readout(ws, lh, gw, NGW, lane); } SEAM(pb + 3);
        }
        if (EN(9) && IN(pb + 4)) {
            PHASE_IDS();
            const pg8::bf16_t* Wt = (layer & 1) ? (const pg8::bf16_t*)(ws + WS_WOG) + (size_t)lh * 1024 * 1024 : (const pg8::bf16_t*)(ws + WS_WOA) + (size_t)lh * 1024 * 1024;
            pg8::Gemm g{(const pg8::bf16_t*)(ws + WS_Q), Wt, MT, 1024, 1024, 0};
            pg8::StaticOrder S; S.init(MT, 1024, G, bx);
            pg8::EpiResGate E{(float*)(ws + WS_X), (const float*)(ws + WS_MOD) + (size_t)layer * MODROWS * NMODC + 2 * 1024};
            pg8::gemm_phase<pg8::EpiResGate, pg8::StaticOrder, true, true>(lds + RING_OFF, g, S, E);
        } SEAM(pb + 4);
        if (EN(10) && IN(pb + 5)) { PHASE_IDS(); phase_modulate2_route(ws, layer, lds, gw, NGW, wave, lane, tid); } SEAM(pb + 5);
        if (EN(11) && IN(pb + 6)) { PHASE_IDS(); phase_moe_gather(ws, layer, lds, gw, NGW, lane, tid); } SEAM(pb + 6);
        if (EN(12) && IN(pb + 7)) {
            PHASE_IDS();
            build_expert_tables(ws, layer, lds, tid);
            const int nT = __builtin_amdgcn_readfirstlane(((const LAS int*)(lds + AUX_NT))[0]);
            pg8::Gemm g{(const pg8::bf16_t*)(ws + WS_XG), (const pg8::bf16_t*)(ws + WS_WGU) + (size_t)layer * 32 * 2048 * 1024, MPAD, 2048, 1024, (size_t)2048 * 1024 * 2};
            pg8::MoeOrder S{nT, 8, G, bx, (const LAS int*)(lds + AUX_T2E)};
            pg8::EpiSwiGLU E{(pg8::bf16_t*)(ws + WS_ACT), PARF(ws) + P_BGU + (size_t)layer * 32 * 2048};
            pg8::gemm_phase<pg8::EpiSwiGLU, pg8::MoeOrder, true, true>(lds + RING_OFF, g, S, E);
        } SEAM(pb + 7);
        if (EN(13) && IN(pb + 8)) {
            PHASE_IDS();
            build_expert_tables(ws, layer, lds, tid);
            const int nT = __builtin_amdgcn_readfirstlane(((const LAS int*)(lds + AUX_NT))[0]);
            pg8::Gemm g{(const pg8::bf16_t*)(ws + WS_ACT), (const pg8::bf16_t*)(ws + WS_WDN) + (size_t)layer * 32 * 1024 * 1024, MPAD, 1024, 1024, (size_t)1024 * 1024 * 2};
            pg8::MoeOrder S{nT, 4, G, bx, (const LAS int*)(lds + AUX_T2E)};
            pg8::EpiBiasBf16 E{(pg8::bf16_t*)(ws + WS_Y), PARF(ws) + P_BDN + (size_t)layer * 32 * 1024};
            pg8::gemm_phase<pg8::EpiBiasBf16, pg8::MoeOrder, true, true>(lds + RING_OFF, g, S, E);
        } SEAM(pb + 8);
        if (EN(14) && IN(pb + 9)) { PHASE_IDS(); phase_moe_combine(ws, args.out, layer, gw, NGW, lane); } SEAM(pb + 9);
    }
#undef IN
#undef EN
#undef SEAM
#undef PHASE_IDS
}

extern "C" void kernel_launch(void* const* d_in, const int* in_sizes, int n_in, void* d_out, int out_size, void* d_ws, size_t ws_size, hipStream_t stream) {
    static int grid = 0;
    if (grid == 0) {
        if (n_in != 25 || out_size != NB * SEQ * DMODEL || ws_size < WS_END) { fprintf(stderr, "kernel_launch: unexpected shapes: n_in %d out %d ws %zu (need >= %zu)\n", n_in, out_size, ws_size, (size_t)WS_END); grid = -1; return; }
        int dev = 0, cus = 0, per_cu = 0;
        if (hipGetDevice(&dev) != hipSuccess || hipDeviceGetAttribute(&cus, hipDeviceAttributeMultiprocessorCount, dev) != hipSuccess) { grid = -1; return; }
        if (hipFuncSetAttribute((const void*)dit_fwd, hipFuncAttributeMaxDynamicSharedMemorySize, LDS_BYTES) != hipSuccess) { fprintf(stderr, "kernel_launch: hipFuncSetAttribute failed\n"); grid = -1; return; }
        if (hipOccupancyMaxActiveBlocksPerMultiprocessor(&per_cu, (const void*)dit_fwd, NWAVES * 64, LDS_BYTES) != hipSuccess || per_cu < 1) fprintf(stderr, "kernel_launch: occupancy query reports %d\n", per_cu);
        (void)hipGetLastError();
        grid = cus;
    }
    if (grid < 0) return;
    if (hipMemsetAsync((char*)d_ws + WS_CTL, 0, CTL_ZERO_BYTES, stream) != hipSuccess) { fprintf(stderr, "kernel_launch: memset failed\n"); return; }
    Args a{};
    for (int i = 0; i < 25; ++i) a.in[i] = (const float*)d_in[i];
    a.out = (float*)d_out; a.ws = (unsigned char*)d_ws;
#if MK_ONE_LAUNCH
    a.ph_lo = 0; a.ph_hi = NPHASE;
    hipLaunchKernelGGL(dit_fwd, dim3(grid), dim3(NWAVES * 64), LDS_BYTES, stream, a);
#else
    for (int p = 0; p < NPHASE; ++p) { a.ph_lo = p; a.ph_hi = p + 1; hipLaunchKernelGGL(dit_fwd, dim3(grid), dim3(NWAVES * 64), LDS_BYTES, stream, a); }
#endif
    const hipError_t le = hipPeekAtLastError();
    if (le != hipSuccess) fprintf(stderr, "kernel_launch: launch failed: %s\n", hipGetErrorName(le));
}
```

```cpp
#include <hip/hip_runtime.h>
#include <hip/hip_bf16.h>
#include <cstdio>
#include <cstdint>
#include <cmath>

#ifndef MK_ONE_LAUNCH
#define MK_ONE_LAUNCH 1
#endif

namespace pg8 {
#define PG8_LAS __attribute__((address_space(3)))
typedef unsigned short bf16_t;
typedef short bf16x8 __attribute__((ext_vector_type(8)));
typedef float f32x4 __attribute__((ext_vector_type(4)));
typedef unsigned u32x4 __attribute__((ext_vector_type(4)));
constexpr int BM = 256, BK = 64, HALF = 128, HTB = HALF * BK * 2  , STAGE_BYTES = 8 * HTB, NXCD = 8, WGM = 8;

__host__ __device__ __forceinline__ int lds_byte(int r, int c) { const int st = (r >> 4) * 2 + (c >> 5), rr = r & 15, cc = c & 31, ob = rr * 64 + cc * 2; return st * 1024 + (ob ^ (((ob >> 9) & 1) << 5)); }
__host__ __device__ __forceinline__ void stage_rc(int b, int& R, int& C) { const int st = b / 1024, sb = b % 1024, swz = sb ^ (((sb >> 9) & 1) << 5); R = (st >> 1) * 16 + swz / 64; C = (st & 1) * 32 + (swz % 64) / 2; }
__host__ __device__ __forceinline__ int perm32(int rho) { const int n = rho >> 4, i = rho & 15; return 8 * (i >> 2) + 4 * n + (i & 3); }

struct Unit { int pm, pn, e; };
struct Gemm { const bf16_t* A; const bf16_t* Bt; int M, N, K; size_t bstride; };

struct StaticOrder {
    int nM, nN, nwg, G, c;
    __host__ __device__ __forceinline__ void init(int M, int N, int G_, int c_) { nM = M / BM; nN = N / BM; nwg = nM * nN; G = G_; c = c_; }
    __host__ __device__ __forceinline__ bool next(int i, Unit& u) const {
        const long L = (long)i * G + c; if (L >= nwg) return false;
        int wgid = (int)L; { const int q = nwg / NXCD, r = nwg % NXCD, xcd = wgid % NXCD, off = wgid / NXCD; wgid = (xcd < r ? xcd * (q + 1) : r * (q + 1) + (xcd - r) * q) + off; }
        const int nig = WGM * nN, gid = wgid / nig, fm = gid * WGM, gsz = (nM - fm) < WGM ? (nM - fm) : WGM;
        u.pm = fm + ((wgid % nig) % gsz); u.pn = (wgid % nig) / gsz; u.e = 0; return true;
    }
    __device__ __forceinline__ void a_ready(const Unit&) const {}
    __device__ __forceinline__ void done(const Unit&) const {}
};
struct MoeOrder {
    int nT, nN, G, c; const PG8_LAS int* t2e;
    __device__ __forceinline__ bool next(int i, Unit& u) const {
        const int L = i * G + c, mt = L / nN; if (mt >= nT) return false;
        u.pm = mt; u.pn = L - mt * nN; u.e = __builtin_amdgcn_readfirstlane(t2e[mt]); return true;
    }
    __device__ __forceinline__ void a_ready(const Unit&) const {}
    __device__ __forceinline__ void done(const Unit&) const {}
};

__device__ __forceinline__ unsigned cvt_pk_bf16(float lo, float hi) { unsigned r; asm volatile("v_cvt_pk_bf16_f32 %0, %1, %2" : "=v"(r) : "v"(lo), "v"(hi)); return r; }

struct EpiBf16 {
    static constexpr bool PERM = true, AFTER_DRAIN = false;
    bf16_t* O; int ldc;
    __device__ __forceinline__ void operator()(const f32x4 (&acc)[2][2][4][2], const Unit& u, int wr, int wc, int fr, int fq) const {
        const int row0 = u.pm * BM + wr * 64 + fr; const int col0 = u.pn * BM + wc * 32 + 8 * fq;
#pragma unroll
        for (int ai = 0; ai < 2; ++ai)
#pragma unroll
            for (int m = 0; m < 4; ++m) { bf16_t* rowp = O + (size_t)(row0 + ai * HALF + m * 16) * ldc + col0;
#pragma unroll
                for (int bj = 0; bj < 2; ++bj) { const f32x4 v0 = acc[ai][bj][m][0], v1 = acc[ai][bj][m][1];
                    u32x4 w; w.x = cvt_pk_bf16(v0[0], v0[1]); w.y = cvt_pk_bf16(v0[2], v0[3]); w.z = cvt_pk_bf16(v1[0], v1[1]); w.w = cvt_pk_bf16(v1[2], v1[3]);
                    *(u32x4*)(rowp + bj * HALF) = w; } }
    }
};
struct EpiQKV {
    static constexpr bool PERM = true, AFTER_DRAIN = false;
    unsigned char* wsb; size_t offQ, dK, dV;
    __device__ __forceinline__ void operator()(const f32x4 (&acc)[2][2][4][2], const Unit& u, int wr, int wc, int fr, int fq) const {
        const int row0 = u.pm * BM + wr * 64 + fr;
        const int isk = (u.pn >= 4) ? 1 : 0, isv = (u.pn >= 5) ? 1 : 0;
        bf16_t* base = (bf16_t*)(wsb + offQ + (size_t)isk * dK + (size_t)isv * dV); const int ldc = isk ? 256 : 1024, colt = isk ? 0 : u.pn * BM;
        const int col0 = colt + wc * 32 + 8 * fq;
#pragma unroll
        for (int ai = 0; ai < 2; ++ai)
#pragma unroll
            for (int m = 0; m < 4; ++m) { bf16_t* rowp = base + (size_t)(row0 + ai * HALF + m * 16) * ldc + col0;
#pragma unroll
                for (int bj = 0; bj < 2; ++bj) { const f32x4 v0 = acc[ai][bj][m][0], v1 = acc[ai][bj][m][1];
                    u32x4 w; w.x = cvt_pk_bf16(v0[0], v0[1]); w.y = cvt_pk_bf16(v0[2], v0[3]); w.z = cvt_pk_bf16(v1[0], v1[1]); w.w = cvt_pk_bf16(v1[2], v1[3]);
                    *(u32x4*)(rowp + bj * HALF) = w; } }
    }
};
struct EpiResGate {
    static constexpr bool PERM = false, AFTER_DRAIN = false;
    float* X; const float* gate;
    __device__ __forceinline__ void operator()(const f32x4 (&acc)[2][2][4][2], const Unit& u, int wr, int wc, int fr, int fq) const {
        const int row0 = u.pm * BM + wr * 64 + fr; const int col0 = u.pn * BM + wc * 32 + 4 * fq;
        const int bb = u.pm / 17, mr = (u.pm - bb * 17 == 0) ? 8 : bb;
        const float* gp = gate + (size_t)mr * 6144 + col0;
        f32x4 gv[2][2];
#pragma unroll
        for (int bj = 0; bj < 2; ++bj)
#pragma unroll
            for (int n = 0; n < 2; ++n) gv[bj][n] = *(const f32x4*)(gp + bj * HALF + n * 16);
#pragma unroll
        for (int ai = 0; ai < 2; ++ai)
#pragma unroll
            for (int m = 0; m < 4; ++m) { float* rowp = X + (size_t)(row0 + ai * HALF + m * 16) * 1024 + col0;
#pragma unroll
                for (int bj = 0; bj < 2; ++bj)
#pragma unroll
                    for (int n = 0; n < 2; ++n) { f32x4* p = (f32x4*)(rowp + bj * HALF + n * 16); f32x4 x = *p; x = x + gv[bj][n] * acc[ai][bj][m][n]; *p = x; } }
    }
};
struct EpiSwiGLU {
    static constexpr bool PERM = true, AFTER_DRAIN = false;
    bf16_t* O; const float* bias;
    __device__ __forceinline__ void operator()(const f32x4 (&acc)[2][2][4][2], const Unit& u, int wr, int wc, int fr, int fq) const {
        const int row0 = u.pm * BM + wr * 64 + fr; const int col0 = u.pn * HALF + wc * 32 + 8 * fq;
        const float* bp = bias + (size_t)u.e * 2048 + col0;
        f32x4 bg[2], bu[2];
#pragma unroll
        for (int n = 0; n < 2; ++n) { bg[n] = *(const f32x4*)(bp + 4 * n); bu[n] = *(const f32x4*)(bp + 1024 + 4 * n); }
#pragma unroll
        for (int ai = 0; ai < 2; ++ai)
#pragma unroll
            for (int m = 0; m < 4; ++m) { bf16_t* rowp = O + (size_t)(row0 + ai * HALF + m * 16) * 1024 + col0;
                float r[8];
#pragma unroll
                for (int n = 0; n < 2; ++n) { const f32x4 gt = acc[ai][0][m][n] + bg[n], up = acc[ai][1][m][n] + bu[n];
#pragma unroll
                    for (int i = 0; i < 4; ++i) { const float g = fminf(gt[i], 7.0f), uu = fminf(fmaxf(up[i], -7.0f), 7.0f);
                        const float sg = __builtin_amdgcn_rcpf(1.0f + __builtin_amdgcn_exp2f(-1.702f * 1.4426950408889634f * g));
                        r[4 * n + i] = (uu + 1.0f) * (g * sg); } }
                u32x4 w; w.x = cvt_pk_bf16(r[0], r[1]); w.y = cvt_pk_bf16(r[2], r[3]); w.z = cvt_pk_bf16(r[4], r[5]); w.w = cvt_pk_bf16(r[6], r[7]);
                *(u32x4*)rowp = w; }
    }
};
struct EpiBiasBf16 {
    static constexpr bool PERM = true, AFTER_DRAIN = false;
    bf16_t* O; const float* bias;
    __device__ __forceinline__ void operator()(const f32x4 (&acc)[2][2][4][2], const Unit& u, int wr, int wc, int fr, int fq) const {
        const int row0 = u.pm * BM + wr * 64 + fr; const int col0 = u.pn * BM + wc * 32 + 8 * fq;
        const float* bp = bias + (size_t)u.e * 1024 + col0;
        f32x4 bv[2][2];
#pragma unroll
        for (int bj = 0; bj < 2; ++bj)
#pragma unroll
            for (int n = 0; n < 2; ++n) bv[bj][n] = *(const f32x4*)(bp + bj * HALF + 4 * n);
#pragma unroll
        for (int ai = 0; ai < 2; ++ai)
#pragma unroll
            for (int m = 0; m < 4; ++m) { bf16_t* rowp = O + (size_t)(row0 + ai * HALF + m * 16) * 1024 + col0;
#pragma unroll
                for (int bj = 0; bj < 2; ++bj) { const f32x4 v0 = acc[ai][bj][m][0] + bv[bj][0], v1 = acc[ai][bj][m][1] + bv[bj][1];
                    u32x4 w; w.x = cvt_pk_bf16(v0[0], v0[1]); w.y = cvt_pk_bf16(v0[2], v0[3]); w.z = cvt_pk_bf16(v1[0], v1[1]); w.w = cvt_pk_bf16(v1[2], v1[3]);
                    *(u32x4*)(rowp + bj * HALF) = w; } }
    }
};

template <class Epi, class Sched, bool ALIGN_EPI = false, bool SP2 = false>
__device__ __forceinline__ void gemm_phase(PG8_LAS unsigned char* lds, const Gemm g, const Sched& S, const Epi& E) {
    int tid_l = threadIdx.x; asm volatile("" : "+v"(tid_l));
    const int tid = tid_l, wid = __builtin_amdgcn_readfirstlane(tid >> 6), lane = tid & 63, wr = wid >> 2, wc = wid & 3, fr = lane & 15, fq = lane >> 4;
    const int K = g.K, nt = K / BK;
    unsigned voffA[2], voffB[2];
#pragma unroll
    for (int i = 0; i < 2; ++i) { int R, C; stage_rc(tid * 16 + i * 8192, R, C); const int Rb = Epi::PERM ? ((R & ~31) + perm32(R & 31)) : R;
        voffA[i] = (unsigned)(R * K + C) * 2u; voffB[i] = (unsigned)(Rb * K + C) * 2u; }
    const size_t kstep = (size_t)(BK * 2);
    const size_t hstep = (size_t)HALF * K * 2;
    const size_t tstep = 2 * hstep;
    const unsigned ldsw = (unsigned)wid * 1024u;
    const int aoff = lds_byte(wr * 64 + fr, fq * 8), boff = lds_byte(wc * 32 + fr, fq * 8);
#define PG8_SA(b, h) (((b) * 2 + (h)) * HTB)
#define PG8_SB(b, h) ((4 + (b) * 2 + (h)) * HTB)
#define PG8_STAGE(bufoff, gbase, voff) do { _Pragma("unroll") for (int _i = 0; _i < 2; ++_i) \
        __builtin_amdgcn_global_load_lds((const unsigned*)((const char*)(gbase) + (voff)[_i]), (PG8_LAS unsigned*)(lds + (bufoff) + ldsw + _i * 8192), 16, 0, 0); } while (0)
#define PG8_LDA(dst, b, h) do { _Pragma("unroll") for (int m = 0; m < 4; ++m) _Pragma("unroll") for (int k = 0; k < 2; ++k) dst[m][k] = *(const PG8_LAS bf16x8*)(lds + PG8_SA(b, h) + aoff + m * 2048 + k * 1024); } while (0)
#define PG8_LDB(dst, b, h) do { _Pragma("unroll") for (int n = 0; n < 2; ++n) _Pragma("unroll") for (int k = 0; k < 2; ++k) dst[n][k] = *(const PG8_LAS bf16x8*)(lds + PG8_SB(b, h) + boff + n * 2048 + k * 1024); } while (0)
#define PG8_MMA(ai, bj, At, Bt) do { __builtin_amdgcn_s_setprio(1); _Pragma("unroll") for (int m = 0; m < 4; ++m) _Pragma("unroll") for (int n = 0; n < 2; ++n) _Pragma("unroll") for (int k = 0; k < 2; ++k) \
        acc[ai][bj][m][n] = __builtin_amdgcn_mfma_f32_16x16x32_bf16(Bt[n][k], At[m][k], acc[ai][bj][m][n], 0, 0, 0); __builtin_amdgcn_s_setprio(0); } while (0)
#define PG8_WAIT_V(n) asm volatile("s_waitcnt vmcnt(" #n ")" ::: "memory")
#define PG8_WAIT_L(n) asm volatile("s_waitcnt lgkmcnt(" #n ")" ::: "memory")
#define PG8_BAR __builtin_amdgcn_s_barrier()
#define PG8_SCHED __builtin_amdgcn_sched_barrier(0)
    Unit cur, nxt; int ui = 0;
    if (!S.next(0, cur)) return;
    f32x4 acc[2][2][4][2];
#pragma unroll
    for (int a = 0; a < 2; ++a)
#pragma unroll
        for (int b = 0; b < 2; ++b)
#pragma unroll
            for (int m = 0; m < 4; ++m)
#pragma unroll
                for (int n = 0; n < 2; ++n) acc[a][b][m][n] = (f32x4){0.f, 0.f, 0.f, 0.f};
    bf16x8 At[4][2], B0[2][2], B1[2][2];
    const char* cA = (const char*)g.A + (size_t)cur.pm * tstep; const char* cB = (const char*)g.Bt + (size_t)cur.e * g.bstride + (size_t)cur.pn * tstep;
    S.a_ready(cur);
    if constexpr (SP2) {
        PG8_STAGE(PG8_SB(0, 0), cB, voffB); PG8_STAGE(PG8_SB(0, 1), cB + hstep, voffB); PG8_STAGE(PG8_SA(0, 0), cA, voffA); PG8_STAGE(PG8_SA(0, 1), cA + hstep, voffA);
        if (wr == 1) PG8_BAR;
        PG8_WAIT_V(2); PG8_BAR;
        PG8_STAGE(PG8_SB(1, 0), cB + kstep, voffB); PG8_STAGE(PG8_SA(1, 0), cA + kstep, voffA); PG8_STAGE(PG8_SB(1, 1), cB + hstep + kstep, voffB);
        PG8_WAIT_V(6); PG8_BAR;
    } else {
        PG8_STAGE(PG8_SB(0, 0), cB, voffB); PG8_STAGE(PG8_SA(0, 0), cA, voffA); PG8_STAGE(PG8_SB(0, 1), cB + hstep, voffB); PG8_STAGE(PG8_SA(0, 1), cA + hstep, voffA);
        if (wr == 1) PG8_BAR;
        PG8_WAIT_V(4); PG8_BAR;
        PG8_STAGE(PG8_SB(1, 0), cB + kstep, voffB); PG8_STAGE(PG8_SA(1, 0), cA + kstep, voffA); PG8_STAGE(PG8_SB(1, 1), cB + hstep + kstep, voffB);
        PG8_WAIT_V(6); PG8_BAR;
    }
    for (;;) {
        const bool has_next = S.next(ui + 1, nxt);
        const char* nA = has_next ? (const char*)g.A + (size_t)nxt.pm * tstep : cA; const char* nB = has_next ? (const char*)g.Bt + (size_t)nxt.e * g.bstride + (size_t)nxt.pn * tstep : cB;
        for (int t = 0; t < nt; t += 2) {
            const bool last = (t == nt - 2);
            const char* a1 = cA + (size_t)(t + 1) * kstep;
            const char* a2 = last ? nA : cA + (size_t)(t + 2) * kstep; const char* b2 = last ? nB : cB + (size_t)(t + 2) * kstep;
            const char* a3 = a2 + kstep; const char* b3 = b2 + kstep;
            if (last && has_next) S.a_ready(nxt);
            if constexpr (SP2) {
            PG8_LDB(B0, 0, 0); PG8_LDB(B1, 0, 1); PG8_SCHED; PG8_LDA(At, 0, 0); PG8_STAGE(PG8_SA(1, 1), a1 + hstep, voffA);
            PG8_WAIT_V(8); PG8_WAIT_L(0); PG8_BAR; PG8_MMA(0, 0, At, B0); PG8_MMA(0, 1, At, B1); PG8_BAR; PG8_SCHED;
            PG8_LDA(At, 0, 1); PG8_STAGE(PG8_SB(0, 0), b2, voffB); PG8_STAGE(PG8_SB(0, 1), b2 + hstep, voffB); PG8_STAGE(PG8_SA(0, 0), a2, voffA);
            PG8_WAIT_V(8); PG8_WAIT_L(0); PG8_BAR; PG8_MMA(1, 0, At, B0); PG8_MMA(1, 1, At, B1); PG8_BAR; PG8_SCHED;
            PG8_LDB(B0, 1, 0); PG8_LDB(B1, 1, 1); PG8_SCHED; PG8_LDA(At, 1, 0); PG8_STAGE(PG8_SA(0, 1), a2 + hstep, voffA);
            PG8_WAIT_V(8); PG8_WAIT_L(0); PG8_BAR; PG8_MMA(0, 0, At, B0); PG8_MMA(0, 1, At, B1); PG8_BAR; PG8_SCHED;
            PG8_LDA(At, 1, 1); PG8_STAGE(PG8_SB(1, 0), b3, voffB); PG8_STAGE(PG8_SB(1, 1), b3 + hstep, voffB); PG8_STAGE(PG8_SA(1, 0), a3, voffA);
            PG8_WAIT_V(8); PG8_WAIT_L(0); PG8_BAR; PG8_MMA(1, 0, At, B0); PG8_MMA(1, 1, At, B1); PG8_BAR; PG8_SCHED;
            } else {
            PG8_LDB(B0, 0, 0); PG8_SCHED; PG8_LDA(At, 0, 0); PG8_STAGE(PG8_SA(1, 1), a1 + hstep, voffA);
            PG8_WAIT_L(8); PG8_BAR; PG8_WAIT_L(0); PG8_MMA(0, 0, At, B0); PG8_BAR; PG8_SCHED;
            PG8_LDB(B1, 0, 1); PG8_STAGE(PG8_SB(0, 0), b2, voffB);
            PG8_BAR; PG8_WAIT_L(0); PG8_MMA(0, 1, At, B1); PG8_BAR;
            PG8_LDA(At, 0, 1); PG8_STAGE(PG8_SA(0, 0), a2, voffA);
            PG8_BAR; PG8_WAIT_L(0); PG8_MMA(1, 0, At, B0); PG8_BAR; PG8_SCHED;
            PG8_STAGE(PG8_SB(0, 1), b2 + hstep, voffB);
            PG8_WAIT_V(6); PG8_BAR; PG8_MMA(1, 1, At, B1); PG8_BAR;
            PG8_LDB(B0, 1, 0); PG8_SCHED; PG8_LDA(At, 1, 0); PG8_STAGE(PG8_SA(0, 1), a2 + hstep, voffA);
            PG8_WAIT_L(8); PG8_BAR; PG8_WAIT_L(0); PG8_MMA(0, 0, At, B0); PG8_BAR; PG8_SCHED;
            PG8_LDB(B1, 1, 1); PG8_STAGE(PG8_SB(1, 0), b3, voffB);
            PG8_BAR; PG8_WAIT_L(0); PG8_MMA(0, 1, At, B1); PG8_BAR;
            PG8_LDA(At, 1, 1); PG8_STAGE(PG8_SA(1, 0), a3, voffA);
            PG8_BAR; PG8_WAIT_L(0); PG8_MMA(1, 0, At, B0); PG8_BAR; PG8_SCHED;
            PG8_STAGE(PG8_SB(1, 1), b3 + hstep, voffB);
            PG8_WAIT_V(6); PG8_BAR; PG8_MMA(1, 1, At, B1); PG8_BAR;
            }
        }
        if constexpr (ALIGN_EPI) { if (wr == 0) PG8_BAR; }
        if constexpr (!Epi::AFTER_DRAIN) { E(acc, cur, wr, wc, fr, fq); S.done(cur); }
        if (!has_next) break;
#pragma unroll
        for (int a = 0; a < 2; ++a)
#pragma unroll
            for (int b = 0; b < 2; ++b)
#pragma unroll
                for (int m = 0; m < 4; ++m)
#pragma unroll
                    for (int n = 0; n < 2; ++n) acc[a][b][m][n] = (f32x4){0.f, 0.f, 0.f, 0.f};
        cur = nxt; cA = nA; cB = nB; ++ui;
        if constexpr (ALIGN_EPI) { if (wr == 1) PG8_BAR; }
    }
    PG8_WAIT_V(0);
    if constexpr (!ALIGN_EPI) { if (wr == 0) PG8_BAR; }
    PG8_BAR;
    if constexpr (Epi::AFTER_DRAIN) { E.fused(acc, cur, wr, wc, fr, fq, lds, wid, lane); S.done(cur); }
#undef PG8_SA
#undef PG8_SB
#undef PG8_STAGE
#undef PG8_LDA
#undef PG8_LDB
#undef PG8_MMA
#undef PG8_WAIT_V
#undef PG8_WAIT_L
#undef PG8_BAR
#undef PG8_SCHED
}
}
#include <hip/hip_bf16.h>
#include <cmath>
namespace attn_body {
using bf16=__hip_bfloat16;
using bf16x8=__attribute__((ext_vector_type(8)))short;
using s16x4=__attribute__((ext_vector_type(4)))short;
using f32x16=__attribute__((ext_vector_type(16)))float;
using u32x4=__attribute__((ext_vector_type(4)))unsigned;
constexpr int D=64,DM=1024,KVP=256;
constexpr int NW=8,QBLK=32,QB=QBLK*NW,KVBLK=64;
__device__ __forceinline__ int crow(int r,int hi){return (r&3)+8*(r>>2)+4*hi;}
#define SBAR() __builtin_amdgcn_sched_barrier(0)
__device__ __forceinline__ void cmask(f32x16&p0,f32x16&p1,int jb,int qrel,int hi){
  const float NEG=-INFINITY; int kb=64*jb+4*hi;
  #pragma unroll
  for(int r=0;r<16;++r){int kv=kb+(r&3)+8*(r>>2); if(kv>qrel)p0[r]=NEG; if(kv+32>qrel)p1[r]=NEG;}
}

constexpr int NSLOT=3, SLOTB=8192;
constexpr int LDS_K=0, LDS_V=NSLOT*SLOTB, LDS_WS=2*NSLOT*SLOTB, LDS_OST=LDS_WS+NW*64*4, LDS_BYTES=LDS_OST+NW*4096;
constexpr float C2=0.125f*1.4426950408889634f;
__device__ __forceinline__ void glds16(const void*gsrc,unsigned lds_dst){unsigned keep;
  asm volatile("s_mov_b32 %0, m0\n\ts_mov_b32 m0, %2\n\ts_nop 0\n\tglobal_load_lds_dwordx4 %1, off\n\ts_mov_b32 m0, %0":"=&s"(keep):"v"(gsrc),"s"(lds_dst):"memory");}
__device__ __forceinline__ float max3f(float a,float b,float c){float r;asm("v_max3_f32 %0, %1, %2, %3":"=v"(r):"v"(a),"v"(b),"v"(c));return r;}
__device__ __forceinline__ float max2f(float a,float b){float r;asm("v_max_f32_e32 %0, %1, %2":"=v"(r):"v"(a),"v"(b));return r;}
__device__ __forceinline__ float fadd_s(float a,float b){float r;asm("v_add_f32_e32 %0, %1, %2":"=v"(r):"v"(a),"v"(b));return r;}
__device__ __forceinline__ float fsub_s(float a,float b){float r;asm("v_sub_f32_e32 %0, %1, %2":"=v"(r):"v"(a),"v"(b));return r;}
typedef float f32x2_t __attribute__((ext_vector_type(2))); typedef __bf16 bf16x2_t __attribute__((ext_vector_type(2)));
__device__ __forceinline__ unsigned cvtpk_s(float lo,float hi){f32x2_t v={lo,hi};bf16x2_t b=__builtin_convertvector(v,bf16x2_t);return __builtin_bit_cast(unsigned,b);}
#define WAIT_BAR(N) asm volatile("s_waitcnt vmcnt(" #N ") lgkmcnt(0)\n\ts_barrier":::"memory")

__device__ __forceinline__ void qkt(f32x16&p0,f32x16&p1,const char*Kslot,const bf16x8*qr,const f32x16&negm,int r32,int hi){
  const char*kb=Kslot+hi*1024+r32*16;
  #pragma unroll
  for(int d0=0;d0<4;++d0){
    const bf16x8 b0=*reinterpret_cast<const bf16x8*>(kb+d0*2048);
    const bf16x8 b1=*reinterpret_cast<const bf16x8*>(kb+d0*2048+512);
    if(d0==0){p0=__builtin_amdgcn_mfma_f32_32x32x16_bf16(b0,qr[0],negm,0,0,0);p1=__builtin_amdgcn_mfma_f32_32x32x16_bf16(b1,qr[0],negm,0,0,0);}
    else{p0=__builtin_amdgcn_mfma_f32_32x32x16_bf16(b0,qr[d0],p0,0,0,0);p1=__builtin_amdgcn_mfma_f32_32x32x16_bf16(b1,qr[d0],p1,0,0,0);}}
}
typedef __attribute__((address_space(3))) const char* lds_cptr;
typedef short v4i16_t __attribute__((ext_vector_type(4)));
__device__ __forceinline__ void kload8(bf16x8*kf,lds_cptr kp){
  kf[0]=*(const __attribute__((address_space(3))) bf16x8*)(kp);      kf[1]=*(const __attribute__((address_space(3))) bf16x8*)(kp+512);
  kf[2]=*(const __attribute__((address_space(3))) bf16x8*)(kp+2048); kf[3]=*(const __attribute__((address_space(3))) bf16x8*)(kp+2560);
  kf[4]=*(const __attribute__((address_space(3))) bf16x8*)(kp+4096); kf[5]=*(const __attribute__((address_space(3))) bf16x8*)(kp+4608);
  kf[6]=*(const __attribute__((address_space(3))) bf16x8*)(kp+6144); kf[7]=*(const __attribute__((address_space(3))) bf16x8*)(kp+6656);
}
__device__ __forceinline__ void kload2(bf16x8*kf,lds_cptr kp,int j){ kf[2*j]=*(const __attribute__((address_space(3))) bf16x8*)(kp+j*2048); kf[2*j+1]=*(const __attribute__((address_space(3))) bf16x8*)(kp+j*2048+512); }
__device__ __forceinline__ s16x4 vtr(lds_cptr p){ return __builtin_bit_cast(s16x4,__builtin_amdgcn_ds_read_tr16_b64_v4i16((__attribute__((address_space(3))) v4i16_t*)p)); }
__device__ __forceinline__ float rowmax(const f32x16&p0,const f32x16&p1){
  float a=max3f(p0[0],p0[1],p1[0]),b=max3f(p0[2],p0[3],p1[1]);a=max3f(a,p1[2],p1[3]);
  #pragma unroll
  for(int r=4;r<16;r+=4){a=max3f(a,p0[r],p0[r+1]);b=max3f(b,p0[r+2],p0[r+3]);a=max3f(a,p1[r],p1[r+1]);b=max3f(b,p1[r+2],p1[r+3]);}
  const float m=max2f(a,b);
  auto rr=__builtin_amdgcn_permlane32_swap(__float_as_uint(m),__float_as_uint(m),false,false);
  return max2f(__uint_as_float(rr[0]),__uint_as_float(rr[1]));
}
__device__ __forceinline__ void pv(f32x16*o,int vb,bf16x8 pa0,bf16x8 pa1,bf16x8 pa2,bf16x8 pa3){
  #pragma unroll
  for(int d0=0;d0<2;++d0){s16x4 lo[4],hi[4];
    #pragma unroll
    for(int ks=0;ks<4;++ks){
      asm volatile("ds_read_b64_tr_b16 %0,%1 offset:%c2":"=&v"(lo[ks]):"v"(vb),"i"(d0*4096+ks*1024):"memory");
      asm volatile("ds_read_b64_tr_b16 %0,%1 offset:%c2":"=&v"(hi[ks]):"v"(vb),"i"(d0*4096+ks*1024+512):"memory");}
    asm volatile("s_waitcnt lgkmcnt(0)":::"memory");SBAR();
    #define PK(k) (bf16x8){lo[k][0],lo[k][1],lo[k][2],lo[k][3],hi[k][0],hi[k][1],hi[k][2],hi[k][3]}
    o[d0]=__builtin_amdgcn_mfma_f32_32x32x16_bf16(pa0,PK(0),o[d0],0,0,0);
    o[d0]=__builtin_amdgcn_mfma_f32_32x32x16_bf16(pa1,PK(1),o[d0],0,0,0);
    o[d0]=__builtin_amdgcn_mfma_f32_32x32x16_bf16(pa2,PK(2),o[d0],0,0,0);
    o[d0]=__builtin_amdgcn_mfma_f32_32x32x16_bf16(pa3,PK(3),o[d0],0,0,0);
    #undef PK
  }
}

#ifndef ATTN_STORE16
#define ATTN_STORE16(p,v) (*(u32x4*)(p)=(v))
#endif
template<int THRL> __device__ __forceinline__ void attn_unit(long qrow0,long kvrow0,int NT,int h,const bf16*Q,const bf16*__restrict__ K,const bf16*__restrict__ V,bf16*O,char*shm){
  int tid_l=threadIdx.x; asm volatile("":"+v"(tid_l)); const int tid=tid_l,lane=tid&63,r32=lane&31,hi=lane>>5; const int wid=__builtin_amdgcn_readfirstlane(tid>>6);
  const bf16*Qw=Q+(qrow0+wid*QBLK)*DM+h*D;
  const bf16*Kh=K+kvrow0*KVP+(h>>2)*D,*Vh=V+kvrow0*KVP+(h>>2)*D;
  const unsigned lds0=(unsigned)(uintptr_t)shm;
  float*wsf=(float*)(shm+LDS_WS)+wid*64;
  const bf16*ksrc=Kh+(long)lane*KVP+wid*8;
  const bf16*vsrc=Vh+(long)(16*(wid&3)+(lane>>2))*KVP+(wid>>2)*32+(lane&3)*8;
  const unsigned kdst=lds0+LDS_K+wid*1024, vdst=lds0+LDS_V+wid*1024;
  #define DMA_K(t,slot) glds16(ksrc+(long)(t)*KVBLK*KVP,(unsigned)__builtin_amdgcn_readfirstlane(kdst+(slot)))
  #define DMA_V(t,slot) glds16(vsrc+(long)(t)*KVBLK*KVP,(unsigned)__builtin_amdgcn_readfirstlane(vdst+(slot)))
  const int vb0=(int)(lds0+LDS_V)+((lane>>4)&1)*32+(lane&3)*8+(4*hi+((lane&15)>>2))*64;
  const char*Kbase=shm+LDS_K; bf16x8 kf[8];
  const lds_cptr shm3=(lds_cptr)shm; const lds_cptr kp0=shm3+LDS_K+hi*1024+r32*16; const lds_cptr vp0=shm3+LDS_V+((lane>>4)&1)*32+(lane&3)*8+(4*hi+((lane&15)>>2))*64;
  DMA_K(0,0);DMA_V(0,0);DMA_K(1,SLOTB);
  bf16x8 qr[4];
  #pragma unroll
  for(int d0=0;d0<4;++d0)qr[d0]=*reinterpret_cast<const bf16x8*>(&Qw[(long)r32*DM+d0*16+hi*8]);
  float mhat=0.f,l_reg=0.f;f32x16 o[2];o[0]=f32x16{};o[1]=f32x16{};f32x16 negm=f32x16{};asm volatile("":"+v"(negm));
  #define CMASK(P0,P1,t) do{}while(0)
  bool resc=false;
  #define START(P0,P1) do{ const float rm=rowmax(P0,P1); resc=false; \
    { const float dl=rm; mhat=fadd_s(mhat,dl); \
      _Pragma("unroll") for(int r=0;r<16;++r){P0[r]=fsub_s(P0[r],dl);P1[r]=fsub_s(P1[r],dl);} \
      _Pragma("unroll") for(int r=0;r<16;++r)negm[r]=-mhat; asm volatile("":"+v"(negm)); } \
    _Pragma("unroll") for(int r=0;r<16;++r)P0[r]=__builtin_amdgcn_exp2f(P0[r]); }while(0)
  #define RESC() do{ if(resc){ asm volatile("s_waitcnt lgkmcnt(0)":::"memory"); \
      _Pragma("unroll") for(int d_=0;d_<2;++d_) _Pragma("unroll") for(int r=0;r<16;++r)o[d_][r]*=wsf[crow(r,hi)]; } }while(0)
  f32x16 pA0,pA1,pB0,pB1;
  int sl_prev=0,sl_cur=0,sl_next=SLOTB;
  #define ROT() do{sl_prev=sl_cur;sl_cur=sl_next;sl_next=(sl_next==(NSLOT-1)*SLOTB)?0:sl_next+SLOTB;}while(0)
  DMA_K(2,2*SLOTB);
  WAIT_BAR(3);
  qkt(pA0,pA1,Kbase,qr,negm,r32,hi);asm volatile("s_nop 15\n\ts_nop 7":"+v"(pA0),"+v"(pA1));CMASK(pA0,pA1,0);
  START(pA0,pA1);
  _Pragma("unroll") for(int r=0;r<16;++r)pA1[r]=__builtin_amdgcn_exp2f(pA1[r]);
  WAIT_BAR(0);
  DMA_K(3,0);DMA_V(1,SLOTB);
  ROT();
  kload8(kf,kp0+sl_cur);
  WAIT_BAR(2);
  s16x4 vlo[8],vhi[8]; u32x4 pw0,pw1,pw2,pw3;
  #define PKW(P,B) cvtpk_s(P[B],P[B+1])
  #define PAF(k) __builtin_bit_cast(bf16x8,pw##k)
  #define VFR(i) (bf16x8){vlo[i][0],vlo[i][1],vlo[i][2],vlo[i][3],vhi[i][0],vhi[i][1],vhi[i][2],vhi[i][3]}
  #define PIN(x) asm volatile("":"+v"(x))
  #define MX3(a,b,c) __builtin_fmaxf(__builtin_fmaxf((a),(b)),(c))
  #define GAPA(MF,A0,A1,A2,A3,W0,W1,PW) do{ MF; sacc+=A0; sacc+=A1; sacc+=A2; sacc+=A3; PIN(sacc); W0; W1; PIN(PW); SBAR(); }while(0)
  #define EX(v) __builtin_amdgcn_exp2f(v)
  #define GAPB(MF,X,B) do{ MF; X[B]=EX(X[B]); X[B+1]=EX(X[B+1]); X[B+2]=EX(X[B+2]); X[B+3]=EX(X[B+3]); PIN(X); SBAR(); }while(0)
  #define VRD(i) do{ vlo[i]=vtr(vp_+(((i)>>2)*4096+((i)&3)*1024)); vhi[i]=vtr(vp_+(((i)>>2)*4096+((i)&3)*1024+512)); }while(0)
  #define KRD(G,j) do{ if(G){ kload2(kf,kp0+sl_next,j); SBAR(); } }while(0)
  #define STEP(C0,C1,P0,P1,t,GK,GV,GL) do{ SBAR(); \
    const lds_cptr vp_=vp0+sl_prev; \
    VRD(0); SBAR(); float sacc=(P0[0]+P0[1]); \
    GAPA(C0=__builtin_amdgcn_mfma_f32_32x32x16_bf16(kf[0],qr[0],negm,0,0,0), P0[2],P0[3],P0[4],P0[5],     pw0[0]=PKW(P0,0), pw0[1]=PKW(P0,2), pw0); \
    VRD(4); SBAR(); GAPA(C1=__builtin_amdgcn_mfma_f32_32x32x16_bf16(kf[1],qr[0],negm,0,0,0), P0[6],P0[7],P0[8],P0[9],     pw0[2]=PKW(P0,4), pw0[3]=PKW(P0,6), pw0); \
    VRD(1); SBAR(); GAPA(C0=__builtin_amdgcn_mfma_f32_32x32x16_bf16(kf[2],qr[1],C0,0,0,0),   P0[10],P0[11],P0[12],P0[13], pw1[0]=PKW(P0,8), pw1[1]=PKW(P0,10), pw1); \
    VRD(5); SBAR(); GAPA(C1=__builtin_amdgcn_mfma_f32_32x32x16_bf16(kf[3],qr[1],C1,0,0,0),   P0[14],P0[15],P1[0],P1[1],   pw1[2]=PKW(P0,12),pw1[3]=PKW(P0,14), pw1); \
    VRD(2); SBAR(); GAPA(C0=__builtin_amdgcn_mfma_f32_32x32x16_bf16(kf[4],qr[2],C0,0,0,0),   P1[2],P1[3],P1[4],P1[5],     pw2[0]=PKW(P1,0), pw2[1]=PKW(P1,2), pw2); \
    VRD(6); SBAR(); GAPA(C1=__builtin_amdgcn_mfma_f32_32x32x16_bf16(kf[5],qr[2],C1,0,0,0),   P1[6],P1[7],P1[8],P1[9],     pw2[2]=PKW(P1,4), pw2[3]=PKW(P1,6), pw2); \
    VRD(3); SBAR(); GAPA(C0=__builtin_amdgcn_mfma_f32_32x32x16_bf16(kf[6],qr[3],C0,0,0,0),   P1[10],P1[11],P1[12],P1[13], pw3[0]=PKW(P1,8), pw3[1]=PKW(P1,10), pw3); \
    VRD(7); SBAR(); GAPA(C1=__builtin_amdgcn_mfma_f32_32x32x16_bf16(kf[7],qr[3],C1,0,0,0),   P1[14],P1[15],0.f,0.f,       pw3[2]=PKW(P1,12),pw3[3]=PKW(P1,14), pw3); \
    l_reg+=sacc; \
    if(GK){DMA_K((t)+3,sl_cur);} if(GV){DMA_V((t)+1,sl_next);} \
    CMASK(C0,C1,t); \
    { float a=MX3(C0[0],C0[1],C1[0]),b=MX3(C0[2],C0[3],C1[1]); a=MX3(a,C1[2],C1[3]); \
      _Pragma("unroll") for(int r=4;r<16;r+=4){a=MX3(a,C0[r],C0[r+1]);b=MX3(b,C0[r+2],C0[r+3]);a=MX3(a,C1[r],C1[r+1]);b=MX3(b,C1[r+2],C1[r+3]);} \
      float rm=__builtin_fmaxf(a,b); { auto rr=__builtin_amdgcn_permlane32_swap(__float_as_uint(rm),__float_as_uint(rm),false,false); rm=__builtin_fmaxf(__uint_as_float(rr[0]),__uint_as_float(rr[1])); } \
      resc=false; \
      if(__builtin_expect(__any(rm>(float)THRL),0)){ const float dl=__builtin_fmaxf(rm,0.f); mhat+=dl; \
        _Pragma("unroll") for(int r=0;r<16;++r){C0[r]-=dl;C1[r]-=dl;} \
        _Pragma("unroll") for(int r=0;r<16;++r)negm[r]=-mhat; asm volatile("":"+v"(negm)); \
        const float f=__builtin_amdgcn_exp2f(-dl); l_reg*=f; if(hi==0)wsf[r32]=f; resc=true; } } \
    SBAR(); \
    GAPB(o[0]=__builtin_amdgcn_mfma_f32_32x32x16_bf16(PAF(0),VFR(0),o[0],0,0,0), C0,0); \
    GAPB(o[1]=__builtin_amdgcn_mfma_f32_32x32x16_bf16(PAF(0),VFR(4),o[1],0,0,0), C0,4); \
    KRD(GL,0); GAPB(o[0]=__builtin_amdgcn_mfma_f32_32x32x16_bf16(PAF(1),VFR(1),o[0],0,0,0), C0,8); \
    KRD(GL,1); GAPB(o[1]=__builtin_amdgcn_mfma_f32_32x32x16_bf16(PAF(1),VFR(5),o[1],0,0,0), C0,12); \
    KRD(GL,2); GAPB(o[0]=__builtin_amdgcn_mfma_f32_32x32x16_bf16(PAF(2),VFR(2),o[0],0,0,0), C1,0); \
    KRD(GL,3); GAPB(o[1]=__builtin_amdgcn_mfma_f32_32x32x16_bf16(PAF(2),VFR(6),o[1],0,0,0), C1,4); \
    GAPB(o[0]=__builtin_amdgcn_mfma_f32_32x32x16_bf16(PAF(3),VFR(3),o[0],0,0,0), C1,8); \
    GAPB(o[1]=__builtin_amdgcn_mfma_f32_32x32x16_bf16(PAF(3),VFR(7),o[1],0,0,0), C1,12); \
    }while(0)
  int t=1;
  #undef CMASK
  #define CMASK(P0,P1,t) do{}while(0)
  for(;t+5<NT;t+=2){
    STEP(pB0,pB1,pA0,pA1,t,true,true,true);     WAIT_BAR(2); RESC(); ROT();
    STEP(pA0,pA1,pB0,pB1,t+1,true,true,true);   WAIT_BAR(2); RESC(); ROT();
  }
  #undef CMASK
  #define CMASK(P0,P1,t) do{}while(0)
  #define ENDW(tt) do{ if((tt)+3<NT){WAIT_BAR(2);} else if((tt)+2<NT){WAIT_BAR(1);} else {WAIT_BAR(0);} }while(0)
  for(;t+1<NT;t+=2){
    STEP(pB0,pB1,pA0,pA1,t,(t+3<NT),(t+1<NT),(t+1<NT));       ENDW(t);   RESC(); ROT();
    STEP(pA0,pA1,pB0,pB1,t+1,(t+4<NT),(t+2<NT),(t+2<NT));     ENDW(t+1); RESC(); ROT();
  }
  STEP(pB0,pB1,pA0,pA1,NT-1,false,false,false); RESC();
  { float sacc=pB0[0]+pB0[1]; _Pragma("unroll") for(int r=2;r<16;++r)sacc+=pB0[r]; _Pragma("unroll") for(int r=0;r<16;++r)sacc+=pB1[r]; l_reg+=sacc;
    pw0=(u32x4){PKW(pB0,0),PKW(pB0,2),PKW(pB0,4),PKW(pB0,6)};pw1=(u32x4){PKW(pB0,8),PKW(pB0,10),PKW(pB0,12),PKW(pB0,14)};pw2=(u32x4){PKW(pB1,0),PKW(pB1,2),PKW(pB1,4),PKW(pB1,6)};pw3=(u32x4){PKW(pB1,8),PKW(pB1,10),PKW(pB1,12),PKW(pB1,14)};
    SBAR(); pv(o,vb0+sl_cur,PAF(0),PAF(1),PAF(2),PAF(3)); }
  #undef PKW
  #undef PAF
  #undef VFR
  #undef PIN
  #undef MX3
  #undef GAPA
  #undef GAPB
  #undef EX
  #undef VRD
  #undef KRD
  #undef STEP
  #undef ENDW
  {auto rr=__builtin_amdgcn_permlane32_swap(__float_as_uint(l_reg),__float_as_uint(l_reg),false,false);l_reg=__uint_as_float(rr[0])+__uint_as_float(rr[1]);}
  if(hi==0)wsf[32+r32]=l_reg;asm volatile("s_waitcnt lgkmcnt(0)":::"memory");
  float rli[16];
  #pragma unroll
  for(int r=0;r<16;++r)rli[r]=__builtin_amdgcn_rcpf(wsf[32+crow(r,hi)]);
  bf16*Ow=O+(qrow0+wid*QBLK)*DM+h*D;
  { bf16*stg=(bf16*)(shm+LDS_OST)+wid*2048;
    #pragma unroll
    for(int r=0;r<16;++r){const int orow=crow(r,hi);
      #pragma unroll
      for(int d0=0;d0<2;++d0)stg[orow*64+d0*32+r32]=__float2bfloat16(o[d0][r]*rli[r]);}
    asm volatile("s_waitcnt lgkmcnt(0)":::"memory");
    #pragma unroll
    for(int i=0;i<4;++i){const int row=i*8+(lane>>3),ch=lane&7; const u32x4 v=*(const u32x4*)(stg+row*64+ch*8); ATTN_STORE16(Ow+(long)row*DM+ch*8,v);} }
  asm volatile("s_waitcnt lgkmcnt(0)\n\ts_barrier":::"memory");
  #undef DMA_K
  #undef DMA_V
  #undef CMASK
  #undef START
  #undef RESC
  #undef ROT
}
constexpr int ATTN_LDS_BYTES=LDS_BYTES;
#undef SBAR
#undef WAIT_BAR
}

constexpr int NWAVES = 8;
constexpr int NB = 8, SEQ = 4096, CTXL = 256, TB = SEQ + CTXL  , MT = NB * TB  , DMODEL = 1024;
constexpr int NMODC = 6 * DMODEL, MODROWS = 9;
constexpr int QKVN = 1536, WINN = 3104, WINP = 3328;
constexpr int NEXP = 32, TOPK = 4, MPAD = MT * TOPK + NEXP * 256;
constexpr int NLAYER = 4;
constexpr float RMS_EPS = 1e-6f;
constexpr float ATT_C2 = 0.125f * 1.4426950408889634f;

constexpr size_t MiB = 1u << 20;
constexpr size_t WS_CTL = 0, CTL_ZERO_BYTES = 1 * MiB;
constexpr size_t WS_MOD = 1 * MiB, WS_ROPE = 2 * MiB, WS_MODP = 3 * MiB;
constexpr size_t WS_SLOT = 17 * MiB, WS_GATEW = 18 * MiB, WS_SLOTPOS = 19 * MiB;
constexpr size_t WS_WQKV = 20 * MiB, WS_WOA = 26 * MiB, WS_WIN = 30 * MiB, WS_WOG = 43 * MiB, WS_WGU = 48 * MiB, WS_WDN = 560 * MiB;
constexpr size_t WS_X = 816 * MiB, WS_XN = 952 * MiB, WS_Q = 1020 * MiB, WS_K = 1088 * MiB, WS_V = 1105 * MiB, WS_G = 1122 * MiB;
constexpr size_t WS_OF = 1343 * MiB, WS_OB = 1479 * MiB, WS_XG = 1615 * MiB, WS_ACT = 1903 * MiB, WS_Y = 2191 * MiB, WS_PAR = 2479 * MiB, WS_END = 2483 * MiB;
static_assert(WS_MODP + (size_t)16 * NLAYER * MODROWS * NMODC * 4 <= WS_SLOT && WS_WIN + (size_t)2 * WINP * 1024 * 2 <= WS_WOG && WS_G + (size_t)MT * WINP * 2 <= WS_OF && WS_XG + (size_t)MPAD * 1024 * 2 <= WS_ACT, "ws map");
constexpr int CW_TMO = 0, CW_BAR = 4096, CW_CNT = 16384;

constexpr int RING_OFF = 0, RING_BYTES = 131072;
constexpr int WR_STRIDE = 1028;
constexpr int LDS_AUX = 131584;
constexpr int AUX_LCNT = LDS_AUX, AUX_GB = LDS_AUX + 128, AUX_T2E = LDS_AUX + 256  , AUX_BASE = AUX_T2E + 2560  , AUX_NT = AUX_BASE + 128, AUX_ENT = AUX_NT + 64  ;
constexpr int MISC_OFF = 154624;
constexpr int LDS_BYTES = 155648;
static_assert(AUX_ENT + 4352 <= MISC_OFF && 32 * WR_STRIDE * 4 <= LDS_AUX, "LDS map");

#define GAS __attribute__((address_space(1)))
#define LAS __attribute__((address_space(3)))
typedef unsigned short bf16;
typedef unsigned v4u __attribute__((ext_vector_type(4)));
typedef float f32x4 __attribute__((ext_vector_type(4)));
typedef short bf16x8 __attribute__((ext_vector_type(8)));
typedef GAS unsigned gu32;
typedef GAS unsigned long long gu64;
#define RLX_AGENT __ATOMIC_RELAXED, __HIP_MEMORY_SCOPE_AGENT
#define LDS_WAIT() asm volatile("s_waitcnt lgkmcnt(0)" ::: "memory")
#define VM_WAIT() asm volatile("s_waitcnt vmcnt(0)" ::: "memory")
__device__ __forceinline__ unsigned long long rt() { return __builtin_amdgcn_s_memrealtime(); }
__device__ __forceinline__ unsigned f2bf(float f) { unsigned u = __builtin_bit_cast(unsigned, f); return (u + 0x7fffu + ((u >> 16) & 1u)) >> 16; }
__device__ __forceinline__ unsigned pk2(float lo, float hi) { return f2bf(lo) | (f2bf(hi) << 16); }

#define XB_TMO      128
#define XB_XCNT(j)  (256  + 64 * (j))
#define XB_XSUB(j)  (1280 + 64 * (j))
#define XB_XGEN(j)  (2304 + 64 * (j))
#define XB_TOP      3328
#define XB_TOPGEN   3392
#define XCD_BAR_WORDS 3456
#define XB_SPIN_CAP (1u << 18)

__device__ __forceinline__ unsigned xb_ld(unsigned* p)              { return __hip_atomic_load(p, __ATOMIC_RELAXED, __HIP_MEMORY_SCOPE_AGENT); }
__device__ __forceinline__ unsigned xb_add(unsigned* p, unsigned v) { return __hip_atomic_fetch_add(p, v, __ATOMIC_RELAXED, __HIP_MEMORY_SCOPE_AGENT); }
__device__ __forceinline__ unsigned xb_xcc_id() { return (unsigned)__builtin_amdgcn_s_getreg((3 << 11) | 20) & 0xFu; }
#define XB_SPIN(cond, bar) do { unsigned _sp = 0; while (cond) { __builtin_amdgcn_s_sleep(1); \
    if ((++_sp & 255u) == 0u) { if (xb_ld(&(bar)[XB_TMO])) break; if (_sp > XB_SPIN_CAP) { atomicAdd(&(bar)[XB_TMO], 1u); break; } } } } while (0)

struct XcdBarrier {
    unsigned* bar; unsigned x;
    volatile LAS unsigned* st;
};

__device__ __forceinline__ XcdBarrier xcd_barrier_post(unsigned* bar, volatile LAS unsigned* st) {
    XcdBarrier b; b.bar = bar; b.x = xb_xcc_id(); b.st = st;
    if (threadIdx.x == 0) (void)xb_add(&bar[XB_XCNT(b.x)], 1u);
    return b;
}
__device__ __forceinline__ void xcd_barrier_complete(unsigned* bar, unsigned x, unsigned& nloc, unsigned& nx) {
    const unsigned G = gridDim.x * gridDim.y * gridDim.z;
    unsigned sum, cnt, mine, sp = 0u;
    for (;;) {
        sum = 0u; cnt = 0u; mine = 0u;
#pragma unroll
        for (unsigned j = 0; j < 16; ++j) { const unsigned c = xb_ld(&bar[XB_XCNT(j)]); sum += c; cnt += (c > 0u) ? 1u : 0u; mine = (j == x) ? c : mine; }
        if (sum == G) break;
        __builtin_amdgcn_s_sleep(1);
        if ((++sp & 255u) == 0u) { if (xb_ld(&bar[XB_TMO])) break; if (sp > XB_SPIN_CAP) { atomicAdd(&bar[XB_TMO], 1u); break; } }
    }
    nloc = mine > 0u ? mine : 1u; nx = cnt > 0u ? cnt : 1u;
}

__device__ __forceinline__ void xcd_barrier(const XcdBarrier& b) {
    asm volatile("s_waitcnt vmcnt(0)" ::: "memory");
    __syncthreads();
    if (threadIdx.x == 0) {
        unsigned* bar = b.bar;
        __builtin_amdgcn_s_waitcnt(0);
        unsigned nloc = b.st[0], nx = b.st[1];
        if (nloc == 0u) { xcd_barrier_complete(bar, b.x, nloc, nx); b.st[0] = nloc; b.st[1] = nx; }
        const unsigned old = xb_add(&bar[XB_XSUB(b.x)], 1u);
        const unsigned gen = old / nloc;
        if (old + 1u == (gen + 1u) * nloc) {
            __builtin_amdgcn_fence(__ATOMIC_RELEASE, "agent");
            asm volatile("s_waitcnt vmcnt(0)" ::: "memory");
            const unsigned og = xb_add(&bar[XB_TOP], 1u);
            const unsigned tg = og / nx;
            if (og + 1u == (tg + 1u) * nx) xb_add(&bar[XB_TOPGEN], 1u);
            else XB_SPIN(xb_ld(&bar[XB_TOPGEN]) == tg, bar);
            __builtin_amdgcn_fence(__ATOMIC_ACQUIRE, "agent");
            xb_add(&bar[XB_XGEN(b.x)], 1u);
            asm volatile("s_waitcnt vmcnt(0)" ::: "memory");
        } else {
            XB_SPIN(xb_ld(&bar[XB_XGEN(b.x)]) == gen, bar);
            __builtin_amdgcn_fence(__ATOMIC_ACQUIRE, "agent");
            asm volatile("s_waitcnt vmcnt(0)" ::: "memory");
        }
    }
    __syncthreads();
}

typedef float f32x2 __attribute__((ext_vector_type(2)));
__device__ __forceinline__ float wave_sum(float v) {
#pragma unroll
    for (int o = 1; o < 64; o <<= 1) v += __shfl_xor(v, o);
    return v;
}
__device__ __forceinline__ float wave_max(float v) {
#pragma unroll
    for (int o = 1; o < 64; o <<= 1) v = fmaxf(v, __shfl_xor(v, o));
    return v;
}
__device__ __forceinline__ float bf2f(unsigned short h) { return __uint_as_float((unsigned)h << 16); }
__device__ __forceinline__ float silu_f(float x) { return x / (1.0f + __expf(-x)); }
__device__ __forceinline__ int mod_row(int m) { const int b = m / TB; return (m - b * TB < CTXL) ? 8 : b; }

__device__ __forceinline__ void transpose_item(const float* W, int K, int N, bf16* WT, int k0, int n0, int dst_row0, LAS float* scr, int lane) {
#pragma unroll 8
    for (int i = 0; i < 32; ++i) { const int kk = 2 * i + (lane >> 5); scr[kk * 33 + (lane & 31)] = W[(size_t)(k0 + kk) * N + n0 + (lane & 31)]; }
    LDS_WAIT(); asm volatile("" ::: "memory");
    const int c = lane & 7;
#pragma unroll
    for (int j = 0; j < 4; ++j) { const int n = (lane >> 3) + 8 * j; const LAS float* s = scr + (8 * c) * 33 + n;
        v4u o; o.x = pk2(s[0 * 33], s[1 * 33]); o.y = pk2(s[2 * 33], s[3 * 33]); o.z = pk2(s[4 * 33], s[5 * 33]); o.w = pk2(s[6 * 33], s[7 * 33]);
        *(GAS v4u*)(WT + (size_t)(dst_row0 + n) * K + k0 + 8 * c) = o; }
    LDS_WAIT(); asm volatile("" ::: "memory");
}

struct Args { const float* in[25]; float* out; unsigned char* ws; int ph_lo, ph_hi; };
constexpr int P_N1G = 0, P_N2G = 4096, P_QG = 8192, P_KG = 8320, P_GKF = 8448, P_GKB = 24832, P_BGF = 41216, P_BGB = 42240, P_OG = 43264, P_WR = 43776, P_BR = 174848, P_BGU = 174976, P_BDN = 437120, P_END = 568192;
#define LAUNDER_S(p) asm volatile("" : "+s"(p))
#define LAUNDER_V(p) asm volatile("" : "+v"(p))
#define PARF(ws) ((const float*)((ws) + WS_PAR))

__device__ __forceinline__ void p0_prologue(const Args& A, LAS unsigned char* lds, int gw, int NGW, int wave, int lane) {
    unsigned char* ws = A.ws;
    LAS float* scr = (LAS float*)(lds + RING_OFF + wave * 16384);
    constexpr int I_QKV = 2 * 16 * (QKVN / 32), I_WO = 2 * 16 * 32, I_WIN = 2 * 16 * (WINN / 32), I_GU = 128 * 16 * 64, I_DN = 128 * 16 * 32;
    constexpr int NITEMS = I_GU + I_DN + I_QKV + I_WO + I_WIN + I_WO;
    for (int it = gw; it < NITEMS; it += NGW) {
        int r = it;
        if (r < I_GU) { const int mat = r / (16 * 64), q = r - mat * (16 * 64), kb = q / 64, nb = q - kb * 64, n0 = nb * 32;
            const int dst = ((n0 & 1023) >> 7) * 256 + (n0 >> 10) * 128 + (n0 & 127);
            transpose_item(A.in[21] + (size_t)mat * 1024 * 2048, 1024, 2048, (bf16*)(ws + WS_WGU) + (size_t)mat * 2048 * 1024, kb * 64, n0, dst, scr, lane); continue; } r -= I_GU;
        if (r < I_DN) { const int mat = r / (16 * 32), q = r - mat * (16 * 32), kb = q / 32, nb = q - kb * 32;
            transpose_item(A.in[23] + (size_t)mat * 1024 * 1024, 1024, 1024, (bf16*)(ws + WS_WDN) + (size_t)mat * 1024 * 1024, kb * 64, nb * 32, nb * 32, scr, lane); continue; } r -= I_DN;
        if (r < I_QKV) { const int per = 16 * (QKVN / 32), mat = r / per, q = r - mat * per, kb = q / (QKVN / 32), nb = q - kb * (QKVN / 32);
            transpose_item(A.in[8] + (size_t)mat * 1024 * QKVN, 1024, QKVN, (bf16*)(ws + WS_WQKV) + (size_t)mat * QKVN * 1024, kb * 64, nb * 32, nb * 32, scr, lane); continue; } r -= I_QKV;
        if (r < I_WO) { const int mat = r / 512, q = r - mat * 512, kb = q / 32, nb = q - kb * 32;
            transpose_item(A.in[11] + (size_t)mat * 1024 * 1024, 1024, 1024, (bf16*)(ws + WS_WOA) + (size_t)mat * 1024 * 1024, kb * 64, nb * 32, nb * 32, scr, lane); continue; } r -= I_WO;
        if (r < I_WIN) { const int per = 16 * (WINN / 32), mat = r / per, q = r - mat * per, kb = q / (WINN / 32), nb = q - kb * (WINN / 32);
            transpose_item(A.in[12] + (size_t)mat * 1024 * WINN, 1024, WINN, (bf16*)(ws + WS_WIN) + (size_t)mat * WINP * 1024, kb * 64, nb * 32, nb * 32, scr, lane); continue; } r -= I_WIN;
        { const int mat = r / 512, q = r - mat * 512, kb = q / 32, nb = q - kb * 32;
            transpose_item(A.in[18] + (size_t)mat * 1024 * 1024, 1024, 1024, (bf16*)(ws + WS_WOG) + (size_t)mat * 1024 * 1024, kb * 64, nb * 32, nb * 32, scr, lane); }
    }
    for (int it = gw; it < 2 * (WINP - WINN); it += NGW) { const int mat = it / (WINP - WINN), rr = WINN + it - mat * (WINP - WINN);
        GAS v4u* p = (GAS v4u*)((bf16*)(ws + WS_WIN) + ((size_t)mat * WINP + rr) * 1024) + lane; p[0] = (v4u){0u, 0u, 0u, 0u}; p[64] = (v4u){0u, 0u, 0u, 0u}; }
    for (int it = gw; it < NLAYER * 24 * 16; it += NGW) {
        const int l = it / (24 * 16), q = it - l * (24 * 16), cg = q / 16, kc = q - cg * 16;
        float s[MODROWS];
#pragma unroll
        for (int r = 0; r < MODROWS; ++r) { const float cv = (r < 8) ? A.in[1][r * 1024 + kc * 64 + lane] : A.in[3][kc * 64 + lane]; s[r] = silu_f(cv); }
        f32x4 acc[MODROWS];
#pragma unroll
        for (int r = 0; r < MODROWS; ++r) acc[r] = (f32x4){0.f, 0.f, 0.f, 0.f};
        const float* wp = A.in[4] + ((size_t)l * 1024 + kc * 64) * NMODC + cg * 256 + 4 * lane;
#pragma unroll 4
        for (int kk = 0; kk < 64; ++kk) { const f32x4 w = *(const f32x4*)(wp + (size_t)kk * NMODC);
#pragma unroll
            for (int r = 0; r < MODROWS; ++r) { const float sv = __shfl(s[r], kk); acc[r] = acc[r] + w * sv; } }
        float* op = (float*)(ws + WS_MODP) + (size_t)kc * (NLAYER * MODROWS * NMODC) + (size_t)l * MODROWS * NMODC + cg * 256 + 4 * lane;
#pragma unroll
        for (int r = 0; r < MODROWS; ++r) *(f32x4*)(op + (size_t)r * NMODC) = acc[r];
    }
    for (int m = gw; m < MT; m += NGW) { const int b = m / TB, w = m - b * TB;
        const float* src = (w < CTXL) ? A.in[2] + ((size_t)b * CTXL + w) * 1024 : A.in[0] + ((size_t)b * SEQ + (w - CTXL)) * 1024;
        const GAS f32x4* sp = (const GAS f32x4*)src + lane; GAS f32x4* dp = (GAS f32x4*)((float*)(ws + WS_X) + (size_t)m * 1024) + lane;
#pragma unroll
        for (int j = 0; j < 4; ++j) dp[64 * j] = sp[64 * j]; }
    { float* par = (float*)(ws + WS_PAR); const int gt = gw * 64 + lane, NGT = NGW * 64;
#define CPY(src, n, off) for (int i = gt; i < (n); i += NGT) par[(off) + i] = A.in[src][i];
      CPY(6, 4096, P_N1G) CPY(7, 4096, P_N2G) CPY(9, 128, P_QG) CPY(10, 128, P_KG) CPY(13, 16384, P_GKF) CPY(15, 16384, P_GKB) CPY(14, 1024, P_BGF) CPY(16, 1024, P_BGB)
      CPY(17, 512, P_OG) CPY(19, 131072, P_WR) CPY(20, 128, P_BR) CPY(22, 262144, P_BGU) CPY(24, 131072, P_BDN)
#undef CPY
    }
    for (int idx = gw * 64 + lane; idx < SEQ * 32; idx += NGW * 64) { const int s = idx >> 5, i = idx & 31;
        const float invf = 1.0f / powf(10000.0f, (float)(i & 15) * (1.0f / 16.0f));
        const float ang = (float)((i < 16) ? (s >> 6) : (s & 63)) * invf;
        ((float*)(ws + WS_ROPE))[idx] = cosf(ang); ((float*)(ws + WS_ROPE))[SEQ * 32 + idx] = sinf(ang); }
}
__device__ __forceinline__ void p1_mod_reduce(const Args& A, int gtid, int NGT) {
    const float* P = (const float*)(A.ws + WS_MODP); float* Mo = (float*)(A.ws + WS_MOD);
    constexpr int N = NLAYER * MODROWS * NMODC;
    for (int i = gtid; i < N; i += NGT) { const int l = i / (MODROWS * NMODC), c = i % NMODC; float s = A.in[5][l * NMODC + c];
#pragma unroll
        for (int k = 0; k < 16; ++k) s += P[(size_t)k * N + i];
        Mo[i] = s; }
}
__device__ __forceinline__ void modulate_row(const float* xrow, const float* ng, const float* shp, const float* scp, bf16* orow, int lane, f32x4 (&y)[4]) {
    const GAS f32x4* xr = (const GAS f32x4*)xrow + lane;
    float ss = 0.f;
#pragma unroll
    for (int j = 0; j < 4; ++j) { y[j] = xr[64 * j]; ss += (y[j].x * y[j].x + y[j].y * y[j].y) + (y[j].z * y[j].z + y[j].w * y[j].w); }
    const float rs = 1.0f / sqrtf(wave_sum(ss) * (1.0f / 1024.0f) + RMS_EPS);
    GAS unsigned long long* o8 = (GAS unsigned long long*)orow + lane;
#pragma unroll
    for (int j = 0; j < 4; ++j) { const f32x4 g = ((const GAS f32x4*)ng)[64 * j + lane], sh = ((const GAS f32x4*)shp)[64 * j + lane], sc = ((const GAS f32x4*)scp)[64 * j + lane];
        y[j] = (y[j] * rs) * g * (sc + 1.0f) + sh;
        o8[64 * j] = (unsigned long long)pk2(y[j].x, y[j].y) | ((unsigned long long)pk2(y[j].z, y[j].w) << 32); }
}
__device__ __forceinline__ void phase_modulate1(unsigned char* ws, int layer, int gw, int NGW, int lane) {
    const float* X = (const float*)(ws + WS_X); bf16* XN = (bf16*)(ws + WS_XN);
    const float* ng = PARF(ws) + P_N1G + layer * 1024; const float* Mo = (const float*)(ws + WS_MOD) + (size_t)layer * MODROWS * NMODC;
    for (int m = gw; m < MT; m += NGW) { const int mr = mod_row(m); f32x4 y[4];
        modulate_row(X + (size_t)m * 1024, ng, Mo + (size_t)mr * NMODC + 0 * 1024, Mo + (size_t)mr * NMODC + 1 * 1024, XN + (size_t)m * 1024, lane, y); }
}
__device__ __forceinline__ void phase_qknorm_rope(unsigned char* ws, int la, int gw, int NGW, int lane) {
    bf16* Qb = (bf16*)(ws + WS_Q); bf16* Kb = (bf16*)(ws + WS_K);
    const float* qg = PARF(ws) + P_QG + la * 64; const float* kg = PARF(ws) + P_KG + la * 64; const float* ropec = (const float*)(ws + WS_ROPE); const float* ropes = ropec + SEQ * 32;
    const int i = lane & 31, hs = lane >> 5;
    for (int m = gw; m < MT; m += NGW) { const int b = m / TB, w = m - b * TB; const bool lat = w >= CTXL;
        float cs = 1.f, sn = 0.f; if (lat) { cs = ropec[(w - CTXL) * 32 + i]; sn = ropes[(w - CTXL) * 32 + i]; }
#pragma unroll 2
        for (int hh = 0; hh < 20; hh += 2) { const int hd = hh + hs;
            unsigned* p = (hd < 16) ? (unsigned*)(Qb + (size_t)m * 1024 + hd * 64) + i : (unsigned*)(Kb + (size_t)m * 256 + (hd - 16) * 64) + i;
            const float* gp = (hd < 16) ? qg : kg; const float scl = (hd < 16) ? ATT_C2 : 1.0f;
            const unsigned v = *p; const float x1 = __uint_as_float(v << 16), x2 = __uint_as_float(v & 0xffff0000u);
            float ss = x1 * x1 + x2 * x2;
#pragma unroll
            for (int o = 1; o < 32; o <<= 1) ss += __shfl_xor(ss, o);
            const float rs = 1.0f / sqrtf(ss * (1.0f / 64.0f) + RMS_EPS);
            const float y1 = x1 * rs * gp[2 * i], y2 = x2 * rs * gp[2 * i + 1];
            const float r1 = (y1 * cs - y2 * sn) * scl, r2 = (y1 * sn + y2 * cs) * scl;
            *p = pk2(r1, r2); }
    }
}
__device__ __forceinline__ void phase_gla_recurrent(unsigned char* ws, int lg, LAS unsigned char* lds, int tid) {
    const int unit = blockIdx.x; if (unit >= 128) return;
    const int half = unit & 1, dir = (unit >> 1) & 1, h = (unit >> 2) & 3, b = unit >> 4;
    const bf16* G = (const bf16*)(ws + WS_G);
    float* Oo = (float*)(ws + (dir ? WS_OB : WS_OF));
    const float* wg = PARF(ws) + (dir ? P_GKB : P_GKF) + (size_t)lg * 16 * 512; const float* bg = PARF(ws) + (dir ? P_BGB : P_BGF) + lg * 512;
    LAS float* qq = (LAS float*)(lds + RING_OFF); LAS float* kk = qq + 64 * 128; LAS float* dd = kk + 64 * 128; LAS float* vv = dd + 64 * 128;
    const int sd = tid & 127, st0 = tid >> 7;
    float wcol[16];
#pragma unroll
    for (int r = 0; r < 16; ++r) wcol[r] = wg[r * 512 + h * 128 + sd];
    const float bcol = bg[h * 128 + sd];
    const int c = tid >> 2, dq = tid & 3;
    float s[32];
#pragma unroll
    for (int j = 0; j < 32; ++j) s[j] = 0.f;
    const float qscale = 0.08838834764831845f;
    for (int ch = 0; ch < TB / 64; ++ch) {
        __syncthreads();
#pragma unroll 4
        for (int i = 0; i < 16; ++i) { const int tt = st0 + 4 * i, n = 64 * ch + tt;
            const int w = dir ? (n < CTXL ? (CTXL - 1 - n) : (TB + CTXL - 1 - n)) : n;
            const bf16* gr = G + ((size_t)b * TB + w) * WINP;
            const float qv = bf2f(gr[h * 128 + sd]) * qscale, kv = bf2f(gr[512 + h * 128 + sd]);
            const bf16* lp = gr + 3072 + dir * 16; float z = bcol;
#pragma unroll
            for (int r = 0; r < 16; ++r) z += bf2f(lp[r]) * wcol[r];
            const float ls = fminf(z, 0.f) - log1pf(__expf(-fabsf(z)));
            qq[tt * 128 + sd] = qv; kk[tt * 128 + sd] = kv; dd[tt * 128 + sd] = __expf(ls * (1.0f / 16.0f));
            vv[tt * 128 + sd] = bf2f(gr[1024 + h * 256 + half * 128 + sd]); }
        __syncthreads();
        for (int tt = 0; tt < 64; ++tt) { const int n = 64 * ch + tt; const int w = dir ? (n < CTXL ? (CTXL - 1 - n) : (TB + CTXL - 1 - n)) : n;
            const float v = vv[tt * 128 + c]; float acc = 0.f;
            const LAS f32x4* q4 = (const LAS f32x4*)(qq + tt * 128 + dq * 32); const LAS f32x4* k4 = (const LAS f32x4*)(kk + tt * 128 + dq * 32); const LAS f32x4* d4 = (const LAS f32x4*)(dd + tt * 128 + dq * 32);
#pragma unroll
            for (int j = 0; j < 8; ++j) { const f32x4 qv = q4[j], kv = k4[j], dv = d4[j];
                s[4 * j + 0] = s[4 * j + 0] * dv.x + kv.x * v; acc += qv.x * s[4 * j + 0];
                s[4 * j + 1] = s[4 * j + 1] * dv.y + kv.y * v; acc += qv.y * s[4 * j + 1];
                s[4 * j + 2] = s[4 * j + 2] * dv.z + kv.z * v; acc += qv.z * s[4 * j + 2];
                s[4 * j + 3] = s[4 * j + 3] * dv.w + kv.w * v; acc += qv.w * s[4 * j + 3]; }
            acc += __shfl_xor(acc, 1); acc += __shfl_xor(acc, 2);
            if (dq == 0) Oo[((size_t)b * TB + w) * 1024 + h * 256 + half * 128 + c] = acc; }
    }
}
__device__ __forceinline__ void phase_gla_readout(unsigned char* ws, int lg, int gw, int NGW, int lane) {
    const float* OF = (const float*)(ws + WS_OF); const float* OB = (const float*)(ws + WS_OB); const bf16* G = (const bf16*)(ws + WS_G); bf16* OG = (bf16*)(ws + WS_Q);
    const f32x4 og = ((const GAS f32x4*)(PARF(ws) + P_OG + lg * 256))[lane];
    for (int m = gw; m < MT; m += NGW) {
#pragma unroll
        for (int hh = 0; hh < 4; ++hh) { const size_t off = (size_t)m * 1024 + hh * 256 + 4 * lane;
            f32x4 o = *(const GAS f32x4*)(OF + off) + *(const GAS f32x4*)(OB + off);
            const float ss = wave_sum((o.x * o.x + o.y * o.y) + (o.z * o.z + o.w * o.w));
            const float rs = 1.0f / sqrtf(ss * (1.0f / 256.0f) + RMS_EPS);
            const unsigned long long rv = *(const GAS unsigned long long*)(G + (size_t)m * WINP + 2048 + hh * 256 + 4 * lane);
            const float r0 = __uint_as_float((unsigned)(rv & 0xffffu) << 16), r1 = __uint_as_float((unsigned)(rv >> 16) << 16), r2 = __uint_as_float((unsigned)((rv >> 32) & 0xffffu) << 16), r3 = __uint_as_float((unsigned)(rv >> 48) << 16);
            o = o * rs * og;
            o.x *= silu_f(r0); o.y *= silu_f(r1); o.z *= silu_f(r2); o.w *= silu_f(r3);
            *(GAS unsigned long long*)(OG + off) = (unsigned long long)pk2(o.x, o.y) | ((unsigned long long)pk2(o.z, o.w) << 32); }
    }
}
constexpr size_t GL_TILE = 64 * 128 * 2;
constexpr size_t WS_GQ = WS_XG, WS_GKH = WS_XG + 68 * MiB, WS_GKT = WS_XG + 136 * MiB, WS_GVT = WS_XG + 204 * MiB, WS_GDL = WS_ACT, WS_SX = WS_OF;
static_assert((size_t)2176 * 2 * GL_TILE <= 68 * MiB && (size_t)2176 * 256 * 64 * 2 <= 68 * MiB && (size_t)64 * 68 * 65536 <= 272 * MiB, "gla buffers");
typedef float f32x16 __attribute__((ext_vector_type(16)));
__device__ __forceinline__ float log_sigmoid_f(float z) { return fminf(z, 0.f) - log1pf(__expf(-fabsf(z))); }

__device__ __forceinline__ void phase_gla_g0(unsigned char* ws, int lg, LAS unsigned char* lds, int tid) {
    const bf16* G = (const bf16*)(ws + WS_G);
    LAS float* tot = (LAS float*)(lds + RING_OFF);
    const int d = tid & 127, tb = tid >> 7;
    for (int item = blockIdx.x; item < 2176 * 2; item += gridDim.x) {
        const int dir = item & 1, cn = item >> 1, n = cn % 68, bh = cn / 68, h = bh & 3, b = bh >> 2;
        const float* wg = PARF(ws) + (dir ? P_GKB : P_GKF) + (size_t)lg * 16 * 512 + h * 128 + d;
        float wcol[16];
#pragma unroll
        for (int r = 0; r < 16; ++r) wcol[r] = wg[r * 512];
        const float bcol = (PARF(ws) + (dir ? P_BGB : P_BGF))[lg * 512 + h * 128 + d];
        const size_t row0 = (size_t)b * TB + 64 * n;
        float c[16];
        float run = 0.f;
#pragma unroll
        for (int i = 0; i < 16; ++i) { const int p = 16 * tb + i, t = dir ? 63 - p : p;
            const bf16* lp = G + (row0 + t) * WINP + 3072 + dir * 16;
            const v4u l0 = *(const GAS v4u*)lp, l1 = *(const GAS v4u*)(lp + 8);
            float z = bcol;
            z += __uint_as_float(l0.x << 16) * wcol[0] + __uint_as_float(l0.x & 0xffff0000u) * wcol[1]; z += __uint_as_float(l0.y << 16) * wcol[2] + __uint_as_float(l0.y & 0xffff0000u) * wcol[3];
            z += __uint_as_float(l0.z << 16) * wcol[4] + __uint_as_float(l0.z & 0xffff0000u) * wcol[5]; z += __uint_as_float(l0.w << 16) * wcol[6] + __uint_as_float(l0.w & 0xffff0000u) * wcol[7];
            z += __uint_as_float(l1.x << 16) * wcol[8] + __uint_as_float(l1.x & 0xffff0000u) * wcol[9]; z += __uint_as_float(l1.y << 16) * wcol[10] + __uint_as_float(l1.y & 0xffff0000u) * wcol[11];
            z += __uint_as_float(l1.z << 16) * wcol[12] + __uint_as_float(l1.z & 0xffff0000u) * wcol[13]; z += __uint_as_float(l1.w << 16) * wcol[14] + __uint_as_float(l1.w & 0xffff0000u) * wcol[15];
            run += log_sigmoid_f(z) * (1.0f / 16.0f); c[i] = run; }
        __syncthreads();
        tot[tb * 128 + d] = run;
        __syncthreads();
        const float t0 = tot[d], t1 = tot[128 + d], t2 = tot[256 + d], t3 = tot[384 + d];
        const float pre = (tb > 0 ? t0 : 0.f) + (tb > 1 ? t1 : 0.f) + (tb > 2 ? t2 : 0.f), clast = (t0 + t1) + (t2 + t3);
        bf16* Qt = (bf16*)(ws + WS_GQ) + (size_t)item * 8192; bf16* Kh = (bf16*)(ws + WS_GKH) + (size_t)item * 8192; bf16* KtT = (bf16*)(ws + WS_GKT) + (size_t)item * 8192;
        float kt[16];
#pragma unroll
        for (int i = 0; i < 16; ++i) { const int p = 16 * tb + i, t = dir ? 63 - p : p; const float cc = pre + c[i];
            const bf16* gr = G + (row0 + t) * WINP + h * 128 + d;
            const float qv = bf2f(gr[0]) * 0.08838834764831845f, kv = bf2f(gr[512]);
            Qt[t * 128 + d] = (bf16)f2bf(qv * __expf(cc)); Kh[t * 128 + d] = (bf16)f2bf(kv * __expf(-cc)); kt[i] = kv * __expf(clast - cc); }
        {
            const int ts = dir ? 48 - 16 * tb : 16 * tb;
            v4u w0, w1;
            if (dir == 0) { w0.x = pk2(kt[0], kt[1]); w0.y = pk2(kt[2], kt[3]); w0.z = pk2(kt[4], kt[5]); w0.w = pk2(kt[6], kt[7]); w1.x = pk2(kt[8], kt[9]); w1.y = pk2(kt[10], kt[11]); w1.z = pk2(kt[12], kt[13]); w1.w = pk2(kt[14], kt[15]); }
            else { w0.x = pk2(kt[15], kt[14]); w0.y = pk2(kt[13], kt[12]); w0.z = pk2(kt[11], kt[10]); w0.w = pk2(kt[9], kt[8]); w1.x = pk2(kt[7], kt[6]); w1.y = pk2(kt[5], kt[4]); w1.z = pk2(kt[3], kt[2]); w1.w = pk2(kt[1], kt[0]); }
            GAS v4u* kp = (GAS v4u*)(KtT + d * 64 + ts); kp[0] = w0; kp[1] = w1; }
        if (tb == 0) ((float*)(ws + WS_GDL))[(size_t)item * 128 + d] = __expf(clast);
        if (dir == 0) {
            const int dv = tid & 255, th = tid >> 8; const bf16* vp = G + (row0 + 32 * th) * WINP + 1024 + h * 256 + dv;
            unsigned wv[16];
#pragma unroll
            for (int j = 0; j < 16; ++j) wv[j] = (unsigned)vp[(size_t)(2 * j) * WINP] | ((unsigned)vp[(size_t)(2 * j + 1) * WINP] << 16);
            GAS v4u* op = (GAS v4u*)((bf16*)(ws + WS_GVT) + ((size_t)cn * 256 + dv) * 64 + 32 * th);
            op[0] = (v4u){wv[0], wv[1], wv[2], wv[3]}; op[1] = (v4u){wv[4], wv[5], wv[6], wv[7]}; op[2] = (v4u){wv[8], wv[9], wv[10], wv[11]}; op[3] = (v4u){wv[12], wv[13], wv[14], wv[15]}; }
    }
}
__device__ __forceinline__ void phase_gla_g12(unsigned char* ws, int gwv, int lane) {
    if (gwv >= 2048) return;
    const int chain = gwv >> 5, blk = gwv & 31, kb = blk & 3, vb = blk >> 2, dir = chain & 1, bh = chain >> 1;
    const int r = lane & 31, hh = lane >> 5;
    f32x16 acc;
#pragma unroll
    for (int g = 0; g < 16; ++g) acc[g] = 0.f;
    for (int m = 0; m < 68; ++m) {
        const int n = dir ? (m < 4 ? 3 - m : 71 - m) : m; const size_t cn = (size_t)bh * 68 + n, item = cn * 2 + dir;
        bf16* sp = (bf16*)(ws + WS_SX) + (((size_t)(bh * 2 + dir) * 68 + n) * 256 + 32 * vb + r) * 128 + 32 * kb + 4 * hh;
#pragma unroll
        for (int gg = 0; gg < 4; ++gg) *(GAS unsigned long long*)(sp + 8 * gg) = (unsigned long long)pk2(acc[4 * gg], acc[4 * gg + 1]) | ((unsigned long long)pk2(acc[4 * gg + 2], acc[4 * gg + 3]) << 32);
        const bf16* ap = (const bf16*)(ws + WS_GKT) + item * 8192 + (size_t)(32 * kb + r) * 64 + 8 * hh;
        const bf16* bp = (const bf16*)(ws + WS_GVT) + (cn * 256 + 32 * vb + r) * 64 + 8 * hh;
        const float* dp = (const float*)(ws + WS_GDL) + item * 128 + 32 * kb + 4 * hh;
        bf16x8 af[4], bfr[4]; f32x4 dl[4];
#pragma unroll
        for (int ks = 0; ks < 4; ++ks) { af[ks] = *(const GAS bf16x8*)(ap + 16 * ks); bfr[ks] = *(const GAS bf16x8*)(bp + 16 * ks); dl[ks] = *(const GAS f32x4*)(dp + 8 * ks); }
#pragma unroll
        for (int gg = 0; gg < 4; ++gg) { acc[4 * gg] *= dl[gg].x; acc[4 * gg + 1] *= dl[gg].y; acc[4 * gg + 2] *= dl[gg].z; acc[4 * gg + 3] *= dl[gg].w; }
#pragma unroll
        for (int ks = 0; ks < 4; ++ks) acc = __builtin_amdgcn_mfma_f32_32x32x16_bf16(af[ks], bfr[ks], acc, 0, 0, 0);
    }
}
constexpr int G3_LD = 260;
__device__ __forceinline__ void phase_gla_g3(unsigned char* ws, int lg, LAS unsigned char* lds, int tid) {
    const int lane = tid & 63, wave = __builtin_amdgcn_readfirstlane(tid >> 6), r = lane & 31, hh = lane >> 5, tr = wave & 1, vg = wave >> 1;
    LAS float* OL = (LAS float*)(lds + RING_OFF);
    const bf16* G = (const bf16*)(ws + WS_G); bf16* OG = (bf16*)(ws + WS_Q);
    for (int cn = blockIdx.x; cn < 2176; cn += gridDim.x) {
        const int n = cn % 68, bh = cn / 68, h = bh & 3, b = bh >> 2;
        f32x16 P0, P1, O0, O1;
#pragma unroll
        for (int g = 0; g < 16; ++g) { P0[g] = 0.f; P1[g] = 0.f; O0[g] = 0.f; O1[g] = 0.f; }
#pragma unroll
        for (int dir = 0; dir < 2; ++dir) {
            const size_t item = (size_t)cn * 2 + dir;
            const bf16* Qt = (const bf16*)(ws + WS_GQ) + item * 8192 + (size_t)(32 * tr + r) * 128 + 8 * hh;
            const bf16* Kh = (const bf16*)(ws + WS_GKH) + item * 8192 + (size_t)r * 128 + 8 * hh;
            const bf16* Sx = (const bf16*)(ws + WS_SX) + (((size_t)(bh * 2 + dir) * 68 + n) * 256 + 64 * vg + r) * 128 + 8 * hh;
            bf16x8 qf[8];
#pragma unroll
            for (int s = 0; s < 8; ++s) qf[s] = *(const GAS bf16x8*)(Qt + 16 * s);
            f32x16 X0, X1;
#pragma unroll
            for (int g = 0; g < 16; ++g) { X0[g] = 0.f; X1[g] = 0.f; }
#pragma unroll
            for (int s = 0; s < 8; ++s) { const bf16x8 k0 = *(const GAS bf16x8*)(Kh + 16 * s), k1 = *(const GAS bf16x8*)(Kh + 32 * 128 + 16 * s);
                X0 = __builtin_amdgcn_mfma_f32_32x32x16_bf16(k0, qf[s], X0, 0, 0, 0); X1 = __builtin_amdgcn_mfma_f32_32x32x16_bf16(k1, qf[s], X1, 0, 0, 0); }
            const int ti = 32 * tr + r;
#pragma unroll
            for (int g = 0; g < 16; ++g) { const int tj = (g & 3) + 8 * (g >> 2) + 4 * hh;
                const bool k0 = dir ? (tj >= ti) : (tj <= ti), k1 = dir ? (tj + 32 >= ti) : (tj + 32 <= ti);
                P0[g] += k0 ? X0[g] : 0.f; P1[g] += k1 ? X1[g] : 0.f; }
#pragma unroll
            for (int s = 0; s < 8; ++s) { const bf16x8 s0 = *(const GAS bf16x8*)(Sx + 16 * s), s1 = *(const GAS bf16x8*)(Sx + 32 * 128 + 16 * s);
                O0 = __builtin_amdgcn_mfma_f32_32x32x16_bf16(qf[s], s0, O0, 0, 0, 0); O1 = __builtin_amdgcn_mfma_f32_32x32x16_bf16(qf[s], s1, O1, 0, 0, 0); }
        }
        { const bf16* Vt = (const bf16*)(ws + WS_GVT) + ((size_t)cn * 256 + 64 * vg + r) * 64 + 4 * hh;
#pragma unroll
          for (int jb = 0; jb < 2; ++jb)
#pragma unroll
            for (int s2 = 0; s2 < 2; ++s2) {
                const f32x16& P = jb ? P1 : P0;
                v4u pa; pa.x = pk2(P[8 * s2 + 0], P[8 * s2 + 1]); pa.y = pk2(P[8 * s2 + 2], P[8 * s2 + 3]); pa.z = pk2(P[8 * s2 + 4], P[8 * s2 + 5]); pa.w = pk2(P[8 * s2 + 6], P[8 * s2 + 7]);
                const bf16x8 af = __builtin_bit_cast(bf16x8, pa);
#pragma unroll
                for (int vbk = 0; vbk < 2; ++vbk) { const bf16* vp = Vt + (size_t)vbk * 32 * 64 + 32 * jb + 16 * s2;
                    const unsigned long long lo = *(const GAS unsigned long long*)vp, hi8 = *(const GAS unsigned long long*)(vp + 8);
                    v4u pb; pb.x = (unsigned)lo; pb.y = (unsigned)(lo >> 32); pb.z = (unsigned)hi8; pb.w = (unsigned)(hi8 >> 32);
                    const bf16x8 bfv = __builtin_bit_cast(bf16x8, pb);
                    if (vbk == 0) O0 = __builtin_amdgcn_mfma_f32_32x32x16_bf16(af, bfv, O0, 0, 0, 0); else O1 = __builtin_amdgcn_mfma_f32_32x32x16_bf16(af, bfv, O1, 0, 0, 0); } } }
        __syncthreads();
#pragma unroll
        for (int g = 0; g < 16; ++g) { const int t = 32 * tr + (g & 3) + 8 * (g >> 2) + 4 * hh; OL[t * G3_LD + 64 * vg + r] = O0[g]; OL[t * G3_LD + 64 * vg + 32 + r] = O1[g]; }
        __syncthreads();
        { const int t = tid >> 3, cc = tid & 7; const LAS f32x4* op = (const LAS f32x4*)(OL + t * G3_LD + 32 * cc);
          f32x4 o[8]; float ss = 0.f;
#pragma unroll
          for (int j = 0; j < 8; ++j) { o[j] = op[j]; ss += (o[j].x * o[j].x + o[j].y * o[j].y) + (o[j].z * o[j].z + o[j].w * o[j].w); }
          ss += __shfl_xor(ss, 1); ss += __shfl_xor(ss, 2); ss += __shfl_xor(ss, 4);
          const float rs = 1.0f / sqrtf(ss * (1.0f / 256.0f) + RMS_EPS);
          const size_t row = (size_t)b * TB + 64 * n + t;
          const GAS v4u* rp = (const GAS v4u*)(G + row * WINP + 2048 + h * 256 + 32 * cc); const GAS f32x4* gp = (const GAS f32x4*)(PARF(ws) + P_OG + lg * 256 + 32 * cc);
          GAS v4u* dst = (GAS v4u*)(OG + row * 1024 + h * 256 + 32 * cc);
#pragma unroll
          for (int j = 0; j < 4; ++j) { const v4u rv = rp[j]; const f32x4 g0 = gp[2 * j], g1 = gp[2 * j + 1]; const f32x4 a = o[2 * j] * rs * g0, c2 = o[2 * j + 1] * rs * g1;
              v4u w;
              w.x = pk2(a.x * silu_f(__uint_as_float(rv.x << 16)), a.y * silu_f(__uint_as_float(rv.x & 0xffff0000u)));
              w.y = pk2(a.z * silu_f(__uint_as_float(rv.y << 16)), a.w * silu_f(__uint_as_float(rv.y & 0xffff0000u)));
              w.z = pk2(c2.x * silu_f(__uint_as_float(rv.z << 16)), c2.y * silu_f(__uint_as_float(rv.z & 0xffff0000u)));
              w.w = pk2(c2.z * silu_f(__uint_as_float(rv.w << 16)), c2.w * silu_f(__uint_as_float(rv.w & 0xffff0000u)));
              dst[j] = w; } }
    }
}
__device__ __forceinline__ void phase_modulate2_route(unsigned char* ws, int layer, LAS unsigned char* lds, int gw, int NGW, int wave, int lane, int tid) {
    const float* X = (const float*)(ws + WS_X); bf16* XN = (bf16*)(ws + WS_XN);
    const float* ng = PARF(ws) + P_N2G + layer * 1024; const float* Mo = (const float*)(ws + WS_MOD) + (size_t)layer * MODROWS * NMODC;
    LAS float* wr = (LAS float*)(lds + RING_OFF);
    LAS unsigned* lcnt = (LAS unsigned*)(lds + AUX_LCNT); LAS unsigned* gb = (LAS unsigned*)(lds + AUX_GB); LAS unsigned* ent = (LAS unsigned*)(lds + AUX_ENT) + wave * (17 * 4 * 2);
    { const float* wsrc = PARF(ws) + P_WR + (size_t)layer * 1024 * 32;
      for (int idx = tid; idx < 1024 * 32; idx += NWAVES * 64) { const int k = idx >> 5, e = idx & 31; wr[e * WR_STRIDE + k] = wsrc[idx]; }
      if (tid < 32) lcnt[tid] = 0u; }
    __syncthreads();
    const float brt = (PARF(ws) + P_BR)[layer * 32 + (lane >> 1)];
    gu32* cnt = (gu32*)(ws + WS_CTL) + CW_CNT + layer * 32 * 16;
    int ri = 0;
    for (int m = gw; m < MT; m += NGW, ++ri) { const int mr = mod_row(m); f32x4 y[4];
        modulate_row(X + (size_t)m * 1024, ng, Mo + (size_t)mr * NMODC + 3 * 1024, Mo + (size_t)mr * NMODC + 4 * 1024, XN + (size_t)m * 1024, lane, y);
        float p[32];
#pragma unroll
        for (int e = 0; e < 32; ++e) { float a = 0.f;
#pragma unroll
            for (int j = 0; j < 4; ++j) { const f32x4 w = *(const LAS f32x4*)(wr + e * WR_STRIDE + 256 * j + 4 * lane); a += (y[j].x * w.x + y[j].y * w.y) + (y[j].z * w.z + y[j].w * w.w); }
            p[e] = a; }
#define RED_STEP(H, BIT) _Pragma("unroll") for (int e = 0; e < H; ++e) { const bool up = (lane & BIT) != 0; const float keep = up ? p[e + H] : p[e], send = up ? p[e] : p[e + H]; p[e] = keep + __shfl_xor(send, BIT); }
        RED_STEP(16, 32) RED_STEP(8, 16) RED_STEP(4, 8) RED_STEP(2, 4) RED_STEP(1, 2)
#undef RED_STEP
        float lg = p[0] + __shfl_xor(p[0], 1) + brt;
        const int myexp = lane >> 1;
        float tv[4]; int te[4];
#pragma unroll
        for (int k = 0; k < 4; ++k) { const float mx = wave_max(lg); const unsigned long long bm = __ballot(lg == mx); const int first = __ffsll((long long)bm) - 1; te[k] = first >> 1; tv[k] = mx; if (myexp == te[k]) lg = -INFINITY; }
        const float e1 = __expf(tv[1] - tv[0]), e2 = __expf(tv[2] - tv[0]), e3 = __expf(tv[3] - tv[0]); const float inv = 1.0f / (1.0f + e1 + e2 + e3);
        if (lane < 4) { const int e = (lane == 0) ? te[0] : (lane == 1) ? te[1] : (lane == 2) ? te[2] : te[3]; const float w = ((lane == 0) ? 1.0f : (lane == 1) ? e1 : (lane == 2) ? e2 : e3) * inv;
            const unsigned lp = atomicAdd((unsigned*)&lcnt[e], 1u);
            ent[(ri * 4 + lane) * 2 + 0] = ((unsigned)e << 24) | lp; ent[(ri * 4 + lane) * 2 + 1] = __float_as_uint(w); }
    }
    __syncthreads();
    if (tid < 32) gb[tid] = __hip_atomic_fetch_add(cnt + tid * 16, lcnt[tid], __ATOMIC_RELAXED, __HIP_MEMORY_SCOPE_AGENT);
    __syncthreads();
    ri = 0;
    for (int m = gw; m < MT; m += NGW, ++ri) {
        if (lane < 4) { const unsigned pe = ent[(ri * 4 + lane) * 2 + 0]; const unsigned e = pe >> 24, lp = pe & 0xffffffu;
            ((unsigned*)(ws + WS_SLOT))[m * 4 + lane] = (e << 24) | (gb[e] + lp); ((unsigned*)(ws + WS_GATEW))[m * 4 + lane] = ent[(ri * 4 + lane) * 2 + 1]; }
    }
}
__device__ __forceinline__ void build_expert_tables(unsigned char* ws, int layer, LAS unsigned char* lds, int tid) {
    LAS int* t2e = (LAS int*)(lds + AUX_T2E); LAS int* base = (LAS int*)(lds + AUX_BASE); LAS int* ntp = (LAS int*)(lds + AUX_NT);
    gu32* cnt = (gu32*)(ws + WS_CTL) + CW_CNT + layer * 32 * 16;
    __syncthreads();
    if (tid < 64) { const unsigned cval = (tid < 32) ? __hip_atomic_load(cnt + tid * 16, RLX_AGENT) : 0u; const int tiles = (int)((cval + 255u) >> 8);
        int pre = tiles;
#pragma unroll
        for (int o = 1; o < 32; o <<= 1) { const int t = __shfl_up(pre, o); if ((tid & 63) >= o) pre += t; }
        const int start = pre - tiles;
        if (tid < 32) { base[tid] = start * 256; for (int t = 0; t < tiles; ++t) t2e[start + t] = tid; if (tid == 31) ntp[0] = pre; } }
    __syncthreads();
}
__device__ __forceinline__ void phase_moe_gather(unsigned char* ws, int layer, LAS unsigned char* lds, int gw, int NGW, int lane, int tid) {
    build_expert_tables(ws, layer, lds, tid);
    const LAS int* base = (const LAS int*)(lds + AUX_BASE);
    const bf16* XN = (const bf16*)(ws + WS_XN); bf16* XG = (bf16*)(ws + WS_XG);
    const unsigned* slot = (const unsigned*)(ws + WS_SLOT); unsigned* spos = (unsigned*)(ws + WS_SLOTPOS);
    for (int m = gw; m < MT; m += NGW) {
        const GAS v4u* src = (const GAS v4u*)(XN + (size_t)m * 1024) + lane; const v4u a = src[0], b = src[64];
#pragma unroll
        for (int k = 0; k < 4; ++k) { const unsigned pe = slot[m * 4 + k]; const int dst = base[pe >> 24] + (int)(pe & 0xffffffu);
            GAS v4u* dp = (GAS v4u*)(XG + (size_t)dst * 1024) + lane; dp[0] = a; dp[64] = b;
            if (lane == 0) spos[m * 4 + k] = (unsigned)dst; }
    }
}
__device__ __forceinline__ void phase_moe_combine(unsigned char* ws, float* out, int layer, int gw, int NGW, int lane) {
    float* X = (float*)(ws + WS_X); const bf16* Y = (const bf16*)(ws + WS_Y);
    const float* Mo = (const float*)(ws + WS_MOD) + (size_t)layer * MODROWS * NMODC;
    const unsigned* spos = (const unsigned*)(ws + WS_SLOTPOS); const float* gw4 = (const float*)(ws + WS_GATEW);
    for (int m = gw; m < MT; m += NGW) { const int b = m / TB, w = m - b * TB; const int mr = (w < CTXL) ? 8 : b;
        if (layer == NLAYER - 1 && w < CTXL) continue;
        f32x4 f[4];
#pragma unroll
        for (int j = 0; j < 4; ++j) f[j] = (f32x4){0.f, 0.f, 0.f, 0.f};
#pragma unroll
        for (int k = 0; k < 4; ++k) { const unsigned sp = spos[m * 4 + k]; const float wk = gw4[m * 4 + k];
            const GAS unsigned long long* yp = (const GAS unsigned long long*)(Y + (size_t)sp * 1024) + lane;
#pragma unroll
            for (int j = 0; j < 4; ++j) { const unsigned long long v = yp[64 * j];
                f[j].x += wk * __uint_as_float((unsigned)(v & 0xffffu) << 16); f[j].y += wk * __uint_as_float((unsigned)(v >> 16) << 16);
                f[j].z += wk * __uint_as_float((unsigned)((v >> 32) & 0xffffu) << 16); f[j].w += wk * __uint_as_float((unsigned)(v >> 48) << 16); } }
        GAS f32x4* xp = (GAS f32x4*)(X + (size_t)m * 1024) + lane; const GAS f32x4* gp = (const GAS f32x4*)(Mo + (size_t)mr * NMODC + 5 * 1024) + lane;
        GAS f32x4* op = (layer == NLAYER - 1) ? (GAS f32x4*)(out + ((size_t)b * SEQ + (w - CTXL)) * 1024) + lane : xp;
#pragma unroll
        for (int j = 0; j < 4; ++j) op[64 * j] = xp[64 * j] + gp[64 * j] * f[j];
    }
}

constexpr int NPH_L = 11, NPHASE = 2 + NPH_L * NLAYER;
#ifndef PHMASK
#define PHMASK 0x7fff
#endif
#define EN(b) ((PHMASK >> (b)) & 1)
__global__ void __launch_bounds__(NWAVES * 64, 2) dit_fwd(Args args) {
    extern __shared__ __attribute__((aligned(16))) unsigned char lds_raw[];
    LAS unsigned char* lds = (LAS unsigned char*)lds_raw;
    volatile LAS unsigned* MISC = (volatile LAS unsigned*)(lds + MISC_OFF);
    const int G = gridDim.x, bx = blockIdx.x;
    const int vcu = (G % 8 == 0) ? (bx % 8) * (G / 8) + bx / 8 : bx;
    { const int t0 = threadIdx.x; for (int u = t0; u < (LDS_BYTES - MISC_OFF) / 4; u += NWAVES * 64) ((LAS unsigned*)(lds + MISC_OFF))[u] = 0u; }
    __syncthreads();
    const int lo = args.ph_lo, hi = args.ph_hi;
    XcdBarrier bar; bar.bar = (unsigned*)(args.ws + WS_CTL) + CW_BAR; bar.x = 0; bar.st = nullptr;
    if (hi - lo > 1) bar = xcd_barrier_post((unsigned*)(args.ws + WS_CTL) + CW_BAR, MISC + 8);
#define IN(k) (lo <= (k) && (k) < hi)
#define SEAM(k) do { if (IN(k) && IN((k) + 1)) xcd_barrier(bar); } while (0)
#define PHASE_IDS() int tid = threadIdx.x; LAUNDER_V(tid); const int lane = tid & 63, wave = __builtin_amdgcn_readfirstlane(tid >> 6); const int gw = vcu * NWAVES + wave, NGW = G * NWAVES; \
    unsigned zoff_ = 0u; LAUNDER_S(zoff_); unsigned char* ws = args.ws + zoff_; (void)lane; (void)gw; (void)NGW;

    if (EN(0) && IN(0)) { PHASE_IDS(); p0_prologue(args, lds, gw, NGW, wave, lane); } SEAM(0);
    if (EN(1) && IN(1)) { PHASE_IDS(); p1_mod_reduce(args, gw * 64 + lane, NGW * 64); } SEAM(1);

    for (int layer = 0; layer < NLAYER; ++layer) {
        const int pb = 2 + NPH_L * layer, lh = layer >> 1;
        if (EN(2) && IN(pb + 0)) { PHASE_IDS(); phase_modulate1(ws, layer, gw, NGW, lane); } SEAM(pb + 0);
        if ((layer & 1) == 0) {
            if (EN(3) && IN(pb + 1)) {
                PHASE_IDS();
                pg8::Gemm g{(const pg8::bf16_t*)(ws + WS_XN), (const pg8::bf16_t*)(ws + WS_WQKV) + (size_t)lh * QKVN * 1024, MT, QKVN, 1024, 0};
                pg8::StaticOrder S; S.init(MT, QKVN, G, bx);
                pg8::EpiQKV E{ws, WS_Q, WS_K - WS_Q, WS_V - WS_K};
                pg8::gemm_phase<pg8::EpiQKV, pg8::StaticOrder, true, true>(lds + RING_OFF, g, S, E);
            } SEAM(pb + 1);
            if (EN(4) && IN(pb + 2)) { PHASE_IDS(); phase_qknorm_rope(ws, lh, gw, NGW, lane); } SEAM(pb + 2);
            if (EN(5) && IN(pb + 3)) {
                PHASE_IDS();
                const attn_body::bf16* Qp = (const attn_body::bf16*)(ws + WS_Q); const attn_body::bf16* Kp = (const attn_body::bf16*)(ws + WS_K); const attn_body::bf16* Vp = (const attn_body::bf16*)(ws + WS_V);
                attn_body::bf16* Op = (attn_body::bf16*)(ws + WS_Q);
                if (G == 256) {
                    for (int i = 0; i < 9; ++i) {
                        long qrow0, kvrow0; int NT, h;
                        if (i < 8) { const int x = vcu >> 5, j = vcu & 31, pair = 4 * x + (i >> 1), wi = (i & 1) * 32 + j, hq = wi >> 4, qb = wi & 15, b = pair >> 2, hk = pair & 3;
                            h = hk * 4 + hq; qrow0 = (long)b * TB + CTXL + qb * 256; kvrow0 = (long)b * TB; NT = TB / 64; }
                        else { if (vcu >= 128) break; const int b = vcu >> 4; h = vcu & 15; qrow0 = (long)b * TB; kvrow0 = qrow0; NT = CTXL / 64; }
                        attn_body::attn_unit<8>(qrow0, kvrow0, NT, h, Qp, Kp, Vp, Op, (char*)lds_raw + RING_OFF);
                    }
                } else {
                    for (int U = bx; U < 2048 + 128; U += G) {
                        long qrow0, kvrow0; int NT, h;
                        if (U < 2048) { const int pair = U >> 6, wi = U & 63, hq = wi >> 4, qb = wi & 15, b = pair >> 2, hk = pair & 3; h = hk * 4 + hq; qrow0 = (long)b * TB + CTXL + qb * 256; kvrow0 = (long)b * TB; NT = TB / 64; }
                        else { const int v = U - 2048, b = v >> 4; h = v & 15; qrow0 = (long)b * TB; kvrow0 = qrow0; NT = CTXL / 64; }
                        attn_body::attn_unit<8>(qrow0, kvrow0, NT, h, Qp, Kp, Vp, Op, (char*)lds_raw + RING_OFF);
                    }
                }
            } SEAM(pb + 3);
        } else {
            if (EN(6) && IN(pb + 1)) {
                PHASE_IDS();
                pg8::Gemm g{(const pg8::bf16_t*)(ws + WS_XN), (const pg8::bf16_t*)(ws + WS_WIN) + (size_t)lh * WINP * 1024, MT, WINP, 1024, 0};
                pg8::StaticOrder S; S.init(MT, WINP, G, bx);
                pg8::EpiBf16 E{(pg8::bf16_t*)(ws + WS_G), WINP};
                pg8::gemm_phase<pg8::EpiBf16, pg8::StaticOrder, true, true>(lds + RING_OFF, g, S, E);
            } SEAM(pb + 1);
            if (EN(7) && IN(pb + 2)) { PHASE_IDS(); phase_gla_g0(ws, lh, lds, tid); } SEAM(pb + 2);
            if (EN(8) && IN(pb + 3)) { PHASE_IDS(); phase_gla_g12(ws, gw, lane); } SEAM(pb + 3);
            if (EN(8) && IN(pb + 4)) { PHASE_IDS(); phase_gla_g3(ws, lh, lds, tid); } SEAM(pb + 4);
        }
        if (EN(9) && IN(pb + 5)) {
            PHASE_IDS();
            const pg8::bf16_t* Wt = (layer & 1) ? (const pg8::bf16_t*)(ws + WS_WOG) + (size_t)lh * 1024 * 1024 : (const pg8::bf16_t*)(ws + WS_WOA) + (size_t)lh * 1024 * 1024;
            pg8::Gemm g{(const pg8::bf16_t*)(ws + WS_Q), Wt, MT, 1024, 1024, 0};
            pg8::StaticOrder S; S.init(MT, 1024, G, bx);
            pg8::EpiResGate E{(float*)(ws + WS_X), (const float*)(ws + WS_MOD) + (size_t)layer * MODROWS * NMODC + 2 * 1024};
            pg8::gemm_phase<pg8::EpiResGate, pg8::StaticOrder, true, true>(lds + RING_OFF, g, S, E);
        } SEAM(pb + 5);
        if (EN(10) && IN(pb + 6)) { PHASE_IDS(); phase_modulate2_route(ws, layer, lds, gw, NGW, wave, lane, tid); } SEAM(pb + 6);
        if (EN(11) && IN(pb + 7)) { PHASE_IDS(); phase_moe_gather(ws, layer, lds, gw, NGW, lane, tid); } SEAM(pb + 7);
        if (EN(12) && IN(pb + 8)) {
            PHASE_IDS();
            build_expert_tables(ws, layer, lds, tid);
            const int nT = __builtin_amdgcn_readfirstlane(((const LAS int*)(lds + AUX_NT))[0]);
            pg8::Gemm g{(const pg8::bf16_t*)(ws + WS_XG), (const pg8::bf16_t*)(ws + WS_WGU) + (size_t)layer * 32 * 2048 * 1024, MPAD, 2048, 1024, (size_t)2048 * 1024 * 2};
            pg8::MoeOrder S{nT, 8, G, bx, (const LAS int*)(lds + AUX_T2E)};
            pg8::EpiSwiGLU E{(pg8::bf16_t*)(ws + WS_ACT), PARF(ws) + P_BGU + (size_t)layer * 32 * 2048};
            pg8::gemm_phase<pg8::EpiSwiGLU, pg8::MoeOrder, true, true>(lds + RING_OFF, g, S, E);
        } SEAM(pb + 8);
        if (EN(13) && IN(pb + 9)) {
            PHASE_IDS();
            build_expert_tables(ws, layer, lds, tid);
            const int nT = __builtin_amdgcn_readfirstlane(((const LAS int*)(lds + AUX_NT))[0]);
            pg8::Gemm g{(const pg8::bf16_t*)(ws + WS_ACT), (const pg8::bf16_t*)(ws + WS_WDN) + (size_t)layer * 32 * 1024 * 1024, MPAD, 1024, 1024, (size_t)1024 * 1024 * 2};
            pg8::MoeOrder S{nT, 4, G, bx, (const LAS int*)(lds + AUX_T2E)};
            pg8::EpiBiasBf16 E{(pg8::bf16_t*)(ws + WS_Y), PARF(ws) + P_BDN + (size_t)layer * 32 * 1024};
            pg8::gemm_phase<pg8::EpiBiasBf16, pg8::MoeOrder, true, true>(lds + RING_OFF, g, S, E);
        } SEAM(pb + 9);
        if (EN(14) && IN(pb + 10)) { PHASE_IDS(); phase_moe_combine(ws, args.out, layer, gw, NGW, lane); } SEAM(pb + 10);
    }
#undef IN
#undef EN
#undef SEAM
#undef PHASE_IDS
}

extern "C" void kernel_launch(void* const* d_in, const int* in_sizes, int n_in, void* d_out, int out_size, void* d_ws, size_t ws_size, hipStream_t stream) {
    static int grid = 0;
    if (grid == 0) {
        if (n_in != 25 || out_size != NB * SEQ * DMODEL || ws_size < WS_END) { fprintf(stderr, "kernel_launch: unexpected shapes: n_in %d out %d ws %zu (need >= %zu)\n", n_in, out_size, ws_size, (size_t)WS_END); grid = -1; return; }
        int dev = 0, cus = 0, per_cu = 0;
        if (hipGetDevice(&dev) != hipSuccess || hipDeviceGetAttribute(&cus, hipDeviceAttributeMultiprocessorCount, dev) != hipSuccess) { grid = -1; return; }
        if (hipFuncSetAttribute((const void*)dit_fwd, hipFuncAttributeMaxDynamicSharedMemorySize, LDS_BYTES) != hipSuccess) { fprintf(stderr, "kernel_launch: hipFuncSetAttribute failed\n"); grid = -1; return; }
        if (hipOccupancyMaxActiveBlocksPerMultiprocessor(&per_cu, (const void*)dit_fwd, NWAVES * 64, LDS_BYTES) != hipSuccess || per_cu < 1) fprintf(stderr, "kernel_launch: occupancy query reports %d\n", per_cu);
        (void)hipGetLastError();
        grid = cus;
    }
    if (grid < 0) return;
    if (hipMemsetAsync((char*)d_ws + WS_CTL, 0, CTL_ZERO_BYTES, stream) != hipSuccess) { fprintf(stderr, "kernel_launch: memset failed\n"); return; }
    Args a{};
    for (int i = 0; i < 25; ++i) a.in[i] = (const float*)d_in[i];
    a.out = (float*)d_out; a.ws = (unsigned char*)d_ws;
#if MK_ONE_LAUNCH
    a.ph_lo = 0; a.ph_hi = NPHASE;
    hipLaunchKernelGGL(dit_fwd, dim3(grid), dim3(NWAVES * 64), LDS_BYTES, stream, a);
#else
    for (int p = 0; p < NPHASE; ++p) { a.ph_lo = p; a.ph_hi = p + 1; hipLaunchKernelGGL(dit_fwd, dim3(grid), dim3(NWAVES * 64), LDS_BYTES, stream, a); }
#endif
    const hipError_t le = hipPeekAtLastError();
    if (le != hipSuccess) fprintf(stderr, "kernel_launch: launch failed: %s\n", hipGetErrorName(le));
}
```

```cpp
#include <hip/hip_runtime.h>
#include <hip/hip_bf16.h>
#include <cstdio>
#include <cstdint>
#include <cmath>

#ifndef MK_ONE_LAUNCH
#define MK_ONE_LAUNCH 1
#endif

namespace pg8 {
#define PG8_LAS __attribute__((address_space(3)))
typedef unsigned short bf16_t;
typedef short bf16x8 __attribute__((ext_vector_type(8)));
typedef float f32x4 __attribute__((ext_vector_type(4)));
typedef unsigned u32x4 __attribute__((ext_vector_type(4)));
constexpr int BM = 256, BK = 64, HALF = 128, HTB = HALF * BK * 2  , STAGE_BYTES = 8 * HTB, NXCD = 8, WGM = 8;

__host__ __device__ __forceinline__ int lds_byte(int r, int c) { const int st = (r >> 4) * 2 + (c >> 5), rr = r & 15, cc = c & 31, ob = rr * 64 + cc * 2; return st * 1024 + (ob ^ (((ob >> 9) & 1) << 5)); }
__host__ __device__ __forceinline__ void stage_rc(int b, int& R, int& C) { const int st = b / 1024, sb = b % 1024, swz = sb ^ (((sb >> 9) & 1) << 5); R = (st >> 1) * 16 + swz / 64; C = (st & 1) * 32 + (swz % 64) / 2; }
__host__ __device__ __forceinline__ int perm32(int rho) { const int n = rho >> 4, i = rho & 15; return 8 * (i >> 2) + 4 * n + (i & 3); }

struct Unit { int pm, pn, e; };
struct Gemm { const bf16_t* A; const bf16_t* Bt; int M, N, K; size_t bstride; };

struct StaticOrder {
    int nM, nN, nwg, G, c;
    __host__ __device__ __forceinline__ void init(int M, int N, int G_, int c_) { nM = M / BM; nN = N / BM; nwg = nM * nN; G = G_; c = c_; }
    __host__ __device__ __forceinline__ bool next(int i, Unit& u) const {
        const long L = (long)i * G + c; if (L >= nwg) return false;
        int wgid = (int)L; { const int q = nwg / NXCD, r = nwg % NXCD, xcd = wgid % NXCD, off = wgid / NXCD; wgid = (xcd < r ? xcd * (q + 1) : r * (q + 1) + (xcd - r) * q) + off; }
        const int nig = WGM * nN, gid = wgid / nig, fm = gid * WGM, gsz = (nM - fm) < WGM ? (nM - fm) : WGM;
        u.pm = fm + ((wgid % nig) % gsz); u.pn = (wgid % nig) / gsz; u.e = 0; return true;
    }
    __device__ __forceinline__ void a_ready(const Unit&) const {}
    __device__ __forceinline__ void done(const Unit&) const {}
};
struct MoeOrder {
    int nT, nN, G, c; const PG8_LAS int* t2e;
    __device__ __forceinline__ bool next(int i, Unit& u) const {
        const int x = c & 7, j = c >> 3, per = 32 / nN, mt = (i * (G >> 5) + x) * per + j / nN; if (mt >= nT) return false;
        u.pm = mt; u.pn = j % nN; u.e = __builtin_amdgcn_readfirstlane(t2e[mt]); return true;
    }
    __device__ __forceinline__ void a_ready(const Unit&) const {}
    __device__ __forceinline__ void done(const Unit&) const {}
};

__device__ __forceinline__ unsigned cvt_pk_bf16(float lo, float hi) { unsigned r; asm volatile("v_cvt_pk_bf16_f32 %0, %1, %2" : "=v"(r) : "v"(lo), "v"(hi)); return r; }

struct EpiBf16 {
    static constexpr bool PERM = true, AFTER_DRAIN = false;
    bf16_t* O; int ldc;
    __device__ __forceinline__ void operator()(const f32x4 (&acc)[2][2][4][2], const Unit& u, int wr, int wc, int fr, int fq) const {
        const int row0 = u.pm * BM + wr * 64 + fr; const int col0 = u.pn * BM + wc * 32 + 8 * fq;
#pragma unroll
        for (int ai = 0; ai < 2; ++ai)
#pragma unroll
            for (int m = 0; m < 4; ++m) { bf16_t* rowp = O + (size_t)(row0 + ai * HALF + m * 16) * ldc + col0;
#pragma unroll
                for (int bj = 0; bj < 2; ++bj) { const f32x4 v0 = acc[ai][bj][m][0], v1 = acc[ai][bj][m][1];
                    u32x4 w; w.x = cvt_pk_bf16(v0[0], v0[1]); w.y = cvt_pk_bf16(v0[2], v0[3]); w.z = cvt_pk_bf16(v1[0], v1[1]); w.w = cvt_pk_bf16(v1[2], v1[3]);
                    *(u32x4*)(rowp + bj * HALF) = w; } }
    }
};
struct EpiQKV {
    static constexpr bool PERM = true, AFTER_DRAIN = false;
    unsigned char* wsb; size_t offQ, dK, dV;
    __device__ __forceinline__ void operator()(const f32x4 (&acc)[2][2][4][2], const Unit& u, int wr, int wc, int fr, int fq) const {
        const int row0 = u.pm * BM + wr * 64 + fr;
        const int isk = (u.pn >= 4) ? 1 : 0, isv = (u.pn >= 5) ? 1 : 0;
        bf16_t* base = (bf16_t*)(wsb + offQ + (size_t)isk * dK + (size_t)isv * dV); const int ldc = isk ? 256 : 1024, colt = isk ? 0 : u.pn * BM;
        const int col0 = colt + wc * 32 + 8 * fq;
#pragma unroll
        for (int ai = 0; ai < 2; ++ai)
#pragma unroll
            for (int m = 0; m < 4; ++m) { bf16_t* rowp = base + (size_t)(row0 + ai * HALF + m * 16) * ldc + col0;
#pragma unroll
                for (int bj = 0; bj < 2; ++bj) { const f32x4 v0 = acc[ai][bj][m][0], v1 = acc[ai][bj][m][1];
                    u32x4 w; w.x = cvt_pk_bf16(v0[0], v0[1]); w.y = cvt_pk_bf16(v0[2], v0[3]); w.z = cvt_pk_bf16(v1[0], v1[1]); w.w = cvt_pk_bf16(v1[2], v1[3]);
                    *(u32x4*)(rowp + bj * HALF) = w; } }
    }
};
struct EpiResGate {
    static constexpr bool PERM = false, AFTER_DRAIN = false;
    float* X; const float* gate;
    __device__ __forceinline__ void operator()(const f32x4 (&acc)[2][2][4][2], const Unit& u, int wr, int wc, int fr, int fq) const {
        const int row0 = u.pm * BM + wr * 64 + fr; const int col0 = u.pn * BM + wc * 32 + 4 * fq;
        const int bb = u.pm / 17, mr = (u.pm - bb * 17 == 0) ? 8 : bb;
        const float* gp = gate + (size_t)mr * 6144 + col0;
        f32x4 gv[2][2];
#pragma unroll
        for (int bj = 0; bj < 2; ++bj)
#pragma unroll
            for (int n = 0; n < 2; ++n) gv[bj][n] = *(const f32x4*)(gp + bj * HALF + n * 16);
#pragma unroll
        for (int ai = 0; ai < 2; ++ai)
#pragma unroll
            for (int m = 0; m < 4; ++m) { float* rowp = X + (size_t)(row0 + ai * HALF + m * 16) * 1024 + col0;
#pragma unroll
                for (int bj = 0; bj < 2; ++bj)
#pragma unroll
                    for (int n = 0; n < 2; ++n) { f32x4* p = (f32x4*)(rowp + bj * HALF + n * 16); f32x4 x = *p; x = x + gv[bj][n] * acc[ai][bj][m][n]; *p = x; } }
    }
};
struct EpiSwiGLU {
    static constexpr bool PERM = true, AFTER_DRAIN = false;
    bf16_t* O; const float* bias;
    __device__ __forceinline__ void operator()(const f32x4 (&acc)[2][2][4][2], const Unit& u, int wr, int wc, int fr, int fq) const {
        const int row0 = u.pm * BM + wr * 64 + fr; const int col0 = u.pn * HALF + wc * 32 + 8 * fq;
        const float* bp = bias + (size_t)u.e * 2048 + col0;
        f32x4 bg[2], bu[2];
#pragma unroll
        for (int n = 0; n < 2; ++n) { bg[n] = *(const f32x4*)(bp + 4 * n); bu[n] = *(const f32x4*)(bp + 1024 + 4 * n); }
#pragma unroll
        for (int ai = 0; ai < 2; ++ai)
#pragma unroll
            for (int m = 0; m < 4; ++m) { bf16_t* rowp = O + (size_t)(row0 + ai * HALF + m * 16) * 1024 + col0;
                float r[8];
#pragma unroll
                for (int n = 0; n < 2; ++n) { const f32x4 gt = acc[ai][0][m][n] + bg[n], up = acc[ai][1][m][n] + bu[n];
#pragma unroll
                    for (int i = 0; i < 4; ++i) { const float g = fminf(gt[i], 7.0f), uu = fminf(fmaxf(up[i], -7.0f), 7.0f);
                        const float sg = __builtin_amdgcn_rcpf(1.0f + __builtin_amdgcn_exp2f(-1.702f * 1.4426950408889634f * g));
                        r[4 * n + i] = (uu + 1.0f) * (g * sg); } }
                u32x4 w; w.x = cvt_pk_bf16(r[0], r[1]); w.y = cvt_pk_bf16(r[2], r[3]); w.z = cvt_pk_bf16(r[4], r[5]); w.w = cvt_pk_bf16(r[6], r[7]);
                *(u32x4*)rowp = w; }
    }
};
struct EpiBiasBf16 {
    static constexpr bool PERM = true, AFTER_DRAIN = false;
    bf16_t* O; const float* bias;
    __device__ __forceinline__ void operator()(const f32x4 (&acc)[2][2][4][2], const Unit& u, int wr, int wc, int fr, int fq) const {
        const int row0 = u.pm * BM + wr * 64 + fr; const int col0 = u.pn * BM + wc * 32 + 8 * fq;
        const float* bp = bias + (size_t)u.e * 1024 + col0;
        f32x4 bv[2][2];
#pragma unroll
        for (int bj = 0; bj < 2; ++bj)
#pragma unroll
            for (int n = 0; n < 2; ++n) bv[bj][n] = *(const f32x4*)(bp + bj * HALF + 4 * n);
#pragma unroll
        for (int ai = 0; ai < 2; ++ai)
#pragma unroll
            for (int m = 0; m < 4; ++m) { bf16_t* rowp = O + (size_t)(row0 + ai * HALF + m * 16) * 1024 + col0;
#pragma unroll
                for (int bj = 0; bj < 2; ++bj) { const f32x4 v0 = acc[ai][bj][m][0] + bv[bj][0], v1 = acc[ai][bj][m][1] + bv[bj][1];
                    u32x4 w; w.x = cvt_pk_bf16(v0[0], v0[1]); w.y = cvt_pk_bf16(v0[2], v0[3]); w.z = cvt_pk_bf16(v1[0], v1[1]); w.w = cvt_pk_bf16(v1[2], v1[3]);
                    *(u32x4*)(rowp + bj * HALF) = w; } }
    }
};

template <class Epi, class Sched, bool ALIGN_EPI = false, bool SP2 = false>
__device__ __forceinline__ void gemm_phase(PG8_LAS unsigned char* lds, const Gemm g, const Sched& S, const Epi& E) {
    int tid_l = threadIdx.x; asm volatile("" : "+v"(tid_l));
    const int tid = tid_l, wid = __builtin_amdgcn_readfirstlane(tid >> 6), lane = tid & 63, wr = wid >> 2, wc = wid & 3, fr = lane & 15, fq = lane >> 4;
    const int K = g.K, nt = K / BK;
    unsigned voffA[2], voffB[2];
#pragma unroll
    for (int i = 0; i < 2; ++i) { int R, C; stage_rc(tid * 16 + i * 8192, R, C); const int Rb = Epi::PERM ? ((R & ~31) + perm32(R & 31)) : R;
        voffA[i] = (unsigned)(R * K + C) * 2u; voffB[i] = (unsigned)(Rb * K + C) * 2u; }
    const size_t kstep = (size_t)(BK * 2);
    const size_t hstep = (size_t)HALF * K * 2;
    const size_t tstep = 2 * hstep;
    const unsigned ldsw = (unsigned)wid * 1024u;
    const int aoff = lds_byte(wr * 64 + fr, fq * 8), boff = lds_byte(wc * 32 + fr, fq * 8);
#define PG8_SA(b, h) (((b) * 2 + (h)) * HTB)
#define PG8_SB(b, h) ((4 + (b) * 2 + (h)) * HTB)
#define PG8_STAGE(bufoff, gbase, voff) do { _Pragma("unroll") for (int _i = 0; _i < 2; ++_i) \
        __builtin_amdgcn_global_load_lds((const unsigned*)((const char*)(gbase) + (voff)[_i]), (PG8_LAS unsigned*)(lds + (bufoff) + ldsw + _i * 8192), 16, 0, 0); } while (0)
#define PG8_LDA(dst, b, h) do { _Pragma("unroll") for (int m = 0; m < 4; ++m) _Pragma("unroll") for (int k = 0; k < 2; ++k) dst[m][k] = *(const PG8_LAS bf16x8*)(lds + PG8_SA(b, h) + aoff + m * 2048 + k * 1024); } while (0)
#define PG8_LDB(dst, b, h) do { _Pragma("unroll") for (int n = 0; n < 2; ++n) _Pragma("unroll") for (int k = 0; k < 2; ++k) dst[n][k] = *(const PG8_LAS bf16x8*)(lds + PG8_SB(b, h) + boff + n * 2048 + k * 1024); } while (0)
#define PG8_MMA(ai, bj, At, Bt) do { __builtin_amdgcn_s_setprio(1); _Pragma("unroll") for (int m = 0; m < 4; ++m) _Pragma("unroll") for (int n = 0; n < 2; ++n) _Pragma("unroll") for (int k = 0; k < 2; ++k) \
        acc[ai][bj][m][n] = __builtin_amdgcn_mfma_f32_16x16x32_bf16(Bt[n][k], At[m][k], acc[ai][bj][m][n], 0, 0, 0); __builtin_amdgcn_s_setprio(0); } while (0)
#define PG8_WAIT_V(n) asm volatile("s_waitcnt vmcnt(" #n ")" ::: "memory")
#define PG8_WAIT_L(n) asm volatile("s_waitcnt lgkmcnt(" #n ")" ::: "memory")
#define PG8_BAR __builtin_amdgcn_s_barrier()
#define PG8_SCHED __builtin_amdgcn_sched_barrier(0)
    Unit cur, nxt; int ui = 0;
    if (!S.next(0, cur)) return;
    f32x4 acc[2][2][4][2];
#pragma unroll
    for (int a = 0; a < 2; ++a)
#pragma unroll
        for (int b = 0; b < 2; ++b)
#pragma unroll
            for (int m = 0; m < 4; ++m)
#pragma unroll
                for (int n = 0; n < 2; ++n) acc[a][b][m][n] = (f32x4){0.f, 0.f, 0.f, 0.f};
    bf16x8 At[4][2], B0[2][2], B1[2][2];
    const char* cA = (const char*)g.A + (size_t)cur.pm * tstep; const char* cB = (const char*)g.Bt + (size_t)cur.e * g.bstride + (size_t)cur.pn * tstep;
    S.a_ready(cur);
    if constexpr (SP2) {
        PG8_STAGE(PG8_SB(0, 0), cB, voffB); PG8_STAGE(PG8_SB(0, 1), cB + hstep, voffB); PG8_STAGE(PG8_SA(0, 0), cA, voffA); PG8_STAGE(PG8_SA(0, 1), cA + hstep, voffA);
        if (wr == 1) PG8_BAR;
        PG8_WAIT_V(2); PG8_BAR;
        PG8_STAGE(PG8_SB(1, 0), cB + kstep, voffB); PG8_STAGE(PG8_SA(1, 0), cA + kstep, voffA); PG8_STAGE(PG8_SB(1, 1), cB + hstep + kstep, voffB);
        PG8_WAIT_V(6); PG8_BAR;
    } else {
        PG8_STAGE(PG8_SB(0, 0), cB, voffB); PG8_STAGE(PG8_SA(0, 0), cA, voffA); PG8_STAGE(PG8_SB(0, 1), cB + hstep, voffB); PG8_STAGE(PG8_SA(0, 1), cA + hstep, voffA);
        if (wr == 1) PG8_BAR;
        PG8_WAIT_V(4); PG8_BAR;
        PG8_STAGE(PG8_SB(1, 0), cB + kstep, voffB); PG8_STAGE(PG8_SA(1, 0), cA + kstep, voffA); PG8_STAGE(PG8_SB(1, 1), cB + hstep + kstep, voffB);
        PG8_WAIT_V(6); PG8_BAR;
    }
    for (;;) {
        const bool has_next = S.next(ui + 1, nxt);
        const char* nA = has_next ? (const char*)g.A + (size_t)nxt.pm * tstep : cA; const char* nB = has_next ? (const char*)g.Bt + (size_t)nxt.e * g.bstride + (size_t)nxt.pn * tstep : cB;
        for (int t = 0; t < nt; t += 2) {
            const bool last = (t == nt - 2);
            const char* a1 = cA + (size_t)(t + 1) * kstep;
            const char* a2 = last ? nA : cA + (size_t)(t + 2) * kstep; const char* b2 = last ? nB : cB + (size_t)(t + 2) * kstep;
            const char* a3 = a2 + kstep; const char* b3 = b2 + kstep;
            if (last && has_next) S.a_ready(nxt);
            if constexpr (SP2) {
            PG8_LDB(B0, 0, 0); PG8_LDB(B1, 0, 1); PG8_SCHED; PG8_LDA(At, 0, 0); PG8_STAGE(PG8_SA(1, 1), a1 + hstep, voffA);
            PG8_WAIT_V(8); PG8_WAIT_L(0); PG8_BAR; PG8_MMA(0, 0, At, B0); PG8_MMA(0, 1, At, B1); PG8_BAR; PG8_SCHED;
            PG8_LDA(At, 0, 1); PG8_STAGE(PG8_SB(0, 0), b2, voffB); PG8_STAGE(PG8_SB(0, 1), b2 + hstep, voffB); PG8_STAGE(PG8_SA(0, 0), a2, voffA);
            PG8_WAIT_V(8); PG8_WAIT_L(0); PG8_BAR; PG8_MMA(1, 0, At, B0); PG8_MMA(1, 1, At, B1); PG8_BAR; PG8_SCHED;
            PG8_LDB(B0, 1, 0); PG8_LDB(B1, 1, 1); PG8_SCHED; PG8_LDA(At, 1, 0); PG8_STAGE(PG8_SA(0, 1), a2 + hstep, voffA);
            PG8_WAIT_V(8); PG8_WAIT_L(0); PG8_BAR; PG8_MMA(0, 0, At, B0); PG8_MMA(0, 1, At, B1); PG8_BAR; PG8_SCHED;
            PG8_LDA(At, 1, 1); PG8_STAGE(PG8_SB(1, 0), b3, voffB); PG8_STAGE(PG8_SB(1, 1), b3 + hstep, voffB); PG8_STAGE(PG8_SA(1, 0), a3, voffA);
            PG8_WAIT_V(8); PG8_WAIT_L(0); PG8_BAR; PG8_MMA(1, 0, At, B0); PG8_MMA(1, 1, At, B1); PG8_BAR; PG8_SCHED;
            } else {
            PG8_LDB(B0, 0, 0); PG8_SCHED; PG8_LDA(At, 0, 0); PG8_STAGE(PG8_SA(1, 1), a1 + hstep, voffA);
            PG8_WAIT_L(8); PG8_BAR; PG8_WAIT_L(0); PG8_MMA(0, 0, At, B0); PG8_BAR; PG8_SCHED;
            PG8_LDB(B1, 0, 1); PG8_STAGE(PG8_SB(0, 0), b2, voffB);
            PG8_BAR; PG8_WAIT_L(0); PG8_MMA(0, 1, At, B1); PG8_BAR;
            PG8_LDA(At, 0, 1); PG8_STAGE(PG8_SA(0, 0), a2, voffA);
            PG8_BAR; PG8_WAIT_L(0); PG8_MMA(1, 0, At, B0); PG8_BAR; PG8_SCHED;
            PG8_STAGE(PG8_SB(0, 1), b2 + hstep, voffB);
            PG8_WAIT_V(6); PG8_BAR; PG8_MMA(1, 1, At, B1); PG8_BAR;
            PG8_LDB(B0, 1, 0); PG8_SCHED; PG8_LDA(At, 1, 0); PG8_STAGE(PG8_SA(0, 1), a2 + hstep, voffA);
            PG8_WAIT_L(8); PG8_BAR; PG8_WAIT_L(0); PG8_MMA(0, 0, At, B0); PG8_BAR; PG8_SCHED;
            PG8_LDB(B1, 1, 1); PG8_STAGE(PG8_SB(1, 0), b3, voffB);
            PG8_BAR; PG8_WAIT_L(0); PG8_MMA(0, 1, At, B1); PG8_BAR;
            PG8_LDA(At, 1, 1); PG8_STAGE(PG8_SA(1, 0), a3, voffA);
            PG8_BAR; PG8_WAIT_L(0); PG8_MMA(1, 0, At, B0); PG8_BAR; PG8_SCHED;
            PG8_STAGE(PG8_SB(1, 1), b3 + hstep, voffB);
            PG8_WAIT_V(6); PG8_BAR; PG8_MMA(1, 1, At, B1); PG8_BAR;
            }
        }
        if constexpr (ALIGN_EPI) { if (wr == 0) PG8_BAR; }
        if constexpr (!Epi::AFTER_DRAIN) { E(acc, cur, wr, wc, fr, fq); S.done(cur); }
        if (!has_next) break;
#pragma unroll
        for (int a = 0; a < 2; ++a)
#pragma unroll
            for (int b = 0; b < 2; ++b)
#pragma unroll
                for (int m = 0; m < 4; ++m)
#pragma unroll
                    for (int n = 0; n < 2; ++n) acc[a][b][m][n] = (f32x4){0.f, 0.f, 0.f, 0.f};
        cur = nxt; cA = nA; cB = nB; ++ui;
        if constexpr (ALIGN_EPI) { if (wr == 1) PG8_BAR; }
    }
    PG8_WAIT_V(0);
    if constexpr (!ALIGN_EPI) { if (wr == 0) PG8_BAR; }
    PG8_BAR;
    if constexpr (Epi::AFTER_DRAIN) { E.fused(acc, cur, wr, wc, fr, fq, lds, wid, lane); S.done(cur); }
#undef PG8_SA
#undef PG8_SB
#undef PG8_STAGE
#undef PG8_LDA
#undef PG8_LDB
#undef PG8_MMA
#undef PG8_WAIT_V
#undef PG8_WAIT_L
#undef PG8_BAR
#undef PG8_SCHED
}
}
#include <hip/hip_bf16.h>
#include <cmath>
namespace attn_body {
using bf16=__hip_bfloat16;
using bf16x8=__attribute__((ext_vector_type(8)))short;
using s16x4=__attribute__((ext_vector_type(4)))short;
using f32x16=__attribute__((ext_vector_type(16)))float;
using u32x4=__attribute__((ext_vector_type(4)))unsigned;
constexpr int D=64,DM=1024,KVP=256;
constexpr int NW=8,QBLK=32,QB=QBLK*NW,KVBLK=64;
__device__ __forceinline__ int crow(int r,int hi){return (r&3)+8*(r>>2)+4*hi;}
#define SBAR() __builtin_amdgcn_sched_barrier(0)
__device__ __forceinline__ void cmask(f32x16&p0,f32x16&p1,int jb,int qrel,int hi){
  const float NEG=-INFINITY; int kb=64*jb+4*hi;
  #pragma unroll
  for(int r=0;r<16;++r){int kv=kb+(r&3)+8*(r>>2); if(kv>qrel)p0[r]=NEG; if(kv+32>qrel)p1[r]=NEG;}
}

constexpr int NSLOT=3, SLOTB=8192;
constexpr int LDS_K=0, LDS_V=NSLOT*SLOTB, LDS_WS=2*NSLOT*SLOTB, LDS_OST=LDS_WS+NW*64*4, LDS_BYTES=LDS_OST+NW*4096;
constexpr float C2=0.125f*1.4426950408889634f;
__device__ __forceinline__ void glds16(const void*gsrc,unsigned lds_dst){unsigned keep;
  asm volatile("s_mov_b32 %0, m0\n\ts_mov_b32 m0, %2\n\ts_nop 0\n\tglobal_load_lds_dwordx4 %1, off\n\ts_mov_b32 m0, %0":"=&s"(keep):"v"(gsrc),"s"(lds_dst):"memory");}
__device__ __forceinline__ float max3f(float a,float b,float c){float r;asm("v_max3_f32 %0, %1, %2, %3":"=v"(r):"v"(a),"v"(b),"v"(c));return r;}
__device__ __forceinline__ float max2f(float a,float b){float r;asm("v_max_f32_e32 %0, %1, %2":"=v"(r):"v"(a),"v"(b));return r;}
__device__ __forceinline__ float fadd_s(float a,float b){float r;asm("v_add_f32_e32 %0, %1, %2":"=v"(r):"v"(a),"v"(b));return r;}
__device__ __forceinline__ float fsub_s(float a,float b){float r;asm("v_sub_f32_e32 %0, %1, %2":"=v"(r):"v"(a),"v"(b));return r;}
typedef float f32x2_t __attribute__((ext_vector_type(2))); typedef __bf16 bf16x2_t __attribute__((ext_vector_type(2)));
__device__ __forceinline__ unsigned cvtpk_s(float lo,float hi){f32x2_t v={lo,hi};bf16x2_t b=__builtin_convertvector(v,bf16x2_t);return __builtin_bit_cast(unsigned,b);}
#define WAIT_BAR(N) asm volatile("s_waitcnt vmcnt(" #N ") lgkmcnt(0)\n\ts_barrier":::"memory")

__device__ __forceinline__ void qkt(f32x16&p0,f32x16&p1,const char*Kslot,const bf16x8*qr,const f32x16&negm,int r32,int hi){
  const char*kb=Kslot+hi*1024+r32*16;
  #pragma unroll
  for(int d0=0;d0<4;++d0){
    const bf16x8 b0=*reinterpret_cast<const bf16x8*>(kb+d0*2048);
    const bf16x8 b1=*reinterpret_cast<const bf16x8*>(kb+d0*2048+512);
    if(d0==0){p0=__builtin_amdgcn_mfma_f32_32x32x16_bf16(b0,qr[0],negm,0,0,0);p1=__builtin_amdgcn_mfma_f32_32x32x16_bf16(b1,qr[0],negm,0,0,0);}
    else{p0=__builtin_amdgcn_mfma_f32_32x32x16_bf16(b0,qr[d0],p0,0,0,0);p1=__builtin_amdgcn_mfma_f32_32x32x16_bf16(b1,qr[d0],p1,0,0,0);}}
}
typedef __attribute__((address_space(3))) const char* lds_cptr;
typedef short v4i16_t __attribute__((ext_vector_type(4)));
__device__ __forceinline__ void kload8(bf16x8*kf,lds_cptr kp){
  kf[0]=*(const __attribute__((address_space(3))) bf16x8*)(kp);      kf[1]=*(const __attribute__((address_space(3))) bf16x8*)(kp+512);
  kf[2]=*(const __attribute__((address_space(3))) bf16x8*)(kp+2048); kf[3]=*(const __attribute__((address_space(3))) bf16x8*)(kp+2560);
  kf[4]=*(const __attribute__((address_space(3))) bf16x8*)(kp+4096); kf[5]=*(const __attribute__((address_space(3))) bf16x8*)(kp+4608);
  kf[6]=*(const __attribute__((address_space(3))) bf16x8*)(kp+6144); kf[7]=*(const __attribute__((address_space(3))) bf16x8*)(kp+6656);
}
__device__ __forceinline__ void kload2(bf16x8*kf,lds_cptr kp,int j){ kf[2*j]=*(const __attribute__((address_space(3))) bf16x8*)(kp+j*2048); kf[2*j+1]=*(const __attribute__((address_space(3))) bf16x8*)(kp+j*2048+512); }
__device__ __forceinline__ s16x4 vtr(lds_cptr p){ return __builtin_bit_cast(s16x4,__builtin_amdgcn_ds_read_tr16_b64_v4i16((__attribute__((address_space(3))) v4i16_t*)p)); }
__device__ __forceinline__ float rowmax(const f32x16&p0,const f32x16&p1){
  float a=max3f(p0[0],p0[1],p1[0]),b=max3f(p0[2],p0[3],p1[1]);a=max3f(a,p1[2],p1[3]);
  #pragma unroll
  for(int r=4;r<16;r+=4){a=max3f(a,p0[r],p0[r+1]);b=max3f(b,p0[r+2],p0[r+3]);a=max3f(a,p1[r],p1[r+1]);b=max3f(b,p1[r+2],p1[r+3]);}
  const float m=max2f(a,b);
  auto rr=__builtin_amdgcn_permlane32_swap(__float_as_uint(m),__float_as_uint(m),false,false);
  return max2f(__uint_as_float(rr[0]),__uint_as_float(rr[1]));
}
__device__ __forceinline__ void pv(f32x16*o,int vb,bf16x8 pa0,bf16x8 pa1,bf16x8 pa2,bf16x8 pa3){
  #pragma unroll
  for(int d0=0;d0<2;++d0){s16x4 lo[4],hi[4];
    #pragma unroll
    for(int ks=0;ks<4;++ks){
      asm volatile("ds_read_b64_tr_b16 %0,%1 offset:%c2":"=&v"(lo[ks]):"v"(vb),"i"(d0*4096+ks*1024):"memory");
      asm volatile("ds_read_b64_tr_b16 %0,%1 offset:%c2":"=&v"(hi[ks]):"v"(vb),"i"(d0*4096+ks*1024+512):"memory");}
    asm volatile("s_waitcnt lgkmcnt(0)":::"memory");SBAR();
    #define PK(k) (bf16x8){lo[k][0],lo[k][1],lo[k][2],lo[k][3],hi[k][0],hi[k][1],hi[k][2],hi[k][3]}
    o[d0]=__builtin_amdgcn_mfma_f32_32x32x16_bf16(pa0,PK(0),o[d0],0,0,0);
    o[d0]=__builtin_amdgcn_mfma_f32_32x32x16_bf16(pa1,PK(1),o[d0],0,0,0);
    o[d0]=__builtin_amdgcn_mfma_f32_32x32x16_bf16(pa2,PK(2),o[d0],0,0,0);
    o[d0]=__builtin_amdgcn_mfma_f32_32x32x16_bf16(pa3,PK(3),o[d0],0,0,0);
    #undef PK
  }
}

#ifndef ATTN_STORE16
#define ATTN_STORE16(p,v) (*(u32x4*)(p)=(v))
#endif
template<int THRL> __device__ __forceinline__ void attn_unit(long qrow0,long kvrow0,int NT,int h,const bf16*Q,const bf16*__restrict__ K,const bf16*__restrict__ V,bf16*O,char*shm){
  int tid_l=threadIdx.x; asm volatile("":"+v"(tid_l)); const int tid=tid_l,lane=tid&63,r32=lane&31,hi=lane>>5; const int wid=__builtin_amdgcn_readfirstlane(tid>>6);
  const bf16*Qw=Q+(qrow0+wid*QBLK)*DM+h*D;
  const bf16*Kh=K+kvrow0*KVP+(h>>2)*D,*Vh=V+kvrow0*KVP+(h>>2)*D;
  const unsigned lds0=(unsigned)(uintptr_t)shm;
  float*wsf=(float*)(shm+LDS_WS)+wid*64;
  const bf16*ksrc=Kh+(long)lane*KVP+wid*8;
  const bf16*vsrc=Vh+(long)(16*(wid&3)+(lane>>2))*KVP+(wid>>2)*32+(lane&3)*8;
  const unsigned kdst=lds0+LDS_K+wid*1024, vdst=lds0+LDS_V+wid*1024;
  #define DMA_K(t,slot) glds16(ksrc+(long)(t)*KVBLK*KVP,(unsigned)__builtin_amdgcn_readfirstlane(kdst+(slot)))
  #define DMA_V(t,slot) glds16(vsrc+(long)(t)*KVBLK*KVP,(unsigned)__builtin_amdgcn_readfirstlane(vdst+(slot)))
  const int vb0=(int)(lds0+LDS_V)+((lane>>4)&1)*32+(lane&3)*8+(4*hi+((lane&15)>>2))*64;
  const char*Kbase=shm+LDS_K; bf16x8 kf[8];
  const lds_cptr shm3=(lds_cptr)shm; const lds_cptr kp0=shm3+LDS_K+hi*1024+r32*16; const lds_cptr vp0=shm3+LDS_V+((lane>>4)&1)*32+(lane&3)*8+(4*hi+((lane&15)>>2))*64;
  DMA_K(0,0);DMA_V(0,0);DMA_K(1,SLOTB);
  bf16x8 qr[4];
  #pragma unroll
  for(int d0=0;d0<4;++d0)qr[d0]=*reinterpret_cast<const bf16x8*>(&Qw[(long)r32*DM+d0*16+hi*8]);
  float mhat=0.f,l_reg=0.f;f32x16 o[2];o[0]=f32x16{};o[1]=f32x16{};f32x16 negm=f32x16{};asm volatile("":"+v"(negm));
  #define CMASK(P0,P1,t) do{}while(0)
  bool resc=false;
  #define START(P0,P1) do{ const float rm=rowmax(P0,P1); resc=false; \
    { const float dl=rm; mhat=fadd_s(mhat,dl); \
      _Pragma("unroll") for(int r=0;r<16;++r){P0[r]=fsub_s(P0[r],dl);P1[r]=fsub_s(P1[r],dl);} \
      _Pragma("unroll") for(int r=0;r<16;++r)negm[r]=-mhat; asm volatile("":"+v"(negm)); } \
    _Pragma("unroll") for(int r=0;r<16;++r)P0[r]=__builtin_amdgcn_exp2f(P0[r]); }while(0)
  #define RESC() do{ if(resc){ asm volatile("s_waitcnt lgkmcnt(0)":::"memory"); \
      _Pragma("unroll") for(int d_=0;d_<2;++d_) _Pragma("unroll") for(int r=0;r<16;++r)o[d_][r]*=wsf[crow(r,hi)]; } }while(0)
  f32x16 pA0,pA1,pB0,pB1;
  int sl_prev=0,sl_cur=0,sl_next=SLOTB;
  #define ROT() do{sl_prev=sl_cur;sl_cur=sl_next;sl_next=(sl_next==(NSLOT-1)*SLOTB)?0:sl_next+SLOTB;}while(0)
  DMA_K(2,2*SLOTB);
  WAIT_BAR(3);
  qkt(pA0,pA1,Kbase,qr,negm,r32,hi);asm volatile("s_nop 15\n\ts_nop 7":"+v"(pA0),"+v"(pA1));CMASK(pA0,pA1,0);
  START(pA0,pA1);
  _Pragma("unroll") for(int r=0;r<16;++r)pA1[r]=__builtin_amdgcn_exp2f(pA1[r]);
  WAIT_BAR(0);
  DMA_K(3,0);DMA_V(1,SLOTB);
  ROT();
  kload8(kf,kp0+sl_cur);
  WAIT_BAR(2);
  s16x4 vlo[8],vhi[8]; u32x4 pw0,pw1,pw2,pw3;
  #define PKW(P,B) cvtpk_s(P[B],P[B+1])
  #define PAF(k) __builtin_bit_cast(bf16x8,pw##k)
  #define VFR(i) (bf16x8){vlo[i][0],vlo[i][1],vlo[i][2],vlo[i][3],vhi[i][0],vhi[i][1],vhi[i][2],vhi[i][3]}
  #define PIN(x) asm volatile("":"+v"(x))
  #define MX3(a,b,c) __builtin_fmaxf(__builtin_fmaxf((a),(b)),(c))
  #define GAPA(MF,A0,A1,A2,A3,W0,W1,PW) do{ MF; sacc+=A0; sacc+=A1; sacc+=A2; sacc+=A3; PIN(sacc); W0; W1; PIN(PW); SBAR(); }while(0)
  #define EX(v) __builtin_amdgcn_exp2f(v)
  #define GAPB(MF,X,B) do{ MF; X[B]=EX(X[B]); X[B+1]=EX(X[B+1]); X[B+2]=EX(X[B+2]); X[B+3]=EX(X[B+3]); PIN(X); SBAR(); }while(0)
  #define VRD(i) do{ vlo[i]=vtr(vp_+(((i)>>2)*4096+((i)&3)*1024)); vhi[i]=vtr(vp_+(((i)>>2)*4096+((i)&3)*1024+512)); }while(0)
  #define KRD(G,j) do{ if(G){ kload2(kf,kp0+sl_next,j); SBAR(); } }while(0)
  #define STEP(C0,C1,P0,P1,t,GK,GV,GL) do{ SBAR(); \
    const lds_cptr vp_=vp0+sl_prev; \
    VRD(0); SBAR(); float sacc=(P0[0]+P0[1]); \
    GAPA(C0=__builtin_amdgcn_mfma_f32_32x32x16_bf16(kf[0],qr[0],negm,0,0,0), P0[2],P0[3],P0[4],P0[5],     pw0[0]=PKW(P0,0), pw0[1]=PKW(P0,2), pw0); \
    VRD(4); SBAR(); GAPA(C1=__builtin_amdgcn_mfma_f32_32x32x16_bf16(kf[1],qr[0],negm,0,0,0), P0[6],P0[7],P0[8],P0[9],     pw0[2]=PKW(P0,4), pw0[3]=PKW(P0,6), pw0); \
    VRD(1); SBAR(); GAPA(C0=__builtin_amdgcn_mfma_f32_32x32x16_bf16(kf[2],qr[1],C0,0,0,0),   P0[10],P0[11],P0[12],P0[13], pw1[0]=PKW(P0,8), pw1[1]=PKW(P0,10), pw1); \
    VRD(5); SBAR(); GAPA(C1=__builtin_amdgcn_mfma_f32_32x32x16_bf16(kf[3],qr[1],C1,0,0,0),   P0[14],P0[15],P1[0],P1[1],   pw1[2]=PKW(P0,12),pw1[3]=PKW(P0,14), pw1); \
    VRD(2); SBAR(); GAPA(C0=__builtin_amdgcn_mfma_f32_32x32x16_bf16(kf[4],qr[2],C0,0,0,0),   P1[2],P1[3],P1[4],P1[5],     pw2[0]=PKW(P1,0), pw2[1]=PKW(P1,2), pw2); \
    VRD(6); SBAR(); GAPA(C1=__builtin_amdgcn_mfma_f32_32x32x16_bf16(kf[5],qr[2],C1,0,0,0),   P1[6],P1[7],P1[8],P1[9],     pw2[2]=PKW(P1,4), pw2[3]=PKW(P1,6), pw2); \
    VRD(3); SBAR(); GAPA(C0=__builtin_amdgcn_mfma_f32_32x32x16_bf16(kf[6],qr[3],C0,0,0,0),   P1[10],P1[11],P1[12],P1[13], pw3[0]=PKW(P1,8), pw3[1]=PKW(P1,10), pw3); \
    VRD(7); SBAR(); GAPA(C1=__builtin_amdgcn_mfma_f32_32x32x16_bf16(kf[7],qr[3],C1,0,0,0),   P1[14],P1[15],0.f,0.f,       pw3[2]=PKW(P1,12),pw3[3]=PKW(P1,14), pw3); \
    l_reg+=sacc; \
    if(GK){DMA_K((t)+3,sl_cur);} if(GV){DMA_V((t)+1,sl_next);} \
    CMASK(C0,C1,t); \
    { float a=MX3(C0[0],C0[1],C1[0]),b=MX3(C0[2],C0[3],C1[1]); a=MX3(a,C1[2],C1[3]); \
      _Pragma("unroll") for(int r=4;r<16;r+=4){a=MX3(a,C0[r],C0[r+1]);b=MX3(b,C0[r+2],C0[r+3]);a=MX3(a,C1[r],C1[r+1]);b=MX3(b,C1[r+2],C1[r+3]);} \
      float rm=__builtin_fmaxf(a,b); { auto rr=__builtin_amdgcn_permlane32_swap(__float_as_uint(rm),__float_as_uint(rm),false,false); rm=__builtin_fmaxf(__uint_as_float(rr[0]),__uint_as_float(rr[1])); } \
      resc=false; \
      if(__builtin_expect(__any(rm>(float)THRL),0)){ const float dl=__builtin_fmaxf(rm,0.f); mhat+=dl; \
        _Pragma("unroll") for(int r=0;r<16;++r){C0[r]-=dl;C1[r]-=dl;} \
        _Pragma("unroll") for(int r=0;r<16;++r)negm[r]=-mhat; asm volatile("":"+v"(negm)); \
        const float f=__builtin_amdgcn_exp2f(-dl); l_reg*=f; if(hi==0)wsf[r32]=f; resc=true; } } \
    SBAR(); \
    GAPB(o[0]=__builtin_amdgcn_mfma_f32_32x32x16_bf16(PAF(0),VFR(0),o[0],0,0,0), C0,0); \
    GAPB(o[1]=__builtin_amdgcn_mfma_f32_32x32x16_bf16(PAF(0),VFR(4),o[1],0,0,0), C0,4); \
    KRD(GL,0); GAPB(o[0]=__builtin_amdgcn_mfma_f32_32x32x16_bf16(PAF(1),VFR(1),o[0],0,0,0), C0,8); \
    KRD(GL,1); GAPB(o[1]=__builtin_amdgcn_mfma_f32_32x32x16_bf16(PAF(1),VFR(5),o[1],0,0,0), C0,12); \
    KRD(GL,2); GAPB(o[0]=__builtin_amdgcn_mfma_f32_32x32x16_bf16(PAF(2),VFR(2),o[0],0,0,0), C1,0); \
    KRD(GL,3); GAPB(o[1]=__builtin_amdgcn_mfma_f32_32x32x16_bf16(PAF(2),VFR(6),o[1],0,0,0), C1,4); \
    GAPB(o[0]=__builtin_amdgcn_mfma_f32_32x32x16_bf16(PAF(3),VFR(3),o[0],0,0,0), C1,8); \
    GAPB(o[1]=__builtin_amdgcn_mfma_f32_32x32x16_bf16(PAF(3),VFR(7),o[1],0,0,0), C1,12); \
    }while(0)
  int t=1;
  #undef CMASK
  #define CMASK(P0,P1,t) do{}while(0)
  for(;t+5<NT;t+=2){
    STEP(pB0,pB1,pA0,pA1,t,true,true,true);     WAIT_BAR(2); RESC(); ROT();
    STEP(pA0,pA1,pB0,pB1,t+1,true,true,true);   WAIT_BAR(2); RESC(); ROT();
  }
  #undef CMASK
  #define CMASK(P0,P1,t) do{}while(0)
  #define ENDW(tt) do{ if((tt)+3<NT){WAIT_BAR(2);} else if((tt)+2<NT){WAIT_BAR(1);} else {WAIT_BAR(0);} }while(0)
  for(;t+1<NT;t+=2){
    STEP(pB0,pB1,pA0,pA1,t,(t+3<NT),(t+1<NT),(t+1<NT));       ENDW(t);   RESC(); ROT();
    STEP(pA0,pA1,pB0,pB1,t+1,(t+4<NT),(t+2<NT),(t+2<NT));     ENDW(t+1); RESC(); ROT();
  }
  STEP(pB0,pB1,pA0,pA1,NT-1,false,false,false); RESC();
  { float sacc=pB0[0]+pB0[1]; _Pragma("unroll") for(int r=2;r<16;++r)sacc+=pB0[r]; _Pragma("unroll") for(int r=0;r<16;++r)sacc+=pB1[r]; l_reg+=sacc;
    pw0=(u32x4){PKW(pB0,0),PKW(pB0,2),PKW(pB0,4),PKW(pB0,6)};pw1=(u32x4){PKW(pB0,8),PKW(pB0,10),PKW(pB0,12),PKW(pB0,14)};pw2=(u32x4){PKW(pB1,0),PKW(pB1,2),PKW(pB1,4),PKW(pB1,6)};pw3=(u32x4){PKW(pB1,8),PKW(pB1,10),PKW(pB1,12),PKW(pB1,14)};
    SBAR(); pv(o,vb0+sl_cur,PAF(0),PAF(1),PAF(2),PAF(3)); }
  #undef PKW
  #undef PAF
  #undef VFR
  #undef PIN
  #undef MX3
  #undef GAPA
  #undef GAPB
  #undef EX
  #undef VRD
  #undef KRD
  #undef STEP
  #undef ENDW
  {auto rr=__builtin_amdgcn_permlane32_swap(__float_as_uint(l_reg),__float_as_uint(l_reg),false,false);l_reg=__uint_as_float(rr[0])+__uint_as_float(rr[1]);}
  if(hi==0)wsf[32+r32]=l_reg;asm volatile("s_waitcnt lgkmcnt(0)":::"memory");
  float rli[16];
  #pragma unroll
  for(int r=0;r<16;++r)rli[r]=__builtin_amdgcn_rcpf(wsf[32+crow(r,hi)]);
  bf16*Ow=O+(qrow0+wid*QBLK)*DM+h*D;
  { bf16*stg=(bf16*)(shm+LDS_OST)+wid*2048;
    #pragma unroll
    for(int r=0;r<16;++r){const int orow=crow(r,hi);
      #pragma unroll
      for(int d0=0;d0<2;++d0)stg[orow*64+d0*32+r32]=__float2bfloat16(o[d0][r]*rli[r]);}
    asm volatile("s_waitcnt lgkmcnt(0)":::"memory");
    #pragma unroll
    for(int i=0;i<4;++i){const int row=i*8+(lane>>3),ch=lane&7; const u32x4 v=*(const u32x4*)(stg+row*64+ch*8); ATTN_STORE16(Ow+(long)row*DM+ch*8,v);} }
  asm volatile("s_waitcnt lgkmcnt(0)\n\ts_barrier":::"memory");
  #undef DMA_K
  #undef DMA_V
  #undef CMASK
  #undef START
  #undef RESC
  #undef ROT
}
constexpr int ATTN_LDS_BYTES=LDS_BYTES;
#undef SBAR
#undef WAIT_BAR
}

constexpr int NWAVES = 8;
constexpr int NB = 8, SEQ = 4096, CTXL = 256, TB = SEQ + CTXL  , MT = NB * TB  , DMODEL = 1024;
constexpr int NMODC = 6 * DMODEL, MODROWS = 9;
constexpr int QKVN = 1536, WINN = 3104, WINP = 3328;
constexpr int NEXP = 32, TOPK = 4, MPAD = MT * TOPK + NEXP * 256;
constexpr int NLAYER = 4;
constexpr float RMS_EPS = 1e-6f;
constexpr float ATT_C2 = 0.125f * 1.4426950408889634f;

constexpr size_t MiB = 1u << 20;
constexpr size_t WS_CTL = 0, CTL_ZERO_BYTES = 1 * MiB;
constexpr size_t WS_MOD = 1 * MiB, WS_ROPE = 2 * MiB, WS_MODP = 3 * MiB;
constexpr size_t WS_SLOT = 17 * MiB, WS_GATEW = 18 * MiB, WS_SLOTPOS = 19 * MiB;
constexpr size_t WS_WQKV = 20 * MiB, WS_WOA = 26 * MiB, WS_WIN = 30 * MiB, WS_WOG = 43 * MiB, WS_WGU = 48 * MiB, WS_WDN = 560 * MiB;
constexpr size_t WS_X = 816 * MiB, WS_XN = 952 * MiB, WS_Q = 1020 * MiB, WS_K = 1088 * MiB, WS_V = 1105 * MiB, WS_G = 1122 * MiB;
constexpr size_t WS_OF = 1343 * MiB, WS_OB = 1479 * MiB, WS_XG = 1615 * MiB, WS_ACT = 1903 * MiB, WS_Y = 2191 * MiB, WS_PAR = 2479 * MiB, WS_END = 2483 * MiB;
static_assert(WS_MODP + (size_t)16 * NLAYER * MODROWS * NMODC * 4 <= WS_SLOT && WS_WIN + (size_t)2 * WINP * 1024 * 2 <= WS_WOG && WS_G + (size_t)MT * WINP * 2 <= WS_OF && WS_XG + (size_t)MPAD * 1024 * 2 <= WS_ACT, "ws map");
constexpr int CW_TMO = 0, CW_BAR = 4096, CW_CNT = 16384;

constexpr int RING_OFF = 0, RING_BYTES = 131072;
constexpr int WR_STRIDE = 1028;
constexpr int LDS_AUX = 131584;
constexpr int AUX_LCNT = LDS_AUX, AUX_GB = LDS_AUX + 128, AUX_T2E = LDS_AUX + 256  , AUX_BASE = AUX_T2E + 2560  , AUX_NT = AUX_BASE + 128, AUX_ENT = AUX_NT + 64  ;
constexpr int MISC_OFF = 154624;
constexpr int LDS_BYTES = 155648;
static_assert(AUX_ENT + 4352 <= MISC_OFF && 32 * WR_STRIDE * 4 <= LDS_AUX, "LDS map");

#define GAS __attribute__((address_space(1)))
#define LAS __attribute__((address_space(3)))
typedef unsigned short bf16;
typedef unsigned v4u __attribute__((ext_vector_type(4)));
typedef float f32x4 __attribute__((ext_vector_type(4)));
typedef short bf16x8 __attribute__((ext_vector_type(8)));
typedef GAS unsigned gu32;
typedef GAS unsigned long long gu64;
#define RLX_AGENT __ATOMIC_RELAXED, __HIP_MEMORY_SCOPE_AGENT
#define LDS_WAIT() asm volatile("s_waitcnt lgkmcnt(0)" ::: "memory")
#define VM_WAIT() asm volatile("s_waitcnt vmcnt(0)" ::: "memory")
__device__ __forceinline__ unsigned long long rt() { return __builtin_amdgcn_s_memrealtime(); }
__device__ __forceinline__ unsigned f2bf(float f) { unsigned u = __builtin_bit_cast(unsigned, f); return (u + 0x7fffu + ((u >> 16) & 1u)) >> 16; }
__device__ __forceinline__ unsigned pk2(float lo, float hi) { return f2bf(lo) | (f2bf(hi) << 16); }

#define XB_TMO      128
#define XB_XCNT(j)  (256  + 64 * (j))
#define XB_XSUB(j)  (1280 + 64 * (j))
#define XB_XGEN(j)  (2304 + 64 * (j))
#define XB_TOP      3328
#define XB_TOPGEN   3392
#define XCD_BAR_WORDS 3456
#define XB_SPIN_CAP (1u << 18)

__device__ __forceinline__ unsigned xb_ld(unsigned* p)              { return __hip_atomic_load(p, __ATOMIC_RELAXED, __HIP_MEMORY_SCOPE_AGENT); }
__device__ __forceinline__ unsigned xb_add(unsigned* p, unsigned v) { return __hip_atomic_fetch_add(p, v, __ATOMIC_RELAXED, __HIP_MEMORY_SCOPE_AGENT); }
__device__ __forceinline__ unsigned xb_xcc_id() { return (unsigned)__builtin_amdgcn_s_getreg((3 << 11) | 20) & 0xFu; }
#define XB_SPIN(cond, bar) do { unsigned _sp = 0; while (cond) { __builtin_amdgcn_s_sleep(1); \
    if ((++_sp & 255u) == 0u) { if (xb_ld(&(bar)[XB_TMO])) break; if (_sp > XB_SPIN_CAP) { atomicAdd(&(bar)[XB_TMO], 1u); break; } } } } while (0)

struct XcdBarrier {
    unsigned* bar; unsigned x;
    volatile LAS unsigned* st;
};

__device__ __forceinline__ XcdBarrier xcd_barrier_post(unsigned* bar, volatile LAS unsigned* st) {
    XcdBarrier b; b.bar = bar; b.x = xb_xcc_id(); b.st = st;
    if (threadIdx.x == 0) (void)xb_add(&bar[XB_XCNT(b.x)], 1u);
    return b;
}
__device__ __forceinline__ void xcd_barrier_complete(unsigned* bar, unsigned x, unsigned& nloc, unsigned& nx) {
    const unsigned G = gridDim.x * gridDim.y * gridDim.z;
    unsigned sum, cnt, mine, sp = 0u;
    for (;;) {
        sum = 0u; cnt = 0u; mine = 0u;
#pragma unroll
        for (unsigned j = 0; j < 16; ++j) { const unsigned c = xb_ld(&bar[XB_XCNT(j)]); sum += c; cnt += (c > 0u) ? 1u : 0u; mine = (j == x) ? c : mine; }
        if (sum == G) break;
        __builtin_amdgcn_s_sleep(1);
        if ((++sp & 255u) == 0u) { if (xb_ld(&bar[XB_TMO])) break; if (sp > XB_SPIN_CAP) { atomicAdd(&bar[XB_TMO], 1u); break; } }
    }
    nloc = mine > 0u ? mine : 1u; nx = cnt > 0u ? cnt : 1u;
}

__device__ __forceinline__ void xcd_barrier(const XcdBarrier& b) {
    asm volatile("s_waitcnt vmcnt(0)" ::: "memory");
    __syncthreads();
    if (threadIdx.x == 0) {
        unsigned* bar = b.bar;
        __builtin_amdgcn_s_waitcnt(0);
        unsigned nloc = b.st[0], nx = b.st[1];
        if (nloc == 0u) { xcd_barrier_complete(bar, b.x, nloc, nx); b.st[0] = nloc; b.st[1] = nx; }
        const unsigned old = xb_add(&bar[XB_XSUB(b.x)], 1u);
        const unsigned gen = old / nloc;
        if (old + 1u == (gen + 1u) * nloc) {
            __builtin_amdgcn_fence(__ATOMIC_RELEASE, "agent");
            asm volatile("s_waitcnt vmcnt(0)" ::: "memory");
            const unsigned og = xb_add(&bar[XB_TOP], 1u);
            const unsigned tg = og / nx;
            if (og + 1u == (tg + 1u) * nx) xb_add(&bar[XB_TOPGEN], 1u);
            else XB_SPIN(xb_ld(&bar[XB_TOPGEN]) == tg, bar);
            __builtin_amdgcn_fence(__ATOMIC_ACQUIRE, "agent");
            xb_add(&bar[XB_XGEN(b.x)], 1u);
            asm volatile("s_waitcnt vmcnt(0)" ::: "memory");
        } else {
            XB_SPIN(xb_ld(&bar[XB_XGEN(b.x)]) == gen, bar);
            __builtin_amdgcn_fence(__ATOMIC_ACQUIRE, "agent");
            asm volatile("s_waitcnt vmcnt(0)" ::: "memory");
        }
    }
    __syncthreads();
}

typedef float f32x2 __attribute__((ext_vector_type(2)));
__device__ __forceinline__ float wave_sum(float v) {
#pragma unroll
    for (int o = 1; o < 64; o <<= 1) v += __shfl_xor(v, o);
    return v;
}
__device__ __forceinline__ float wave_max(float v) {
#pragma unroll
    for (int o = 1; o < 64; o <<= 1) v = fmaxf(v, __shfl_xor(v, o));
    return v;
}
__device__ __forceinline__ float bf2f(unsigned short h) { return __uint_as_float((unsigned)h << 16); }
__device__ __forceinline__ float silu_f(float x) { return x / (1.0f + __expf(-x)); }
__device__ __forceinline__ int mod_row(int m) { const int b = m / TB; return (m - b * TB < CTXL) ? 8 : b; }

__device__ __forceinline__ void transpose_item(const float* W, int K, int N, bf16* WT, int k0, int n0, int dst_row0, LAS float* scr, int lane) {
#pragma unroll 8
    for (int i = 0; i < 32; ++i) { const int kk = 2 * i + (lane >> 5); scr[kk * 33 + (lane & 31)] = W[(size_t)(k0 + kk) * N + n0 + (lane & 31)]; }
    LDS_WAIT(); asm volatile("" ::: "memory");
    const int c = lane & 7;
#pragma unroll
    for (int j = 0; j < 4; ++j) { const int n = (lane >> 3) + 8 * j; const LAS float* s = scr + (8 * c) * 33 + n;
        v4u o; o.x = pk2(s[0 * 33], s[1 * 33]); o.y = pk2(s[2 * 33], s[3 * 33]); o.z = pk2(s[4 * 33], s[5 * 33]); o.w = pk2(s[6 * 33], s[7 * 33]);
        *(GAS v4u*)(WT + (size_t)(dst_row0 + n) * K + k0 + 8 * c) = o; }
    LDS_WAIT(); asm volatile("" ::: "memory");
}

struct Args { const float* in[25]; float* out; unsigned char* ws; int ph_lo, ph_hi; };
constexpr int P_N1G = 0, P_N2G = 4096, P_QG = 8192, P_KG = 8320, P_GKF = 8448, P_GKB = 24832, P_BGF = 41216, P_BGB = 42240, P_OG = 43264, P_WR = 43776, P_BR = 174848, P_BGU = 174976, P_BDN = 437120, P_END = 568192;
#define LAUNDER_S(p) asm volatile("" : "+s"(p))
#define LAUNDER_V(p) asm volatile("" : "+v"(p))
#define PARF(ws) ((const float*)((ws) + WS_PAR))

__device__ __forceinline__ void p0_prologue(const Args& A, LAS unsigned char* lds, int gw, int NGW, int wave, int lane) {
    unsigned char* ws = A.ws;
    LAS float* scr = (LAS float*)(lds + RING_OFF + wave * 16384);
    constexpr int I_QKV = 2 * 16 * (QKVN / 32), I_WO = 2 * 16 * 32, I_WIN = 2 * 16 * (WINN / 32), I_GU = 128 * 16 * 64, I_DN = 128 * 16 * 32;
    constexpr int NITEMS = I_GU + I_DN + I_QKV + I_WO + I_WIN + I_WO;
    for (int it = gw; it < NITEMS; it += NGW) {
        int r = it;
        if (r < I_GU) { const int mat = r / (16 * 64), q = r - mat * (16 * 64), kb = q / 64, nb = q - kb * 64, n0 = nb * 32;
            const int dst = ((n0 & 1023) >> 7) * 256 + (n0 >> 10) * 128 + (n0 & 127);
            transpose_item(A.in[21] + (size_t)mat * 1024 * 2048, 1024, 2048, (bf16*)(ws + WS_WGU) + (size_t)mat * 2048 * 1024, kb * 64, n0, dst, scr, lane); continue; } r -= I_GU;
        if (r < I_DN) { const int mat = r / (16 * 32), q = r - mat * (16 * 32), kb = q / 32, nb = q - kb * 32;
            transpose_item(A.in[23] + (size_t)mat * 1024 * 1024, 1024, 1024, (bf16*)(ws + WS_WDN) + (size_t)mat * 1024 * 1024, kb * 64, nb * 32, nb * 32, scr, lane); continue; } r -= I_DN;
        if (r < I_QKV) { const int per = 16 * (QKVN / 32), mat = r / per, q = r - mat * per, kb = q / (QKVN / 32), nb = q - kb * (QKVN / 32);
            transpose_item(A.in[8] + (size_t)mat * 1024 * QKVN, 1024, QKVN, (bf16*)(ws + WS_WQKV) + (size_t)mat * QKVN * 1024, kb * 64, nb * 32, nb * 32, scr, lane); continue; } r -= I_QKV;
        if (r < I_WO) { const int mat = r / 512, q = r - mat * 512, kb = q / 32, nb = q - kb * 32;
            transpose_item(A.in[11] + (size_t)mat * 1024 * 1024, 1024, 1024, (bf16*)(ws + WS_WOA) + (size_t)mat * 1024 * 1024, kb * 64, nb * 32, nb * 32, scr, lane); continue; } r -= I_WO;
        if (r < I_WIN) { const int per = 16 * (WINN / 32), mat = r / per, q = r - mat * per, kb = q / (WINN / 32), nb = q - kb * (WINN / 32);
            transpose_item(A.in[12] + (size_t)mat * 1024 * WINN, 1024, WINN, (bf16*)(ws + WS_WIN) + (size_t)mat * WINP * 1024, kb * 64, nb * 32, nb * 32, scr, lane); continue; } r -= I_WIN;
        { const int mat = r / 512, q = r - mat * 512, kb = q / 32, nb = q - kb * 32;
            transpose_item(A.in[18] + (size_t)mat * 1024 * 1024, 1024, 1024, (bf16*)(ws + WS_WOG) + (size_t)mat * 1024 * 1024, kb * 64, nb * 32, nb * 32, scr, lane); }
    }
    for (int it = gw; it < 2 * (WINP - WINN); it += NGW) { const int mat = it / (WINP - WINN), rr = WINN + it - mat * (WINP - WINN);
        GAS v4u* p = (GAS v4u*)((bf16*)(ws + WS_WIN) + ((size_t)mat * WINP + rr) * 1024) + lane; p[0] = (v4u){0u, 0u, 0u, 0u}; p[64] = (v4u){0u, 0u, 0u, 0u}; }
    for (int it = gw; it < NLAYER * 24 * 16; it += NGW) {
        const int l = it / (24 * 16), q = it - l * (24 * 16), cg = q / 16, kc = q - cg * 16;
        float s[MODROWS];
#pragma unroll
        for (int r = 0; r < MODROWS; ++r) { const float cv = (r < 8) ? A.in[1][r * 1024 + kc * 64 + lane] : A.in[3][kc * 64 + lane]; s[r] = silu_f(cv); }
        f32x4 acc[MODROWS];
#pragma unroll
        for (int r = 0; r < MODROWS; ++r) acc[r] = (f32x4){0.f, 0.f, 0.f, 0.f};
        const float* wp = A.in[4] + ((size_t)l * 1024 + kc * 64) * NMODC + cg * 256 + 4 * lane;
#pragma unroll 4
        for (int kk = 0; kk < 64; ++kk) { const f32x4 w = *(const f32x4*)(wp + (size_t)kk * NMODC);
#pragma unroll
            for (int r = 0; r < MODROWS; ++r) { const float sv = __shfl(s[r], kk); acc[r] = acc[r] + w * sv; } }
        float* op = (float*)(ws + WS_MODP) + (size_t)kc * (NLAYER * MODROWS * NMODC) + (size_t)l * MODROWS * NMODC + cg * 256 + 4 * lane;
#pragma unroll
        for (int r = 0; r < MODROWS; ++r) *(f32x4*)(op + (size_t)r * NMODC) = acc[r];
    }
    for (int m = gw; m < MT; m += NGW) { const int b = m / TB, w = m - b * TB;
        const float* src = (w < CTXL) ? A.in[2] + ((size_t)b * CTXL + w) * 1024 : A.in[0] + ((size_t)b * SEQ + (w - CTXL)) * 1024;
        const GAS f32x4* sp = (const GAS f32x4*)src + lane; GAS f32x4* dp = (GAS f32x4*)((float*)(ws + WS_X) + (size_t)m * 1024) + lane;
#pragma unroll
        for (int j = 0; j < 4; ++j) dp[64 * j] = sp[64 * j]; }
    { float* par = (float*)(ws + WS_PAR); const int gt = gw * 64 + lane, NGT = NGW * 64;
#define CPY(src, n, off) for (int i = gt; i < (n); i += NGT) par[(off) + i] = A.in[src][i];
      CPY(6, 4096, P_N1G) CPY(7, 4096, P_N2G) CPY(9, 128, P_QG) CPY(10, 128, P_KG) CPY(13, 16384, P_GKF) CPY(15, 16384, P_GKB) CPY(14, 1024, P_BGF) CPY(16, 1024, P_BGB)
      CPY(17, 512, P_OG) CPY(19, 131072, P_WR) CPY(20, 128, P_BR) CPY(22, 262144, P_BGU) CPY(24, 131072, P_BDN)
#undef CPY
    }
    for (int idx = gw * 64 + lane; idx < SEQ * 32; idx += NGW * 64) { const int s = idx >> 5, i = idx & 31;
        const float invf = 1.0f / powf(10000.0f, (float)(i & 15) * (1.0f / 16.0f));
        const float ang = (float)((i < 16) ? (s >> 6) : (s & 63)) * invf;
        ((float*)(ws + WS_ROPE))[idx] = cosf(ang); ((float*)(ws + WS_ROPE))[SEQ * 32 + idx] = sinf(ang); }
}
__device__ __forceinline__ void p1_mod_reduce(const Args& A, int gtid, int NGT) {
    const float* P = (const float*)(A.ws + WS_MODP); float* Mo = (float*)(A.ws + WS_MOD);
    constexpr int N = NLAYER * MODROWS * NMODC;
    for (int i = gtid; i < N; i += NGT) { const int l = i / (MODROWS * NMODC), c = i % NMODC; float s = A.in[5][l * NMODC + c];
#pragma unroll
        for (int k = 0; k < 16; ++k) s += P[(size_t)k * N + i];
        Mo[i] = s; }
}
__device__ __forceinline__ void modulate_row(const float* xrow, const float* ng, const float* shp, const float* scp, bf16* orow, int lane, f32x4 (&y)[4]) {
    const GAS f32x4* xr = (const GAS f32x4*)xrow + lane;
    float ss = 0.f;
#pragma unroll
    for (int j = 0; j < 4; ++j) { y[j] = xr[64 * j]; ss += (y[j].x * y[j].x + y[j].y * y[j].y) + (y[j].z * y[j].z + y[j].w * y[j].w); }
    const float rs = 1.0f / sqrtf(wave_sum(ss) * (1.0f / 1024.0f) + RMS_EPS);
    GAS unsigned long long* o8 = (GAS unsigned long long*)orow + lane;
#pragma unroll
    for (int j = 0; j < 4; ++j) { const f32x4 g = ((const GAS f32x4*)ng)[64 * j + lane], sh = ((const GAS f32x4*)shp)[64 * j + lane], sc = ((const GAS f32x4*)scp)[64 * j + lane];
        y[j] = (y[j] * rs) * g * (sc + 1.0f) + sh;
        o8[64 * j] = (unsigned long long)pk2(y[j].x, y[j].y) | ((unsigned long long)pk2(y[j].z, y[j].w) << 32); }
}
__device__ __forceinline__ void phase_modulate1(unsigned char* ws, int layer, int gw, int NGW, int lane) {
    const float* X = (const float*)(ws + WS_X); bf16* XN = (bf16*)(ws + WS_XN);
    const float* ng = PARF(ws) + P_N1G + layer * 1024; const float* Mo = (const float*)(ws + WS_MOD) + (size_t)layer * MODROWS * NMODC;
    for (int m = gw; m < MT; m += NGW) { const int mr = mod_row(m); f32x4 y[4];
        modulate_row(X + (size_t)m * 1024, ng, Mo + (size_t)mr * NMODC + 0 * 1024, Mo + (size_t)mr * NMODC + 1 * 1024, XN + (size_t)m * 1024, lane, y); }
}
__device__ __forceinline__ void phase_qknorm_rope(unsigned char* ws, int la, int gw, int NGW, int lane) {
    bf16* Qb = (bf16*)(ws + WS_Q); bf16* Kb = (bf16*)(ws + WS_K);
    const float* qg = PARF(ws) + P_QG + la * 64; const float* kg = PARF(ws) + P_KG + la * 64; const float* ropec = (const float*)(ws + WS_ROPE); const float* ropes = ropec + SEQ * 32;
    const int i = lane & 31, hs = lane >> 5;
    for (int m = gw; m < MT; m += NGW) { const int b = m / TB, w = m - b * TB; const bool lat = w >= CTXL;
        float cs = 1.f, sn = 0.f; if (lat) { cs = ropec[(w - CTXL) * 32 + i]; sn = ropes[(w - CTXL) * 32 + i]; }
#pragma unroll 2
        for (int hh = 0; hh < 20; hh += 2) { const int hd = hh + hs;
            unsigned* p = (hd < 16) ? (unsigned*)(Qb + (size_t)m * 1024 + hd * 64) + i : (unsigned*)(Kb + (size_t)m * 256 + (hd - 16) * 64) + i;
            const float* gp = (hd < 16) ? qg : kg; const float scl = (hd < 16) ? ATT_C2 : 1.0f;
            const unsigned v = *p; const float x1 = __uint_as_float(v << 16), x2 = __uint_as_float(v & 0xffff0000u);
            float ss = x1 * x1 + x2 * x2;
#pragma unroll
            for (int o = 1; o < 32; o <<= 1) ss += __shfl_xor(ss, o);
            const float rs = 1.0f / sqrtf(ss * (1.0f / 64.0f) + RMS_EPS);
            const float y1 = x1 * rs * gp[2 * i], y2 = x2 * rs * gp[2 * i + 1];
            const float r1 = (y1 * cs - y2 * sn) * scl, r2 = (y1 * sn + y2 * cs) * scl;
            *p = pk2(r1, r2); }
    }
}
__device__ __forceinline__ void phase_gla_recurrent(unsigned char* ws, int lg, LAS unsigned char* lds, int tid) {
    const int unit = blockIdx.x; if (unit >= 128) return;
    const int half = unit & 1, dir = (unit >> 1) & 1, h = (unit >> 2) & 3, b = unit >> 4;
    const bf16* G = (const bf16*)(ws + WS_G);
    float* Oo = (float*)(ws + (dir ? WS_OB : WS_OF));
    const float* wg = PARF(ws) + (dir ? P_GKB : P_GKF) + (size_t)lg * 16 * 512; const float* bg = PARF(ws) + (dir ? P_BGB : P_BGF) + lg * 512;
    LAS float* qq = (LAS float*)(lds + RING_OFF); LAS float* kk = qq + 64 * 128; LAS float* dd = kk + 64 * 128; LAS float* vv = dd + 64 * 128;
    const int sd = tid & 127, st0 = tid >> 7;
    float wcol[16];
#pragma unroll
    for (int r = 0; r < 16; ++r) wcol[r] = wg[r * 512 + h * 128 + sd];
    const float bcol = bg[h * 128 + sd];
    const int c = tid >> 2, dq = tid & 3;
    float s[32];
#pragma unroll
    for (int j = 0; j < 32; ++j) s[j] = 0.f;
    const float qscale = 0.08838834764831845f;
    for (int ch = 0; ch < TB / 64; ++ch) {
        __syncthreads();
#pragma unroll 4
        for (int i = 0; i < 16; ++i) { const int tt = st0 + 4 * i, n = 64 * ch + tt;
            const int w = dir ? (n < CTXL ? (CTXL - 1 - n) : (TB + CTXL - 1 - n)) : n;
            const bf16* gr = G + ((size_t)b * TB + w) * WINP;
            const float qv = bf2f(gr[h * 128 + sd]) * qscale, kv = bf2f(gr[512 + h * 128 + sd]);
            const bf16* lp = gr + 3072 + dir * 16; float z = bcol;
#pragma unroll
            for (int r = 0; r < 16; ++r) z += bf2f(lp[r]) * wcol[r];
            const float ls = fminf(z, 0.f) - log1pf(__expf(-fabsf(z)));
            qq[tt * 128 + sd] = qv; kk[tt * 128 + sd] = kv; dd[tt * 128 + sd] = __expf(ls * (1.0f / 16.0f));
            vv[tt * 128 + sd] = bf2f(gr[1024 + h * 256 + half * 128 + sd]); }
        __syncthreads();
        for (int tt = 0; tt < 64; ++tt) { const int n = 64 * ch + tt; const int w = dir ? (n < CTXL ? (CTXL - 1 - n) : (TB + CTXL - 1 - n)) : n;
            const float v = vv[tt * 128 + c]; float acc = 0.f;
            const LAS f32x4* q4 = (const LAS f32x4*)(qq + tt * 128 + dq * 32); const LAS f32x4* k4 = (const LAS f32x4*)(kk + tt * 128 + dq * 32); const LAS f32x4* d4 = (const LAS f32x4*)(dd + tt * 128 + dq * 32);
#pragma unroll
            for (int j = 0; j < 8; ++j) { const f32x4 qv = q4[j], kv = k4[j], dv = d4[j];
                s[4 * j + 0] = s[4 * j + 0] * dv.x + kv.x * v; acc += qv.x * s[4 * j + 0];
                s[4 * j + 1] = s[4 * j + 1] * dv.y + kv.y * v; acc += qv.y * s[4 * j + 1];
                s[4 * j + 2] = s[4 * j + 2] * dv.z + kv.z * v; acc += qv.z * s[4 * j + 2];
                s[4 * j + 3] = s[4 * j + 3] * dv.w + kv.w * v; acc += qv.w * s[4 * j + 3]; }
            acc += __shfl_xor(acc, 1); acc += __shfl_xor(acc, 2);
            if (dq == 0) Oo[((size_t)b * TB + w) * 1024 + h * 256 + half * 128 + c] = acc; }
    }
}
__device__ __forceinline__ void phase_gla_readout(unsigned char* ws, int lg, int gw, int NGW, int lane) {
    const float* OF = (const float*)(ws + WS_OF); const float* OB = (const float*)(ws + WS_OB); const bf16* G = (const bf16*)(ws + WS_G); bf16* OG = (bf16*)(ws + WS_Q);
    const f32x4 og = ((const GAS f32x4*)(PARF(ws) + P_OG + lg * 256))[lane];
    for (int m = gw; m < MT; m += NGW) {
#pragma unroll
        for (int hh = 0; hh < 4; ++hh) { const size_t off = (size_t)m * 1024 + hh * 256 + 4 * lane;
            f32x4 o = *(const GAS f32x4*)(OF + off) + *(const GAS f32x4*)(OB + off);
            const float ss = wave_sum((o.x * o.x + o.y * o.y) + (o.z * o.z + o.w * o.w));
            const float rs = 1.0f / sqrtf(ss * (1.0f / 256.0f) + RMS_EPS);
            const unsigned long long rv = *(const GAS unsigned long long*)(G + (size_t)m * WINP + 2048 + hh * 256 + 4 * lane);
            const float r0 = __uint_as_float((unsigned)(rv & 0xffffu) << 16), r1 = __uint_as_float((unsigned)(rv >> 16) << 16), r2 = __uint_as_float((unsigned)((rv >> 32) & 0xffffu) << 16), r3 = __uint_as_float((unsigned)(rv >> 48) << 16);
            o = o * rs * og;
            o.x *= silu_f(r0); o.y *= silu_f(r1); o.z *= silu_f(r2); o.w *= silu_f(r3);
            *(GAS unsigned long long*)(OG + off) = (unsigned long long)pk2(o.x, o.y) | ((unsigned long long)pk2(o.z, o.w) << 32); }
    }
}
constexpr size_t WS_GQ = WS_XG, WS_GKH = WS_XG + 68 * MiB, WS_GKT = WS_XG + 136 * MiB, WS_GVT = WS_XG + 204 * MiB, WS_GDL = WS_ACT, WS_SX = WS_OF;
static_assert((size_t)2176 * 2 * 16384 <= 68 * MiB && (size_t)2176 * 256 * 64 * 2 <= 68 * MiB && (size_t)64 * 68 * 65536 <= 272 * MiB, "gla buffers");
typedef float f32x16 __attribute__((ext_vector_type(16)));
__device__ __forceinline__ float log_sigmoid_fast(float z) { return fminf(z, 0.f) - __logf(1.0f + __expf(-fabsf(z))); }

__device__ __forceinline__ void phase_gla_g0(unsigned char* ws, int lg, LAS unsigned char* lds, int tid) {
    const bf16* G = (const bf16*)(ws + WS_G);
    LAS float* tot = (LAS float*)(lds + RING_OFF);
    const int d2 = tid & 63, tb = tid >> 6;
    for (int cn = blockIdx.x; cn < 2176; cn += gridDim.x) {
        const int n = cn % 68, bh = cn / 68, h = bh & 3, b = bh >> 2;
        const size_t row0 = (size_t)b * TB + 64 * n + 8 * tb;
        float wf0[16], wf1[16], wb0[16], wb1[16];
        { const float* wgf = PARF(ws) + P_GKF + (size_t)lg * 16 * 512 + h * 128 + 2 * d2; const float* wgb = PARF(ws) + P_GKB + (size_t)lg * 16 * 512 + h * 128 + 2 * d2;
#pragma unroll
          for (int r = 0; r < 16; ++r) { const f32x2 a = *(const GAS f32x2*)(wgf + r * 512), c = *(const GAS f32x2*)(wgb + r * 512); wf0[r] = a.x; wf1[r] = a.y; wb0[r] = c.x; wb1[r] = c.y; } }
        const f32x2 bf_ = *(const GAS f32x2*)(PARF(ws) + P_BGF + lg * 512 + h * 128 + 2 * d2), bb_ = *(const GAS f32x2*)(PARF(ws) + P_BGB + lg * 512 + h * 128 + 2 * d2);
        float gf0[8], gf1[8], gb0[8], gb1[8]; unsigned qk[8][2];
#pragma unroll
        for (int j = 0; j < 8; ++j) { const bf16* gr = G + (row0 + j) * WINP;
            const v4u l0 = *(const GAS v4u*)(gr + 3072), l1 = *(const GAS v4u*)(gr + 3080), l2 = *(const GAS v4u*)(gr + 3088), l3 = *(const GAS v4u*)(gr + 3096);
            qk[j][0] = *(const GAS unsigned*)(gr + h * 128 + 2 * d2); qk[j][1] = *(const GAS unsigned*)(gr + 512 + h * 128 + 2 * d2);
            float lf[16], lb[16];
            lf[0] = __uint_as_float(l0.x << 16); lf[1] = __uint_as_float(l0.x & 0xffff0000u); lf[2] = __uint_as_float(l0.y << 16); lf[3] = __uint_as_float(l0.y & 0xffff0000u);
            lf[4] = __uint_as_float(l0.z << 16); lf[5] = __uint_as_float(l0.z & 0xffff0000u); lf[6] = __uint_as_float(l0.w << 16); lf[7] = __uint_as_float(l0.w & 0xffff0000u);
            lf[8] = __uint_as_float(l1.x << 16); lf[9] = __uint_as_float(l1.x & 0xffff0000u); lf[10] = __uint_as_float(l1.y << 16); lf[11] = __uint_as_float(l1.y & 0xffff0000u);
            lf[12] = __uint_as_float(l1.z << 16); lf[13] = __uint_as_float(l1.z & 0xffff0000u); lf[14] = __uint_as_float(l1.w << 16); lf[15] = __uint_as_float(l1.w & 0xffff0000u);
            lb[0] = __uint_as_float(l2.x << 16); lb[1] = __uint_as_float(l2.x & 0xffff0000u); lb[2] = __uint_as_float(l2.y << 16); lb[3] = __uint_as_float(l2.y & 0xffff0000u);
            lb[4] = __uint_as_float(l2.z << 16); lb[5] = __uint_as_float(l2.z & 0xffff0000u); lb[6] = __uint_as_float(l2.w << 16); lb[7] = __uint_as_float(l2.w & 0xffff0000u);
            lb[8] = __uint_as_float(l3.x << 16); lb[9] = __uint_as_float(l3.x & 0xffff0000u); lb[10] = __uint_as_float(l3.y << 16); lb[11] = __uint_as_float(l3.y & 0xffff0000u);
            lb[12] = __uint_as_float(l3.z << 16); lb[13] = __uint_as_float(l3.z & 0xffff0000u); lb[14] = __uint_as_float(l3.w << 16); lb[15] = __uint_as_float(l3.w & 0xffff0000u);
            float zf0 = bf_.x, zf1 = bf_.y, zb0 = bb_.x, zb1 = bb_.y;
#pragma unroll
            for (int r = 0; r < 16; ++r) { zf0 += lf[r] * wf0[r]; zf1 += lf[r] * wf1[r]; zb0 += lb[r] * wb0[r]; zb1 += lb[r] * wb1[r]; }
            gf0[j] = log_sigmoid_fast(zf0) * 0.0625f; gf1[j] = log_sigmoid_fast(zf1) * 0.0625f; gb0[j] = log_sigmoid_fast(zb0) * 0.0625f; gb1[j] = log_sigmoid_fast(zb1) * 0.0625f; }
#pragma unroll
        for (int j = 1; j < 8; ++j) { gf0[j] += gf0[j - 1]; gf1[j] += gf1[j - 1]; gb0[7 - j] += gb0[8 - j]; gb1[7 - j] += gb1[8 - j]; }
        __syncthreads();
        *(LAS f32x2*)(tot + (0 * 8 + tb) * 128 + 2 * d2) = (f32x2){gf0[7], gf1[7]}; *(LAS f32x2*)(tot + (1 * 8 + tb) * 128 + 2 * d2) = (f32x2){gb0[0], gb1[0]};
        __syncthreads();
        float pf0 = 0.f, pf1 = 0.f, pb0 = 0.f, pb1 = 0.f, lf0 = 0.f, lf1 = 0.f, lb0 = 0.f, lb1 = 0.f;
#pragma unroll
        for (int q = 0; q < 8; ++q) { const f32x2 a = *(const LAS f32x2*)(tot + (0 * 8 + q) * 128 + 2 * d2), c = *(const LAS f32x2*)(tot + (1 * 8 + q) * 128 + 2 * d2);
            lf0 += a.x; lf1 += a.y; lb0 += c.x; lb1 += c.y;
            if (q < tb) { pf0 += a.x; pf1 += a.y; } if (q > tb) { pb0 += c.x; pb1 += c.y; } }
        const size_t itf = (size_t)cn * 2, itb = itf + 1;
        bf16* Qf = (bf16*)(ws + WS_GQ) + itf * 8192; bf16* Qb = Qf + 8192; bf16* Kf = (bf16*)(ws + WS_GKH) + itf * 8192; bf16* Kb = Kf + 8192;
        const float elf0 = __expf(lf0), elf1 = __expf(lf1), elb0 = __expf(lb0), elb1 = __expf(lb1);
        float ktf0[8], ktf1[8], ktb0[8], ktb1[8];
#pragma unroll
        for (int j = 0; j < 8; ++j) { const int t = 8 * tb + j;
            const float q0 = __uint_as_float(qk[j][0] << 16) * 0.08838834764831845f, q1 = __uint_as_float(qk[j][0] & 0xffff0000u) * 0.08838834764831845f;
            const float k0 = __uint_as_float(qk[j][1] << 16), k1 = __uint_as_float(qk[j][1] & 0xffff0000u);
            const float ef0 = __expf(pf0 + gf0[j]), ef1 = __expf(pf1 + gf1[j]), eb0 = __expf(pb0 + gb0[j]), eb1 = __expf(pb1 + gb1[j]);
            const float rf0 = __builtin_amdgcn_rcpf(ef0), rf1 = __builtin_amdgcn_rcpf(ef1), rb0 = __builtin_amdgcn_rcpf(eb0), rb1 = __builtin_amdgcn_rcpf(eb1);
            *(GAS unsigned*)(Qf + t * 128 + 2 * d2) = pk2(q0 * ef0, q1 * ef1); *(GAS unsigned*)(Qb + t * 128 + 2 * d2) = pk2(q0 * eb0, q1 * eb1);
            *(GAS unsigned*)(Kf + t * 128 + 2 * d2) = pk2(k0 * rf0, k1 * rf1); *(GAS unsigned*)(Kb + t * 128 + 2 * d2) = pk2(k0 * rb0, k1 * rb1);
            ktf0[j] = k0 * rf0 * elf0; ktf1[j] = k1 * rf1 * elf1; ktb0[j] = k0 * rb0 * elb0; ktb1[j] = k1 * rb1 * elb1; }
        { bf16* Tf = (bf16*)(ws + WS_GKT) + itf * 8192 + (size_t)(2 * d2) * 64 + 8 * tb; bf16* Tb = Tf + 8192;
          *(GAS v4u*)Tf = (v4u){pk2(ktf0[0], ktf0[1]), pk2(ktf0[2], ktf0[3]), pk2(ktf0[4], ktf0[5]), pk2(ktf0[6], ktf0[7])};
          *(GAS v4u*)(Tf + 64) = (v4u){pk2(ktf1[0], ktf1[1]), pk2(ktf1[2], ktf1[3]), pk2(ktf1[4], ktf1[5]), pk2(ktf1[6], ktf1[7])};
          *(GAS v4u*)Tb = (v4u){pk2(ktb0[0], ktb0[1]), pk2(ktb0[2], ktb0[3]), pk2(ktb0[4], ktb0[5]), pk2(ktb0[6], ktb0[7])};
          *(GAS v4u*)(Tb + 64) = (v4u){pk2(ktb1[0], ktb1[1]), pk2(ktb1[2], ktb1[3]), pk2(ktb1[4], ktb1[5]), pk2(ktb1[6], ktb1[7])}; }
        if (tb == 0) { float* DLp = (float*)(ws + WS_GDL) + itf * 128 + 2 * d2; *(GAS f32x2*)DLp = (f32x2){elf0, elf1}; *(GAS f32x2*)(DLp + 128) = (f32x2){elb0, elb1}; }
        {
            const int dv = tid & 255, th = tid >> 8; const bf16* vp = G + ((size_t)b * TB + 64 * n + 32 * th) * WINP + 1024 + h * 256 + dv;
            unsigned wv[16];
#pragma unroll
            for (int j = 0; j < 16; ++j) wv[j] = (unsigned)vp[(size_t)(2 * j) * WINP] | ((unsigned)vp[(size_t)(2 * j + 1) * WINP] << 16);
            GAS v4u* op = (GAS v4u*)((bf16*)(ws + WS_GVT) + ((size_t)cn * 256 + dv) * 64 + 32 * th);
            op[0] = (v4u){wv[0], wv[1], wv[2], wv[3]}; op[1] = (v4u){wv[4], wv[5], wv[6], wv[7]}; op[2] = (v4u){wv[8], wv[9], wv[10], wv[11]}; op[3] = (v4u){wv[12], wv[13], wv[14], wv[15]}; }
    }
}
struct G12Ops { bf16x8 a[4], b[4]; f32x4 d[4]; };
__device__ __forceinline__ void g12_load(G12Ops& o, unsigned char* ws, int bh, int dir, int m, int kb, int vb, int r, int hh) {
    const int n = dir ? (m < 4 ? 3 - m : 71 - m) : m; const size_t cn = (size_t)bh * 68 + n, item = cn * 2 + dir;
    const bf16* ap = (const bf16*)(ws + WS_GKT) + item * 8192 + (size_t)(32 * kb + r) * 64 + 8 * hh;
    const bf16* bp = (const bf16*)(ws + WS_GVT) + (cn * 256 + 32 * vb + r) * 64 + 8 * hh;
    const float* dp = (const float*)(ws + WS_GDL) + item * 128 + 32 * kb + 4 * hh;
#pragma unroll
    for (int ks = 0; ks < 4; ++ks) { o.a[ks] = *(const GAS bf16x8*)(ap + 16 * ks); o.b[ks] = *(const GAS bf16x8*)(bp + 16 * ks); o.d[ks] = *(const GAS f32x4*)(dp + 8 * ks); }
}
__device__ __forceinline__ void phase_gla_g12(unsigned char* ws, LAS unsigned char* lds, int gwv, int wave, int lane) {
    if (gwv >= 2048) return;
    const int chain = gwv >> 5, blk = gwv & 31, kb = blk & 3, vb = blk >> 2, dir = chain & 1, bh = chain >> 1;
    const int r = lane & 31, hh = lane >> 5;
    LAS unsigned char* wl = lds + RING_OFF + wave * 2048;
    f32x16 acc;
#pragma unroll
    for (int g = 0; g < 16; ++g) acc[g] = 0.f;
    G12Ops cur, nxt;
    g12_load(cur, ws, bh, dir, 0, kb, vb, r, hh);
    for (int m = 0; m < 68; ++m) {
        const int n = dir ? (m < 4 ? 3 - m : 71 - m) : m;
        if (m + 1 < 68) g12_load(nxt, ws, bh, dir, m + 1, kb, vb, r, hh); else nxt = cur;
#pragma unroll
        for (int gg = 0; gg < 4; ++gg) *(LAS unsigned long long*)(wl + r * 64 + 16 * gg + 8 * hh) = (unsigned long long)pk2(acc[4 * gg], acc[4 * gg + 1]) | ((unsigned long long)pk2(acc[4 * gg + 2], acc[4 * gg + 3]) << 32);
        LDS_WAIT();
        const v4u s0 = *(const LAS v4u*)(wl + lane * 16), s1 = *(const LAS v4u*)(wl + 1024 + lane * 16);
        LDS_WAIT();
        { bf16* sp = (bf16*)(ws + WS_SX) + ((size_t)(bh * 2 + dir) * 68 + n) * 32768 + (size_t)(kb * 8 + vb) * 1024; ((GAS v4u*)sp)[lane] = s0; ((GAS v4u*)sp)[64 + lane] = s1; }
#pragma unroll
        for (int gg = 0; gg < 4; ++gg) { acc[4 * gg] *= cur.d[gg].x; acc[4 * gg + 1] *= cur.d[gg].y; acc[4 * gg + 2] *= cur.d[gg].z; acc[4 * gg + 3] *= cur.d[gg].w; }
#pragma unroll
        for (int ks = 0; ks < 4; ++ks) acc = __builtin_amdgcn_mfma_f32_32x32x16_bf16(cur.a[ks], cur.b[ks], acc, 0, 0, 0);
        cur = nxt;
    }
}
constexpr int G3_RS = 272, G3_TILE = 64 * G3_RS, G3_OL = 4 * G3_TILE  , G3_LD = 260;
static_assert(G3_OL + 64 * G3_LD * 4 <= MISC_OFF, "G3 LDS");
__device__ __forceinline__ void phase_gla_g3(unsigned char* ws, int lg, LAS unsigned char* lds, int tid) {
    const int lane = tid & 63, wave = __builtin_amdgcn_readfirstlane(tid >> 6), r = lane & 31, hh = lane >> 5, vb = wave;
    LAS unsigned char* TL = lds + RING_OFF; LAS float* OL = (LAS float*)(lds + RING_OFF + G3_OL);
    const bf16* G = (const bf16*)(ws + WS_G); bf16* OG = (bf16*)(ws + WS_Q);
    for (int cn = blockIdx.x; cn < 2176; cn += gridDim.x) {
        const int n = cn % 68, bh = cn / 68, h = bh & 3, b = bh >> 2;
        v4u st[4][2];
#pragma unroll
        for (int tl = 0; tl < 4; ++tl) { const bf16* src = (const bf16*)(ws + ((tl & 1) ? WS_GKH : WS_GQ)) + ((size_t)cn * 2 + (tl >> 1)) * 8192;
#pragma unroll
            for (int j = 0; j < 2; ++j) st[tl][j] = ((const GAS v4u*)src)[tid + 512 * j]; }
        __syncthreads();
#pragma unroll
        for (int tl = 0; tl < 4; ++tl)
#pragma unroll
            for (int j = 0; j < 2; ++j) { const int q = tid + 512 * j, row = q >> 4, ch = q & 15; *(LAS v4u*)(TL + tl * G3_TILE + row * G3_RS + ch * 16) = st[tl][j]; }
        __syncthreads();
        f32x16 P00, P01, P10, P11, O0, O1;
#pragma unroll
        for (int g = 0; g < 16; ++g) { P00[g] = 0.f; P01[g] = 0.f; P10[g] = 0.f; P11[g] = 0.f; O0[g] = 0.f; O1[g] = 0.f; }
#pragma unroll
        for (int dir = 0; dir < 2; ++dir) {
            const LAS unsigned char* Qt = TL + (2 * dir) * G3_TILE + r * G3_RS + 16 * hh; const LAS unsigned char* Kh = TL + (2 * dir + 1) * G3_TILE + r * G3_RS + 16 * hh;
            const bf16* Sx = (const bf16*)(ws + WS_SX) + ((size_t)(bh * 2 + dir) * 68 + n) * 32768 + (size_t)vb * 1024 + r * 32 + 8 * hh;
            f32x16 X00, X11, Xoff;
#pragma unroll
            for (int g = 0; g < 16; ++g) { X00[g] = 0.f; X11[g] = 0.f; Xoff[g] = 0.f; }
#pragma unroll
            for (int s = 0; s < 8; ++s) {
                const bf16x8 q0 = *(const LAS bf16x8*)(Qt + 32 * s), q1 = *(const LAS bf16x8*)(Qt + 32 * G3_RS + 32 * s);
                const bf16x8 k0 = *(const LAS bf16x8*)(Kh + 32 * s), k1 = *(const LAS bf16x8*)(Kh + 32 * G3_RS + 32 * s);
                const bf16x8 sx = *(const GAS bf16x8*)(Sx + (s >> 1) * 8192 + 16 * (s & 1));
                X00 = __builtin_amdgcn_mfma_f32_32x32x16_bf16(k0, q0, X00, 0, 0, 0);
                X11 = __builtin_amdgcn_mfma_f32_32x32x16_bf16(k1, q1, X11, 0, 0, 0);
                if (dir == 0) Xoff = __builtin_amdgcn_mfma_f32_32x32x16_bf16(k0, q1, Xoff, 0, 0, 0); else Xoff = __builtin_amdgcn_mfma_f32_32x32x16_bf16(k1, q0, Xoff, 0, 0, 0);
                O0 = __builtin_amdgcn_mfma_f32_32x32x16_bf16(q0, sx, O0, 0, 0, 0); O1 = __builtin_amdgcn_mfma_f32_32x32x16_bf16(q1, sx, O1, 0, 0, 0); }
#pragma unroll
            for (int g = 0; g < 16; ++g) { const int tj = (g & 3) + 8 * (g >> 2) + 4 * hh; const bool keep = dir ? (tj >= r) : (tj <= r);
                P00[g] += keep ? X00[g] : 0.f; P11[g] += keep ? X11[g] : 0.f;
                if (dir == 0) P01[g] += Xoff[g]; else P10[g] += Xoff[g]; }
        }
        { const bf16* Vt = (const bf16*)(ws + WS_GVT) + ((size_t)cn * 256 + 32 * vb + r) * 64 + 4 * hh;
#pragma unroll
          for (int jb = 0; jb < 2; ++jb)
#pragma unroll
            for (int s2 = 0; s2 < 2; ++s2) { const bf16* vp = Vt + 32 * jb + 16 * s2;
                const unsigned long long lo = *(const GAS unsigned long long*)vp, hi8 = *(const GAS unsigned long long*)(vp + 8);
                const bf16x8 bfv = __builtin_bit_cast(bf16x8, ((v4u){(unsigned)lo, (unsigned)(lo >> 32), (unsigned)hi8, (unsigned)(hi8 >> 32)}));
                const f32x16& Pa = jb ? P10 : P00; const f32x16& Pb = jb ? P11 : P01;
                const bf16x8 a0 = __builtin_bit_cast(bf16x8, ((v4u){pk2(Pa[8 * s2 + 0], Pa[8 * s2 + 1]), pk2(Pa[8 * s2 + 2], Pa[8 * s2 + 3]), pk2(Pa[8 * s2 + 4], Pa[8 * s2 + 5]), pk2(Pa[8 * s2 + 6], Pa[8 * s2 + 7])}));
                const bf16x8 a1 = __builtin_bit_cast(bf16x8, ((v4u){pk2(Pb[8 * s2 + 0], Pb[8 * s2 + 1]), pk2(Pb[8 * s2 + 2], Pb[8 * s2 + 3]), pk2(Pb[8 * s2 + 4], Pb[8 * s2 + 5]), pk2(Pb[8 * s2 + 6], Pb[8 * s2 + 7])}));
                O0 = __builtin_amdgcn_mfma_f32_32x32x16_bf16(a0, bfv, O0, 0, 0, 0); O1 = __builtin_amdgcn_mfma_f32_32x32x16_bf16(a1, bfv, O1, 0, 0, 0); } }
#pragma unroll
        for (int g = 0; g < 16; ++g) { const int t = (g & 3) + 8 * (g >> 2) + 4 * hh; OL[t * G3_LD + 32 * vb + r] = O0[g]; OL[(32 + t) * G3_LD + 32 * vb + r] = O1[g]; }
        __syncthreads();
        { const int t = tid >> 3, cc = tid & 7; const LAS f32x4* op = (const LAS f32x4*)(OL + t * G3_LD + 32 * cc);
          f32x4 o[8]; float ss = 0.f;
#pragma unroll
          for (int j = 0; j < 8; ++j) { o[j] = op[j]; ss += (o[j].x * o[j].x + o[j].y * o[j].y) + (o[j].z * o[j].z + o[j].w * o[j].w); }
          ss += __shfl_xor(ss, 1); ss += __shfl_xor(ss, 2); ss += __shfl_xor(ss, 4);
          const float rs = 1.0f / sqrtf(ss * (1.0f / 256.0f) + RMS_EPS);
          const size_t row = (size_t)b * TB + 64 * n + t;
          const GAS v4u* rp = (const GAS v4u*)(G + row * WINP + 2048 + h * 256 + 32 * cc); const GAS f32x4* gp = (const GAS f32x4*)(PARF(ws) + P_OG + lg * 256 + 32 * cc);
          GAS v4u* dst = (GAS v4u*)(OG + row * 1024 + h * 256 + 32 * cc);
#pragma unroll
          for (int j = 0; j < 4; ++j) { const v4u rv = rp[j]; const f32x4 g0 = gp[2 * j], g1 = gp[2 * j + 1]; const f32x4 a = o[2 * j] * rs * g0, c2 = o[2 * j + 1] * rs * g1;
              v4u w;
              w.x = pk2(a.x * silu_f(__uint_as_float(rv.x << 16)), a.y * silu_f(__uint_as_float(rv.x & 0xffff0000u)));
              w.y = pk2(a.z * silu_f(__uint_as_float(rv.y << 16)), a.w * silu_f(__uint_as_float(rv.y & 0xffff0000u)));
              w.z = pk2(c2.x * silu_f(__uint_as_float(rv.z << 16)), c2.y * silu_f(__uint_as_float(rv.z & 0xffff0000u)));
              w.w = pk2(c2.z * silu_f(__uint_as_float(rv.w << 16)), c2.w * silu_f(__uint_as_float(rv.w & 0xffff0000u)));
              dst[j] = w; } }
    }
}
__device__ __forceinline__ void phase_modulate2_route(unsigned char* ws, int layer, LAS unsigned char* lds, int gw, int NGW, int wave, int lane, int tid) {
    const float* X = (const float*)(ws + WS_X); bf16* XN = (bf16*)(ws + WS_XN);
    const float* ng = PARF(ws) + P_N2G + layer * 1024; const float* Mo = (const float*)(ws + WS_MOD) + (size_t)layer * MODROWS * NMODC;
    LAS float* wr = (LAS float*)(lds + RING_OFF);
    LAS unsigned* lcnt = (LAS unsigned*)(lds + AUX_LCNT); LAS unsigned* gb = (LAS unsigned*)(lds + AUX_GB); LAS unsigned* ent = (LAS unsigned*)(lds + AUX_ENT) + wave * (17 * 4 * 2);
    { const float* wsrc = PARF(ws) + P_WR + (size_t)layer * 1024 * 32;
      for (int idx = tid; idx < 1024 * 32; idx += NWAVES * 64) { const int k = idx >> 5, e = idx & 31; wr[e * WR_STRIDE + k] = wsrc[idx]; }
      if (tid < 32) lcnt[tid] = 0u; }
    __syncthreads();
    const float brt = (PARF(ws) + P_BR)[layer * 32 + (lane >> 1)];
    gu32* cnt = (gu32*)(ws + WS_CTL) + CW_CNT + layer * 32 * 16;
    int ri = 0;
    for (int m = gw; m < MT; m += NGW, ++ri) { const int mr = mod_row(m); f32x4 y[4];
        if (layer == NLAYER - 1 && mr == 8) { if (lane < 4) ent[(ri * 4 + lane) * 2 + 0] = 0xffffffffu; continue; }
        modulate_row(X + (size_t)m * 1024, ng, Mo + (size_t)mr * NMODC + 3 * 1024, Mo + (size_t)mr * NMODC + 4 * 1024, XN + (size_t)m * 1024, lane, y);
        float p[32];
#pragma unroll
        for (int e = 0; e < 32; ++e) { float a = 0.f;
#pragma unroll
            for (int j = 0; j < 4; ++j) { const f32x4 w = *(const LAS f32x4*)(wr + e * WR_STRIDE + 256 * j + 4 * lane); a += (y[j].x * w.x + y[j].y * w.y) + (y[j].z * w.z + y[j].w * w.w); }
            p[e] = a; }
#define RED_STEP(H, BIT) _Pragma("unroll") for (int e = 0; e < H; ++e) { const bool up = (lane & BIT) != 0; const float keep = up ? p[e + H] : p[e], send = up ? p[e] : p[e + H]; p[e] = keep + __shfl_xor(send, BIT); }
        RED_STEP(16, 32) RED_STEP(8, 16) RED_STEP(4, 8) RED_STEP(2, 4) RED_STEP(1, 2)
#undef RED_STEP
        float lg = p[0] + __shfl_xor(p[0], 1) + brt;
        const int myexp = lane >> 1;
        float tv[4]; int te[4];
#pragma unroll
        for (int k = 0; k < 4; ++k) { const float mx = wave_max(lg); const unsigned long long bm = __ballot(lg == mx); const int first = __ffsll((long long)bm) - 1; te[k] = first >> 1; tv[k] = mx; if (myexp == te[k]) lg = -INFINITY; }
        const float e1 = __expf(tv[1] - tv[0]), e2 = __expf(tv[2] - tv[0]), e3 = __expf(tv[3] - tv[0]); const float inv = 1.0f / (1.0f + e1 + e2 + e3);
        if (lane < 4) { const int e = (lane == 0) ? te[0] : (lane == 1) ? te[1] : (lane == 2) ? te[2] : te[3]; const float w = ((lane == 0) ? 1.0f : (lane == 1) ? e1 : (lane == 2) ? e2 : e3) * inv;
            const unsigned lp = atomicAdd((unsigned*)&lcnt[e], 1u);
            ent[(ri * 4 + lane) * 2 + 0] = ((unsigned)e << 24) | lp; ent[(ri * 4 + lane) * 2 + 1] = __float_as_uint(w); }
    }
    __syncthreads();
    if (tid < 32) gb[tid] = __hip_atomic_fetch_add(cnt + tid * 16, lcnt[tid], __ATOMIC_RELAXED, __HIP_MEMORY_SCOPE_AGENT);
    __syncthreads();
    ri = 0;
    for (int m = gw; m < MT; m += NGW, ++ri) {
        if (lane < 4 && ent[(ri * 4 + lane) * 2 + 0] != 0xffffffffu) { const unsigned pe = ent[(ri * 4 + lane) * 2 + 0]; const unsigned e = pe >> 24, lp = pe & 0xffffffu;
            ((unsigned*)(ws + WS_SLOT))[m * 4 + lane] = (e << 24) | (gb[e] + lp); ((unsigned*)(ws + WS_GATEW))[m * 4 + lane] = ent[(ri * 4 + lane) * 2 + 1]; }
    }
}
__device__ __forceinline__ void build_expert_tables(unsigned char* ws, int layer, LAS unsigned char* lds, int tid) {
    LAS int* t2e = (LAS int*)(lds + AUX_T2E); LAS int* base = (LAS int*)(lds + AUX_BASE); LAS int* ntp = (LAS int*)(lds + AUX_NT);
    gu32* cnt = (gu32*)(ws + WS_CTL) + CW_CNT + layer * 32 * 16;
    __syncthreads();
    if (tid < 64) { const unsigned cval = (tid < 32) ? __hip_atomic_load(cnt + tid * 16, RLX_AGENT) : 0u; const int tiles = (int)((cval + 255u) >> 8);
        int pre = tiles;
#pragma unroll
        for (int o = 1; o < 32; o <<= 1) { const int t = __shfl_up(pre, o); if ((tid & 63) >= o) pre += t; }
        const int start = pre - tiles;
        if (tid < 32) { base[tid] = start * 256; for (int t = 0; t < tiles; ++t) t2e[start + t] = tid; if (tid == 31) ntp[0] = pre; } }
    __syncthreads();
}
__device__ __forceinline__ void phase_moe_gather(unsigned char* ws, int layer, LAS unsigned char* lds, int gw, int NGW, int lane, int tid) {
    build_expert_tables(ws, layer, lds, tid);
    const LAS int* base = (const LAS int*)(lds + AUX_BASE);
    const bf16* XN = (const bf16*)(ws + WS_XN); bf16* XG = (bf16*)(ws + WS_XG);
    const unsigned* slot = (const unsigned*)(ws + WS_SLOT); unsigned* spos = (unsigned*)(ws + WS_SLOTPOS);
    for (int m = gw; m < MT; m += NGW) {
        if (layer == NLAYER - 1 && mod_row(m) == 8) continue;
        const GAS v4u* src = (const GAS v4u*)(XN + (size_t)m * 1024) + lane; const v4u a = src[0], b = src[64];
#pragma unroll
        for (int k = 0; k < 4; ++k) { const unsigned pe = slot[m * 4 + k]; const int dst = base[pe >> 24] + (int)(pe & 0xffffffu);
            GAS v4u* dp = (GAS v4u*)(XG + (size_t)dst * 1024) + lane; dp[0] = a; dp[64] = b;
            if (lane == 0) spos[m * 4 + k] = (unsigned)dst; }
    }
}
__device__ __forceinline__ void phase_moe_combine(unsigned char* ws, float* out, int layer, int gw, int NGW, int lane) {
    float* X = (float*)(ws + WS_X); const bf16* Y = (const bf16*)(ws + WS_Y);
    const float* Mo = (const float*)(ws + WS_MOD) + (size_t)layer * MODROWS * NMODC;
    const unsigned* spos = (const unsigned*)(ws + WS_SLOTPOS); const float* gw4 = (const float*)(ws + WS_GATEW);
    for (int m = gw; m < MT; m += NGW) { const int b = m / TB, w = m - b * TB; const int mr = (w < CTXL) ? 8 : b;
        if (layer == NLAYER - 1 && w < CTXL) continue;
        f32x4 f[4];
#pragma unroll
        for (int j = 0; j < 4; ++j) f[j] = (f32x4){0.f, 0.f, 0.f, 0.f};
#pragma unroll
        for (int k = 0; k < 4; ++k) { const unsigned sp = spos[m * 4 + k]; const float wk = gw4[m * 4 + k];
            const GAS unsigned long long* yp = (const GAS unsigned long long*)(Y + (size_t)sp * 1024) + lane;
#pragma unroll
            for (int j = 0; j < 4; ++j) { const unsigned long long v = yp[64 * j];
                f[j].x += wk * __uint_as_float((unsigned)(v & 0xffffu) << 16); f[j].y += wk * __uint_as_float((unsigned)(v >> 16) << 16);
                f[j].z += wk * __uint_as_float((unsigned)((v >> 32) & 0xffffu) << 16); f[j].w += wk * __uint_as_float((unsigned)(v >> 48) << 16); } }
        GAS f32x4* xp = (GAS f32x4*)(X + (size_t)m * 1024) + lane; const GAS f32x4* gp = (const GAS f32x4*)(Mo + (size_t)mr * NMODC + 5 * 1024) + lane;
        GAS f32x4* op = (layer == NLAYER - 1) ? (GAS f32x4*)(out + ((size_t)b * SEQ + (w - CTXL)) * 1024) + lane : xp;
#pragma unroll
        for (int j = 0; j < 4; ++j) op[64 * j] = xp[64 * j] + gp[64 * j] * f[j];
    }
}

constexpr int NPH_L = 11, NPHASE = 2 + NPH_L * NLAYER;
#ifndef PHMASK
#define PHMASK 0x7fff
#endif
#define EN(b) ((PHMASK >> (b)) & 1)
#ifndef DUPMASK
#define DUPMASK 0
#endif
#define DUP(b) for (int rep_ = 0; rep_ < (((DUPMASK >> (b)) & 1) ? 2 : 1); ++rep_)
__global__ void __launch_bounds__(NWAVES * 64, 2) dit_fwd(Args args) {
    extern __shared__ __attribute__((aligned(16))) unsigned char lds_raw[];
    LAS unsigned char* lds = (LAS unsigned char*)lds_raw;
    volatile LAS unsigned* MISC = (volatile LAS unsigned*)(lds + MISC_OFF);
    const int G = gridDim.x, bx = blockIdx.x;
    const int vcu = (G % 8 == 0) ? (bx % 8) * (G / 8) + bx / 8 : bx;
    { const int t0 = threadIdx.x; for (int u = t0; u < (LDS_BYTES - MISC_OFF) / 4; u += NWAVES * 64) ((LAS unsigned*)(lds + MISC_OFF))[u] = 0u; }
    __syncthreads();
    const int lo = args.ph_lo, hi = args.ph_hi;
    XcdBarrier bar; bar.bar = (unsigned*)(args.ws + WS_CTL) + CW_BAR; bar.x = 0; bar.st = nullptr;
    if (hi - lo > 1) bar = xcd_barrier_post((unsigned*)(args.ws + WS_CTL) + CW_BAR, MISC + 8);
#define IN(k) (lo <= (k) && (k) < hi)
#define SEAM(k) do { if (IN(k) && IN((k) + 1)) xcd_barrier(bar); } while (0)
#define PHASE_IDS() int tid = threadIdx.x; LAUNDER_V(tid); const int lane = tid & 63, wave = __builtin_amdgcn_readfirstlane(tid >> 6); const int gw = vcu * NWAVES + wave, NGW = G * NWAVES; \
    unsigned zoff_ = 0u; LAUNDER_S(zoff_); unsigned char* ws = args.ws + zoff_; (void)lane; (void)gw; (void)NGW;

    if (EN(0) && IN(0)) DUP(0) { PHASE_IDS(); p0_prologue(args, lds, gw, NGW, wave, lane); } SEAM(0);
    if (EN(1) && IN(1)) { PHASE_IDS(); p1_mod_reduce(args, gw * 64 + lane, NGW * 64); } SEAM(1);

    for (int layer = 0; layer < NLAYER; ++layer) {
        const int pb = 2 + NPH_L * layer, lh = layer >> 1;
        if (EN(2) && IN(pb + 0)) DUP(2) { PHASE_IDS(); phase_modulate1(ws, layer, gw, NGW, lane); } SEAM(pb + 0);
        if ((layer & 1) == 0) {
            if (EN(3) && IN(pb + 1)) DUP(3) {
                PHASE_IDS();
                pg8::Gemm g{(const pg8::bf16_t*)(ws + WS_XN), (const pg8::bf16_t*)(ws + WS_WQKV) + (size_t)lh * QKVN * 1024, MT, QKVN, 1024, 0};
                pg8::StaticOrder S; S.init(MT, QKVN, G, bx);
                pg8::EpiQKV E{ws, WS_Q, WS_K - WS_Q, WS_V - WS_K};
                pg8::gemm_phase<pg8::EpiQKV, pg8::StaticOrder, true, true>(lds + RING_OFF, g, S, E);
            } SEAM(pb + 1);
            if (EN(4) && IN(pb + 2)) { PHASE_IDS(); phase_qknorm_rope(ws, lh, gw, NGW, lane); } SEAM(pb + 2);
            if (EN(5) && IN(pb + 3)) {
                PHASE_IDS();
                const attn_body::bf16* Qp = (const attn_body::bf16*)(ws + WS_Q); const attn_body::bf16* Kp = (const attn_body::bf16*)(ws + WS_K); const attn_body::bf16* Vp = (const attn_body::bf16*)(ws + WS_V);
                attn_body::bf16* Op = (attn_body::bf16*)(ws + WS_Q);
                if (G == 256) {
                    for (int i = 0; i < 9; ++i) {
                        long qrow0, kvrow0; int NT, h;
                        if (i < 8) { const int x = vcu >> 5, j = vcu & 31, pair = 4 * x + (i >> 1), wi = (i & 1) * 32 + j, hq = wi >> 4, qb = wi & 15, b = pair >> 2, hk = pair & 3;
                            h = hk * 4 + hq; qrow0 = (long)b * TB + CTXL + qb * 256; kvrow0 = (long)b * TB; NT = TB / 64; }
                        else { if (vcu >= 128) break; const int b = vcu >> 4; h = vcu & 15; qrow0 = (long)b * TB; kvrow0 = qrow0; NT = CTXL / 64; }
                        attn_body::attn_unit<8>(qrow0, kvrow0, NT, h, Qp, Kp, Vp, Op, (char*)lds_raw + RING_OFF);
                    }
                } else {
                    for (int U = bx; U < 2048 + 128; U += G) {
                        long qrow0, kvrow0; int NT, h;
                        if (U < 2048) { const int pair = U >> 6, wi = U & 63, hq = wi >> 4, qb = wi & 15, b = pair >> 2, hk = pair & 3; h = hk * 4 + hq; qrow0 = (long)b * TB + CTXL + qb * 256; kvrow0 = (long)b * TB; NT = TB / 64; }
                        else { const int v = U - 2048, b = v >> 4; h = v & 15; qrow0 = (long)b * TB; kvrow0 = qrow0; NT = CTXL / 64; }
                        attn_body::attn_unit<8>(qrow0, kvrow0, NT, h, Qp, Kp, Vp, Op, (char*)lds_raw + RING_OFF);
                    }
                }
            } SEAM(pb + 3);
        } else {
            if (EN(6) && IN(pb + 1)) DUP(6) {
                PHASE_IDS();
                pg8::Gemm g{(const pg8::bf16_t*)(ws + WS_XN), (const pg8::bf16_t*)(ws + WS_WIN) + (size_t)lh * WINP * 1024, MT, WINP, 1024, 0};
                pg8::StaticOrder S; S.init(MT, WINP, G, bx);
                pg8::EpiBf16 E{(pg8::bf16_t*)(ws + WS_G), WINP};
                pg8::gemm_phase<pg8::EpiBf16, pg8::StaticOrder, true, true>(lds + RING_OFF, g, S, E);
            } SEAM(pb + 1);
            if (EN(7) && IN(pb + 2)) DUP(7) { PHASE_IDS(); phase_gla_g0(ws, lh, lds, tid); } SEAM(pb + 2);
            if (EN(8) && IN(pb + 3)) DUP(8) { PHASE_IDS(); phase_gla_g12(ws, lds, gw, wave, lane); } SEAM(pb + 3);
            if (EN(8) && IN(pb + 4)) DUP(9) { PHASE_IDS(); phase_gla_g3(ws, lh, lds, tid); } SEAM(pb + 4);
        }
        if (EN(9) && IN(pb + 5)) {
            PHASE_IDS();
            const pg8::bf16_t* Wt = (layer & 1) ? (const pg8::bf16_t*)(ws + WS_WOG) + (size_t)lh * 1024 * 1024 : (const pg8::bf16_t*)(ws + WS_WOA) + (size_t)lh * 1024 * 1024;
            pg8::Gemm g{(const pg8::bf16_t*)(ws + WS_Q), Wt, MT, 1024, 1024, 0};
            pg8::StaticOrder S; S.init(MT, 1024, G, bx);
            pg8::EpiResGate E{(float*)(ws + WS_X), (const float*)(ws + WS_MOD) + (size_t)layer * MODROWS * NMODC + 2 * 1024};
            pg8::gemm_phase<pg8::EpiResGate, pg8::StaticOrder, true, true>(lds + RING_OFF, g, S, E);
        } SEAM(pb + 5);
        if (EN(10) && IN(pb + 6)) { PHASE_IDS(); phase_modulate2_route(ws, layer, lds, gw, NGW, wave, lane, tid); } SEAM(pb + 6);
        if (EN(11) && IN(pb + 7)) DUP(11) { PHASE_IDS(); phase_moe_gather(ws, layer, lds, gw, NGW, lane, tid); } SEAM(pb + 7);
        if (EN(12) && IN(pb + 8)) DUP(12) {
            PHASE_IDS();
            build_expert_tables(ws, layer, lds, tid);
            const int nT = __builtin_amdgcn_readfirstlane(((const LAS int*)(lds + AUX_NT))[0]);
            pg8::Gemm g{(const pg8::bf16_t*)(ws + WS_XG), (const pg8::bf16_t*)(ws + WS_WGU) + (size_t)layer * 32 * 2048 * 1024, MPAD, 2048, 1024, (size_t)2048 * 1024 * 2};
            pg8::MoeOrder S{nT, 8, G, bx, (const LAS int*)(lds + AUX_T2E)};
            pg8::EpiSwiGLU E{(pg8::bf16_t*)(ws + WS_ACT), PARF(ws) + P_BGU + (size_t)layer * 32 * 2048};
            pg8::gemm_phase<pg8::EpiSwiGLU, pg8::MoeOrder, true, true>(lds + RING_OFF, g, S, E);
        } SEAM(pb + 8);
        if (EN(13) && IN(pb + 9)) DUP(13) {
            PHASE_IDS();
            build_expert_tables(ws, layer, lds, tid);
            const int nT = __builtin_amdgcn_readfirstlane(((const LAS int*)(lds + AUX_NT))[0]);
            pg8::Gemm g{(const pg8::bf16_t*)(ws + WS_ACT), (const pg8::bf16_t*)(ws + WS_WDN) + (size_t)layer * 32 * 1024 * 1024, MPAD, 1024, 1024, (size_t)1024 * 1024 * 2};
            pg8::MoeOrder S{nT, 4, G, bx, (const LAS int*)(lds + AUX_T2E)};
            pg8::EpiBiasBf16 E{(pg8::bf16_t*)(ws + WS_Y), PARF(ws) + P_BDN + (size_t)layer * 32 * 1024};
            pg8::gemm_phase<pg8::EpiBiasBf16, pg8::MoeOrder, true, true>(lds + RING_OFF, g, S, E);
        } SEAM(pb + 9);
        if (EN(14) && IN(pb + 10)) { PHASE_IDS(); phase_moe_combine(ws, args.out, layer, gw, NGW, lane); } SEAM(pb + 10);
    }
#undef IN
#undef EN
#undef DUP
#undef SEAM
#undef PHASE_IDS
}

extern "C" void kernel_launch(void* const* d_in, const int* in_sizes, int n_in, void* d_out, int out_size, void* d_ws, size_t ws_size, hipStream_t stream) {
    static int grid = 0;
    if (grid == 0) {
        if (n_in != 25 || out_size != NB * SEQ * DMODEL || ws_size < WS_END) { fprintf(stderr, "kernel_launch: unexpected shapes: n_in %d out %d ws %zu (need >= %zu)\n", n_in, out_size, ws_size, (size_t)WS_END); grid = -1; return; }
        int dev = 0, cus = 0, per_cu = 0;
        if (hipGetDevice(&dev) != hipSuccess || hipDeviceGetAttribute(&cus, hipDeviceAttributeMultiprocessorCount, dev) != hipSuccess) { grid = -1; return; }
        if (hipFuncSetAttribute((const void*)dit_fwd, hipFuncAttributeMaxDynamicSharedMemorySize, LDS_BYTES) != hipSuccess) { fprintf(stderr, "kernel_launch: hipFuncSetAttribute failed\n"); grid = -1; return; }
        if (hipOccupancyMaxActiveBlocksPerMultiprocessor(&per_cu, (const void*)dit_fwd, NWAVES * 64, LDS_BYTES) != hipSuccess || per_cu < 1) fprintf(stderr, "kernel_launch: occupancy query reports %d\n", per_cu);
        (void)hipGetLastError();
        grid = cus;
    }
    if (grid < 0) return;
    if (hipMemsetAsync((char*)d_ws + WS_CTL, 0, CTL_ZERO_BYTES, stream) != hipSuccess) { fprintf(stderr, "kernel_launch: memset failed\n"); return; }
    Args a{};
    for (int i = 0; i < 25; ++i) a.in[i] = (const float*)d_in[i];
    a.out = (float*)d_out; a.ws = (unsigned char*)d_ws;
#if MK_ONE_LAUNCH
    a.ph_lo = 0; a.ph_hi = NPHASE;
    hipLaunchKernelGGL(dit_fwd, dim3(grid), dim3(NWAVES * 64), LDS_BYTES, stream, a);
#else
    for (int p = 0; p < NPHASE; ++p) { a.ph_lo = p; a.ph_hi = p + 1; hipLaunchKernelGGL(dit_fwd, dim3(grid), dim3(NWAVES * 64), LDS_BYTES, stream, a); }
#endif
    const hipError_t le = hipPeekAtLastError();
    if (le != hipSuccess) fprintf(stderr, "kernel_launch: launch failed: %s\n", hipGetErrorName(le));
}
```

```cpp
#include <hip/hip_runtime.h>
#include <hip/hip_bf16.h>
#include <cstdio>
#include <cstdint>
#include <cmath>

#ifndef MK_ONE_LAUNCH
#define MK_ONE_LAUNCH 1
#endif

namespace pg8 {
#define PG8_LAS __attribute__((address_space(3)))
typedef unsigned short bf16_t;
typedef short bf16x8 __attribute__((ext_vector_type(8)));
typedef float f32x4 __attribute__((ext_vector_type(4)));
typedef unsigned u32x4 __attribute__((ext_vector_type(4)));
constexpr int BM = 256, BK = 64, HALF = 128, HTB = HALF * BK * 2  , STAGE_BYTES = 8 * HTB, NXCD = 8, WGM = 8;

__host__ __device__ __forceinline__ int lds_byte(int r, int c) { const int st = (r >> 4) * 2 + (c >> 5), rr = r & 15, cc = c & 31, ob = rr * 64 + cc * 2; return st * 1024 + (ob ^ (((ob >> 9) & 1) << 5)); }
__host__ __device__ __forceinline__ void stage_rc(int b, int& R, int& C) { const int st = b / 1024, sb = b % 1024, swz = sb ^ (((sb >> 9) & 1) << 5); R = (st >> 1) * 16 + swz / 64; C = (st & 1) * 32 + (swz % 64) / 2; }
__host__ __device__ __forceinline__ int perm32(int rho) { const int n = rho >> 4, i = rho & 15; return 8 * (i >> 2) + 4 * n + (i & 3); }

struct Unit { int pm, pn, e; };
struct Gemm { const bf16_t* A; const bf16_t* Bt; int M, N, K; size_t bstride; const PG8_LAS unsigned short* rowtab; };

struct StaticOrder {
    int nM, nN, nwg, G, c;
    __host__ __device__ __forceinline__ void init(int M, int N, int G_, int c_) { nM = M / BM; nN = N / BM; nwg = nM * nN; G = G_; c = c_; }
    __host__ __device__ __forceinline__ bool next(int i, Unit& u) const {
        const long L = (long)i * G + c; if (L >= nwg) return false;
        int wgid = (int)L; { const int q = nwg / NXCD, r = nwg % NXCD, xcd = wgid % NXCD, off = wgid / NXCD; wgid = (xcd < r ? xcd * (q + 1) : r * (q + 1) + (xcd - r) * q) + off; }
        const int nig = WGM * nN, gid = wgid / nig, fm = gid * WGM, gsz = (nM - fm) < WGM ? (nM - fm) : WGM;
        u.pm = fm + ((wgid % nig) % gsz); u.pn = (wgid % nig) / gsz; u.e = 0; return true;
    }
    __device__ __forceinline__ void a_ready(const Unit&) const {}
    __device__ __forceinline__ void done(const Unit&) const {}
};
struct MoeOrder {
    int nT, nN, G, c; const PG8_LAS int* t2e;
    __device__ __forceinline__ bool next(int i, Unit& u) const {
        const int x = c & 7, j = c >> 3, per = 32 / nN, mt = (i * (G >> 5) + x) * per + j / nN; if (mt >= nT) return false;
        u.pm = mt; u.pn = j % nN; u.e = __builtin_amdgcn_readfirstlane(t2e[mt]); return true;
    }
    __device__ __forceinline__ void a_ready(const Unit&) const {}
    __device__ __forceinline__ void done(const Unit&) const {}
};

__device__ __forceinline__ unsigned cvt_pk_bf16(float lo, float hi) { unsigned r; asm volatile("v_cvt_pk_bf16_f32 %0, %1, %2" : "=v"(r) : "v"(lo), "v"(hi)); return r; }

struct EpiBf16 {
    static constexpr bool PERM = true, AFTER_DRAIN = false;
    bf16_t* O; int ldc;
    __device__ __forceinline__ void operator()(const f32x4 (&acc)[2][2][4][2], const Unit& u, int wr, int wc, int fr, int fq) const {
        const int row0 = u.pm * BM + wr * 64 + fr; const int col0 = u.pn * BM + wc * 32 + 8 * fq;
#pragma unroll
        for (int ai = 0; ai < 2; ++ai)
#pragma unroll
            for (int m = 0; m < 4; ++m) { bf16_t* rowp = O + (size_t)(row0 + ai * HALF + m * 16) * ldc + col0;
#pragma unroll
                for (int bj = 0; bj < 2; ++bj) { const f32x4 v0 = acc[ai][bj][m][0], v1 = acc[ai][bj][m][1];
                    u32x4 w; w.x = cvt_pk_bf16(v0[0], v0[1]); w.y = cvt_pk_bf16(v0[2], v0[3]); w.z = cvt_pk_bf16(v1[0], v1[1]); w.w = cvt_pk_bf16(v1[2], v1[3]);
                    *(u32x4*)(rowp + bj * HALF) = w; } }
    }
};
struct EpiQKV {
    static constexpr bool PERM = true, AFTER_DRAIN = false;
    unsigned char* wsb; size_t offQ, dK, dV;
    __device__ __forceinline__ void operator()(const f32x4 (&acc)[2][2][4][2], const Unit& u, int wr, int wc, int fr, int fq) const {
        const int row0 = u.pm * BM + wr * 64 + fr;
        const int isk = (u.pn >= 4) ? 1 : 0, isv = (u.pn >= 5) ? 1 : 0;
        bf16_t* base = (bf16_t*)(wsb + offQ + (size_t)isk * dK + (size_t)isv * dV); const int ldc = isk ? 256 : 1024, colt = isk ? 0 : u.pn * BM;
        const int col0 = colt + wc * 32 + 8 * fq;
#pragma unroll
        for (int ai = 0; ai < 2; ++ai)
#pragma unroll
            for (int m = 0; m < 4; ++m) { bf16_t* rowp = base + (size_t)(row0 + ai * HALF + m * 16) * ldc + col0;
#pragma unroll
                for (int bj = 0; bj < 2; ++bj) { const f32x4 v0 = acc[ai][bj][m][0], v1 = acc[ai][bj][m][1];
                    u32x4 w; w.x = cvt_pk_bf16(v0[0], v0[1]); w.y = cvt_pk_bf16(v0[2], v0[3]); w.z = cvt_pk_bf16(v1[0], v1[1]); w.w = cvt_pk_bf16(v1[2], v1[3]);
                    *(u32x4*)(rowp + bj * HALF) = w; } }
    }
};
struct EpiResGate {
    static constexpr bool PERM = false, AFTER_DRAIN = false;
    float* X; const float* gate;
    __device__ __forceinline__ void operator()(const f32x4 (&acc)[2][2][4][2], const Unit& u, int wr, int wc, int fr, int fq) const {
        const int row0 = u.pm * BM + wr * 64 + fr; const int col0 = u.pn * BM + wc * 32 + 4 * fq;
        const int bb = u.pm / 17, mr = (u.pm - bb * 17 == 0) ? 8 : bb;
        const float* gp = gate + (size_t)mr * 6144 + col0;
        f32x4 gv[2][2];
#pragma unroll
        for (int bj = 0; bj < 2; ++bj)
#pragma unroll
            for (int n = 0; n < 2; ++n) gv[bj][n] = *(const f32x4*)(gp + bj * HALF + n * 16);
#pragma unroll
        for (int ai = 0; ai < 2; ++ai)
#pragma unroll
            for (int m = 0; m < 4; ++m) { float* rowp = X + (size_t)(row0 + ai * HALF + m * 16) * 1024 + col0;
#pragma unroll
                for (int bj = 0; bj < 2; ++bj)
#pragma unroll
                    for (int n = 0; n < 2; ++n) { f32x4* p = (f32x4*)(rowp + bj * HALF + n * 16); f32x4 x = *p; x = x + gv[bj][n] * acc[ai][bj][m][n]; *p = x; } }
    }
};
struct EpiSwiGLU {
    static constexpr bool PERM = true, AFTER_DRAIN = false;
    bf16_t* O; const float* bias;
    __device__ __forceinline__ void operator()(const f32x4 (&acc)[2][2][4][2], const Unit& u, int wr, int wc, int fr, int fq) const {
        const int row0 = u.pm * BM + wr * 64 + fr; const int col0 = u.pn * HALF + wc * 32 + 8 * fq;
        const float* bp = bias + (size_t)u.e * 2048 + col0;
        f32x4 bg[2], bu[2];
#pragma unroll
        for (int n = 0; n < 2; ++n) { bg[n] = *(const f32x4*)(bp + 4 * n); bu[n] = *(const f32x4*)(bp + 1024 + 4 * n); }
#pragma unroll
        for (int ai = 0; ai < 2; ++ai)
#pragma unroll
            for (int m = 0; m < 4; ++m) { bf16_t* rowp = O + (size_t)(row0 + ai * HALF + m * 16) * 1024 + col0;
                float r[8];
#pragma unroll
                for (int n = 0; n < 2; ++n) { const f32x4 gt = acc[ai][0][m][n] + bg[n], up = acc[ai][1][m][n] + bu[n];
#pragma unroll
                    for (int i = 0; i < 4; ++i) { const float g = fminf(gt[i], 7.0f), uu = fminf(fmaxf(up[i], -7.0f), 7.0f);
                        const float sg = __builtin_amdgcn_rcpf(1.0f + __builtin_amdgcn_exp2f(-1.702f * 1.4426950408889634f * g));
                        r[4 * n + i] = (uu + 1.0f) * (g * sg); } }
                u32x4 w; w.x = cvt_pk_bf16(r[0], r[1]); w.y = cvt_pk_bf16(r[2], r[3]); w.z = cvt_pk_bf16(r[4], r[5]); w.w = cvt_pk_bf16(r[6], r[7]);
                *(u32x4*)rowp = w; }
    }
};
struct EpiBiasBf16 {
    static constexpr bool PERM = true, AFTER_DRAIN = false;
    bf16_t* O; const float* bias;
    __device__ __forceinline__ void operator()(const f32x4 (&acc)[2][2][4][2], const Unit& u, int wr, int wc, int fr, int fq) const {
        const int row0 = u.pm * BM + wr * 64 + fr; const int col0 = u.pn * BM + wc * 32 + 8 * fq;
        const float* bp = bias + (size_t)u.e * 1024 + col0;
        f32x4 bv[2][2];
#pragma unroll
        for (int bj = 0; bj < 2; ++bj)
#pragma unroll
            for (int n = 0; n < 2; ++n) bv[bj][n] = *(const f32x4*)(bp + bj * HALF + 4 * n);
#pragma unroll
        for (int ai = 0; ai < 2; ++ai)
#pragma unroll
            for (int m = 0; m < 4; ++m) { bf16_t* rowp = O + (size_t)(row0 + ai * HALF + m * 16) * 1024 + col0;
#pragma unroll
                for (int bj = 0; bj < 2; ++bj) { const f32x4 v0 = acc[ai][bj][m][0] + bv[bj][0], v1 = acc[ai][bj][m][1] + bv[bj][1];
                    u32x4 w; w.x = cvt_pk_bf16(v0[0], v0[1]); w.y = cvt_pk_bf16(v0[2], v0[3]); w.z = cvt_pk_bf16(v1[0], v1[1]); w.w = cvt_pk_bf16(v1[2], v1[3]);
                    *(u32x4*)(rowp + bj * HALF) = w; } }
    }
};

template <class Epi, class Sched, bool ALIGN_EPI = false, bool SP2 = false, bool GATHER = false>
__device__ __forceinline__ void gemm_phase(PG8_LAS unsigned char* lds, const Gemm g, const Sched& S, const Epi& E) {
    int tid_l = threadIdx.x; asm volatile("" : "+v"(tid_l));
    const int tid = tid_l, wid = __builtin_amdgcn_readfirstlane(tid >> 6), lane = tid & 63, wr = wid >> 2, wc = wid & 3, fr = lane & 15, fq = lane >> 4;
    const int K = g.K, nt = K / BK;
    unsigned voffA[2], voffB[2];
#pragma unroll
    for (int i = 0; i < 2; ++i) { int R, C; stage_rc(tid * 16 + i * 8192, R, C); const int Rb = Epi::PERM ? ((R & ~31) + perm32(R & 31)) : R;
        voffA[i] = (unsigned)(R * K + C) * 2u; voffB[i] = (unsigned)(Rb * K + C) * 2u; }
    const size_t kstep = (size_t)(BK * 2);
    static_assert(!GATHER || SP2, "GATHER is wired into the SP2 loop only");
    unsigned vAc0[2], vAc1[2], vAn0[2], vAn1[2]; int gR[2]; unsigned gC[2];
#pragma unroll
    for (int i = 0; i < 2; ++i) { int R, C; stage_rc(tid * 16 + i * 8192, R, C); gR[i] = R; gC[i] = (unsigned)C * 2u; vAc0[i] = voffA[i]; vAc1[i] = voffA[i]; vAn0[i] = voffA[i]; vAn1[i] = voffA[i]; }
#define PG8_GFETCH(d0, d1, ord) do { if constexpr (GATHER) { _Pragma("unroll") for (int _i = 0; _i < 2; ++_i) { \
        d0[_i] = (unsigned)g.rowtab[(ord) * 256 + gR[_i]] * (unsigned)(K * 2) + gC[_i]; d1[_i] = (unsigned)g.rowtab[(ord) * 256 + 128 + gR[_i]] * (unsigned)(K * 2) + gC[_i]; } } } while (0)
    const size_t hstep = (size_t)HALF * K * 2;
    const size_t hstepA = GATHER ? 0 : hstep;
    const size_t tstep = 2 * hstep;
    const unsigned ldsw = (unsigned)wid * 1024u;
    const int aoff = lds_byte(wr * 64 + fr, fq * 8), boff = lds_byte(wc * 32 + fr, fq * 8);
#define PG8_SA(b, h) (((b) * 2 + (h)) * HTB)
#define PG8_SB(b, h) ((4 + (b) * 2 + (h)) * HTB)
#define PG8_STAGE(bufoff, gbase, voff) do { _Pragma("unroll") for (int _i = 0; _i < 2; ++_i) \
        __builtin_amdgcn_global_load_lds((const unsigned*)((const char*)(gbase) + (voff)[_i]), (PG8_LAS unsigned*)(lds + (bufoff) + ldsw + _i * 8192), 16, 0, 0); } while (0)
#define PG8_LDA(dst, b, h) do { _Pragma("unroll") for (int m = 0; m < 4; ++m) _Pragma("unroll") for (int k = 0; k < 2; ++k) dst[m][k] = *(const PG8_LAS bf16x8*)(lds + PG8_SA(b, h) + aoff + m * 2048 + k * 1024); } while (0)
#define PG8_LDB(dst, b, h) do { _Pragma("unroll") for (int n = 0; n < 2; ++n) _Pragma("unroll") for (int k = 0; k < 2; ++k) dst[n][k] = *(const PG8_LAS bf16x8*)(lds + PG8_SB(b, h) + boff + n * 2048 + k * 1024); } while (0)
#define PG8_MMA(ai, bj, At, Bt) do { __builtin_amdgcn_s_setprio(1); _Pragma("unroll") for (int m = 0; m < 4; ++m) _Pragma("unroll") for (int n = 0; n < 2; ++n) _Pragma("unroll") for (int k = 0; k < 2; ++k) \
        acc[ai][bj][m][n] = __builtin_amdgcn_mfma_f32_16x16x32_bf16(Bt[n][k], At[m][k], acc[ai][bj][m][n], 0, 0, 0); __builtin_amdgcn_s_setprio(0); } while (0)
#define PG8_WAIT_V(n) asm volatile("s_waitcnt vmcnt(" #n ")" ::: "memory")
#define PG8_WAIT_L(n) asm volatile("s_waitcnt lgkmcnt(" #n ")" ::: "memory")
#define PG8_BAR __builtin_amdgcn_s_barrier()
#define PG8_SCHED __builtin_amdgcn_sched_barrier(0)
    Unit cur, nxt; int ui = 0;
    if (!S.next(0, cur)) return;
    f32x4 acc[2][2][4][2];
#pragma unroll
    for (int a = 0; a < 2; ++a)
#pragma unroll
        for (int b = 0; b < 2; ++b)
#pragma unroll
            for (int m = 0; m < 4; ++m)
#pragma unroll
                for (int n = 0; n < 2; ++n) acc[a][b][m][n] = (f32x4){0.f, 0.f, 0.f, 0.f};
    bf16x8 At[4][2], B0[2][2], B1[2][2];
    const char* cA = (const char*)g.A + (GATHER ? (size_t)0 : (size_t)cur.pm * tstep); PG8_GFETCH(vAc0, vAc1, 0); const char* cB = (const char*)g.Bt + (size_t)cur.e * g.bstride + (size_t)cur.pn * tstep;
    S.a_ready(cur);
    if constexpr (SP2) {
        PG8_STAGE(PG8_SB(0, 0), cB, voffB); PG8_STAGE(PG8_SB(0, 1), cB + hstep, voffB); PG8_STAGE(PG8_SA(0, 0), cA, vAc0); PG8_STAGE(PG8_SA(0, 1), cA + hstepA, vAc1);
        if (wr == 1) PG8_BAR;
        PG8_WAIT_V(2); PG8_BAR;
        PG8_STAGE(PG8_SB(1, 0), cB + kstep, voffB); PG8_STAGE(PG8_SA(1, 0), cA + kstep, vAc0); PG8_STAGE(PG8_SB(1, 1), cB + hstep + kstep, voffB);
        PG8_WAIT_V(6); PG8_BAR;
    } else {
        PG8_STAGE(PG8_SB(0, 0), cB, voffB); PG8_STAGE(PG8_SA(0, 0), cA, voffA); PG8_STAGE(PG8_SB(0, 1), cB + hstep, voffB); PG8_STAGE(PG8_SA(0, 1), cA + hstep, voffA);
        if (wr == 1) PG8_BAR;
        PG8_WAIT_V(4); PG8_BAR;
        PG8_STAGE(PG8_SB(1, 0), cB + kstep, voffB); PG8_STAGE(PG8_SA(1, 0), cA + kstep, voffA); PG8_STAGE(PG8_SB(1, 1), cB + hstep + kstep, voffB);
        PG8_WAIT_V(6); PG8_BAR;
    }
    for (;;) {
        const bool has_next = S.next(ui + 1, nxt);
        const char* nA = (has_next && !GATHER) ? (const char*)g.A + (size_t)nxt.pm * tstep : cA;
        if constexpr (GATHER) { if (has_next) PG8_GFETCH(vAn0, vAn1, ui + 1); else { vAn0[0] = vAc0[0]; vAn0[1] = vAc0[1]; vAn1[0] = vAc1[0]; vAn1[1] = vAc1[1]; } }
        const char* nB = has_next ? (const char*)g.Bt + (size_t)nxt.e * g.bstride + (size_t)nxt.pn * tstep : cB;
        for (int t = 0; t < nt; t += 2) {
            const bool last = (t == nt - 2);
            const char* a1 = cA + (size_t)(t + 1) * kstep;
            const char* a2 = last ? nA : cA + (size_t)(t + 2) * kstep; const char* b2 = last ? nB : cB + (size_t)(t + 2) * kstep;
            const char* a3 = a2 + kstep; const char* b3 = b2 + kstep;
            if (last && has_next) S.a_ready(nxt);
            unsigned vS0[2], vS1[2];
            vS0[0] = last ? vAn0[0] : vAc0[0]; vS0[1] = last ? vAn0[1] : vAc0[1]; vS1[0] = last ? vAn1[0] : vAc1[0]; vS1[1] = last ? vAn1[1] : vAc1[1];
            if constexpr (SP2) {
            PG8_LDB(B0, 0, 0); PG8_LDB(B1, 0, 1); PG8_SCHED; PG8_LDA(At, 0, 0); PG8_STAGE(PG8_SA(1, 1), a1 + hstepA, vAc1);
            PG8_WAIT_V(8); PG8_WAIT_L(0); PG8_BAR; PG8_MMA(0, 0, At, B0); PG8_MMA(0, 1, At, B1); PG8_BAR; PG8_SCHED;
            PG8_LDA(At, 0, 1); PG8_STAGE(PG8_SB(0, 0), b2, voffB); PG8_STAGE(PG8_SB(0, 1), b2 + hstep, voffB); PG8_STAGE(PG8_SA(0, 0), a2, vS0);
            PG8_WAIT_V(8); PG8_WAIT_L(0); PG8_BAR; PG8_MMA(1, 0, At, B0); PG8_MMA(1, 1, At, B1); PG8_BAR; PG8_SCHED;
            PG8_LDB(B0, 1, 0); PG8_LDB(B1, 1, 1); PG8_SCHED; PG8_LDA(At, 1, 0); PG8_STAGE(PG8_SA(0, 1), a2 + hstepA, vS1);
            PG8_WAIT_V(8); PG8_WAIT_L(0); PG8_BAR; PG8_MMA(0, 0, At, B0); PG8_MMA(0, 1, At, B1); PG8_BAR; PG8_SCHED;
            PG8_LDA(At, 1, 1); PG8_STAGE(PG8_SB(1, 0), b3, voffB); PG8_STAGE(PG8_SB(1, 1), b3 + hstep, voffB); PG8_STAGE(PG8_SA(1, 0), a3, vS0);
            PG8_WAIT_V(8); PG8_WAIT_L(0); PG8_BAR; PG8_MMA(1, 0, At, B0); PG8_MMA(1, 1, At, B1); PG8_BAR; PG8_SCHED;
            } else {
            PG8_LDB(B0, 0, 0); PG8_SCHED; PG8_LDA(At, 0, 0); PG8_STAGE(PG8_SA(1, 1), a1 + hstep, voffA);
            PG8_WAIT_L(8); PG8_BAR; PG8_WAIT_L(0); PG8_MMA(0, 0, At, B0); PG8_BAR; PG8_SCHED;
            PG8_LDB(B1, 0, 1); PG8_STAGE(PG8_SB(0, 0), b2, voffB);
            PG8_BAR; PG8_WAIT_L(0); PG8_MMA(0, 1, At, B1); PG8_BAR;
            PG8_LDA(At, 0, 1); PG8_STAGE(PG8_SA(0, 0), a2, voffA);
            PG8_BAR; PG8_WAIT_L(0); PG8_MMA(1, 0, At, B0); PG8_BAR; PG8_SCHED;
            PG8_STAGE(PG8_SB(0, 1), b2 + hstep, voffB);
            PG8_WAIT_V(6); PG8_BAR; PG8_MMA(1, 1, At, B1); PG8_BAR;
            PG8_LDB(B0, 1, 0); PG8_SCHED; PG8_LDA(At, 1, 0); PG8_STAGE(PG8_SA(0, 1), a2 + hstep, voffA);
            PG8_WAIT_L(8); PG8_BAR; PG8_WAIT_L(0); PG8_MMA(0, 0, At, B0); PG8_BAR; PG8_SCHED;
            PG8_LDB(B1, 1, 1); PG8_STAGE(PG8_SB(1, 0), b3, voffB);
            PG8_BAR; PG8_WAIT_L(0); PG8_MMA(0, 1, At, B1); PG8_BAR;
            PG8_LDA(At, 1, 1); PG8_STAGE(PG8_SA(1, 0), a3, voffA);
            PG8_BAR; PG8_WAIT_L(0); PG8_MMA(1, 0, At, B0); PG8_BAR; PG8_SCHED;
            PG8_STAGE(PG8_SB(1, 1), b3 + hstep, voffB);
            PG8_WAIT_V(6); PG8_BAR; PG8_MMA(1, 1, At, B1); PG8_BAR;
            }
        }
        if constexpr (ALIGN_EPI) { if (wr == 0) PG8_BAR; }
        if constexpr (!Epi::AFTER_DRAIN) { E(acc, cur, wr, wc, fr, fq); S.done(cur); }
        if (!has_next) break;
#pragma unroll
        for (int a = 0; a < 2; ++a)
#pragma unroll
            for (int b = 0; b < 2; ++b)
#pragma unroll
                for (int m = 0; m < 4; ++m)
#pragma unroll
                    for (int n = 0; n < 2; ++n) acc[a][b][m][n] = (f32x4){0.f, 0.f, 0.f, 0.f};
        cur = nxt; cA = nA; cB = nB; ++ui;
        if constexpr (GATHER) { vAc0[0] = vAn0[0]; vAc0[1] = vAn0[1]; vAc1[0] = vAn1[0]; vAc1[1] = vAn1[1]; }
        if constexpr (ALIGN_EPI) { if (wr == 1) PG8_BAR; }
    }
    PG8_WAIT_V(0);
    if constexpr (!ALIGN_EPI) { if (wr == 0) PG8_BAR; }
    PG8_BAR;
    if constexpr (Epi::AFTER_DRAIN) { E.fused(acc, cur, wr, wc, fr, fq, lds, wid, lane); S.done(cur); }
#undef PG8_SA
#undef PG8_SB
#undef PG8_STAGE
#undef PG8_LDA
#undef PG8_LDB
#undef PG8_MMA
#undef PG8_WAIT_V
#undef PG8_WAIT_L
#undef PG8_BAR
#undef PG8_SCHED
#undef PG8_GFETCH
}
}
#include <hip/hip_bf16.h>
#include <cmath>
namespace attn_body {
using bf16=__hip_bfloat16;
using bf16x8=__attribute__((ext_vector_type(8)))short;
using s16x4=__attribute__((ext_vector_type(4)))short;
using f32x16=__attribute__((ext_vector_type(16)))float;
using u32x4=__attribute__((ext_vector_type(4)))unsigned;
constexpr int D=64,DM=1024,KVP=256;
constexpr int NW=8,QBLK=32,QB=QBLK*NW,KVBLK=64;
__device__ __forceinline__ int crow(int r,int hi){return (r&3)+8*(r>>2)+4*hi;}
#define SBAR() __builtin_amdgcn_sched_barrier(0)
__device__ __forceinline__ void cmask(f32x16&p0,f32x16&p1,int jb,int qrel,int hi){
  const float NEG=-INFINITY; int kb=64*jb+4*hi;
  #pragma unroll
  for(int r=0;r<16;++r){int kv=kb+(r&3)+8*(r>>2); if(kv>qrel)p0[r]=NEG; if(kv+32>qrel)p1[r]=NEG;}
}

constexpr int NSLOT=3, SLOTB=8192;
constexpr int LDS_K=0, LDS_V=NSLOT*SLOTB, LDS_WS=2*NSLOT*SLOTB, LDS_OST=LDS_WS+NW*64*4, LDS_BYTES=LDS_OST+NW*4096;
constexpr float C2=0.125f*1.4426950408889634f;
__device__ __forceinline__ void glds16(const void*gsrc,unsigned lds_dst){unsigned keep;
  asm volatile("s_mov_b32 %0, m0\n\ts_mov_b32 m0, %2\n\ts_nop 0\n\tglobal_load_lds_dwordx4 %1, off\n\ts_mov_b32 m0, %0":"=&s"(keep):"v"(gsrc),"s"(lds_dst):"memory");}
__device__ __forceinline__ float max3f(float a,float b,float c){float r;asm("v_max3_f32 %0, %1, %2, %3":"=v"(r):"v"(a),"v"(b),"v"(c));return r;}
__device__ __forceinline__ float max2f(float a,float b){float r;asm("v_max_f32_e32 %0, %1, %2":"=v"(r):"v"(a),"v"(b));return r;}
__device__ __forceinline__ float fadd_s(float a,float b){float r;asm("v_add_f32_e32 %0, %1, %2":"=v"(r):"v"(a),"v"(b));return r;}
__device__ __forceinline__ float fsub_s(float a,float b){float r;asm("v_sub_f32_e32 %0, %1, %2":"=v"(r):"v"(a),"v"(b));return r;}
typedef float f32x2_t __attribute__((ext_vector_type(2))); typedef __bf16 bf16x2_t __attribute__((ext_vector_type(2)));
__device__ __forceinline__ unsigned cvtpk_s(float lo,float hi){f32x2_t v={lo,hi};bf16x2_t b=__builtin_convertvector(v,bf16x2_t);return __builtin_bit_cast(unsigned,b);}
#define WAIT_BAR(N) asm volatile("s_waitcnt vmcnt(" #N ") lgkmcnt(0)\n\ts_barrier":::"memory")

__device__ __forceinline__ void qkt(f32x16&p0,f32x16&p1,const char*Kslot,const bf16x8*qr,const f32x16&negm,int r32,int hi){
  const char*kb=Kslot+hi*1024+r32*16;
  #pragma unroll
  for(int d0=0;d0<4;++d0){
    const bf16x8 b0=*reinterpret_cast<const bf16x8*>(kb+d0*2048);
    const bf16x8 b1=*reinterpret_cast<const bf16x8*>(kb+d0*2048+512);
    if(d0==0){p0=__builtin_amdgcn_mfma_f32_32x32x16_bf16(b0,qr[0],negm,0,0,0);p1=__builtin_amdgcn_mfma_f32_32x32x16_bf16(b1,qr[0],negm,0,0,0);}
    else{p0=__builtin_amdgcn_mfma_f32_32x32x16_bf16(b0,qr[d0],p0,0,0,0);p1=__builtin_amdgcn_mfma_f32_32x32x16_bf16(b1,qr[d0],p1,0,0,0);}}
}
typedef __attribute__((address_space(3))) const char* lds_cptr;
typedef short v4i16_t __attribute__((ext_vector_type(4)));
__device__ __forceinline__ void kload8(bf16x8*kf,lds_cptr kp){
  kf[0]=*(const __attribute__((address_space(3))) bf16x8*)(kp);      kf[1]=*(const __attribute__((address_space(3))) bf16x8*)(kp+512);
  kf[2]=*(const __attribute__((address_space(3))) bf16x8*)(kp+2048); kf[3]=*(const __attribute__((address_space(3))) bf16x8*)(kp+2560);
  kf[4]=*(const __attribute__((address_space(3))) bf16x8*)(kp+4096); kf[5]=*(const __attribute__((address_space(3))) bf16x8*)(kp+4608);
  kf[6]=*(const __attribute__((address_space(3))) bf16x8*)(kp+6144); kf[7]=*(const __attribute__((address_space(3))) bf16x8*)(kp+6656);
}
__device__ __forceinline__ void kload2(bf16x8*kf,lds_cptr kp,int j){ kf[2*j]=*(const __attribute__((address_space(3))) bf16x8*)(kp+j*2048); kf[2*j+1]=*(const __attribute__((address_space(3))) bf16x8*)(kp+j*2048+512); }
__device__ __forceinline__ s16x4 vtr(lds_cptr p){ return __builtin_bit_cast(s16x4,__builtin_amdgcn_ds_read_tr16_b64_v4i16((__attribute__((address_space(3))) v4i16_t*)p)); }
__device__ __forceinline__ float rowmax(const f32x16&p0,const f32x16&p1){
  float a=max3f(p0[0],p0[1],p1[0]),b=max3f(p0[2],p0[3],p1[1]);a=max3f(a,p1[2],p1[3]);
  #pragma unroll
  for(int r=4;r<16;r+=4){a=max3f(a,p0[r],p0[r+1]);b=max3f(b,p0[r+2],p0[r+3]);a=max3f(a,p1[r],p1[r+1]);b=max3f(b,p1[r+2],p1[r+3]);}
  const float m=max2f(a,b);
  auto rr=__builtin_amdgcn_permlane32_swap(__float_as_uint(m),__float_as_uint(m),false,false);
  return max2f(__uint_as_float(rr[0]),__uint_as_float(rr[1]));
}
__device__ __forceinline__ void pv(f32x16*o,int vb,bf16x8 pa0,bf16x8 pa1,bf16x8 pa2,bf16x8 pa3){
  #pragma unroll
  for(int d0=0;d0<2;++d0){s16x4 lo[4],hi[4];
    #pragma unroll
    for(int ks=0;ks<4;++ks){
      asm volatile("ds_read_b64_tr_b16 %0,%1 offset:%c2":"=&v"(lo[ks]):"v"(vb),"i"(d0*4096+ks*1024):"memory");
      asm volatile("ds_read_b64_tr_b16 %0,%1 offset:%c2":"=&v"(hi[ks]):"v"(vb),"i"(d0*4096+ks*1024+512):"memory");}
    asm volatile("s_waitcnt lgkmcnt(0)":::"memory");SBAR();
    #define PK(k) (bf16x8){lo[k][0],lo[k][1],lo[k][2],lo[k][3],hi[k][0],hi[k][1],hi[k][2],hi[k][3]}
    o[d0]=__builtin_amdgcn_mfma_f32_32x32x16_bf16(pa0,PK(0),o[d0],0,0,0);
    o[d0]=__builtin_amdgcn_mfma_f32_32x32x16_bf16(pa1,PK(1),o[d0],0,0,0);
    o[d0]=__builtin_amdgcn_mfma_f32_32x32x16_bf16(pa2,PK(2),o[d0],0,0,0);
    o[d0]=__builtin_amdgcn_mfma_f32_32x32x16_bf16(pa3,PK(3),o[d0],0,0,0);
    #undef PK
  }
}

#ifndef ATTN_STORE16
#define ATTN_STORE16(p,v) (*(u32x4*)(p)=(v))
#endif
template<int THRL> __device__ __forceinline__ void attn_unit(long qrow0,long kvrow0,int NT,int h,const bf16*Q,const bf16*__restrict__ K,const bf16*__restrict__ V,bf16*O,char*shm){
  int tid_l=threadIdx.x; asm volatile("":"+v"(tid_l)); const int tid=tid_l,lane=tid&63,r32=lane&31,hi=lane>>5; const int wid=__builtin_amdgcn_readfirstlane(tid>>6);
  const bf16*Qw=Q+(qrow0+wid*QBLK)*DM+h*D;
  const bf16*Kh=K+kvrow0*KVP+(h>>2)*D,*Vh=V+kvrow0*KVP+(h>>2)*D;
  const unsigned lds0=(unsigned)(uintptr_t)shm;
  float*wsf=(float*)(shm+LDS_WS)+wid*64;
  const bf16*ksrc=Kh+(long)lane*KVP+wid*8;
  const bf16*vsrc=Vh+(long)(16*(wid&3)+(lane>>2))*KVP+(wid>>2)*32+(lane&3)*8;
  const unsigned kdst=lds0+LDS_K+wid*1024, vdst=lds0+LDS_V+wid*1024;
  #define DMA_K(t,slot) glds16(ksrc+(long)(t)*KVBLK*KVP,(unsigned)__builtin_amdgcn_readfirstlane(kdst+(slot)))
  #define DMA_V(t,slot) glds16(vsrc+(long)(t)*KVBLK*KVP,(unsigned)__builtin_amdgcn_readfirstlane(vdst+(slot)))
  const int vb0=(int)(lds0+LDS_V)+((lane>>4)&1)*32+(lane&3)*8+(4*hi+((lane&15)>>2))*64;
  const char*Kbase=shm+LDS_K; bf16x8 kf[8];
  const lds_cptr shm3=(lds_cptr)shm; const lds_cptr kp0=shm3+LDS_K+hi*1024+r32*16; const lds_cptr vp0=shm3+LDS_V+((lane>>4)&1)*32+(lane&3)*8+(4*hi+((lane&15)>>2))*64;
  DMA_K(0,0);DMA_V(0,0);DMA_K(1,SLOTB);
  bf16x8 qr[4];
  #pragma unroll
  for(int d0=0;d0<4;++d0)qr[d0]=*reinterpret_cast<const bf16x8*>(&Qw[(long)r32*DM+d0*16+hi*8]);
  float mhat=0.f,l_reg=0.f;f32x16 o[2];o[0]=f32x16{};o[1]=f32x16{};f32x16 negm=f32x16{};asm volatile("":"+v"(negm));
  #define CMASK(P0,P1,t) do{}while(0)
  bool resc=false;
  #define START(P0,P1) do{ const float rm=rowmax(P0,P1); resc=false; \
    { const float dl=rm; mhat=fadd_s(mhat,dl); \
      _Pragma("unroll") for(int r=0;r<16;++r){P0[r]=fsub_s(P0[r],dl);P1[r]=fsub_s(P1[r],dl);} \
      _Pragma("unroll") for(int r=0;r<16;++r)negm[r]=-mhat; asm volatile("":"+v"(negm)); } \
    _Pragma("unroll") for(int r=0;r<16;++r)P0[r]=__builtin_amdgcn_exp2f(P0[r]); }while(0)
  #define RESC() do{ if(resc){ asm volatile("s_waitcnt lgkmcnt(0)":::"memory"); \
      _Pragma("unroll") for(int d_=0;d_<2;++d_) _Pragma("unroll") for(int r=0;r<16;++r)o[d_][r]*=wsf[crow(r,hi)]; } }while(0)
  f32x16 pA0,pA1,pB0,pB1;
  int sl_prev=0,sl_cur=0,sl_next=SLOTB;
  #define ROT() do{sl_prev=sl_cur;sl_cur=sl_next;sl_next=(sl_next==(NSLOT-1)*SLOTB)?0:sl_next+SLOTB;}while(0)
  DMA_K(2,2*SLOTB);
  WAIT_BAR(3);
  qkt(pA0,pA1,Kbase,qr,negm,r32,hi);asm volatile("s_nop 15\n\ts_nop 7":"+v"(pA0),"+v"(pA1));CMASK(pA0,pA1,0);
  START(pA0,pA1);
  _Pragma("unroll") for(int r=0;r<16;++r)pA1[r]=__builtin_amdgcn_exp2f(pA1[r]);
  WAIT_BAR(0);
  DMA_K(3,0);DMA_V(1,SLOTB);
  ROT();
  kload8(kf,kp0+sl_cur);
  WAIT_BAR(2);
  s16x4 vlo[8],vhi[8]; u32x4 pw0,pw1,pw2,pw3;
  #define PKW(P,B) cvtpk_s(P[B],P[B+1])
  #define PAF(k) __builtin_bit_cast(bf16x8,pw##k)
  #define VFR(i) (bf16x8){vlo[i][0],vlo[i][1],vlo[i][2],vlo[i][3],vhi[i][0],vhi[i][1],vhi[i][2],vhi[i][3]}
  #define PIN(x) asm volatile("":"+v"(x))
  #define MX3(a,b,c) __builtin_fmaxf(__builtin_fmaxf((a),(b)),(c))
  #define GAPA(MF,A0,A1,A2,A3,W0,W1,PW) do{ MF; sacc+=A0; sacc+=A1; sacc+=A2; sacc+=A3; PIN(sacc); W0; W1; PIN(PW); SBAR(); }while(0)
  #define EX(v) __builtin_amdgcn_exp2f(v)
  #define GAPB(MF,X,B) do{ MF; X[B]=EX(X[B]); X[B+1]=EX(X[B+1]); X[B+2]=EX(X[B+2]); X[B+3]=EX(X[B+3]); PIN(X); SBAR(); }while(0)
  #define VRD(i) do{ vlo[i]=vtr(vp_+(((i)>>2)*4096+((i)&3)*1024)); vhi[i]=vtr(vp_+(((i)>>2)*4096+((i)&3)*1024+512)); }while(0)
  #define KRD(G,j) do{ if(G){ kload2(kf,kp0+sl_next,j); SBAR(); } }while(0)
  #define STEP(C0,C1,P0,P1,t,GK,GV,GL) do{ SBAR(); \
    const lds_cptr vp_=vp0+sl_prev; \
    VRD(0); SBAR(); float sacc=(P0[0]+P0[1]); \
    GAPA(C0=__builtin_amdgcn_mfma_f32_32x32x16_bf16(kf[0],qr[0],negm,0,0,0), P0[2],P0[3],P0[4],P0[5],     pw0[0]=PKW(P0,0), pw0[1]=PKW(P0,2), pw0); \
    VRD(4); SBAR(); GAPA(C1=__builtin_amdgcn_mfma_f32_32x32x16_bf16(kf[1],qr[0],negm,0,0,0), P0[6],P0[7],P0[8],P0[9],     pw0[2]=PKW(P0,4), pw0[3]=PKW(P0,6), pw0); \
    VRD(1); SBAR(); GAPA(C0=__builtin_amdgcn_mfma_f32_32x32x16_bf16(kf[2],qr[1],C0,0,0,0),   P0[10],P0[11],P0[12],P0[13], pw1[0]=PKW(P0,8), pw1[1]=PKW(P0,10), pw1); \
    VRD(5); SBAR(); GAPA(C1=__builtin_amdgcn_mfma_f32_32x32x16_bf16(kf[3],qr[1],C1,0,0,0),   P0[14],P0[15],P1[0],P1[1],   pw1[2]=PKW(P0,12),pw1[3]=PKW(P0,14), pw1); \
    VRD(2); SBAR(); GAPA(C0=__builtin_amdgcn_mfma_f32_32x32x16_bf16(kf[4],qr[2],C0,0,0,0),   P1[2],P1[3],P1[4],P1[5],     pw2[0]=PKW(P1,0), pw2[1]=PKW(P1,2), pw2); \
    VRD(6); SBAR(); GAPA(C1=__builtin_amdgcn_mfma_f32_32x32x16_bf16(kf[5],qr[2],C1,0,0,0),   P1[6],P1[7],P1[8],P1[9],     pw2[2]=PKW(P1,4), pw2[3]=PKW(P1,6), pw2); \
    VRD(3); SBAR(); GAPA(C0=__builtin_amdgcn_mfma_f32_32x32x16_bf16(kf[6],qr[3],C0,0,0,0),   P1[10],P1[11],P1[12],P1[13], pw3[0]=PKW(P1,8), pw3[1]=PKW(P1,10), pw3); \
    VRD(7); SBAR(); GAPA(C1=__builtin_amdgcn_mfma_f32_32x32x16_bf16(kf[7],qr[3],C1,0,0,0),   P1[14],P1[15],0.f,0.f,       pw3[2]=PKW(P1,12),pw3[3]=PKW(P1,14), pw3); \
    l_reg+=sacc; \
    if(GK){DMA_K((t)+3,sl_cur);} if(GV){DMA_V((t)+1,sl_next);} \
    CMASK(C0,C1,t); \
    { float a=MX3(C0[0],C0[1],C1[0]),b=MX3(C0[2],C0[3],C1[1]); a=MX3(a,C1[2],C1[3]); \
      _Pragma("unroll") for(int r=4;r<16;r+=4){a=MX3(a,C0[r],C0[r+1]);b=MX3(b,C0[r+2],C0[r+3]);a=MX3(a,C1[r],C1[r+1]);b=MX3(b,C1[r+2],C1[r+3]);} \
      float rm=__builtin_fmaxf(a,b); { auto rr=__builtin_amdgcn_permlane32_swap(__float_as_uint(rm),__float_as_uint(rm),false,false); rm=__builtin_fmaxf(__uint_as_float(rr[0]),__uint_as_float(rr[1])); } \
      resc=false; \
      if(__builtin_expect(__any(rm>(float)THRL),0)){ const float dl=__builtin_fmaxf(rm,0.f); mhat+=dl; \
        _Pragma("unroll") for(int r=0;r<16;++r){C0[r]-=dl;C1[r]-=dl;} \
        _Pragma("unroll") for(int r=0;r<16;++r)negm[r]=-mhat; asm volatile("":"+v"(negm)); \
        const float f=__builtin_amdgcn_exp2f(-dl); l_reg*=f; if(hi==0)wsf[r32]=f; resc=true; } } \
    SBAR(); \
    GAPB(o[0]=__builtin_amdgcn_mfma_f32_32x32x16_bf16(PAF(0),VFR(0),o[0],0,0,0), C0,0); \
    GAPB(o[1]=__builtin_amdgcn_mfma_f32_32x32x16_bf16(PAF(0),VFR(4),o[1],0,0,0), C0,4); \
    KRD(GL,0); GAPB(o[0]=__builtin_amdgcn_mfma_f32_32x32x16_bf16(PAF(1),VFR(1),o[0],0,0,0), C0,8); \
    KRD(GL,1); GAPB(o[1]=__builtin_amdgcn_mfma_f32_32x32x16_bf16(PAF(1),VFR(5),o[1],0,0,0), C0,12); \
    KRD(GL,2); GAPB(o[0]=__builtin_amdgcn_mfma_f32_32x32x16_bf16(PAF(2),VFR(2),o[0],0,0,0), C1,0); \
    KRD(GL,3); GAPB(o[1]=__builtin_amdgcn_mfma_f32_32x32x16_bf16(PAF(2),VFR(6),o[1],0,0,0), C1,4); \
    GAPB(o[0]=__builtin_amdgcn_mfma_f32_32x32x16_bf16(PAF(3),VFR(3),o[0],0,0,0), C1,8); \
    GAPB(o[1]=__builtin_amdgcn_mfma_f32_32x32x16_bf16(PAF(3),VFR(7),o[1],0,0,0), C1,12); \
    }while(0)
  int t=1;
  #undef CMASK
  #define CMASK(P0,P1,t) do{}while(0)
  for(;t+5<NT;t+=2){
    STEP(pB0,pB1,pA0,pA1,t,true,true,true);     WAIT_BAR(2); RESC(); ROT();
    STEP(pA0,pA1,pB0,pB1,t+1,true,true,true);   WAIT_BAR(2); RESC(); ROT();
  }
  #undef CMASK
  #define CMASK(P0,P1,t) do{}while(0)
  #define ENDW(tt) do{ if((tt)+3<NT){WAIT_BAR(2);} else if((tt)+2<NT){WAIT_BAR(1);} else {WAIT_BAR(0);} }while(0)
  for(;t+1<NT;t+=2){
    STEP(pB0,pB1,pA0,pA1,t,(t+3<NT),(t+1<NT),(t+1<NT));       ENDW(t);   RESC(); ROT();
    STEP(pA0,pA1,pB0,pB1,t+1,(t+4<NT),(t+2<NT),(t+2<NT));     ENDW(t+1); RESC(); ROT();
  }
  STEP(pB0,pB1,pA0,pA1,NT-1,false,false,false); RESC();
  { float sacc=pB0[0]+pB0[1]; _Pragma("unroll") for(int r=2;r<16;++r)sacc+=pB0[r]; _Pragma("unroll") for(int r=0;r<16;++r)sacc+=pB1[r]; l_reg+=sacc;
    pw0=(u32x4){PKW(pB0,0),PKW(pB0,2),PKW(pB0,4),PKW(pB0,6)};pw1=(u32x4){PKW(pB0,8),PKW(pB0,10),PKW(pB0,12),PKW(pB0,14)};pw2=(u32x4){PKW(pB1,0),PKW(pB1,2),PKW(pB1,4),PKW(pB1,6)};pw3=(u32x4){PKW(pB1,8),PKW(pB1,10),PKW(pB1,12),PKW(pB1,14)};
    SBAR(); pv(o,vb0+sl_cur,PAF(0),PAF(1),PAF(2),PAF(3)); }
  #undef PKW
  #undef PAF
  #undef VFR
  #undef PIN
  #undef MX3
  #undef GAPA
  #undef GAPB
  #undef EX
  #undef VRD
  #undef KRD
  #undef STEP
  #undef ENDW
  {auto rr=__builtin_amdgcn_permlane32_swap(__float_as_uint(l_reg),__float_as_uint(l_reg),false,false);l_reg=__uint_as_float(rr[0])+__uint_as_float(rr[1]);}
  if(hi==0)wsf[32+r32]=l_reg;asm volatile("s_waitcnt lgkmcnt(0)":::"memory");
  float rli[16];
  #pragma unroll
  for(int r=0;r<16;++r)rli[r]=__builtin_amdgcn_rcpf(wsf[32+crow(r,hi)]);
  bf16*Ow=O+(qrow0+wid*QBLK)*DM+h*D;
  { bf16*stg=(bf16*)(shm+LDS_OST)+wid*2048;
    #pragma unroll
    for(int r=0;r<16;++r){const int orow=crow(r,hi);
      #pragma unroll
      for(int d0=0;d0<2;++d0)stg[orow*64+d0*32+r32]=__float2bfloat16(o[d0][r]*rli[r]);}
    asm volatile("s_waitcnt lgkmcnt(0)":::"memory");
    #pragma unroll
    for(int i=0;i<4;++i){const int row=i*8+(lane>>3),ch=lane&7; const u32x4 v=*(const u32x4*)(stg+row*64+ch*8); ATTN_STORE16(Ow+(long)row*DM+ch*8,v);} }
  asm volatile("s_waitcnt lgkmcnt(0)\n\ts_barrier":::"memory");
  #undef DMA_K
  #undef DMA_V
  #undef CMASK
  #undef START
  #undef RESC
  #undef ROT
}
constexpr int ATTN_LDS_BYTES=LDS_BYTES;
#undef SBAR
#undef WAIT_BAR
}

constexpr int NWAVES = 8;
constexpr int NB = 8, SEQ = 4096, CTXL = 256, TB = SEQ + CTXL  , MT = NB * TB  , DMODEL = 1024;
constexpr int NMODC = 6 * DMODEL, MODROWS = 9;
constexpr int QKVN = 1536, WINN = 3104, WINP = 3328;
constexpr int NEXP = 32, TOPK = 4, MPAD = MT * TOPK + NEXP * 256;
constexpr int NLAYER = 4;
constexpr float RMS_EPS = 1e-6f;
constexpr float ATT_C2 = 0.125f * 1.4426950408889634f;

constexpr size_t MiB = 1u << 20;
constexpr size_t WS_CTL = 0, CTL_ZERO_BYTES = 1 * MiB;
constexpr size_t WS_MOD = 1 * MiB, WS_ROPE = 2 * MiB, WS_MODP = 3 * MiB;
constexpr size_t WS_SLOT = 17 * MiB, WS_GATEW = 18 * MiB, WS_SLOTPOS = 19 * MiB;
constexpr size_t WS_WQKV = 20 * MiB, WS_WOA = 26 * MiB, WS_WIN = 30 * MiB, WS_WOG = 43 * MiB, WS_WGU = 48 * MiB, WS_WDN = 560 * MiB;
constexpr size_t WS_X = 816 * MiB, WS_XN = 952 * MiB, WS_Q = 1020 * MiB, WS_K = 1088 * MiB, WS_V = 1105 * MiB, WS_G = 1122 * MiB;
constexpr size_t WS_OF = 1343 * MiB, WS_OB = 1479 * MiB, WS_XG = 1615 * MiB, WS_ACT = 1903 * MiB, WS_Y = 2191 * MiB, WS_PAR = 2479 * MiB, WS_LIST = 2483 * MiB  , WS_END = 2488 * MiB;
static_assert(WS_MODP + (size_t)16 * NLAYER * MODROWS * NMODC * 4 <= WS_SLOT && WS_WIN + (size_t)2 * WINP * 1024 * 2 <= WS_WOG && WS_G + (size_t)MT * WINP * 2 <= WS_OF && WS_XG + (size_t)MPAD * 1024 * 2 <= WS_ACT, "ws map");
constexpr int CW_TMO = 0, CW_BAR = 4096, CW_CNT = 16384;

constexpr int RING_OFF = 0, RING_BYTES = 131072;
constexpr int WR_STRIDE = 1028;
constexpr int LDS_AUX = 133120;
constexpr int AUX_LCNT = LDS_AUX, AUX_GB = LDS_AUX + 128, AUX_T2E = LDS_AUX + 256  , AUX_BASE = AUX_T2E + 2560  , AUX_NT = AUX_BASE + 128, AUX_CNT = AUX_NT + 64  , AUX_ENT = AUX_CNT + 128  , AUX_RS = AUX_ENT + 4352  , AUX_ROWTAB = AUX_RS + 576, ROWTAB_UNITS = 18  ;
constexpr int MISC_OFF = 154624;
constexpr int LDS_BYTES = 155648;
static_assert(AUX_ROWTAB + ROWTAB_UNITS * 512 <= MISC_OFF, "LDS map");

#define GAS __attribute__((address_space(1)))
#define LAS __attribute__((address_space(3)))
typedef unsigned short bf16;
typedef unsigned v4u __attribute__((ext_vector_type(4)));
typedef float f32x4 __attribute__((ext_vector_type(4)));
typedef short bf16x8 __attribute__((ext_vector_type(8)));
typedef GAS unsigned gu32;
typedef GAS unsigned long long gu64;
#define RLX_AGENT __ATOMIC_RELAXED, __HIP_MEMORY_SCOPE_AGENT
#define LDS_WAIT() asm volatile("s_waitcnt lgkmcnt(0)" ::: "memory")
#define VM_WAIT() asm volatile("s_waitcnt vmcnt(0)" ::: "memory")
__device__ __forceinline__ unsigned long long rt() { return __builtin_amdgcn_s_memrealtime(); }
__device__ __forceinline__ unsigned f2bf(float f) { unsigned u = __builtin_bit_cast(unsigned, f); return (u + 0x7fffu + ((u >> 16) & 1u)) >> 16; }
__device__ __forceinline__ unsigned pk2(float lo, float hi) { return f2bf(lo) | (f2bf(hi) << 16); }

#define XB_TMO      128
#define XB_XCNT(j)  (256  + 64 * (j))
#define XB_XSUB(j)  (1280 + 64 * (j))
#define XB_XGEN(j)  (2304 + 64 * (j))
#define XB_TOP      3328
#define XB_TOPGEN   3392
#define XCD_BAR_WORDS 3456
#define XB_SPIN_CAP (1u << 18)

__device__ __forceinline__ unsigned xb_ld(unsigned* p)              { return __hip_atomic_load(p, __ATOMIC_RELAXED, __HIP_MEMORY_SCOPE_AGENT); }
__device__ __forceinline__ unsigned xb_add(unsigned* p, unsigned v) { return __hip_atomic_fetch_add(p, v, __ATOMIC_RELAXED, __HIP_MEMORY_SCOPE_AGENT); }
__device__ __forceinline__ unsigned xb_xcc_id() { return (unsigned)__builtin_amdgcn_s_getreg((3 << 11) | 20) & 0xFu; }
#define XB_SPIN(cond, bar) do { unsigned _sp = 0; while (cond) { __builtin_amdgcn_s_sleep(1); \
    if ((++_sp & 255u) == 0u) { if (xb_ld(&(bar)[XB_TMO])) break; if (_sp > XB_SPIN_CAP) { atomicAdd(&(bar)[XB_TMO], 1u); break; } } } } while (0)

struct XcdBarrier {
    unsigned* bar; unsigned x;
    volatile LAS unsigned* st;
};

__device__ __forceinline__ XcdBarrier xcd_barrier_post(unsigned* bar, volatile LAS unsigned* st) {
    XcdBarrier b; b.bar = bar; b.x = xb_xcc_id(); b.st = st;
    if (threadIdx.x == 0) (void)xb_add(&bar[XB_XCNT(b.x)], 1u);
    return b;
}
__device__ __forceinline__ void xcd_barrier_complete(unsigned* bar, unsigned x, unsigned& nloc, unsigned& nx) {
    const unsigned G = gridDim.x * gridDim.y * gridDim.z;
    unsigned sum, cnt, mine, sp = 0u;
    for (;;) {
        sum = 0u; cnt = 0u; mine = 0u;
#pragma unroll
        for (unsigned j = 0; j < 16; ++j) { const unsigned c = xb_ld(&bar[XB_XCNT(j)]); sum += c; cnt += (c > 0u) ? 1u : 0u; mine = (j == x) ? c : mine; }
        if (sum == G) break;
        __builtin_amdgcn_s_sleep(1);
        if ((++sp & 255u) == 0u) { if (xb_ld(&bar[XB_TMO])) break; if (sp > XB_SPIN_CAP) { atomicAdd(&bar[XB_TMO], 1u); break; } }
    }
    nloc = mine > 0u ? mine : 1u; nx = cnt > 0u ? cnt : 1u;
}

__device__ __forceinline__ void xcd_barrier(const XcdBarrier& b) {
    asm volatile("s_waitcnt vmcnt(0)" ::: "memory");
    __syncthreads();
    if (threadIdx.x == 0) {
        unsigned* bar = b.bar;
        __builtin_amdgcn_s_waitcnt(0);
        unsigned nloc = b.st[0], nx = b.st[1];
        if (nloc == 0u) { xcd_barrier_complete(bar, b.x, nloc, nx); b.st[0] = nloc; b.st[1] = nx; }
        const unsigned old = xb_add(&bar[XB_XSUB(b.x)], 1u);
        const unsigned gen = old / nloc;
        if (old + 1u == (gen + 1u) * nloc) {
            __builtin_amdgcn_fence(__ATOMIC_RELEASE, "agent");
            asm volatile("s_waitcnt vmcnt(0)" ::: "memory");
            const unsigned og = xb_add(&bar[XB_TOP], 1u);
            const unsigned tg = og / nx;
            if (og + 1u == (tg + 1u) * nx) xb_add(&bar[XB_TOPGEN], 1u);
            else XB_SPIN(xb_ld(&bar[XB_TOPGEN]) == tg, bar);
            __builtin_amdgcn_fence(__ATOMIC_ACQUIRE, "agent");
            xb_add(&bar[XB_XGEN(b.x)], 1u);
            asm volatile("s_waitcnt vmcnt(0)" ::: "memory");
        } else {
            XB_SPIN(xb_ld(&bar[XB_XGEN(b.x)]) == gen, bar);
            __builtin_amdgcn_fence(__ATOMIC_ACQUIRE, "agent");
            asm volatile("s_waitcnt vmcnt(0)" ::: "memory");
        }
    }
    __syncthreads();
}

typedef float f32x2 __attribute__((ext_vector_type(2)));
__device__ __forceinline__ float wave_sum(float v) {
#pragma unroll
    for (int o = 1; o < 64; o <<= 1) v += __shfl_xor(v, o);
    return v;
}
__device__ __forceinline__ float wave_max(float v) {
#pragma unroll
    for (int o = 1; o < 64; o <<= 1) v = fmaxf(v, __shfl_xor(v, o));
    return v;
}
__device__ __forceinline__ float bf2f(unsigned short h) { return __uint_as_float((unsigned)h << 16); }
__device__ __forceinline__ float silu_f(float x) { return x / (1.0f + __expf(-x)); }
__device__ __forceinline__ int mod_row(int m) { const int b = m / TB; return (m - b * TB < CTXL) ? 8 : b; }

__device__ __forceinline__ void transpose_item(const float* W, int K, int N, bf16* WT, int k0, int n0, int dst_row0, LAS float* scr, int lane) {
#pragma unroll 8
    for (int i = 0; i < 32; ++i) { const int kk = 2 * i + (lane >> 5); scr[kk * 33 + (lane & 31)] = W[(size_t)(k0 + kk) * N + n0 + (lane & 31)]; }
    LDS_WAIT(); asm volatile("" ::: "memory");
    const int c = lane & 7;
#pragma unroll
    for (int j = 0; j < 4; ++j) { const int n = (lane >> 3) + 8 * j; const LAS float* s = scr + (8 * c) * 33 + n;
        v4u o; o.x = pk2(s[0 * 33], s[1 * 33]); o.y = pk2(s[2 * 33], s[3 * 33]); o.z = pk2(s[4 * 33], s[5 * 33]); o.w = pk2(s[6 * 33], s[7 * 33]);
        *(GAS v4u*)(WT + (size_t)(dst_row0 + n) * K + k0 + 8 * c) = o; }
    LDS_WAIT(); asm volatile("" ::: "memory");
}

struct Args { const float* in[25]; float* out; unsigned char* ws; int ph_lo, ph_hi; };
constexpr int P_N1G = 0, P_N2G = 4096, P_QG = 8192, P_KG = 8320, P_GKF = 8448, P_GKB = 24832, P_BGF = 41216, P_BGB = 42240, P_OG = 43264, P_WR = 43776, P_BR = 174848, P_BGU = 174976, P_BDN = 437120, P_END = 568192;
#define LAUNDER_S(p) asm volatile("" : "+s"(p))
#define LAUNDER_V(p) asm volatile("" : "+v"(p))
#define PARF(ws) ((const float*)((ws) + WS_PAR))

__device__ __forceinline__ void p0_prologue(const Args& A, LAS unsigned char* lds, int gw, int NGW, int wave, int lane) {
    unsigned char* ws = A.ws;
    LAS float* scr = (LAS float*)(lds + RING_OFF + wave * 16384);
    constexpr int I_QKV = 2 * 16 * (QKVN / 32), I_WO = 2 * 16 * 32, I_WIN = 2 * 16 * (WINN / 32), I_GU = 128 * 16 * 64, I_DN = 128 * 16 * 32;
    constexpr int NITEMS = I_GU + I_DN + I_QKV + I_WO + I_WIN + I_WO;
    for (int it = gw; it < NITEMS; it += NGW) {
        int r = it;
        if (r < I_GU) { const int mat = r / (16 * 64), q = r - mat * (16 * 64), kb = q / 64, nb = q - kb * 64, n0 = nb * 32;
            const int dst = ((n0 & 1023) >> 7) * 256 + (n0 >> 10) * 128 + (n0 & 127);
            transpose_item(A.in[21] + (size_t)mat * 1024 * 2048, 1024, 2048, (bf16*)(ws + WS_WGU) + (size_t)mat * 2048 * 1024, kb * 64, n0, dst, scr, lane); continue; } r -= I_GU;
        if (r < I_DN) { const int mat = r / (16 * 32), q = r - mat * (16 * 32), kb = q / 32, nb = q - kb * 32;
            transpose_item(A.in[23] + (size_t)mat * 1024 * 1024, 1024, 1024, (bf16*)(ws + WS_WDN) + (size_t)mat * 1024 * 1024, kb * 64, nb * 32, nb * 32, scr, lane); continue; } r -= I_DN;
        if (r < I_QKV) { const int per = 16 * (QKVN / 32), mat = r / per, q = r - mat * per, kb = q / (QKVN / 32), nb = q - kb * (QKVN / 32);
            transpose_item(A.in[8] + (size_t)mat * 1024 * QKVN, 1024, QKVN, (bf16*)(ws + WS_WQKV) + (size_t)mat * QKVN * 1024, kb * 64, nb * 32, nb * 32, scr, lane); continue; } r -= I_QKV;
        if (r < I_WO) { const int mat = r / 512, q = r - mat * 512, kb = q / 32, nb = q - kb * 32;
            transpose_item(A.in[11] + (size_t)mat * 1024 * 1024, 1024, 1024, (bf16*)(ws + WS_WOA) + (size_t)mat * 1024 * 1024, kb * 64, nb * 32, nb * 32, scr, lane); continue; } r -= I_WO;
        if (r < I_WIN) { const int per = 16 * (WINN / 32), mat = r / per, q = r - mat * per, kb = q / (WINN / 32), nb = q - kb * (WINN / 32);
            transpose_item(A.in[12] + (size_t)mat * 1024 * WINN, 1024, WINN, (bf16*)(ws + WS_WIN) + (size_t)mat * WINP * 1024, kb * 64, nb * 32, nb * 32, scr, lane); continue; } r -= I_WIN;
        { const int mat = r / 512, q = r - mat * 512, kb = q / 32, nb = q - kb * 32;
            transpose_item(A.in[18] + (size_t)mat * 1024 * 1024, 1024, 1024, (bf16*)(ws + WS_WOG) + (size_t)mat * 1024 * 1024, kb * 64, nb * 32, nb * 32, scr, lane); }
    }
    for (int it = gw; it < 2 * (WINP - WINN); it += NGW) { const int mat = it / (WINP - WINN), rr = WINN + it - mat * (WINP - WINN);
        GAS v4u* p = (GAS v4u*)((bf16*)(ws + WS_WIN) + ((size_t)mat * WINP + rr) * 1024) + lane; p[0] = (v4u){0u, 0u, 0u, 0u}; p[64] = (v4u){0u, 0u, 0u, 0u}; }
    for (int it = gw; it < NLAYER * 24 * 16; it += NGW) {
        const int l = it / (24 * 16), q = it - l * (24 * 16), cg = q / 16, kc = q - cg * 16;
        float s[MODROWS];
#pragma unroll
        for (int r = 0; r < MODROWS; ++r) { const float cv = (r < 8) ? A.in[1][r * 1024 + kc * 64 + lane] : A.in[3][kc * 64 + lane]; s[r] = silu_f(cv); }
        f32x4 acc[MODROWS];
#pragma unroll
        for (int r = 0; r < MODROWS; ++r) acc[r] = (f32x4){0.f, 0.f, 0.f, 0.f};
        const float* wp = A.in[4] + ((size_t)l * 1024 + kc * 64) * NMODC + cg * 256 + 4 * lane;
#pragma unroll 4
        for (int kk = 0; kk < 64; ++kk) { const f32x4 w = *(const f32x4*)(wp + (size_t)kk * NMODC);
#pragma unroll
            for (int r = 0; r < MODROWS; ++r) { const float sv = __shfl(s[r], kk); acc[r] = acc[r] + w * sv; } }
        float* op = (float*)(ws + WS_MODP) + (size_t)kc * (NLAYER * MODROWS * NMODC) + (size_t)l * MODROWS * NMODC + cg * 256 + 4 * lane;
#pragma unroll
        for (int r = 0; r < MODROWS; ++r) *(f32x4*)(op + (size_t)r * NMODC) = acc[r];
    }
    for (int m = gw; m < MT; m += NGW) { const int b = m / TB, w = m - b * TB;
        const float* src = (w < CTXL) ? A.in[2] + ((size_t)b * CTXL + w) * 1024 : A.in[0] + ((size_t)b * SEQ + (w - CTXL)) * 1024;
        const GAS f32x4* sp = (const GAS f32x4*)src + lane; GAS f32x4* dp = (GAS f32x4*)((float*)(ws + WS_X) + (size_t)m * 1024) + lane;
#pragma unroll
        for (int j = 0; j < 4; ++j) dp[64 * j] = sp[64 * j]; }
    { float* par = (float*)(ws + WS_PAR); const int gt = gw * 64 + lane, NGT = NGW * 64;
#define CPY(src, n, off) for (int i = gt; i < (n); i += NGT) par[(off) + i] = A.in[src][i];
      CPY(6, 4096, P_N1G) CPY(7, 4096, P_N2G) CPY(9, 128, P_QG) CPY(10, 128, P_KG) CPY(13, 16384, P_GKF) CPY(15, 16384, P_GKB) CPY(14, 1024, P_BGF) CPY(16, 1024, P_BGB)
      CPY(17, 512, P_OG) CPY(19, 131072, P_WR) CPY(20, 128, P_BR) CPY(22, 262144, P_BGU) CPY(24, 131072, P_BDN)
#undef CPY
    }
    for (int idx = gw * 64 + lane; idx < SEQ * 32; idx += NGW * 64) { const int s = idx >> 5, i = idx & 31;
        const float invf = 1.0f / powf(10000.0f, (float)(i & 15) * (1.0f / 16.0f));
        const float ang = (float)((i < 16) ? (s >> 6) : (s & 63)) * invf;
        ((float*)(ws + WS_ROPE))[idx] = cosf(ang); ((float*)(ws + WS_ROPE))[SEQ * 32 + idx] = sinf(ang); }
}
__device__ __forceinline__ void p1_mod_reduce(const Args& A, int gtid, int NGT) {
    const float* P = (const float*)(A.ws + WS_MODP); float* Mo = (float*)(A.ws + WS_MOD);
    constexpr int N = NLAYER * MODROWS * NMODC;
    for (int i = gtid; i < N; i += NGT) { const int l = i / (MODROWS * NMODC), c = i % NMODC; float s = A.in[5][l * NMODC + c];
#pragma unroll
        for (int k = 0; k < 16; ++k) s += P[(size_t)k * N + i];
        Mo[i] = s; }
}
__device__ __forceinline__ void modulate_row(const float* xrow, const float* ng, const float* shp, const float* scp, bf16* orow, int lane, f32x4 (&y)[4], float& rs_out) {
    const GAS f32x4* xr = (const GAS f32x4*)xrow + lane;
    float ss = 0.f;
#pragma unroll
    for (int j = 0; j < 4; ++j) { y[j] = xr[64 * j]; ss += (y[j].x * y[j].x + y[j].y * y[j].y) + (y[j].z * y[j].z + y[j].w * y[j].w); }
    const float rs = 1.0f / sqrtf(wave_sum(ss) * (1.0f / 1024.0f) + RMS_EPS); rs_out = rs;
    GAS unsigned long long* o8 = (GAS unsigned long long*)orow + lane;
#pragma unroll
    for (int j = 0; j < 4; ++j) { const f32x4 g = ((const GAS f32x4*)ng)[64 * j + lane], sh = ((const GAS f32x4*)shp)[64 * j + lane], sc = ((const GAS f32x4*)scp)[64 * j + lane];
        y[j] = (y[j] * rs) * g * (sc + 1.0f) + sh;
        o8[64 * j] = (unsigned long long)pk2(y[j].x, y[j].y) | ((unsigned long long)pk2(y[j].z, y[j].w) << 32); }
}
__device__ __forceinline__ void phase_modulate1(unsigned char* ws, int layer, int gw, int NGW, int lane) {
    const float* X = (const float*)(ws + WS_X); bf16* XN = (bf16*)(ws + WS_XN);
    const float* ng = PARF(ws) + P_N1G + layer * 1024; const float* Mo = (const float*)(ws + WS_MOD) + (size_t)layer * MODROWS * NMODC;
    for (int m = gw; m < MT; m += NGW) { const int mr = mod_row(m); f32x4 y[4]; float rs;
        modulate_row(X + (size_t)m * 1024, ng, Mo + (size_t)mr * NMODC + 0 * 1024, Mo + (size_t)mr * NMODC + 1 * 1024, XN + (size_t)m * 1024, lane, y, rs); }
}
__device__ __forceinline__ void phase_qknorm_rope(unsigned char* ws, int la, int gw, int NGW, int lane) {
    bf16* Qb = (bf16*)(ws + WS_Q); bf16* Kb = (bf16*)(ws + WS_K);
    const float* qg = PARF(ws) + P_QG + la * 64; const float* kg = PARF(ws) + P_KG + la * 64; const float* ropec = (const float*)(ws + WS_ROPE); const float* ropes = ropec + SEQ * 32;
    const int i = lane & 31, hs = lane >> 5;
    for (int m = gw; m < MT; m += NGW) { const int b = m / TB, w = m - b * TB; const bool lat = w >= CTXL;
        float cs = 1.f, sn = 0.f; if (lat) { cs = ropec[(w - CTXL) * 32 + i]; sn = ropes[(w - CTXL) * 32 + i]; }
#pragma unroll 2
        for (int hh = 0; hh < 20; hh += 2) { const int hd = hh + hs;
            unsigned* p = (hd < 16) ? (unsigned*)(Qb + (size_t)m * 1024 + hd * 64) + i : (unsigned*)(Kb + (size_t)m * 256 + (hd - 16) * 64) + i;
            const float* gp = (hd < 16) ? qg : kg; const float scl = (hd < 16) ? ATT_C2 : 1.0f;
            const unsigned v = *p; const float x1 = __uint_as_float(v << 16), x2 = __uint_as_float(v & 0xffff0000u);
            float ss = x1 * x1 + x2 * x2;
#pragma unroll
            for (int o = 1; o < 32; o <<= 1) ss += __shfl_xor(ss, o);
            const float rs = 1.0f / sqrtf(ss * (1.0f / 64.0f) + RMS_EPS);
            const float y1 = x1 * rs * gp[2 * i], y2 = x2 * rs * gp[2 * i + 1];
            const float r1 = (y1 * cs - y2 * sn) * scl, r2 = (y1 * sn + y2 * cs) * scl;
            *p = pk2(r1, r2); }
    }
}
__device__ __forceinline__ void phase_gla_recurrent(unsigned char* ws, int lg, LAS unsigned char* lds, int tid) {
    const int unit = blockIdx.x; if (unit >= 128) return;
    const int half = unit & 1, dir = (unit >> 1) & 1, h = (unit >> 2) & 3, b = unit >> 4;
    const bf16* G = (const bf16*)(ws + WS_G);
    float* Oo = (float*)(ws + (dir ? WS_OB : WS_OF));
    const float* wg = PARF(ws) + (dir ? P_GKB : P_GKF) + (size_t)lg * 16 * 512; const float* bg = PARF(ws) + (dir ? P_BGB : P_BGF) + lg * 512;
    LAS float* qq = (LAS float*)(lds + RING_OFF); LAS float* kk = qq + 64 * 128; LAS float* dd = kk + 64 * 128; LAS float* vv = dd + 64 * 128;
    const int sd = tid & 127, st0 = tid >> 7;
    float wcol[16];
#pragma unroll
    for (int r = 0; r < 16; ++r) wcol[r] = wg[r * 512 + h * 128 + sd];
    const float bcol = bg[h * 128 + sd];
    const int c = tid >> 2, dq = tid & 3;
    float s[32];
#pragma unroll
    for (int j = 0; j < 32; ++j) s[j] = 0.f;
    const float qscale = 0.08838834764831845f;
    for (int ch = 0; ch < TB / 64; ++ch) {
        __syncthreads();
#pragma unroll 4
        for (int i = 0; i < 16; ++i) { const int tt = st0 + 4 * i, n = 64 * ch + tt;
            const int w = dir ? (n < CTXL ? (CTXL - 1 - n) : (TB + CTXL - 1 - n)) : n;
            const bf16* gr = G + ((size_t)b * TB + w) * WINP;
            const float qv = bf2f(gr[h * 128 + sd]) * qscale, kv = bf2f(gr[512 + h * 128 + sd]);
            const bf16* lp = gr + 3072 + dir * 16; float z = bcol;
#pragma unroll
            for (int r = 0; r < 16; ++r) z += bf2f(lp[r]) * wcol[r];
            const float ls = fminf(z, 0.f) - log1pf(__expf(-fabsf(z)));
            qq[tt * 128 + sd] = qv; kk[tt * 128 + sd] = kv; dd[tt * 128 + sd] = __expf(ls * (1.0f / 16.0f));
            vv[tt * 128 + sd] = bf2f(gr[1024 + h * 256 + half * 128 + sd]); }
        __syncthreads();
        for (int tt = 0; tt < 64; ++tt) { const int n = 64 * ch + tt; const int w = dir ? (n < CTXL ? (CTXL - 1 - n) : (TB + CTXL - 1 - n)) : n;
            const float v = vv[tt * 128 + c]; float acc = 0.f;
            const LAS f32x4* q4 = (const LAS f32x4*)(qq + tt * 128 + dq * 32); const LAS f32x4* k4 = (const LAS f32x4*)(kk + tt * 128 + dq * 32); const LAS f32x4* d4 = (const LAS f32x4*)(dd + tt * 128 + dq * 32);
#pragma unroll
            for (int j = 0; j < 8; ++j) { const f32x4 qv = q4[j], kv = k4[j], dv = d4[j];
                s[4 * j + 0] = s[4 * j + 0] * dv.x + kv.x * v; acc += qv.x * s[4 * j + 0];
                s[4 * j + 1] = s[4 * j + 1] * dv.y + kv.y * v; acc += qv.y * s[4 * j + 1];
                s[4 * j + 2] = s[4 * j + 2] * dv.z + kv.z * v; acc += qv.z * s[4 * j + 2];
                s[4 * j + 3] = s[4 * j + 3] * dv.w + kv.w * v; acc += qv.w * s[4 * j + 3]; }
            acc += __shfl_xor(acc, 1); acc += __shfl_xor(acc, 2);
            if (dq == 0) Oo[((size_t)b * TB + w) * 1024 + h * 256 + half * 128 + c] = acc; }
    }
}
__device__ __forceinline__ void phase_gla_readout(unsigned char* ws, int lg, int gw, int NGW, int lane) {
    const float* OF = (const float*)(ws + WS_OF); const float* OB = (const float*)(ws + WS_OB); const bf16* G = (const bf16*)(ws + WS_G); bf16* OG = (bf16*)(ws + WS_Q);
    const f32x4 og = ((const GAS f32x4*)(PARF(ws) + P_OG + lg * 256))[lane];
    for (int m = gw; m < MT; m += NGW) {
#pragma unroll
        for (int hh = 0; hh < 4; ++hh) { const size_t off = (size_t)m * 1024 + hh * 256 + 4 * lane;
            f32x4 o = *(const GAS f32x4*)(OF + off) + *(const GAS f32x4*)(OB + off);
            const float ss = wave_sum((o.x * o.x + o.y * o.y) + (o.z * o.z + o.w * o.w));
            const float rs = 1.0f / sqrtf(ss * (1.0f / 256.0f) + RMS_EPS);
            const unsigned long long rv = *(const GAS unsigned long long*)(G + (size_t)m * WINP + 2048 + hh * 256 + 4 * lane);
            const float r0 = __uint_as_float((unsigned)(rv & 0xffffu) << 16), r1 = __uint_as_float((unsigned)(rv >> 16) << 16), r2 = __uint_as_float((unsigned)((rv >> 32) & 0xffffu) << 16), r3 = __uint_as_float((unsigned)(rv >> 48) << 16);
            o = o * rs * og;
            o.x *= silu_f(r0); o.y *= silu_f(r1); o.z *= silu_f(r2); o.w *= silu_f(r3);
            *(GAS unsigned long long*)(OG + off) = (unsigned long long)pk2(o.x, o.y) | ((unsigned long long)pk2(o.z, o.w) << 32); }
    }
}
constexpr size_t WS_GQ = WS_XG, WS_GKH = WS_XG + 68 * MiB, WS_GKT = WS_XG + 136 * MiB, WS_GVT = WS_XG + 204 * MiB, WS_GDL = WS_ACT, WS_SX = WS_OF;
static_assert((size_t)2176 * 2 * 16384 <= 68 * MiB && (size_t)2176 * 256 * 64 * 2 <= 68 * MiB && (size_t)64 * 68 * 65536 <= 272 * MiB, "gla buffers");
typedef float f32x16 __attribute__((ext_vector_type(16)));
__device__ __forceinline__ float log_sigmoid_fast(float z) { return fminf(z, 0.f) - __logf(1.0f + __expf(-fabsf(z))); }

__device__ __forceinline__ void phase_gla_g0(unsigned char* ws, int lg, LAS unsigned char* lds, int tid) {
    const bf16* G = (const bf16*)(ws + WS_G);
    LAS float* tot = (LAS float*)(lds + RING_OFF);
    const int d2 = tid & 63, tb = tid >> 6;
    for (int cn = blockIdx.x; cn < 2176; cn += gridDim.x) {
        const int n = cn % 68, bh = cn / 68, h = bh & 3, b = bh >> 2;
        const size_t row0 = (size_t)b * TB + 64 * n + 8 * tb;
        float wf0[16], wf1[16], wb0[16], wb1[16];
        { const float* wgf = PARF(ws) + P_GKF + (size_t)lg * 16 * 512 + h * 128 + 2 * d2; const float* wgb = PARF(ws) + P_GKB + (size_t)lg * 16 * 512 + h * 128 + 2 * d2;
#pragma unroll
          for (int r = 0; r < 16; ++r) { const f32x2 a = *(const GAS f32x2*)(wgf + r * 512), c = *(const GAS f32x2*)(wgb + r * 512); wf0[r] = a.x; wf1[r] = a.y; wb0[r] = c.x; wb1[r] = c.y; } }
        const f32x2 bf_ = *(const GAS f32x2*)(PARF(ws) + P_BGF + lg * 512 + h * 128 + 2 * d2), bb_ = *(const GAS f32x2*)(PARF(ws) + P_BGB + lg * 512 + h * 128 + 2 * d2);
        float gf0[8], gf1[8], gb0[8], gb1[8]; unsigned qk[8][2];
#pragma unroll
        for (int j = 0; j < 8; ++j) { const bf16* gr = G + (row0 + j) * WINP;
            const v4u l0 = *(const GAS v4u*)(gr + 3072), l1 = *(const GAS v4u*)(gr + 3080), l2 = *(const GAS v4u*)(gr + 3088), l3 = *(const GAS v4u*)(gr + 3096);
            qk[j][0] = *(const GAS unsigned*)(gr + h * 128 + 2 * d2); qk[j][1] = *(const GAS unsigned*)(gr + 512 + h * 128 + 2 * d2);
            float lf[16], lb[16];
            lf[0] = __uint_as_float(l0.x << 16); lf[1] = __uint_as_float(l0.x & 0xffff0000u); lf[2] = __uint_as_float(l0.y << 16); lf[3] = __uint_as_float(l0.y & 0xffff0000u);
            lf[4] = __uint_as_float(l0.z << 16); lf[5] = __uint_as_float(l0.z & 0xffff0000u); lf[6] = __uint_as_float(l0.w << 16); lf[7] = __uint_as_float(l0.w & 0xffff0000u);
            lf[8] = __uint_as_float(l1.x << 16); lf[9] = __uint_as_float(l1.x & 0xffff0000u); lf[10] = __uint_as_float(l1.y << 16); lf[11] = __uint_as_float(l1.y & 0xffff0000u);
            lf[12] = __uint_as_float(l1.z << 16); lf[13] = __uint_as_float(l1.z & 0xffff0000u); lf[14] = __uint_as_float(l1.w << 16); lf[15] = __uint_as_float(l1.w & 0xffff0000u);
            lb[0] = __uint_as_float(l2.x << 16); lb[1] = __uint_as_float(l2.x & 0xffff0000u); lb[2] = __uint_as_float(l2.y << 16); lb[3] = __uint_as_float(l2.y & 0xffff0000u);
            lb[4] = __uint_as_float(l2.z << 16); lb[5] = __uint_as_float(l2.z & 0xffff0000u); lb[6] = __uint_as_float(l2.w << 16); lb[7] = __uint_as_float(l2.w & 0xffff0000u);
            lb[8] = __uint_as_float(l3.x << 16); lb[9] = __uint_as_float(l3.x & 0xffff0000u); lb[10] = __uint_as_float(l3.y << 16); lb[11] = __uint_as_float(l3.y & 0xffff0000u);
            lb[12] = __uint_as_float(l3.z << 16); lb[13] = __uint_as_float(l3.z & 0xffff0000u); lb[14] = __uint_as_float(l3.w << 16); lb[15] = __uint_as_float(l3.w & 0xffff0000u);
            float zf0 = bf_.x, zf1 = bf_.y, zb0 = bb_.x, zb1 = bb_.y;
#pragma unroll
            for (int r = 0; r < 16; ++r) { zf0 += lf[r] * wf0[r]; zf1 += lf[r] * wf1[r]; zb0 += lb[r] * wb0[r]; zb1 += lb[r] * wb1[r]; }
            gf0[j] = log_sigmoid_fast(zf0) * 0.0625f; gf1[j] = log_sigmoid_fast(zf1) * 0.0625f; gb0[j] = log_sigmoid_fast(zb0) * 0.0625f; gb1[j] = log_sigmoid_fast(zb1) * 0.0625f; }
#pragma unroll
        for (int j = 1; j < 8; ++j) { gf0[j] += gf0[j - 1]; gf1[j] += gf1[j - 1]; gb0[7 - j] += gb0[8 - j]; gb1[7 - j] += gb1[8 - j]; }
        __syncthreads();
        *(LAS f32x2*)(tot + (0 * 8 + tb) * 128 + 2 * d2) = (f32x2){gf0[7], gf1[7]}; *(LAS f32x2*)(tot + (1 * 8 + tb) * 128 + 2 * d2) = (f32x2){gb0[0], gb1[0]};
        __syncthreads();
        float pf0 = 0.f, pf1 = 0.f, pb0 = 0.f, pb1 = 0.f, lf0 = 0.f, lf1 = 0.f, lb0 = 0.f, lb1 = 0.f;
#pragma unroll
        for (int q = 0; q < 8; ++q) { const f32x2 a = *(const LAS f32x2*)(tot + (0 * 8 + q) * 128 + 2 * d2), c = *(const LAS f32x2*)(tot + (1 * 8 + q) * 128 + 2 * d2);
            lf0 += a.x; lf1 += a.y; lb0 += c.x; lb1 += c.y;
            if (q < tb) { pf0 += a.x; pf1 += a.y; } if (q > tb) { pb0 += c.x; pb1 += c.y; } }
        const size_t itf = (size_t)cn * 2, itb = itf + 1;
        bf16* Qf = (bf16*)(ws + WS_GQ) + itf * 8192; bf16* Qb = Qf + 8192; bf16* Kf = (bf16*)(ws + WS_GKH) + itf * 8192; bf16* Kb = Kf + 8192;
        const float elf0 = __expf(lf0), elf1 = __expf(lf1), elb0 = __expf(lb0), elb1 = __expf(lb1);
        float ktf0[8], ktf1[8], ktb0[8], ktb1[8];
#pragma unroll
        for (int j = 0; j < 8; ++j) { const int t = 8 * tb + j;
            const float q0 = __uint_as_float(qk[j][0] << 16) * 0.08838834764831845f, q1 = __uint_as_float(qk[j][0] & 0xffff0000u) * 0.08838834764831845f;
            const float k0 = __uint_as_float(qk[j][1] << 16), k1 = __uint_as_float(qk[j][1] & 0xffff0000u);
            const float ef0 = __expf(pf0 + gf0[j]), ef1 = __expf(pf1 + gf1[j]), eb0 = __expf(pb0 + gb0[j]), eb1 = __expf(pb1 + gb1[j]);
            const float rf0 = __builtin_amdgcn_rcpf(ef0), rf1 = __builtin_amdgcn_rcpf(ef1), rb0 = __builtin_amdgcn_rcpf(eb0), rb1 = __builtin_amdgcn_rcpf(eb1);
            *(GAS unsigned*)(Qf + t * 128 + 2 * d2) = pk2(q0 * ef0, q1 * ef1); *(GAS unsigned*)(Qb + t * 128 + 2 * d2) = pk2(q0 * eb0, q1 * eb1);
            *(GAS unsigned*)(Kf + t * 128 + 2 * d2) = pk2(k0 * rf0, k1 * rf1); *(GAS unsigned*)(Kb + t * 128 + 2 * d2) = pk2(k0 * rb0, k1 * rb1);
            ktf0[j] = k0 * rf0 * elf0; ktf1[j] = k1 * rf1 * elf1; ktb0[j] = k0 * rb0 * elb0; ktb1[j] = k1 * rb1 * elb1; }
        { bf16* Tf = (bf16*)(ws + WS_GKT) + itf * 8192 + (size_t)(2 * d2) * 64 + 8 * tb; bf16* Tb = Tf + 8192;
          *(GAS v4u*)Tf = (v4u){pk2(ktf0[0], ktf0[1]), pk2(ktf0[2], ktf0[3]), pk2(ktf0[4], ktf0[5]), pk2(ktf0[6], ktf0[7])};
          *(GAS v4u*)(Tf + 64) = (v4u){pk2(ktf1[0], ktf1[1]), pk2(ktf1[2], ktf1[3]), pk2(ktf1[4], ktf1[5]), pk2(ktf1[6], ktf1[7])};
          *(GAS v4u*)Tb = (v4u){pk2(ktb0[0], ktb0[1]), pk2(ktb0[2], ktb0[3]), pk2(ktb0[4], ktb0[5]), pk2(ktb0[6], ktb0[7])};
          *(GAS v4u*)(Tb + 64) = (v4u){pk2(ktb1[0], ktb1[1]), pk2(ktb1[2], ktb1[3]), pk2(ktb1[4], ktb1[5]), pk2(ktb1[6], ktb1[7])}; }
        if (tb == 0) { float* DLp = (float*)(ws + WS_GDL) + itf * 128 + 2 * d2; *(GAS f32x2*)DLp = (f32x2){elf0, elf1}; *(GAS f32x2*)(DLp + 128) = (f32x2){elb0, elb1}; }
        {
            const int dv = tid & 255, th = tid >> 8; const bf16* vp = G + ((size_t)b * TB + 64 * n + 32 * th) * WINP + 1024 + h * 256 + dv;
            unsigned wv[16];
#pragma unroll
            for (int j = 0; j < 16; ++j) wv[j] = (unsigned)vp[(size_t)(2 * j) * WINP] | ((unsigned)vp[(size_t)(2 * j + 1) * WINP] << 16);
            GAS v4u* op = (GAS v4u*)((bf16*)(ws + WS_GVT) + ((size_t)cn * 256 + dv) * 64 + 32 * th);
            op[0] = (v4u){wv[0], wv[1], wv[2], wv[3]}; op[1] = (v4u){wv[4], wv[5], wv[6], wv[7]}; op[2] = (v4u){wv[8], wv[9], wv[10], wv[11]}; op[3] = (v4u){wv[12], wv[13], wv[14], wv[15]}; }
    }
}
struct G12Ops { bf16x8 a[4], b[4]; f32x4 d[4]; };
__device__ __forceinline__ void g12_load(G12Ops& o, unsigned char* ws, int bh, int dir, int m, int kb, int vb, int r, int hh) {
    const int n = dir ? (m < 4 ? 3 - m : 71 - m) : m; const size_t cn = (size_t)bh * 68 + n, item = cn * 2 + dir;
    const bf16* ap = (const bf16*)(ws + WS_GKT) + item * 8192 + (size_t)(32 * kb + r) * 64 + 8 * hh;
    const bf16* bp = (const bf16*)(ws + WS_GVT) + (cn * 256 + 32 * vb + r) * 64 + 8 * hh;
    const float* dp = (const float*)(ws + WS_GDL) + item * 128 + 32 * kb + 4 * hh;
#pragma unroll
    for (int ks = 0; ks < 4; ++ks) { o.a[ks] = *(const GAS bf16x8*)(ap + 16 * ks); o.b[ks] = *(const GAS bf16x8*)(bp + 16 * ks); o.d[ks] = *(const GAS f32x4*)(dp + 8 * ks); }
}
__device__ __forceinline__ void phase_gla_g12(unsigned char* ws, LAS unsigned char* lds, int gwv, int wave, int lane) {
    if (gwv >= 2048) return;
    const int chain = gwv >> 5, blk = gwv & 31, kb = blk & 3, vb = blk >> 2, dir = chain & 1, bh = chain >> 1;
    const int r = lane & 31, hh = lane >> 5;
    LAS unsigned char* wl = lds + RING_OFF + wave * 2048;
    f32x16 acc;
#pragma unroll
    for (int g = 0; g < 16; ++g) acc[g] = 0.f;
    G12Ops cur, nxt;
    g12_load(cur, ws, bh, dir, 0, kb, vb, r, hh);
    for (int m = 0; m < 68; ++m) {
        const int n = dir ? (m < 4 ? 3 - m : 71 - m) : m;
        if (m + 1 < 68) g12_load(nxt, ws, bh, dir, m + 1, kb, vb, r, hh); else nxt = cur;
#pragma unroll
        for (int gg = 0; gg < 4; ++gg) *(LAS unsigned long long*)(wl + r * 64 + 16 * gg + 8 * hh) = (unsigned long long)pk2(acc[4 * gg], acc[4 * gg + 1]) | ((unsigned long long)pk2(acc[4 * gg + 2], acc[4 * gg + 3]) << 32);
        LDS_WAIT();
        const v4u s0 = *(const LAS v4u*)(wl + lane * 16), s1 = *(const LAS v4u*)(wl + 1024 + lane * 16);
        LDS_WAIT();
        { bf16* sp = (bf16*)(ws + WS_SX) + ((size_t)(bh * 2 + dir) * 68 + n) * 32768 + (size_t)(kb * 8 + vb) * 1024; ((GAS v4u*)sp)[lane] = s0; ((GAS v4u*)sp)[64 + lane] = s1; }
#pragma unroll
        for (int gg = 0; gg < 4; ++gg) { acc[4 * gg] *= cur.d[gg].x; acc[4 * gg + 1] *= cur.d[gg].y; acc[4 * gg + 2] *= cur.d[gg].z; acc[4 * gg + 3] *= cur.d[gg].w; }
#pragma unroll
        for (int ks = 0; ks < 4; ++ks) acc = __builtin_amdgcn_mfma_f32_32x32x16_bf16(cur.a[ks], cur.b[ks], acc, 0, 0, 0);
        cur = nxt;
    }
}
constexpr int G3_RS = 272, G3_TILE = 64 * G3_RS, G3_OL = 4 * G3_TILE  , G3_LD = 260;
static_assert(G3_OL + 64 * G3_LD * 4 <= MISC_OFF, "G3 LDS");
__device__ __forceinline__ void phase_gla_g3(unsigned char* ws, int lg, LAS unsigned char* lds, int tid) {
    const int lane = tid & 63, wave = __builtin_amdgcn_readfirstlane(tid >> 6), r = lane & 31, hh = lane >> 5, vb = wave;
    LAS unsigned char* TL = lds + RING_OFF; LAS float* OL = (LAS float*)(lds + RING_OFF + G3_OL);
    const bf16* G = (const bf16*)(ws + WS_G); bf16* OG = (bf16*)(ws + WS_Q);
    for (int cn = blockIdx.x; cn < 2176; cn += gridDim.x) {
        const int n = cn % 68, bh = cn / 68, h = bh & 3, b = bh >> 2;
        v4u st[4][2];
#pragma unroll
        for (int tl = 0; tl < 4; ++tl) { const bf16* src = (const bf16*)(ws + ((tl & 1) ? WS_GKH : WS_GQ)) + ((size_t)cn * 2 + (tl >> 1)) * 8192;
#pragma unroll
            for (int j = 0; j < 2; ++j) st[tl][j] = ((const GAS v4u*)src)[tid + 512 * j]; }
        __syncthreads();
#pragma unroll
        for (int tl = 0; tl < 4; ++tl)
#pragma unroll
            for (int j = 0; j < 2; ++j) { const int q = tid + 512 * j, row = q >> 4, ch = q & 15; *(LAS v4u*)(TL + tl * G3_TILE + row * G3_RS + ch * 16) = st[tl][j]; }
        __syncthreads();
        f32x16 P00, P01, P10, P11, O0, O1;
#pragma unroll
        for (int g = 0; g < 16; ++g) { P00[g] = 0.f; P01[g] = 0.f; P10[g] = 0.f; P11[g] = 0.f; O0[g] = 0.f; O1[g] = 0.f; }
#pragma unroll
        for (int dir = 0; dir < 2; ++dir) {
            const LAS unsigned char* Qt = TL + (2 * dir) * G3_TILE + r * G3_RS + 16 * hh; const LAS unsigned char* Kh = TL + (2 * dir + 1) * G3_TILE + r * G3_RS + 16 * hh;
            const bf16* Sx = (const bf16*)(ws + WS_SX) + ((size_t)(bh * 2 + dir) * 68 + n) * 32768 + (size_t)vb * 1024 + r * 32 + 8 * hh;
            f32x16 X00, X11, Xoff;
#pragma unroll
            for (int g = 0; g < 16; ++g) { X00[g] = 0.f; X11[g] = 0.f; Xoff[g] = 0.f; }
#pragma unroll
            for (int s = 0; s < 8; ++s) {
                const bf16x8 q0 = *(const LAS bf16x8*)(Qt + 32 * s), q1 = *(const LAS bf16x8*)(Qt + 32 * G3_RS + 32 * s);
                const bf16x8 k0 = *(const LAS bf16x8*)(Kh + 32 * s), k1 = *(const LAS bf16x8*)(Kh + 32 * G3_RS + 32 * s);
                const bf16x8 sx = *(const GAS bf16x8*)(Sx + (s >> 1) * 8192 + 16 * (s & 1));
                X00 = __builtin_amdgcn_mfma_f32_32x32x16_bf16(k0, q0, X00, 0, 0, 0);
                X11 = __builtin_amdgcn_mfma_f32_32x32x16_bf16(k1, q1, X11, 0, 0, 0);
                if (dir == 0) Xoff = __builtin_amdgcn_mfma_f32_32x32x16_bf16(k0, q1, Xoff, 0, 0, 0); else Xoff = __builtin_amdgcn_mfma_f32_32x32x16_bf16(k1, q0, Xoff, 0, 0, 0);
                O0 = __builtin_amdgcn_mfma_f32_32x32x16_bf16(q0, sx, O0, 0, 0, 0); O1 = __builtin_amdgcn_mfma_f32_32x32x16_bf16(q1, sx, O1, 0, 0, 0); }
#pragma unroll
            for (int g = 0; g < 16; ++g) { const int tj = (g & 3) + 8 * (g >> 2) + 4 * hh; const bool keep = dir ? (tj >= r) : (tj <= r);
                P00[g] += keep ? X00[g] : 0.f; P11[g] += keep ? X11[g] : 0.f;
                if (dir == 0) P01[g] += Xoff[g]; else P10[g] += Xoff[g]; }
        }
        { const bf16* Vt = (const bf16*)(ws + WS_GVT) + ((size_t)cn * 256 + 32 * vb + r) * 64 + 4 * hh;
#pragma unroll
          for (int jb = 0; jb < 2; ++jb)
#pragma unroll
            for (int s2 = 0; s2 < 2; ++s2) { const bf16* vp = Vt + 32 * jb + 16 * s2;
                const unsigned long long lo = *(const GAS unsigned long long*)vp, hi8 = *(const GAS unsigned long long*)(vp + 8);
                const bf16x8 bfv = __builtin_bit_cast(bf16x8, ((v4u){(unsigned)lo, (unsigned)(lo >> 32), (unsigned)hi8, (unsigned)(hi8 >> 32)}));
                const f32x16& Pa = jb ? P10 : P00; const f32x16& Pb = jb ? P11 : P01;
                const bf16x8 a0 = __builtin_bit_cast(bf16x8, ((v4u){pk2(Pa[8 * s2 + 0], Pa[8 * s2 + 1]), pk2(Pa[8 * s2 + 2], Pa[8 * s2 + 3]), pk2(Pa[8 * s2 + 4], Pa[8 * s2 + 5]), pk2(Pa[8 * s2 + 6], Pa[8 * s2 + 7])}));
                const bf16x8 a1 = __builtin_bit_cast(bf16x8, ((v4u){pk2(Pb[8 * s2 + 0], Pb[8 * s2 + 1]), pk2(Pb[8 * s2 + 2], Pb[8 * s2 + 3]), pk2(Pb[8 * s2 + 4], Pb[8 * s2 + 5]), pk2(Pb[8 * s2 + 6], Pb[8 * s2 + 7])}));
                O0 = __builtin_amdgcn_mfma_f32_32x32x16_bf16(a0, bfv, O0, 0, 0, 0); O1 = __builtin_amdgcn_mfma_f32_32x32x16_bf16(a1, bfv, O1, 0, 0, 0); } }
#pragma unroll
        for (int g = 0; g < 16; ++g) { const int t = (g & 3) + 8 * (g >> 2) + 4 * hh; OL[t * G3_LD + 32 * vb + r] = O0[g]; OL[(32 + t) * G3_LD + 32 * vb + r] = O1[g]; }
        __syncthreads();
        { const int t = tid >> 3, cc = tid & 7; const LAS f32x4* op = (const LAS f32x4*)(OL + t * G3_LD + 32 * cc);
          f32x4 o[8]; float ss = 0.f;
#pragma unroll
          for (int j = 0; j < 8; ++j) { o[j] = op[j]; ss += (o[j].x * o[j].x + o[j].y * o[j].y) + (o[j].z * o[j].z + o[j].w * o[j].w); }
          ss += __shfl_xor(ss, 1); ss += __shfl_xor(ss, 2); ss += __shfl_xor(ss, 4);
          const float rs = 1.0f / sqrtf(ss * (1.0f / 256.0f) + RMS_EPS);
          const size_t row = (size_t)b * TB + 64 * n + t;
          const GAS v4u* rp = (const GAS v4u*)(G + row * WINP + 2048 + h * 256 + 32 * cc); const GAS f32x4* gp = (const GAS f32x4*)(PARF(ws) + P_OG + lg * 256 + 32 * cc);
          GAS v4u* dst = (GAS v4u*)(OG + row * 1024 + h * 256 + 32 * cc);
#pragma unroll
          for (int j = 0; j < 4; ++j) { const v4u rv = rp[j]; const f32x4 g0 = gp[2 * j], g1 = gp[2 * j + 1]; const f32x4 a = o[2 * j] * rs * g0, c2 = o[2 * j + 1] * rs * g1;
              v4u w;
              w.x = pk2(a.x * silu_f(__uint_as_float(rv.x << 16)), a.y * silu_f(__uint_as_float(rv.x & 0xffff0000u)));
              w.y = pk2(a.z * silu_f(__uint_as_float(rv.y << 16)), a.w * silu_f(__uint_as_float(rv.y & 0xffff0000u)));
              w.z = pk2(c2.x * silu_f(__uint_as_float(rv.z << 16)), c2.y * silu_f(__uint_as_float(rv.z & 0xffff0000u)));
              w.w = pk2(c2.z * silu_f(__uint_as_float(rv.w << 16)), c2.w * silu_f(__uint_as_float(rv.w & 0xffff0000u)));
              dst[j] = w; } }
    }
}
constexpr int WIMG_RS = 2064;
static_assert(2 * 32 * WIMG_RS <= LDS_AUX, "router images below the aux tables");
__device__ __forceinline__ void phase_modulate2_route(unsigned char* ws, int layer, LAS unsigned char* lds, int vcu, int wave, int lane, int tid, bool dummy = false) {
    const float* X = (const float*)(ws + WS_X); bf16* XN = (bf16*)(ws + WS_XN);
    const float* ng = PARF(ws) + P_N2G + layer * 1024; const float* Mo = (const float*)(ws + WS_MOD) + (size_t)layer * MODROWS * NMODC;
    LAS unsigned char* WHI = lds + RING_OFF; LAS unsigned char* WLO = WHI + 32 * WIMG_RS;
    LAS unsigned* lcnt = (LAS unsigned*)(lds + AUX_LCNT); LAS unsigned* gb = (LAS unsigned*)(lds + AUX_GB); LAS unsigned* ent = (LAS unsigned*)(lds + AUX_ENT); LAS float* rsl = (LAS float*)(lds + AUX_RS);
    { const float* wsrc = PARF(ws) + P_WR + (size_t)layer * 1024 * 32;
      for (int idx = tid; idx < 1024 * 32; idx += NWAVES * 64) { const int k = idx >> 5, e = idx & 31; const float w = wsrc[idx]; const unsigned hi = f2bf(w), lo = f2bf(w - __uint_as_float(hi << 16));
          *(LAS unsigned short*)(WHI + e * WIMG_RS + 2 * k) = (unsigned short)hi; *(LAS unsigned short*)(WLO + e * WIMG_RS + 2 * k) = (unsigned short)lo; }
      if (tid < 32) lcnt[tid] = 0u; }
    gu32* cnt = (gu32*)(ws + WS_CTL) + CW_CNT + (layer + (dummy ? 4 : 0)) * 32 * 16;
    unsigned char* sbase = dummy ? ws + WS_XG : ws;
    const bool lastl = (layer == NLAYER - 1);
  for (int grp = vcu; grp < MT / 136; grp += (int)gridDim.x) {
    const int rbase = grp * 136;
    if (grp != vcu) { __syncthreads(); if (tid < 32) lcnt[tid] = 0u; }
    for (int rl = wave; rl < 136; rl += NWAVES) { const int m = rbase + rl, mr = mod_row(m);
        if (lastl && mr == 8) { if (lane == 0) rsl[rl] = 0.f; continue; }
        f32x4 y[4]; float rs;
        modulate_row(X + (size_t)m * 1024, ng, Mo + (size_t)mr * NMODC + 3 * 1024, Mo + (size_t)mr * NMODC + 4 * 1024, XN + (size_t)m * 1024, lane, y, rs);
        if (lane == 0) rsl[rl] = rs; }
    __syncthreads();
    if (wave < 5) {
        const int r = lane & 31, hh = lane >> 5; const int rl = (32 * wave + r < 136) ? 32 * wave + r : 135; const int m = rbase + rl, mr = mod_row(m);
        const float rsr = rsl[rl];
        const float* xp = X + (size_t)m * 1024 + 8 * hh; const float* gp = ng + 8 * hh; const float* scp = Mo + (size_t)mr * NMODC + 4 * 1024 + 8 * hh; const float* shp = Mo + (size_t)mr * NMODC + 3 * 1024 + 8 * hh;
        const LAS unsigned char* wh = WHI + r * WIMG_RS + 16 * hh; const LAS unsigned char* wl = WLO + r * WIMG_RS + 16 * hh;
        f32x16 acc;
#pragma unroll
        for (int g = 0; g < 16; ++g) acc[g] = 0.f;
#pragma unroll 2
        for (int s = 0; s < 64; ++s) {
            const f32x4 x0 = *(const GAS f32x4*)(xp + 16 * s), x1 = *(const GAS f32x4*)(xp + 16 * s + 4), g0 = *(const GAS f32x4*)(gp + 16 * s), g1 = *(const GAS f32x4*)(gp + 16 * s + 4);
            const f32x4 c0 = *(const GAS f32x4*)(scp + 16 * s), c1 = *(const GAS f32x4*)(scp + 16 * s + 4), h0 = *(const GAS f32x4*)(shp + 16 * s), h1 = *(const GAS f32x4*)(shp + 16 * s + 4);
            const f32x4 y0 = (x0 * rsr) * g0 * (c0 + 1.0f) + h0, y1 = (x1 * rsr) * g1 * (c1 + 1.0f) + h1;
            v4u ph, pl;
            ph.x = pg8::cvt_pk_bf16(y0.x, y0.y); ph.y = pg8::cvt_pk_bf16(y0.z, y0.w); ph.z = pg8::cvt_pk_bf16(y1.x, y1.y); ph.w = pg8::cvt_pk_bf16(y1.z, y1.w);
            pl.x = pg8::cvt_pk_bf16(y0.x - __uint_as_float(ph.x << 16), y0.y - __uint_as_float(ph.x & 0xffff0000u)); pl.y = pg8::cvt_pk_bf16(y0.z - __uint_as_float(ph.y << 16), y0.w - __uint_as_float(ph.y & 0xffff0000u));
            pl.z = pg8::cvt_pk_bf16(y1.x - __uint_as_float(ph.z << 16), y1.y - __uint_as_float(ph.z & 0xffff0000u)); pl.w = pg8::cvt_pk_bf16(y1.z - __uint_as_float(ph.w << 16), y1.w - __uint_as_float(ph.w & 0xffff0000u));
            const bf16x8 ahi = __builtin_bit_cast(bf16x8, ph), alo = __builtin_bit_cast(bf16x8, pl);
            const bf16x8 bhi = *(const LAS bf16x8*)(wh + 32 * s), blo = *(const LAS bf16x8*)(wl + 32 * s);
            acc = __builtin_amdgcn_mfma_f32_32x32x16_bf16(ahi, bhi, acc, 0, 0, 0); acc = __builtin_amdgcn_mfma_f32_32x32x16_bf16(alo, bhi, acc, 0, 0, 0); acc = __builtin_amdgcn_mfma_f32_32x32x16_bf16(ahi, blo, acc, 0, 0, 0); }
        const float brt = (PARF(ws) + P_BR)[layer * 32 + r];
#pragma unroll
        for (int g = 0; g < 16; ++g) { const int rowl = 32 * wave + (g & 3) + 8 * (g >> 2) + 4 * hh;
            float v = acc[g] + brt; float tv[4]; int te[4];
#pragma unroll
            for (int k = 0; k < 4; ++k) { float mx = v;
#pragma unroll
                for (int o = 1; o < 32; o <<= 1) mx = fmaxf(mx, __shfl_xor(mx, o));
                const unsigned long long bm = __ballot(v == mx); const unsigned hm = hh ? (unsigned)(bm >> 32) : (unsigned)bm; const int first = __ffs((int)hm) - 1;
                te[k] = first; tv[k] = mx; if (r == first) v = -INFINITY; }
            const bool valid = rowl < 136 && !(lastl && mod_row(rbase + (rowl < 136 ? rowl : 135)) == 8);
            if (r == 0 && rowl < 136) {
                if (valid) { const float e1 = __expf(tv[1] - tv[0]), e2 = __expf(tv[2] - tv[0]), e3 = __expf(tv[3] - tv[0]); const float inv = 1.0f / (1.0f + e1 + e2 + e3);
                    const float wk[4] = {inv, e1 * inv, e2 * inv, e3 * inv};
#pragma unroll
                    for (int k = 0; k < 4; ++k) { const unsigned lp = atomicAdd((unsigned*)&lcnt[te[k]], 1u); ent[(rowl * 4 + k) * 2 + 0] = ((unsigned)te[k] << 24) | lp; ent[(rowl * 4 + k) * 2 + 1] = __float_as_uint(wk[k]); } }
                else {
#pragma unroll
                    for (int k = 0; k < 4; ++k) ent[(rowl * 4 + k) * 2 + 0] = 0xffffffffu; } } }
    }
    __syncthreads();
    if (tid < 32) gb[tid] = __hip_atomic_fetch_add(cnt + tid * 16, lcnt[tid], __ATOMIC_RELAXED, __HIP_MEMORY_SCOPE_AGENT);
    __syncthreads();
    for (int q = tid; q < 136 * 4; q += NWAVES * 64) { const unsigned pe = ent[q * 2 + 0];
        if (pe != 0xffffffffu) { const unsigned e = pe >> 24, lp = pe & 0xffffffu; const int m = rbase + (q >> 2);
            ((unsigned*)(sbase + WS_SLOT))[m * 4 + (q & 3)] = (e << 24) | (gb[e] + lp); ((unsigned*)(sbase + WS_GATEW))[m * 4 + (q & 3)] = ent[q * 2 + 1];
            if (!dummy) ((int*)(ws + WS_LIST))[(size_t)e * MT + gb[e] + lp] = m; } }
  }
}
__device__ __forceinline__ void build_expert_tables(unsigned char* ws, int layer, LAS unsigned char* lds, int tid) {
    LAS int* t2e = (LAS int*)(lds + AUX_T2E); LAS int* base = (LAS int*)(lds + AUX_BASE); LAS int* ntp = (LAS int*)(lds + AUX_NT); LAS int* cntl = (LAS int*)(lds + AUX_CNT);
    gu32* cnt = (gu32*)(ws + WS_CTL) + CW_CNT + layer * 32 * 16;
    __syncthreads();
    if (tid < 64) { const unsigned cval = (tid < 32) ? __hip_atomic_load(cnt + tid * 16, RLX_AGENT) : 0u; const int tiles = (int)((cval + 255u) >> 8);
        int pre = tiles;
#pragma unroll
        for (int o = 1; o < 32; o <<= 1) { const int t = __shfl_up(pre, o); if ((tid & 63) >= o) pre += t; }
        const int start = pre - tiles;
        if (tid < 32) { base[tid] = start * 256; cntl[tid] = (int)cval; for (int t = 0; t < tiles; ++t) t2e[start + t] = tid; if (tid == 31) ntp[0] = pre; } }
    __syncthreads();
}
__device__ __forceinline__ void phase_moe_gather(unsigned char* ws, int layer, LAS unsigned char* lds, int gw, int NGW, int lane, int tid) {
    build_expert_tables(ws, layer, lds, tid);
    const LAS int* base = (const LAS int*)(lds + AUX_BASE);
    const bf16* XN = (const bf16*)(ws + WS_XN); bf16* XG = (bf16*)(ws + WS_XG);
    const unsigned* slot = (const unsigned*)(ws + WS_SLOT); unsigned* spos = (unsigned*)(ws + WS_SLOTPOS);
    for (int m = gw; m < MT; m += NGW) {
        if (layer == NLAYER - 1 && mod_row(m) == 8) continue;
        const GAS v4u* src = (const GAS v4u*)(XN + (size_t)m * 1024) + lane; const v4u a = src[0], b = src[64];
#pragma unroll
        for (int k = 0; k < 4; ++k) { const unsigned pe = slot[m * 4 + k]; const int dst = base[pe >> 24] + (int)(pe & 0xffffffu);
            GAS v4u* dp = (GAS v4u*)(XG + (size_t)dst * 1024) + lane; dp[0] = a; dp[64] = b;
            if (lane == 0) spos[m * 4 + k] = (unsigned)dst; }
    }
}
__device__ __forceinline__ void phase_moe_combine(unsigned char* ws, float* out, int layer, LAS unsigned char* lds, int gw, int NGW, int lane, int tid, bool dummy = false) {
    build_expert_tables(ws, layer, lds, tid);
    const LAS int* base = (const LAS int*)(lds + AUX_BASE);
    float* X = (float*)(ws + WS_X); const bf16* Y = (const bf16*)(ws + WS_Y);
    const float* Mo = (const float*)(ws + WS_MOD) + (size_t)layer * MODROWS * NMODC;
    const unsigned* slot = (const unsigned*)(ws + WS_SLOT); const float* gw4 = (const float*)(ws + WS_GATEW);
    for (int m = gw; m < MT; m += NGW) { const int b = m / TB, w = m - b * TB; const int mr = (w < CTXL) ? 8 : b;
        if (layer == NLAYER - 1 && w < CTXL) continue;
        f32x4 f[4];
#pragma unroll
        for (int j = 0; j < 4; ++j) f[j] = (f32x4){0.f, 0.f, 0.f, 0.f};
#pragma unroll
        for (int k = 0; k < 4; ++k) { const unsigned pe = slot[m * 4 + k]; const unsigned sp = (unsigned)base[pe >> 24] + (pe & 0xffffffu); const float wk = gw4[m * 4 + k];
            const GAS unsigned long long* yp = (const GAS unsigned long long*)(Y + (size_t)sp * 1024) + lane;
#pragma unroll
            for (int j = 0; j < 4; ++j) { const unsigned long long v = yp[64 * j];
                f[j].x += wk * __uint_as_float((unsigned)(v & 0xffffu) << 16); f[j].y += wk * __uint_as_float((unsigned)(v >> 16) << 16);
                f[j].z += wk * __uint_as_float((unsigned)((v >> 32) & 0xffffu) << 16); f[j].w += wk * __uint_as_float((unsigned)(v >> 48) << 16); } }
        GAS f32x4* xp = (GAS f32x4*)(X + (size_t)m * 1024) + lane; const GAS f32x4* gp = (const GAS f32x4*)(Mo + (size_t)mr * NMODC + 5 * 1024) + lane;
        GAS f32x4* op = dummy ? (GAS f32x4*)((float*)(ws + WS_XG) + (size_t)m * 1024) + lane : (layer == NLAYER - 1) ? (GAS f32x4*)(out + ((size_t)b * SEQ + (w - CTXL)) * 1024) + lane : xp;
        float ss = 0.f;
#pragma unroll
        for (int j = 0; j < 4; ++j) { f[j] = xp[64 * j] + gp[64 * j] * f[j]; op[64 * j] = f[j]; ss += (f[j].x * f[j].x + f[j].y * f[j].y) + (f[j].z * f[j].z + f[j].w * f[j].w); }
        if (layer < NLAYER - 1 && !dummy) {
            const float rs = 1.0f / sqrtf(wave_sum(ss) * (1.0f / 1024.0f) + RMS_EPS);
            const float* ng = PARF(ws) + P_N1G + (layer + 1) * 1024; const float* Mn = (const float*)(ws + WS_MOD) + (size_t)(layer + 1) * MODROWS * NMODC + (size_t)mr * NMODC;
            GAS unsigned long long* o8 = (GAS unsigned long long*)((bf16*)(ws + WS_XN) + (size_t)m * 1024) + lane;
#pragma unroll
            for (int j = 0; j < 4; ++j) { const f32x4 g = ((const GAS f32x4*)ng)[64 * j + lane], sh = ((const GAS f32x4*)Mn)[64 * j + lane], sc = ((const GAS f32x4*)(Mn + 1024))[64 * j + lane];
                const f32x4 y = (f[j] * rs) * g * (sc + 1.0f) + sh;
                o8[64 * j] = (unsigned long long)pk2(y.x, y.y) | ((unsigned long long)pk2(y.z, y.w) << 32); } }
    }
}

constexpr int NPH_L = 11, NPHASE = 2 + NPH_L * NLAYER;
#ifndef PHMASK
#define PHMASK 0x7fff
#endif
#define EN(b) ((PHMASK >> (b)) & 1)
#ifndef DUPMASK
#define DUPMASK 0
#endif
#define DUP(b) for (int rep_ = 0; rep_ < (((DUPMASK >> (b)) & 1) ? 2 : 1); ++rep_)
__global__ void __launch_bounds__(NWAVES * 64, 2) dit_fwd(Args args) {
    extern __shared__ __attribute__((aligned(16))) unsigned char lds_raw[];
    LAS unsigned char* lds = (LAS unsigned char*)lds_raw;
    volatile LAS unsigned* MISC = (volatile LAS unsigned*)(lds + MISC_OFF);
    const int G = gridDim.x, bx = blockIdx.x;
    const int vcu = (G % 8 == 0) ? (bx % 8) * (G / 8) + bx / 8 : bx;
    { const int t0 = threadIdx.x; for (int u = t0; u < (LDS_BYTES - MISC_OFF) / 4; u += NWAVES * 64) ((LAS unsigned*)(lds + MISC_OFF))[u] = 0u; }
    __syncthreads();
    const int lo = args.ph_lo, hi = args.ph_hi;
    XcdBarrier bar; bar.bar = (unsigned*)(args.ws + WS_CTL) + CW_BAR; bar.x = 0; bar.st = nullptr;
    if (hi - lo > 1) bar = xcd_barrier_post((unsigned*)(args.ws + WS_CTL) + CW_BAR, MISC + 8);
#define IN(k) (lo <= (k) && (k) < hi)
#define SEAM(k) do { if (IN(k) && IN((k) + 1)) xcd_barrier(bar); } while (0)
#define PHASE_IDS() int tid = threadIdx.x; LAUNDER_V(tid); const int lane = tid & 63, wave = __builtin_amdgcn_readfirstlane(tid >> 6); const int gw = vcu * NWAVES + wave, NGW = G * NWAVES; \
    unsigned zoff_ = 0u; LAUNDER_S(zoff_); unsigned char* ws = args.ws + zoff_; (void)lane; (void)gw; (void)NGW;

    if (EN(0) && IN(0)) DUP(0) { PHASE_IDS(); p0_prologue(args, lds, gw, NGW, wave, lane); } SEAM(0);
    if (EN(1) && IN(1)) { PHASE_IDS(); p1_mod_reduce(args, gw * 64 + lane, NGW * 64); } SEAM(1);

    for (int layer = 0; layer < NLAYER; ++layer) {
        const int pb = 2 + NPH_L * layer, lh = layer >> 1;
        if (layer == 0) { if (EN(2) && IN(pb + 0)) DUP(2) { PHASE_IDS(); phase_modulate1(ws, layer, gw, NGW, lane); } SEAM(pb + 0); }
        if ((layer & 1) == 0) {
            if (EN(3) && IN(pb + 1)) DUP(3) {
                PHASE_IDS();
                pg8::Gemm g{(const pg8::bf16_t*)(ws + WS_XN), (const pg8::bf16_t*)(ws + WS_WQKV) + (size_t)lh * QKVN * 1024, MT, QKVN, 1024, 0};
                pg8::StaticOrder S; S.init(MT, QKVN, G, bx);
                pg8::EpiQKV E{ws, WS_Q, WS_K - WS_Q, WS_V - WS_K};
                pg8::gemm_phase<pg8::EpiQKV, pg8::StaticOrder, true, true>(lds + RING_OFF, g, S, E);
            } SEAM(pb + 1);
            if (EN(4) && IN(pb + 2)) { PHASE_IDS(); phase_qknorm_rope(ws, lh, gw, NGW, lane); } SEAM(pb + 2);
            if (EN(5) && IN(pb + 3)) DUP(5) {
                PHASE_IDS();
                const attn_body::bf16* Qp = (const attn_body::bf16*)(ws + WS_Q); const attn_body::bf16* Kp = (const attn_body::bf16*)(ws + WS_K); const attn_body::bf16* Vp = (const attn_body::bf16*)(ws + WS_V);
                attn_body::bf16* Op = (attn_body::bf16*)(ws + WS_XN);
                if (G == 256) {
                    for (int i = 0; i < 9; ++i) {
                        long qrow0, kvrow0; int NT, h;
                        if (i < 8) { const int x = vcu >> 5, j = vcu & 31, pair = 4 * x + (i >> 1), wi = (i & 1) * 32 + j, hq = wi >> 4, qb = wi & 15, b = pair >> 2, hk = pair & 3;
                            h = hk * 4 + hq; qrow0 = (long)b * TB + CTXL + qb * 256; kvrow0 = (long)b * TB; NT = TB / 64; }
                        else { if (vcu >= 128) break; const int b = vcu >> 4; h = vcu & 15; qrow0 = (long)b * TB; kvrow0 = qrow0; NT = CTXL / 64; }
                        attn_body::attn_unit<8>(qrow0, kvrow0, NT, h, Qp, Kp, Vp, Op, (char*)lds_raw + RING_OFF);
                    }
                } else {
                    for (int U = bx; U < 2048 + 128; U += G) {
                        long qrow0, kvrow0; int NT, h;
                        if (U < 2048) { const int pair = U >> 6, wi = U & 63, hq = wi >> 4, qb = wi & 15, b = pair >> 2, hk = pair & 3; h = hk * 4 + hq; qrow0 = (long)b * TB + CTXL + qb * 256; kvrow0 = (long)b * TB; NT = TB / 64; }
                        else { const int v = U - 2048, b = v >> 4; h = v & 15; qrow0 = (long)b * TB; kvrow0 = qrow0; NT = CTXL / 64; }
                        attn_body::attn_unit<8>(qrow0, kvrow0, NT, h, Qp, Kp, Vp, Op, (char*)lds_raw + RING_OFF);
                    }
                }
            } SEAM(pb + 3);
        } else {
            if (EN(6) && IN(pb + 1)) DUP(6) {
                PHASE_IDS();
                pg8::Gemm g{(const pg8::bf16_t*)(ws + WS_XN), (const pg8::bf16_t*)(ws + WS_WIN) + (size_t)lh * WINP * 1024, MT, WINP, 1024, 0};
                pg8::StaticOrder S; S.init(MT, WINP, G, bx);
                pg8::EpiBf16 E{(pg8::bf16_t*)(ws + WS_G), WINP};
                pg8::gemm_phase<pg8::EpiBf16, pg8::StaticOrder, true, true>(lds + RING_OFF, g, S, E);
            } SEAM(pb + 1);
            if (EN(7) && IN(pb + 2)) DUP(7) { PHASE_IDS(); phase_gla_g0(ws, lh, lds, tid); } SEAM(pb + 2);
            if (EN(8) && IN(pb + 3)) DUP(8) { PHASE_IDS(); phase_gla_g12(ws, lds, gw, wave, lane); } SEAM(pb + 3);
            if (EN(8) && IN(pb + 4)) DUP(9) { PHASE_IDS(); phase_gla_g3(ws, lh, lds, tid); } SEAM(pb + 4);
        }
        if (EN(9) && IN(pb + 5)) {
            PHASE_IDS();
            const pg8::bf16_t* Wt = (layer & 1) ? (const pg8::bf16_t*)(ws + WS_WOG) + (size_t)lh * 1024 * 1024 : (const pg8::bf16_t*)(ws + WS_WOA) + (size_t)lh * 1024 * 1024;
            pg8::Gemm g{(const pg8::bf16_t*)(ws + ((layer & 1) ? WS_Q : WS_XN)), Wt, MT, 1024, 1024, 0};
            pg8::StaticOrder S; S.init(MT, 1024, G, bx);
            pg8::EpiResGate E{(float*)(ws + WS_X), (const float*)(ws + WS_MOD) + (size_t)layer * MODROWS * NMODC + 2 * 1024};
            pg8::gemm_phase<pg8::EpiResGate, pg8::StaticOrder, true, true>(lds + RING_OFF, g, S, E);
        } SEAM(pb + 5);
        if (EN(10) && IN(pb + 6)) { if ((DUPMASK >> 10) & 1) { PHASE_IDS(); phase_modulate2_route(ws, layer, lds, vcu, wave, lane, tid, true); __syncthreads(); } PHASE_IDS(); phase_modulate2_route(ws, layer, lds, vcu, wave, lane, tid); } SEAM(pb + 6);
        if (EN(12) && IN(pb + 8)) DUP(12) {
            PHASE_IDS();
            build_expert_tables(ws, layer, lds, tid);
            const int nT = __builtin_amdgcn_readfirstlane(((const LAS int*)(lds + AUX_NT))[0]);
            pg8::MoeOrder S{nT, 8, G, bx, (const LAS int*)(lds + AUX_T2E)};
            LAS unsigned short* rowtab = (LAS unsigned short*)(lds + AUX_ROWTAB);
            { const LAS int* base = (const LAS int*)(lds + AUX_BASE); const LAS int* cntl = (const LAS int*)(lds + AUX_CNT); const int* LIST = (const int*)(ws + WS_LIST);
              pg8::Unit u;
              for (int i = 0; i < ROWTAB_UNITS && S.next(i, u); ++i) if (tid < 256) { const int pos = (u.pm - (base[u.e] >> 8)) * 256 + tid; rowtab[i * 256 + tid] = (unsigned short)((pos < cntl[u.e]) ? LIST[(size_t)u.e * MT + pos] : 0); }
              __syncthreads(); }
            pg8::Gemm g{(const pg8::bf16_t*)(ws + WS_XN), (const pg8::bf16_t*)(ws + WS_WGU) + (size_t)layer * 32 * 2048 * 1024, MPAD, 2048, 1024, (size_t)2048 * 1024 * 2, rowtab};
            pg8::EpiSwiGLU E{(pg8::bf16_t*)(ws + WS_ACT), PARF(ws) + P_BGU + (size_t)layer * 32 * 2048};
            pg8::gemm_phase<pg8::EpiSwiGLU, pg8::MoeOrder, true, true, true>(lds + RING_OFF, g, S, E);
        } SEAM(pb + 8);
        if (EN(13) && IN(pb + 9)) DUP(13) {
            PHASE_IDS();
            build_expert_tables(ws, layer, lds, tid);
            const int nT = __builtin_amdgcn_readfirstlane(((const LAS int*)(lds + AUX_NT))[0]);
            pg8::Gemm g{(const pg8::bf16_t*)(ws + WS_ACT), (const pg8::bf16_t*)(ws + WS_WDN) + (size_t)layer * 32 * 1024 * 1024, MPAD, 1024, 1024, (size_t)1024 * 1024 * 2};
            pg8::MoeOrder S{nT, 4, G, bx, (const LAS int*)(lds + AUX_T2E)};
            pg8::EpiBiasBf16 E{(pg8::bf16_t*)(ws + WS_Y), PARF(ws) + P_BDN + (size_t)layer * 32 * 1024};
            pg8::gemm_phase<pg8::EpiBiasBf16, pg8::MoeOrder, true, true>(lds + RING_OFF, g, S, E);
        } SEAM(pb + 9);
        if (EN(14) && IN(pb + 10)) { if ((DUPMASK >> 14) & 1) { PHASE_IDS(); phase_moe_combine(ws, args.out, layer, lds, gw, NGW, lane, tid, true); } PHASE_IDS(); phase_moe_combine(ws, args.out, layer, lds, gw, NGW, lane, tid); } SEAM(pb + 10);
    }
#undef IN
#undef EN
#undef DUP
#undef SEAM
#undef PHASE_IDS
}

extern "C" void kernel_launch(void* const* d_in, const int* in_sizes, int n_in, void* d_out, int out_size, void* d_ws, size_t ws_size, hipStream_t stream) {
    static int grid = 0;
    if (grid == 0) {
        if (n_in != 25 || out_size != NB * SEQ * DMODEL || ws_size < WS_END) { fprintf(stderr, "kernel_launch: unexpected shapes: n_in %d out %d ws %zu (need >= %zu)\n", n_in, out_size, ws_size, (size_t)WS_END); grid = -1; return; }
        int dev = 0, cus = 0, per_cu = 0;
        if (hipGetDevice(&dev) != hipSuccess || hipDeviceGetAttribute(&cus, hipDeviceAttributeMultiprocessorCount, dev) != hipSuccess) { grid = -1; return; }
        if (hipFuncSetAttribute((const void*)dit_fwd, hipFuncAttributeMaxDynamicSharedMemorySize, LDS_BYTES) != hipSuccess) { fprintf(stderr, "kernel_launch: hipFuncSetAttribute failed\n"); grid = -1; return; }
        if (hipOccupancyMaxActiveBlocksPerMultiprocessor(&per_cu, (const void*)dit_fwd, NWAVES * 64, LDS_BYTES) != hipSuccess || per_cu < 1) fprintf(stderr, "kernel_launch: occupancy query reports %d\n", per_cu);
        (void)hipGetLastError();
        grid = cus;
    }
    if (grid < 0) return;
    if (hipMemsetAsync((char*)d_ws + WS_CTL, 0, CTL_ZERO_BYTES, stream) != hipSuccess) { fprintf(stderr, "kernel_launch: memset failed\n"); return; }
    Args a{};
    for (int i = 0; i < 25; ++i) a.in[i] = (const float*)d_in[i];
    a.out = (float*)d_out; a.ws = (unsigned char*)d_ws;
#if MK_ONE_LAUNCH
    a.ph_lo = 0; a.ph_hi = NPHASE;
    hipLaunchKernelGGL(dit_fwd, dim3(grid), dim3(NWAVES * 64), LDS_BYTES, stream, a);
#else
    for (int p = 0; p < NPHASE; ++p) { a.ph_lo = p; a.ph_hi = p + 1; hipLaunchKernelGGL(dit_fwd, dim3(grid), dim3(NWAVES * 64), LDS_BYTES, stream, a); }
#endif
    const hipError_t le = hipPeekAtLastError();
    if (le != hipSuccess) fprintf(stderr, "kernel_launch: launch failed: %s\n", hipGetErrorName(le));
}
```

```cpp
#include <hip/hip_runtime.h>
#include <hip/hip_bf16.h>
#include <cstdio>
#include <cstdint>
#include <cmath>

#ifndef MK_ONE_LAUNCH
#define MK_ONE_LAUNCH 1
#endif

namespace pg8 {
#define PG8_LAS __attribute__((address_space(3)))
typedef unsigned short bf16_t;
typedef short bf16x8 __attribute__((ext_vector_type(8)));
typedef float f32x4 __attribute__((ext_vector_type(4)));
typedef unsigned u32x4 __attribute__((ext_vector_type(4)));
constexpr int BM = 256, BK = 64, HALF = 128, HTB = HALF * BK * 2  , STAGE_BYTES = 8 * HTB, NXCD = 8, WGM = 8;

__host__ __device__ __forceinline__ int lds_byte(int r, int c) { const int st = (r >> 4) * 2 + (c >> 5), rr = r & 15, cc = c & 31, ob = rr * 64 + cc * 2; return st * 1024 + (ob ^ (((ob >> 9) & 1) << 5)); }
__host__ __device__ __forceinline__ void stage_rc(int b, int& R, int& C) { const int st = b / 1024, sb = b % 1024, swz = sb ^ (((sb >> 9) & 1) << 5); R = (st >> 1) * 16 + swz / 64; C = (st & 1) * 32 + (swz % 64) / 2; }
__host__ __device__ __forceinline__ int perm32(int rho) { const int n = rho >> 4, i = rho & 15; return 8 * (i >> 2) + 4 * n + (i & 3); }

struct Unit { int pm, pn, e; };
struct Gemm { const bf16_t* A; const bf16_t* Bt; int M, N, K; size_t bstride; const PG8_LAS unsigned short* rowtab; };

struct StaticOrder {
    int nM, nN, nwg, G, c;
    __host__ __device__ __forceinline__ void init(int M, int N, int G_, int c_) { nM = M / BM; nN = N / BM; nwg = nM * nN; G = G_; c = c_; }
    __host__ __device__ __forceinline__ bool next(int i, Unit& u) const {
        const long L = (long)i * G + c; if (L >= nwg) return false;
        int wgid = (int)L; { const int q = nwg / NXCD, r = nwg % NXCD, xcd = wgid % NXCD, off = wgid / NXCD; wgid = (xcd < r ? xcd * (q + 1) : r * (q + 1) + (xcd - r) * q) + off; }
        const int nig = WGM * nN, gid = wgid / nig, fm = gid * WGM, gsz = (nM - fm) < WGM ? (nM - fm) : WGM;
        u.pm = fm + ((wgid % nig) % gsz); u.pn = (wgid % nig) / gsz; u.e = 0; return true;
    }
    __device__ __forceinline__ void a_ready(const Unit&) const {}
    __device__ __forceinline__ void done(const Unit&) const {}
};
struct MoeOrder {
    int nT, nN, G, c; const PG8_LAS int* t2e;
    __device__ __forceinline__ bool next(int i, Unit& u) const {
        const int x = c & 7, j = c >> 3, per = 32 / nN, mt = (i * (G >> 5) + x) * per + j / nN; if (mt >= nT) return false;
        u.pm = mt; u.pn = j % nN; u.e = __builtin_amdgcn_readfirstlane(t2e[mt]); return true;
    }
    __device__ __forceinline__ void a_ready(const Unit&) const {}
    __device__ __forceinline__ void done(const Unit&) const {}
};

__device__ __forceinline__ unsigned cvt_pk_bf16(float lo, float hi) { unsigned r; asm volatile("v_cvt_pk_bf16_f32 %0, %1, %2" : "=v"(r) : "v"(lo), "v"(hi)); return r; }

struct EpiBf16 {
    static constexpr bool PERM = true, AFTER_DRAIN = false;
    bf16_t* O; int ldc;
    __device__ __forceinline__ void operator()(const f32x4 (&acc)[2][2][4][2], const Unit& u, int wr, int wc, int fr, int fq) const {
        const int row0 = u.pm * BM + wr * 64 + fr; const int col0 = u.pn * BM + wc * 32 + 8 * fq;
#pragma unroll
        for (int ai = 0; ai < 2; ++ai)
#pragma unroll
            for (int m = 0; m < 4; ++m) { bf16_t* rowp = O + (size_t)(row0 + ai * HALF + m * 16) * ldc + col0;
#pragma unroll
                for (int bj = 0; bj < 2; ++bj) { const f32x4 v0 = acc[ai][bj][m][0], v1 = acc[ai][bj][m][1];
                    u32x4 w; w.x = cvt_pk_bf16(v0[0], v0[1]); w.y = cvt_pk_bf16(v0[2], v0[3]); w.z = cvt_pk_bf16(v1[0], v1[1]); w.w = cvt_pk_bf16(v1[2], v1[3]);
                    *(u32x4*)(rowp + bj * HALF) = w; } }
    }
};
struct EpiQKV {
    static constexpr bool PERM = true, AFTER_DRAIN = false;
    unsigned char* wsb; size_t offQ, dK, dV;
    __device__ __forceinline__ void operator()(const f32x4 (&acc)[2][2][4][2], const Unit& u, int wr, int wc, int fr, int fq) const {
        const int row0 = u.pm * BM + wr * 64 + fr;
        const int isk = (u.pn >= 4) ? 1 : 0, isv = (u.pn >= 5) ? 1 : 0;
        bf16_t* base = (bf16_t*)(wsb + offQ + (size_t)isk * dK + (size_t)isv * dV); const int ldc = isk ? 256 : 1024, colt = isk ? 0 : u.pn * BM;
        const int col0 = colt + wc * 32 + 8 * fq;
#pragma unroll
        for (int ai = 0; ai < 2; ++ai)
#pragma unroll
            for (int m = 0; m < 4; ++m) { bf16_t* rowp = base + (size_t)(row0 + ai * HALF + m * 16) * ldc + col0;
#pragma unroll
                for (int bj = 0; bj < 2; ++bj) { const f32x4 v0 = acc[ai][bj][m][0], v1 = acc[ai][bj][m][1];
                    u32x4 w; w.x = cvt_pk_bf16(v0[0], v0[1]); w.y = cvt_pk_bf16(v0[2], v0[3]); w.z = cvt_pk_bf16(v1[0], v1[1]); w.w = cvt_pk_bf16(v1[2], v1[3]);
                    *(u32x4*)(rowp + bj * HALF) = w; } }
    }
};
struct EpiResGate {
    static constexpr bool PERM = false, AFTER_DRAIN = false;
    bf16_t* X; const float* gate;
    __device__ __forceinline__ void operator()(const f32x4 (&acc)[2][2][4][2], const Unit& u, int wr, int wc, int fr, int fq) const {
        const int row0 = u.pm * BM + wr * 64 + fr; const int col0 = u.pn * BM + wc * 32 + 4 * fq;
        const int bb = u.pm / 17, mr = (u.pm - bb * 17 == 0) ? 8 : bb;
        const float* gp = gate + (size_t)mr * 6144 + col0;
        f32x4 gv[2][2];
#pragma unroll
        for (int bj = 0; bj < 2; ++bj)
#pragma unroll
            for (int n = 0; n < 2; ++n) gv[bj][n] = *(const f32x4*)(gp + bj * HALF + n * 16);
#pragma unroll
        for (int ai = 0; ai < 2; ++ai)
#pragma unroll
            for (int m = 0; m < 4; ++m) { bf16_t* rowp = X + (size_t)(row0 + ai * HALF + m * 16) * 1024 + col0;
#pragma unroll
                for (int bj = 0; bj < 2; ++bj)
#pragma unroll
                    for (int n = 0; n < 2; ++n) { unsigned long long* p = (unsigned long long*)(rowp + bj * HALF + n * 16); const unsigned long long v = *p;
                        f32x4 x = (f32x4){__uint_as_float((unsigned)(v & 0xffffu) << 16), __uint_as_float((unsigned)(v >> 16) << 16), __uint_as_float((unsigned)((v >> 32) & 0xffffu) << 16), __uint_as_float((unsigned)(v >> 48) << 16)};
                        x = x + gv[bj][n] * acc[ai][bj][m][n];
                        *p = (unsigned long long)cvt_pk_bf16(x[0], x[1]) | ((unsigned long long)cvt_pk_bf16(x[2], x[3]) << 32); } }
    }
};
struct EpiSwiGLU {
    static constexpr bool PERM = true, AFTER_DRAIN = false;
    bf16_t* O; const float* bias;
    __device__ __forceinline__ void operator()(const f32x4 (&acc)[2][2][4][2], const Unit& u, int wr, int wc, int fr, int fq) const {
        const int row0 = u.pm * BM + wr * 64 + fr; const int col0 = u.pn * HALF + wc * 32 + 8 * fq;
        const float* bp = bias + (size_t)u.e * 2048 + col0;
        f32x4 bg[2], bu[2];
#pragma unroll
        for (int n = 0; n < 2; ++n) { bg[n] = *(const f32x4*)(bp + 4 * n); bu[n] = *(const f32x4*)(bp + 1024 + 4 * n); }
#pragma unroll
        for (int ai = 0; ai < 2; ++ai)
#pragma unroll
            for (int m = 0; m < 4; ++m) { bf16_t* rowp = O + (size_t)(row0 + ai * HALF + m * 16) * 1024 + col0;
                float r[8];
#pragma unroll
                for (int n = 0; n < 2; ++n) { const f32x4 gt = acc[ai][0][m][n] + bg[n], up = acc[ai][1][m][n] + bu[n];
#pragma unroll
                    for (int i = 0; i < 4; ++i) { const float g = fminf(gt[i], 7.0f), uu = fminf(fmaxf(up[i], -7.0f), 7.0f);
                        const float sg = __builtin_amdgcn_rcpf(1.0f + __builtin_amdgcn_exp2f(-1.702f * 1.4426950408889634f * g));
                        r[4 * n + i] = (uu + 1.0f) * (g * sg); } }
                u32x4 w; w.x = cvt_pk_bf16(r[0], r[1]); w.y = cvt_pk_bf16(r[2], r[3]); w.z = cvt_pk_bf16(r[4], r[5]); w.w = cvt_pk_bf16(r[6], r[7]);
                *(u32x4*)rowp = w; }
    }
};
struct EpiBiasBf16 {
    static constexpr bool PERM = true, AFTER_DRAIN = false;
    bf16_t* O; const float* bias;
    __device__ __forceinline__ void operator()(const f32x4 (&acc)[2][2][4][2], const Unit& u, int wr, int wc, int fr, int fq) const {
        const int row0 = u.pm * BM + wr * 64 + fr; const int col0 = u.pn * BM + wc * 32 + 8 * fq;
        const float* bp = bias + (size_t)u.e * 1024 + col0;
        f32x4 bv[2][2];
#pragma unroll
        for (int bj = 0; bj < 2; ++bj)
#pragma unroll
            for (int n = 0; n < 2; ++n) bv[bj][n] = *(const f32x4*)(bp + bj * HALF + 4 * n);
#pragma unroll
        for (int ai = 0; ai < 2; ++ai)
#pragma unroll
            for (int m = 0; m < 4; ++m) { bf16_t* rowp = O + (size_t)(row0 + ai * HALF + m * 16) * 1024 + col0;
#pragma unroll
                for (int bj = 0; bj < 2; ++bj) { const f32x4 v0 = acc[ai][bj][m][0] + bv[bj][0], v1 = acc[ai][bj][m][1] + bv[bj][1];
                    u32x4 w; w.x = cvt_pk_bf16(v0[0], v0[1]); w.y = cvt_pk_bf16(v0[2], v0[3]); w.z = cvt_pk_bf16(v1[0], v1[1]); w.w = cvt_pk_bf16(v1[2], v1[3]);
                    *(u32x4*)(rowp + bj * HALF) = w; } }
    }
};

template <class Epi, class Sched, bool ALIGN_EPI = false, bool SP2 = false, bool GATHER = false>
__device__ __forceinline__ void gemm_phase(PG8_LAS unsigned char* lds, const Gemm g, const Sched& S, const Epi& E) {
    int tid_l = threadIdx.x; asm volatile("" : "+v"(tid_l));
    const int tid = tid_l, wid = __builtin_amdgcn_readfirstlane(tid >> 6), lane = tid & 63, wr = wid >> 2, wc = wid & 3, fr = lane & 15, fq = lane >> 4;
    const int K = g.K, nt = K / BK;
    unsigned voffA[2], voffB[2];
#pragma unroll
    for (int i = 0; i < 2; ++i) { int R, C; stage_rc(tid * 16 + i * 8192, R, C); const int Rb = Epi::PERM ? ((R & ~31) + perm32(R & 31)) : R;
        voffA[i] = (unsigned)(R * K + C) * 2u; voffB[i] = (unsigned)(Rb * K + C) * 2u; }
    const size_t kstep = (size_t)(BK * 2);
    static_assert(!GATHER || SP2, "GATHER is wired into the SP2 loop only");
    unsigned vAc0[2], vAc1[2], vAn0[2], vAn1[2]; int gR[2]; unsigned gC[2];
#pragma unroll
    for (int i = 0; i < 2; ++i) { int R, C; stage_rc(tid * 16 + i * 8192, R, C); gR[i] = R; gC[i] = (unsigned)C * 2u; vAc0[i] = voffA[i]; vAc1[i] = voffA[i]; vAn0[i] = voffA[i]; vAn1[i] = voffA[i]; }
#define PG8_GFETCH(d0, d1, ord) do { if constexpr (GATHER) { _Pragma("unroll") for (int _i = 0; _i < 2; ++_i) { \
        d0[_i] = (unsigned)g.rowtab[(ord) * 256 + gR[_i]] * (unsigned)(K * 2) + gC[_i]; d1[_i] = (unsigned)g.rowtab[(ord) * 256 + 128 + gR[_i]] * (unsigned)(K * 2) + gC[_i]; } } } while (0)
    const size_t hstep = (size_t)HALF * K * 2;
    const size_t hstepA = GATHER ? 0 : hstep;
    const size_t tstep = 2 * hstep;
    const unsigned ldsw = (unsigned)wid * 1024u;
    const int aoff = lds_byte(wr * 64 + fr, fq * 8), boff = lds_byte(wc * 32 + fr, fq * 8);
#define PG8_SA(b, h) (((b) * 2 + (h)) * HTB)
#define PG8_SB(b, h) ((4 + (b) * 2 + (h)) * HTB)
#define PG8_STAGE(bufoff, gbase, voff) do { _Pragma("unroll") for (int _i = 0; _i < 2; ++_i) \
        __builtin_amdgcn_global_load_lds((const unsigned*)((const char*)(gbase) + (voff)[_i]), (PG8_LAS unsigned*)(lds + (bufoff) + ldsw + _i * 8192), 16, 0, 0); } while (0)
#define PG8_LDA(dst, b, h) do { _Pragma("unroll") for (int m = 0; m < 4; ++m) _Pragma("unroll") for (int k = 0; k < 2; ++k) dst[m][k] = *(const PG8_LAS bf16x8*)(lds + PG8_SA(b, h) + aoff + m * 2048 + k * 1024); } while (0)
#define PG8_LDB(dst, b, h) do { _Pragma("unroll") for (int n = 0; n < 2; ++n) _Pragma("unroll") for (int k = 0; k < 2; ++k) dst[n][k] = *(const PG8_LAS bf16x8*)(lds + PG8_SB(b, h) + boff + n * 2048 + k * 1024); } while (0)
#define PG8_MMA(ai, bj, At, Bt) do { __builtin_amdgcn_s_setprio(1); _Pragma("unroll") for (int m = 0; m < 4; ++m) _Pragma("unroll") for (int n = 0; n < 2; ++n) _Pragma("unroll") for (int k = 0; k < 2; ++k) \
        acc[ai][bj][m][n] = __builtin_amdgcn_mfma_f32_16x16x32_bf16(Bt[n][k], At[m][k], acc[ai][bj][m][n], 0, 0, 0); __builtin_amdgcn_s_setprio(0); } while (0)
#define PG8_WAIT_V(n) asm volatile("s_waitcnt vmcnt(" #n ")" ::: "memory")
#define PG8_WAIT_L(n) asm volatile("s_waitcnt lgkmcnt(" #n ")" ::: "memory")
#define PG8_BAR __builtin_amdgcn_s_barrier()
#define PG8_SCHED __builtin_amdgcn_sched_barrier(0)
    Unit cur, nxt; int ui = 0;
    if (!S.next(0, cur)) return;
    f32x4 acc[2][2][4][2];
#pragma unroll
    for (int a = 0; a < 2; ++a)
#pragma unroll
        for (int b = 0; b < 2; ++b)
#pragma unroll
            for (int m = 0; m < 4; ++m)
#pragma unroll
                for (int n = 0; n < 2; ++n) acc[a][b][m][n] = (f32x4){0.f, 0.f, 0.f, 0.f};
    bf16x8 At[4][2], B0[2][2], B1[2][2];
    const char* cA = (const char*)g.A + (GATHER ? (size_t)0 : (size_t)cur.pm * tstep); PG8_GFETCH(vAc0, vAc1, 0); const char* cB = (const char*)g.Bt + (size_t)cur.e * g.bstride + (size_t)cur.pn * tstep;
    S.a_ready(cur);
    if constexpr (SP2) {
        PG8_STAGE(PG8_SB(0, 0), cB, voffB); PG8_STAGE(PG8_SB(0, 1), cB + hstep, voffB); PG8_STAGE(PG8_SA(0, 0), cA, vAc0); PG8_STAGE(PG8_SA(0, 1), cA + hstepA, vAc1);
        if (wr == 1) PG8_BAR;
        PG8_WAIT_V(2); PG8_BAR;
        PG8_STAGE(PG8_SB(1, 0), cB + kstep, voffB); PG8_STAGE(PG8_SA(1, 0), cA + kstep, vAc0); PG8_STAGE(PG8_SB(1, 1), cB + hstep + kstep, voffB);
        PG8_WAIT_V(6); PG8_BAR;
    } else {
        PG8_STAGE(PG8_SB(0, 0), cB, voffB); PG8_STAGE(PG8_SA(0, 0), cA, voffA); PG8_STAGE(PG8_SB(0, 1), cB + hstep, voffB); PG8_STAGE(PG8_SA(0, 1), cA + hstep, voffA);
        if (wr == 1) PG8_BAR;
        PG8_WAIT_V(4); PG8_BAR;
        PG8_STAGE(PG8_SB(1, 0), cB + kstep, voffB); PG8_STAGE(PG8_SA(1, 0), cA + kstep, voffA); PG8_STAGE(PG8_SB(1, 1), cB + hstep + kstep, voffB);
        PG8_WAIT_V(6); PG8_BAR;
    }
    for (;;) {
        const bool has_next = S.next(ui + 1, nxt);
        const char* nA = (has_next && !GATHER) ? (const char*)g.A + (size_t)nxt.pm * tstep : cA;
        if constexpr (GATHER) { if (has_next) PG8_GFETCH(vAn0, vAn1, ui + 1); else { vAn0[0] = vAc0[0]; vAn0[1] = vAc0[1]; vAn1[0] = vAc1[0]; vAn1[1] = vAc1[1]; } }
        const char* nB = has_next ? (const char*)g.Bt + (size_t)nxt.e * g.bstride + (size_t)nxt.pn * tstep : cB;
        for (int t = 0; t < nt; t += 2) {
            const bool last = (t == nt - 2);
            const char* a1 = cA + (size_t)(t + 1) * kstep;
            const char* a2 = last ? nA : cA + (size_t)(t + 2) * kstep; const char* b2 = last ? nB : cB + (size_t)(t + 2) * kstep;
            const char* a3 = a2 + kstep; const char* b3 = b2 + kstep;
            if (last && has_next) S.a_ready(nxt);
            unsigned vS0[2], vS1[2];
            vS0[0] = last ? vAn0[0] : vAc0[0]; vS0[1] = last ? vAn0[1] : vAc0[1]; vS1[0] = last ? vAn1[0] : vAc1[0]; vS1[1] = last ? vAn1[1] : vAc1[1];
            if constexpr (SP2) {
            PG8_LDB(B0, 0, 0); PG8_LDB(B1, 0, 1); PG8_SCHED; PG8_LDA(At, 0, 0); PG8_STAGE(PG8_SA(1, 1), a1 + hstepA, vAc1);
            PG8_WAIT_V(8); PG8_WAIT_L(0); PG8_BAR; PG8_MMA(0, 0, At, B0); PG8_MMA(0, 1, At, B1); PG8_BAR; PG8_SCHED;
            PG8_LDA(At, 0, 1); PG8_STAGE(PG8_SB(0, 0), b2, voffB); PG8_STAGE(PG8_SB(0, 1), b2 + hstep, voffB); PG8_STAGE(PG8_SA(0, 0), a2, vS0);
            PG8_WAIT_V(8); PG8_WAIT_L(0); PG8_BAR; PG8_MMA(1, 0, At, B0); PG8_MMA(1, 1, At, B1); PG8_BAR; PG8_SCHED;
            PG8_LDB(B0, 1, 0); PG8_LDB(B1, 1, 1); PG8_SCHED; PG8_LDA(At, 1, 0); PG8_STAGE(PG8_SA(0, 1), a2 + hstepA, vS1);
            PG8_WAIT_V(8); PG8_WAIT_L(0); PG8_BAR; PG8_MMA(0, 0, At, B0); PG8_MMA(0, 1, At, B1); PG8_BAR; PG8_SCHED;
            PG8_LDA(At, 1, 1); PG8_STAGE(PG8_SB(1, 0), b3, voffB); PG8_STAGE(PG8_SB(1, 1), b3 + hstep, voffB); PG8_STAGE(PG8_SA(1, 0), a3, vS0);
            PG8_WAIT_V(8); PG8_WAIT_L(0); PG8_BAR; PG8_MMA(1, 0, At, B0); PG8_MMA(1, 1, At, B1); PG8_BAR; PG8_SCHED;
            } else {
            PG8_LDB(B0, 0, 0); PG8_SCHED; PG8_LDA(At, 0, 0); PG8_STAGE(PG8_SA(1, 1), a1 + hstep, voffA);
            PG8_WAIT_L(8); PG8_BAR; PG8_WAIT_L(0); PG8_MMA(0, 0, At, B0); PG8_BAR; PG8_SCHED;
            PG8_LDB(B1, 0, 1); PG8_STAGE(PG8_SB(0, 0), b2, voffB);
            PG8_BAR; PG8_WAIT_L(0); PG8_MMA(0, 1, At, B1); PG8_BAR;
            PG8_LDA(At, 0, 1); PG8_STAGE(PG8_SA(0, 0), a2, voffA);
            PG8_BAR; PG8_WAIT_L(0); PG8_MMA(1, 0, At, B0); PG8_BAR; PG8_SCHED;
            PG8_STAGE(PG8_SB(0, 1), b2 + hstep, voffB);
            PG8_WAIT_V(6); PG8_BAR; PG8_MMA(1, 1, At, B1); PG8_BAR;
            PG8_LDB(B0, 1, 0); PG8_SCHED; PG8_LDA(At, 1, 0); PG8_STAGE(PG8_SA(0, 1), a2 + hstep, voffA);
            PG8_WAIT_L(8); PG8_BAR; PG8_WAIT_L(0); PG8_MMA(0, 0, At, B0); PG8_BAR; PG8_SCHED;
            PG8_LDB(B1, 1, 1); PG8_STAGE(PG8_SB(1, 0), b3, voffB);
            PG8_BAR; PG8_WAIT_L(0); PG8_MMA(0, 1, At, B1); PG8_BAR;
            PG8_LDA(At, 1, 1); PG8_STAGE(PG8_SA(1, 0), a3, voffA);
            PG8_BAR; PG8_WAIT_L(0); PG8_MMA(1, 0, At, B0); PG8_BAR; PG8_SCHED;
            PG8_STAGE(PG8_SB(1, 1), b3 + hstep, voffB);
            PG8_WAIT_V(6); PG8_BAR; PG8_MMA(1, 1, At, B1); PG8_BAR;
            }
        }
        if constexpr (ALIGN_EPI) { if (wr == 0) PG8_BAR; }
        if constexpr (!Epi::AFTER_DRAIN) { E(acc, cur, wr, wc, fr, fq); S.done(cur); }
        if (!has_next) break;
#pragma unroll
        for (int a = 0; a < 2; ++a)
#pragma unroll
            for (int b = 0; b < 2; ++b)
#pragma unroll
                for (int m = 0; m < 4; ++m)
#pragma unroll
                    for (int n = 0; n < 2; ++n) acc[a][b][m][n] = (f32x4){0.f, 0.f, 0.f, 0.f};
        cur = nxt; cA = nA; cB = nB; ++ui;
        if constexpr (GATHER) { vAc0[0] = vAn0[0]; vAc0[1] = vAn0[1]; vAc1[0] = vAn1[0]; vAc1[1] = vAn1[1]; }
        if constexpr (ALIGN_EPI) { if (wr == 1) PG8_BAR; }
    }
    PG8_WAIT_V(0);
    if constexpr (!ALIGN_EPI) { if (wr == 0) PG8_BAR; }
    PG8_BAR;
    if constexpr (Epi::AFTER_DRAIN) { E.fused(acc, cur, wr, wc, fr, fq, lds, wid, lane); S.done(cur); }
#undef PG8_SA
#undef PG8_SB
#undef PG8_STAGE
#undef PG8_LDA
#undef PG8_LDB
#undef PG8_MMA
#undef PG8_WAIT_V
#undef PG8_WAIT_L
#undef PG8_BAR
#undef PG8_SCHED
#undef PG8_GFETCH
}
}
#include <hip/hip_bf16.h>
#include <cmath>
namespace attn_body {
using bf16=__hip_bfloat16;
using bf16x8=__attribute__((ext_vector_type(8)))short;
using s16x4=__attribute__((ext_vector_type(4)))short;
using f32x16=__attribute__((ext_vector_type(16)))float;
using u32x4=__attribute__((ext_vector_type(4)))unsigned;
constexpr int D=64,DM=1024,KVP=256;
constexpr int NW=8,QBLK=32,QB=QBLK*NW,KVBLK=64;
__device__ __forceinline__ int crow(int r,int hi){return (r&3)+8*(r>>2)+4*hi;}
#define SBAR() __builtin_amdgcn_sched_barrier(0)
__device__ __forceinline__ void cmask(f32x16&p0,f32x16&p1,int jb,int qrel,int hi){
  const float NEG=-INFINITY; int kb=64*jb+4*hi;
  #pragma unroll
  for(int r=0;r<16;++r){int kv=kb+(r&3)+8*(r>>2); if(kv>qrel)p0[r]=NEG; if(kv+32>qrel)p1[r]=NEG;}
}

constexpr int NSLOT=3, SLOTB=8192;
constexpr int LDS_K=0, LDS_V=NSLOT*SLOTB, LDS_WS=2*NSLOT*SLOTB, LDS_OST=LDS_WS+NW*64*4, LDS_BYTES=LDS_OST+NW*4096;
constexpr float C2=0.125f*1.4426950408889634f;
__device__ __forceinline__ void glds16(const void*gsrc,unsigned lds_dst){unsigned keep;
  asm volatile("s_mov_b32 %0, m0\n\ts_mov_b32 m0, %2\n\ts_nop 0\n\tglobal_load_lds_dwordx4 %1, off\n\ts_mov_b32 m0, %0":"=&s"(keep):"v"(gsrc),"s"(lds_dst):"memory");}
__device__ __forceinline__ float max3f(float a,float b,float c){float r;asm("v_max3_f32 %0, %1, %2, %3":"=v"(r):"v"(a),"v"(b),"v"(c));return r;}
__device__ __forceinline__ float max2f(float a,float b){float r;asm("v_max_f32_e32 %0, %1, %2":"=v"(r):"v"(a),"v"(b));return r;}
__device__ __forceinline__ float fadd_s(float a,float b){float r;asm("v_add_f32_e32 %0, %1, %2":"=v"(r):"v"(a),"v"(b));return r;}
__device__ __forceinline__ float fsub_s(float a,float b){float r;asm("v_sub_f32_e32 %0, %1, %2":"=v"(r):"v"(a),"v"(b));return r;}
typedef float f32x2_t __attribute__((ext_vector_type(2))); typedef __bf16 bf16x2_t __attribute__((ext_vector_type(2)));
__device__ __forceinline__ unsigned cvtpk_s(float lo,float hi){f32x2_t v={lo,hi};bf16x2_t b=__builtin_convertvector(v,bf16x2_t);return __builtin_bit_cast(unsigned,b);}
#define WAIT_BAR(N) asm volatile("s_waitcnt vmcnt(" #N ") lgkmcnt(0)\n\ts_barrier":::"memory")

__device__ __forceinline__ void qkt(f32x16&p0,f32x16&p1,const char*Kslot,const bf16x8*qr,const f32x16&negm,int r32,int hi){
  const char*kb=Kslot+hi*1024+r32*16;
  #pragma unroll
  for(int d0=0;d0<4;++d0){
    const bf16x8 b0=*reinterpret_cast<const bf16x8*>(kb+d0*2048);
    const bf16x8 b1=*reinterpret_cast<const bf16x8*>(kb+d0*2048+512);
    if(d0==0){p0=__builtin_amdgcn_mfma_f32_32x32x16_bf16(b0,qr[0],negm,0,0,0);p1=__builtin_amdgcn_mfma_f32_32x32x16_bf16(b1,qr[0],negm,0,0,0);}
    else{p0=__builtin_amdgcn_mfma_f32_32x32x16_bf16(b0,qr[d0],p0,0,0,0);p1=__builtin_amdgcn_mfma_f32_32x32x16_bf16(b1,qr[d0],p1,0,0,0);}}
}
typedef __attribute__((address_space(3))) const char* lds_cptr;
typedef short v4i16_t __attribute__((ext_vector_type(4)));
__device__ __forceinline__ void kload8(bf16x8*kf,lds_cptr kp){
  kf[0]=*(const __attribute__((address_space(3))) bf16x8*)(kp);      kf[1]=*(const __attribute__((address_space(3))) bf16x8*)(kp+512);
  kf[2]=*(const __attribute__((address_space(3))) bf16x8*)(kp+2048); kf[3]=*(const __attribute__((address_space(3))) bf16x8*)(kp+2560);
  kf[4]=*(const __attribute__((address_space(3))) bf16x8*)(kp+4096); kf[5]=*(const __attribute__((address_space(3))) bf16x8*)(kp+4608);
  kf[6]=*(const __attribute__((address_space(3))) bf16x8*)(kp+6144); kf[7]=*(const __attribute__((address_space(3))) bf16x8*)(kp+6656);
}
__device__ __forceinline__ void kload2(bf16x8*kf,lds_cptr kp,int j){ kf[2*j]=*(const __attribute__((address_space(3))) bf16x8*)(kp+j*2048); kf[2*j+1]=*(const __attribute__((address_space(3))) bf16x8*)(kp+j*2048+512); }
__device__ __forceinline__ s16x4 vtr(lds_cptr p){ return __builtin_bit_cast(s16x4,__builtin_amdgcn_ds_read_tr16_b64_v4i16((__attribute__((address_space(3))) v4i16_t*)p)); }
__device__ __forceinline__ float rowmax(const f32x16&p0,const f32x16&p1){
  float a=max3f(p0[0],p0[1],p1[0]),b=max3f(p0[2],p0[3],p1[1]);a=max3f(a,p1[2],p1[3]);
  #pragma unroll
  for(int r=4;r<16;r+=4){a=max3f(a,p0[r],p0[r+1]);b=max3f(b,p0[r+2],p0[r+3]);a=max3f(a,p1[r],p1[r+1]);b=max3f(b,p1[r+2],p1[r+3]);}
  const float m=max2f(a,b);
  auto rr=__builtin_amdgcn_permlane32_swap(__float_as_uint(m),__float_as_uint(m),false,false);
  return max2f(__uint_as_float(rr[0]),__uint_as_float(rr[1]));
}
__device__ __forceinline__ void pv(f32x16*o,int vb,bf16x8 pa0,bf16x8 pa1,bf16x8 pa2,bf16x8 pa3){
  #pragma unroll
  for(int d0=0;d0<2;++d0){s16x4 lo[4],hi[4];
    #pragma unroll
    for(int ks=0;ks<4;++ks){
      asm volatile("ds_read_b64_tr_b16 %0,%1 offset:%c2":"=&v"(lo[ks]):"v"(vb),"i"(d0*4096+ks*1024):"memory");
      asm volatile("ds_read_b64_tr_b16 %0,%1 offset:%c2":"=&v"(hi[ks]):"v"(vb),"i"(d0*4096+ks*1024+512):"memory");}
    asm volatile("s_waitcnt lgkmcnt(0)":::"memory");SBAR();
    #define PK(k) (bf16x8){lo[k][0],lo[k][1],lo[k][2],lo[k][3],hi[k][0],hi[k][1],hi[k][2],hi[k][3]}
    o[d0]=__builtin_amdgcn_mfma_f32_32x32x16_bf16(pa0,PK(0),o[d0],0,0,0);
    o[d0]=__builtin_amdgcn_mfma_f32_32x32x16_bf16(pa1,PK(1),o[d0],0,0,0);
    o[d0]=__builtin_amdgcn_mfma_f32_32x32x16_bf16(pa2,PK(2),o[d0],0,0,0);
    o[d0]=__builtin_amdgcn_mfma_f32_32x32x16_bf16(pa3,PK(3),o[d0],0,0,0);
    #undef PK
  }
}

#ifndef ATTN_STORE16
#define ATTN_STORE16(p,v) (*(u32x4*)(p)=(v))
#endif
template<int THRL> __device__ __forceinline__ void attn_unit(long qrow0,long kvrow0,int NT,int h,const bf16*Q,const bf16*__restrict__ K,const bf16*__restrict__ V,bf16*O,char*shm){
  int tid_l=threadIdx.x; asm volatile("":"+v"(tid_l)); const int tid=tid_l,lane=tid&63,r32=lane&31,hi=lane>>5; const int wid=__builtin_amdgcn_readfirstlane(tid>>6);
  const bf16*Qw=Q+(qrow0+wid*QBLK)*DM+h*D;
  const bf16*Kh=K+kvrow0*KVP+(h>>2)*D,*Vh=V+kvrow0*KVP+(h>>2)*D;
  const unsigned lds0=(unsigned)(uintptr_t)shm;
  float*wsf=(float*)(shm+LDS_WS)+wid*64;
  const bf16*ksrc=Kh+(long)lane*KVP+wid*8;
  const bf16*vsrc=Vh+(long)(16*(wid&3)+(lane>>2))*KVP+(wid>>2)*32+(lane&3)*8;
  const unsigned kdst=lds0+LDS_K+wid*1024, vdst=lds0+LDS_V+wid*1024;
  #define DMA_K(t,slot) glds16(ksrc+(long)(t)*KVBLK*KVP,(unsigned)__builtin_amdgcn_readfirstlane(kdst+(slot)))
  #define DMA_V(t,slot) glds16(vsrc+(long)(t)*KVBLK*KVP,(unsigned)__builtin_amdgcn_readfirstlane(vdst+(slot)))
  const int vb0=(int)(lds0+LDS_V)+((lane>>4)&1)*32+(lane&3)*8+(4*hi+((lane&15)>>2))*64;
  const char*Kbase=shm+LDS_K; bf16x8 kf[8];
  const lds_cptr shm3=(lds_cptr)shm; const lds_cptr kp0=shm3+LDS_K+hi*1024+r32*16; const lds_cptr vp0=shm3+LDS_V+((lane>>4)&1)*32+(lane&3)*8+(4*hi+((lane&15)>>2))*64;
  DMA_K(0,0);DMA_V(0,0);DMA_K(1,SLOTB);
  bf16x8 qr[4];
  #pragma unroll
  for(int d0=0;d0<4;++d0)qr[d0]=*reinterpret_cast<const bf16x8*>(&Qw[(long)r32*DM+d0*16+hi*8]);
  float mhat=0.f,l_reg=0.f;f32x16 o[2];o[0]=f32x16{};o[1]=f32x16{};f32x16 negm=f32x16{};asm volatile("":"+v"(negm));
  #define CMASK(P0,P1,t) do{}while(0)
  bool resc=false;
  #define START(P0,P1) do{ const float rm=rowmax(P0,P1); resc=false; \
    { const float dl=rm; mhat=fadd_s(mhat,dl); \
      _Pragma("unroll") for(int r=0;r<16;++r){P0[r]=fsub_s(P0[r],dl);P1[r]=fsub_s(P1[r],dl);} \
      _Pragma("unroll") for(int r=0;r<16;++r)negm[r]=-mhat; asm volatile("":"+v"(negm)); } \
    _Pragma("unroll") for(int r=0;r<16;++r)P0[r]=__builtin_amdgcn_exp2f(P0[r]); }while(0)
  #define RESC() do{ if(resc){ asm volatile("s_waitcnt lgkmcnt(0)":::"memory"); \
      _Pragma("unroll") for(int d_=0;d_<2;++d_) _Pragma("unroll") for(int r=0;r<16;++r)o[d_][r]*=wsf[crow(r,hi)]; } }while(0)
  f32x16 pA0,pA1,pB0,pB1;
  int sl_prev=0,sl_cur=0,sl_next=SLOTB;
  #define ROT() do{sl_prev=sl_cur;sl_cur=sl_next;sl_next=(sl_next==(NSLOT-1)*SLOTB)?0:sl_next+SLOTB;}while(0)
  DMA_K(2,2*SLOTB);
  WAIT_BAR(3);
  qkt(pA0,pA1,Kbase,qr,negm,r32,hi);asm volatile("s_nop 15\n\ts_nop 7":"+v"(pA0),"+v"(pA1));CMASK(pA0,pA1,0);
  START(pA0,pA1);
  _Pragma("unroll") for(int r=0;r<16;++r)pA1[r]=__builtin_amdgcn_exp2f(pA1[r]);
  WAIT_BAR(0);
  DMA_K(3,0);DMA_V(1,SLOTB);
  ROT();
  kload8(kf,kp0+sl_cur);
  WAIT_BAR(2);
  s16x4 vlo[8],vhi[8]; u32x4 pw0,pw1,pw2,pw3;
  #define PKW(P,B) cvtpk_s(P[B],P[B+1])
  #define PAF(k) __builtin_bit_cast(bf16x8,pw##k)
  #define VFR(i) (bf16x8){vlo[i][0],vlo[i][1],vlo[i][2],vlo[i][3],vhi[i][0],vhi[i][1],vhi[i][2],vhi[i][3]}
  #define PIN(x) asm volatile("":"+v"(x))
  #define MX3(a,b,c) __builtin_fmaxf(__builtin_fmaxf((a),(b)),(c))
  #define GAPA(MF,A0,A1,A2,A3,W0,W1,PW) do{ MF; sacc+=A0; sacc+=A1; sacc+=A2; sacc+=A3; PIN(sacc); W0; W1; PIN(PW); SBAR(); }while(0)
  #define EX(v) __builtin_amdgcn_exp2f(v)
  #define GAPB(MF,X,B) do{ MF; X[B]=EX(X[B]); X[B+1]=EX(X[B+1]); X[B+2]=EX(X[B+2]); X[B+3]=EX(X[B+3]); PIN(X); SBAR(); }while(0)
  #define VRD(i) do{ vlo[i]=vtr(vp_+(((i)>>2)*4096+((i)&3)*1024)); vhi[i]=vtr(vp_+(((i)>>2)*4096+((i)&3)*1024+512)); }while(0)
  #define KRD(G,j) do{ if(G){ kload2(kf,kp0+sl_next,j); SBAR(); } }while(0)
  #define STEP(C0,C1,P0,P1,t,GK,GV,GL) do{ SBAR(); \
    const lds_cptr vp_=vp0+sl_prev; \
    VRD(0); SBAR(); float sacc=(P0[0]+P0[1]); \
    GAPA(C0=__builtin_amdgcn_mfma_f32_32x32x16_bf16(kf[0],qr[0],negm,0,0,0), P0[2],P0[3],P0[4],P0[5],     pw0[0]=PKW(P0,0), pw0[1]=PKW(P0,2), pw0); \
    VRD(4); SBAR(); GAPA(C1=__builtin_amdgcn_mfma_f32_32x32x16_bf16(kf[1],qr[0],negm,0,0,0), P0[6],P0[7],P0[8],P0[9],     pw0[2]=PKW(P0,4), pw0[3]=PKW(P0,6), pw0); \
    VRD(1); SBAR(); GAPA(C0=__builtin_amdgcn_mfma_f32_32x32x16_bf16(kf[2],qr[1],C0,0,0,0),   P0[10],P0[11],P0[12],P0[13], pw1[0]=PKW(P0,8), pw1[1]=PKW(P0,10), pw1); \
    VRD(5); SBAR(); GAPA(C1=__builtin_amdgcn_mfma_f32_32x32x16_bf16(kf[3],qr[1],C1,0,0,0),   P0[14],P0[15],P1[0],P1[1],   pw1[2]=PKW(P0,12),pw1[3]=PKW(P0,14), pw1); \
    VRD(2); SBAR(); GAPA(C0=__builtin_amdgcn_mfma_f32_32x32x16_bf16(kf[4],qr[2],C0,0,0,0),   P1[2],P1[3],P1[4],P1[5],     pw2[0]=PKW(P1,0), pw2[1]=PKW(P1,2), pw2); \
    VRD(6); SBAR(); GAPA(C1=__builtin_amdgcn_mfma_f32_32x32x16_bf16(kf[5],qr[2],C1,0,0,0),   P1[6],P1[7],P1[8],P1[9],     pw2[2]=PKW(P1,4), pw2[3]=PKW(P1,6), pw2); \
    VRD(3); SBAR(); GAPA(C0=__builtin_amdgcn_mfma_f32_32x32x16_bf16(kf[6],qr[3],C0,0,0,0),   P1[10],P1[11],P1[12],P1[13], pw3[0]=PKW(P1,8), pw3[1]=PKW(P1,10), pw3); \
    VRD(7); SBAR(); GAPA(C1=__builtin_amdgcn_mfma_f32_32x32x16_bf16(kf[7],qr[3],C1,0,0,0),   P1[14],P1[15],0.f,0.f,       pw3[2]=PKW(P1,12),pw3[3]=PKW(P1,14), pw3); \
    l_reg+=sacc; \
    if(GK){DMA_K((t)+3,sl_cur);} if(GV){DMA_V((t)+1,sl_next);} \
    CMASK(C0,C1,t); \
    { float a=MX3(C0[0],C0[1],C1[0]),b=MX3(C0[2],C0[3],C1[1]); a=MX3(a,C1[2],C1[3]); \
      _Pragma("unroll") for(int r=4;r<16;r+=4){a=MX3(a,C0[r],C0[r+1]);b=MX3(b,C0[r+2],C0[r+3]);a=MX3(a,C1[r],C1[r+1]);b=MX3(b,C1[r+2],C1[r+3]);} \
      float rm=__builtin_fmaxf(a,b); { auto rr=__builtin_amdgcn_permlane32_swap(__float_as_uint(rm),__float_as_uint(rm),false,false); rm=__builtin_fmaxf(__uint_as_float(rr[0]),__uint_as_float(rr[1])); } \
      resc=false; \
      if(__builtin_expect(__any(rm>(float)THRL),0)){ const float dl=__builtin_fmaxf(rm,0.f); mhat+=dl; \
        _Pragma("unroll") for(int r=0;r<16;++r){C0[r]-=dl;C1[r]-=dl;} \
        _Pragma("unroll") for(int r=0;r<16;++r)negm[r]=-mhat; asm volatile("":"+v"(negm)); \
        const float f=__builtin_amdgcn_exp2f(-dl); l_reg*=f; if(hi==0)wsf[r32]=f; resc=true; } } \
    SBAR(); \
    GAPB(o[0]=__builtin_amdgcn_mfma_f32_32x32x16_bf16(PAF(0),VFR(0),o[0],0,0,0), C0,0); \
    GAPB(o[1]=__builtin_amdgcn_mfma_f32_32x32x16_bf16(PAF(0),VFR(4),o[1],0,0,0), C0,4); \
    KRD(GL,0); GAPB(o[0]=__builtin_amdgcn_mfma_f32_32x32x16_bf16(PAF(1),VFR(1),o[0],0,0,0), C0,8); \
    KRD(GL,1); GAPB(o[1]=__builtin_amdgcn_mfma_f32_32x32x16_bf16(PAF(1),VFR(5),o[1],0,0,0), C0,12); \
    KRD(GL,2); GAPB(o[0]=__builtin_amdgcn_mfma_f32_32x32x16_bf16(PAF(2),VFR(2),o[0],0,0,0), C1,0); \
    KRD(GL,3); GAPB(o[1]=__builtin_amdgcn_mfma_f32_32x32x16_bf16(PAF(2),VFR(6),o[1],0,0,0), C1,4); \
    GAPB(o[0]=__builtin_amdgcn_mfma_f32_32x32x16_bf16(PAF(3),VFR(3),o[0],0,0,0), C1,8); \
    GAPB(o[1]=__builtin_amdgcn_mfma_f32_32x32x16_bf16(PAF(3),VFR(7),o[1],0,0,0), C1,12); \
    }while(0)
  int t=1;
  #undef CMASK
  #define CMASK(P0,P1,t) do{}while(0)
  for(;t+5<NT;t+=2){
    STEP(pB0,pB1,pA0,pA1,t,true,true,true);     WAIT_BAR(2); RESC(); ROT();
    STEP(pA0,pA1,pB0,pB1,t+1,true,true,true);   WAIT_BAR(2); RESC(); ROT();
  }
  #undef CMASK
  #define CMASK(P0,P1,t) do{}while(0)
  #define ENDW(tt) do{ if((tt)+3<NT){WAIT_BAR(2);} else if((tt)+2<NT){WAIT_BAR(1);} else {WAIT_BAR(0);} }while(0)
  for(;t+1<NT;t+=2){
    STEP(pB0,pB1,pA0,pA1,t,(t+3<NT),(t+1<NT),(t+1<NT));       ENDW(t);   RESC(); ROT();
    STEP(pA0,pA1,pB0,pB1,t+1,(t+4<NT),(t+2<NT),(t+2<NT));     ENDW(t+1); RESC(); ROT();
  }
  STEP(pB0,pB1,pA0,pA1,NT-1,false,false,false); RESC();
  { float sacc=pB0[0]+pB0[1]; _Pragma("unroll") for(int r=2;r<16;++r)sacc+=pB0[r]; _Pragma("unroll") for(int r=0;r<16;++r)sacc+=pB1[r]; l_reg+=sacc;
    pw0=(u32x4){PKW(pB0,0),PKW(pB0,2),PKW(pB0,4),PKW(pB0,6)};pw1=(u32x4){PKW(pB0,8),PKW(pB0,10),PKW(pB0,12),PKW(pB0,14)};pw2=(u32x4){PKW(pB1,0),PKW(pB1,2),PKW(pB1,4),PKW(pB1,6)};pw3=(u32x4){PKW(pB1,8),PKW(pB1,10),PKW(pB1,12),PKW(pB1,14)};
    SBAR(); pv(o,vb0+sl_cur,PAF(0),PAF(1),PAF(2),PAF(3)); }
  #undef PKW
  #undef PAF
  #undef VFR
  #undef PIN
  #undef MX3
  #undef GAPA
  #undef GAPB
  #undef EX
  #undef VRD
  #undef KRD
  #undef STEP
  #undef ENDW
  {auto rr=__builtin_amdgcn_permlane32_swap(__float_as_uint(l_reg),__float_as_uint(l_reg),false,false);l_reg=__uint_as_float(rr[0])+__uint_as_float(rr[1]);}
  if(hi==0)wsf[32+r32]=l_reg;asm volatile("s_waitcnt lgkmcnt(0)":::"memory");
  float rli[16];
  #pragma unroll
  for(int r=0;r<16;++r)rli[r]=__builtin_amdgcn_rcpf(wsf[32+crow(r,hi)]);
  bf16*Ow=O+(qrow0+wid*QBLK)*DM+h*D;
  { bf16*stg=(bf16*)(shm+LDS_OST)+wid*2048;
    #pragma unroll
    for(int r=0;r<16;++r){const int orow=crow(r,hi);
      #pragma unroll
      for(int d0=0;d0<2;++d0)stg[orow*64+d0*32+r32]=__float2bfloat16(o[d0][r]*rli[r]);}
    asm volatile("s_waitcnt lgkmcnt(0)":::"memory");
    #pragma unroll
    for(int i=0;i<4;++i){const int row=i*8+(lane>>3),ch=lane&7; const u32x4 v=*(const u32x4*)(stg+row*64+ch*8); ATTN_STORE16(Ow+(long)row*DM+ch*8,v);} }
  asm volatile("s_waitcnt lgkmcnt(0)\n\ts_barrier":::"memory");
  #undef DMA_K
  #undef DMA_V
  #undef CMASK
  #undef START
  #undef RESC
  #undef ROT
}
constexpr int ATTN_LDS_BYTES=LDS_BYTES;
#undef SBAR
#undef WAIT_BAR
}

constexpr int NWAVES = 8;
constexpr int NB = 8, SEQ = 4096, CTXL = 256, TB = SEQ + CTXL  , MT = NB * TB  , DMODEL = 1024;
constexpr int NMODC = 6 * DMODEL, MODROWS = 9;
constexpr int QKVN = 1536, WINN = 3104, WINP = 3328;
constexpr int NEXP = 32, TOPK = 4, MPAD = MT * TOPK + NEXP * 256;
constexpr int NLAYER = 4;
constexpr float RMS_EPS = 1e-6f;
constexpr float ATT_C2 = 0.125f * 1.4426950408889634f;

constexpr size_t MiB = 1u << 20;
constexpr size_t WS_CTL = 0, CTL_ZERO_BYTES = 1 * MiB;
constexpr size_t WS_MOD = 1 * MiB, WS_ROPE = 2 * MiB, WS_MODP = 3 * MiB;
constexpr size_t WS_SLOT = 17 * MiB, WS_GATEW = 18 * MiB, WS_SLOTPOS = 19 * MiB;
constexpr size_t WS_WQKV = 20 * MiB, WS_WOA = 26 * MiB, WS_WIN = 30 * MiB, WS_WOG = 43 * MiB, WS_WGU = 48 * MiB, WS_WDN = 560 * MiB;
constexpr size_t WS_X = 816 * MiB, WS_XN = 952 * MiB, WS_Q = 1020 * MiB, WS_K = 1088 * MiB, WS_V = 1105 * MiB, WS_G = 1122 * MiB;
constexpr size_t WS_OF = 1343 * MiB, WS_OB = 1479 * MiB, WS_XG = 1615 * MiB, WS_ACT = 1903 * MiB, WS_Y = 2191 * MiB, WS_PAR = 2479 * MiB, WS_LIST = 2483 * MiB  , WS_END = 2488 * MiB;
static_assert(WS_MODP + (size_t)16 * NLAYER * MODROWS * NMODC * 4 <= WS_SLOT && WS_WIN + (size_t)2 * WINP * 1024 * 2 <= WS_WOG && WS_G + (size_t)MT * WINP * 2 <= WS_OF && WS_XG + (size_t)MPAD * 1024 * 2 <= WS_ACT, "ws map");
constexpr int CW_TMO = 0, CW_BAR = 4096, CW_CNT = 16384;

constexpr int RING_OFF = 0, RING_BYTES = 131072;
constexpr int WR_STRIDE = 1028;
constexpr int LDS_AUX = 133120;
constexpr int AUX_LCNT = LDS_AUX, AUX_GB = LDS_AUX + 128, AUX_T2E = LDS_AUX + 256  , AUX_BASE = AUX_T2E + 2560  , AUX_NT = AUX_BASE + 128, AUX_CNT = AUX_NT + 64  , AUX_ENT = AUX_CNT + 128  , AUX_RS = AUX_ENT + 4352  , AUX_ROWTAB = AUX_RS + 576, ROWTAB_UNITS = 18  ;
constexpr int MISC_OFF = 154624;
constexpr int LDS_BYTES = 155648;
static_assert(AUX_ROWTAB + ROWTAB_UNITS * 512 <= MISC_OFF, "LDS map");

#define GAS __attribute__((address_space(1)))
#define LAS __attribute__((address_space(3)))
typedef unsigned short bf16;
typedef unsigned v4u __attribute__((ext_vector_type(4)));
typedef float f32x4 __attribute__((ext_vector_type(4)));
typedef short bf16x8 __attribute__((ext_vector_type(8)));
typedef GAS unsigned gu32;
typedef GAS unsigned long long gu64;
#define RLX_AGENT __ATOMIC_RELAXED, __HIP_MEMORY_SCOPE_AGENT
#define LDS_WAIT() asm volatile("s_waitcnt lgkmcnt(0)" ::: "memory")
#define VM_WAIT() asm volatile("s_waitcnt vmcnt(0)" ::: "memory")
__device__ __forceinline__ unsigned long long rt() { return __builtin_amdgcn_s_memrealtime(); }
__device__ __forceinline__ unsigned f2bf(float f) { unsigned u = __builtin_bit_cast(unsigned, f); return (u + 0x7fffu + ((u >> 16) & 1u)) >> 16; }
__device__ __forceinline__ unsigned pk2(float lo, float hi) { return f2bf(lo) | (f2bf(hi) << 16); }

#define XB_TMO      128
#define XB_XCNT(j)  (256  + 64 * (j))
#define XB_XSUB(j)  (1280 + 64 * (j))
#define XB_XGEN(j)  (2304 + 64 * (j))
#define XB_TOP      3328
#define XB_TOPGEN   3392
#define XCD_BAR_WORDS 3456
#define XB_SPIN_CAP (1u << 18)

__device__ __forceinline__ unsigned xb_ld(unsigned* p)              { return __hip_atomic_load(p, __ATOMIC_RELAXED, __HIP_MEMORY_SCOPE_AGENT); }
__device__ __forceinline__ unsigned xb_add(unsigned* p, unsigned v) { return __hip_atomic_fetch_add(p, v, __ATOMIC_RELAXED, __HIP_MEMORY_SCOPE_AGENT); }
__device__ __forceinline__ unsigned xb_xcc_id() { return (unsigned)__builtin_amdgcn_s_getreg((3 << 11) | 20) & 0xFu; }
#define XB_SPIN(cond, bar) do { unsigned _sp = 0; while (cond) { __builtin_amdgcn_s_sleep(1); \
    if ((++_sp & 255u) == 0u) { if (xb_ld(&(bar)[XB_TMO])) break; if (_sp > XB_SPIN_CAP) { atomicAdd(&(bar)[XB_TMO], 1u); break; } } } } while (0)

struct XcdBarrier {
    unsigned* bar; unsigned x;
    volatile LAS unsigned* st;
};

__device__ __forceinline__ XcdBarrier xcd_barrier_post(unsigned* bar, volatile LAS unsigned* st) {
    XcdBarrier b; b.bar = bar; b.x = xb_xcc_id(); b.st = st;
    if (threadIdx.x == 0) (void)xb_add(&bar[XB_XCNT(b.x)], 1u);
    return b;
}
__device__ __forceinline__ void xcd_barrier_complete(unsigned* bar, unsigned x, unsigned& nloc, unsigned& nx) {
    const unsigned G = gridDim.x * gridDim.y * gridDim.z;
    unsigned sum, cnt, mine, sp = 0u;
    for (;;) {
        sum = 0u; cnt = 0u; mine = 0u;
#pragma unroll
        for (unsigned j = 0; j < 16; ++j) { const unsigned c = xb_ld(&bar[XB_XCNT(j)]); sum += c; cnt += (c > 0u) ? 1u : 0u; mine = (j == x) ? c : mine; }
        if (sum == G) break;
        __builtin_amdgcn_s_sleep(1);
        if ((++sp & 255u) == 0u) { if (xb_ld(&bar[XB_TMO])) break; if (sp > XB_SPIN_CAP) { atomicAdd(&bar[XB_TMO], 1u); break; } }
    }
    nloc = mine > 0u ? mine : 1u; nx = cnt > 0u ? cnt : 1u;
}

__device__ __forceinline__ void xcd_barrier(const XcdBarrier& b) {
    asm volatile("s_waitcnt vmcnt(0)" ::: "memory");
    __syncthreads();
    if (threadIdx.x == 0) {
        unsigned* bar = b.bar;
        __builtin_amdgcn_s_waitcnt(0);
        unsigned nloc = b.st[0], nx = b.st[1];
        if (nloc == 0u) { xcd_barrier_complete(bar, b.x, nloc, nx); b.st[0] = nloc; b.st[1] = nx; }
        const unsigned old = xb_add(&bar[XB_XSUB(b.x)], 1u);
        const unsigned gen = old / nloc;
        if (old + 1u == (gen + 1u) * nloc) {
            __builtin_amdgcn_fence(__ATOMIC_RELEASE, "agent");
            asm volatile("s_waitcnt vmcnt(0)" ::: "memory");
            const unsigned og = xb_add(&bar[XB_TOP], 1u);
            const unsigned tg = og / nx;
            if (og + 1u == (tg + 1u) * nx) xb_add(&bar[XB_TOPGEN], 1u);
            else XB_SPIN(xb_ld(&bar[XB_TOPGEN]) == tg, bar);
            __builtin_amdgcn_fence(__ATOMIC_ACQUIRE, "agent");
            xb_add(&bar[XB_XGEN(b.x)], 1u);
            asm volatile("s_waitcnt vmcnt(0)" ::: "memory");
        } else {
            XB_SPIN(xb_ld(&bar[XB_XGEN(b.x)]) == gen, bar);
            __builtin_amdgcn_fence(__ATOMIC_ACQUIRE, "agent");
            asm volatile("s_waitcnt vmcnt(0)" ::: "memory");
        }
    }
    __syncthreads();
}

typedef float f32x2 __attribute__((ext_vector_type(2)));
__device__ __forceinline__ float wave_sum(float v) {
#pragma unroll
    for (int o = 1; o < 64; o <<= 1) v += __shfl_xor(v, o);
    return v;
}
__device__ __forceinline__ float wave_max(float v) {
#pragma unroll
    for (int o = 1; o < 64; o <<= 1) v = fmaxf(v, __shfl_xor(v, o));
    return v;
}
__device__ __forceinline__ float bf2f(unsigned short h) { return __uint_as_float((unsigned)h << 16); }
__device__ __forceinline__ float silu_f(float x) { return x / (1.0f + __expf(-x)); }
__device__ __forceinline__ f32x4 bf4_to_f32(unsigned long long v) { return (f32x4){__uint_as_float((unsigned)(v & 0xffffu) << 16), __uint_as_float((unsigned)(v >> 16) << 16), __uint_as_float((unsigned)((v >> 32) & 0xffffu) << 16), __uint_as_float((unsigned)(v >> 48) << 16)}; }
__device__ __forceinline__ unsigned long long f32_to_bf4(f32x4 y) { return (unsigned long long)pk2(y.x, y.y) | ((unsigned long long)pk2(y.z, y.w) << 32); }
__device__ __forceinline__ int mod_row(int m) { const int b = m / TB; return (m - b * TB < CTXL) ? 8 : b; }

__device__ __forceinline__ void transpose_item(const float* W, int K, int N, bf16* WT, int k0, int n0, int dst_row0, LAS float* scr, int lane) {
#pragma unroll 8
    for (int i = 0; i < 32; ++i) { const int kk = 2 * i + (lane >> 5); scr[kk * 33 + (lane & 31)] = W[(size_t)(k0 + kk) * N + n0 + (lane & 31)]; }
    LDS_WAIT(); asm volatile("" ::: "memory");
    const int c = lane & 7;
#pragma unroll
    for (int j = 0; j < 4; ++j) { const int n = (lane >> 3) + 8 * j; const LAS float* s = scr + (8 * c) * 33 + n;
        v4u o; o.x = pk2(s[0 * 33], s[1 * 33]); o.y = pk2(s[2 * 33], s[3 * 33]); o.z = pk2(s[4 * 33], s[5 * 33]); o.w = pk2(s[6 * 33], s[7 * 33]);
        *(GAS v4u*)(WT + (size_t)(dst_row0 + n) * K + k0 + 8 * c) = o; }
    LDS_WAIT(); asm volatile("" ::: "memory");
}

struct Args { const float* in[25]; float* out; unsigned char* ws; int ph_lo, ph_hi; };
constexpr int P_N1G = 0, P_N2G = 4096, P_QG = 8192, P_KG = 8320, P_GKF = 8448, P_GKB = 24832, P_BGF = 41216, P_BGB = 42240, P_OG = 43264, P_WR = 43776, P_BR = 174848, P_BGU = 174976, P_BDN = 437120, P_END = 568192;
#define LAUNDER_S(p) asm volatile("" : "+s"(p))
#define LAUNDER_V(p) asm volatile("" : "+v"(p))
#define PARF(ws) ((const float*)((ws) + WS_PAR))

__device__ __forceinline__ void p0_prologue(const Args& A, LAS unsigned char* lds, int gw, int NGW, int wave, int lane) {
    unsigned char* ws = A.ws;
    LAS float* scr = (LAS float*)(lds + RING_OFF + wave * 16384);
    constexpr int I_QKV = 2 * 16 * (QKVN / 32), I_WO = 2 * 16 * 32, I_WIN = 2 * 16 * (WINN / 32), I_GU = 128 * 16 * 64, I_DN = 128 * 16 * 32;
    constexpr int NITEMS = I_GU + I_DN + I_QKV + I_WO + I_WIN + I_WO;
    for (int it = gw; it < NITEMS; it += NGW) {
        int r = it;
        if (r < I_GU) { const int mat = r / (16 * 64), q = r - mat * (16 * 64), kb = q / 64, nb = q - kb * 64, n0 = nb * 32;
            const int dst = ((n0 & 1023) >> 7) * 256 + (n0 >> 10) * 128 + (n0 & 127);
            transpose_item(A.in[21] + (size_t)mat * 1024 * 2048, 1024, 2048, (bf16*)(ws + WS_WGU) + (size_t)mat * 2048 * 1024, kb * 64, n0, dst, scr, lane); continue; } r -= I_GU;
        if (r < I_DN) { const int mat = r / (16 * 32), q = r - mat * (16 * 32), kb = q / 32, nb = q - kb * 32;
            transpose_item(A.in[23] + (size_t)mat * 1024 * 1024, 1024, 1024, (bf16*)(ws + WS_WDN) + (size_t)mat * 1024 * 1024, kb * 64, nb * 32, nb * 32, scr, lane); continue; } r -= I_DN;
        if (r < I_QKV) { const int per = 16 * (QKVN / 32), mat = r / per, q = r - mat * per, kb = q / (QKVN / 32), nb = q - kb * (QKVN / 32);
            transpose_item(A.in[8] + (size_t)mat * 1024 * QKVN, 1024, QKVN, (bf16*)(ws + WS_WQKV) + (size_t)mat * QKVN * 1024, kb * 64, nb * 32, nb * 32, scr, lane); continue; } r -= I_QKV;
        if (r < I_WO) { const int mat = r / 512, q = r - mat * 512, kb = q / 32, nb = q - kb * 32;
            transpose_item(A.in[11] + (size_t)mat * 1024 * 1024, 1024, 1024, (bf16*)(ws + WS_WOA) + (size_t)mat * 1024 * 1024, kb * 64, nb * 32, nb * 32, scr, lane); continue; } r -= I_WO;
        if (r < I_WIN) { const int per = 16 * (WINN / 32), mat = r / per, q = r - mat * per, kb = q / (WINN / 32), nb = q - kb * (WINN / 32);
            transpose_item(A.in[12] + (size_t)mat * 1024 * WINN, 1024, WINN, (bf16*)(ws + WS_WIN) + (size_t)mat * WINP * 1024, kb * 64, nb * 32, nb * 32, scr, lane); continue; } r -= I_WIN;
        { const int mat = r / 512, q = r - mat * 512, kb = q / 32, nb = q - kb * 32;
            transpose_item(A.in[18] + (size_t)mat * 1024 * 1024, 1024, 1024, (bf16*)(ws + WS_WOG) + (size_t)mat * 1024 * 1024, kb * 64, nb * 32, nb * 32, scr, lane); }
    }
    for (int it = gw; it < 2 * (WINP - WINN); it += NGW) { const int mat = it / (WINP - WINN), rr = WINN + it - mat * (WINP - WINN);
        GAS v4u* p = (GAS v4u*)((bf16*)(ws + WS_WIN) + ((size_t)mat * WINP + rr) * 1024) + lane; p[0] = (v4u){0u, 0u, 0u, 0u}; p[64] = (v4u){0u, 0u, 0u, 0u}; }
    for (int it = gw; it < NLAYER * 24 * 16; it += NGW) {
        const int l = it / (24 * 16), q = it - l * (24 * 16), cg = q / 16, kc = q - cg * 16;
        float s[MODROWS];
#pragma unroll
        for (int r = 0; r < MODROWS; ++r) { const float cv = (r < 8) ? A.in[1][r * 1024 + kc * 64 + lane] : A.in[3][kc * 64 + lane]; s[r] = silu_f(cv); }
        f32x4 acc[MODROWS];
#pragma unroll
        for (int r = 0; r < MODROWS; ++r) acc[r] = (f32x4){0.f, 0.f, 0.f, 0.f};
        const float* wp = A.in[4] + ((size_t)l * 1024 + kc * 64) * NMODC + cg * 256 + 4 * lane;
#pragma unroll 4
        for (int kk = 0; kk < 64; ++kk) { const f32x4 w = *(const f32x4*)(wp + (size_t)kk * NMODC);
#pragma unroll
            for (int r = 0; r < MODROWS; ++r) { const float sv = __shfl(s[r], kk); acc[r] = acc[r] + w * sv; } }
        float* op = (float*)(ws + WS_MODP) + (size_t)kc * (NLAYER * MODROWS * NMODC) + (size_t)l * MODROWS * NMODC + cg * 256 + 4 * lane;
#pragma unroll
        for (int r = 0; r < MODROWS; ++r) *(f32x4*)(op + (size_t)r * NMODC) = acc[r];
    }
    for (int m = gw; m < MT; m += NGW) { const int b = m / TB, w = m - b * TB;
        const float* src = (w < CTXL) ? A.in[2] + ((size_t)b * CTXL + w) * 1024 : A.in[0] + ((size_t)b * SEQ + (w - CTXL)) * 1024;
        const GAS f32x4* sp = (const GAS f32x4*)src + lane; GAS unsigned long long* dp = (GAS unsigned long long*)((bf16*)(ws + WS_X) + (size_t)m * 1024) + lane;
#pragma unroll
        for (int j = 0; j < 4; ++j) dp[64 * j] = f32_to_bf4(sp[64 * j]); }
    { float* par = (float*)(ws + WS_PAR); const int gt = gw * 64 + lane, NGT = NGW * 64;
#define CPY(src, n, off) for (int i = gt; i < (n); i += NGT) par[(off) + i] = A.in[src][i];
      CPY(6, 4096, P_N1G) CPY(7, 4096, P_N2G) CPY(9, 128, P_QG) CPY(10, 128, P_KG) CPY(13, 16384, P_GKF) CPY(15, 16384, P_GKB) CPY(14, 1024, P_BGF) CPY(16, 1024, P_BGB)
      CPY(17, 512, P_OG) CPY(19, 131072, P_WR) CPY(20, 128, P_BR) CPY(22, 262144, P_BGU) CPY(24, 131072, P_BDN)
#undef CPY
    }
    for (int idx = gw * 64 + lane; idx < SEQ * 32; idx += NGW * 64) { const int s = idx >> 5, i = idx & 31;
        const float invf = 1.0f / powf(10000.0f, (float)(i & 15) * (1.0f / 16.0f));
        const float ang = (float)((i < 16) ? (s >> 6) : (s & 63)) * invf;
        ((float*)(ws + WS_ROPE))[idx] = cosf(ang); ((float*)(ws + WS_ROPE))[SEQ * 32 + idx] = sinf(ang); }
}
__device__ __forceinline__ void p1_mod_reduce(const Args& A, int gtid, int NGT) {
    const float* P = (const float*)(A.ws + WS_MODP); float* Mo = (float*)(A.ws + WS_MOD);
    constexpr int N = NLAYER * MODROWS * NMODC;
    for (int i = gtid; i < N; i += NGT) { const int l = i / (MODROWS * NMODC), c = i % NMODC; float s = A.in[5][l * NMODC + c];
#pragma unroll
        for (int k = 0; k < 16; ++k) s += P[(size_t)k * N + i];
        Mo[i] = s; }
}
__device__ __forceinline__ void modulate_row(const bf16* xrow, const float* ng, const float* shp, const float* scp, bf16* orow, int lane, f32x4 (&y)[4], float& rs_out) {
    const GAS unsigned long long* xr = (const GAS unsigned long long*)xrow + lane;
    float ss = 0.f;
#pragma unroll
    for (int j = 0; j < 4; ++j) { y[j] = bf4_to_f32(xr[64 * j]); ss += (y[j].x * y[j].x + y[j].y * y[j].y) + (y[j].z * y[j].z + y[j].w * y[j].w); }
    const float rs = 1.0f / sqrtf(wave_sum(ss) * (1.0f / 1024.0f) + RMS_EPS); rs_out = rs;
    GAS unsigned long long* o8 = (GAS unsigned long long*)orow + lane;
#pragma unroll
    for (int j = 0; j < 4; ++j) { const f32x4 g = ((const GAS f32x4*)ng)[64 * j + lane], sh = ((const GAS f32x4*)shp)[64 * j + lane], sc = ((const GAS f32x4*)scp)[64 * j + lane];
        y[j] = (y[j] * rs) * g * (sc + 1.0f) + sh;
        o8[64 * j] = (unsigned long long)pk2(y[j].x, y[j].y) | ((unsigned long long)pk2(y[j].z, y[j].w) << 32); }
}
__device__ __forceinline__ void phase_modulate1(unsigned char* ws, int layer, int gw, int NGW, int lane) {
    const bf16* X = (const bf16*)(ws + WS_X); bf16* XN = (bf16*)(ws + WS_XN);
    const float* ng = PARF(ws) + P_N1G + layer * 1024; const float* Mo = (const float*)(ws + WS_MOD) + (size_t)layer * MODROWS * NMODC;
    for (int m = gw; m < MT; m += NGW) { const int mr = mod_row(m); f32x4 y[4]; float rs;
        modulate_row(X + (size_t)m * 1024, ng, Mo + (size_t)mr * NMODC + 0 * 1024, Mo + (size_t)mr * NMODC + 1 * 1024, XN + (size_t)m * 1024, lane, y, rs); }
}
__device__ __forceinline__ void phase_qknorm_rope(unsigned char* ws, int la, int gw, int NGW, int lane) {
    bf16* Qb = (bf16*)(ws + WS_Q); bf16* Kb = (bf16*)(ws + WS_K);
    const float* qg = PARF(ws) + P_QG + la * 64; const float* kg = PARF(ws) + P_KG + la * 64; const float* ropec = (const float*)(ws + WS_ROPE); const float* ropes = ropec + SEQ * 32;
    const int i = lane & 31, hs = lane >> 5;
    for (int m = gw; m < MT; m += NGW) { const int b = m / TB, w = m - b * TB; const bool lat = w >= CTXL;
        float cs = 1.f, sn = 0.f; if (lat) { cs = ropec[(w - CTXL) * 32 + i]; sn = ropes[(w - CTXL) * 32 + i]; }
#pragma unroll 2
        for (int hh = 0; hh < 20; hh += 2) { const int hd = hh + hs;
            unsigned* p = (hd < 16) ? (unsigned*)(Qb + (size_t)m * 1024 + hd * 64) + i : (unsigned*)(Kb + (size_t)m * 256 + (hd - 16) * 64) + i;
            const float* gp = (hd < 16) ? qg : kg; const float scl = (hd < 16) ? ATT_C2 : 1.0f;
            const unsigned v = *p; const float x1 = __uint_as_float(v << 16), x2 = __uint_as_float(v & 0xffff0000u);
            float ss = x1 * x1 + x2 * x2;
#pragma unroll
            for (int o = 1; o < 32; o <<= 1) ss += __shfl_xor(ss, o);
            const float rs = 1.0f / sqrtf(ss * (1.0f / 64.0f) + RMS_EPS);
            const float y1 = x1 * rs * gp[2 * i], y2 = x2 * rs * gp[2 * i + 1];
            const float r1 = (y1 * cs - y2 * sn) * scl, r2 = (y1 * sn + y2 * cs) * scl;
            *p = pk2(r1, r2); }
    }
}
__device__ __forceinline__ void phase_gla_recurrent(unsigned char* ws, int lg, LAS unsigned char* lds, int tid) {
    const int unit = blockIdx.x; if (unit >= 128) return;
    const int half = unit & 1, dir = (unit >> 1) & 1, h = (unit >> 2) & 3, b = unit >> 4;
    const bf16* G = (const bf16*)(ws + WS_G);
    float* Oo = (float*)(ws + (dir ? WS_OB : WS_OF));
    const float* wg = PARF(ws) + (dir ? P_GKB : P_GKF) + (size_t)lg * 16 * 512; const float* bg = PARF(ws) + (dir ? P_BGB : P_BGF) + lg * 512;
    LAS float* qq = (LAS float*)(lds + RING_OFF); LAS float* kk = qq + 64 * 128; LAS float* dd = kk + 64 * 128; LAS float* vv = dd + 64 * 128;
    const int sd = tid & 127, st0 = tid >> 7;
    float wcol[16];
#pragma unroll
    for (int r = 0; r < 16; ++r) wcol[r] = wg[r * 512 + h * 128 + sd];
    const float bcol = bg[h * 128 + sd];
    const int c = tid >> 2, dq = tid & 3;
    float s[32];
#pragma unroll
    for (int j = 0; j < 32; ++j) s[j] = 0.f;
    const float qscale = 0.08838834764831845f;
    for (int ch = 0; ch < TB / 64; ++ch) {
        __syncthreads();
#pragma unroll 4
        for (int i = 0; i < 16; ++i) { const int tt = st0 + 4 * i, n = 64 * ch + tt;
            const int w = dir ? (n < CTXL ? (CTXL - 1 - n) : (TB + CTXL - 1 - n)) : n;
            const bf16* gr = G + ((size_t)b * TB + w) * WINP;
            const float qv = bf2f(gr[h * 128 + sd]) * qscale, kv = bf2f(gr[512 + h * 128 + sd]);
            const bf16* lp = gr + 3072 + dir * 16; float z = bcol;
#pragma unroll
            for (int r = 0; r < 16; ++r) z += bf2f(lp[r]) * wcol[r];
            const float ls = fminf(z, 0.f) - log1pf(__expf(-fabsf(z)));
            qq[tt * 128 + sd] = qv; kk[tt * 128 + sd] = kv; dd[tt * 128 + sd] = __expf(ls * (1.0f / 16.0f));
            vv[tt * 128 + sd] = bf2f(gr[1024 + h * 256 + half * 128 + sd]); }
        __syncthreads();
        for (int tt = 0; tt < 64; ++tt) { const int n = 64 * ch + tt; const int w = dir ? (n < CTXL ? (CTXL - 1 - n) : (TB + CTXL - 1 - n)) : n;
            const float v = vv[tt * 128 + c]; float acc = 0.f;
            const LAS f32x4* q4 = (const LAS f32x4*)(qq + tt * 128 + dq * 32); const LAS f32x4* k4 = (const LAS f32x4*)(kk + tt * 128 + dq * 32); const LAS f32x4* d4 = (const LAS f32x4*)(dd + tt * 128 + dq * 32);
#pragma unroll
            for (int j = 0; j < 8; ++j) { const f32x4 qv = q4[j], kv = k4[j], dv = d4[j];
                s[4 * j + 0] = s[4 * j + 0] * dv.x + kv.x * v; acc += qv.x * s[4 * j + 0];
                s[4 * j + 1] = s[4 * j + 1] * dv.y + kv.y * v; acc += qv.y * s[4 * j + 1];
                s[4 * j + 2] = s[4 * j + 2] * dv.z + kv.z * v; acc += qv.z * s[4 * j + 2];
                s[4 * j + 3] = s[4 * j + 3] * dv.w + kv.w * v; acc += qv.w * s[4 * j + 3]; }
            acc += __shfl_xor(acc, 1); acc += __shfl_xor(acc, 2);
            if (dq == 0) Oo[((size_t)b * TB + w) * 1024 + h * 256 + half * 128 + c] = acc; }
    }
}
__device__ __forceinline__ void phase_gla_readout(unsigned char* ws, int lg, int gw, int NGW, int lane) {
    const float* OF = (const float*)(ws + WS_OF); const float* OB = (const float*)(ws + WS_OB); const bf16* G = (const bf16*)(ws + WS_G); bf16* OG = (bf16*)(ws + WS_Q);
    const f32x4 og = ((const GAS f32x4*)(PARF(ws) + P_OG + lg * 256))[lane];
    for (int m = gw; m < MT; m += NGW) {
#pragma unroll
        for (int hh = 0; hh < 4; ++hh) { const size_t off = (size_t)m * 1024 + hh * 256 + 4 * lane;
            f32x4 o = *(const GAS f32x4*)(OF + off) + *(const GAS f32x4*)(OB + off);
            const float ss = wave_sum((o.x * o.x + o.y * o.y) + (o.z * o.z + o.w * o.w));
            const float rs = 1.0f / sqrtf(ss * (1.0f / 256.0f) + RMS_EPS);
            const unsigned long long rv = *(const GAS unsigned long long*)(G + (size_t)m * WINP + 2048 + hh * 256 + 4 * lane);
            const float r0 = __uint_as_float((unsigned)(rv & 0xffffu) << 16), r1 = __uint_as_float((unsigned)(rv >> 16) << 16), r2 = __uint_as_float((unsigned)((rv >> 32) & 0xffffu) << 16), r3 = __uint_as_float((unsigned)(rv >> 48) << 16);
            o = o * rs * og;
            o.x *= silu_f(r0); o.y *= silu_f(r1); o.z *= silu_f(r2); o.w *= silu_f(r3);
            *(GAS unsigned long long*)(OG + off) = (unsigned long long)pk2(o.x, o.y) | ((unsigned long long)pk2(o.z, o.w) << 32); }
    }
}
constexpr size_t WS_GQ = WS_XG, WS_GKH = WS_XG + 68 * MiB, WS_GKT = WS_XG + 136 * MiB, WS_GVT = WS_XG + 204 * MiB, WS_GDL = WS_ACT, WS_SX = WS_OF;
static_assert((size_t)2176 * 2 * 16384 <= 68 * MiB && (size_t)2176 * 256 * 64 * 2 <= 68 * MiB && (size_t)64 * 68 * 65536 <= 272 * MiB, "gla buffers");
typedef float f32x16 __attribute__((ext_vector_type(16)));
__device__ __forceinline__ float log_sigmoid_fast(float z) { return fminf(z, 0.f) - __logf(1.0f + __expf(-fabsf(z))); }

__device__ __forceinline__ void phase_gla_g0(unsigned char* ws, int lg, LAS unsigned char* lds, int tid) {
    const bf16* G = (const bf16*)(ws + WS_G);
    LAS float* tot = (LAS float*)(lds + RING_OFF);
    const int d2 = tid & 63, tb = tid >> 6;
    for (int cn = blockIdx.x; cn < 2176; cn += gridDim.x) {
        const int n = cn % 68, bh = cn / 68, h = bh & 3, b = bh >> 2;
        const size_t row0 = (size_t)b * TB + 64 * n + 8 * tb;
        float wf0[16], wf1[16], wb0[16], wb1[16];
        { const float* wgf = PARF(ws) + P_GKF + (size_t)lg * 16 * 512 + h * 128 + 2 * d2; const float* wgb = PARF(ws) + P_GKB + (size_t)lg * 16 * 512 + h * 128 + 2 * d2;
#pragma unroll
          for (int r = 0; r < 16; ++r) { const f32x2 a = *(const GAS f32x2*)(wgf + r * 512), c = *(const GAS f32x2*)(wgb + r * 512); wf0[r] = a.x; wf1[r] = a.y; wb0[r] = c.x; wb1[r] = c.y; } }
        const f32x2 bf_ = *(const GAS f32x2*)(PARF(ws) + P_BGF + lg * 512 + h * 128 + 2 * d2), bb_ = *(const GAS f32x2*)(PARF(ws) + P_BGB + lg * 512 + h * 128 + 2 * d2);
        float gf0[8], gf1[8], gb0[8], gb1[8]; unsigned qk[8][2];
#pragma unroll
        for (int j = 0; j < 8; ++j) { const bf16* gr = G + (row0 + j) * WINP;
            const v4u l0 = *(const GAS v4u*)(gr + 3072), l1 = *(const GAS v4u*)(gr + 3080), l2 = *(const GAS v4u*)(gr + 3088), l3 = *(const GAS v4u*)(gr + 3096);
            qk[j][0] = *(const GAS unsigned*)(gr + h * 128 + 2 * d2); qk[j][1] = *(const GAS unsigned*)(gr + 512 + h * 128 + 2 * d2);
            float lf[16], lb[16];
            lf[0] = __uint_as_float(l0.x << 16); lf[1] = __uint_as_float(l0.x & 0xffff0000u); lf[2] = __uint_as_float(l0.y << 16); lf[3] = __uint_as_float(l0.y & 0xffff0000u);
            lf[4] = __uint_as_float(l0.z << 16); lf[5] = __uint_as_float(l0.z & 0xffff0000u); lf[6] = __uint_as_float(l0.w << 16); lf[7] = __uint_as_float(l0.w & 0xffff0000u);
            lf[8] = __uint_as_float(l1.x << 16); lf[9] = __uint_as_float(l1.x & 0xffff0000u); lf[10] = __uint_as_float(l1.y << 16); lf[11] = __uint_as_float(l1.y & 0xffff0000u);
            lf[12] = __uint_as_float(l1.z << 16); lf[13] = __uint_as_float(l1.z & 0xffff0000u); lf[14] = __uint_as_float(l1.w << 16); lf[15] = __uint_as_float(l1.w & 0xffff0000u);
            lb[0] = __uint_as_float(l2.x << 16); lb[1] = __uint_as_float(l2.x & 0xffff0000u); lb[2] = __uint_as_float(l2.y << 16); lb[3] = __uint_as_float(l2.y & 0xffff0000u);
            lb[4] = __uint_as_float(l2.z << 16); lb[5] = __uint_as_float(l2.z & 0xffff0000u); lb[6] = __uint_as_float(l2.w << 16); lb[7] = __uint_as_float(l2.w & 0xffff0000u);
            lb[8] = __uint_as_float(l3.x << 16); lb[9] = __uint_as_float(l3.x & 0xffff0000u); lb[10] = __uint_as_float(l3.y << 16); lb[11] = __uint_as_float(l3.y & 0xffff0000u);
            lb[12] = __uint_as_float(l3.z << 16); lb[13] = __uint_as_float(l3.z & 0xffff0000u); lb[14] = __uint_as_float(l3.w << 16); lb[15] = __uint_as_float(l3.w & 0xffff0000u);
            float zf0 = bf_.x, zf1 = bf_.y, zb0 = bb_.x, zb1 = bb_.y;
#pragma unroll
            for (int r = 0; r < 16; ++r) { zf0 += lf[r] * wf0[r]; zf1 += lf[r] * wf1[r]; zb0 += lb[r] * wb0[r]; zb1 += lb[r] * wb1[r]; }
            gf0[j] = log_sigmoid_fast(zf0) * 0.0625f; gf1[j] = log_sigmoid_fast(zf1) * 0.0625f; gb0[j] = log_sigmoid_fast(zb0) * 0.0625f; gb1[j] = log_sigmoid_fast(zb1) * 0.0625f; }
#pragma unroll
        for (int j = 1; j < 8; ++j) { gf0[j] += gf0[j - 1]; gf1[j] += gf1[j - 1]; gb0[7 - j] += gb0[8 - j]; gb1[7 - j] += gb1[8 - j]; }
        __syncthreads();
        *(LAS f32x2*)(tot + (0 * 8 + tb) * 128 + 2 * d2) = (f32x2){gf0[7], gf1[7]}; *(LAS f32x2*)(tot + (1 * 8 + tb) * 128 + 2 * d2) = (f32x2){gb0[0], gb1[0]};
        __syncthreads();
        float pf0 = 0.f, pf1 = 0.f, pb0 = 0.f, pb1 = 0.f, lf0 = 0.f, lf1 = 0.f, lb0 = 0.f, lb1 = 0.f;
#pragma unroll
        for (int q = 0; q < 8; ++q) { const f32x2 a = *(const LAS f32x2*)(tot + (0 * 8 + q) * 128 + 2 * d2), c = *(const LAS f32x2*)(tot + (1 * 8 + q) * 128 + 2 * d2);
            lf0 += a.x; lf1 += a.y; lb0 += c.x; lb1 += c.y;
            if (q < tb) { pf0 += a.x; pf1 += a.y; } if (q > tb) { pb0 += c.x; pb1 += c.y; } }
        const size_t itf = (size_t)cn * 2, itb = itf + 1;
        bf16* Qf = (bf16*)(ws + WS_GQ) + itf * 8192; bf16* Qb = Qf + 8192; bf16* Kf = (bf16*)(ws + WS_GKH) + itf * 8192; bf16* Kb = Kf + 8192;
        const float elf0 = __expf(lf0), elf1 = __expf(lf1), elb0 = __expf(lb0), elb1 = __expf(lb1);
        float ktf0[8], ktf1[8], ktb0[8], ktb1[8];
#pragma unroll
        for (int j = 0; j < 8; ++j) { const int t = 8 * tb + j;
            const float q0 = __uint_as_float(qk[j][0] << 16) * 0.08838834764831845f, q1 = __uint_as_float(qk[j][0] & 0xffff0000u) * 0.08838834764831845f;
            const float k0 = __uint_as_float(qk[j][1] << 16), k1 = __uint_as_float(qk[j][1] & 0xffff0000u);
            const float ef0 = __expf(pf0 + gf0[j]), ef1 = __expf(pf1 + gf1[j]), eb0 = __expf(pb0 + gb0[j]), eb1 = __expf(pb1 + gb1[j]);
            const float rf0 = __builtin_amdgcn_rcpf(ef0), rf1 = __builtin_amdgcn_rcpf(ef1), rb0 = __builtin_amdgcn_rcpf(eb0), rb1 = __builtin_amdgcn_rcpf(eb1);
            *(GAS unsigned*)(Qf + t * 128 + 2 * d2) = pk2(q0 * ef0, q1 * ef1); *(GAS unsigned*)(Qb + t * 128 + 2 * d2) = pk2(q0 * eb0, q1 * eb1);
            *(GAS unsigned*)(Kf + t * 128 + 2 * d2) = pk2(k0 * rf0, k1 * rf1); *(GAS unsigned*)(Kb + t * 128 + 2 * d2) = pk2(k0 * rb0, k1 * rb1);
            ktf0[j] = k0 * rf0 * elf0; ktf1[j] = k1 * rf1 * elf1; ktb0[j] = k0 * rb0 * elb0; ktb1[j] = k1 * rb1 * elb1; }
        { bf16* Tf = (bf16*)(ws + WS_GKT) + itf * 8192 + (size_t)(2 * d2) * 64 + 8 * tb; bf16* Tb = Tf + 8192;
          *(GAS v4u*)Tf = (v4u){pk2(ktf0[0], ktf0[1]), pk2(ktf0[2], ktf0[3]), pk2(ktf0[4], ktf0[5]), pk2(ktf0[6], ktf0[7])};
          *(GAS v4u*)(Tf + 64) = (v4u){pk2(ktf1[0], ktf1[1]), pk2(ktf1[2], ktf1[3]), pk2(ktf1[4], ktf1[5]), pk2(ktf1[6], ktf1[7])};
          *(GAS v4u*)Tb = (v4u){pk2(ktb0[0], ktb0[1]), pk2(ktb0[2], ktb0[3]), pk2(ktb0[4], ktb0[5]), pk2(ktb0[6], ktb0[7])};
          *(GAS v4u*)(Tb + 64) = (v4u){pk2(ktb1[0], ktb1[1]), pk2(ktb1[2], ktb1[3]), pk2(ktb1[4], ktb1[5]), pk2(ktb1[6], ktb1[7])}; }
        if (tb == 0) { float* DLp = (float*)(ws + WS_GDL) + itf * 128 + 2 * d2; *(GAS f32x2*)DLp = (f32x2){elf0, elf1}; *(GAS f32x2*)(DLp + 128) = (f32x2){elb0, elb1}; }
        {
            const int dv = tid & 255, th = tid >> 8; const bf16* vp = G + ((size_t)b * TB + 64 * n + 32 * th) * WINP + 1024 + h * 256 + dv;
            unsigned wv[16];
#pragma unroll
            for (int j = 0; j < 16; ++j) wv[j] = (unsigned)vp[(size_t)(2 * j) * WINP] | ((unsigned)vp[(size_t)(2 * j + 1) * WINP] << 16);
            GAS v4u* op = (GAS v4u*)((bf16*)(ws + WS_GVT) + ((size_t)cn * 256 + dv) * 64 + 32 * th);
            op[0] = (v4u){wv[0], wv[1], wv[2], wv[3]}; op[1] = (v4u){wv[4], wv[5], wv[6], wv[7]}; op[2] = (v4u){wv[8], wv[9], wv[10], wv[11]}; op[3] = (v4u){wv[12], wv[13], wv[14], wv[15]}; }
    }
}
struct G12Ops { bf16x8 a[4], b[4]; f32x4 d[4]; };
__device__ __forceinline__ void g12_load(G12Ops& o, unsigned char* ws, int bh, int dir, int m, int kb, int vb, int r, int hh) {
    const int n = dir ? (m < 4 ? 3 - m : 71 - m) : m; const size_t cn = (size_t)bh * 68 + n, item = cn * 2 + dir;
    const bf16* ap = (const bf16*)(ws + WS_GKT) + item * 8192 + (size_t)(32 * kb + r) * 64 + 8 * hh;
    const bf16* bp = (const bf16*)(ws + WS_GVT) + (cn * 256 + 32 * vb + r) * 64 + 8 * hh;
    const float* dp = (const float*)(ws + WS_GDL) + item * 128 + 32 * kb + 4 * hh;
#pragma unroll
    for (int ks = 0; ks < 4; ++ks) { o.a[ks] = *(const GAS bf16x8*)(ap + 16 * ks); o.b[ks] = *(const GAS bf16x8*)(bp + 16 * ks); o.d[ks] = *(const GAS f32x4*)(dp + 8 * ks); }
}
__device__ __forceinline__ void phase_gla_g12(unsigned char* ws, LAS unsigned char* lds, int gwv, int wave, int lane) {
    if (gwv >= 2048) return;
    const int chain = gwv >> 5, blk = gwv & 31, kb = blk & 3, vb = blk >> 2, dir = chain & 1, bh = chain >> 1;
    const int r = lane & 31, hh = lane >> 5;
    LAS unsigned char* wl = lds + RING_OFF + wave * 2048;
    f32x16 acc;
#pragma unroll
    for (int g = 0; g < 16; ++g) acc[g] = 0.f;
    G12Ops cur, nxt;
    g12_load(cur, ws, bh, dir, 0, kb, vb, r, hh);
    for (int m = 0; m < 68; ++m) {
        const int n = dir ? (m < 4 ? 3 - m : 71 - m) : m;
        if (m + 1 < 68) g12_load(nxt, ws, bh, dir, m + 1, kb, vb, r, hh); else nxt = cur;
#pragma unroll
        for (int gg = 0; gg < 4; ++gg) *(LAS unsigned long long*)(wl + r * 64 + 16 * gg + 8 * hh) = (unsigned long long)pk2(acc[4 * gg], acc[4 * gg + 1]) | ((unsigned long long)pk2(acc[4 * gg + 2], acc[4 * gg + 3]) << 32);
        LDS_WAIT();
        const v4u s0 = *(const LAS v4u*)(wl + lane * 16), s1 = *(const LAS v4u*)(wl + 1024 + lane * 16);
        LDS_WAIT();
        { bf16* sp = (bf16*)(ws + WS_SX) + ((size_t)(bh * 2 + dir) * 68 + n) * 32768 + (size_t)(kb * 8 + vb) * 1024; ((GAS v4u*)sp)[lane] = s0; ((GAS v4u*)sp)[64 + lane] = s1; }
#pragma unroll
        for (int gg = 0; gg < 4; ++gg) { acc[4 * gg] *= cur.d[gg].x; acc[4 * gg + 1] *= cur.d[gg].y; acc[4 * gg + 2] *= cur.d[gg].z; acc[4 * gg + 3] *= cur.d[gg].w; }
#pragma unroll
        for (int ks = 0; ks < 4; ++ks) acc = __builtin_amdgcn_mfma_f32_32x32x16_bf16(cur.a[ks], cur.b[ks], acc, 0, 0, 0);
        cur = nxt;
    }
}
constexpr int G3_RS = 272, G3_TILE = 64 * G3_RS, G3_OL = 4 * G3_TILE  , G3_LD = 260;
static_assert(G3_OL + 64 * G3_LD * 4 <= MISC_OFF, "G3 LDS");
__device__ __forceinline__ void phase_gla_g3(unsigned char* ws, int lg, LAS unsigned char* lds, int tid) {
    const int lane = tid & 63, wave = __builtin_amdgcn_readfirstlane(tid >> 6), r = lane & 31, hh = lane >> 5, vb = wave;
    LAS unsigned char* TL = lds + RING_OFF; LAS float* OL = (LAS float*)(lds + RING_OFF + G3_OL);
    const bf16* G = (const bf16*)(ws + WS_G); bf16* OG = (bf16*)(ws + WS_Q);
    for (int cn = blockIdx.x; cn < 2176; cn += gridDim.x) {
        const int n = cn % 68, bh = cn / 68, h = bh & 3, b = bh >> 2;
        v4u st[4][2];
#pragma unroll
        for (int tl = 0; tl < 4; ++tl) { const bf16* src = (const bf16*)(ws + ((tl & 1) ? WS_GKH : WS_GQ)) + ((size_t)cn * 2 + (tl >> 1)) * 8192;
#pragma unroll
            for (int j = 0; j < 2; ++j) st[tl][j] = ((const GAS v4u*)src)[tid + 512 * j]; }
        __syncthreads();
#pragma unroll
        for (int tl = 0; tl < 4; ++tl)
#pragma unroll
            for (int j = 0; j < 2; ++j) { const int q = tid + 512 * j, row = q >> 4, ch = q & 15; *(LAS v4u*)(TL + tl * G3_TILE + row * G3_RS + ch * 16) = st[tl][j]; }
        __syncthreads();
        f32x16 P00, P01, P10, P11, O0, O1;
#pragma unroll
        for (int g = 0; g < 16; ++g) { P00[g] = 0.f; P01[g] = 0.f; P10[g] = 0.f; P11[g] = 0.f; O0[g] = 0.f; O1[g] = 0.f; }
#pragma unroll
        for (int dir = 0; dir < 2; ++dir) {
            const LAS unsigned char* Qt = TL + (2 * dir) * G3_TILE + r * G3_RS + 16 * hh; const LAS unsigned char* Kh = TL + (2 * dir + 1) * G3_TILE + r * G3_RS + 16 * hh;
            const bf16* Sx = (const bf16*)(ws + WS_SX) + ((size_t)(bh * 2 + dir) * 68 + n) * 32768 + (size_t)vb * 1024 + r * 32 + 8 * hh;
            f32x16 X00, X11, Xoff;
#pragma unroll
            for (int g = 0; g < 16; ++g) { X00[g] = 0.f; X11[g] = 0.f; Xoff[g] = 0.f; }
#pragma unroll
            for (int s = 0; s < 8; ++s) {
                const bf16x8 q0 = *(const LAS bf16x8*)(Qt + 32 * s), q1 = *(const LAS bf16x8*)(Qt + 32 * G3_RS + 32 * s);
                const bf16x8 k0 = *(const LAS bf16x8*)(Kh + 32 * s), k1 = *(const LAS bf16x8*)(Kh + 32 * G3_RS + 32 * s);
                const bf16x8 sx = *(const GAS bf16x8*)(Sx + (s >> 1) * 8192 + 16 * (s & 1));
                X00 = __builtin_amdgcn_mfma_f32_32x32x16_bf16(k0, q0, X00, 0, 0, 0);
                X11 = __builtin_amdgcn_mfma_f32_32x32x16_bf16(k1, q1, X11, 0, 0, 0);
                if (dir == 0) Xoff = __builtin_amdgcn_mfma_f32_32x32x16_bf16(k0, q1, Xoff, 0, 0, 0); else Xoff = __builtin_amdgcn_mfma_f32_32x32x16_bf16(k1, q0, Xoff, 0, 0, 0);
                O0 = __builtin_amdgcn_mfma_f32_32x32x16_bf16(q0, sx, O0, 0, 0, 0); O1 = __builtin_amdgcn_mfma_f32_32x32x16_bf16(q1, sx, O1, 0, 0, 0); }
#pragma unroll
            for (int g = 0; g < 16; ++g) { const int tj = (g & 3) + 8 * (g >> 2) + 4 * hh; const bool keep = dir ? (tj >= r) : (tj <= r);
                P00[g] += keep ? X00[g] : 0.f; P11[g] += keep ? X11[g] : 0.f;
                if (dir == 0) P01[g] += Xoff[g]; else P10[g] += Xoff[g]; }
        }
        { const bf16* Vt = (const bf16*)(ws + WS_GVT) + ((size_t)cn * 256 + 32 * vb + r) * 64 + 4 * hh;
#pragma unroll
          for (int jb = 0; jb < 2; ++jb)
#pragma unroll
            for (int s2 = 0; s2 < 2; ++s2) { const bf16* vp = Vt + 32 * jb + 16 * s2;
                const unsigned long long lo = *(const GAS unsigned long long*)vp, hi8 = *(const GAS unsigned long long*)(vp + 8);
                const bf16x8 bfv = __builtin_bit_cast(bf16x8, ((v4u){(unsigned)lo, (unsigned)(lo >> 32), (unsigned)hi8, (unsigned)(hi8 >> 32)}));
                const f32x16& Pa = jb ? P10 : P00; const f32x16& Pb = jb ? P11 : P01;
                const bf16x8 a0 = __builtin_bit_cast(bf16x8, ((v4u){pk2(Pa[8 * s2 + 0], Pa[8 * s2 + 1]), pk2(Pa[8 * s2 + 2], Pa[8 * s2 + 3]), pk2(Pa[8 * s2 + 4], Pa[8 * s2 + 5]), pk2(Pa[8 * s2 + 6], Pa[8 * s2 + 7])}));
                const bf16x8 a1 = __builtin_bit_cast(bf16x8, ((v4u){pk2(Pb[8 * s2 + 0], Pb[8 * s2 + 1]), pk2(Pb[8 * s2 + 2], Pb[8 * s2 + 3]), pk2(Pb[8 * s2 + 4], Pb[8 * s2 + 5]), pk2(Pb[8 * s2 + 6], Pb[8 * s2 + 7])}));
                O0 = __builtin_amdgcn_mfma_f32_32x32x16_bf16(a0, bfv, O0, 0, 0, 0); O1 = __builtin_amdgcn_mfma_f32_32x32x16_bf16(a1, bfv, O1, 0, 0, 0); } }
#pragma unroll
        for (int g = 0; g < 16; ++g) { const int t = (g & 3) + 8 * (g >> 2) + 4 * hh; OL[t * G3_LD + 32 * vb + r] = O0[g]; OL[(32 + t) * G3_LD + 32 * vb + r] = O1[g]; }
        __syncthreads();
        { const int t = tid >> 3, cc = tid & 7; const LAS f32x4* op = (const LAS f32x4*)(OL + t * G3_LD + 32 * cc);
          f32x4 o[8]; float ss = 0.f;
#pragma unroll
          for (int j = 0; j < 8; ++j) { o[j] = op[j]; ss += (o[j].x * o[j].x + o[j].y * o[j].y) + (o[j].z * o[j].z + o[j].w * o[j].w); }
          ss += __shfl_xor(ss, 1); ss += __shfl_xor(ss, 2); ss += __shfl_xor(ss, 4);
          const float rs = 1.0f / sqrtf(ss * (1.0f / 256.0f) + RMS_EPS);
          const size_t row = (size_t)b * TB + 64 * n + t;
          const GAS v4u* rp = (const GAS v4u*)(G + row * WINP + 2048 + h * 256 + 32 * cc); const GAS f32x4* gp = (const GAS f32x4*)(PARF(ws) + P_OG + lg * 256 + 32 * cc);
          GAS v4u* dst = (GAS v4u*)(OG + row * 1024 + h * 256 + 32 * cc);
#pragma unroll
          for (int j = 0; j < 4; ++j) { const v4u rv = rp[j]; const f32x4 g0 = gp[2 * j], g1 = gp[2 * j + 1]; const f32x4 a = o[2 * j] * rs * g0, c2 = o[2 * j + 1] * rs * g1;
              v4u w;
              w.x = pk2(a.x * silu_f(__uint_as_float(rv.x << 16)), a.y * silu_f(__uint_as_float(rv.x & 0xffff0000u)));
              w.y = pk2(a.z * silu_f(__uint_as_float(rv.y << 16)), a.w * silu_f(__uint_as_float(rv.y & 0xffff0000u)));
              w.z = pk2(c2.x * silu_f(__uint_as_float(rv.z << 16)), c2.y * silu_f(__uint_as_float(rv.z & 0xffff0000u)));
              w.w = pk2(c2.z * silu_f(__uint_as_float(rv.w << 16)), c2.w * silu_f(__uint_as_float(rv.w & 0xffff0000u)));
              dst[j] = w; } }
    }
}
constexpr int WIMG_RS = 2064;
static_assert(2 * 32 * WIMG_RS <= LDS_AUX, "router images below the aux tables");
__device__ __forceinline__ void phase_modulate2_route(unsigned char* ws, int layer, LAS unsigned char* lds, int vcu, int wave, int lane, int tid, bool dummy = false) {
    const bf16* X = (const bf16*)(ws + WS_X); bf16* XN = (bf16*)(ws + WS_XN);
    const float* ng = PARF(ws) + P_N2G + layer * 1024; const float* Mo = (const float*)(ws + WS_MOD) + (size_t)layer * MODROWS * NMODC;
    LAS unsigned char* WHI = lds + RING_OFF; LAS unsigned char* WLO = WHI + 32 * WIMG_RS;
    LAS unsigned* lcnt = (LAS unsigned*)(lds + AUX_LCNT); LAS unsigned* gb = (LAS unsigned*)(lds + AUX_GB); LAS unsigned* ent = (LAS unsigned*)(lds + AUX_ENT); LAS float* rsl = (LAS float*)(lds + AUX_RS);
    { const float* wsrc = PARF(ws) + P_WR + (size_t)layer * 1024 * 32;
      for (int idx = tid; idx < 1024 * 32; idx += NWAVES * 64) { const int k = idx >> 5, e = idx & 31; const float w = wsrc[idx]; const unsigned hi = f2bf(w), lo = f2bf(w - __uint_as_float(hi << 16));
          *(LAS unsigned short*)(WHI + e * WIMG_RS + 2 * k) = (unsigned short)hi; *(LAS unsigned short*)(WLO + e * WIMG_RS + 2 * k) = (unsigned short)lo; }
      if (tid < 32) lcnt[tid] = 0u; }
    gu32* cnt = (gu32*)(ws + WS_CTL) + CW_CNT + (layer + (dummy ? 4 : 0)) * 32 * 16;
    unsigned char* sbase = dummy ? ws + WS_XG : ws;
    const bool lastl = (layer == NLAYER - 1);
  for (int grp = vcu; grp < MT / 136; grp += (int)gridDim.x) {
    const int rbase = grp * 136;
    if (grp != vcu) { __syncthreads(); if (tid < 32) lcnt[tid] = 0u; }
    for (int rl = wave; rl < 136; rl += NWAVES) { const int m = rbase + rl, mr = mod_row(m);
        if (lastl && mr == 8) { if (lane == 0) rsl[rl] = 0.f; continue; }
        f32x4 y[4]; float rs;
        modulate_row(X + (size_t)m * 1024, ng, Mo + (size_t)mr * NMODC + 3 * 1024, Mo + (size_t)mr * NMODC + 4 * 1024, XN + (size_t)m * 1024, lane, y, rs);
        if (lane == 0) rsl[rl] = rs; }
    __syncthreads();
    if (wave < 5) {
        const int r = lane & 31, hh = lane >> 5; const int rl = (32 * wave + r < 136) ? 32 * wave + r : 135; const int m = rbase + rl, mr = mod_row(m);
        const float rsr = rsl[rl];
        const bf16* xp = X + (size_t)m * 1024 + 8 * hh; const float* gp = ng + 8 * hh; const float* scp = Mo + (size_t)mr * NMODC + 4 * 1024 + 8 * hh; const float* shp = Mo + (size_t)mr * NMODC + 3 * 1024 + 8 * hh;
        const LAS unsigned char* wh = WHI + r * WIMG_RS + 16 * hh; const LAS unsigned char* wl = WLO + r * WIMG_RS + 16 * hh;
        f32x16 acc;
#pragma unroll
        for (int g = 0; g < 16; ++g) acc[g] = 0.f;
#pragma unroll 2
        for (int s = 0; s < 64; ++s) {
            const v4u xr8 = *(const GAS v4u*)(xp + 16 * s); const f32x4 x0 = (f32x4){__uint_as_float(xr8.x << 16), __uint_as_float(xr8.x & 0xffff0000u), __uint_as_float(xr8.y << 16), __uint_as_float(xr8.y & 0xffff0000u)}, x1 = (f32x4){__uint_as_float(xr8.z << 16), __uint_as_float(xr8.z & 0xffff0000u), __uint_as_float(xr8.w << 16), __uint_as_float(xr8.w & 0xffff0000u)}; const f32x4 g0 = *(const GAS f32x4*)(gp + 16 * s), g1 = *(const GAS f32x4*)(gp + 16 * s + 4);
            const f32x4 c0 = *(const GAS f32x4*)(scp + 16 * s), c1 = *(const GAS f32x4*)(scp + 16 * s + 4), h0 = *(const GAS f32x4*)(shp + 16 * s), h1 = *(const GAS f32x4*)(shp + 16 * s + 4);
            const f32x4 y0 = (x0 * rsr) * g0 * (c0 + 1.0f) + h0, y1 = (x1 * rsr) * g1 * (c1 + 1.0f) + h1;
            v4u ph, pl;
            ph.x = pg8::cvt_pk_bf16(y0.x, y0.y); ph.y = pg8::cvt_pk_bf16(y0.z, y0.w); ph.z = pg8::cvt_pk_bf16(y1.x, y1.y); ph.w = pg8::cvt_pk_bf16(y1.z, y1.w);
            pl.x = pg8::cvt_pk_bf16(y0.x - __uint_as_float(ph.x << 16), y0.y - __uint_as_float(ph.x & 0xffff0000u)); pl.y = pg8::cvt_pk_bf16(y0.z - __uint_as_float(ph.y << 16), y0.w - __uint_as_float(ph.y & 0xffff0000u));
            pl.z = pg8::cvt_pk_bf16(y1.x - __uint_as_float(ph.z << 16), y1.y - __uint_as_float(ph.z & 0xffff0000u)); pl.w = pg8::cvt_pk_bf16(y1.z - __uint_as_float(ph.w << 16), y1.w - __uint_as_float(ph.w & 0xffff0000u));
            const bf16x8 ahi = __builtin_bit_cast(bf16x8, ph), alo = __builtin_bit_cast(bf16x8, pl);
            const bf16x8 bhi = *(const LAS bf16x8*)(wh + 32 * s), blo = *(const LAS bf16x8*)(wl + 32 * s);
            acc = __builtin_amdgcn_mfma_f32_32x32x16_bf16(ahi, bhi, acc, 0, 0, 0); acc = __builtin_amdgcn_mfma_f32_32x32x16_bf16(alo, bhi, acc, 0, 0, 0); acc = __builtin_amdgcn_mfma_f32_32x32x16_bf16(ahi, blo, acc, 0, 0, 0); }
        const float brt = (PARF(ws) + P_BR)[layer * 32 + r];
#pragma unroll
        for (int g = 0; g < 16; ++g) { const int rowl = 32 * wave + (g & 3) + 8 * (g >> 2) + 4 * hh;
            float v = acc[g] + brt; float tv[4]; int te[4];
#pragma unroll
            for (int k = 0; k < 4; ++k) { float mx = v;
#pragma unroll
                for (int o = 1; o < 32; o <<= 1) mx = fmaxf(mx, __shfl_xor(mx, o));
                const unsigned long long bm = __ballot(v == mx); const unsigned hm = hh ? (unsigned)(bm >> 32) : (unsigned)bm; const int first = __ffs((int)hm) - 1;
                te[k] = first; tv[k] = mx; if (r == first) v = -INFINITY; }
            const bool valid = rowl < 136 && !(lastl && mod_row(rbase + (rowl < 136 ? rowl : 135)) == 8);
            if (r == 0 && rowl < 136) {
                if (valid) { const float e1 = __expf(tv[1] - tv[0]), e2 = __expf(tv[2] - tv[0]), e3 = __expf(tv[3] - tv[0]); const float inv = 1.0f / (1.0f + e1 + e2 + e3);
                    const float wk[4] = {inv, e1 * inv, e2 * inv, e3 * inv};
#pragma unroll
                    for (int k = 0; k < 4; ++k) { const unsigned lp = atomicAdd((unsigned*)&lcnt[te[k]], 1u); ent[(rowl * 4 + k) * 2 + 0] = ((unsigned)te[k] << 24) | lp; ent[(rowl * 4 + k) * 2 + 1] = __float_as_uint(wk[k]); } }
                else {
#pragma unroll
                    for (int k = 0; k < 4; ++k) ent[(rowl * 4 + k) * 2 + 0] = 0xffffffffu; } } }
    }
    __syncthreads();
    if (tid < 32) gb[tid] = __hip_atomic_fetch_add(cnt + tid * 16, lcnt[tid], __ATOMIC_RELAXED, __HIP_MEMORY_SCOPE_AGENT);
    __syncthreads();
    for (int q = tid; q < 136 * 4; q += NWAVES * 64) { const unsigned pe = ent[q * 2 + 0];
        if (pe != 0xffffffffu) { const unsigned e = pe >> 24, lp = pe & 0xffffffu; const int m = rbase + (q >> 2);
            ((unsigned*)(sbase + WS_SLOT))[m * 4 + (q & 3)] = (e << 24) | (gb[e] + lp); ((unsigned*)(sbase + WS_GATEW))[m * 4 + (q & 3)] = ent[q * 2 + 1];
            if (!dummy) ((int*)(ws + WS_LIST))[(size_t)e * MT + gb[e] + lp] = m; } }
  }
}
__device__ __forceinline__ void build_expert_tables(unsigned char* ws, int layer, LAS unsigned char* lds, int tid) {
    LAS int* t2e = (LAS int*)(lds + AUX_T2E); LAS int* base = (LAS int*)(lds + AUX_BASE); LAS int* ntp = (LAS int*)(lds + AUX_NT); LAS int* cntl = (LAS int*)(lds + AUX_CNT);
    gu32* cnt = (gu32*)(ws + WS_CTL) + CW_CNT + layer * 32 * 16;
    __syncthreads();
    if (tid < 64) { const unsigned cval = (tid < 32) ? __hip_atomic_load(cnt + tid * 16, RLX_AGENT) : 0u; const int tiles = (int)((cval + 255u) >> 8);
        int pre = tiles;
#pragma unroll
        for (int o = 1; o < 32; o <<= 1) { const int t = __shfl_up(pre, o); if ((tid & 63) >= o) pre += t; }
        const int start = pre - tiles;
        if (tid < 32) { base[tid] = start * 256; cntl[tid] = (int)cval; for (int t = 0; t < tiles; ++t) t2e[start + t] = tid; if (tid == 31) ntp[0] = pre; } }
    __syncthreads();
}
__device__ __forceinline__ void phase_moe_gather(unsigned char* ws, int layer, LAS unsigned char* lds, int gw, int NGW, int lane, int tid) {
    build_expert_tables(ws, layer, lds, tid);
    const LAS int* base = (const LAS int*)(lds + AUX_BASE);
    const bf16* XN = (const bf16*)(ws + WS_XN); bf16* XG = (bf16*)(ws + WS_XG);
    const unsigned* slot = (const unsigned*)(ws + WS_SLOT); unsigned* spos = (unsigned*)(ws + WS_SLOTPOS);
    for (int m = gw; m < MT; m += NGW) {
        if (layer == NLAYER - 1 && mod_row(m) == 8) continue;
        const GAS v4u* src = (const GAS v4u*)(XN + (size_t)m * 1024) + lane; const v4u a = src[0], b = src[64];
#pragma unroll
        for (int k = 0; k < 4; ++k) { const unsigned pe = slot[m * 4 + k]; const int dst = base[pe >> 24] + (int)(pe & 0xffffffu);
            GAS v4u* dp = (GAS v4u*)(XG + (size_t)dst * 1024) + lane; dp[0] = a; dp[64] = b;
            if (lane == 0) spos[m * 4 + k] = (unsigned)dst; }
    }
}
__device__ __forceinline__ void phase_moe_combine(unsigned char* ws, float* out, int layer, LAS unsigned char* lds, int gw, int NGW, int lane, int tid, bool dummy = false) {
    build_expert_tables(ws, layer, lds, tid);
    const LAS int* base = (const LAS int*)(lds + AUX_BASE);
    bf16* X = (bf16*)(ws + WS_X); const bf16* Y = (const bf16*)(ws + WS_Y);
    const float* Mo = (const float*)(ws + WS_MOD) + (size_t)layer * MODROWS * NMODC;
    const unsigned* slot = (const unsigned*)(ws + WS_SLOT); const float* gw4 = (const float*)(ws + WS_GATEW);
    for (int m = gw; m < MT; m += NGW) { const int b = m / TB, w = m - b * TB; const int mr = (w < CTXL) ? 8 : b;
        if (layer == NLAYER - 1 && w < CTXL) continue;
        f32x4 f[4];
#pragma unroll
        for (int j = 0; j < 4; ++j) f[j] = (f32x4){0.f, 0.f, 0.f, 0.f};
#pragma unroll
        for (int k = 0; k < 4; ++k) { const unsigned pe = slot[m * 4 + k]; const unsigned sp = (unsigned)base[pe >> 24] + (pe & 0xffffffu); const float wk = gw4[m * 4 + k];
            const GAS unsigned long long* yp = (const GAS unsigned long long*)(Y + (size_t)sp * 1024) + lane;
#pragma unroll
            for (int j = 0; j < 4; ++j) { const unsigned long long v = yp[64 * j];
                f[j].x += wk * __uint_as_float((unsigned)(v & 0xffffu) << 16); f[j].y += wk * __uint_as_float((unsigned)(v >> 16) << 16);
                f[j].z += wk * __uint_as_float((unsigned)((v >> 32) & 0xffffu) << 16); f[j].w += wk * __uint_as_float((unsigned)(v >> 48) << 16); } }
        GAS unsigned long long* xp = (GAS unsigned long long*)(X + (size_t)m * 1024) + lane; const GAS f32x4* gp = (const GAS f32x4*)(Mo + (size_t)mr * NMODC + 5 * 1024) + lane;
        GAS f32x4* op = (GAS f32x4*)(out + ((size_t)b * SEQ + (w - CTXL)) * 1024) + lane;
        float ss = 0.f;
#pragma unroll
        for (int j = 0; j < 4; ++j) { f[j] = bf4_to_f32(xp[64 * j]) + gp[64 * j] * f[j]; if (dummy) ((GAS f32x4*)((float*)(ws + WS_XG) + (size_t)m * 1024) + lane)[64 * j] = f[j]; else if (layer == NLAYER - 1) op[64 * j] = f[j]; else { const unsigned long long pk = f32_to_bf4(f[j]); xp[64 * j] = pk; f[j] = bf4_to_f32(pk); } ss += (f[j].x * f[j].x + f[j].y * f[j].y) + (f[j].z * f[j].z + f[j].w * f[j].w); }
        if (layer < NLAYER - 1 && !dummy) {
            const float rs = 1.0f / sqrtf(wave_sum(ss) * (1.0f / 1024.0f) + RMS_EPS);
            const float* ng = PARF(ws) + P_N1G + (layer + 1) * 1024; const float* Mn = (const float*)(ws + WS_MOD) + (size_t)(layer + 1) * MODROWS * NMODC + (size_t)mr * NMODC;
            GAS unsigned long long* o8 = (GAS unsigned long long*)((bf16*)(ws + WS_XN) + (size_t)m * 1024) + lane;
#pragma unroll
            for (int j = 0; j < 4; ++j) { const f32x4 g = ((const GAS f32x4*)ng)[64 * j + lane], sh = ((const GAS f32x4*)Mn)[64 * j + lane], sc = ((const GAS f32x4*)(Mn + 1024))[64 * j + lane];
                const f32x4 y = (f[j] * rs) * g * (sc + 1.0f) + sh;
                o8[64 * j] = (unsigned long long)pk2(y.x, y.y) | ((unsigned long long)pk2(y.z, y.w) << 32); } }
    }
}

constexpr int NPH_L = 11, NPHASE = 2 + NPH_L * NLAYER;
#ifndef PHMASK
#define PHMASK 0x7fff
#endif
#define EN(b) ((PHMASK >> (b)) & 1)
#ifndef DUPMASK
#define DUPMASK 0
#endif
#define DUP(b) for (int rep_ = 0; rep_ < (((DUPMASK >> (b)) & 1) ? 2 : 1); ++rep_)
__global__ void __launch_bounds__(NWAVES * 64, 2) dit_fwd(Args args) {
    extern __shared__ __attribute__((aligned(16))) unsigned char lds_raw[];
    LAS unsigned char* lds = (LAS unsigned char*)lds_raw;
    volatile LAS unsigned* MISC = (volatile LAS unsigned*)(lds + MISC_OFF);
    const int G = gridDim.x, bx = blockIdx.x;
    const int vcu = (G % 8 == 0) ? (bx % 8) * (G / 8) + bx / 8 : bx;
    { const int t0 = threadIdx.x; for (int u = t0; u < (LDS_BYTES - MISC_OFF) / 4; u += NWAVES * 64) ((LAS unsigned*)(lds + MISC_OFF))[u] = 0u; }
    __syncthreads();
    const int lo = args.ph_lo, hi = args.ph_hi;
    XcdBarrier bar; bar.bar = (unsigned*)(args.ws + WS_CTL) + CW_BAR; bar.x = 0; bar.st = nullptr;
    if (hi - lo > 1) bar = xcd_barrier_post((unsigned*)(args.ws + WS_CTL) + CW_BAR, MISC + 8);
#define IN(k) (lo <= (k) && (k) < hi)
#define SEAM(k) do { if (IN(k) && IN((k) + 1)) xcd_barrier(bar); } while (0)
#define PHASE_IDS() int tid = threadIdx.x; LAUNDER_V(tid); const int lane = tid & 63, wave = __builtin_amdgcn_readfirstlane(tid >> 6); const int gw = vcu * NWAVES + wave, NGW = G * NWAVES; \
    unsigned zoff_ = 0u; LAUNDER_S(zoff_); unsigned char* ws = args.ws + zoff_; (void)lane; (void)gw; (void)NGW;

    if (EN(0) && IN(0)) DUP(0) { PHASE_IDS(); p0_prologue(args, lds, gw, NGW, wave, lane); } SEAM(0);
    if (EN(1) && IN(1)) { PHASE_IDS(); p1_mod_reduce(args, gw * 64 + lane, NGW * 64); } SEAM(1);

    for (int layer = 0; layer < NLAYER; ++layer) {
        const int pb = 2 + NPH_L * layer, lh = layer >> 1;
        if (layer == 0) { if (EN(2) && IN(pb + 0)) DUP(2) { PHASE_IDS(); phase_modulate1(ws, layer, gw, NGW, lane); } SEAM(pb + 0); }
        if ((layer & 1) == 0) {
            if (EN(3) && IN(pb + 1)) DUP(3) {
                PHASE_IDS();
                pg8::Gemm g{(const pg8::bf16_t*)(ws + WS_XN), (const pg8::bf16_t*)(ws + WS_WQKV) + (size_t)lh * QKVN * 1024, MT, QKVN, 1024, 0};
                pg8::StaticOrder S; S.init(MT, QKVN, G, bx);
                pg8::EpiQKV E{ws, WS_Q, WS_K - WS_Q, WS_V - WS_K};
                pg8::gemm_phase<pg8::EpiQKV, pg8::StaticOrder, true, true>(lds + RING_OFF, g, S, E);
            } SEAM(pb + 1);
            if (EN(4) && IN(pb + 2)) { PHASE_IDS(); phase_qknorm_rope(ws, lh, gw, NGW, lane); } SEAM(pb + 2);
            if (EN(5) && IN(pb + 3)) DUP(5) {
                PHASE_IDS();
                const attn_body::bf16* Qp = (const attn_body::bf16*)(ws + WS_Q); const attn_body::bf16* Kp = (const attn_body::bf16*)(ws + WS_K); const attn_body::bf16* Vp = (const attn_body::bf16*)(ws + WS_V);
                attn_body::bf16* Op = (attn_body::bf16*)(ws + WS_XN);
                if (G == 256) {
                    for (int i = 0; i < 9; ++i) {
                        long qrow0, kvrow0; int NT, h;
                        if (i < 8) { const int x = vcu >> 5, j = vcu & 31, pair = 4 * x + (i >> 1), wi = (i & 1) * 32 + j, hq = wi >> 4, qb = wi & 15, b = pair >> 2, hk = pair & 3;
                            h = hk * 4 + hq; qrow0 = (long)b * TB + CTXL + qb * 256; kvrow0 = (long)b * TB; NT = TB / 64; }
                        else { if (vcu >= 128) break; const int b = vcu >> 4; h = vcu & 15; qrow0 = (long)b * TB; kvrow0 = qrow0; NT = CTXL / 64; }
                        attn_body::attn_unit<8>(qrow0, kvrow0, NT, h, Qp, Kp, Vp, Op, (char*)lds_raw + RING_OFF);
                    }
                } else {
                    for (int U = bx; U < 2048 + 128; U += G) {
                        long qrow0, kvrow0; int NT, h;
                        if (U < 2048) { const int pair = U >> 6, wi = U & 63, hq = wi >> 4, qb = wi & 15, b = pair >> 2, hk = pair & 3; h = hk * 4 + hq; qrow0 = (long)b * TB + CTXL + qb * 256; kvrow0 = (long)b * TB; NT = TB / 64; }
                        else { const int v = U - 2048, b = v >> 4; h = v & 15; qrow0 = (long)b * TB; kvrow0 = qrow0; NT = CTXL / 64; }
                        attn_body::attn_unit<8>(qrow0, kvrow0, NT, h, Qp, Kp, Vp, Op, (char*)lds_raw + RING_OFF);
                    }
                }
            } SEAM(pb + 3);
        } else {
            if (EN(6) && IN(pb + 1)) DUP(6) {
                PHASE_IDS();
                pg8::Gemm g{(const pg8::bf16_t*)(ws + WS_XN), (const pg8::bf16_t*)(ws + WS_WIN) + (size_t)lh * WINP * 1024, MT, WINP, 1024, 0};
                pg8::StaticOrder S; S.init(MT, WINP, G, bx);
                pg8::EpiBf16 E{(pg8::bf16_t*)(ws + WS_G), WINP};
                pg8::gemm_phase<pg8::EpiBf16, pg8::StaticOrder, true, true>(lds + RING_OFF, g, S, E);
            } SEAM(pb + 1);
            if (EN(7) && IN(pb + 2)) DUP(7) { PHASE_IDS(); phase_gla_g0(ws, lh, lds, tid); } SEAM(pb + 2);
            if (EN(8) && IN(pb + 3)) DUP(8) { PHASE_IDS(); phase_gla_g12(ws, lds, gw, wave, lane); } SEAM(pb + 3);
            if (EN(8) && IN(pb + 4)) DUP(9) { PHASE_IDS(); phase_gla_g3(ws, lh, lds, tid); } SEAM(pb + 4);
        }
        if (EN(9) && IN(pb + 5)) {
            PHASE_IDS();
            const pg8::bf16_t* Wt = (layer & 1) ? (const pg8::bf16_t*)(ws + WS_WOG) + (size_t)lh * 1024 * 1024 : (const pg8::bf16_t*)(ws + WS_WOA) + (size_t)lh * 1024 * 1024;
            pg8::Gemm g{(const pg8::bf16_t*)(ws + ((layer & 1) ? WS_Q : WS_XN)), Wt, MT, 1024, 1024, 0};
            pg8::StaticOrder S; S.init(MT, 1024, G, bx);
            pg8::EpiResGate E{(pg8::bf16_t*)(ws + WS_X), (const float*)(ws + WS_MOD) + (size_t)layer * MODROWS * NMODC + 2 * 1024};
            pg8::gemm_phase<pg8::EpiResGate, pg8::StaticOrder, true, true>(lds + RING_OFF, g, S, E);
        } SEAM(pb + 5);
        if (EN(10) && IN(pb + 6)) { if ((DUPMASK >> 10) & 1) { PHASE_IDS(); phase_modulate2_route(ws, layer, lds, vcu, wave, lane, tid, true); __syncthreads(); } PHASE_IDS(); phase_modulate2_route(ws, layer, lds, vcu, wave, lane, tid); } SEAM(pb + 6);
        if (EN(12) && IN(pb + 8)) DUP(12) {
            PHASE_IDS();
            build_expert_tables(ws, layer, lds, tid);
            const int nT = __builtin_amdgcn_readfirstlane(((const LAS int*)(lds + AUX_NT))[0]);
            pg8::MoeOrder S{nT, 8, G, bx, (const LAS int*)(lds + AUX_T2E)};
            LAS unsigned short* rowtab = (LAS unsigned short*)(lds + AUX_ROWTAB);
            { const LAS int* base = (const LAS int*)(lds + AUX_BASE); const LAS int* cntl = (const LAS int*)(lds + AUX_CNT); const int* LIST = (const int*)(ws + WS_LIST);
              pg8::Unit u;
              for (int i = 0; i < ROWTAB_UNITS && S.next(i, u); ++i) if (tid < 256) { const int pos = (u.pm - (base[u.e] >> 8)) * 256 + tid; rowtab[i * 256 + tid] = (unsigned short)((pos < cntl[u.e]) ? LIST[(size_t)u.e * MT + pos] : 0); }
              __syncthreads(); }
            pg8::Gemm g{(const pg8::bf16_t*)(ws + WS_XN), (const pg8::bf16_t*)(ws + WS_WGU) + (size_t)layer * 32 * 2048 * 1024, MPAD, 2048, 1024, (size_t)2048 * 1024 * 2, rowtab};
            pg8::EpiSwiGLU E{(pg8::bf16_t*)(ws + WS_ACT), PARF(ws) + P_BGU + (size_t)layer * 32 * 2048};
            pg8::gemm_phase<pg8::EpiSwiGLU, pg8::MoeOrder, true, true, true>(lds + RING_OFF, g, S, E);
        } SEAM(pb + 8);
        if (EN(13) && IN(pb + 9)) DUP(13) {
            PHASE_IDS();
            build_expert_tables(ws, layer, lds, tid);
            const int nT = __builtin_amdgcn_readfirstlane(((const LAS int*)(lds + AUX_NT))[0]);
            pg8::Gemm g{(const pg8::bf16_t*)(ws + WS_ACT), (const pg8::bf16_t*)(ws + WS_WDN) + (size_t)layer * 32 * 1024 * 1024, MPAD, 1024, 1024, (size_t)1024 * 1024 * 2};
            pg8::MoeOrder S{nT, 4, G, bx, (const LAS int*)(lds + AUX_T2E)};
            pg8::EpiBiasBf16 E{(pg8::bf16_t*)(ws + WS_Y), PARF(ws) + P_BDN + (size_t)layer * 32 * 1024};
            pg8::gemm_phase<pg8::EpiBiasBf16, pg8::MoeOrder, true, true>(lds + RING_OFF, g, S, E);
        } SEAM(pb + 9);
        if (EN(14) && IN(pb + 10)) { if ((DUPMASK >> 14) & 1) { PHASE_IDS(); phase_moe_combine(ws, args.out, layer, lds, gw, NGW, lane, tid, true); } PHASE_IDS(); phase_moe_combine(ws, args.out, layer, lds, gw, NGW, lane, tid); } SEAM(pb + 10);
    }
#undef IN
#undef EN
#undef DUP
#undef SEAM
#undef PHASE_IDS
}

extern "C" void kernel_launch(void* const* d_in, const int* in_sizes, int n_in, void* d_out, int out_size, void* d_ws, size_t ws_size, hipStream_t stream) {
    static int grid = 0;
    if (grid == 0) {
        if (n_in != 25 || out_size != NB * SEQ * DMODEL || ws_size < WS_END) { fprintf(stderr, "kernel_launch: unexpected shapes: n_in %d out %d ws %zu (need >= %zu)\n", n_in, out_size, ws_size, (size_t)WS_END); grid = -1; return; }
        int dev = 0, cus = 0, per_cu = 0;
        if (hipGetDevice(&dev) != hipSuccess || hipDeviceGetAttribute(&cus, hipDeviceAttributeMultiprocessorCount, dev) != hipSuccess) { grid = -1; return; }
        if (hipFuncSetAttribute((const void*)dit_fwd, hipFuncAttributeMaxDynamicSharedMemorySize, LDS_BYTES) != hipSuccess) { fprintf(stderr, "kernel_launch: hipFuncSetAttribute failed\n"); grid = -1; return; }
        if (hipOccupancyMaxActiveBlocksPerMultiprocessor(&per_cu, (const void*)dit_fwd, NWAVES * 64, LDS_BYTES) != hipSuccess || per_cu < 1) fprintf(stderr, "kernel_launch: occupancy query reports %d\n", per_cu);
        (void)hipGetLastError();
        grid = cus;
    }
    if (grid < 0) return;
    if (hipMemsetAsync((char*)d_ws + WS_CTL, 0, CTL_ZERO_BYTES, stream) != hipSuccess) { fprintf(stderr, "kernel_launch: memset failed\n"); return; }
    Args a{};
    for (int i = 0; i < 25; ++i) a.in[i] = (const float*)d_in[i];
    a.out = (float*)d_out; a.ws = (unsigned char*)d_ws;
#if MK_ONE_LAUNCH
    a.ph_lo = 0; a.ph_hi = NPHASE;
    hipLaunchKernelGGL(dit_fwd, dim3(grid), dim3(NWAVES * 64), LDS_BYTES, stream, a);
#else
    for (int p = 0; p < NPHASE; ++p) { a.ph_lo = p; a.ph_hi = p + 1; hipLaunchKernelGGL(dit_fwd, dim3(grid), dim3(NWAVES * 64), LDS_BYTES, stream, a); }
#endif
    const hipError_t le = hipPeekAtLastError();
    if (le != hipSuccess) fprintf(stderr, "kernel_launch: launch failed: %s\n", hipGetErrorName(le));
}
```

```cpp
#include <hip/hip_runtime.h>
#include <hip/hip_bf16.h>
#include <cstdio>
#include <cstdint>
#include <cmath>

#ifndef MK_ONE_LAUNCH
#define MK_ONE_LAUNCH 1
#endif

namespace pg8 {
#define PG8_LAS __attribute__((address_space(3)))
typedef unsigned short bf16_t;
typedef short bf16x8 __attribute__((ext_vector_type(8)));
typedef float f32x4 __attribute__((ext_vector_type(4)));
typedef unsigned u32x4 __attribute__((ext_vector_type(4)));
constexpr int BM = 256, BK = 64, HALF = 128, HTB = HALF * BK * 2  , STAGE_BYTES = 8 * HTB, NXCD = 8, WGM = 8;

__host__ __device__ __forceinline__ int lds_byte(int r, int c) { const int st = (r >> 4) * 2 + (c >> 5), rr = r & 15, cc = c & 31, ob = rr * 64 + cc * 2; return st * 1024 + (ob ^ (((ob >> 9) & 1) << 5)); }
__host__ __device__ __forceinline__ void stage_rc(int b, int& R, int& C) { const int st = b / 1024, sb = b % 1024, swz = sb ^ (((sb >> 9) & 1) << 5); R = (st >> 1) * 16 + swz / 64; C = (st & 1) * 32 + (swz % 64) / 2; }
__host__ __device__ __forceinline__ int perm32(int rho) { const int n = rho >> 4, i = rho & 15; return 8 * (i >> 2) + 4 * n + (i & 3); }

struct Unit { int pm, pn, e; };
struct Gemm { const bf16_t* A; const bf16_t* Bt; int M, N, K; size_t bstride; const PG8_LAS unsigned short* rowtab; };

struct StaticOrder {
    int nM, nN, nwg, G, c;
    __host__ __device__ __forceinline__ void init(int M, int N, int G_, int c_) { nM = M / BM; nN = N / BM; nwg = nM * nN; G = G_; c = c_; }
    __host__ __device__ __forceinline__ bool next(int i, Unit& u) const {
        const long L = (long)i * G + c; if (L >= nwg) return false;
        int wgid = (int)L; { const int q = nwg / NXCD, r = nwg % NXCD, xcd = wgid % NXCD, off = wgid / NXCD; wgid = (xcd < r ? xcd * (q + 1) : r * (q + 1) + (xcd - r) * q) + off; }
        const int nig = WGM * nN, gid = wgid / nig, fm = gid * WGM, gsz = (nM - fm) < WGM ? (nM - fm) : WGM;
        u.pm = fm + ((wgid % nig) % gsz); u.pn = (wgid % nig) / gsz; u.e = 0; return true;
    }
    __device__ __forceinline__ void a_ready(const Unit&) const {}
    __device__ __forceinline__ void done(const Unit&) const {}
};
struct MoeOrder {
    int nT, nN, G, c; const PG8_LAS int* t2e;
    __device__ __forceinline__ bool next(int i, Unit& u) const {
        const int x = c & 7, j = c >> 3, per = 32 / nN, mt = (i * (G >> 5) + x) * per + j / nN; if (mt >= nT) return false;
        u.pm = mt; u.pn = j % nN; u.e = __builtin_amdgcn_readfirstlane(t2e[mt]); return true;
    }
    __device__ __forceinline__ void a_ready(const Unit&) const {}
    __device__ __forceinline__ void done(const Unit&) const {}
};

__device__ __forceinline__ int lane_now() { unsigned z; asm volatile("s_mov_b32 %0, 0" : "=s"(z)); return (int)__builtin_amdgcn_mbcnt_hi(~0u, __builtin_amdgcn_mbcnt_lo(~0u, z)); }
__device__ __forceinline__ float shx(float v, int m, int ln) { return __int_as_float(__builtin_amdgcn_ds_bpermute((ln ^ m) << 2, __float_as_int(v))); }
__device__ __forceinline__ unsigned cvt_pk_bf16(float lo, float hi) { unsigned r; asm volatile("v_cvt_pk_bf16_f32 %0, %1, %2" : "=v"(r) : "v"(lo), "v"(hi)); return r; }

struct EpiBf16 {
    static constexpr bool PERM = true, AFTER_DRAIN = false;
    bf16_t* O; int ldc;
    __device__ __forceinline__ void operator()(const f32x4 (&acc)[2][2][4][2], const Unit& u, int wr, int wc, int fr, int fq) const {
        const int row0 = u.pm * BM + wr * 64 + fr; const int col0 = u.pn * BM + wc * 32 + 8 * fq;
#pragma unroll
        for (int ai = 0; ai < 2; ++ai)
#pragma unroll
            for (int m = 0; m < 4; ++m) { bf16_t* rowp = O + (size_t)(row0 + ai * HALF + m * 16) * ldc + col0;
#pragma unroll
                for (int bj = 0; bj < 2; ++bj) { const f32x4 v0 = acc[ai][bj][m][0], v1 = acc[ai][bj][m][1];
                    u32x4 w; w.x = cvt_pk_bf16(v0[0], v0[1]); w.y = cvt_pk_bf16(v0[2], v0[3]); w.z = cvt_pk_bf16(v1[0], v1[1]); w.w = cvt_pk_bf16(v1[2], v1[3]);
                    *(u32x4*)(rowp + bj * HALF) = w; } }
    }
};
struct EpiQKV {
    static constexpr bool PERM = true, AFTER_DRAIN = false;
    unsigned char* wsb; size_t offQ, dK, dV;
    const PG8_LAS float* gl; const float* ropec; float c2;
    __device__ __forceinline__ void operator()(const f32x4 (&acc)[2][2][4][2], const Unit& u, int wr, int wc, int fr, int fq) const {
        const int isk = (u.pn >= 4) ? 1 : 0, isv = (u.pn >= 5) ? 1 : 0;
        bf16_t* base = (bf16_t*)(wsb + offQ + (size_t)isk * dK + (size_t)isv * dV); const int ldc = isk ? 256 : 1024;
        const int hcol = (isk ? wc : (u.pn * 4 + wc)) * 64 + 8 * fq;
        const int pmb = u.pm / 17, pml = u.pm - pmb * 17; const bool lat = pml != 0;
        const PG8_LAS float* gp = gl + (isk ? 64 : 0) + 8 * fq; const float scl = isk ? 1.0f : c2;
#pragma unroll
        for (int ai = 0; ai < 2; ++ai)
#pragma unroll
            for (int m = 0; m < 4; ++m) { const int rl = ai * HALF + wr * 64 + m * 16 + fr; const size_t row = (size_t)u.pm * BM + rl;
                f32x4 v[2][2]; float ss = 0.f;
#pragma unroll
                for (int bj = 0; bj < 2; ++bj)
#pragma unroll
                    for (int n = 0; n < 2; ++n) { v[bj][n] = acc[ai][bj][m][n]; ss += (v[bj][n][0] * v[bj][n][0] + v[bj][n][1] * v[bj][n][1]) + (v[bj][n][2] * v[bj][n][2] + v[bj][n][3] * v[bj][n][3]); }
                if (!isv) { const int ln = lane_now(); ss += shx(ss, 16, ln); ss += shx(ss, 32, ln);
                    const float rs = 1.0f / sqrtf(ss * (1.0f / 64.0f) + 1e-6f);
                    const int spos = (pml - 1) * 256 + rl;
#pragma unroll
                    for (int bj = 0; bj < 2; ++bj) { f32x4 cs = (f32x4){1.f, 1.f, 1.f, 1.f}, sn = (f32x4){0.f, 0.f, 0.f, 0.f};
                        if (lat) { const float* cp = ropec + (size_t)spos * 32 + 16 * bj + 4 * fq; cs = *(const f32x4*)cp; sn = *(const f32x4*)(cp + 4096 * 32); }
#pragma unroll
                        for (int n = 0; n < 2; ++n) { const f32x4 y = v[bj][n] * rs * *(const PG8_LAS f32x4*)(gp + 32 * bj + 4 * n);
                            const float c0 = cs[2 * n], s0 = sn[2 * n], c1 = cs[2 * n + 1], s1 = sn[2 * n + 1];
                            v[bj][n] = (f32x4){(y[0] * c0 - y[1] * s0) * scl, (y[0] * s0 + y[1] * c0) * scl, (y[2] * c1 - y[3] * s1) * scl, (y[2] * s1 + y[3] * c1) * scl}; } } }
                bf16_t* rowp = base + row * ldc + hcol;
#pragma unroll
                for (int bj = 0; bj < 2; ++bj) { u32x4 w; w.x = cvt_pk_bf16(v[bj][0][0], v[bj][0][1]); w.y = cvt_pk_bf16(v[bj][0][2], v[bj][0][3]); w.z = cvt_pk_bf16(v[bj][1][0], v[bj][1][1]); w.w = cvt_pk_bf16(v[bj][1][2], v[bj][1][3]);
                    *(u32x4*)(rowp + 32 * bj) = w; } }
    }
};
struct EpiResGate {
    static constexpr bool PERM = false, AFTER_DRAIN = false;
    bf16_t* X; const float* gate;
    __device__ __forceinline__ void operator()(const f32x4 (&acc)[2][2][4][2], const Unit& u, int wr, int wc, int fr, int fq) const {
        const int row0 = u.pm * BM + wr * 64 + fr; const int col0 = u.pn * BM + wc * 32 + 4 * fq;
        const int bb = u.pm / 17, mr = (u.pm - bb * 17 == 0) ? 8 : bb;
        const float* gp = gate + (size_t)mr * 6144 + col0;
        f32x4 gv[2][2];
#pragma unroll
        for (int bj = 0; bj < 2; ++bj)
#pragma unroll
            for (int n = 0; n < 2; ++n) gv[bj][n] = *(const f32x4*)(gp + bj * HALF + n * 16);
#pragma unroll
        for (int ai = 0; ai < 2; ++ai)
#pragma unroll
            for (int m = 0; m < 4; ++m) { bf16_t* rowp = X + (size_t)(row0 + ai * HALF + m * 16) * 1024 + col0;
#pragma unroll
                for (int bj = 0; bj < 2; ++bj)
#pragma unroll
                    for (int n = 0; n < 2; ++n) { unsigned long long* p = (unsigned long long*)(rowp + bj * HALF + n * 16); const unsigned long long v = *p;
                        f32x4 x = (f32x4){__uint_as_float((unsigned)(v & 0xffffu) << 16), __uint_as_float((unsigned)(v >> 16) << 16), __uint_as_float((unsigned)((v >> 32) & 0xffffu) << 16), __uint_as_float((unsigned)(v >> 48) << 16)};
                        x = x + gv[bj][n] * acc[ai][bj][m][n];
                        *p = (unsigned long long)cvt_pk_bf16(x[0], x[1]) | ((unsigned long long)cvt_pk_bf16(x[2], x[3]) << 32); } }
    }
};
struct EpiSwiGLU {
    static constexpr bool PERM = true, AFTER_DRAIN = false;
    bf16_t* O; const float* bias;
    __device__ __forceinline__ void operator()(const f32x4 (&acc)[2][2][4][2], const Unit& u, int wr, int wc, int fr, int fq) const {
        const int row0 = u.pm * BM + wr * 64 + fr; const int col0 = u.pn * HALF + wc * 32 + 8 * fq;
        const float* bp = bias + (size_t)u.e * 2048 + col0;
        f32x4 bg[2], bu[2];
#pragma unroll
        for (int n = 0; n < 2; ++n) { bg[n] = *(const f32x4*)(bp + 4 * n); bu[n] = *(const f32x4*)(bp + 1024 + 4 * n); }
#pragma unroll
        for (int ai = 0; ai < 2; ++ai)
#pragma unroll
            for (int m = 0; m < 4; ++m) { bf16_t* rowp = O + (size_t)(row0 + ai * HALF + m * 16) * 1024 + col0;
                float r[8];
#pragma unroll
                for (int n = 0; n < 2; ++n) { const f32x4 gt = acc[ai][0][m][n] + bg[n], up = acc[ai][1][m][n] + bu[n];
#pragma unroll
                    for (int i = 0; i < 4; ++i) { const float g = fminf(gt[i], 7.0f), uu = fminf(fmaxf(up[i], -7.0f), 7.0f);
                        const float sg = __builtin_amdgcn_rcpf(1.0f + __builtin_amdgcn_exp2f(-1.702f * 1.4426950408889634f * g));
                        r[4 * n + i] = (uu + 1.0f) * (g * sg); } }
                u32x4 w; w.x = cvt_pk_bf16(r[0], r[1]); w.y = cvt_pk_bf16(r[2], r[3]); w.z = cvt_pk_bf16(r[4], r[5]); w.w = cvt_pk_bf16(r[6], r[7]);
                *(u32x4*)rowp = w; }
    }
};
struct EpiBiasBf16 {
    static constexpr bool PERM = true, AFTER_DRAIN = false;
    bf16_t* O; const float* bias;
    __device__ __forceinline__ void operator()(const f32x4 (&acc)[2][2][4][2], const Unit& u, int wr, int wc, int fr, int fq) const {
        const int row0 = u.pm * BM + wr * 64 + fr; const int col0 = u.pn * BM + wc * 32 + 8 * fq;
        const float* bp = bias + (size_t)u.e * 1024 + col0;
        f32x4 bv[2][2];
#pragma unroll
        for (int bj = 0; bj < 2; ++bj)
#pragma unroll
            for (int n = 0; n < 2; ++n) bv[bj][n] = *(const f32x4*)(bp + bj * HALF + 4 * n);
#pragma unroll
        for (int ai = 0; ai < 2; ++ai)
#pragma unroll
            for (int m = 0; m < 4; ++m) { bf16_t* rowp = O + (size_t)(row0 + ai * HALF + m * 16) * 1024 + col0;
#pragma unroll
                for (int bj = 0; bj < 2; ++bj) { const f32x4 v0 = acc[ai][bj][m][0] + bv[bj][0], v1 = acc[ai][bj][m][1] + bv[bj][1];
                    u32x4 w; w.x = cvt_pk_bf16(v0[0], v0[1]); w.y = cvt_pk_bf16(v0[2], v0[3]); w.z = cvt_pk_bf16(v1[0], v1[1]); w.w = cvt_pk_bf16(v1[2], v1[3]);
                    *(u32x4*)(rowp + bj * HALF) = w; } }
    }
};

template <class Epi, class Sched, bool ALIGN_EPI = false, bool SP2 = false, bool GATHER = false>
__device__ __forceinline__ void gemm_phase(PG8_LAS unsigned char* lds, const Gemm g, const Sched& S, const Epi& E, int tid_in) {
    int tid_l = tid_in; asm volatile("" : "+v"(tid_l));
    const int tid = tid_l, wid = __builtin_amdgcn_readfirstlane(tid >> 6), lane = tid & 63, wr = wid >> 2, wc = wid & 3, fr = lane & 15, fq = lane >> 4;
    const int K = g.K, nt = K / BK;
    unsigned voffA[2], voffB[2];
#pragma unroll
    for (int i = 0; i < 2; ++i) { int R, C; stage_rc(tid * 16 + i * 8192, R, C); const int Rb = Epi::PERM ? ((R & ~31) + perm32(R & 31)) : R;
        voffA[i] = (unsigned)(R * K + C) * 2u; voffB[i] = (unsigned)(Rb * K + C) * 2u; }
    const size_t kstep = (size_t)(BK * 2);
    static_assert(!GATHER || SP2, "GATHER is wired into the SP2 loop only");
    unsigned vAc0[2], vAc1[2], vAn0[2], vAn1[2]; int gR[2]; unsigned gC[2];
#pragma unroll
    for (int i = 0; i < 2; ++i) { int R, C; stage_rc(tid * 16 + i * 8192, R, C); gR[i] = R; gC[i] = (unsigned)C * 2u; vAc0[i] = voffA[i]; vAc1[i] = voffA[i]; vAn0[i] = voffA[i]; vAn1[i] = voffA[i]; }
#define PG8_GFETCH(d0, d1, ord) do { if constexpr (GATHER) { _Pragma("unroll") for (int _i = 0; _i < 2; ++_i) { \
        d0[_i] = (unsigned)g.rowtab[(ord) * 256 + gR[_i]] * (unsigned)(K * 2) + gC[_i]; d1[_i] = (unsigned)g.rowtab[(ord) * 256 + 128 + gR[_i]] * (unsigned)(K * 2) + gC[_i]; } } } while (0)
    const size_t hstep = (size_t)HALF * K * 2;
    const size_t hstepA = GATHER ? 0 : hstep;
    const size_t tstep = 2 * hstep;
    const unsigned ldsw = (unsigned)wid * 1024u;
    const int aoff = lds_byte(wr * 64 + fr, fq * 8), boff = lds_byte(wc * 32 + fr, fq * 8);
#define PG8_SA(b, h) (((b) * 2 + (h)) * HTB)
#define PG8_SB(b, h) ((4 + (b) * 2 + (h)) * HTB)
#define PG8_STAGE(bufoff, gbase, voff) do { _Pragma("unroll") for (int _i = 0; _i < 2; ++_i) \
        __builtin_amdgcn_global_load_lds((const unsigned*)((const char*)(gbase) + (voff)[_i]), (PG8_LAS unsigned*)(lds + (bufoff) + ldsw + _i * 8192), 16, 0, 0); } while (0)
#define PG8_LDA(dst, b, h) do { _Pragma("unroll") for (int m = 0; m < 4; ++m) _Pragma("unroll") for (int k = 0; k < 2; ++k) dst[m][k] = *(const PG8_LAS bf16x8*)(lds + PG8_SA(b, h) + aoff + m * 2048 + k * 1024); } while (0)
#define PG8_LDB(dst, b, h) do { _Pragma("unroll") for (int n = 0; n < 2; ++n) _Pragma("unroll") for (int k = 0; k < 2; ++k) dst[n][k] = *(const PG8_LAS bf16x8*)(lds + PG8_SB(b, h) + boff + n * 2048 + k * 1024); } while (0)
#define PG8_MMA(ai, bj, At, Bt) do { __builtin_amdgcn_s_setprio(1); _Pragma("unroll") for (int m = 0; m < 4; ++m) _Pragma("unroll") for (int n = 0; n < 2; ++n) _Pragma("unroll") for (int k = 0; k < 2; ++k) \
        acc[ai][bj][m][n] = __builtin_amdgcn_mfma_f32_16x16x32_bf16(Bt[n][k], At[m][k], acc[ai][bj][m][n], 0, 0, 0); __builtin_amdgcn_s_setprio(0); } while (0)
#define PG8_WAIT_V(n) asm volatile("s_waitcnt vmcnt(" #n ")" ::: "memory")
#define PG8_WAIT_L(n) asm volatile("s_waitcnt lgkmcnt(" #n ")" ::: "memory")
#define PG8_BAR __builtin_amdgcn_s_barrier()
#define PG8_SCHED __builtin_amdgcn_sched_barrier(0)
    Unit cur, nxt; int ui = 0;
    if (!S.next(0, cur)) return;
    f32x4 acc[2][2][4][2];
#pragma unroll
    for (int a = 0; a < 2; ++a)
#pragma unroll
        for (int b = 0; b < 2; ++b)
#pragma unroll
            for (int m = 0; m < 4; ++m)
#pragma unroll
                for (int n = 0; n < 2; ++n) acc[a][b][m][n] = (f32x4){0.f, 0.f, 0.f, 0.f};
    bf16x8 At[4][2], B0[2][2], B1[2][2];
    const char* cA = (const char*)g.A + (GATHER ? (size_t)0 : (size_t)cur.pm * tstep); PG8_GFETCH(vAc0, vAc1, 0); const char* cB = (const char*)g.Bt + (size_t)cur.e * g.bstride + (size_t)cur.pn * tstep;
    S.a_ready(cur);
    if constexpr (SP2) {
        PG8_STAGE(PG8_SB(0, 0), cB, voffB); PG8_STAGE(PG8_SB(0, 1), cB + hstep, voffB); PG8_STAGE(PG8_SA(0, 0), cA, vAc0); PG8_STAGE(PG8_SA(0, 1), cA + hstepA, vAc1);
        if (wr == 1) PG8_BAR;
        PG8_WAIT_V(2); PG8_BAR;
        PG8_STAGE(PG8_SB(1, 0), cB + kstep, voffB); PG8_STAGE(PG8_SA(1, 0), cA + kstep, vAc0); PG8_STAGE(PG8_SB(1, 1), cB + hstep + kstep, voffB);
        PG8_WAIT_V(6); PG8_BAR;
    } else {
        PG8_STAGE(PG8_SB(0, 0), cB, voffB); PG8_STAGE(PG8_SA(0, 0), cA, voffA); PG8_STAGE(PG8_SB(0, 1), cB + hstep, voffB); PG8_STAGE(PG8_SA(0, 1), cA + hstep, voffA);
        if (wr == 1) PG8_BAR;
        PG8_WAIT_V(4); PG8_BAR;
        PG8_STAGE(PG8_SB(1, 0), cB + kstep, voffB); PG8_STAGE(PG8_SA(1, 0), cA + kstep, voffA); PG8_STAGE(PG8_SB(1, 1), cB + hstep + kstep, voffB);
        PG8_WAIT_V(6); PG8_BAR;
    }
    for (;;) {
        const bool has_next = S.next(ui + 1, nxt);
        const char* nA = (has_next && !GATHER) ? (const char*)g.A + (size_t)nxt.pm * tstep : cA;
        if constexpr (GATHER) { if (has_next) PG8_GFETCH(vAn0, vAn1, ui + 1); else { vAn0[0] = vAc0[0]; vAn0[1] = vAc0[1]; vAn1[0] = vAc1[0]; vAn1[1] = vAc1[1]; } }
        const char* nB = has_next ? (const char*)g.Bt + (size_t)nxt.e * g.bstride + (size_t)nxt.pn * tstep : cB;
        for (int t = 0; t < nt; t += 2) {
            const bool last = (t == nt - 2);
            const char* a1 = cA + (size_t)(t + 1) * kstep;
            const char* a2 = last ? nA : cA + (size_t)(t + 2) * kstep; const char* b2 = last ? nB : cB + (size_t)(t + 2) * kstep;
            const char* a3 = a2 + kstep; const char* b3 = b2 + kstep;
            if (last && has_next) S.a_ready(nxt);
            unsigned vS0[2], vS1[2];
            vS0[0] = last ? vAn0[0] : vAc0[0]; vS0[1] = last ? vAn0[1] : vAc0[1]; vS1[0] = last ? vAn1[0] : vAc1[0]; vS1[1] = last ? vAn1[1] : vAc1[1];
            if constexpr (SP2) {
            PG8_LDB(B0, 0, 0); PG8_LDB(B1, 0, 1); PG8_SCHED; PG8_LDA(At, 0, 0); PG8_STAGE(PG8_SA(1, 1), a1 + hstepA, vAc1);
            PG8_WAIT_V(8); PG8_WAIT_L(0); PG8_BAR; PG8_MMA(0, 0, At, B0); PG8_MMA(0, 1, At, B1); PG8_BAR; PG8_SCHED;
            PG8_LDA(At, 0, 1); PG8_STAGE(PG8_SB(0, 0), b2, voffB); PG8_STAGE(PG8_SB(0, 1), b2 + hstep, voffB); PG8_STAGE(PG8_SA(0, 0), a2, vS0);
            PG8_WAIT_V(8); PG8_WAIT_L(0); PG8_BAR; PG8_MMA(1, 0, At, B0); PG8_MMA(1, 1, At, B1); PG8_BAR; PG8_SCHED;
            PG8_LDB(B0, 1, 0); PG8_LDB(B1, 1, 1); PG8_SCHED; PG8_LDA(At, 1, 0); PG8_STAGE(PG8_SA(0, 1), a2 + hstepA, vS1);
            PG8_WAIT_V(8); PG8_WAIT_L(0); PG8_BAR; PG8_MMA(0, 0, At, B0); PG8_MMA(0, 1, At, B1); PG8_BAR; PG8_SCHED;
            PG8_LDA(At, 1, 1); PG8_STAGE(PG8_SB(1, 0), b3, voffB); PG8_STAGE(PG8_SB(1, 1), b3 + hstep, voffB); PG8_STAGE(PG8_SA(1, 0), a3, vS0);
            PG8_WAIT_V(8); PG8_WAIT_L(0); PG8_BAR; PG8_MMA(1, 0, At, B0); PG8_MMA(1, 1, At, B1); PG8_BAR; PG8_SCHED;
            } else {
            PG8_LDB(B0, 0, 0); PG8_SCHED; PG8_LDA(At, 0, 0); PG8_STAGE(PG8_SA(1, 1), a1 + hstep, voffA);
            PG8_WAIT_L(8); PG8_BAR; PG8_WAIT_L(0); PG8_MMA(0, 0, At, B0); PG8_BAR; PG8_SCHED;
            PG8_LDB(B1, 0, 1); PG8_STAGE(PG8_SB(0, 0), b2, voffB);
            PG8_BAR; PG8_WAIT_L(0); PG8_MMA(0, 1, At, B1); PG8_BAR;
            PG8_LDA(At, 0, 1); PG8_STAGE(PG8_SA(0, 0), a2, voffA);
            PG8_BAR; PG8_WAIT_L(0); PG8_MMA(1, 0, At, B0); PG8_BAR; PG8_SCHED;
            PG8_STAGE(PG8_SB(0, 1), b2 + hstep, voffB);
            PG8_WAIT_V(6); PG8_BAR; PG8_MMA(1, 1, At, B1); PG8_BAR;
            PG8_LDB(B0, 1, 0); PG8_SCHED; PG8_LDA(At, 1, 0); PG8_STAGE(PG8_SA(0, 1), a2 + hstep, voffA);
            PG8_WAIT_L(8); PG8_BAR; PG8_WAIT_L(0); PG8_MMA(0, 0, At, B0); PG8_BAR; PG8_SCHED;
            PG8_LDB(B1, 1, 1); PG8_STAGE(PG8_SB(1, 0), b3, voffB);
            PG8_BAR; PG8_WAIT_L(0); PG8_MMA(0, 1, At, B1); PG8_BAR;
            PG8_LDA(At, 1, 1); PG8_STAGE(PG8_SA(1, 0), a3, voffA);
            PG8_BAR; PG8_WAIT_L(0); PG8_MMA(1, 0, At, B0); PG8_BAR; PG8_SCHED;
            PG8_STAGE(PG8_SB(1, 1), b3 + hstep, voffB);
            PG8_WAIT_V(6); PG8_BAR; PG8_MMA(1, 1, At, B1); PG8_BAR;
            }
        }
        if constexpr (ALIGN_EPI) { if (wr == 0) PG8_BAR; }
        if constexpr (!Epi::AFTER_DRAIN) { E(acc, cur, wr, wc, fr, fq); S.done(cur); }
        if (!has_next) break;
#pragma unroll
        for (int a = 0; a < 2; ++a)
#pragma unroll
            for (int b = 0; b < 2; ++b)
#pragma unroll
                for (int m = 0; m < 4; ++m)
#pragma unroll
                    for (int n = 0; n < 2; ++n) acc[a][b][m][n] = (f32x4){0.f, 0.f, 0.f, 0.f};
        cur = nxt; cA = nA; cB = nB; ++ui;
        if constexpr (GATHER) { vAc0[0] = vAn0[0]; vAc0[1] = vAn0[1]; vAc1[0] = vAn1[0]; vAc1[1] = vAn1[1]; }
        if constexpr (ALIGN_EPI) { if (wr == 1) PG8_BAR; }
    }
    PG8_WAIT_V(0);
    if constexpr (!ALIGN_EPI) { if (wr == 0) PG8_BAR; }
    PG8_BAR;
    if constexpr (Epi::AFTER_DRAIN) { E.fused(acc, cur, wr, wc, fr, fq, lds, wid, lane); S.done(cur); }
#undef PG8_SA
#undef PG8_SB
#undef PG8_STAGE
#undef PG8_LDA
#undef PG8_LDB
#undef PG8_MMA
#undef PG8_WAIT_V
#undef PG8_WAIT_L
#undef PG8_BAR
#undef PG8_SCHED
#undef PG8_GFETCH
}
}
#include <hip/hip_bf16.h>
#include <cmath>
namespace attn_body {
using bf16=__hip_bfloat16;
using bf16x8=__attribute__((ext_vector_type(8)))short;
using s16x4=__attribute__((ext_vector_type(4)))short;
using f32x16=__attribute__((ext_vector_type(16)))float;
using u32x4=__attribute__((ext_vector_type(4)))unsigned;
constexpr int D=64,DM=1024,KVP=256;
constexpr int NW=8,QBLK=32,QB=QBLK*NW,KVBLK=64;
__device__ __forceinline__ int crow(int r,int hi){return (r&3)+8*(r>>2)+4*hi;}
#define SBAR() __builtin_amdgcn_sched_barrier(0)
__device__ __forceinline__ void cmask(f32x16&p0,f32x16&p1,int jb,int qrel,int hi){
  const float NEG=-INFINITY; int kb=64*jb+4*hi;
  #pragma unroll
  for(int r=0;r<16;++r){int kv=kb+(r&3)+8*(r>>2); if(kv>qrel)p0[r]=NEG; if(kv+32>qrel)p1[r]=NEG;}
}

constexpr int NSLOT=3, SLOTB=8192;
constexpr int LDS_K=0, LDS_V=NSLOT*SLOTB, LDS_WS=2*NSLOT*SLOTB, LDS_OST=LDS_WS+NW*64*4, LDS_BYTES=LDS_OST+NW*4096;
constexpr float C2=0.125f*1.4426950408889634f;
__device__ __forceinline__ void glds16(const void*gsrc,unsigned lds_dst){unsigned keep;
  asm volatile("s_mov_b32 %0, m0\n\ts_mov_b32 m0, %2\n\ts_nop 0\n\tglobal_load_lds_dwordx4 %1, off\n\ts_mov_b32 m0, %0":"=&s"(keep):"v"(gsrc),"s"(lds_dst):"memory");}
__device__ __forceinline__ float max3f(float a,float b,float c){float r;asm("v_max3_f32 %0, %1, %2, %3":"=v"(r):"v"(a),"v"(b),"v"(c));return r;}
__device__ __forceinline__ float max2f(float a,float b){float r;asm("v_max_f32_e32 %0, %1, %2":"=v"(r):"v"(a),"v"(b));return r;}
__device__ __forceinline__ float fadd_s(float a,float b){float r;asm("v_add_f32_e32 %0, %1, %2":"=v"(r):"v"(a),"v"(b));return r;}
__device__ __forceinline__ float fsub_s(float a,float b){float r;asm("v_sub_f32_e32 %0, %1, %2":"=v"(r):"v"(a),"v"(b));return r;}
typedef float f32x2_t __attribute__((ext_vector_type(2))); typedef __bf16 bf16x2_t __attribute__((ext_vector_type(2)));
__device__ __forceinline__ unsigned cvtpk_s(float lo,float hi){f32x2_t v={lo,hi};bf16x2_t b=__builtin_convertvector(v,bf16x2_t);return __builtin_bit_cast(unsigned,b);}
#define WAIT_BAR(N) asm volatile("s_waitcnt vmcnt(" #N ") lgkmcnt(0)\n\ts_barrier":::"memory")

__device__ __forceinline__ void qkt(f32x16&p0,f32x16&p1,const char*Kslot,const bf16x8*qr,const f32x16&negm,int r32,int hi){
  const char*kb=Kslot+hi*1024+r32*16;
  #pragma unroll
  for(int d0=0;d0<4;++d0){
    const bf16x8 b0=*reinterpret_cast<const bf16x8*>(kb+d0*2048);
    const bf16x8 b1=*reinterpret_cast<const bf16x8*>(kb+d0*2048+512);
    if(d0==0){p0=__builtin_amdgcn_mfma_f32_32x32x16_bf16(b0,qr[0],negm,0,0,0);p1=__builtin_amdgcn_mfma_f32_32x32x16_bf16(b1,qr[0],negm,0,0,0);}
    else{p0=__builtin_amdgcn_mfma_f32_32x32x16_bf16(b0,qr[d0],p0,0,0,0);p1=__builtin_amdgcn_mfma_f32_32x32x16_bf16(b1,qr[d0],p1,0,0,0);}}
}
typedef __attribute__((address_space(3))) const char* lds_cptr;
typedef short v4i16_t __attribute__((ext_vector_type(4)));
__device__ __forceinline__ void kload8(bf16x8*kf,lds_cptr kp){
  kf[0]=*(const __attribute__((address_space(3))) bf16x8*)(kp);      kf[1]=*(const __attribute__((address_space(3))) bf16x8*)(kp+512);
  kf[2]=*(const __attribute__((address_space(3))) bf16x8*)(kp+2048); kf[3]=*(const __attribute__((address_space(3))) bf16x8*)(kp+2560);
  kf[4]=*(const __attribute__((address_space(3))) bf16x8*)(kp+4096); kf[5]=*(const __attribute__((address_space(3))) bf16x8*)(kp+4608);
  kf[6]=*(const __attribute__((address_space(3))) bf16x8*)(kp+6144); kf[7]=*(const __attribute__((address_space(3))) bf16x8*)(kp+6656);
}
__device__ __forceinline__ void kload2(bf16x8*kf,lds_cptr kp,int j){ kf[2*j]=*(const __attribute__((address_space(3))) bf16x8*)(kp+j*2048); kf[2*j+1]=*(const __attribute__((address_space(3))) bf16x8*)(kp+j*2048+512); }
__device__ __forceinline__ s16x4 vtr(lds_cptr p){ return __builtin_bit_cast(s16x4,__builtin_amdgcn_ds_read_tr16_b64_v4i16((__attribute__((address_space(3))) v4i16_t*)p)); }
__device__ __forceinline__ float rowmax(const f32x16&p0,const f32x16&p1){
  float a=max3f(p0[0],p0[1],p1[0]),b=max3f(p0[2],p0[3],p1[1]);a=max3f(a,p1[2],p1[3]);
  #pragma unroll
  for(int r=4;r<16;r+=4){a=max3f(a,p0[r],p0[r+1]);b=max3f(b,p0[r+2],p0[r+3]);a=max3f(a,p1[r],p1[r+1]);b=max3f(b,p1[r+2],p1[r+3]);}
  const float m=max2f(a,b);
  auto rr=__builtin_amdgcn_permlane32_swap(__float_as_uint(m),__float_as_uint(m),false,false);
  return max2f(__uint_as_float(rr[0]),__uint_as_float(rr[1]));
}
__device__ __forceinline__ void pv(f32x16*o,int vb,bf16x8 pa0,bf16x8 pa1,bf16x8 pa2,bf16x8 pa3){
  #pragma unroll
  for(int d0=0;d0<2;++d0){s16x4 lo[4],hi[4];
    #pragma unroll
    for(int ks=0;ks<4;++ks){
      asm volatile("ds_read_b64_tr_b16 %0,%1 offset:%c2":"=&v"(lo[ks]):"v"(vb),"i"(d0*4096+ks*1024):"memory");
      asm volatile("ds_read_b64_tr_b16 %0,%1 offset:%c2":"=&v"(hi[ks]):"v"(vb),"i"(d0*4096+ks*1024+512):"memory");}
    asm volatile("s_waitcnt lgkmcnt(0)":::"memory");SBAR();
    #define PK(k) (bf16x8){lo[k][0],lo[k][1],lo[k][2],lo[k][3],hi[k][0],hi[k][1],hi[k][2],hi[k][3]}
    o[d0]=__builtin_amdgcn_mfma_f32_32x32x16_bf16(pa0,PK(0),o[d0],0,0,0);
    o[d0]=__builtin_amdgcn_mfma_f32_32x32x16_bf16(pa1,PK(1),o[d0],0,0,0);
    o[d0]=__builtin_amdgcn_mfma_f32_32x32x16_bf16(pa2,PK(2),o[d0],0,0,0);
    o[d0]=__builtin_amdgcn_mfma_f32_32x32x16_bf16(pa3,PK(3),o[d0],0,0,0);
    #undef PK
  }
}

#ifndef ATTN_STORE16
#define ATTN_STORE16(p,v) (*(u32x4*)(p)=(v))
#endif
template<int THRL> __device__ __forceinline__ void attn_unit(long qrow0,long kvrow0,int NT,int h,const bf16*Q,const bf16*__restrict__ K,const bf16*__restrict__ V,bf16*O,char*shm,int tid_in){
  int tid_l=tid_in; asm volatile("":"+v"(tid_l)); const int tid=tid_l,lane=tid&63,r32=lane&31,hi=lane>>5; const int wid=__builtin_amdgcn_readfirstlane(tid>>6);
  const bf16*Qw=Q+(qrow0+wid*QBLK)*DM+h*D;
  const bf16*Kh=K+kvrow0*KVP+(h>>2)*D,*Vh=V+kvrow0*KVP+(h>>2)*D;
  const unsigned lds0=(unsigned)(uintptr_t)shm;
  float*wsf=(float*)(shm+LDS_WS)+wid*64;
  const bf16*ksrc=Kh+(long)lane*KVP+wid*8;
  const bf16*vsrc=Vh+(long)(16*(wid&3)+(lane>>2))*KVP+(wid>>2)*32+(lane&3)*8;
  const unsigned kdst=lds0+LDS_K+wid*1024, vdst=lds0+LDS_V+wid*1024;
  #define DMA_K(t,slot) glds16(ksrc+(long)(t)*KVBLK*KVP,(unsigned)__builtin_amdgcn_readfirstlane(kdst+(slot)))
  #define DMA_V(t,slot) glds16(vsrc+(long)(t)*KVBLK*KVP,(unsigned)__builtin_amdgcn_readfirstlane(vdst+(slot)))
  const int vb0=(int)(lds0+LDS_V)+((lane>>4)&1)*32+(lane&3)*8+(4*hi+((lane&15)>>2))*64;
  const char*Kbase=shm+LDS_K; bf16x8 kf[8];
  const lds_cptr shm3=(lds_cptr)shm; const lds_cptr kp0=shm3+LDS_K+hi*1024+r32*16; const lds_cptr vp0=shm3+LDS_V+((lane>>4)&1)*32+(lane&3)*8+(4*hi+((lane&15)>>2))*64;
  DMA_K(0,0);DMA_V(0,0);DMA_K(1,SLOTB);
  bf16x8 qr[4];
  #pragma unroll
  for(int d0=0;d0<4;++d0)qr[d0]=*reinterpret_cast<const bf16x8*>(&Qw[(long)r32*DM+d0*16+hi*8]);
  float mhat=0.f,l_reg=0.f;f32x16 o[2];o[0]=f32x16{};o[1]=f32x16{};f32x16 negm=f32x16{};asm volatile("":"+v"(negm));
  #define CMASK(P0,P1,t) do{}while(0)
  bool resc=false;
  #define START(P0,P1) do{ const float rm=rowmax(P0,P1); resc=false; \
    { const float dl=rm; mhat=fadd_s(mhat,dl); \
      _Pragma("unroll") for(int r=0;r<16;++r){P0[r]=fsub_s(P0[r],dl);P1[r]=fsub_s(P1[r],dl);} \
      _Pragma("unroll") for(int r=0;r<16;++r)negm[r]=-mhat; asm volatile("":"+v"(negm)); } \
    _Pragma("unroll") for(int r=0;r<16;++r)P0[r]=__builtin_amdgcn_exp2f(P0[r]); }while(0)
  #define RESC() do{ if(resc){ asm volatile("s_waitcnt lgkmcnt(0)":::"memory"); \
      _Pragma("unroll") for(int d_=0;d_<2;++d_) _Pragma("unroll") for(int r=0;r<16;++r)o[d_][r]*=wsf[crow(r,hi)]; } }while(0)
  f32x16 pA0,pA1,pB0,pB1;
  int sl_prev=0,sl_cur=0,sl_next=SLOTB;
  #define ROT() do{sl_prev=sl_cur;sl_cur=sl_next;sl_next=(sl_next==(NSLOT-1)*SLOTB)?0:sl_next+SLOTB;}while(0)
  DMA_K(2,2*SLOTB);
  WAIT_BAR(3);
  qkt(pA0,pA1,Kbase,qr,negm,r32,hi);asm volatile("s_nop 15\n\ts_nop 7":"+v"(pA0),"+v"(pA1));CMASK(pA0,pA1,0);
  START(pA0,pA1);
  _Pragma("unroll") for(int r=0;r<16;++r)pA1[r]=__builtin_amdgcn_exp2f(pA1[r]);
  WAIT_BAR(0);
  DMA_K(3,0);DMA_V(1,SLOTB);
  ROT();
  kload8(kf,kp0+sl_cur);
  WAIT_BAR(2);
  s16x4 vlo[8],vhi[8]; u32x4 pw0,pw1,pw2,pw3;
  #define PKW(P,B) cvtpk_s(P[B],P[B+1])
  #define PAF(k) __builtin_bit_cast(bf16x8,pw##k)
  #define VFR(i) (bf16x8){vlo[i][0],vlo[i][1],vlo[i][2],vlo[i][3],vhi[i][0],vhi[i][1],vhi[i][2],vhi[i][3]}
  #define PIN(x) asm volatile("":"+v"(x))
  #define MX3(a,b,c) __builtin_fmaxf(__builtin_fmaxf((a),(b)),(c))
  #define GAPA(MF,A0,A1,A2,A3,W0,W1,PW) do{ MF; sacc+=A0; sacc+=A1; sacc+=A2; sacc+=A3; PIN(sacc); W0; W1; PIN(PW); SBAR(); }while(0)
  #define EX(v) __builtin_amdgcn_exp2f(v)
  #define GAPB(MF,X,B) do{ MF; X[B]=EX(X[B]); X[B+1]=EX(X[B+1]); X[B+2]=EX(X[B+2]); X[B+3]=EX(X[B+3]); PIN(X); SBAR(); }while(0)
  #define VRD(i) do{ vlo[i]=vtr(vp_+(((i)>>2)*4096+((i)&3)*1024)); vhi[i]=vtr(vp_+(((i)>>2)*4096+((i)&3)*1024+512)); }while(0)
  #define KRD(G,j) do{ if(G){ kload2(kf,kp0+sl_next,j); SBAR(); } }while(0)
  #define STEP(C0,C1,P0,P1,t,GK,GV,GL) do{ SBAR(); \
    const lds_cptr vp_=vp0+sl_prev; \
    VRD(0); SBAR(); float sacc=(P0[0]+P0[1]); \
    GAPA(C0=__builtin_amdgcn_mfma_f32_32x32x16_bf16(kf[0],qr[0],negm,0,0,0), P0[2],P0[3],P0[4],P0[5],     pw0[0]=PKW(P0,0), pw0[1]=PKW(P0,2), pw0); \
    VRD(4); SBAR(); GAPA(C1=__builtin_amdgcn_mfma_f32_32x32x16_bf16(kf[1],qr[0],negm,0,0,0), P0[6],P0[7],P0[8],P0[9],     pw0[2]=PKW(P0,4), pw0[3]=PKW(P0,6), pw0); \
    VRD(1); SBAR(); GAPA(C0=__builtin_amdgcn_mfma_f32_32x32x16_bf16(kf[2],qr[1],C0,0,0,0),   P0[10],P0[11],P0[12],P0[13], pw1[0]=PKW(P0,8), pw1[1]=PKW(P0,10), pw1); \
    VRD(5); SBAR(); GAPA(C1=__builtin_amdgcn_mfma_f32_32x32x16_bf16(kf[3],qr[1],C1,0,0,0),   P0[14],P0[15],P1[0],P1[1],   pw1[2]=PKW(P0,12),pw1[3]=PKW(P0,14), pw1); \
    VRD(2); SBAR(); GAPA(C0=__builtin_amdgcn_mfma_f32_32x32x16_bf16(kf[4],qr[2],C0,0,0,0),   P1[2],P1[3],P1[4],P1[5],     pw2[0]=PKW(P1,0), pw2[1]=PKW(P1,2), pw2); \
    VRD(6); SBAR(); GAPA(C1=__builtin_amdgcn_mfma_f32_32x32x16_bf16(kf[5],qr[2],C1,0,0,0),   P1[6],P1[7],P1[8],P1[9],     pw2[2]=PKW(P1,4), pw2[3]=PKW(P1,6), pw2); \
    VRD(3); SBAR(); GAPA(C0=__builtin_amdgcn_mfma_f32_32x32x16_bf16(kf[6],qr[3],C0,0,0,0),   P1[10],P1[11],P1[12],P1[13], pw3[0]=PKW(P1,8), pw3[1]=PKW(P1,10), pw3); \
    VRD(7); SBAR(); GAPA(C1=__builtin_amdgcn_mfma_f32_32x32x16_bf16(kf[7],qr[3],C1,0,0,0),   P1[14],P1[15],0.f,0.f,       pw3[2]=PKW(P1,12),pw3[3]=PKW(P1,14), pw3); \
    l_reg+=sacc; \
    if(GK){DMA_K((t)+3,sl_cur);} if(GV){DMA_V((t)+1,sl_next);} \
    CMASK(C0,C1,t); \
    { float a=MX3(C0[0],C0[1],C1[0]),b=MX3(C0[2],C0[3],C1[1]); a=MX3(a,C1[2],C1[3]); \
      _Pragma("unroll") for(int r=4;r<16;r+=4){a=MX3(a,C0[r],C0[r+1]);b=MX3(b,C0[r+2],C0[r+3]);a=MX3(a,C1[r],C1[r+1]);b=MX3(b,C1[r+2],C1[r+3]);} \
      float rm=__builtin_fmaxf(a,b); { auto rr=__builtin_amdgcn_permlane32_swap(__float_as_uint(rm),__float_as_uint(rm),false,false); rm=__builtin_fmaxf(__uint_as_float(rr[0]),__uint_as_float(rr[1])); } \
      resc=false; \
      if(__builtin_expect(__any(rm>(float)THRL),0)){ const float dl=__builtin_fmaxf(rm,0.f); mhat+=dl; \
        _Pragma("unroll") for(int r=0;r<16;++r){C0[r]-=dl;C1[r]-=dl;} \
        _Pragma("unroll") for(int r=0;r<16;++r)negm[r]=-mhat; asm volatile("":"+v"(negm)); \
        const float f=__builtin_amdgcn_exp2f(-dl); l_reg*=f; if(hi==0)wsf[r32]=f; resc=true; } } \
    SBAR(); \
    GAPB(o[0]=__builtin_amdgcn_mfma_f32_32x32x16_bf16(PAF(0),VFR(0),o[0],0,0,0), C0,0); \
    GAPB(o[1]=__builtin_amdgcn_mfma_f32_32x32x16_bf16(PAF(0),VFR(4),o[1],0,0,0), C0,4); \
    KRD(GL,0); GAPB(o[0]=__builtin_amdgcn_mfma_f32_32x32x16_bf16(PAF(1),VFR(1),o[0],0,0,0), C0,8); \
    KRD(GL,1); GAPB(o[1]=__builtin_amdgcn_mfma_f32_32x32x16_bf16(PAF(1),VFR(5),o[1],0,0,0), C0,12); \
    KRD(GL,2); GAPB(o[0]=__builtin_amdgcn_mfma_f32_32x32x16_bf16(PAF(2),VFR(2),o[0],0,0,0), C1,0); \
    KRD(GL,3); GAPB(o[1]=__builtin_amdgcn_mfma_f32_32x32x16_bf16(PAF(2),VFR(6),o[1],0,0,0), C1,4); \
    GAPB(o[0]=__builtin_amdgcn_mfma_f32_32x32x16_bf16(PAF(3),VFR(3),o[0],0,0,0), C1,8); \
    GAPB(o[1]=__builtin_amdgcn_mfma_f32_32x32x16_bf16(PAF(3),VFR(7),o[1],0,0,0), C1,12); \
    }while(0)
  int t=1;
  #undef CMASK
  #define CMASK(P0,P1,t) do{}while(0)
  for(;t+5<NT;t+=2){
    STEP(pB0,pB1,pA0,pA1,t,true,true,true);     WAIT_BAR(2); RESC(); ROT();
    STEP(pA0,pA1,pB0,pB1,t+1,true,true,true);   WAIT_BAR(2); RESC(); ROT();
  }
  #undef CMASK
  #define CMASK(P0,P1,t) do{}while(0)
  #define ENDW(tt) do{ if((tt)+3<NT){WAIT_BAR(2);} else if((tt)+2<NT){WAIT_BAR(1);} else {WAIT_BAR(0);} }while(0)
  for(;t+1<NT;t+=2){
    STEP(pB0,pB1,pA0,pA1,t,(t+3<NT),(t+1<NT),(t+1<NT));       ENDW(t);   RESC(); ROT();
    STEP(pA0,pA1,pB0,pB1,t+1,(t+4<NT),(t+2<NT),(t+2<NT));     ENDW(t+1); RESC(); ROT();
  }
  STEP(pB0,pB1,pA0,pA1,NT-1,false,false,false); RESC();
  { float sacc=pB0[0]+pB0[1]; _Pragma("unroll") for(int r=2;r<16;++r)sacc+=pB0[r]; _Pragma("unroll") for(int r=0;r<16;++r)sacc+=pB1[r]; l_reg+=sacc;
    pw0=(u32x4){PKW(pB0,0),PKW(pB0,2),PKW(pB0,4),PKW(pB0,6)};pw1=(u32x4){PKW(pB0,8),PKW(pB0,10),PKW(pB0,12),PKW(pB0,14)};pw2=(u32x4){PKW(pB1,0),PKW(pB1,2),PKW(pB1,4),PKW(pB1,6)};pw3=(u32x4){PKW(pB1,8),PKW(pB1,10),PKW(pB1,12),PKW(pB1,14)};
    SBAR(); pv(o,vb0+sl_cur,PAF(0),PAF(1),PAF(2),PAF(3)); }
  #undef PKW
  #undef PAF
  #undef VFR
  #undef PIN
  #undef MX3
  #undef GAPA
  #undef GAPB
  #undef EX
  #undef VRD
  #undef KRD
  #undef STEP
  #undef ENDW
  {auto rr=__builtin_amdgcn_permlane32_swap(__float_as_uint(l_reg),__float_as_uint(l_reg),false,false);l_reg=__uint_as_float(rr[0])+__uint_as_float(rr[1]);}
  if(hi==0)wsf[32+r32]=l_reg;asm volatile("s_waitcnt lgkmcnt(0)":::"memory");
  float rli[16];
  #pragma unroll
  for(int r=0;r<16;++r)rli[r]=__builtin_amdgcn_rcpf(wsf[32+crow(r,hi)]);
  bf16*Ow=O+(qrow0+wid*QBLK)*DM+h*D;
  { bf16*stg=(bf16*)(shm+LDS_OST)+wid*2048;
    #pragma unroll
    for(int r=0;r<16;++r){const int orow=crow(r,hi);
      #pragma unroll
      for(int d0=0;d0<2;++d0)stg[orow*64+d0*32+r32]=__float2bfloat16(o[d0][r]*rli[r]);}
    asm volatile("s_waitcnt lgkmcnt(0)":::"memory");
    #pragma unroll
    for(int i=0;i<4;++i){const int row=i*8+(lane>>3),ch=lane&7; const u32x4 v=*(const u32x4*)(stg+row*64+ch*8); ATTN_STORE16(Ow+(long)row*DM+ch*8,v);} }
  asm volatile("s_waitcnt lgkmcnt(0)\n\ts_barrier":::"memory");
  #undef DMA_K
  #undef DMA_V
  #undef CMASK
  #undef START
  #undef RESC
  #undef ROT
}
constexpr int ATTN_LDS_BYTES=LDS_BYTES;
#undef SBAR
#undef WAIT_BAR
}

constexpr int NWAVES = 8;
constexpr int NB = 8, SEQ = 4096, CTXL = 256, TB = SEQ + CTXL  , MT = NB * TB  , DMODEL = 1024;
constexpr int NMODC = 6 * DMODEL, MODROWS = 9;
constexpr int QKVN = 1536, WINN = 3104, WINP = 3328;
constexpr int NEXP = 32, TOPK = 4, MPAD = MT * TOPK + NEXP * 256;
constexpr int NLAYER = 4;
constexpr float RMS_EPS = 1e-6f;
constexpr float ATT_C2 = 0.125f * 1.4426950408889634f;

constexpr size_t MiB = 1u << 20;
constexpr size_t WS_CTL = 0, CTL_ZERO_BYTES = 1 * MiB;
constexpr size_t WS_MOD = 1 * MiB, WS_ROPE = 2 * MiB, WS_MODP = 3 * MiB;
constexpr size_t WS_SLOT = 17 * MiB, WS_GATEW = 18 * MiB, WS_SLOTPOS = 19 * MiB;
constexpr size_t WS_WQKV = 20 * MiB, WS_WOA = 26 * MiB, WS_WIN = 30 * MiB, WS_WOG = 43 * MiB, WS_WGU = 48 * MiB, WS_WDN = 560 * MiB;
constexpr size_t WS_X = 816 * MiB, WS_XN = 952 * MiB, WS_Q = 1020 * MiB, WS_K = 1088 * MiB, WS_V = 1105 * MiB, WS_G = 1122 * MiB;
constexpr size_t WS_OF = 1343 * MiB, WS_OB = 1479 * MiB, WS_XG = 1615 * MiB, WS_ACT = 1903 * MiB, WS_Y = 2191 * MiB, WS_PAR = 2479 * MiB, WS_LIST = 2483 * MiB  , WS_END = 2488 * MiB;
static_assert(WS_MODP + (size_t)16 * NLAYER * MODROWS * NMODC * 4 <= WS_SLOT && WS_WIN + (size_t)2 * WINP * 1024 * 2 <= WS_WOG && WS_G + (size_t)MT * WINP * 2 <= WS_OF && WS_XG + (size_t)MPAD * 1024 * 2 <= WS_ACT, "ws map");
constexpr int CW_TMO = 0, CW_BAR = 4096, CW_CNT = 16384;

constexpr int RING_OFF = 0, RING_BYTES = 131072;
constexpr int WR_STRIDE = 1028;
constexpr int LDS_AUX = 133120;
constexpr int AUX_LCNT = LDS_AUX, AUX_GB = LDS_AUX + 128, AUX_T2E = LDS_AUX + 256  , AUX_BASE = AUX_T2E + 2560  , AUX_NT = AUX_BASE + 128, AUX_CNT = AUX_NT + 64  , AUX_ENT = AUX_CNT + 128  , AUX_RS = AUX_ENT + 4352  , AUX_ROWTAB = AUX_RS + 576, ROWTAB_UNITS = 18  ;
constexpr int MISC_OFF = 154624;
constexpr int LDS_BYTES = 155648;
static_assert(AUX_ROWTAB + ROWTAB_UNITS * 512 <= MISC_OFF, "LDS map");

#define GAS __attribute__((address_space(1)))
#define LAS __attribute__((address_space(3)))
typedef unsigned short bf16;
typedef unsigned v4u __attribute__((ext_vector_type(4)));
typedef float f32x4 __attribute__((ext_vector_type(4)));
typedef short bf16x8 __attribute__((ext_vector_type(8)));
typedef GAS unsigned gu32;
typedef GAS unsigned long long gu64;
#define RLX_AGENT __ATOMIC_RELAXED, __HIP_MEMORY_SCOPE_AGENT
#define LDS_WAIT() asm volatile("s_waitcnt lgkmcnt(0)" ::: "memory")
#define VM_WAIT() asm volatile("s_waitcnt vmcnt(0)" ::: "memory")
__device__ __forceinline__ unsigned long long rt() { return __builtin_amdgcn_s_memrealtime(); }
__device__ __forceinline__ unsigned f2bf(float f) { unsigned u = __builtin_bit_cast(unsigned, f); return (u + 0x7fffu + ((u >> 16) & 1u)) >> 16; }
__device__ __forceinline__ unsigned pk2(float lo, float hi) { return f2bf(lo) | (f2bf(hi) << 16); }

#define XB_TMO      128
#define XB_XCNT(j)  (256  + 64 * (j))
#define XB_XSUB(j)  (1280 + 64 * (j))
#define XB_XGEN(j)  (2304 + 64 * (j))
#define XB_TOP      3328
#define XB_TOPGEN   3392
#define XCD_BAR_WORDS 3456
#define XB_SPIN_CAP (1u << 18)

__device__ __forceinline__ unsigned xb_ld(unsigned* p)              { return __hip_atomic_load(p, __ATOMIC_RELAXED, __HIP_MEMORY_SCOPE_AGENT); }
__device__ __forceinline__ unsigned xb_add(unsigned* p, unsigned v) { return __hip_atomic_fetch_add(p, v, __ATOMIC_RELAXED, __HIP_MEMORY_SCOPE_AGENT); }
__device__ __forceinline__ unsigned xb_xcc_id() { return (unsigned)__builtin_amdgcn_s_getreg((3 << 11) | 20) & 0xFu; }
#define XB_SPIN(cond, bar) do { unsigned _sp = 0; while (cond) { __builtin_amdgcn_s_sleep(1); \
    if ((++_sp & 255u) == 0u) { if (xb_ld(&(bar)[XB_TMO])) break; if (_sp > XB_SPIN_CAP) { atomicAdd(&(bar)[XB_TMO], 1u); break; } } } } while (0)

struct XcdBarrier {
    unsigned* bar; unsigned x;
    volatile LAS unsigned* st;
};

__device__ __forceinline__ XcdBarrier xcd_barrier_post(unsigned* bar, volatile LAS unsigned* st, bool xb_t0  ) {
    XcdBarrier b; b.bar = bar; b.x = xb_xcc_id(); b.st = st;
    if (xb_t0) (void)xb_add(&bar[XB_XCNT(b.x)], 1u);
    return b;
}
__device__ __forceinline__ void xcd_barrier_complete(unsigned* bar, unsigned x, unsigned& nloc, unsigned& nx) {
    const unsigned G = gridDim.x * gridDim.y * gridDim.z;
    unsigned sum, cnt, mine, sp = 0u;
    for (;;) {
        sum = 0u; cnt = 0u; mine = 0u;
#pragma unroll
        for (unsigned j = 0; j < 16; ++j) { const unsigned c = xb_ld(&bar[XB_XCNT(j)]); sum += c; cnt += (c > 0u) ? 1u : 0u; mine = (j == x) ? c : mine; }
        if (sum == G) break;
        __builtin_amdgcn_s_sleep(1);
        if ((++sp & 255u) == 0u) { if (xb_ld(&bar[XB_TMO])) break; if (sp > XB_SPIN_CAP) { atomicAdd(&bar[XB_TMO], 1u); break; } }
    }
    nloc = mine > 0u ? mine : 1u; nx = cnt > 0u ? cnt : 1u;
}

__device__ __forceinline__ void xcd_barrier(const XcdBarrier& b, bool xb_t0  ) {
    asm volatile("s_waitcnt vmcnt(0)" ::: "memory");
    __syncthreads();
    if (xb_t0) {
        unsigned* bar = b.bar;
        __builtin_amdgcn_s_waitcnt(0);
        unsigned nloc = b.st[0], nx = b.st[1];
        if (nloc == 0u) { xcd_barrier_complete(bar, b.x, nloc, nx); b.st[0] = nloc; b.st[1] = nx; }
        const unsigned old = xb_add(&bar[XB_XSUB(b.x)], 1u);
        const unsigned gen = old / nloc;
        if (old + 1u == (gen + 1u) * nloc) {
            __builtin_amdgcn_fence(__ATOMIC_RELEASE, "agent");
            asm volatile("s_waitcnt vmcnt(0)" ::: "memory");
            const unsigned og = xb_add(&bar[XB_TOP], 1u);
            const unsigned tg = og / nx;
            if (og + 1u == (tg + 1u) * nx) xb_add(&bar[XB_TOPGEN], 1u);
            else XB_SPIN(xb_ld(&bar[XB_TOPGEN]) == tg, bar);
            __builtin_amdgcn_fence(__ATOMIC_ACQUIRE, "agent");
            xb_add(&bar[XB_XGEN(b.x)], 1u);
            asm volatile("s_waitcnt vmcnt(0)" ::: "memory");
        } else {
            XB_SPIN(xb_ld(&bar[XB_XGEN(b.x)]) == gen, bar);
            __builtin_amdgcn_fence(__ATOMIC_ACQUIRE, "agent");
            asm volatile("s_waitcnt vmcnt(0)" ::: "memory");
        }
    }
    __syncthreads();
}

typedef float f32x2 __attribute__((ext_vector_type(2)));
using pg8::lane_now; using pg8::shx;
__device__ __forceinline__ float wave_sum(float v) {
    const int ln = lane_now();
#pragma unroll
    for (int o = 1; o < 64; o <<= 1) v += shx(v, o, ln);
    return v;
}
__device__ __forceinline__ float wave_max(float v) {
    const int ln = lane_now();
#pragma unroll
    for (int o = 1; o < 64; o <<= 1) v = fmaxf(v, shx(v, o, ln));
    return v;
}
__device__ __forceinline__ float bf2f(unsigned short h) { return __uint_as_float((unsigned)h << 16); }
__device__ __forceinline__ float silu_f(float x) { return x / (1.0f + __expf(-x)); }
__device__ __forceinline__ f32x4 bf4_to_f32(unsigned long long v) { return (f32x4){__uint_as_float((unsigned)(v & 0xffffu) << 16), __uint_as_float((unsigned)(v >> 16) << 16), __uint_as_float((unsigned)((v >> 32) & 0xffffu) << 16), __uint_as_float((unsigned)(v >> 48) << 16)}; }
__device__ __forceinline__ unsigned long long f32_to_bf4(f32x4 y) { return (unsigned long long)pk2(y.x, y.y) | ((unsigned long long)pk2(y.z, y.w) << 32); }
__device__ __forceinline__ int mod_row(int m) { const int b = m / TB; return (m - b * TB < CTXL) ? 8 : b; }

__device__ __forceinline__ void transpose_item(const float* W, int K, int N, bf16* WT, int k0, int n0, int dst_row0, LAS float* scr, int lane) {
#pragma unroll 8
    for (int i = 0; i < 32; ++i) { const int kk = 2 * i + (lane >> 5); scr[kk * 33 + (lane & 31)] = W[(size_t)(k0 + kk) * N + n0 + (lane & 31)]; }
    LDS_WAIT(); asm volatile("" ::: "memory");
    const int c = lane & 7;
#pragma unroll
    for (int j = 0; j < 4; ++j) { const int n = (lane >> 3) + 8 * j; const LAS float* s = scr + (8 * c) * 33 + n;
        v4u o; o.x = pk2(s[0 * 33], s[1 * 33]); o.y = pk2(s[2 * 33], s[3 * 33]); o.z = pk2(s[4 * 33], s[5 * 33]); o.w = pk2(s[6 * 33], s[7 * 33]);
        *(GAS v4u*)(WT + (size_t)(dst_row0 + n) * K + k0 + 8 * c) = o; }
    LDS_WAIT(); asm volatile("" ::: "memory");
}

struct Args { const float* in[25]; float* out; unsigned char* ws; int ph_lo, ph_hi; };
constexpr int P_N1G = 0, P_N2G = 4096, P_QG = 8192, P_KG = 8320, P_GKF = 8448, P_GKB = 24832, P_BGF = 41216, P_BGB = 42240, P_OG = 43264, P_WR = 43776, P_BR = 174848, P_BGU = 174976, P_BDN = 437120, P_END = 568192;
#define LAUNDER_S(p) asm volatile("" : "+s"(p))
#define LAUNDER_V(p) asm volatile("" : "+v"(p))
#define PARF(ws) ((const float*)((ws) + WS_PAR))

__device__ __forceinline__ void p0_prologue(const Args& A, LAS unsigned char* lds, int gw, int NGW, int wave, int lane) {
    unsigned char* ws = A.ws;
    LAS float* scr = (LAS float*)(lds + RING_OFF + wave * 16384);
    constexpr int I_QKV = 2 * 16 * (QKVN / 32), I_WO = 2 * 16 * 32, I_WIN = 2 * 16 * (WINN / 32), I_GU = 128 * 16 * 64, I_DN = 128 * 16 * 32;
    constexpr int NITEMS = I_GU + I_DN + I_QKV + I_WO + I_WIN + I_WO;
    for (int it = gw; it < NITEMS; it += NGW) {
        int r = it;
        if (r < I_GU) { const int mat = r / (16 * 64), q = r - mat * (16 * 64), kb = q / 64, nb = q - kb * 64, n0 = nb * 32;
            const int dst = ((n0 & 1023) >> 7) * 256 + (n0 >> 10) * 128 + (n0 & 127);
            transpose_item(A.in[21] + (size_t)mat * 1024 * 2048, 1024, 2048, (bf16*)(ws + WS_WGU) + (size_t)mat * 2048 * 1024, kb * 64, n0, dst, scr, lane); continue; } r -= I_GU;
        if (r < I_DN) { const int mat = r / (16 * 32), q = r - mat * (16 * 32), kb = q / 32, nb = q - kb * 32;
            transpose_item(A.in[23] + (size_t)mat * 1024 * 1024, 1024, 1024, (bf16*)(ws + WS_WDN) + (size_t)mat * 1024 * 1024, kb * 64, nb * 32, nb * 32, scr, lane); continue; } r -= I_DN;
        if (r < I_QKV) { const int per = 16 * (QKVN / 32), mat = r / per, q = r - mat * per, kb = q / (QKVN / 32), nb = q - kb * (QKVN / 32);
            const int n0 = nb * 32, dst = (n0 & ~255) + ((n0 >> 5) & 1) * 128 + ((n0 >> 6) & 3) * 32;
            transpose_item(A.in[8] + (size_t)mat * 1024 * QKVN, 1024, QKVN, (bf16*)(ws + WS_WQKV) + (size_t)mat * QKVN * 1024, kb * 64, n0, dst, scr, lane); continue; } r -= I_QKV;
        if (r < I_WO) { const int mat = r / 512, q = r - mat * 512, kb = q / 32, nb = q - kb * 32;
            transpose_item(A.in[11] + (size_t)mat * 1024 * 1024, 1024, 1024, (bf16*)(ws + WS_WOA) + (size_t)mat * 1024 * 1024, kb * 64, nb * 32, nb * 32, scr, lane); continue; } r -= I_WO;
        if (r < I_WIN) { const int per = 16 * (WINN / 32), mat = r / per, q = r - mat * per, kb = q / (WINN / 32), nb = q - kb * (WINN / 32);
            transpose_item(A.in[12] + (size_t)mat * 1024 * WINN, 1024, WINN, (bf16*)(ws + WS_WIN) + (size_t)mat * WINP * 1024, kb * 64, nb * 32, nb * 32, scr, lane); continue; } r -= I_WIN;
        { const int mat = r / 512, q = r - mat * 512, kb = q / 32, nb = q - kb * 32;
            transpose_item(A.in[18] + (size_t)mat * 1024 * 1024, 1024, 1024, (bf16*)(ws + WS_WOG) + (size_t)mat * 1024 * 1024, kb * 64, nb * 32, nb * 32, scr, lane); }
    }
    for (int it = gw; it < 2 * (WINP - WINN); it += NGW) { const int mat = it / (WINP - WINN), rr = WINN + it - mat * (WINP - WINN);
        GAS v4u* p = (GAS v4u*)((bf16*)(ws + WS_WIN) + ((size_t)mat * WINP + rr) * 1024) + lane; p[0] = (v4u){0u, 0u, 0u, 0u}; p[64] = (v4u){0u, 0u, 0u, 0u}; }
    for (int it = gw; it < NLAYER * 24 * 16; it += NGW) {
        const int l = it / (24 * 16), q = it - l * (24 * 16), cg = q / 16, kc = q - cg * 16;
        float s[MODROWS];
#pragma unroll
        for (int r = 0; r < MODROWS; ++r) { const float cv = (r < 8) ? A.in[1][r * 1024 + kc * 64 + lane] : A.in[3][kc * 64 + lane]; s[r] = silu_f(cv); }
        f32x4 acc[MODROWS];
#pragma unroll
        for (int r = 0; r < MODROWS; ++r) acc[r] = (f32x4){0.f, 0.f, 0.f, 0.f};
        const float* wp = A.in[4] + ((size_t)l * 1024 + kc * 64) * NMODC + cg * 256 + 4 * lane;
#pragma unroll 4
        for (int kk = 0; kk < 64; ++kk) { const f32x4 w = *(const f32x4*)(wp + (size_t)kk * NMODC);
#pragma unroll
            for (int r = 0; r < MODROWS; ++r) { const float sv = __shfl(s[r], kk); acc[r] = acc[r] + w * sv; } }
        float* op = (float*)(ws + WS_MODP) + (size_t)kc * (NLAYER * MODROWS * NMODC) + (size_t)l * MODROWS * NMODC + cg * 256 + 4 * lane;
#pragma unroll
        for (int r = 0; r < MODROWS; ++r) *(f32x4*)(op + (size_t)r * NMODC) = acc[r];
    }
    for (int m = gw; m < MT; m += NGW) { const int b = m / TB, w = m - b * TB;
        const float* src = (w < CTXL) ? A.in[2] + ((size_t)b * CTXL + w) * 1024 : A.in[0] + ((size_t)b * SEQ + (w - CTXL)) * 1024;
        const GAS f32x4* sp = (const GAS f32x4*)src + lane; GAS unsigned long long* dp = (GAS unsigned long long*)((bf16*)(ws + WS_X) + (size_t)m * 1024) + lane;
#pragma unroll
        for (int j = 0; j < 4; ++j) dp[64 * j] = f32_to_bf4(sp[64 * j]); }
    { float* par = (float*)(ws + WS_PAR); const int gt = gw * 64 + lane, NGT = NGW * 64;
#define CPY(src, n, off) for (int i = gt; i < (n); i += NGT) par[(off) + i] = A.in[src][i];
      CPY(6, 4096, P_N1G) CPY(7, 4096, P_N2G) CPY(9, 128, P_QG) CPY(10, 128, P_KG) CPY(13, 16384, P_GKF) CPY(15, 16384, P_GKB) CPY(14, 1024, P_BGF) CPY(16, 1024, P_BGB)
      CPY(17, 512, P_OG) CPY(19, 131072, P_WR) CPY(20, 128, P_BR) CPY(22, 262144, P_BGU) CPY(24, 131072, P_BDN)
#undef CPY
    }
    for (int idx = gw * 64 + lane; idx < SEQ * 32; idx += NGW * 64) { const int s = idx >> 5, i = idx & 31;
        const float invf = 1.0f / powf(10000.0f, (float)(i & 15) * (1.0f / 16.0f));
        const float ang = (float)((i < 16) ? (s >> 6) : (s & 63)) * invf;
        ((float*)(ws + WS_ROPE))[idx] = cosf(ang); ((float*)(ws + WS_ROPE))[SEQ * 32 + idx] = sinf(ang); }
}
__device__ __forceinline__ void p1_mod_reduce(const Args& A, int gtid, int NGT) {
    const float* P = (const float*)(A.ws + WS_MODP); float* Mo = (float*)(A.ws + WS_MOD);
    constexpr int N = NLAYER * MODROWS * NMODC;
    for (int i = gtid; i < N; i += NGT) { const int l = i / (MODROWS * NMODC), c = i % NMODC; float s = A.in[5][l * NMODC + c];
#pragma unroll
        for (int k = 0; k < 16; ++k) s += P[(size_t)k * N + i];
        Mo[i] = s; }
}
__device__ __forceinline__ void modulate_row(const bf16* xrow, const float* ng, const float* shp, const float* scp, bf16* orow, int lane, f32x4 (&y)[4], float& rs_out) {
    const GAS unsigned long long* xr = (const GAS unsigned long long*)xrow + lane;
    float ss = 0.f;
#pragma unroll
    for (int j = 0; j < 4; ++j) { y[j] = bf4_to_f32(xr[64 * j]); ss += (y[j].x * y[j].x + y[j].y * y[j].y) + (y[j].z * y[j].z + y[j].w * y[j].w); }
    const float rs = 1.0f / sqrtf(wave_sum(ss) * (1.0f / 1024.0f) + RMS_EPS); rs_out = rs;
    GAS unsigned long long* o8 = (GAS unsigned long long*)orow + lane;
#pragma unroll
    for (int j = 0; j < 4; ++j) { const f32x4 g = ((const GAS f32x4*)ng)[64 * j + lane], sh = ((const GAS f32x4*)shp)[64 * j + lane], sc = ((const GAS f32x4*)scp)[64 * j + lane];
        y[j] = (y[j] * rs) * g * (sc + 1.0f) + sh;
        o8[64 * j] = (unsigned long long)pk2(y[j].x, y[j].y) | ((unsigned long long)pk2(y[j].z, y[j].w) << 32); }
}
__device__ __forceinline__ void phase_modulate1(unsigned char* ws, int layer, int gw, int NGW, int lane) {
    const bf16* X = (const bf16*)(ws + WS_X); bf16* XN = (bf16*)(ws + WS_XN);
    const float* ng = PARF(ws) + P_N1G + layer * 1024; const float* Mo = (const float*)(ws + WS_MOD) + (size_t)layer * MODROWS * NMODC;
    for (int m = gw; m < MT; m += NGW) { const int mr = mod_row(m); f32x4 y[4]; float rs;
        modulate_row(X + (size_t)m * 1024, ng, Mo + (size_t)mr * NMODC + 0 * 1024, Mo + (size_t)mr * NMODC + 1 * 1024, XN + (size_t)m * 1024, lane, y, rs); }
}
__device__ __forceinline__ void phase_qknorm_rope(unsigned char* ws, int la, int gw, int NGW, int lane) {
    bf16* Qb = (bf16*)(ws + WS_Q); bf16* Kb = (bf16*)(ws + WS_K);
    const float* qg = PARF(ws) + P_QG + la * 64; const float* kg = PARF(ws) + P_KG + la * 64; const float* ropec = (const float*)(ws + WS_ROPE); const float* ropes = ropec + SEQ * 32;
    const int i = lane & 31, hs = lane >> 5;
    for (int m = gw; m < MT; m += NGW) { const int b = m / TB, w = m - b * TB; const bool lat = w >= CTXL;
        float cs = 1.f, sn = 0.f; if (lat) { cs = ropec[(w - CTXL) * 32 + i]; sn = ropes[(w - CTXL) * 32 + i]; }
#pragma unroll 2
        for (int hh = 0; hh < 20; hh += 2) { const int hd = hh + hs;
            unsigned* p = (hd < 16) ? (unsigned*)(Qb + (size_t)m * 1024 + hd * 64) + i : (unsigned*)(Kb + (size_t)m * 256 + (hd - 16) * 64) + i;
            const float* gp = (hd < 16) ? qg : kg; const float scl = (hd < 16) ? ATT_C2 : 1.0f;
            const unsigned v = *p; const float x1 = __uint_as_float(v << 16), x2 = __uint_as_float(v & 0xffff0000u);
            float ss = x1 * x1 + x2 * x2;
#pragma unroll
            for (int o = 1; o < 32; o <<= 1) ss += shx(ss, o, lane);
            const float rs = 1.0f / sqrtf(ss * (1.0f / 64.0f) + RMS_EPS);
            const float y1 = x1 * rs * gp[2 * i], y2 = x2 * rs * gp[2 * i + 1];
            const float r1 = (y1 * cs - y2 * sn) * scl, r2 = (y1 * sn + y2 * cs) * scl;
            *p = pk2(r1, r2); }
    }
}
__device__ __forceinline__ void phase_gla_recurrent(unsigned char* ws, int lg, LAS unsigned char* lds, int tid) {
    const int unit = blockIdx.x; if (unit >= 128) return;
    const int half = unit & 1, dir = (unit >> 1) & 1, h = (unit >> 2) & 3, b = unit >> 4;
    const bf16* G = (const bf16*)(ws + WS_G);
    float* Oo = (float*)(ws + (dir ? WS_OB : WS_OF));
    const float* wg = PARF(ws) + (dir ? P_GKB : P_GKF) + (size_t)lg * 16 * 512; const float* bg = PARF(ws) + (dir ? P_BGB : P_BGF) + lg * 512;
    LAS float* qq = (LAS float*)(lds + RING_OFF); LAS float* kk = qq + 64 * 128; LAS float* dd = kk + 64 * 128; LAS float* vv = dd + 64 * 128;
    const int sd = tid & 127, st0 = tid >> 7;
    float wcol[16];
#pragma unroll
    for (int r = 0; r < 16; ++r) wcol[r] = wg[r * 512 + h * 128 + sd];
    const float bcol = bg[h * 128 + sd];
    const int c = tid >> 2, dq = tid & 3;
    float s[32];
#pragma unroll
    for (int j = 0; j < 32; ++j) s[j] = 0.f;
    const float qscale = 0.08838834764831845f;
    for (int ch = 0; ch < TB / 64; ++ch) {
        __syncthreads();
#pragma unroll 4
        for (int i = 0; i < 16; ++i) { const int tt = st0 + 4 * i, n = 64 * ch + tt;
            const int w = dir ? (n < CTXL ? (CTXL - 1 - n) : (TB + CTXL - 1 - n)) : n;
            const bf16* gr = G + ((size_t)b * TB + w) * WINP;
            const float qv = bf2f(gr[h * 128 + sd]) * qscale, kv = bf2f(gr[512 + h * 128 + sd]);
            const bf16* lp = gr + 3072 + dir * 16; float z = bcol;
#pragma unroll
            for (int r = 0; r < 16; ++r) z += bf2f(lp[r]) * wcol[r];
            const float ls = fminf(z, 0.f) - log1pf(__expf(-fabsf(z)));
            qq[tt * 128 + sd] = qv; kk[tt * 128 + sd] = kv; dd[tt * 128 + sd] = __expf(ls * (1.0f / 16.0f));
            vv[tt * 128 + sd] = bf2f(gr[1024 + h * 256 + half * 128 + sd]); }
        __syncthreads();
        for (int tt = 0; tt < 64; ++tt) { const int n = 64 * ch + tt; const int w = dir ? (n < CTXL ? (CTXL - 1 - n) : (TB + CTXL - 1 - n)) : n;
            const float v = vv[tt * 128 + c]; float acc = 0.f;
            const LAS f32x4* q4 = (const LAS f32x4*)(qq + tt * 128 + dq * 32); const LAS f32x4* k4 = (const LAS f32x4*)(kk + tt * 128 + dq * 32); const LAS f32x4* d4 = (const LAS f32x4*)(dd + tt * 128 + dq * 32);
#pragma unroll
            for (int j = 0; j < 8; ++j) { const f32x4 qv = q4[j], kv = k4[j], dv = d4[j];
                s[4 * j + 0] = s[4 * j + 0] * dv.x + kv.x * v; acc += qv.x * s[4 * j + 0];
                s[4 * j + 1] = s[4 * j + 1] * dv.y + kv.y * v; acc += qv.y * s[4 * j + 1];
                s[4 * j + 2] = s[4 * j + 2] * dv.z + kv.z * v; acc += qv.z * s[4 * j + 2];
                s[4 * j + 3] = s[4 * j + 3] * dv.w + kv.w * v; acc += qv.w * s[4 * j + 3]; }
            acc += shx(acc, 1, tid & 63); acc += shx(acc, 2, tid & 63);
            if (dq == 0) Oo[((size_t)b * TB + w) * 1024 + h * 256 + half * 128 + c] = acc; }
    }
}
__device__ __forceinline__ void phase_gla_readout(unsigned char* ws, int lg, int gw, int NGW, int lane) {
    const float* OF = (const float*)(ws + WS_OF); const float* OB = (const float*)(ws + WS_OB); const bf16* G = (const bf16*)(ws + WS_G); bf16* OG = (bf16*)(ws + WS_Q);
    const f32x4 og = ((const GAS f32x4*)(PARF(ws) + P_OG + lg * 256))[lane];
    for (int m = gw; m < MT; m += NGW) {
#pragma unroll
        for (int hh = 0; hh < 4; ++hh) { const size_t off = (size_t)m * 1024 + hh * 256 + 4 * lane;
            f32x4 o = *(const GAS f32x4*)(OF + off) + *(const GAS f32x4*)(OB + off);
            const float ss = wave_sum((o.x * o.x + o.y * o.y) + (o.z * o.z + o.w * o.w));
            const float rs = 1.0f / sqrtf(ss * (1.0f / 256.0f) + RMS_EPS);
            const unsigned long long rv = *(const GAS unsigned long long*)(G + (size_t)m * WINP + 2048 + hh * 256 + 4 * lane);
            const float r0 = __uint_as_float((unsigned)(rv & 0xffffu) << 16), r1 = __uint_as_float((unsigned)(rv >> 16) << 16), r2 = __uint_as_float((unsigned)((rv >> 32) & 0xffffu) << 16), r3 = __uint_as_float((unsigned)(rv >> 48) << 16);
            o = o * rs * og;
            o.x *= silu_f(r0); o.y *= silu_f(r1); o.z *= silu_f(r2); o.w *= silu_f(r3);
            *(GAS unsigned long long*)(OG + off) = (unsigned long long)pk2(o.x, o.y) | ((unsigned long long)pk2(o.z, o.w) << 32); }
    }
}
constexpr size_t WS_GQ = WS_XG, WS_GKH = WS_XG + 68 * MiB, WS_GKT = WS_XG + 136 * MiB, WS_GVT = WS_XG + 204 * MiB, WS_GDL = WS_ACT, WS_SX = WS_OF;
static_assert((size_t)2176 * 2 * 16384 <= 68 * MiB && (size_t)2176 * 256 * 64 * 2 <= 68 * MiB && (size_t)64 * 68 * 65536 <= 272 * MiB, "gla buffers");
typedef float f32x16 __attribute__((ext_vector_type(16)));
__device__ __forceinline__ float log_sigmoid_fast(float z) { return fminf(z, 0.f) - __logf(1.0f + __expf(-fabsf(z))); }

__device__ __forceinline__ void phase_gla_g0(unsigned char* ws, int lg, LAS unsigned char* lds, int tid) {
    const bf16* G = (const bf16*)(ws + WS_G);
    LAS float* tot = (LAS float*)(lds + RING_OFF);
    const int d2 = tid & 63, tb = tid >> 6;
    for (int cn = blockIdx.x; cn < 2176; cn += gridDim.x) {
        const int n = cn % 68, bh = cn / 68, h = bh & 3, b = bh >> 2;
        const size_t row0 = (size_t)b * TB + 64 * n + 8 * tb;
        float wf0[16], wf1[16], wb0[16], wb1[16];
        { const float* wgf = PARF(ws) + P_GKF + (size_t)lg * 16 * 512 + h * 128 + 2 * d2; const float* wgb = PARF(ws) + P_GKB + (size_t)lg * 16 * 512 + h * 128 + 2 * d2;
#pragma unroll
          for (int r = 0; r < 16; ++r) { const f32x2 a = *(const GAS f32x2*)(wgf + r * 512), c = *(const GAS f32x2*)(wgb + r * 512); wf0[r] = a.x; wf1[r] = a.y; wb0[r] = c.x; wb1[r] = c.y; } }
        const f32x2 bf_ = *(const GAS f32x2*)(PARF(ws) + P_BGF + lg * 512 + h * 128 + 2 * d2), bb_ = *(const GAS f32x2*)(PARF(ws) + P_BGB + lg * 512 + h * 128 + 2 * d2);
        float gf0[8], gf1[8], gb0[8], gb1[8]; unsigned qk[8][2];
#pragma unroll
        for (int j = 0; j < 8; ++j) { const bf16* gr = G + (row0 + j) * WINP;
            const v4u l0 = *(const GAS v4u*)(gr + 3072), l1 = *(const GAS v4u*)(gr + 3080), l2 = *(const GAS v4u*)(gr + 3088), l3 = *(const GAS v4u*)(gr + 3096);
            qk[j][0] = *(const GAS unsigned*)(gr + h * 128 + 2 * d2); qk[j][1] = *(const GAS unsigned*)(gr + 512 + h * 128 + 2 * d2);
            float lf[16], lb[16];
            lf[0] = __uint_as_float(l0.x << 16); lf[1] = __uint_as_float(l0.x & 0xffff0000u); lf[2] = __uint_as_float(l0.y << 16); lf[3] = __uint_as_float(l0.y & 0xffff0000u);
            lf[4] = __uint_as_float(l0.z << 16); lf[5] = __uint_as_float(l0.z & 0xffff0000u); lf[6] = __uint_as_float(l0.w << 16); lf[7] = __uint_as_float(l0.w & 0xffff0000u);
            lf[8] = __uint_as_float(l1.x << 16); lf[9] = __uint_as_float(l1.x & 0xffff0000u); lf[10] = __uint_as_float(l1.y << 16); lf[11] = __uint_as_float(l1.y & 0xffff0000u);
            lf[12] = __uint_as_float(l1.z << 16); lf[13] = __uint_as_float(l1.z & 0xffff0000u); lf[14] = __uint_as_float(l1.w << 16); lf[15] = __uint_as_float(l1.w & 0xffff0000u);
            lb[0] = __uint_as_float(l2.x << 16); lb[1] = __uint_as_float(l2.x & 0xffff0000u); lb[2] = __uint_as_float(l2.y << 16); lb[3] = __uint_as_float(l2.y & 0xffff0000u);
            lb[4] = __uint_as_float(l2.z << 16); lb[5] = __uint_as_float(l2.z & 0xffff0000u); lb[6] = __uint_as_float(l2.w << 16); lb[7] = __uint_as_float(l2.w & 0xffff0000u);
            lb[8] = __uint_as_float(l3.x << 16); lb[9] = __uint_as_float(l3.x & 0xffff0000u); lb[10] = __uint_as_float(l3.y << 16); lb[11] = __uint_as_float(l3.y & 0xffff0000u);
            lb[12] = __uint_as_float(l3.z << 16); lb[13] = __uint_as_float(l3.z & 0xffff0000u); lb[14] = __uint_as_float(l3.w << 16); lb[15] = __uint_as_float(l3.w & 0xffff0000u);
            float zf0 = bf_.x, zf1 = bf_.y, zb0 = bb_.x, zb1 = bb_.y;
#pragma unroll
            for (int r = 0; r < 16; ++r) { zf0 += lf[r] * wf0[r]; zf1 += lf[r] * wf1[r]; zb0 += lb[r] * wb0[r]; zb1 += lb[r] * wb1[r]; }
            gf0[j] = log_sigmoid_fast(zf0) * 0.0625f; gf1[j] = log_sigmoid_fast(zf1) * 0.0625f; gb0[j] = log_sigmoid_fast(zb0) * 0.0625f; gb1[j] = log_sigmoid_fast(zb1) * 0.0625f; }
#pragma unroll
        for (int j = 1; j < 8; ++j) { gf0[j] += gf0[j - 1]; gf1[j] += gf1[j - 1]; gb0[7 - j] += gb0[8 - j]; gb1[7 - j] += gb1[8 - j]; }
        __syncthreads();
        *(LAS f32x2*)(tot + (0 * 8 + tb) * 128 + 2 * d2) = (f32x2){gf0[7], gf1[7]}; *(LAS f32x2*)(tot + (1 * 8 + tb) * 128 + 2 * d2) = (f32x2){gb0[0], gb1[0]};
        __syncthreads();
        float pf0 = 0.f, pf1 = 0.f, pb0 = 0.f, pb1 = 0.f, lf0 = 0.f, lf1 = 0.f, lb0 = 0.f, lb1 = 0.f;
#pragma unroll
        for (int q = 0; q < 8; ++q) { const f32x2 a = *(const LAS f32x2*)(tot + (0 * 8 + q) * 128 + 2 * d2), c = *(const LAS f32x2*)(tot + (1 * 8 + q) * 128 + 2 * d2);
            lf0 += a.x; lf1 += a.y; lb0 += c.x; lb1 += c.y;
            if (q < tb) { pf0 += a.x; pf1 += a.y; } if (q > tb) { pb0 += c.x; pb1 += c.y; } }
        const size_t itf = (size_t)cn * 2, itb = itf + 1;
        bf16* Qf = (bf16*)(ws + WS_GQ) + itf * 8192; bf16* Qb = Qf + 8192; bf16* Kf = (bf16*)(ws + WS_GKH) + itf * 8192; bf16* Kb = Kf + 8192;
        const float elf0 = __expf(lf0), elf1 = __expf(lf1), elb0 = __expf(lb0), elb1 = __expf(lb1);
        float ktf0[8], ktf1[8], ktb0[8], ktb1[8];
#pragma unroll
        for (int j = 0; j < 8; ++j) { const int t = 8 * tb + j;
            const float q0 = __uint_as_float(qk[j][0] << 16) * 0.08838834764831845f, q1 = __uint_as_float(qk[j][0] & 0xffff0000u) * 0.08838834764831845f;
            const float k0 = __uint_as_float(qk[j][1] << 16), k1 = __uint_as_float(qk[j][1] & 0xffff0000u);
            const float ef0 = __expf(pf0 + gf0[j]), ef1 = __expf(pf1 + gf1[j]), eb0 = __expf(pb0 + gb0[j]), eb1 = __expf(pb1 + gb1[j]);
            const float rf0 = __builtin_amdgcn_rcpf(ef0), rf1 = __builtin_amdgcn_rcpf(ef1), rb0 = __builtin_amdgcn_rcpf(eb0), rb1 = __builtin_amdgcn_rcpf(eb1);
            *(GAS unsigned*)(Qf + t * 128 + 2 * d2) = pk2(q0 * ef0, q1 * ef1); *(GAS unsigned*)(Qb + t * 128 + 2 * d2) = pk2(q0 * eb0, q1 * eb1);
            *(GAS unsigned*)(Kf + t * 128 + 2 * d2) = pk2(k0 * rf0, k1 * rf1); *(GAS unsigned*)(Kb + t * 128 + 2 * d2) = pk2(k0 * rb0, k1 * rb1);
            ktf0[j] = k0 * rf0 * elf0; ktf1[j] = k1 * rf1 * elf1; ktb0[j] = k0 * rb0 * elb0; ktb1[j] = k1 * rb1 * elb1; }
        { bf16* Tf = (bf16*)(ws + WS_GKT) + itf * 8192 + (size_t)(2 * d2) * 64 + 8 * tb; bf16* Tb = Tf + 8192;
          *(GAS v4u*)Tf = (v4u){pk2(ktf0[0], ktf0[1]), pk2(ktf0[2], ktf0[3]), pk2(ktf0[4], ktf0[5]), pk2(ktf0[6], ktf0[7])};
          *(GAS v4u*)(Tf + 64) = (v4u){pk2(ktf1[0], ktf1[1]), pk2(ktf1[2], ktf1[3]), pk2(ktf1[4], ktf1[5]), pk2(ktf1[6], ktf1[7])};
          *(GAS v4u*)Tb = (v4u){pk2(ktb0[0], ktb0[1]), pk2(ktb0[2], ktb0[3]), pk2(ktb0[4], ktb0[5]), pk2(ktb0[6], ktb0[7])};
          *(GAS v4u*)(Tb + 64) = (v4u){pk2(ktb1[0], ktb1[1]), pk2(ktb1[2], ktb1[3]), pk2(ktb1[4], ktb1[5]), pk2(ktb1[6], ktb1[7])}; }
        if (tb == 0) { float* DLp = (float*)(ws + WS_GDL) + itf * 128 + 2 * d2; *(GAS f32x2*)DLp = (f32x2){elf0, elf1}; *(GAS f32x2*)(DLp + 128) = (f32x2){elb0, elb1}; }
        {
            const int dv = tid & 255, th = tid >> 8; const bf16* vp = G + ((size_t)b * TB + 64 * n + 32 * th) * WINP + 1024 + h * 256 + dv;
            unsigned wv[16];
#pragma unroll
            for (int j = 0; j < 16; ++j) wv[j] = (unsigned)vp[(size_t)(2 * j) * WINP] | ((unsigned)vp[(size_t)(2 * j + 1) * WINP] << 16);
            GAS v4u* op = (GAS v4u*)((bf16*)(ws + WS_GVT) + ((size_t)cn * 256 + dv) * 64 + 32 * th);
            op[0] = (v4u){wv[0], wv[1], wv[2], wv[3]}; op[1] = (v4u){wv[4], wv[5], wv[6], wv[7]}; op[2] = (v4u){wv[8], wv[9], wv[10], wv[11]}; op[3] = (v4u){wv[12], wv[13], wv[14], wv[15]}; }
    }
}
struct G12Ops { bf16x8 a[4], b[4]; f32x4 d[4]; };
__device__ __forceinline__ void g12_load(G12Ops& o, unsigned char* ws, int bh, int dir, int m, int kb, int vb, int r, int hh) {
    const int n = dir ? (m < 4 ? 3 - m : 71 - m) : m; const size_t cn = (size_t)bh * 68 + n, item = cn * 2 + dir;
    const bf16* ap = (const bf16*)(ws + WS_GKT) + item * 8192 + (size_t)(32 * kb + r) * 64 + 8 * hh;
    const bf16* bp = (const bf16*)(ws + WS_GVT) + (cn * 256 + 32 * vb + r) * 64 + 8 * hh;
    const float* dp = (const float*)(ws + WS_GDL) + item * 128 + 32 * kb + 4 * hh;
#pragma unroll
    for (int ks = 0; ks < 4; ++ks) { o.a[ks] = *(const GAS bf16x8*)(ap + 16 * ks); o.b[ks] = *(const GAS bf16x8*)(bp + 16 * ks); o.d[ks] = *(const GAS f32x4*)(dp + 8 * ks); }
}
__device__ __forceinline__ void phase_gla_g12(unsigned char* ws, LAS unsigned char* lds, int gwv, int wave, int lane) {
    if (gwv >= 2048) return;
    const int chain = gwv >> 5, blk = gwv & 31, kb = blk & 3, vb = blk >> 2, dir = chain & 1, bh = chain >> 1;
    const int r = lane & 31, hh = lane >> 5;
    LAS unsigned char* wl = lds + RING_OFF + wave * 2048;
    f32x16 acc;
#pragma unroll
    for (int g = 0; g < 16; ++g) acc[g] = 0.f;
    G12Ops cur, nxt;
    g12_load(cur, ws, bh, dir, 0, kb, vb, r, hh);
    for (int m = 0; m < 68; ++m) {
        const int n = dir ? (m < 4 ? 3 - m : 71 - m) : m;
        if (m + 1 < 68) g12_load(nxt, ws, bh, dir, m + 1, kb, vb, r, hh); else nxt = cur;
#pragma unroll
        for (int gg = 0; gg < 4; ++gg) *(LAS unsigned long long*)(wl + r * 64 + 16 * gg + 8 * hh) = (unsigned long long)pk2(acc[4 * gg], acc[4 * gg + 1]) | ((unsigned long long)pk2(acc[4 * gg + 2], acc[4 * gg + 3]) << 32);
        LDS_WAIT();
        const v4u s0 = *(const LAS v4u*)(wl + lane * 16), s1 = *(const LAS v4u*)(wl + 1024 + lane * 16);
        LDS_WAIT();
        { bf16* sp = (bf16*)(ws + WS_SX) + ((size_t)(bh * 2 + dir) * 68 + n) * 32768 + (size_t)(kb * 8 + vb) * 1024; ((GAS v4u*)sp)[lane] = s0; ((GAS v4u*)sp)[64 + lane] = s1; }
#pragma unroll
        for (int gg = 0; gg < 4; ++gg) { acc[4 * gg] *= cur.d[gg].x; acc[4 * gg + 1] *= cur.d[gg].y; acc[4 * gg + 2] *= cur.d[gg].z; acc[4 * gg + 3] *= cur.d[gg].w; }
#pragma unroll
        for (int ks = 0; ks < 4; ++ks) acc = __builtin_amdgcn_mfma_f32_32x32x16_bf16(cur.a[ks], cur.b[ks], acc, 0, 0, 0);
        cur = nxt;
    }
}
constexpr int G3_RS = 272, G3_TILE = 64 * G3_RS, G3_OL = 4 * G3_TILE  , G3_LD = 260;
static_assert(G3_OL + 64 * G3_LD * 4 <= MISC_OFF, "G3 LDS");
__device__ __forceinline__ void phase_gla_g3(unsigned char* ws, int lg, LAS unsigned char* lds, int tid) {
    const int lane = tid & 63, wave = __builtin_amdgcn_readfirstlane(tid >> 6), r = lane & 31, hh = lane >> 5, vb = wave;
    LAS unsigned char* TL = lds + RING_OFF; LAS float* OL = (LAS float*)(lds + RING_OFF + G3_OL);
    const bf16* G = (const bf16*)(ws + WS_G); bf16* OG = (bf16*)(ws + WS_Q);
    for (int cn = blockIdx.x; cn < 2176; cn += gridDim.x) {
        const int n = cn % 68, bh = cn / 68, h = bh & 3, b = bh >> 2;
        v4u st[4][2];
#pragma unroll
        for (int tl = 0; tl < 4; ++tl) { const bf16* src = (const bf16*)(ws + ((tl & 1) ? WS_GKH : WS_GQ)) + ((size_t)cn * 2 + (tl >> 1)) * 8192;
#pragma unroll
            for (int j = 0; j < 2; ++j) st[tl][j] = ((const GAS v4u*)src)[tid + 512 * j]; }
        __syncthreads();
#pragma unroll
        for (int tl = 0; tl < 4; ++tl)
#pragma unroll
            for (int j = 0; j < 2; ++j) { const int q = tid + 512 * j, row = q >> 4, ch = q & 15; *(LAS v4u*)(TL + tl * G3_TILE + row * G3_RS + ch * 16) = st[tl][j]; }
        __syncthreads();
        f32x16 P00, P01, P10, P11, O0, O1;
#pragma unroll
        for (int g = 0; g < 16; ++g) { P00[g] = 0.f; P01[g] = 0.f; P10[g] = 0.f; P11[g] = 0.f; O0[g] = 0.f; O1[g] = 0.f; }
#pragma unroll
        for (int dir = 0; dir < 2; ++dir) {
            const LAS unsigned char* Qt = TL + (2 * dir) * G3_TILE + r * G3_RS + 16 * hh; const LAS unsigned char* Kh = TL + (2 * dir + 1) * G3_TILE + r * G3_RS + 16 * hh;
            const bf16* Sx = (const bf16*)(ws + WS_SX) + ((size_t)(bh * 2 + dir) * 68 + n) * 32768 + (size_t)vb * 1024 + r * 32 + 8 * hh;
            f32x16 X00, X11, Xoff;
#pragma unroll
            for (int g = 0; g < 16; ++g) { X00[g] = 0.f; X11[g] = 0.f; Xoff[g] = 0.f; }
#pragma unroll
            for (int s = 0; s < 8; ++s) {
                const bf16x8 q0 = *(const LAS bf16x8*)(Qt + 32 * s), q1 = *(const LAS bf16x8*)(Qt + 32 * G3_RS + 32 * s);
                const bf16x8 k0 = *(const LAS bf16x8*)(Kh + 32 * s), k1 = *(const LAS bf16x8*)(Kh + 32 * G3_RS + 32 * s);
                const bf16x8 sx = *(const GAS bf16x8*)(Sx + (s >> 1) * 8192 + 16 * (s & 1));
                X00 = __builtin_amdgcn_mfma_f32_32x32x16_bf16(k0, q0, X00, 0, 0, 0);
                X11 = __builtin_amdgcn_mfma_f32_32x32x16_bf16(k1, q1, X11, 0, 0, 0);
                if (dir == 0) Xoff = __builtin_amdgcn_mfma_f32_32x32x16_bf16(k0, q1, Xoff, 0, 0, 0); else Xoff = __builtin_amdgcn_mfma_f32_32x32x16_bf16(k1, q0, Xoff, 0, 0, 0);
                O0 = __builtin_amdgcn_mfma_f32_32x32x16_bf16(q0, sx, O0, 0, 0, 0); O1 = __builtin_amdgcn_mfma_f32_32x32x16_bf16(q1, sx, O1, 0, 0, 0); }
#pragma unroll
            for (int g = 0; g < 16; ++g) { const int tj = (g & 3) + 8 * (g >> 2) + 4 * hh; const bool keep = dir ? (tj >= r) : (tj <= r);
                P00[g] += keep ? X00[g] : 0.f; P11[g] += keep ? X11[g] : 0.f;
                if (dir == 0) P01[g] += Xoff[g]; else P10[g] += Xoff[g]; }
        }
        { const bf16* Vt = (const bf16*)(ws + WS_GVT) + ((size_t)cn * 256 + 32 * vb + r) * 64 + 4 * hh;
#pragma unroll
          for (int jb = 0; jb < 2; ++jb)
#pragma unroll
            for (int s2 = 0; s2 < 2; ++s2) { const bf16* vp = Vt + 32 * jb + 16 * s2;
                const unsigned long long lo = *(const GAS unsigned long long*)vp, hi8 = *(const GAS unsigned long long*)(vp + 8);
                const bf16x8 bfv = __builtin_bit_cast(bf16x8, ((v4u){(unsigned)lo, (unsigned)(lo >> 32), (unsigned)hi8, (unsigned)(hi8 >> 32)}));
                const f32x16& Pa = jb ? P10 : P00; const f32x16& Pb = jb ? P11 : P01;
                const bf16x8 a0 = __builtin_bit_cast(bf16x8, ((v4u){pk2(Pa[8 * s2 + 0], Pa[8 * s2 + 1]), pk2(Pa[8 * s2 + 2], Pa[8 * s2 + 3]), pk2(Pa[8 * s2 + 4], Pa[8 * s2 + 5]), pk2(Pa[8 * s2 + 6], Pa[8 * s2 + 7])}));
                const bf16x8 a1 = __builtin_bit_cast(bf16x8, ((v4u){pk2(Pb[8 * s2 + 0], Pb[8 * s2 + 1]), pk2(Pb[8 * s2 + 2], Pb[8 * s2 + 3]), pk2(Pb[8 * s2 + 4], Pb[8 * s2 + 5]), pk2(Pb[8 * s2 + 6], Pb[8 * s2 + 7])}));
                O0 = __builtin_amdgcn_mfma_f32_32x32x16_bf16(a0, bfv, O0, 0, 0, 0); O1 = __builtin_amdgcn_mfma_f32_32x32x16_bf16(a1, bfv, O1, 0, 0, 0); } }
#pragma unroll
        for (int g = 0; g < 16; ++g) { const int t = (g & 3) + 8 * (g >> 2) + 4 * hh; OL[t * G3_LD + 32 * vb + r] = O0[g]; OL[(32 + t) * G3_LD + 32 * vb + r] = O1[g]; }
        __syncthreads();
        { const int t = tid >> 3, cc = tid & 7; const LAS f32x4* op = (const LAS f32x4*)(OL + t * G3_LD + 32 * cc);
          f32x4 o[8]; float ss = 0.f;
#pragma unroll
          for (int j = 0; j < 8; ++j) { o[j] = op[j]; ss += (o[j].x * o[j].x + o[j].y * o[j].y) + (o[j].z * o[j].z + o[j].w * o[j].w); }
          ss += shx(ss, 1, lane); ss += shx(ss, 2, lane); ss += shx(ss, 4, lane);
          const float rs = 1.0f / sqrtf(ss * (1.0f / 256.0f) + RMS_EPS);
          const size_t row = (size_t)b * TB + 64 * n + t;
          const GAS v4u* rp = (const GAS v4u*)(G + row * WINP + 2048 + h * 256 + 32 * cc); const GAS f32x4* gp = (const GAS f32x4*)(PARF(ws) + P_OG + lg * 256 + 32 * cc);
          GAS v4u* dst = (GAS v4u*)(OG + row * 1024 + h * 256 + 32 * cc);
#pragma unroll
          for (int j = 0; j < 4; ++j) { const v4u rv = rp[j]; const f32x4 g0 = gp[2 * j], g1 = gp[2 * j + 1]; const f32x4 a = o[2 * j] * rs * g0, c2 = o[2 * j + 1] * rs * g1;
              v4u w;
              w.x = pk2(a.x * silu_f(__uint_as_float(rv.x << 16)), a.y * silu_f(__uint_as_float(rv.x & 0xffff0000u)));
              w.y = pk2(a.z * silu_f(__uint_as_float(rv.y << 16)), a.w * silu_f(__uint_as_float(rv.y & 0xffff0000u)));
              w.z = pk2(c2.x * silu_f(__uint_as_float(rv.z << 16)), c2.y * silu_f(__uint_as_float(rv.z & 0xffff0000u)));
              w.w = pk2(c2.z * silu_f(__uint_as_float(rv.w << 16)), c2.w * silu_f(__uint_as_float(rv.w & 0xffff0000u)));
              dst[j] = w; } }
    }
}
constexpr int WIMG_RS = 2064;
static_assert(2 * 32 * WIMG_RS <= LDS_AUX, "router images below the aux tables");
__device__ __forceinline__ void phase_modulate2_route(unsigned char* ws, int layer, LAS unsigned char* lds, int vcu, int wave, int lane, int tid, bool dummy = false) {
    const bf16* X = (const bf16*)(ws + WS_X); bf16* XN = (bf16*)(ws + WS_XN);
    const float* ng = PARF(ws) + P_N2G + layer * 1024; const float* Mo = (const float*)(ws + WS_MOD) + (size_t)layer * MODROWS * NMODC;
    LAS unsigned char* WHI = lds + RING_OFF; LAS unsigned char* WLO = WHI + 32 * WIMG_RS;
    LAS unsigned* lcnt = (LAS unsigned*)(lds + AUX_LCNT); LAS unsigned* gb = (LAS unsigned*)(lds + AUX_GB); LAS unsigned* ent = (LAS unsigned*)(lds + AUX_ENT); LAS float* rsl = (LAS float*)(lds + AUX_RS);
    { const float* wsrc = PARF(ws) + P_WR + (size_t)layer * 1024 * 32;
      for (int idx = tid; idx < 1024 * 32; idx += NWAVES * 64) { const int k = idx >> 5, e = idx & 31; const float w = wsrc[idx]; const unsigned hi = f2bf(w), lo = f2bf(w - __uint_as_float(hi << 16));
          *(LAS unsigned short*)(WHI + e * WIMG_RS + 2 * k) = (unsigned short)hi; *(LAS unsigned short*)(WLO + e * WIMG_RS + 2 * k) = (unsigned short)lo; }
      if (tid < 32) lcnt[tid] = 0u; }
    gu32* cnt = (gu32*)(ws + WS_CTL) + CW_CNT + (layer + (dummy ? 4 : 0)) * 32 * 16;
    unsigned char* sbase = dummy ? ws + WS_XG : ws;
    const bool lastl = (layer == NLAYER - 1);
  for (int grp = vcu; grp < MT / 136; grp += (int)gridDim.x) {
    const int rbase = grp * 136;
    if (grp != vcu) { __syncthreads(); if (tid < 32) lcnt[tid] = 0u; }
    for (int rl = wave; rl < 136; rl += NWAVES) { const int m = rbase + rl, mr = mod_row(m);
        if (lastl && mr == 8) { if (lane == 0) rsl[rl] = 0.f; continue; }
        f32x4 y[4]; float rs;
        modulate_row(X + (size_t)m * 1024, ng, Mo + (size_t)mr * NMODC + 3 * 1024, Mo + (size_t)mr * NMODC + 4 * 1024, XN + (size_t)m * 1024, lane, y, rs);
        if (lane == 0) rsl[rl] = rs; }
    __syncthreads();
    if (wave < 5) {
        const int r = lane & 31, hh = lane >> 5; const int rl = (32 * wave + r < 136) ? 32 * wave + r : 135; const int m = rbase + rl, mr = mod_row(m);
        const float rsr = rsl[rl];
        const bf16* xp = X + (size_t)m * 1024 + 8 * hh; const float* gp = ng + 8 * hh; const float* scp = Mo + (size_t)mr * NMODC + 4 * 1024 + 8 * hh; const float* shp = Mo + (size_t)mr * NMODC + 3 * 1024 + 8 * hh;
        const LAS unsigned char* wh = WHI + r * WIMG_RS + 16 * hh; const LAS unsigned char* wl = WLO + r * WIMG_RS + 16 * hh;
        f32x16 acc;
#pragma unroll
        for (int g = 0; g < 16; ++g) acc[g] = 0.f;
#pragma unroll 2
        for (int s = 0; s < 64; ++s) {
            const v4u xr8 = *(const GAS v4u*)(xp + 16 * s); const f32x4 x0 = (f32x4){__uint_as_float(xr8.x << 16), __uint_as_float(xr8.x & 0xffff0000u), __uint_as_float(xr8.y << 16), __uint_as_float(xr8.y & 0xffff0000u)}, x1 = (f32x4){__uint_as_float(xr8.z << 16), __uint_as_float(xr8.z & 0xffff0000u), __uint_as_float(xr8.w << 16), __uint_as_float(xr8.w & 0xffff0000u)}; const f32x4 g0 = *(const GAS f32x4*)(gp + 16 * s), g1 = *(const GAS f32x4*)(gp + 16 * s + 4);
            const f32x4 c0 = *(const GAS f32x4*)(scp + 16 * s), c1 = *(const GAS f32x4*)(scp + 16 * s + 4), h0 = *(const GAS f32x4*)(shp + 16 * s), h1 = *(const GAS f32x4*)(shp + 16 * s + 4);
            const f32x4 y0 = (x0 * rsr) * g0 * (c0 + 1.0f) + h0, y1 = (x1 * rsr) * g1 * (c1 + 1.0f) + h1;
            v4u ph, pl;
            ph.x = pg8::cvt_pk_bf16(y0.x, y0.y); ph.y = pg8::cvt_pk_bf16(y0.z, y0.w); ph.z = pg8::cvt_pk_bf16(y1.x, y1.y); ph.w = pg8::cvt_pk_bf16(y1.z, y1.w);
            pl.x = pg8::cvt_pk_bf16(y0.x - __uint_as_float(ph.x << 16), y0.y - __uint_as_float(ph.x & 0xffff0000u)); pl.y = pg8::cvt_pk_bf16(y0.z - __uint_as_float(ph.y << 16), y0.w - __uint_as_float(ph.y & 0xffff0000u));
            pl.z = pg8::cvt_pk_bf16(y1.x - __uint_as_float(ph.z << 16), y1.y - __uint_as_float(ph.z & 0xffff0000u)); pl.w = pg8::cvt_pk_bf16(y1.z - __uint_as_float(ph.w << 16), y1.w - __uint_as_float(ph.w & 0xffff0000u));
            const bf16x8 ahi = __builtin_bit_cast(bf16x8, ph), alo = __builtin_bit_cast(bf16x8, pl);
            const bf16x8 bhi = *(const LAS bf16x8*)(wh + 32 * s), blo = *(const LAS bf16x8*)(wl + 32 * s);
            acc = __builtin_amdgcn_mfma_f32_32x32x16_bf16(ahi, bhi, acc, 0, 0, 0); acc = __builtin_amdgcn_mfma_f32_32x32x16_bf16(alo, bhi, acc, 0, 0, 0); acc = __builtin_amdgcn_mfma_f32_32x32x16_bf16(ahi, blo, acc, 0, 0, 0); }
        const float brt = (PARF(ws) + P_BR)[layer * 32 + r];
#pragma unroll
        for (int g = 0; g < 16; ++g) { const int rowl = 32 * wave + (g & 3) + 8 * (g >> 2) + 4 * hh;
            float v = acc[g] + brt; float tv[4]; int te[4];
#pragma unroll
            for (int k = 0; k < 4; ++k) { float mx = v;
#pragma unroll
                for (int o = 1; o < 32; o <<= 1) mx = fmaxf(mx, shx(mx, o, lane));
                const unsigned long long bm = __ballot(v == mx); const unsigned hm = hh ? (unsigned)(bm >> 32) : (unsigned)bm; const int first = __ffs((int)hm) - 1;
                te[k] = first; tv[k] = mx; if (r == first) v = -INFINITY; }
            const bool valid = rowl < 136 && !(lastl && mod_row(rbase + (rowl < 136 ? rowl : 135)) == 8);
            if (r == 0 && rowl < 136) {
                if (valid) { const float e1 = __expf(tv[1] - tv[0]), e2 = __expf(tv[2] - tv[0]), e3 = __expf(tv[3] - tv[0]); const float inv = 1.0f / (1.0f + e1 + e2 + e3);
                    const float wk[4] = {inv, e1 * inv, e2 * inv, e3 * inv};
#pragma unroll
                    for (int k = 0; k < 4; ++k) { const unsigned lp = atomicAdd((unsigned*)&lcnt[te[k]], 1u); ent[(rowl * 4 + k) * 2 + 0] = ((unsigned)te[k] << 24) | lp; ent[(rowl * 4 + k) * 2 + 1] = __float_as_uint(wk[k]); } }
                else {
#pragma unroll
                    for (int k = 0; k < 4; ++k) ent[(rowl * 4 + k) * 2 + 0] = 0xffffffffu; } } }
    }
    __syncthreads();
    if (tid < 32) gb[tid] = __hip_atomic_fetch_add(cnt + tid * 16, lcnt[tid], __ATOMIC_RELAXED, __HIP_MEMORY_SCOPE_AGENT);
    __syncthreads();
    for (int q = tid; q < 136 * 4; q += NWAVES * 64) { const unsigned pe = ent[q * 2 + 0];
        if (pe != 0xffffffffu) { const unsigned e = pe >> 24, lp = pe & 0xffffffu; const int m = rbase + (q >> 2);
            ((unsigned*)(sbase + WS_SLOT))[m * 4 + (q & 3)] = (e << 24) | (gb[e] + lp); ((unsigned*)(sbase + WS_GATEW))[m * 4 + (q & 3)] = ent[q * 2 + 1];
            if (!dummy) ((int*)(ws + WS_LIST))[(size_t)e * MT + gb[e] + lp] = m; } }
  }
}
__device__ __forceinline__ void build_expert_tables(unsigned char* ws, int layer, LAS unsigned char* lds, int tid) {
    LAS int* t2e = (LAS int*)(lds + AUX_T2E); LAS int* base = (LAS int*)(lds + AUX_BASE); LAS int* ntp = (LAS int*)(lds + AUX_NT); LAS int* cntl = (LAS int*)(lds + AUX_CNT);
    gu32* cnt = (gu32*)(ws + WS_CTL) + CW_CNT + layer * 32 * 16;
    __syncthreads();
    if (tid < 64) { const unsigned cval = (tid < 32) ? __hip_atomic_load(cnt + tid * 16, RLX_AGENT) : 0u; const int tiles = (int)((cval + 255u) >> 8);
        int pre = tiles;
#pragma unroll
        for (int o = 1; o < 32; o <<= 1) { const int ln = tid & 63; const int t = __builtin_amdgcn_ds_bpermute(((ln >= o) ? ln - o : ln) << 2, pre); if (ln >= o) pre += t; }
        const int start = pre - tiles;
        if (tid < 32) { base[tid] = start * 256; cntl[tid] = (int)cval; for (int t = 0; t < tiles; ++t) t2e[start + t] = tid; if (tid == 31) ntp[0] = pre; } }
    __syncthreads();
}
__device__ __forceinline__ void phase_moe_gather(unsigned char* ws, int layer, LAS unsigned char* lds, int gw, int NGW, int lane, int tid) {
    build_expert_tables(ws, layer, lds, tid);
    const LAS int* base = (const LAS int*)(lds + AUX_BASE);
    const bf16* XN = (const bf16*)(ws + WS_XN); bf16* XG = (bf16*)(ws + WS_XG);
    const unsigned* slot = (const unsigned*)(ws + WS_SLOT); unsigned* spos = (unsigned*)(ws + WS_SLOTPOS);
    for (int m = gw; m < MT; m += NGW) {
        if (layer == NLAYER - 1 && mod_row(m) == 8) continue;
        const GAS v4u* src = (const GAS v4u*)(XN + (size_t)m * 1024) + lane; const v4u a = src[0], b = src[64];
#pragma unroll
        for (int k = 0; k < 4; ++k) { const unsigned pe = slot[m * 4 + k]; const int dst = base[pe >> 24] + (int)(pe & 0xffffffu);
            GAS v4u* dp = (GAS v4u*)(XG + (size_t)dst * 1024) + lane; dp[0] = a; dp[64] = b;
            if (lane == 0) spos[m * 4 + k] = (unsigned)dst; }
    }
}
__device__ __forceinline__ void phase_moe_combine(unsigned char* ws, float* out, int layer, LAS unsigned char* lds, int gw, int NGW, int lane, int tid, bool dummy = false) {
    build_expert_tables(ws, layer, lds, tid);
    const LAS int* base = (const LAS int*)(lds + AUX_BASE);
    bf16* X = (bf16*)(ws + WS_X); const bf16* Y = (const bf16*)(ws + WS_Y);
    const float* Mo = (const float*)(ws + WS_MOD) + (size_t)layer * MODROWS * NMODC;
    const unsigned* slot = (const unsigned*)(ws + WS_SLOT); const float* gw4 = (const float*)(ws + WS_GATEW);
    for (int m = gw; m < MT; m += NGW) { const int b = m / TB, w = m - b * TB; const int mr = (w < CTXL) ? 8 : b;
        if (layer == NLAYER - 1 && w < CTXL) continue;
        f32x4 f[4];
#pragma unroll
        for (int j = 0; j < 4; ++j) f[j] = (f32x4){0.f, 0.f, 0.f, 0.f};
#pragma unroll
        for (int k = 0; k < 4; ++k) { const unsigned pe = slot[m * 4 + k]; const unsigned sp = (unsigned)base[pe >> 24] + (pe & 0xffffffu); const float wk = gw4[m * 4 + k];
            const GAS unsigned long long* yp = (const GAS unsigned long long*)(Y + (size_t)sp * 1024) + lane;
#pragma unroll
            for (int j = 0; j < 4; ++j) { const unsigned long long v = yp[64 * j];
                f[j].x += wk * __uint_as_float((unsigned)(v & 0xffffu) << 16); f[j].y += wk * __uint_as_float((unsigned)(v >> 16) << 16);
                f[j].z += wk * __uint_as_float((unsigned)((v >> 32) & 0xffffu) << 16); f[j].w += wk * __uint_as_float((unsigned)(v >> 48) << 16); } }
        GAS unsigned long long* xp = (GAS unsigned long long*)(X + (size_t)m * 1024) + lane; const GAS f32x4* gp = (const GAS f32x4*)(Mo + (size_t)mr * NMODC + 5 * 1024) + lane;
        GAS f32x4* op = (GAS f32x4*)(out + ((size_t)b * SEQ + (w - CTXL)) * 1024) + lane;
        float ss = 0.f;
#pragma unroll
        for (int j = 0; j < 4; ++j) { f[j] = bf4_to_f32(xp[64 * j]) + gp[64 * j] * f[j]; if (dummy) ((GAS f32x4*)((float*)(ws + WS_XG) + (size_t)m * 1024) + lane)[64 * j] = f[j]; else if (layer == NLAYER - 1) op[64 * j] = f[j]; else { const unsigned long long pk = f32_to_bf4(f[j]); xp[64 * j] = pk; f[j] = bf4_to_f32(pk); } ss += (f[j].x * f[j].x + f[j].y * f[j].y) + (f[j].z * f[j].z + f[j].w * f[j].w); }
        if (layer < NLAYER - 1 && !dummy) {
            const float rs = 1.0f / sqrtf(wave_sum(ss) * (1.0f / 1024.0f) + RMS_EPS);
            const float* ng = PARF(ws) + P_N1G + (layer + 1) * 1024; const float* Mn = (const float*)(ws + WS_MOD) + (size_t)(layer + 1) * MODROWS * NMODC + (size_t)mr * NMODC;
            GAS unsigned long long* o8 = (GAS unsigned long long*)((bf16*)(ws + WS_XN) + (size_t)m * 1024) + lane;
#pragma unroll
            for (int j = 0; j < 4; ++j) { const f32x4 g = ((const GAS f32x4*)ng)[64 * j + lane], sh = ((const GAS f32x4*)Mn)[64 * j + lane], sc = ((const GAS f32x4*)(Mn + 1024))[64 * j + lane];
                const f32x4 y = (f[j] * rs) * g * (sc + 1.0f) + sh;
                o8[64 * j] = (unsigned long long)pk2(y.x, y.y) | ((unsigned long long)pk2(y.z, y.w) << 32); } }
    }
}

constexpr int NPH_L = 11, NPHASE = 2 + NPH_L * NLAYER;
#ifndef PHMASK
#define PHMASK 0x7fff
#endif
#define EN(b) ((PHMASK >> (b)) & 1)
#ifndef DUPMASK
#define DUPMASK 0
#endif
#define DUP(b) for (int rep_ = 0; rep_ < (((DUPMASK >> (b)) & 1) ? 2 : 1); ++rep_)
__global__ void __launch_bounds__(NWAVES * 64, 2) dit_fwd(Args args) {
    extern __shared__ __attribute__((aligned(16))) unsigned char lds_raw[];
    LAS unsigned char* lds = (LAS unsigned char*)lds_raw;
    volatile LAS unsigned* MISC = (volatile LAS unsigned*)(lds + MISC_OFF);
    const int G = gridDim.x, bx = blockIdx.x;
    const int vcu = (G % 8 == 0) ? (bx % 8) * (G / 8) + bx / 8 : bx;
    const int wave0 = __builtin_amdgcn_readfirstlane((int)threadIdx.x >> 6);
#define LANE_ID(z) ((int)__builtin_amdgcn_mbcnt_hi(~0u, __builtin_amdgcn_mbcnt_lo(~0u, (z))))
    { const int t0 = (wave0 << 6) | LANE_ID(0u); for (int u = t0; u < (LDS_BYTES - MISC_OFF) / 4; u += NWAVES * 64) ((LAS unsigned*)(lds + MISC_OFF))[u] = 0u; }
    __syncthreads();
    const int lo = args.ph_lo, hi = args.ph_hi;
    XcdBarrier bar; bar.bar = (unsigned*)(args.ws + WS_CTL) + CW_BAR; bar.x = 0; bar.st = nullptr;
    if (hi - lo > 1) bar = xcd_barrier_post((unsigned*)(args.ws + WS_CTL) + CW_BAR, MISC + 8, wave0 == 0 && LANE_ID(0u) == 0);
#define IN(k) (lo <= (k) && (k) < hi)
#define SEAM(k) do { if (IN(k) && IN((k) + 1)) { XcdBarrier b_ = bar; unsigned zb_ = 0u; LAUNDER_S(zb_); b_.bar = bar.bar + zb_; xcd_barrier(b_, wave0 == 0 && LANE_ID(zb_) == 0); } } while (0)
#define PHASE_IDS() unsigned zoff_ = 0u; LAUNDER_S(zoff_); int tid = (wave0 << 6) | LANE_ID(zoff_); LAUNDER_V(tid); const int lane = tid & 63, wave = __builtin_amdgcn_readfirstlane(tid >> 6); const int gw = vcu * NWAVES + wave, NGW = G * NWAVES; \
    unsigned char* ws = args.ws + zoff_; const int Gp = G + (int)zoff_, bxp = bx + (int)zoff_; (void)lane; (void)gw; (void)NGW; (void)Gp; (void)bxp;

    if (EN(0) && IN(0)) DUP(0) { PHASE_IDS(); p0_prologue(args, lds, gw, NGW, wave, lane); } SEAM(0);
    if (EN(1) && IN(1)) { PHASE_IDS(); p1_mod_reduce(args, gw * 64 + lane, NGW * 64); } SEAM(1);

    for (int layer = 0; layer < NLAYER; ++layer) {
        const int pb = 2 + NPH_L * layer, lh = layer >> 1;
        if (layer == 0) { if (EN(2) && IN(pb + 0)) DUP(2) { PHASE_IDS(); phase_modulate1(ws, layer, gw, NGW, lane); } SEAM(pb + 0); }
        if ((layer & 1) == 0) {
            if (EN(3) && IN(pb + 1)) DUP(3) {
                PHASE_IDS();
                pg8::Gemm g{(const pg8::bf16_t*)(ws + WS_XN), (const pg8::bf16_t*)(ws + WS_WQKV) + (size_t)lh * QKVN * 1024, MT, QKVN, 1024, 0};
                pg8::StaticOrder S; S.init(MT, QKVN, Gp, bxp);
                LAS float* gl = (LAS float*)(lds + AUX_RS);
                if (tid < 128) gl[tid] = (PARF(ws) + (tid < 64 ? P_QG : P_KG - 64) + lh * 64)[tid];
                __syncthreads();
                pg8::EpiQKV E{ws, WS_Q, WS_K - WS_Q, WS_V - WS_K, gl, (const float*)(ws + WS_ROPE), ATT_C2};
                pg8::gemm_phase<pg8::EpiQKV, pg8::StaticOrder, true, true>(lds + RING_OFF, g, S, E, tid);
            } SEAM(pb + 1);
            if (EN(5) && IN(pb + 3)) DUP(5) {
                PHASE_IDS();
                const attn_body::bf16* Qp = (const attn_body::bf16*)(ws + WS_Q); const attn_body::bf16* Kp = (const attn_body::bf16*)(ws + WS_K); const attn_body::bf16* Vp = (const attn_body::bf16*)(ws + WS_V);
                attn_body::bf16* Op = (attn_body::bf16*)(ws + WS_XN);
                if (G == 256) {
                    for (int i = 0; i < 9; ++i) {
                        long qrow0, kvrow0; int NT, h;
                        if (i < 8) { const int x = vcu >> 5, j = vcu & 31, pair = 4 * x + (i >> 1), wi = (i & 1) * 32 + j, hq = wi >> 4, qb = wi & 15, b = pair >> 2, hk = pair & 3;
                            h = hk * 4 + hq; qrow0 = (long)b * TB + CTXL + qb * 256; kvrow0 = (long)b * TB; NT = TB / 64; }
                        else { if (vcu >= 128) break; const int b = vcu >> 4; h = vcu & 15; qrow0 = (long)b * TB; kvrow0 = qrow0; NT = CTXL / 64; }
                        attn_body::attn_unit<8>(qrow0, kvrow0, NT, h, Qp, Kp, Vp, Op, (char*)lds_raw + RING_OFF, tid);
                    }
                } else {
                    for (int U = bx; U < 2048 + 128; U += G) {
                        long qrow0, kvrow0; int NT, h;
                        if (U < 2048) { const int pair = U >> 6, wi = U & 63, hq = wi >> 4, qb = wi & 15, b = pair >> 2, hk = pair & 3; h = hk * 4 + hq; qrow0 = (long)b * TB + CTXL + qb * 256; kvrow0 = (long)b * TB; NT = TB / 64; }
                        else { const int v = U - 2048, b = v >> 4; h = v & 15; qrow0 = (long)b * TB; kvrow0 = qrow0; NT = CTXL / 64; }
                        attn_body::attn_unit<8>(qrow0, kvrow0, NT, h, Qp, Kp, Vp, Op, (char*)lds_raw + RING_OFF, tid);
                    }
                }
            } SEAM(pb + 3);
        } else {
            if (EN(6) && IN(pb + 1)) DUP(6) {
                PHASE_IDS();
                pg8::Gemm g{(const pg8::bf16_t*)(ws + WS_XN), (const pg8::bf16_t*)(ws + WS_WIN) + (size_t)lh * WINP * 1024, MT, WINP, 1024, 0};
                pg8::StaticOrder S; S.init(MT, WINP, Gp, bxp);
                pg8::EpiBf16 E{(pg8::bf16_t*)(ws + WS_G), WINP};
                pg8::gemm_phase<pg8::EpiBf16, pg8::StaticOrder, true, true>(lds + RING_OFF, g, S, E, tid);
            } SEAM(pb + 1);
            if (EN(7) && IN(pb + 2)) DUP(7) { PHASE_IDS(); phase_gla_g0(ws, lh, lds, tid); } SEAM(pb + 2);
            if (EN(8) && IN(pb + 3)) DUP(8) { PHASE_IDS(); phase_gla_g12(ws, lds, gw, wave, lane); } SEAM(pb + 3);
            if (EN(8) && IN(pb + 4)) DUP(9) { PHASE_IDS(); phase_gla_g3(ws, lh, lds, tid); } SEAM(pb + 4);
        }
        if (EN(9) && IN(pb + 5)) {
            PHASE_IDS();
            const pg8::bf16_t* Wt = (layer & 1) ? (const pg8::bf16_t*)(ws + WS_WOG) + (size_t)lh * 1024 * 1024 : (const pg8::bf16_t*)(ws + WS_WOA) + (size_t)lh * 1024 * 1024;
            pg8::Gemm g{(const pg8::bf16_t*)(ws + ((layer & 1) ? WS_Q : WS_XN)), Wt, MT, 1024, 1024, 0};
            pg8::StaticOrder S; S.init(MT, 1024, Gp, bxp);
            pg8::EpiResGate E{(pg8::bf16_t*)(ws + WS_X), (const float*)(ws + WS_MOD) + (size_t)layer * MODROWS * NMODC + 2 * 1024};
            pg8::gemm_phase<pg8::EpiResGate, pg8::StaticOrder, true, true>(lds + RING_OFF, g, S, E, tid);
        } SEAM(pb + 5);
        if (EN(10) && IN(pb + 6)) { if ((DUPMASK >> 10) & 1) { PHASE_IDS(); phase_modulate2_route(ws, layer, lds, vcu, wave, lane, tid, true); __syncthreads(); } PHASE_IDS(); phase_modulate2_route(ws, layer, lds, vcu, wave, lane, tid); } SEAM(pb + 6);
        if (EN(12) && IN(pb + 8)) DUP(12) {
            PHASE_IDS();
            build_expert_tables(ws, layer, lds, tid);
            const int nT = __builtin_amdgcn_readfirstlane(((const LAS int*)(lds + AUX_NT))[0]);
            pg8::MoeOrder S{nT, 8, Gp, bxp, (const LAS int*)(lds + AUX_T2E)};
            LAS unsigned short* rowtab = (LAS unsigned short*)(lds + AUX_ROWTAB);
            { const LAS int* base = (const LAS int*)(lds + AUX_BASE); const LAS int* cntl = (const LAS int*)(lds + AUX_CNT); const int* LIST = (const int*)(ws + WS_LIST);
              pg8::Unit u;
              for (int i = 0; i < ROWTAB_UNITS && S.next(i, u); ++i) if (tid < 256) { const int pos = (u.pm - (base[u.e] >> 8)) * 256 + tid; rowtab[i * 256 + tid] = (unsigned short)((pos < cntl[u.e]) ? LIST[(size_t)u.e * MT + pos] : 0); }
              __syncthreads(); }
            pg8::Gemm g{(const pg8::bf16_t*)(ws + WS_XN), (const pg8::bf16_t*)(ws + WS_WGU) + (size_t)layer * 32 * 2048 * 1024, MPAD, 2048, 1024, (size_t)2048 * 1024 * 2, rowtab};
            pg8::EpiSwiGLU E{(pg8::bf16_t*)(ws + WS_ACT), PARF(ws) + P_BGU + (size_t)layer * 32 * 2048};
            pg8::gemm_phase<pg8::EpiSwiGLU, pg8::MoeOrder, true, true, true>(lds + RING_OFF, g, S, E, tid);
        } SEAM(pb + 8);
        if (EN(13) && IN(pb + 9)) DUP(13) {
            PHASE_IDS();
            build_expert_tables(ws, layer, lds, tid);
            const int nT = __builtin_amdgcn_readfirstlane(((const LAS int*)(lds + AUX_NT))[0]);
            pg8::Gemm g{(const pg8::bf16_t*)(ws + WS_ACT), (const pg8::bf16_t*)(ws + WS_WDN) + (size_t)layer * 32 * 1024 * 1024, MPAD, 1024, 1024, (size_t)1024 * 1024 * 2};
            pg8::MoeOrder S{nT, 4, Gp, bxp, (const LAS int*)(lds + AUX_T2E)};
            pg8::EpiBiasBf16 E{(pg8::bf16_t*)(ws + WS_Y), PARF(ws) + P_BDN + (size_t)layer * 32 * 1024};
            pg8::gemm_phase<pg8::EpiBiasBf16, pg8::MoeOrder, true, true>(lds + RING_OFF, g, S, E, tid);
        } SEAM(pb + 9);
        if (EN(14) && IN(pb + 10)) { if ((DUPMASK >> 14) & 1) { PHASE_IDS(); phase_moe_combine(ws, args.out, layer, lds, gw, NGW, lane, tid, true); } PHASE_IDS(); phase_moe_combine(ws, args.out, layer, lds, gw, NGW, lane, tid); } SEAM(pb + 10);
    }
#undef IN
#undef EN
#undef DUP
#undef SEAM
#undef PHASE_IDS
#undef LANE_ID
}

extern "C" void kernel_launch(void* const* d_in, const int* in_sizes, int n_in, void* d_out, int out_size, void* d_ws, size_t ws_size, hipStream_t stream) {
    static int grid = 0;
    if (grid == 0) {
        if (n_in != 25 || out_size != NB * SEQ * DMODEL || ws_size < WS_END) { fprintf(stderr, "kernel_launch: unexpected shapes: n_in %d out %d ws %zu (need >= %zu)\n", n_in, out_size, ws_size, (size_t)WS_END); grid = -1; return; }
        int dev = 0, cus = 0, per_cu = 0;
        if (hipGetDevice(&dev) != hipSuccess || hipDeviceGetAttribute(&cus, hipDeviceAttributeMultiprocessorCount, dev) != hipSuccess) { grid = -1; return; }
        if (hipFuncSetAttribute((const void*)dit_fwd, hipFuncAttributeMaxDynamicSharedMemorySize, LDS_BYTES) != hipSuccess) { fprintf(stderr, "kernel_launch: hipFuncSetAttribute failed\n"); grid = -1; return; }
        if (hipOccupancyMaxActiveBlocksPerMultiprocessor(&per_cu, (const void*)dit_fwd, NWAVES * 64, LDS_BYTES) != hipSuccess || per_cu < 1) fprintf(stderr, "kernel_launch: occupancy query reports %d\n", per_cu);
        (void)hipGetLastError();
        grid = cus;
    }
    if (grid < 0) return;
    if (hipMemsetAsync((char*)d_ws + WS_CTL, 0, CTL_ZERO_BYTES, stream) != hipSuccess) { fprintf(stderr, "kernel_launch: memset failed\n"); return; }
    Args a{};
    for (int i = 0; i < 25; ++i) a.in[i] = (const float*)d_in[i];
    a.out = (float*)d_out; a.ws = (unsigned char*)d_ws;
#if MK_ONE_LAUNCH
    a.ph_lo = 0; a.ph_hi = NPHASE;
    hipLaunchKernelGGL(dit_fwd, dim3(grid), dim3(NWAVES * 64), LDS_BYTES, stream, a);
#else
    for (int p = 0; p < NPHASE; ++p) { a.ph_lo = p; a.ph_hi = p + 1; hipLaunchKernelGGL(dit_fwd, dim3(grid), dim3(NWAVES * 64), LDS_BYTES, stream, a); }
#endif
    const hipError_t le = hipPeekAtLastError();
    if (le != hipSuccess) fprintf(stderr, "kernel_launch: launch failed: %s\n", hipGetErrorName(le));
}
```

```cpp
#include <hip/hip_runtime.h>
#include <hip/hip_bf16.h>
#include <cstdio>
#include <cstdint>
#include <cmath>

#ifndef MK_ONE_LAUNCH
#define MK_ONE_LAUNCH 1
#endif

namespace pg8 {
#define PG8_LAS __attribute__((address_space(3)))
typedef unsigned short bf16_t;
typedef short bf16x8 __attribute__((ext_vector_type(8)));
typedef float f32x4 __attribute__((ext_vector_type(4)));
typedef unsigned u32x4 __attribute__((ext_vector_type(4)));
constexpr int BM = 256, BK = 64, HALF = 128, HTB = HALF * BK * 2  , STAGE_BYTES = 8 * HTB, NXCD = 8, WGM = 8;

__host__ __device__ __forceinline__ int lds_byte(int r, int c) { const int st = (r >> 4) * 2 + (c >> 5), rr = r & 15, cc = c & 31, ob = rr * 64 + cc * 2; return st * 1024 + (ob ^ (((ob >> 9) & 1) << 5)); }
__host__ __device__ __forceinline__ void stage_rc(int b, int& R, int& C) { const int st = b / 1024, sb = b % 1024, swz = sb ^ (((sb >> 9) & 1) << 5); R = (st >> 1) * 16 + swz / 64; C = (st & 1) * 32 + (swz % 64) / 2; }
__host__ __device__ __forceinline__ int perm32(int rho) { const int n = rho >> 4, i = rho & 15; return 8 * (i >> 2) + 4 * n + (i & 3); }

struct Unit { int pm, pn, e; };
struct Gemm { const bf16_t* A; const bf16_t* Bt; int M, N, K; size_t bstride; const PG8_LAS unsigned short* rowtab; };

struct StaticOrder {
    int nM, nN, nwg, G, c; bool latent_only;
    __host__ __device__ __forceinline__ void init(int M, int N, int G_, int c_, bool lat_ = false) { nM = M / BM; nN = N / BM; nwg = nM * nN; G = G_; c = c_; latent_only = lat_; }
    __host__ __device__ __forceinline__ bool next(int i, Unit& u) const {
        const long L = (long)i * G + c; if (L >= nwg) return false;
        int wgid = (int)L; { const int q = nwg / NXCD, r = nwg % NXCD, xcd = wgid % NXCD, off = wgid / NXCD; wgid = (xcd < r ? xcd * (q + 1) : r * (q + 1) + (xcd - r) * q) + off; }
        const int nig = WGM * nN, gid = wgid / nig, fm = gid * WGM, gsz = (nM - fm) < WGM ? (nM - fm) : WGM;
        u.pm = fm + ((wgid % nig) % gsz); u.pn = (wgid % nig) / gsz; u.e = 0;
        if (latent_only) u.pm = (u.pm >> 4) * 17 + 1 + (u.pm & 15);
        return true;
    }
    __device__ __forceinline__ void a_ready(const Unit&) const {}
    __device__ __forceinline__ void done(const Unit&) const {}
};
struct MoeOrder {
    int nT, nN, G, c; const PG8_LAS int* t2e;
    __device__ __forceinline__ bool next(int i, Unit& u) const {
        const int x = c & 7, j = c >> 3, per = 32 / nN, mt = (i * (G >> 5) + x) * per + j / nN; if (mt >= nT) return false;
        u.pm = mt; u.pn = j % nN; u.e = __builtin_amdgcn_readfirstlane(t2e[mt]); return true;
    }
    __device__ __forceinline__ void a_ready(const Unit&) const {}
    __device__ __forceinline__ void done(const Unit&) const {}
};

__device__ __forceinline__ int lane_now() { unsigned z; asm volatile("s_mov_b32 %0, 0" : "=s"(z)); return (int)__builtin_amdgcn_mbcnt_hi(~0u, __builtin_amdgcn_mbcnt_lo(~0u, z)); }
__device__ __forceinline__ float shx(float v, int m, int ln) { return __int_as_float(__builtin_amdgcn_ds_bpermute((ln ^ m) << 2, __float_as_int(v))); }
__device__ __forceinline__ unsigned cvt_pk_bf16(float lo, float hi) { unsigned r; asm volatile("v_cvt_pk_bf16_f32 %0, %1, %2" : "=v"(r) : "v"(lo), "v"(hi)); return r; }

struct EpiBf16 {
    static constexpr bool PERM = true, AFTER_DRAIN = false;
    bf16_t* O; int ldc;
    __device__ __forceinline__ void operator()(const f32x4 (&acc)[2][2][4][2], const Unit& u, int wr, int wc, int fr, int fq) const {
        const int row0 = u.pm * BM + wr * 64 + fr; const int col0 = u.pn * BM + wc * 32 + 8 * fq;
#pragma unroll
        for (int ai = 0; ai < 2; ++ai)
#pragma unroll
            for (int m = 0; m < 4; ++m) { bf16_t* rowp = O + (size_t)(row0 + ai * HALF + m * 16) * ldc + col0;
#pragma unroll
                for (int bj = 0; bj < 2; ++bj) { const f32x4 v0 = acc[ai][bj][m][0], v1 = acc[ai][bj][m][1];
                    u32x4 w; w.x = cvt_pk_bf16(v0[0], v0[1]); w.y = cvt_pk_bf16(v0[2], v0[3]); w.z = cvt_pk_bf16(v1[0], v1[1]); w.w = cvt_pk_bf16(v1[2], v1[3]);
                    *(u32x4*)(rowp + bj * HALF) = w; } }
    }
};
struct EpiQKV {
    static constexpr bool PERM = true, AFTER_DRAIN = false;
    unsigned char* wsb; size_t offQ, dK, dV;
    const PG8_LAS float* gl; const float* ropec; float c2;
    __device__ __forceinline__ void operator()(const f32x4 (&acc)[2][2][4][2], const Unit& u, int wr, int wc, int fr, int fq) const {
        const int isk = (u.pn >= 4) ? 1 : 0, isv = (u.pn >= 5) ? 1 : 0;
        bf16_t* base = (bf16_t*)(wsb + offQ + (size_t)isk * dK + (size_t)isv * dV); const int ldc = isk ? 256 : 1024;
        const int hcol = (isk ? wc : (u.pn * 4 + wc)) * 64 + 8 * fq;
        const int pmb = u.pm / 17, pml = u.pm - pmb * 17; const bool lat = pml != 0;
        const PG8_LAS float* gp = gl + (isk ? 64 : 0) + 8 * fq; const float scl = isk ? 1.0f : c2;
#pragma unroll
        for (int ai = 0; ai < 2; ++ai)
#pragma unroll
            for (int m = 0; m < 4; ++m) { const int rl = ai * HALF + wr * 64 + m * 16 + fr; const size_t row = (size_t)u.pm * BM + rl;
                f32x4 v[2][2]; float ss = 0.f;
#pragma unroll
                for (int bj = 0; bj < 2; ++bj)
#pragma unroll
                    for (int n = 0; n < 2; ++n) { v[bj][n] = acc[ai][bj][m][n]; ss += (v[bj][n][0] * v[bj][n][0] + v[bj][n][1] * v[bj][n][1]) + (v[bj][n][2] * v[bj][n][2] + v[bj][n][3] * v[bj][n][3]); }
                if (!isv) { const int ln = lane_now(); ss += shx(ss, 16, ln); ss += shx(ss, 32, ln);
                    const float rs = 1.0f / sqrtf(ss * (1.0f / 64.0f) + 1e-6f);
                    const int spos = (pml - 1) * 256 + rl;
#pragma unroll
                    for (int bj = 0; bj < 2; ++bj) { f32x4 cs = (f32x4){1.f, 1.f, 1.f, 1.f}, sn = (f32x4){0.f, 0.f, 0.f, 0.f};
                        if (lat) { const float* cp = ropec + (size_t)spos * 32 + 16 * bj + 4 * fq; cs = *(const f32x4*)cp; sn = *(const f32x4*)(cp + 4096 * 32); }
#pragma unroll
                        for (int n = 0; n < 2; ++n) { const f32x4 y = v[bj][n] * rs * *(const PG8_LAS f32x4*)(gp + 32 * bj + 4 * n);
                            const float c0 = cs[2 * n], s0 = sn[2 * n], c1 = cs[2 * n + 1], s1 = sn[2 * n + 1];
                            v[bj][n] = (f32x4){(y[0] * c0 - y[1] * s0) * scl, (y[0] * s0 + y[1] * c0) * scl, (y[2] * c1 - y[3] * s1) * scl, (y[2] * s1 + y[3] * c1) * scl}; } } }
                bf16_t* rowp = base + row * ldc + hcol;
#pragma unroll
                for (int bj = 0; bj < 2; ++bj) { u32x4 w; w.x = cvt_pk_bf16(v[bj][0][0], v[bj][0][1]); w.y = cvt_pk_bf16(v[bj][0][2], v[bj][0][3]); w.z = cvt_pk_bf16(v[bj][1][0], v[bj][1][1]); w.w = cvt_pk_bf16(v[bj][1][2], v[bj][1][3]);
                    *(u32x4*)(rowp + 32 * bj) = w; } }
    }
};
struct EpiResGate {
    static constexpr bool PERM = false, AFTER_DRAIN = false;
    bf16_t* X; const float* gate;
    __device__ __forceinline__ void operator()(const f32x4 (&acc)[2][2][4][2], const Unit& u, int wr, int wc, int fr, int fq) const {
        const int row0 = u.pm * BM + wr * 64 + fr; const int col0 = u.pn * BM + wc * 32 + 4 * fq;
        const int bb = u.pm / 17, mr = (u.pm - bb * 17 == 0) ? 8 : bb;
        const float* gp = gate + (size_t)mr * 6144 + col0;
        f32x4 gv[2][2];
#pragma unroll
        for (int bj = 0; bj < 2; ++bj)
#pragma unroll
            for (int n = 0; n < 2; ++n) gv[bj][n] = *(const f32x4*)(gp + bj * HALF + n * 16);
#pragma unroll
        for (int ai = 0; ai < 2; ++ai)
#pragma unroll
            for (int m = 0; m < 4; ++m) { bf16_t* rowp = X + (size_t)(row0 + ai * HALF + m * 16) * 1024 + col0;
#pragma unroll
                for (int bj = 0; bj < 2; ++bj)
#pragma unroll
                    for (int n = 0; n < 2; ++n) { unsigned long long* p = (unsigned long long*)(rowp + bj * HALF + n * 16); const unsigned long long v = *p;
                        f32x4 x = (f32x4){__uint_as_float((unsigned)(v & 0xffffu) << 16), __uint_as_float((unsigned)(v >> 16) << 16), __uint_as_float((unsigned)((v >> 32) & 0xffffu) << 16), __uint_as_float((unsigned)(v >> 48) << 16)};
                        x = x + gv[bj][n] * acc[ai][bj][m][n];
                        *p = (unsigned long long)cvt_pk_bf16(x[0], x[1]) | ((unsigned long long)cvt_pk_bf16(x[2], x[3]) << 32); } }
    }
};
struct EpiSwiGLU {
    static constexpr bool PERM = true, AFTER_DRAIN = false;
    bf16_t* O; const float* bias;
    __device__ __forceinline__ void operator()(const f32x4 (&acc)[2][2][4][2], const Unit& u, int wr, int wc, int fr, int fq) const {
        const int row0 = u.pm * BM + wr * 64 + fr; const int col0 = u.pn * HALF + wc * 32 + 8 * fq;
        const float* bp = bias + (size_t)u.e * 2048 + col0;
        f32x4 bg[2], bu[2];
#pragma unroll
        for (int n = 0; n < 2; ++n) { bg[n] = *(const f32x4*)(bp + 4 * n); bu[n] = *(const f32x4*)(bp + 1024 + 4 * n); }
#pragma unroll
        for (int ai = 0; ai < 2; ++ai)
#pragma unroll
            for (int m = 0; m < 4; ++m) { bf16_t* rowp = O + (size_t)(row0 + ai * HALF + m * 16) * 1024 + col0;
                float r[8];
#pragma unroll
                for (int n = 0; n < 2; ++n) { const f32x4 gt = acc[ai][0][m][n] + bg[n], up = acc[ai][1][m][n] + bu[n];
#pragma unroll
                    for (int i = 0; i < 4; ++i) { const float g = fminf(gt[i], 7.0f), uu = fminf(fmaxf(up[i], -7.0f), 7.0f);
                        const float sg = __builtin_amdgcn_rcpf(1.0f + __builtin_amdgcn_exp2f(-1.702f * 1.4426950408889634f * g));
                        r[4 * n + i] = (uu + 1.0f) * (g * sg); } }
                u32x4 w; w.x = cvt_pk_bf16(r[0], r[1]); w.y = cvt_pk_bf16(r[2], r[3]); w.z = cvt_pk_bf16(r[4], r[5]); w.w = cvt_pk_bf16(r[6], r[7]);
                *(u32x4*)rowp = w; }
    }
};
struct EpiBiasBf16 {
    static constexpr bool PERM = true, AFTER_DRAIN = false;
    bf16_t* O; const float* bias;
    __device__ __forceinline__ void operator()(const f32x4 (&acc)[2][2][4][2], const Unit& u, int wr, int wc, int fr, int fq) const {
        const int row0 = u.pm * BM + wr * 64 + fr; const int col0 = u.pn * BM + wc * 32 + 8 * fq;
        const float* bp = bias + (size_t)u.e * 1024 + col0;
        f32x4 bv[2][2];
#pragma unroll
        for (int bj = 0; bj < 2; ++bj)
#pragma unroll
            for (int n = 0; n < 2; ++n) bv[bj][n] = *(const f32x4*)(bp + bj * HALF + 4 * n);
#pragma unroll
        for (int ai = 0; ai < 2; ++ai)
#pragma unroll
            for (int m = 0; m < 4; ++m) { bf16_t* rowp = O + (size_t)(row0 + ai * HALF + m * 16) * 1024 + col0;
#pragma unroll
                for (int bj = 0; bj < 2; ++bj) { const f32x4 v0 = acc[ai][bj][m][0] + bv[bj][0], v1 = acc[ai][bj][m][1] + bv[bj][1];
                    u32x4 w; w.x = cvt_pk_bf16(v0[0], v0[1]); w.y = cvt_pk_bf16(v0[2], v0[3]); w.z = cvt_pk_bf16(v1[0], v1[1]); w.w = cvt_pk_bf16(v1[2], v1[3]);
                    *(u32x4*)(rowp + bj * HALF) = w; } }
    }
};

template <class Epi, class Sched, bool ALIGN_EPI = false, bool SP2 = false, bool GATHER = false>
__device__ __forceinline__ void gemm_phase(PG8_LAS unsigned char* lds, const Gemm g, const Sched& S, const Epi& E, int tid_in) {
    int tid_l = tid_in; asm volatile("" : "+v"(tid_l));
    const int tid = tid_l, wid = __builtin_amdgcn_readfirstlane(tid >> 6), lane = tid & 63, wr = wid >> 2, wc = wid & 3, fr = lane & 15, fq = lane >> 4;
    const int K = g.K, nt = K / BK;
    unsigned voffA[2], voffB[2];
#pragma unroll
    for (int i = 0; i < 2; ++i) { int R, C; stage_rc(tid * 16 + i * 8192, R, C); const int Rb = Epi::PERM ? ((R & ~31) + perm32(R & 31)) : R;
        voffA[i] = (unsigned)(R * K + C) * 2u; voffB[i] = (unsigned)(Rb * K + C) * 2u; }
    const size_t kstep = (size_t)(BK * 2);
    static_assert(!GATHER || SP2, "GATHER is wired into the SP2 loop only");
    unsigned vAc0[2], vAc1[2], vAn0[2], vAn1[2]; int gR[2]; unsigned gC[2];
#pragma unroll
    for (int i = 0; i < 2; ++i) { int R, C; stage_rc(tid * 16 + i * 8192, R, C); gR[i] = R; gC[i] = (unsigned)C * 2u; vAc0[i] = voffA[i]; vAc1[i] = voffA[i]; vAn0[i] = voffA[i]; vAn1[i] = voffA[i]; }
#define PG8_GFETCH(d0, d1, ord) do { if constexpr (GATHER) { _Pragma("unroll") for (int _i = 0; _i < 2; ++_i) { \
        d0[_i] = (unsigned)g.rowtab[(ord) * 256 + gR[_i]] * (unsigned)(K * 2) + gC[_i]; d1[_i] = (unsigned)g.rowtab[(ord) * 256 + 128 + gR[_i]] * (unsigned)(K * 2) + gC[_i]; } } } while (0)
    const size_t hstep = (size_t)HALF * K * 2;
    const size_t hstepA = GATHER ? 0 : hstep;
    const size_t tstep = 2 * hstep;
    const unsigned ldsw = (unsigned)wid * 1024u;
    const int aoff = lds_byte(wr * 64 + fr, fq * 8), boff = lds_byte(wc * 32 + fr, fq * 8);
#define PG8_SA(b, h) (((b) * 2 + (h)) * HTB)
#define PG8_SB(b, h) ((4 + (b) * 2 + (h)) * HTB)
#define PG8_STAGE(bufoff, gbase, voff) do { _Pragma("unroll") for (int _i = 0; _i < 2; ++_i) \
        __builtin_amdgcn_global_load_lds((const unsigned*)((const char*)(gbase) + (voff)[_i]), (PG8_LAS unsigned*)(lds + (bufoff) + ldsw + _i * 8192), 16, 0, 0); } while (0)
#define PG8_LDA(dst, b, h) do { _Pragma("unroll") for (int m = 0; m < 4; ++m) _Pragma("unroll") for (int k = 0; k < 2; ++k) dst[m][k] = *(const PG8_LAS bf16x8*)(lds + PG8_SA(b, h) + aoff + m * 2048 + k * 1024); } while (0)
#define PG8_LDB(dst, b, h) do { _Pragma("unroll") for (int n = 0; n < 2; ++n) _Pragma("unroll") for (int k = 0; k < 2; ++k) dst[n][k] = *(const PG8_LAS bf16x8*)(lds + PG8_SB(b, h) + boff + n * 2048 + k * 1024); } while (0)
#define PG8_MMA(ai, bj, At, Bt) do { __builtin_amdgcn_s_setprio(1); _Pragma("unroll") for (int m = 0; m < 4; ++m) _Pragma("unroll") for (int n = 0; n < 2; ++n) _Pragma("unroll") for (int k = 0; k < 2; ++k) \
        acc[ai][bj][m][n] = __builtin_amdgcn_mfma_f32_16x16x32_bf16(Bt[n][k], At[m][k], acc[ai][bj][m][n], 0, 0, 0); __builtin_amdgcn_s_setprio(0); } while (0)
#define PG8_WAIT_V(n) asm volatile("s_waitcnt vmcnt(" #n ")" ::: "memory")
#define PG8_WAIT_L(n) asm volatile("s_waitcnt lgkmcnt(" #n ")" ::: "memory")
#define PG8_BAR __builtin_amdgcn_s_barrier()
#define PG8_SCHED __builtin_amdgcn_sched_barrier(0)
    Unit cur, nxt; int ui = 0;
    if (!S.next(0, cur)) return;
    f32x4 acc[2][2][4][2];
#pragma unroll
    for (int a = 0; a < 2; ++a)
#pragma unroll
        for (int b = 0; b < 2; ++b)
#pragma unroll
            for (int m = 0; m < 4; ++m)
#pragma unroll
                for (int n = 0; n < 2; ++n) acc[a][b][m][n] = (f32x4){0.f, 0.f, 0.f, 0.f};
    bf16x8 At[4][2], B0[2][2], B1[2][2];
    const char* cA = (const char*)g.A + (GATHER ? (size_t)0 : (size_t)cur.pm * tstep); PG8_GFETCH(vAc0, vAc1, 0); const char* cB = (const char*)g.Bt + (size_t)cur.e * g.bstride + (size_t)cur.pn * tstep;
    S.a_ready(cur);
    if constexpr (SP2) {
        PG8_STAGE(PG8_SB(0, 0), cB, voffB); PG8_STAGE(PG8_SB(0, 1), cB + hstep, voffB); PG8_STAGE(PG8_SA(0, 0), cA, vAc0); PG8_STAGE(PG8_SA(0, 1), cA + hstepA, vAc1);
        if (wr == 1) PG8_BAR;
        PG8_WAIT_V(2); PG8_BAR;
        PG8_STAGE(PG8_SB(1, 0), cB + kstep, voffB); PG8_STAGE(PG8_SA(1, 0), cA + kstep, vAc0); PG8_STAGE(PG8_SB(1, 1), cB + hstep + kstep, voffB);
        PG8_WAIT_V(6); PG8_BAR;
    } else {
        PG8_STAGE(PG8_SB(0, 0), cB, voffB); PG8_STAGE(PG8_SA(0, 0), cA, voffA); PG8_STAGE(PG8_SB(0, 1), cB + hstep, voffB); PG8_STAGE(PG8_SA(0, 1), cA + hstep, voffA);
        if (wr == 1) PG8_BAR;
        PG8_WAIT_V(4); PG8_BAR;
        PG8_STAGE(PG8_SB(1, 0), cB + kstep, voffB); PG8_STAGE(PG8_SA(1, 0), cA + kstep, voffA); PG8_STAGE(PG8_SB(1, 1), cB + hstep + kstep, voffB);
        PG8_WAIT_V(6); PG8_BAR;
    }
    for (;;) {
        const bool has_next = S.next(ui + 1, nxt);
        const char* nA = (has_next && !GATHER) ? (const char*)g.A + (size_t)nxt.pm * tstep : cA;
        if constexpr (GATHER) { if (has_next) PG8_GFETCH(vAn0, vAn1, ui + 1); else { vAn0[0] = vAc0[0]; vAn0[1] = vAc0[1]; vAn1[0] = vAc1[0]; vAn1[1] = vAc1[1]; } }
        const char* nB = has_next ? (const char*)g.Bt + (size_t)nxt.e * g.bstride + (size_t)nxt.pn * tstep : cB;
        for (int t = 0; t < nt; t += 2) {
            const bool last = (t == nt - 2);
            const char* a1 = cA + (size_t)(t + 1) * kstep;
            const char* a2 = last ? nA : cA + (size_t)(t + 2) * kstep; const char* b2 = last ? nB : cB + (size_t)(t + 2) * kstep;
            const char* a3 = a2 + kstep; const char* b3 = b2 + kstep;
            if (last && has_next) S.a_ready(nxt);
            unsigned vS0[2], vS1[2];
            vS0[0] = last ? vAn0[0] : vAc0[0]; vS0[1] = last ? vAn0[1] : vAc0[1]; vS1[0] = last ? vAn1[0] : vAc1[0]; vS1[1] = last ? vAn1[1] : vAc1[1];
            if constexpr (SP2) {
            PG8_LDB(B0, 0, 0); PG8_LDB(B1, 0, 1); PG8_SCHED; PG8_LDA(At, 0, 0); PG8_STAGE(PG8_SA(1, 1), a1 + hstepA, vAc1);
            PG8_WAIT_V(8); PG8_WAIT_L(0); PG8_BAR; PG8_MMA(0, 0, At, B0); PG8_MMA(0, 1, At, B1); PG8_BAR; PG8_SCHED;
            PG8_LDA(At, 0, 1); PG8_STAGE(PG8_SB(0, 0), b2, voffB); PG8_STAGE(PG8_SB(0, 1), b2 + hstep, voffB); PG8_STAGE(PG8_SA(0, 0), a2, vS0);
            PG8_WAIT_V(8); PG8_WAIT_L(0); PG8_BAR; PG8_MMA(1, 0, At, B0); PG8_MMA(1, 1, At, B1); PG8_BAR; PG8_SCHED;
            PG8_LDB(B0, 1, 0); PG8_LDB(B1, 1, 1); PG8_SCHED; PG8_LDA(At, 1, 0); PG8_STAGE(PG8_SA(0, 1), a2 + hstepA, vS1);
            PG8_WAIT_V(8); PG8_WAIT_L(0); PG8_BAR; PG8_MMA(0, 0, At, B0); PG8_MMA(0, 1, At, B1); PG8_BAR; PG8_SCHED;
            PG8_LDA(At, 1, 1); PG8_STAGE(PG8_SB(1, 0), b3, voffB); PG8_STAGE(PG8_SB(1, 1), b3 + hstep, voffB); PG8_STAGE(PG8_SA(1, 0), a3, vS0);
            PG8_WAIT_V(8); PG8_WAIT_L(0); PG8_BAR; PG8_MMA(1, 0, At, B0); PG8_MMA(1, 1, At, B1); PG8_BAR; PG8_SCHED;
            } else {
            PG8_LDB(B0, 0, 0); PG8_SCHED; PG8_LDA(At, 0, 0); PG8_STAGE(PG8_SA(1, 1), a1 + hstep, voffA);
            PG8_WAIT_L(8); PG8_BAR; PG8_WAIT_L(0); PG8_MMA(0, 0, At, B0); PG8_BAR; PG8_SCHED;
            PG8_LDB(B1, 0, 1); PG8_STAGE(PG8_SB(0, 0), b2, voffB);
            PG8_BAR; PG8_WAIT_L(0); PG8_MMA(0, 1, At, B1); PG8_BAR;
            PG8_LDA(At, 0, 1); PG8_STAGE(PG8_SA(0, 0), a2, voffA);
            PG8_BAR; PG8_WAIT_L(0); PG8_MMA(1, 0, At, B0); PG8_BAR; PG8_SCHED;
            PG8_STAGE(PG8_SB(0, 1), b2 + hstep, voffB);
            PG8_WAIT_V(6); PG8_BAR; PG8_MMA(1, 1, At, B1); PG8_BAR;
            PG8_LDB(B0, 1, 0); PG8_SCHED; PG8_LDA(At, 1, 0); PG8_STAGE(PG8_SA(0, 1), a2 + hstep, voffA);
            PG8_WAIT_L(8); PG8_BAR; PG8_WAIT_L(0); PG8_MMA(0, 0, At, B0); PG8_BAR; PG8_SCHED;
            PG8_LDB(B1, 1, 1); PG8_STAGE(PG8_SB(1, 0), b3, voffB);
            PG8_BAR; PG8_WAIT_L(0); PG8_MMA(0, 1, At, B1); PG8_BAR;
            PG8_LDA(At, 1, 1); PG8_STAGE(PG8_SA(1, 0), a3, voffA);
            PG8_BAR; PG8_WAIT_L(0); PG8_MMA(1, 0, At, B0); PG8_BAR; PG8_SCHED;
            PG8_STAGE(PG8_SB(1, 1), b3 + hstep, voffB);
            PG8_WAIT_V(6); PG8_BAR; PG8_MMA(1, 1, At, B1); PG8_BAR;
            }
        }
        if constexpr (ALIGN_EPI) { if (wr == 0) PG8_BAR; }
        if constexpr (!Epi::AFTER_DRAIN) { E(acc, cur, wr, wc, fr, fq); S.done(cur); }
        if (!has_next) break;
#pragma unroll
        for (int a = 0; a < 2; ++a)
#pragma unroll
            for (int b = 0; b < 2; ++b)
#pragma unroll
                for (int m = 0; m < 4; ++m)
#pragma unroll
                    for (int n = 0; n < 2; ++n) acc[a][b][m][n] = (f32x4){0.f, 0.f, 0.f, 0.f};
        cur = nxt; cA = nA; cB = nB; ++ui;
        if constexpr (GATHER) { vAc0[0] = vAn0[0]; vAc0[1] = vAn0[1]; vAc1[0] = vAn1[0]; vAc1[1] = vAn1[1]; }
        if constexpr (ALIGN_EPI) { if (wr == 1) PG8_BAR; }
    }
    PG8_WAIT_V(0);
    if constexpr (!ALIGN_EPI) { if (wr == 0) PG8_BAR; }
    PG8_BAR;
    if constexpr (Epi::AFTER_DRAIN) { E.fused(acc, cur, wr, wc, fr, fq, lds, wid, lane); S.done(cur); }
#undef PG8_SA
#undef PG8_SB
#undef PG8_STAGE
#undef PG8_LDA
#undef PG8_LDB
#undef PG8_MMA
#undef PG8_WAIT_V
#undef PG8_WAIT_L
#undef PG8_BAR
#undef PG8_SCHED
#undef PG8_GFETCH
}
}
#include <hip/hip_bf16.h>
#include <cmath>
namespace attn_body {
using bf16=__hip_bfloat16;
using bf16x8=__attribute__((ext_vector_type(8)))short;
using s16x4=__attribute__((ext_vector_type(4)))short;
using f32x16=__attribute__((ext_vector_type(16)))float;
using u32x4=__attribute__((ext_vector_type(4)))unsigned;
constexpr int D=64,DM=1024,KVP=256;
constexpr int NW=8,QBLK=32,QB=QBLK*NW,KVBLK=64;
__device__ __forceinline__ int crow(int r,int hi){return (r&3)+8*(r>>2)+4*hi;}
#define SBAR() __builtin_amdgcn_sched_barrier(0)
__device__ __forceinline__ void cmask(f32x16&p0,f32x16&p1,int jb,int qrel,int hi){
  const float NEG=-INFINITY; int kb=64*jb+4*hi;
  #pragma unroll
  for(int r=0;r<16;++r){int kv=kb+(r&3)+8*(r>>2); if(kv>qrel)p0[r]=NEG; if(kv+32>qrel)p1[r]=NEG;}
}

constexpr int NSLOT=3, SLOTB=8192;
constexpr int LDS_K=0, LDS_V=NSLOT*SLOTB, LDS_WS=2*NSLOT*SLOTB, LDS_OST=LDS_WS+NW*64*4, LDS_BYTES=LDS_OST+NW*4096;
constexpr float C2=0.125f*1.4426950408889634f;
__device__ __forceinline__ void glds16(const void*gsrc,unsigned lds_dst){unsigned keep;
  asm volatile("s_mov_b32 %0, m0\n\ts_mov_b32 m0, %2\n\ts_nop 0\n\tglobal_load_lds_dwordx4 %1, off\n\ts_mov_b32 m0, %0":"=&s"(keep):"v"(gsrc),"s"(lds_dst):"memory");}
__device__ __forceinline__ float max3f(float a,float b,float c){float r;asm("v_max3_f32 %0, %1, %2, %3":"=v"(r):"v"(a),"v"(b),"v"(c));return r;}
__device__ __forceinline__ float max2f(float a,float b){float r;asm("v_max_f32_e32 %0, %1, %2":"=v"(r):"v"(a),"v"(b));return r;}
__device__ __forceinline__ float fadd_s(float a,float b){float r;asm("v_add_f32_e32 %0, %1, %2":"=v"(r):"v"(a),"v"(b));return r;}
__device__ __forceinline__ float fsub_s(float a,float b){float r;asm("v_sub_f32_e32 %0, %1, %2":"=v"(r):"v"(a),"v"(b));return r;}
typedef float f32x2_t __attribute__((ext_vector_type(2))); typedef __bf16 bf16x2_t __attribute__((ext_vector_type(2)));
__device__ __forceinline__ unsigned cvtpk_s(float lo,float hi){f32x2_t v={lo,hi};bf16x2_t b=__builtin_convertvector(v,bf16x2_t);return __builtin_bit_cast(unsigned,b);}
#define WAIT_BAR(N) asm volatile("s_waitcnt vmcnt(" #N ") lgkmcnt(0)\n\ts_barrier":::"memory")

__device__ __forceinline__ void qkt(f32x16&p0,f32x16&p1,const char*Kslot,const bf16x8*qr,const f32x16&negm,int r32,int hi){
  const char*kb=Kslot+hi*1024+r32*16;
  #pragma unroll
  for(int d0=0;d0<4;++d0){
    const bf16x8 b0=*reinterpret_cast<const bf16x8*>(kb+d0*2048);
    const bf16x8 b1=*reinterpret_cast<const bf16x8*>(kb+d0*2048+512);
    if(d0==0){p0=__builtin_amdgcn_mfma_f32_32x32x16_bf16(b0,qr[0],negm,0,0,0);p1=__builtin_amdgcn_mfma_f32_32x32x16_bf16(b1,qr[0],negm,0,0,0);}
    else{p0=__builtin_amdgcn_mfma_f32_32x32x16_bf16(b0,qr[d0],p0,0,0,0);p1=__builtin_amdgcn_mfma_f32_32x32x16_bf16(b1,qr[d0],p1,0,0,0);}}
}
typedef __attribute__((address_space(3))) const char* lds_cptr;
typedef short v4i16_t __attribute__((ext_vector_type(4)));
__device__ __forceinline__ void kload8(bf16x8*kf,lds_cptr kp){
  kf[0]=*(const __attribute__((address_space(3))) bf16x8*)(kp);      kf[1]=*(const __attribute__((address_space(3))) bf16x8*)(kp+512);
  kf[2]=*(const __attribute__((address_space(3))) bf16x8*)(kp+2048); kf[3]=*(const __attribute__((address_space(3))) bf16x8*)(kp+2560);
  kf[4]=*(const __attribute__((address_space(3))) bf16x8*)(kp+4096); kf[5]=*(const __attribute__((address_space(3))) bf16x8*)(kp+4608);
  kf[6]=*(const __attribute__((address_space(3))) bf16x8*)(kp+6144); kf[7]=*(const __attribute__((address_space(3))) bf16x8*)(kp+6656);
}
__device__ __forceinline__ void kload2(bf16x8*kf,lds_cptr kp,int j){ kf[2*j]=*(const __attribute__((address_space(3))) bf16x8*)(kp+j*2048); kf[2*j+1]=*(const __attribute__((address_space(3))) bf16x8*)(kp+j*2048+512); }
__device__ __forceinline__ s16x4 vtr(lds_cptr p){ return __builtin_bit_cast(s16x4,__builtin_amdgcn_ds_read_tr16_b64_v4i16((__attribute__((address_space(3))) v4i16_t*)p)); }
__device__ __forceinline__ float rowmax(const f32x16&p0,const f32x16&p1){
  float a=max3f(p0[0],p0[1],p1[0]),b=max3f(p0[2],p0[3],p1[1]);a=max3f(a,p1[2],p1[3]);
  #pragma unroll
  for(int r=4;r<16;r+=4){a=max3f(a,p0[r],p0[r+1]);b=max3f(b,p0[r+2],p0[r+3]);a=max3f(a,p1[r],p1[r+1]);b=max3f(b,p1[r+2],p1[r+3]);}
  const float m=max2f(a,b);
  auto rr=__builtin_amdgcn_permlane32_swap(__float_as_uint(m),__float_as_uint(m),false,false);
  return max2f(__uint_as_float(rr[0]),__uint_as_float(rr[1]));
}
__device__ __forceinline__ void pv(f32x16*o,int vb,bf16x8 pa0,bf16x8 pa1,bf16x8 pa2,bf16x8 pa3){
  #pragma unroll
  for(int d0=0;d0<2;++d0){s16x4 lo[4],hi[4];
    #pragma unroll
    for(int ks=0;ks<4;++ks){
      asm volatile("ds_read_b64_tr_b16 %0,%1 offset:%c2":"=&v"(lo[ks]):"v"(vb),"i"(d0*4096+ks*1024):"memory");
      asm volatile("ds_read_b64_tr_b16 %0,%1 offset:%c2":"=&v"(hi[ks]):"v"(vb),"i"(d0*4096+ks*1024+512):"memory");}
    asm volatile("s_waitcnt lgkmcnt(0)":::"memory");SBAR();
    #define PK(k) (bf16x8){lo[k][0],lo[k][1],lo[k][2],lo[k][3],hi[k][0],hi[k][1],hi[k][2],hi[k][3]}
    o[d0]=__builtin_amdgcn_mfma_f32_32x32x16_bf16(pa0,PK(0),o[d0],0,0,0);
    o[d0]=__builtin_amdgcn_mfma_f32_32x32x16_bf16(pa1,PK(1),o[d0],0,0,0);
    o[d0]=__builtin_amdgcn_mfma_f32_32x32x16_bf16(pa2,PK(2),o[d0],0,0,0);
    o[d0]=__builtin_amdgcn_mfma_f32_32x32x16_bf16(pa3,PK(3),o[d0],0,0,0);
    #undef PK
  }
}

#ifndef ATTN_STORE16
#define ATTN_STORE16(p,v) (*(u32x4*)(p)=(v))
#endif
template<int THRL> __device__ __forceinline__ void attn_unit(long qrow0,long kvrow0,int NT,int h,const bf16*Q,const bf16*__restrict__ K,const bf16*__restrict__ V,bf16*O,char*shm,int tid_in){
  int tid_l=tid_in; asm volatile("":"+v"(tid_l)); const int tid=tid_l,lane=tid&63,r32=lane&31,hi=lane>>5; const int wid=__builtin_amdgcn_readfirstlane(tid>>6);
  const bf16*Qw=Q+(qrow0+wid*QBLK)*DM+h*D;
  const bf16*Kh=K+kvrow0*KVP+(h>>2)*D,*Vh=V+kvrow0*KVP+(h>>2)*D;
  const unsigned lds0=(unsigned)(uintptr_t)shm;
  float*wsf=(float*)(shm+LDS_WS)+wid*64;
  const bf16*ksrc=Kh+(long)lane*KVP+wid*8;
  const bf16*vsrc=Vh+(long)(16*(wid&3)+(lane>>2))*KVP+(wid>>2)*32+(lane&3)*8;
  const unsigned kdst=lds0+LDS_K+wid*1024, vdst=lds0+LDS_V+wid*1024;
  #define DMA_K(t,slot) glds16(ksrc+(long)(t)*KVBLK*KVP,(unsigned)__builtin_amdgcn_readfirstlane(kdst+(slot)))
  #define DMA_V(t,slot) glds16(vsrc+(long)(t)*KVBLK*KVP,(unsigned)__builtin_amdgcn_readfirstlane(vdst+(slot)))
  const int vb0=(int)(lds0+LDS_V)+((lane>>4)&1)*32+(lane&3)*8+(4*hi+((lane&15)>>2))*64;
  const char*Kbase=shm+LDS_K; bf16x8 kf[8];
  const lds_cptr shm3=(lds_cptr)shm; const lds_cptr kp0=shm3+LDS_K+hi*1024+r32*16; const lds_cptr vp0=shm3+LDS_V+((lane>>4)&1)*32+(lane&3)*8+(4*hi+((lane&15)>>2))*64;
  DMA_K(0,0);DMA_V(0,0);DMA_K(1,SLOTB);
  bf16x8 qr[4];
  #pragma unroll
  for(int d0=0;d0<4;++d0)qr[d0]=*reinterpret_cast<const bf16x8*>(&Qw[(long)r32*DM+d0*16+hi*8]);
  float mhat=0.f,l_reg=0.f;f32x16 o[2];o[0]=f32x16{};o[1]=f32x16{};f32x16 negm=f32x16{};asm volatile("":"+v"(negm));
  #define CMASK(P0,P1,t) do{}while(0)
  bool resc=false;
  #define START(P0,P1) do{ const float rm=rowmax(P0,P1); resc=false; \
    { const float dl=rm; mhat=fadd_s(mhat,dl); \
      _Pragma("unroll") for(int r=0;r<16;++r){P0[r]=fsub_s(P0[r],dl);P1[r]=fsub_s(P1[r],dl);} \
      _Pragma("unroll") for(int r=0;r<16;++r)negm[r]=-mhat; asm volatile("":"+v"(negm)); } \
    _Pragma("unroll") for(int r=0;r<16;++r)P0[r]=__builtin_amdgcn_exp2f(P0[r]); }while(0)
  #define RESC() do{ if(resc){ asm volatile("s_waitcnt lgkmcnt(0)":::"memory"); \
      _Pragma("unroll") for(int d_=0;d_<2;++d_) _Pragma("unroll") for(int r=0;r<16;++r)o[d_][r]*=wsf[crow(r,hi)]; } }while(0)
  f32x16 pA0,pA1,pB0,pB1;
  int sl_prev=0,sl_cur=0,sl_next=SLOTB;
  #define ROT() do{sl_prev=sl_cur;sl_cur=sl_next;sl_next=(sl_next==(NSLOT-1)*SLOTB)?0:sl_next+SLOTB;}while(0)
  DMA_K(2,2*SLOTB);
  WAIT_BAR(3);
  qkt(pA0,pA1,Kbase,qr,negm,r32,hi);asm volatile("s_nop 15\n\ts_nop 7":"+v"(pA0),"+v"(pA1));CMASK(pA0,pA1,0);
  START(pA0,pA1);
  _Pragma("unroll") for(int r=0;r<16;++r)pA1[r]=__builtin_amdgcn_exp2f(pA1[r]);
  WAIT_BAR(0);
  DMA_K(3,0);DMA_V(1,SLOTB);
  ROT();
  kload8(kf,kp0+sl_cur);
  WAIT_BAR(2);
  s16x4 vlo[8],vhi[8]; u32x4 pw0,pw1,pw2,pw3;
  #define PKW(P,B) cvtpk_s(P[B],P[B+1])
  #define PAF(k) __builtin_bit_cast(bf16x8,pw##k)
  #define VFR(i) (bf16x8){vlo[i][0],vlo[i][1],vlo[i][2],vlo[i][3],vhi[i][0],vhi[i][1],vhi[i][2],vhi[i][3]}
  #define PIN(x) asm volatile("":"+v"(x))
  #define MX3(a,b,c) __builtin_fmaxf(__builtin_fmaxf((a),(b)),(c))
  #define GAPA(MF,A0,A1,A2,A3,W0,W1,PW) do{ MF; sacc+=A0; sacc+=A1; sacc+=A2; sacc+=A3; PIN(sacc); W0; W1; PIN(PW); SBAR(); }while(0)
  #define EX(v) __builtin_amdgcn_exp2f(v)
  #define GAPB(MF,X,B) do{ MF; X[B]=EX(X[B]); X[B+1]=EX(X[B+1]); X[B+2]=EX(X[B+2]); X[B+3]=EX(X[B+3]); PIN(X); SBAR(); }while(0)
  #define VRD(i) do{ vlo[i]=vtr(vp_+(((i)>>2)*4096+((i)&3)*1024)); vhi[i]=vtr(vp_+(((i)>>2)*4096+((i)&3)*1024+512)); }while(0)
  #define KRD(G,j) do{ if(G){ kload2(kf,kp0+sl_next,j); SBAR(); } }while(0)
  #define STEP(C0,C1,P0,P1,t,GK,GV,GL) do{ SBAR(); \
    const lds_cptr vp_=vp0+sl_prev; \
    VRD(0); SBAR(); float sacc=(P0[0]+P0[1]); \
    GAPA(C0=__builtin_amdgcn_mfma_f32_32x32x16_bf16(kf[0],qr[0],negm,0,0,0), P0[2],P0[3],P0[4],P0[5],     pw0[0]=PKW(P0,0), pw0[1]=PKW(P0,2), pw0); \
    VRD(4); SBAR(); GAPA(C1=__builtin_amdgcn_mfma_f32_32x32x16_bf16(kf[1],qr[0],negm,0,0,0), P0[6],P0[7],P0[8],P0[9],     pw0[2]=PKW(P0,4), pw0[3]=PKW(P0,6), pw0); \
    VRD(1); SBAR(); GAPA(C0=__builtin_amdgcn_mfma_f32_32x32x16_bf16(kf[2],qr[1],C0,0,0,0),   P0[10],P0[11],P0[12],P0[13], pw1[0]=PKW(P0,8), pw1[1]=PKW(P0,10), pw1); \
    VRD(5); SBAR(); GAPA(C1=__builtin_amdgcn_mfma_f32_32x32x16_bf16(kf[3],qr[1],C1,0,0,0),   P0[14],P0[15],P1[0],P1[1],   pw1[2]=PKW(P0,12),pw1[3]=PKW(P0,14), pw1); \
    VRD(2); SBAR(); GAPA(C0=__builtin_amdgcn_mfma_f32_32x32x16_bf16(kf[4],qr[2],C0,0,0,0),   P1[2],P1[3],P1[4],P1[5],     pw2[0]=PKW(P1,0), pw2[1]=PKW(P1,2), pw2); \
    VRD(6); SBAR(); GAPA(C1=__builtin_amdgcn_mfma_f32_32x32x16_bf16(kf[5],qr[2],C1,0,0,0),   P1[6],P1[7],P1[8],P1[9],     pw2[2]=PKW(P1,4), pw2[3]=PKW(P1,6), pw2); \
    VRD(3); SBAR(); GAPA(C0=__builtin_amdgcn_mfma_f32_32x32x16_bf16(kf[6],qr[3],C0,0,0,0),   P1[10],P1[11],P1[12],P1[13], pw3[0]=PKW(P1,8), pw3[1]=PKW(P1,10), pw3); \
    VRD(7); SBAR(); GAPA(C1=__builtin_amdgcn_mfma_f32_32x32x16_bf16(kf[7],qr[3],C1,0,0,0),   P1[14],P1[15],0.f,0.f,       pw3[2]=PKW(P1,12),pw3[3]=PKW(P1,14), pw3); \
    l_reg+=sacc; \
    if(GK){DMA_K((t)+3,sl_cur);} if(GV){DMA_V((t)+1,sl_next);} \
    CMASK(C0,C1,t); \
    { float a=MX3(C0[0],C0[1],C1[0]),b=MX3(C0[2],C0[3],C1[1]); a=MX3(a,C1[2],C1[3]); \
      _Pragma("unroll") for(int r=4;r<16;r+=4){a=MX3(a,C0[r],C0[r+1]);b=MX3(b,C0[r+2],C0[r+3]);a=MX3(a,C1[r],C1[r+1]);b=MX3(b,C1[r+2],C1[r+3]);} \
      float rm=__builtin_fmaxf(a,b); { auto rr=__builtin_amdgcn_permlane32_swap(__float_as_uint(rm),__float_as_uint(rm),false,false); rm=__builtin_fmaxf(__uint_as_float(rr[0]),__uint_as_float(rr[1])); } \
      resc=false; \
      if(__builtin_expect(__any(rm>(float)THRL),0)){ const float dl=__builtin_fmaxf(rm,0.f); mhat+=dl; \
        _Pragma("unroll") for(int r=0;r<16;++r){C0[r]-=dl;C1[r]-=dl;} \
        _Pragma("unroll") for(int r=0;r<16;++r)negm[r]=-mhat; asm volatile("":"+v"(negm)); \
        const float f=__builtin_amdgcn_exp2f(-dl); l_reg*=f; if(hi==0)wsf[r32]=f; resc=true; } } \
    SBAR(); \
    GAPB(o[0]=__builtin_amdgcn_mfma_f32_32x32x16_bf16(PAF(0),VFR(0),o[0],0,0,0), C0,0); \
    GAPB(o[1]=__builtin_amdgcn_mfma_f32_32x32x16_bf16(PAF(0),VFR(4),o[1],0,0,0), C0,4); \
    KRD(GL,0); GAPB(o[0]=__builtin_amdgcn_mfma_f32_32x32x16_bf16(PAF(1),VFR(1),o[0],0,0,0), C0,8); \
    KRD(GL,1); GAPB(o[1]=__builtin_amdgcn_mfma_f32_32x32x16_bf16(PAF(1),VFR(5),o[1],0,0,0), C0,12); \
    KRD(GL,2); GAPB(o[0]=__builtin_amdgcn_mfma_f32_32x32x16_bf16(PAF(2),VFR(2),o[0],0,0,0), C1,0); \
    KRD(GL,3); GAPB(o[1]=__builtin_amdgcn_mfma_f32_32x32x16_bf16(PAF(2),VFR(6),o[1],0,0,0), C1,4); \
    GAPB(o[0]=__builtin_amdgcn_mfma_f32_32x32x16_bf16(PAF(3),VFR(3),o[0],0,0,0), C1,8); \
    GAPB(o[1]=__builtin_amdgcn_mfma_f32_32x32x16_bf16(PAF(3),VFR(7),o[1],0,0,0), C1,12); \
    }while(0)
  int t=1;
  #undef CMASK
  #define CMASK(P0,P1,t) do{}while(0)
  for(;t+5<NT;t+=2){
    STEP(pB0,pB1,pA0,pA1,t,true,true,true);     WAIT_BAR(2); RESC(); ROT();
    STEP(pA0,pA1,pB0,pB1,t+1,true,true,true);   WAIT_BAR(2); RESC(); ROT();
  }
  #undef CMASK
  #define CMASK(P0,P1,t) do{}while(0)
  #define ENDW(tt) do{ if((tt)+3<NT){WAIT_BAR(2);} else if((tt)+2<NT){WAIT_BAR(1);} else {WAIT_BAR(0);} }while(0)
  for(;t+1<NT;t+=2){
    STEP(pB0,pB1,pA0,pA1,t,(t+3<NT),(t+1<NT),(t+1<NT));       ENDW(t);   RESC(); ROT();
    STEP(pA0,pA1,pB0,pB1,t+1,(t+4<NT),(t+2<NT),(t+2<NT));     ENDW(t+1); RESC(); ROT();
  }
  STEP(pB0,pB1,pA0,pA1,NT-1,false,false,false); RESC();
  { float sacc=pB0[0]+pB0[1]; _Pragma("unroll") for(int r=2;r<16;++r)sacc+=pB0[r]; _Pragma("unroll") for(int r=0;r<16;++r)sacc+=pB1[r]; l_reg+=sacc;
    pw0=(u32x4){PKW(pB0,0),PKW(pB0,2),PKW(pB0,4),PKW(pB0,6)};pw1=(u32x4){PKW(pB0,8),PKW(pB0,10),PKW(pB0,12),PKW(pB0,14)};pw2=(u32x4){PKW(pB1,0),PKW(pB1,2),PKW(pB1,4),PKW(pB1,6)};pw3=(u32x4){PKW(pB1,8),PKW(pB1,10),PKW(pB1,12),PKW(pB1,14)};
    SBAR(); pv(o,vb0+sl_cur,PAF(0),PAF(1),PAF(2),PAF(3)); }
  #undef PKW
  #undef PAF
  #undef VFR
  #undef PIN
  #undef MX3
  #undef GAPA
  #undef GAPB
  #undef EX
  #undef VRD
  #undef KRD
  #undef STEP
  #undef ENDW
  {auto rr=__builtin_amdgcn_permlane32_swap(__float_as_uint(l_reg),__float_as_uint(l_reg),false,false);l_reg=__uint_as_float(rr[0])+__uint_as_float(rr[1]);}
  if(hi==0)wsf[32+r32]=l_reg;asm volatile("s_waitcnt lgkmcnt(0)":::"memory");
  float rli[16];
  #pragma unroll
  for(int r=0;r<16;++r)rli[r]=__builtin_amdgcn_rcpf(wsf[32+crow(r,hi)]);
  bf16*Ow=O+(qrow0+wid*QBLK)*DM+h*D;
  { bf16*stg=(bf16*)(shm+LDS_OST)+wid*2048;
    #pragma unroll
    for(int r=0;r<16;++r){const int orow=crow(r,hi);
      #pragma unroll
      for(int d0=0;d0<2;++d0)stg[orow*64+d0*32+r32]=__float2bfloat16(o[d0][r]*rli[r]);}
    asm volatile("s_waitcnt lgkmcnt(0)":::"memory");
    #pragma unroll
    for(int i=0;i<4;++i){const int row=i*8+(lane>>3),ch=lane&7; const u32x4 v=*(const u32x4*)(stg+row*64+ch*8); ATTN_STORE16(Ow+(long)row*DM+ch*8,v);} }
  asm volatile("s_waitcnt lgkmcnt(0)\n\ts_barrier":::"memory");
  #undef DMA_K
  #undef DMA_V
  #undef CMASK
  #undef START
  #undef RESC
  #undef ROT
}
constexpr int ATTN_LDS_BYTES=LDS_BYTES;
#undef SBAR
#undef WAIT_BAR
}

constexpr int NWAVES = 8;
constexpr int NB = 8, SEQ = 4096, CTXL = 256, TB = SEQ + CTXL  , MT = NB * TB  , DMODEL = 1024;
constexpr int NMODC = 6 * DMODEL, MODROWS = 9;
constexpr int QKVN = 1536, WINN = 3104, WINP = 3328;
constexpr int NEXP = 32, TOPK = 4, MPAD = MT * TOPK + NEXP * 256;
constexpr int NLAYER = 4;
constexpr float RMS_EPS = 1e-6f;
constexpr float ATT_C2 = 0.125f * 1.4426950408889634f;

constexpr size_t MiB = 1u << 20;
constexpr size_t WS_CTL = 0, CTL_ZERO_BYTES = 1 * MiB;
constexpr size_t WS_MOD = 1 * MiB, WS_ROPE = 2 * MiB, WS_MODP = 3 * MiB;
constexpr size_t WS_SLOT = 17 * MiB, WS_GATEW = 18 * MiB, WS_SLOTPOS = 19 * MiB;
constexpr size_t WS_WQKV = 20 * MiB, WS_WOA = 26 * MiB, WS_WIN = 30 * MiB, WS_WOG = 43 * MiB, WS_WGU = 48 * MiB, WS_WDN = 560 * MiB;
constexpr size_t WS_X = 816 * MiB, WS_XN = 952 * MiB, WS_Q = 1020 * MiB, WS_K = 1088 * MiB, WS_V = 1105 * MiB, WS_G = 1122 * MiB;
constexpr size_t WS_OF = 1343 * MiB, WS_OB = 1479 * MiB, WS_XG = 1615 * MiB, WS_ACT = 1903 * MiB, WS_Y = 2191 * MiB, WS_PAR = 2479 * MiB, WS_LIST = 2483 * MiB  , WS_END = 2488 * MiB;
static_assert(WS_MODP + (size_t)16 * NLAYER * MODROWS * NMODC * 4 <= WS_SLOT && WS_WIN + (size_t)2 * WINP * 1024 * 2 <= WS_WOG && WS_G + (size_t)MT * WINP * 2 <= WS_OF && WS_XG + (size_t)MPAD * 1024 * 2 <= WS_ACT, "ws map");
constexpr int CW_TMO = 0, CW_BAR = 4096, CW_CNT = 16384;

constexpr int RING_OFF = 0, RING_BYTES = 131072;
constexpr int WR_STRIDE = 1028;
constexpr int LDS_AUX = 133120;
constexpr int AUX_LCNT = LDS_AUX, AUX_GB = LDS_AUX + 128, AUX_T2E = LDS_AUX + 256  , AUX_BASE = AUX_T2E + 2560  , AUX_NT = AUX_BASE + 128, AUX_CNT = AUX_NT + 64  , AUX_ENT = AUX_CNT + 128  , AUX_RS = AUX_ENT + 4352  , AUX_ROWTAB = AUX_RS + 576, ROWTAB_UNITS = 18  ;
constexpr int MISC_OFF = 154624;
constexpr int LDS_BYTES = 155648;
static_assert(AUX_ROWTAB + ROWTAB_UNITS * 512 <= MISC_OFF, "LDS map");

#define GAS __attribute__((address_space(1)))
#define LAS __attribute__((address_space(3)))
typedef unsigned short bf16;
typedef unsigned v4u __attribute__((ext_vector_type(4)));
typedef float f32x4 __attribute__((ext_vector_type(4)));
typedef short bf16x8 __attribute__((ext_vector_type(8)));
typedef GAS unsigned gu32;
typedef GAS unsigned long long gu64;
#define RLX_AGENT __ATOMIC_RELAXED, __HIP_MEMORY_SCOPE_AGENT
#define LDS_WAIT() asm volatile("s_waitcnt lgkmcnt(0)" ::: "memory")
#define VM_WAIT() asm volatile("s_waitcnt vmcnt(0)" ::: "memory")
__device__ __forceinline__ unsigned long long rt() { return __builtin_amdgcn_s_memrealtime(); }
__device__ __forceinline__ unsigned f2bf(float f) { unsigned u = __builtin_bit_cast(unsigned, f); return (u + 0x7fffu + ((u >> 16) & 1u)) >> 16; }
__device__ __forceinline__ unsigned pk2(float lo, float hi) { return f2bf(lo) | (f2bf(hi) << 16); }

#define XB_TMO      128
#define XB_XCNT(j)  (256  + 64 * (j))
#define XB_XSUB(j)  (1280 + 64 * (j))
#define XB_XGEN(j)  (2304 + 64 * (j))
#define XB_TOP      3328
#define XB_TOPGEN   3392
#define XCD_BAR_WORDS 3456
#define XB_SPIN_CAP (1u << 18)

__device__ __forceinline__ unsigned xb_ld(unsigned* p)              { return __hip_atomic_load(p, __ATOMIC_RELAXED, __HIP_MEMORY_SCOPE_AGENT); }
__device__ __forceinline__ unsigned xb_add(unsigned* p, unsigned v) { return __hip_atomic_fetch_add(p, v, __ATOMIC_RELAXED, __HIP_MEMORY_SCOPE_AGENT); }
__device__ __forceinline__ unsigned xb_xcc_id() { return (unsigned)__builtin_amdgcn_s_getreg((3 << 11) | 20) & 0xFu; }
#define XB_SPIN(cond, bar) do { unsigned _sp = 0; while (cond) { __builtin_amdgcn_s_sleep(1); \
    if ((++_sp & 255u) == 0u) { if (xb_ld(&(bar)[XB_TMO])) break; if (_sp > XB_SPIN_CAP) { atomicAdd(&(bar)[XB_TMO], 1u); break; } } } } while (0)

struct XcdBarrier {
    unsigned* bar; unsigned x;
    volatile LAS unsigned* st;
};

__device__ __forceinline__ XcdBarrier xcd_barrier_post(unsigned* bar, volatile LAS unsigned* st, bool xb_t0  ) {
    XcdBarrier b; b.bar = bar; b.x = xb_xcc_id(); b.st = st;
    if (xb_t0) (void)xb_add(&bar[XB_XCNT(b.x)], 1u);
    return b;
}
__device__ __forceinline__ void xcd_barrier_complete(unsigned* bar, unsigned x, unsigned& nloc, unsigned& nx) {
    const unsigned G = gridDim.x * gridDim.y * gridDim.z;
    unsigned sum, cnt, mine, sp = 0u;
    for (;;) {
        sum = 0u; cnt = 0u; mine = 0u;
#pragma unroll
        for (unsigned j = 0; j < 16; ++j) { const unsigned c = xb_ld(&bar[XB_XCNT(j)]); sum += c; cnt += (c > 0u) ? 1u : 0u; mine = (j == x) ? c : mine; }
        if (sum == G) break;
        __builtin_amdgcn_s_sleep(1);
        if ((++sp & 255u) == 0u) { if (xb_ld(&bar[XB_TMO])) break; if (sp > XB_SPIN_CAP) { atomicAdd(&bar[XB_TMO], 1u); break; } }
    }
    nloc = mine > 0u ? mine : 1u; nx = cnt > 0u ? cnt : 1u;
}

__device__ __forceinline__ void xcd_barrier(const XcdBarrier& b, bool xb_t0  ) {
    asm volatile("s_waitcnt vmcnt(0)" ::: "memory");
    __syncthreads();
    if (xb_t0) {
        unsigned* bar = b.bar;
        __builtin_amdgcn_s_waitcnt(0);
        unsigned nloc = b.st[0], nx = b.st[1];
        if (nloc == 0u) { xcd_barrier_complete(bar, b.x, nloc, nx); b.st[0] = nloc; b.st[1] = nx; }
        const unsigned old = xb_add(&bar[XB_XSUB(b.x)], 1u);
        const unsigned gen = old / nloc;
        if (old + 1u == (gen + 1u) * nloc) {
            __builtin_amdgcn_fence(__ATOMIC_RELEASE, "agent");
            asm volatile("s_waitcnt vmcnt(0)" ::: "memory");
            const unsigned og = xb_add(&bar[XB_TOP], 1u);
            const unsigned tg = og / nx;
            if (og + 1u == (tg + 1u) * nx) xb_add(&bar[XB_TOPGEN], 1u);
            else XB_SPIN(xb_ld(&bar[XB_TOPGEN]) == tg, bar);
            __builtin_amdgcn_fence(__ATOMIC_ACQUIRE, "agent");
            xb_add(&bar[XB_XGEN(b.x)], 1u);
            asm volatile("s_waitcnt vmcnt(0)" ::: "memory");
        } else {
            XB_SPIN(xb_ld(&bar[XB_XGEN(b.x)]) == gen, bar);
            __builtin_amdgcn_fence(__ATOMIC_ACQUIRE, "agent");
            asm volatile("s_waitcnt vmcnt(0)" ::: "memory");
        }
    }
    __syncthreads();
}

typedef float f32x2 __attribute__((ext_vector_type(2)));
using pg8::lane_now; using pg8::shx;
__device__ __forceinline__ float wave_sum(float v) {
    const int ln = lane_now();
#pragma unroll
    for (int o = 1; o < 64; o <<= 1) v += shx(v, o, ln);
    return v;
}
__device__ __forceinline__ float wave_max(float v) {
    const int ln = lane_now();
#pragma unroll
    for (int o = 1; o < 64; o <<= 1) v = fmaxf(v, shx(v, o, ln));
    return v;
}
__device__ __forceinline__ float bf2f(unsigned short h) { return __uint_as_float((unsigned)h << 16); }
__device__ __forceinline__ float silu_f(float x) { return x / (1.0f + __expf(-x)); }
__device__ __forceinline__ f32x4 bf4_to_f32(unsigned long long v) { return (f32x4){__uint_as_float((unsigned)(v & 0xffffu) << 16), __uint_as_float((unsigned)(v >> 16) << 16), __uint_as_float((unsigned)((v >> 32) & 0xffffu) << 16), __uint_as_float((unsigned)(v >> 48) << 16)}; }
__device__ __forceinline__ unsigned long long f32_to_bf4(f32x4 y) { return (unsigned long long)pk2(y.x, y.y) | ((unsigned long long)pk2(y.z, y.w) << 32); }
__device__ __forceinline__ int mod_row(int m) { const int b = m / TB; return (m - b * TB < CTXL) ? 8 : b; }

__device__ __forceinline__ void transpose_item(const float* W, int K, int N, bf16* WT, int k0, int n0, int dst_row0, LAS float* scr, int lane) {
#pragma unroll 8
    for (int i = 0; i < 32; ++i) { const int kk = 2 * i + (lane >> 5); scr[kk * 33 + (lane & 31)] = W[(size_t)(k0 + kk) * N + n0 + (lane & 31)]; }
    LDS_WAIT(); asm volatile("" ::: "memory");
    const int c = lane & 7;
#pragma unroll
    for (int j = 0; j < 4; ++j) { const int n = (lane >> 3) + 8 * j; const LAS float* s = scr + (8 * c) * 33 + n;
        v4u o; o.x = pk2(s[0 * 33], s[1 * 33]); o.y = pk2(s[2 * 33], s[3 * 33]); o.z = pk2(s[4 * 33], s[5 * 33]); o.w = pk2(s[6 * 33], s[7 * 33]);
        *(GAS v4u*)(WT + (size_t)(dst_row0 + n) * K + k0 + 8 * c) = o; }
    LDS_WAIT(); asm volatile("" ::: "memory");
}

struct Args { const float* in[25]; float* out; unsigned char* ws; int ph_lo, ph_hi; };
constexpr int P_N1G = 0, P_N2G = 4096, P_QG = 8192, P_KG = 8320, P_GKF = 8448, P_GKB = 24832, P_BGF = 41216, P_BGB = 42240, P_OG = 43264, P_WR = 43776, P_BR = 174848, P_BGU = 174976, P_BDN = 437120, P_END = 568192;
#define LAUNDER_S(p) asm volatile("" : "+s"(p))
#define LAUNDER_V(p) asm volatile("" : "+v"(p))
#define PARF(ws) ((const float*)((ws) + WS_PAR))

__device__ __forceinline__ void p0_prologue(const Args& A, LAS unsigned char* lds, int gw, int NGW, int wave, int lane) {
    unsigned char* ws = A.ws;
    LAS float* scr = (LAS float*)(lds + RING_OFF + wave * 16384);
    constexpr int I_QKV = 2 * 16 * (QKVN / 32), I_WO = 2 * 16 * 32, I_WIN = 2 * 16 * (WINN / 32), I_GU = 128 * 16 * 64, I_DN = 128 * 16 * 32;
    constexpr int NITEMS = I_GU + I_DN + I_QKV + I_WO + I_WIN + I_WO;
    for (int it = gw; it < NITEMS; it += NGW) {
        int r = it;
        if (r < I_GU) { const int mat = r / (16 * 64), q = r - mat * (16 * 64), kb = q / 64, nb = q - kb * 64, n0 = nb * 32;
            const int dst = ((n0 & 1023) >> 7) * 256 + (n0 >> 10) * 128 + (n0 & 127);
            transpose_item(A.in[21] + (size_t)mat * 1024 * 2048, 1024, 2048, (bf16*)(ws + WS_WGU) + (size_t)mat * 2048 * 1024, kb * 64, n0, dst, scr, lane); continue; } r -= I_GU;
        if (r < I_DN) { const int mat = r / (16 * 32), q = r - mat * (16 * 32), kb = q / 32, nb = q - kb * 32;
            transpose_item(A.in[23] + (size_t)mat * 1024 * 1024, 1024, 1024, (bf16*)(ws + WS_WDN) + (size_t)mat * 1024 * 1024, kb * 64, nb * 32, nb * 32, scr, lane); continue; } r -= I_DN;
        if (r < I_QKV) { const int per = 16 * (QKVN / 32), mat = r / per, q = r - mat * per, kb = q / (QKVN / 32), nb = q - kb * (QKVN / 32);
            const int n0 = nb * 32, dst = (n0 & ~255) + ((n0 >> 5) & 1) * 128 + ((n0 >> 6) & 3) * 32;
            transpose_item(A.in[8] + (size_t)mat * 1024 * QKVN, 1024, QKVN, (bf16*)(ws + WS_WQKV) + (size_t)mat * QKVN * 1024, kb * 64, n0, dst, scr, lane); continue; } r -= I_QKV;
        if (r < I_WO) { const int mat = r / 512, q = r - mat * 512, kb = q / 32, nb = q - kb * 32;
            transpose_item(A.in[11] + (size_t)mat * 1024 * 1024, 1024, 1024, (bf16*)(ws + WS_WOA) + (size_t)mat * 1024 * 1024, kb * 64, nb * 32, nb * 32, scr, lane); continue; } r -= I_WO;
        if (r < I_WIN) { const int per = 16 * (WINN / 32), mat = r / per, q = r - mat * per, kb = q / (WINN / 32), nb = q - kb * (WINN / 32);
            transpose_item(A.in[12] + (size_t)mat * 1024 * WINN, 1024, WINN, (bf16*)(ws + WS_WIN) + (size_t)mat * WINP * 1024, kb * 64, nb * 32, nb * 32, scr, lane); continue; } r -= I_WIN;
        { const int mat = r / 512, q = r - mat * 512, kb = q / 32, nb = q - kb * 32;
            transpose_item(A.in[18] + (size_t)mat * 1024 * 1024, 1024, 1024, (bf16*)(ws + WS_WOG) + (size_t)mat * 1024 * 1024, kb * 64, nb * 32, nb * 32, scr, lane); }
    }
    for (int it = gw; it < 2 * (WINP - WINN); it += NGW) { const int mat = it / (WINP - WINN), rr = WINN + it - mat * (WINP - WINN);
        GAS v4u* p = (GAS v4u*)((bf16*)(ws + WS_WIN) + ((size_t)mat * WINP + rr) * 1024) + lane; p[0] = (v4u){0u, 0u, 0u, 0u}; p[64] = (v4u){0u, 0u, 0u, 0u}; }
    for (int it = gw; it < NLAYER * 24 * 16; it += NGW) {
        const int l = it / (24 * 16), q = it - l * (24 * 16), cg = q / 16, kc = q - cg * 16;
        float s[MODROWS];
#pragma unroll
        for (int r = 0; r < MODROWS; ++r) { const float cv = (r < 8) ? A.in[1][r * 1024 + kc * 64 + lane] : A.in[3][kc * 64 + lane]; s[r] = silu_f(cv); }
        f32x4 acc[MODROWS];
#pragma unroll
        for (int r = 0; r < MODROWS; ++r) acc[r] = (f32x4){0.f, 0.f, 0.f, 0.f};
        const float* wp = A.in[4] + ((size_t)l * 1024 + kc * 64) * NMODC + cg * 256 + 4 * lane;
#pragma unroll 4
        for (int kk = 0; kk < 64; ++kk) { const f32x4 w = *(const f32x4*)(wp + (size_t)kk * NMODC);
#pragma unroll
            for (int r = 0; r < MODROWS; ++r) { const float sv = __shfl(s[r], kk); acc[r] = acc[r] + w * sv; } }
        float* op = (float*)(ws + WS_MODP) + (size_t)kc * (NLAYER * MODROWS * NMODC) + (size_t)l * MODROWS * NMODC + cg * 256 + 4 * lane;
#pragma unroll
        for (int r = 0; r < MODROWS; ++r) *(f32x4*)(op + (size_t)r * NMODC) = acc[r];
    }
    for (int m = gw; m < MT; m += NGW) { const int b = m / TB, w = m - b * TB;
        const float* src = (w < CTXL) ? A.in[2] + ((size_t)b * CTXL + w) * 1024 : A.in[0] + ((size_t)b * SEQ + (w - CTXL)) * 1024;
        const GAS f32x4* sp = (const GAS f32x4*)src + lane; GAS unsigned long long* dp = (GAS unsigned long long*)((bf16*)(ws + WS_X) + (size_t)m * 1024) + lane;
#pragma unroll
        for (int j = 0; j < 4; ++j) dp[64 * j] = f32_to_bf4(sp[64 * j]); }
    { float* par = (float*)(ws + WS_PAR); const int gt = gw * 64 + lane, NGT = NGW * 64;
#define CPY(src, n, off) for (int i = gt; i < (n); i += NGT) par[(off) + i] = A.in[src][i];
      CPY(6, 4096, P_N1G) CPY(7, 4096, P_N2G) CPY(9, 128, P_QG) CPY(10, 128, P_KG) CPY(13, 16384, P_GKF) CPY(15, 16384, P_GKB) CPY(14, 1024, P_BGF) CPY(16, 1024, P_BGB)
      CPY(17, 512, P_OG) CPY(19, 131072, P_WR) CPY(20, 128, P_BR) CPY(22, 262144, P_BGU) CPY(24, 131072, P_BDN)
#undef CPY
    }
    for (int idx = gw * 64 + lane; idx < SEQ * 32; idx += NGW * 64) { const int s = idx >> 5, i = idx & 31;
        const float invf = 1.0f / powf(10000.0f, (float)(i & 15) * (1.0f / 16.0f));
        const float ang = (float)((i < 16) ? (s >> 6) : (s & 63)) * invf;
        ((float*)(ws + WS_ROPE))[idx] = cosf(ang); ((float*)(ws + WS_ROPE))[SEQ * 32 + idx] = sinf(ang); }
}
__device__ __forceinline__ void p1_mod_reduce(const Args& A, int gtid, int NGT) {
    const float* P = (const float*)(A.ws + WS_MODP); float* Mo = (float*)(A.ws + WS_MOD);
    constexpr int N = NLAYER * MODROWS * NMODC;
    for (int i = gtid; i < N; i += NGT) { const int l = i / (MODROWS * NMODC), c = i % NMODC; float s = A.in[5][l * NMODC + c];
#pragma unroll
        for (int k = 0; k < 16; ++k) s += P[(size_t)k * N + i];
        Mo[i] = s; }
}
__device__ __forceinline__ void modulate_row(const bf16* xrow, const float* ng, const float* shp, const float* scp, bf16* orow, int lane, f32x4 (&y)[4], float& rs_out) {
    const GAS unsigned long long* xr = (const GAS unsigned long long*)xrow + lane;
    float ss = 0.f;
#pragma unroll
    for (int j = 0; j < 4; ++j) { y[j] = bf4_to_f32(xr[64 * j]); ss += (y[j].x * y[j].x + y[j].y * y[j].y) + (y[j].z * y[j].z + y[j].w * y[j].w); }
    const float rs = 1.0f / sqrtf(wave_sum(ss) * (1.0f / 1024.0f) + RMS_EPS); rs_out = rs;
    GAS unsigned long long* o8 = (GAS unsigned long long*)orow + lane;
#pragma unroll
    for (int j = 0; j < 4; ++j) { const f32x4 g = ((const GAS f32x4*)ng)[64 * j + lane], sh = ((const GAS f32x4*)shp)[64 * j + lane], sc = ((const GAS f32x4*)scp)[64 * j + lane];
        y[j] = (y[j] * rs) * g * (sc + 1.0f) + sh;
        o8[64 * j] = (unsigned long long)pk2(y[j].x, y[j].y) | ((unsigned long long)pk2(y[j].z, y[j].w) << 32); }
}
__device__ __forceinline__ void modulate_row2(const bf16* xa, const bf16* xb, const float* ng, const float* sha, const float* sca, const float* shb, const float* scb, bf16* oa, bf16* ob, int lane, float& rsa, float& rsb) {
    const GAS unsigned long long* pa = (const GAS unsigned long long*)xa + lane; const GAS unsigned long long* pb = (const GAS unsigned long long*)xb + lane;
    unsigned long long ra[4], rb[4];
#pragma unroll
    for (int j = 0; j < 4; ++j) { ra[j] = pa[64 * j]; rb[j] = pb[64 * j]; }
    f32x4 ya[4], yb[4]; float sa = 0.f, sb = 0.f;
#pragma unroll
    for (int j = 0; j < 4; ++j) { ya[j] = bf4_to_f32(ra[j]); yb[j] = bf4_to_f32(rb[j]); sa += (ya[j].x * ya[j].x + ya[j].y * ya[j].y) + (ya[j].z * ya[j].z + ya[j].w * ya[j].w); sb += (yb[j].x * yb[j].x + yb[j].y * yb[j].y) + (yb[j].z * yb[j].z + yb[j].w * yb[j].w); }
    const int ln = lane_now();
#pragma unroll
    for (int o = 1; o < 64; o <<= 1) { sa += shx(sa, o, ln); sb += shx(sb, o, ln); }
    rsa = 1.0f / sqrtf(sa * (1.0f / 1024.0f) + RMS_EPS); rsb = 1.0f / sqrtf(sb * (1.0f / 1024.0f) + RMS_EPS);
    GAS unsigned long long* qa = (GAS unsigned long long*)oa + lane; GAS unsigned long long* qb = (GAS unsigned long long*)ob + lane;
#pragma unroll
    for (int j = 0; j < 4; ++j) { const f32x4 g = ((const GAS f32x4*)ng)[64 * j + lane];
        const f32x4 ha = ((const GAS f32x4*)sha)[64 * j + lane], ca = ((const GAS f32x4*)sca)[64 * j + lane], hb = ((const GAS f32x4*)shb)[64 * j + lane], cb = ((const GAS f32x4*)scb)[64 * j + lane];
        qa[64 * j] = f32_to_bf4((ya[j] * rsa) * g * (ca + 1.0f) + ha); qb[64 * j] = f32_to_bf4((yb[j] * rsb) * g * (cb + 1.0f) + hb); }
}
__device__ __forceinline__ void phase_modulate1(unsigned char* ws, int layer, int gw, int NGW, int lane) {
    const bf16* X = (const bf16*)(ws + WS_X); bf16* XN = (bf16*)(ws + WS_XN);
    const float* ng = PARF(ws) + P_N1G + layer * 1024; const float* Mo = (const float*)(ws + WS_MOD) + (size_t)layer * MODROWS * NMODC;
    for (int m = gw; m < MT; m += NGW) { const int mr = mod_row(m); f32x4 y[4]; float rs;
        modulate_row(X + (size_t)m * 1024, ng, Mo + (size_t)mr * NMODC + 0 * 1024, Mo + (size_t)mr * NMODC + 1 * 1024, XN + (size_t)m * 1024, lane, y, rs); }
}
__device__ __forceinline__ void phase_qknorm_rope(unsigned char* ws, int la, int gw, int NGW, int lane) {
    bf16* Qb = (bf16*)(ws + WS_Q); bf16* Kb = (bf16*)(ws + WS_K);
    const float* qg = PARF(ws) + P_QG + la * 64; const float* kg = PARF(ws) + P_KG + la * 64; const float* ropec = (const float*)(ws + WS_ROPE); const float* ropes = ropec + SEQ * 32;
    const int i = lane & 31, hs = lane >> 5;
    for (int m = gw; m < MT; m += NGW) { const int b = m / TB, w = m - b * TB; const bool lat = w >= CTXL;
        float cs = 1.f, sn = 0.f; if (lat) { cs = ropec[(w - CTXL) * 32 + i]; sn = ropes[(w - CTXL) * 32 + i]; }
#pragma unroll 2
        for (int hh = 0; hh < 20; hh += 2) { const int hd = hh + hs;
            unsigned* p = (hd < 16) ? (unsigned*)(Qb + (size_t)m * 1024 + hd * 64) + i : (unsigned*)(Kb + (size_t)m * 256 + (hd - 16) * 64) + i;
            const float* gp = (hd < 16) ? qg : kg; const float scl = (hd < 16) ? ATT_C2 : 1.0f;
            const unsigned v = *p; const float x1 = __uint_as_float(v << 16), x2 = __uint_as_float(v & 0xffff0000u);
            float ss = x1 * x1 + x2 * x2;
#pragma unroll
            for (int o = 1; o < 32; o <<= 1) ss += shx(ss, o, lane);
            const float rs = 1.0f / sqrtf(ss * (1.0f / 64.0f) + RMS_EPS);
            const float y1 = x1 * rs * gp[2 * i], y2 = x2 * rs * gp[2 * i + 1];
            const float r1 = (y1 * cs - y2 * sn) * scl, r2 = (y1 * sn + y2 * cs) * scl;
            *p = pk2(r1, r2); }
    }
}
__device__ __forceinline__ void phase_gla_recurrent(unsigned char* ws, int lg, LAS unsigned char* lds, int tid) {
    const int unit = blockIdx.x; if (unit >= 128) return;
    const int half = unit & 1, dir = (unit >> 1) & 1, h = (unit >> 2) & 3, b = unit >> 4;
    const bf16* G = (const bf16*)(ws + WS_G);
    float* Oo = (float*)(ws + (dir ? WS_OB : WS_OF));
    const float* wg = PARF(ws) + (dir ? P_GKB : P_GKF) + (size_t)lg * 16 * 512; const float* bg = PARF(ws) + (dir ? P_BGB : P_BGF) + lg * 512;
    LAS float* qq = (LAS float*)(lds + RING_OFF); LAS float* kk = qq + 64 * 128; LAS float* dd = kk + 64 * 128; LAS float* vv = dd + 64 * 128;
    const int sd = tid & 127, st0 = tid >> 7;
    float wcol[16];
#pragma unroll
    for (int r = 0; r < 16; ++r) wcol[r] = wg[r * 512 + h * 128 + sd];
    const float bcol = bg[h * 128 + sd];
    const int c = tid >> 2, dq = tid & 3;
    float s[32];
#pragma unroll
    for (int j = 0; j < 32; ++j) s[j] = 0.f;
    const float qscale = 0.08838834764831845f;
    for (int ch = 0; ch < TB / 64; ++ch) {
        __syncthreads();
#pragma unroll 4
        for (int i = 0; i < 16; ++i) { const int tt = st0 + 4 * i, n = 64 * ch + tt;
            const int w = dir ? (n < CTXL ? (CTXL - 1 - n) : (TB + CTXL - 1 - n)) : n;
            const bf16* gr = G + ((size_t)b * TB + w) * WINP;
            const float qv = bf2f(gr[h * 128 + sd]) * qscale, kv = bf2f(gr[512 + h * 128 + sd]);
            const bf16* lp = gr + 3072 + dir * 16; float z = bcol;
#pragma unroll
            for (int r = 0; r < 16; ++r) z += bf2f(lp[r]) * wcol[r];
            const float ls = fminf(z, 0.f) - log1pf(__expf(-fabsf(z)));
            qq[tt * 128 + sd] = qv; kk[tt * 128 + sd] = kv; dd[tt * 128 + sd] = __expf(ls * (1.0f / 16.0f));
            vv[tt * 128 + sd] = bf2f(gr[1024 + h * 256 + half * 128 + sd]); }
        __syncthreads();
        for (int tt = 0; tt < 64; ++tt) { const int n = 64 * ch + tt; const int w = dir ? (n < CTXL ? (CTXL - 1 - n) : (TB + CTXL - 1 - n)) : n;
            const float v = vv[tt * 128 + c]; float acc = 0.f;
            const LAS f32x4* q4 = (const LAS f32x4*)(qq + tt * 128 + dq * 32); const LAS f32x4* k4 = (const LAS f32x4*)(kk + tt * 128 + dq * 32); const LAS f32x4* d4 = (const LAS f32x4*)(dd + tt * 128 + dq * 32);
#pragma unroll
            for (int j = 0; j < 8; ++j) { const f32x4 qv = q4[j], kv = k4[j], dv = d4[j];
                s[4 * j + 0] = s[4 * j + 0] * dv.x + kv.x * v; acc += qv.x * s[4 * j + 0];
                s[4 * j + 1] = s[4 * j + 1] * dv.y + kv.y * v; acc += qv.y * s[4 * j + 1];
                s[4 * j + 2] = s[4 * j + 2] * dv.z + kv.z * v; acc += qv.z * s[4 * j + 2];
                s[4 * j + 3] = s[4 * j + 3] * dv.w + kv.w * v; acc += qv.w * s[4 * j + 3]; }
            acc += shx(acc, 1, tid & 63); acc += shx(acc, 2, tid & 63);
            if (dq == 0) Oo[((size_t)b * TB + w) * 1024 + h * 256 + half * 128 + c] = acc; }
    }
}
__device__ __forceinline__ void phase_gla_readout(unsigned char* ws, int lg, int gw, int NGW, int lane) {
    const float* OF = (const float*)(ws + WS_OF); const float* OB = (const float*)(ws + WS_OB); const bf16* G = (const bf16*)(ws + WS_G); bf16* OG = (bf16*)(ws + WS_Q);
    const f32x4 og = ((const GAS f32x4*)(PARF(ws) + P_OG + lg * 256))[lane];
    for (int m = gw; m < MT; m += NGW) {
#pragma unroll
        for (int hh = 0; hh < 4; ++hh) { const size_t off = (size_t)m * 1024 + hh * 256 + 4 * lane;
            f32x4 o = *(const GAS f32x4*)(OF + off) + *(const GAS f32x4*)(OB + off);
            const float ss = wave_sum((o.x * o.x + o.y * o.y) + (o.z * o.z + o.w * o.w));
            const float rs = 1.0f / sqrtf(ss * (1.0f / 256.0f) + RMS_EPS);
            const unsigned long long rv = *(const GAS unsigned long long*)(G + (size_t)m * WINP + 2048 + hh * 256 + 4 * lane);
            const float r0 = __uint_as_float((unsigned)(rv & 0xffffu) << 16), r1 = __uint_as_float((unsigned)(rv >> 16) << 16), r2 = __uint_as_float((unsigned)((rv >> 32) & 0xffffu) << 16), r3 = __uint_as_float((unsigned)(rv >> 48) << 16);
            o = o * rs * og;
            o.x *= silu_f(r0); o.y *= silu_f(r1); o.z *= silu_f(r2); o.w *= silu_f(r3);
            *(GAS unsigned long long*)(OG + off) = (unsigned long long)pk2(o.x, o.y) | ((unsigned long long)pk2(o.z, o.w) << 32); }
    }
}
constexpr size_t WS_GQ = WS_XG, WS_GKH = WS_XG + 68 * MiB, WS_GKT = WS_XG + 136 * MiB, WS_GVT = WS_XG + 204 * MiB, WS_GDL = WS_ACT, WS_SX = WS_OF;
static_assert((size_t)2176 * 2 * 16384 <= 68 * MiB && (size_t)2176 * 256 * 64 * 2 <= 68 * MiB && (size_t)64 * 68 * 65536 <= 272 * MiB, "gla buffers");
typedef float f32x16 __attribute__((ext_vector_type(16)));
__device__ __forceinline__ float log_sigmoid_fast(float z) { return fminf(z, 0.f) - __logf(1.0f + __expf(-fabsf(z))); }

__device__ __forceinline__ void phase_gla_g0(unsigned char* ws, int lg, LAS unsigned char* lds, int tid) {
    const bf16* G = (const bf16*)(ws + WS_G);
    LAS float* tot = (LAS float*)(lds + RING_OFF);
    const int d2 = tid & 63, tb = tid >> 6;
    for (int cn = blockIdx.x; cn < 2176; cn += gridDim.x) {
        const int n = cn % 68, bh = cn / 68, h = bh & 3, b = bh >> 2;
        const size_t row0 = (size_t)b * TB + 64 * n + 8 * tb;
        float wf0[16], wf1[16], wb0[16], wb1[16];
        { const float* wgf = PARF(ws) + P_GKF + (size_t)lg * 16 * 512 + h * 128 + 2 * d2; const float* wgb = PARF(ws) + P_GKB + (size_t)lg * 16 * 512 + h * 128 + 2 * d2;
#pragma unroll
          for (int r = 0; r < 16; ++r) { const f32x2 a = *(const GAS f32x2*)(wgf + r * 512), c = *(const GAS f32x2*)(wgb + r * 512); wf0[r] = a.x; wf1[r] = a.y; wb0[r] = c.x; wb1[r] = c.y; } }
        const f32x2 bf_ = *(const GAS f32x2*)(PARF(ws) + P_BGF + lg * 512 + h * 128 + 2 * d2), bb_ = *(const GAS f32x2*)(PARF(ws) + P_BGB + lg * 512 + h * 128 + 2 * d2);
        float gf0[8], gf1[8], gb0[8], gb1[8]; unsigned qk[8][2];
#pragma unroll
        for (int j = 0; j < 8; ++j) { const bf16* gr = G + (row0 + j) * WINP;
            const v4u l0 = *(const GAS v4u*)(gr + 3072), l1 = *(const GAS v4u*)(gr + 3080), l2 = *(const GAS v4u*)(gr + 3088), l3 = *(const GAS v4u*)(gr + 3096);
            qk[j][0] = *(const GAS unsigned*)(gr + h * 128 + 2 * d2); qk[j][1] = *(const GAS unsigned*)(gr + 512 + h * 128 + 2 * d2);
            float lf[16], lb[16];
            lf[0] = __uint_as_float(l0.x << 16); lf[1] = __uint_as_float(l0.x & 0xffff0000u); lf[2] = __uint_as_float(l0.y << 16); lf[3] = __uint_as_float(l0.y & 0xffff0000u);
            lf[4] = __uint_as_float(l0.z << 16); lf[5] = __uint_as_float(l0.z & 0xffff0000u); lf[6] = __uint_as_float(l0.w << 16); lf[7] = __uint_as_float(l0.w & 0xffff0000u);
            lf[8] = __uint_as_float(l1.x << 16); lf[9] = __uint_as_float(l1.x & 0xffff0000u); lf[10] = __uint_as_float(l1.y << 16); lf[11] = __uint_as_float(l1.y & 0xffff0000u);
            lf[12] = __uint_as_float(l1.z << 16); lf[13] = __uint_as_float(l1.z & 0xffff0000u); lf[14] = __uint_as_float(l1.w << 16); lf[15] = __uint_as_float(l1.w & 0xffff0000u);
            lb[0] = __uint_as_float(l2.x << 16); lb[1] = __uint_as_float(l2.x & 0xffff0000u); lb[2] = __uint_as_float(l2.y << 16); lb[3] = __uint_as_float(l2.y & 0xffff0000u);
            lb[4] = __uint_as_float(l2.z << 16); lb[5] = __uint_as_float(l2.z & 0xffff0000u); lb[6] = __uint_as_float(l2.w << 16); lb[7] = __uint_as_float(l2.w & 0xffff0000u);
            lb[8] = __uint_as_float(l3.x << 16); lb[9] = __uint_as_float(l3.x & 0xffff0000u); lb[10] = __uint_as_float(l3.y << 16); lb[11] = __uint_as_float(l3.y & 0xffff0000u);
            lb[12] = __uint_as_float(l3.z << 16); lb[13] = __uint_as_float(l3.z & 0xffff0000u); lb[14] = __uint_as_float(l3.w << 16); lb[15] = __uint_as_float(l3.w & 0xffff0000u);
            float zf0 = bf_.x, zf1 = bf_.y, zb0 = bb_.x, zb1 = bb_.y;
#pragma unroll
            for (int r = 0; r < 16; ++r) { zf0 += lf[r] * wf0[r]; zf1 += lf[r] * wf1[r]; zb0 += lb[r] * wb0[r]; zb1 += lb[r] * wb1[r]; }
            gf0[j] = log_sigmoid_fast(zf0) * 0.0625f; gf1[j] = log_sigmoid_fast(zf1) * 0.0625f; gb0[j] = log_sigmoid_fast(zb0) * 0.0625f; gb1[j] = log_sigmoid_fast(zb1) * 0.0625f; }
#pragma unroll
        for (int j = 1; j < 8; ++j) { gf0[j] += gf0[j - 1]; gf1[j] += gf1[j - 1]; gb0[7 - j] += gb0[8 - j]; gb1[7 - j] += gb1[8 - j]; }
        __syncthreads();
        *(LAS f32x2*)(tot + (0 * 8 + tb) * 128 + 2 * d2) = (f32x2){gf0[7], gf1[7]}; *(LAS f32x2*)(tot + (1 * 8 + tb) * 128 + 2 * d2) = (f32x2){gb0[0], gb1[0]};
        __syncthreads();
        float pf0 = 0.f, pf1 = 0.f, pb0 = 0.f, pb1 = 0.f, lf0 = 0.f, lf1 = 0.f, lb0 = 0.f, lb1 = 0.f;
#pragma unroll
        for (int q = 0; q < 8; ++q) { const f32x2 a = *(const LAS f32x2*)(tot + (0 * 8 + q) * 128 + 2 * d2), c = *(const LAS f32x2*)(tot + (1 * 8 + q) * 128 + 2 * d2);
            lf0 += a.x; lf1 += a.y; lb0 += c.x; lb1 += c.y;
            if (q < tb) { pf0 += a.x; pf1 += a.y; } if (q > tb) { pb0 += c.x; pb1 += c.y; } }
        const size_t itf = (size_t)cn * 2, itb = itf + 1;
        bf16* Qf = (bf16*)(ws + WS_GQ) + itf * 8192; bf16* Qb = Qf + 8192; bf16* Kf = (bf16*)(ws + WS_GKH) + itf * 8192; bf16* Kb = Kf + 8192;
        const float elf0 = __expf(lf0), elf1 = __expf(lf1), elb0 = __expf(lb0), elb1 = __expf(lb1);
        float ktf0[8], ktf1[8], ktb0[8], ktb1[8];
#pragma unroll
        for (int j = 0; j < 8; ++j) { const int t = 8 * tb + j;
            const float q0 = __uint_as_float(qk[j][0] << 16) * 0.08838834764831845f, q1 = __uint_as_float(qk[j][0] & 0xffff0000u) * 0.08838834764831845f;
            const float k0 = __uint_as_float(qk[j][1] << 16), k1 = __uint_as_float(qk[j][1] & 0xffff0000u);
            const float ef0 = __expf(pf0 + gf0[j]), ef1 = __expf(pf1 + gf1[j]), eb0 = __expf(pb0 + gb0[j]), eb1 = __expf(pb1 + gb1[j]);
            const float rf0 = __builtin_amdgcn_rcpf(ef0), rf1 = __builtin_amdgcn_rcpf(ef1), rb0 = __builtin_amdgcn_rcpf(eb0), rb1 = __builtin_amdgcn_rcpf(eb1);
            *(GAS unsigned*)(Qf + t * 128 + 2 * d2) = pk2(q0 * ef0, q1 * ef1); *(GAS unsigned*)(Qb + t * 128 + 2 * d2) = pk2(q0 * eb0, q1 * eb1);
            *(GAS unsigned*)(Kf + t * 128 + 2 * d2) = pk2(k0 * rf0, k1 * rf1); *(GAS unsigned*)(Kb + t * 128 + 2 * d2) = pk2(k0 * rb0, k1 * rb1);
            ktf0[j] = k0 * rf0 * elf0; ktf1[j] = k1 * rf1 * elf1; ktb0[j] = k0 * rb0 * elb0; ktb1[j] = k1 * rb1 * elb1; }
        {
          unsigned char* Tf = ws + WS_GKT + itf * 16384 + (size_t)((((tb >> 1) * 4 + (d2 >> 4)) * 64 + ((2 * d2) & 31)) * 16 + 8 * (tb & 1)); unsigned char* Tb = Tf + 16384;
          *(GAS unsigned long long*)(Tf) = (unsigned long long)pk2(ktf0[0], ktf0[1]) | ((unsigned long long)pk2(ktf0[2], ktf0[3]) << 32);
          *(GAS unsigned long long*)(Tf + 512) = (unsigned long long)pk2(ktf0[4], ktf0[5]) | ((unsigned long long)pk2(ktf0[6], ktf0[7]) << 32);
          *(GAS unsigned long long*)(Tf + 16) = (unsigned long long)pk2(ktf1[0], ktf1[1]) | ((unsigned long long)pk2(ktf1[2], ktf1[3]) << 32);
          *(GAS unsigned long long*)(Tf + 528) = (unsigned long long)pk2(ktf1[4], ktf1[5]) | ((unsigned long long)pk2(ktf1[6], ktf1[7]) << 32);
          *(GAS unsigned long long*)(Tb) = (unsigned long long)pk2(ktb0[0], ktb0[1]) | ((unsigned long long)pk2(ktb0[2], ktb0[3]) << 32);
          *(GAS unsigned long long*)(Tb + 512) = (unsigned long long)pk2(ktb0[4], ktb0[5]) | ((unsigned long long)pk2(ktb0[6], ktb0[7]) << 32);
          *(GAS unsigned long long*)(Tb + 16) = (unsigned long long)pk2(ktb1[0], ktb1[1]) | ((unsigned long long)pk2(ktb1[2], ktb1[3]) << 32);
          *(GAS unsigned long long*)(Tb + 528) = (unsigned long long)pk2(ktb1[4], ktb1[5]) | ((unsigned long long)pk2(ktb1[6], ktb1[7]) << 32); }
        if (tb == 0) { float* DLp = (float*)(ws + WS_GDL) + itf * 128 + 2 * d2; *(GAS f32x2*)DLp = (f32x2){elf0, elf1}; *(GAS f32x2*)(DLp + 128) = (f32x2){elb0, elb1}; }
        {
            const int dv = tid & 255, th = tid >> 8; const bf16* vp = G + ((size_t)b * TB + 64 * n + 32 * th) * WINP + 1024 + h * 256 + dv;
            unsigned wv[16];
#pragma unroll
            for (int j = 0; j < 16; ++j) wv[j] = (unsigned)vp[(size_t)(2 * j) * WINP] | ((unsigned)vp[(size_t)(2 * j + 1) * WINP] << 16);
            unsigned char* vo = ws + WS_GVT + (size_t)cn * 32768 + (size_t)(((2 * th) * 8 + (dv >> 5)) * 64 + (dv & 31)) * 16;
#pragma unroll
            for (int ql = 0; ql < 2; ++ql)
#pragma unroll
                for (int hq = 0; hq < 2; ++hq) *(GAS v4u*)(vo + ql * 8192 + hq * 512) = (v4u){wv[8 * ql + 2 * hq], wv[8 * ql + 2 * hq + 1], wv[8 * ql + 2 * hq + 4], wv[8 * ql + 2 * hq + 5]}; }
    }
}
struct G12Ops { bf16x8 a[4], b[4]; f32x4 d[4]; };
__device__ __forceinline__ void g12_load(G12Ops& o, unsigned char* ws, int bh, int dir, int m, int kb, int vb, int r, int hh) {
    const int n = dir ? (m < 4 ? 3 - m : 71 - m) : m; const size_t cn = (size_t)bh * 68 + n, item = cn * 2 + dir;
    const GAS bf16x8* ap = (const GAS bf16x8*)(ws + WS_GKT + item * 16384) + kb * 64 + (hh * 32 + r);
    const GAS bf16x8* bp = (const GAS bf16x8*)(ws + WS_GVT + cn * 32768) + vb * 64 + (hh * 32 + r);
    const float* dp = (const float*)(ws + WS_GDL) + item * 128 + 32 * kb + 4 * hh;
#pragma unroll
    for (int ks = 0; ks < 4; ++ks) { o.a[ks] = ap[ks * 256]; o.b[ks] = bp[ks * 512]; o.d[ks] = *(const GAS f32x4*)(dp + 8 * ks); }
}
__device__ __forceinline__ void phase_gla_g12(unsigned char* ws, LAS unsigned char* lds, int gwv, int wave, int lane) {
    if (gwv >= 2048) return;
    const int chain = gwv >> 5, blk = gwv & 31, kb = blk & 3, vb = blk >> 2, dir = chain & 1, bh = chain >> 1;
    const int r = lane & 31, hh = lane >> 5;
    LAS unsigned char* wl = lds + RING_OFF + wave * 2048;
    f32x16 acc;
#pragma unroll
    for (int g = 0; g < 16; ++g) acc[g] = 0.f;
    G12Ops o0, o1, o2;
    g12_load(o0, ws, bh, dir, 0, kb, vb, r, hh); g12_load(o1, ws, bh, dir, 1, kb, vb, r, hh);
#define G12_STEP(CUR, m_) do { const int mm_ = (m_); const int n = dir ? (mm_ < 4 ? 3 - mm_ : 71 - mm_) : mm_; \
        _Pragma("unroll") for (int gg = 0; gg < 4; ++gg) *(LAS unsigned long long*)(wl + (((gg >> 1) * 64 + (gg & 1) * 32 + r) * 16 + 8 * hh)) = (unsigned long long)pk2(acc[4 * gg], acc[4 * gg + 1]) | ((unsigned long long)pk2(acc[4 * gg + 2], acc[4 * gg + 3]) << 32); \
        LDS_WAIT(); const v4u s0 = *(const LAS v4u*)(wl + lane * 16), s1 = *(const LAS v4u*)(wl + 1024 + lane * 16); LDS_WAIT(); \
        { bf16* sp = (bf16*)(ws + WS_SX) + ((size_t)(bh * 2 + dir) * 68 + n) * 32768 + (size_t)(kb * 8 + vb) * 1024; ((GAS v4u*)sp)[lane] = s0; ((GAS v4u*)sp)[64 + lane] = s1; } \
        _Pragma("unroll") for (int gg = 0; gg < 4; ++gg) { acc[4 * gg] *= CUR.d[gg].x; acc[4 * gg + 1] *= CUR.d[gg].y; acc[4 * gg + 2] *= CUR.d[gg].z; acc[4 * gg + 3] *= CUR.d[gg].w; } \
        _Pragma("unroll") for (int ks = 0; ks < 4; ++ks) acc = __builtin_amdgcn_mfma_f32_32x32x16_bf16(CUR.a[ks], CUR.b[ks], acc, 0, 0, 0); } while (0)
    for (int m = 0; m < 66; m += 3) {
        g12_load(o2, ws, bh, dir, m + 2, kb, vb, r, hh); G12_STEP(o0, m);
        g12_load(o0, ws, bh, dir, m + 3, kb, vb, r, hh); G12_STEP(o1, m + 1);
        g12_load(o1, ws, bh, dir, (m + 4 < 68) ? m + 4 : 67, kb, vb, r, hh); G12_STEP(o2, m + 2);
    }
    G12_STEP(o0, 66); G12_STEP(o1, 67);
#undef G12_STEP
}
constexpr int G3_RS = 272, G3_TILE = 64 * G3_RS, G3_OL = 4 * G3_TILE  , G3_LD = 260;
static_assert(G3_OL + 64 * G3_LD * 4 <= MISC_OFF, "G3 LDS");
__device__ __forceinline__ void phase_gla_g3(unsigned char* ws, int lg, LAS unsigned char* lds, int tid) {
    const int lane = tid & 63, wave = __builtin_amdgcn_readfirstlane(tid >> 6), r = lane & 31, hh = lane >> 5, vb = wave;
    LAS unsigned char* TL = lds + RING_OFF; LAS float* OL = (LAS float*)(lds + RING_OFF + G3_OL);
    const bf16* G = (const bf16*)(ws + WS_G); bf16* OG = (bf16*)(ws + WS_Q);
    for (int cn = blockIdx.x; cn < 2176; cn += gridDim.x) {
        const int n = cn % 68, bh = cn / 68, h = bh & 3, b = bh >> 2;
        v4u st[4][2];
#pragma unroll
        for (int tl = 0; tl < 4; ++tl) { const bf16* src = (const bf16*)(ws + ((tl & 1) ? WS_GKH : WS_GQ)) + ((size_t)cn * 2 + (tl >> 1)) * 8192;
#pragma unroll
            for (int j = 0; j < 2; ++j) st[tl][j] = ((const GAS v4u*)src)[tid + 512 * j]; }
        __syncthreads();
#pragma unroll
        for (int tl = 0; tl < 4; ++tl)
#pragma unroll
            for (int j = 0; j < 2; ++j) { const int q = tid + 512 * j, row = q >> 4, ch = q & 15; *(LAS v4u*)(TL + tl * G3_TILE + row * G3_RS + ch * 16) = st[tl][j]; }
        __syncthreads();
        f32x16 P00, P01, P10, P11, O0, O1;
#pragma unroll
        for (int g = 0; g < 16; ++g) { P00[g] = 0.f; P01[g] = 0.f; P10[g] = 0.f; P11[g] = 0.f; O0[g] = 0.f; O1[g] = 0.f; }
#pragma unroll
        for (int dir = 0; dir < 2; ++dir) {
            const LAS unsigned char* Qt = TL + (2 * dir) * G3_TILE + r * G3_RS + 16 * hh; const LAS unsigned char* Kh = TL + (2 * dir + 1) * G3_TILE + r * G3_RS + 16 * hh;
            const GAS bf16x8* Sx = (const GAS bf16x8*)((const bf16*)(ws + WS_SX) + ((size_t)(bh * 2 + dir) * 68 + n) * 32768 + (size_t)vb * 1024) + lane;
            f32x16 X00, X11, Xoff;
#pragma unroll
            for (int g = 0; g < 16; ++g) { X00[g] = 0.f; X11[g] = 0.f; Xoff[g] = 0.f; }
#pragma unroll
            for (int s = 0; s < 8; ++s) {
                const bf16x8 q0 = *(const LAS bf16x8*)(Qt + 32 * s), q1 = *(const LAS bf16x8*)(Qt + 32 * G3_RS + 32 * s);
                const bf16x8 k0 = *(const LAS bf16x8*)(Kh + 32 * s), k1 = *(const LAS bf16x8*)(Kh + 32 * G3_RS + 32 * s);
                const bf16x8 sx = Sx[(s >> 1) * 1024 + (s & 1) * 64];
                X00 = __builtin_amdgcn_mfma_f32_32x32x16_bf16(k0, q0, X00, 0, 0, 0);
                X11 = __builtin_amdgcn_mfma_f32_32x32x16_bf16(k1, q1, X11, 0, 0, 0);
                if (dir == 0) Xoff = __builtin_amdgcn_mfma_f32_32x32x16_bf16(k0, q1, Xoff, 0, 0, 0); else Xoff = __builtin_amdgcn_mfma_f32_32x32x16_bf16(k1, q0, Xoff, 0, 0, 0);
                O0 = __builtin_amdgcn_mfma_f32_32x32x16_bf16(q0, sx, O0, 0, 0, 0); O1 = __builtin_amdgcn_mfma_f32_32x32x16_bf16(q1, sx, O1, 0, 0, 0); }
#pragma unroll
            for (int g = 0; g < 16; ++g) { const int tj = (g & 3) + 8 * (g >> 2) + 4 * hh; const bool keep = dir ? (tj >= r) : (tj <= r);
                P00[g] += keep ? X00[g] : 0.f; P11[g] += keep ? X11[g] : 0.f;
                if (dir == 0) P01[g] += Xoff[g]; else P10[g] += Xoff[g]; }
        }
        { const GAS bf16x8* Vt = (const GAS bf16x8*)(ws + WS_GVT + (size_t)cn * 32768) + vb * 64 + lane;
#pragma unroll
          for (int jb = 0; jb < 2; ++jb)
#pragma unroll
            for (int s2 = 0; s2 < 2; ++s2) { const bf16x8 bfv = Vt[(2 * jb + s2) * 512];
                const f32x16& Pa = jb ? P10 : P00; const f32x16& Pb = jb ? P11 : P01;
                const bf16x8 a0 = __builtin_bit_cast(bf16x8, ((v4u){pk2(Pa[8 * s2 + 0], Pa[8 * s2 + 1]), pk2(Pa[8 * s2 + 2], Pa[8 * s2 + 3]), pk2(Pa[8 * s2 + 4], Pa[8 * s2 + 5]), pk2(Pa[8 * s2 + 6], Pa[8 * s2 + 7])}));
                const bf16x8 a1 = __builtin_bit_cast(bf16x8, ((v4u){pk2(Pb[8 * s2 + 0], Pb[8 * s2 + 1]), pk2(Pb[8 * s2 + 2], Pb[8 * s2 + 3]), pk2(Pb[8 * s2 + 4], Pb[8 * s2 + 5]), pk2(Pb[8 * s2 + 6], Pb[8 * s2 + 7])}));
                O0 = __builtin_amdgcn_mfma_f32_32x32x16_bf16(a0, bfv, O0, 0, 0, 0); O1 = __builtin_amdgcn_mfma_f32_32x32x16_bf16(a1, bfv, O1, 0, 0, 0); } }
#pragma unroll
        for (int g = 0; g < 16; ++g) { const int t = (g & 3) + 8 * (g >> 2) + 4 * hh; OL[t * G3_LD + 32 * vb + r] = O0[g]; OL[(32 + t) * G3_LD + 32 * vb + r] = O1[g]; }
        __syncthreads();
        { const int t = tid >> 3, cc = tid & 7; const LAS f32x4* op = (const LAS f32x4*)(OL + t * G3_LD + 32 * cc);
          f32x4 o[8]; float ss = 0.f;
#pragma unroll
          for (int j = 0; j < 8; ++j) { o[j] = op[j]; ss += (o[j].x * o[j].x + o[j].y * o[j].y) + (o[j].z * o[j].z + o[j].w * o[j].w); }
          ss += __shfl_xor(ss, 1); ss += __shfl_xor(ss, 2); ss += __shfl_xor(ss, 4);
          const float rs = 1.0f / sqrtf(ss * (1.0f / 256.0f) + RMS_EPS);
          const size_t row = (size_t)b * TB + 64 * n + t;
          const GAS v4u* rp = (const GAS v4u*)(G + row * WINP + 2048 + h * 256 + 32 * cc); const GAS f32x4* gp = (const GAS f32x4*)(PARF(ws) + P_OG + lg * 256 + 32 * cc);
          GAS v4u* dst = (GAS v4u*)(OG + row * 1024 + h * 256 + 32 * cc);
#pragma unroll
          for (int j = 0; j < 4; ++j) { const v4u rv = rp[j]; const f32x4 g0 = gp[2 * j], g1 = gp[2 * j + 1]; const f32x4 a = o[2 * j] * rs * g0, c2 = o[2 * j + 1] * rs * g1;
              v4u w;
              w.x = pk2(a.x * silu_f(__uint_as_float(rv.x << 16)), a.y * silu_f(__uint_as_float(rv.x & 0xffff0000u)));
              w.y = pk2(a.z * silu_f(__uint_as_float(rv.y << 16)), a.w * silu_f(__uint_as_float(rv.y & 0xffff0000u)));
              w.z = pk2(c2.x * silu_f(__uint_as_float(rv.z << 16)), c2.y * silu_f(__uint_as_float(rv.z & 0xffff0000u)));
              w.w = pk2(c2.z * silu_f(__uint_as_float(rv.w << 16)), c2.w * silu_f(__uint_as_float(rv.w & 0xffff0000u)));
              dst[j] = w; } }
    }
}
constexpr int WIMG_RS = 2064;
static_assert(2 * 32 * WIMG_RS <= LDS_AUX, "router images below the aux tables");
__device__ __forceinline__ void phase_modulate2_route(unsigned char* ws, int layer, LAS unsigned char* lds, int vcu, int wave, int lane, int tid, bool dummy = false) {
    const bf16* X = (const bf16*)(ws + WS_X); bf16* XN = (bf16*)(ws + WS_XN);
    const float* ng = PARF(ws) + P_N2G + layer * 1024; const float* Mo = (const float*)(ws + WS_MOD) + (size_t)layer * MODROWS * NMODC;
    LAS unsigned char* WHI = lds + RING_OFF; LAS unsigned char* WLO = WHI + 32 * WIMG_RS;
    LAS unsigned* lcnt = (LAS unsigned*)(lds + AUX_LCNT); LAS unsigned* gb = (LAS unsigned*)(lds + AUX_GB); LAS unsigned* ent = (LAS unsigned*)(lds + AUX_ENT); LAS float* rsl = (LAS float*)(lds + AUX_RS);
    { const float* wsrc = PARF(ws) + P_WR + (size_t)layer * 1024 * 32;
      for (int idx = tid; idx < 1024 * 32; idx += NWAVES * 64) { const int k = idx >> 5, e = idx & 31; const float w = wsrc[idx]; const unsigned hi = f2bf(w), lo = f2bf(w - __uint_as_float(hi << 16));
          *(LAS unsigned short*)(WHI + e * WIMG_RS + 2 * k) = (unsigned short)hi; *(LAS unsigned short*)(WLO + e * WIMG_RS + 2 * k) = (unsigned short)lo; }
      if (tid < 32) lcnt[tid] = 0u; }
    gu32* cnt = (gu32*)(ws + WS_CTL) + CW_CNT + (layer + (dummy ? 4 : 0)) * 32 * 16;
    unsigned char* sbase = dummy ? ws + WS_XG : ws;
    const bool lastl = (layer == NLAYER - 1);
  for (int grp = vcu; grp < MT / 136; grp += (int)gridDim.x) {
    const int rbase = grp * 136;
    if (grp != vcu) { __syncthreads(); if (tid < 32) lcnt[tid] = 0u; }
    for (int rl = wave; rl < 136; rl += 2 * NWAVES) {
        const int rl2 = (rl + NWAVES < 136) ? rl + NWAVES : rl; const int m = rbase + rl, m2 = rbase + rl2, mr = mod_row(m), mr2 = mod_row(m2);
        float rs, rs2;
        modulate_row2(X + (size_t)m * 1024, X + (size_t)m2 * 1024, ng, Mo + (size_t)mr * NMODC + 3 * 1024, Mo + (size_t)mr * NMODC + 4 * 1024, Mo + (size_t)mr2 * NMODC + 3 * 1024, Mo + (size_t)mr2 * NMODC + 4 * 1024,
                      XN + (size_t)m * 1024, XN + (size_t)m2 * 1024, lane, rs, rs2);
        if (lane == 0) { rsl[rl] = rs; rsl[rl2] = rs2; } }
    __syncthreads();
    if (wave < 5) {
        const int r = lane & 31, hh = lane >> 5; const int rl = (32 * wave + r < 136) ? 32 * wave + r : 135; const int m = rbase + rl, mr = mod_row(m);
        const float rsr = rsl[rl];
        const bf16* xp = X + (size_t)m * 1024 + 8 * hh; const float* gp = ng + 8 * hh; const float* scp = Mo + (size_t)mr * NMODC + 4 * 1024 + 8 * hh; const float* shp = Mo + (size_t)mr * NMODC + 3 * 1024 + 8 * hh;
        const LAS unsigned char* wh = WHI + r * WIMG_RS + 16 * hh; const LAS unsigned char* wl = WLO + r * WIMG_RS + 16 * hh;
        f32x16 acc;
#pragma unroll
        for (int g = 0; g < 16; ++g) acc[g] = 0.f;
#pragma unroll 2
        for (int s = 0; s < 64; ++s) {
            const v4u xr8 = *(const GAS v4u*)(xp + 16 * s); const f32x4 x0 = (f32x4){__uint_as_float(xr8.x << 16), __uint_as_float(xr8.x & 0xffff0000u), __uint_as_float(xr8.y << 16), __uint_as_float(xr8.y & 0xffff0000u)}, x1 = (f32x4){__uint_as_float(xr8.z << 16), __uint_as_float(xr8.z & 0xffff0000u), __uint_as_float(xr8.w << 16), __uint_as_float(xr8.w & 0xffff0000u)}; const f32x4 g0 = *(const GAS f32x4*)(gp + 16 * s), g1 = *(const GAS f32x4*)(gp + 16 * s + 4);
            const f32x4 c0 = *(const GAS f32x4*)(scp + 16 * s), c1 = *(const GAS f32x4*)(scp + 16 * s + 4), h0 = *(const GAS f32x4*)(shp + 16 * s), h1 = *(const GAS f32x4*)(shp + 16 * s + 4);
            const f32x4 y0 = (x0 * rsr) * g0 * (c0 + 1.0f) + h0, y1 = (x1 * rsr) * g1 * (c1 + 1.0f) + h1;
            v4u ph, pl;
            ph.x = pg8::cvt_pk_bf16(y0.x, y0.y); ph.y = pg8::cvt_pk_bf16(y0.z, y0.w); ph.z = pg8::cvt_pk_bf16(y1.x, y1.y); ph.w = pg8::cvt_pk_bf16(y1.z, y1.w);
            pl.x = pg8::cvt_pk_bf16(y0.x - __uint_as_float(ph.x << 16), y0.y - __uint_as_float(ph.x & 0xffff0000u)); pl.y = pg8::cvt_pk_bf16(y0.z - __uint_as_float(ph.y << 16), y0.w - __uint_as_float(ph.y & 0xffff0000u));
            pl.z = pg8::cvt_pk_bf16(y1.x - __uint_as_float(ph.z << 16), y1.y - __uint_as_float(ph.z & 0xffff0000u)); pl.w = pg8::cvt_pk_bf16(y1.z - __uint_as_float(ph.w << 16), y1.w - __uint_as_float(ph.w & 0xffff0000u));
            const bf16x8 ahi = __builtin_bit_cast(bf16x8, ph), alo = __builtin_bit_cast(bf16x8, pl);
            const bf16x8 bhi = *(const LAS bf16x8*)(wh + 32 * s), blo = *(const LAS bf16x8*)(wl + 32 * s);
            acc = __builtin_amdgcn_mfma_f32_32x32x16_bf16(ahi, bhi, acc, 0, 0, 0); acc = __builtin_amdgcn_mfma_f32_32x32x16_bf16(alo, bhi, acc, 0, 0, 0); acc = __builtin_amdgcn_mfma_f32_32x32x16_bf16(ahi, blo, acc, 0, 0, 0); }
        const float brt = (PARF(ws) + P_BR)[layer * 32 + r];
#pragma unroll
        for (int g = 0; g < 16; ++g) { const int rowl = 32 * wave + (g & 3) + 8 * (g >> 2) + 4 * hh;
            float v = acc[g] + brt; float tv[4]; int te[4];
#pragma unroll
            for (int k = 0; k < 4; ++k) { float mx = v;
#pragma unroll
                for (int o = 1; o < 32; o <<= 1) mx = fmaxf(mx, shx(mx, o, lane));
                const unsigned long long bm = __ballot(v == mx); const unsigned hm = hh ? (unsigned)(bm >> 32) : (unsigned)bm; const int first = __ffs((int)hm) - 1;
                te[k] = first; tv[k] = mx; if (r == first) v = -INFINITY; }
            const bool valid = rowl < 136 && !(lastl && mod_row(rbase + (rowl < 136 ? rowl : 135)) == 8);
            if (r == 0 && rowl < 136) {
                if (valid) { const float e1 = __expf(tv[1] - tv[0]), e2 = __expf(tv[2] - tv[0]), e3 = __expf(tv[3] - tv[0]); const float inv = 1.0f / (1.0f + e1 + e2 + e3);
                    const float wk[4] = {inv, e1 * inv, e2 * inv, e3 * inv};
#pragma unroll
                    for (int k = 0; k < 4; ++k) { const unsigned lp = atomicAdd((unsigned*)&lcnt[te[k]], 1u); ent[(rowl * 4 + k) * 2 + 0] = ((unsigned)te[k] << 24) | lp; ent[(rowl * 4 + k) * 2 + 1] = __float_as_uint(wk[k]); } }
                else {
#pragma unroll
                    for (int k = 0; k < 4; ++k) ent[(rowl * 4 + k) * 2 + 0] = 0xffffffffu; } } }
    }
    __syncthreads();
    if (tid < 32) gb[tid] = __hip_atomic_fetch_add(cnt + tid * 16, lcnt[tid], __ATOMIC_RELAXED, __HIP_MEMORY_SCOPE_AGENT);
    __syncthreads();
    for (int q = tid; q < 136 * 4; q += NWAVES * 64) { const unsigned pe = ent[q * 2 + 0];
        if (pe != 0xffffffffu) { const unsigned e = pe >> 24, lp = pe & 0xffffffu; const int m = rbase + (q >> 2);
            ((unsigned*)(sbase + WS_SLOT))[m * 4 + (q & 3)] = (e << 24) | (gb[e] + lp); ((unsigned*)(sbase + WS_GATEW))[m * 4 + (q & 3)] = ent[q * 2 + 1];
            if (!dummy) ((int*)(ws + WS_LIST))[(size_t)e * MT + gb[e] + lp] = m; } }
  }
}
__device__ __forceinline__ void build_expert_tables(unsigned char* ws, int layer, LAS unsigned char* lds, int tid) {
    LAS int* t2e = (LAS int*)(lds + AUX_T2E); LAS int* base = (LAS int*)(lds + AUX_BASE); LAS int* ntp = (LAS int*)(lds + AUX_NT); LAS int* cntl = (LAS int*)(lds + AUX_CNT);
    gu32* cnt = (gu32*)(ws + WS_CTL) + CW_CNT + layer * 32 * 16;
    __syncthreads();
    if (tid < 64) { const unsigned cval = (tid < 32) ? __hip_atomic_load(cnt + tid * 16, RLX_AGENT) : 0u; const int tiles = (int)((cval + 255u) >> 8);
        int pre = tiles;
#pragma unroll
        for (int o = 1; o < 32; o <<= 1) { const int ln = tid & 63; const int t = __builtin_amdgcn_ds_bpermute(((ln >= o) ? ln - o : ln) << 2, pre); if (ln >= o) pre += t; }
        const int start = pre - tiles;
        if (tid < 32) { base[tid] = start * 256; cntl[tid] = (int)cval; for (int t = 0; t < tiles; ++t) t2e[start + t] = tid; if (tid == 31) ntp[0] = pre; } }
    __syncthreads();
}
__device__ __forceinline__ void phase_moe_gather(unsigned char* ws, int layer, LAS unsigned char* lds, int gw, int NGW, int lane, int tid) {
    build_expert_tables(ws, layer, lds, tid);
    const LAS int* base = (const LAS int*)(lds + AUX_BASE);
    const bf16* XN = (const bf16*)(ws + WS_XN); bf16* XG = (bf16*)(ws + WS_XG);
    const unsigned* slot = (const unsigned*)(ws + WS_SLOT); unsigned* spos = (unsigned*)(ws + WS_SLOTPOS);
    for (int m = gw; m < MT; m += NGW) {
        if (layer == NLAYER - 1 && mod_row(m) == 8) continue;
        const GAS v4u* src = (const GAS v4u*)(XN + (size_t)m * 1024) + lane; const v4u a = src[0], b = src[64];
#pragma unroll
        for (int k = 0; k < 4; ++k) { const unsigned pe = slot[m * 4 + k]; const int dst = base[pe >> 24] + (int)(pe & 0xffffffu);
            GAS v4u* dp = (GAS v4u*)(XG + (size_t)dst * 1024) + lane; dp[0] = a; dp[64] = b;
            if (lane == 0) spos[m * 4 + k] = (unsigned)dst; }
    }
}
__device__ __forceinline__ void phase_moe_combine(unsigned char* ws, float* out, int layer, LAS unsigned char* lds, int gw, int NGW, int lane, int tid, bool dummy = false) {
    build_expert_tables(ws, layer, lds, tid);
    const LAS int* base = (const LAS int*)(lds + AUX_BASE);
    bf16* X = (bf16*)(ws + WS_X); const bf16* Y = (const bf16*)(ws + WS_Y);
    const float* Mo = (const float*)(ws + WS_MOD) + (size_t)layer * MODROWS * NMODC;
    const unsigned* slot = (const unsigned*)(ws + WS_SLOT); const float* gw4 = (const float*)(ws + WS_GATEW);
    for (int m = gw; m < MT; m += NGW) { const int b = m / TB, w = m - b * TB; const int mr = (w < CTXL) ? 8 : b;
        if (layer == NLAYER - 1 && w < CTXL) continue;
        f32x4 f[4];
#pragma unroll
        for (int j = 0; j < 4; ++j) f[j] = (f32x4){0.f, 0.f, 0.f, 0.f};
#pragma unroll
        for (int k = 0; k < 4; ++k) { const unsigned pe = slot[m * 4 + k]; const unsigned sp = (unsigned)base[pe >> 24] + (pe & 0xffffffu); const float wk = gw4[m * 4 + k];
            const GAS unsigned long long* yp = (const GAS unsigned long long*)(Y + (size_t)sp * 1024) + lane;
#pragma unroll
            for (int j = 0; j < 4; ++j) { const unsigned long long v = yp[64 * j];
                f[j].x += wk * __uint_as_float((unsigned)(v & 0xffffu) << 16); f[j].y += wk * __uint_as_float((unsigned)(v >> 16) << 16);
                f[j].z += wk * __uint_as_float((unsigned)((v >> 32) & 0xffffu) << 16); f[j].w += wk * __uint_as_float((unsigned)(v >> 48) << 16); } }
        GAS unsigned long long* xp = (GAS unsigned long long*)(X + (size_t)m * 1024) + lane; const GAS f32x4* gp = (const GAS f32x4*)(Mo + (size_t)mr * NMODC + 5 * 1024) + lane;
        GAS f32x4* op = (GAS f32x4*)(out + ((size_t)b * SEQ + (w - CTXL)) * 1024) + lane;
        float ss = 0.f;
#pragma unroll
        for (int j = 0; j < 4; ++j) { f[j] = bf4_to_f32(xp[64 * j]) + gp[64 * j] * f[j]; if (dummy) ((GAS f32x4*)((float*)(ws + WS_XG) + (size_t)m * 1024) + lane)[64 * j] = f[j]; else if (layer == NLAYER - 1) op[64 * j] = f[j]; else { const unsigned long long pk = f32_to_bf4(f[j]); xp[64 * j] = pk; f[j] = bf4_to_f32(pk); } ss += (f[j].x * f[j].x + f[j].y * f[j].y) + (f[j].z * f[j].z + f[j].w * f[j].w); }
        if (layer < NLAYER - 1 && !dummy) {
            const float rs = 1.0f / sqrtf(wave_sum(ss) * (1.0f / 1024.0f) + RMS_EPS);
            const float* ng = PARF(ws) + P_N1G + (layer + 1) * 1024; const float* Mn = (const float*)(ws + WS_MOD) + (size_t)(layer + 1) * MODROWS * NMODC + (size_t)mr * NMODC;
            GAS unsigned long long* o8 = (GAS unsigned long long*)((bf16*)(ws + WS_XN) + (size_t)m * 1024) + lane;
#pragma unroll
            for (int j = 0; j < 4; ++j) { const f32x4 g = ((const GAS f32x4*)ng)[64 * j + lane], sh = ((const GAS f32x4*)Mn)[64 * j + lane], sc = ((const GAS f32x4*)(Mn + 1024))[64 * j + lane];
                const f32x4 y = (f[j] * rs) * g * (sc + 1.0f) + sh;
                o8[64 * j] = (unsigned long long)pk2(y.x, y.y) | ((unsigned long long)pk2(y.z, y.w) << 32); } }
    }
}

constexpr int NPH_L = 11, NPHASE = 2 + NPH_L * NLAYER;
#ifndef PHMASK
#define PHMASK 0x7fff
#endif
#define EN(b) ((PHMASK >> (b)) & 1)
#ifndef DUPMASK
#define DUPMASK 0
#endif
#define DUP(b) for (int rep_ = 0; rep_ < (((DUPMASK >> (b)) & 1) ? 2 : 1); ++rep_)
__global__ void __launch_bounds__(NWAVES * 64, 2) dit_fwd(Args args) {
    extern __shared__ __attribute__((aligned(16))) unsigned char lds_raw[];
    LAS unsigned char* lds = (LAS unsigned char*)lds_raw;
    volatile LAS unsigned* MISC = (volatile LAS unsigned*)(lds + MISC_OFF);
    const int G = gridDim.x, bx = blockIdx.x;
    const int vcu = (G % 8 == 0) ? (bx % 8) * (G / 8) + bx / 8 : bx;
    const int wave0 = __builtin_amdgcn_readfirstlane((int)threadIdx.x >> 6);
#define LANE_ID(z) ((int)__builtin_amdgcn_mbcnt_hi(~0u, __builtin_amdgcn_mbcnt_lo(~0u, (z))))
    { const int t0 = (wave0 << 6) | LANE_ID(0u); for (int u = t0; u < (LDS_BYTES - MISC_OFF) / 4; u += NWAVES * 64) ((LAS unsigned*)(lds + MISC_OFF))[u] = 0u; }
    __syncthreads();
    const int lo = args.ph_lo, hi = args.ph_hi;
    XcdBarrier bar; bar.bar = (unsigned*)(args.ws + WS_CTL) + CW_BAR; bar.x = 0; bar.st = nullptr;
    if (hi - lo > 1) bar = xcd_barrier_post((unsigned*)(args.ws + WS_CTL) + CW_BAR, MISC + 8, wave0 == 0 && LANE_ID(0u) == 0);
#define IN(k) (lo <= (k) && (k) < hi)
#define SEAM(k) do { if (IN(k) && IN((k) + 1)) { XcdBarrier b_ = bar; unsigned zb_ = 0u; LAUNDER_S(zb_); b_.bar = bar.bar + zb_; xcd_barrier(b_, wave0 == 0 && LANE_ID(zb_) == 0); } } while (0)
#define PHASE_IDS() unsigned zoff_ = 0u; LAUNDER_S(zoff_); int tid = (wave0 << 6) | LANE_ID(zoff_); LAUNDER_V(tid); const int lane = tid & 63, wave = __builtin_amdgcn_readfirstlane(tid >> 6); const int gw = vcu * NWAVES + wave, NGW = G * NWAVES; \
    unsigned char* ws = args.ws + zoff_; const int Gp = G + (int)zoff_, bxp = bx + (int)zoff_; (void)lane; (void)gw; (void)NGW; (void)Gp; (void)bxp;

    if (EN(0) && IN(0)) DUP(0) { PHASE_IDS(); p0_prologue(args, lds, gw, NGW, wave, lane); } SEAM(0);
    if (EN(1) && IN(1)) { PHASE_IDS(); p1_mod_reduce(args, gw * 64 + lane, NGW * 64); } SEAM(1);

    for (int layer = 0; layer < NLAYER; ++layer) {
        const int pb = 2 + NPH_L * layer, lh = layer >> 1;
        if (layer == 0) { if (EN(2) && IN(pb + 0)) DUP(2) { PHASE_IDS(); phase_modulate1(ws, layer, gw, NGW, lane); } SEAM(pb + 0); }
        if ((layer & 1) == 0) {
            if (EN(3) && IN(pb + 1)) DUP(3) {
                PHASE_IDS();
                pg8::Gemm g{(const pg8::bf16_t*)(ws + WS_XN), (const pg8::bf16_t*)(ws + WS_WQKV) + (size_t)lh * QKVN * 1024, MT, QKVN, 1024, 0};
                pg8::StaticOrder S; S.init(MT, QKVN, Gp, bxp);
                LAS float* gl = (LAS float*)(lds + AUX_RS);
                if (tid < 128) gl[tid] = (PARF(ws) + (tid < 64 ? P_QG : P_KG - 64) + lh * 64)[tid];
                __syncthreads();
                pg8::EpiQKV E{ws, WS_Q, WS_K - WS_Q, WS_V - WS_K, gl, (const float*)(ws + WS_ROPE), ATT_C2};
                pg8::gemm_phase<pg8::EpiQKV, pg8::StaticOrder, true, true>(lds + RING_OFF, g, S, E, tid);
            } SEAM(pb + 1);
            if (EN(5) && IN(pb + 3)) DUP(5) {
                PHASE_IDS();
                const attn_body::bf16* Qp = (const attn_body::bf16*)(ws + WS_Q); const attn_body::bf16* Kp = (const attn_body::bf16*)(ws + WS_K); const attn_body::bf16* Vp = (const attn_body::bf16*)(ws + WS_V);
                attn_body::bf16* Op = (attn_body::bf16*)(ws + WS_XN);
                if (G == 256) {
                    for (int i = 0; i < 9; ++i) {
                        long qrow0, kvrow0; int NT, h;
                        if (i < 8) { const int x = vcu >> 5, j = vcu & 31, pair = 4 * x + (i >> 1), wi = (i & 1) * 32 + j, hq = wi >> 4, qb = wi & 15, b = pair >> 2, hk = pair & 3;
                            h = hk * 4 + hq; qrow0 = (long)b * TB + CTXL + qb * 256; kvrow0 = (long)b * TB; NT = TB / 64; }
                        else { if (vcu >= 128) break; const int b = vcu >> 4; h = vcu & 15; qrow0 = (long)b * TB; kvrow0 = qrow0; NT = CTXL / 64; }
                        attn_body::attn_unit<8>(qrow0, kvrow0, NT, h, Qp, Kp, Vp, Op, (char*)lds_raw + RING_OFF, tid);
                    }
                } else {
                    for (int U = bx; U < 2048 + 128; U += G) {
                        long qrow0, kvrow0; int NT, h;
                        if (U < 2048) { const int pair = U >> 6, wi = U & 63, hq = wi >> 4, qb = wi & 15, b = pair >> 2, hk = pair & 3; h = hk * 4 + hq; qrow0 = (long)b * TB + CTXL + qb * 256; kvrow0 = (long)b * TB; NT = TB / 64; }
                        else { const int v = U - 2048, b = v >> 4; h = v & 15; qrow0 = (long)b * TB; kvrow0 = qrow0; NT = CTXL / 64; }
                        attn_body::attn_unit<8>(qrow0, kvrow0, NT, h, Qp, Kp, Vp, Op, (char*)lds_raw + RING_OFF, tid);
                    }
                }
            } SEAM(pb + 3);
        } else {
            if (EN(6) && IN(pb + 1)) DUP(6) {
                PHASE_IDS();
                pg8::Gemm g{(const pg8::bf16_t*)(ws + WS_XN), (const pg8::bf16_t*)(ws + WS_WIN) + (size_t)lh * WINP * 1024, MT, WINP, 1024, 0};
                pg8::StaticOrder S; S.init(MT, WINP, Gp, bxp);
                pg8::EpiBf16 E{(pg8::bf16_t*)(ws + WS_G), WINP};
                pg8::gemm_phase<pg8::EpiBf16, pg8::StaticOrder, true, true>(lds + RING_OFF, g, S, E, tid);
            } SEAM(pb + 1);
            if (EN(7) && IN(pb + 2)) DUP(7) { PHASE_IDS(); phase_gla_g0(ws, lh, lds, tid); } SEAM(pb + 2);
            if (EN(8) && IN(pb + 3)) DUP(8) { PHASE_IDS(); phase_gla_g12(ws, lds, gw, wave, lane); } SEAM(pb + 3);
            if (EN(8) && IN(pb + 4)) DUP(9) { PHASE_IDS(); phase_gla_g3(ws, lh, lds, tid); } SEAM(pb + 4);
        }
        if (EN(9) && IN(pb + 5)) {
            PHASE_IDS();
            const pg8::bf16_t* Wt = (layer & 1) ? (const pg8::bf16_t*)(ws + WS_WOG) + (size_t)lh * 1024 * 1024 : (const pg8::bf16_t*)(ws + WS_WOA) + (size_t)lh * 1024 * 1024;
            pg8::Gemm g{(const pg8::bf16_t*)(ws + ((layer & 1) ? WS_Q : WS_XN)), Wt, MT, 1024, 1024, 0};
            pg8::StaticOrder S; if (layer == NLAYER - 1) S.init(NB * SEQ, 1024, Gp, bxp, true); else S.init(MT, 1024, Gp, bxp);
            pg8::EpiResGate E{(pg8::bf16_t*)(ws + WS_X), (const float*)(ws + WS_MOD) + (size_t)layer * MODROWS * NMODC + 2 * 1024};
            pg8::gemm_phase<pg8::EpiResGate, pg8::StaticOrder, true, true>(lds + RING_OFF, g, S, E, tid);
        } SEAM(pb + 5);
        if (EN(10) && IN(pb + 6)) { if ((DUPMASK >> 10) & 1) { PHASE_IDS(); phase_modulate2_route(ws, layer, lds, vcu, wave, lane, tid, true); __syncthreads(); } PHASE_IDS(); phase_modulate2_route(ws, layer, lds, vcu, wave, lane, tid); } SEAM(pb + 6);
        if (EN(12) && IN(pb + 8)) DUP(12) {
            PHASE_IDS();
            build_expert_tables(ws, layer, lds, tid);
            const int nT = __builtin_amdgcn_readfirstlane(((const LAS int*)(lds + AUX_NT))[0]);
            pg8::MoeOrder S{nT, 8, Gp, bxp, (const LAS int*)(lds + AUX_T2E)};
            LAS unsigned short* rowtab = (LAS unsigned short*)(lds + AUX_ROWTAB);
            { const LAS int* base = (const LAS int*)(lds + AUX_BASE); const LAS int* cntl = (const LAS int*)(lds + AUX_CNT); const int* LIST = (const int*)(ws + WS_LIST);
              pg8::Unit u;
              for (int i = 0; i < ROWTAB_UNITS && S.next(i, u); ++i) if (tid < 256) { const int pos = (u.pm - (base[u.e] >> 8)) * 256 + tid; rowtab[i * 256 + tid] = (unsigned short)((pos < cntl[u.e]) ? LIST[(size_t)u.e * MT + pos] : 0); }
              __syncthreads(); }
            pg8::Gemm g{(const pg8::bf16_t*)(ws + WS_XN), (const pg8::bf16_t*)(ws + WS_WGU) + (size_t)layer * 32 * 2048 * 1024, MPAD, 2048, 1024, (size_t)2048 * 1024 * 2, rowtab};
            pg8::EpiSwiGLU E{(pg8::bf16_t*)(ws + WS_ACT), PARF(ws) + P_BGU + (size_t)layer * 32 * 2048};
            pg8::gemm_phase<pg8::EpiSwiGLU, pg8::MoeOrder, true, true, true>(lds + RING_OFF, g, S, E, tid);
        } SEAM(pb + 8);
        if (EN(13) && IN(pb + 9)) DUP(13) {
            PHASE_IDS();
            build_expert_tables(ws, layer, lds, tid);
            const int nT = __builtin_amdgcn_readfirstlane(((const LAS int*)(lds + AUX_NT))[0]);
            pg8::Gemm g{(const pg8::bf16_t*)(ws + WS_ACT), (const pg8::bf16_t*)(ws + WS_WDN) + (size_t)layer * 32 * 1024 * 1024, MPAD, 1024, 1024, (size_t)1024 * 1024 * 2};
            pg8::MoeOrder S{nT, 4, Gp, bxp, (const LAS int*)(lds + AUX_T2E)};
            pg8::EpiBiasBf16 E{(pg8::bf16_t*)(ws + WS_Y), PARF(ws) + P_BDN + (size_t)layer * 32 * 1024};
            pg8::gemm_phase<pg8::EpiBiasBf16, pg8::MoeOrder, true, true>(lds + RING_OFF, g, S, E, tid);
        } SEAM(pb + 9);
        if (EN(14) && IN(pb + 10)) { if ((DUPMASK >> 14) & 1) { PHASE_IDS(); phase_moe_combine(ws, args.out, layer, lds, gw, NGW, lane, tid, true); } PHASE_IDS(); phase_moe_combine(ws, args.out, layer, lds, gw, NGW, lane, tid); } SEAM(pb + 10);
    }
#undef IN
#undef EN
#undef DUP
#undef SEAM
#undef PHASE_IDS
#undef LANE_ID
}

extern "C" void kernel_launch(void* const* d_in, const int* in_sizes, int n_in, void* d_out, int out_size, void* d_ws, size_t ws_size, hipStream_t stream) {
    static int grid = 0;
    if (grid == 0) {
        if (n_in != 25 || out_size != NB * SEQ * DMODEL || ws_size < WS_END) { fprintf(stderr, "kernel_launch: unexpected shapes: n_in %d out %d ws %zu (need >= %zu)\n", n_in, out_size, ws_size, (size_t)WS_END); grid = -1; return; }
        int dev = 0, cus = 0, per_cu = 0;
        if (hipGetDevice(&dev) != hipSuccess || hipDeviceGetAttribute(&cus, hipDeviceAttributeMultiprocessorCount, dev) != hipSuccess) { grid = -1; return; }
        if (hipFuncSetAttribute((const void*)dit_fwd, hipFuncAttributeMaxDynamicSharedMemorySize, LDS_BYTES) != hipSuccess) { fprintf(stderr, "kernel_launch: hipFuncSetAttribute failed\n"); grid = -1; return; }
        if (hipOccupancyMaxActiveBlocksPerMultiprocessor(&per_cu, (const void*)dit_fwd, NWAVES * 64, LDS_BYTES) != hipSuccess || per_cu < 1) fprintf(stderr, "kernel_launch: occupancy query reports %d\n", per_cu);
        (void)hipGetLastError();
        grid = cus;
    }
    if (grid < 0) return;
    if (hipMemsetAsync((char*)d_ws + WS_CTL, 0, CTL_ZERO_BYTES, stream) != hipSuccess) { fprintf(stderr, "kernel_launch: memset failed\n"); return; }
    Args a{};
    for (int i = 0; i < 25; ++i) a.in[i] = (const float*)d_in[i];
    a.out = (float*)d_out; a.ws = (unsigned char*)d_ws;
#if MK_ONE_LAUNCH
    a.ph_lo = 0; a.ph_hi = NPHASE;
    hipLaunchKernelGGL(dit_fwd, dim3(grid), dim3(NWAVES * 64), LDS_BYTES, stream, a);
#else
    for (int p = 0; p < NPHASE; ++p) { a.ph_lo = p; a.ph_hi = p + 1; hipLaunchKernelGGL(dit_fwd, dim3(grid), dim3(NWAVES * 64), LDS_BYTES, stream, a); }
#endif
    const hipError_t le = hipPeekAtLastError();
    if (le != hipSuccess) fprintf(stderr, "kernel_launch: launch failed: %s\n", hipGetErrorName(le));
}
```

```cpp
#include <hip/hip_runtime.h>
#include <hip/hip_bf16.h>
#include <cstdio>
#include <cstdint>
#include <cmath>

#ifndef MK_ONE_LAUNCH
#define MK_ONE_LAUNCH 1
#endif

namespace pg8 {
#define PG8_LAS __attribute__((address_space(3)))
typedef unsigned short bf16_t;
typedef short bf16x8 __attribute__((ext_vector_type(8)));
typedef float f32x4 __attribute__((ext_vector_type(4)));
typedef unsigned u32x4 __attribute__((ext_vector_type(4)));
constexpr int BM = 256, BK = 64, HALF = 128, HTB = HALF * BK * 2  , STAGE_BYTES = 8 * HTB, NXCD = 8, WGM = 8;

__host__ __device__ __forceinline__ int lds_byte(int r, int c) { const int st = (r >> 4) * 2 + (c >> 5), rr = r & 15, cc = c & 31, ob = rr * 64 + cc * 2; return st * 1024 + (ob ^ (((ob >> 9) & 1) << 5)); }
__host__ __device__ __forceinline__ void stage_rc(int b, int& R, int& C) { const int st = b / 1024, sb = b % 1024, swz = sb ^ (((sb >> 9) & 1) << 5); R = (st >> 1) * 16 + swz / 64; C = (st & 1) * 32 + (swz % 64) / 2; }
__host__ __device__ __forceinline__ int perm32(int rho) { const int n = rho >> 4, i = rho & 15; return 8 * (i >> 2) + 4 * n + (i & 3); }

struct Unit { int pm, pn, e; };
struct Gemm { const bf16_t* A; const bf16_t* Bt; int M, N, K; size_t bstride; const PG8_LAS unsigned short* rowtab; };

struct StaticOrder {
    int nM, nN, nwg, G, c; bool latent_only;
    __host__ __device__ __forceinline__ void init(int M, int N, int G_, int c_, bool lat_ = false) { nM = M / BM; nN = N / BM; nwg = nM * nN; G = G_; c = c_; latent_only = lat_; }
    __host__ __device__ __forceinline__ bool next(int i, Unit& u) const {
        const long L = (long)i * G + c; if (L >= nwg) return false;
        int wgid = (int)L; { const int q = nwg / NXCD, r = nwg % NXCD, xcd = wgid % NXCD, off = wgid / NXCD; wgid = (xcd < r ? xcd * (q + 1) : r * (q + 1) + (xcd - r) * q) + off; }
        const int nig = WGM * nN, gid = wgid / nig, fm = gid * WGM, gsz = (nM - fm) < WGM ? (nM - fm) : WGM;
        u.pm = fm + ((wgid % nig) % gsz); u.pn = (wgid % nig) / gsz; u.e = 0;
        if (latent_only) u.pm = (u.pm >> 4) * 17 + 1 + (u.pm & 15);
        return true;
    }
    __device__ __forceinline__ void a_ready(const Unit&) const {}
    __device__ __forceinline__ void done(const Unit&) const {}
};
struct MoeOrder {
    int nT, nN, G, c; const PG8_LAS int* t2e;
    __device__ __forceinline__ bool next(int i, Unit& u) const {
        const int x = c & 7, j = c >> 3, per = 32 / nN, mt = (i * (G >> 5) + x) * per + j / nN; if (mt >= nT) return false;
        u.pm = mt; u.pn = j % nN; u.e = __builtin_amdgcn_readfirstlane(t2e[mt]); return true;
    }
    __device__ __forceinline__ void a_ready(const Unit&) const {}
    __device__ __forceinline__ void done(const Unit&) const {}
};

__device__ __forceinline__ int lane_now() { unsigned z; asm volatile("s_mov_b32 %0, 0" : "=s"(z)); return (int)__builtin_amdgcn_mbcnt_hi(~0u, __builtin_amdgcn_mbcnt_lo(~0u, z)); }
__device__ __forceinline__ float shx(float v, int m, int ln) { return __int_as_float(__builtin_amdgcn_ds_bpermute((ln ^ m) << 2, __float_as_int(v))); }
__device__ __forceinline__ unsigned cvt_pk_bf16(float lo, float hi) { unsigned r; asm volatile("v_cvt_pk_bf16_f32 %0, %1, %2" : "=v"(r) : "v"(lo), "v"(hi)); return r; }

struct EpiBf16 {
    static constexpr bool PERM = true, AFTER_DRAIN = false;
    bf16_t* O; int ldc;
    __device__ __forceinline__ void operator()(const f32x4 (&acc)[2][2][4][2], const Unit& u, int wr, int wc, int fr, int fq) const {
        const int row0 = u.pm * BM + wr * 64 + fr; const int col0 = u.pn * BM + wc * 32 + 8 * fq;
#pragma unroll
        for (int ai = 0; ai < 2; ++ai)
#pragma unroll
            for (int m = 0; m < 4; ++m) { bf16_t* rowp = O + (size_t)(row0 + ai * HALF + m * 16) * ldc + col0;
#pragma unroll
                for (int bj = 0; bj < 2; ++bj) { const f32x4 v0 = acc[ai][bj][m][0], v1 = acc[ai][bj][m][1];
                    u32x4 w; w.x = cvt_pk_bf16(v0[0], v0[1]); w.y = cvt_pk_bf16(v0[2], v0[3]); w.z = cvt_pk_bf16(v1[0], v1[1]); w.w = cvt_pk_bf16(v1[2], v1[3]);
                    *(u32x4*)(rowp + bj * HALF) = w; } }
    }
};
struct EpiQKV {
    static constexpr bool PERM = true, AFTER_DRAIN = false;
    unsigned char* wsb; size_t offQ, dK, dV;
    const PG8_LAS float* gl; const float* ropec; float c2;
    __device__ __forceinline__ void operator()(const f32x4 (&acc)[2][2][4][2], const Unit& u, int wr, int wc, int fr, int fq) const {
        const int isk = (u.pn >= 4) ? 1 : 0, isv = (u.pn >= 5) ? 1 : 0;
        bf16_t* base = (bf16_t*)(wsb + offQ + (size_t)isk * dK + (size_t)isv * dV); const int ldc = isk ? 256 : 1024;
        const int hcol = (isk ? wc : (u.pn * 4 + wc)) * 64 + 8 * fq;
        const int pmb = u.pm / 17, pml = u.pm - pmb * 17; const bool lat = pml != 0;
        const PG8_LAS float* gp = gl + (isk ? 64 : 0) + 8 * fq; const float scl = isk ? 1.0f : c2;
#pragma unroll
        for (int ai = 0; ai < 2; ++ai)
#pragma unroll
            for (int m = 0; m < 4; ++m) { const int rl = ai * HALF + wr * 64 + m * 16 + fr; const size_t row = (size_t)u.pm * BM + rl;
                f32x4 v[2][2]; float ss = 0.f;
#pragma unroll
                for (int bj = 0; bj < 2; ++bj)
#pragma unroll
                    for (int n = 0; n < 2; ++n) { v[bj][n] = acc[ai][bj][m][n]; ss += (v[bj][n][0] * v[bj][n][0] + v[bj][n][1] * v[bj][n][1]) + (v[bj][n][2] * v[bj][n][2] + v[bj][n][3] * v[bj][n][3]); }
                if (!isv) { const int ln = lane_now(); ss += shx(ss, 16, ln); ss += shx(ss, 32, ln);
                    const float rs = 1.0f / sqrtf(ss * (1.0f / 64.0f) + 1e-6f);
                    const int spos = (pml - 1) * 256 + rl;
#pragma unroll
                    for (int bj = 0; bj < 2; ++bj) { f32x4 cs = (f32x4){1.f, 1.f, 1.f, 1.f}, sn = (f32x4){0.f, 0.f, 0.f, 0.f};
                        if (lat) { const float* cp = ropec + (size_t)spos * 32 + 16 * bj + 4 * fq; cs = *(const f32x4*)cp; sn = *(const f32x4*)(cp + 4096 * 32); }
#pragma unroll
                        for (int n = 0; n < 2; ++n) { const f32x4 y = v[bj][n] * rs * *(const PG8_LAS f32x4*)(gp + 32 * bj + 4 * n);
                            const float c0 = cs[2 * n], s0 = sn[2 * n], c1 = cs[2 * n + 1], s1 = sn[2 * n + 1];
                            v[bj][n] = (f32x4){(y[0] * c0 - y[1] * s0) * scl, (y[0] * s0 + y[1] * c0) * scl, (y[2] * c1 - y[3] * s1) * scl, (y[2] * s1 + y[3] * c1) * scl}; } } }
                bf16_t* rowp = base + row * ldc + hcol;
#pragma unroll
                for (int bj = 0; bj < 2; ++bj) { u32x4 w; w.x = cvt_pk_bf16(v[bj][0][0], v[bj][0][1]); w.y = cvt_pk_bf16(v[bj][0][2], v[bj][0][3]); w.z = cvt_pk_bf16(v[bj][1][0], v[bj][1][1]); w.w = cvt_pk_bf16(v[bj][1][2], v[bj][1][3]);
                    *(u32x4*)(rowp + 32 * bj) = w; } }
    }
};
struct EpiResGate {
    static constexpr bool PERM = false, AFTER_DRAIN = false;
    bf16_t* X; const float* gate;
    __device__ __forceinline__ void operator()(const f32x4 (&acc)[2][2][4][2], const Unit& u, int wr, int wc, int fr, int fq) const {
        const int row0 = u.pm * BM + wr * 64 + fr; const int col0 = u.pn * BM + wc * 32 + 4 * fq;
        const int bb = u.pm / 17, mr = (u.pm - bb * 17 == 0) ? 8 : bb;
        const float* gp = gate + (size_t)mr * 6144 + col0;
        f32x4 gv[2][2];
#pragma unroll
        for (int bj = 0; bj < 2; ++bj)
#pragma unroll
            for (int n = 0; n < 2; ++n) gv[bj][n] = *(const f32x4*)(gp + bj * HALF + n * 16);
#pragma unroll
        for (int ai = 0; ai < 2; ++ai)
#pragma unroll
            for (int m = 0; m < 4; ++m) { bf16_t* rowp = X + (size_t)(row0 + ai * HALF + m * 16) * 1024 + col0;
#pragma unroll
                for (int bj = 0; bj < 2; ++bj)
#pragma unroll
                    for (int n = 0; n < 2; ++n) { unsigned long long* p = (unsigned long long*)(rowp + bj * HALF + n * 16); const unsigned long long v = *p;
                        f32x4 x = (f32x4){__uint_as_float((unsigned)(v & 0xffffu) << 16), __uint_as_float((unsigned)(v >> 16) << 16), __uint_as_float((unsigned)((v >> 32) & 0xffffu) << 16), __uint_as_float((unsigned)(v >> 48) << 16)};
                        x = x + gv[bj][n] * acc[ai][bj][m][n];
                        *p = (unsigned long long)cvt_pk_bf16(x[0], x[1]) | ((unsigned long long)cvt_pk_bf16(x[2], x[3]) << 32); } }
    }
};
struct EpiSwiGLU {
    static constexpr bool PERM = true, AFTER_DRAIN = false;
    bf16_t* O; const float* bias;
    __device__ __forceinline__ void operator()(const f32x4 (&acc)[2][2][4][2], const Unit& u, int wr, int wc, int fr, int fq) const {
        const int row0 = u.pm * BM + wr * 64 + fr; const int col0 = u.pn * HALF + wc * 32 + 8 * fq;
        const float* bp = bias + (size_t)u.e * 2048 + col0;
        f32x4 bg[2], bu[2];
#pragma unroll
        for (int n = 0; n < 2; ++n) { bg[n] = *(const f32x4*)(bp + 4 * n); bu[n] = *(const f32x4*)(bp + 1024 + 4 * n); }
#pragma unroll
        for (int ai = 0; ai < 2; ++ai)
#pragma unroll
            for (int m = 0; m < 4; ++m) { bf16_t* rowp = O + (size_t)(row0 + ai * HALF + m * 16) * 1024 + col0;
                float r[8];
#pragma unroll
                for (int n = 0; n < 2; ++n) { const f32x4 gt = acc[ai][0][m][n] + bg[n], up = acc[ai][1][m][n] + bu[n];
#pragma unroll
                    for (int i = 0; i < 4; ++i) { const float g = fminf(gt[i], 7.0f), uu = fminf(fmaxf(up[i], -7.0f), 7.0f);
                        const float sg = __builtin_amdgcn_rcpf(1.0f + __builtin_amdgcn_exp2f(-1.702f * 1.4426950408889634f * g));
                        r[4 * n + i] = (uu + 1.0f) * (g * sg); } }
                u32x4 w; w.x = cvt_pk_bf16(r[0], r[1]); w.y = cvt_pk_bf16(r[2], r[3]); w.z = cvt_pk_bf16(r[4], r[5]); w.w = cvt_pk_bf16(r[6], r[7]);
                *(u32x4*)rowp = w; }
    }
};
__device__ __forceinline__ unsigned pk4_fp8(float a, float b, float c, float d) { int w = 0; w = __builtin_amdgcn_cvt_pk_fp8_f32(a, b, w, false); w = __builtin_amdgcn_cvt_pk_fp8_f32(c, d, w, true); return (unsigned)w; }
struct EpiSwiGLU8 {
    static constexpr bool PERM = true, AFTER_DRAIN = false;
    unsigned char* O; const float* bias; float ascale;
    __device__ __forceinline__ void operator()(const f32x4 (&acc)[2][2][4][2], const Unit& u, int wr, int wc, int fr, int fq) const {
        const int row0 = u.pm * BM + wr * 64 + fr; const int col0 = u.pn * HALF + wc * 32 + 8 * fq;
        const float* bp = bias + (size_t)u.e * 2048 + col0;
        f32x4 bg[2], bu[2];
#pragma unroll
        for (int n = 0; n < 2; ++n) { bg[n] = *(const f32x4*)(bp + 4 * n); bu[n] = *(const f32x4*)(bp + 1024 + 4 * n); }
#pragma unroll
        for (int ai = 0; ai < 2; ++ai)
#pragma unroll
            for (int m = 0; m < 4; ++m) { unsigned char* rowp = O + (size_t)(row0 + ai * HALF + m * 16) * 1024 + col0;
                float r[8];
#pragma unroll
                for (int n = 0; n < 2; ++n) { const f32x4 gt = acc[ai][0][m][n] * ascale + bg[n], up = acc[ai][1][m][n] * ascale + bu[n];
#pragma unroll
                    for (int i = 0; i < 4; ++i) { const float g = fminf(gt[i], 7.0f), uu = fminf(fmaxf(up[i], -7.0f), 7.0f);
                        const float sg = __builtin_amdgcn_rcpf(1.0f + __builtin_amdgcn_exp2f(-1.702f * 1.4426950408889634f * g));
                        r[4 * n + i] = (uu + 1.0f) * (g * sg); } }
                *(unsigned long long*)rowp = (unsigned long long)pk4_fp8(r[0], r[1], r[2], r[3]) | ((unsigned long long)pk4_fp8(r[4], r[5], r[6], r[7]) << 32); }
    }
};
struct EpiBiasBf16 {
    static constexpr bool PERM = true, AFTER_DRAIN = false;
    bf16_t* O; const float* bias; float ascale;
    __device__ __forceinline__ void operator()(const f32x4 (&acc)[2][2][4][2], const Unit& u, int wr, int wc, int fr, int fq) const {
        const int row0 = u.pm * BM + wr * 64 + fr; const int col0 = u.pn * BM + wc * 32 + 8 * fq;
        const float* bp = bias + (size_t)u.e * 1024 + col0;
        f32x4 bv[2][2];
#pragma unroll
        for (int bj = 0; bj < 2; ++bj)
#pragma unroll
            for (int n = 0; n < 2; ++n) bv[bj][n] = *(const f32x4*)(bp + bj * HALF + 4 * n);
#pragma unroll
        for (int ai = 0; ai < 2; ++ai)
#pragma unroll
            for (int m = 0; m < 4; ++m) { bf16_t* rowp = O + (size_t)(row0 + ai * HALF + m * 16) * 1024 + col0;
#pragma unroll
                for (int bj = 0; bj < 2; ++bj) { const f32x4 v0 = acc[ai][bj][m][0] * ascale + bv[bj][0], v1 = acc[ai][bj][m][1] * ascale + bv[bj][1];
                    u32x4 w; w.x = cvt_pk_bf16(v0[0], v0[1]); w.y = cvt_pk_bf16(v0[2], v0[3]); w.z = cvt_pk_bf16(v1[0], v1[1]); w.w = cvt_pk_bf16(v1[2], v1[3]);
                    *(u32x4*)(rowp + bj * HALF) = w; } }
    }
};

template <class Epi, class Sched, bool ALIGN_EPI = false, bool SP2 = false, bool GATHER = false, bool F8 = false>
__device__ __forceinline__ void gemm_phase(PG8_LAS unsigned char* lds, const Gemm g, const Sched& S, const Epi& E, int tid_in) {
    int tid_l = tid_in; asm volatile("" : "+v"(tid_l));
    const int tid = tid_l, wid = __builtin_amdgcn_readfirstlane(tid >> 6), lane = tid & 63, wr = wid >> 2, wc = wid & 3, fr = lane & 15, fq = lane >> 4;
    const int K = g.K, nt = K / BK;
    unsigned voffA[2], voffB[2];
#pragma unroll
    for (int i = 0; i < 2; ++i) { int R, C; stage_rc(tid * 16 + i * 8192, R, C); const int Rb = Epi::PERM ? ((R & ~31) + perm32(R & 31)) : R;
        voffA[i] = (unsigned)(R * K + C) * 2u; voffB[i] = (unsigned)(Rb * K + C) * 2u; }
    const size_t kstep = (size_t)(BK * 2);
    static_assert(!GATHER || SP2, "GATHER is wired into the SP2 loop only");
    unsigned vAc0[2], vAc1[2], vAn0[2], vAn1[2]; int gR[2]; unsigned gC[2];
#pragma unroll
    for (int i = 0; i < 2; ++i) { int R, C; stage_rc(tid * 16 + i * 8192, R, C); gR[i] = R; gC[i] = (unsigned)C * 2u; vAc0[i] = voffA[i]; vAc1[i] = voffA[i]; vAn0[i] = voffA[i]; vAn1[i] = voffA[i]; }
#define PG8_GFETCH(d0, d1, ord) do { if constexpr (GATHER) { _Pragma("unroll") for (int _i = 0; _i < 2; ++_i) { \
        d0[_i] = (unsigned)g.rowtab[(ord) * 256 + gR[_i]] * (unsigned)(K * 2) + gC[_i]; d1[_i] = (unsigned)g.rowtab[(ord) * 256 + 128 + gR[_i]] * (unsigned)(K * 2) + gC[_i]; } } } while (0)
    const size_t hstep = (size_t)HALF * K * 2;
    const size_t hstepA = GATHER ? 0 : hstep;
    const size_t tstep = 2 * hstep;
    const unsigned ldsw = (unsigned)wid * 1024u;
    const int aoff = lds_byte(wr * 64 + fr, fq * 8), boff = lds_byte(wc * 32 + fr, fq * 8);
    typedef int v8i_t __attribute__((ext_vector_type(8))); typedef int v8i_a16 __attribute__((ext_vector_type(8), aligned(16)));
    const int f8c = 32 * (fq >> 1) + 16 * (fq & 1);
    const int aoff8a = lds_byte(wr * 64 + fr, f8c), boff8a = lds_byte(wc * 32 + fr, f8c);
    v8i_t At8[4], Au8[4], B08[2], B18[2]; int f8scale = 127; asm volatile("" : "+v"(f8scale));
#define PG8_SA(b, h) (((b) * 2 + (h)) * HTB)
#define PG8_SB(b, h) ((4 + (b) * 2 + (h)) * HTB)
#define PG8_STAGE(bufoff, gbase, voff) do { _Pragma("unroll") for (int _i = 0; _i < 2; ++_i) \
        __builtin_amdgcn_global_load_lds((const unsigned*)((const char*)(gbase) + (voff)[_i]), (PG8_LAS unsigned*)(lds + (bufoff) + ldsw + _i * 8192), 16, 0, 0); } while (0)
#define PG8_LDA(dst, b, h) do { if constexpr (F8) { _Pragma("unroll") for (int m = 0; m < 4; ++m) { dst##8[m] = *(const PG8_LAS v8i_a16*)(lds + PG8_SA(b, h) + aoff8a + m * 2048); } } \
        else { _Pragma("unroll") for (int m = 0; m < 4; ++m) _Pragma("unroll") for (int k = 0; k < 2; ++k) dst[m][k] = *(const PG8_LAS bf16x8*)(lds + PG8_SA(b, h) + aoff + m * 2048 + k * 1024); } } while (0)
#define PG8_LDB(dst, b, h) do { if constexpr (F8) { _Pragma("unroll") for (int n = 0; n < 2; ++n) { dst##8[n] = *(const PG8_LAS v8i_a16*)(lds + PG8_SB(b, h) + boff8a + n * 2048); } } \
        else { _Pragma("unroll") for (int n = 0; n < 2; ++n) _Pragma("unroll") for (int k = 0; k < 2; ++k) dst[n][k] = *(const PG8_LAS bf16x8*)(lds + PG8_SB(b, h) + boff + n * 2048 + k * 1024); } } while (0)
#define PG8_MMA(ai, bj, At, Bt) do { __builtin_amdgcn_s_setprio(1); if constexpr (F8) { _Pragma("unroll") for (int m = 0; m < 4; ++m) _Pragma("unroll") for (int n = 0; n < 2; ++n) \
            asm volatile("v_mfma_scale_f32_16x16x128_f8f6f4 %0, %1, %2, %0, %3, %3 op_sel_hi:[0,0,0]" : "+v"(acc[ai][bj][m][n]) : "v"(Bt##8[n]), "v"(At##8[m]), "v"(f8scale)); } \
        else { _Pragma("unroll") for (int m = 0; m < 4; ++m) _Pragma("unroll") for (int n = 0; n < 2; ++n) _Pragma("unroll") for (int k = 0; k < 2; ++k) \
        acc[ai][bj][m][n] = __builtin_amdgcn_mfma_f32_16x16x32_bf16(Bt[n][k], At[m][k], acc[ai][bj][m][n], 0, 0, 0); } __builtin_amdgcn_s_setprio(0); } while (0)
#define PG8_WAIT_V(n) asm volatile("s_waitcnt vmcnt(" #n ")" ::: "memory")
#define PG8_WAIT_L(n) asm volatile("s_waitcnt lgkmcnt(" #n ")" ::: "memory")
#define PG8_BAR __builtin_amdgcn_s_barrier()
#define PG8_SCHED __builtin_amdgcn_sched_barrier(0)
    Unit cur, nxt; int ui = 0;
    if (!S.next(0, cur)) return;
    f32x4 acc[2][2][4][2];
#pragma unroll
    for (int a = 0; a < 2; ++a)
#pragma unroll
        for (int b = 0; b < 2; ++b)
#pragma unroll
            for (int m = 0; m < 4; ++m)
#pragma unroll
                for (int n = 0; n < 2; ++n) acc[a][b][m][n] = (f32x4){0.f, 0.f, 0.f, 0.f};
    bf16x8 At[4][2], Au[4][2], B0[2][2], B1[2][2];
    const char* cA = (const char*)g.A + (GATHER ? (size_t)0 : (size_t)cur.pm * tstep); PG8_GFETCH(vAc0, vAc1, 0); const char* cB = (const char*)g.Bt + (size_t)cur.e * g.bstride + (size_t)cur.pn * tstep;
    S.a_ready(cur);
    if constexpr (SP2) {
        PG8_STAGE(PG8_SB(0, 0), cB, voffB); PG8_STAGE(PG8_SB(0, 1), cB + hstep, voffB); PG8_STAGE(PG8_SA(0, 0), cA, vAc0); PG8_STAGE(PG8_SA(0, 1), cA + hstepA, vAc1);
        if (wr == 1) PG8_BAR;
        PG8_WAIT_V(2); PG8_BAR;
        PG8_STAGE(PG8_SB(1, 0), cB + kstep, voffB); PG8_STAGE(PG8_SA(1, 0), cA + kstep, vAc0); PG8_STAGE(PG8_SB(1, 1), cB + hstep + kstep, voffB);
        PG8_WAIT_V(6); PG8_BAR;
    } else {
        PG8_STAGE(PG8_SB(0, 0), cB, voffB); PG8_STAGE(PG8_SA(0, 0), cA, voffA); PG8_STAGE(PG8_SB(0, 1), cB + hstep, voffB); PG8_STAGE(PG8_SA(0, 1), cA + hstep, voffA);
        if (wr == 1) PG8_BAR;
        PG8_WAIT_V(4); PG8_BAR;
        PG8_STAGE(PG8_SB(1, 0), cB + kstep, voffB); PG8_STAGE(PG8_SA(1, 0), cA + kstep, voffA); PG8_STAGE(PG8_SB(1, 1), cB + hstep + kstep, voffB);
        PG8_WAIT_V(6); PG8_BAR;
    }
    for (;;) {
        const bool has_next = S.next(ui + 1, nxt);
        const char* nA = (has_next && !GATHER) ? (const char*)g.A + (size_t)nxt.pm * tstep : cA;
        if constexpr (GATHER) { if (has_next) PG8_GFETCH(vAn0, vAn1, ui + 1); else { vAn0[0] = vAc0[0]; vAn0[1] = vAc0[1]; vAn1[0] = vAc1[0]; vAn1[1] = vAc1[1]; } }
        const char* nB = has_next ? (const char*)g.Bt + (size_t)nxt.e * g.bstride + (size_t)nxt.pn * tstep : cB;
#pragma unroll 1
        for (int t = 0; t < nt; t += 2) {
            const bool last = (t == nt - 2);
            const char* a1 = cA + (size_t)(t + 1) * kstep;
            const char* a2 = last ? nA : cA + (size_t)(t + 2) * kstep; const char* b2 = last ? nB : cB + (size_t)(t + 2) * kstep;
            const char* a3 = a2 + kstep; const char* b3 = b2 + kstep;
            if (last && has_next) S.a_ready(nxt);
            unsigned vS0[2], vS1[2];
            vS0[0] = last ? vAn0[0] : vAc0[0]; vS0[1] = last ? vAn0[1] : vAc0[1]; vS1[0] = last ? vAn1[0] : vAc1[0]; vS1[1] = last ? vAn1[1] : vAc1[1];
            if constexpr (SP2) {
            PG8_LDB(B0, 0, 0); PG8_LDB(B1, 0, 1); PG8_SCHED; PG8_LDA(At, 0, 0); PG8_STAGE(PG8_SA(1, 1), a1 + hstepA, vAc1);
            PG8_WAIT_V(8); PG8_WAIT_L(0); PG8_BAR; PG8_MMA(0, 0, At, B0); PG8_MMA(0, 1, At, B1); PG8_BAR; PG8_SCHED;
            if constexpr (F8) { PG8_LDA(Au, 0, 1); } else { PG8_LDA(At, 0, 1); } PG8_STAGE(PG8_SB(0, 0), b2, voffB); PG8_STAGE(PG8_SB(0, 1), b2 + hstep, voffB); PG8_STAGE(PG8_SA(0, 0), a2, vS0);
            PG8_WAIT_V(8); PG8_WAIT_L(0); PG8_BAR; if constexpr (F8) { PG8_MMA(1, 0, Au, B0); PG8_MMA(1, 1, Au, B1); } else { PG8_MMA(1, 0, At, B0); PG8_MMA(1, 1, At, B1); } PG8_BAR; PG8_SCHED;
            PG8_LDB(B0, 1, 0); PG8_LDB(B1, 1, 1); PG8_SCHED; PG8_LDA(At, 1, 0); PG8_STAGE(PG8_SA(0, 1), a2 + hstepA, vS1);
            PG8_WAIT_V(8); PG8_WAIT_L(0); PG8_BAR; PG8_MMA(0, 0, At, B0); PG8_MMA(0, 1, At, B1); PG8_BAR; PG8_SCHED;
            if constexpr (F8) { PG8_LDA(Au, 1, 1); } else { PG8_LDA(At, 1, 1); } PG8_STAGE(PG8_SB(1, 0), b3, voffB); PG8_STAGE(PG8_SB(1, 1), b3 + hstep, voffB); PG8_STAGE(PG8_SA(1, 0), a3, vS0);
            PG8_WAIT_V(8); PG8_WAIT_L(0); PG8_BAR; if constexpr (F8) { PG8_MMA(1, 0, Au, B0); PG8_MMA(1, 1, Au, B1); } else { PG8_MMA(1, 0, At, B0); PG8_MMA(1, 1, At, B1); } PG8_BAR; PG8_SCHED;
            } else {
            PG8_LDB(B0, 0, 0); PG8_SCHED; PG8_LDA(At, 0, 0); PG8_STAGE(PG8_SA(1, 1), a1 + hstep, voffA);
            PG8_WAIT_L(8); PG8_BAR; PG8_WAIT_L(0); PG8_MMA(0, 0, At, B0); PG8_BAR; PG8_SCHED;
            PG8_LDB(B1, 0, 1); PG8_STAGE(PG8_SB(0, 0), b2, voffB);
            PG8_BAR; PG8_WAIT_L(0); PG8_MMA(0, 1, At, B1); PG8_BAR;
            PG8_LDA(At, 0, 1); PG8_STAGE(PG8_SA(0, 0), a2, voffA);
            PG8_BAR; PG8_WAIT_L(0); PG8_MMA(1, 0, At, B0); PG8_BAR; PG8_SCHED;
            PG8_STAGE(PG8_SB(0, 1), b2 + hstep, voffB);
            PG8_WAIT_V(6); PG8_BAR; PG8_MMA(1, 1, At, B1); PG8_BAR;
            PG8_LDB(B0, 1, 0); PG8_SCHED; PG8_LDA(At, 1, 0); PG8_STAGE(PG8_SA(0, 1), a2 + hstep, voffA);
            PG8_WAIT_L(8); PG8_BAR; PG8_WAIT_L(0); PG8_MMA(0, 0, At, B0); PG8_BAR; PG8_SCHED;
            PG8_LDB(B1, 1, 1); PG8_STAGE(PG8_SB(1, 0), b3, voffB);
            PG8_BAR; PG8_WAIT_L(0); PG8_MMA(0, 1, At, B1); PG8_BAR;
            PG8_LDA(At, 1, 1); PG8_STAGE(PG8_SA(1, 0), a3, voffA);
            PG8_BAR; PG8_WAIT_L(0); PG8_MMA(1, 0, At, B0); PG8_BAR; PG8_SCHED;
            PG8_STAGE(PG8_SB(1, 1), b3 + hstep, voffB);
            PG8_WAIT_V(6); PG8_BAR; PG8_MMA(1, 1, At, B1); PG8_BAR;
            }
        }
        if constexpr (ALIGN_EPI) { if (wr == 0) PG8_BAR; }
        if constexpr (F8) asm volatile("s_nop 15\n\ts_nop 15" ::: "memory");
        if constexpr (!Epi::AFTER_DRAIN) { E(acc, cur, wr, wc, fr, fq); S.done(cur); }
        if (!has_next) break;
#pragma unroll
        for (int a = 0; a < 2; ++a)
#pragma unroll
            for (int b = 0; b < 2; ++b)
#pragma unroll
                for (int m = 0; m < 4; ++m)
#pragma unroll
                    for (int n = 0; n < 2; ++n) acc[a][b][m][n] = (f32x4){0.f, 0.f, 0.f, 0.f};
        cur = nxt; cA = nA; cB = nB; ++ui;
        if constexpr (GATHER) { vAc0[0] = vAn0[0]; vAc0[1] = vAn0[1]; vAc1[0] = vAn1[0]; vAc1[1] = vAn1[1]; }
        if constexpr (ALIGN_EPI) { if (wr == 1) PG8_BAR; }
    }
    PG8_WAIT_V(0);
    if constexpr (!ALIGN_EPI) { if (wr == 0) PG8_BAR; }
    PG8_BAR;
    if constexpr (Epi::AFTER_DRAIN) { E.fused(acc, cur, wr, wc, fr, fq, lds, wid, lane); S.done(cur); }
#undef PG8_SA
#undef PG8_SB
#undef PG8_STAGE
#undef PG8_LDA
#undef PG8_LDB
#undef PG8_MMA
#undef PG8_WAIT_V
#undef PG8_WAIT_L
#undef PG8_BAR
#undef PG8_SCHED
#undef PG8_GFETCH
}
}
#include <hip/hip_bf16.h>
#include <cmath>
namespace attn_body {
using bf16=__hip_bfloat16;
using bf16x8=__attribute__((ext_vector_type(8)))short;
using s16x4=__attribute__((ext_vector_type(4)))short;
using f32x16=__attribute__((ext_vector_type(16)))float;
using u32x4=__attribute__((ext_vector_type(4)))unsigned;
constexpr int D=64,DM=1024,KVP=256;
constexpr int NW=8,QBLK=32,QB=QBLK*NW,KVBLK=64;
__device__ __forceinline__ int crow(int r,int hi){return (r&3)+8*(r>>2)+4*hi;}
#define SBAR() __builtin_amdgcn_sched_barrier(0)
__device__ __forceinline__ void cmask(f32x16&p0,f32x16&p1,int jb,int qrel,int hi){
  const float NEG=-INFINITY; int kb=64*jb+4*hi;
  #pragma unroll
  for(int r=0;r<16;++r){int kv=kb+(r&3)+8*(r>>2); if(kv>qrel)p0[r]=NEG; if(kv+32>qrel)p1[r]=NEG;}
}

constexpr int NSLOT=3, SLOTB=8192;
constexpr int LDS_K=0, LDS_V=NSLOT*SLOTB, LDS_WS=2*NSLOT*SLOTB, LDS_OST=LDS_WS+NW*64*4, LDS_BYTES=LDS_OST+NW*4096;
constexpr float C2=0.125f*1.4426950408889634f;
__device__ __forceinline__ void glds16(const void*gsrc,unsigned lds_dst){unsigned keep;
  asm volatile("s_mov_b32 %0, m0\n\ts_mov_b32 m0, %2\n\ts_nop 0\n\tglobal_load_lds_dwordx4 %1, off\n\ts_mov_b32 m0, %0":"=&s"(keep):"v"(gsrc),"s"(lds_dst):"memory");}
__device__ __forceinline__ float max3f(float a,float b,float c){float r;asm("v_max3_f32 %0, %1, %2, %3":"=v"(r):"v"(a),"v"(b),"v"(c));return r;}
__device__ __forceinline__ float max2f(float a,float b){float r;asm("v_max_f32_e32 %0, %1, %2":"=v"(r):"v"(a),"v"(b));return r;}
__device__ __forceinline__ float fadd_s(float a,float b){float r;asm("v_add_f32_e32 %0, %1, %2":"=v"(r):"v"(a),"v"(b));return r;}
__device__ __forceinline__ float fsub_s(float a,float b){float r;asm("v_sub_f32_e32 %0, %1, %2":"=v"(r):"v"(a),"v"(b));return r;}
typedef float f32x2_t __attribute__((ext_vector_type(2))); typedef __bf16 bf16x2_t __attribute__((ext_vector_type(2)));
__device__ __forceinline__ unsigned cvtpk_s(float lo,float hi){f32x2_t v={lo,hi};bf16x2_t b=__builtin_convertvector(v,bf16x2_t);return __builtin_bit_cast(unsigned,b);}
#define WAIT_BAR(N) asm volatile("s_waitcnt vmcnt(" #N ") lgkmcnt(0)\n\ts_barrier":::"memory")

__device__ __forceinline__ void qkt(f32x16&p0,f32x16&p1,const char*Kslot,const bf16x8*qr,const f32x16&negm,int r32,int hi){
  const char*kb=Kslot+hi*1024+r32*16;
  #pragma unroll
  for(int d0=0;d0<4;++d0){
    const bf16x8 b0=*reinterpret_cast<const bf16x8*>(kb+d0*2048);
    const bf16x8 b1=*reinterpret_cast<const bf16x8*>(kb+d0*2048+512);
    if(d0==0){p0=__builtin_amdgcn_mfma_f32_32x32x16_bf16(b0,qr[0],negm,0,0,0);p1=__builtin_amdgcn_mfma_f32_32x32x16_bf16(b1,qr[0],negm,0,0,0);}
    else{p0=__builtin_amdgcn_mfma_f32_32x32x16_bf16(b0,qr[d0],p0,0,0,0);p1=__builtin_amdgcn_mfma_f32_32x32x16_bf16(b1,qr[d0],p1,0,0,0);}}
}
typedef __attribute__((address_space(3))) const char* lds_cptr;
typedef short v4i16_t __attribute__((ext_vector_type(4)));
__device__ __forceinline__ void kload8(bf16x8*kf,lds_cptr kp){
  kf[0]=*(const __attribute__((address_space(3))) bf16x8*)(kp);      kf[1]=*(const __attribute__((address_space(3))) bf16x8*)(kp+512);
  kf[2]=*(const __attribute__((address_space(3))) bf16x8*)(kp+2048); kf[3]=*(const __attribute__((address_space(3))) bf16x8*)(kp+2560);
  kf[4]=*(const __attribute__((address_space(3))) bf16x8*)(kp+4096); kf[5]=*(const __attribute__((address_space(3))) bf16x8*)(kp+4608);
  kf[6]=*(const __attribute__((address_space(3))) bf16x8*)(kp+6144); kf[7]=*(const __attribute__((address_space(3))) bf16x8*)(kp+6656);
}
__device__ __forceinline__ void kload2(bf16x8*kf,lds_cptr kp,int j){ kf[2*j]=*(const __attribute__((address_space(3))) bf16x8*)(kp+j*2048); kf[2*j+1]=*(const __attribute__((address_space(3))) bf16x8*)(kp+j*2048+512); }
__device__ __forceinline__ s16x4 vtr(lds_cptr p){ return __builtin_bit_cast(s16x4,__builtin_amdgcn_ds_read_tr16_b64_v4i16((__attribute__((address_space(3))) v4i16_t*)p)); }
__device__ __forceinline__ float rowmax(const f32x16&p0,const f32x16&p1){
  float a=max3f(p0[0],p0[1],p1[0]),b=max3f(p0[2],p0[3],p1[1]);a=max3f(a,p1[2],p1[3]);
  #pragma unroll
  for(int r=4;r<16;r+=4){a=max3f(a,p0[r],p0[r+1]);b=max3f(b,p0[r+2],p0[r+3]);a=max3f(a,p1[r],p1[r+1]);b=max3f(b,p1[r+2],p1[r+3]);}
  const float m=max2f(a,b);
  auto rr=__builtin_amdgcn_permlane32_swap(__float_as_uint(m),__float_as_uint(m),false,false);
  return max2f(__uint_as_float(rr[0]),__uint_as_float(rr[1]));
}
__device__ __forceinline__ void pv(f32x16*o,int vb,bf16x8 pa0,bf16x8 pa1,bf16x8 pa2,bf16x8 pa3){
  #pragma unroll
  for(int d0=0;d0<2;++d0){s16x4 lo[4],hi[4];
    #pragma unroll
    for(int ks=0;ks<4;++ks){
      asm volatile("ds_read_b64_tr_b16 %0,%1 offset:%c2":"=&v"(lo[ks]):"v"(vb),"i"(d0*4096+ks*1024):"memory");
      asm volatile("ds_read_b64_tr_b16 %0,%1 offset:%c2":"=&v"(hi[ks]):"v"(vb),"i"(d0*4096+ks*1024+512):"memory");}
    asm volatile("s_waitcnt lgkmcnt(0)":::"memory");SBAR();
    #define PK(k) (bf16x8){lo[k][0],lo[k][1],lo[k][2],lo[k][3],hi[k][0],hi[k][1],hi[k][2],hi[k][3]}
    o[d0]=__builtin_amdgcn_mfma_f32_32x32x16_bf16(pa0,PK(0),o[d0],0,0,0);
    o[d0]=__builtin_amdgcn_mfma_f32_32x32x16_bf16(pa1,PK(1),o[d0],0,0,0);
    o[d0]=__builtin_amdgcn_mfma_f32_32x32x16_bf16(pa2,PK(2),o[d0],0,0,0);
    o[d0]=__builtin_amdgcn_mfma_f32_32x32x16_bf16(pa3,PK(3),o[d0],0,0,0);
    #undef PK
  }
}

#ifndef ATTN_STORE16
#define ATTN_STORE16(p,v) (*(u32x4*)(p)=(v))
#endif
template<int THRL> __device__ __forceinline__ void attn_unit(long qrow0,long kvrow0,int NT,int h,const bf16*Q,const bf16*__restrict__ K,const bf16*__restrict__ V,bf16*O,char*shm,int tid_in){
  int tid_l=tid_in; asm volatile("":"+v"(tid_l)); const int tid=tid_l,lane=tid&63,r32=lane&31,hi=lane>>5; const int wid=__builtin_amdgcn_readfirstlane(tid>>6);
  const bf16*Qw=Q+(qrow0+wid*QBLK)*DM+h*D;
  const bf16*Kh=K+kvrow0*KVP+(h>>2)*D,*Vh=V+kvrow0*KVP+(h>>2)*D;
  const unsigned lds0=(unsigned)(uintptr_t)shm;
  float*wsf=(float*)(shm+LDS_WS)+wid*64;
  const bf16*ksrc=Kh+(long)lane*KVP+wid*8;
  const bf16*vsrc=Vh+(long)(16*(wid&3)+(lane>>2))*KVP+(wid>>2)*32+(lane&3)*8;
  const unsigned kdst=lds0+LDS_K+wid*1024, vdst=lds0+LDS_V+wid*1024;
  #define DMA_K(t,slot) glds16(ksrc+(long)(t)*KVBLK*KVP,(unsigned)__builtin_amdgcn_readfirstlane(kdst+(slot)))
  #define DMA_V(t,slot) glds16(vsrc+(long)(t)*KVBLK*KVP,(unsigned)__builtin_amdgcn_readfirstlane(vdst+(slot)))
  const int vb0=(int)(lds0+LDS_V)+((lane>>4)&1)*32+(lane&3)*8+(4*hi+((lane&15)>>2))*64;
  const char*Kbase=shm+LDS_K; bf16x8 kf[8];
  const lds_cptr shm3=(lds_cptr)shm; const lds_cptr kp0=shm3+LDS_K+hi*1024+r32*16; const lds_cptr vp0=shm3+LDS_V+((lane>>4)&1)*32+(lane&3)*8+(4*hi+((lane&15)>>2))*64;
  DMA_K(0,0);DMA_V(0,0);DMA_K(1,SLOTB);
  bf16x8 qr[4];
  #pragma unroll
  for(int d0=0;d0<4;++d0)qr[d0]=*reinterpret_cast<const bf16x8*>(&Qw[(long)r32*DM+d0*16+hi*8]);
  float mhat=0.f,l_reg=0.f;f32x16 o[2];o[0]=f32x16{};o[1]=f32x16{};f32x16 negm=f32x16{};asm volatile("":"+v"(negm));
  #define CMASK(P0,P1,t) do{}while(0)
  bool resc=false;
  #define START(P0,P1) do{ const float rm=rowmax(P0,P1); resc=false; \
    { const float dl=rm; mhat=fadd_s(mhat,dl); \
      _Pragma("unroll") for(int r=0;r<16;++r){P0[r]=fsub_s(P0[r],dl);P1[r]=fsub_s(P1[r],dl);} \
      _Pragma("unroll") for(int r=0;r<16;++r)negm[r]=-mhat; asm volatile("":"+v"(negm)); } \
    _Pragma("unroll") for(int r=0;r<16;++r)P0[r]=__builtin_amdgcn_exp2f(P0[r]); }while(0)
  #define RESC() do{ if(resc){ asm volatile("s_waitcnt lgkmcnt(0)":::"memory"); \
      _Pragma("unroll") for(int d_=0;d_<2;++d_) _Pragma("unroll") for(int r=0;r<16;++r)o[d_][r]*=wsf[crow(r,hi)]; } }while(0)
  f32x16 pA0,pA1,pB0,pB1;
  int sl_prev=0,sl_cur=0,sl_next=SLOTB;
  #define ROT() do{sl_prev=sl_cur;sl_cur=sl_next;sl_next=(sl_next==(NSLOT-1)*SLOTB)?0:sl_next+SLOTB;}while(0)
  DMA_K(2,2*SLOTB);
  WAIT_BAR(3);
  qkt(pA0,pA1,Kbase,qr,negm,r32,hi);asm volatile("s_nop 15\n\ts_nop 7":"+v"(pA0),"+v"(pA1));CMASK(pA0,pA1,0);
  START(pA0,pA1);
  _Pragma("unroll") for(int r=0;r<16;++r)pA1[r]=__builtin_amdgcn_exp2f(pA1[r]);
  WAIT_BAR(0);
  DMA_K(3,0);DMA_V(1,SLOTB);
  ROT();
  kload8(kf,kp0+sl_cur);
  WAIT_BAR(2);
  s16x4 vlo[8],vhi[8]; u32x4 pw0,pw1,pw2,pw3;
  #define PKW(P,B) cvtpk_s(P[B],P[B+1])
  #define PAF(k) __builtin_bit_cast(bf16x8,pw##k)
  #define VFR(i) (bf16x8){vlo[i][0],vlo[i][1],vlo[i][2],vlo[i][3],vhi[i][0],vhi[i][1],vhi[i][2],vhi[i][3]}
  #define PIN(x) asm volatile("":"+v"(x))
  #define MX3(a,b,c) __builtin_fmaxf(__builtin_fmaxf((a),(b)),(c))
  #define GAPA(MF,A0,A1,A2,A3,W0,W1,PW) do{ MF; sacc+=A0; sacc+=A1; sacc+=A2; sacc+=A3; PIN(sacc); W0; W1; PIN(PW); SBAR(); }while(0)
  #define EX(v) __builtin_amdgcn_exp2f(v)
  #define GAPB(MF,X,B) do{ MF; X[B]=EX(X[B]); X[B+1]=EX(X[B+1]); X[B+2]=EX(X[B+2]); X[B+3]=EX(X[B+3]); PIN(X); SBAR(); }while(0)
  #define VRD(i) do{ vlo[i]=vtr(vp_+(((i)>>2)*4096+((i)&3)*1024)); vhi[i]=vtr(vp_+(((i)>>2)*4096+((i)&3)*1024+512)); }while(0)
  #define KRD(G,j) do{ if(G){ kload2(kf,kp0+sl_next,j); SBAR(); } }while(0)
  #define STEP(C0,C1,P0,P1,t,GK,GV,GL) do{ SBAR(); \
    const lds_cptr vp_=vp0+sl_prev; \
    VRD(0); SBAR(); float sacc=(P0[0]+P0[1]); \
    GAPA(C0=__builtin_amdgcn_mfma_f32_32x32x16_bf16(kf[0],qr[0],negm,0,0,0), P0[2],P0[3],P0[4],P0[5],     pw0[0]=PKW(P0,0), pw0[1]=PKW(P0,2), pw0); \
    VRD(4); SBAR(); GAPA(C1=__builtin_amdgcn_mfma_f32_32x32x16_bf16(kf[1],qr[0],negm,0,0,0), P0[6],P0[7],P0[8],P0[9],     pw0[2]=PKW(P0,4), pw0[3]=PKW(P0,6), pw0); \
    VRD(1); SBAR(); GAPA(C0=__builtin_amdgcn_mfma_f32_32x32x16_bf16(kf[2],qr[1],C0,0,0,0),   P0[10],P0[11],P0[12],P0[13], pw1[0]=PKW(P0,8), pw1[1]=PKW(P0,10), pw1); \
    VRD(5); SBAR(); GAPA(C1=__builtin_amdgcn_mfma_f32_32x32x16_bf16(kf[3],qr[1],C1,0,0,0),   P0[14],P0[15],P1[0],P1[1],   pw1[2]=PKW(P0,12),pw1[3]=PKW(P0,14), pw1); \
    VRD(2); SBAR(); GAPA(C0=__builtin_amdgcn_mfma_f32_32x32x16_bf16(kf[4],qr[2],C0,0,0,0),   P1[2],P1[3],P1[4],P1[5],     pw2[0]=PKW(P1,0), pw2[1]=PKW(P1,2), pw2); \
    VRD(6); SBAR(); GAPA(C1=__builtin_amdgcn_mfma_f32_32x32x16_bf16(kf[5],qr[2],C1,0,0,0),   P1[6],P1[7],P1[8],P1[9],     pw2[2]=PKW(P1,4), pw2[3]=PKW(P1,6), pw2); \
    VRD(3); SBAR(); GAPA(C0=__builtin_amdgcn_mfma_f32_32x32x16_bf16(kf[6],qr[3],C0,0,0,0),   P1[10],P1[11],P1[12],P1[13], pw3[0]=PKW(P1,8), pw3[1]=PKW(P1,10), pw3); \
    VRD(7); SBAR(); GAPA(C1=__builtin_amdgcn_mfma_f32_32x32x16_bf16(kf[7],qr[3],C1,0,0,0),   P1[14],P1[15],0.f,0.f,       pw3[2]=PKW(P1,12),pw3[3]=PKW(P1,14), pw3); \
    l_reg+=sacc; \
    if(GK){DMA_K((t)+3,sl_cur);} if(GV){DMA_V((t)+1,sl_next);} \
    CMASK(C0,C1,t); \
    { float a=MX3(C0[0],C0[1],C1[0]),b=MX3(C0[2],C0[3],C1[1]); a=MX3(a,C1[2],C1[3]); \
      _Pragma("unroll") for(int r=4;r<16;r+=4){a=MX3(a,C0[r],C0[r+1]);b=MX3(b,C0[r+2],C0[r+3]);a=MX3(a,C1[r],C1[r+1]);b=MX3(b,C1[r+2],C1[r+3]);} \
      float rm=__builtin_fmaxf(a,b); { auto rr=__builtin_amdgcn_permlane32_swap(__float_as_uint(rm),__float_as_uint(rm),false,false); rm=__builtin_fmaxf(__uint_as_float(rr[0]),__uint_as_float(rr[1])); } \
      resc=false; \
      if(__builtin_expect(__any(rm>(float)THRL),0)){ const float dl=__builtin_fmaxf(rm,0.f); mhat+=dl; \
        _Pragma("unroll") for(int r=0;r<16;++r){C0[r]-=dl;C1[r]-=dl;} \
        _Pragma("unroll") for(int r=0;r<16;++r)negm[r]=-mhat; asm volatile("":"+v"(negm)); \
        const float f=__builtin_amdgcn_exp2f(-dl); l_reg*=f; if(hi==0)wsf[r32]=f; resc=true; } } \
    SBAR(); \
    GAPB(o[0]=__builtin_amdgcn_mfma_f32_32x32x16_bf16(PAF(0),VFR(0),o[0],0,0,0), C0,0); \
    GAPB(o[1]=__builtin_amdgcn_mfma_f32_32x32x16_bf16(PAF(0),VFR(4),o[1],0,0,0), C0,4); \
    KRD(GL,0); GAPB(o[0]=__builtin_amdgcn_mfma_f32_32x32x16_bf16(PAF(1),VFR(1),o[0],0,0,0), C0,8); \
    KRD(GL,1); GAPB(o[1]=__builtin_amdgcn_mfma_f32_32x32x16_bf16(PAF(1),VFR(5),o[1],0,0,0), C0,12); \
    KRD(GL,2); GAPB(o[0]=__builtin_amdgcn_mfma_f32_32x32x16_bf16(PAF(2),VFR(2),o[0],0,0,0), C1,0); \
    KRD(GL,3); GAPB(o[1]=__builtin_amdgcn_mfma_f32_32x32x16_bf16(PAF(2),VFR(6),o[1],0,0,0), C1,4); \
    GAPB(o[0]=__builtin_amdgcn_mfma_f32_32x32x16_bf16(PAF(3),VFR(3),o[0],0,0,0), C1,8); \
    GAPB(o[1]=__builtin_amdgcn_mfma_f32_32x32x16_bf16(PAF(3),VFR(7),o[1],0,0,0), C1,12); \
    }while(0)
  int t=1;
  #undef CMASK
  #define CMASK(P0,P1,t) do{}while(0)
  for(;t+5<NT;t+=2){
    STEP(pB0,pB1,pA0,pA1,t,true,true,true);     WAIT_BAR(2); RESC(); ROT();
    STEP(pA0,pA1,pB0,pB1,t+1,true,true,true);   WAIT_BAR(2); RESC(); ROT();
  }
  #undef CMASK
  #define CMASK(P0,P1,t) do{}while(0)
  #define ENDW(tt) do{ if((tt)+3<NT){WAIT_BAR(2);} else if((tt)+2<NT){WAIT_BAR(1);} else {WAIT_BAR(0);} }while(0)
  for(;t+1<NT;t+=2){
    STEP(pB0,pB1,pA0,pA1,t,(t+3<NT),(t+1<NT),(t+1<NT));       ENDW(t);   RESC(); ROT();
    STEP(pA0,pA1,pB0,pB1,t+1,(t+4<NT),(t+2<NT),(t+2<NT));     ENDW(t+1); RESC(); ROT();
  }
  STEP(pB0,pB1,pA0,pA1,NT-1,false,false,false); RESC();
  { float sacc=pB0[0]+pB0[1]; _Pragma("unroll") for(int r=2;r<16;++r)sacc+=pB0[r]; _Pragma("unroll") for(int r=0;r<16;++r)sacc+=pB1[r]; l_reg+=sacc;
    pw0=(u32x4){PKW(pB0,0),PKW(pB0,2),PKW(pB0,4),PKW(pB0,6)};pw1=(u32x4){PKW(pB0,8),PKW(pB0,10),PKW(pB0,12),PKW(pB0,14)};pw2=(u32x4){PKW(pB1,0),PKW(pB1,2),PKW(pB1,4),PKW(pB1,6)};pw3=(u32x4){PKW(pB1,8),PKW(pB1,10),PKW(pB1,12),PKW(pB1,14)};
    SBAR(); pv(o,vb0+sl_cur,PAF(0),PAF(1),PAF(2),PAF(3)); }
  #undef PKW
  #undef PAF
  #undef VFR
  #undef PIN
  #undef MX3
  #undef GAPA
  #undef GAPB
  #undef EX
  #undef VRD
  #undef KRD
  #undef STEP
  #undef ENDW
  {auto rr=__builtin_amdgcn_permlane32_swap(__float_as_uint(l_reg),__float_as_uint(l_reg),false,false);l_reg=__uint_as_float(rr[0])+__uint_as_float(rr[1]);}
  if(hi==0)wsf[32+r32]=l_reg;asm volatile("s_waitcnt lgkmcnt(0)":::"memory");
  float rli[16];
  #pragma unroll
  for(int r=0;r<16;++r)rli[r]=__builtin_amdgcn_rcpf(wsf[32+crow(r,hi)]);
  bf16*Ow=O+(qrow0+wid*QBLK)*DM+h*D;
  { bf16*stg=(bf16*)(shm+LDS_OST)+wid*2048;
    #pragma unroll
    for(int r=0;r<16;++r){const int orow=crow(r,hi);
      #pragma unroll
      for(int d0=0;d0<2;++d0)stg[orow*64+d0*32+r32]=__float2bfloat16(o[d0][r]*rli[r]);}
    asm volatile("s_waitcnt lgkmcnt(0)":::"memory");
    #pragma unroll
    for(int i=0;i<4;++i){const int row=i*8+(lane>>3),ch=lane&7; const u32x4 v=*(const u32x4*)(stg+row*64+ch*8); ATTN_STORE16(Ow+(long)row*DM+ch*8,v);} }
  asm volatile("s_waitcnt lgkmcnt(0)\n\ts_barrier":::"memory");
  #undef DMA_K
  #undef DMA_V
  #undef CMASK
  #undef START
  #undef RESC
  #undef ROT
}
constexpr int ATTN_LDS_BYTES=LDS_BYTES;
#undef SBAR
#undef WAIT_BAR
}

constexpr int NWAVES = 8;
constexpr int NB = 8, SEQ = 4096, CTXL = 256, TB = SEQ + CTXL  , MT = NB * TB  , DMODEL = 1024;
constexpr int NMODC = 6 * DMODEL, MODROWS = 9;
constexpr int QKVN = 1536, WINN = 3104, WINP = 3328;
constexpr int NEXP = 32, TOPK = 4, MPAD = MT * TOPK + NEXP * 256;
constexpr int NLAYER = 4;
constexpr float RMS_EPS = 1e-6f;
constexpr float ATT_C2 = 0.125f * 1.4426950408889634f;

constexpr size_t MiB = 1u << 20;
constexpr size_t WS_CTL = 0, CTL_ZERO_BYTES = 1 * MiB;
constexpr size_t WS_MOD = 1 * MiB, WS_ROPE = 2 * MiB, WS_MODP = 3 * MiB;
constexpr size_t WS_SLOT = 17 * MiB, WS_GATEW = 18 * MiB, WS_SLOTPOS = 19 * MiB;
constexpr size_t WS_WQKV = 20 * MiB, WS_WOA = 26 * MiB, WS_WIN = 30 * MiB, WS_WOG = 43 * MiB, WS_WGU = 48 * MiB, WS_WDN = 560 * MiB;
constexpr size_t WS_X = 816 * MiB, WS_XN = 952 * MiB, WS_Q = 1020 * MiB, WS_K = 1088 * MiB, WS_V = 1105 * MiB, WS_G = 1122 * MiB;
constexpr size_t WS_OF = 1343 * MiB, WS_OB = 1479 * MiB, WS_XG = 1615 * MiB, WS_ACT = 1903 * MiB, WS_Y = 2191 * MiB, WS_XN8 = WS_ACT + 150 * MiB  , WS_PAR = 2479 * MiB, WS_LIST = 2483 * MiB  , WS_END = 2488 * MiB;
static_assert(WS_MODP + (size_t)16 * NLAYER * MODROWS * NMODC * 4 <= WS_SLOT && WS_WIN + (size_t)2 * WINP * 1024 * 2 <= WS_WOG && WS_G + (size_t)MT * WINP * 2 <= WS_OF && WS_XG + (size_t)MPAD * 1024 * 2 <= WS_ACT, "ws map");
constexpr int CW_TMO = 0, CW_BAR = 4096, CW_CNT = 16384;

constexpr int RING_OFF = 0, RING_BYTES = 131072;
constexpr int WR_STRIDE = 1028;
constexpr int LDS_AUX = 133120;
constexpr int AUX_LCNT = LDS_AUX, AUX_GB = LDS_AUX + 128, AUX_T2E = LDS_AUX + 256  , AUX_BASE = AUX_T2E + 2560  , AUX_NT = AUX_BASE + 128, AUX_CNT = AUX_NT + 64  , AUX_ENT = AUX_CNT + 128  , AUX_RS = AUX_ENT + 4352  , AUX_ROWTAB = AUX_RS + 576, ROWTAB_UNITS = 18  ;
constexpr int MISC_OFF = 154624;
constexpr int LDS_BYTES = 155648;
static_assert(AUX_ROWTAB + ROWTAB_UNITS * 512 <= MISC_OFF, "LDS map");

#define GAS __attribute__((address_space(1)))
#define LAS __attribute__((address_space(3)))
typedef unsigned short bf16;
typedef unsigned v4u __attribute__((ext_vector_type(4)));
typedef float f32x4 __attribute__((ext_vector_type(4)));
typedef short bf16x8 __attribute__((ext_vector_type(8)));
typedef GAS unsigned gu32;
typedef GAS unsigned long long gu64;
#define RLX_AGENT __ATOMIC_RELAXED, __HIP_MEMORY_SCOPE_AGENT
#define LDS_WAIT() asm volatile("s_waitcnt lgkmcnt(0)" ::: "memory")
#define VM_WAIT() asm volatile("s_waitcnt vmcnt(0)" ::: "memory")
__device__ __forceinline__ unsigned long long rt() { return __builtin_amdgcn_s_memrealtime(); }
__device__ __forceinline__ unsigned f2bf(float f) { unsigned u = __builtin_bit_cast(unsigned, f); return (u + 0x7fffu + ((u >> 16) & 1u)) >> 16; }
__device__ __forceinline__ unsigned pk2(float lo, float hi) { return f2bf(lo) | (f2bf(hi) << 16); }

#define XB_TMO      128
#define XB_XCNT(j)  (256  + 64 * (j))
#define XB_XSUB(j)  (1280 + 64 * (j))
#define XB_XGEN(j)  (2304 + 64 * (j))
#define XB_TOP      3328
#define XB_TOPGEN   3392
#define XCD_BAR_WORDS 3456
#define XB_SPIN_CAP (1u << 18)

__device__ __forceinline__ unsigned xb_ld(unsigned* p)              { return __hip_atomic_load(p, __ATOMIC_RELAXED, __HIP_MEMORY_SCOPE_AGENT); }
__device__ __forceinline__ unsigned xb_add(unsigned* p, unsigned v) { return __hip_atomic_fetch_add(p, v, __ATOMIC_RELAXED, __HIP_MEMORY_SCOPE_AGENT); }
__device__ __forceinline__ unsigned xb_xcc_id() { return (unsigned)__builtin_amdgcn_s_getreg((3 << 11) | 20) & 0xFu; }
#define XB_SPIN(cond, bar) do { unsigned _sp = 0; while (cond) { __builtin_amdgcn_s_sleep(1); \
    if ((++_sp & 255u) == 0u) { if (xb_ld(&(bar)[XB_TMO])) break; if (_sp > XB_SPIN_CAP) { atomicAdd(&(bar)[XB_TMO], 1u); break; } } } } while (0)

struct XcdBarrier {
    unsigned* bar; unsigned x;
    volatile LAS unsigned* st;
};

__device__ __forceinline__ XcdBarrier xcd_barrier_post(unsigned* bar, volatile LAS unsigned* st, bool xb_t0  ) {
    XcdBarrier b; b.bar = bar; b.x = xb_xcc_id(); b.st = st;
    if (xb_t0) (void)xb_add(&bar[XB_XCNT(b.x)], 1u);
    return b;
}
__device__ __forceinline__ void xcd_barrier_complete(unsigned* bar, unsigned x, unsigned& nloc, unsigned& nx) {
    const unsigned G = gridDim.x * gridDim.y * gridDim.z;
    unsigned sum, cnt, mine, sp = 0u;
    for (;;) {
        sum = 0u; cnt = 0u; mine = 0u;
#pragma unroll
        for (unsigned j = 0; j < 16; ++j) { const unsigned c = xb_ld(&bar[XB_XCNT(j)]); sum += c; cnt += (c > 0u) ? 1u : 0u; mine = (j == x) ? c : mine; }
        if (sum == G) break;
        __builtin_amdgcn_s_sleep(1);
        if ((++sp & 255u) == 0u) { if (xb_ld(&bar[XB_TMO])) break; if (sp > XB_SPIN_CAP) { atomicAdd(&bar[XB_TMO], 1u); break; } }
    }
    nloc = mine > 0u ? mine : 1u; nx = cnt > 0u ? cnt : 1u;
}

__device__ __forceinline__ void xcd_barrier(const XcdBarrier& b, bool xb_t0  ) {
    asm volatile("s_waitcnt vmcnt(0)" ::: "memory");
    __syncthreads();
    if (xb_t0) {
        unsigned* bar = b.bar;
        __builtin_amdgcn_s_waitcnt(0);
        unsigned nloc = b.st[0], nx = b.st[1];
        if (nloc == 0u) { xcd_barrier_complete(bar, b.x, nloc, nx); b.st[0] = nloc; b.st[1] = nx; }
        const unsigned old = xb_add(&bar[XB_XSUB(b.x)], 1u);
        const unsigned gen = old / nloc;
        if (old + 1u == (gen + 1u) * nloc) {
            __builtin_amdgcn_fence(__ATOMIC_RELEASE, "agent");
            asm volatile("s_waitcnt vmcnt(0)" ::: "memory");
            const unsigned og = xb_add(&bar[XB_TOP], 1u);
            const unsigned tg = og / nx;
            if (og + 1u == (tg + 1u) * nx) xb_add(&bar[XB_TOPGEN], 1u);
            else XB_SPIN(xb_ld(&bar[XB_TOPGEN]) == tg, bar);
            __builtin_amdgcn_fence(__ATOMIC_ACQUIRE, "agent");
            xb_add(&bar[XB_XGEN(b.x)], 1u);
            asm volatile("s_waitcnt vmcnt(0)" ::: "memory");
        } else {
            XB_SPIN(xb_ld(&bar[XB_XGEN(b.x)]) == gen, bar);
            __builtin_amdgcn_fence(__ATOMIC_ACQUIRE, "agent");
            asm volatile("s_waitcnt vmcnt(0)" ::: "memory");
        }
    }
    __syncthreads();
}

typedef float f32x2 __attribute__((ext_vector_type(2)));
using pg8::lane_now; using pg8::shx;
__device__ __forceinline__ float wave_sum(float v) {
    const int ln = lane_now();
#pragma unroll
    for (int o = 1; o < 64; o <<= 1) v += shx(v, o, ln);
    return v;
}
__device__ __forceinline__ float wave_max(float v) {
    const int ln = lane_now();
#pragma unroll
    for (int o = 1; o < 64; o <<= 1) v = fmaxf(v, shx(v, o, ln));
    return v;
}
__device__ __forceinline__ float bf2f(unsigned short h) { return __uint_as_float((unsigned)h << 16); }
__device__ __forceinline__ float silu_f(float x) { return x / (1.0f + __expf(-x)); }
__device__ __forceinline__ f32x4 bf4_to_f32(unsigned long long v) { return (f32x4){__uint_as_float((unsigned)(v & 0xffffu) << 16), __uint_as_float((unsigned)(v >> 16) << 16), __uint_as_float((unsigned)((v >> 32) & 0xffffu) << 16), __uint_as_float((unsigned)(v >> 48) << 16)}; }
__device__ __forceinline__ unsigned long long f32_to_bf4(f32x4 y) { return (unsigned long long)pk2(y.x, y.y) | ((unsigned long long)pk2(y.z, y.w) << 32); }
__device__ __forceinline__ int mod_row(int m) { const int b = m / TB; return (m - b * TB < CTXL) ? 8 : b; }

__device__ __forceinline__ void transpose_item(const float* W, int K, int N, bf16* WT, int k0, int n0, int dst_row0, LAS float* scr, int lane) {
#pragma unroll 8
    for (int i = 0; i < 32; ++i) { const int kk = 2 * i + (lane >> 5); scr[kk * 33 + (lane & 31)] = W[(size_t)(k0 + kk) * N + n0 + (lane & 31)]; }
    LDS_WAIT(); asm volatile("" ::: "memory");
    const int c = lane & 7;
#pragma unroll
    for (int j = 0; j < 4; ++j) { const int n = (lane >> 3) + 8 * j; const LAS float* s = scr + (8 * c) * 33 + n;
        v4u o; o.x = pk2(s[0 * 33], s[1 * 33]); o.y = pk2(s[2 * 33], s[3 * 33]); o.z = pk2(s[4 * 33], s[5 * 33]); o.w = pk2(s[6 * 33], s[7 * 33]);
        *(GAS v4u*)(WT + (size_t)(dst_row0 + n) * K + k0 + 8 * c) = o; }
    LDS_WAIT(); asm volatile("" ::: "memory");
}

__device__ __forceinline__ void transpose_item8(const float* W, int K, int N, unsigned char* WT8, int k0, int n0, int dst_row0, LAS float* scr, int lane) {
#pragma unroll 8
    for (int i = 0; i < 32; ++i) { const int kk = 2 * i + (lane >> 5); scr[kk * 33 + (lane & 31)] = W[(size_t)(k0 + kk) * N + n0 + (lane & 31)]; }
    LDS_WAIT(); asm volatile("" ::: "memory");
    const int n = lane & 31;
#pragma unroll
    for (int q = 0; q < 2; ++q) { const int ch = (lane >> 5) + 2 * q; const LAS float* s = scr + (16 * ch) * 33 + n;
        v4u o;
        o.x = pg8::pk4_fp8(s[0 * 33] * 32.f, s[1 * 33] * 32.f, s[2 * 33] * 32.f, s[3 * 33] * 32.f); o.y = pg8::pk4_fp8(s[4 * 33] * 32.f, s[5 * 33] * 32.f, s[6 * 33] * 32.f, s[7 * 33] * 32.f);
        o.z = pg8::pk4_fp8(s[8 * 33] * 32.f, s[9 * 33] * 32.f, s[10 * 33] * 32.f, s[11 * 33] * 32.f); o.w = pg8::pk4_fp8(s[12 * 33] * 32.f, s[13 * 33] * 32.f, s[14 * 33] * 32.f, s[15 * 33] * 32.f);
        *(GAS v4u*)(WT8 + (size_t)(dst_row0 + n) * K + k0 + 16 * ch) = o; }
    LDS_WAIT(); asm volatile("" ::: "memory");
}

struct Args { const float* in[25]; float* out; unsigned char* ws; int ph_lo, ph_hi; };
constexpr int P_N1G = 0, P_N2G = 4096, P_QG = 8192, P_KG = 8320, P_GKF = 8448, P_GKB = 24832, P_BGF = 41216, P_BGB = 42240, P_OG = 43264, P_WR = 43776, P_BR = 174848, P_BGU = 174976, P_BDN = 437120, P_END = 568192;
#define LAUNDER_S(p) asm volatile("" : "+s"(p))
#define LAUNDER_V(p) asm volatile("" : "+v"(p))
#define PARF(ws) ((const float*)((ws) + WS_PAR))

__device__ __forceinline__ void p0_prologue(const Args& A, LAS unsigned char* lds, int gw, int NGW, int wave, int lane) {
    unsigned char* ws = A.ws;
    LAS float* scr = (LAS float*)(lds + RING_OFF + wave * 16384);
    constexpr int I_QKV = 2 * 16 * (QKVN / 32), I_WO = 2 * 16 * 32, I_WIN = 2 * 16 * (WINN / 32), I_GU = 128 * 16 * 64, I_DN = 128 * 16 * 32;
    constexpr int NITEMS = I_GU + I_DN + I_QKV + I_WO + I_WIN + I_WO;
    for (int it = gw; it < NITEMS; it += NGW) {
        int r = it;
        if (r < I_GU) { const int mat = r / (16 * 64), q = r - mat * (16 * 64), kb = q / 64, nb = q - kb * 64, n0 = nb * 32;
            const int dst = ((n0 & 1023) >> 7) * 256 + (n0 >> 10) * 128 + (n0 & 127);
            transpose_item8(A.in[21] + (size_t)mat * 1024 * 2048, 1024, 2048, ws + WS_WGU + (size_t)mat * 2048 * 1024, kb * 64, n0, dst, scr, lane); continue; } r -= I_GU;
        if (r < I_DN) { const int mat = r / (16 * 32), q = r - mat * (16 * 32), kb = q / 32, nb = q - kb * 32;
            transpose_item8(A.in[23] + (size_t)mat * 1024 * 1024, 1024, 1024, ws + WS_WDN + (size_t)mat * 1024 * 1024, kb * 64, nb * 32, nb * 32, scr, lane); continue; } r -= I_DN;
        if (r < I_QKV) { const int per = 16 * (QKVN / 32), mat = r / per, q = r - mat * per, kb = q / (QKVN / 32), nb = q - kb * (QKVN / 32);
            const int n0 = nb * 32, dst = (n0 & ~255) + ((n0 >> 5) & 1) * 128 + ((n0 >> 6) & 3) * 32;
            transpose_item(A.in[8] + (size_t)mat * 1024 * QKVN, 1024, QKVN, (bf16*)(ws + WS_WQKV) + (size_t)mat * QKVN * 1024, kb * 64, n0, dst, scr, lane); continue; } r -= I_QKV;
        if (r < I_WO) { const int mat = r / 512, q = r - mat * 512, kb = q / 32, nb = q - kb * 32;
            transpose_item(A.in[11] + (size_t)mat * 1024 * 1024, 1024, 1024, (bf16*)(ws + WS_WOA) + (size_t)mat * 1024 * 1024, kb * 64, nb * 32, nb * 32, scr, lane); continue; } r -= I_WO;
        if (r < I_WIN) { const int per = 16 * (WINN / 32), mat = r / per, q = r - mat * per, kb = q / (WINN / 32), nb = q - kb * (WINN / 32);
            transpose_item(A.in[12] + (size_t)mat * 1024 * WINN, 1024, WINN, (bf16*)(ws + WS_WIN) + (size_t)mat * WINP * 1024, kb * 64, nb * 32, nb * 32, scr, lane); continue; } r -= I_WIN;
        { const int mat = r / 512, q = r - mat * 512, kb = q / 32, nb = q - kb * 32;
            transpose_item(A.in[18] + (size_t)mat * 1024 * 1024, 1024, 1024, (bf16*)(ws + WS_WOG) + (size_t)mat * 1024 * 1024, kb * 64, nb * 32, nb * 32, scr, lane); }
    }
    for (int it = gw; it < 2 * (WINP - WINN); it += NGW) { const int mat = it / (WINP - WINN), rr = WINN + it - mat * (WINP - WINN);
        GAS v4u* p = (GAS v4u*)((bf16*)(ws + WS_WIN) + ((size_t)mat * WINP + rr) * 1024) + lane; p[0] = (v4u){0u, 0u, 0u, 0u}; p[64] = (v4u){0u, 0u, 0u, 0u}; }
    for (int it = gw; it < NLAYER * 24 * 16; it += NGW) {
        const int l = it / (24 * 16), q = it - l * (24 * 16), cg = q / 16, kc = q - cg * 16;
        float s[MODROWS];
#pragma unroll
        for (int r = 0; r < MODROWS; ++r) { const float cv = (r < 8) ? A.in[1][r * 1024 + kc * 64 + lane] : A.in[3][kc * 64 + lane]; s[r] = silu_f(cv); }
        f32x4 acc[MODROWS];
#pragma unroll
        for (int r = 0; r < MODROWS; ++r) acc[r] = (f32x4){0.f, 0.f, 0.f, 0.f};
        const float* wp = A.in[4] + ((size_t)l * 1024 + kc * 64) * NMODC + cg * 256 + 4 * lane;
#pragma unroll 4
        for (int kk = 0; kk < 64; ++kk) { const f32x4 w = *(const f32x4*)(wp + (size_t)kk * NMODC);
#pragma unroll
            for (int r = 0; r < MODROWS; ++r) { const float sv = __shfl(s[r], kk); acc[r] = acc[r] + w * sv; } }
        float* op = (float*)(ws + WS_MODP) + (size_t)kc * (NLAYER * MODROWS * NMODC) + (size_t)l * MODROWS * NMODC + cg * 256 + 4 * lane;
#pragma unroll
        for (int r = 0; r < MODROWS; ++r) *(f32x4*)(op + (size_t)r * NMODC) = acc[r];
    }
    for (int m = gw; m < MT; m += NGW) { const int b = m / TB, w = m - b * TB;
        const float* src = (w < CTXL) ? A.in[2] + ((size_t)b * CTXL + w) * 1024 : A.in[0] + ((size_t)b * SEQ + (w - CTXL)) * 1024;
        const GAS f32x4* sp = (const GAS f32x4*)src + lane; GAS unsigned long long* dp = (GAS unsigned long long*)((bf16*)(ws + WS_X) + (size_t)m * 1024) + lane;
#pragma unroll
        for (int j = 0; j < 4; ++j) dp[64 * j] = f32_to_bf4(sp[64 * j]); }
    { float* par = (float*)(ws + WS_PAR); const int gt = gw * 64 + lane, NGT = NGW * 64;
#define CPY(src, n, off) for (int i = gt; i < (n); i += NGT) par[(off) + i] = A.in[src][i];
      CPY(6, 4096, P_N1G) CPY(7, 4096, P_N2G) CPY(9, 128, P_QG) CPY(10, 128, P_KG) CPY(13, 16384, P_GKF) CPY(15, 16384, P_GKB) CPY(14, 1024, P_BGF) CPY(16, 1024, P_BGB)
      CPY(17, 512, P_OG) CPY(19, 131072, P_WR) CPY(20, 128, P_BR) CPY(22, 262144, P_BGU) CPY(24, 131072, P_BDN)
#undef CPY
    }
    for (int idx = gw * 64 + lane; idx < SEQ * 32; idx += NGW * 64) { const int s = idx >> 5, i = idx & 31;
        const float invf = 1.0f / powf(10000.0f, (float)(i & 15) * (1.0f / 16.0f));
        const float ang = (float)((i < 16) ? (s >> 6) : (s & 63)) * invf;
        ((float*)(ws + WS_ROPE))[idx] = cosf(ang); ((float*)(ws + WS_ROPE))[SEQ * 32 + idx] = sinf(ang); }
}
__device__ __forceinline__ void p1_mod_reduce(const Args& A, int gtid, int NGT) {
    const float* P = (const float*)(A.ws + WS_MODP); float* Mo = (float*)(A.ws + WS_MOD);
    constexpr int N = NLAYER * MODROWS * NMODC;
    for (int i = gtid; i < N; i += NGT) { const int l = i / (MODROWS * NMODC), c = i % NMODC; float s = A.in[5][l * NMODC + c];
#pragma unroll
        for (int k = 0; k < 16; ++k) s += P[(size_t)k * N + i];
        Mo[i] = s; }
}
__device__ __forceinline__ void modulate_row(const bf16* xrow, const float* ng, const float* shp, const float* scp, bf16* orow, int lane, f32x4 (&y)[4], float& rs_out) {
    const GAS unsigned long long* xr = (const GAS unsigned long long*)xrow + lane;
    float ss = 0.f;
#pragma unroll
    for (int j = 0; j < 4; ++j) { y[j] = bf4_to_f32(xr[64 * j]); ss += (y[j].x * y[j].x + y[j].y * y[j].y) + (y[j].z * y[j].z + y[j].w * y[j].w); }
    const float rs = 1.0f / sqrtf(wave_sum(ss) * (1.0f / 1024.0f) + RMS_EPS); rs_out = rs;
    GAS unsigned long long* o8 = (GAS unsigned long long*)orow + lane;
#pragma unroll
    for (int j = 0; j < 4; ++j) { const f32x4 g = ((const GAS f32x4*)ng)[64 * j + lane], sh = ((const GAS f32x4*)shp)[64 * j + lane], sc = ((const GAS f32x4*)scp)[64 * j + lane];
        y[j] = (y[j] * rs) * g * (sc + 1.0f) + sh;
        o8[64 * j] = (unsigned long long)pk2(y[j].x, y[j].y) | ((unsigned long long)pk2(y[j].z, y[j].w) << 32); }
}
__device__ __forceinline__ void modulate_row2(const bf16* xa, const bf16* xb, const float* ng, const float* sha, const float* sca, const float* shb, const float* scb, unsigned char* oa, unsigned char* ob, int lane, float& rsa, float& rsb) {
    const GAS unsigned long long* pa = (const GAS unsigned long long*)xa + lane; const GAS unsigned long long* pb = (const GAS unsigned long long*)xb + lane;
    unsigned long long ra[4], rb[4];
#pragma unroll
    for (int j = 0; j < 4; ++j) { ra[j] = pa[64 * j]; rb[j] = pb[64 * j]; }
    f32x4 ya[4], yb[4]; float sa = 0.f, sb = 0.f;
#pragma unroll
    for (int j = 0; j < 4; ++j) { ya[j] = bf4_to_f32(ra[j]); yb[j] = bf4_to_f32(rb[j]); sa += (ya[j].x * ya[j].x + ya[j].y * ya[j].y) + (ya[j].z * ya[j].z + ya[j].w * ya[j].w); sb += (yb[j].x * yb[j].x + yb[j].y * yb[j].y) + (yb[j].z * yb[j].z + yb[j].w * yb[j].w); }
    const int ln = lane_now();
#pragma unroll
    for (int o = 1; o < 64; o <<= 1) { sa += shx(sa, o, ln); sb += shx(sb, o, ln); }
    rsa = 1.0f / sqrtf(sa * (1.0f / 1024.0f) + RMS_EPS); rsb = 1.0f / sqrtf(sb * (1.0f / 1024.0f) + RMS_EPS);
    GAS unsigned* qa = (GAS unsigned*)oa + lane; GAS unsigned* qb = (GAS unsigned*)ob + lane;
#pragma unroll
    for (int j = 0; j < 4; ++j) { const f32x4 g = ((const GAS f32x4*)ng)[64 * j + lane];
        const f32x4 ha = ((const GAS f32x4*)sha)[64 * j + lane], ca = ((const GAS f32x4*)sca)[64 * j + lane], hb = ((const GAS f32x4*)shb)[64 * j + lane], cb = ((const GAS f32x4*)scb)[64 * j + lane];
        const f32x4 va = (ya[j] * rsa) * g * (ca + 1.0f) + ha, vb = (yb[j] * rsb) * g * (cb + 1.0f) + hb;
        qa[64 * j] = pg8::pk4_fp8(va.x, va.y, va.z, va.w); qb[64 * j] = pg8::pk4_fp8(vb.x, vb.y, vb.z, vb.w); }
}
__device__ __forceinline__ void phase_modulate1(unsigned char* ws, int layer, int gw, int NGW, int lane) {
    const bf16* X = (const bf16*)(ws + WS_X); bf16* XN = (bf16*)(ws + WS_XN);
    const float* ng = PARF(ws) + P_N1G + layer * 1024; const float* Mo = (const float*)(ws + WS_MOD) + (size_t)layer * MODROWS * NMODC;
    for (int m = gw; m < MT; m += NGW) { const int mr = mod_row(m); f32x4 y[4]; float rs;
        modulate_row(X + (size_t)m * 1024, ng, Mo + (size_t)mr * NMODC + 0 * 1024, Mo + (size_t)mr * NMODC + 1 * 1024, XN + (size_t)m * 1024, lane, y, rs); }
}
__device__ __forceinline__ void phase_qknorm_rope(unsigned char* ws, int la, int gw, int NGW, int lane) {
    bf16* Qb = (bf16*)(ws + WS_Q); bf16* Kb = (bf16*)(ws + WS_K);
    const float* qg = PARF(ws) + P_QG + la * 64; const float* kg = PARF(ws) + P_KG + la * 64; const float* ropec = (const float*)(ws + WS_ROPE); const float* ropes = ropec + SEQ * 32;
    const int i = lane & 31, hs = lane >> 5;
    for (int m = gw; m < MT; m += NGW) { const int b = m / TB, w = m - b * TB; const bool lat = w >= CTXL;
        float cs = 1.f, sn = 0.f; if (lat) { cs = ropec[(w - CTXL) * 32 + i]; sn = ropes[(w - CTXL) * 32 + i]; }
#pragma unroll 2
        for (int hh = 0; hh < 20; hh += 2) { const int hd = hh + hs;
            unsigned* p = (hd < 16) ? (unsigned*)(Qb + (size_t)m * 1024 + hd * 64) + i : (unsigned*)(Kb + (size_t)m * 256 + (hd - 16) * 64) + i;
            const float* gp = (hd < 16) ? qg : kg; const float scl = (hd < 16) ? ATT_C2 : 1.0f;
            const unsigned v = *p; const float x1 = __uint_as_float(v << 16), x2 = __uint_as_float(v & 0xffff0000u);
            float ss = x1 * x1 + x2 * x2;
#pragma unroll
            for (int o = 1; o < 32; o <<= 1) ss += shx(ss, o, lane);
            const float rs = 1.0f / sqrtf(ss * (1.0f / 64.0f) + RMS_EPS);
            const float y1 = x1 * rs * gp[2 * i], y2 = x2 * rs * gp[2 * i + 1];
            const float r1 = (y1 * cs - y2 * sn) * scl, r2 = (y1 * sn + y2 * cs) * scl;
            *p = pk2(r1, r2); }
    }
}
__device__ __forceinline__ void phase_gla_recurrent(unsigned char* ws, int lg, LAS unsigned char* lds, int tid) {
    const int unit = blockIdx.x; if (unit >= 128) return;
    const int half = unit & 1, dir = (unit >> 1) & 1, h = (unit >> 2) & 3, b = unit >> 4;
    const bf16* G = (const bf16*)(ws + WS_G);
    float* Oo = (float*)(ws + (dir ? WS_OB : WS_OF));
    const float* wg = PARF(ws) + (dir ? P_GKB : P_GKF) + (size_t)lg * 16 * 512; const float* bg = PARF(ws) + (dir ? P_BGB : P_BGF) + lg * 512;
    LAS float* qq = (LAS float*)(lds + RING_OFF); LAS float* kk = qq + 64 * 128; LAS float* dd = kk + 64 * 128; LAS float* vv = dd + 64 * 128;
    const int sd = tid & 127, st0 = tid >> 7;
    float wcol[16];
#pragma unroll
    for (int r = 0; r < 16; ++r) wcol[r] = wg[r * 512 + h * 128 + sd];
    const float bcol = bg[h * 128 + sd];
    const int c = tid >> 2, dq = tid & 3;
    float s[32];
#pragma unroll
    for (int j = 0; j < 32; ++j) s[j] = 0.f;
    const float qscale = 0.08838834764831845f;
    for (int ch = 0; ch < TB / 64; ++ch) {
        __syncthreads();
#pragma unroll 4
        for (int i = 0; i < 16; ++i) { const int tt = st0 + 4 * i, n = 64 * ch + tt;
            const int w = dir ? (n < CTXL ? (CTXL - 1 - n) : (TB + CTXL - 1 - n)) : n;
            const bf16* gr = G + ((size_t)b * TB + w) * WINP;
            const float qv = bf2f(gr[h * 128 + sd]) * qscale, kv = bf2f(gr[512 + h * 128 + sd]);
            const bf16* lp = gr + 3072 + dir * 16; float z = bcol;
#pragma unroll
            for (int r = 0; r < 16; ++r) z += bf2f(lp[r]) * wcol[r];
            const float ls = fminf(z, 0.f) - log1pf(__expf(-fabsf(z)));
            qq[tt * 128 + sd] = qv; kk[tt * 128 + sd] = kv; dd[tt * 128 + sd] = __expf(ls * (1.0f / 16.0f));
            vv[tt * 128 + sd] = bf2f(gr[1024 + h * 256 + half * 128 + sd]); }
        __syncthreads();
        for (int tt = 0; tt < 64; ++tt) { const int n = 64 * ch + tt; const int w = dir ? (n < CTXL ? (CTXL - 1 - n) : (TB + CTXL - 1 - n)) : n;
            const float v = vv[tt * 128 + c]; float acc = 0.f;
            const LAS f32x4* q4 = (const LAS f32x4*)(qq + tt * 128 + dq * 32); const LAS f32x4* k4 = (const LAS f32x4*)(kk + tt * 128 + dq * 32); const LAS f32x4* d4 = (const LAS f32x4*)(dd + tt * 128 + dq * 32);
#pragma unroll
            for (int j = 0; j < 8; ++j) { const f32x4 qv = q4[j], kv = k4[j], dv = d4[j];
                s[4 * j + 0] = s[4 * j + 0] * dv.x + kv.x * v; acc += qv.x * s[4 * j + 0];
                s[4 * j + 1] = s[4 * j + 1] * dv.y + kv.y * v; acc += qv.y * s[4 * j + 1];
                s[4 * j + 2] = s[4 * j + 2] * dv.z + kv.z * v; acc += qv.z * s[4 * j + 2];
                s[4 * j + 3] = s[4 * j + 3] * dv.w + kv.w * v; acc += qv.w * s[4 * j + 3]; }
            acc += shx(acc, 1, tid & 63); acc += shx(acc, 2, tid & 63);
            if (dq == 0) Oo[((size_t)b * TB + w) * 1024 + h * 256 + half * 128 + c] = acc; }
    }
}
__device__ __forceinline__ void phase_gla_readout(unsigned char* ws, int lg, int gw, int NGW, int lane) {
    const float* OF = (const float*)(ws + WS_OF); const float* OB = (const float*)(ws + WS_OB); const bf16* G = (const bf16*)(ws + WS_G); bf16* OG = (bf16*)(ws + WS_Q);
    const f32x4 og = ((const GAS f32x4*)(PARF(ws) + P_OG + lg * 256))[lane];
    for (int m = gw; m < MT; m += NGW) {
#pragma unroll
        for (int hh = 0; hh < 4; ++hh) { const size_t off = (size_t)m * 1024 + hh * 256 + 4 * lane;
            f32x4 o = *(const GAS f32x4*)(OF + off) + *(const GAS f32x4*)(OB + off);
            const float ss = wave_sum((o.x * o.x + o.y * o.y) + (o.z * o.z + o.w * o.w));
            const float rs = 1.0f / sqrtf(ss * (1.0f / 256.0f) + RMS_EPS);
            const unsigned long long rv = *(const GAS unsigned long long*)(G + (size_t)m * WINP + 2048 + hh * 256 + 4 * lane);
            const float r0 = __uint_as_float((unsigned)(rv & 0xffffu) << 16), r1 = __uint_as_float((unsigned)(rv >> 16) << 16), r2 = __uint_as_float((unsigned)((rv >> 32) & 0xffffu) << 16), r3 = __uint_as_float((unsigned)(rv >> 48) << 16);
            o = o * rs * og;
            o.x *= silu_f(r0); o.y *= silu_f(r1); o.z *= silu_f(r2); o.w *= silu_f(r3);
            *(GAS unsigned long long*)(OG + off) = (unsigned long long)pk2(o.x, o.y) | ((unsigned long long)pk2(o.z, o.w) << 32); }
    }
}
constexpr size_t WS_GQ = WS_XG, WS_GKH = WS_XG + 68 * MiB, WS_GKT = WS_XG + 136 * MiB, WS_GVT = WS_XG + 204 * MiB, WS_GDL = WS_ACT, WS_SX = WS_OF;
static_assert((size_t)2176 * 2 * 16384 <= 68 * MiB && (size_t)2176 * 256 * 64 * 2 <= 68 * MiB && (size_t)64 * 68 * 65536 <= 272 * MiB, "gla buffers");
typedef float f32x16 __attribute__((ext_vector_type(16)));
__device__ __forceinline__ float log_sigmoid_fast(float z) { return fminf(z, 0.f) - __logf(1.0f + __expf(-fabsf(z))); }

__device__ __forceinline__ void phase_gla_g0(unsigned char* ws, int lg, LAS unsigned char* lds, int tid) {
    const bf16* G = (const bf16*)(ws + WS_G);
    LAS float* tot = (LAS float*)(lds + RING_OFF);
    const int d2 = tid & 63, tb = tid >> 6;
    for (int cn = blockIdx.x; cn < 2176; cn += gridDim.x) {
        const int n = cn % 68, bh = cn / 68, h = bh & 3, b = bh >> 2;
        const size_t row0 = (size_t)b * TB + 64 * n + 8 * tb;
        float wf0[16], wf1[16], wb0[16], wb1[16];
        { const float* wgf = PARF(ws) + P_GKF + (size_t)lg * 16 * 512 + h * 128 + 2 * d2; const float* wgb = PARF(ws) + P_GKB + (size_t)lg * 16 * 512 + h * 128 + 2 * d2;
#pragma unroll
          for (int r = 0; r < 16; ++r) { const f32x2 a = *(const GAS f32x2*)(wgf + r * 512), c = *(const GAS f32x2*)(wgb + r * 512); wf0[r] = a.x; wf1[r] = a.y; wb0[r] = c.x; wb1[r] = c.y; } }
        const f32x2 bf_ = *(const GAS f32x2*)(PARF(ws) + P_BGF + lg * 512 + h * 128 + 2 * d2), bb_ = *(const GAS f32x2*)(PARF(ws) + P_BGB + lg * 512 + h * 128 + 2 * d2);
        float gf0[8], gf1[8], gb0[8], gb1[8]; unsigned qk[8][2];
#pragma unroll
        for (int j = 0; j < 8; ++j) { const bf16* gr = G + (row0 + j) * WINP;
            const v4u l0 = *(const GAS v4u*)(gr + 3072), l1 = *(const GAS v4u*)(gr + 3080), l2 = *(const GAS v4u*)(gr + 3088), l3 = *(const GAS v4u*)(gr + 3096);
            qk[j][0] = *(const GAS unsigned*)(gr + h * 128 + 2 * d2); qk[j][1] = *(const GAS unsigned*)(gr + 512 + h * 128 + 2 * d2);
            float lf[16], lb[16];
            lf[0] = __uint_as_float(l0.x << 16); lf[1] = __uint_as_float(l0.x & 0xffff0000u); lf[2] = __uint_as_float(l0.y << 16); lf[3] = __uint_as_float(l0.y & 0xffff0000u);
            lf[4] = __uint_as_float(l0.z << 16); lf[5] = __uint_as_float(l0.z & 0xffff0000u); lf[6] = __uint_as_float(l0.w << 16); lf[7] = __uint_as_float(l0.w & 0xffff0000u);
            lf[8] = __uint_as_float(l1.x << 16); lf[9] = __uint_as_float(l1.x & 0xffff0000u); lf[10] = __uint_as_float(l1.y << 16); lf[11] = __uint_as_float(l1.y & 0xffff0000u);
            lf[12] = __uint_as_float(l1.z << 16); lf[13] = __uint_as_float(l1.z & 0xffff0000u); lf[14] = __uint_as_float(l1.w << 16); lf[15] = __uint_as_float(l1.w & 0xffff0000u);
            lb[0] = __uint_as_float(l2.x << 16); lb[1] = __uint_as_float(l2.x & 0xffff0000u); lb[2] = __uint_as_float(l2.y << 16); lb[3] = __uint_as_float(l2.y & 0xffff0000u);
            lb[4] = __uint_as_float(l2.z << 16); lb[5] = __uint_as_float(l2.z & 0xffff0000u); lb[6] = __uint_as_float(l2.w << 16); lb[7] = __uint_as_float(l2.w & 0xffff0000u);
            lb[8] = __uint_as_float(l3.x << 16); lb[9] = __uint_as_float(l3.x & 0xffff0000u); lb[10] = __uint_as_float(l3.y << 16); lb[11] = __uint_as_float(l3.y & 0xffff0000u);
            lb[12] = __uint_as_float(l3.z << 16); lb[13] = __uint_as_float(l3.z & 0xffff0000u); lb[14] = __uint_as_float(l3.w << 16); lb[15] = __uint_as_float(l3.w & 0xffff0000u);
            float zf0 = bf_.x, zf1 = bf_.y, zb0 = bb_.x, zb1 = bb_.y;
#pragma unroll
            for (int r = 0; r < 16; ++r) { zf0 += lf[r] * wf0[r]; zf1 += lf[r] * wf1[r]; zb0 += lb[r] * wb0[r]; zb1 += lb[r] * wb1[r]; }
            gf0[j] = log_sigmoid_fast(zf0) * 0.0625f; gf1[j] = log_sigmoid_fast(zf1) * 0.0625f; gb0[j] = log_sigmoid_fast(zb0) * 0.0625f; gb1[j] = log_sigmoid_fast(zb1) * 0.0625f; }
#pragma unroll
        for (int j = 1; j < 8; ++j) { gf0[j] += gf0[j - 1]; gf1[j] += gf1[j - 1]; gb0[7 - j] += gb0[8 - j]; gb1[7 - j] += gb1[8 - j]; }
        __syncthreads();
        *(LAS f32x2*)(tot + (0 * 8 + tb) * 128 + 2 * d2) = (f32x2){gf0[7], gf1[7]}; *(LAS f32x2*)(tot + (1 * 8 + tb) * 128 + 2 * d2) = (f32x2){gb0[0], gb1[0]};
        __syncthreads();
        float pf0 = 0.f, pf1 = 0.f, pb0 = 0.f, pb1 = 0.f, lf0 = 0.f, lf1 = 0.f, lb0 = 0.f, lb1 = 0.f;
#pragma unroll
        for (int q = 0; q < 8; ++q) { const f32x2 a = *(const LAS f32x2*)(tot + (0 * 8 + q) * 128 + 2 * d2), c = *(const LAS f32x2*)(tot + (1 * 8 + q) * 128 + 2 * d2);
            lf0 += a.x; lf1 += a.y; lb0 += c.x; lb1 += c.y;
            if (q < tb) { pf0 += a.x; pf1 += a.y; } if (q > tb) { pb0 += c.x; pb1 += c.y; } }
        const size_t itf = (size_t)cn * 2, itb = itf + 1;
        bf16* Qf = (bf16*)(ws + WS_GQ) + itf * 8192; bf16* Qb = Qf + 8192; bf16* Kf = (bf16*)(ws + WS_GKH) + itf * 8192; bf16* Kb = Kf + 8192;
        const float elf0 = __expf(lf0), elf1 = __expf(lf1), elb0 = __expf(lb0), elb1 = __expf(lb1);
        float ktf0[8], ktf1[8], ktb0[8], ktb1[8];
#pragma unroll
        for (int j = 0; j < 8; ++j) { const int t = 8 * tb + j;
            const float q0 = __uint_as_float(qk[j][0] << 16) * 0.08838834764831845f, q1 = __uint_as_float(qk[j][0] & 0xffff0000u) * 0.08838834764831845f;
            const float k0 = __uint_as_float(qk[j][1] << 16), k1 = __uint_as_float(qk[j][1] & 0xffff0000u);
            const float ef0 = __expf(pf0 + gf0[j]), ef1 = __expf(pf1 + gf1[j]), eb0 = __expf(pb0 + gb0[j]), eb1 = __expf(pb1 + gb1[j]);
            const float rf0 = __builtin_amdgcn_rcpf(ef0), rf1 = __builtin_amdgcn_rcpf(ef1), rb0 = __builtin_amdgcn_rcpf(eb0), rb1 = __builtin_amdgcn_rcpf(eb1);
            *(GAS unsigned*)(Qf + t * 128 + 2 * d2) = pk2(q0 * ef0, q1 * ef1); *(GAS unsigned*)(Qb + t * 128 + 2 * d2) = pk2(q0 * eb0, q1 * eb1);
            *(GAS unsigned*)(Kf + t * 128 + 2 * d2) = pk2(k0 * rf0, k1 * rf1); *(GAS unsigned*)(Kb + t * 128 + 2 * d2) = pk2(k0 * rb0, k1 * rb1);
            ktf0[j] = k0 * rf0 * elf0; ktf1[j] = k1 * rf1 * elf1; ktb0[j] = k0 * rb0 * elb0; ktb1[j] = k1 * rb1 * elb1; }
        {
          unsigned char* Tf = ws + WS_GKT + itf * 16384 + (size_t)((((tb >> 1) * 4 + (d2 >> 4)) * 64 + ((2 * d2) & 31)) * 16 + 8 * (tb & 1)); unsigned char* Tb = Tf + 16384;
          *(GAS unsigned long long*)(Tf) = (unsigned long long)pk2(ktf0[0], ktf0[1]) | ((unsigned long long)pk2(ktf0[2], ktf0[3]) << 32);
          *(GAS unsigned long long*)(Tf + 512) = (unsigned long long)pk2(ktf0[4], ktf0[5]) | ((unsigned long long)pk2(ktf0[6], ktf0[7]) << 32);
          *(GAS unsigned long long*)(Tf + 16) = (unsigned long long)pk2(ktf1[0], ktf1[1]) | ((unsigned long long)pk2(ktf1[2], ktf1[3]) << 32);
          *(GAS unsigned long long*)(Tf + 528) = (unsigned long long)pk2(ktf1[4], ktf1[5]) | ((unsigned long long)pk2(ktf1[6], ktf1[7]) << 32);
          *(GAS unsigned long long*)(Tb) = (unsigned long long)pk2(ktb0[0], ktb0[1]) | ((unsigned long long)pk2(ktb0[2], ktb0[3]) << 32);
          *(GAS unsigned long long*)(Tb + 512) = (unsigned long long)pk2(ktb0[4], ktb0[5]) | ((unsigned long long)pk2(ktb0[6], ktb0[7]) << 32);
          *(GAS unsigned long long*)(Tb + 16) = (unsigned long long)pk2(ktb1[0], ktb1[1]) | ((unsigned long long)pk2(ktb1[2], ktb1[3]) << 32);
          *(GAS unsigned long long*)(Tb + 528) = (unsigned long long)pk2(ktb1[4], ktb1[5]) | ((unsigned long long)pk2(ktb1[6], ktb1[7]) << 32); }
        if (tb == 0) { float* DLp = (float*)(ws + WS_GDL) + itf * 128 + 2 * d2; *(GAS f32x2*)DLp = (f32x2){elf0, elf1}; *(GAS f32x2*)(DLp + 128) = (f32x2){elb0, elb1}; }
        {
            const int dv = tid & 255, th = tid >> 8; const bf16* vp = G + ((size_t)b * TB + 64 * n + 32 * th) * WINP + 1024 + h * 256 + dv;
            unsigned wv[16];
#pragma unroll
            for (int j = 0; j < 16; ++j) wv[j] = (unsigned)vp[(size_t)(2 * j) * WINP] | ((unsigned)vp[(size_t)(2 * j + 1) * WINP] << 16);
            unsigned char* vo = ws + WS_GVT + (size_t)cn * 32768 + (size_t)(((2 * th) * 8 + (dv >> 5)) * 64 + (dv & 31)) * 16;
#pragma unroll
            for (int ql = 0; ql < 2; ++ql)
#pragma unroll
                for (int hq = 0; hq < 2; ++hq) *(GAS v4u*)(vo + ql * 8192 + hq * 512) = (v4u){wv[8 * ql + 2 * hq], wv[8 * ql + 2 * hq + 1], wv[8 * ql + 2 * hq + 4], wv[8 * ql + 2 * hq + 5]}; }
    }
}
struct G12Ops { bf16x8 a[4], b[4]; f32x4 d[4]; };
__device__ __forceinline__ void g12_load(G12Ops& o, unsigned char* ws, int bh, int dir, int m, int kb, int vb, int r, int hh) {
    const int n = dir ? (m < 4 ? 3 - m : 71 - m) : m; const size_t cn = (size_t)bh * 68 + n, item = cn * 2 + dir;
    const GAS bf16x8* ap = (const GAS bf16x8*)(ws + WS_GKT + item * 16384) + kb * 64 + (hh * 32 + r);
    const GAS bf16x8* bp = (const GAS bf16x8*)(ws + WS_GVT + cn * 32768) + vb * 64 + (hh * 32 + r);
    const float* dp = (const float*)(ws + WS_GDL) + item * 128 + 32 * kb + 4 * hh;
#pragma unroll
    for (int ks = 0; ks < 4; ++ks) { o.a[ks] = ap[ks * 256]; o.b[ks] = bp[ks * 512]; o.d[ks] = *(const GAS f32x4*)(dp + 8 * ks); }
}
__device__ __forceinline__ void phase_gla_g12(unsigned char* ws, LAS unsigned char* lds, int gwv, int wave, int lane) {
    if (gwv >= 2048) return;
    const int chain = gwv >> 5, blk = gwv & 31, kb = blk & 3, vb = blk >> 2, dir = chain & 1, bh = chain >> 1;
    const int r = lane & 31, hh = lane >> 5;
    LAS unsigned char* wl = lds + RING_OFF + wave * 2048;
    f32x16 acc;
#pragma unroll
    for (int g = 0; g < 16; ++g) acc[g] = 0.f;
    G12Ops o0, o1, o2;
    g12_load(o0, ws, bh, dir, 0, kb, vb, r, hh); g12_load(o1, ws, bh, dir, 1, kb, vb, r, hh);
#define G12_STEP(CUR, m_) do { const int mm_ = (m_); const int n = dir ? (mm_ < 4 ? 3 - mm_ : 71 - mm_) : mm_; \
        _Pragma("unroll") for (int gg = 0; gg < 4; ++gg) *(LAS unsigned long long*)(wl + (((gg >> 1) * 64 + (gg & 1) * 32 + r) * 16 + 8 * hh)) = (unsigned long long)pk2(acc[4 * gg], acc[4 * gg + 1]) | ((unsigned long long)pk2(acc[4 * gg + 2], acc[4 * gg + 3]) << 32); \
        LDS_WAIT(); const v4u s0 = *(const LAS v4u*)(wl + lane * 16), s1 = *(const LAS v4u*)(wl + 1024 + lane * 16); LDS_WAIT(); \
        { bf16* sp = (bf16*)(ws + WS_SX) + ((size_t)(bh * 2 + dir) * 68 + n) * 32768 + (size_t)(kb * 8 + vb) * 1024; ((GAS v4u*)sp)[lane] = s0; ((GAS v4u*)sp)[64 + lane] = s1; } \
        _Pragma("unroll") for (int gg = 0; gg < 4; ++gg) { acc[4 * gg] *= CUR.d[gg].x; acc[4 * gg + 1] *= CUR.d[gg].y; acc[4 * gg + 2] *= CUR.d[gg].z; acc[4 * gg + 3] *= CUR.d[gg].w; } \
        _Pragma("unroll") for (int ks = 0; ks < 4; ++ks) acc = __builtin_amdgcn_mfma_f32_32x32x16_bf16(CUR.a[ks], CUR.b[ks], acc, 0, 0, 0); } while (0)
    for (int m = 0; m < 66; m += 3) {
        g12_load(o2, ws, bh, dir, m + 2, kb, vb, r, hh); G12_STEP(o0, m);
        g12_load(o0, ws, bh, dir, m + 3, kb, vb, r, hh); G12_STEP(o1, m + 1);
        g12_load(o1, ws, bh, dir, (m + 4 < 68) ? m + 4 : 67, kb, vb, r, hh); G12_STEP(o2, m + 2);
    }
    G12_STEP(o0, 66); G12_STEP(o1, 67);
#undef G12_STEP
}
constexpr int G3_RS = 272, G3_TILE = 64 * G3_RS, G3_OL = 4 * G3_TILE  , G3_LD = 260;
static_assert(G3_OL + 64 * G3_LD * 4 <= MISC_OFF, "G3 LDS");
__device__ __forceinline__ void phase_gla_g3(unsigned char* ws, int lg, LAS unsigned char* lds, int tid) {
    const int lane = tid & 63, wave = __builtin_amdgcn_readfirstlane(tid >> 6), r = lane & 31, hh = lane >> 5, vb = wave;
    LAS unsigned char* TL = lds + RING_OFF; LAS float* OL = (LAS float*)(lds + RING_OFF + G3_OL);
    const bf16* G = (const bf16*)(ws + WS_G); bf16* OG = (bf16*)(ws + WS_Q);
    for (int cn = blockIdx.x; cn < 2176; cn += gridDim.x) {
        const int n = cn % 68, bh = cn / 68, h = bh & 3, b = bh >> 2;
        v4u st[4][2];
#pragma unroll
        for (int tl = 0; tl < 4; ++tl) { const bf16* src = (const bf16*)(ws + ((tl & 1) ? WS_GKH : WS_GQ)) + ((size_t)cn * 2 + (tl >> 1)) * 8192;
#pragma unroll
            for (int j = 0; j < 2; ++j) st[tl][j] = ((const GAS v4u*)src)[tid + 512 * j]; }
        __syncthreads();
#pragma unroll
        for (int tl = 0; tl < 4; ++tl)
#pragma unroll
            for (int j = 0; j < 2; ++j) { const int q = tid + 512 * j, row = q >> 4, ch = q & 15; *(LAS v4u*)(TL + tl * G3_TILE + row * G3_RS + ch * 16) = st[tl][j]; }
        __syncthreads();
        f32x16 P00, P01, P10, P11, O0, O1;
#pragma unroll
        for (int g = 0; g < 16; ++g) { P00[g] = 0.f; P01[g] = 0.f; P10[g] = 0.f; P11[g] = 0.f; O0[g] = 0.f; O1[g] = 0.f; }
#pragma unroll
        for (int dir = 0; dir < 2; ++dir) {
            const LAS unsigned char* Qt = TL + (2 * dir) * G3_TILE + r * G3_RS + 16 * hh; const LAS unsigned char* Kh = TL + (2 * dir + 1) * G3_TILE + r * G3_RS + 16 * hh;
            const GAS bf16x8* Sx = (const GAS bf16x8*)((const bf16*)(ws + WS_SX) + ((size_t)(bh * 2 + dir) * 68 + n) * 32768 + (size_t)vb * 1024) + lane;
            f32x16 X00, X11, Xoff;
#pragma unroll
            for (int g = 0; g < 16; ++g) { X00[g] = 0.f; X11[g] = 0.f; Xoff[g] = 0.f; }
#pragma unroll
            for (int s = 0; s < 8; ++s) {
                const bf16x8 q0 = *(const LAS bf16x8*)(Qt + 32 * s), q1 = *(const LAS bf16x8*)(Qt + 32 * G3_RS + 32 * s);
                const bf16x8 k0 = *(const LAS bf16x8*)(Kh + 32 * s), k1 = *(const LAS bf16x8*)(Kh + 32 * G3_RS + 32 * s);
                const bf16x8 sx = Sx[(s >> 1) * 1024 + (s & 1) * 64];
                X00 = __builtin_amdgcn_mfma_f32_32x32x16_bf16(k0, q0, X00, 0, 0, 0);
                X11 = __builtin_amdgcn_mfma_f32_32x32x16_bf16(k1, q1, X11, 0, 0, 0);
                if (dir == 0) Xoff = __builtin_amdgcn_mfma_f32_32x32x16_bf16(k0, q1, Xoff, 0, 0, 0); else Xoff = __builtin_amdgcn_mfma_f32_32x32x16_bf16(k1, q0, Xoff, 0, 0, 0);
                O0 = __builtin_amdgcn_mfma_f32_32x32x16_bf16(q0, sx, O0, 0, 0, 0); O1 = __builtin_amdgcn_mfma_f32_32x32x16_bf16(q1, sx, O1, 0, 0, 0); }
#pragma unroll
            for (int g = 0; g < 16; ++g) { const int tj = (g & 3) + 8 * (g >> 2) + 4 * hh; const bool keep = dir ? (tj >= r) : (tj <= r);
                P00[g] += keep ? X00[g] : 0.f; P11[g] += keep ? X11[g] : 0.f;
                if (dir == 0) P01[g] += Xoff[g]; else P10[g] += Xoff[g]; }
        }
        { const GAS bf16x8* Vt = (const GAS bf16x8*)(ws + WS_GVT + (size_t)cn * 32768) + vb * 64 + lane;
#pragma unroll
          for (int jb = 0; jb < 2; ++jb)
#pragma unroll
            for (int s2 = 0; s2 < 2; ++s2) { const bf16x8 bfv = Vt[(2 * jb + s2) * 512];
                const f32x16& Pa = jb ? P10 : P00; const f32x16& Pb = jb ? P11 : P01;
                const bf16x8 a0 = __builtin_bit_cast(bf16x8, ((v4u){pk2(Pa[8 * s2 + 0], Pa[8 * s2 + 1]), pk2(Pa[8 * s2 + 2], Pa[8 * s2 + 3]), pk2(Pa[8 * s2 + 4], Pa[8 * s2 + 5]), pk2(Pa[8 * s2 + 6], Pa[8 * s2 + 7])}));
                const bf16x8 a1 = __builtin_bit_cast(bf16x8, ((v4u){pk2(Pb[8 * s2 + 0], Pb[8 * s2 + 1]), pk2(Pb[8 * s2 + 2], Pb[8 * s2 + 3]), pk2(Pb[8 * s2 + 4], Pb[8 * s2 + 5]), pk2(Pb[8 * s2 + 6], Pb[8 * s2 + 7])}));
                O0 = __builtin_amdgcn_mfma_f32_32x32x16_bf16(a0, bfv, O0, 0, 0, 0); O1 = __builtin_amdgcn_mfma_f32_32x32x16_bf16(a1, bfv, O1, 0, 0, 0); } }
#pragma unroll
        for (int g = 0; g < 16; ++g) { const int t = (g & 3) + 8 * (g >> 2) + 4 * hh; OL[t * G3_LD + 32 * vb + r] = O0[g]; OL[(32 + t) * G3_LD + 32 * vb + r] = O1[g]; }
        __syncthreads();
        { const int t = tid >> 3, cc = tid & 7; const LAS f32x4* op = (const LAS f32x4*)(OL + t * G3_LD + 32 * cc);
          f32x4 o[8]; float ss = 0.f;
#pragma unroll
          for (int j = 0; j < 8; ++j) { o[j] = op[j]; ss += (o[j].x * o[j].x + o[j].y * o[j].y) + (o[j].z * o[j].z + o[j].w * o[j].w); }
          ss += __shfl_xor(ss, 1); ss += __shfl_xor(ss, 2); ss += __shfl_xor(ss, 4);
          const float rs = 1.0f / sqrtf(ss * (1.0f / 256.0f) + RMS_EPS);
          const size_t row = (size_t)b * TB + 64 * n + t;
          const GAS v4u* rp = (const GAS v4u*)(G + row * WINP + 2048 + h * 256 + 32 * cc); const GAS f32x4* gp = (const GAS f32x4*)(PARF(ws) + P_OG + lg * 256 + 32 * cc);
          GAS v4u* dst = (GAS v4u*)(OG + row * 1024 + h * 256 + 32 * cc);
#pragma unroll
          for (int j = 0; j < 4; ++j) { const v4u rv = rp[j]; const f32x4 g0 = gp[2 * j], g1 = gp[2 * j + 1]; const f32x4 a = o[2 * j] * rs * g0, c2 = o[2 * j + 1] * rs * g1;
              v4u w;
              w.x = pk2(a.x * silu_f(__uint_as_float(rv.x << 16)), a.y * silu_f(__uint_as_float(rv.x & 0xffff0000u)));
              w.y = pk2(a.z * silu_f(__uint_as_float(rv.y << 16)), a.w * silu_f(__uint_as_float(rv.y & 0xffff0000u)));
              w.z = pk2(c2.x * silu_f(__uint_as_float(rv.z << 16)), c2.y * silu_f(__uint_as_float(rv.z & 0xffff0000u)));
              w.w = pk2(c2.z * silu_f(__uint_as_float(rv.w << 16)), c2.w * silu_f(__uint_as_float(rv.w & 0xffff0000u)));
              dst[j] = w; } }
    }
}
constexpr int WIMG_RS = 2064;
static_assert(2 * 32 * WIMG_RS <= LDS_AUX, "router images below the aux tables");
__device__ __forceinline__ void phase_modulate2_route(unsigned char* ws, int layer, LAS unsigned char* lds, int vcu, int wave, int lane, int tid, bool dummy = false) {
    const bf16* X = (const bf16*)(ws + WS_X); bf16* XN = (bf16*)(ws + WS_XN);
    const float* ng = PARF(ws) + P_N2G + layer * 1024; const float* Mo = (const float*)(ws + WS_MOD) + (size_t)layer * MODROWS * NMODC;
    LAS unsigned char* WHI = lds + RING_OFF; LAS unsigned char* WLO = WHI + 32 * WIMG_RS;
    LAS unsigned* lcnt = (LAS unsigned*)(lds + AUX_LCNT); LAS unsigned* gb = (LAS unsigned*)(lds + AUX_GB); LAS unsigned* ent = (LAS unsigned*)(lds + AUX_ENT); LAS float* rsl = (LAS float*)(lds + AUX_RS);
    { const float* wsrc = PARF(ws) + P_WR + (size_t)layer * 1024 * 32;
      for (int idx = tid; idx < 1024 * 32; idx += NWAVES * 64) { const int k = idx >> 5, e = idx & 31; const float w = wsrc[idx]; const unsigned hi = f2bf(w), lo = f2bf(w - __uint_as_float(hi << 16));
          *(LAS unsigned short*)(WHI + e * WIMG_RS + 2 * k) = (unsigned short)hi; *(LAS unsigned short*)(WLO + e * WIMG_RS + 2 * k) = (unsigned short)lo; }
      if (tid < 32) lcnt[tid] = 0u; }
    gu32* cnt = (gu32*)(ws + WS_CTL) + CW_CNT + (layer + (dummy ? 4 : 0)) * 32 * 16;
    unsigned char* sbase = dummy ? ws + WS_XG : ws;
    const bool lastl = (layer == NLAYER - 1);
  for (int grp = vcu; grp < MT / 136; grp += (int)gridDim.x) {
    const int rbase = grp * 136;
    if (grp != vcu) { __syncthreads(); if (tid < 32) lcnt[tid] = 0u; }
    for (int rl = wave; rl < 136; rl += 2 * NWAVES) {
        const int rl2 = (rl + NWAVES < 136) ? rl + NWAVES : rl; const int m = rbase + rl, m2 = rbase + rl2, mr = mod_row(m), mr2 = mod_row(m2);
        float rs, rs2;
        modulate_row2(X + (size_t)m * 1024, X + (size_t)m2 * 1024, ng, Mo + (size_t)mr * NMODC + 3 * 1024, Mo + (size_t)mr * NMODC + 4 * 1024, Mo + (size_t)mr2 * NMODC + 3 * 1024, Mo + (size_t)mr2 * NMODC + 4 * 1024,
                      ws + WS_XN8 + (size_t)m * 1024, ws + WS_XN8 + (size_t)m2 * 1024, lane, rs, rs2);
        if (lane == 0) { rsl[rl] = rs; rsl[rl2] = rs2; } }
    __syncthreads();
    if (wave < 5) {
        const int r = lane & 31, hh = lane >> 5; const int rl = (32 * wave + r < 136) ? 32 * wave + r : 135; const int m = rbase + rl, mr = mod_row(m);
        const float rsr = rsl[rl];
        const bf16* xp = X + (size_t)m * 1024 + 8 * hh; const float* gp = ng + 8 * hh; const float* scp = Mo + (size_t)mr * NMODC + 4 * 1024 + 8 * hh; const float* shp = Mo + (size_t)mr * NMODC + 3 * 1024 + 8 * hh;
        const LAS unsigned char* wh = WHI + r * WIMG_RS + 16 * hh; const LAS unsigned char* wl = WLO + r * WIMG_RS + 16 * hh;
        f32x16 acc;
#pragma unroll
        for (int g = 0; g < 16; ++g) acc[g] = 0.f;
#pragma unroll 2
        for (int s = 0; s < 64; ++s) {
            const v4u xr8 = *(const GAS v4u*)(xp + 16 * s); const f32x4 x0 = (f32x4){__uint_as_float(xr8.x << 16), __uint_as_float(xr8.x & 0xffff0000u), __uint_as_float(xr8.y << 16), __uint_as_float(xr8.y & 0xffff0000u)}, x1 = (f32x4){__uint_as_float(xr8.z << 16), __uint_as_float(xr8.z & 0xffff0000u), __uint_as_float(xr8.w << 16), __uint_as_float(xr8.w & 0xffff0000u)}; const f32x4 g0 = *(const GAS f32x4*)(gp + 16 * s), g1 = *(const GAS f32x4*)(gp + 16 * s + 4);
            const f32x4 c0 = *(const GAS f32x4*)(scp + 16 * s), c1 = *(const GAS f32x4*)(scp + 16 * s + 4), h0 = *(const GAS f32x4*)(shp + 16 * s), h1 = *(const GAS f32x4*)(shp + 16 * s + 4);
            const f32x4 y0 = (x0 * rsr) * g0 * (c0 + 1.0f) + h0, y1 = (x1 * rsr) * g1 * (c1 + 1.0f) + h1;
            v4u ph, pl;
            ph.x = pg8::cvt_pk_bf16(y0.x, y0.y); ph.y = pg8::cvt_pk_bf16(y0.z, y0.w); ph.z = pg8::cvt_pk_bf16(y1.x, y1.y); ph.w = pg8::cvt_pk_bf16(y1.z, y1.w);
            pl.x = pg8::cvt_pk_bf16(y0.x - __uint_as_float(ph.x << 16), y0.y - __uint_as_float(ph.x & 0xffff0000u)); pl.y = pg8::cvt_pk_bf16(y0.z - __uint_as_float(ph.y << 16), y0.w - __uint_as_float(ph.y & 0xffff0000u));
            pl.z = pg8::cvt_pk_bf16(y1.x - __uint_as_float(ph.z << 16), y1.y - __uint_as_float(ph.z & 0xffff0000u)); pl.w = pg8::cvt_pk_bf16(y1.z - __uint_as_float(ph.w << 16), y1.w - __uint_as_float(ph.w & 0xffff0000u));
            const bf16x8 ahi = __builtin_bit_cast(bf16x8, ph), alo = __builtin_bit_cast(bf16x8, pl);
            const bf16x8 bhi = *(const LAS bf16x8*)(wh + 32 * s), blo = *(const LAS bf16x8*)(wl + 32 * s);
            acc = __builtin_amdgcn_mfma_f32_32x32x16_bf16(ahi, bhi, acc, 0, 0, 0); acc = __builtin_amdgcn_mfma_f32_32x32x16_bf16(alo, bhi, acc, 0, 0, 0); acc = __builtin_amdgcn_mfma_f32_32x32x16_bf16(ahi, blo, acc, 0, 0, 0); }
        const float brt = (PARF(ws) + P_BR)[layer * 32 + r];
#pragma unroll
        for (int g = 0; g < 16; ++g) { const int rowl = 32 * wave + (g & 3) + 8 * (g >> 2) + 4 * hh;
            float v = acc[g] + brt; float tv[4]; int te[4];
#pragma unroll
            for (int k = 0; k < 4; ++k) { float mx = v;
#pragma unroll
                for (int o = 1; o < 32; o <<= 1) mx = fmaxf(mx, shx(mx, o, lane));
                const unsigned long long bm = __ballot(v == mx); const unsigned hm = hh ? (unsigned)(bm >> 32) : (unsigned)bm; const int first = __ffs((int)hm) - 1;
                te[k] = first; tv[k] = mx; if (r == first) v = -INFINITY; }
            const bool valid = rowl < 136 && !(lastl && mod_row(rbase + (rowl < 136 ? rowl : 135)) == 8);
            if (r == 0 && rowl < 136) {
                if (valid) { const float e1 = __expf(tv[1] - tv[0]), e2 = __expf(tv[2] - tv[0]), e3 = __expf(tv[3] - tv[0]); const float inv = 1.0f / (1.0f + e1 + e2 + e3);
                    const float wk[4] = {inv, e1 * inv, e2 * inv, e3 * inv};
#pragma unroll
                    for (int k = 0; k < 4; ++k) { const unsigned lp = atomicAdd((unsigned*)&lcnt[te[k]], 1u); ent[(rowl * 4 + k) * 2 + 0] = ((unsigned)te[k] << 24) | lp; ent[(rowl * 4 + k) * 2 + 1] = __float_as_uint(wk[k]); } }
                else {
#pragma unroll
                    for (int k = 0; k < 4; ++k) ent[(rowl * 4 + k) * 2 + 0] = 0xffffffffu; } } }
    }
    __syncthreads();
    if (tid < 32) gb[tid] = __hip_atomic_fetch_add(cnt + tid * 16, lcnt[tid], __ATOMIC_RELAXED, __HIP_MEMORY_SCOPE_AGENT);
    __syncthreads();
    for (int q = tid; q < 136 * 4; q += NWAVES * 64) { const unsigned pe = ent[q * 2 + 0];
        if (pe != 0xffffffffu) { const unsigned e = pe >> 24, lp = pe & 0xffffffu; const int m = rbase + (q >> 2);
            ((unsigned*)(sbase + WS_SLOT))[m * 4 + (q & 3)] = (e << 24) | (gb[e] + lp); ((unsigned*)(sbase + WS_GATEW))[m * 4 + (q & 3)] = ent[q * 2 + 1];
            if (!dummy) ((int*)(ws + WS_LIST))[(size_t)e * MT + gb[e] + lp] = m; } }
  }
}
__device__ __forceinline__ void build_expert_tables(unsigned char* ws, int layer, LAS unsigned char* lds, int tid) {
    LAS int* t2e = (LAS int*)(lds + AUX_T2E); LAS int* base = (LAS int*)(lds + AUX_BASE); LAS int* ntp = (LAS int*)(lds + AUX_NT); LAS int* cntl = (LAS int*)(lds + AUX_CNT);
    gu32* cnt = (gu32*)(ws + WS_CTL) + CW_CNT + layer * 32 * 16;
    __syncthreads();
    if (tid < 64) { const unsigned cval = (tid < 32) ? __hip_atomic_load(cnt + tid * 16, RLX_AGENT) : 0u; const int tiles = (int)((cval + 255u) >> 8);
        int pre = tiles;
#pragma unroll
        for (int o = 1; o < 32; o <<= 1) { const int ln = tid & 63; const int t = __builtin_amdgcn_ds_bpermute(((ln >= o) ? ln - o : ln) << 2, pre); if (ln >= o) pre += t; }
        const int start = pre - tiles;
        if (tid < 32) { base[tid] = start * 256; cntl[tid] = (int)cval; for (int t = 0; t < tiles; ++t) t2e[start + t] = tid; if (tid == 31) ntp[0] = pre; } }
    __syncthreads();
}
__device__ __forceinline__ void phase_moe_gather(unsigned char* ws, int layer, LAS unsigned char* lds, int gw, int NGW, int lane, int tid) {
    build_expert_tables(ws, layer, lds, tid);
    const LAS int* base = (const LAS int*)(lds + AUX_BASE);
    const bf16* XN = (const bf16*)(ws + WS_XN); bf16* XG = (bf16*)(ws + WS_XG);
    const unsigned* slot = (const unsigned*)(ws + WS_SLOT); unsigned* spos = (unsigned*)(ws + WS_SLOTPOS);
    for (int m = gw; m < MT; m += NGW) {
        if (layer == NLAYER - 1 && mod_row(m) == 8) continue;
        const GAS v4u* src = (const GAS v4u*)(XN + (size_t)m * 1024) + lane; const v4u a = src[0], b = src[64];
#pragma unroll
        for (int k = 0; k < 4; ++k) { const unsigned pe = slot[m * 4 + k]; const int dst = base[pe >> 24] + (int)(pe & 0xffffffu);
            GAS v4u* dp = (GAS v4u*)(XG + (size_t)dst * 1024) + lane; dp[0] = a; dp[64] = b;
            if (lane == 0) spos[m * 4 + k] = (unsigned)dst; }
    }
}
__device__ __forceinline__ void phase_moe_combine(unsigned char* ws, float* out, int layer, LAS unsigned char* lds, int gw, int NGW, int lane, int tid, bool dummy = false) {
    build_expert_tables(ws, layer, lds, tid);
    const LAS int* base = (const LAS int*)(lds + AUX_BASE);
    bf16* X = (bf16*)(ws + WS_X); const bf16* Y = (const bf16*)(ws + WS_Y);
    const float* Mo = (const float*)(ws + WS_MOD) + (size_t)layer * MODROWS * NMODC;
    const unsigned* slot = (const unsigned*)(ws + WS_SLOT); const float* gw4 = (const float*)(ws + WS_GATEW);
    for (int m0 = gw; m0 < MT; m0 += 2 * NGW) {
        int mm[2], bb[2], ww[2], mrr[2]; bool ok[2];
#pragma unroll
        for (int p = 0; p < 2; ++p) { const int m = m0 + p * NGW; ok[p] = m < MT; mm[p] = ok[p] ? m : m0; bb[p] = mm[p] / TB; ww[p] = mm[p] - bb[p] * TB; mrr[p] = (ww[p] < CTXL) ? 8 : bb[p];
            if (layer == NLAYER - 1 && ww[p] < CTXL) ok[p] = false; }
        if (!ok[0] && !ok[1]) continue;
        unsigned pe[2][4]; float wk[2][4];
#pragma unroll
        for (int p = 0; p < 2; ++p)
#pragma unroll
            for (int k = 0; k < 4; ++k) { pe[p][k] = slot[mm[p] * 4 + k]; wk[p][k] = gw4[mm[p] * 4 + k]; }
        unsigned long long xv[2][4];
#pragma unroll
        for (int p = 0; p < 2; ++p) { const GAS unsigned long long* xp = (const GAS unsigned long long*)(X + (size_t)mm[p] * 1024) + lane;
#pragma unroll
            for (int j = 0; j < 4; ++j) xv[p][j] = xp[64 * j]; }
        unsigned long long yv[2][4][4];
#pragma unroll
        for (int p = 0; p < 2; ++p)
#pragma unroll
            for (int k = 0; k < 4; ++k) { unsigned e = pe[p][k] >> 24; if (!ok[p] || e > 31u) e = 0u;
                const unsigned sp = ok[p] ? (unsigned)base[e] + (pe[p][k] & 0xffffffu) : 0u;
                const GAS unsigned long long* yp = (const GAS unsigned long long*)(Y + (size_t)sp * 1024) + lane;
#pragma unroll
                for (int j = 0; j < 4; ++j) yv[p][k][j] = yp[64 * j]; }
        f32x4 f[2][4]; float ss[2];
#pragma unroll
        for (int p = 0; p < 2; ++p) { const GAS f32x4* gp = (const GAS f32x4*)(Mo + (size_t)mrr[p] * NMODC + 5 * 1024) + lane;
            ss[p] = 0.f;
#pragma unroll
            for (int j = 0; j < 4; ++j) { f32x4 a = (f32x4){0.f, 0.f, 0.f, 0.f};
#pragma unroll
                for (int k = 0; k < 4; ++k) a = a + bf4_to_f32(yv[p][k][j]) * wk[p][k];
                f[p][j] = bf4_to_f32(xv[p][j]) + gp[64 * j] * a; } }
        asm volatile("" ::: "memory");
        const bool fuse = (layer < NLAYER - 1) && !dummy;
#pragma unroll
        for (int p = 0; p < 2; ++p) { if (!ok[p]) continue;
            GAS unsigned long long* xp = (GAS unsigned long long*)(X + (size_t)mm[p] * 1024) + lane;
            GAS f32x4* op = (GAS f32x4*)(out + ((size_t)bb[p] * SEQ + (ww[p] - CTXL)) * 1024) + lane;
#pragma unroll
            for (int j = 0; j < 4; ++j) { if (dummy) ((GAS f32x4*)((float*)(ws + WS_XG) + (size_t)mm[p] * 1024) + lane)[64 * j] = f[p][j]; else if (layer == NLAYER - 1) op[64 * j] = f[p][j]; else { const unsigned long long pk = f32_to_bf4(f[p][j]); xp[64 * j] = pk; f[p][j] = bf4_to_f32(pk); }
                ss[p] += (f[p][j].x * f[p][j].x + f[p][j].y * f[p][j].y) + (f[p][j].z * f[p][j].z + f[p][j].w * f[p][j].w); }
            if (fuse) { const float rs = 1.0f / sqrtf(wave_sum(ss[p]) * (1.0f / 1024.0f) + RMS_EPS);
                const float* ng = PARF(ws) + P_N1G + (layer + 1) * 1024; const float* Mn = (const float*)(ws + WS_MOD) + (size_t)(layer + 1) * MODROWS * NMODC + (size_t)mrr[p] * NMODC;
                GAS unsigned long long* o8 = (GAS unsigned long long*)((bf16*)(ws + WS_XN) + (size_t)mm[p] * 1024) + lane;
#pragma unroll
                for (int j = 0; j < 4; ++j) { const f32x4 g = ((const GAS f32x4*)ng)[64 * j + lane], sh = ((const GAS f32x4*)Mn)[64 * j + lane], sc = ((const GAS f32x4*)(Mn + 1024))[64 * j + lane];
                    o8[64 * j] = f32_to_bf4((f[p][j] * rs) * g * (sc + 1.0f) + sh); } } }
    }
}

constexpr int NPH_L = 11, NPHASE = 2 + NPH_L * NLAYER;
#ifndef PHMASK
#define PHMASK 0x7fff
#endif
#define EN(b) ((PHMASK >> (b)) & 1)
#ifndef DUPMASK
#define DUPMASK 0
#endif
#define DUP(b) for (int rep_ = 0; rep_ < (((DUPMASK >> (b)) & 1) ? 2 : 1); ++rep_)
__global__ void __launch_bounds__(NWAVES * 64, 2) dit_fwd(Args args) {
    extern __shared__ __attribute__((aligned(16))) unsigned char lds_raw[];
    LAS unsigned char* lds = (LAS unsigned char*)lds_raw;
    volatile LAS unsigned* MISC = (volatile LAS unsigned*)(lds + MISC_OFF);
    const int G = gridDim.x, bx = blockIdx.x;
    const int vcu = (G % 8 == 0) ? (bx % 8) * (G / 8) + bx / 8 : bx;
    const int wave0 = __builtin_amdgcn_readfirstlane((int)threadIdx.x >> 6);
#define LANE_ID(z) ((int)__builtin_amdgcn_mbcnt_hi(~0u, __builtin_amdgcn_mbcnt_lo(~0u, (z))))
    { const int t0 = (wave0 << 6) | LANE_ID(0u); for (int u = t0; u < (LDS_BYTES - MISC_OFF) / 4; u += NWAVES * 64) ((LAS unsigned*)(lds + MISC_OFF))[u] = 0u; }
    __syncthreads();
    const int lo = args.ph_lo, hi = args.ph_hi;
    XcdBarrier bar; bar.bar = (unsigned*)(args.ws + WS_CTL) + CW_BAR; bar.x = 0; bar.st = nullptr;
    if (hi - lo > 1) bar = xcd_barrier_post((unsigned*)(args.ws + WS_CTL) + CW_BAR, MISC + 8, wave0 == 0 && LANE_ID(0u) == 0);
#define IN(k) (lo <= (k) && (k) < hi)
#define SEAM(k) do { if (IN(k) && IN((k) + 1)) { XcdBarrier b_ = bar; unsigned zb_ = 0u; LAUNDER_S(zb_); b_.bar = bar.bar + zb_; xcd_barrier(b_, wave0 == 0 && LANE_ID(zb_) == 0); } } while (0)
#define PHASE_IDS() unsigned zoff_ = 0u; LAUNDER_S(zoff_); int tid = (wave0 << 6) | LANE_ID(zoff_); LAUNDER_V(tid); const int lane = tid & 63, wave = __builtin_amdgcn_readfirstlane(tid >> 6); const int gw = vcu * NWAVES + wave, NGW = G * NWAVES; \
    unsigned char* ws = args.ws + zoff_; const int Gp = G + (int)zoff_, bxp = bx + (int)zoff_; (void)lane; (void)gw; (void)NGW; (void)Gp; (void)bxp;

    if (EN(0) && IN(0)) DUP(0) { PHASE_IDS(); p0_prologue(args, lds, gw, NGW, wave, lane); } SEAM(0);
    if (EN(1) && IN(1)) { PHASE_IDS(); p1_mod_reduce(args, gw * 64 + lane, NGW * 64); } SEAM(1);

    for (int layer = 0; layer < NLAYER; ++layer) {
        const int pb = 2 + NPH_L * layer, lh = layer >> 1;
        if (layer == 0) { if (EN(2) && IN(pb + 0)) DUP(2) { PHASE_IDS(); phase_modulate1(ws, layer, gw, NGW, lane); } SEAM(pb + 0); }
        if ((layer & 1) == 0) {
            if (EN(3) && IN(pb + 1)) DUP(3) {
                PHASE_IDS();
                pg8::Gemm g{(const pg8::bf16_t*)(ws + WS_XN), (const pg8::bf16_t*)(ws + WS_WQKV) + (size_t)lh * QKVN * 1024, MT, QKVN, 1024, 0};
                pg8::StaticOrder S; S.init(MT, QKVN, Gp, bxp);
                LAS float* gl = (LAS float*)(lds + AUX_RS);
                if (tid < 128) gl[tid] = (PARF(ws) + (tid < 64 ? P_QG : P_KG - 64) + lh * 64)[tid];
                __syncthreads();
                pg8::EpiQKV E{ws, WS_Q, WS_K - WS_Q, WS_V - WS_K, gl, (const float*)(ws + WS_ROPE), ATT_C2};
                pg8::gemm_phase<pg8::EpiQKV, pg8::StaticOrder, true, true>(lds + RING_OFF, g, S, E, tid);
            } SEAM(pb + 1);
            if (EN(5) && IN(pb + 3)) DUP(5) {
                PHASE_IDS();
                const attn_body::bf16* Qp = (const attn_body::bf16*)(ws + WS_Q); const attn_body::bf16* Kp = (const attn_body::bf16*)(ws + WS_K); const attn_body::bf16* Vp = (const attn_body::bf16*)(ws + WS_V);
                attn_body::bf16* Op = (attn_body::bf16*)(ws + WS_XN);
                if (G == 256) {
                    for (int i = 0; i < 9; ++i) {
                        long qrow0, kvrow0; int NT, h;
                        if (i < 8) { const int x = vcu >> 5, j = vcu & 31, pair = 4 * x + (i >> 1), wi = (i & 1) * 32 + j, hq = wi >> 4, qb = wi & 15, b = pair >> 2, hk = pair & 3;
                            h = hk * 4 + hq; qrow0 = (long)b * TB + CTXL + qb * 256; kvrow0 = (long)b * TB; NT = TB / 64; }
                        else { if (vcu >= 128) break; const int b = vcu >> 4; h = vcu & 15; qrow0 = (long)b * TB; kvrow0 = qrow0; NT = CTXL / 64; }
                        attn_body::attn_unit<8>(qrow0, kvrow0, NT, h, Qp, Kp, Vp, Op, (char*)lds_raw + RING_OFF, tid);
                    }
                } else {
                    for (int U = bx; U < 2048 + 128; U += G) {
                        long qrow0, kvrow0; int NT, h;
                        if (U < 2048) { const int pair = U >> 6, wi = U & 63, hq = wi >> 4, qb = wi & 15, b = pair >> 2, hk = pair & 3; h = hk * 4 + hq; qrow0 = (long)b * TB + CTXL + qb * 256; kvrow0 = (long)b * TB; NT = TB / 64; }
                        else { const int v = U - 2048, b = v >> 4; h = v & 15; qrow0 = (long)b * TB; kvrow0 = qrow0; NT = CTXL / 64; }
                        attn_body::attn_unit<8>(qrow0, kvrow0, NT, h, Qp, Kp, Vp, Op, (char*)lds_raw + RING_OFF, tid);
                    }
                }
            } SEAM(pb + 3);
        } else {
            if (EN(6) && IN(pb + 1)) DUP(6) {
                PHASE_IDS();
                pg8::Gemm g{(const pg8::bf16_t*)(ws + WS_XN), (const pg8::bf16_t*)(ws + WS_WIN) + (size_t)lh * WINP * 1024, MT, WINP, 1024, 0};
                pg8::StaticOrder S; S.init(MT, WINP, Gp, bxp);
                pg8::EpiBf16 E{(pg8::bf16_t*)(ws + WS_G), WINP};
                pg8::gemm_phase<pg8::EpiBf16, pg8::StaticOrder, true, true>(lds + RING_OFF, g, S, E, tid);
            } SEAM(pb + 1);
            if (EN(7) && IN(pb + 2)) DUP(7) { PHASE_IDS(); phase_gla_g0(ws, lh, lds, tid); } SEAM(pb + 2);
            if (EN(8) && IN(pb + 3)) DUP(8) { PHASE_IDS(); phase_gla_g12(ws, lds, gw, wave, lane); } SEAM(pb + 3);
            if (EN(8) && IN(pb + 4)) DUP(9) { PHASE_IDS(); phase_gla_g3(ws, lh, lds, tid); } SEAM(pb + 4);
        }
        if (EN(9) && IN(pb + 5)) {
            PHASE_IDS();
            const pg8::bf16_t* Wt = (layer & 1) ? (const pg8::bf16_t*)(ws + WS_WOG) + (size_t)lh * 1024 * 1024 : (const pg8::bf16_t*)(ws + WS_WOA) + (size_t)lh * 1024 * 1024;
            pg8::Gemm g{(const pg8::bf16_t*)(ws + ((layer & 1) ? WS_Q : WS_XN)), Wt, MT, 1024, 1024, 0};
            pg8::StaticOrder S; if (layer == NLAYER - 1) S.init(NB * SEQ, 1024, Gp, bxp, true); else S.init(MT, 1024, Gp, bxp);
            pg8::EpiResGate E{(pg8::bf16_t*)(ws + WS_X), (const float*)(ws + WS_MOD) + (size_t)layer * MODROWS * NMODC + 2 * 1024};
            pg8::gemm_phase<pg8::EpiResGate, pg8::StaticOrder, true, true>(lds + RING_OFF, g, S, E, tid);
        } SEAM(pb + 5);
        if (EN(10) && IN(pb + 6)) { if ((DUPMASK >> 10) & 1) { PHASE_IDS(); phase_modulate2_route(ws, layer, lds, vcu, wave, lane, tid, true); __syncthreads(); } PHASE_IDS(); phase_modulate2_route(ws, layer, lds, vcu, wave, lane, tid); } SEAM(pb + 6);
        if (EN(12) && IN(pb + 8)) DUP(12) {
            PHASE_IDS();
            build_expert_tables(ws, layer, lds, tid);
            const int nT = __builtin_amdgcn_readfirstlane(((const LAS int*)(lds + AUX_NT))[0]);
            pg8::MoeOrder S{nT, 8, Gp, bxp, (const LAS int*)(lds + AUX_T2E)};
            LAS unsigned short* rowtab = (LAS unsigned short*)(lds + AUX_ROWTAB);
            { const LAS int* base = (const LAS int*)(lds + AUX_BASE); const LAS int* cntl = (const LAS int*)(lds + AUX_CNT); const int* LIST = (const int*)(ws + WS_LIST);
              pg8::Unit u;
              for (int i = 0; i < ROWTAB_UNITS && S.next(i, u); ++i) if (tid < 256) { const int pos = (u.pm - (base[u.e] >> 8)) * 256 + tid; rowtab[i * 256 + tid] = (unsigned short)((pos < cntl[u.e]) ? LIST[(size_t)u.e * MT + pos] : 0); }
              __syncthreads(); }
            pg8::Gemm g{(const pg8::bf16_t*)(ws + WS_XN8), (const pg8::bf16_t*)(ws + WS_WGU + (size_t)layer * 32 * 2048 * 1024), MPAD, 2048, 512, (size_t)2048 * 1024, rowtab};
            pg8::EpiSwiGLU8 E{ws + WS_ACT, PARF(ws) + P_BGU + (size_t)layer * 32 * 2048, 1.0f / 32.0f};
            pg8::gemm_phase<pg8::EpiSwiGLU8, pg8::MoeOrder, true, true, true, true>(lds + RING_OFF, g, S, E, tid);
        } SEAM(pb + 8);
        if (EN(13) && IN(pb + 9)) DUP(13) {
            PHASE_IDS();
            build_expert_tables(ws, layer, lds, tid);
            const int nT = __builtin_amdgcn_readfirstlane(((const LAS int*)(lds + AUX_NT))[0]);
            pg8::Gemm g{(const pg8::bf16_t*)(ws + WS_ACT), (const pg8::bf16_t*)(ws + WS_WDN + (size_t)layer * 32 * 1024 * 1024), MPAD, 1024, 512, (size_t)1024 * 1024};
            pg8::MoeOrder S{nT, 4, Gp, bxp, (const LAS int*)(lds + AUX_T2E)};
            pg8::EpiBiasBf16 E{(pg8::bf16_t*)(ws + WS_Y), PARF(ws) + P_BDN + (size_t)layer * 32 * 1024, 1.0f / 32.0f};
            pg8::gemm_phase<pg8::EpiBiasBf16, pg8::MoeOrder, true, true, false, true>(lds + RING_OFF, g, S, E, tid);
        } SEAM(pb + 9);
        if (EN(14) && IN(pb + 10)) { if ((DUPMASK >> 14) & 1) { PHASE_IDS(); phase_moe_combine(ws, args.out, layer, lds, gw, NGW, lane, tid, true); } PHASE_IDS(); phase_moe_combine(ws, args.out, layer, lds, gw, NGW, lane, tid); } SEAM(pb + 10);
    }
#undef IN
#undef EN
#undef DUP
#undef SEAM
#undef PHASE_IDS
#undef LANE_ID
}

extern "C" void kernel_launch(void* const* d_in, const int* in_sizes, int n_in, void* d_out, int out_size, void* d_ws, size_t ws_size, hipStream_t stream) {
    static int grid = 0;
    if (grid == 0) {
        if (n_in != 25 || out_size != NB * SEQ * DMODEL || ws_size < WS_END) { fprintf(stderr, "kernel_launch: unexpected shapes: n_in %d out %d ws %zu (need >= %zu)\n", n_in, out_size, ws_size, (size_t)WS_END); grid = -1; return; }
        int dev = 0, cus = 0, per_cu = 0;
        if (hipGetDevice(&dev) != hipSuccess || hipDeviceGetAttribute(&cus, hipDeviceAttributeMultiprocessorCount, dev) != hipSuccess) { grid = -1; return; }
        if (hipFuncSetAttribute((const void*)dit_fwd, hipFuncAttributeMaxDynamicSharedMemorySize, LDS_BYTES) != hipSuccess) { fprintf(stderr, "kernel_launch: hipFuncSetAttribute failed\n"); grid = -1; return; }
        if (hipOccupancyMaxActiveBlocksPerMultiprocessor(&per_cu, (const void*)dit_fwd, NWAVES * 64, LDS_BYTES) != hipSuccess || per_cu < 1) fprintf(stderr, "kernel_launch: occupancy query reports %d\n", per_cu);
        (void)hipGetLastError();
        grid = cus;
    }
    if (grid < 0) return;
    if (hipMemsetAsync((char*)d_ws + WS_CTL, 0, CTL_ZERO_BYTES, stream) != hipSuccess) { fprintf(stderr, "kernel_launch: memset failed\n"); return; }
    Args a{};
    for (int i = 0; i < 25; ++i) a.in[i] = (const float*)d_in[i];
    a.out = (float*)d_out; a.ws = (unsigned char*)d_ws;
#if MK_ONE_LAUNCH
    a.ph_lo = 0; a.ph_hi = NPHASE;
    hipLaunchKernelGGL(dit_fwd, dim3(grid), dim3(NWAVES * 64), LDS_BYTES, stream, a);
#else
    for (int p = 0; p < NPHASE; ++p) { a.ph_lo = p; a.ph_hi = p + 1; hipLaunchKernelGGL(dit_fwd, dim3(grid), dim3(NWAVES * 64), LDS_BYTES, stream, a); }
#endif
    const hipError_t le = hipPeekAtLastError();
    if (le != hipSuccess) fprintf(stderr, "kernel_launch: launch failed: %s\n", hipGetErrorName(le));
}
```

```cpp
#include <hip/hip_runtime.h>
#include <hip/hip_bf16.h>
#include <cstdio>
#include <cstdint>
#include <cmath>

#ifndef MK_ONE_LAUNCH
#define MK_ONE_LAUNCH 1
#endif

namespace pg8 {
#define PG8_LAS __attribute__((address_space(3)))
typedef unsigned short bf16_t;
typedef short bf16x8 __attribute__((ext_vector_type(8)));
typedef float f32x4 __attribute__((ext_vector_type(4)));
typedef unsigned u32x4 __attribute__((ext_vector_type(4)));
constexpr int BM = 256, BK = 64, HALF = 128, HTB = HALF * BK * 2  , STAGE_BYTES = 8 * HTB, NXCD = 8, WGM = 8;

__host__ __device__ __forceinline__ int lds_byte(int r, int c) { const int st = (r >> 4) * 2 + (c >> 5), rr = r & 15, cc = c & 31, ob = rr * 64 + cc * 2; return st * 1024 + (ob ^ (((ob >> 9) & 1) << 5)); }
__host__ __device__ __forceinline__ void stage_rc(int b, int& R, int& C) { const int st = b / 1024, sb = b % 1024, swz = sb ^ (((sb >> 9) & 1) << 5); R = (st >> 1) * 16 + swz / 64; C = (st & 1) * 32 + (swz % 64) / 2; }
__host__ __device__ __forceinline__ int perm32(int rho) { const int n = rho >> 4, i = rho & 15; return 8 * (i >> 2) + 4 * n + (i & 3); }

struct Unit { int pm, pn, e; };
struct Gemm { const bf16_t* A; const bf16_t* Bt; int M, N, K; size_t bstride; const PG8_LAS unsigned short* rowtab; };

struct StaticOrder {
    int nM, nN, nwg, G, c; bool latent_only;
    __host__ __device__ __forceinline__ void init(int M, int N, int G_, int c_, bool lat_ = false) { nM = M / BM; nN = N / BM; nwg = nM * nN; G = G_; c = c_; latent_only = lat_; }
    __host__ __device__ __forceinline__ bool next(int i, Unit& u) const {
        const long L = (long)i * G + c; if (L >= nwg) return false;
        int wgid = (int)L; { const int q = nwg / NXCD, r = nwg % NXCD, xcd = wgid % NXCD, off = wgid / NXCD; wgid = (xcd < r ? xcd * (q + 1) : r * (q + 1) + (xcd - r) * q) + off; }
        const int nig = WGM * nN, gid = wgid / nig, fm = gid * WGM, gsz = (nM - fm) < WGM ? (nM - fm) : WGM;
        u.pm = fm + ((wgid % nig) % gsz); u.pn = (wgid % nig) / gsz; u.e = 0;
        if (latent_only) u.pm = (u.pm >> 4) * 17 + 1 + (u.pm & 15);
        return true;
    }
    __device__ __forceinline__ void a_ready(const Unit&) const {}
    __device__ __forceinline__ void done(const Unit&) const {}
};
struct MoeOrder {
    int nT, nN, G, c; const PG8_LAS int* t2e;
    __device__ __forceinline__ bool next(int i, Unit& u) const {
        const int x = c & 7, j = c >> 3, per = 32 / nN, mt = (i * (G >> 5) + x) * per + j / nN; if (mt >= nT) return false;
        u.pm = mt; u.pn = j % nN; u.e = __builtin_amdgcn_readfirstlane(t2e[mt]); return true;
    }
    __device__ __forceinline__ void a_ready(const Unit&) const {}
    __device__ __forceinline__ void done(const Unit&) const {}
};

__device__ __forceinline__ int lane_now() { unsigned z; asm volatile("s_mov_b32 %0, 0" : "=s"(z)); return (int)__builtin_amdgcn_mbcnt_hi(~0u, __builtin_amdgcn_mbcnt_lo(~0u, z)); }
__device__ __forceinline__ float shx(float v, int m, int ln) { return __int_as_float(__builtin_amdgcn_ds_bpermute((ln ^ m) << 2, __float_as_int(v))); }
__device__ __forceinline__ unsigned pk4_fp8(float a, float b, float c, float d) { int w = 0; w = __builtin_amdgcn_cvt_pk_fp8_f32(a, b, w, false); w = __builtin_amdgcn_cvt_pk_fp8_f32(c, d, w, true); return (unsigned)w; }
__device__ __forceinline__ unsigned cvt_pk_bf16(float lo, float hi) { unsigned r; asm volatile("v_cvt_pk_bf16_f32 %0, %1, %2" : "=v"(r) : "v"(lo), "v"(hi)); return r; }

struct EpiBf16 {
    static constexpr bool PERM = true, AFTER_DRAIN = false;
    bf16_t* O; int ldc;
    __device__ __forceinline__ void operator()(const f32x4 (&acc)[2][2][4][2], const Unit& u, int wr, int wc, int fr, int fq) const {
        const int row0 = u.pm * BM + wr * 64 + fr; const int col0 = u.pn * BM + wc * 32 + 8 * fq;
#pragma unroll
        for (int ai = 0; ai < 2; ++ai)
#pragma unroll
            for (int m = 0; m < 4; ++m) { bf16_t* rowp = O + (size_t)(row0 + ai * HALF + m * 16) * ldc + col0;
#pragma unroll
                for (int bj = 0; bj < 2; ++bj) { const f32x4 v0 = acc[ai][bj][m][0], v1 = acc[ai][bj][m][1];
                    u32x4 w; w.x = cvt_pk_bf16(v0[0], v0[1]); w.y = cvt_pk_bf16(v0[2], v0[3]); w.z = cvt_pk_bf16(v1[0], v1[1]); w.w = cvt_pk_bf16(v1[2], v1[3]);
                    *(u32x4*)(rowp + bj * HALF) = w; } }
    }
};
struct EpiQKV {
    static constexpr bool PERM = true, AFTER_DRAIN = false;
    unsigned char* wsb; size_t offQ, dK, dV;
    const PG8_LAS float* gl; const float* ropec; float c2;
    __device__ __forceinline__ void operator()(const f32x4 (&acc)[2][2][4][2], const Unit& u, int wr, int wc, int fr, int fq) const {
        const int isk = (u.pn >= 4) ? 1 : 0, isv = (u.pn >= 5) ? 1 : 0;
        bf16_t* base = (bf16_t*)(wsb + offQ + (size_t)isk * dK + (size_t)isv * dV); const int ldc = isk ? 256 : 1024;
        const int hcol = (isk ? wc : (u.pn * 4 + wc)) * 64 + 8 * fq;
        const int pmb = u.pm / 17, pml = u.pm - pmb * 17; const bool lat = pml != 0;
        const PG8_LAS float* gp = gl + (isk ? 64 : 0) + 8 * fq; const float scl = isk ? 1.0f : c2;
#pragma unroll
        for (int ai = 0; ai < 2; ++ai)
#pragma unroll
            for (int m = 0; m < 4; ++m) { const int rl = ai * HALF + wr * 64 + m * 16 + fr; const size_t row = (size_t)u.pm * BM + rl;
                f32x4 v[2][2]; float ss = 0.f;
#pragma unroll
                for (int bj = 0; bj < 2; ++bj)
#pragma unroll
                    for (int n = 0; n < 2; ++n) { v[bj][n] = acc[ai][bj][m][n]; ss += (v[bj][n][0] * v[bj][n][0] + v[bj][n][1] * v[bj][n][1]) + (v[bj][n][2] * v[bj][n][2] + v[bj][n][3] * v[bj][n][3]); }
                if (!isv) { const int ln = lane_now(); ss += shx(ss, 16, ln); ss += shx(ss, 32, ln);
                    const float rs = 1.0f / sqrtf(ss * (1.0f / 64.0f) + 1e-6f);
                    const int spos = (pml - 1) * 256 + rl;
#pragma unroll
                    for (int bj = 0; bj < 2; ++bj) { f32x4 cs = (f32x4){1.f, 1.f, 1.f, 1.f}, sn = (f32x4){0.f, 0.f, 0.f, 0.f};
                        if (lat) { const float* cp = ropec + (size_t)spos * 32 + 16 * bj + 4 * fq; cs = *(const f32x4*)cp; sn = *(const f32x4*)(cp + 4096 * 32); }
#pragma unroll
                        for (int n = 0; n < 2; ++n) { const f32x4 y = v[bj][n] * rs * *(const PG8_LAS f32x4*)(gp + 32 * bj + 4 * n);
                            const float c0 = cs[2 * n], s0 = sn[2 * n], c1 = cs[2 * n + 1], s1 = sn[2 * n + 1];
                            v[bj][n] = (f32x4){(y[0] * c0 - y[1] * s0) * scl, (y[0] * s0 + y[1] * c0) * scl, (y[2] * c1 - y[3] * s1) * scl, (y[2] * s1 + y[3] * c1) * scl}; } } }
                bf16_t* rowp = base + row * ldc + hcol;
#pragma unroll
                for (int bj = 0; bj < 2; ++bj) { u32x4 w; w.x = cvt_pk_bf16(v[bj][0][0], v[bj][0][1]); w.y = cvt_pk_bf16(v[bj][0][2], v[bj][0][3]); w.z = cvt_pk_bf16(v[bj][1][0], v[bj][1][1]); w.w = cvt_pk_bf16(v[bj][1][2], v[bj][1][3]);
                    *(u32x4*)(rowp + 32 * bj) = w; } }
    }
};
struct EpiBiasF8 {
    static constexpr bool PERM = true, AFTER_DRAIN = false;
    unsigned char* O; const float* bias; float ascale;
    __device__ __forceinline__ void operator()(const f32x4 (&acc)[2][2][4][2], const Unit& u, int wr, int wc, int fr, int fq) const {
        const int row0 = u.pm * BM + wr * 64 + fr; const int col0 = u.pn * BM + wc * 32 + 8 * fq;
        const float* bp = bias + (size_t)u.e * 1024 + col0;
        f32x4 bv[2][2];
#pragma unroll
        for (int bj = 0; bj < 2; ++bj)
#pragma unroll
            for (int n = 0; n < 2; ++n) bv[bj][n] = *(const f32x4*)(bp + bj * HALF + 4 * n);
#pragma unroll
        for (int ai = 0; ai < 2; ++ai)
#pragma unroll
            for (int m = 0; m < 4; ++m) { unsigned char* rowp = O + (size_t)(row0 + ai * HALF + m * 16) * 1024 + col0;
#pragma unroll
                for (int bj = 0; bj < 2; ++bj) { const f32x4 v0 = acc[ai][bj][m][0] * ascale + bv[bj][0], v1 = acc[ai][bj][m][1] * ascale + bv[bj][1];
                    *(unsigned long long*)(rowp + bj * HALF) = (unsigned long long)pk4_fp8(v0[0], v0[1], v0[2], v0[3]) | ((unsigned long long)pk4_fp8(v1[0], v1[1], v1[2], v1[3]) << 32); } }
    }
};
struct EpiResGate {
    static constexpr bool PERM = false, AFTER_DRAIN = false;
    bf16_t* X; const float* gate;
    __device__ __forceinline__ void operator()(const f32x4 (&acc)[2][2][4][2], const Unit& u, int wr, int wc, int fr, int fq) const {
        const int row0 = u.pm * BM + wr * 64 + fr; const int col0 = u.pn * BM + wc * 32 + 4 * fq;
        const int bb = u.pm / 17, mr = (u.pm - bb * 17 == 0) ? 8 : bb;
        const float* gp = gate + (size_t)mr * 6144 + col0;
        f32x4 gv[2][2];
#pragma unroll
        for (int bj = 0; bj < 2; ++bj)
#pragma unroll
            for (int n = 0; n < 2; ++n) gv[bj][n] = *(const f32x4*)(gp + bj * HALF + n * 16);
#pragma unroll
        for (int ai = 0; ai < 2; ++ai)
#pragma unroll
            for (int m = 0; m < 4; ++m) { bf16_t* rowp = X + (size_t)(row0 + ai * HALF + m * 16) * 1024 + col0;
#pragma unroll
                for (int bj = 0; bj < 2; ++bj)
#pragma unroll
                    for (int n = 0; n < 2; ++n) { unsigned long long* p = (unsigned long long*)(rowp + bj * HALF + n * 16); const unsigned long long v = *p;
                        f32x4 x = (f32x4){__uint_as_float((unsigned)(v & 0xffffu) << 16), __uint_as_float((unsigned)(v >> 16) << 16), __uint_as_float((unsigned)((v >> 32) & 0xffffu) << 16), __uint_as_float((unsigned)(v >> 48) << 16)};
                        x = x + gv[bj][n] * acc[ai][bj][m][n];
                        *p = (unsigned long long)cvt_pk_bf16(x[0], x[1]) | ((unsigned long long)cvt_pk_bf16(x[2], x[3]) << 32); } }
    }
};
struct EpiSwiGLU {
    static constexpr bool PERM = true, AFTER_DRAIN = false;
    bf16_t* O; const float* bias;
    __device__ __forceinline__ void operator()(const f32x4 (&acc)[2][2][4][2], const Unit& u, int wr, int wc, int fr, int fq) const {
        const int row0 = u.pm * BM + wr * 64 + fr; const int col0 = u.pn * HALF + wc * 32 + 8 * fq;
        const float* bp = bias + (size_t)u.e * 2048 + col0;
        f32x4 bg[2], bu[2];
#pragma unroll
        for (int n = 0; n < 2; ++n) { bg[n] = *(const f32x4*)(bp + 4 * n); bu[n] = *(const f32x4*)(bp + 1024 + 4 * n); }
#pragma unroll
        for (int ai = 0; ai < 2; ++ai)
#pragma unroll
            for (int m = 0; m < 4; ++m) { bf16_t* rowp = O + (size_t)(row0 + ai * HALF + m * 16) * 1024 + col0;
                float r[8];
#pragma unroll
                for (int n = 0; n < 2; ++n) { const f32x4 gt = acc[ai][0][m][n] + bg[n], up = acc[ai][1][m][n] + bu[n];
#pragma unroll
                    for (int i = 0; i < 4; ++i) { const float g = fminf(gt[i], 7.0f), uu = fminf(fmaxf(up[i], -7.0f), 7.0f);
                        const float sg = __builtin_amdgcn_rcpf(1.0f + __builtin_amdgcn_exp2f(-1.702f * 1.4426950408889634f * g));
                        r[4 * n + i] = (uu + 1.0f) * (g * sg); } }
                u32x4 w; w.x = cvt_pk_bf16(r[0], r[1]); w.y = cvt_pk_bf16(r[2], r[3]); w.z = cvt_pk_bf16(r[4], r[5]); w.w = cvt_pk_bf16(r[6], r[7]);
                *(u32x4*)rowp = w; }
    }
};
struct EpiSwiGLU8 {
    static constexpr bool PERM = true, AFTER_DRAIN = false;
    unsigned char* O; const float* bias; float ascale;
    __device__ __forceinline__ void operator()(const f32x4 (&acc)[2][2][4][2], const Unit& u, int wr, int wc, int fr, int fq) const {
        const int row0 = u.pm * BM + wr * 64 + fr; const int col0 = u.pn * HALF + wc * 32 + 8 * fq;
        const float* bp = bias + (size_t)u.e * 2048 + col0;
        f32x4 bg[2], bu[2];
#pragma unroll
        for (int n = 0; n < 2; ++n) { bg[n] = *(const f32x4*)(bp + 4 * n); bu[n] = *(const f32x4*)(bp + 1024 + 4 * n); }
#pragma unroll
        for (int ai = 0; ai < 2; ++ai)
#pragma unroll
            for (int m = 0; m < 4; ++m) { unsigned char* rowp = O + (size_t)(row0 + ai * HALF + m * 16) * 1024 + col0;
                float r[8];
#pragma unroll
                for (int n = 0; n < 2; ++n) { const f32x4 gt = acc[ai][0][m][n] * ascale + bg[n], up = acc[ai][1][m][n] * ascale + bu[n];
#pragma unroll
                    for (int i = 0; i < 4; ++i) { const float g = fminf(gt[i], 7.0f), uu = fminf(fmaxf(up[i], -7.0f), 7.0f);
                        const float sg = __builtin_amdgcn_rcpf(1.0f + __builtin_amdgcn_exp2f(-1.702f * 1.4426950408889634f * g));
                        r[4 * n + i] = (uu + 1.0f) * (g * sg); } }
                *(unsigned long long*)rowp = (unsigned long long)pk4_fp8(r[0], r[1], r[2], r[3]) | ((unsigned long long)pk4_fp8(r[4], r[5], r[6], r[7]) << 32); }
    }
};
struct EpiBiasBf16 {
    static constexpr bool PERM = true, AFTER_DRAIN = false;
    bf16_t* O; const float* bias; float ascale;
    __device__ __forceinline__ void operator()(const f32x4 (&acc)[2][2][4][2], const Unit& u, int wr, int wc, int fr, int fq) const {
        const int row0 = u.pm * BM + wr * 64 + fr; const int col0 = u.pn * BM + wc * 32 + 8 * fq;
        const float* bp = bias + (size_t)u.e * 1024 + col0;
        f32x4 bv[2][2];
#pragma unroll
        for (int bj = 0; bj < 2; ++bj)
#pragma unroll
            for (int n = 0; n < 2; ++n) bv[bj][n] = *(const f32x4*)(bp + bj * HALF + 4 * n);
#pragma unroll
        for (int ai = 0; ai < 2; ++ai)
#pragma unroll
            for (int m = 0; m < 4; ++m) { bf16_t* rowp = O + (size_t)(row0 + ai * HALF + m * 16) * 1024 + col0;
#pragma unroll
                for (int bj = 0; bj < 2; ++bj) { const f32x4 v0 = acc[ai][bj][m][0] * ascale + bv[bj][0], v1 = acc[ai][bj][m][1] * ascale + bv[bj][1];
                    u32x4 w; w.x = cvt_pk_bf16(v0[0], v0[1]); w.y = cvt_pk_bf16(v0[2], v0[3]); w.z = cvt_pk_bf16(v1[0], v1[1]); w.w = cvt_pk_bf16(v1[2], v1[3]);
                    *(u32x4*)(rowp + bj * HALF) = w; } }
    }
};

template <class Epi, class Sched, bool ALIGN_EPI = false, bool SP2 = false, bool GATHER = false, bool F8 = false>
__device__ __forceinline__ void gemm_phase(PG8_LAS unsigned char* lds, const Gemm g, const Sched& S, const Epi& E, int tid_in) {
    int tid_l = tid_in; asm volatile("" : "+v"(tid_l));
    const int tid = tid_l, wid = __builtin_amdgcn_readfirstlane(tid >> 6), lane = tid & 63, wr = wid >> 2, wc = wid & 3, fr = lane & 15, fq = lane >> 4;
    const int K = g.K, nt = K / BK;
    unsigned voffA[2], voffB[2];
#pragma unroll
    for (int i = 0; i < 2; ++i) { int R, C; stage_rc(tid * 16 + i * 8192, R, C); const int Rb = Epi::PERM ? ((R & ~31) + perm32(R & 31)) : R;
        voffA[i] = (unsigned)(R * K + C) * 2u; voffB[i] = (unsigned)(Rb * K + C) * 2u; }
    const size_t kstep = (size_t)(BK * 2);
    static_assert(!GATHER || SP2, "GATHER is wired into the SP2 loop only");
    unsigned vAc0[2], vAc1[2], vAn0[2], vAn1[2]; int gR[2]; unsigned gC[2];
#pragma unroll
    for (int i = 0; i < 2; ++i) { int R, C; stage_rc(tid * 16 + i * 8192, R, C); gR[i] = R; gC[i] = (unsigned)C * 2u; vAc0[i] = voffA[i]; vAc1[i] = voffA[i]; vAn0[i] = voffA[i]; vAn1[i] = voffA[i]; }
#define PG8_GFETCH(d0, d1, ord) do { if constexpr (GATHER) { _Pragma("unroll") for (int _i = 0; _i < 2; ++_i) { \
        d0[_i] = (unsigned)g.rowtab[(ord) * 256 + gR[_i]] * (unsigned)(K * 2) + gC[_i]; d1[_i] = (unsigned)g.rowtab[(ord) * 256 + 128 + gR[_i]] * (unsigned)(K * 2) + gC[_i]; } } } while (0)
    const size_t hstep = (size_t)HALF * K * 2;
    const size_t hstepA = GATHER ? 0 : hstep;
    const size_t tstep = 2 * hstep;
    const unsigned ldsw = (unsigned)wid * 1024u;
    const int aoff = lds_byte(wr * 64 + fr, fq * 8), boff = lds_byte(wc * 32 + fr, fq * 8);
    typedef int v8i_t __attribute__((ext_vector_type(8))); typedef int v8i_a16 __attribute__((ext_vector_type(8), aligned(16)));
    const int f8c = 32 * (fq >> 1) + 16 * (fq & 1);
    const int aoff8a = lds_byte(wr * 64 + fr, f8c), boff8a = lds_byte(wc * 32 + fr, f8c);
    v8i_t At8[4], Au8[4], B08[2], B18[2]; int f8scale = 127; asm volatile("" : "+v"(f8scale));
#define PG8_SA(b, h) (((b) * 2 + (h)) * HTB)
#define PG8_SB(b, h) ((4 + (b) * 2 + (h)) * HTB)
#define PG8_STAGE(bufoff, gbase, voff) do { _Pragma("unroll") for (int _i = 0; _i < 2; ++_i) \
        __builtin_amdgcn_global_load_lds((const unsigned*)((const char*)(gbase) + (voff)[_i]), (PG8_LAS unsigned*)(lds + (bufoff) + ldsw + _i * 8192), 16, 0, 0); } while (0)
#define PG8_LDA(dst, b, h) do { if constexpr (F8) { _Pragma("unroll") for (int m = 0; m < 4; ++m) { dst##8[m] = *(const PG8_LAS v8i_a16*)(lds + PG8_SA(b, h) + aoff8a + m * 2048); } } \
        else { _Pragma("unroll") for (int m = 0; m < 4; ++m) _Pragma("unroll") for (int k = 0; k < 2; ++k) dst[m][k] = *(const PG8_LAS bf16x8*)(lds + PG8_SA(b, h) + aoff + m * 2048 + k * 1024); } } while (0)
#define PG8_LDB(dst, b, h) do { if constexpr (F8) { _Pragma("unroll") for (int n = 0; n < 2; ++n) { dst##8[n] = *(const PG8_LAS v8i_a16*)(lds + PG8_SB(b, h) + boff8a + n * 2048); } } \
        else { _Pragma("unroll") for (int n = 0; n < 2; ++n) _Pragma("unroll") for (int k = 0; k < 2; ++k) dst[n][k] = *(const PG8_LAS bf16x8*)(lds + PG8_SB(b, h) + boff + n * 2048 + k * 1024); } } while (0)
#define PG8_MMA(ai, bj, At, Bt) do { __builtin_amdgcn_s_setprio(1); if constexpr (F8) { _Pragma("unroll") for (int m = 0; m < 4; ++m) _Pragma("unroll") for (int n = 0; n < 2; ++n) \
            asm volatile("v_mfma_scale_f32_16x16x128_f8f6f4 %0, %1, %2, %0, %3, %3 op_sel_hi:[0,0,0]" : "+v"(acc[ai][bj][m][n]) : "v"(Bt##8[n]), "v"(At##8[m]), "v"(f8scale)); } \
        else { _Pragma("unroll") for (int m = 0; m < 4; ++m) _Pragma("unroll") for (int n = 0; n < 2; ++n) _Pragma("unroll") for (int k = 0; k < 2; ++k) \
        acc[ai][bj][m][n] = __builtin_amdgcn_mfma_f32_16x16x32_bf16(Bt[n][k], At[m][k], acc[ai][bj][m][n], 0, 0, 0); } __builtin_amdgcn_s_setprio(0); } while (0)
#define PG8_WAIT_V(n) asm volatile("s_waitcnt vmcnt(" #n ")" ::: "memory")
#define PG8_WAIT_L(n) asm volatile("s_waitcnt lgkmcnt(" #n ")" ::: "memory")
#define PG8_BAR __builtin_amdgcn_s_barrier()
#define PG8_SCHED __builtin_amdgcn_sched_barrier(0)
    Unit cur, nxt; int ui = 0;
    if (!S.next(0, cur)) return;
    f32x4 acc[2][2][4][2];
#pragma unroll
    for (int a = 0; a < 2; ++a)
#pragma unroll
        for (int b = 0; b < 2; ++b)
#pragma unroll
            for (int m = 0; m < 4; ++m)
#pragma unroll
                for (int n = 0; n < 2; ++n) acc[a][b][m][n] = (f32x4){0.f, 0.f, 0.f, 0.f};
    bf16x8 At[4][2], Au[4][2], B0[2][2], B1[2][2];
    const char* cA = (const char*)g.A + (GATHER ? (size_t)0 : (size_t)cur.pm * tstep); PG8_GFETCH(vAc0, vAc1, 0); const char* cB = (const char*)g.Bt + (size_t)cur.e * g.bstride + (size_t)cur.pn * tstep;
    S.a_ready(cur);
    if constexpr (SP2) {
        PG8_STAGE(PG8_SB(0, 0), cB, voffB); PG8_STAGE(PG8_SB(0, 1), cB + hstep, voffB); PG8_STAGE(PG8_SA(0, 0), cA, vAc0); PG8_STAGE(PG8_SA(0, 1), cA + hstepA, vAc1);
        if (wr == 1) PG8_BAR;
        PG8_WAIT_V(2); PG8_BAR;
        PG8_STAGE(PG8_SB(1, 0), cB + kstep, voffB); PG8_STAGE(PG8_SA(1, 0), cA + kstep, vAc0); PG8_STAGE(PG8_SB(1, 1), cB + hstep + kstep, voffB);
        PG8_WAIT_V(6); PG8_BAR;
    } else {
        PG8_STAGE(PG8_SB(0, 0), cB, voffB); PG8_STAGE(PG8_SA(0, 0), cA, voffA); PG8_STAGE(PG8_SB(0, 1), cB + hstep, voffB); PG8_STAGE(PG8_SA(0, 1), cA + hstep, voffA);
        if (wr == 1) PG8_BAR;
        PG8_WAIT_V(4); PG8_BAR;
        PG8_STAGE(PG8_SB(1, 0), cB + kstep, voffB); PG8_STAGE(PG8_SA(1, 0), cA + kstep, voffA); PG8_STAGE(PG8_SB(1, 1), cB + hstep + kstep, voffB);
        PG8_WAIT_V(6); PG8_BAR;
    }
    for (;;) {
        const bool has_next = S.next(ui + 1, nxt);
        const char* nA = (has_next && !GATHER) ? (const char*)g.A + (size_t)nxt.pm * tstep : cA;
        if constexpr (GATHER) { if (has_next) PG8_GFETCH(vAn0, vAn1, ui + 1); else { vAn0[0] = vAc0[0]; vAn0[1] = vAc0[1]; vAn1[0] = vAc1[0]; vAn1[1] = vAc1[1]; } }
        const char* nB = has_next ? (const char*)g.Bt + (size_t)nxt.e * g.bstride + (size_t)nxt.pn * tstep : cB;
#pragma unroll 1
        for (int t = 0; t < nt; t += 2) {
            const bool last = (t == nt - 2);
            const char* a1 = cA + (size_t)(t + 1) * kstep;
            const char* a2 = last ? nA : cA + (size_t)(t + 2) * kstep; const char* b2 = last ? nB : cB + (size_t)(t + 2) * kstep;
            const char* a3 = a2 + kstep; const char* b3 = b2 + kstep;
            if (last && has_next) S.a_ready(nxt);
            unsigned vS0[2], vS1[2];
            vS0[0] = last ? vAn0[0] : vAc0[0]; vS0[1] = last ? vAn0[1] : vAc0[1]; vS1[0] = last ? vAn1[0] : vAc1[0]; vS1[1] = last ? vAn1[1] : vAc1[1];
            if constexpr (SP2) {
            PG8_LDB(B0, 0, 0); PG8_LDB(B1, 0, 1); PG8_SCHED; PG8_LDA(At, 0, 0); PG8_STAGE(PG8_SA(1, 1), a1 + hstepA, vAc1);
            PG8_WAIT_V(8); PG8_WAIT_L(0); PG8_BAR; PG8_MMA(0, 0, At, B0); PG8_MMA(0, 1, At, B1); PG8_BAR; PG8_SCHED;
            if constexpr (F8) { PG8_LDA(Au, 0, 1); } else { PG8_LDA(At, 0, 1); } PG8_STAGE(PG8_SB(0, 0), b2, voffB); PG8_STAGE(PG8_SB(0, 1), b2 + hstep, voffB); PG8_STAGE(PG8_SA(0, 0), a2, vS0);
            PG8_WAIT_V(8); PG8_WAIT_L(0); PG8_BAR; if constexpr (F8) { PG8_MMA(1, 0, Au, B0); PG8_MMA(1, 1, Au, B1); } else { PG8_MMA(1, 0, At, B0); PG8_MMA(1, 1, At, B1); } PG8_BAR; PG8_SCHED;
            PG8_LDB(B0, 1, 0); PG8_LDB(B1, 1, 1); PG8_SCHED; PG8_LDA(At, 1, 0); PG8_STAGE(PG8_SA(0, 1), a2 + hstepA, vS1);
            PG8_WAIT_V(8); PG8_WAIT_L(0); PG8_BAR; PG8_MMA(0, 0, At, B0); PG8_MMA(0, 1, At, B1); PG8_BAR; PG8_SCHED;
            if constexpr (F8) { PG8_LDA(Au, 1, 1); } else { PG8_LDA(At, 1, 1); } PG8_STAGE(PG8_SB(1, 0), b3, voffB); PG8_STAGE(PG8_SB(1, 1), b3 + hstep, voffB); PG8_STAGE(PG8_SA(1, 0), a3, vS0);
            PG8_WAIT_V(8); PG8_WAIT_L(0); PG8_BAR; if constexpr (F8) { PG8_MMA(1, 0, Au, B0); PG8_MMA(1, 1, Au, B1); } else { PG8_MMA(1, 0, At, B0); PG8_MMA(1, 1, At, B1); } PG8_BAR; PG8_SCHED;
            } else {
            PG8_LDB(B0, 0, 0); PG8_SCHED; PG8_LDA(At, 0, 0); PG8_STAGE(PG8_SA(1, 1), a1 + hstep, voffA);
            PG8_WAIT_L(8); PG8_BAR; PG8_WAIT_L(0); PG8_MMA(0, 0, At, B0); PG8_BAR; PG8_SCHED;
            PG8_LDB(B1, 0, 1); PG8_STAGE(PG8_SB(0, 0), b2, voffB);
            PG8_BAR; PG8_WAIT_L(0); PG8_MMA(0, 1, At, B1); PG8_BAR;
            PG8_LDA(At, 0, 1); PG8_STAGE(PG8_SA(0, 0), a2, voffA);
            PG8_BAR; PG8_WAIT_L(0); PG8_MMA(1, 0, At, B0); PG8_BAR; PG8_SCHED;
            PG8_STAGE(PG8_SB(0, 1), b2 + hstep, voffB);
            PG8_WAIT_V(6); PG8_BAR; PG8_MMA(1, 1, At, B1); PG8_BAR;
            PG8_LDB(B0, 1, 0); PG8_SCHED; PG8_LDA(At, 1, 0); PG8_STAGE(PG8_SA(0, 1), a2 + hstep, voffA);
            PG8_WAIT_L(8); PG8_BAR; PG8_WAIT_L(0); PG8_MMA(0, 0, At, B0); PG8_BAR; PG8_SCHED;
            PG8_LDB(B1, 1, 1); PG8_STAGE(PG8_SB(1, 0), b3, voffB);
            PG8_BAR; PG8_WAIT_L(0); PG8_MMA(0, 1, At, B1); PG8_BAR;
            PG8_LDA(At, 1, 1); PG8_STAGE(PG8_SA(1, 0), a3, voffA);
            PG8_BAR; PG8_WAIT_L(0); PG8_MMA(1, 0, At, B0); PG8_BAR; PG8_SCHED;
            PG8_STAGE(PG8_SB(1, 1), b3 + hstep, voffB);
            PG8_WAIT_V(6); PG8_BAR; PG8_MMA(1, 1, At, B1); PG8_BAR;
            }
        }
        if constexpr (ALIGN_EPI) { if (wr == 0) PG8_BAR; }
        if constexpr (F8) asm volatile("s_nop 15\n\ts_nop 15" ::: "memory");
        if constexpr (!Epi::AFTER_DRAIN) { E(acc, cur, wr, wc, fr, fq); S.done(cur); }
        if (!has_next) break;
#pragma unroll
        for (int a = 0; a < 2; ++a)
#pragma unroll
            for (int b = 0; b < 2; ++b)
#pragma unroll
                for (int m = 0; m < 4; ++m)
#pragma unroll
                    for (int n = 0; n < 2; ++n) acc[a][b][m][n] = (f32x4){0.f, 0.f, 0.f, 0.f};
        cur = nxt; cA = nA; cB = nB; ++ui;
        if constexpr (GATHER) { vAc0[0] = vAn0[0]; vAc0[1] = vAn0[1]; vAc1[0] = vAn1[0]; vAc1[1] = vAn1[1]; }
        if constexpr (ALIGN_EPI) { if (wr == 1) PG8_BAR; }
    }
    PG8_WAIT_V(0);
    if constexpr (!ALIGN_EPI) { if (wr == 0) PG8_BAR; }
    PG8_BAR;
    if constexpr (Epi::AFTER_DRAIN) { E.fused(acc, cur, wr, wc, fr, fq, lds, wid, lane); S.done(cur); }
#undef PG8_SA
#undef PG8_SB
#undef PG8_STAGE
#undef PG8_LDA
#undef PG8_LDB
#undef PG8_MMA
#undef PG8_WAIT_V
#undef PG8_WAIT_L
#undef PG8_BAR
#undef PG8_SCHED
#undef PG8_GFETCH
}
}
#include <hip/hip_bf16.h>
#include <cmath>
namespace attn_body {
using bf16=__hip_bfloat16;
using bf16x8=__attribute__((ext_vector_type(8)))short;
using s16x4=__attribute__((ext_vector_type(4)))short;
using f32x16=__attribute__((ext_vector_type(16)))float;
using u32x4=__attribute__((ext_vector_type(4)))unsigned;
constexpr int D=64,DM=1024,KVP=256;
constexpr int NW=8,QBLK=32,QB=QBLK*NW,KVBLK=64;
__device__ __forceinline__ int crow(int r,int hi){return (r&3)+8*(r>>2)+4*hi;}
#define SBAR() __builtin_amdgcn_sched_barrier(0)
__device__ __forceinline__ void cmask(f32x16&p0,f32x16&p1,int jb,int qrel,int hi){
  const float NEG=-INFINITY; int kb=64*jb+4*hi;
  #pragma unroll
  for(int r=0;r<16;++r){int kv=kb+(r&3)+8*(r>>2); if(kv>qrel)p0[r]=NEG; if(kv+32>qrel)p1[r]=NEG;}
}

constexpr int NSLOT=3, SLOTB=8192;
constexpr int LDS_K=0, LDS_V=NSLOT*SLOTB, LDS_WS=2*NSLOT*SLOTB, LDS_OST=LDS_WS+NW*64*4, LDS_BYTES=LDS_OST+NW*4096;
constexpr float C2=0.125f*1.4426950408889634f;
__device__ __forceinline__ void glds16(const void*gsrc,unsigned lds_dst){unsigned keep;
  asm volatile("s_mov_b32 %0, m0\n\ts_mov_b32 m0, %2\n\ts_nop 0\n\tglobal_load_lds_dwordx4 %1, off\n\ts_mov_b32 m0, %0":"=&s"(keep):"v"(gsrc),"s"(lds_dst):"memory");}
__device__ __forceinline__ float max3f(float a,float b,float c){float r;asm("v_max3_f32 %0, %1, %2, %3":"=v"(r):"v"(a),"v"(b),"v"(c));return r;}
__device__ __forceinline__ float max2f(float a,float b){float r;asm("v_max_f32_e32 %0, %1, %2":"=v"(r):"v"(a),"v"(b));return r;}
__device__ __forceinline__ float fadd_s(float a,float b){float r;asm("v_add_f32_e32 %0, %1, %2":"=v"(r):"v"(a),"v"(b));return r;}
__device__ __forceinline__ float fsub_s(float a,float b){float r;asm("v_sub_f32_e32 %0, %1, %2":"=v"(r):"v"(a),"v"(b));return r;}
typedef float f32x2_t __attribute__((ext_vector_type(2))); typedef __bf16 bf16x2_t __attribute__((ext_vector_type(2)));
__device__ __forceinline__ unsigned cvtpk_s(float lo,float hi){f32x2_t v={lo,hi};bf16x2_t b=__builtin_convertvector(v,bf16x2_t);return __builtin_bit_cast(unsigned,b);}
#define WAIT_BAR(N) asm volatile("s_waitcnt vmcnt(" #N ") lgkmcnt(0)\n\ts_barrier":::"memory")

__device__ __forceinline__ void qkt(f32x16&p0,f32x16&p1,const char*Kslot,const bf16x8*qr,const f32x16&negm,int r32,int hi){
  const char*kb=Kslot+hi*1024+r32*16;
  #pragma unroll
  for(int d0=0;d0<4;++d0){
    const bf16x8 b0=*reinterpret_cast<const bf16x8*>(kb+d0*2048);
    const bf16x8 b1=*reinterpret_cast<const bf16x8*>(kb+d0*2048+512);
    if(d0==0){p0=__builtin_amdgcn_mfma_f32_32x32x16_bf16(b0,qr[0],negm,0,0,0);p1=__builtin_amdgcn_mfma_f32_32x32x16_bf16(b1,qr[0],negm,0,0,0);}
    else{p0=__builtin_amdgcn_mfma_f32_32x32x16_bf16(b0,qr[d0],p0,0,0,0);p1=__builtin_amdgcn_mfma_f32_32x32x16_bf16(b1,qr[d0],p1,0,0,0);}}
}
typedef __attribute__((address_space(3))) const char* lds_cptr;
typedef short v4i16_t __attribute__((ext_vector_type(4)));
__device__ __forceinline__ void kload8(bf16x8*kf,lds_cptr kp){
  kf[0]=*(const __attribute__((address_space(3))) bf16x8*)(kp);      kf[1]=*(const __attribute__((address_space(3))) bf16x8*)(kp+512);
  kf[2]=*(const __attribute__((address_space(3))) bf16x8*)(kp+2048); kf[3]=*(const __attribute__((address_space(3))) bf16x8*)(kp+2560);
  kf[4]=*(const __attribute__((address_space(3))) bf16x8*)(kp+4096); kf[5]=*(const __attribute__((address_space(3))) bf16x8*)(kp+4608);
  kf[6]=*(const __attribute__((address_space(3))) bf16x8*)(kp+6144); kf[7]=*(const __attribute__((address_space(3))) bf16x8*)(kp+6656);
}
__device__ __forceinline__ void kload2(bf16x8*kf,lds_cptr kp,int j){ kf[2*j]=*(const __attribute__((address_space(3))) bf16x8*)(kp+j*2048); kf[2*j+1]=*(const __attribute__((address_space(3))) bf16x8*)(kp+j*2048+512); }
__device__ __forceinline__ s16x4 vtr(lds_cptr p){ return __builtin_bit_cast(s16x4,__builtin_amdgcn_ds_read_tr16_b64_v4i16((__attribute__((address_space(3))) v4i16_t*)p)); }
__device__ __forceinline__ float rowmax(const f32x16&p0,const f32x16&p1){
  float a=max3f(p0[0],p0[1],p1[0]),b=max3f(p0[2],p0[3],p1[1]);a=max3f(a,p1[2],p1[3]);
  #pragma unroll
  for(int r=4;r<16;r+=4){a=max3f(a,p0[r],p0[r+1]);b=max3f(b,p0[r+2],p0[r+3]);a=max3f(a,p1[r],p1[r+1]);b=max3f(b,p1[r+2],p1[r+3]);}
  const float m=max2f(a,b);
  auto rr=__builtin_amdgcn_permlane32_swap(__float_as_uint(m),__float_as_uint(m),false,false);
  return max2f(__uint_as_float(rr[0]),__uint_as_float(rr[1]));
}
__device__ __forceinline__ void pv(f32x16*o,int vb,bf16x8 pa0,bf16x8 pa1,bf16x8 pa2,bf16x8 pa3){
  #pragma unroll
  for(int d0=0;d0<2;++d0){s16x4 lo[4],hi[4];
    #pragma unroll
    for(int ks=0;ks<4;++ks){
      asm volatile("ds_read_b64_tr_b16 %0,%1 offset:%c2":"=&v"(lo[ks]):"v"(vb),"i"(d0*4096+ks*1024):"memory");
      asm volatile("ds_read_b64_tr_b16 %0,%1 offset:%c2":"=&v"(hi[ks]):"v"(vb),"i"(d0*4096+ks*1024+512):"memory");}
    asm volatile("s_waitcnt lgkmcnt(0)":::"memory");SBAR();
    #define PK(k) (bf16x8){lo[k][0],lo[k][1],lo[k][2],lo[k][3],hi[k][0],hi[k][1],hi[k][2],hi[k][3]}
    o[d0]=__builtin_amdgcn_mfma_f32_32x32x16_bf16(pa0,PK(0),o[d0],0,0,0);
    o[d0]=__builtin_amdgcn_mfma_f32_32x32x16_bf16(pa1,PK(1),o[d0],0,0,0);
    o[d0]=__builtin_amdgcn_mfma_f32_32x32x16_bf16(pa2,PK(2),o[d0],0,0,0);
    o[d0]=__builtin_amdgcn_mfma_f32_32x32x16_bf16(pa3,PK(3),o[d0],0,0,0);
    #undef PK
  }
}

#ifndef ATTN_STORE16
#define ATTN_STORE16(p,v) (*(u32x4*)(p)=(v))
#endif
template<int THRL> __device__ __forceinline__ void attn_unit(long qrow0,long kvrow0,int NT,int h,const bf16*Q,const bf16*__restrict__ K,const bf16*__restrict__ V,bf16*O,char*shm,int tid_in){
  int tid_l=tid_in; asm volatile("":"+v"(tid_l)); const int tid=tid_l,lane=tid&63,r32=lane&31,hi=lane>>5; const int wid=__builtin_amdgcn_readfirstlane(tid>>6);
  const bf16*Qw=Q+(qrow0+wid*QBLK)*DM+h*D;
  const bf16*Kh=K+kvrow0*KVP+(h>>2)*D,*Vh=V+kvrow0*KVP+(h>>2)*D;
  const unsigned lds0=(unsigned)(uintptr_t)shm;
  float*wsf=(float*)(shm+LDS_WS)+wid*64;
  const bf16*ksrc=Kh+(long)lane*KVP+wid*8;
  const bf16*vsrc=Vh+(long)(16*(wid&3)+(lane>>2))*KVP+(wid>>2)*32+(lane&3)*8;
  const unsigned kdst=lds0+LDS_K+wid*1024, vdst=lds0+LDS_V+wid*1024;
  #define DMA_K(t,slot) glds16(ksrc+(long)(t)*KVBLK*KVP,(unsigned)__builtin_amdgcn_readfirstlane(kdst+(slot)))
  #define DMA_V(t,slot) glds16(vsrc+(long)(t)*KVBLK*KVP,(unsigned)__builtin_amdgcn_readfirstlane(vdst+(slot)))
  const int vb0=(int)(lds0+LDS_V)+((lane>>4)&1)*32+(lane&3)*8+(4*hi+((lane&15)>>2))*64;
  const char*Kbase=shm+LDS_K; bf16x8 kf[8];
  const lds_cptr shm3=(lds_cptr)shm; const lds_cptr kp0=shm3+LDS_K+hi*1024+r32*16; const lds_cptr vp0=shm3+LDS_V+((lane>>4)&1)*32+(lane&3)*8+(4*hi+((lane&15)>>2))*64;
  DMA_K(0,0);DMA_V(0,0);DMA_K(1,SLOTB);
  bf16x8 qr[4];
  #pragma unroll
  for(int d0=0;d0<4;++d0)qr[d0]=*reinterpret_cast<const bf16x8*>(&Qw[(long)r32*DM+d0*16+hi*8]);
  float mhat=0.f,l_reg=0.f;f32x16 o[2];o[0]=f32x16{};o[1]=f32x16{};f32x16 negm=f32x16{};asm volatile("":"+v"(negm));
  #define CMASK(P0,P1,t) do{}while(0)
  bool resc=false;
  #define START(P0,P1) do{ const float rm=rowmax(P0,P1); resc=false; \
    { const float dl=rm; mhat=fadd_s(mhat,dl); \
      _Pragma("unroll") for(int r=0;r<16;++r){P0[r]=fsub_s(P0[r],dl);P1[r]=fsub_s(P1[r],dl);} \
      _Pragma("unroll") for(int r=0;r<16;++r)negm[r]=-mhat; asm volatile("":"+v"(negm)); } \
    _Pragma("unroll") for(int r=0;r<16;++r)P0[r]=__builtin_amdgcn_exp2f(P0[r]); }while(0)
  #define RESC() do{ if(resc){ asm volatile("s_waitcnt lgkmcnt(0)":::"memory"); \
      _Pragma("unroll") for(int d_=0;d_<2;++d_) _Pragma("unroll") for(int r=0;r<16;++r)o[d_][r]*=wsf[crow(r,hi)]; } }while(0)
  f32x16 pA0,pA1,pB0,pB1;
  int sl_prev=0,sl_cur=0,sl_next=SLOTB;
  #define ROT() do{sl_prev=sl_cur;sl_cur=sl_next;sl_next=(sl_next==(NSLOT-1)*SLOTB)?0:sl_next+SLOTB;}while(0)
  DMA_K(2,2*SLOTB);
  WAIT_BAR(3);
  qkt(pA0,pA1,Kbase,qr,negm,r32,hi);asm volatile("s_nop 15\n\ts_nop 7":"+v"(pA0),"+v"(pA1));CMASK(pA0,pA1,0);
  START(pA0,pA1);
  _Pragma("unroll") for(int r=0;r<16;++r)pA1[r]=__builtin_amdgcn_exp2f(pA1[r]);
  WAIT_BAR(0);
  DMA_K(3,0);DMA_V(1,SLOTB);
  ROT();
  kload8(kf,kp0+sl_cur);
  WAIT_BAR(2);
  s16x4 vlo[8],vhi[8]; u32x4 pw0,pw1,pw2,pw3;
  #define PKW(P,B) cvtpk_s(P[B],P[B+1])
  #define PAF(k) __builtin_bit_cast(bf16x8,pw##k)
  #define VFR(i) (bf16x8){vlo[i][0],vlo[i][1],vlo[i][2],vlo[i][3],vhi[i][0],vhi[i][1],vhi[i][2],vhi[i][3]}
  #define PIN(x) asm volatile("":"+v"(x))
  #define MX3(a,b,c) __builtin_fmaxf(__builtin_fmaxf((a),(b)),(c))
  #define GAPA(MF,A0,A1,A2,A3,W0,W1,PW) do{ MF; sacc+=A0; sacc+=A1; sacc+=A2; sacc+=A3; PIN(sacc); W0; W1; PIN(PW); SBAR(); }while(0)
  #define EX(v) __builtin_amdgcn_exp2f(v)
  #define GAPB(MF,X,B) do{ MF; X[B]=EX(X[B]); X[B+1]=EX(X[B+1]); X[B+2]=EX(X[B+2]); X[B+3]=EX(X[B+3]); PIN(X); SBAR(); }while(0)
  #define VRD(i) do{ vlo[i]=vtr(vp_+(((i)>>2)*4096+((i)&3)*1024)); vhi[i]=vtr(vp_+(((i)>>2)*4096+((i)&3)*1024+512)); }while(0)
  #define KRD(G,j) do{ if(G){ kload2(kf,kp0+sl_next,j); SBAR(); } }while(0)
  #define STEP(C0,C1,P0,P1,t,GK,GV,GL) do{ SBAR(); \
    const lds_cptr vp_=vp0+sl_prev; \
    VRD(0); SBAR(); float sacc=(P0[0]+P0[1]); \
    GAPA(C0=__builtin_amdgcn_mfma_f32_32x32x16_bf16(kf[0],qr[0],negm,0,0,0), P0[2],P0[3],P0[4],P0[5],     pw0[0]=PKW(P0,0), pw0[1]=PKW(P0,2), pw0); \
    VRD(4); SBAR(); GAPA(C1=__builtin_amdgcn_mfma_f32_32x32x16_bf16(kf[1],qr[0],negm,0,0,0), P0[6],P0[7],P0[8],P0[9],     pw0[2]=PKW(P0,4), pw0[3]=PKW(P0,6), pw0); \
    VRD(1); SBAR(); GAPA(C0=__builtin_amdgcn_mfma_f32_32x32x16_bf16(kf[2],qr[1],C0,0,0,0),   P0[10],P0[11],P0[12],P0[13], pw1[0]=PKW(P0,8), pw1[1]=PKW(P0,10), pw1); \
    VRD(5); SBAR(); GAPA(C1=__builtin_amdgcn_mfma_f32_32x32x16_bf16(kf[3],qr[1],C1,0,0,0),   P0[14],P0[15],P1[0],P1[1],   pw1[2]=PKW(P0,12),pw1[3]=PKW(P0,14), pw1); \
    VRD(2); SBAR(); GAPA(C0=__builtin_amdgcn_mfma_f32_32x32x16_bf16(kf[4],qr[2],C0,0,0,0),   P1[2],P1[3],P1[4],P1[5],     pw2[0]=PKW(P1,0), pw2[1]=PKW(P1,2), pw2); \
    VRD(6); SBAR(); GAPA(C1=__builtin_amdgcn_mfma_f32_32x32x16_bf16(kf[5],qr[2],C1,0,0,0),   P1[6],P1[7],P1[8],P1[9],     pw2[2]=PKW(P1,4), pw2[3]=PKW(P1,6), pw2); \
    VRD(3); SBAR(); GAPA(C0=__builtin_amdgcn_mfma_f32_32x32x16_bf16(kf[6],qr[3],C0,0,0,0),   P1[10],P1[11],P1[12],P1[13], pw3[0]=PKW(P1,8), pw3[1]=PKW(P1,10), pw3); \
    VRD(7); SBAR(); GAPA(C1=__builtin_amdgcn_mfma_f32_32x32x16_bf16(kf[7],qr[3],C1,0,0,0),   P1[14],P1[15],0.f,0.f,       pw3[2]=PKW(P1,12),pw3[3]=PKW(P1,14), pw3); \
    l_reg+=sacc; \
    if(GK){DMA_K((t)+3,sl_cur);} if(GV){DMA_V((t)+1,sl_next);} \
    CMASK(C0,C1,t); \
    { float a=MX3(C0[0],C0[1],C1[0]),b=MX3(C0[2],C0[3],C1[1]); a=MX3(a,C1[2],C1[3]); \
      _Pragma("unroll") for(int r=4;r<16;r+=4){a=MX3(a,C0[r],C0[r+1]);b=MX3(b,C0[r+2],C0[r+3]);a=MX3(a,C1[r],C1[r+1]);b=MX3(b,C1[r+2],C1[r+3]);} \
      float rm=__builtin_fmaxf(a,b); { auto rr=__builtin_amdgcn_permlane32_swap(__float_as_uint(rm),__float_as_uint(rm),false,false); rm=__builtin_fmaxf(__uint_as_float(rr[0]),__uint_as_float(rr[1])); } \
      resc=false; \
      if(__builtin_expect(__any(rm>(float)THRL),0)){ const float dl=__builtin_fmaxf(rm,0.f); mhat+=dl; \
        _Pragma("unroll") for(int r=0;r<16;++r){C0[r]-=dl;C1[r]-=dl;} \
        _Pragma("unroll") for(int r=0;r<16;++r)negm[r]=-mhat; asm volatile("":"+v"(negm)); \
        const float f=__builtin_amdgcn_exp2f(-dl); l_reg*=f; if(hi==0)wsf[r32]=f; resc=true; } } \
    SBAR(); \
    GAPB(o[0]=__builtin_amdgcn_mfma_f32_32x32x16_bf16(PAF(0),VFR(0),o[0],0,0,0), C0,0); \
    GAPB(o[1]=__builtin_amdgcn_mfma_f32_32x32x16_bf16(PAF(0),VFR(4),o[1],0,0,0), C0,4); \
    KRD(GL,0); GAPB(o[0]=__builtin_amdgcn_mfma_f32_32x32x16_bf16(PAF(1),VFR(1),o[0],0,0,0), C0,8); \
    KRD(GL,1); GAPB(o[1]=__builtin_amdgcn_mfma_f32_32x32x16_bf16(PAF(1),VFR(5),o[1],0,0,0), C0,12); \
    KRD(GL,2); GAPB(o[0]=__builtin_amdgcn_mfma_f32_32x32x16_bf16(PAF(2),VFR(2),o[0],0,0,0), C1,0); \
    KRD(GL,3); GAPB(o[1]=__builtin_amdgcn_mfma_f32_32x32x16_bf16(PAF(2),VFR(6),o[1],0,0,0), C1,4); \
    GAPB(o[0]=__builtin_amdgcn_mfma_f32_32x32x16_bf16(PAF(3),VFR(3),o[0],0,0,0), C1,8); \
    GAPB(o[1]=__builtin_amdgcn_mfma_f32_32x32x16_bf16(PAF(3),VFR(7),o[1],0,0,0), C1,12); \
    }while(0)
  int t=1;
  #undef CMASK
  #define CMASK(P0,P1,t) do{}while(0)
  for(;t+5<NT;t+=2){
    STEP(pB0,pB1,pA0,pA1,t,true,true,true);     WAIT_BAR(2); RESC(); ROT();
    STEP(pA0,pA1,pB0,pB1,t+1,true,true,true);   WAIT_BAR(2); RESC(); ROT();
  }
  #undef CMASK
  #define CMASK(P0,P1,t) do{}while(0)
  #define ENDW(tt) do{ if((tt)+3<NT){WAIT_BAR(2);} else if((tt)+2<NT){WAIT_BAR(1);} else {WAIT_BAR(0);} }while(0)
  for(;t+1<NT;t+=2){
    STEP(pB0,pB1,pA0,pA1,t,(t+3<NT),(t+1<NT),(t+1<NT));       ENDW(t);   RESC(); ROT();
    STEP(pA0,pA1,pB0,pB1,t+1,(t+4<NT),(t+2<NT),(t+2<NT));     ENDW(t+1); RESC(); ROT();
  }
  STEP(pB0,pB1,pA0,pA1,NT-1,false,false,false); RESC();
  { float sacc=pB0[0]+pB0[1]; _Pragma("unroll") for(int r=2;r<16;++r)sacc+=pB0[r]; _Pragma("unroll") for(int r=0;r<16;++r)sacc+=pB1[r]; l_reg+=sacc;
    pw0=(u32x4){PKW(pB0,0),PKW(pB0,2),PKW(pB0,4),PKW(pB0,6)};pw1=(u32x4){PKW(pB0,8),PKW(pB0,10),PKW(pB0,12),PKW(pB0,14)};pw2=(u32x4){PKW(pB1,0),PKW(pB1,2),PKW(pB1,4),PKW(pB1,6)};pw3=(u32x4){PKW(pB1,8),PKW(pB1,10),PKW(pB1,12),PKW(pB1,14)};
    SBAR(); pv(o,vb0+sl_cur,PAF(0),PAF(1),PAF(2),PAF(3)); }
  #undef PKW
  #undef PAF
  #undef VFR
  #undef PIN
  #undef MX3
  #undef GAPA
  #undef GAPB
  #undef EX
  #undef VRD
  #undef KRD
  #undef STEP
  #undef ENDW
  {auto rr=__builtin_amdgcn_permlane32_swap(__float_as_uint(l_reg),__float_as_uint(l_reg),false,false);l_reg=__uint_as_float(rr[0])+__uint_as_float(rr[1]);}
  if(hi==0)wsf[32+r32]=l_reg;asm volatile("s_waitcnt lgkmcnt(0)":::"memory");
  float rli[16];
  #pragma unroll
  for(int r=0;r<16;++r)rli[r]=__builtin_amdgcn_rcpf(wsf[32+crow(r,hi)]);
  bf16*Ow=O+(qrow0+wid*QBLK)*DM+h*D;
  { bf16*stg=(bf16*)(shm+LDS_OST)+wid*2048;
    #pragma unroll
    for(int r=0;r<16;++r){const int orow=crow(r,hi);
      #pragma unroll
      for(int d0=0;d0<2;++d0)stg[orow*64+d0*32+r32]=__float2bfloat16(o[d0][r]*rli[r]);}
    asm volatile("s_waitcnt lgkmcnt(0)":::"memory");
    #pragma unroll
    for(int i=0;i<4;++i){const int row=i*8+(lane>>3),ch=lane&7; const u32x4 v=*(const u32x4*)(stg+row*64+ch*8); ATTN_STORE16(Ow+(long)row*DM+ch*8,v);} }
  asm volatile("s_waitcnt lgkmcnt(0)\n\ts_barrier":::"memory");
  #undef DMA_K
  #undef DMA_V
  #undef CMASK
  #undef START
  #undef RESC
  #undef ROT
}
constexpr int ATTN_LDS_BYTES=LDS_BYTES;
#undef SBAR
#undef WAIT_BAR
}

constexpr int NWAVES = 8;
constexpr int NB = 8, SEQ = 4096, CTXL = 256, TB = SEQ + CTXL  , MT = NB * TB  , DMODEL = 1024;
constexpr int NMODC = 6 * DMODEL, MODROWS = 9;
constexpr int QKVN = 1536, WINN = 3104, WINP = 3328;
constexpr int NEXP = 32, TOPK = 4, MPAD = MT * TOPK + NEXP * 256;
constexpr int NLAYER = 4;
constexpr float RMS_EPS = 1e-6f;
constexpr float ATT_C2 = 0.125f * 1.4426950408889634f;

constexpr size_t MiB = 1u << 20;
constexpr size_t WS_CTL = 0, CTL_ZERO_BYTES = 1 * MiB;
constexpr size_t WS_MOD = 1 * MiB, WS_ROPE = 2 * MiB, WS_MODP = 3 * MiB;
constexpr size_t WS_SLOT = 17 * MiB, WS_GATEW = 18 * MiB, WS_SLOTPOS = 19 * MiB;
constexpr size_t WS_WQKV = 20 * MiB, WS_WOA = 26 * MiB, WS_WIN = 30 * MiB, WS_WOG = 43 * MiB, WS_WGU = 48 * MiB, WS_WDN = 560 * MiB;
constexpr size_t WS_X = 816 * MiB, WS_XN = 952 * MiB, WS_Q = 1020 * MiB, WS_K = 1088 * MiB, WS_V = 1105 * MiB, WS_G = 1122 * MiB;
constexpr size_t WS_OF = 1343 * MiB, WS_OB = 1479 * MiB, WS_XG = 1615 * MiB, WS_ACT = 1903 * MiB, WS_Y = 2191 * MiB, WS_XN8 = WS_ACT + 150 * MiB  , WS_PAR = 2479 * MiB, WS_LIST = 2483 * MiB  , WS_END = 2488 * MiB;
static_assert(WS_MODP + (size_t)16 * NLAYER * MODROWS * NMODC * 4 <= WS_SLOT && WS_WIN + (size_t)2 * WINP * 1024 * 2 <= WS_WOG && WS_G + (size_t)MT * WINP * 2 <= WS_OF && WS_XG + (size_t)MPAD * 1024 * 2 <= WS_ACT, "ws map");
constexpr int CW_TMO = 0, CW_BAR = 4096, CW_CNT = 16384;

constexpr int RING_OFF = 0, RING_BYTES = 131072;
constexpr int WR_STRIDE = 1028;
constexpr int LDS_AUX = 133120;
constexpr int AUX_LCNT = LDS_AUX, AUX_GB = LDS_AUX + 128, AUX_T2E = LDS_AUX + 256  , AUX_BASE = AUX_T2E + 2560  , AUX_NT = AUX_BASE + 128, AUX_CNT = AUX_NT + 64  , AUX_ENT = AUX_CNT + 128  , AUX_RS = AUX_ENT + 4352  , AUX_ROWTAB = AUX_RS + 576, ROWTAB_UNITS = 18  ;
constexpr int MISC_OFF = 154624;
constexpr int LDS_BYTES = 155648;
static_assert(AUX_ROWTAB + ROWTAB_UNITS * 512 <= MISC_OFF, "LDS map");

#define GAS __attribute__((address_space(1)))
#define LAS __attribute__((address_space(3)))
typedef unsigned short bf16;
typedef unsigned v4u __attribute__((ext_vector_type(4)));
typedef float f32x4 __attribute__((ext_vector_type(4)));
typedef short bf16x8 __attribute__((ext_vector_type(8)));
typedef GAS unsigned gu32;
typedef GAS unsigned long long gu64;
#define RLX_AGENT __ATOMIC_RELAXED, __HIP_MEMORY_SCOPE_AGENT
#define LDS_WAIT() asm volatile("s_waitcnt lgkmcnt(0)" ::: "memory")
#define VM_WAIT() asm volatile("s_waitcnt vmcnt(0)" ::: "memory")
__device__ __forceinline__ unsigned long long rt() { return __builtin_amdgcn_s_memrealtime(); }
__device__ __forceinline__ unsigned f2bf(float f) { unsigned u = __builtin_bit_cast(unsigned, f); return (u + 0x7fffu + ((u >> 16) & 1u)) >> 16; }
__device__ __forceinline__ unsigned pk2(float lo, float hi) { return f2bf(lo) | (f2bf(hi) << 16); }

#define XB_TMO      128
#define XB_XCNT(j)  (256  + 64 * (j))
#define XB_XSUB(j)  (1280 + 64 * (j))
#define XB_XGEN(j)  (2304 + 64 * (j))
#define XB_TOP      3328
#define XB_TOPGEN   3392
#define XCD_BAR_WORDS 3456
#define XB_SPIN_CAP (1u << 18)

__device__ __forceinline__ unsigned xb_ld(unsigned* p)              { return __hip_atomic_load(p, __ATOMIC_RELAXED, __HIP_MEMORY_SCOPE_AGENT); }
__device__ __forceinline__ unsigned xb_add(unsigned* p, unsigned v) { return __hip_atomic_fetch_add(p, v, __ATOMIC_RELAXED, __HIP_MEMORY_SCOPE_AGENT); }
__device__ __forceinline__ unsigned xb_xcc_id() { return (unsigned)__builtin_amdgcn_s_getreg((3 << 11) | 20) & 0xFu; }
#define XB_SPIN(cond, bar) do { unsigned _sp = 0; while (cond) { __builtin_amdgcn_s_sleep(1); \
    if ((++_sp & 255u) == 0u) { if (xb_ld(&(bar)[XB_TMO])) break; if (_sp > XB_SPIN_CAP) { atomicAdd(&(bar)[XB_TMO], 1u); break; } } } } while (0)

struct XcdBarrier {
    unsigned* bar; unsigned x;
    volatile LAS unsigned* st;
};

__device__ __forceinline__ XcdBarrier xcd_barrier_post(unsigned* bar, volatile LAS unsigned* st, bool xb_t0  ) {
    XcdBarrier b; b.bar = bar; b.x = xb_xcc_id(); b.st = st;
    if (xb_t0) (void)xb_add(&bar[XB_XCNT(b.x)], 1u);
    return b;
}
__device__ __forceinline__ void xcd_barrier_complete(unsigned* bar, unsigned x, unsigned& nloc, unsigned& nx) {
    const unsigned G = gridDim.x * gridDim.y * gridDim.z;
    unsigned sum, cnt, mine, sp = 0u;
    for (;;) {
        sum = 0u; cnt = 0u; mine = 0u;
#pragma unroll
        for (unsigned j = 0; j < 16; ++j) { const unsigned c = xb_ld(&bar[XB_XCNT(j)]); sum += c; cnt += (c > 0u) ? 1u : 0u; mine = (j == x) ? c : mine; }
        if (sum == G) break;
        __builtin_amdgcn_s_sleep(1);
        if ((++sp & 255u) == 0u) { if (xb_ld(&bar[XB_TMO])) break; if (sp > XB_SPIN_CAP) { atomicAdd(&bar[XB_TMO], 1u); break; } }
    }
    nloc = mine > 0u ? mine : 1u; nx = cnt > 0u ? cnt : 1u;
}

__device__ __forceinline__ void xcd_barrier(const XcdBarrier& b, bool xb_t0  ) {
    asm volatile("s_waitcnt vmcnt(0)" ::: "memory");
    __syncthreads();
    if (xb_t0) {
        unsigned* bar = b.bar;
        __builtin_amdgcn_s_waitcnt(0);
        unsigned nloc = b.st[0], nx = b.st[1];
        if (nloc == 0u) { xcd_barrier_complete(bar, b.x, nloc, nx); b.st[0] = nloc; b.st[1] = nx; }
        const unsigned old = xb_add(&bar[XB_XSUB(b.x)], 1u);
        const unsigned gen = old / nloc;
        if (old + 1u == (gen + 1u) * nloc) {
            __builtin_amdgcn_fence(__ATOMIC_RELEASE, "agent");
            asm volatile("s_waitcnt vmcnt(0)" ::: "memory");
            const unsigned og = xb_add(&bar[XB_TOP], 1u);
            const unsigned tg = og / nx;
            if (og + 1u == (tg + 1u) * nx) xb_add(&bar[XB_TOPGEN], 1u);
            else XB_SPIN(xb_ld(&bar[XB_TOPGEN]) == tg, bar);
            __builtin_amdgcn_fence(__ATOMIC_ACQUIRE, "agent");
            xb_add(&bar[XB_XGEN(b.x)], 1u);
            asm volatile("s_waitcnt vmcnt(0)" ::: "memory");
        } else {
            XB_SPIN(xb_ld(&bar[XB_XGEN(b.x)]) == gen, bar);
            __builtin_amdgcn_fence(__ATOMIC_ACQUIRE, "agent");
            asm volatile("s_waitcnt vmcnt(0)" ::: "memory");
        }
    }
    __syncthreads();
}

typedef float f32x2 __attribute__((ext_vector_type(2)));
using pg8::lane_now; using pg8::shx;
__device__ __forceinline__ float wave_sum(float v) {
    const int ln = lane_now();
#pragma unroll
    for (int o = 1; o < 64; o <<= 1) v += shx(v, o, ln);
    return v;
}
__device__ __forceinline__ float wave_max(float v) {
    const int ln = lane_now();
#pragma unroll
    for (int o = 1; o < 64; o <<= 1) v = fmaxf(v, shx(v, o, ln));
    return v;
}
__device__ __forceinline__ float bf2f(unsigned short h) { return __uint_as_float((unsigned)h << 16); }
__device__ __forceinline__ float silu_f(float x) { return x / (1.0f + __expf(-x)); }
__device__ __forceinline__ f32x4 bf4_to_f32(unsigned long long v) { return (f32x4){__uint_as_float((unsigned)(v & 0xffffu) << 16), __uint_as_float((unsigned)(v >> 16) << 16), __uint_as_float((unsigned)((v >> 32) & 0xffffu) << 16), __uint_as_float((unsigned)(v >> 48) << 16)}; }
__device__ __forceinline__ unsigned long long f32_to_bf4(f32x4 y) { return (unsigned long long)pk2(y.x, y.y) | ((unsigned long long)pk2(y.z, y.w) << 32); }
__device__ __forceinline__ int mod_row(int m) { const int b = m / TB; return (m - b * TB < CTXL) ? 8 : b; }

__device__ __forceinline__ void transpose_item(const float* W, int K, int N, bf16* WT, int k0, int n0, int dst_row0, LAS float* scr, int lane) {
#pragma unroll 8
    for (int i = 0; i < 32; ++i) { const int kk = 2 * i + (lane >> 5); scr[kk * 33 + (lane & 31)] = W[(size_t)(k0 + kk) * N + n0 + (lane & 31)]; }
    LDS_WAIT(); asm volatile("" ::: "memory");
    const int c = lane & 7;
#pragma unroll
    for (int j = 0; j < 4; ++j) { const int n = (lane >> 3) + 8 * j; const LAS float* s = scr + (8 * c) * 33 + n;
        v4u o; o.x = pk2(s[0 * 33], s[1 * 33]); o.y = pk2(s[2 * 33], s[3 * 33]); o.z = pk2(s[4 * 33], s[5 * 33]); o.w = pk2(s[6 * 33], s[7 * 33]);
        *(GAS v4u*)(WT + (size_t)(dst_row0 + n) * K + k0 + 8 * c) = o; }
    LDS_WAIT(); asm volatile("" ::: "memory");
}

__device__ __forceinline__ void transpose_item8(const float* W, int K, int N, unsigned char* WT8, int k0, int n0, int dst_row0, LAS float* scr, int lane) {
#pragma unroll 8
    for (int i = 0; i < 32; ++i) { const int kk = 2 * i + (lane >> 5); scr[kk * 33 + (lane & 31)] = W[(size_t)(k0 + kk) * N + n0 + (lane & 31)]; }
    LDS_WAIT(); asm volatile("" ::: "memory");
    const int n = lane & 31;
#pragma unroll
    for (int q = 0; q < 2; ++q) { const int ch = (lane >> 5) + 2 * q; const LAS float* s = scr + (16 * ch) * 33 + n;
        v4u o;
        o.x = pg8::pk4_fp8(s[0 * 33] * 32.f, s[1 * 33] * 32.f, s[2 * 33] * 32.f, s[3 * 33] * 32.f); o.y = pg8::pk4_fp8(s[4 * 33] * 32.f, s[5 * 33] * 32.f, s[6 * 33] * 32.f, s[7 * 33] * 32.f);
        o.z = pg8::pk4_fp8(s[8 * 33] * 32.f, s[9 * 33] * 32.f, s[10 * 33] * 32.f, s[11 * 33] * 32.f); o.w = pg8::pk4_fp8(s[12 * 33] * 32.f, s[13 * 33] * 32.f, s[14 * 33] * 32.f, s[15 * 33] * 32.f);
        *(GAS v4u*)(WT8 + (size_t)(dst_row0 + n) * K + k0 + 16 * ch) = o; }
    LDS_WAIT(); asm volatile("" ::: "memory");
}

struct Args { const float* in[25]; float* out; unsigned char* ws; int ph_lo, ph_hi; };
constexpr int P_N1G = 0, P_N2G = 4096, P_QG = 8192, P_KG = 8320, P_GKF = 8448, P_GKB = 24832, P_BGF = 41216, P_BGB = 42240, P_OG = 43264, P_WR = 43776, P_BR = 174848, P_BGU = 174976, P_BDN = 437120, P_END = 568192;
#define LAUNDER_S(p) asm volatile("" : "+s"(p))
#define LAUNDER_V(p) asm volatile("" : "+v"(p))
#define PARF(ws) ((const float*)((ws) + WS_PAR))

__device__ __forceinline__ void p0_prologue(const Args& A, LAS unsigned char* lds, int gw, int NGW, int wave, int lane) {
    unsigned char* ws = A.ws;
    LAS float* scr = (LAS float*)(lds + RING_OFF + wave * 16384);
    constexpr int I_QKV = 2 * 16 * (QKVN / 32), I_WO = 2 * 16 * 32, I_WIN = 2 * 16 * (WINN / 32), I_GU = 128 * 16 * 64, I_DN = 128 * 16 * 32;
    constexpr int NITEMS = I_GU + I_DN + I_QKV + I_WO + I_WIN + I_WO;
    for (int it = gw; it < NITEMS; it += NGW) {
        int r = it;
        if (r < I_GU) { const int mat = r / (16 * 64), q = r - mat * (16 * 64), kb = q / 64, nb = q - kb * 64, n0 = nb * 32;
            const int dst = ((n0 & 1023) >> 7) * 256 + (n0 >> 10) * 128 + (n0 & 127);
            transpose_item8(A.in[21] + (size_t)mat * 1024 * 2048, 1024, 2048, ws + WS_WGU + (size_t)mat * 2048 * 1024, kb * 64, n0, dst, scr, lane); continue; } r -= I_GU;
        if (r < I_DN) { const int mat = r / (16 * 32), q = r - mat * (16 * 32), kb = q / 32, nb = q - kb * 32;
            transpose_item8(A.in[23] + (size_t)mat * 1024 * 1024, 1024, 1024, ws + WS_WDN + (size_t)mat * 1024 * 1024, kb * 64, nb * 32, nb * 32, scr, lane); continue; } r -= I_DN;
        if (r < I_QKV) { const int per = 16 * (QKVN / 32), mat = r / per, q = r - mat * per, kb = q / (QKVN / 32), nb = q - kb * (QKVN / 32);
            const int n0 = nb * 32, dst = (n0 & ~255) + ((n0 >> 5) & 1) * 128 + ((n0 >> 6) & 3) * 32;
            transpose_item(A.in[8] + (size_t)mat * 1024 * QKVN, 1024, QKVN, (bf16*)(ws + WS_WQKV) + (size_t)mat * QKVN * 1024, kb * 64, n0, dst, scr, lane); continue; } r -= I_QKV;
        if (r < I_WO) { const int mat = r / 512, q = r - mat * 512, kb = q / 32, nb = q - kb * 32;
            transpose_item(A.in[11] + (size_t)mat * 1024 * 1024, 1024, 1024, (bf16*)(ws + WS_WOA) + (size_t)mat * 1024 * 1024, kb * 64, nb * 32, nb * 32, scr, lane); continue; } r -= I_WO;
        if (r < I_WIN) { const int per = 16 * (WINN / 32), mat = r / per, q = r - mat * per, kb = q / (WINN / 32), nb = q - kb * (WINN / 32);
            transpose_item(A.in[12] + (size_t)mat * 1024 * WINN, 1024, WINN, (bf16*)(ws + WS_WIN) + (size_t)mat * WINP * 1024, kb * 64, nb * 32, nb * 32, scr, lane); continue; } r -= I_WIN;
        { const int mat = r / 512, q = r - mat * 512, kb = q / 32, nb = q - kb * 32;
            transpose_item(A.in[18] + (size_t)mat * 1024 * 1024, 1024, 1024, (bf16*)(ws + WS_WOG) + (size_t)mat * 1024 * 1024, kb * 64, nb * 32, nb * 32, scr, lane); }
    }
    for (int it = gw; it < 2 * (WINP - WINN); it += NGW) { const int mat = it / (WINP - WINN), rr = WINN + it - mat * (WINP - WINN);
        GAS v4u* p = (GAS v4u*)((bf16*)(ws + WS_WIN) + ((size_t)mat * WINP + rr) * 1024) + lane; p[0] = (v4u){0u, 0u, 0u, 0u}; p[64] = (v4u){0u, 0u, 0u, 0u}; }
    for (int it = gw; it < NLAYER * 24 * 16; it += NGW) {
        const int l = it / (24 * 16), q = it - l * (24 * 16), cg = q / 16, kc = q - cg * 16;
        float s[MODROWS];
#pragma unroll
        for (int r = 0; r < MODROWS; ++r) { const float cv = (r < 8) ? A.in[1][r * 1024 + kc * 64 + lane] : A.in[3][kc * 64 + lane]; s[r] = silu_f(cv); }
        f32x4 acc[MODROWS];
#pragma unroll
        for (int r = 0; r < MODROWS; ++r) acc[r] = (f32x4){0.f, 0.f, 0.f, 0.f};
        const float* wp = A.in[4] + ((size_t)l * 1024 + kc * 64) * NMODC + cg * 256 + 4 * lane;
#pragma unroll 4
        for (int kk = 0; kk < 64; ++kk) { const f32x4 w = *(const f32x4*)(wp + (size_t)kk * NMODC);
#pragma unroll
            for (int r = 0; r < MODROWS; ++r) { const float sv = __shfl(s[r], kk); acc[r] = acc[r] + w * sv; } }
        float* op = (float*)(ws + WS_MODP) + (size_t)kc * (NLAYER * MODROWS * NMODC) + (size_t)l * MODROWS * NMODC + cg * 256 + 4 * lane;
#pragma unroll
        for (int r = 0; r < MODROWS; ++r) *(f32x4*)(op + (size_t)r * NMODC) = acc[r];
    }
    for (int m = gw; m < MT; m += NGW) { const int b = m / TB, w = m - b * TB;
        const float* src = (w < CTXL) ? A.in[2] + ((size_t)b * CTXL + w) * 1024 : A.in[0] + ((size_t)b * SEQ + (w - CTXL)) * 1024;
        const GAS f32x4* sp = (const GAS f32x4*)src + lane; GAS unsigned long long* dp = (GAS unsigned long long*)((bf16*)(ws + WS_X) + (size_t)m * 1024) + lane;
#pragma unroll
        for (int j = 0; j < 4; ++j) dp[64 * j] = f32_to_bf4(sp[64 * j]); }
    { float* par = (float*)(ws + WS_PAR); const int gt = gw * 64 + lane, NGT = NGW * 64;
#define CPY(src, n, off) for (int i = gt; i < (n); i += NGT) par[(off) + i] = A.in[src][i];
      CPY(6, 4096, P_N1G) CPY(7, 4096, P_N2G) CPY(9, 128, P_QG) CPY(10, 128, P_KG) CPY(13, 16384, P_GKF) CPY(15, 16384, P_GKB) CPY(14, 1024, P_BGF) CPY(16, 1024, P_BGB)
      CPY(17, 512, P_OG) CPY(19, 131072, P_WR) CPY(20, 128, P_BR) CPY(22, 262144, P_BGU) CPY(24, 131072, P_BDN)
#undef CPY
    }
    for (int idx = gw * 64 + lane; idx < SEQ * 32; idx += NGW * 64) { const int s = idx >> 5, i = idx & 31;
        const float invf = 1.0f / powf(10000.0f, (float)(i & 15) * (1.0f / 16.0f));
        const float ang = (float)((i < 16) ? (s >> 6) : (s & 63)) * invf;
        ((float*)(ws + WS_ROPE))[idx] = cosf(ang); ((float*)(ws + WS_ROPE))[SEQ * 32 + idx] = sinf(ang); }
}
__device__ __forceinline__ void p1_mod_reduce(const Args& A, int gtid, int NGT) {
    const float* P = (const float*)(A.ws + WS_MODP); float* Mo = (float*)(A.ws + WS_MOD);
    constexpr int N = NLAYER * MODROWS * NMODC;
    for (int i = gtid; i < N; i += NGT) { const int l = i / (MODROWS * NMODC), c = i % NMODC; float s = A.in[5][l * NMODC + c];
#pragma unroll
        for (int k = 0; k < 16; ++k) s += P[(size_t)k * N + i];
        Mo[i] = s; }
}
__device__ __forceinline__ void modulate_row(const bf16* xrow, const float* ng, const float* shp, const float* scp, bf16* orow, int lane, f32x4 (&y)[4], float& rs_out) {
    const GAS unsigned long long* xr = (const GAS unsigned long long*)xrow + lane;
    float ss = 0.f;
#pragma unroll
    for (int j = 0; j < 4; ++j) { y[j] = bf4_to_f32(xr[64 * j]); ss += (y[j].x * y[j].x + y[j].y * y[j].y) + (y[j].z * y[j].z + y[j].w * y[j].w); }
    const float rs = 1.0f / sqrtf(wave_sum(ss) * (1.0f / 1024.0f) + RMS_EPS); rs_out = rs;
    GAS unsigned long long* o8 = (GAS unsigned long long*)orow + lane;
#pragma unroll
    for (int j = 0; j < 4; ++j) { const f32x4 g = ((const GAS f32x4*)ng)[64 * j + lane], sh = ((const GAS f32x4*)shp)[64 * j + lane], sc = ((const GAS f32x4*)scp)[64 * j + lane];
        y[j] = (y[j] * rs) * g * (sc + 1.0f) + sh;
        o8[64 * j] = (unsigned long long)pk2(y[j].x, y[j].y) | ((unsigned long long)pk2(y[j].z, y[j].w) << 32); }
}
__device__ __forceinline__ void modulate_row2(const bf16* xa, const bf16* xb, const float* ng, const float* sha, const float* sca, const float* shb, const float* scb, unsigned char* oa, unsigned char* ob, int lane, float& rsa, float& rsb) {
    const GAS unsigned long long* pa = (const GAS unsigned long long*)xa + lane; const GAS unsigned long long* pb = (const GAS unsigned long long*)xb + lane;
    unsigned long long ra[4], rb[4];
#pragma unroll
    for (int j = 0; j < 4; ++j) { ra[j] = pa[64 * j]; rb[j] = pb[64 * j]; }
    f32x4 ya[4], yb[4]; float sa = 0.f, sb = 0.f;
#pragma unroll
    for (int j = 0; j < 4; ++j) { ya[j] = bf4_to_f32(ra[j]); yb[j] = bf4_to_f32(rb[j]); sa += (ya[j].x * ya[j].x + ya[j].y * ya[j].y) + (ya[j].z * ya[j].z + ya[j].w * ya[j].w); sb += (yb[j].x * yb[j].x + yb[j].y * yb[j].y) + (yb[j].z * yb[j].z + yb[j].w * yb[j].w); }
    const int ln = lane_now();
#pragma unroll
    for (int o = 1; o < 64; o <<= 1) { sa += shx(sa, o, ln); sb += shx(sb, o, ln); }
    rsa = 1.0f / sqrtf(sa * (1.0f / 1024.0f) + RMS_EPS); rsb = 1.0f / sqrtf(sb * (1.0f / 1024.0f) + RMS_EPS);
    GAS unsigned* qa = (GAS unsigned*)oa + lane; GAS unsigned* qb = (GAS unsigned*)ob + lane;
#pragma unroll
    for (int j = 0; j < 4; ++j) { const f32x4 g = ((const GAS f32x4*)ng)[64 * j + lane];
        const f32x4 ha = ((const GAS f32x4*)sha)[64 * j + lane], ca = ((const GAS f32x4*)sca)[64 * j + lane], hb = ((const GAS f32x4*)shb)[64 * j + lane], cb = ((const GAS f32x4*)scb)[64 * j + lane];
        const f32x4 va = (ya[j] * rsa) * g * (ca + 1.0f) + ha, vb = (yb[j] * rsb) * g * (cb + 1.0f) + hb;
        qa[64 * j] = pg8::pk4_fp8(va.x, va.y, va.z, va.w); qb[64 * j] = pg8::pk4_fp8(vb.x, vb.y, vb.z, vb.w); }
}
__device__ __forceinline__ void phase_modulate1(unsigned char* ws, int layer, int gw, int NGW, int lane) {
    const bf16* X = (const bf16*)(ws + WS_X); bf16* XN = (bf16*)(ws + WS_XN);
    const float* ng = PARF(ws) + P_N1G + layer * 1024; const float* Mo = (const float*)(ws + WS_MOD) + (size_t)layer * MODROWS * NMODC;
    for (int m = gw; m < MT; m += NGW) { const int mr = mod_row(m); f32x4 y[4]; float rs;
        modulate_row(X + (size_t)m * 1024, ng, Mo + (size_t)mr * NMODC + 0 * 1024, Mo + (size_t)mr * NMODC + 1 * 1024, XN + (size_t)m * 1024, lane, y, rs); }
}
__device__ __forceinline__ void phase_qknorm_rope(unsigned char* ws, int la, int gw, int NGW, int lane) {
    bf16* Qb = (bf16*)(ws + WS_Q); bf16* Kb = (bf16*)(ws + WS_K);
    const float* qg = PARF(ws) + P_QG + la * 64; const float* kg = PARF(ws) + P_KG + la * 64; const float* ropec = (const float*)(ws + WS_ROPE); const float* ropes = ropec + SEQ * 32;
    const int i = lane & 31, hs = lane >> 5;
    for (int m = gw; m < MT; m += NGW) { const int b = m / TB, w = m - b * TB; const bool lat = w >= CTXL;
        float cs = 1.f, sn = 0.f; if (lat) { cs = ropec[(w - CTXL) * 32 + i]; sn = ropes[(w - CTXL) * 32 + i]; }
#pragma unroll 2
        for (int hh = 0; hh < 20; hh += 2) { const int hd = hh + hs;
            unsigned* p = (hd < 16) ? (unsigned*)(Qb + (size_t)m * 1024 + hd * 64) + i : (unsigned*)(Kb + (size_t)m * 256 + (hd - 16) * 64) + i;
            const float* gp = (hd < 16) ? qg : kg; const float scl = (hd < 16) ? ATT_C2 : 1.0f;
            const unsigned v = *p; const float x1 = __uint_as_float(v << 16), x2 = __uint_as_float(v & 0xffff0000u);
            float ss = x1 * x1 + x2 * x2;
#pragma unroll
            for (int o = 1; o < 32; o <<= 1) ss += shx(ss, o, lane);
            const float rs = 1.0f / sqrtf(ss * (1.0f / 64.0f) + RMS_EPS);
            const float y1 = x1 * rs * gp[2 * i], y2 = x2 * rs * gp[2 * i + 1];
            const float r1 = (y1 * cs - y2 * sn) * scl, r2 = (y1 * sn + y2 * cs) * scl;
            *p = pk2(r1, r2); }
    }
}
__device__ __forceinline__ void phase_gla_recurrent(unsigned char* ws, int lg, LAS unsigned char* lds, int tid) {
    const int unit = blockIdx.x; if (unit >= 128) return;
    const int half = unit & 1, dir = (unit >> 1) & 1, h = (unit >> 2) & 3, b = unit >> 4;
    const bf16* G = (const bf16*)(ws + WS_G);
    float* Oo = (float*)(ws + (dir ? WS_OB : WS_OF));
    const float* wg = PARF(ws) + (dir ? P_GKB : P_GKF) + (size_t)lg * 16 * 512; const float* bg = PARF(ws) + (dir ? P_BGB : P_BGF) + lg * 512;
    LAS float* qq = (LAS float*)(lds + RING_OFF); LAS float* kk = qq + 64 * 128; LAS float* dd = kk + 64 * 128; LAS float* vv = dd + 64 * 128;
    const int sd = tid & 127, st0 = tid >> 7;
    float wcol[16];
#pragma unroll
    for (int r = 0; r < 16; ++r) wcol[r] = wg[r * 512 + h * 128 + sd];
    const float bcol = bg[h * 128 + sd];
    const int c = tid >> 2, dq = tid & 3;
    float s[32];
#pragma unroll
    for (int j = 0; j < 32; ++j) s[j] = 0.f;
    const float qscale = 0.08838834764831845f;
    for (int ch = 0; ch < TB / 64; ++ch) {
        __syncthreads();
#pragma unroll 4
        for (int i = 0; i < 16; ++i) { const int tt = st0 + 4 * i, n = 64 * ch + tt;
            const int w = dir ? (n < CTXL ? (CTXL - 1 - n) : (TB + CTXL - 1 - n)) : n;
            const bf16* gr = G + ((size_t)b * TB + w) * WINP;
            const float qv = bf2f(gr[h * 128 + sd]) * qscale, kv = bf2f(gr[512 + h * 128 + sd]);
            const bf16* lp = gr + 3072 + dir * 16; float z = bcol;
#pragma unroll
            for (int r = 0; r < 16; ++r) z += bf2f(lp[r]) * wcol[r];
            const float ls = fminf(z, 0.f) - log1pf(__expf(-fabsf(z)));
            qq[tt * 128 + sd] = qv; kk[tt * 128 + sd] = kv; dd[tt * 128 + sd] = __expf(ls * (1.0f / 16.0f));
            vv[tt * 128 + sd] = bf2f(gr[1024 + h * 256 + half * 128 + sd]); }
        __syncthreads();
        for (int tt = 0; tt < 64; ++tt) { const int n = 64 * ch + tt; const int w = dir ? (n < CTXL ? (CTXL - 1 - n) : (TB + CTXL - 1 - n)) : n;
            const float v = vv[tt * 128 + c]; float acc = 0.f;
            const LAS f32x4* q4 = (const LAS f32x4*)(qq + tt * 128 + dq * 32); const LAS f32x4* k4 = (const LAS f32x4*)(kk + tt * 128 + dq * 32); const LAS f32x4* d4 = (const LAS f32x4*)(dd + tt * 128 + dq * 32);
#pragma unroll
            for (int j = 0; j < 8; ++j) { const f32x4 qv = q4[j], kv = k4[j], dv = d4[j];
                s[4 * j + 0] = s[4 * j + 0] * dv.x + kv.x * v; acc += qv.x * s[4 * j + 0];
                s[4 * j + 1] = s[4 * j + 1] * dv.y + kv.y * v; acc += qv.y * s[4 * j + 1];
                s[4 * j + 2] = s[4 * j + 2] * dv.z + kv.z * v; acc += qv.z * s[4 * j + 2];
                s[4 * j + 3] = s[4 * j + 3] * dv.w + kv.w * v; acc += qv.w * s[4 * j + 3]; }
            acc += shx(acc, 1, tid & 63); acc += shx(acc, 2, tid & 63);
            if (dq == 0) Oo[((size_t)b * TB + w) * 1024 + h * 256 + half * 128 + c] = acc; }
    }
}
__device__ __forceinline__ void phase_gla_readout(unsigned char* ws, int lg, int gw, int NGW, int lane) {
    const float* OF = (const float*)(ws + WS_OF); const float* OB = (const float*)(ws + WS_OB); const bf16* G = (const bf16*)(ws + WS_G); bf16* OG = (bf16*)(ws + WS_Q);
    const f32x4 og = ((const GAS f32x4*)(PARF(ws) + P_OG + lg * 256))[lane];
    for (int m = gw; m < MT; m += NGW) {
#pragma unroll
        for (int hh = 0; hh < 4; ++hh) { const size_t off = (size_t)m * 1024 + hh * 256 + 4 * lane;
            f32x4 o = *(const GAS f32x4*)(OF + off) + *(const GAS f32x4*)(OB + off);
            const float ss = wave_sum((o.x * o.x + o.y * o.y) + (o.z * o.z + o.w * o.w));
            const float rs = 1.0f / sqrtf(ss * (1.0f / 256.0f) + RMS_EPS);
            const unsigned long long rv = *(const GAS unsigned long long*)(G + (size_t)m * WINP + 2048 + hh * 256 + 4 * lane);
            const float r0 = __uint_as_float((unsigned)(rv & 0xffffu) << 16), r1 = __uint_as_float((unsigned)(rv >> 16) << 16), r2 = __uint_as_float((unsigned)((rv >> 32) & 0xffffu) << 16), r3 = __uint_as_float((unsigned)(rv >> 48) << 16);
            o = o * rs * og;
            o.x *= silu_f(r0); o.y *= silu_f(r1); o.z *= silu_f(r2); o.w *= silu_f(r3);
            *(GAS unsigned long long*)(OG + off) = (unsigned long long)pk2(o.x, o.y) | ((unsigned long long)pk2(o.z, o.w) << 32); }
    }
}
constexpr size_t WS_GQ = WS_XG, WS_GKH = WS_XG + 68 * MiB, WS_GKT = WS_XG + 136 * MiB, WS_GVT = WS_XG + 204 * MiB, WS_GDL = WS_ACT, WS_SX = WS_OF;
static_assert((size_t)2176 * 2 * 16384 <= 68 * MiB && (size_t)2176 * 256 * 64 * 2 <= 68 * MiB && (size_t)64 * 68 * 65536 <= 272 * MiB, "gla buffers");
typedef float f32x16 __attribute__((ext_vector_type(16)));
__device__ __forceinline__ float log_sigmoid_fast(float z) { return fminf(z, 0.f) - __logf(1.0f + __expf(-fabsf(z))); }

struct G0Raw { unsigned qk[8][2]; v4u lfb; };
__device__ __forceinline__ void g0_load(G0Raw& R, unsigned char* ws, int cn, int tid) {
    const bf16* G = (const bf16*)(ws + WS_G);
    const int d2 = tid & 63, tb = tid >> 6, n = cn % 68, bh = cn / 68, h = bh & 3, b = bh >> 2;
    const size_t r0 = (size_t)b * TB + 64 * n;
#pragma unroll
    for (int j = 0; j < 8; ++j) { const bf16* gr = G + (r0 + 8 * tb + j) * WINP; R.qk[j][0] = *(const GAS unsigned*)(gr + h * 128 + 2 * d2); R.qk[j][1] = *(const GAS unsigned*)(gr + 512 + h * 128 + 2 * d2); }
    R.lfb = *(const GAS v4u*)(G + (r0 + ((tid & 255) >> 2)) * WINP + 3072 + 8 * (tid & 3));
}
__device__ __forceinline__ void phase_gla_g0(unsigned char* ws, int lg, LAS unsigned char* lds, int tid) {
    LAS float* tot = (LAS float*)(lds + RING_OFF);
    LAS unsigned char* lfl = lds + RING_OFF + 8192;
    const int d2 = tid & 63, tb = tid >> 6;
    if ((int)blockIdx.x >= 2176) return;
    G0Raw R; g0_load(R, ws, blockIdx.x, tid);
    for (int cn = blockIdx.x; cn < 2176; cn += gridDim.x) {
        const int n = cn % 68, bh = cn / 68, h = bh & 3, b = bh >> 2;
        float wf0[16], wf1[16], wb0[16], wb1[16];
        { const float* wgf = PARF(ws) + P_GKF + (size_t)lg * 16 * 512 + h * 128 + 2 * d2; const float* wgb = PARF(ws) + P_GKB + (size_t)lg * 16 * 512 + h * 128 + 2 * d2;
#pragma unroll
          for (int r = 0; r < 16; ++r) { const f32x2 a = *(const GAS f32x2*)(wgf + r * 512), c = *(const GAS f32x2*)(wgb + r * 512); wf0[r] = a.x; wf1[r] = a.y; wb0[r] = c.x; wb1[r] = c.y; } }
        const f32x2 bf_ = *(const GAS f32x2*)(PARF(ws) + P_BGF + lg * 512 + h * 128 + 2 * d2), bb_ = *(const GAS f32x2*)(PARF(ws) + P_BGB + lg * 512 + h * 128 + 2 * d2);
        __syncthreads();
        if (tid < 256) *(LAS v4u*)(lfl + tid * 16) = R.lfb;
        unsigned qk[8][2];
#pragma unroll
        for (int j = 0; j < 8; ++j) { qk[j][0] = R.qk[j][0]; qk[j][1] = R.qk[j][1]; }
        __syncthreads();
        if (cn + (int)gridDim.x < 2176) g0_load(R, ws, cn + (int)gridDim.x, tid);
        float gf0[8], gf1[8], gb0[8], gb1[8];
#pragma unroll
        for (int j = 0; j < 8; ++j) { const LAS v4u* lp = (const LAS v4u*)(lfl + (8 * tb + j) * 64);
            const v4u l0 = lp[0], l1 = lp[1], l2 = lp[2], l3 = lp[3];
            float lf[16], lb[16];
            lf[0] = __uint_as_float(l0.x << 16); lf[1] = __uint_as_float(l0.x & 0xffff0000u); lf[2] = __uint_as_float(l0.y << 16); lf[3] = __uint_as_float(l0.y & 0xffff0000u);
            lf[4] = __uint_as_float(l0.z << 16); lf[5] = __uint_as_float(l0.z & 0xffff0000u); lf[6] = __uint_as_float(l0.w << 16); lf[7] = __uint_as_float(l0.w & 0xffff0000u);
            lf[8] = __uint_as_float(l1.x << 16); lf[9] = __uint_as_float(l1.x & 0xffff0000u); lf[10] = __uint_as_float(l1.y << 16); lf[11] = __uint_as_float(l1.y & 0xffff0000u);
            lf[12] = __uint_as_float(l1.z << 16); lf[13] = __uint_as_float(l1.z & 0xffff0000u); lf[14] = __uint_as_float(l1.w << 16); lf[15] = __uint_as_float(l1.w & 0xffff0000u);
            lb[0] = __uint_as_float(l2.x << 16); lb[1] = __uint_as_float(l2.x & 0xffff0000u); lb[2] = __uint_as_float(l2.y << 16); lb[3] = __uint_as_float(l2.y & 0xffff0000u);
            lb[4] = __uint_as_float(l2.z << 16); lb[5] = __uint_as_float(l2.z & 0xffff0000u); lb[6] = __uint_as_float(l2.w << 16); lb[7] = __uint_as_float(l2.w & 0xffff0000u);
            lb[8] = __uint_as_float(l3.x << 16); lb[9] = __uint_as_float(l3.x & 0xffff0000u); lb[10] = __uint_as_float(l3.y << 16); lb[11] = __uint_as_float(l3.y & 0xffff0000u);
            lb[12] = __uint_as_float(l3.z << 16); lb[13] = __uint_as_float(l3.z & 0xffff0000u); lb[14] = __uint_as_float(l3.w << 16); lb[15] = __uint_as_float(l3.w & 0xffff0000u);
            float zf0 = bf_.x, zf1 = bf_.y, zb0 = bb_.x, zb1 = bb_.y;
#pragma unroll
            for (int r = 0; r < 16; ++r) { zf0 += lf[r] * wf0[r]; zf1 += lf[r] * wf1[r]; zb0 += lb[r] * wb0[r]; zb1 += lb[r] * wb1[r]; }
            gf0[j] = log_sigmoid_fast(zf0) * 0.0625f; gf1[j] = log_sigmoid_fast(zf1) * 0.0625f; gb0[j] = log_sigmoid_fast(zb0) * 0.0625f; gb1[j] = log_sigmoid_fast(zb1) * 0.0625f; }
#pragma unroll
        for (int j = 1; j < 8; ++j) { gf0[j] += gf0[j - 1]; gf1[j] += gf1[j - 1]; gb0[7 - j] += gb0[8 - j]; gb1[7 - j] += gb1[8 - j]; }
        *(LAS f32x2*)(tot + (0 * 8 + tb) * 128 + 2 * d2) = (f32x2){gf0[7], gf1[7]}; *(LAS f32x2*)(tot + (1 * 8 + tb) * 128 + 2 * d2) = (f32x2){gb0[0], gb1[0]};
        __syncthreads();
        float pf0 = 0.f, pf1 = 0.f, pb0 = 0.f, pb1 = 0.f, lf0 = 0.f, lf1 = 0.f, lb0 = 0.f, lb1 = 0.f;
#pragma unroll
        for (int q = 0; q < 8; ++q) { const f32x2 a = *(const LAS f32x2*)(tot + (0 * 8 + q) * 128 + 2 * d2), c = *(const LAS f32x2*)(tot + (1 * 8 + q) * 128 + 2 * d2);
            lf0 += a.x; lf1 += a.y; lb0 += c.x; lb1 += c.y;
            if (q < tb) { pf0 += a.x; pf1 += a.y; } if (q > tb) { pb0 += c.x; pb1 += c.y; } }
        const size_t itf = (size_t)cn * 2, itb = itf + 1;
        bf16* Qf = (bf16*)(ws + WS_GQ) + itf * 8192; bf16* Qb = Qf + 8192; bf16* Kf = (bf16*)(ws + WS_GKH) + itf * 8192; bf16* Kb = Kf + 8192;
        const float elf0 = __expf(lf0), elf1 = __expf(lf1), elb0 = __expf(lb0), elb1 = __expf(lb1);
        float ktf0[8], ktf1[8], ktb0[8], ktb1[8];
#pragma unroll
        for (int j = 0; j < 8; ++j) { const int t = 8 * tb + j;
            const float q0 = __uint_as_float(qk[j][0] << 16) * 0.08838834764831845f, q1 = __uint_as_float(qk[j][0] & 0xffff0000u) * 0.08838834764831845f;
            const float k0 = __uint_as_float(qk[j][1] << 16), k1 = __uint_as_float(qk[j][1] & 0xffff0000u);
            const float ef0 = __expf(pf0 + gf0[j]), ef1 = __expf(pf1 + gf1[j]), eb0 = __expf(pb0 + gb0[j]), eb1 = __expf(pb1 + gb1[j]);
            const float rf0 = __builtin_amdgcn_rcpf(ef0), rf1 = __builtin_amdgcn_rcpf(ef1), rb0 = __builtin_amdgcn_rcpf(eb0), rb1 = __builtin_amdgcn_rcpf(eb1);
            *(GAS unsigned*)(Qf + t * 128 + 2 * d2) = pk2(q0 * ef0, q1 * ef1); *(GAS unsigned*)(Qb + t * 128 + 2 * d2) = pk2(q0 * eb0, q1 * eb1);
            *(GAS unsigned*)(Kf + t * 128 + 2 * d2) = pk2(k0 * rf0, k1 * rf1); *(GAS unsigned*)(Kb + t * 128 + 2 * d2) = pk2(k0 * rb0, k1 * rb1);
            ktf0[j] = k0 * rf0 * elf0; ktf1[j] = k1 * rf1 * elf1; ktb0[j] = k0 * rb0 * elb0; ktb1[j] = k1 * rb1 * elb1; }
        {
          unsigned char* Tf = ws + WS_GKT + itf * 16384 + (size_t)((((tb >> 1) * 4 + (d2 >> 4)) * 64 + ((2 * d2) & 31)) * 16 + 8 * (tb & 1)); unsigned char* Tb = Tf + 16384;
          *(GAS unsigned long long*)(Tf) = (unsigned long long)pk2(ktf0[0], ktf0[1]) | ((unsigned long long)pk2(ktf0[2], ktf0[3]) << 32);
          *(GAS unsigned long long*)(Tf + 512) = (unsigned long long)pk2(ktf0[4], ktf0[5]) | ((unsigned long long)pk2(ktf0[6], ktf0[7]) << 32);
          *(GAS unsigned long long*)(Tf + 16) = (unsigned long long)pk2(ktf1[0], ktf1[1]) | ((unsigned long long)pk2(ktf1[2], ktf1[3]) << 32);
          *(GAS unsigned long long*)(Tf + 528) = (unsigned long long)pk2(ktf1[4], ktf1[5]) | ((unsigned long long)pk2(ktf1[6], ktf1[7]) << 32);
          *(GAS unsigned long long*)(Tb) = (unsigned long long)pk2(ktb0[0], ktb0[1]) | ((unsigned long long)pk2(ktb0[2], ktb0[3]) << 32);
          *(GAS unsigned long long*)(Tb + 512) = (unsigned long long)pk2(ktb0[4], ktb0[5]) | ((unsigned long long)pk2(ktb0[6], ktb0[7]) << 32);
          *(GAS unsigned long long*)(Tb + 16) = (unsigned long long)pk2(ktb1[0], ktb1[1]) | ((unsigned long long)pk2(ktb1[2], ktb1[3]) << 32);
          *(GAS unsigned long long*)(Tb + 528) = (unsigned long long)pk2(ktb1[4], ktb1[5]) | ((unsigned long long)pk2(ktb1[6], ktb1[7]) << 32); }
        if (tb == 0) { float* DLp = (float*)(ws + WS_GDL) + itf * 128 + 2 * d2; *(GAS f32x2*)DLp = (f32x2){elf0, elf1}; *(GAS f32x2*)(DLp + 128) = (f32x2){elb0, elb1}; }
        {
            const int dv = tid & 255, th = tid >> 8; const bf16* vp = (const bf16*)(ws + WS_G) + ((size_t)b * TB + 64 * n + 32 * th) * WINP + 1024 + h * 256 + dv;
            unsigned wv[16];
#pragma unroll
            for (int j = 0; j < 16; ++j) wv[j] = (unsigned)vp[(size_t)(2 * j) * WINP] | ((unsigned)vp[(size_t)(2 * j + 1) * WINP] << 16);
            unsigned char* vo = ws + WS_GVT + (size_t)cn * 32768 + (size_t)(((2 * th) * 8 + (dv >> 5)) * 64 + (dv & 31)) * 16;
#pragma unroll
            for (int ql = 0; ql < 2; ++ql)
#pragma unroll
                for (int hq = 0; hq < 2; ++hq) *(GAS v4u*)(vo + ql * 8192 + hq * 512) = (v4u){wv[8 * ql + 2 * hq], wv[8 * ql + 2 * hq + 1], wv[8 * ql + 2 * hq + 4], wv[8 * ql + 2 * hq + 5]}; }
    }
}
struct G12Ops { bf16x8 a[4], b[4]; f32x4 d[4]; };
__device__ __forceinline__ void g12_load(G12Ops& o, unsigned char* ws, int bh, int dir, int m, int kb, int vb, int r, int hh) {
    const int n = dir ? (m < 4 ? 3 - m : 71 - m) : m; const size_t cn = (size_t)bh * 68 + n, item = cn * 2 + dir;
    const GAS bf16x8* ap = (const GAS bf16x8*)(ws + WS_GKT + item * 16384) + kb * 64 + (hh * 32 + r);
    const GAS bf16x8* bp = (const GAS bf16x8*)(ws + WS_GVT + cn * 32768) + vb * 64 + (hh * 32 + r);
    const float* dp = (const float*)(ws + WS_GDL) + item * 128 + 32 * kb + 4 * hh;
#pragma unroll
    for (int ks = 0; ks < 4; ++ks) { o.a[ks] = ap[ks * 256]; o.b[ks] = bp[ks * 512]; o.d[ks] = *(const GAS f32x4*)(dp + 8 * ks); }
}
__device__ __forceinline__ void phase_gla_g12(unsigned char* ws, LAS unsigned char* lds, int gwv, int wave, int lane) {
    if (gwv >= 2048) return;
    const int chain = gwv >> 5, blk = gwv & 31, kb = blk & 3, vb = blk >> 2, dir = chain & 1, bh = chain >> 1;
    const int r = lane & 31, hh = lane >> 5;
    LAS unsigned char* wl = lds + RING_OFF + wave * 2048;
    f32x16 acc;
#pragma unroll
    for (int g = 0; g < 16; ++g) acc[g] = 0.f;
    G12Ops o0, o1, o2;
    g12_load(o0, ws, bh, dir, 0, kb, vb, r, hh); g12_load(o1, ws, bh, dir, 1, kb, vb, r, hh);
#define G12_STEP(CUR, m_) do { const int mm_ = (m_); const int n = dir ? (mm_ < 4 ? 3 - mm_ : 71 - mm_) : mm_; \
        _Pragma("unroll") for (int gg = 0; gg < 4; ++gg) *(LAS unsigned long long*)(wl + (((gg >> 1) * 64 + (gg & 1) * 32 + r) * 16 + 8 * hh)) = (unsigned long long)pk2(acc[4 * gg], acc[4 * gg + 1]) | ((unsigned long long)pk2(acc[4 * gg + 2], acc[4 * gg + 3]) << 32); \
        LDS_WAIT(); const v4u s0 = *(const LAS v4u*)(wl + lane * 16), s1 = *(const LAS v4u*)(wl + 1024 + lane * 16); LDS_WAIT(); \
        { bf16* sp = (bf16*)(ws + WS_SX) + ((size_t)(bh * 2 + dir) * 68 + n) * 32768 + (size_t)(kb * 8 + vb) * 1024; ((GAS v4u*)sp)[lane] = s0; ((GAS v4u*)sp)[64 + lane] = s1; } \
        _Pragma("unroll") for (int gg = 0; gg < 4; ++gg) { acc[4 * gg] *= CUR.d[gg].x; acc[4 * gg + 1] *= CUR.d[gg].y; acc[4 * gg + 2] *= CUR.d[gg].z; acc[4 * gg + 3] *= CUR.d[gg].w; } \
        _Pragma("unroll") for (int ks = 0; ks < 4; ++ks) acc = __builtin_amdgcn_mfma_f32_32x32x16_bf16(CUR.a[ks], CUR.b[ks], acc, 0, 0, 0); } while (0)
    for (int m = 0; m < 66; m += 3) {
        g12_load(o2, ws, bh, dir, m + 2, kb, vb, r, hh); G12_STEP(o0, m);
        g12_load(o0, ws, bh, dir, m + 3, kb, vb, r, hh); G12_STEP(o1, m + 1);
        g12_load(o1, ws, bh, dir, (m + 4 < 68) ? m + 4 : 67, kb, vb, r, hh); G12_STEP(o2, m + 2);
    }
    G12_STEP(o0, 66); G12_STEP(o1, 67);
#undef G12_STEP
}
constexpr int G3_RS = 272, G3_TILE = 64 * G3_RS, G3_OL = 4 * G3_TILE  , G3_LD = 260;
static_assert(G3_OL + 64 * G3_LD * 4 <= MISC_OFF, "G3 LDS");
__device__ __forceinline__ void phase_gla_g3(unsigned char* ws, int lg, LAS unsigned char* lds, int tid) {
    const int lane = tid & 63, wave = __builtin_amdgcn_readfirstlane(tid >> 6), r = lane & 31, hh = lane >> 5, vb = wave;
    LAS unsigned char* TL = lds + RING_OFF; LAS float* OL = (LAS float*)(lds + RING_OFF + G3_OL);
    const bf16* G = (const bf16*)(ws + WS_G); bf16* OG = (bf16*)(ws + WS_Q);
    for (int cn = blockIdx.x; cn < 2176; cn += gridDim.x) {
        const int n = cn % 68, bh = cn / 68, h = bh & 3, b = bh >> 2;
        v4u st[4][2];
#pragma unroll
        for (int tl = 0; tl < 4; ++tl) { const bf16* src = (const bf16*)(ws + ((tl & 1) ? WS_GKH : WS_GQ)) + ((size_t)cn * 2 + (tl >> 1)) * 8192;
#pragma unroll
            for (int j = 0; j < 2; ++j) st[tl][j] = ((const GAS v4u*)src)[tid + 512 * j]; }
        __syncthreads();
#pragma unroll
        for (int tl = 0; tl < 4; ++tl)
#pragma unroll
            for (int j = 0; j < 2; ++j) { const int q = tid + 512 * j, row = q >> 4, ch = q & 15; *(LAS v4u*)(TL + tl * G3_TILE + row * G3_RS + ch * 16) = st[tl][j]; }
        __syncthreads();
        f32x16 P00, P01, P10, P11, O0, O1;
#pragma unroll
        for (int g = 0; g < 16; ++g) { P00[g] = 0.f; P01[g] = 0.f; P10[g] = 0.f; P11[g] = 0.f; O0[g] = 0.f; O1[g] = 0.f; }
#pragma unroll
        for (int dir = 0; dir < 2; ++dir) {
            const LAS unsigned char* Qt = TL + (2 * dir) * G3_TILE + r * G3_RS + 16 * hh; const LAS unsigned char* Kh = TL + (2 * dir + 1) * G3_TILE + r * G3_RS + 16 * hh;
            const GAS bf16x8* Sx = (const GAS bf16x8*)((const bf16*)(ws + WS_SX) + ((size_t)(bh * 2 + dir) * 68 + n) * 32768 + (size_t)vb * 1024) + lane;
            f32x16 X00, X11, Xoff;
#pragma unroll
            for (int g = 0; g < 16; ++g) { X00[g] = 0.f; X11[g] = 0.f; Xoff[g] = 0.f; }
#pragma unroll
            for (int s = 0; s < 8; ++s) {
                const bf16x8 q0 = *(const LAS bf16x8*)(Qt + 32 * s), q1 = *(const LAS bf16x8*)(Qt + 32 * G3_RS + 32 * s);
                const bf16x8 k0 = *(const LAS bf16x8*)(Kh + 32 * s), k1 = *(const LAS bf16x8*)(Kh + 32 * G3_RS + 32 * s);
                const bf16x8 sx = Sx[(s >> 1) * 1024 + (s & 1) * 64];
                X00 = __builtin_amdgcn_mfma_f32_32x32x16_bf16(k0, q0, X00, 0, 0, 0);
                X11 = __builtin_amdgcn_mfma_f32_32x32x16_bf16(k1, q1, X11, 0, 0, 0);
                if (dir == 0) Xoff = __builtin_amdgcn_mfma_f32_32x32x16_bf16(k0, q1, Xoff, 0, 0, 0); else Xoff = __builtin_amdgcn_mfma_f32_32x32x16_bf16(k1, q0, Xoff, 0, 0, 0);
                O0 = __builtin_amdgcn_mfma_f32_32x32x16_bf16(q0, sx, O0, 0, 0, 0); O1 = __builtin_amdgcn_mfma_f32_32x32x16_bf16(q1, sx, O1, 0, 0, 0); }
#pragma unroll
            for (int g = 0; g < 16; ++g) { const int tj = (g & 3) + 8 * (g >> 2) + 4 * hh; const bool keep = dir ? (tj >= r) : (tj <= r);
                P00[g] += keep ? X00[g] : 0.f; P11[g] += keep ? X11[g] : 0.f;
                if (dir == 0) P01[g] += Xoff[g]; else P10[g] += Xoff[g]; }
        }
        { const GAS bf16x8* Vt = (const GAS bf16x8*)(ws + WS_GVT + (size_t)cn * 32768) + vb * 64 + lane;
#pragma unroll
          for (int jb = 0; jb < 2; ++jb)
#pragma unroll
            for (int s2 = 0; s2 < 2; ++s2) { const bf16x8 bfv = Vt[(2 * jb + s2) * 512];
                const f32x16& Pa = jb ? P10 : P00; const f32x16& Pb = jb ? P11 : P01;
                const bf16x8 a0 = __builtin_bit_cast(bf16x8, ((v4u){pk2(Pa[8 * s2 + 0], Pa[8 * s2 + 1]), pk2(Pa[8 * s2 + 2], Pa[8 * s2 + 3]), pk2(Pa[8 * s2 + 4], Pa[8 * s2 + 5]), pk2(Pa[8 * s2 + 6], Pa[8 * s2 + 7])}));
                const bf16x8 a1 = __builtin_bit_cast(bf16x8, ((v4u){pk2(Pb[8 * s2 + 0], Pb[8 * s2 + 1]), pk2(Pb[8 * s2 + 2], Pb[8 * s2 + 3]), pk2(Pb[8 * s2 + 4], Pb[8 * s2 + 5]), pk2(Pb[8 * s2 + 6], Pb[8 * s2 + 7])}));
                O0 = __builtin_amdgcn_mfma_f32_32x32x16_bf16(a0, bfv, O0, 0, 0, 0); O1 = __builtin_amdgcn_mfma_f32_32x32x16_bf16(a1, bfv, O1, 0, 0, 0); } }
#pragma unroll
        for (int g = 0; g < 16; ++g) { const int t = (g & 3) + 8 * (g >> 2) + 4 * hh; OL[t * G3_LD + 32 * vb + r] = O0[g]; OL[(32 + t) * G3_LD + 32 * vb + r] = O1[g]; }
        __syncthreads();
        { const int t = tid >> 3, cc = tid & 7; const LAS f32x4* op = (const LAS f32x4*)(OL + t * G3_LD + 32 * cc);
          f32x4 o[8]; float ss = 0.f;
#pragma unroll
          for (int j = 0; j < 8; ++j) { o[j] = op[j]; ss += (o[j].x * o[j].x + o[j].y * o[j].y) + (o[j].z * o[j].z + o[j].w * o[j].w); }
          ss += __shfl_xor(ss, 1); ss += __shfl_xor(ss, 2); ss += __shfl_xor(ss, 4);
          const float rs = 1.0f / sqrtf(ss * (1.0f / 256.0f) + RMS_EPS);
          const size_t row = (size_t)b * TB + 64 * n + t;
          const GAS v4u* rp = (const GAS v4u*)(G + row * WINP + 2048 + h * 256 + 32 * cc); const GAS f32x4* gp = (const GAS f32x4*)(PARF(ws) + P_OG + lg * 256 + 32 * cc);
          GAS v4u* dst = (GAS v4u*)(OG + row * 1024 + h * 256 + 32 * cc);
#pragma unroll
          for (int j = 0; j < 4; ++j) { const v4u rv = rp[j]; const f32x4 g0 = gp[2 * j], g1 = gp[2 * j + 1]; const f32x4 a = o[2 * j] * rs * g0, c2 = o[2 * j + 1] * rs * g1;
              v4u w;
              w.x = pk2(a.x * silu_f(__uint_as_float(rv.x << 16)), a.y * silu_f(__uint_as_float(rv.x & 0xffff0000u)));
              w.y = pk2(a.z * silu_f(__uint_as_float(rv.y << 16)), a.w * silu_f(__uint_as_float(rv.y & 0xffff0000u)));
              w.z = pk2(c2.x * silu_f(__uint_as_float(rv.z << 16)), c2.y * silu_f(__uint_as_float(rv.z & 0xffff0000u)));
              w.w = pk2(c2.z * silu_f(__uint_as_float(rv.w << 16)), c2.w * silu_f(__uint_as_float(rv.w & 0xffff0000u)));
              dst[j] = w; } }
    }
}
constexpr int WIMG_RS = 2064;
static_assert(2 * 32 * WIMG_RS <= LDS_AUX, "router images below the aux tables");
__device__ __forceinline__ void phase_modulate2_route(unsigned char* ws, int layer, LAS unsigned char* lds, int vcu, int wave, int lane, int tid, bool dummy = false) {
    const bf16* X = (const bf16*)(ws + WS_X); bf16* XN = (bf16*)(ws + WS_XN);
    const float* ng = PARF(ws) + P_N2G + layer * 1024; const float* Mo = (const float*)(ws + WS_MOD) + (size_t)layer * MODROWS * NMODC;
    LAS unsigned char* WHI = lds + RING_OFF; LAS unsigned char* WLO = WHI + 32 * WIMG_RS;
    LAS unsigned* lcnt = (LAS unsigned*)(lds + AUX_LCNT); LAS unsigned* gb = (LAS unsigned*)(lds + AUX_GB); LAS unsigned* ent = (LAS unsigned*)(lds + AUX_ENT); LAS float* rsl = (LAS float*)(lds + AUX_RS);
    { const float* wsrc = PARF(ws) + P_WR + (size_t)layer * 1024 * 32;
      for (int idx = tid; idx < 1024 * 32; idx += NWAVES * 64) { const int k = idx >> 5, e = idx & 31; const float w = wsrc[idx]; const unsigned hi = f2bf(w), lo = f2bf(w - __uint_as_float(hi << 16));
          *(LAS unsigned short*)(WHI + e * WIMG_RS + 2 * k) = (unsigned short)hi; *(LAS unsigned short*)(WLO + e * WIMG_RS + 2 * k) = (unsigned short)lo; }
      if (tid < 32) lcnt[tid] = 0u; }
    gu32* cnt = (gu32*)(ws + WS_CTL) + CW_CNT + (layer + (dummy ? 4 : 0)) * 32 * 16;
    unsigned char* sbase = dummy ? ws + WS_XG : ws;
    const bool lastl = (layer == NLAYER - 1);
  for (int grp = vcu; grp < MT / 136; grp += (int)gridDim.x) {
    const int rbase = grp * 136;
    if (grp != vcu) { __syncthreads(); if (tid < 32) lcnt[tid] = 0u; }
    for (int rl = wave; rl < 136; rl += 2 * NWAVES) {
        const int rl2 = (rl + NWAVES < 136) ? rl + NWAVES : rl; const int m = rbase + rl, m2 = rbase + rl2, mr = mod_row(m), mr2 = mod_row(m2);
        float rs, rs2;
        modulate_row2(X + (size_t)m * 1024, X + (size_t)m2 * 1024, ng, Mo + (size_t)mr * NMODC + 3 * 1024, Mo + (size_t)mr * NMODC + 4 * 1024, Mo + (size_t)mr2 * NMODC + 3 * 1024, Mo + (size_t)mr2 * NMODC + 4 * 1024,
                      ws + WS_XN8 + (size_t)m * 1024, ws + WS_XN8 + (size_t)m2 * 1024, lane, rs, rs2);
        if (lane == 0) { rsl[rl] = rs; rsl[rl2] = rs2; } }
    __syncthreads();
    if (wave < 5) {
        const int r = lane & 31, hh = lane >> 5; const int rl = (32 * wave + r < 136) ? 32 * wave + r : 135; const int m = rbase + rl, mr = mod_row(m);
        const float rsr = rsl[rl];
        const bf16* xp = X + (size_t)m * 1024 + 8 * hh; const float* gp = ng + 8 * hh; const float* scp = Mo + (size_t)mr * NMODC + 4 * 1024 + 8 * hh; const float* shp = Mo + (size_t)mr * NMODC + 3 * 1024 + 8 * hh;
        const LAS unsigned char* wh = WHI + r * WIMG_RS + 16 * hh; const LAS unsigned char* wl = WLO + r * WIMG_RS + 16 * hh;
        f32x16 acc;
#pragma unroll
        for (int g = 0; g < 16; ++g) acc[g] = 0.f;
#pragma unroll 2
        for (int s = 0; s < 64; ++s) {
            const v4u xr8 = *(const GAS v4u*)(xp + 16 * s); const f32x4 x0 = (f32x4){__uint_as_float(xr8.x << 16), __uint_as_float(xr8.x & 0xffff0000u), __uint_as_float(xr8.y << 16), __uint_as_float(xr8.y & 0xffff0000u)}, x1 = (f32x4){__uint_as_float(xr8.z << 16), __uint_as_float(xr8.z & 0xffff0000u), __uint_as_float(xr8.w << 16), __uint_as_float(xr8.w & 0xffff0000u)}; const f32x4 g0 = *(const GAS f32x4*)(gp + 16 * s), g1 = *(const GAS f32x4*)(gp + 16 * s + 4);
            const f32x4 c0 = *(const GAS f32x4*)(scp + 16 * s), c1 = *(const GAS f32x4*)(scp + 16 * s + 4), h0 = *(const GAS f32x4*)(shp + 16 * s), h1 = *(const GAS f32x4*)(shp + 16 * s + 4);
            const f32x4 y0 = (x0 * rsr) * g0 * (c0 + 1.0f) + h0, y1 = (x1 * rsr) * g1 * (c1 + 1.0f) + h1;
            v4u ph, pl;
            ph.x = pg8::cvt_pk_bf16(y0.x, y0.y); ph.y = pg8::cvt_pk_bf16(y0.z, y0.w); ph.z = pg8::cvt_pk_bf16(y1.x, y1.y); ph.w = pg8::cvt_pk_bf16(y1.z, y1.w);
            pl.x = pg8::cvt_pk_bf16(y0.x - __uint_as_float(ph.x << 16), y0.y - __uint_as_float(ph.x & 0xffff0000u)); pl.y = pg8::cvt_pk_bf16(y0.z - __uint_as_float(ph.y << 16), y0.w - __uint_as_float(ph.y & 0xffff0000u));
            pl.z = pg8::cvt_pk_bf16(y1.x - __uint_as_float(ph.z << 16), y1.y - __uint_as_float(ph.z & 0xffff0000u)); pl.w = pg8::cvt_pk_bf16(y1.z - __uint_as_float(ph.w << 16), y1.w - __uint_as_float(ph.w & 0xffff0000u));
            const bf16x8 ahi = __builtin_bit_cast(bf16x8, ph), alo = __builtin_bit_cast(bf16x8, pl);
            const bf16x8 bhi = *(const LAS bf16x8*)(wh + 32 * s), blo = *(const LAS bf16x8*)(wl + 32 * s);
            acc = __builtin_amdgcn_mfma_f32_32x32x16_bf16(ahi, bhi, acc, 0, 0, 0); acc = __builtin_amdgcn_mfma_f32_32x32x16_bf16(alo, bhi, acc, 0, 0, 0); acc = __builtin_amdgcn_mfma_f32_32x32x16_bf16(ahi, blo, acc, 0, 0, 0); }
        const float brt = (PARF(ws) + P_BR)[layer * 32 + r];
#pragma unroll
        for (int g = 0; g < 16; ++g) { const int rowl = 32 * wave + (g & 3) + 8 * (g >> 2) + 4 * hh;
            float v = acc[g] + brt; float tv[4]; int te[4];
#pragma unroll
            for (int k = 0; k < 4; ++k) { float mx = v;
#pragma unroll
                for (int o = 1; o < 32; o <<= 1) mx = fmaxf(mx, shx(mx, o, lane));
                const unsigned long long bm = __ballot(v == mx); const unsigned hm = hh ? (unsigned)(bm >> 32) : (unsigned)bm; const int first = __ffs((int)hm) - 1;
                te[k] = first; tv[k] = mx; if (r == first) v = -INFINITY; }
            const bool valid = rowl < 136 && !(lastl && mod_row(rbase + (rowl < 136 ? rowl : 135)) == 8);
            if (r == 0 && rowl < 136) {
                if (valid) { const float e1 = __expf(tv[1] - tv[0]), e2 = __expf(tv[2] - tv[0]), e3 = __expf(tv[3] - tv[0]); const float inv = 1.0f / (1.0f + e1 + e2 + e3);
                    const float wk[4] = {inv, e1 * inv, e2 * inv, e3 * inv};
#pragma unroll
                    for (int k = 0; k < 4; ++k) { const unsigned lp = atomicAdd((unsigned*)&lcnt[te[k]], 1u); ent[(rowl * 4 + k) * 2 + 0] = ((unsigned)te[k] << 24) | lp; ent[(rowl * 4 + k) * 2 + 1] = __float_as_uint(wk[k]); } }
                else {
#pragma unroll
                    for (int k = 0; k < 4; ++k) ent[(rowl * 4 + k) * 2 + 0] = 0xffffffffu; } } }
    }
    __syncthreads();
    if (tid < 32) gb[tid] = __hip_atomic_fetch_add(cnt + tid * 16, lcnt[tid], __ATOMIC_RELAXED, __HIP_MEMORY_SCOPE_AGENT);
    __syncthreads();
    for (int q = tid; q < 136 * 4; q += NWAVES * 64) { const unsigned pe = ent[q * 2 + 0];
        if (pe != 0xffffffffu) { const unsigned e = pe >> 24, lp = pe & 0xffffffu; const int m = rbase + (q >> 2);
            ((unsigned*)(sbase + WS_SLOT))[m * 4 + (q & 3)] = (e << 24) | (gb[e] + lp); ((unsigned*)(sbase + WS_GATEW))[m * 4 + (q & 3)] = ent[q * 2 + 1];
            if (!dummy) ((int*)(ws + WS_LIST))[(size_t)e * MT + gb[e] + lp] = m; } }
  }
}
__device__ __forceinline__ void build_expert_tables(unsigned char* ws, int layer, LAS unsigned char* lds, int tid) {
    LAS int* t2e = (LAS int*)(lds + AUX_T2E); LAS int* base = (LAS int*)(lds + AUX_BASE); LAS int* ntp = (LAS int*)(lds + AUX_NT); LAS int* cntl = (LAS int*)(lds + AUX_CNT);
    gu32* cnt = (gu32*)(ws + WS_CTL) + CW_CNT + layer * 32 * 16;
    __syncthreads();
    if (tid < 64) { const unsigned cval = (tid < 32) ? __hip_atomic_load(cnt + tid * 16, RLX_AGENT) : 0u; const int tiles = (int)((cval + 255u) >> 8);
        int pre = tiles;
#pragma unroll
        for (int o = 1; o < 32; o <<= 1) { const int ln = tid & 63; const int t = __builtin_amdgcn_ds_bpermute(((ln >= o) ? ln - o : ln) << 2, pre); if (ln >= o) pre += t; }
        const int start = pre - tiles;
        if (tid < 32) { base[tid] = start * 256; cntl[tid] = (int)cval; for (int t = 0; t < tiles; ++t) t2e[start + t] = tid; if (tid == 31) ntp[0] = pre; } }
    __syncthreads();
}
__device__ __forceinline__ void phase_moe_gather(unsigned char* ws, int layer, LAS unsigned char* lds, int gw, int NGW, int lane, int tid) {
    build_expert_tables(ws, layer, lds, tid);
    const LAS int* base = (const LAS int*)(lds + AUX_BASE);
    const bf16* XN = (const bf16*)(ws + WS_XN); bf16* XG = (bf16*)(ws + WS_XG);
    const unsigned* slot = (const unsigned*)(ws + WS_SLOT); unsigned* spos = (unsigned*)(ws + WS_SLOTPOS);
    for (int m = gw; m < MT; m += NGW) {
        if (layer == NLAYER - 1 && mod_row(m) == 8) continue;
        const GAS v4u* src = (const GAS v4u*)(XN + (size_t)m * 1024) + lane; const v4u a = src[0], b = src[64];
#pragma unroll
        for (int k = 0; k < 4; ++k) { const unsigned pe = slot[m * 4 + k]; const int dst = base[pe >> 24] + (int)(pe & 0xffffffu);
            GAS v4u* dp = (GAS v4u*)(XG + (size_t)dst * 1024) + lane; dp[0] = a; dp[64] = b;
            if (lane == 0) spos[m * 4 + k] = (unsigned)dst; }
    }
}
__device__ __forceinline__ void phase_moe_combine(unsigned char* ws, float* out, int layer, LAS unsigned char* lds, int gw, int NGW, int lane, int tid, bool dummy = false) {
    build_expert_tables(ws, layer, lds, tid);
    const LAS int* base = (const LAS int*)(lds + AUX_BASE);
    bf16* X = (bf16*)(ws + WS_X); const unsigned char* Y = ws + WS_Y;
    const float* Mo = (const float*)(ws + WS_MOD) + (size_t)layer * MODROWS * NMODC;
    const unsigned* slot = (const unsigned*)(ws + WS_SLOT); const float* gw4 = (const float*)(ws + WS_GATEW);
    for (int m0 = gw; m0 < MT; m0 += 2 * NGW) {
        int mm[2], bb[2], ww[2], mrr[2]; bool ok[2];
#pragma unroll
        for (int p = 0; p < 2; ++p) { const int m = m0 + p * NGW; ok[p] = m < MT; mm[p] = ok[p] ? m : m0; bb[p] = mm[p] / TB; ww[p] = mm[p] - bb[p] * TB; mrr[p] = (ww[p] < CTXL) ? 8 : bb[p];
            if (layer == NLAYER - 1 && ww[p] < CTXL) ok[p] = false; }
        if (!ok[0] && !ok[1]) continue;
        unsigned pe[2][4]; float wk[2][4];
#pragma unroll
        for (int p = 0; p < 2; ++p)
#pragma unroll
            for (int k = 0; k < 4; ++k) { pe[p][k] = slot[mm[p] * 4 + k]; wk[p][k] = gw4[mm[p] * 4 + k]; }
        unsigned long long xv[2][4];
#pragma unroll
        for (int p = 0; p < 2; ++p) { const GAS unsigned long long* xp = (const GAS unsigned long long*)(X + (size_t)mm[p] * 1024) + lane;
#pragma unroll
            for (int j = 0; j < 4; ++j) xv[p][j] = xp[64 * j]; }
        unsigned yv[2][4][4];
#pragma unroll
        for (int p = 0; p < 2; ++p)
#pragma unroll
            for (int k = 0; k < 4; ++k) { unsigned e = pe[p][k] >> 24; if (!ok[p] || e > 31u) e = 0u;
                const unsigned sp = ok[p] ? (unsigned)base[e] + (pe[p][k] & 0xffffffu) : 0u;
                const GAS unsigned* yp = (const GAS unsigned*)(Y + (size_t)sp * 1024) + lane;
#pragma unroll
                for (int j = 0; j < 4; ++j) yv[p][k][j] = yp[64 * j]; }
        f32x4 f[2][4]; float ss[2];
#pragma unroll
        for (int p = 0; p < 2; ++p) { const GAS f32x4* gp = (const GAS f32x4*)(Mo + (size_t)mrr[p] * NMODC + 5 * 1024) + lane;
            ss[p] = 0.f;
#pragma unroll
            for (int j = 0; j < 4; ++j) { f32x4 a = (f32x4){0.f, 0.f, 0.f, 0.f};
#pragma unroll
                for (int k = 0; k < 4; ++k) { const unsigned w8 = yv[p][k][j]; const f32x2 lo2 = __builtin_amdgcn_cvt_pk_f32_fp8((int)w8, false), hi2 = __builtin_amdgcn_cvt_pk_f32_fp8((int)w8, true); a = a + (f32x4){lo2.x, lo2.y, hi2.x, hi2.y} * wk[p][k]; }
                f[p][j] = bf4_to_f32(xv[p][j]) + gp[64 * j] * a; } }
        asm volatile("" ::: "memory");
        const bool fuse = (layer < NLAYER - 1) && !dummy;
#pragma unroll
        for (int p = 0; p < 2; ++p) { if (!ok[p]) continue;
            GAS unsigned long long* xp = (GAS unsigned long long*)(X + (size_t)mm[p] * 1024) + lane;
            GAS f32x4* op = (GAS f32x4*)(out + ((size_t)bb[p] * SEQ + (ww[p] - CTXL)) * 1024) + lane;
#pragma unroll
            for (int j = 0; j < 4; ++j) { if (dummy) ((GAS f32x4*)((float*)(ws + WS_XG) + (size_t)mm[p] * 1024) + lane)[64 * j] = f[p][j]; else if (layer == NLAYER - 1) op[64 * j] = f[p][j]; else { const unsigned long long pk = f32_to_bf4(f[p][j]); xp[64 * j] = pk; f[p][j] = bf4_to_f32(pk); }
                ss[p] += (f[p][j].x * f[p][j].x + f[p][j].y * f[p][j].y) + (f[p][j].z * f[p][j].z + f[p][j].w * f[p][j].w); }
            if (fuse) { const float rs = 1.0f / sqrtf(wave_sum(ss[p]) * (1.0f / 1024.0f) + RMS_EPS);
                const float* ng = PARF(ws) + P_N1G + (layer + 1) * 1024; const float* Mn = (const float*)(ws + WS_MOD) + (size_t)(layer + 1) * MODROWS * NMODC + (size_t)mrr[p] * NMODC;
                GAS unsigned long long* o8 = (GAS unsigned long long*)((bf16*)(ws + WS_XN) + (size_t)mm[p] * 1024) + lane;
#pragma unroll
                for (int j = 0; j < 4; ++j) { const f32x4 g = ((const GAS f32x4*)ng)[64 * j + lane], sh = ((const GAS f32x4*)Mn)[64 * j + lane], sc = ((const GAS f32x4*)(Mn + 1024))[64 * j + lane];
                    o8[64 * j] = f32_to_bf4((f[p][j] * rs) * g * (sc + 1.0f) + sh); } } }
    }
}

constexpr int NPH_L = 11, NPHASE = 2 + NPH_L * NLAYER;
#ifndef PHMASK
#define PHMASK 0x7fff
#endif
#define EN(b) ((PHMASK >> (b)) & 1)
#ifndef DUPMASK
#define DUPMASK 0
#endif
#define DUP(b) for (int rep_ = 0; rep_ < (((DUPMASK >> (b)) & 1) ? 2 : 1); ++rep_)
__global__ void __launch_bounds__(NWAVES * 64, 2) dit_fwd(Args args) {
    extern __shared__ __attribute__((aligned(16))) unsigned char lds_raw[];
    LAS unsigned char* lds = (LAS unsigned char*)lds_raw;
    volatile LAS unsigned* MISC = (volatile LAS unsigned*)(lds + MISC_OFF);
    const int G = gridDim.x, bx = blockIdx.x;
    const int vcu = (G % 8 == 0) ? (bx % 8) * (G / 8) + bx / 8 : bx;
    const int wave0 = __builtin_amdgcn_readfirstlane((int)threadIdx.x >> 6);
#define LANE_ID(z) ((int)__builtin_amdgcn_mbcnt_hi(~0u, __builtin_amdgcn_mbcnt_lo(~0u, (z))))
    { const int t0 = (wave0 << 6) | LANE_ID(0u); for (int u = t0; u < (LDS_BYTES - MISC_OFF) / 4; u += NWAVES * 64) ((LAS unsigned*)(lds + MISC_OFF))[u] = 0u; }
    __syncthreads();
    const int lo = args.ph_lo, hi = args.ph_hi;
    XcdBarrier bar; bar.bar = (unsigned*)(args.ws + WS_CTL) + CW_BAR; bar.x = 0; bar.st = nullptr;
    if (hi - lo > 1) bar = xcd_barrier_post((unsigned*)(args.ws + WS_CTL) + CW_BAR, MISC + 8, wave0 == 0 && LANE_ID(0u) == 0);
#define IN(k) (lo <= (k) && (k) < hi)
#define SEAM(k) do { if (IN(k) && IN((k) + 1)) { XcdBarrier b_ = bar; unsigned zb_ = 0u; LAUNDER_S(zb_); b_.bar = bar.bar + zb_; xcd_barrier(b_, wave0 == 0 && LANE_ID(zb_) == 0); } } while (0)
#define PHASE_IDS() unsigned zoff_ = 0u; LAUNDER_S(zoff_); int tid = (wave0 << 6) | LANE_ID(zoff_); LAUNDER_V(tid); const int lane = tid & 63, wave = __builtin_amdgcn_readfirstlane(tid >> 6); const int gw = vcu * NWAVES + wave, NGW = G * NWAVES; \
    unsigned char* ws = args.ws + zoff_; const int Gp = G + (int)zoff_, bxp = bx + (int)zoff_; (void)lane; (void)gw; (void)NGW; (void)Gp; (void)bxp;

    if (EN(0) && IN(0)) DUP(0) { PHASE_IDS(); p0_prologue(args, lds, gw, NGW, wave, lane); } SEAM(0);
    if (EN(1) && IN(1)) { PHASE_IDS(); p1_mod_reduce(args, gw * 64 + lane, NGW * 64); } SEAM(1);

    for (int layer = 0; layer < NLAYER; ++layer) {
        const int pb = 2 + NPH_L * layer, lh = layer >> 1;
        if (layer == 0) { if (EN(2) && IN(pb + 0)) DUP(2) { PHASE_IDS(); phase_modulate1(ws, layer, gw, NGW, lane); } SEAM(pb + 0); }
        if ((layer & 1) == 0) {
            if (EN(3) && IN(pb + 1)) DUP(3) {
                PHASE_IDS();
                pg8::Gemm g{(const pg8::bf16_t*)(ws + WS_XN), (const pg8::bf16_t*)(ws + WS_WQKV) + (size_t)lh * QKVN * 1024, MT, QKVN, 1024, 0};
                pg8::StaticOrder S; S.init(MT, QKVN, Gp, bxp);
                LAS float* gl = (LAS float*)(lds + AUX_RS);
                if (tid < 128) gl[tid] = (PARF(ws) + (tid < 64 ? P_QG : P_KG - 64) + lh * 64)[tid];
                __syncthreads();
                pg8::EpiQKV E{ws, WS_Q, WS_K - WS_Q, WS_V - WS_K, gl, (const float*)(ws + WS_ROPE), ATT_C2};
                pg8::gemm_phase<pg8::EpiQKV, pg8::StaticOrder, true, true>(lds + RING_OFF, g, S, E, tid);
            } SEAM(pb + 1);
            if (EN(5) && IN(pb + 3)) DUP(5) {
                PHASE_IDS();
                const attn_body::bf16* Qp = (const attn_body::bf16*)(ws + WS_Q); const attn_body::bf16* Kp = (const attn_body::bf16*)(ws + WS_K); const attn_body::bf16* Vp = (const attn_body::bf16*)(ws + WS_V);
                attn_body::bf16* Op = (attn_body::bf16*)(ws + WS_XN);
                if (G == 256) {
                    for (int i = 0; i < 9; ++i) {
                        long qrow0, kvrow0; int NT, h;
                        if (i < 8) { const int x = vcu >> 5, j = vcu & 31, pair = 4 * x + (i >> 1), wi = (i & 1) * 32 + j, hq = wi >> 4, qb = wi & 15, b = pair >> 2, hk = pair & 3;
                            h = hk * 4 + hq; qrow0 = (long)b * TB + CTXL + qb * 256; kvrow0 = (long)b * TB; NT = TB / 64; }
                        else { if (vcu >= 128) break; const int b = vcu >> 4; h = vcu & 15; qrow0 = (long)b * TB; kvrow0 = qrow0; NT = CTXL / 64; }
                        attn_body::attn_unit<8>(qrow0, kvrow0, NT, h, Qp, Kp, Vp, Op, (char*)lds_raw + RING_OFF, tid);
                    }
                } else {
                    for (int U = bx; U < 2048 + 128; U += G) {
                        long qrow0, kvrow0; int NT, h;
                        if (U < 2048) { const int pair = U >> 6, wi = U & 63, hq = wi >> 4, qb = wi & 15, b = pair >> 2, hk = pair & 3; h = hk * 4 + hq; qrow0 = (long)b * TB + CTXL + qb * 256; kvrow0 = (long)b * TB; NT = TB / 64; }
                        else { const int v = U - 2048, b = v >> 4; h = v & 15; qrow0 = (long)b * TB; kvrow0 = qrow0; NT = CTXL / 64; }
                        attn_body::attn_unit<8>(qrow0, kvrow0, NT, h, Qp, Kp, Vp, Op, (char*)lds_raw + RING_OFF, tid);
                    }
                }
            } SEAM(pb + 3);
        } else {
            if (EN(6) && IN(pb + 1)) DUP(6) {
                PHASE_IDS();
                pg8::Gemm g{(const pg8::bf16_t*)(ws + WS_XN), (const pg8::bf16_t*)(ws + WS_WIN) + (size_t)lh * WINP * 1024, MT, WINP, 1024, 0};
                pg8::StaticOrder S; S.init(MT, WINP, Gp, bxp);
                pg8::EpiBf16 E{(pg8::bf16_t*)(ws + WS_G), WINP};
                pg8::gemm_phase<pg8::EpiBf16, pg8::StaticOrder, true, true>(lds + RING_OFF, g, S, E, tid);
            } SEAM(pb + 1);
            if (EN(7) && IN(pb + 2)) DUP(7) { PHASE_IDS(); phase_gla_g0(ws, lh, lds, tid); } SEAM(pb + 2);
            if (EN(8) && IN(pb + 3)) DUP(8) { PHASE_IDS(); phase_gla_g12(ws, lds, gw, wave, lane); } SEAM(pb + 3);
            if (EN(8) && IN(pb + 4)) DUP(9) { PHASE_IDS(); phase_gla_g3(ws, lh, lds, tid); } SEAM(pb + 4);
        }
        if (EN(9) && IN(pb + 5)) {
            PHASE_IDS();
            const pg8::bf16_t* Wt = (layer & 1) ? (const pg8::bf16_t*)(ws + WS_WOG) + (size_t)lh * 1024 * 1024 : (const pg8::bf16_t*)(ws + WS_WOA) + (size_t)lh * 1024 * 1024;
            pg8::Gemm g{(const pg8::bf16_t*)(ws + ((layer & 1) ? WS_Q : WS_XN)), Wt, MT, 1024, 1024, 0};
            pg8::StaticOrder S; if (layer == NLAYER - 1) S.init(NB * SEQ, 1024, Gp, bxp, true); else S.init(MT, 1024, Gp, bxp);
            pg8::EpiResGate E{(pg8::bf16_t*)(ws + WS_X), (const float*)(ws + WS_MOD) + (size_t)layer * MODROWS * NMODC + 2 * 1024};
            pg8::gemm_phase<pg8::EpiResGate, pg8::StaticOrder, true, true>(lds + RING_OFF, g, S, E, tid);
        } SEAM(pb + 5);
        if (EN(10) && IN(pb + 6)) { if ((DUPMASK >> 10) & 1) { PHASE_IDS(); phase_modulate2_route(ws, layer, lds, vcu, wave, lane, tid, true); __syncthreads(); } PHASE_IDS(); phase_modulate2_route(ws, layer, lds, vcu, wave, lane, tid); } SEAM(pb + 6);
        if (EN(12) && IN(pb + 8)) DUP(12) {
            PHASE_IDS();
            build_expert_tables(ws, layer, lds, tid);
            const int nT = __builtin_amdgcn_readfirstlane(((const LAS int*)(lds + AUX_NT))[0]);
            pg8::MoeOrder S{nT, 8, Gp, bxp, (const LAS int*)(lds + AUX_T2E)};
            LAS unsigned short* rowtab = (LAS unsigned short*)(lds + AUX_ROWTAB);
            { const LAS int* base = (const LAS int*)(lds + AUX_BASE); const LAS int* cntl = (const LAS int*)(lds + AUX_CNT); const int* LIST = (const int*)(ws + WS_LIST);
              pg8::Unit u;
              for (int i = 0; i < ROWTAB_UNITS && S.next(i, u); ++i) if (tid < 256) { const int pos = (u.pm - (base[u.e] >> 8)) * 256 + tid; rowtab[i * 256 + tid] = (unsigned short)((pos < cntl[u.e]) ? LIST[(size_t)u.e * MT + pos] : 0); }
              __syncthreads(); }
            pg8::Gemm g{(const pg8::bf16_t*)(ws + WS_XN8), (const pg8::bf16_t*)(ws + WS_WGU + (size_t)layer * 32 * 2048 * 1024), MPAD, 2048, 512, (size_t)2048 * 1024, rowtab};
            pg8::EpiSwiGLU8 E{ws + WS_ACT, PARF(ws) + P_BGU + (size_t)layer * 32 * 2048, 1.0f / 32.0f};
            pg8::gemm_phase<pg8::EpiSwiGLU8, pg8::MoeOrder, true, true, true, true>(lds + RING_OFF, g, S, E, tid);
        } SEAM(pb + 8);
        if (EN(13) && IN(pb + 9)) DUP(13) {
            PHASE_IDS();
            build_expert_tables(ws, layer, lds, tid);
            const int nT = __builtin_amdgcn_readfirstlane(((const LAS int*)(lds + AUX_NT))[0]);
            pg8::Gemm g{(const pg8::bf16_t*)(ws + WS_ACT), (const pg8::bf16_t*)(ws + WS_WDN + (size_t)layer * 32 * 1024 * 1024), MPAD, 1024, 512, (size_t)1024 * 1024};
            pg8::MoeOrder S{nT, 4, Gp, bxp, (const LAS int*)(lds + AUX_T2E)};
            pg8::EpiBiasF8 E{ws + WS_Y, PARF(ws) + P_BDN + (size_t)layer * 32 * 1024, 1.0f / 32.0f};
            pg8::gemm_phase<pg8::EpiBiasF8, pg8::MoeOrder, true, true, false, true>(lds + RING_OFF, g, S, E, tid);
        } SEAM(pb + 9);
        if (EN(14) && IN(pb + 10)) { if ((DUPMASK >> 14) & 1) { PHASE_IDS(); phase_moe_combine(ws, args.out, layer, lds, gw, NGW, lane, tid, true); } PHASE_IDS(); phase_moe_combine(ws, args.out, layer, lds, gw, NGW, lane, tid); } SEAM(pb + 10);
    }
#undef IN
#undef EN
#undef DUP
#undef SEAM
#undef PHASE_IDS
#undef LANE_ID
}

extern "C" void kernel_launch(void* const* d_in, const int* in_sizes, int n_in, void* d_out, int out_size, void* d_ws, size_t ws_size, hipStream_t stream) {
    static int grid = 0;
    if (grid == 0) {
        if (n_in != 25 || out_size != NB * SEQ * DMODEL || ws_size < WS_END) { fprintf(stderr, "kernel_launch: unexpected shapes: n_in %d out %d ws %zu (need >= %zu)\n", n_in, out_size, ws_size, (size_t)WS_END); grid = -1; return; }
        int dev = 0, cus = 0, per_cu = 0;
        if (hipGetDevice(&dev) != hipSuccess || hipDeviceGetAttribute(&cus, hipDeviceAttributeMultiprocessorCount, dev) != hipSuccess) { grid = -1; return; }
        if (hipFuncSetAttribute((const void*)dit_fwd, hipFuncAttributeMaxDynamicSharedMemorySize, LDS_BYTES) != hipSuccess) { fprintf(stderr, "kernel_launch: hipFuncSetAttribute failed\n"); grid = -1; return; }
        if (hipOccupancyMaxActiveBlocksPerMultiprocessor(&per_cu, (const void*)dit_fwd, NWAVES * 64, LDS_BYTES) != hipSuccess || per_cu < 1) fprintf(stderr, "kernel_launch: occupancy query reports %d\n", per_cu);
        (void)hipGetLastError();
        grid = cus;
    }
    if (grid < 0) return;
    if (hipMemsetAsync((char*)d_ws + WS_CTL, 0, CTL_ZERO_BYTES, stream) != hipSuccess) { fprintf(stderr, "kernel_launch: memset failed\n"); return; }
    Args a{};
    for (int i = 0; i < 25; ++i) a.in[i] = (const float*)d_in[i];
    a.out = (float*)d_out; a.ws = (unsigned char*)d_ws;
#if MK_ONE_LAUNCH
    a.ph_lo = 0; a.ph_hi = NPHASE;
    hipLaunchKernelGGL(dit_fwd, dim3(grid), dim3(NWAVES * 64), LDS_BYTES, stream, a);
#else
    for (int p = 0; p < NPHASE; ++p) { a.ph_lo = p; a.ph_hi = p + 1; hipLaunchKernelGGL(dit_fwd, dim3(grid), dim3(NWAVES * 64), LDS_BYTES, stream, a); }
#endif
    const hipError_t le = hipPeekAtLastError();
    if (le != hipSuccess) fprintf(stderr, "kernel_launch: launch failed: %s\n", hipGetErrorName(le));
}
```

```cpp
#include <hip/hip_runtime.h>
#include <hip/hip_bf16.h>
#include <cstdio>
#include <cstdint>
#include <cmath>

#ifndef MK_ONE_LAUNCH
#define MK_ONE_LAUNCH 1
#endif

namespace pg8 {
#define PG8_LAS __attribute__((address_space(3)))
typedef unsigned short bf16_t;
typedef short bf16x8 __attribute__((ext_vector_type(8)));
typedef float f32x4 __attribute__((ext_vector_type(4)));
typedef unsigned u32x4 __attribute__((ext_vector_type(4)));
constexpr int BM = 256, BK = 64, HALF = 128, HTB = HALF * BK * 2  , STAGE_BYTES = 8 * HTB, NXCD = 8, WGM = 8;

__host__ __device__ __forceinline__ int lds_byte(int r, int c) { const int st = (r >> 4) * 2 + (c >> 5), rr = r & 15, cc = c & 31, ob = rr * 64 + cc * 2; return st * 1024 + (ob ^ (((ob >> 9) & 1) << 5)); }
__host__ __device__ __forceinline__ void stage_rc(int b, int& R, int& C) { const int st = b / 1024, sb = b % 1024, swz = sb ^ (((sb >> 9) & 1) << 5); R = (st >> 1) * 16 + swz / 64; C = (st & 1) * 32 + (swz % 64) / 2; }
__host__ __device__ __forceinline__ int perm32(int rho) { const int n = rho >> 4, i = rho & 15; return 8 * (i >> 2) + 4 * n + (i & 3); }

struct Unit { int pm, pn, e; };
struct Gemm { const bf16_t* A; const bf16_t* Bt; int M, N, K; size_t bstride; const PG8_LAS unsigned short* rowtab; };

struct StaticOrder {
    int nM, nN, nwg, G, c; bool latent_only;
    __host__ __device__ __forceinline__ void init(int M, int N, int G_, int c_, bool lat_ = false) { nM = M / BM; nN = N / BM; nwg = nM * nN; G = G_; c = c_; latent_only = lat_; }
    __host__ __device__ __forceinline__ bool next(int i, Unit& u) const {
        const long L = (long)i * G + c; if (L >= nwg) return false;
        int wgid = (int)L; { const int q = nwg / NXCD, r = nwg % NXCD, xcd = wgid % NXCD, off = wgid / NXCD; wgid = (xcd < r ? xcd * (q + 1) : r * (q + 1) + (xcd - r) * q) + off; }
        const int nig = WGM * nN, gid = wgid / nig, fm = gid * WGM, gsz = (nM - fm) < WGM ? (nM - fm) : WGM;
        u.pm = fm + ((wgid % nig) % gsz); u.pn = (wgid % nig) / gsz; u.e = 0;
        if (latent_only) u.pm = (u.pm >> 4) * 17 + 1 + (u.pm & 15);
        return true;
    }
    __device__ __forceinline__ void a_ready(const Unit&) const {}
    __device__ __forceinline__ void done(const Unit&) const {}
};
struct MoeOrder {
    int nT, nN, G, c; const PG8_LAS int* t2e;
    __device__ __forceinline__ bool next(int i, Unit& u) const {
        const int x = c & 7, j = c >> 3, per = 32 / nN, mt = (i * (G >> 5) + x) * per + j / nN; if (mt >= nT) return false;
        u.pm = mt; u.pn = j % nN; u.e = __builtin_amdgcn_readfirstlane(t2e[mt]); return true;
    }
    __device__ __forceinline__ void a_ready(const Unit&) const {}
    __device__ __forceinline__ void done(const Unit&) const {}
};

__device__ __forceinline__ int lane_now() { unsigned z; asm volatile("s_mov_b32 %0, 0" : "=s"(z)); return (int)__builtin_amdgcn_mbcnt_hi(~0u, __builtin_amdgcn_mbcnt_lo(~0u, z)); }
__device__ __forceinline__ float shx(float v, int m, int ln) { return __int_as_float(__builtin_amdgcn_ds_bpermute((ln ^ m) << 2, __float_as_int(v))); }
__device__ __forceinline__ unsigned pk4_fp8(float a, float b, float c, float d) { int w = 0; w = __builtin_amdgcn_cvt_pk_fp8_f32(a, b, w, false); w = __builtin_amdgcn_cvt_pk_fp8_f32(c, d, w, true); return (unsigned)w; }
__device__ __forceinline__ unsigned cvt_pk_bf16(float lo, float hi) { unsigned r; asm volatile("v_cvt_pk_bf16_f32 %0, %1, %2" : "=v"(r) : "v"(lo), "v"(hi)); return r; }

struct EpiBf16 {
    static constexpr bool PERM = true, AFTER_DRAIN = false;
    bf16_t* O; int ldc;
    __device__ __forceinline__ void operator()(const f32x4 (&acc)[2][2][4][2], const Unit& u, int wr, int wc, int fr, int fq) const {
        const int row0 = u.pm * BM + wr * 64 + fr; const int col0 = u.pn * BM + wc * 32 + 8 * fq;
#pragma unroll
        for (int ai = 0; ai < 2; ++ai)
#pragma unroll
            for (int m = 0; m < 4; ++m) { bf16_t* rowp = O + (size_t)(row0 + ai * HALF + m * 16) * ldc + col0;
#pragma unroll
                for (int bj = 0; bj < 2; ++bj) { const f32x4 v0 = acc[ai][bj][m][0], v1 = acc[ai][bj][m][1];
                    u32x4 w; w.x = cvt_pk_bf16(v0[0], v0[1]); w.y = cvt_pk_bf16(v0[2], v0[3]); w.z = cvt_pk_bf16(v1[0], v1[1]); w.w = cvt_pk_bf16(v1[2], v1[3]);
                    *(u32x4*)(rowp + bj * HALF) = w; } }
    }
};
struct EpiQKV {
    static constexpr bool PERM = true, AFTER_DRAIN = false;
    unsigned char* wsb; size_t offQ, dK, dV;
    const PG8_LAS float* gl; const float* ropec; float c2;
    __device__ __forceinline__ void operator()(const f32x4 (&acc)[2][2][4][2], const Unit& u, int wr, int wc, int fr, int fq) const {
        const int isk = (u.pn >= 4) ? 1 : 0, isv = (u.pn >= 5) ? 1 : 0;
        bf16_t* base = (bf16_t*)(wsb + offQ + (size_t)isk * dK + (size_t)isv * dV); const int ldc = isk ? 256 : 1024;
        const int hcol = (isk ? wc : (u.pn * 4 + wc)) * 64 + 8 * fq;
        const int pmb = u.pm / 17, pml = u.pm - pmb * 17; const bool lat = pml != 0;
        const PG8_LAS float* gp = gl + (isk ? 64 : 0) + 8 * fq; const float scl = isk ? 1.0f : c2;
#pragma unroll
        for (int ai = 0; ai < 2; ++ai)
#pragma unroll
            for (int m = 0; m < 4; ++m) { const int rl = ai * HALF + wr * 64 + m * 16 + fr; const size_t row = (size_t)u.pm * BM + rl;
                f32x4 v[2][2]; float ss = 0.f;
#pragma unroll
                for (int bj = 0; bj < 2; ++bj)
#pragma unroll
                    for (int n = 0; n < 2; ++n) { v[bj][n] = acc[ai][bj][m][n]; ss += (v[bj][n][0] * v[bj][n][0] + v[bj][n][1] * v[bj][n][1]) + (v[bj][n][2] * v[bj][n][2] + v[bj][n][3] * v[bj][n][3]); }
                if (!isv) { const int ln = lane_now(); ss += shx(ss, 16, ln); ss += shx(ss, 32, ln);
                    const float rs = 1.0f / sqrtf(ss * (1.0f / 64.0f) + 1e-6f);
                    const int spos = (pml - 1) * 256 + rl;
#pragma unroll
                    for (int bj = 0; bj < 2; ++bj) { f32x4 cs = (f32x4){1.f, 1.f, 1.f, 1.f}, sn = (f32x4){0.f, 0.f, 0.f, 0.f};
                        if (lat) { const float* cp = ropec + (size_t)spos * 32 + 16 * bj + 4 * fq; cs = *(const f32x4*)cp; sn = *(const f32x4*)(cp + 4096 * 32); }
#pragma unroll
                        for (int n = 0; n < 2; ++n) { const f32x4 y = v[bj][n] * rs * *(const PG8_LAS f32x4*)(gp + 32 * bj + 4 * n);
                            const float c0 = cs[2 * n], s0 = sn[2 * n], c1 = cs[2 * n + 1], s1 = sn[2 * n + 1];
                            v[bj][n] = (f32x4){(y[0] * c0 - y[1] * s0) * scl, (y[0] * s0 + y[1] * c0) * scl, (y[2] * c1 - y[3] * s1) * scl, (y[2] * s1 + y[3] * c1) * scl}; } } }
                bf16_t* rowp = base + row * ldc + hcol;
#pragma unroll
                for (int bj = 0; bj < 2; ++bj) { u32x4 w; w.x = cvt_pk_bf16(v[bj][0][0], v[bj][0][1]); w.y = cvt_pk_bf16(v[bj][0][2], v[bj][0][3]); w.z = cvt_pk_bf16(v[bj][1][0], v[bj][1][1]); w.w = cvt_pk_bf16(v[bj][1][2], v[bj][1][3]);
                    *(u32x4*)(rowp + 32 * bj) = w; } }
    }
};
struct EpiBiasF8 {
    static constexpr bool PERM = true, AFTER_DRAIN = false;
    unsigned char* O; const float* bias; float ascale;
    __device__ __forceinline__ void operator()(const f32x4 (&acc)[2][2][4][2], const Unit& u, int wr, int wc, int fr, int fq) const {
        const int row0 = u.pm * BM + wr * 64 + fr; const int col0 = u.pn * BM + wc * 32 + 8 * fq;
        const float* bp = bias + (size_t)u.e * 1024 + col0;
        f32x4 bv[2][2];
#pragma unroll
        for (int bj = 0; bj < 2; ++bj)
#pragma unroll
            for (int n = 0; n < 2; ++n) bv[bj][n] = *(const f32x4*)(bp + bj * HALF + 4 * n);
#pragma unroll
        for (int ai = 0; ai < 2; ++ai)
#pragma unroll
            for (int m = 0; m < 4; ++m) { unsigned char* rowp = O + (size_t)(row0 + ai * HALF + m * 16) * 1024 + col0;
#pragma unroll
                for (int bj = 0; bj < 2; ++bj) { const f32x4 v0 = acc[ai][bj][m][0] * ascale + bv[bj][0], v1 = acc[ai][bj][m][1] * ascale + bv[bj][1];
                    *(unsigned long long*)(rowp + bj * HALF) = (unsigned long long)pk4_fp8(v0[0], v0[1], v0[2], v0[3]) | ((unsigned long long)pk4_fp8(v1[0], v1[1], v1[2], v1[3]) << 32); } }
    }
};
struct EpiResGate {
    static constexpr bool PERM = false, AFTER_DRAIN = false;
    bf16_t* X; const float* gate;
    __device__ __forceinline__ void operator()(const f32x4 (&acc)[2][2][4][2], const Unit& u, int wr, int wc, int fr, int fq) const {
        const int row0 = u.pm * BM + wr * 64 + fr; const int col0 = u.pn * BM + wc * 32 + 4 * fq;
        const int bb = u.pm / 17, mr = (u.pm - bb * 17 == 0) ? 8 : bb;
        const float* gp = gate + (size_t)mr * 6144 + col0;
        f32x4 gv[2][2];
#pragma unroll
        for (int bj = 0; bj < 2; ++bj)
#pragma unroll
            for (int n = 0; n < 2; ++n) gv[bj][n] = *(const f32x4*)(gp + bj * HALF + n * 16);
#pragma unroll
        for (int ai = 0; ai < 2; ++ai)
#pragma unroll
            for (int m = 0; m < 4; ++m) { bf16_t* rowp = X + (size_t)(row0 + ai * HALF + m * 16) * 1024 + col0;
#pragma unroll
                for (int bj = 0; bj < 2; ++bj)
#pragma unroll
                    for (int n = 0; n < 2; ++n) { unsigned long long* p = (unsigned long long*)(rowp + bj * HALF + n * 16); const unsigned long long v = *p;
                        f32x4 x = (f32x4){__uint_as_float((unsigned)(v & 0xffffu) << 16), __uint_as_float((unsigned)(v >> 16) << 16), __uint_as_float((unsigned)((v >> 32) & 0xffffu) << 16), __uint_as_float((unsigned)(v >> 48) << 16)};
                        x = x + gv[bj][n] * acc[ai][bj][m][n];
                        *p = (unsigned long long)cvt_pk_bf16(x[0], x[1]) | ((unsigned long long)cvt_pk_bf16(x[2], x[3]) << 32); } }
    }
};
struct EpiSwiGLU {
    static constexpr bool PERM = true, AFTER_DRAIN = false;
    bf16_t* O; const float* bias;
    __device__ __forceinline__ void operator()(const f32x4 (&acc)[2][2][4][2], const Unit& u, int wr, int wc, int fr, int fq) const {
        const int row0 = u.pm * BM + wr * 64 + fr; const int col0 = u.pn * HALF + wc * 32 + 8 * fq;
        const float* bp = bias + (size_t)u.e * 2048 + col0;
        f32x4 bg[2], bu[2];
#pragma unroll
        for (int n = 0; n < 2; ++n) { bg[n] = *(const f32x4*)(bp + 4 * n); bu[n] = *(const f32x4*)(bp + 1024 + 4 * n); }
#pragma unroll
        for (int ai = 0; ai < 2; ++ai)
#pragma unroll
            for (int m = 0; m < 4; ++m) { bf16_t* rowp = O + (size_t)(row0 + ai * HALF + m * 16) * 1024 + col0;
                float r[8];
#pragma unroll
                for (int n = 0; n < 2; ++n) { const f32x4 gt = acc[ai][0][m][n] + bg[n], up = acc[ai][1][m][n] + bu[n];
#pragma unroll
                    for (int i = 0; i < 4; ++i) { const float g = fminf(gt[i], 7.0f), uu = fminf(fmaxf(up[i], -7.0f), 7.0f);
                        const float sg = __builtin_amdgcn_rcpf(1.0f + __builtin_amdgcn_exp2f(-1.702f * 1.4426950408889634f * g));
                        r[4 * n + i] = (uu + 1.0f) * (g * sg); } }
                u32x4 w; w.x = cvt_pk_bf16(r[0], r[1]); w.y = cvt_pk_bf16(r[2], r[3]); w.z = cvt_pk_bf16(r[4], r[5]); w.w = cvt_pk_bf16(r[6], r[7]);
                *(u32x4*)rowp = w; }
    }
};
struct EpiSwiGLU8 {
    static constexpr bool PERM = true, AFTER_DRAIN = false;
    unsigned char* O; const float* bias; float ascale;
    __device__ __forceinline__ void operator()(const f32x4 (&acc)[2][2][4][2], const Unit& u, int wr, int wc, int fr, int fq) const {
        const int row0 = u.pm * BM + wr * 64 + fr; const int col0 = u.pn * HALF + wc * 32 + 8 * fq;
        const float* bp = bias + (size_t)u.e * 2048 + col0;
        f32x4 bg[2], bu[2];
#pragma unroll
        for (int n = 0; n < 2; ++n) { bg[n] = *(const f32x4*)(bp + 4 * n); bu[n] = *(const f32x4*)(bp + 1024 + 4 * n); }
#pragma unroll
        for (int ai = 0; ai < 2; ++ai)
#pragma unroll
            for (int m = 0; m < 4; ++m) { unsigned char* rowp = O + (size_t)(row0 + ai * HALF + m * 16) * 1024 + col0;
                float r[8];
#pragma unroll
                for (int n = 0; n < 2; ++n) { const f32x4 gt = acc[ai][0][m][n] * ascale + bg[n], up = acc[ai][1][m][n] * ascale + bu[n];
#pragma unroll
                    for (int i = 0; i < 4; ++i) { const float g = fminf(gt[i], 7.0f), uu = fminf(fmaxf(up[i], -7.0f), 7.0f);
                        const float sg = __builtin_amdgcn_rcpf(1.0f + __builtin_amdgcn_exp2f(-1.702f * 1.4426950408889634f * g));
                        r[4 * n + i] = (uu + 1.0f) * (g * sg); } }
                *(unsigned long long*)rowp = (unsigned long long)pk4_fp8(r[0], r[1], r[2], r[3]) | ((unsigned long long)pk4_fp8(r[4], r[5], r[6], r[7]) << 32); }
    }
};
struct EpiBiasBf16 {
    static constexpr bool PERM = true, AFTER_DRAIN = false;
    bf16_t* O; const float* bias; float ascale;
    __device__ __forceinline__ void operator()(const f32x4 (&acc)[2][2][4][2], const Unit& u, int wr, int wc, int fr, int fq) const {
        const int row0 = u.pm * BM + wr * 64 + fr; const int col0 = u.pn * BM + wc * 32 + 8 * fq;
        const float* bp = bias + (size_t)u.e * 1024 + col0;
        f32x4 bv[2][2];
#pragma unroll
        for (int bj = 0; bj < 2; ++bj)
#pragma unroll
            for (int n = 0; n < 2; ++n) bv[bj][n] = *(const f32x4*)(bp + bj * HALF + 4 * n);
#pragma unroll
        for (int ai = 0; ai < 2; ++ai)
#pragma unroll
            for (int m = 0; m < 4; ++m) { bf16_t* rowp = O + (size_t)(row0 + ai * HALF + m * 16) * 1024 + col0;
#pragma unroll
                for (int bj = 0; bj < 2; ++bj) { const f32x4 v0 = acc[ai][bj][m][0] * ascale + bv[bj][0], v1 = acc[ai][bj][m][1] * ascale + bv[bj][1];
                    u32x4 w; w.x = cvt_pk_bf16(v0[0], v0[1]); w.y = cvt_pk_bf16(v0[2], v0[3]); w.z = cvt_pk_bf16(v1[0], v1[1]); w.w = cvt_pk_bf16(v1[2], v1[3]);
                    *(u32x4*)(rowp + bj * HALF) = w; } }
    }
};

template <class Epi, class Sched, bool ALIGN_EPI = false, bool SP2 = false, bool GATHER = false, bool F8 = false>
__device__ __forceinline__ void gemm_phase(PG8_LAS unsigned char* lds, const Gemm g, const Sched& S, const Epi& E, int tid_in) {
    int tid_l = tid_in; asm volatile("" : "+v"(tid_l));
    const int tid = tid_l, wid = __builtin_amdgcn_readfirstlane(tid >> 6), lane = tid & 63, wr = wid >> 2, wc = wid & 3, fr = lane & 15, fq = lane >> 4;
    const int K = g.K, nt = K / BK;
    unsigned voffA[2], voffB[2];
#pragma unroll
    for (int i = 0; i < 2; ++i) { int R, C; stage_rc(tid * 16 + i * 8192, R, C); const int Rb = Epi::PERM ? ((R & ~31) + perm32(R & 31)) : R;
        voffA[i] = (unsigned)(R * K + C) * 2u; voffB[i] = (unsigned)(Rb * K + C) * 2u; }
    const size_t kstep = (size_t)(BK * 2);
    static_assert(!GATHER || SP2, "GATHER is wired into the SP2 loop only");
    unsigned vAc0[2], vAc1[2], vAn0[2], vAn1[2]; int gR[2]; unsigned gC[2];
#pragma unroll
    for (int i = 0; i < 2; ++i) { int R, C; stage_rc(tid * 16 + i * 8192, R, C); gR[i] = R; gC[i] = (unsigned)C * 2u; vAc0[i] = voffA[i]; vAc1[i] = voffA[i]; vAn0[i] = voffA[i]; vAn1[i] = voffA[i]; }
#define PG8_GFETCH(d0, d1, ord) do { if constexpr (GATHER) { _Pragma("unroll") for (int _i = 0; _i < 2; ++_i) { \
        d0[_i] = (unsigned)g.rowtab[(ord) * 256 + gR[_i]] * (unsigned)(K * 2) + gC[_i]; d1[_i] = (unsigned)g.rowtab[(ord) * 256 + 128 + gR[_i]] * (unsigned)(K * 2) + gC[_i]; } } } while (0)
    const size_t hstep = (size_t)HALF * K * 2;
    const size_t hstepA = GATHER ? 0 : hstep;
    const size_t tstep = 2 * hstep;
    const unsigned ldsw = (unsigned)wid * 1024u;
    const int aoff = lds_byte(wr * 64 + fr, fq * 8), boff = lds_byte(wc * 32 + fr, fq * 8);
    typedef int v8i_t __attribute__((ext_vector_type(8))); typedef short v16s_a16 __attribute__((ext_vector_type(16), aligned(16)));
    const int f8c = 32 * (fq >> 1) + 16 * (fq & 1);
    const int aoff8a = lds_byte(wr * 64 + fr, f8c), boff8a = lds_byte(wc * 32 + fr, f8c);
    v8i_t At8[4], Au8[4], B08[2], B18[2]; int f8scale = 127; asm volatile("" : "+v"(f8scale));
#define PG8_SA(b, h) (((b) * 2 + (h)) * HTB)
#define PG8_SB(b, h) ((4 + (b) * 2 + (h)) * HTB)
#define PG8_STAGE(bufoff, gbase, voff) do { _Pragma("unroll") for (int _i = 0; _i < 2; ++_i) \
        __builtin_amdgcn_global_load_lds((const unsigned*)((const char*)(gbase) + (voff)[_i]), (PG8_LAS unsigned*)(lds + (bufoff) + ldsw + _i * 8192), 16, 0, 0); } while (0)
#define PG8_LDA(dst, b, h) do { if constexpr (F8) { _Pragma("unroll") for (int m = 0; m < 4; ++m) { const bf16x8 lo_ = *(const PG8_LAS bf16x8*)(lds + PG8_SA(b, h) + aoff8a + m * 2048), hi_ = *(const PG8_LAS bf16x8*)(lds + PG8_SA(b, h) + aoff8a + m * 2048 + 16); dst##8[m] = __builtin_bit_cast(v8i_t, __builtin_shufflevector(lo_, hi_, 0, 1, 2, 3, 4, 5, 6, 7, 8, 9, 10, 11, 12, 13, 14, 15)); } } \
        else { _Pragma("unroll") for (int m = 0; m < 4; ++m) _Pragma("unroll") for (int k = 0; k < 2; ++k) dst[m][k] = *(const PG8_LAS bf16x8*)(lds + PG8_SA(b, h) + aoff + m * 2048 + k * 1024); } } while (0)
#define PG8_LDB(dst, b, h) do { if constexpr (F8) { _Pragma("unroll") for (int n = 0; n < 2; ++n) { const bf16x8 lo_ = *(const PG8_LAS bf16x8*)(lds + PG8_SB(b, h) + boff8a + n * 2048), hi_ = *(const PG8_LAS bf16x8*)(lds + PG8_SB(b, h) + boff8a + n * 2048 + 16); dst##8[n] = __builtin_bit_cast(v8i_t, __builtin_shufflevector(lo_, hi_, 0, 1, 2, 3, 4, 5, 6, 7, 8, 9, 10, 11, 12, 13, 14, 15)); } } \
        else { _Pragma("unroll") for (int n = 0; n < 2; ++n) _Pragma("unroll") for (int k = 0; k < 2; ++k) dst[n][k] = *(const PG8_LAS bf16x8*)(lds + PG8_SB(b, h) + boff + n * 2048 + k * 1024); } } while (0)
#define PG8_MMA(ai, bj, At, Bt) do { __builtin_amdgcn_s_setprio(1); if constexpr (F8) { _Pragma("unroll") for (int m = 0; m < 4; ++m) _Pragma("unroll") for (int n = 0; n < 2; ++n) \
            asm volatile("v_mfma_scale_f32_16x16x128_f8f6f4 %0, %1, %2, %0, %3, %3 op_sel_hi:[0,0,0]" : "+v"(acc[ai][bj][m][n]) : "v"(Bt##8[n]), "v"(At##8[m]), "v"(f8scale)); } \
        else { _Pragma("unroll") for (int m = 0; m < 4; ++m) _Pragma("unroll") for (int n = 0; n < 2; ++n) _Pragma("unroll") for (int k = 0; k < 2; ++k) \
        acc[ai][bj][m][n] = __builtin_amdgcn_mfma_f32_16x16x32_bf16(Bt[n][k], At[m][k], acc[ai][bj][m][n], 0, 0, 0); } __builtin_amdgcn_s_setprio(0); } while (0)
#define PG8_WAIT_V(n) asm volatile("s_waitcnt vmcnt(" #n ")" ::: "memory")
#define PG8_WAIT_L(n) asm volatile("s_waitcnt lgkmcnt(" #n ")" ::: "memory")
#define PG8_BAR __builtin_amdgcn_s_barrier()
#define PG8_SCHED __builtin_amdgcn_sched_barrier(0)
    Unit cur, nxt; int ui = 0;
    if (!S.next(0, cur)) return;
    f32x4 acc[2][2][4][2];
#pragma unroll
    for (int a = 0; a < 2; ++a)
#pragma unroll
        for (int b = 0; b < 2; ++b)
#pragma unroll
            for (int m = 0; m < 4; ++m)
#pragma unroll
                for (int n = 0; n < 2; ++n) acc[a][b][m][n] = (f32x4){0.f, 0.f, 0.f, 0.f};
    bf16x8 At[4][2], Au[4][2], B0[2][2], B1[2][2];
    const char* cA = (const char*)g.A + (GATHER ? (size_t)0 : (size_t)cur.pm * tstep); PG8_GFETCH(vAc0, vAc1, 0); const char* cB = (const char*)g.Bt + (size_t)cur.e * g.bstride + (size_t)cur.pn * tstep;
    S.a_ready(cur);
    if constexpr (SP2) {
        PG8_STAGE(PG8_SB(0, 0), cB, voffB); PG8_STAGE(PG8_SB(0, 1), cB + hstep, voffB); PG8_STAGE(PG8_SA(0, 0), cA, vAc0); PG8_STAGE(PG8_SA(0, 1), cA + hstepA, vAc1);
        if (wr == 1) PG8_BAR;
        PG8_WAIT_V(2); PG8_BAR;
        PG8_STAGE(PG8_SB(1, 0), cB + kstep, voffB); PG8_STAGE(PG8_SA(1, 0), cA + kstep, vAc0); PG8_STAGE(PG8_SB(1, 1), cB + hstep + kstep, voffB);
        PG8_WAIT_V(6); PG8_BAR;
    } else {
        PG8_STAGE(PG8_SB(0, 0), cB, voffB); PG8_STAGE(PG8_SA(0, 0), cA, voffA); PG8_STAGE(PG8_SB(0, 1), cB + hstep, voffB); PG8_STAGE(PG8_SA(0, 1), cA + hstep, voffA);
        if (wr == 1) PG8_BAR;
        PG8_WAIT_V(4); PG8_BAR;
        PG8_STAGE(PG8_SB(1, 0), cB + kstep, voffB); PG8_STAGE(PG8_SA(1, 0), cA + kstep, voffA); PG8_STAGE(PG8_SB(1, 1), cB + hstep + kstep, voffB);
        PG8_WAIT_V(6); PG8_BAR;
    }
    for (;;) {
        const bool has_next = S.next(ui + 1, nxt);
        const char* nA = (has_next && !GATHER) ? (const char*)g.A + (size_t)nxt.pm * tstep : cA;
        if constexpr (GATHER) { if (has_next) PG8_GFETCH(vAn0, vAn1, ui + 1); else { vAn0[0] = vAc0[0]; vAn0[1] = vAc0[1]; vAn1[0] = vAc1[0]; vAn1[1] = vAc1[1]; } }
        const char* nB = has_next ? (const char*)g.Bt + (size_t)nxt.e * g.bstride + (size_t)nxt.pn * tstep : cB;
#pragma unroll 1
        for (int t = 0; t < nt; t += 2) {
            const bool last = (t == nt - 2);
            const char* a1 = cA + (size_t)(t + 1) * kstep;
            const char* a2 = last ? nA : cA + (size_t)(t + 2) * kstep; const char* b2 = last ? nB : cB + (size_t)(t + 2) * kstep;
            const char* a3 = a2 + kstep; const char* b3 = b2 + kstep;
            if (last && has_next) S.a_ready(nxt);
            unsigned vS0[2], vS1[2];
            vS0[0] = last ? vAn0[0] : vAc0[0]; vS0[1] = last ? vAn0[1] : vAc0[1]; vS1[0] = last ? vAn1[0] : vAc1[0]; vS1[1] = last ? vAn1[1] : vAc1[1];
            if constexpr (SP2) {
            PG8_LDB(B0, 0, 0); PG8_LDB(B1, 0, 1); PG8_SCHED; PG8_LDA(At, 0, 0); PG8_STAGE(PG8_SA(1, 1), a1 + hstepA, vAc1);
            PG8_WAIT_V(8); PG8_WAIT_L(0); PG8_BAR; PG8_MMA(0, 0, At, B0); PG8_MMA(0, 1, At, B1); PG8_BAR; PG8_SCHED;
            if constexpr (F8) { PG8_LDA(Au, 0, 1); } else { PG8_LDA(At, 0, 1); } PG8_STAGE(PG8_SB(0, 0), b2, voffB); PG8_STAGE(PG8_SB(0, 1), b2 + hstep, voffB); PG8_STAGE(PG8_SA(0, 0), a2, vS0);
            PG8_WAIT_V(8); PG8_WAIT_L(0); PG8_BAR; if constexpr (F8) { PG8_MMA(1, 0, Au, B0); PG8_MMA(1, 1, Au, B1); } else { PG8_MMA(1, 0, At, B0); PG8_MMA(1, 1, At, B1); } PG8_BAR; PG8_SCHED;
            PG8_LDB(B0, 1, 0); PG8_LDB(B1, 1, 1); PG8_SCHED; PG8_LDA(At, 1, 0); PG8_STAGE(PG8_SA(0, 1), a2 + hstepA, vS1);
            PG8_WAIT_V(8); PG8_WAIT_L(0); PG8_BAR; PG8_MMA(0, 0, At, B0); PG8_MMA(0, 1, At, B1); PG8_BAR; PG8_SCHED;
            if constexpr (F8) { PG8_LDA(Au, 1, 1); } else { PG8_LDA(At, 1, 1); } PG8_STAGE(PG8_SB(1, 0), b3, voffB); PG8_STAGE(PG8_SB(1, 1), b3 + hstep, voffB); PG8_STAGE(PG8_SA(1, 0), a3, vS0);
            PG8_WAIT_V(8); PG8_WAIT_L(0); PG8_BAR; if constexpr (F8) { PG8_MMA(1, 0, Au, B0); PG8_MMA(1, 1, Au, B1); } else { PG8_MMA(1, 0, At, B0); PG8_MMA(1, 1, At, B1); } PG8_BAR; PG8_SCHED;
            } else {
            PG8_LDB(B0, 0, 0); PG8_SCHED; PG8_LDA(At, 0, 0); PG8_STAGE(PG8_SA(1, 1), a1 + hstep, voffA);
            PG8_WAIT_L(8); PG8_BAR; PG8_WAIT_L(0); PG8_MMA(0, 0, At, B0); PG8_BAR; PG8_SCHED;
            PG8_LDB(B1, 0, 1); PG8_STAGE(PG8_SB(0, 0), b2, voffB);
            PG8_BAR; PG8_WAIT_L(0); PG8_MMA(0, 1, At, B1); PG8_BAR;
            PG8_LDA(At, 0, 1); PG8_STAGE(PG8_SA(0, 0), a2, voffA);
            PG8_BAR; PG8_WAIT_L(0); PG8_MMA(1, 0, At, B0); PG8_BAR; PG8_SCHED;
            PG8_STAGE(PG8_SB(0, 1), b2 + hstep, voffB);
            PG8_WAIT_V(6); PG8_BAR; PG8_MMA(1, 1, At, B1); PG8_BAR;
            PG8_LDB(B0, 1, 0); PG8_SCHED; PG8_LDA(At, 1, 0); PG8_STAGE(PG8_SA(0, 1), a2 + hstep, voffA);
            PG8_WAIT_L(8); PG8_BAR; PG8_WAIT_L(0); PG8_MMA(0, 0, At, B0); PG8_BAR; PG8_SCHED;
            PG8_LDB(B1, 1, 1); PG8_STAGE(PG8_SB(1, 0), b3, voffB);
            PG8_BAR; PG8_WAIT_L(0); PG8_MMA(0, 1, At, B1); PG8_BAR;
            PG8_LDA(At, 1, 1); PG8_STAGE(PG8_SA(1, 0), a3, voffA);
            PG8_BAR; PG8_WAIT_L(0); PG8_MMA(1, 0, At, B0); PG8_BAR; PG8_SCHED;
            PG8_STAGE(PG8_SB(1, 1), b3 + hstep, voffB);
            PG8_WAIT_V(6); PG8_BAR; PG8_MMA(1, 1, At, B1); PG8_BAR;
            }
        }
        if constexpr (ALIGN_EPI) { if (wr == 0) PG8_BAR; }
        if constexpr (F8) asm volatile("s_nop 15\n\ts_nop 15" ::: "memory");
        if constexpr (!Epi::AFTER_DRAIN) { E(acc, cur, wr, wc, fr, fq); S.done(cur); }
        if (!has_next) break;
#pragma unroll
        for (int a = 0; a < 2; ++a)
#pragma unroll
            for (int b = 0; b < 2; ++b)
#pragma unroll
                for (int m = 0; m < 4; ++m)
#pragma unroll
                    for (int n = 0; n < 2; ++n) acc[a][b][m][n] = (f32x4){0.f, 0.f, 0.f, 0.f};
        cur = nxt; cA = nA; cB = nB; ++ui;
        if constexpr (GATHER) { vAc0[0] = vAn0[0]; vAc0[1] = vAn0[1]; vAc1[0] = vAn1[0]; vAc1[1] = vAn1[1]; }
        if constexpr (ALIGN_EPI) { if (wr == 1) PG8_BAR; }
    }
    PG8_WAIT_V(0);
    if constexpr (!ALIGN_EPI) { if (wr == 0) PG8_BAR; }
    PG8_BAR;
    if constexpr (Epi::AFTER_DRAIN) { E.fused(acc, cur, wr, wc, fr, fq, lds, wid, lane); S.done(cur); }
#undef PG8_SA
#undef PG8_SB
#undef PG8_STAGE
#undef PG8_LDA
#undef PG8_LDB
#undef PG8_MMA
#undef PG8_WAIT_V
#undef PG8_WAIT_L
#undef PG8_BAR
#undef PG8_SCHED
#undef PG8_GFETCH
}
}
#include <hip/hip_bf16.h>
#include <cmath>
namespace attn_body {
using bf16=__hip_bfloat16;
using bf16x8=__attribute__((ext_vector_type(8)))short;
using s16x4=__attribute__((ext_vector_type(4)))short;
using f32x16=__attribute__((ext_vector_type(16)))float;
using u32x4=__attribute__((ext_vector_type(4)))unsigned;
constexpr int D=64,DM=1024,KVP=256;
constexpr int NW=8,QBLK=32,QB=QBLK*NW,KVBLK=64;
__device__ __forceinline__ int crow(int r,int hi){return (r&3)+8*(r>>2)+4*hi;}
#define SBAR() __builtin_amdgcn_sched_barrier(0)
__device__ __forceinline__ void cmask(f32x16&p0,f32x16&p1,int jb,int qrel,int hi){
  const float NEG=-INFINITY; int kb=64*jb+4*hi;
  #pragma unroll
  for(int r=0;r<16;++r){int kv=kb+(r&3)+8*(r>>2); if(kv>qrel)p0[r]=NEG; if(kv+32>qrel)p1[r]=NEG;}
}

constexpr int NSLOT=3, SLOTB=8192;
constexpr int LDS_K=0, LDS_V=NSLOT*SLOTB, LDS_WS=2*NSLOT*SLOTB, LDS_OST=LDS_WS+NW*64*4, LDS_BYTES=LDS_OST+NW*4096;
constexpr float C2=0.125f*1.4426950408889634f;
__device__ __forceinline__ void glds16(const void*gsrc,unsigned lds_dst){unsigned keep;
  asm volatile("s_mov_b32 %0, m0\n\ts_mov_b32 m0, %2\n\ts_nop 0\n\tglobal_load_lds_dwordx4 %1, off\n\ts_mov_b32 m0, %0":"=&s"(keep):"v"(gsrc),"s"(lds_dst):"memory");}
__device__ __forceinline__ float max3f(float a,float b,float c){float r;asm("v_max3_f32 %0, %1, %2, %3":"=v"(r):"v"(a),"v"(b),"v"(c));return r;}
__device__ __forceinline__ float max2f(float a,float b){float r;asm("v_max_f32_e32 %0, %1, %2":"=v"(r):"v"(a),"v"(b));return r;}
__device__ __forceinline__ float fadd_s(float a,float b){float r;asm("v_add_f32_e32 %0, %1, %2":"=v"(r):"v"(a),"v"(b));return r;}
__device__ __forceinline__ float fsub_s(float a,float b){float r;asm("v_sub_f32_e32 %0, %1, %2":"=v"(r):"v"(a),"v"(b));return r;}
typedef float f32x2_t __attribute__((ext_vector_type(2))); typedef __bf16 bf16x2_t __attribute__((ext_vector_type(2)));
__device__ __forceinline__ unsigned cvtpk_s(float lo,float hi){f32x2_t v={lo,hi};bf16x2_t b=__builtin_convertvector(v,bf16x2_t);return __builtin_bit_cast(unsigned,b);}
#define WAIT_BAR(N) asm volatile("s_waitcnt vmcnt(" #N ") lgkmcnt(0)\n\ts_barrier":::"memory")

__device__ __forceinline__ void qkt(f32x16&p0,f32x16&p1,const char*Kslot,const bf16x8*qr,const f32x16&negm,int r32,int hi){
  const char*kb=Kslot+hi*1024+r32*16;
  #pragma unroll
  for(int d0=0;d0<4;++d0){
    const bf16x8 b0=*reinterpret_cast<const bf16x8*>(kb+d0*2048);
    const bf16x8 b1=*reinterpret_cast<const bf16x8*>(kb+d0*2048+512);
    if(d0==0){p0=__builtin_amdgcn_mfma_f32_32x32x16_bf16(b0,qr[0],negm,0,0,0);p1=__builtin_amdgcn_mfma_f32_32x32x16_bf16(b1,qr[0],negm,0,0,0);}
    else{p0=__builtin_amdgcn_mfma_f32_32x32x16_bf16(b0,qr[d0],p0,0,0,0);p1=__builtin_amdgcn_mfma_f32_32x32x16_bf16(b1,qr[d0],p1,0,0,0);}}
}
typedef __attribute__((address_space(3))) const char* lds_cptr;
typedef short v4i16_t __attribute__((ext_vector_type(4)));
__device__ __forceinline__ void kload8(bf16x8*kf,lds_cptr kp){
  kf[0]=*(const __attribute__((address_space(3))) bf16x8*)(kp);      kf[1]=*(const __attribute__((address_space(3))) bf16x8*)(kp+512);
  kf[2]=*(const __attribute__((address_space(3))) bf16x8*)(kp+2048); kf[3]=*(const __attribute__((address_space(3))) bf16x8*)(kp+2560);
  kf[4]=*(const __attribute__((address_space(3))) bf16x8*)(kp+4096); kf[5]=*(const __attribute__((address_space(3))) bf16x8*)(kp+4608);
  kf[6]=*(const __attribute__((address_space(3))) bf16x8*)(kp+6144); kf[7]=*(const __attribute__((address_space(3))) bf16x8*)(kp+6656);
}
__device__ __forceinline__ void kload2(bf16x8*kf,lds_cptr kp,int j){ kf[2*j]=*(const __attribute__((address_space(3))) bf16x8*)(kp+j*2048); kf[2*j+1]=*(const __attribute__((address_space(3))) bf16x8*)(kp+j*2048+512); }
__device__ __forceinline__ s16x4 vtr(lds_cptr p){ return __builtin_bit_cast(s16x4,__builtin_amdgcn_ds_read_tr16_b64_v4i16((__attribute__((address_space(3))) v4i16_t*)p)); }
__device__ __forceinline__ float rowmax(const f32x16&p0,const f32x16&p1){
  float a=max3f(p0[0],p0[1],p1[0]),b=max3f(p0[2],p0[3],p1[1]);a=max3f(a,p1[2],p1[3]);
  #pragma unroll
  for(int r=4;r<16;r+=4){a=max3f(a,p0[r],p0[r+1]);b=max3f(b,p0[r+2],p0[r+3]);a=max3f(a,p1[r],p1[r+1]);b=max3f(b,p1[r+2],p1[r+3]);}
  const float m=max2f(a,b);
  auto rr=__builtin_amdgcn_permlane32_swap(__float_as_uint(m),__float_as_uint(m),false,false);
  return max2f(__uint_as_float(rr[0]),__uint_as_float(rr[1]));
}
__device__ __forceinline__ void pv(f32x16*o,int vb,bf16x8 pa0,bf16x8 pa1,bf16x8 pa2,bf16x8 pa3){
  #pragma unroll
  for(int d0=0;d0<2;++d0){s16x4 lo[4],hi[4];
    #pragma unroll
    for(int ks=0;ks<4;++ks){
      asm volatile("ds_read_b64_tr_b16 %0,%1 offset:%c2":"=&v"(lo[ks]):"v"(vb),"i"(d0*4096+ks*1024):"memory");
      asm volatile("ds_read_b64_tr_b16 %0,%1 offset:%c2":"=&v"(hi[ks]):"v"(vb),"i"(d0*4096+ks*1024+512):"memory");}
    asm volatile("s_waitcnt lgkmcnt(0)":::"memory");SBAR();
    #define PK(k) (bf16x8){lo[k][0],lo[k][1],lo[k][2],lo[k][3],hi[k][0],hi[k][1],hi[k][2],hi[k][3]}
    o[d0]=__builtin_amdgcn_mfma_f32_32x32x16_bf16(pa0,PK(0),o[d0],0,0,0);
    o[d0]=__builtin_amdgcn_mfma_f32_32x32x16_bf16(pa1,PK(1),o[d0],0,0,0);
    o[d0]=__builtin_amdgcn_mfma_f32_32x32x16_bf16(pa2,PK(2),o[d0],0,0,0);
    o[d0]=__builtin_amdgcn_mfma_f32_32x32x16_bf16(pa3,PK(3),o[d0],0,0,0);
    #undef PK
  }
}

#ifndef ATTN_STORE16
#define ATTN_STORE16(p,v) (*(u32x4*)(p)=(v))
#endif
template<int THRL> __device__ __forceinline__ void attn_unit(long qrow0,long kvrow0,int NT,int h,const bf16*Q,const bf16*__restrict__ K,const bf16*__restrict__ V,bf16*O,char*shm,int tid_in){
  int tid_l=tid_in; asm volatile("":"+v"(tid_l)); const int tid=tid_l,lane=tid&63,r32=lane&31,hi=lane>>5; const int wid=__builtin_amdgcn_readfirstlane(tid>>6);
  const bf16*Qw=Q+(qrow0+wid*QBLK)*DM+h*D;
  const bf16*Kh=K+kvrow0*KVP+(h>>2)*D,*Vh=V+kvrow0*KVP+(h>>2)*D;
  const unsigned lds0=(unsigned)(uintptr_t)shm;
  float*wsf=(float*)(shm+LDS_WS)+wid*64;
  const bf16*ksrc=Kh+(long)lane*KVP+wid*8;
  const bf16*vsrc=Vh+(long)(16*(wid&3)+(lane>>2))*KVP+(wid>>2)*32+(lane&3)*8;
  const unsigned kdst=lds0+LDS_K+wid*1024, vdst=lds0+LDS_V+wid*1024;
  #define DMA_K(t,slot) glds16(ksrc+(long)(t)*KVBLK*KVP,(unsigned)__builtin_amdgcn_readfirstlane(kdst+(slot)))
  #define DMA_V(t,slot) glds16(vsrc+(long)(t)*KVBLK*KVP,(unsigned)__builtin_amdgcn_readfirstlane(vdst+(slot)))
  const int vb0=(int)(lds0+LDS_V)+((lane>>4)&1)*32+(lane&3)*8+(4*hi+((lane&15)>>2))*64;
  const char*Kbase=shm+LDS_K; bf16x8 kf[8];
  const lds_cptr shm3=(lds_cptr)shm; const lds_cptr kp0=shm3+LDS_K+hi*1024+r32*16; const lds_cptr vp0=shm3+LDS_V+((lane>>4)&1)*32+(lane&3)*8+(4*hi+((lane&15)>>2))*64;
  DMA_K(0,0);DMA_V(0,0);DMA_K(1,SLOTB);
  bf16x8 qr[4];
  #pragma unroll
  for(int d0=0;d0<4;++d0)qr[d0]=*reinterpret_cast<const bf16x8*>(&Qw[(long)r32*DM+d0*16+hi*8]);
  float mhat=0.f,l_reg=0.f;f32x16 o[2];o[0]=f32x16{};o[1]=f32x16{};f32x16 negm=f32x16{};asm volatile("":"+v"(negm));
  #define CMASK(P0,P1,t) do{}while(0)
  bool resc=false;
  #define START(P0,P1) do{ const float rm=rowmax(P0,P1); resc=false; \
    { const float dl=rm; mhat=fadd_s(mhat,dl); \
      _Pragma("unroll") for(int r=0;r<16;++r){P0[r]=fsub_s(P0[r],dl);P1[r]=fsub_s(P1[r],dl);} \
      _Pragma("unroll") for(int r=0;r<16;++r)negm[r]=-mhat; asm volatile("":"+v"(negm)); } \
    _Pragma("unroll") for(int r=0;r<16;++r)P0[r]=__builtin_amdgcn_exp2f(P0[r]); }while(0)
  #define RESC() do{ if(resc){ asm volatile("s_waitcnt lgkmcnt(0)":::"memory"); \
      _Pragma("unroll") for(int d_=0;d_<2;++d_) _Pragma("unroll") for(int r=0;r<16;++r)o[d_][r]*=wsf[crow(r,hi)]; } }while(0)
  f32x16 pA0,pA1,pB0,pB1;
  int sl_prev=0,sl_cur=0,sl_next=SLOTB;
  #define ROT() do{sl_prev=sl_cur;sl_cur=sl_next;sl_next=(sl_next==(NSLOT-1)*SLOTB)?0:sl_next+SLOTB;}while(0)
  DMA_K(2,2*SLOTB);
  WAIT_BAR(3);
  qkt(pA0,pA1,Kbase,qr,negm,r32,hi);asm volatile("s_nop 15\n\ts_nop 7":"+v"(pA0),"+v"(pA1));CMASK(pA0,pA1,0);
  START(pA0,pA1);
  _Pragma("unroll") for(int r=0;r<16;++r)pA1[r]=__builtin_amdgcn_exp2f(pA1[r]);
  WAIT_BAR(0);
  DMA_K(3,0);DMA_V(1,SLOTB);
  ROT();
  kload8(kf,kp0+sl_cur);
  WAIT_BAR(2);
  s16x4 vlo[8],vhi[8]; u32x4 pw0,pw1,pw2,pw3;
  #define PKW(P,B) cvtpk_s(P[B],P[B+1])
  #define PAF(k) __builtin_bit_cast(bf16x8,pw##k)
  #define VFR(i) (bf16x8){vlo[i][0],vlo[i][1],vlo[i][2],vlo[i][3],vhi[i][0],vhi[i][1],vhi[i][2],vhi[i][3]}
  #define PIN(x) asm volatile("":"+v"(x))
  #define MX3(a,b,c) __builtin_fmaxf(__builtin_fmaxf((a),(b)),(c))
  #define GAPA(MF,A0,A1,A2,A3,W0,W1,PW) do{ MF; sacc+=A0; sacc+=A1; sacc+=A2; sacc+=A3; PIN(sacc); W0; W1; PIN(PW); SBAR(); }while(0)
  #define EX(v) __builtin_amdgcn_exp2f(v)
  #define GAPB(MF,X,B) do{ MF; X[B]=EX(X[B]); X[B+1]=EX(X[B+1]); X[B+2]=EX(X[B+2]); X[B+3]=EX(X[B+3]); PIN(X); SBAR(); }while(0)
  #define VRD(i) do{ vlo[i]=vtr(vp_+(((i)>>2)*4096+((i)&3)*1024)); vhi[i]=vtr(vp_+(((i)>>2)*4096+((i)&3)*1024+512)); }while(0)
  #define KRD(G,j) do{ if(G){ kload2(kf,kp0+sl_next,j); SBAR(); } }while(0)
  #define STEP(C0,C1,P0,P1,t,GK,GV,GL) do{ SBAR(); \
    const lds_cptr vp_=vp0+sl_prev; \
    VRD(0); SBAR(); float sacc=(P0[0]+P0[1]); \
    GAPA(C0=__builtin_amdgcn_mfma_f32_32x32x16_bf16(kf[0],qr[0],negm,0,0,0), P0[2],P0[3],P0[4],P0[5],     pw0[0]=PKW(P0,0), pw0[1]=PKW(P0,2), pw0); \
    VRD(4); SBAR(); GAPA(C1=__builtin_amdgcn_mfma_f32_32x32x16_bf16(kf[1],qr[0],negm,0,0,0), P0[6],P0[7],P0[8],P0[9],     pw0[2]=PKW(P0,4), pw0[3]=PKW(P0,6), pw0); \
    VRD(1); SBAR(); GAPA(C0=__builtin_amdgcn_mfma_f32_32x32x16_bf16(kf[2],qr[1],C0,0,0,0),   P0[10],P0[11],P0[12],P0[13], pw1[0]=PKW(P0,8), pw1[1]=PKW(P0,10), pw1); \
    VRD(5); SBAR(); GAPA(C1=__builtin_amdgcn_mfma_f32_32x32x16_bf16(kf[3],qr[1],C1,0,0,0),   P0[14],P0[15],P1[0],P1[1],   pw1[2]=PKW(P0,12),pw1[3]=PKW(P0,14), pw1); \
    VRD(2); SBAR(); GAPA(C0=__builtin_amdgcn_mfma_f32_32x32x16_bf16(kf[4],qr[2],C0,0,0,0),   P1[2],P1[3],P1[4],P1[5],     pw2[0]=PKW(P1,0), pw2[1]=PKW(P1,2), pw2); \
    VRD(6); SBAR(); GAPA(C1=__builtin_amdgcn_mfma_f32_32x32x16_bf16(kf[5],qr[2],C1,0,0,0),   P1[6],P1[7],P1[8],P1[9],     pw2[2]=PKW(P1,4), pw2[3]=PKW(P1,6), pw2); \
    VRD(3); SBAR(); GAPA(C0=__builtin_amdgcn_mfma_f32_32x32x16_bf16(kf[6],qr[3],C0,0,0,0),   P1[10],P1[11],P1[12],P1[13], pw3[0]=PKW(P1,8), pw3[1]=PKW(P1,10), pw3); \
    VRD(7); SBAR(); GAPA(C1=__builtin_amdgcn_mfma_f32_32x32x16_bf16(kf[7],qr[3],C1,0,0,0),   P1[14],P1[15],0.f,0.f,       pw3[2]=PKW(P1,12),pw3[3]=PKW(P1,14), pw3); \
    l_reg+=sacc; \
    if(GK){DMA_K((t)+3,sl_cur);} if(GV){DMA_V((t)+1,sl_next);} \
    CMASK(C0,C1,t); \
    { float a=MX3(C0[0],C0[1],C1[0]),b=MX3(C0[2],C0[3],C1[1]); a=MX3(a,C1[2],C1[3]); \
      _Pragma("unroll") for(int r=4;r<16;r+=4){a=MX3(a,C0[r],C0[r+1]);b=MX3(b,C0[r+2],C0[r+3]);a=MX3(a,C1[r],C1[r+1]);b=MX3(b,C1[r+2],C1[r+3]);} \
      float rm=__builtin_fmaxf(a,b); { auto rr=__builtin_amdgcn_permlane32_swap(__float_as_uint(rm),__float_as_uint(rm),false,false); rm=__builtin_fmaxf(__uint_as_float(rr[0]),__uint_as_float(rr[1])); } \
      resc=false; \
      if(__builtin_expect(__any(rm>(float)THRL),0)){ const float dl=__builtin_fmaxf(rm,0.f); mhat+=dl; \
        _Pragma("unroll") for(int r=0;r<16;++r){C0[r]-=dl;C1[r]-=dl;} \
        _Pragma("unroll") for(int r=0;r<16;++r)negm[r]=-mhat; asm volatile("":"+v"(negm)); \
        const float f=__builtin_amdgcn_exp2f(-dl); l_reg*=f; if(hi==0)wsf[r32]=f; resc=true; } } \
    SBAR(); \
    GAPB(o[0]=__builtin_amdgcn_mfma_f32_32x32x16_bf16(PAF(0),VFR(0),o[0],0,0,0), C0,0); \
    GAPB(o[1]=__builtin_amdgcn_mfma_f32_32x32x16_bf16(PAF(0),VFR(4),o[1],0,0,0), C0,4); \
    KRD(GL,0); GAPB(o[0]=__builtin_amdgcn_mfma_f32_32x32x16_bf16(PAF(1),VFR(1),o[0],0,0,0), C0,8); \
    KRD(GL,1); GAPB(o[1]=__builtin_amdgcn_mfma_f32_32x32x16_bf16(PAF(1),VFR(5),o[1],0,0,0), C0,12); \
    KRD(GL,2); GAPB(o[0]=__builtin_amdgcn_mfma_f32_32x32x16_bf16(PAF(2),VFR(2),o[0],0,0,0), C1,0); \
    KRD(GL,3); GAPB(o[1]=__builtin_amdgcn_mfma_f32_32x32x16_bf16(PAF(2),VFR(6),o[1],0,0,0), C1,4); \
    GAPB(o[0]=__builtin_amdgcn_mfma_f32_32x32x16_bf16(PAF(3),VFR(3),o[0],0,0,0), C1,8); \
    GAPB(o[1]=__builtin_amdgcn_mfma_f32_32x32x16_bf16(PAF(3),VFR(7),o[1],0,0,0), C1,12); \
    }while(0)
  int t=1;
  #undef CMASK
  #define CMASK(P0,P1,t) do{}while(0)
  for(;t+5<NT;t+=2){
    STEP(pB0,pB1,pA0,pA1,t,true,true,true);     WAIT_BAR(2); RESC(); ROT();
    STEP(pA0,pA1,pB0,pB1,t+1,true,true,true);   WAIT_BAR(2); RESC(); ROT();
  }
  #undef CMASK
  #define CMASK(P0,P1,t) do{}while(0)
  #define ENDW(tt) do{ if((tt)+3<NT){WAIT_BAR(2);} else if((tt)+2<NT){WAIT_BAR(1);} else {WAIT_BAR(0);} }while(0)
  for(;t+1<NT;t+=2){
    STEP(pB0,pB1,pA0,pA1,t,(t+3<NT),(t+1<NT),(t+1<NT));       ENDW(t);   RESC(); ROT();
    STEP(pA0,pA1,pB0,pB1,t+1,(t+4<NT),(t+2<NT),(t+2<NT));     ENDW(t+1); RESC(); ROT();
  }
  STEP(pB0,pB1,pA0,pA1,NT-1,false,false,false); RESC();
  { float sacc=pB0[0]+pB0[1]; _Pragma("unroll") for(int r=2;r<16;++r)sacc+=pB0[r]; _Pragma("unroll") for(int r=0;r<16;++r)sacc+=pB1[r]; l_reg+=sacc;
    pw0=(u32x4){PKW(pB0,0),PKW(pB0,2),PKW(pB0,4),PKW(pB0,6)};pw1=(u32x4){PKW(pB0,8),PKW(pB0,10),PKW(pB0,12),PKW(pB0,14)};pw2=(u32x4){PKW(pB1,0),PKW(pB1,2),PKW(pB1,4),PKW(pB1,6)};pw3=(u32x4){PKW(pB1,8),PKW(pB1,10),PKW(pB1,12),PKW(pB1,14)};
    SBAR(); pv(o,vb0+sl_cur,PAF(0),PAF(1),PAF(2),PAF(3)); }
  #undef PKW
  #undef PAF
  #undef VFR
  #undef PIN
  #undef MX3
  #undef GAPA
  #undef GAPB
  #undef EX
  #undef VRD
  #undef KRD
  #undef STEP
  #undef ENDW
  {auto rr=__builtin_amdgcn_permlane32_swap(__float_as_uint(l_reg),__float_as_uint(l_reg),false,false);l_reg=__uint_as_float(rr[0])+__uint_as_float(rr[1]);}
  if(hi==0)wsf[32+r32]=l_reg;asm volatile("s_waitcnt lgkmcnt(0)":::"memory");
  float rli[16];
  #pragma unroll
  for(int r=0;r<16;++r)rli[r]=__builtin_amdgcn_rcpf(wsf[32+crow(r,hi)]);
  bf16*Ow=O+(qrow0+wid*QBLK)*DM+h*D;
  { bf16*stg=(bf16*)(shm+LDS_OST)+wid*2048;
    #pragma unroll
    for(int r=0;r<16;++r){const int orow=crow(r,hi);
      #pragma unroll
      for(int d0=0;d0<2;++d0)stg[orow*64+d0*32+r32]=__float2bfloat16(o[d0][r]*rli[r]);}
    asm volatile("s_waitcnt lgkmcnt(0)":::"memory");
    #pragma unroll
    for(int i=0;i<4;++i){const int row=i*8+(lane>>3),ch=lane&7; const u32x4 v=*(const u32x4*)(stg+row*64+ch*8); ATTN_STORE16(Ow+(long)row*DM+ch*8,v);} }
  asm volatile("s_waitcnt lgkmcnt(0)\n\ts_barrier":::"memory");
  #undef DMA_K
  #undef DMA_V
  #undef CMASK
  #undef START
  #undef RESC
  #undef ROT
}
constexpr int ATTN_LDS_BYTES=LDS_BYTES;
#undef SBAR
#undef WAIT_BAR
}

constexpr int NWAVES = 8;
constexpr int NB = 8, SEQ = 4096, CTXL = 256, TB = SEQ + CTXL  , MT = NB * TB  , DMODEL = 1024;
constexpr int NMODC = 6 * DMODEL, MODROWS = 9;
constexpr int QKVN = 1536, WINN = 3104, WINP = 3328;
constexpr int NEXP = 32, TOPK = 4, MPAD = MT * TOPK + NEXP * 256;
constexpr int NLAYER = 4;
constexpr float RMS_EPS = 1e-6f;
constexpr float ATT_C2 = 0.125f * 1.4426950408889634f;

constexpr size_t MiB = 1u << 20;
constexpr size_t WS_CTL = 0, CTL_ZERO_BYTES = 1 * MiB;
constexpr size_t WS_MOD = 1 * MiB, WS_ROPE = 2 * MiB, WS_MODP = 3 * MiB;
constexpr size_t WS_SLOT = 17 * MiB, WS_GATEW = 18 * MiB, WS_SLOTPOS = 19 * MiB;
constexpr size_t WS_WQKV = 20 * MiB, WS_WOA = 26 * MiB, WS_WIN = 30 * MiB, WS_WOG = 43 * MiB, WS_WGU = 48 * MiB, WS_WDN = 560 * MiB;
constexpr size_t WS_X = 816 * MiB, WS_XN = 952 * MiB, WS_Q = 1020 * MiB, WS_K = 1088 * MiB, WS_V = 1105 * MiB, WS_G = 1122 * MiB;
constexpr size_t WS_OF = 1343 * MiB, WS_OB = 1479 * MiB, WS_XG = 1615 * MiB, WS_ACT = 1903 * MiB, WS_Y = 2191 * MiB, WS_XN8 = WS_ACT + 150 * MiB  , WS_PAR = 2479 * MiB, WS_LIST = 2483 * MiB  , WS_END = 2488 * MiB;
static_assert(WS_MODP + (size_t)16 * NLAYER * MODROWS * NMODC * 4 <= WS_SLOT && WS_WIN + (size_t)2 * WINP * 1024 * 2 <= WS_WOG && WS_G + (size_t)MT * WINP * 2 <= WS_OF && WS_XG + (size_t)MPAD * 1024 * 2 <= WS_ACT, "ws map");
constexpr int CW_TMO = 0, CW_BAR = 4096, CW_CNT = 16384;

constexpr int RING_OFF = 0, RING_BYTES = 131072;
constexpr int WR_STRIDE = 1028;
constexpr int LDS_AUX = 133120;
constexpr int AUX_LCNT = LDS_AUX, AUX_GB = LDS_AUX + 128, AUX_T2E = LDS_AUX + 256  , AUX_BASE = AUX_T2E + 2560  , AUX_NT = AUX_BASE + 128, AUX_CNT = AUX_NT + 64  , AUX_ENT = AUX_CNT + 128  , AUX_RS = AUX_ENT + 4352  , AUX_ROWTAB = AUX_RS + 576, ROWTAB_UNITS = 18  ;
constexpr int MISC_OFF = 154624;
constexpr int LDS_BYTES = 155648;
static_assert(AUX_ROWTAB + ROWTAB_UNITS * 512 <= MISC_OFF, "LDS map");

#define GAS __attribute__((address_space(1)))
#define LAS __attribute__((address_space(3)))
typedef unsigned short bf16;
typedef unsigned v4u __attribute__((ext_vector_type(4)));
typedef float f32x4 __attribute__((ext_vector_type(4)));
typedef short bf16x8 __attribute__((ext_vector_type(8)));
typedef GAS unsigned gu32;
typedef GAS unsigned long long gu64;
#define RLX_AGENT __ATOMIC_RELAXED, __HIP_MEMORY_SCOPE_AGENT
#define LDS_WAIT() asm volatile("s_waitcnt lgkmcnt(0)" ::: "memory")
#define VM_WAIT() asm volatile("s_waitcnt vmcnt(0)" ::: "memory")
__device__ __forceinline__ unsigned long long rt() { return __builtin_amdgcn_s_memrealtime(); }
__device__ __forceinline__ unsigned f2bf(float f) { unsigned u = __builtin_bit_cast(unsigned, f); return (u + 0x7fffu + ((u >> 16) & 1u)) >> 16; }
__device__ __forceinline__ unsigned pk2(float lo, float hi) { return f2bf(lo) | (f2bf(hi) << 16); }

#define XB_TMO      128
#define XB_XCNT(j)  (256  + 64 * (j))
#define XB_XSUB(j)  (1280 + 64 * (j))
#define XB_XGEN(j)  (2304 + 64 * (j))
#define XB_TOP      3328
#define XB_TOPGEN   3392
#define XCD_BAR_WORDS 3456
#define XB_SPIN_CAP (1u << 18)

__device__ __forceinline__ unsigned xb_ld(unsigned* p)              { return __hip_atomic_load(p, __ATOMIC_RELAXED, __HIP_MEMORY_SCOPE_AGENT); }
__device__ __forceinline__ unsigned xb_add(unsigned* p, unsigned v) { return __hip_atomic_fetch_add(p, v, __ATOMIC_RELAXED, __HIP_MEMORY_SCOPE_AGENT); }
__device__ __forceinline__ unsigned xb_xcc_id() { return (unsigned)__builtin_amdgcn_s_getreg((3 << 11) | 20) & 0xFu; }
#define XB_SPIN(cond, bar) do { unsigned _sp = 0; while (cond) { __builtin_amdgcn_s_sleep(1); \
    if ((++_sp & 255u) == 0u) { if (xb_ld(&(bar)[XB_TMO])) break; if (_sp > XB_SPIN_CAP) { atomicAdd(&(bar)[XB_TMO], 1u); break; } } } } while (0)

struct XcdBarrier {
    unsigned* bar; unsigned x;
    volatile LAS unsigned* st;
};

__device__ __forceinline__ XcdBarrier xcd_barrier_post(unsigned* bar, volatile LAS unsigned* st, bool xb_t0  ) {
    XcdBarrier b; b.bar = bar; b.x = xb_xcc_id(); b.st = st;
    if (xb_t0) (void)xb_add(&bar[XB_XCNT(b.x)], 1u);
    return b;
}
__device__ __forceinline__ void xcd_barrier_complete(unsigned* bar, unsigned x, unsigned& nloc, unsigned& nx) {
    const unsigned G = gridDim.x * gridDim.y * gridDim.z;
    unsigned sum, cnt, mine, sp = 0u;
    for (;;) {
        sum = 0u; cnt = 0u; mine = 0u;
#pragma unroll
        for (unsigned j = 0; j < 16; ++j) { const unsigned c = xb_ld(&bar[XB_XCNT(j)]); sum += c; cnt += (c > 0u) ? 1u : 0u; mine = (j == x) ? c : mine; }
        if (sum == G) break;
        __builtin_amdgcn_s_sleep(1);
        if ((++sp & 255u) == 0u) { if (xb_ld(&bar[XB_TMO])) break; if (sp > XB_SPIN_CAP) { atomicAdd(&bar[XB_TMO], 1u); break; } }
    }
    nloc = mine > 0u ? mine : 1u; nx = cnt > 0u ? cnt : 1u;
}

__device__ __forceinline__ void xcd_barrier(const XcdBarrier& b, bool xb_t0  ) {
    asm volatile("s_waitcnt vmcnt(0)" ::: "memory");
    __syncthreads();
    if (xb_t0) {
        unsigned* bar = b.bar;
        __builtin_amdgcn_s_waitcnt(0);
        unsigned nloc = b.st[0], nx = b.st[1];
        if (nloc == 0u) { xcd_barrier_complete(bar, b.x, nloc, nx); b.st[0] = nloc; b.st[1] = nx; }
        const unsigned old = xb_add(&bar[XB_XSUB(b.x)], 1u);
        const unsigned gen = old / nloc;
        if (old + 1u == (gen + 1u) * nloc) {
            __builtin_amdgcn_fence(__ATOMIC_RELEASE, "agent");
            asm volatile("s_waitcnt vmcnt(0)" ::: "memory");
            const unsigned og = xb_add(&bar[XB_TOP], 1u);
            const unsigned tg = og / nx;
            if (og + 1u == (tg + 1u) * nx) xb_add(&bar[XB_TOPGEN], 1u);
            else XB_SPIN(xb_ld(&bar[XB_TOPGEN]) == tg, bar);
            __builtin_amdgcn_fence(__ATOMIC_ACQUIRE, "agent");
            xb_add(&bar[XB_XGEN(b.x)], 1u);
            asm volatile("s_waitcnt vmcnt(0)" ::: "memory");
        } else {
            XB_SPIN(xb_ld(&bar[XB_XGEN(b.x)]) == gen, bar);
            __builtin_amdgcn_fence(__ATOMIC_ACQUIRE, "agent");
            asm volatile("s_waitcnt vmcnt(0)" ::: "memory");
        }
    }
    __syncthreads();
}

typedef float f32x2 __attribute__((ext_vector_type(2)));
using pg8::lane_now; using pg8::shx;
__device__ __forceinline__ float wave_sum(float v) {
    const int ln = lane_now();
#pragma unroll
    for (int o = 1; o < 64; o <<= 1) v += shx(v, o, ln);
    return v;
}
__device__ __forceinline__ float wave_max(float v) {
    const int ln = lane_now();
#pragma unroll
    for (int o = 1; o < 64; o <<= 1) v = fmaxf(v, shx(v, o, ln));
    return v;
}
__device__ __forceinline__ float bf2f(unsigned short h) { return __uint_as_float((unsigned)h << 16); }
__device__ __forceinline__ float silu_f(float x) { return x / (1.0f + __expf(-x)); }
__device__ __forceinline__ f32x4 bf4_to_f32(unsigned long long v) { return (f32x4){__uint_as_float((unsigned)(v & 0xffffu) << 16), __uint_as_float((unsigned)(v >> 16) << 16), __uint_as_float((unsigned)((v >> 32) & 0xffffu) << 16), __uint_as_float((unsigned)(v >> 48) << 16)}; }
__device__ __forceinline__ unsigned long long f32_to_bf4(f32x4 y) { return (unsigned long long)pk2(y.x, y.y) | ((unsigned long long)pk2(y.z, y.w) << 32); }
__device__ __forceinline__ int mod_row(int m) { const int b = m / TB; return (m - b * TB < CTXL) ? 8 : b; }

__device__ __forceinline__ void transpose_item(const float* W, int K, int N, bf16* WT, int k0, int n0, int dst_row0, LAS float* scr, int lane) {
#pragma unroll 8
    for (int i = 0; i < 32; ++i) { const int kk = 2 * i + (lane >> 5); scr[kk * 33 + (lane & 31)] = W[(size_t)(k0 + kk) * N + n0 + (lane & 31)]; }
    LDS_WAIT(); asm volatile("" ::: "memory");
    const int c = lane & 7;
#pragma unroll
    for (int j = 0; j < 4; ++j) { const int n = (lane >> 3) + 8 * j; const LAS float* s = scr + (8 * c) * 33 + n;
        v4u o; o.x = pk2(s[0 * 33], s[1 * 33]); o.y = pk2(s[2 * 33], s[3 * 33]); o.z = pk2(s[4 * 33], s[5 * 33]); o.w = pk2(s[6 * 33], s[7 * 33]);
        *(GAS v4u*)(WT + (size_t)(dst_row0 + n) * K + k0 + 8 * c) = o; }
    LDS_WAIT(); asm volatile("" ::: "memory");
}

__device__ __forceinline__ void transpose_item8(const float* W, int K, int N, unsigned char* WT8, int k0, int n0, int dst_row0, LAS float* scr, int lane) {
#pragma unroll 8
    for (int i = 0; i < 32; ++i) { const int kk = 2 * i + (lane >> 5); scr[kk * 33 + (lane & 31)] = W[(size_t)(k0 + kk) * N + n0 + (lane & 31)]; }
    LDS_WAIT(); asm volatile("" ::: "memory");
    const int n = lane & 31;
#pragma unroll
    for (int q = 0; q < 2; ++q) { const int ch = (lane >> 5) + 2 * q; const LAS float* s = scr + (16 * ch) * 33 + n;
        v4u o;
        o.x = pg8::pk4_fp8(s[0 * 33] * 32.f, s[1 * 33] * 32.f, s[2 * 33] * 32.f, s[3 * 33] * 32.f); o.y = pg8::pk4_fp8(s[4 * 33] * 32.f, s[5 * 33] * 32.f, s[6 * 33] * 32.f, s[7 * 33] * 32.f);
        o.z = pg8::pk4_fp8(s[8 * 33] * 32.f, s[9 * 33] * 32.f, s[10 * 33] * 32.f, s[11 * 33] * 32.f); o.w = pg8::pk4_fp8(s[12 * 33] * 32.f, s[13 * 33] * 32.f, s[14 * 33] * 32.f, s[15 * 33] * 32.f);
        *(GAS v4u*)(WT8 + (size_t)(dst_row0 + n) * K + k0 + 16 * ch) = o; }
    LDS_WAIT(); asm volatile("" ::: "memory");
}

struct Args { const float* in[25]; float* out; unsigned char* ws; int ph_lo, ph_hi; };
constexpr int P_N1G = 0, P_N2G = 4096, P_QG = 8192, P_KG = 8320, P_GKF = 8448, P_GKB = 24832, P_BGF = 41216, P_BGB = 42240, P_OG = 43264, P_WR = 43776, P_BR = 174848, P_BGU = 174976, P_BDN = 437120, P_END = 568192;
#define LAUNDER_S(p) asm volatile("" : "+s"(p))
#define LAUNDER_V(p) asm volatile("" : "+v"(p))
#define PARF(ws) ((const float*)((ws) + WS_PAR))

__device__ __forceinline__ void p0_prologue(const Args& A, LAS unsigned char* lds, int gw, int NGW, int wave, int lane) {
    unsigned char* ws = A.ws;
    LAS float* scr = (LAS float*)(lds + RING_OFF + wave * 16384);
    constexpr int I_QKV = 2 * 16 * (QKVN / 32), I_WO = 2 * 16 * 32, I_WIN = 2 * 16 * (WINN / 32), I_GU = 128 * 16 * 64, I_DN = 128 * 16 * 32;
    constexpr int NITEMS = I_GU + I_DN + I_QKV + I_WO + I_WIN + I_WO;
    for (int it = gw; it < NITEMS; it += NGW) {
        int r = it;
        if (r < I_GU) { const int mat = r / (16 * 64), q = r - mat * (16 * 64), kb = q / 64, nb = q - kb * 64, n0 = nb * 32;
            const int dst = ((n0 & 1023) >> 7) * 256 + (n0 >> 10) * 128 + (n0 & 127);
            transpose_item8(A.in[21] + (size_t)mat * 1024 * 2048, 1024, 2048, ws + WS_WGU + (size_t)mat * 2048 * 1024, kb * 64, n0, dst, scr, lane); continue; } r -= I_GU;
        if (r < I_DN) { const int mat = r / (16 * 32), q = r - mat * (16 * 32), kb = q / 32, nb = q - kb * 32;
            transpose_item8(A.in[23] + (size_t)mat * 1024 * 1024, 1024, 1024, ws + WS_WDN + (size_t)mat * 1024 * 1024, kb * 64, nb * 32, nb * 32, scr, lane); continue; } r -= I_DN;
        if (r < I_QKV) { const int per = 16 * (QKVN / 32), mat = r / per, q = r - mat * per, kb = q / (QKVN / 32), nb = q - kb * (QKVN / 32);
            const int n0 = nb * 32, dst = (n0 & ~255) + ((n0 >> 5) & 1) * 128 + ((n0 >> 6) & 3) * 32;
            transpose_item(A.in[8] + (size_t)mat * 1024 * QKVN, 1024, QKVN, (bf16*)(ws + WS_WQKV) + (size_t)mat * QKVN * 1024, kb * 64, n0, dst, scr, lane); continue; } r -= I_QKV;
        if (r < I_WO) { const int mat = r / 512, q = r - mat * 512, kb = q / 32, nb = q - kb * 32;
            transpose_item(A.in[11] + (size_t)mat * 1024 * 1024, 1024, 1024, (bf16*)(ws + WS_WOA) + (size_t)mat * 1024 * 1024, kb * 64, nb * 32, nb * 32, scr, lane); continue; } r -= I_WO;
        if (r < I_WIN) { const int per = 16 * (WINN / 32), mat = r / per, q = r - mat * per, kb = q / (WINN / 32), nb = q - kb * (WINN / 32);
            transpose_item(A.in[12] + (size_t)mat * 1024 * WINN, 1024, WINN, (bf16*)(ws + WS_WIN) + (size_t)mat * WINP * 1024, kb * 64, nb * 32, nb * 32, scr, lane); continue; } r -= I_WIN;
        { const int mat = r / 512, q = r - mat * 512, kb = q / 32, nb = q - kb * 32;
            transpose_item(A.in[18] + (size_t)mat * 1024 * 1024, 1024, 1024, (bf16*)(ws + WS_WOG) + (size_t)mat * 1024 * 1024, kb * 64, nb * 32, nb * 32, scr, lane); }
    }
    for (int it = gw; it < 2 * (WINP - WINN); it += NGW) { const int mat = it / (WINP - WINN), rr = WINN + it - mat * (WINP - WINN);
        GAS v4u* p = (GAS v4u*)((bf16*)(ws + WS_WIN) + ((size_t)mat * WINP + rr) * 1024) + lane; p[0] = (v4u){0u, 0u, 0u, 0u}; p[64] = (v4u){0u, 0u, 0u, 0u}; }
    for (int it = gw; it < NLAYER * 24 * 16; it += NGW) {
        const int l = it / (24 * 16), q = it - l * (24 * 16), cg = q / 16, kc = q - cg * 16;
        float s[MODROWS];
#pragma unroll
        for (int r = 0; r < MODROWS; ++r) { const float cv = (r < 8) ? A.in[1][r * 1024 + kc * 64 + lane] : A.in[3][kc * 64 + lane]; s[r] = silu_f(cv); }
        f32x4 acc[MODROWS];
#pragma unroll
        for (int r = 0; r < MODROWS; ++r) acc[r] = (f32x4){0.f, 0.f, 0.f, 0.f};
        const float* wp = A.in[4] + ((size_t)l * 1024 + kc * 64) * NMODC + cg * 256 + 4 * lane;
#pragma unroll 4
        for (int kk = 0; kk < 64; ++kk) { const f32x4 w = *(const f32x4*)(wp + (size_t)kk * NMODC);
#pragma unroll
            for (int r = 0; r < MODROWS; ++r) { const float sv = __shfl(s[r], kk); acc[r] = acc[r] + w * sv; } }
        float* op = (float*)(ws + WS_MODP) + (size_t)kc * (NLAYER * MODROWS * NMODC) + (size_t)l * MODROWS * NMODC + cg * 256 + 4 * lane;
#pragma unroll
        for (int r = 0; r < MODROWS; ++r) *(f32x4*)(op + (size_t)r * NMODC) = acc[r];
    }
    for (int m = gw; m < MT; m += NGW) { const int b = m / TB, w = m - b * TB;
        const float* src = (w < CTXL) ? A.in[2] + ((size_t)b * CTXL + w) * 1024 : A.in[0] + ((size_t)b * SEQ + (w - CTXL)) * 1024;
        const GAS f32x4* sp = (const GAS f32x4*)src + lane; GAS unsigned long long* dp = (GAS unsigned long long*)((bf16*)(ws + WS_X) + (size_t)m * 1024) + lane;
#pragma unroll
        for (int j = 0; j < 4; ++j) dp[64 * j] = f32_to_bf4(sp[64 * j]); }
    { float* par = (float*)(ws + WS_PAR); const int gt = gw * 64 + lane, NGT = NGW * 64;
#define CPY(src, n, off) for (int i = gt; i < (n); i += NGT) par[(off) + i] = A.in[src][i];
      CPY(6, 4096, P_N1G) CPY(7, 4096, P_N2G) CPY(9, 128, P_QG) CPY(10, 128, P_KG) CPY(13, 16384, P_GKF) CPY(15, 16384, P_GKB) CPY(14, 1024, P_BGF) CPY(16, 1024, P_BGB)
      CPY(17, 512, P_OG) CPY(19, 131072, P_WR) CPY(20, 128, P_BR) CPY(22, 262144, P_BGU) CPY(24, 131072, P_BDN)
#undef CPY
    }
    for (int idx = gw * 64 + lane; idx < SEQ * 32; idx += NGW * 64) { const int s = idx >> 5, i = idx & 31;
        const float invf = 1.0f / powf(10000.0f, (float)(i & 15) * (1.0f / 16.0f));
        const float ang = (float)((i < 16) ? (s >> 6) : (s & 63)) * invf;
        ((float*)(ws + WS_ROPE))[idx] = cosf(ang); ((float*)(ws + WS_ROPE))[SEQ * 32 + idx] = sinf(ang); }
}
__device__ __forceinline__ void p1_mod_reduce(const Args& A, int gtid, int NGT) {
    const float* P = (const float*)(A.ws + WS_MODP); float* Mo = (float*)(A.ws + WS_MOD);
    constexpr int N = NLAYER * MODROWS * NMODC;
    for (int i = gtid; i < N; i += NGT) { const int l = i / (MODROWS * NMODC), c = i % NMODC; float s = A.in[5][l * NMODC + c];
#pragma unroll
        for (int k = 0; k < 16; ++k) s += P[(size_t)k * N + i];
        Mo[i] = s; }
}
__device__ __forceinline__ void modulate_row(const bf16* xrow, const float* ng, const float* shp, const float* scp, bf16* orow, int lane, f32x4 (&y)[4], float& rs_out) {
    const GAS unsigned long long* xr = (const GAS unsigned long long*)xrow + lane;
    float ss = 0.f;
#pragma unroll
    for (int j = 0; j < 4; ++j) { y[j] = bf4_to_f32(xr[64 * j]); ss += (y[j].x * y[j].x + y[j].y * y[j].y) + (y[j].z * y[j].z + y[j].w * y[j].w); }
    const float rs = 1.0f / sqrtf(wave_sum(ss) * (1.0f / 1024.0f) + RMS_EPS); rs_out = rs;
    GAS unsigned long long* o8 = (GAS unsigned long long*)orow + lane;
#pragma unroll
    for (int j = 0; j < 4; ++j) { const f32x4 g = ((const GAS f32x4*)ng)[64 * j + lane], sh = ((const GAS f32x4*)shp)[64 * j + lane], sc = ((const GAS f32x4*)scp)[64 * j + lane];
        y[j] = (y[j] * rs) * g * (sc + 1.0f) + sh;
        o8[64 * j] = (unsigned long long)pk2(y[j].x, y[j].y) | ((unsigned long long)pk2(y[j].z, y[j].w) << 32); }
}
__device__ __forceinline__ void modulate_row2(const bf16* xa, const bf16* xb, const float* ng, const float* sha, const float* sca, const float* shb, const float* scb, unsigned char* oa, unsigned char* ob, int lane, float& rsa, float& rsb) {
    const GAS unsigned long long* pa = (const GAS unsigned long long*)xa + lane; const GAS unsigned long long* pb = (const GAS unsigned long long*)xb + lane;
    unsigned long long ra[4], rb[4];
#pragma unroll
    for (int j = 0; j < 4; ++j) { ra[j] = pa[64 * j]; rb[j] = pb[64 * j]; }
    f32x4 ya[4], yb[4]; float sa = 0.f, sb = 0.f;
#pragma unroll
    for (int j = 0; j < 4; ++j) { ya[j] = bf4_to_f32(ra[j]); yb[j] = bf4_to_f32(rb[j]); sa += (ya[j].x * ya[j].x + ya[j].y * ya[j].y) + (ya[j].z * ya[j].z + ya[j].w * ya[j].w); sb += (yb[j].x * yb[j].x + yb[j].y * yb[j].y) + (yb[j].z * yb[j].z + yb[j].w * yb[j].w); }
    const int ln = lane_now();
#pragma unroll
    for (int o = 1; o < 64; o <<= 1) { sa += shx(sa, o, ln); sb += shx(sb, o, ln); }
    rsa = 1.0f / sqrtf(sa * (1.0f / 1024.0f) + RMS_EPS); rsb = 1.0f / sqrtf(sb * (1.0f / 1024.0f) + RMS_EPS);
    GAS unsigned* qa = (GAS unsigned*)oa + lane; GAS unsigned* qb = (GAS unsigned*)ob + lane;
#pragma unroll
    for (int j = 0; j < 4; ++j) { const f32x4 g = ((const GAS f32x4*)ng)[64 * j + lane];
        const f32x4 ha = ((const GAS f32x4*)sha)[64 * j + lane], ca = ((const GAS f32x4*)sca)[64 * j + lane], hb = ((const GAS f32x4*)shb)[64 * j + lane], cb = ((const GAS f32x4*)scb)[64 * j + lane];
        const f32x4 va = (ya[j] * rsa) * g * (ca + 1.0f) + ha, vb = (yb[j] * rsb) * g * (cb + 1.0f) + hb;
        qa[64 * j] = pg8::pk4_fp8(va.x, va.y, va.z, va.w); qb[64 * j] = pg8::pk4_fp8(vb.x, vb.y, vb.z, vb.w); }
}
__device__ __forceinline__ void phase_modulate1(unsigned char* ws, int layer, int gw, int NGW, int lane) {
    const bf16* X = (const bf16*)(ws + WS_X); bf16* XN = (bf16*)(ws + WS_XN);
    const float* ng = PARF(ws) + P_N1G + layer * 1024; const float* Mo = (const float*)(ws + WS_MOD) + (size_t)layer * MODROWS * NMODC;
    for (int m = gw; m < MT; m += NGW) { const int mr = mod_row(m); f32x4 y[4]; float rs;
        modulate_row(X + (size_t)m * 1024, ng, Mo + (size_t)mr * NMODC + 0 * 1024, Mo + (size_t)mr * NMODC + 1 * 1024, XN + (size_t)m * 1024, lane, y, rs); }
}
__device__ __forceinline__ void phase_qknorm_rope(unsigned char* ws, int la, int gw, int NGW, int lane) {
    bf16* Qb = (bf16*)(ws + WS_Q); bf16* Kb = (bf16*)(ws + WS_K);
    const float* qg = PARF(ws) + P_QG + la * 64; const float* kg = PARF(ws) + P_KG + la * 64; const float* ropec = (const float*)(ws + WS_ROPE); const float* ropes = ropec + SEQ * 32;
    const int i = lane & 31, hs = lane >> 5;
    for (int m = gw; m < MT; m += NGW) { const int b = m / TB, w = m - b * TB; const bool lat = w >= CTXL;
        float cs = 1.f, sn = 0.f; if (lat) { cs = ropec[(w - CTXL) * 32 + i]; sn = ropes[(w - CTXL) * 32 + i]; }
#pragma unroll 2
        for (int hh = 0; hh < 20; hh += 2) { const int hd = hh + hs;
            unsigned* p = (hd < 16) ? (unsigned*)(Qb + (size_t)m * 1024 + hd * 64) + i : (unsigned*)(Kb + (size_t)m * 256 + (hd - 16) * 64) + i;
            const float* gp = (hd < 16) ? qg : kg; const float scl = (hd < 16) ? ATT_C2 : 1.0f;
            const unsigned v = *p; const float x1 = __uint_as_float(v << 16), x2 = __uint_as_float(v & 0xffff0000u);
            float ss = x1 * x1 + x2 * x2;
#pragma unroll
            for (int o = 1; o < 32; o <<= 1) ss += shx(ss, o, lane);
            const float rs = 1.0f / sqrtf(ss * (1.0f / 64.0f) + RMS_EPS);
            const float y1 = x1 * rs * gp[2 * i], y2 = x2 * rs * gp[2 * i + 1];
            const float r1 = (y1 * cs - y2 * sn) * scl, r2 = (y1 * sn + y2 * cs) * scl;
            *p = pk2(r1, r2); }
    }
}
__device__ __forceinline__ void phase_gla_recurrent(unsigned char* ws, int lg, LAS unsigned char* lds, int tid) {
    const int unit = blockIdx.x; if (unit >= 128) return;
    const int half = unit & 1, dir = (unit >> 1) & 1, h = (unit >> 2) & 3, b = unit >> 4;
    const bf16* G = (const bf16*)(ws + WS_G);
    float* Oo = (float*)(ws + (dir ? WS_OB : WS_OF));
    const float* wg = PARF(ws) + (dir ? P_GKB : P_GKF) + (size_t)lg * 16 * 512; const float* bg = PARF(ws) + (dir ? P_BGB : P_BGF) + lg * 512;
    LAS float* qq = (LAS float*)(lds + RING_OFF); LAS float* kk = qq + 64 * 128; LAS float* dd = kk + 64 * 128; LAS float* vv = dd + 64 * 128;
    const int sd = tid & 127, st0 = tid >> 7;
    float wcol[16];
#pragma unroll
    for (int r = 0; r < 16; ++r) wcol[r] = wg[r * 512 + h * 128 + sd];
    const float bcol = bg[h * 128 + sd];
    const int c = tid >> 2, dq = tid & 3;
    float s[32];
#pragma unroll
    for (int j = 0; j < 32; ++j) s[j] = 0.f;
    const float qscale = 0.08838834764831845f;
    for (int ch = 0; ch < TB / 64; ++ch) {
        __syncthreads();
#pragma unroll 4
        for (int i = 0; i < 16; ++i) { const int tt = st0 + 4 * i, n = 64 * ch + tt;
            const int w = dir ? (n < CTXL ? (CTXL - 1 - n) : (TB + CTXL - 1 - n)) : n;
            const bf16* gr = G + ((size_t)b * TB + w) * WINP;
            const float qv = bf2f(gr[h * 128 + sd]) * qscale, kv = bf2f(gr[512 + h * 128 + sd]);
            const bf16* lp = gr + 3072 + dir * 16; float z = bcol;
#pragma unroll
            for (int r = 0; r < 16; ++r) z += bf2f(lp[r]) * wcol[r];
            const float ls = fminf(z, 0.f) - log1pf(__expf(-fabsf(z)));
            qq[tt * 128 + sd] = qv; kk[tt * 128 + sd] = kv; dd[tt * 128 + sd] = __expf(ls * (1.0f / 16.0f));
            vv[tt * 128 + sd] = bf2f(gr[1024 + h * 256 + half * 128 + sd]); }
        __syncthreads();
        for (int tt = 0; tt < 64; ++tt) { const int n = 64 * ch + tt; const int w = dir ? (n < CTXL ? (CTXL - 1 - n) : (TB + CTXL - 1 - n)) : n;
            const float v = vv[tt * 128 + c]; float acc = 0.f;
            const LAS f32x4* q4 = (const LAS f32x4*)(qq + tt * 128 + dq * 32); const LAS f32x4* k4 = (const LAS f32x4*)(kk + tt * 128 + dq * 32); const LAS f32x4* d4 = (const LAS f32x4*)(dd + tt * 128 + dq * 32);
#pragma unroll
            for (int j = 0; j < 8; ++j) { const f32x4 qv = q4[j], kv = k4[j], dv = d4[j];
                s[4 * j + 0] = s[4 * j + 0] * dv.x + kv.x * v; acc += qv.x * s[4 * j + 0];
                s[4 * j + 1] = s[4 * j + 1] * dv.y + kv.y * v; acc += qv.y * s[4 * j + 1];
                s[4 * j + 2] = s[4 * j + 2] * dv.z + kv.z * v; acc += qv.z * s[4 * j + 2];
                s[4 * j + 3] = s[4 * j + 3] * dv.w + kv.w * v; acc += qv.w * s[4 * j + 3]; }
            acc += shx(acc, 1, tid & 63); acc += shx(acc, 2, tid & 63);
            if (dq == 0) Oo[((size_t)b * TB + w) * 1024 + h * 256 + half * 128 + c] = acc; }
    }
}
__device__ __forceinline__ void phase_gla_readout(unsigned char* ws, int lg, int gw, int NGW, int lane) {
    const float* OF = (const float*)(ws + WS_OF); const float* OB = (const float*)(ws + WS_OB); const bf16* G = (const bf16*)(ws + WS_G); bf16* OG = (bf16*)(ws + WS_Q);
    const f32x4 og = ((const GAS f32x4*)(PARF(ws) + P_OG + lg * 256))[lane];
    for (int m = gw; m < MT; m += NGW) {
#pragma unroll
        for (int hh = 0; hh < 4; ++hh) { const size_t off = (size_t)m * 1024 + hh * 256 + 4 * lane;
            f32x4 o = *(const GAS f32x4*)(OF + off) + *(const GAS f32x4*)(OB + off);
            const float ss = wave_sum((o.x * o.x + o.y * o.y) + (o.z * o.z + o.w * o.w));
            const float rs = 1.0f / sqrtf(ss * (1.0f / 256.0f) + RMS_EPS);
            const unsigned long long rv = *(const GAS unsigned long long*)(G + (size_t)m * WINP + 2048 + hh * 256 + 4 * lane);
            const float r0 = __uint_as_float((unsigned)(rv & 0xffffu) << 16), r1 = __uint_as_float((unsigned)(rv >> 16) << 16), r2 = __uint_as_float((unsigned)((rv >> 32) & 0xffffu) << 16), r3 = __uint_as_float((unsigned)(rv >> 48) << 16);
            o = o * rs * og;
            o.x *= silu_f(r0); o.y *= silu_f(r1); o.z *= silu_f(r2); o.w *= silu_f(r3);
            *(GAS unsigned long long*)(OG + off) = (unsigned long long)pk2(o.x, o.y) | ((unsigned long long)pk2(o.z, o.w) << 32); }
    }
}
constexpr size_t WS_GQ = WS_XG, WS_GKH = WS_XG + 68 * MiB, WS_GKT = WS_XG + 136 * MiB, WS_GVT = WS_XG + 204 * MiB, WS_GDL = WS_ACT, WS_SX = WS_OF;
static_assert((size_t)2176 * 2 * 16384 <= 68 * MiB && (size_t)2176 * 256 * 64 * 2 <= 68 * MiB && (size_t)64 * 68 * 65536 <= 272 * MiB, "gla buffers");
typedef float f32x16 __attribute__((ext_vector_type(16)));
__device__ __forceinline__ float log_sigmoid_fast(float z) { return fminf(z, 0.f) - __logf(1.0f + __expf(-fabsf(z))); }

struct G0Raw { unsigned qk[8][2]; v4u lfb; };
__device__ __forceinline__ void g0_load(G0Raw& R, unsigned char* ws, int cn, int tid) {
    const bf16* G = (const bf16*)(ws + WS_G);
    const int d2 = tid & 63, tb = tid >> 6, n = cn % 68, bh = cn / 68, h = bh & 3, b = bh >> 2;
    const size_t r0 = (size_t)b * TB + 64 * n;
#pragma unroll
    for (int j = 0; j < 8; ++j) { const bf16* gr = G + (r0 + 8 * tb + j) * WINP; R.qk[j][0] = *(const GAS unsigned*)(gr + h * 128 + 2 * d2); R.qk[j][1] = *(const GAS unsigned*)(gr + 512 + h * 128 + 2 * d2); }
    R.lfb = *(const GAS v4u*)(G + (r0 + ((tid & 255) >> 2)) * WINP + 3072 + 8 * (tid & 3));
}
__device__ __forceinline__ void phase_gla_g0(unsigned char* ws, int lg, LAS unsigned char* lds, int tid) {
    LAS float* tot = (LAS float*)(lds + RING_OFF);
    LAS unsigned char* lfl = lds + RING_OFF + 8192;
    const int d2 = tid & 63, tb = tid >> 6;
    if ((int)blockIdx.x >= 2176) return;
    G0Raw R; g0_load(R, ws, blockIdx.x, tid);
    for (int cn = blockIdx.x; cn < 2176; cn += gridDim.x) {
        const int n = cn % 68, bh = cn / 68, h = bh & 3, b = bh >> 2;
        float wf0[16], wf1[16], wb0[16], wb1[16];
        { const float* wgf = PARF(ws) + P_GKF + (size_t)lg * 16 * 512 + h * 128 + 2 * d2; const float* wgb = PARF(ws) + P_GKB + (size_t)lg * 16 * 512 + h * 128 + 2 * d2;
#pragma unroll
          for (int r = 0; r < 16; ++r) { const f32x2 a = *(const GAS f32x2*)(wgf + r * 512), c = *(const GAS f32x2*)(wgb + r * 512); wf0[r] = a.x; wf1[r] = a.y; wb0[r] = c.x; wb1[r] = c.y; } }
        const f32x2 bf_ = *(const GAS f32x2*)(PARF(ws) + P_BGF + lg * 512 + h * 128 + 2 * d2), bb_ = *(const GAS f32x2*)(PARF(ws) + P_BGB + lg * 512 + h * 128 + 2 * d2);
        __syncthreads();
        if (tid < 256) *(LAS v4u*)(lfl + tid * 16) = R.lfb;
        unsigned qk[8][2];
#pragma unroll
        for (int j = 0; j < 8; ++j) { qk[j][0] = R.qk[j][0]; qk[j][1] = R.qk[j][1]; }
        __syncthreads();
        if (cn + (int)gridDim.x < 2176) g0_load(R, ws, cn + (int)gridDim.x, tid);
        float gf0[8], gf1[8], gb0[8], gb1[8];
#pragma unroll
        for (int j = 0; j < 8; ++j) { const LAS v4u* lp = (const LAS v4u*)(lfl + (8 * tb + j) * 64);
            const v4u l0 = lp[0], l1 = lp[1], l2 = lp[2], l3 = lp[3];
            float lf[16], lb[16];
            lf[0] = __uint_as_float(l0.x << 16); lf[1] = __uint_as_float(l0.x & 0xffff0000u); lf[2] = __uint_as_float(l0.y << 16); lf[3] = __uint_as_float(l0.y & 0xffff0000u);
            lf[4] = __uint_as_float(l0.z << 16); lf[5] = __uint_as_float(l0.z & 0xffff0000u); lf[6] = __uint_as_float(l0.w << 16); lf[7] = __uint_as_float(l0.w & 0xffff0000u);
            lf[8] = __uint_as_float(l1.x << 16); lf[9] = __uint_as_float(l1.x & 0xffff0000u); lf[10] = __uint_as_float(l1.y << 16); lf[11] = __uint_as_float(l1.y & 0xffff0000u);
            lf[12] = __uint_as_float(l1.z << 16); lf[13] = __uint_as_float(l1.z & 0xffff0000u); lf[14] = __uint_as_float(l1.w << 16); lf[15] = __uint_as_float(l1.w & 0xffff0000u);
            lb[0] = __uint_as_float(l2.x << 16); lb[1] = __uint_as_float(l2.x & 0xffff0000u); lb[2] = __uint_as_float(l2.y << 16); lb[3] = __uint_as_float(l2.y & 0xffff0000u);
            lb[4] = __uint_as_float(l2.z << 16); lb[5] = __uint_as_float(l2.z & 0xffff0000u); lb[6] = __uint_as_float(l2.w << 16); lb[7] = __uint_as_float(l2.w & 0xffff0000u);
            lb[8] = __uint_as_float(l3.x << 16); lb[9] = __uint_as_float(l3.x & 0xffff0000u); lb[10] = __uint_as_float(l3.y << 16); lb[11] = __uint_as_float(l3.y & 0xffff0000u);
            lb[12] = __uint_as_float(l3.z << 16); lb[13] = __uint_as_float(l3.z & 0xffff0000u); lb[14] = __uint_as_float(l3.w << 16); lb[15] = __uint_as_float(l3.w & 0xffff0000u);
            float zf0 = bf_.x, zf1 = bf_.y, zb0 = bb_.x, zb1 = bb_.y;
#pragma unroll
            for (int r = 0; r < 16; ++r) { zf0 += lf[r] * wf0[r]; zf1 += lf[r] * wf1[r]; zb0 += lb[r] * wb0[r]; zb1 += lb[r] * wb1[r]; }
            gf0[j] = log_sigmoid_fast(zf0) * 0.0625f; gf1[j] = log_sigmoid_fast(zf1) * 0.0625f; gb0[j] = log_sigmoid_fast(zb0) * 0.0625f; gb1[j] = log_sigmoid_fast(zb1) * 0.0625f; }
#pragma unroll
        for (int j = 1; j < 8; ++j) { gf0[j] += gf0[j - 1]; gf1[j] += gf1[j - 1]; gb0[7 - j] += gb0[8 - j]; gb1[7 - j] += gb1[8 - j]; }
        *(LAS f32x2*)(tot + (0 * 8 + tb) * 128 + 2 * d2) = (f32x2){gf0[7], gf1[7]}; *(LAS f32x2*)(tot + (1 * 8 + tb) * 128 + 2 * d2) = (f32x2){gb0[0], gb1[0]};
        __syncthreads();
        float pf0 = 0.f, pf1 = 0.f, pb0 = 0.f, pb1 = 0.f, lf0 = 0.f, lf1 = 0.f, lb0 = 0.f, lb1 = 0.f;
#pragma unroll
        for (int q = 0; q < 8; ++q) { const f32x2 a = *(const LAS f32x2*)(tot + (0 * 8 + q) * 128 + 2 * d2), c = *(const LAS f32x2*)(tot + (1 * 8 + q) * 128 + 2 * d2);
            lf0 += a.x; lf1 += a.y; lb0 += c.x; lb1 += c.y;
            if (q < tb) { pf0 += a.x; pf1 += a.y; } if (q > tb) { pb0 += c.x; pb1 += c.y; } }
        const size_t itf = (size_t)cn * 2, itb = itf + 1;
        bf16* Qf = (bf16*)(ws + WS_GQ) + itf * 8192; bf16* Qb = Qf + 8192; bf16* Kf = (bf16*)(ws + WS_GKH) + itf * 8192; bf16* Kb = Kf + 8192;
        const float elf0 = __expf(lf0), elf1 = __expf(lf1), elb0 = __expf(lb0), elb1 = __expf(lb1);
        float ktf0[8], ktf1[8], ktb0[8], ktb1[8];
#pragma unroll
        for (int j = 0; j < 8; ++j) { const int t = 8 * tb + j;
            const float q0 = __uint_as_float(qk[j][0] << 16) * 0.08838834764831845f, q1 = __uint_as_float(qk[j][0] & 0xffff0000u) * 0.08838834764831845f;
            const float k0 = __uint_as_float(qk[j][1] << 16), k1 = __uint_as_float(qk[j][1] & 0xffff0000u);
            const float ef0 = __expf(pf0 + gf0[j]), ef1 = __expf(pf1 + gf1[j]), eb0 = __expf(pb0 + gb0[j]), eb1 = __expf(pb1 + gb1[j]);
            const float rf0 = __builtin_amdgcn_rcpf(ef0), rf1 = __builtin_amdgcn_rcpf(ef1), rb0 = __builtin_amdgcn_rcpf(eb0), rb1 = __builtin_amdgcn_rcpf(eb1);
            *(GAS unsigned*)(Qf + t * 128 + 2 * d2) = pk2(q0 * ef0, q1 * ef1); *(GAS unsigned*)(Qb + t * 128 + 2 * d2) = pk2(q0 * eb0, q1 * eb1);
            *(GAS unsigned*)(Kf + t * 128 + 2 * d2) = pk2(k0 * rf0, k1 * rf1); *(GAS unsigned*)(Kb + t * 128 + 2 * d2) = pk2(k0 * rb0, k1 * rb1);
            ktf0[j] = k0 * rf0 * elf0; ktf1[j] = k1 * rf1 * elf1; ktb0[j] = k0 * rb0 * elb0; ktb1[j] = k1 * rb1 * elb1; }
        {
          unsigned char* Tf = ws + WS_GKT + itf * 16384 + (size_t)((((tb >> 1) * 4 + (d2 >> 4)) * 64 + ((2 * d2) & 31)) * 16 + 8 * (tb & 1)); unsigned char* Tb = Tf + 16384;
          *(GAS unsigned long long*)(Tf) = (unsigned long long)pk2(ktf0[0], ktf0[1]) | ((unsigned long long)pk2(ktf0[2], ktf0[3]) << 32);
          *(GAS unsigned long long*)(Tf + 512) = (unsigned long long)pk2(ktf0[4], ktf0[5]) | ((unsigned long long)pk2(ktf0[6], ktf0[7]) << 32);
          *(GAS unsigned long long*)(Tf + 16) = (unsigned long long)pk2(ktf1[0], ktf1[1]) | ((unsigned long long)pk2(ktf1[2], ktf1[3]) << 32);
          *(GAS unsigned long long*)(Tf + 528) = (unsigned long long)pk2(ktf1[4], ktf1[5]) | ((unsigned long long)pk2(ktf1[6], ktf1[7]) << 32);
          *(GAS unsigned long long*)(Tb) = (unsigned long long)pk2(ktb0[0], ktb0[1]) | ((unsigned long long)pk2(ktb0[2], ktb0[3]) << 32);
          *(GAS unsigned long long*)(Tb + 512) = (unsigned long long)pk2(ktb0[4], ktb0[5]) | ((unsigned long long)pk2(ktb0[6], ktb0[7]) << 32);
          *(GAS unsigned long long*)(Tb + 16) = (unsigned long long)pk2(ktb1[0], ktb1[1]) | ((unsigned long long)pk2(ktb1[2], ktb1[3]) << 32);
          *(GAS unsigned long long*)(Tb + 528) = (unsigned long long)pk2(ktb1[4], ktb1[5]) | ((unsigned long long)pk2(ktb1[6], ktb1[7]) << 32); }
        if (tb == 0) { float* DLp = (float*)(ws + WS_GDL) + itf * 128 + 2 * d2; *(GAS f32x2*)DLp = (f32x2){elf0, elf1}; *(GAS f32x2*)(DLp + 128) = (f32x2){elb0, elb1}; }
        {
            const int dv = tid & 255, th = tid >> 8; const bf16* vp = (const bf16*)(ws + WS_G) + ((size_t)b * TB + 64 * n + 32 * th) * WINP + 1024 + h * 256 + dv;
            unsigned wv[16];
#pragma unroll
            for (int j = 0; j < 16; ++j) wv[j] = (unsigned)vp[(size_t)(2 * j) * WINP] | ((unsigned)vp[(size_t)(2 * j + 1) * WINP] << 16);
            unsigned char* vo = ws + WS_GVT + (size_t)cn * 32768 + (size_t)(((2 * th) * 8 + (dv >> 5)) * 64 + (dv & 31)) * 16;
#pragma unroll
            for (int ql = 0; ql < 2; ++ql)
#pragma unroll
                for (int hq = 0; hq < 2; ++hq) *(GAS v4u*)(vo + ql * 8192 + hq * 512) = (v4u){wv[8 * ql + 2 * hq], wv[8 * ql + 2 * hq + 1], wv[8 * ql + 2 * hq + 4], wv[8 * ql + 2 * hq + 5]}; }
    }
}
struct G12Ops { bf16x8 a[4], b[4]; f32x4 d[4]; };
__device__ __forceinline__ void g12_load(G12Ops& o, unsigned char* ws, int bh, int dir, int m, int kb, int vb, int r, int hh) {
    const int n = dir ? (m < 4 ? 3 - m : 71 - m) : m; const size_t cn = (size_t)bh * 68 + n, item = cn * 2 + dir;
    const GAS bf16x8* ap = (const GAS bf16x8*)(ws + WS_GKT + item * 16384) + kb * 64 + (hh * 32 + r);
    const GAS bf16x8* bp = (const GAS bf16x8*)(ws + WS_GVT + cn * 32768) + vb * 64 + (hh * 32 + r);
    const float* dp = (const float*)(ws + WS_GDL) + item * 128 + 32 * kb + 4 * hh;
#pragma unroll
    for (int ks = 0; ks < 4; ++ks) { o.a[ks] = ap[ks * 256]; o.b[ks] = bp[ks * 512]; o.d[ks] = *(const GAS f32x4*)(dp + 8 * ks); }
}
__device__ __forceinline__ void phase_gla_g12(unsigned char* ws, LAS unsigned char* lds, int gwv, int wave, int lane) {
    if (gwv >= 2048) return;
    const int chain = gwv >> 5, blk = gwv & 31, kb = blk & 3, vb = blk >> 2, dir = chain & 1, bh = chain >> 1;
    const int r = lane & 31, hh = lane >> 5;
    LAS unsigned char* wl = lds + RING_OFF + wave * 2048;
    f32x16 acc;
#pragma unroll
    for (int g = 0; g < 16; ++g) acc[g] = 0.f;
    G12Ops o0, o1, o2;
    g12_load(o0, ws, bh, dir, 0, kb, vb, r, hh); g12_load(o1, ws, bh, dir, 1, kb, vb, r, hh);
#define G12_STEP(CUR, m_) do { const int mm_ = (m_); const int n = dir ? (mm_ < 4 ? 3 - mm_ : 71 - mm_) : mm_; \
        _Pragma("unroll") for (int gg = 0; gg < 4; ++gg) *(LAS unsigned long long*)(wl + (((gg >> 1) * 64 + (gg & 1) * 32 + r) * 16 + 8 * hh)) = (unsigned long long)pk2(acc[4 * gg], acc[4 * gg + 1]) | ((unsigned long long)pk2(acc[4 * gg + 2], acc[4 * gg + 3]) << 32); \
        LDS_WAIT(); const v4u s0 = *(const LAS v4u*)(wl + lane * 16), s1 = *(const LAS v4u*)(wl + 1024 + lane * 16); LDS_WAIT(); \
        { bf16* sp = (bf16*)(ws + WS_SX) + ((size_t)(bh * 2 + dir) * 68 + n) * 32768 + (size_t)(kb * 8 + vb) * 1024; ((GAS v4u*)sp)[lane] = s0; ((GAS v4u*)sp)[64 + lane] = s1; } \
        _Pragma("unroll") for (int gg = 0; gg < 4; ++gg) { acc[4 * gg] *= CUR.d[gg].x; acc[4 * gg + 1] *= CUR.d[gg].y; acc[4 * gg + 2] *= CUR.d[gg].z; acc[4 * gg + 3] *= CUR.d[gg].w; } \
        _Pragma("unroll") for (int ks = 0; ks < 4; ++ks) acc = __builtin_amdgcn_mfma_f32_32x32x16_bf16(CUR.a[ks], CUR.b[ks], acc, 0, 0, 0); } while (0)
    for (int m = 0; m < 66; m += 3) {
        g12_load(o2, ws, bh, dir, m + 2, kb, vb, r, hh); G12_STEP(o0, m);
        g12_load(o0, ws, bh, dir, m + 3, kb, vb, r, hh); G12_STEP(o1, m + 1);
        g12_load(o1, ws, bh, dir, (m + 4 < 68) ? m + 4 : 67, kb, vb, r, hh); G12_STEP(o2, m + 2);
    }
    G12_STEP(o0, 66); G12_STEP(o1, 67);
#undef G12_STEP
}
constexpr int G3_RS = 272, G3_TILE = 64 * G3_RS, G3_OL = 4 * G3_TILE  , G3_LD = 260;
static_assert(G3_OL + 64 * G3_LD * 4 <= MISC_OFF, "G3 LDS");
__device__ __forceinline__ void phase_gla_g3(unsigned char* ws, int lg, LAS unsigned char* lds, int tid) {
    const int lane = tid & 63, wave = __builtin_amdgcn_readfirstlane(tid >> 6), r = lane & 31, hh = lane >> 5, vb = wave;
    LAS unsigned char* TL = lds + RING_OFF; LAS float* OL = (LAS float*)(lds + RING_OFF + G3_OL);
    const bf16* G = (const bf16*)(ws + WS_G); bf16* OG = (bf16*)(ws + WS_Q);
    for (int cn = blockIdx.x; cn < 2176; cn += gridDim.x) {
        const int n = cn % 68, bh = cn / 68, h = bh & 3, b = bh >> 2;
        v4u st[4][2];
#pragma unroll
        for (int tl = 0; tl < 4; ++tl) { const bf16* src = (const bf16*)(ws + ((tl & 1) ? WS_GKH : WS_GQ)) + ((size_t)cn * 2 + (tl >> 1)) * 8192;
#pragma unroll
            for (int j = 0; j < 2; ++j) st[tl][j] = ((const GAS v4u*)src)[tid + 512 * j]; }
        __syncthreads();
#pragma unroll
        for (int tl = 0; tl < 4; ++tl)
#pragma unroll
            for (int j = 0; j < 2; ++j) { const int q = tid + 512 * j, row = q >> 4, ch = q & 15; *(LAS v4u*)(TL + tl * G3_TILE + row * G3_RS + ch * 16) = st[tl][j]; }
        __syncthreads();
        f32x16 P00, P01, P10, P11, O0, O1;
#pragma unroll
        for (int g = 0; g < 16; ++g) { P00[g] = 0.f; P01[g] = 0.f; P10[g] = 0.f; P11[g] = 0.f; O0[g] = 0.f; O1[g] = 0.f; }
#pragma unroll
        for (int dir = 0; dir < 2; ++dir) {
            const LAS unsigned char* Qt = TL + (2 * dir) * G3_TILE + r * G3_RS + 16 * hh; const LAS unsigned char* Kh = TL + (2 * dir + 1) * G3_TILE + r * G3_RS + 16 * hh;
            const GAS bf16x8* Sx = (const GAS bf16x8*)((const bf16*)(ws + WS_SX) + ((size_t)(bh * 2 + dir) * 68 + n) * 32768 + (size_t)vb * 1024) + lane;
            f32x16 X00, X11, Xoff;
#pragma unroll
            for (int g = 0; g < 16; ++g) { X00[g] = 0.f; X11[g] = 0.f; Xoff[g] = 0.f; }
#pragma unroll
            for (int s = 0; s < 8; ++s) {
                const bf16x8 q0 = *(const LAS bf16x8*)(Qt + 32 * s), q1 = *(const LAS bf16x8*)(Qt + 32 * G3_RS + 32 * s);
                const bf16x8 k0 = *(const LAS bf16x8*)(Kh + 32 * s), k1 = *(const LAS bf16x8*)(Kh + 32 * G3_RS + 32 * s);
                const bf16x8 sx = Sx[(s >> 1) * 1024 + (s & 1) * 64];
                X00 = __builtin_amdgcn_mfma_f32_32x32x16_bf16(k0, q0, X00, 0, 0, 0);
                X11 = __builtin_amdgcn_mfma_f32_32x32x16_bf16(k1, q1, X11, 0, 0, 0);
                if (dir == 0) Xoff = __builtin_amdgcn_mfma_f32_32x32x16_bf16(k0, q1, Xoff, 0, 0, 0); else Xoff = __builtin_amdgcn_mfma_f32_32x32x16_bf16(k1, q0, Xoff, 0, 0, 0);
                O0 = __builtin_amdgcn_mfma_f32_32x32x16_bf16(q0, sx, O0, 0, 0, 0); O1 = __builtin_amdgcn_mfma_f32_32x32x16_bf16(q1, sx, O1, 0, 0, 0); }
#pragma unroll
            for (int g = 0; g < 16; ++g) { const int tj = (g & 3) + 8 * (g >> 2) + 4 * hh; const bool keep = dir ? (tj >= r) : (tj <= r);
                P00[g] += keep ? X00[g] : 0.f; P11[g] += keep ? X11[g] : 0.f;
                if (dir == 0) P01[g] += Xoff[g]; else P10[g] += Xoff[g]; }
        }
        { const GAS bf16x8* Vt = (const GAS bf16x8*)(ws + WS_GVT + (size_t)cn * 32768) + vb * 64 + lane;
#pragma unroll
          for (int jb = 0; jb < 2; ++jb)
#pragma unroll
            for (int s2 = 0; s2 < 2; ++s2) { const bf16x8 bfv = Vt[(2 * jb + s2) * 512];
                const f32x16& Pa = jb ? P10 : P00; const f32x16& Pb = jb ? P11 : P01;
                const bf16x8 a0 = __builtin_bit_cast(bf16x8, ((v4u){pk2(Pa[8 * s2 + 0], Pa[8 * s2 + 1]), pk2(Pa[8 * s2 + 2], Pa[8 * s2 + 3]), pk2(Pa[8 * s2 + 4], Pa[8 * s2 + 5]), pk2(Pa[8 * s2 + 6], Pa[8 * s2 + 7])}));
                const bf16x8 a1 = __builtin_bit_cast(bf16x8, ((v4u){pk2(Pb[8 * s2 + 0], Pb[8 * s2 + 1]), pk2(Pb[8 * s2 + 2], Pb[8 * s2 + 3]), pk2(Pb[8 * s2 + 4], Pb[8 * s2 + 5]), pk2(Pb[8 * s2 + 6], Pb[8 * s2 + 7])}));
                O0 = __builtin_amdgcn_mfma_f32_32x32x16_bf16(a0, bfv, O0, 0, 0, 0); O1 = __builtin_amdgcn_mfma_f32_32x32x16_bf16(a1, bfv, O1, 0, 0, 0); } }
#pragma unroll
        for (int g = 0; g < 16; ++g) { const int t = (g & 3) + 8 * (g >> 2) + 4 * hh; OL[t * G3_LD + 32 * vb + r] = O0[g]; OL[(32 + t) * G3_LD + 32 * vb + r] = O1[g]; }
        __syncthreads();
        { const int t = tid >> 3, cc = tid & 7; const LAS f32x4* op = (const LAS f32x4*)(OL + t * G3_LD + 32 * cc);
          f32x4 o[8]; float ss = 0.f;
#pragma unroll
          for (int j = 0; j < 8; ++j) { o[j] = op[j]; ss += (o[j].x * o[j].x + o[j].y * o[j].y) + (o[j].z * o[j].z + o[j].w * o[j].w); }
          ss += __shfl_xor(ss, 1); ss += __shfl_xor(ss, 2); ss += __shfl_xor(ss, 4);
          const float rs = 1.0f / sqrtf(ss * (1.0f / 256.0f) + RMS_EPS);
          const size_t row = (size_t)b * TB + 64 * n + t;
          const GAS v4u* rp = (const GAS v4u*)(G + row * WINP + 2048 + h * 256 + 32 * cc); const GAS f32x4* gp = (const GAS f32x4*)(PARF(ws) + P_OG + lg * 256 + 32 * cc);
          GAS v4u* dst = (GAS v4u*)(OG + row * 1024 + h * 256 + 32 * cc);
#pragma unroll
          for (int j = 0; j < 4; ++j) { const v4u rv = rp[j]; const f32x4 g0 = gp[2 * j], g1 = gp[2 * j + 1]; const f32x4 a = o[2 * j] * rs * g0, c2 = o[2 * j + 1] * rs * g1;
              v4u w;
              w.x = pk2(a.x * silu_f(__uint_as_float(rv.x << 16)), a.y * silu_f(__uint_as_float(rv.x & 0xffff0000u)));
              w.y = pk2(a.z * silu_f(__uint_as_float(rv.y << 16)), a.w * silu_f(__uint_as_float(rv.y & 0xffff0000u)));
              w.z = pk2(c2.x * silu_f(__uint_as_float(rv.z << 16)), c2.y * silu_f(__uint_as_float(rv.z & 0xffff0000u)));
              w.w = pk2(c2.z * silu_f(__uint_as_float(rv.w << 16)), c2.w * silu_f(__uint_as_float(rv.w & 0xffff0000u)));
              dst[j] = w; } }
    }
}
constexpr int WIMG_RS = 2064;
static_assert(2 * 32 * WIMG_RS <= LDS_AUX, "router images below the aux tables");
__device__ __forceinline__ void phase_modulate2_route(unsigned char* ws, int layer, LAS unsigned char* lds, int vcu, int wave, int lane, int tid, bool dummy = false) {
    const bf16* X = (const bf16*)(ws + WS_X); bf16* XN = (bf16*)(ws + WS_XN);
    const float* ng = PARF(ws) + P_N2G + layer * 1024; const float* Mo = (const float*)(ws + WS_MOD) + (size_t)layer * MODROWS * NMODC;
    LAS unsigned char* WHI = lds + RING_OFF; LAS unsigned char* WLO = WHI + 32 * WIMG_RS;
    LAS unsigned* lcnt = (LAS unsigned*)(lds + AUX_LCNT); LAS unsigned* gb = (LAS unsigned*)(lds + AUX_GB); LAS unsigned* ent = (LAS unsigned*)(lds + AUX_ENT); LAS float* rsl = (LAS float*)(lds + AUX_RS);
    { const float* wsrc = PARF(ws) + P_WR + (size_t)layer * 1024 * 32;
      for (int idx = tid; idx < 1024 * 32; idx += NWAVES * 64) { const int k = idx >> 5, e = idx & 31; const float w = wsrc[idx]; const unsigned hi = f2bf(w), lo = f2bf(w - __uint_as_float(hi << 16));
          *(LAS unsigned short*)(WHI + e * WIMG_RS + 2 * k) = (unsigned short)hi; *(LAS unsigned short*)(WLO + e * WIMG_RS + 2 * k) = (unsigned short)lo; }
      if (tid < 32) lcnt[tid] = 0u; }
    gu32* cnt = (gu32*)(ws + WS_CTL) + CW_CNT + (layer + (dummy ? 4 : 0)) * 32 * 16;
    unsigned char* sbase = dummy ? ws + WS_XG : ws;
    const bool lastl = (layer == NLAYER - 1);
  for (int grp = vcu; grp < MT / 136; grp += (int)gridDim.x) {
    const int rbase = grp * 136;
    if (grp != vcu) { __syncthreads(); if (tid < 32) lcnt[tid] = 0u; }
    for (int rl = wave; rl < 136; rl += 2 * NWAVES) {
        const int rl2 = (rl + NWAVES < 136) ? rl + NWAVES : rl; const int m = rbase + rl, m2 = rbase + rl2, mr = mod_row(m), mr2 = mod_row(m2);
        float rs, rs2;
        modulate_row2(X + (size_t)m * 1024, X + (size_t)m2 * 1024, ng, Mo + (size_t)mr * NMODC + 3 * 1024, Mo + (size_t)mr * NMODC + 4 * 1024, Mo + (size_t)mr2 * NMODC + 3 * 1024, Mo + (size_t)mr2 * NMODC + 4 * 1024,
                      ws + WS_XN8 + (size_t)m * 1024, ws + WS_XN8 + (size_t)m2 * 1024, lane, rs, rs2);
        if (lane == 0) { rsl[rl] = rs; rsl[rl2] = rs2; } }
    __syncthreads();
    if (wave < 5) {
        const int r = lane & 31, hh = lane >> 5; const int rl = (32 * wave + r < 136) ? 32 * wave + r : 135; const int m = rbase + rl, mr = mod_row(m);
        const float rsr = rsl[rl];
        const bf16* xp = X + (size_t)m * 1024 + 8 * hh; const float* gp = ng + 8 * hh; const float* scp = Mo + (size_t)mr * NMODC + 4 * 1024 + 8 * hh; const float* shp = Mo + (size_t)mr * NMODC + 3 * 1024 + 8 * hh;
        const LAS unsigned char* wh = WHI + r * WIMG_RS + 16 * hh; const LAS unsigned char* wl = WLO + r * WIMG_RS + 16 * hh;
        f32x16 acc;
#pragma unroll
        for (int g = 0; g < 16; ++g) acc[g] = 0.f;
#pragma unroll 2
        for (int s = 0; s < 64; ++s) {
            const v4u xr8 = *(const GAS v4u*)(xp + 16 * s); const f32x4 x0 = (f32x4){__uint_as_float(xr8.x << 16), __uint_as_float(xr8.x & 0xffff0000u), __uint_as_float(xr8.y << 16), __uint_as_float(xr8.y & 0xffff0000u)}, x1 = (f32x4){__uint_as_float(xr8.z << 16), __uint_as_float(xr8.z & 0xffff0000u), __uint_as_float(xr8.w << 16), __uint_as_float(xr8.w & 0xffff0000u)}; const f32x4 g0 = *(const GAS f32x4*)(gp + 16 * s), g1 = *(const GAS f32x4*)(gp + 16 * s + 4);
            const f32x4 c0 = *(const GAS f32x4*)(scp + 16 * s), c1 = *(const GAS f32x4*)(scp + 16 * s + 4), h0 = *(const GAS f32x4*)(shp + 16 * s), h1 = *(const GAS f32x4*)(shp + 16 * s + 4);
            const f32x4 y0 = (x0 * rsr) * g0 * (c0 + 1.0f) + h0, y1 = (x1 * rsr) * g1 * (c1 + 1.0f) + h1;
            v4u ph, pl;
            ph.x = pg8::cvt_pk_bf16(y0.x, y0.y); ph.y = pg8::cvt_pk_bf16(y0.z, y0.w); ph.z = pg8::cvt_pk_bf16(y1.x, y1.y); ph.w = pg8::cvt_pk_bf16(y1.z, y1.w);
            pl.x = pg8::cvt_pk_bf16(y0.x - __uint_as_float(ph.x << 16), y0.y - __uint_as_float(ph.x & 0xffff0000u)); pl.y = pg8::cvt_pk_bf16(y0.z - __uint_as_float(ph.y << 16), y0.w - __uint_as_float(ph.y & 0xffff0000u));
            pl.z = pg8::cvt_pk_bf16(y1.x - __uint_as_float(ph.z << 16), y1.y - __uint_as_float(ph.z & 0xffff0000u)); pl.w = pg8::cvt_pk_bf16(y1.z - __uint_as_float(ph.w << 16), y1.w - __uint_as_float(ph.w & 0xffff0000u));
            const bf16x8 ahi = __builtin_bit_cast(bf16x8, ph), alo = __builtin_bit_cast(bf16x8, pl);
            const bf16x8 bhi = *(const LAS bf16x8*)(wh + 32 * s), blo = *(const LAS bf16x8*)(wl + 32 * s);
            acc = __builtin_amdgcn_mfma_f32_32x32x16_bf16(ahi, bhi, acc, 0, 0, 0); acc = __builtin_amdgcn_mfma_f32_32x32x16_bf16(alo, bhi, acc, 0, 0, 0); acc = __builtin_amdgcn_mfma_f32_32x32x16_bf16(ahi, blo, acc, 0, 0, 0); }
        const float brt = (PARF(ws) + P_BR)[layer * 32 + r];
#pragma unroll
        for (int g = 0; g < 16; ++g) { const int rowl = 32 * wave + (g & 3) + 8 * (g >> 2) + 4 * hh;
            float v = acc[g] + brt; float tv[4]; int te[4];
#pragma unroll
            for (int k = 0; k < 4; ++k) { float mx = v;
#pragma unroll
                for (int o = 1; o < 32; o <<= 1) mx = fmaxf(mx, shx(mx, o, lane));
                const unsigned long long bm = __ballot(v == mx); const unsigned hm = hh ? (unsigned)(bm >> 32) : (unsigned)bm; const int first = __ffs((int)hm) - 1;
                te[k] = first; tv[k] = mx; if (r == first) v = -INFINITY; }
            const bool valid = rowl < 136 && !(lastl && mod_row(rbase + (rowl < 136 ? rowl : 135)) == 8);
            if (r == 0 && rowl < 136) {
                if (valid) { const float e1 = __expf(tv[1] - tv[0]), e2 = __expf(tv[2] - tv[0]), e3 = __expf(tv[3] - tv[0]); const float inv = 1.0f / (1.0f + e1 + e2 + e3);
                    const float wk[4] = {inv, e1 * inv, e2 * inv, e3 * inv};
#pragma unroll
                    for (int k = 0; k < 4; ++k) { const unsigned lp = atomicAdd((unsigned*)&lcnt[te[k]], 1u); ent[(rowl * 4 + k) * 2 + 0] = ((unsigned)te[k] << 24) | lp; ent[(rowl * 4 + k) * 2 + 1] = __float_as_uint(wk[k]); } }
                else {
#pragma unroll
                    for (int k = 0; k < 4; ++k) ent[(rowl * 4 + k) * 2 + 0] = 0xffffffffu; } } }
    }
    __syncthreads();
    if (tid < 32) gb[tid] = __hip_atomic_fetch_add(cnt + tid * 16, lcnt[tid], __ATOMIC_RELAXED, __HIP_MEMORY_SCOPE_AGENT);
    __syncthreads();
    for (int q = tid; q < 136 * 4; q += NWAVES * 64) { const unsigned pe = ent[q * 2 + 0];
        if (pe != 0xffffffffu) { const unsigned e = pe >> 24, lp = pe & 0xffffffu; const int m = rbase + (q >> 2);
            ((unsigned*)(sbase + WS_SLOT))[m * 4 + (q & 3)] = (e << 24) | (gb[e] + lp); ((unsigned*)(sbase + WS_GATEW))[m * 4 + (q & 3)] = ent[q * 2 + 1];
            if (!dummy) ((int*)(ws + WS_LIST))[(size_t)e * MT + gb[e] + lp] = m; } }
  }
}
__device__ __forceinline__ void build_expert_tables(unsigned char* ws, int layer, LAS unsigned char* lds, int tid) {
    LAS int* t2e = (LAS int*)(lds + AUX_T2E); LAS int* base = (LAS int*)(lds + AUX_BASE); LAS int* ntp = (LAS int*)(lds + AUX_NT); LAS int* cntl = (LAS int*)(lds + AUX_CNT);
    gu32* cnt = (gu32*)(ws + WS_CTL) + CW_CNT + layer * 32 * 16;
    __syncthreads();
    if (tid < 64) { const unsigned cval = (tid < 32) ? __hip_atomic_load(cnt + tid * 16, RLX_AGENT) : 0u; const int tiles = (int)((cval + 255u) >> 8);
        int pre = tiles;
#pragma unroll
        for (int o = 1; o < 32; o <<= 1) { const int ln = tid & 63; const int t = __builtin_amdgcn_ds_bpermute(((ln >= o) ? ln - o : ln) << 2, pre); if (ln >= o) pre += t; }
        const int start = pre - tiles;
        if (tid < 32) { base[tid] = start * 256; cntl[tid] = (int)cval; for (int t = 0; t < tiles; ++t) t2e[start + t] = tid; if (tid == 31) ntp[0] = pre; } }
    __syncthreads();
}
__device__ __forceinline__ void phase_moe_gather(unsigned char* ws, int layer, LAS unsigned char* lds, int gw, int NGW, int lane, int tid) {
    build_expert_tables(ws, layer, lds, tid);
    const LAS int* base = (const LAS int*)(lds + AUX_BASE);
    const bf16* XN = (const bf16*)(ws + WS_XN); bf16* XG = (bf16*)(ws + WS_XG);
    const unsigned* slot = (const unsigned*)(ws + WS_SLOT); unsigned* spos = (unsigned*)(ws + WS_SLOTPOS);
    for (int m = gw; m < MT; m += NGW) {
        if (layer == NLAYER - 1 && mod_row(m) == 8) continue;
        const GAS v4u* src = (const GAS v4u*)(XN + (size_t)m * 1024) + lane; const v4u a = src[0], b = src[64];
#pragma unroll
        for (int k = 0; k < 4; ++k) { const unsigned pe = slot[m * 4 + k]; const int dst = base[pe >> 24] + (int)(pe & 0xffffffu);
            GAS v4u* dp = (GAS v4u*)(XG + (size_t)dst * 1024) + lane; dp[0] = a; dp[64] = b;
            if (lane == 0) spos[m * 4 + k] = (unsigned)dst; }
    }
}
__device__ __forceinline__ void phase_moe_combine(unsigned char* ws, float* out, int layer, LAS unsigned char* lds, int gw, int NGW, int lane, int tid, bool dummy = false) {
    build_expert_tables(ws, layer, lds, tid);
    const LAS int* base = (const LAS int*)(lds + AUX_BASE);
    bf16* X = (bf16*)(ws + WS_X); const unsigned char* Y = ws + WS_Y;
    const float* Mo = (const float*)(ws + WS_MOD) + (size_t)layer * MODROWS * NMODC;
    const unsigned* slot = (const unsigned*)(ws + WS_SLOT); const float* gw4 = (const float*)(ws + WS_GATEW);
    for (int m0 = gw; m0 < MT; m0 += 2 * NGW) {
        int mm[2], bb[2], ww[2], mrr[2]; bool ok[2];
#pragma unroll
        for (int p = 0; p < 2; ++p) { const int m = m0 + p * NGW; ok[p] = m < MT; mm[p] = ok[p] ? m : m0; bb[p] = mm[p] / TB; ww[p] = mm[p] - bb[p] * TB; mrr[p] = (ww[p] < CTXL) ? 8 : bb[p];
            if (layer == NLAYER - 1 && ww[p] < CTXL) ok[p] = false; }
        if (!ok[0] && !ok[1]) continue;
        unsigned pe[2][4]; float wk[2][4];
#pragma unroll
        for (int p = 0; p < 2; ++p)
#pragma unroll
            for (int k = 0; k < 4; ++k) { pe[p][k] = slot[mm[p] * 4 + k]; wk[p][k] = gw4[mm[p] * 4 + k]; }
        unsigned long long xv[2][4];
#pragma unroll
        for (int p = 0; p < 2; ++p) { const GAS unsigned long long* xp = (const GAS unsigned long long*)(X + (size_t)mm[p] * 1024) + lane;
#pragma unroll
            for (int j = 0; j < 4; ++j) xv[p][j] = xp[64 * j]; }
        unsigned yv[2][4][4];
#pragma unroll
        for (int p = 0; p < 2; ++p)
#pragma unroll
            for (int k = 0; k < 4; ++k) { unsigned e = pe[p][k] >> 24; if (!ok[p] || e > 31u) e = 0u;
                const unsigned sp = ok[p] ? (unsigned)base[e] + (pe[p][k] & 0xffffffu) : 0u;
                const GAS unsigned* yp = (const GAS unsigned*)(Y + (size_t)sp * 1024) + lane;
#pragma unroll
                for (int j = 0; j < 4; ++j) yv[p][k][j] = yp[64 * j]; }
        f32x4 f[2][4]; float ss[2];
#pragma unroll
        for (int p = 0; p < 2; ++p) { const GAS f32x4* gp = (const GAS f32x4*)(Mo + (size_t)mrr[p] * NMODC + 5 * 1024) + lane;
            ss[p] = 0.f;
#pragma unroll
            for (int j = 0; j < 4; ++j) { f32x4 a = (f32x4){0.f, 0.f, 0.f, 0.f};
#pragma unroll
                for (int k = 0; k < 4; ++k) { const unsigned w8 = yv[p][k][j]; const f32x2 lo2 = __builtin_amdgcn_cvt_pk_f32_fp8((int)w8, false), hi2 = __builtin_amdgcn_cvt_pk_f32_fp8((int)w8, true); a = a + (f32x4){lo2.x, lo2.y, hi2.x, hi2.y} * wk[p][k]; }
                f[p][j] = bf4_to_f32(xv[p][j]) + gp[64 * j] * a; } }
        asm volatile("" ::: "memory");
        const bool fuse = (layer < NLAYER - 1) && !dummy;
#pragma unroll
        for (int p = 0; p < 2; ++p) { if (!ok[p]) continue;
            GAS unsigned long long* xp = (GAS unsigned long long*)(X + (size_t)mm[p] * 1024) + lane;
            GAS f32x4* op = (GAS f32x4*)(out + ((size_t)bb[p] * SEQ + (ww[p] - CTXL)) * 1024) + lane;
#pragma unroll
            for (int j = 0; j < 4; ++j) { if (dummy) ((GAS f32x4*)((float*)(ws + WS_XG) + (size_t)mm[p] * 1024) + lane)[64 * j] = f[p][j]; else if (layer == NLAYER - 1) op[64 * j] = f[p][j]; else { const unsigned long long pk = f32_to_bf4(f[p][j]); xp[64 * j] = pk; f[p][j] = bf4_to_f32(pk); }
                ss[p] += (f[p][j].x * f[p][j].x + f[p][j].y * f[p][j].y) + (f[p][j].z * f[p][j].z + f[p][j].w * f[p][j].w); }
            if (fuse) { const float rs = 1.0f / sqrtf(wave_sum(ss[p]) * (1.0f / 1024.0f) + RMS_EPS);
                const float* ng = PARF(ws) + P_N1G + (layer + 1) * 1024; const float* Mn = (const float*)(ws + WS_MOD) + (size_t)(layer + 1) * MODROWS * NMODC + (size_t)mrr[p] * NMODC;
                GAS unsigned long long* o8 = (GAS unsigned long long*)((bf16*)(ws + WS_XN) + (size_t)mm[p] * 1024) + lane;
#pragma unroll
                for (int j = 0; j < 4; ++j) { const f32x4 g = ((const GAS f32x4*)ng)[64 * j + lane], sh = ((const GAS f32x4*)Mn)[64 * j + lane], sc = ((const GAS f32x4*)(Mn + 1024))[64 * j + lane];
                    o8[64 * j] = f32_to_bf4((f[p][j] * rs) * g * (sc + 1.0f) + sh); } } }
    }
}

constexpr int NPH_L = 11, NPHASE = 2 + NPH_L * NLAYER;
#ifndef PHMASK
#define PHMASK 0x7fff
#endif
#define EN(b) ((PHMASK >> (b)) & 1)
#ifndef DUPMASK
#define DUPMASK 0
#endif
#define DUP(b) for (int rep_ = 0; rep_ < (((DUPMASK >> (b)) & 1) ? 2 : 1); ++rep_)
__global__ void __launch_bounds__(NWAVES * 64, 2) dit_fwd(Args args) {
    extern __shared__ __attribute__((aligned(16))) unsigned char lds_raw[];
    LAS unsigned char* lds = (LAS unsigned char*)lds_raw;
    volatile LAS unsigned* MISC = (volatile LAS unsigned*)(lds + MISC_OFF);
    const int G = gridDim.x, bx = blockIdx.x;
    const int vcu = (G % 8 == 0) ? (bx % 8) * (G / 8) + bx / 8 : bx;
    const int wave0 = __builtin_amdgcn_readfirstlane((int)threadIdx.x >> 6);
#define LANE_ID(z) ((int)__builtin_amdgcn_mbcnt_hi(~0u, __builtin_amdgcn_mbcnt_lo(~0u, (z))))
    { const int t0 = (wave0 << 6) | LANE_ID(0u); for (int u = t0; u < (LDS_BYTES - MISC_OFF) / 4; u += NWAVES * 64) ((LAS unsigned*)(lds + MISC_OFF))[u] = 0u; }
    __syncthreads();
    const int lo = args.ph_lo, hi = args.ph_hi;
    XcdBarrier bar; bar.bar = (unsigned*)(args.ws + WS_CTL) + CW_BAR; bar.x = 0; bar.st = nullptr;
    if (hi - lo > 1) bar = xcd_barrier_post((unsigned*)(args.ws + WS_CTL) + CW_BAR, MISC + 8, wave0 == 0 && LANE_ID(0u) == 0);
#define IN(k) (lo <= (k) && (k) < hi)
#define SEAM(k) do { if (IN(k) && IN((k) + 1)) { XcdBarrier b_ = bar; unsigned zb_ = 0u; LAUNDER_S(zb_); b_.bar = bar.bar + zb_; xcd_barrier(b_, wave0 == 0 && LANE_ID(zb_) == 0); } } while (0)
#define PHASE_IDS() unsigned zoff_ = 0u; LAUNDER_S(zoff_); int tid = (wave0 << 6) | LANE_ID(zoff_); LAUNDER_V(tid); const int lane = tid & 63, wave = __builtin_amdgcn_readfirstlane(tid >> 6); const int gw = vcu * NWAVES + wave, NGW = G * NWAVES; \
    unsigned char* ws = args.ws + zoff_; const int Gp = G + (int)zoff_, bxp = bx + (int)zoff_; (void)lane; (void)gw; (void)NGW; (void)Gp; (void)bxp;

    if (EN(0) && IN(0)) DUP(0) { PHASE_IDS(); p0_prologue(args, lds, gw, NGW, wave, lane); } SEAM(0);
    if (EN(1) && IN(1)) { PHASE_IDS(); p1_mod_reduce(args, gw * 64 + lane, NGW * 64); } SEAM(1);

    for (int layer = 0; layer < NLAYER; ++layer) {
        const int pb = 2 + NPH_L * layer, lh = layer >> 1;
        if (layer == 0) { if (EN(2) && IN(pb + 0)) DUP(2) { PHASE_IDS(); phase_modulate1(ws, layer, gw, NGW, lane); } SEAM(pb + 0); }
        if ((layer & 1) == 0) {
            if (EN(3) && IN(pb + 1)) DUP(3) {
                PHASE_IDS();
                pg8::Gemm g{(const pg8::bf16_t*)(ws + WS_XN), (const pg8::bf16_t*)(ws + WS_WQKV) + (size_t)lh * QKVN * 1024, MT, QKVN, 1024, 0};
                pg8::StaticOrder S; S.init(MT, QKVN, Gp, bxp);
                LAS float* gl = (LAS float*)(lds + AUX_RS);
                if (tid < 128) gl[tid] = (PARF(ws) + (tid < 64 ? P_QG : P_KG - 64) + lh * 64)[tid];
                __syncthreads();
                pg8::EpiQKV E{ws, WS_Q, WS_K - WS_Q, WS_V - WS_K, gl, (const float*)(ws + WS_ROPE), ATT_C2};
                pg8::gemm_phase<pg8::EpiQKV, pg8::StaticOrder, true, true>(lds + RING_OFF, g, S, E, tid);
            } SEAM(pb + 1);
            if (EN(5) && IN(pb + 3)) DUP(5) {
                PHASE_IDS();
                const attn_body::bf16* Qp = (const attn_body::bf16*)(ws + WS_Q); const attn_body::bf16* Kp = (const attn_body::bf16*)(ws + WS_K); const attn_body::bf16* Vp = (const attn_body::bf16*)(ws + WS_V);
                attn_body::bf16* Op = (attn_body::bf16*)(ws + WS_XN);
                if (G == 256) {
                    for (int i = 0; i < 9; ++i) {
                        long qrow0, kvrow0; int NT, h;
                        if (i < 8) { const int x = vcu >> 5, j = vcu & 31, pair = 4 * x + (i >> 1), wi = (i & 1) * 32 + j, hq = wi >> 4, qb = wi & 15, b = pair >> 2, hk = pair & 3;
                            h = hk * 4 + hq; qrow0 = (long)b * TB + CTXL + qb * 256; kvrow0 = (long)b * TB; NT = TB / 64; }
                        else { if (vcu >= 128) break; const int b = vcu >> 4; h = vcu & 15; qrow0 = (long)b * TB; kvrow0 = qrow0; NT = CTXL / 64; }
                        attn_body::attn_unit<8>(qrow0, kvrow0, NT, h, Qp, Kp, Vp, Op, (char*)lds_raw + RING_OFF, tid);
                    }
                } else {
                    for (int U = bx; U < 2048 + 128; U += G) {
                        long qrow0, kvrow0; int NT, h;
                        if (U < 2048) { const int pair = U >> 6, wi = U & 63, hq = wi >> 4, qb = wi & 15, b = pair >> 2, hk = pair & 3; h = hk * 4 + hq; qrow0 = (long)b * TB + CTXL + qb * 256; kvrow0 = (long)b * TB; NT = TB / 64; }
                        else { const int v = U - 2048, b = v >> 4; h = v & 15; qrow0 = (long)b * TB; kvrow0 = qrow0; NT = CTXL / 64; }
                        attn_body::attn_unit<8>(qrow0, kvrow0, NT, h, Qp, Kp, Vp, Op, (char*)lds_raw + RING_OFF, tid);
                    }
                }
            } SEAM(pb + 3);
        } else {
            if (EN(6) && IN(pb + 1)) DUP(6) {
                PHASE_IDS();
                pg8::Gemm g{(const pg8::bf16_t*)(ws + WS_XN), (const pg8::bf16_t*)(ws + WS_WIN) + (size_t)lh * WINP * 1024, MT, WINP, 1024, 0};
                pg8::StaticOrder S; S.init(MT, WINP, Gp, bxp);
                pg8::EpiBf16 E{(pg8::bf16_t*)(ws + WS_G), WINP};
                pg8::gemm_phase<pg8::EpiBf16, pg8::StaticOrder, true, true>(lds + RING_OFF, g, S, E, tid);
            } SEAM(pb + 1);
            if (EN(7) && IN(pb + 2)) DUP(7) { PHASE_IDS(); phase_gla_g0(ws, lh, lds, tid); } SEAM(pb + 2);
            if (EN(8) && IN(pb + 3)) DUP(8) { PHASE_IDS(); phase_gla_g12(ws, lds, gw, wave, lane); } SEAM(pb + 3);
            if (EN(8) && IN(pb + 4)) DUP(9) { PHASE_IDS(); phase_gla_g3(ws, lh, lds, tid); } SEAM(pb + 4);
        }
        if (EN(9) && IN(pb + 5)) {
            PHASE_IDS();
            const pg8::bf16_t* Wt = (layer & 1) ? (const pg8::bf16_t*)(ws + WS_WOG) + (size_t)lh * 1024 * 1024 : (const pg8::bf16_t*)(ws + WS_WOA) + (size_t)lh * 1024 * 1024;
            pg8::Gemm g{(const pg8::bf16_t*)(ws + ((layer & 1) ? WS_Q : WS_XN)), Wt, MT, 1024, 1024, 0};
            pg8::StaticOrder S; if (layer == NLAYER - 1) S.init(NB * SEQ, 1024, Gp, bxp, true); else S.init(MT, 1024, Gp, bxp);
            pg8::EpiResGate E{(pg8::bf16_t*)(ws + WS_X), (const float*)(ws + WS_MOD) + (size_t)layer * MODROWS * NMODC + 2 * 1024};
            pg8::gemm_phase<pg8::EpiResGate, pg8::StaticOrder, true, true>(lds + RING_OFF, g, S, E, tid);
        } SEAM(pb + 5);
        if (EN(10) && IN(pb + 6)) { if ((DUPMASK >> 10) & 1) { PHASE_IDS(); phase_modulate2_route(ws, layer, lds, vcu, wave, lane, tid, true); __syncthreads(); } PHASE_IDS(); phase_modulate2_route(ws, layer, lds, vcu, wave, lane, tid); } SEAM(pb + 6);
        if (EN(12) && IN(pb + 8)) DUP(12) {
            PHASE_IDS();
            build_expert_tables(ws, layer, lds, tid);
            const int nT = __builtin_amdgcn_readfirstlane(((const LAS int*)(lds + AUX_NT))[0]);
            pg8::MoeOrder S{nT, 8, Gp, bxp, (const LAS int*)(lds + AUX_T2E)};
            LAS unsigned short* rowtab = (LAS unsigned short*)(lds + AUX_ROWTAB);
            { const LAS int* base = (const LAS int*)(lds + AUX_BASE); const LAS int* cntl = (const LAS int*)(lds + AUX_CNT); const int* LIST = (const int*)(ws + WS_LIST);
              pg8::Unit u;
              for (int i = 0; i < ROWTAB_UNITS && S.next(i, u); ++i) if (tid < 256) { const int pos = (u.pm - (base[u.e] >> 8)) * 256 + tid; rowtab[i * 256 + tid] = (unsigned short)((pos < cntl[u.e]) ? LIST[(size_t)u.e * MT + pos] : 0); }
              __syncthreads(); }
            pg8::Gemm g{(const pg8::bf16_t*)(ws + WS_XN8), (const pg8::bf16_t*)(ws + WS_WGU + (size_t)layer * 32 * 2048 * 1024), MPAD, 2048, 512, (size_t)2048 * 1024, rowtab};
            pg8::EpiSwiGLU8 E{ws + WS_ACT, PARF(ws) + P_BGU + (size_t)layer * 32 * 2048, 1.0f / 32.0f};
            pg8::gemm_phase<pg8::EpiSwiGLU8, pg8::MoeOrder, true, true, true, true>(lds + RING_OFF, g, S, E, tid);
        } SEAM(pb + 8);
        if (EN(13) && IN(pb + 9)) DUP(13) {
            PHASE_IDS();
            build_expert_tables(ws, layer, lds, tid);
            const int nT = __builtin_amdgcn_readfirstlane(((const LAS int*)(lds + AUX_NT))[0]);
            pg8::Gemm g{(const pg8::bf16_t*)(ws + WS_ACT), (const pg8::bf16_t*)(ws + WS_WDN + (size_t)layer * 32 * 1024 * 1024), MPAD, 1024, 512, (size_t)1024 * 1024};
            pg8::MoeOrder S{nT, 4, Gp, bxp, (const LAS int*)(lds + AUX_T2E)};
            pg8::EpiBiasF8 E{ws + WS_Y, PARF(ws) + P_BDN + (size_t)layer * 32 * 1024, 1.0f / 32.0f};
            pg8::gemm_phase<pg8::EpiBiasF8, pg8::MoeOrder, true, true, false, true>(lds + RING_OFF, g, S, E, tid);
        } SEAM(pb + 9);
        if (EN(14) && IN(pb + 10)) { if ((DUPMASK >> 14) & 1) { PHASE_IDS(); phase_moe_combine(ws, args.out, layer, lds, gw, NGW, lane, tid, true); } PHASE_IDS(); phase_moe_combine(ws, args.out, layer, lds, gw, NGW, lane, tid); } SEAM(pb + 10);
    }
#undef IN
#undef EN
#undef DUP
#undef SEAM
#undef PHASE_IDS
#undef LANE_ID
}

extern "C" void kernel_launch(void* const* d_in, const int* in_sizes, int n_in, void* d_out, int out_size, void* d_ws, size_t ws_size, hipStream_t stream) {
    static int grid = 0;
    if (grid == 0) {
        if (n_in != 25 || out_size != NB * SEQ * DMODEL || ws_size < WS_END) { fprintf(stderr, "kernel_launch: unexpected shapes: n_in %d out %d ws %zu (need >= %zu)\n", n_in, out_size, ws_size, (size_t)WS_END); grid = -1; return; }
        int dev = 0, cus = 0, per_cu = 0;
        if (hipGetDevice(&dev) != hipSuccess || hipDeviceGetAttribute(&cus, hipDeviceAttributeMultiprocessorCount, dev) != hipSuccess) { grid = -1; return; }
        if (hipFuncSetAttribute((const void*)dit_fwd, hipFuncAttributeMaxDynamicSharedMemorySize, LDS_BYTES) != hipSuccess) { fprintf(stderr, "kernel_launch: hipFuncSetAttribute failed\n"); grid = -1; return; }
        if (hipOccupancyMaxActiveBlocksPerMultiprocessor(&per_cu, (const void*)dit_fwd, NWAVES * 64, LDS_BYTES) != hipSuccess || per_cu < 1) fprintf(stderr, "kernel_launch: occupancy query reports %d\n", per_cu);
        (void)hipGetLastError();
        grid = cus;
    }
    if (grid < 0) return;
    if (hipMemsetAsync((char*)d_ws + WS_CTL, 0, CTL_ZERO_BYTES, stream) != hipSuccess) { fprintf(stderr, "kernel_launch: memset failed\n"); return; }
    Args a{};
    for (int i = 0; i < 25; ++i) a.in[i] = (const float*)d_in[i];
    a.out = (float*)d_out; a.ws = (unsigned char*)d_ws;
#if MK_ONE_LAUNCH
    a.ph_lo = 0; a.ph_hi = NPHASE;
    hipLaunchKernelGGL(dit_fwd, dim3(grid), dim3(NWAVES * 64), LDS_BYTES, stream, a);
#else
    for (int p = 0; p < NPHASE; ++p) { a.ph_lo = p; a.ph_hi = p + 1; hipLaunchKernelGGL(dit_fwd, dim3(grid), dim3(NWAVES * 64), LDS_BYTES, stream, a); }
#endif
    const hipError_t le = hipPeekAtLastError();
    if (le != hipSuccess) fprintf(stderr, "kernel_launch: launch failed: %s\n", hipGetErrorName(le));
}
```

```cpp
#include <hip/hip_runtime.h>
#include <hip/hip_bf16.h>
#include <cstdio>
#include <cstdint>
#include <cmath>

#ifndef MK_ONE_LAUNCH
#define MK_ONE_LAUNCH 1
#endif

namespace pg8 {
#define PG8_LAS __attribute__((address_space(3)))
typedef unsigned short bf16_t;
typedef short bf16x8 __attribute__((ext_vector_type(8)));
typedef float f32x4 __attribute__((ext_vector_type(4)));
typedef unsigned u32x4 __attribute__((ext_vector_type(4)));
constexpr int BM = 256, BK = 64, HALF = 128, HTB = HALF * BK * 2  , STAGE_BYTES = 8 * HTB, NXCD = 8, WGM = 8;

__host__ __device__ __forceinline__ int lds_byte(int r, int c) { const int st = (r >> 4) * 2 + (c >> 5), rr = r & 15, cc = c & 31, ob = rr * 64 + cc * 2; return st * 1024 + (ob ^ (((ob >> 9) & 1) << 5)); }
__host__ __device__ __forceinline__ void stage_rc(int b, int& R, int& C) { const int st = b / 1024, sb = b % 1024, swz = sb ^ (((sb >> 9) & 1) << 5); R = (st >> 1) * 16 + swz / 64; C = (st & 1) * 32 + (swz % 64) / 2; }
__host__ __device__ __forceinline__ int perm32(int rho) { const int n = rho >> 4, i = rho & 15; return 8 * (i >> 2) + 4 * n + (i & 3); }

struct Unit { int pm, pn, e; };
struct Gemm { const bf16_t* A; const bf16_t* Bt; int M, N, K; size_t bstride; const PG8_LAS unsigned short* rowtab; };

struct StaticOrder {
    int nM, nN, nwg, G, c; bool latent_only;
    __host__ __device__ __forceinline__ void init(int M, int N, int G_, int c_, bool lat_ = false) { nM = M / BM; nN = N / BM; nwg = nM * nN; G = G_; c = c_; latent_only = lat_; }
    __host__ __device__ __forceinline__ bool next(int i, Unit& u) const {
        const long L = (long)i * G + c; if (L >= nwg) return false;
        int wgid = (int)L; { const int q = nwg / NXCD, r = nwg % NXCD, xcd = wgid % NXCD, off = wgid / NXCD; wgid = (xcd < r ? xcd * (q + 1) : r * (q + 1) + (xcd - r) * q) + off; }
        const int nig = WGM * nN, gid = wgid / nig, fm = gid * WGM, gsz = (nM - fm) < WGM ? (nM - fm) : WGM;
        u.pm = fm + ((wgid % nig) % gsz); u.pn = (wgid % nig) / gsz; u.e = 0;
        if (latent_only) u.pm = (u.pm >> 4) * 17 + 1 + (u.pm & 15);
        return true;
    }
    __device__ __forceinline__ void a_ready(const Unit&) const {}
    __device__ __forceinline__ void done(const Unit&) const {}
};
struct MoeOrder {
    int nT, nN, G, c; const PG8_LAS int* t2e;
    __device__ __forceinline__ bool next(int i, Unit& u) const {
        const int x = c & 7, j = c >> 3, per = 32 / nN, mt = (i * (G >> 5) + x) * per + j / nN; if (mt >= nT) return false;
        u.pm = mt; u.pn = j % nN; u.e = __builtin_amdgcn_readfirstlane(t2e[mt]); return true;
    }
    __device__ __forceinline__ void a_ready(const Unit&) const {}
    __device__ __forceinline__ void done(const Unit&) const {}
};

__device__ __forceinline__ int lane_now() { unsigned z; asm volatile("s_mov_b32 %0, 0" : "=s"(z)); return (int)__builtin_amdgcn_mbcnt_hi(~0u, __builtin_amdgcn_mbcnt_lo(~0u, z)); }
__device__ __forceinline__ float shx(float v, int m, int ln) { return __int_as_float(__builtin_amdgcn_ds_bpermute((ln ^ m) << 2, __float_as_int(v))); }
__device__ __forceinline__ unsigned pk4_fp8(float a, float b, float c, float d) { int w = 0; w = __builtin_amdgcn_cvt_pk_fp8_f32(a, b, w, false); w = __builtin_amdgcn_cvt_pk_fp8_f32(c, d, w, true); return (unsigned)w; }
__device__ __forceinline__ unsigned cvt_pk_bf16(float lo, float hi) { unsigned r; asm volatile("v_cvt_pk_bf16_f32 %0, %1, %2" : "=v"(r) : "v"(lo), "v"(hi)); return r; }

struct EpiBf16 {
    static constexpr bool PERM = true, AFTER_DRAIN = false;
    bf16_t* O; int ldc;
    __device__ __forceinline__ void operator()(const f32x4 (&acc)[2][2][4][2], const Unit& u, int wr, int wc, int fr, int fq) const {
        const int row0 = u.pm * BM + wr * 64 + fr; const int col0 = u.pn * BM + wc * 32 + 8 * fq;
#pragma unroll
        for (int ai = 0; ai < 2; ++ai)
#pragma unroll
            for (int m = 0; m < 4; ++m) { bf16_t* rowp = O + (size_t)(row0 + ai * HALF + m * 16) * ldc + col0;
#pragma unroll
                for (int bj = 0; bj < 2; ++bj) { const f32x4 v0 = acc[ai][bj][m][0], v1 = acc[ai][bj][m][1];
                    u32x4 w; w.x = cvt_pk_bf16(v0[0], v0[1]); w.y = cvt_pk_bf16(v0[2], v0[3]); w.z = cvt_pk_bf16(v1[0], v1[1]); w.w = cvt_pk_bf16(v1[2], v1[3]);
                    *(u32x4*)(rowp + bj * HALF) = w; } }
    }
};
struct EpiQKV {
    static constexpr bool PERM = true, AFTER_DRAIN = false;
    unsigned char* wsb; size_t offQ, dK, dV;
    const PG8_LAS float* gl; const float* ropec; float c2;
    __device__ __forceinline__ void operator()(const f32x4 (&acc)[2][2][4][2], const Unit& u, int wr, int wc, int fr, int fq) const {
        const int isk = (u.pn >= 4) ? 1 : 0, isv = (u.pn >= 5) ? 1 : 0;
        bf16_t* base = (bf16_t*)(wsb + offQ + (size_t)isk * dK + (size_t)isv * dV); const int ldc = isk ? 256 : 1024;
        const int hcol = (isk ? wc : (u.pn * 4 + wc)) * 64 + 8 * fq;
        const int pmb = u.pm / 17, pml = u.pm - pmb * 17; const bool lat = pml != 0;
        const PG8_LAS float* gp = gl + (isk ? 64 : 0) + 8 * fq; const float scl = isk ? 1.0f : c2;
#pragma unroll
        for (int ai = 0; ai < 2; ++ai)
#pragma unroll
            for (int m = 0; m < 4; ++m) { const int rl = ai * HALF + wr * 64 + m * 16 + fr; const size_t row = (size_t)u.pm * BM + rl;
                f32x4 v[2][2]; float ss = 0.f;
#pragma unroll
                for (int bj = 0; bj < 2; ++bj)
#pragma unroll
                    for (int n = 0; n < 2; ++n) { v[bj][n] = acc[ai][bj][m][n]; ss += (v[bj][n][0] * v[bj][n][0] + v[bj][n][1] * v[bj][n][1]) + (v[bj][n][2] * v[bj][n][2] + v[bj][n][3] * v[bj][n][3]); }
                if (!isv) { const int ln = lane_now(); ss += shx(ss, 16, ln); ss += shx(ss, 32, ln);
                    const float rs = 1.0f / sqrtf(ss * (1.0f / 64.0f) + 1e-6f);
                    const int spos = (pml - 1) * 256 + rl;
#pragma unroll
                    for (int bj = 0; bj < 2; ++bj) { f32x4 cs = (f32x4){1.f, 1.f, 1.f, 1.f}, sn = (f32x4){0.f, 0.f, 0.f, 0.f};
                        if (lat) { const float* cp = ropec + (size_t)spos * 32 + 16 * bj + 4 * fq; cs = *(const f32x4*)cp; sn = *(const f32x4*)(cp + 4096 * 32); }
#pragma unroll
                        for (int n = 0; n < 2; ++n) { const f32x4 y = v[bj][n] * rs * *(const PG8_LAS f32x4*)(gp + 32 * bj + 4 * n);
                            const float c0 = cs[2 * n], s0 = sn[2 * n], c1 = cs[2 * n + 1], s1 = sn[2 * n + 1];
                            v[bj][n] = (f32x4){(y[0] * c0 - y[1] * s0) * scl, (y[0] * s0 + y[1] * c0) * scl, (y[2] * c1 - y[3] * s1) * scl, (y[2] * s1 + y[3] * c1) * scl}; } } }
                bf16_t* rowp = base + row * ldc + hcol;
#pragma unroll
                for (int bj = 0; bj < 2; ++bj) { u32x4 w; w.x = cvt_pk_bf16(v[bj][0][0], v[bj][0][1]); w.y = cvt_pk_bf16(v[bj][0][2], v[bj][0][3]); w.z = cvt_pk_bf16(v[bj][1][0], v[bj][1][1]); w.w = cvt_pk_bf16(v[bj][1][2], v[bj][1][3]);
                    *(u32x4*)(rowp + 32 * bj) = w; } }
    }
};
struct EpiBiasF8 {
    static constexpr bool PERM = true, AFTER_DRAIN = false;
    unsigned char* O; const float* bias; float ascale;
    __device__ __forceinline__ void operator()(const f32x4 (&acc)[2][2][4][2], const Unit& u, int wr, int wc, int fr, int fq) const {
        const int row0 = u.pm * BM + wr * 64 + fr; const int col0 = u.pn * BM + wc * 32 + 8 * fq;
        const float* bp = bias + (size_t)u.e * 1024 + col0;
        f32x4 bv[2][2];
#pragma unroll
        for (int bj = 0; bj < 2; ++bj)
#pragma unroll
            for (int n = 0; n < 2; ++n) bv[bj][n] = *(const f32x4*)(bp + bj * HALF + 4 * n);
#pragma unroll
        for (int ai = 0; ai < 2; ++ai)
#pragma unroll
            for (int m = 0; m < 4; ++m) { unsigned char* rowp = O + (size_t)(row0 + ai * HALF + m * 16) * 1024 + col0;
#pragma unroll
                for (int bj = 0; bj < 2; ++bj) { const f32x4 v0 = acc[ai][bj][m][0] * ascale + bv[bj][0], v1 = acc[ai][bj][m][1] * ascale + bv[bj][1];
                    *(unsigned long long*)(rowp + bj * HALF) = (unsigned long long)pk4_fp8(v0[0], v0[1], v0[2], v0[3]) | ((unsigned long long)pk4_fp8(v1[0], v1[1], v1[2], v1[3]) << 32); } }
    }
};
struct EpiResGate {
    static constexpr bool PERM = false, AFTER_DRAIN = false;
    bf16_t* X; const float* gate;
    __device__ __forceinline__ void operator()(const f32x4 (&acc)[2][2][4][2], const Unit& u, int wr, int wc, int fr, int fq) const {
        const int row0 = u.pm * BM + wr * 64 + fr; const int col0 = u.pn * BM + wc * 32 + 4 * fq;
        const int bb = u.pm / 17, mr = (u.pm - bb * 17 == 0) ? 8 : bb;
        const float* gp = gate + (size_t)mr * 6144 + col0;
        f32x4 gv[2][2];
#pragma unroll
        for (int bj = 0; bj < 2; ++bj)
#pragma unroll
            for (int n = 0; n < 2; ++n) gv[bj][n] = *(const f32x4*)(gp + bj * HALF + n * 16);
#pragma unroll
        for (int ai = 0; ai < 2; ++ai)
#pragma unroll
            for (int m = 0; m < 4; ++m) { bf16_t* rowp = X + (size_t)(row0 + ai * HALF + m * 16) * 1024 + col0;
#pragma unroll
                for (int bj = 0; bj < 2; ++bj)
#pragma unroll
                    for (int n = 0; n < 2; ++n) { unsigned long long* p = (unsigned long long*)(rowp + bj * HALF + n * 16); const unsigned long long v = *p;
                        f32x4 x = (f32x4){__uint_as_float((unsigned)(v & 0xffffu) << 16), __uint_as_float((unsigned)(v >> 16) << 16), __uint_as_float((unsigned)((v >> 32) & 0xffffu) << 16), __uint_as_float((unsigned)(v >> 48) << 16)};
                        x = x + gv[bj][n] * acc[ai][bj][m][n];
                        *p = (unsigned long long)cvt_pk_bf16(x[0], x[1]) | ((unsigned long long)cvt_pk_bf16(x[2], x[3]) << 32); } }
    }
};
struct EpiSwiGLU {
    static constexpr bool PERM = true, AFTER_DRAIN = false;
    bf16_t* O; const float* bias;
    __device__ __forceinline__ void operator()(const f32x4 (&acc)[2][2][4][2], const Unit& u, int wr, int wc, int fr, int fq) const {
        const int row0 = u.pm * BM + wr * 64 + fr; const int col0 = u.pn * HALF + wc * 32 + 8 * fq;
        const float* bp = bias + (size_t)u.e * 2048 + col0;
        f32x4 bg[2], bu[2];
#pragma unroll
        for (int n = 0; n < 2; ++n) { bg[n] = *(const f32x4*)(bp + 4 * n); bu[n] = *(const f32x4*)(bp + 1024 + 4 * n); }
#pragma unroll
        for (int ai = 0; ai < 2; ++ai)
#pragma unroll
            for (int m = 0; m < 4; ++m) { bf16_t* rowp = O + (size_t)(row0 + ai * HALF + m * 16) * 1024 + col0;
                float r[8];
#pragma unroll
                for (int n = 0; n < 2; ++n) { const f32x4 gt = acc[ai][0][m][n] + bg[n], up = acc[ai][1][m][n] + bu[n];
#pragma unroll
                    for (int i = 0; i < 4; ++i) { const float g = fminf(gt[i], 7.0f), uu = fminf(fmaxf(up[i], -7.0f), 7.0f);
                        const float sg = __builtin_amdgcn_rcpf(1.0f + __builtin_amdgcn_exp2f(-1.702f * 1.4426950408889634f * g));
                        r[4 * n + i] = (uu + 1.0f) * (g * sg); } }
                u32x4 w; w.x = cvt_pk_bf16(r[0], r[1]); w.y = cvt_pk_bf16(r[2], r[3]); w.z = cvt_pk_bf16(r[4], r[5]); w.w = cvt_pk_bf16(r[6], r[7]);
                *(u32x4*)rowp = w; }
    }
};
struct EpiSwiGLU8 {
    static constexpr bool PERM = true, AFTER_DRAIN = false;
    unsigned char* O; const float* bias; float ascale;
    __device__ __forceinline__ void operator()(const f32x4 (&acc)[2][2][4][2], const Unit& u, int wr, int wc, int fr, int fq) const {
        const int row0 = u.pm * BM + wr * 64 + fr; const int col0 = u.pn * HALF + wc * 32 + 8 * fq;
        const float* bp = bias + (size_t)u.e * 2048 + col0;
        f32x4 bg[2], bu[2];
#pragma unroll
        for (int n = 0; n < 2; ++n) { bg[n] = *(const f32x4*)(bp + 4 * n); bu[n] = *(const f32x4*)(bp + 1024 + 4 * n); }
#pragma unroll
        for (int ai = 0; ai < 2; ++ai)
#pragma unroll
            for (int m = 0; m < 4; ++m) { unsigned char* rowp = O + (size_t)(row0 + ai * HALF + m * 16) * 1024 + col0;
                float r[8];
#pragma unroll
                for (int n = 0; n < 2; ++n) { const f32x4 gt = acc[ai][0][m][n] * ascale + bg[n], up = acc[ai][1][m][n] * ascale + bu[n];
#pragma unroll
                    for (int i = 0; i < 4; ++i) { const float g = fminf(gt[i], 7.0f), uu = fminf(fmaxf(up[i], -7.0f), 7.0f);
                        const float sg = __builtin_amdgcn_rcpf(1.0f + __builtin_amdgcn_exp2f(-1.702f * 1.4426950408889634f * g));
                        r[4 * n + i] = (uu + 1.0f) * (g * sg); } }
                *(unsigned long long*)rowp = (unsigned long long)pk4_fp8(r[0], r[1], r[2], r[3]) | ((unsigned long long)pk4_fp8(r[4], r[5], r[6], r[7]) << 32); }
    }
};
struct EpiBiasBf16 {
    static constexpr bool PERM = true, AFTER_DRAIN = false;
    bf16_t* O; const float* bias; float ascale;
    __device__ __forceinline__ void operator()(const f32x4 (&acc)[2][2][4][2], const Unit& u, int wr, int wc, int fr, int fq) const {
        const int row0 = u.pm * BM + wr * 64 + fr; const int col0 = u.pn * BM + wc * 32 + 8 * fq;
        const float* bp = bias + (size_t)u.e * 1024 + col0;
        f32x4 bv[2][2];
#pragma unroll
        for (int bj = 0; bj < 2; ++bj)
#pragma unroll
            for (int n = 0; n < 2; ++n) bv[bj][n] = *(const f32x4*)(bp + bj * HALF + 4 * n);
#pragma unroll
        for (int ai = 0; ai < 2; ++ai)
#pragma unroll
            for (int m = 0; m < 4; ++m) { bf16_t* rowp = O + (size_t)(row0 + ai * HALF + m * 16) * 1024 + col0;
#pragma unroll
                for (int bj = 0; bj < 2; ++bj) { const f32x4 v0 = acc[ai][bj][m][0] * ascale + bv[bj][0], v1 = acc[ai][bj][m][1] * ascale + bv[bj][1];
                    u32x4 w; w.x = cvt_pk_bf16(v0[0], v0[1]); w.y = cvt_pk_bf16(v0[2], v0[3]); w.z = cvt_pk_bf16(v1[0], v1[1]); w.w = cvt_pk_bf16(v1[2], v1[3]);
                    *(u32x4*)(rowp + bj * HALF) = w; } }
    }
};

template <class Epi, class Sched, bool ALIGN_EPI = false, bool SP2 = false, bool GATHER = false, bool F8 = false>
__device__ __forceinline__ void gemm_phase(PG8_LAS unsigned char* lds, const Gemm g, const Sched& S, const Epi& E, int tid_in) {
    int tid_l = tid_in; asm volatile("" : "+v"(tid_l));
    const int tid = tid_l, wid = __builtin_amdgcn_readfirstlane(tid >> 6), lane = tid & 63, wr = wid >> 2, wc = wid & 3, fr = lane & 15, fq = lane >> 4;
    const int K = g.K, nt = K / BK;
    unsigned voffA[2], voffB[2];
#pragma unroll
    for (int i = 0; i < 2; ++i) { int R, C; stage_rc(tid * 16 + i * 8192, R, C); const int Rb = Epi::PERM ? ((R & ~31) + perm32(R & 31)) : R;
        voffA[i] = (unsigned)(R * K + C) * 2u; voffB[i] = (unsigned)(Rb * K + C) * 2u; }
    const size_t kstep = (size_t)(BK * 2);
    static_assert(!GATHER || SP2, "GATHER is wired into the SP2 loop only");
    unsigned vAc0[2], vAc1[2], vAn0[2], vAn1[2]; int gR[2]; unsigned gC[2];
#pragma unroll
    for (int i = 0; i < 2; ++i) { int R, C; stage_rc(tid * 16 + i * 8192, R, C); gR[i] = R; gC[i] = (unsigned)C * 2u; vAc0[i] = voffA[i]; vAc1[i] = voffA[i]; vAn0[i] = voffA[i]; vAn1[i] = voffA[i]; }
#define PG8_GFETCH(d0, d1, ord) do { if constexpr (GATHER) { _Pragma("unroll") for (int _i = 0; _i < 2; ++_i) { \
        d0[_i] = (unsigned)g.rowtab[(ord) * 256 + gR[_i]] * (unsigned)(K * 2) + gC[_i]; d1[_i] = (unsigned)g.rowtab[(ord) * 256 + 128 + gR[_i]] * (unsigned)(K * 2) + gC[_i]; } } } while (0)
    const size_t hstep = (size_t)HALF * K * 2;
    const size_t hstepA = GATHER ? 0 : hstep;
    const size_t tstep = 2 * hstep;
    const unsigned ldsw = (unsigned)wid * 1024u;
    const int aoff = lds_byte(wr * 64 + fr, fq * 8), boff = lds_byte(wc * 32 + fr, fq * 8);
    typedef int v8i_t __attribute__((ext_vector_type(8))); typedef short v16s_a16 __attribute__((ext_vector_type(16), aligned(16)));
    const int f8c = 32 * (fq >> 1) + 16 * (fq & 1);
    const int aoff8a = lds_byte(wr * 64 + fr, f8c), boff8a = lds_byte(wc * 32 + fr, f8c);
    v8i_t At8[4], Au8[4], B08[2], B18[2]; int f8scale = 127; asm volatile("" : "+v"(f8scale));
#define PG8_SA(b, h) (((b) * 2 + (h)) * HTB)
#define PG8_SB(b, h) ((4 + (b) * 2 + (h)) * HTB)
#define PG8_STAGE(bufoff, gbase, voff) do { _Pragma("unroll") for (int _i = 0; _i < 2; ++_i) \
        __builtin_amdgcn_global_load_lds((const unsigned*)((const char*)(gbase) + (voff)[_i]), (PG8_LAS unsigned*)(lds + (bufoff) + ldsw + _i * 8192), 16, 0, 0); } while (0)
#define PG8_LDA(dst, b, h) do { if constexpr (F8) { _Pragma("unroll") for (int m = 0; m < 4; ++m) { const bf16x8 lo_ = *(const PG8_LAS bf16x8*)(lds + PG8_SA(b, h) + aoff8a + m * 2048), hi_ = *(const PG8_LAS bf16x8*)(lds + PG8_SA(b, h) + aoff8a + m * 2048 + 16); dst##8[m] = __builtin_bit_cast(v8i_t, __builtin_shufflevector(lo_, hi_, 0, 1, 2, 3, 4, 5, 6, 7, 8, 9, 10, 11, 12, 13, 14, 15)); } } \
        else { _Pragma("unroll") for (int m = 0; m < 4; ++m) _Pragma("unroll") for (int k = 0; k < 2; ++k) dst[m][k] = *(const PG8_LAS bf16x8*)(lds + PG8_SA(b, h) + aoff + m * 2048 + k * 1024); } } while (0)
#define PG8_LDB(dst, b, h) do { if constexpr (F8) { _Pragma("unroll") for (int n = 0; n < 2; ++n) { const bf16x8 lo_ = *(const PG8_LAS bf16x8*)(lds + PG8_SB(b, h) + boff8a + n * 2048), hi_ = *(const PG8_LAS bf16x8*)(lds + PG8_SB(b, h) + boff8a + n * 2048 + 16); dst##8[n] = __builtin_bit_cast(v8i_t, __builtin_shufflevector(lo_, hi_, 0, 1, 2, 3, 4, 5, 6, 7, 8, 9, 10, 11, 12, 13, 14, 15)); } } \
        else { _Pragma("unroll") for (int n = 0; n < 2; ++n) _Pragma("unroll") for (int k = 0; k < 2; ++k) dst[n][k] = *(const PG8_LAS bf16x8*)(lds + PG8_SB(b, h) + boff + n * 2048 + k * 1024); } } while (0)
#define PG8_MMA(ai, bj, At, Bt) do { __builtin_amdgcn_s_setprio(1); if constexpr (F8) { _Pragma("unroll") for (int m = 0; m < 4; ++m) _Pragma("unroll") for (int n = 0; n < 2; ++n) \
            asm volatile("v_mfma_scale_f32_16x16x128_f8f6f4 %0, %1, %2, %0, %3, %3 op_sel_hi:[0,0,0]" : "+v"(acc[ai][bj][m][n]) : "v"(Bt##8[n]), "v"(At##8[m]), "v"(f8scale)); } \
        else { _Pragma("unroll") for (int m = 0; m < 4; ++m) _Pragma("unroll") for (int n = 0; n < 2; ++n) _Pragma("unroll") for (int k = 0; k < 2; ++k) \
        acc[ai][bj][m][n] = __builtin_amdgcn_mfma_f32_16x16x32_bf16(Bt[n][k], At[m][k], acc[ai][bj][m][n], 0, 0, 0); } __builtin_amdgcn_s_setprio(0); } while (0)
#define PG8_WAIT_V(n) asm volatile("s_waitcnt vmcnt(" #n ")" ::: "memory")
#define PG8_WAIT_L(n) asm volatile("s_waitcnt lgkmcnt(" #n ")" ::: "memory")
#define PG8_BAR __builtin_amdgcn_s_barrier()
#define PG8_SCHED __builtin_amdgcn_sched_barrier(0)
    Unit cur, nxt; int ui = 0;
    if (!S.next(0, cur)) return;
    f32x4 acc[2][2][4][2];
#pragma unroll
    for (int a = 0; a < 2; ++a)
#pragma unroll
        for (int b = 0; b < 2; ++b)
#pragma unroll
            for (int m = 0; m < 4; ++m)
#pragma unroll
                for (int n = 0; n < 2; ++n) acc[a][b][m][n] = (f32x4){0.f, 0.f, 0.f, 0.f};
    bf16x8 At[4][2], Au[4][2], B0[2][2], B1[2][2];
    const char* cA = (const char*)g.A + (GATHER ? (size_t)0 : (size_t)cur.pm * tstep); PG8_GFETCH(vAc0, vAc1, 0); const char* cB = (const char*)g.Bt + (size_t)cur.e * g.bstride + (size_t)cur.pn * tstep;
    S.a_ready(cur);
    if constexpr (SP2) {
        PG8_STAGE(PG8_SB(0, 0), cB, voffB); PG8_STAGE(PG8_SB(0, 1), cB + hstep, voffB); PG8_STAGE(PG8_SA(0, 0), cA, vAc0); PG8_STAGE(PG8_SA(0, 1), cA + hstepA, vAc1);
        if (wr == 1) PG8_BAR;
        PG8_WAIT_V(2); PG8_BAR;
        PG8_STAGE(PG8_SB(1, 0), cB + kstep, voffB); PG8_STAGE(PG8_SA(1, 0), cA + kstep, vAc0); PG8_STAGE(PG8_SB(1, 1), cB + hstep + kstep, voffB);
        PG8_WAIT_V(6); PG8_BAR;
    } else {
        PG8_STAGE(PG8_SB(0, 0), cB, voffB); PG8_STAGE(PG8_SA(0, 0), cA, voffA); PG8_STAGE(PG8_SB(0, 1), cB + hstep, voffB); PG8_STAGE(PG8_SA(0, 1), cA + hstep, voffA);
        if (wr == 1) PG8_BAR;
        PG8_WAIT_V(4); PG8_BAR;
        PG8_STAGE(PG8_SB(1, 0), cB + kstep, voffB); PG8_STAGE(PG8_SA(1, 0), cA + kstep, voffA); PG8_STAGE(PG8_SB(1, 1), cB + hstep + kstep, voffB);
        PG8_WAIT_V(6); PG8_BAR;
    }
    for (;;) {
        const bool has_next = S.next(ui + 1, nxt);
        const char* nA = (has_next && !GATHER) ? (const char*)g.A + (size_t)nxt.pm * tstep : cA;
        if constexpr (GATHER) { if (has_next) PG8_GFETCH(vAn0, vAn1, ui + 1); else { vAn0[0] = vAc0[0]; vAn0[1] = vAc0[1]; vAn1[0] = vAc1[0]; vAn1[1] = vAc1[1]; } }
        const char* nB = has_next ? (const char*)g.Bt + (size_t)nxt.e * g.bstride + (size_t)nxt.pn * tstep : cB;
#pragma unroll 1
        for (int t = 0; t < nt; t += 2) {
            const bool last = (t == nt - 2);
            const char* a1 = cA + (size_t)(t + 1) * kstep;
            const char* a2 = last ? nA : cA + (size_t)(t + 2) * kstep; const char* b2 = last ? nB : cB + (size_t)(t + 2) * kstep;
            const char* a3 = a2 + kstep; const char* b3 = b2 + kstep;
            if (last && has_next) S.a_ready(nxt);
            unsigned vS0[2], vS1[2];
            vS0[0] = last ? vAn0[0] : vAc0[0]; vS0[1] = last ? vAn0[1] : vAc0[1]; vS1[0] = last ? vAn1[0] : vAc1[0]; vS1[1] = last ? vAn1[1] : vAc1[1];
            if constexpr (SP2) {
            PG8_LDB(B0, 0, 0); PG8_LDB(B1, 0, 1); PG8_SCHED; PG8_LDA(At, 0, 0); PG8_STAGE(PG8_SA(1, 1), a1 + hstepA, vAc1);
            PG8_WAIT_V(8); PG8_WAIT_L(0); PG8_BAR; PG8_MMA(0, 0, At, B0); PG8_MMA(0, 1, At, B1); PG8_BAR; PG8_SCHED;
            if constexpr (F8) { PG8_LDA(Au, 0, 1); } else { PG8_LDA(At, 0, 1); } PG8_STAGE(PG8_SB(0, 0), b2, voffB); PG8_STAGE(PG8_SB(0, 1), b2 + hstep, voffB); PG8_STAGE(PG8_SA(0, 0), a2, vS0);
            PG8_WAIT_V(8); PG8_WAIT_L(0); PG8_BAR; if constexpr (F8) { PG8_MMA(1, 0, Au, B0); PG8_MMA(1, 1, Au, B1); } else { PG8_MMA(1, 0, At, B0); PG8_MMA(1, 1, At, B1); } PG8_BAR; PG8_SCHED;
            PG8_LDB(B0, 1, 0); PG8_LDB(B1, 1, 1); PG8_SCHED; PG8_LDA(At, 1, 0); PG8_STAGE(PG8_SA(0, 1), a2 + hstepA, vS1);
            PG8_WAIT_V(8); PG8_WAIT_L(0); PG8_BAR; PG8_MMA(0, 0, At, B0); PG8_MMA(0, 1, At, B1); PG8_BAR; PG8_SCHED;
            if constexpr (F8) { PG8_LDA(Au, 1, 1); } else { PG8_LDA(At, 1, 1); } PG8_STAGE(PG8_SB(1, 0), b3, voffB); PG8_STAGE(PG8_SB(1, 1), b3 + hstep, voffB); PG8_STAGE(PG8_SA(1, 0), a3, vS0);
            PG8_WAIT_V(8); PG8_WAIT_L(0); PG8_BAR; if constexpr (F8) { PG8_MMA(1, 0, Au, B0); PG8_MMA(1, 1, Au, B1); } else { PG8_MMA(1, 0, At, B0); PG8_MMA(1, 1, At, B1); } PG8_BAR; PG8_SCHED;
            } else {
            PG8_LDB(B0, 0, 0); PG8_SCHED; PG8_LDA(At, 0, 0); PG8_STAGE(PG8_SA(1, 1), a1 + hstep, voffA);
            PG8_WAIT_L(8); PG8_BAR; PG8_WAIT_L(0); PG8_MMA(0, 0, At, B0); PG8_BAR; PG8_SCHED;
            PG8_LDB(B1, 0, 1); PG8_STAGE(PG8_SB(0, 0), b2, voffB);
            PG8_BAR; PG8_WAIT_L(0); PG8_MMA(0, 1, At, B1); PG8_BAR;
            PG8_LDA(At, 0, 1); PG8_STAGE(PG8_SA(0, 0), a2, voffA);
            PG8_BAR; PG8_WAIT_L(0); PG8_MMA(1, 0, At, B0); PG8_BAR; PG8_SCHED;
            PG8_STAGE(PG8_SB(0, 1), b2 + hstep, voffB);
            PG8_WAIT_V(6); PG8_BAR; PG8_MMA(1, 1, At, B1); PG8_BAR;
            PG8_LDB(B0, 1, 0); PG8_SCHED; PG8_LDA(At, 1, 0); PG8_STAGE(PG8_SA(0, 1), a2 + hstep, voffA);
            PG8_WAIT_L(8); PG8_BAR; PG8_WAIT_L(0); PG8_MMA(0, 0, At, B0); PG8_BAR; PG8_SCHED;
            PG8_LDB(B1, 1, 1); PG8_STAGE(PG8_SB(1, 0), b3, voffB);
            PG8_BAR; PG8_WAIT_L(0); PG8_MMA(0, 1, At, B1); PG8_BAR;
            PG8_LDA(At, 1, 1); PG8_STAGE(PG8_SA(1, 0), a3, voffA);
            PG8_BAR; PG8_WAIT_L(0); PG8_MMA(1, 0, At, B0); PG8_BAR; PG8_SCHED;
            PG8_STAGE(PG8_SB(1, 1), b3 + hstep, voffB);
            PG8_WAIT_V(6); PG8_BAR; PG8_MMA(1, 1, At, B1); PG8_BAR;
            }
        }
        if constexpr (ALIGN_EPI) { if (wr == 0) PG8_BAR; }
        if constexpr (F8) asm volatile("s_nop 15\n\ts_nop 15" ::: "memory");
        if constexpr (!Epi::AFTER_DRAIN) { E(acc, cur, wr, wc, fr, fq); S.done(cur); }
        if (!has_next) break;
#pragma unroll
        for (int a = 0; a < 2; ++a)
#pragma unroll
            for (int b = 0; b < 2; ++b)
#pragma unroll
                for (int m = 0; m < 4; ++m)
#pragma unroll
                    for (int n = 0; n < 2; ++n) acc[a][b][m][n] = (f32x4){0.f, 0.f, 0.f, 0.f};
        cur = nxt; cA = nA; cB = nB; ++ui;
        if constexpr (GATHER) { vAc0[0] = vAn0[0]; vAc0[1] = vAn0[1]; vAc1[0] = vAn1[0]; vAc1[1] = vAn1[1]; }
        if constexpr (ALIGN_EPI) { if (wr == 1) PG8_BAR; }
    }
    PG8_WAIT_V(0);
    if constexpr (!ALIGN_EPI) { if (wr == 0) PG8_BAR; }
    PG8_BAR;
    if constexpr (Epi::AFTER_DRAIN) { E.fused(acc, cur, wr, wc, fr, fq, lds, wid, lane); S.done(cur); }
#undef PG8_SA
#undef PG8_SB
#undef PG8_STAGE
#undef PG8_LDA
#undef PG8_LDB
#undef PG8_MMA
#undef PG8_WAIT_V
#undef PG8_WAIT_L
#undef PG8_BAR
#undef PG8_SCHED
#undef PG8_GFETCH
}
}
#include <hip/hip_bf16.h>
#include <cmath>
namespace attn_body {
using bf16=__hip_bfloat16;
using bf16x8=__attribute__((ext_vector_type(8)))short;
using s16x4=__attribute__((ext_vector_type(4)))short;
using f32x16=__attribute__((ext_vector_type(16)))float;
using u32x4=__attribute__((ext_vector_type(4)))unsigned;
constexpr int D=64,DM=1024,KVP=256;
constexpr int NW=8,QBLK=32,QB=QBLK*NW,KVBLK=64;
__device__ __forceinline__ int crow(int r,int hi){return (r&3)+8*(r>>2)+4*hi;}
#define SBAR() __builtin_amdgcn_sched_barrier(0)
__device__ __forceinline__ void cmask(f32x16&p0,f32x16&p1,int jb,int qrel,int hi){
  const float NEG=-INFINITY; int kb=64*jb+4*hi;
  #pragma unroll
  for(int r=0;r<16;++r){int kv=kb+(r&3)+8*(r>>2); if(kv>qrel)p0[r]=NEG; if(kv+32>qrel)p1[r]=NEG;}
}

constexpr int NSLOT=3, SLOTB=8192;
constexpr int LDS_K=0, LDS_V=NSLOT*SLOTB, LDS_WS=2*NSLOT*SLOTB, LDS_OST=LDS_WS+NW*64*4, LDS_BYTES=LDS_OST+NW*4096;
constexpr float C2=0.125f*1.4426950408889634f;
__device__ __forceinline__ void glds16(const void*gsrc,unsigned lds_dst){unsigned keep;
  asm volatile("s_mov_b32 %0, m0\n\ts_mov_b32 m0, %2\n\ts_nop 0\n\tglobal_load_lds_dwordx4 %1, off\n\ts_mov_b32 m0, %0":"=&s"(keep):"v"(gsrc),"s"(lds_dst):"memory");}
__device__ __forceinline__ float max3f(float a,float b,float c){float r;asm("v_max3_f32 %0, %1, %2, %3":"=v"(r):"v"(a),"v"(b),"v"(c));return r;}
__device__ __forceinline__ float max2f(float a,float b){float r;asm("v_max_f32_e32 %0, %1, %2":"=v"(r):"v"(a),"v"(b));return r;}
__device__ __forceinline__ float fadd_s(float a,float b){float r;asm("v_add_f32_e32 %0, %1, %2":"=v"(r):"v"(a),"v"(b));return r;}
__device__ __forceinline__ float fsub_s(float a,float b){float r;asm("v_sub_f32_e32 %0, %1, %2":"=v"(r):"v"(a),"v"(b));return r;}
typedef float f32x2_t __attribute__((ext_vector_type(2))); typedef __bf16 bf16x2_t __attribute__((ext_vector_type(2)));
__device__ __forceinline__ unsigned cvtpk_s(float lo,float hi){f32x2_t v={lo,hi};bf16x2_t b=__builtin_convertvector(v,bf16x2_t);return __builtin_bit_cast(unsigned,b);}
#define WAIT_BAR(N) asm volatile("s_waitcnt vmcnt(" #N ") lgkmcnt(0)\n\ts_barrier":::"memory")

__device__ __forceinline__ void qkt(f32x16&p0,f32x16&p1,const char*Kslot,const bf16x8*qr,const f32x16&negm,int r32,int hi){
  const char*kb=Kslot+hi*1024+r32*16;
  #pragma unroll
  for(int d0=0;d0<4;++d0){
    const bf16x8 b0=*reinterpret_cast<const bf16x8*>(kb+d0*2048);
    const bf16x8 b1=*reinterpret_cast<const bf16x8*>(kb+d0*2048+512);
    if(d0==0){p0=__builtin_amdgcn_mfma_f32_32x32x16_bf16(b0,qr[0],negm,0,0,0);p1=__builtin_amdgcn_mfma_f32_32x32x16_bf16(b1,qr[0],negm,0,0,0);}
    else{p0=__builtin_amdgcn_mfma_f32_32x32x16_bf16(b0,qr[d0],p0,0,0,0);p1=__builtin_amdgcn_mfma_f32_32x32x16_bf16(b1,qr[d0],p1,0,0,0);}}
}
typedef __attribute__((address_space(3))) const char* lds_cptr;
typedef short v4i16_t __attribute__((ext_vector_type(4)));
__device__ __forceinline__ void kload8(bf16x8*kf,lds_cptr kp){
  kf[0]=*(const __attribute__((address_space(3))) bf16x8*)(kp);      kf[1]=*(const __attribute__((address_space(3))) bf16x8*)(kp+512);
  kf[2]=*(const __attribute__((address_space(3))) bf16x8*)(kp+2048); kf[3]=*(const __attribute__((address_space(3))) bf16x8*)(kp+2560);
  kf[4]=*(const __attribute__((address_space(3))) bf16x8*)(kp+4096); kf[5]=*(const __attribute__((address_space(3))) bf16x8*)(kp+4608);
  kf[6]=*(const __attribute__((address_space(3))) bf16x8*)(kp+6144); kf[7]=*(const __attribute__((address_space(3))) bf16x8*)(kp+6656);
}
__device__ __forceinline__ void kload2(bf16x8*kf,lds_cptr kp,int j){ kf[2*j]=*(const __attribute__((address_space(3))) bf16x8*)(kp+j*2048); kf[2*j+1]=*(const __attribute__((address_space(3))) bf16x8*)(kp+j*2048+512); }
__device__ __forceinline__ s16x4 vtr(lds_cptr p){ return __builtin_bit_cast(s16x4,__builtin_amdgcn_ds_read_tr16_b64_v4i16((__attribute__((address_space(3))) v4i16_t*)p)); }
__device__ __forceinline__ float rowmax(const f32x16&p0,const f32x16&p1){
  float a=max3f(p0[0],p0[1],p1[0]),b=max3f(p0[2],p0[3],p1[1]);a=max3f(a,p1[2],p1[3]);
  #pragma unroll
  for(int r=4;r<16;r+=4){a=max3f(a,p0[r],p0[r+1]);b=max3f(b,p0[r+2],p0[r+3]);a=max3f(a,p1[r],p1[r+1]);b=max3f(b,p1[r+2],p1[r+3]);}
  const float m=max2f(a,b);
  auto rr=__builtin_amdgcn_permlane32_swap(__float_as_uint(m),__float_as_uint(m),false,false);
  return max2f(__uint_as_float(rr[0]),__uint_as_float(rr[1]));
}
__device__ __forceinline__ void pv(f32x16*o,int vb,bf16x8 pa0,bf16x8 pa1,bf16x8 pa2,bf16x8 pa3){
  #pragma unroll
  for(int d0=0;d0<2;++d0){s16x4 lo[4],hi[4];
    #pragma unroll
    for(int ks=0;ks<4;++ks){
      asm volatile("ds_read_b64_tr_b16 %0,%1 offset:%c2":"=&v"(lo[ks]):"v"(vb),"i"(d0*4096+ks*1024):"memory");
      asm volatile("ds_read_b64_tr_b16 %0,%1 offset:%c2":"=&v"(hi[ks]):"v"(vb),"i"(d0*4096+ks*1024+512):"memory");}
    asm volatile("s_waitcnt lgkmcnt(0)":::"memory");SBAR();
    #define PK(k) (bf16x8){lo[k][0],lo[k][1],lo[k][2],lo[k][3],hi[k][0],hi[k][1],hi[k][2],hi[k][3]}
    o[d0]=__builtin_amdgcn_mfma_f32_32x32x16_bf16(pa0,PK(0),o[d0],0,0,0);
    o[d0]=__builtin_amdgcn_mfma_f32_32x32x16_bf16(pa1,PK(1),o[d0],0,0,0);
    o[d0]=__builtin_amdgcn_mfma_f32_32x32x16_bf16(pa2,PK(2),o[d0],0,0,0);
    o[d0]=__builtin_amdgcn_mfma_f32_32x32x16_bf16(pa3,PK(3),o[d0],0,0,0);
    #undef PK
  }
}

#ifndef ATTN_STORE16
#define ATTN_STORE16(p,v) (*(u32x4*)(p)=(v))
#endif
template<int THRL> __device__ __forceinline__ void attn_unit(long qrow0,long kvrow0,int NT,int h,const bf16*Q,const bf16*__restrict__ K,const bf16*__restrict__ V,bf16*O,char*shm,int tid_in){
  int tid_l=tid_in; asm volatile("":"+v"(tid_l)); const int tid=tid_l,lane=tid&63,r32=lane&31,hi=lane>>5; const int wid=__builtin_amdgcn_readfirstlane(tid>>6);
  const bf16*Qw=Q+(qrow0+wid*QBLK)*DM+h*D;
  const bf16*Kh=K+kvrow0*KVP+(h>>2)*D,*Vh=V+kvrow0*KVP+(h>>2)*D;
  const unsigned lds0=(unsigned)(uintptr_t)shm;
  float*wsf=(float*)(shm+LDS_WS)+wid*64;
  const bf16*ksrc=Kh+(long)lane*KVP+wid*8;
  const bf16*vsrc=Vh+(long)(16*(wid&3)+(lane>>2))*KVP+(wid>>2)*32+(lane&3)*8;
  const unsigned kdst=lds0+LDS_K+wid*1024, vdst=lds0+LDS_V+wid*1024;
  #define DMA_K(t,slot) glds16(ksrc+(long)(t)*KVBLK*KVP,(unsigned)__builtin_amdgcn_readfirstlane(kdst+(slot)))
  #define DMA_V(t,slot) glds16(vsrc+(long)(t)*KVBLK*KVP,(unsigned)__builtin_amdgcn_readfirstlane(vdst+(slot)))
  const int vb0=(int)(lds0+LDS_V)+((lane>>4)&1)*32+(lane&3)*8+(4*hi+((lane&15)>>2))*64;
  const char*Kbase=shm+LDS_K; bf16x8 kf[8];
  const lds_cptr shm3=(lds_cptr)shm; const lds_cptr kp0=shm3+LDS_K+hi*1024+r32*16; const lds_cptr vp0=shm3+LDS_V+((lane>>4)&1)*32+(lane&3)*8+(4*hi+((lane&15)>>2))*64;
  DMA_K(0,0);DMA_V(0,0);DMA_K(1,SLOTB);
  bf16x8 qr[4];
  #pragma unroll
  for(int d0=0;d0<4;++d0)qr[d0]=*reinterpret_cast<const bf16x8*>(&Qw[(long)r32*DM+d0*16+hi*8]);
  float mhat=0.f,l_reg=0.f;f32x16 o[2];o[0]=f32x16{};o[1]=f32x16{};f32x16 negm=f32x16{};asm volatile("":"+v"(negm));
  #define CMASK(P0,P1,t) do{}while(0)
  bool resc=false;
  #define START(P0,P1) do{ const float rm=rowmax(P0,P1); resc=false; \
    { const float dl=rm; mhat=fadd_s(mhat,dl); \
      _Pragma("unroll") for(int r=0;r<16;++r){P0[r]=fsub_s(P0[r],dl);P1[r]=fsub_s(P1[r],dl);} \
      _Pragma("unroll") for(int r=0;r<16;++r)negm[r]=-mhat; asm volatile("":"+v"(negm)); } \
    _Pragma("unroll") for(int r=0;r<16;++r)P0[r]=__builtin_amdgcn_exp2f(P0[r]); }while(0)
  #define RESC() do{ if(resc){ asm volatile("s_waitcnt lgkmcnt(0)":::"memory"); \
      _Pragma("unroll") for(int d_=0;d_<2;++d_) _Pragma("unroll") for(int r=0;r<16;++r)o[d_][r]*=wsf[crow(r,hi)]; } }while(0)
  f32x16 pA0,pA1,pB0,pB1;
  int sl_prev=0,sl_cur=0,sl_next=SLOTB;
  #define ROT() do{sl_prev=sl_cur;sl_cur=sl_next;sl_next=(sl_next==(NSLOT-1)*SLOTB)?0:sl_next+SLOTB;}while(0)
  DMA_K(2,2*SLOTB);
  WAIT_BAR(3);
  qkt(pA0,pA1,Kbase,qr,negm,r32,hi);asm volatile("s_nop 15\n\ts_nop 7":"+v"(pA0),"+v"(pA1));CMASK(pA0,pA1,0);
  START(pA0,pA1);
  _Pragma("unroll") for(int r=0;r<16;++r)pA1[r]=__builtin_amdgcn_exp2f(pA1[r]);
  WAIT_BAR(0);
  DMA_K(3,0);DMA_V(1,SLOTB);
  ROT();
  kload8(kf,kp0+sl_cur);
  WAIT_BAR(2);
  s16x4 vlo[8],vhi[8]; u32x4 pw0,pw1,pw2,pw3;
  #define PKW(P,B) cvtpk_s(P[B],P[B+1])
  #define PAF(k) __builtin_bit_cast(bf16x8,pw##k)
  #define VFR(i) (bf16x8){vlo[i][0],vlo[i][1],vlo[i][2],vlo[i][3],vhi[i][0],vhi[i][1],vhi[i][2],vhi[i][3]}
  #define PIN(x) asm volatile("":"+v"(x))
  #define MX3(a,b,c) __builtin_fmaxf(__builtin_fmaxf((a),(b)),(c))
  #define GAPA(MF,A0,A1,A2,A3,W0,W1,PW) do{ MF; sacc+=A0; sacc+=A1; sacc+=A2; sacc+=A3; PIN(sacc); W0; W1; PIN(PW); SBAR(); }while(0)
  #define EX(v) __builtin_amdgcn_exp2f(v)
  #define GAPB(MF,X,B) do{ MF; X[B]=EX(X[B]); X[B+1]=EX(X[B+1]); X[B+2]=EX(X[B+2]); X[B+3]=EX(X[B+3]); PIN(X); SBAR(); }while(0)
  #define VRD(i) do{ vlo[i]=vtr(vp_+(((i)>>2)*4096+((i)&3)*1024)); vhi[i]=vtr(vp_+(((i)>>2)*4096+((i)&3)*1024+512)); }while(0)
  #define KRD(G,j) do{ if(G){ kload2(kf,kp0+sl_next,j); SBAR(); } }while(0)
  #define STEP(C0,C1,P0,P1,t,GK,GV,GL) do{ SBAR(); \
    const lds_cptr vp_=vp0+sl_prev; \
    VRD(0); SBAR(); float sacc=(P0[0]+P0[1]); \
    GAPA(C0=__builtin_amdgcn_mfma_f32_32x32x16_bf16(kf[0],qr[0],negm,0,0,0), P0[2],P0[3],P0[4],P0[5],     pw0[0]=PKW(P0,0), pw0[1]=PKW(P0,2), pw0); \
    VRD(4); SBAR(); GAPA(C1=__builtin_amdgcn_mfma_f32_32x32x16_bf16(kf[1],qr[0],negm,0,0,0), P0[6],P0[7],P0[8],P0[9],     pw0[2]=PKW(P0,4), pw0[3]=PKW(P0,6), pw0); \
    VRD(1); SBAR(); GAPA(C0=__builtin_amdgcn_mfma_f32_32x32x16_bf16(kf[2],qr[1],C0,0,0,0),   P0[10],P0[11],P0[12],P0[13], pw1[0]=PKW(P0,8), pw1[1]=PKW(P0,10), pw1); \
    VRD(5); SBAR(); GAPA(C1=__builtin_amdgcn_mfma_f32_32x32x16_bf16(kf[3],qr[1],C1,0,0,0),   P0[14],P0[15],P1[0],P1[1],   pw1[2]=PKW(P0,12),pw1[3]=PKW(P0,14), pw1); \
    VRD(2); SBAR(); GAPA(C0=__builtin_amdgcn_mfma_f32_32x32x16_bf16(kf[4],qr[2],C0,0,0,0),   P1[2],P1[3],P1[4],P1[5],     pw2[0]=PKW(P1,0), pw2[1]=PKW(P1,2), pw2); \
    VRD(6); SBAR(); GAPA(C1=__builtin_amdgcn_mfma_f32_32x32x16_bf16(kf[5],qr[2],C1,0,0,0),   P1[6],P1[7],P1[8],P1[9],     pw2[2]=PKW(P1,4), pw2[3]=PKW(P1,6), pw2); \
    VRD(3); SBAR(); GAPA(C0=__builtin_amdgcn_mfma_f32_32x32x16_bf16(kf[6],qr[3],C0,0,0,0),   P1[10],P1[11],P1[12],P1[13], pw3[0]=PKW(P1,8), pw3[1]=PKW(P1,10), pw3); \
    VRD(7); SBAR(); GAPA(C1=__builtin_amdgcn_mfma_f32_32x32x16_bf16(kf[7],qr[3],C1,0,0,0),   P1[14],P1[15],0.f,0.f,       pw3[2]=PKW(P1,12),pw3[3]=PKW(P1,14), pw3); \
    l_reg+=sacc; \
    if(GK){DMA_K((t)+3,sl_cur);} if(GV){DMA_V((t)+1,sl_next);} \
    CMASK(C0,C1,t); \
    { float a=MX3(C0[0],C0[1],C1[0]),b=MX3(C0[2],C0[3],C1[1]); a=MX3(a,C1[2],C1[3]); \
      _Pragma("unroll") for(int r=4;r<16;r+=4){a=MX3(a,C0[r],C0[r+1]);b=MX3(b,C0[r+2],C0[r+3]);a=MX3(a,C1[r],C1[r+1]);b=MX3(b,C1[r+2],C1[r+3]);} \
      float rm=__builtin_fmaxf(a,b); { auto rr=__builtin_amdgcn_permlane32_swap(__float_as_uint(rm),__float_as_uint(rm),false,false); rm=__builtin_fmaxf(__uint_as_float(rr[0]),__uint_as_float(rr[1])); } \
      resc=false; \
      if(__builtin_expect(__any(rm>(float)THRL),0)){ const float dl=__builtin_fmaxf(rm,0.f); mhat+=dl; \
        _Pragma("unroll") for(int r=0;r<16;++r){C0[r]-=dl;C1[r]-=dl;} \
        _Pragma("unroll") for(int r=0;r<16;++r)negm[r]=-mhat; asm volatile("":"+v"(negm)); \
        const float f=__builtin_amdgcn_exp2f(-dl); l_reg*=f; if(hi==0)wsf[r32]=f; resc=true; } } \
    SBAR(); \
    GAPB(o[0]=__builtin_amdgcn_mfma_f32_32x32x16_bf16(PAF(0),VFR(0),o[0],0,0,0), C0,0); \
    GAPB(o[1]=__builtin_amdgcn_mfma_f32_32x32x16_bf16(PAF(0),VFR(4),o[1],0,0,0), C0,4); \
    KRD(GL,0); GAPB(o[0]=__builtin_amdgcn_mfma_f32_32x32x16_bf16(PAF(1),VFR(1),o[0],0,0,0), C0,8); \
    KRD(GL,1); GAPB(o[1]=__builtin_amdgcn_mfma_f32_32x32x16_bf16(PAF(1),VFR(5),o[1],0,0,0), C0,12); \
    KRD(GL,2); GAPB(o[0]=__builtin_amdgcn_mfma_f32_32x32x16_bf16(PAF(2),VFR(2),o[0],0,0,0), C1,0); \
    KRD(GL,3); GAPB(o[1]=__builtin_amdgcn_mfma_f32_32x32x16_bf16(PAF(2),VFR(6),o[1],0,0,0), C1,4); \
    GAPB(o[0]=__builtin_amdgcn_mfma_f32_32x32x16_bf16(PAF(3),VFR(3),o[0],0,0,0), C1,8); \
    GAPB(o[1]=__builtin_amdgcn_mfma_f32_32x32x16_bf16(PAF(3),VFR(7),o[1],0,0,0), C1,12); \
    }while(0)
  int t=1;
  #undef CMASK
  #define CMASK(P0,P1,t) do{}while(0)
  for(;t+5<NT;t+=2){
    STEP(pB0,pB1,pA0,pA1,t,true,true,true);     WAIT_BAR(2); RESC(); ROT();
    STEP(pA0,pA1,pB0,pB1,t+1,true,true,true);   WAIT_BAR(2); RESC(); ROT();
  }
  #undef CMASK
  #define CMASK(P0,P1,t) do{}while(0)
  #define ENDW(tt) do{ if((tt)+3<NT){WAIT_BAR(2);} else if((tt)+2<NT){WAIT_BAR(1);} else {WAIT_BAR(0);} }while(0)
  for(;t+1<NT;t+=2){
    STEP(pB0,pB1,pA0,pA1,t,(t+3<NT),(t+1<NT),(t+1<NT));       ENDW(t);   RESC(); ROT();
    STEP(pA0,pA1,pB0,pB1,t+1,(t+4<NT),(t+2<NT),(t+2<NT));     ENDW(t+1); RESC(); ROT();
  }
  STEP(pB0,pB1,pA0,pA1,NT-1,false,false,false); RESC();
  { float sacc=pB0[0]+pB0[1]; _Pragma("unroll") for(int r=2;r<16;++r)sacc+=pB0[r]; _Pragma("unroll") for(int r=0;r<16;++r)sacc+=pB1[r]; l_reg+=sacc;
    pw0=(u32x4){PKW(pB0,0),PKW(pB0,2),PKW(pB0,4),PKW(pB0,6)};pw1=(u32x4){PKW(pB0,8),PKW(pB0,10),PKW(pB0,12),PKW(pB0,14)};pw2=(u32x4){PKW(pB1,0),PKW(pB1,2),PKW(pB1,4),PKW(pB1,6)};pw3=(u32x4){PKW(pB1,8),PKW(pB1,10),PKW(pB1,12),PKW(pB1,14)};
    SBAR(); pv(o,vb0+sl_cur,PAF(0),PAF(1),PAF(2),PAF(3)); }
  #undef PKW
  #undef PAF
  #undef VFR
  #undef PIN
  #undef MX3
  #undef GAPA
  #undef GAPB
  #undef EX
  #undef VRD
  #undef KRD
  #undef STEP
  #undef ENDW
  {auto rr=__builtin_amdgcn_permlane32_swap(__float_as_uint(l_reg),__float_as_uint(l_reg),false,false);l_reg=__uint_as_float(rr[0])+__uint_as_float(rr[1]);}
  if(hi==0)wsf[32+r32]=l_reg;asm volatile("s_waitcnt lgkmcnt(0)":::"memory");
  float rli[16];
  #pragma unroll
  for(int r=0;r<16;++r)rli[r]=__builtin_amdgcn_rcpf(wsf[32+crow(r,hi)]);
  bf16*Ow=O+(qrow0+wid*QBLK)*DM+h*D;
  { bf16*stg=(bf16*)(shm+LDS_OST)+wid*2048;
    #pragma unroll
    for(int r=0;r<16;++r){const int orow=crow(r,hi);
      #pragma unroll
      for(int d0=0;d0<2;++d0)stg[orow*64+d0*32+r32]=__float2bfloat16(o[d0][r]*rli[r]);}
    asm volatile("s_waitcnt lgkmcnt(0)":::"memory");
    #pragma unroll
    for(int i=0;i<4;++i){const int row=i*8+(lane>>3),ch=lane&7; const u32x4 v=*(const u32x4*)(stg+row*64+ch*8); ATTN_STORE16(Ow+(long)row*DM+ch*8,v);} }
  asm volatile("s_waitcnt lgkmcnt(0)\n\ts_barrier":::"memory");
  #undef DMA_K
  #undef DMA_V
  #undef CMASK
  #undef START
  #undef RESC
  #undef ROT
}
constexpr int ATTN_LDS_BYTES=LDS_BYTES;
#undef SBAR
#undef WAIT_BAR
}

constexpr int NWAVES = 8;
constexpr int NB = 8, SEQ = 4096, CTXL = 256, TB = SEQ + CTXL  , MT = NB * TB  , DMODEL = 1024;
constexpr int NMODC = 6 * DMODEL, MODROWS = 9;
constexpr int QKVN = 1536, WINN = 3104, WINP = 3328;
constexpr int NEXP = 32, TOPK = 4, MPAD = MT * TOPK + NEXP * 256;
constexpr int NLAYER = 4;
constexpr float RMS_EPS = 1e-6f;
constexpr float ATT_C2 = 0.125f * 1.4426950408889634f;

constexpr size_t MiB = 1u << 20;
constexpr size_t WS_CTL = 0, CTL_ZERO_BYTES = 1 * MiB;
constexpr size_t WS_MOD = 1 * MiB, WS_ROPE = 2 * MiB, WS_MODP = 3 * MiB;
constexpr size_t WS_SLOT = 17 * MiB, WS_GATEW = 18 * MiB, WS_SLOTPOS = 19 * MiB;
constexpr size_t WS_WQKV = 20 * MiB, WS_WOA = 26 * MiB, WS_WIN = 30 * MiB, WS_WOG = 43 * MiB, WS_WGU = 48 * MiB, WS_WDN = 560 * MiB;
constexpr size_t WS_X = 816 * MiB, WS_XN = 952 * MiB, WS_Q = 1020 * MiB, WS_K = 1088 * MiB, WS_V = 1105 * MiB, WS_G = 1122 * MiB;
constexpr size_t WS_OF = 1343 * MiB, WS_OB = 1479 * MiB, WS_XG = 1615 * MiB, WS_ACT = 1903 * MiB, WS_Y = 2191 * MiB, WS_XN8 = WS_ACT + 150 * MiB  , WS_PAR = 2479 * MiB, WS_LIST = 2483 * MiB  , WS_END = 2488 * MiB;
static_assert(WS_MODP + (size_t)16 * NLAYER * MODROWS * NMODC * 4 <= WS_SLOT && WS_WIN + (size_t)2 * WINP * 1024 * 2 <= WS_WOG && WS_G + (size_t)MT * WINP * 2 <= WS_OF && WS_XG + (size_t)MPAD * 1024 * 2 <= WS_ACT, "ws map");
constexpr int CW_TMO = 0, CW_BAR = 4096, CW_CNT = 16384;

constexpr int RING_OFF = 0, RING_BYTES = 131072;
constexpr int WR_STRIDE = 1028;
constexpr int LDS_AUX = 133120;
constexpr int AUX_LCNT = LDS_AUX, AUX_GB = LDS_AUX + 128, AUX_T2E = LDS_AUX + 256  , AUX_BASE = AUX_T2E + 2560  , AUX_NT = AUX_BASE + 128, AUX_CNT = AUX_NT + 64  , AUX_ENT = AUX_CNT + 128  , AUX_RS = AUX_ENT + 4352  , AUX_ROWTAB = AUX_RS + 576, ROWTAB_UNITS = 18  ;
constexpr int MISC_OFF = 154624;
constexpr int LDS_BYTES = 155648;
static_assert(AUX_ROWTAB + ROWTAB_UNITS * 512 <= MISC_OFF, "LDS map");

#define GAS __attribute__((address_space(1)))
#define LAS __attribute__((address_space(3)))
typedef unsigned short bf16;
typedef unsigned v4u __attribute__((ext_vector_type(4)));
typedef float f32x4 __attribute__((ext_vector_type(4)));
typedef short bf16x8 __attribute__((ext_vector_type(8)));
typedef GAS unsigned gu32;
typedef GAS unsigned long long gu64;
#define RLX_AGENT __ATOMIC_RELAXED, __HIP_MEMORY_SCOPE_AGENT
#define LDS_WAIT() asm volatile("s_waitcnt lgkmcnt(0)" ::: "memory")
#define VM_WAIT() asm volatile("s_waitcnt vmcnt(0)" ::: "memory")
__device__ __forceinline__ unsigned long long rt() { return __builtin_amdgcn_s_memrealtime(); }
__device__ __forceinline__ unsigned f2bf(float f) { unsigned u = __builtin_bit_cast(unsigned, f); return (u + 0x7fffu + ((u >> 16) & 1u)) >> 16; }
__device__ __forceinline__ unsigned pk2(float lo, float hi) { return f2bf(lo) | (f2bf(hi) << 16); }

#define XB_TMO      128
#define XB_XCNT(j)  (256  + 64 * (j))
#define XB_XSUB(j)  (1280 + 64 * (j))
#define XB_XGEN(j)  (2304 + 64 * (j))
#define XB_TOP      3328
#define XB_TOPGEN   3392
#define XCD_BAR_WORDS 3456
#define XB_SPIN_CAP (1u << 18)

__device__ __forceinline__ unsigned xb_ld(unsigned* p)              { return __hip_atomic_load(p, __ATOMIC_RELAXED, __HIP_MEMORY_SCOPE_AGENT); }
__device__ __forceinline__ unsigned xb_add(unsigned* p, unsigned v) { return __hip_atomic_fetch_add(p, v, __ATOMIC_RELAXED, __HIP_MEMORY_SCOPE_AGENT); }
__device__ __forceinline__ unsigned xb_xcc_id() { return (unsigned)__builtin_amdgcn_s_getreg((3 << 11) | 20) & 0xFu; }
#define XB_SPIN(cond, bar) do { unsigned _sp = 0; while (cond) { __builtin_amdgcn_s_sleep(1); \
    if ((++_sp & 255u) == 0u) { if (xb_ld(&(bar)[XB_TMO])) break; if (_sp > XB_SPIN_CAP) { atomicAdd(&(bar)[XB_TMO], 1u); break; } } } } while (0)

struct XcdBarrier {
    unsigned* bar; unsigned x;
    volatile LAS unsigned* st;
};

__device__ __forceinline__ XcdBarrier xcd_barrier_post(unsigned* bar, volatile LAS unsigned* st, bool xb_t0  ) {
    XcdBarrier b; b.bar = bar; b.x = xb_xcc_id(); b.st = st;
    if (xb_t0) (void)xb_add(&bar[XB_XCNT(b.x)], 1u);
    return b;
}
__device__ __forceinline__ void xcd_barrier_complete(unsigned* bar, unsigned x, unsigned& nloc, unsigned& nx) {
    const unsigned G = gridDim.x * gridDim.y * gridDim.z;
    unsigned sum, cnt, mine, sp = 0u;
    for (;;) {
        sum = 0u; cnt = 0u; mine = 0u;
#pragma unroll
        for (unsigned j = 0; j < 16; ++j) { const unsigned c = xb_ld(&bar[XB_XCNT(j)]); sum += c; cnt += (c > 0u) ? 1u : 0u; mine = (j == x) ? c : mine; }
        if (sum == G) break;
        __builtin_amdgcn_s_sleep(1);
        if ((++sp & 255u) == 0u) { if (xb_ld(&bar[XB_TMO])) break; if (sp > XB_SPIN_CAP) { atomicAdd(&bar[XB_TMO], 1u); break; } }
    }
    nloc = mine > 0u ? mine : 1u; nx = cnt > 0u ? cnt : 1u;
}

__device__ __forceinline__ void xcd_barrier(const XcdBarrier& b, bool xb_t0  ) {
    asm volatile("s_waitcnt vmcnt(0)" ::: "memory");
    __syncthreads();
    if (xb_t0) {
        unsigned* bar = b.bar;
        __builtin_amdgcn_s_waitcnt(0);
        unsigned nloc = b.st[0], nx = b.st[1];
        if (nloc == 0u) { xcd_barrier_complete(bar, b.x, nloc, nx); b.st[0] = nloc; b.st[1] = nx; }
        const unsigned old = xb_add(&bar[XB_XSUB(b.x)], 1u);
        const unsigned gen = old / nloc;
        if (old + 1u == (gen + 1u) * nloc) {
            __builtin_amdgcn_fence(__ATOMIC_RELEASE, "agent");
            asm volatile("s_waitcnt vmcnt(0)" ::: "memory");
            const unsigned og = xb_add(&bar[XB_TOP], 1u);
            const unsigned tg = og / nx;
            if (og + 1u == (tg + 1u) * nx) xb_add(&bar[XB_TOPGEN], 1u);
            else XB_SPIN(xb_ld(&bar[XB_TOPGEN]) == tg, bar);
            __builtin_amdgcn_fence(__ATOMIC_ACQUIRE, "agent");
            xb_add(&bar[XB_XGEN(b.x)], 1u);
            asm volatile("s_waitcnt vmcnt(0)" ::: "memory");
        } else {
            XB_SPIN(xb_ld(&bar[XB_XGEN(b.x)]) == gen, bar);
            __builtin_amdgcn_fence(__ATOMIC_ACQUIRE, "agent");
            asm volatile("s_waitcnt vmcnt(0)" ::: "memory");
        }
    }
    __syncthreads();
}

typedef float f32x2 __attribute__((ext_vector_type(2)));
using pg8::lane_now; using pg8::shx;
__device__ __forceinline__ float wave_sum(float v) {
    const int ln = lane_now();
#pragma unroll
    for (int o = 1; o < 64; o <<= 1) v += shx(v, o, ln);
    return v;
}
__device__ __forceinline__ float wave_max(float v) {
    const int ln = lane_now();
#pragma unroll
    for (int o = 1; o < 64; o <<= 1) v = fmaxf(v, shx(v, o, ln));
    return v;
}
__device__ __forceinline__ float bf2f(unsigned short h) { return __uint_as_float((unsigned)h << 16); }
__device__ __forceinline__ float silu_f(float x) { return x / (1.0f + __expf(-x)); }
__device__ __forceinline__ f32x4 bf4_to_f32(unsigned long long v) { return (f32x4){__uint_as_float((unsigned)(v & 0xffffu) << 16), __uint_as_float((unsigned)(v >> 16) << 16), __uint_as_float((unsigned)((v >> 32) & 0xffffu) << 16), __uint_as_float((unsigned)(v >> 48) << 16)}; }
__device__ __forceinline__ unsigned long long f32_to_bf4(f32x4 y) { return (unsigned long long)pk2(y.x, y.y) | ((unsigned long long)pk2(y.z, y.w) << 32); }
__device__ __forceinline__ int mod_row(int m) { const int b = m / TB; return (m - b * TB < CTXL) ? 8 : b; }

__device__ __forceinline__ void titem_load(const float* W, int N, int k0, int n0, int lane, f32x4 (&v)[16]) {
    const GAS f32x4* p = (const GAS f32x4*)(W + (size_t)(k0 + 16 * (lane >> 3)) * N + n0 + 4 * (lane & 7));
#pragma unroll
    for (int j = 0; j < 16; ++j) v[j] = p[(size_t)j * (N >> 2)];
}
__device__ __forceinline__ void titem_store8(const f32x4 (&v)[16], unsigned char* WT8, int K, int k0, int dst_row0, int lane) {
    unsigned char* o = WT8 + (size_t)(dst_row0 + 4 * (lane & 7)) * K + k0 + 16 * (lane >> 3);
#pragma unroll
    for (int i = 0; i < 4; ++i) { v4u q;
        q.x = pg8::pk4_fp8(v[0][i] * 32.f, v[1][i] * 32.f, v[2][i] * 32.f, v[3][i] * 32.f); q.y = pg8::pk4_fp8(v[4][i] * 32.f, v[5][i] * 32.f, v[6][i] * 32.f, v[7][i] * 32.f);
        q.z = pg8::pk4_fp8(v[8][i] * 32.f, v[9][i] * 32.f, v[10][i] * 32.f, v[11][i] * 32.f); q.w = pg8::pk4_fp8(v[12][i] * 32.f, v[13][i] * 32.f, v[14][i] * 32.f, v[15][i] * 32.f);
        *(GAS v4u*)(o + (size_t)i * K) = q; }
}
__device__ __forceinline__ void titem_store16(const f32x4 (&v)[16], bf16* WT, int K, int k0, int dst_row0, int lane) {
    bf16* o = WT + (size_t)(dst_row0 + 4 * (lane & 7)) * K + k0 + 16 * (lane >> 3);
#pragma unroll
    for (int i = 0; i < 4; ++i) { v4u q0, q1;
        q0.x = pk2(v[0][i], v[1][i]); q0.y = pk2(v[2][i], v[3][i]); q0.z = pk2(v[4][i], v[5][i]); q0.w = pk2(v[6][i], v[7][i]);
        q1.x = pk2(v[8][i], v[9][i]); q1.y = pk2(v[10][i], v[11][i]); q1.z = pk2(v[12][i], v[13][i]); q1.w = pk2(v[14][i], v[15][i]);
        *(GAS v4u*)(o + (size_t)i * K) = q0; *(GAS v4u*)(o + (size_t)i * K + 8) = q1; }
}

struct Args { const float* in[25]; float* out; unsigned char* ws; int ph_lo, ph_hi; };
constexpr int P_N1G = 0, P_N2G = 4096, P_QG = 8192, P_KG = 8320, P_GKF = 8448, P_GKB = 24832, P_BGF = 41216, P_BGB = 42240, P_OG = 43264, P_WR = 43776, P_BR = 174848, P_BGU = 174976, P_BDN = 437120, P_END = 568192;
#define LAUNDER_S(p) asm volatile("" : "+s"(p))
#define LAUNDER_V(p) asm volatile("" : "+v"(p))
#define PARF(ws) ((const float*)((ws) + WS_PAR))

constexpr int I8_GU = 128 * 8 * 64, I8_DN = 128 * 8 * 32, NI8 = I8_GU + I8_DN;
struct T8 { const float* W; unsigned char* O; int N, k0, n0, dst; };
__device__ __forceinline__ T8 dec8(const Args& A, unsigned char* ws, int it) { T8 t;
    const bool gu = it < I8_GU; const int r = gu ? it : it - I8_GU, sh = gu ? 6 : 5, mat = r >> (3 + sh), q = r & ((8 << sh) - 1), kb = q >> sh, n0 = (q & ((1 << sh) - 1)) * 32;
    t.N = gu ? 2048 : 1024; t.W = (gu ? A.in[21] : A.in[23]) + (size_t)mat * 1024 * t.N; t.O = ws + (gu ? WS_WGU : WS_WDN) + (size_t)mat * 1024 * t.N; t.k0 = kb * 128; t.n0 = n0;
    t.dst = gu ? ((n0 & 1023) >> 7) * 256 + (n0 >> 10) * 128 + (n0 & 127) : n0;
    return t; }
__device__ __forceinline__ void p0_prologue(const Args& A, LAS unsigned char* lds, int gw, int NGW, int wave, int lane) {
    unsigned char* ws = A.ws;
    { f32x4 va[16], vb[16]; int it = gw;
      if (it < NI8) { const T8 t = dec8(A, ws, it); titem_load(t.W, t.N, t.k0, t.n0, lane, va); }
      while (it + 2 * NGW < NI8) {
          { const T8 t = dec8(A, ws, it + NGW); titem_load(t.W, t.N, t.k0, t.n0, lane, vb); }
          { const T8 t = dec8(A, ws, it); titem_store8(va, t.O, 1024, t.k0, t.dst, lane); }
          { const T8 t = dec8(A, ws, it + 2 * NGW); titem_load(t.W, t.N, t.k0, t.n0, lane, va); }
          { const T8 t = dec8(A, ws, it + NGW); titem_store8(vb, t.O, 1024, t.k0, t.dst, lane); }
          it += 2 * NGW; }
      if (it < NI8) { const bool hb = it + NGW < NI8;
          if (hb) { const T8 t = dec8(A, ws, it + NGW); titem_load(t.W, t.N, t.k0, t.n0, lane, vb); }
          { const T8 t = dec8(A, ws, it); titem_store8(va, t.O, 1024, t.k0, t.dst, lane); }
          if (hb) { const T8 t = dec8(A, ws, it + NGW); titem_store8(vb, t.O, 1024, t.k0, t.dst, lane); } } }
    constexpr int J_QKV = 2 * 8 * (QKVN / 32), J_WO = 2 * 8 * 32, J_WIN = 2 * 8 * (WINN / 32), NJ = J_QKV + J_WO + J_WIN + J_WO;
    for (int it = gw; it < NJ; it += NGW) { int r = it; const float* W; bf16* O; int N, kb, n0, dst;
        if (r < J_QKV) { const int per = 8 * (QKVN / 32), mat = r / per, q = r - mat * per; kb = q / (QKVN / 32); n0 = (q - kb * (QKVN / 32)) * 32;
            dst = (n0 & ~255) + ((n0 >> 5) & 1) * 128 + ((n0 >> 6) & 3) * 32;
            W = A.in[8] + (size_t)mat * 1024 * QKVN; N = QKVN; O = (bf16*)(ws + WS_WQKV) + (size_t)mat * QKVN * 1024; }
        else if ((r -= J_QKV) < J_WO) { const int mat = r >> 8, q = r & 255; kb = q >> 5; n0 = (q & 31) * 32; dst = n0;
            W = A.in[11] + (size_t)mat * 1024 * 1024; N = 1024; O = (bf16*)(ws + WS_WOA) + (size_t)mat * 1024 * 1024; }
        else if ((r -= J_WO) < J_WIN) { const int per = 8 * (WINN / 32), mat = r / per, q = r - mat * per; kb = q / (WINN / 32); n0 = (q - kb * (WINN / 32)) * 32; dst = n0;
            W = A.in[12] + (size_t)mat * 1024 * WINN; N = WINN; O = (bf16*)(ws + WS_WIN) + (size_t)mat * WINP * 1024; }
        else { r -= J_WIN; const int mat = r >> 8, q = r & 255; kb = q >> 5; n0 = (q & 31) * 32; dst = n0;
            W = A.in[18] + (size_t)mat * 1024 * 1024; N = 1024; O = (bf16*)(ws + WS_WOG) + (size_t)mat * 1024 * 1024; }
        f32x4 v[16]; titem_load(W, N, kb * 128, n0, lane, v); titem_store16(v, O, 1024, kb * 128, dst, lane); }
    for (int it = gw; it < 2 * (WINP - WINN); it += NGW) { const int mat = it / (WINP - WINN), rr = WINN + it - mat * (WINP - WINN);
        GAS v4u* p = (GAS v4u*)((bf16*)(ws + WS_WIN) + ((size_t)mat * WINP + rr) * 1024) + lane; p[0] = (v4u){0u, 0u, 0u, 0u}; p[64] = (v4u){0u, 0u, 0u, 0u}; }
    for (int it = NGW - 1 - gw; it < NLAYER * 24 * 16; it += NGW) {
        const int l = it / (24 * 16), q = it - l * (24 * 16), cg = q / 16, kc = q - cg * 16;
        float s[MODROWS];
#pragma unroll
        for (int r = 0; r < MODROWS; ++r) { const float cv = (r < 8) ? A.in[1][r * 1024 + kc * 64 + lane] : A.in[3][kc * 64 + lane]; s[r] = silu_f(cv); }
        f32x4 acc[MODROWS];
#pragma unroll
        for (int r = 0; r < MODROWS; ++r) acc[r] = (f32x4){0.f, 0.f, 0.f, 0.f};
        const float* wp = A.in[4] + ((size_t)l * 1024 + kc * 64) * NMODC + cg * 256 + 4 * lane;
#pragma unroll 8
        for (int kk = 0; kk < 64; ++kk) { const f32x4 w = *(const f32x4*)(wp + (size_t)kk * NMODC);
#pragma unroll
            for (int r = 0; r < MODROWS; ++r) { const float sv = __shfl(s[r], kk); acc[r] = acc[r] + w * sv; } }
        float* op = (float*)(ws + WS_MODP) + (size_t)kc * (NLAYER * MODROWS * NMODC) + (size_t)l * MODROWS * NMODC + cg * 256 + 4 * lane;
#pragma unroll
        for (int r = 0; r < MODROWS; ++r) *(f32x4*)(op + (size_t)r * NMODC) = acc[r];
    }
    for (int m0 = gw; m0 < MT; m0 += 4 * NGW) { f32x4 x[4][4];
#pragma unroll
        for (int r = 0; r < 4; ++r) { const int m = m0 + r * NGW; if (m < MT) { const int b = m / TB, w = m - b * TB;
            const float* src = (w < CTXL) ? A.in[2] + ((size_t)b * CTXL + w) * 1024 : A.in[0] + ((size_t)b * SEQ + (w - CTXL)) * 1024; const GAS f32x4* sp = (const GAS f32x4*)src + lane;
#pragma unroll
            for (int j = 0; j < 4; ++j) x[r][j] = sp[64 * j]; } }
#pragma unroll
        for (int r = 0; r < 4; ++r) { const int m = m0 + r * NGW; if (m < MT) { GAS unsigned long long* dp = (GAS unsigned long long*)((bf16*)(ws + WS_X) + (size_t)m * 1024) + lane;
#pragma unroll
            for (int j = 0; j < 4; ++j) dp[64 * j] = f32_to_bf4(x[r][j]); } } }
    { float* par = (float*)(ws + WS_PAR); const int gt = gw * 64 + lane, NGT = NGW * 64;
#define CPL(k, src, n) float c##k##a = 0.f, c##k##b = 0.f; if (gt < (n)) c##k##a = A.in[src][gt]; if (gt + NGT < (n)) c##k##b = A.in[src][gt + NGT];
#define CPS(k, src, n, off) if (gt < (n)) par[(off) + gt] = c##k##a; if (gt + NGT < (n)) par[(off) + gt + NGT] = c##k##b; for (int i = gt + 2 * NGT; i < (n); i += NGT) par[(off) + i] = A.in[src][i];
      CPL(0, 6, 4096) CPL(1, 7, 4096) CPL(2, 9, 128) CPL(3, 10, 128) CPL(4, 13, 16384) CPL(5, 15, 16384) CPL(6, 14, 1024) CPL(7, 16, 1024) CPL(8, 17, 512) CPL(9, 19, 131072) CPL(10, 20, 128) CPL(11, 22, 262144) CPL(12, 24, 131072)
      CPS(0, 6, 4096, P_N1G) CPS(1, 7, 4096, P_N2G) CPS(2, 9, 128, P_QG) CPS(3, 10, 128, P_KG) CPS(4, 13, 16384, P_GKF) CPS(5, 15, 16384, P_GKB) CPS(6, 14, 1024, P_BGF) CPS(7, 16, 1024, P_BGB)
      CPS(8, 17, 512, P_OG) CPS(9, 19, 131072, P_WR) CPS(10, 20, 128, P_BR) CPS(11, 22, 262144, P_BGU) CPS(12, 24, 131072, P_BDN)
#undef CPL
#undef CPS
    }
    for (int idx = gw * 64 + lane; idx < SEQ * 32; idx += NGW * 64) { const int s = idx >> 5, i = idx & 31;
        const float invf = 1.0f / powf(10000.0f, (float)(i & 15) * (1.0f / 16.0f));
        const float ang = (float)((i < 16) ? (s >> 6) : (s & 63)) * invf;
        ((float*)(ws + WS_ROPE))[idx] = cosf(ang); ((float*)(ws + WS_ROPE))[SEQ * 32 + idx] = sinf(ang); }
}
__device__ __forceinline__ void p1_mod_reduce(const Args& A, int gtid, int NGT) {
    const float* P = (const float*)(A.ws + WS_MODP); float* Mo = (float*)(A.ws + WS_MOD);
    constexpr int N = NLAYER * MODROWS * NMODC;
    for (int i = gtid; i < N; i += NGT) { const int l = i / (MODROWS * NMODC), c = i % NMODC; float s = A.in[5][l * NMODC + c];
#pragma unroll
        for (int k = 0; k < 16; ++k) s += P[(size_t)k * N + i];
        Mo[i] = s; }
}
__device__ __forceinline__ void modulate_row(const bf16* xrow, const float* ng, const float* shp, const float* scp, bf16* orow, int lane, f32x4 (&y)[4], float& rs_out) {
    const GAS unsigned long long* xr = (const GAS unsigned long long*)xrow + lane;
    float ss = 0.f;
#pragma unroll
    for (int j = 0; j < 4; ++j) { y[j] = bf4_to_f32(xr[64 * j]); ss += (y[j].x * y[j].x + y[j].y * y[j].y) + (y[j].z * y[j].z + y[j].w * y[j].w); }
    const float rs = 1.0f / sqrtf(wave_sum(ss) * (1.0f / 1024.0f) + RMS_EPS); rs_out = rs;
    GAS unsigned long long* o8 = (GAS unsigned long long*)orow + lane;
#pragma unroll
    for (int j = 0; j < 4; ++j) { const f32x4 g = ((const GAS f32x4*)ng)[64 * j + lane], sh = ((const GAS f32x4*)shp)[64 * j + lane], sc = ((const GAS f32x4*)scp)[64 * j + lane];
        y[j] = (y[j] * rs) * g * (sc + 1.0f) + sh;
        o8[64 * j] = (unsigned long long)pk2(y[j].x, y[j].y) | ((unsigned long long)pk2(y[j].z, y[j].w) << 32); }
}
__device__ __forceinline__ void modulate_row2(const bf16* xa, const bf16* xb, const float* ng, const float* sha, const float* sca, const float* shb, const float* scb, unsigned char* oa, unsigned char* ob, int lane, float& rsa, float& rsb) {
    const GAS unsigned long long* pa = (const GAS unsigned long long*)xa + lane; const GAS unsigned long long* pb = (const GAS unsigned long long*)xb + lane;
    unsigned long long ra[4], rb[4];
#pragma unroll
    for (int j = 0; j < 4; ++j) { ra[j] = pa[64 * j]; rb[j] = pb[64 * j]; }
    f32x4 ya[4], yb[4]; float sa = 0.f, sb = 0.f;
#pragma unroll
    for (int j = 0; j < 4; ++j) { ya[j] = bf4_to_f32(ra[j]); yb[j] = bf4_to_f32(rb[j]); sa += (ya[j].x * ya[j].x + ya[j].y * ya[j].y) + (ya[j].z * ya[j].z + ya[j].w * ya[j].w); sb += (yb[j].x * yb[j].x + yb[j].y * yb[j].y) + (yb[j].z * yb[j].z + yb[j].w * yb[j].w); }
    const int ln = lane_now();
#pragma unroll
    for (int o = 1; o < 64; o <<= 1) { sa += shx(sa, o, ln); sb += shx(sb, o, ln); }
    rsa = 1.0f / sqrtf(sa * (1.0f / 1024.0f) + RMS_EPS); rsb = 1.0f / sqrtf(sb * (1.0f / 1024.0f) + RMS_EPS);
    GAS unsigned* qa = (GAS unsigned*)oa + lane; GAS unsigned* qb = (GAS unsigned*)ob + lane;
#pragma unroll
    for (int j = 0; j < 4; ++j) { const f32x4 g = ((const GAS f32x4*)ng)[64 * j + lane];
        const f32x4 ha = ((const GAS f32x4*)sha)[64 * j + lane], ca = ((const GAS f32x4*)sca)[64 * j + lane], hb = ((const GAS f32x4*)shb)[64 * j + lane], cb = ((const GAS f32x4*)scb)[64 * j + lane];
        const f32x4 va = (ya[j] * rsa) * g * (ca + 1.0f) + ha, vb = (yb[j] * rsb) * g * (cb + 1.0f) + hb;
        qa[64 * j] = pg8::pk4_fp8(va.x, va.y, va.z, va.w); qb[64 * j] = pg8::pk4_fp8(vb.x, vb.y, vb.z, vb.w); }
}
__device__ __forceinline__ void phase_modulate1(unsigned char* ws, int layer, int gw, int NGW, int lane) {
    const bf16* X = (const bf16*)(ws + WS_X); bf16* XN = (bf16*)(ws + WS_XN);
    const float* ng = PARF(ws) + P_N1G + layer * 1024; const float* Mo = (const float*)(ws + WS_MOD) + (size_t)layer * MODROWS * NMODC;
    for (int m = gw; m < MT; m += NGW) { const int mr = mod_row(m); f32x4 y[4]; float rs;
        modulate_row(X + (size_t)m * 1024, ng, Mo + (size_t)mr * NMODC + 0 * 1024, Mo + (size_t)mr * NMODC + 1 * 1024, XN + (size_t)m * 1024, lane, y, rs); }
}
__device__ __forceinline__ void phase_qknorm_rope(unsigned char* ws, int la, int gw, int NGW, int lane) {
    bf16* Qb = (bf16*)(ws + WS_Q); bf16* Kb = (bf16*)(ws + WS_K);
    const float* qg = PARF(ws) + P_QG + la * 64; const float* kg = PARF(ws) + P_KG + la * 64; const float* ropec = (const float*)(ws + WS_ROPE); const float* ropes = ropec + SEQ * 32;
    const int i = lane & 31, hs = lane >> 5;
    for (int m = gw; m < MT; m += NGW) { const int b = m / TB, w = m - b * TB; const bool lat = w >= CTXL;
        float cs = 1.f, sn = 0.f; if (lat) { cs = ropec[(w - CTXL) * 32 + i]; sn = ropes[(w - CTXL) * 32 + i]; }
#pragma unroll 2
        for (int hh = 0; hh < 20; hh += 2) { const int hd = hh + hs;
            unsigned* p = (hd < 16) ? (unsigned*)(Qb + (size_t)m * 1024 + hd * 64) + i : (unsigned*)(Kb + (size_t)m * 256 + (hd - 16) * 64) + i;
            const float* gp = (hd < 16) ? qg : kg; const float scl = (hd < 16) ? ATT_C2 : 1.0f;
            const unsigned v = *p; const float x1 = __uint_as_float(v << 16), x2 = __uint_as_float(v & 0xffff0000u);
            float ss = x1 * x1 + x2 * x2;
#pragma unroll
            for (int o = 1; o < 32; o <<= 1) ss += shx(ss, o, lane);
            const float rs = 1.0f / sqrtf(ss * (1.0f / 64.0f) + RMS_EPS);
            const float y1 = x1 * rs * gp[2 * i], y2 = x2 * rs * gp[2 * i + 1];
            const float r1 = (y1 * cs - y2 * sn) * scl, r2 = (y1 * sn + y2 * cs) * scl;
            *p = pk2(r1, r2); }
    }
}
__device__ __forceinline__ void phase_gla_recurrent(unsigned char* ws, int lg, LAS unsigned char* lds, int tid) {
    const int unit = blockIdx.x; if (unit >= 128) return;
    const int half = unit & 1, dir = (unit >> 1) & 1, h = (unit >> 2) & 3, b = unit >> 4;
    const bf16* G = (const bf16*)(ws + WS_G);
    float* Oo = (float*)(ws + (dir ? WS_OB : WS_OF));
    const float* wg = PARF(ws) + (dir ? P_GKB : P_GKF) + (size_t)lg * 16 * 512; const float* bg = PARF(ws) + (dir ? P_BGB : P_BGF) + lg * 512;
    LAS float* qq = (LAS float*)(lds + RING_OFF); LAS float* kk = qq + 64 * 128; LAS float* dd = kk + 64 * 128; LAS float* vv = dd + 64 * 128;
    const int sd = tid & 127, st0 = tid >> 7;
    float wcol[16];
#pragma unroll
    for (int r = 0; r < 16; ++r) wcol[r] = wg[r * 512 + h * 128 + sd];
    const float bcol = bg[h * 128 + sd];
    const int c = tid >> 2, dq = tid & 3;
    float s[32];
#pragma unroll
    for (int j = 0; j < 32; ++j) s[j] = 0.f;
    const float qscale = 0.08838834764831845f;
    for (int ch = 0; ch < TB / 64; ++ch) {
        __syncthreads();
#pragma unroll 4
        for (int i = 0; i < 16; ++i) { const int tt = st0 + 4 * i, n = 64 * ch + tt;
            const int w = dir ? (n < CTXL ? (CTXL - 1 - n) : (TB + CTXL - 1 - n)) : n;
            const bf16* gr = G + ((size_t)b * TB + w) * WINP;
            const float qv = bf2f(gr[h * 128 + sd]) * qscale, kv = bf2f(gr[512 + h * 128 + sd]);
            const bf16* lp = gr + 3072 + dir * 16; float z = bcol;
#pragma unroll
            for (int r = 0; r < 16; ++r) z += bf2f(lp[r]) * wcol[r];
            const float ls = fminf(z, 0.f) - log1pf(__expf(-fabsf(z)));
            qq[tt * 128 + sd] = qv; kk[tt * 128 + sd] = kv; dd[tt * 128 + sd] = __expf(ls * (1.0f / 16.0f));
            vv[tt * 128 + sd] = bf2f(gr[1024 + h * 256 + half * 128 + sd]); }
        __syncthreads();
        for (int tt = 0; tt < 64; ++tt) { const int n = 64 * ch + tt; const int w = dir ? (n < CTXL ? (CTXL - 1 - n) : (TB + CTXL - 1 - n)) : n;
            const float v = vv[tt * 128 + c]; float acc = 0.f;
            const LAS f32x4* q4 = (const LAS f32x4*)(qq + tt * 128 + dq * 32); const LAS f32x4* k4 = (const LAS f32x4*)(kk + tt * 128 + dq * 32); const LAS f32x4* d4 = (const LAS f32x4*)(dd + tt * 128 + dq * 32);
#pragma unroll
            for (int j = 0; j < 8; ++j) { const f32x4 qv = q4[j], kv = k4[j], dv = d4[j];
                s[4 * j + 0] = s[4 * j + 0] * dv.x + kv.x * v; acc += qv.x * s[4 * j + 0];
                s[4 * j + 1] = s[4 * j + 1] * dv.y + kv.y * v; acc += qv.y * s[4 * j + 1];
                s[4 * j + 2] = s[4 * j + 2] * dv.z + kv.z * v; acc += qv.z * s[4 * j + 2];
                s[4 * j + 3] = s[4 * j + 3] * dv.w + kv.w * v; acc += qv.w * s[4 * j + 3]; }
            acc += shx(acc, 1, tid & 63); acc += shx(acc, 2, tid & 63);
            if (dq == 0) Oo[((size_t)b * TB + w) * 1024 + h * 256 + half * 128 + c] = acc; }
    }
}
__device__ __forceinline__ void phase_gla_readout(unsigned char* ws, int lg, int gw, int NGW, int lane) {
    const float* OF = (const float*)(ws + WS_OF); const float* OB = (const float*)(ws + WS_OB); const bf16* G = (const bf16*)(ws + WS_G); bf16* OG = (bf16*)(ws + WS_Q);
    const f32x4 og = ((const GAS f32x4*)(PARF(ws) + P_OG + lg * 256))[lane];
    for (int m = gw; m < MT; m += NGW) {
#pragma unroll
        for (int hh = 0; hh < 4; ++hh) { const size_t off = (size_t)m * 1024 + hh * 256 + 4 * lane;
            f32x4 o = *(const GAS f32x4*)(OF + off) + *(const GAS f32x4*)(OB + off);
            const float ss = wave_sum((o.x * o.x + o.y * o.y) + (o.z * o.z + o.w * o.w));
            const float rs = 1.0f / sqrtf(ss * (1.0f / 256.0f) + RMS_EPS);
            const unsigned long long rv = *(const GAS unsigned long long*)(G + (size_t)m * WINP + 2048 + hh * 256 + 4 * lane);
            const float r0 = __uint_as_float((unsigned)(rv & 0xffffu) << 16), r1 = __uint_as_float((unsigned)(rv >> 16) << 16), r2 = __uint_as_float((unsigned)((rv >> 32) & 0xffffu) << 16), r3 = __uint_as_float((unsigned)(rv >> 48) << 16);
            o = o * rs * og;
            o.x *= silu_f(r0); o.y *= silu_f(r1); o.z *= silu_f(r2); o.w *= silu_f(r3);
            *(GAS unsigned long long*)(OG + off) = (unsigned long long)pk2(o.x, o.y) | ((unsigned long long)pk2(o.z, o.w) << 32); }
    }
}
constexpr size_t WS_GQ = WS_XG, WS_GKH = WS_XG + 68 * MiB, WS_GKT = WS_XG + 136 * MiB, WS_GVT = WS_XG + 204 * MiB, WS_GDL = WS_ACT, WS_SX = WS_OF;
static_assert((size_t)2176 * 2 * 16384 <= 68 * MiB && (size_t)2176 * 256 * 64 * 2 <= 68 * MiB && (size_t)64 * 68 * 65536 <= 272 * MiB, "gla buffers");
typedef float f32x16 __attribute__((ext_vector_type(16)));
__device__ __forceinline__ float log_sigmoid_fast(float z) { return fminf(z, 0.f) - __logf(1.0f + __expf(-fabsf(z))); }

struct G0Raw { unsigned qk[8][2]; v4u lfb; };
__device__ __forceinline__ void g0_load(G0Raw& R, unsigned char* ws, int cn, int tid) {
    const bf16* G = (const bf16*)(ws + WS_G);
    const int d2 = tid & 63, tb = tid >> 6, n = cn % 68, bh = cn / 68, h = bh & 3, b = bh >> 2;
    const size_t r0 = (size_t)b * TB + 64 * n;
#pragma unroll
    for (int j = 0; j < 8; ++j) { const bf16* gr = G + (r0 + 8 * tb + j) * WINP; R.qk[j][0] = *(const GAS unsigned*)(gr + h * 128 + 2 * d2); R.qk[j][1] = *(const GAS unsigned*)(gr + 512 + h * 128 + 2 * d2); }
    R.lfb = *(const GAS v4u*)(G + (r0 + ((tid & 255) >> 2)) * WINP + 3072 + 8 * (tid & 3));
}
__device__ __forceinline__ void phase_gla_g0(unsigned char* ws, int lg, LAS unsigned char* lds, int tid) {
    LAS float* tot = (LAS float*)(lds + RING_OFF);
    LAS unsigned char* lfl = lds + RING_OFF + 8192;
    const int d2 = tid & 63, tb = tid >> 6;
    if ((int)blockIdx.x >= 2176) return;
    G0Raw R; g0_load(R, ws, blockIdx.x, tid);
    for (int cn = blockIdx.x; cn < 2176; cn += gridDim.x) {
        const int n = cn % 68, bh = cn / 68, h = bh & 3, b = bh >> 2;
        float wf0[16], wf1[16], wb0[16], wb1[16];
        { const float* wgf = PARF(ws) + P_GKF + (size_t)lg * 16 * 512 + h * 128 + 2 * d2; const float* wgb = PARF(ws) + P_GKB + (size_t)lg * 16 * 512 + h * 128 + 2 * d2;
#pragma unroll
          for (int r = 0; r < 16; ++r) { const f32x2 a = *(const GAS f32x2*)(wgf + r * 512), c = *(const GAS f32x2*)(wgb + r * 512); wf0[r] = a.x; wf1[r] = a.y; wb0[r] = c.x; wb1[r] = c.y; } }
        const f32x2 bf_ = *(const GAS f32x2*)(PARF(ws) + P_BGF + lg * 512 + h * 128 + 2 * d2), bb_ = *(const GAS f32x2*)(PARF(ws) + P_BGB + lg * 512 + h * 128 + 2 * d2);
        __syncthreads();
        if (tid < 256) *(LAS v4u*)(lfl + tid * 16) = R.lfb;
        unsigned qk[8][2];
#pragma unroll
        for (int j = 0; j < 8; ++j) { qk[j][0] = R.qk[j][0]; qk[j][1] = R.qk[j][1]; }
        __syncthreads();
        if (cn + (int)gridDim.x < 2176) g0_load(R, ws, cn + (int)gridDim.x, tid);
        float gf0[8], gf1[8], gb0[8], gb1[8];
#pragma unroll
        for (int j = 0; j < 8; ++j) { const LAS v4u* lp = (const LAS v4u*)(lfl + (8 * tb + j) * 64);
            const v4u l0 = lp[0], l1 = lp[1], l2 = lp[2], l3 = lp[3];
            float lf[16], lb[16];
            lf[0] = __uint_as_float(l0.x << 16); lf[1] = __uint_as_float(l0.x & 0xffff0000u); lf[2] = __uint_as_float(l0.y << 16); lf[3] = __uint_as_float(l0.y & 0xffff0000u);
            lf[4] = __uint_as_float(l0.z << 16); lf[5] = __uint_as_float(l0.z & 0xffff0000u); lf[6] = __uint_as_float(l0.w << 16); lf[7] = __uint_as_float(l0.w & 0xffff0000u);
            lf[8] = __uint_as_float(l1.x << 16); lf[9] = __uint_as_float(l1.x & 0xffff0000u); lf[10] = __uint_as_float(l1.y << 16); lf[11] = __uint_as_float(l1.y & 0xffff0000u);
            lf[12] = __uint_as_float(l1.z << 16); lf[13] = __uint_as_float(l1.z & 0xffff0000u); lf[14] = __uint_as_float(l1.w << 16); lf[15] = __uint_as_float(l1.w & 0xffff0000u);
            lb[0] = __uint_as_float(l2.x << 16); lb[1] = __uint_as_float(l2.x & 0xffff0000u); lb[2] = __uint_as_float(l2.y << 16); lb[3] = __uint_as_float(l2.y & 0xffff0000u);
            lb[4] = __uint_as_float(l2.z << 16); lb[5] = __uint_as_float(l2.z & 0xffff0000u); lb[6] = __uint_as_float(l2.w << 16); lb[7] = __uint_as_float(l2.w & 0xffff0000u);
            lb[8] = __uint_as_float(l3.x << 16); lb[9] = __uint_as_float(l3.x & 0xffff0000u); lb[10] = __uint_as_float(l3.y << 16); lb[11] = __uint_as_float(l3.y & 0xffff0000u);
            lb[12] = __uint_as_float(l3.z << 16); lb[13] = __uint_as_float(l3.z & 0xffff0000u); lb[14] = __uint_as_float(l3.w << 16); lb[15] = __uint_as_float(l3.w & 0xffff0000u);
            float zf0 = bf_.x, zf1 = bf_.y, zb0 = bb_.x, zb1 = bb_.y;
#pragma unroll
            for (int r = 0; r < 16; ++r) { zf0 += lf[r] * wf0[r]; zf1 += lf[r] * wf1[r]; zb0 += lb[r] * wb0[r]; zb1 += lb[r] * wb1[r]; }
            gf0[j] = log_sigmoid_fast(zf0) * 0.0625f; gf1[j] = log_sigmoid_fast(zf1) * 0.0625f; gb0[j] = log_sigmoid_fast(zb0) * 0.0625f; gb1[j] = log_sigmoid_fast(zb1) * 0.0625f; }
#pragma unroll
        for (int j = 1; j < 8; ++j) { gf0[j] += gf0[j - 1]; gf1[j] += gf1[j - 1]; gb0[7 - j] += gb0[8 - j]; gb1[7 - j] += gb1[8 - j]; }
        *(LAS f32x2*)(tot + (0 * 8 + tb) * 128 + 2 * d2) = (f32x2){gf0[7], gf1[7]}; *(LAS f32x2*)(tot + (1 * 8 + tb) * 128 + 2 * d2) = (f32x2){gb0[0], gb1[0]};
        __syncthreads();
        float pf0 = 0.f, pf1 = 0.f, pb0 = 0.f, pb1 = 0.f, lf0 = 0.f, lf1 = 0.f, lb0 = 0.f, lb1 = 0.f;
#pragma unroll
        for (int q = 0; q < 8; ++q) { const f32x2 a = *(const LAS f32x2*)(tot + (0 * 8 + q) * 128 + 2 * d2), c = *(const LAS f32x2*)(tot + (1 * 8 + q) * 128 + 2 * d2);
            lf0 += a.x; lf1 += a.y; lb0 += c.x; lb1 += c.y;
            if (q < tb) { pf0 += a.x; pf1 += a.y; } if (q > tb) { pb0 += c.x; pb1 += c.y; } }
        const size_t itf = (size_t)cn * 2, itb = itf + 1;
        bf16* Qf = (bf16*)(ws + WS_GQ) + itf * 8192; bf16* Qb = Qf + 8192; bf16* Kf = (bf16*)(ws + WS_GKH) + itf * 8192; bf16* Kb = Kf + 8192;
        const float elf0 = __expf(lf0), elf1 = __expf(lf1), elb0 = __expf(lb0), elb1 = __expf(lb1);
        float ktf0[8], ktf1[8], ktb0[8], ktb1[8];
#pragma unroll
        for (int j = 0; j < 8; ++j) { const int t = 8 * tb + j;
            const float q0 = __uint_as_float(qk[j][0] << 16) * 0.08838834764831845f, q1 = __uint_as_float(qk[j][0] & 0xffff0000u) * 0.08838834764831845f;
            const float k0 = __uint_as_float(qk[j][1] << 16), k1 = __uint_as_float(qk[j][1] & 0xffff0000u);
            const float ef0 = __expf(pf0 + gf0[j]), ef1 = __expf(pf1 + gf1[j]), eb0 = __expf(pb0 + gb0[j]), eb1 = __expf(pb1 + gb1[j]);
            const float rf0 = __builtin_amdgcn_rcpf(ef0), rf1 = __builtin_amdgcn_rcpf(ef1), rb0 = __builtin_amdgcn_rcpf(eb0), rb1 = __builtin_amdgcn_rcpf(eb1);
            *(GAS unsigned*)(Qf + t * 128 + 2 * d2) = pk2(q0 * ef0, q1 * ef1); *(GAS unsigned*)(Qb + t * 128 + 2 * d2) = pk2(q0 * eb0, q1 * eb1);
            *(GAS unsigned*)(Kf + t * 128 + 2 * d2) = pk2(k0 * rf0, k1 * rf1); *(GAS unsigned*)(Kb + t * 128 + 2 * d2) = pk2(k0 * rb0, k1 * rb1);
            ktf0[j] = k0 * rf0 * elf0; ktf1[j] = k1 * rf1 * elf1; ktb0[j] = k0 * rb0 * elb0; ktb1[j] = k1 * rb1 * elb1; }
        {
          unsigned char* Tf = ws + WS_GKT + itf * 16384 + (size_t)((((tb >> 1) * 4 + (d2 >> 4)) * 64 + ((2 * d2) & 31)) * 16 + 8 * (tb & 1)); unsigned char* Tb = Tf + 16384;
          *(GAS unsigned long long*)(Tf) = (unsigned long long)pk2(ktf0[0], ktf0[1]) | ((unsigned long long)pk2(ktf0[2], ktf0[3]) << 32);
          *(GAS unsigned long long*)(Tf + 512) = (unsigned long long)pk2(ktf0[4], ktf0[5]) | ((unsigned long long)pk2(ktf0[6], ktf0[7]) << 32);
          *(GAS unsigned long long*)(Tf + 16) = (unsigned long long)pk2(ktf1[0], ktf1[1]) | ((unsigned long long)pk2(ktf1[2], ktf1[3]) << 32);
          *(GAS unsigned long long*)(Tf + 528) = (unsigned long long)pk2(ktf1[4], ktf1[5]) | ((unsigned long long)pk2(ktf1[6], ktf1[7]) << 32);
          *(GAS unsigned long long*)(Tb) = (unsigned long long)pk2(ktb0[0], ktb0[1]) | ((unsigned long long)pk2(ktb0[2], ktb0[3]) << 32);
          *(GAS unsigned long long*)(Tb + 512) = (unsigned long long)pk2(ktb0[4], ktb0[5]) | ((unsigned long long)pk2(ktb0[6], ktb0[7]) << 32);
          *(GAS unsigned long long*)(Tb + 16) = (unsigned long long)pk2(ktb1[0], ktb1[1]) | ((unsigned long long)pk2(ktb1[2], ktb1[3]) << 32);
          *(GAS unsigned long long*)(Tb + 528) = (unsigned long long)pk2(ktb1[4], ktb1[5]) | ((unsigned long long)pk2(ktb1[6], ktb1[7]) << 32); }
        if (tb == 0) { float* DLp = (float*)(ws + WS_GDL) + itf * 128 + 2 * d2; *(GAS f32x2*)DLp = (f32x2){elf0, elf1}; *(GAS f32x2*)(DLp + 128) = (f32x2){elb0, elb1}; }
        {
            const int dv = tid & 255, th = tid >> 8; const bf16* vp = (const bf16*)(ws + WS_G) + ((size_t)b * TB + 64 * n + 32 * th) * WINP + 1024 + h * 256 + dv;
            unsigned wv[16];
#pragma unroll
            for (int j = 0; j < 16; ++j) wv[j] = (unsigned)vp[(size_t)(2 * j) * WINP] | ((unsigned)vp[(size_t)(2 * j + 1) * WINP] << 16);
            unsigned char* vo = ws + WS_GVT + (size_t)cn * 32768 + (size_t)(((2 * th) * 8 + (dv >> 5)) * 64 + (dv & 31)) * 16;
#pragma unroll
            for (int ql = 0; ql < 2; ++ql)
#pragma unroll
                for (int hq = 0; hq < 2; ++hq) *(GAS v4u*)(vo + ql * 8192 + hq * 512) = (v4u){wv[8 * ql + 2 * hq], wv[8 * ql + 2 * hq + 1], wv[8 * ql + 2 * hq + 4], wv[8 * ql + 2 * hq + 5]}; }
    }
}
struct G12Ops { bf16x8 a[4], b[4]; f32x4 d[4]; };
__device__ __forceinline__ void g12_load(G12Ops& o, unsigned char* ws, int bh, int dir, int m, int kb, int vb, int r, int hh) {
    const int n = dir ? (m < 4 ? 3 - m : 71 - m) : m; const size_t cn = (size_t)bh * 68 + n, item = cn * 2 + dir;
    const GAS bf16x8* ap = (const GAS bf16x8*)(ws + WS_GKT + item * 16384) + kb * 64 + (hh * 32 + r);
    const GAS bf16x8* bp = (const GAS bf16x8*)(ws + WS_GVT + cn * 32768) + vb * 64 + (hh * 32 + r);
    const float* dp = (const float*)(ws + WS_GDL) + item * 128 + 32 * kb + 4 * hh;
#pragma unroll
    for (int ks = 0; ks < 4; ++ks) { o.a[ks] = ap[ks * 256]; o.b[ks] = bp[ks * 512]; o.d[ks] = *(const GAS f32x4*)(dp + 8 * ks); }
}
__device__ __forceinline__ void phase_gla_g12(unsigned char* ws, LAS unsigned char* lds, int gwv, int wave, int lane) {
    if (gwv >= 2048) return;
    const int chain = gwv >> 5, blk = gwv & 31, kb = blk & 3, vb = blk >> 2, dir = chain & 1, bh = chain >> 1;
    const int r = lane & 31, hh = lane >> 5;
    LAS unsigned char* wl = lds + RING_OFF + wave * 2048;
    f32x16 acc;
#pragma unroll
    for (int g = 0; g < 16; ++g) acc[g] = 0.f;
    G12Ops o0, o1, o2;
    g12_load(o0, ws, bh, dir, 0, kb, vb, r, hh); g12_load(o1, ws, bh, dir, 1, kb, vb, r, hh);
#define G12_STEP(CUR, m_) do { const int mm_ = (m_); const int n = dir ? (mm_ < 4 ? 3 - mm_ : 71 - mm_) : mm_; \
        _Pragma("unroll") for (int gg = 0; gg < 4; ++gg) *(LAS unsigned long long*)(wl + (((gg >> 1) * 64 + (gg & 1) * 32 + r) * 16 + 8 * hh)) = (unsigned long long)pk2(acc[4 * gg], acc[4 * gg + 1]) | ((unsigned long long)pk2(acc[4 * gg + 2], acc[4 * gg + 3]) << 32); \
        LDS_WAIT(); const v4u s0 = *(const LAS v4u*)(wl + lane * 16), s1 = *(const LAS v4u*)(wl + 1024 + lane * 16); LDS_WAIT(); \
        { bf16* sp = (bf16*)(ws + WS_SX) + ((size_t)(bh * 2 + dir) * 68 + n) * 32768 + (size_t)(kb * 8 + vb) * 1024; ((GAS v4u*)sp)[lane] = s0; ((GAS v4u*)sp)[64 + lane] = s1; } \
        _Pragma("unroll") for (int gg = 0; gg < 4; ++gg) { acc[4 * gg] *= CUR.d[gg].x; acc[4 * gg + 1] *= CUR.d[gg].y; acc[4 * gg + 2] *= CUR.d[gg].z; acc[4 * gg + 3] *= CUR.d[gg].w; } \
        _Pragma("unroll") for (int ks = 0; ks < 4; ++ks) acc = __builtin_amdgcn_mfma_f32_32x32x16_bf16(CUR.a[ks], CUR.b[ks], acc, 0, 0, 0); } while (0)
    for (int m = 0; m < 66; m += 3) {
        g12_load(o2, ws, bh, dir, m + 2, kb, vb, r, hh); G12_STEP(o0, m);
        g12_load(o0, ws, bh, dir, m + 3, kb, vb, r, hh); G12_STEP(o1, m + 1);
        g12_load(o1, ws, bh, dir, (m + 4 < 68) ? m + 4 : 67, kb, vb, r, hh); G12_STEP(o2, m + 2);
    }
    G12_STEP(o0, 66); G12_STEP(o1, 67);
#undef G12_STEP
}
constexpr int G3_RS = 272, G3_TILE = 64 * G3_RS, G3_OL = 4 * G3_TILE  , G3_LD = 260;
static_assert(G3_OL + 64 * G3_LD * 4 <= MISC_OFF, "G3 LDS");
__device__ __forceinline__ void phase_gla_g3(unsigned char* ws, int lg, LAS unsigned char* lds, int tid) {
    const int lane = tid & 63, wave = __builtin_amdgcn_readfirstlane(tid >> 6), r = lane & 31, hh = lane >> 5, vb = wave;
    LAS unsigned char* TL = lds + RING_OFF; LAS float* OL = (LAS float*)(lds + RING_OFF + G3_OL);
    const bf16* G = (const bf16*)(ws + WS_G); bf16* OG = (bf16*)(ws + WS_Q);
    for (int cn = blockIdx.x; cn < 2176; cn += gridDim.x) {
        const int n = cn % 68, bh = cn / 68, h = bh & 3, b = bh >> 2;
        v4u st[4][2];
#pragma unroll
        for (int tl = 0; tl < 4; ++tl) { const bf16* src = (const bf16*)(ws + ((tl & 1) ? WS_GKH : WS_GQ)) + ((size_t)cn * 2 + (tl >> 1)) * 8192;
#pragma unroll
            for (int j = 0; j < 2; ++j) st[tl][j] = ((const GAS v4u*)src)[tid + 512 * j]; }
        __syncthreads();
#pragma unroll
        for (int tl = 0; tl < 4; ++tl)
#pragma unroll
            for (int j = 0; j < 2; ++j) { const int q = tid + 512 * j, row = q >> 4, ch = q & 15; *(LAS v4u*)(TL + tl * G3_TILE + row * G3_RS + ch * 16) = st[tl][j]; }
        __syncthreads();
        f32x16 P00, P01, P10, P11, O0, O1;
#pragma unroll
        for (int g = 0; g < 16; ++g) { P00[g] = 0.f; P01[g] = 0.f; P10[g] = 0.f; P11[g] = 0.f; O0[g] = 0.f; O1[g] = 0.f; }
#pragma unroll
        for (int dir = 0; dir < 2; ++dir) {
            const LAS unsigned char* Qt = TL + (2 * dir) * G3_TILE + r * G3_RS + 16 * hh; const LAS unsigned char* Kh = TL + (2 * dir + 1) * G3_TILE + r * G3_RS + 16 * hh;
            const GAS bf16x8* Sx = (const GAS bf16x8*)((const bf16*)(ws + WS_SX) + ((size_t)(bh * 2 + dir) * 68 + n) * 32768 + (size_t)vb * 1024) + lane;
            f32x16 X00, X11, Xoff;
#pragma unroll
            for (int g = 0; g < 16; ++g) { X00[g] = 0.f; X11[g] = 0.f; Xoff[g] = 0.f; }
#pragma unroll
            for (int s = 0; s < 8; ++s) {
                const bf16x8 q0 = *(const LAS bf16x8*)(Qt + 32 * s), q1 = *(const LAS bf16x8*)(Qt + 32 * G3_RS + 32 * s);
                const bf16x8 k0 = *(const LAS bf16x8*)(Kh + 32 * s), k1 = *(const LAS bf16x8*)(Kh + 32 * G3_RS + 32 * s);
                const bf16x8 sx = Sx[(s >> 1) * 1024 + (s & 1) * 64];
                X00 = __builtin_amdgcn_mfma_f32_32x32x16_bf16(k0, q0, X00, 0, 0, 0);
                X11 = __builtin_amdgcn_mfma_f32_32x32x16_bf16(k1, q1, X11, 0, 0, 0);
                if (dir == 0) Xoff = __builtin_amdgcn_mfma_f32_32x32x16_bf16(k0, q1, Xoff, 0, 0, 0); else Xoff = __builtin_amdgcn_mfma_f32_32x32x16_bf16(k1, q0, Xoff, 0, 0, 0);
                O0 = __builtin_amdgcn_mfma_f32_32x32x16_bf16(q0, sx, O0, 0, 0, 0); O1 = __builtin_amdgcn_mfma_f32_32x32x16_bf16(q1, sx, O1, 0, 0, 0); }
#pragma unroll
            for (int g = 0; g < 16; ++g) { const int tj = (g & 3) + 8 * (g >> 2) + 4 * hh; const bool keep = dir ? (tj >= r) : (tj <= r);
                P00[g] += keep ? X00[g] : 0.f; P11[g] += keep ? X11[g] : 0.f;
                if (dir == 0) P01[g] += Xoff[g]; else P10[g] += Xoff[g]; }
        }
        { const GAS bf16x8* Vt = (const GAS bf16x8*)(ws + WS_GVT + (size_t)cn * 32768) + vb * 64 + lane;
#pragma unroll
          for (int jb = 0; jb < 2; ++jb)
#pragma unroll
            for (int s2 = 0; s2 < 2; ++s2) { const bf16x8 bfv = Vt[(2 * jb + s2) * 512];
                const f32x16& Pa = jb ? P10 : P00; const f32x16& Pb = jb ? P11 : P01;
                const bf16x8 a0 = __builtin_bit_cast(bf16x8, ((v4u){pk2(Pa[8 * s2 + 0], Pa[8 * s2 + 1]), pk2(Pa[8 * s2 + 2], Pa[8 * s2 + 3]), pk2(Pa[8 * s2 + 4], Pa[8 * s2 + 5]), pk2(Pa[8 * s2 + 6], Pa[8 * s2 + 7])}));
                const bf16x8 a1 = __builtin_bit_cast(bf16x8, ((v4u){pk2(Pb[8 * s2 + 0], Pb[8 * s2 + 1]), pk2(Pb[8 * s2 + 2], Pb[8 * s2 + 3]), pk2(Pb[8 * s2 + 4], Pb[8 * s2 + 5]), pk2(Pb[8 * s2 + 6], Pb[8 * s2 + 7])}));
                O0 = __builtin_amdgcn_mfma_f32_32x32x16_bf16(a0, bfv, O0, 0, 0, 0); O1 = __builtin_amdgcn_mfma_f32_32x32x16_bf16(a1, bfv, O1, 0, 0, 0); } }
#pragma unroll
        for (int g = 0; g < 16; ++g) { const int t = (g & 3) + 8 * (g >> 2) + 4 * hh; OL[t * G3_LD + 32 * vb + r] = O0[g]; OL[(32 + t) * G3_LD + 32 * vb + r] = O1[g]; }
        __syncthreads();
        { const int t = tid >> 3, cc = tid & 7; const LAS f32x4* op = (const LAS f32x4*)(OL + t * G3_LD + 32 * cc);
          f32x4 o[8]; float ss = 0.f;
#pragma unroll
          for (int j = 0; j < 8; ++j) { o[j] = op[j]; ss += (o[j].x * o[j].x + o[j].y * o[j].y) + (o[j].z * o[j].z + o[j].w * o[j].w); }
          ss += __shfl_xor(ss, 1); ss += __shfl_xor(ss, 2); ss += __shfl_xor(ss, 4);
          const float rs = 1.0f / sqrtf(ss * (1.0f / 256.0f) + RMS_EPS);
          const size_t row = (size_t)b * TB + 64 * n + t;
          const GAS v4u* rp = (const GAS v4u*)(G + row * WINP + 2048 + h * 256 + 32 * cc); const GAS f32x4* gp = (const GAS f32x4*)(PARF(ws) + P_OG + lg * 256 + 32 * cc);
          GAS v4u* dst = (GAS v4u*)(OG + row * 1024 + h * 256 + 32 * cc);
#pragma unroll
          for (int j = 0; j < 4; ++j) { const v4u rv = rp[j]; const f32x4 g0 = gp[2 * j], g1 = gp[2 * j + 1]; const f32x4 a = o[2 * j] * rs * g0, c2 = o[2 * j + 1] * rs * g1;
              v4u w;
              w.x = pk2(a.x * silu_f(__uint_as_float(rv.x << 16)), a.y * silu_f(__uint_as_float(rv.x & 0xffff0000u)));
              w.y = pk2(a.z * silu_f(__uint_as_float(rv.y << 16)), a.w * silu_f(__uint_as_float(rv.y & 0xffff0000u)));
              w.z = pk2(c2.x * silu_f(__uint_as_float(rv.z << 16)), c2.y * silu_f(__uint_as_float(rv.z & 0xffff0000u)));
              w.w = pk2(c2.z * silu_f(__uint_as_float(rv.w << 16)), c2.w * silu_f(__uint_as_float(rv.w & 0xffff0000u)));
              dst[j] = w; } }
    }
}
constexpr int WIMG_RS = 2064;
static_assert(2 * 32 * WIMG_RS <= LDS_AUX, "router images below the aux tables");
__device__ __forceinline__ void phase_modulate2_route(unsigned char* ws, int layer, LAS unsigned char* lds, int vcu, int wave, int lane, int tid, bool dummy = false) {
    const bf16* X = (const bf16*)(ws + WS_X); bf16* XN = (bf16*)(ws + WS_XN);
    const float* ng = PARF(ws) + P_N2G + layer * 1024; const float* Mo = (const float*)(ws + WS_MOD) + (size_t)layer * MODROWS * NMODC;
    LAS unsigned char* WHI = lds + RING_OFF; LAS unsigned char* WLO = WHI + 32 * WIMG_RS;
    LAS unsigned* lcnt = (LAS unsigned*)(lds + AUX_LCNT); LAS unsigned* gb = (LAS unsigned*)(lds + AUX_GB); LAS unsigned* ent = (LAS unsigned*)(lds + AUX_ENT); LAS float* rsl = (LAS float*)(lds + AUX_RS);
    { const float* wsrc = PARF(ws) + P_WR + (size_t)layer * 1024 * 32;
      for (int idx = tid; idx < 1024 * 32; idx += NWAVES * 64) { const int k = idx >> 5, e = idx & 31; const float w = wsrc[idx]; const unsigned hi = f2bf(w), lo = f2bf(w - __uint_as_float(hi << 16));
          *(LAS unsigned short*)(WHI + e * WIMG_RS + 2 * k) = (unsigned short)hi; *(LAS unsigned short*)(WLO + e * WIMG_RS + 2 * k) = (unsigned short)lo; }
      if (tid < 32) lcnt[tid] = 0u; }
    gu32* cnt = (gu32*)(ws + WS_CTL) + CW_CNT + (layer + (dummy ? 4 : 0)) * 32 * 16;
    unsigned char* sbase = dummy ? ws + WS_XG : ws;
    const bool lastl = (layer == NLAYER - 1);
  for (int grp = vcu; grp < MT / 136; grp += (int)gridDim.x) {
    const int rbase = grp * 136;
    if (grp != vcu) { __syncthreads(); if (tid < 32) lcnt[tid] = 0u; }
    for (int rl = wave; rl < 136; rl += 2 * NWAVES) {
        const int rl2 = (rl + NWAVES < 136) ? rl + NWAVES : rl; const int m = rbase + rl, m2 = rbase + rl2, mr = mod_row(m), mr2 = mod_row(m2);
        float rs, rs2;
        modulate_row2(X + (size_t)m * 1024, X + (size_t)m2 * 1024, ng, Mo + (size_t)mr * NMODC + 3 * 1024, Mo + (size_t)mr * NMODC + 4 * 1024, Mo + (size_t)mr2 * NMODC + 3 * 1024, Mo + (size_t)mr2 * NMODC + 4 * 1024,
                      ws + WS_XN8 + (size_t)m * 1024, ws + WS_XN8 + (size_t)m2 * 1024, lane, rs, rs2);
        if (lane == 0) { rsl[rl] = rs; rsl[rl2] = rs2; } }
    __syncthreads();
    if (wave < 5) {
        const int r = lane & 31, hh = lane >> 5; const int rl = (32 * wave + r < 136) ? 32 * wave + r : 135; const int m = rbase + rl, mr = mod_row(m);
        const float rsr = rsl[rl];
        const bf16* xp = X + (size_t)m * 1024 + 8 * hh; const float* gp = ng + 8 * hh; const float* scp = Mo + (size_t)mr * NMODC + 4 * 1024 + 8 * hh; const float* shp = Mo + (size_t)mr * NMODC + 3 * 1024 + 8 * hh;
        const LAS unsigned char* wh = WHI + r * WIMG_RS + 16 * hh; const LAS unsigned char* wl = WLO + r * WIMG_RS + 16 * hh;
        f32x16 acc;
#pragma unroll
        for (int g = 0; g < 16; ++g) acc[g] = 0.f;
#pragma unroll 2
        for (int s = 0; s < 64; ++s) {
            const v4u xr8 = *(const GAS v4u*)(xp + 16 * s); const f32x4 x0 = (f32x4){__uint_as_float(xr8.x << 16), __uint_as_float(xr8.x & 0xffff0000u), __uint_as_float(xr8.y << 16), __uint_as_float(xr8.y & 0xffff0000u)}, x1 = (f32x4){__uint_as_float(xr8.z << 16), __uint_as_float(xr8.z & 0xffff0000u), __uint_as_float(xr8.w << 16), __uint_as_float(xr8.w & 0xffff0000u)}; const f32x4 g0 = *(const GAS f32x4*)(gp + 16 * s), g1 = *(const GAS f32x4*)(gp + 16 * s + 4);
            const f32x4 c0 = *(const GAS f32x4*)(scp + 16 * s), c1 = *(const GAS f32x4*)(scp + 16 * s + 4), h0 = *(const GAS f32x4*)(shp + 16 * s), h1 = *(const GAS f32x4*)(shp + 16 * s + 4);
            const f32x4 y0 = (x0 * rsr) * g0 * (c0 + 1.0f) + h0, y1 = (x1 * rsr) * g1 * (c1 + 1.0f) + h1;
            v4u ph, pl;
            ph.x = pg8::cvt_pk_bf16(y0.x, y0.y); ph.y = pg8::cvt_pk_bf16(y0.z, y0.w); ph.z = pg8::cvt_pk_bf16(y1.x, y1.y); ph.w = pg8::cvt_pk_bf16(y1.z, y1.w);
            pl.x = pg8::cvt_pk_bf16(y0.x - __uint_as_float(ph.x << 16), y0.y - __uint_as_float(ph.x & 0xffff0000u)); pl.y = pg8::cvt_pk_bf16(y0.z - __uint_as_float(ph.y << 16), y0.w - __uint_as_float(ph.y & 0xffff0000u));
            pl.z = pg8::cvt_pk_bf16(y1.x - __uint_as_float(ph.z << 16), y1.y - __uint_as_float(ph.z & 0xffff0000u)); pl.w = pg8::cvt_pk_bf16(y1.z - __uint_as_float(ph.w << 16), y1.w - __uint_as_float(ph.w & 0xffff0000u));
            const bf16x8 ahi = __builtin_bit_cast(bf16x8, ph), alo = __builtin_bit_cast(bf16x8, pl);
            const bf16x8 bhi = *(const LAS bf16x8*)(wh + 32 * s), blo = *(const LAS bf16x8*)(wl + 32 * s);
            acc = __builtin_amdgcn_mfma_f32_32x32x16_bf16(ahi, bhi, acc, 0, 0, 0); acc = __builtin_amdgcn_mfma_f32_32x32x16_bf16(alo, bhi, acc, 0, 0, 0); acc = __builtin_amdgcn_mfma_f32_32x32x16_bf16(ahi, blo, acc, 0, 0, 0); }
        const float brt = (PARF(ws) + P_BR)[layer * 32 + r];
#pragma unroll
        for (int g = 0; g < 16; ++g) { const int rowl = 32 * wave + (g & 3) + 8 * (g >> 2) + 4 * hh;
            float v = acc[g] + brt; float tv[4]; int te[4];
#pragma unroll
            for (int k = 0; k < 4; ++k) { float mx = v;
#pragma unroll
                for (int o = 1; o < 32; o <<= 1) mx = fmaxf(mx, shx(mx, o, lane));
                const unsigned long long bm = __ballot(v == mx); const unsigned hm = hh ? (unsigned)(bm >> 32) : (unsigned)bm; const int first = __ffs((int)hm) - 1;
                te[k] = first; tv[k] = mx; if (r == first) v = -INFINITY; }
            const bool valid = rowl < 136 && !(lastl && mod_row(rbase + (rowl < 136 ? rowl : 135)) == 8);
            if (r == 0 && rowl < 136) {
                if (valid) { const float e1 = __expf(tv[1] - tv[0]), e2 = __expf(tv[2] - tv[0]), e3 = __expf(tv[3] - tv[0]); const float inv = 1.0f / (1.0f + e1 + e2 + e3);
                    const float wk[4] = {inv, e1 * inv, e2 * inv, e3 * inv};
#pragma unroll
                    for (int k = 0; k < 4; ++k) { const unsigned lp = atomicAdd((unsigned*)&lcnt[te[k]], 1u); ent[(rowl * 4 + k) * 2 + 0] = ((unsigned)te[k] << 24) | lp; ent[(rowl * 4 + k) * 2 + 1] = __float_as_uint(wk[k]); } }
                else {
#pragma unroll
                    for (int k = 0; k < 4; ++k) ent[(rowl * 4 + k) * 2 + 0] = 0xffffffffu; } } }
    }
    __syncthreads();
    if (tid < 32) gb[tid] = __hip_atomic_fetch_add(cnt + tid * 16, lcnt[tid], __ATOMIC_RELAXED, __HIP_MEMORY_SCOPE_AGENT);
    __syncthreads();
    for (int q = tid; q < 136 * 4; q += NWAVES * 64) { const unsigned pe = ent[q * 2 + 0];
        if (pe != 0xffffffffu) { const unsigned e = pe >> 24, lp = pe & 0xffffffu; const int m = rbase + (q >> 2);
            ((unsigned*)(sbase + WS_SLOT))[m * 4 + (q & 3)] = (e << 24) | (gb[e] + lp); ((unsigned*)(sbase + WS_GATEW))[m * 4 + (q & 3)] = ent[q * 2 + 1];
            if (!dummy) ((int*)(ws + WS_LIST))[(size_t)e * MT + gb[e] + lp] = m; } }
  }
}
__device__ __forceinline__ void build_expert_tables(unsigned char* ws, int layer, LAS unsigned char* lds, int tid) {
    LAS int* t2e = (LAS int*)(lds + AUX_T2E); LAS int* base = (LAS int*)(lds + AUX_BASE); LAS int* ntp = (LAS int*)(lds + AUX_NT); LAS int* cntl = (LAS int*)(lds + AUX_CNT);
    gu32* cnt = (gu32*)(ws + WS_CTL) + CW_CNT + layer * 32 * 16;
    __syncthreads();
    if (tid < 64) { const unsigned cval = (tid < 32) ? __hip_atomic_load(cnt + tid * 16, RLX_AGENT) : 0u; const int tiles = (int)((cval + 255u) >> 8);
        int pre = tiles;
#pragma unroll
        for (int o = 1; o < 32; o <<= 1) { const int ln = tid & 63; const int t = __builtin_amdgcn_ds_bpermute(((ln >= o) ? ln - o : ln) << 2, pre); if (ln >= o) pre += t; }
        const int start = pre - tiles;
        if (tid < 32) { base[tid] = start * 256; cntl[tid] = (int)cval; for (int t = 0; t < tiles; ++t) t2e[start + t] = tid; if (tid == 31) ntp[0] = pre; } }
    __syncthreads();
}
__device__ __forceinline__ void phase_moe_gather(unsigned char* ws, int layer, LAS unsigned char* lds, int gw, int NGW, int lane, int tid) {
    build_expert_tables(ws, layer, lds, tid);
    const LAS int* base = (const LAS int*)(lds + AUX_BASE);
    const bf16* XN = (const bf16*)(ws + WS_XN); bf16* XG = (bf16*)(ws + WS_XG);
    const unsigned* slot = (const unsigned*)(ws + WS_SLOT); unsigned* spos = (unsigned*)(ws + WS_SLOTPOS);
    for (int m = gw; m < MT; m += NGW) {
        if (layer == NLAYER - 1 && mod_row(m) == 8) continue;
        const GAS v4u* src = (const GAS v4u*)(XN + (size_t)m * 1024) + lane; const v4u a = src[0], b = src[64];
#pragma unroll
        for (int k = 0; k < 4; ++k) { const unsigned pe = slot[m * 4 + k]; const int dst = base[pe >> 24] + (int)(pe & 0xffffffu);
            GAS v4u* dp = (GAS v4u*)(XG + (size_t)dst * 1024) + lane; dp[0] = a; dp[64] = b;
            if (lane == 0) spos[m * 4 + k] = (unsigned)dst; }
    }
}
__device__ __forceinline__ void phase_moe_combine(unsigned char* ws, float* out, int layer, LAS unsigned char* lds, int gw, int NGW, int lane, int tid, bool dummy = false) {
    build_expert_tables(ws, layer, lds, tid);
    const LAS int* base = (const LAS int*)(lds + AUX_BASE);
    bf16* X = (bf16*)(ws + WS_X); const unsigned char* Y = ws + WS_Y;
    const float* Mo = (const float*)(ws + WS_MOD) + (size_t)layer * MODROWS * NMODC;
    const unsigned* slot = (const unsigned*)(ws + WS_SLOT); const float* gw4 = (const float*)(ws + WS_GATEW);
    for (int m0 = gw; m0 < MT; m0 += 2 * NGW) {
        int mm[2], bb[2], ww[2], mrr[2]; bool ok[2];
#pragma unroll
        for (int p = 0; p < 2; ++p) { const int m = m0 + p * NGW; ok[p] = m < MT; mm[p] = ok[p] ? m : m0; bb[p] = mm[p] / TB; ww[p] = mm[p] - bb[p] * TB; mrr[p] = (ww[p] < CTXL) ? 8 : bb[p];
            if (layer == NLAYER - 1 && ww[p] < CTXL) ok[p] = false; }
        if (!ok[0] && !ok[1]) continue;
        unsigned pe[2][4]; float wk[2][4];
#pragma unroll
        for (int p = 0; p < 2; ++p)
#pragma unroll
            for (int k = 0; k < 4; ++k) { pe[p][k] = slot[mm[p] * 4 + k]; wk[p][k] = gw4[mm[p] * 4 + k]; }
        unsigned long long xv[2][4];
#pragma unroll
        for (int p = 0; p < 2; ++p) { const GAS unsigned long long* xp = (const GAS unsigned long long*)(X + (size_t)mm[p] * 1024) + lane;
#pragma unroll
            for (int j = 0; j < 4; ++j) xv[p][j] = xp[64 * j]; }
        unsigned yv[2][4][4];
#pragma unroll
        for (int p = 0; p < 2; ++p)
#pragma unroll
            for (int k = 0; k < 4; ++k) { unsigned e = pe[p][k] >> 24; if (!ok[p] || e > 31u) e = 0u;
                const unsigned sp = ok[p] ? (unsigned)base[e] + (pe[p][k] & 0xffffffu) : 0u;
                const GAS unsigned* yp = (const GAS unsigned*)(Y + (size_t)sp * 1024) + lane;
#pragma unroll
                for (int j = 0; j < 4; ++j) yv[p][k][j] = yp[64 * j]; }
        f32x4 f[2][4]; float ss[2];
#pragma unroll
        for (int p = 0; p < 2; ++p) { const GAS f32x4* gp = (const GAS f32x4*)(Mo + (size_t)mrr[p] * NMODC + 5 * 1024) + lane;
            ss[p] = 0.f;
#pragma unroll
            for (int j = 0; j < 4; ++j) { f32x4 a = (f32x4){0.f, 0.f, 0.f, 0.f};
#pragma unroll
                for (int k = 0; k < 4; ++k) { const unsigned w8 = yv[p][k][j]; const f32x2 lo2 = __builtin_amdgcn_cvt_pk_f32_fp8((int)w8, false), hi2 = __builtin_amdgcn_cvt_pk_f32_fp8((int)w8, true); a = a + (f32x4){lo2.x, lo2.y, hi2.x, hi2.y} * wk[p][k]; }
                f[p][j] = bf4_to_f32(xv[p][j]) + gp[64 * j] * a; } }
        asm volatile("" ::: "memory");
        const bool fuse = (layer < NLAYER - 1) && !dummy;
#pragma unroll
        for (int p = 0; p < 2; ++p) { if (!ok[p]) continue;
            GAS unsigned long long* xp = (GAS unsigned long long*)(X + (size_t)mm[p] * 1024) + lane;
            GAS f32x4* op = (GAS f32x4*)(out + ((size_t)bb[p] * SEQ + (ww[p] - CTXL)) * 1024) + lane;
#pragma unroll
            for (int j = 0; j < 4; ++j) { if (dummy) ((GAS f32x4*)((float*)(ws + WS_XG) + (size_t)mm[p] * 1024) + lane)[64 * j] = f[p][j]; else if (layer == NLAYER - 1) op[64 * j] = f[p][j]; else { const unsigned long long pk = f32_to_bf4(f[p][j]); xp[64 * j] = pk; f[p][j] = bf4_to_f32(pk); }
                ss[p] += (f[p][j].x * f[p][j].x + f[p][j].y * f[p][j].y) + (f[p][j].z * f[p][j].z + f[p][j].w * f[p][j].w); }
            if (fuse) { const float rs = 1.0f / sqrtf(wave_sum(ss[p]) * (1.0f / 1024.0f) + RMS_EPS);
                const float* ng = PARF(ws) + P_N1G + (layer + 1) * 1024; const float* Mn = (const float*)(ws + WS_MOD) + (size_t)(layer + 1) * MODROWS * NMODC + (size_t)mrr[p] * NMODC;
                GAS unsigned long long* o8 = (GAS unsigned long long*)((bf16*)(ws + WS_XN) + (size_t)mm[p] * 1024) + lane;
#pragma unroll
                for (int j = 0; j < 4; ++j) { const f32x4 g = ((const GAS f32x4*)ng)[64 * j + lane], sh = ((const GAS f32x4*)Mn)[64 * j + lane], sc = ((const GAS f32x4*)(Mn + 1024))[64 * j + lane];
                    o8[64 * j] = f32_to_bf4((f[p][j] * rs) * g * (sc + 1.0f) + sh); } } }
    }
}

constexpr int NPH_L = 11, NPHASE = 2 + NPH_L * NLAYER;
#ifndef PHMASK
#define PHMASK 0x7fff
#endif
#define EN(b) ((PHMASK >> (b)) & 1)
#ifndef DUPMASK
#define DUPMASK 0
#endif
#define DUP(b) for (int rep_ = 0; rep_ < (((DUPMASK >> (b)) & 1) ? 2 : 1); ++rep_)
__global__ void __launch_bounds__(NWAVES * 64, 2) dit_fwd(Args args) {
    extern __shared__ __attribute__((aligned(16))) unsigned char lds_raw[];
    LAS unsigned char* lds = (LAS unsigned char*)lds_raw;
    volatile LAS unsigned* MISC = (volatile LAS unsigned*)(lds + MISC_OFF);
    const int G = gridDim.x, bx = blockIdx.x;
    const int vcu = (G % 8 == 0) ? (bx % 8) * (G / 8) + bx / 8 : bx;
    const int wave0 = __builtin_amdgcn_readfirstlane((int)threadIdx.x >> 6);
#define LANE_ID(z) ((int)__builtin_amdgcn_mbcnt_hi(~0u, __builtin_amdgcn_mbcnt_lo(~0u, (z))))
    { const int t0 = (wave0 << 6) | LANE_ID(0u); for (int u = t0; u < (LDS_BYTES - MISC_OFF) / 4; u += NWAVES * 64) ((LAS unsigned*)(lds + MISC_OFF))[u] = 0u; }
    __syncthreads();
    const int lo = args.ph_lo, hi = args.ph_hi;
    XcdBarrier bar; bar.bar = (unsigned*)(args.ws + WS_CTL) + CW_BAR; bar.x = 0; bar.st = nullptr;
    if (hi - lo > 1) bar = xcd_barrier_post((unsigned*)(args.ws + WS_CTL) + CW_BAR, MISC + 8, wave0 == 0 && LANE_ID(0u) == 0);
#define IN(k) (lo <= (k) && (k) < hi)
#define SEAM(k) do { if (IN(k) && IN((k) + 1)) { XcdBarrier b_ = bar; unsigned zb_ = 0u; LAUNDER_S(zb_); b_.bar = bar.bar + zb_; xcd_barrier(b_, wave0 == 0 && LANE_ID(zb_) == 0); } } while (0)
#define PHASE_IDS() unsigned zoff_ = 0u; LAUNDER_S(zoff_); int tid = (wave0 << 6) | LANE_ID(zoff_); LAUNDER_V(tid); const int lane = tid & 63, wave = __builtin_amdgcn_readfirstlane(tid >> 6); const int gw = vcu * NWAVES + wave, NGW = G * NWAVES; \
    unsigned char* ws = args.ws + zoff_; const int Gp = G + (int)zoff_, bxp = bx + (int)zoff_; (void)lane; (void)gw; (void)NGW; (void)Gp; (void)bxp;

    if (EN(0) && IN(0)) DUP(0) { PHASE_IDS(); p0_prologue(args, lds, gw, NGW, wave, lane); } SEAM(0);
    if (EN(1) && IN(1)) { PHASE_IDS(); p1_mod_reduce(args, gw * 64 + lane, NGW * 64); } SEAM(1);

    for (int layer = 0; layer < NLAYER; ++layer) {
        const int pb = 2 + NPH_L * layer, lh = layer >> 1;
        if (layer == 0) { if (EN(2) && IN(pb + 0)) DUP(2) { PHASE_IDS(); phase_modulate1(ws, layer, gw, NGW, lane); } SEAM(pb + 0); }
        if ((layer & 1) == 0) {
            if (EN(3) && IN(pb + 1)) DUP(3) {
                PHASE_IDS();
                pg8::Gemm g{(const pg8::bf16_t*)(ws + WS_XN), (const pg8::bf16_t*)(ws + WS_WQKV) + (size_t)lh * QKVN * 1024, MT, QKVN, 1024, 0};
                pg8::StaticOrder S; S.init(MT, QKVN, Gp, bxp);
                LAS float* gl = (LAS float*)(lds + AUX_RS);
                if (tid < 128) gl[tid] = (PARF(ws) + (tid < 64 ? P_QG : P_KG - 64) + lh * 64)[tid];
                __syncthreads();
                pg8::EpiQKV E{ws, WS_Q, WS_K - WS_Q, WS_V - WS_K, gl, (const float*)(ws + WS_ROPE), ATT_C2};
                pg8::gemm_phase<pg8::EpiQKV, pg8::StaticOrder, true, true>(lds + RING_OFF, g, S, E, tid);
            } SEAM(pb + 1);
            if (EN(5) && IN(pb + 3)) DUP(5) {
                PHASE_IDS();
                const attn_body::bf16* Qp = (const attn_body::bf16*)(ws + WS_Q); const attn_body::bf16* Kp = (const attn_body::bf16*)(ws + WS_K); const attn_body::bf16* Vp = (const attn_body::bf16*)(ws + WS_V);
                attn_body::bf16* Op = (attn_body::bf16*)(ws + WS_XN);
                if (G == 256) {
                    for (int i = 0; i < 9; ++i) {
                        long qrow0, kvrow0; int NT, h;
                        if (i < 8) { const int x = vcu >> 5, j = vcu & 31, pair = 4 * x + (i >> 1), wi = (i & 1) * 32 + j, hq = wi >> 4, qb = wi & 15, b = pair >> 2, hk = pair & 3;
                            h = hk * 4 + hq; qrow0 = (long)b * TB + CTXL + qb * 256; kvrow0 = (long)b * TB; NT = TB / 64; }
                        else { if (vcu >= 128) break; const int b = vcu >> 4; h = vcu & 15; qrow0 = (long)b * TB; kvrow0 = qrow0; NT = CTXL / 64; }
                        attn_body::attn_unit<8>(qrow0, kvrow0, NT, h, Qp, Kp, Vp, Op, (char*)lds_raw + RING_OFF, tid);
                    }
                } else {
                    for (int U = bx; U < 2048 + 128; U += G) {
                        long qrow0, kvrow0; int NT, h;
                        if (U < 2048) { const int pair = U >> 6, wi = U & 63, hq = wi >> 4, qb = wi & 15, b = pair >> 2, hk = pair & 3; h = hk * 4 + hq; qrow0 = (long)b * TB + CTXL + qb * 256; kvrow0 = (long)b * TB; NT = TB / 64; }
                        else { const int v = U - 2048, b = v >> 4; h = v & 15; qrow0 = (long)b * TB; kvrow0 = qrow0; NT = CTXL / 64; }
                        attn_body::attn_unit<8>(qrow0, kvrow0, NT, h, Qp, Kp, Vp, Op, (char*)lds_raw + RING_OFF, tid);
                    }
                }
            } SEAM(pb + 3);
        } else {
            if (EN(6) && IN(pb + 1)) DUP(6) {
                PHASE_IDS();
                pg8::Gemm g{(const pg8::bf16_t*)(ws + WS_XN), (const pg8::bf16_t*)(ws + WS_WIN) + (size_t)lh * WINP * 1024, MT, WINP, 1024, 0};
                pg8::StaticOrder S; S.init(MT, WINP, Gp, bxp);
                pg8::EpiBf16 E{(pg8::bf16_t*)(ws + WS_G), WINP};
                pg8::gemm_phase<pg8::EpiBf16, pg8::StaticOrder, true, true>(lds + RING_OFF, g, S, E, tid);
            } SEAM(pb + 1);
            if (EN(7) && IN(pb + 2)) DUP(7) { PHASE_IDS(); phase_gla_g0(ws, lh, lds, tid); } SEAM(pb + 2);
            if (EN(8) && IN(pb + 3)) DUP(8) { PHASE_IDS(); phase_gla_g12(ws, lds, gw, wave, lane); } SEAM(pb + 3);
            if (EN(8) && IN(pb + 4)) DUP(9) { PHASE_IDS(); phase_gla_g3(ws, lh, lds, tid); } SEAM(pb + 4);
        }
        if (EN(9) && IN(pb + 5)) {
            PHASE_IDS();
            const pg8::bf16_t* Wt = (layer & 1) ? (const pg8::bf16_t*)(ws + WS_WOG) + (size_t)lh * 1024 * 1024 : (const pg8::bf16_t*)(ws + WS_WOA) + (size_t)lh * 1024 * 1024;
            pg8::Gemm g{(const pg8::bf16_t*)(ws + ((layer & 1) ? WS_Q : WS_XN)), Wt, MT, 1024, 1024, 0};
            pg8::StaticOrder S; if (layer == NLAYER - 1) S.init(NB * SEQ, 1024, Gp, bxp, true); else S.init(MT, 1024, Gp, bxp);
            pg8::EpiResGate E{(pg8::bf16_t*)(ws + WS_X), (const float*)(ws + WS_MOD) + (size_t)layer * MODROWS * NMODC + 2 * 1024};
            pg8::gemm_phase<pg8::EpiResGate, pg8::StaticOrder, true, true>(lds + RING_OFF, g, S, E, tid);
        } SEAM(pb + 5);
        if (EN(10) && IN(pb + 6)) { if ((DUPMASK >> 10) & 1) { PHASE_IDS(); phase_modulate2_route(ws, layer, lds, vcu, wave, lane, tid, true); __syncthreads(); } PHASE_IDS(); phase_modulate2_route(ws, layer, lds, vcu, wave, lane, tid); } SEAM(pb + 6);
        if (EN(12) && IN(pb + 8)) DUP(12) {
            PHASE_IDS();
            build_expert_tables(ws, layer, lds, tid);
            const int nT = __builtin_amdgcn_readfirstlane(((const LAS int*)(lds + AUX_NT))[0]);
            pg8::MoeOrder S{nT, 8, Gp, bxp, (const LAS int*)(lds + AUX_T2E)};
            LAS unsigned short* rowtab = (LAS unsigned short*)(lds + AUX_ROWTAB);
            { const LAS int* base = (const LAS int*)(lds + AUX_BASE); const LAS int* cntl = (const LAS int*)(lds + AUX_CNT); const int* LIST = (const int*)(ws + WS_LIST);
              pg8::Unit u;
              for (int i = 0; i < ROWTAB_UNITS && S.next(i, u); ++i) if (tid < 256) { const int pos = (u.pm - (base[u.e] >> 8)) * 256 + tid; rowtab[i * 256 + tid] = (unsigned short)((pos < cntl[u.e]) ? LIST[(size_t)u.e * MT + pos] : 0); }
              __syncthreads(); }
            pg8::Gemm g{(const pg8::bf16_t*)(ws + WS_XN8), (const pg8::bf16_t*)(ws + WS_WGU + (size_t)layer * 32 * 2048 * 1024), MPAD, 2048, 512, (size_t)2048 * 1024, rowtab};
            pg8::EpiSwiGLU8 E{ws + WS_ACT, PARF(ws) + P_BGU + (size_t)layer * 32 * 2048, 1.0f / 32.0f};
            pg8::gemm_phase<pg8::EpiSwiGLU8, pg8::MoeOrder, true, true, true, true>(lds + RING_OFF, g, S, E, tid);
        } SEAM(pb + 8);
        if (EN(13) && IN(pb + 9)) DUP(13) {
            PHASE_IDS();
            build_expert_tables(ws, layer, lds, tid);
            const int nT = __builtin_amdgcn_readfirstlane(((const LAS int*)(lds + AUX_NT))[0]);
            pg8::Gemm g{(const pg8::bf16_t*)(ws + WS_ACT), (const pg8::bf16_t*)(ws + WS_WDN + (size_t)layer * 32 * 1024 * 1024), MPAD, 1024, 512, (size_t)1024 * 1024};
            pg8::MoeOrder S{nT, 4, Gp, bxp, (const LAS int*)(lds + AUX_T2E)};
            pg8::EpiBiasF8 E{ws + WS_Y, PARF(ws) + P_BDN + (size_t)layer * 32 * 1024, 1.0f / 32.0f};
            pg8::gemm_phase<pg8::EpiBiasF8, pg8::MoeOrder, true, true, false, true>(lds + RING_OFF, g, S, E, tid);
        } SEAM(pb + 9);
        if (EN(14) && IN(pb + 10)) { if ((DUPMASK >> 14) & 1) { PHASE_IDS(); phase_moe_combine(ws, args.out, layer, lds, gw, NGW, lane, tid, true); } PHASE_IDS(); phase_moe_combine(ws, args.out, layer, lds, gw, NGW, lane, tid); } SEAM(pb + 10);
    }
#undef IN
#undef EN
#undef DUP
#undef SEAM
#undef PHASE_IDS
#undef LANE_ID
}

extern "C" void kernel_launch(void* const* d_in, const int* in_sizes, int n_in, void* d_out, int out_size, void* d_ws, size_t ws_size, hipStream_t stream) {
    static int grid = 0;
    if (grid == 0) {
        if (n_in != 25 || out_size != NB * SEQ * DMODEL || ws_size < WS_END) { fprintf(stderr, "kernel_launch: unexpected shapes: n_in %d out %d ws %zu (need >= %zu)\n", n_in, out_size, ws_size, (size_t)WS_END); grid = -1; return; }
        int dev = 0, cus = 0, per_cu = 0;
        if (hipGetDevice(&dev) != hipSuccess || hipDeviceGetAttribute(&cus, hipDeviceAttributeMultiprocessorCount, dev) != hipSuccess) { grid = -1; return; }
        if (hipFuncSetAttribute((const void*)dit_fwd, hipFuncAttributeMaxDynamicSharedMemorySize, LDS_BYTES) != hipSuccess) { fprintf(stderr, "kernel_launch: hipFuncSetAttribute failed\n"); grid = -1; return; }
        if (hipOccupancyMaxActiveBlocksPerMultiprocessor(&per_cu, (const void*)dit_fwd, NWAVES * 64, LDS_BYTES) != hipSuccess || per_cu < 1) fprintf(stderr, "kernel_launch: occupancy query reports %d\n", per_cu);
        (void)hipGetLastError();
        grid = cus;
    }
    if (grid < 0) return;
    if (hipMemsetAsync((char*)d_ws + WS_CTL, 0, CTL_ZERO_BYTES, stream) != hipSuccess) { fprintf(stderr, "kernel_launch: memset failed\n"); return; }
    Args a{};
    for (int i = 0; i < 25; ++i) a.in[i] = (const float*)d_in[i];
    a.out = (float*)d_out; a.ws = (unsigned char*)d_ws;
#if MK_ONE_LAUNCH
    a.ph_lo = 0; a.ph_hi = NPHASE;
    hipLaunchKernelGGL(dit_fwd, dim3(grid), dim3(NWAVES * 64), LDS_BYTES, stream, a);
#else
    for (int p = 0; p < NPHASE; ++p) { a.ph_lo = p; a.ph_hi = p + 1; hipLaunchKernelGGL(dit_fwd, dim3(grid), dim3(NWAVES * 64), LDS_BYTES, stream, a); }
#endif
    const hipError_t le = hipPeekAtLastError();
    if (le != hipSuccess) fprintf(stderr, "kernel_launch: launch failed: %s\n", hipGetErrorName(le));
}
```

```cpp
#include <hip/hip_runtime.h>
#include <hip/hip_bf16.h>
#include <cstdio>
#include <cstdint>
#include <cmath>

#ifndef MK_ONE_LAUNCH
#define MK_ONE_LAUNCH 1
#endif

namespace pg8 {
#define PG8_LAS __attribute__((address_space(3)))
typedef unsigned short bf16_t;
typedef short bf16x8 __attribute__((ext_vector_type(8)));
typedef float f32x4 __attribute__((ext_vector_type(4)));
typedef unsigned u32x4 __attribute__((ext_vector_type(4)));
constexpr int BM = 256, BK = 64, HALF = 128, HTB = HALF * BK * 2  , STAGE_BYTES = 8 * HTB, NXCD = 8, WGM = 8;

__host__ __device__ __forceinline__ int lds_byte(int r, int c) { const int st = (r >> 4) * 2 + (c >> 5), rr = r & 15, cc = c & 31, ob = rr * 64 + cc * 2; return st * 1024 + (ob ^ (((ob >> 9) & 1) << 5)); }
__host__ __device__ __forceinline__ void stage_rc(int b, int& R, int& C) { const int st = b / 1024, sb = b % 1024, swz = sb ^ (((sb >> 9) & 1) << 5); R = (st >> 1) * 16 + swz / 64; C = (st & 1) * 32 + (swz % 64) / 2; }
__host__ __device__ __forceinline__ int perm32(int rho) { const int n = rho >> 4, i = rho & 15; return 8 * (i >> 2) + 4 * n + (i & 3); }

struct Unit { int pm, pn, e; };
struct Gemm { const bf16_t* A; const bf16_t* Bt; int M, N, K; size_t bstride; const PG8_LAS unsigned short* rowtab; };

struct StaticOrder {
    int nM, nN, nwg, G, c; bool latent_only;
    __host__ __device__ __forceinline__ void init(int M, int N, int G_, int c_, bool lat_ = false) { nM = M / BM; nN = N / BM; nwg = nM * nN; G = G_; c = c_; latent_only = lat_; }
    __host__ __device__ __forceinline__ bool next(int i, Unit& u) const {
        const long L = (long)i * G + c; if (L >= nwg) return false;
        int wgid = (int)L; { const int q = nwg / NXCD, r = nwg % NXCD, xcd = wgid % NXCD, off = wgid / NXCD; wgid = (xcd < r ? xcd * (q + 1) : r * (q + 1) + (xcd - r) * q) + off; }
        const int nig = WGM * nN, gid = wgid / nig, fm = gid * WGM, gsz = (nM - fm) < WGM ? (nM - fm) : WGM;
        u.pm = fm + ((wgid % nig) % gsz); u.pn = (wgid % nig) / gsz; u.e = 0;
        if (latent_only) u.pm = (u.pm >> 4) * 17 + 1 + (u.pm & 15);
        return true;
    }
    __device__ __forceinline__ void a_ready(const Unit&) const {}
    __device__ __forceinline__ void done(const Unit&) const {}
};
struct MoeOrder {
    int nT, nN, G, c; const PG8_LAS int* t2e;
    __device__ __forceinline__ bool next(int i, Unit& u) const {
        const int x = c & 7, j = c >> 3, per = 32 / nN, mt = (i * (G >> 5) + x) * per + j / nN; if (mt >= nT) return false;
        u.pm = mt; u.pn = j % nN; u.e = __builtin_amdgcn_readfirstlane(t2e[mt]); return true;
    }
    __device__ __forceinline__ void a_ready(const Unit&) const {}
    __device__ __forceinline__ void done(const Unit&) const {}
};

__device__ __forceinline__ int lane_now() { unsigned z; asm volatile("s_mov_b32 %0, 0" : "=s"(z)); return (int)__builtin_amdgcn_mbcnt_hi(~0u, __builtin_amdgcn_mbcnt_lo(~0u, z)); }
__device__ __forceinline__ float shx(float v, int m, int ln) { return __int_as_float(__builtin_amdgcn_ds_bpermute((ln ^ m) << 2, __float_as_int(v))); }
__device__ __forceinline__ unsigned pk4_fp8(float a, float b, float c, float d) { int w = 0; w = __builtin_amdgcn_cvt_pk_fp8_f32(a, b, w, false); w = __builtin_amdgcn_cvt_pk_fp8_f32(c, d, w, true); return (unsigned)w; }
__device__ __forceinline__ unsigned cvt_pk_bf16(float lo, float hi) { unsigned r; asm volatile("v_cvt_pk_bf16_f32 %0, %1, %2" : "=v"(r) : "v"(lo), "v"(hi)); return r; }

struct EpiBf16 {
    static constexpr bool PERM = true, AFTER_DRAIN = false;
    bf16_t* O; int ldc;
    __device__ __forceinline__ void operator()(const f32x4 (&acc)[2][2][4][2], const Unit& u, int wr, int wc, int fr, int fq) const {
        const int row0 = u.pm * BM + wr * 64 + fr; const int col0 = u.pn * BM + wc * 32 + 8 * fq;
#pragma unroll
        for (int ai = 0; ai < 2; ++ai)
#pragma unroll
            for (int m = 0; m < 4; ++m) { bf16_t* rowp = O + (size_t)(row0 + ai * HALF + m * 16) * ldc + col0;
#pragma unroll
                for (int bj = 0; bj < 2; ++bj) { const f32x4 v0 = acc[ai][bj][m][0], v1 = acc[ai][bj][m][1];
                    u32x4 w; w.x = cvt_pk_bf16(v0[0], v0[1]); w.y = cvt_pk_bf16(v0[2], v0[3]); w.z = cvt_pk_bf16(v1[0], v1[1]); w.w = cvt_pk_bf16(v1[2], v1[3]);
                    *(u32x4*)(rowp + bj * HALF) = w; } }
    }
};
struct EpiQKV {
    static constexpr bool PERM = true, AFTER_DRAIN = false;
    unsigned char* wsb; size_t offQ, dK, dV;
    const PG8_LAS float* gl; const float* ropec; float c2;
    __device__ __forceinline__ void operator()(const f32x4 (&acc)[2][2][4][2], const Unit& u, int wr, int wc, int fr, int fq) const {
        const int isk = (u.pn >= 4) ? 1 : 0, isv = (u.pn >= 5) ? 1 : 0;
        bf16_t* base = (bf16_t*)(wsb + offQ + (size_t)isk * dK + (size_t)isv * dV); const int ldc = isk ? 256 : 1024;
        const int hcol = (isk ? wc : (u.pn * 4 + wc)) * 64 + 8 * fq;
        const int pmb = u.pm / 17, pml = u.pm - pmb * 17; const bool lat = pml != 0;
        const PG8_LAS float* gp = gl + (isk ? 64 : 0) + 8 * fq; const float scl = isk ? 1.0f : c2;
#pragma unroll
        for (int ai = 0; ai < 2; ++ai)
#pragma unroll
            for (int m = 0; m < 4; ++m) { const int rl = ai * HALF + wr * 64 + m * 16 + fr; const size_t row = (size_t)u.pm * BM + rl;
                f32x4 v[2][2]; float ss = 0.f;
#pragma unroll
                for (int bj = 0; bj < 2; ++bj)
#pragma unroll
                    for (int n = 0; n < 2; ++n) { v[bj][n] = acc[ai][bj][m][n]; ss += (v[bj][n][0] * v[bj][n][0] + v[bj][n][1] * v[bj][n][1]) + (v[bj][n][2] * v[bj][n][2] + v[bj][n][3] * v[bj][n][3]); }
                if (!isv) { const int ln = lane_now(); ss += shx(ss, 16, ln); ss += shx(ss, 32, ln);
                    const float rs = 1.0f / sqrtf(ss * (1.0f / 64.0f) + 1e-6f);
                    const int spos = (pml - 1) * 256 + rl;
#pragma unroll
                    for (int bj = 0; bj < 2; ++bj) { f32x4 cs = (f32x4){1.f, 1.f, 1.f, 1.f}, sn = (f32x4){0.f, 0.f, 0.f, 0.f};
                        if (lat) { const float* cp = ropec + (size_t)spos * 32 + 16 * bj + 4 * fq; cs = *(const f32x4*)cp; sn = *(const f32x4*)(cp + 4096 * 32); }
#pragma unroll
                        for (int n = 0; n < 2; ++n) { const f32x4 y = v[bj][n] * rs * *(const PG8_LAS f32x4*)(gp + 32 * bj + 4 * n);
                            const float c0 = cs[2 * n], s0 = sn[2 * n], c1 = cs[2 * n + 1], s1 = sn[2 * n + 1];
                            v[bj][n] = (f32x4){(y[0] * c0 - y[1] * s0) * scl, (y[0] * s0 + y[1] * c0) * scl, (y[2] * c1 - y[3] * s1) * scl, (y[2] * s1 + y[3] * c1) * scl}; } } }
                bf16_t* rowp = base + row * ldc + hcol;
#pragma unroll
                for (int bj = 0; bj < 2; ++bj) { u32x4 w; w.x = cvt_pk_bf16(v[bj][0][0], v[bj][0][1]); w.y = cvt_pk_bf16(v[bj][0][2], v[bj][0][3]); w.z = cvt_pk_bf16(v[bj][1][0], v[bj][1][1]); w.w = cvt_pk_bf16(v[bj][1][2], v[bj][1][3]);
                    *(u32x4*)(rowp + 32 * bj) = w; } }
    }
};
struct EpiBiasF8 {
    static constexpr bool PERM = true, AFTER_DRAIN = false;
    unsigned char* O; const float* bias; float ascale;
    __device__ __forceinline__ void operator()(const f32x4 (&acc)[2][2][4][2], const Unit& u, int wr, int wc, int fr, int fq) const {
        const int row0 = u.pm * BM + wr * 64 + fr; const int col0 = u.pn * BM + wc * 32 + 8 * fq;
        const float* bp = bias + (size_t)u.e * 1024 + col0;
        f32x4 bv[2][2];
#pragma unroll
        for (int bj = 0; bj < 2; ++bj)
#pragma unroll
            for (int n = 0; n < 2; ++n) bv[bj][n] = *(const f32x4*)(bp + bj * HALF + 4 * n);
#pragma unroll
        for (int ai = 0; ai < 2; ++ai)
#pragma unroll
            for (int m = 0; m < 4; ++m) { unsigned char* rowp = O + (size_t)(row0 + ai * HALF + m * 16) * 1024 + col0;
#pragma unroll
                for (int bj = 0; bj < 2; ++bj) { const f32x4 v0 = acc[ai][bj][m][0] * ascale + bv[bj][0], v1 = acc[ai][bj][m][1] * ascale + bv[bj][1];
                    *(unsigned long long*)(rowp + bj * HALF) = (unsigned long long)pk4_fp8(v0[0], v0[1], v0[2], v0[3]) | ((unsigned long long)pk4_fp8(v1[0], v1[1], v1[2], v1[3]) << 32); } }
    }
};
struct EpiResGate {
    static constexpr bool PERM = false, AFTER_DRAIN = false;
    bf16_t* X; const float* gate;
    __device__ __forceinline__ void operator()(const f32x4 (&acc)[2][2][4][2], const Unit& u, int wr, int wc, int fr, int fq) const {
        const int row0 = u.pm * BM + wr * 64 + fr; const int col0 = u.pn * BM + wc * 32 + 4 * fq;
        const int bb = u.pm / 17, mr = (u.pm - bb * 17 == 0) ? 8 : bb;
        const float* gp = gate + (size_t)mr * 6144 + col0;
        f32x4 gv[2][2];
#pragma unroll
        for (int bj = 0; bj < 2; ++bj)
#pragma unroll
            for (int n = 0; n < 2; ++n) gv[bj][n] = *(const f32x4*)(gp + bj * HALF + n * 16);
#pragma unroll
        for (int ai = 0; ai < 2; ++ai)
#pragma unroll
            for (int m = 0; m < 4; ++m) { bf16_t* rowp = X + (size_t)(row0 + ai * HALF + m * 16) * 1024 + col0;
#pragma unroll
                for (int bj = 0; bj < 2; ++bj)
#pragma unroll
                    for (int n = 0; n < 2; ++n) { unsigned long long* p = (unsigned long long*)(rowp + bj * HALF + n * 16); const unsigned long long v = *p;
                        f32x4 x = (f32x4){__uint_as_float((unsigned)(v & 0xffffu) << 16), __uint_as_float((unsigned)(v >> 16) << 16), __uint_as_float((unsigned)((v >> 32) & 0xffffu) << 16), __uint_as_float((unsigned)(v >> 48) << 16)};
                        x = x + gv[bj][n] * acc[ai][bj][m][n];
                        *p = (unsigned long long)cvt_pk_bf16(x[0], x[1]) | ((unsigned long long)cvt_pk_bf16(x[2], x[3]) << 32); } }
    }
};
struct EpiSwiGLU {
    static constexpr bool PERM = true, AFTER_DRAIN = false;
    bf16_t* O; const float* bias;
    __device__ __forceinline__ void operator()(const f32x4 (&acc)[2][2][4][2], const Unit& u, int wr, int wc, int fr, int fq) const {
        const int row0 = u.pm * BM + wr * 64 + fr; const int col0 = u.pn * HALF + wc * 32 + 8 * fq;
        const float* bp = bias + (size_t)u.e * 2048 + col0;
        f32x4 bg[2], bu[2];
#pragma unroll
        for (int n = 0; n < 2; ++n) { bg[n] = *(const f32x4*)(bp + 4 * n); bu[n] = *(const f32x4*)(bp + 1024 + 4 * n); }
#pragma unroll
        for (int ai = 0; ai < 2; ++ai)
#pragma unroll
            for (int m = 0; m < 4; ++m) { bf16_t* rowp = O + (size_t)(row0 + ai * HALF + m * 16) * 1024 + col0;
                float r[8];
#pragma unroll
                for (int n = 0; n < 2; ++n) { const f32x4 gt = acc[ai][0][m][n] + bg[n], up = acc[ai][1][m][n] + bu[n];
#pragma unroll
                    for (int i = 0; i < 4; ++i) { const float g = fminf(gt[i], 7.0f), uu = fminf(fmaxf(up[i], -7.0f), 7.0f);
                        const float sg = __builtin_amdgcn_rcpf(1.0f + __builtin_amdgcn_exp2f(-1.702f * 1.4426950408889634f * g));
                        r[4 * n + i] = (uu + 1.0f) * (g * sg); } }
                u32x4 w; w.x = cvt_pk_bf16(r[0], r[1]); w.y = cvt_pk_bf16(r[2], r[3]); w.z = cvt_pk_bf16(r[4], r[5]); w.w = cvt_pk_bf16(r[6], r[7]);
                *(u32x4*)rowp = w; }
    }
};
struct EpiSwiGLU8 {
    static constexpr bool PERM = true, AFTER_DRAIN = false;
    unsigned char* O; const float* bias; float ascale;
    __device__ __forceinline__ void operator()(const f32x4 (&acc)[2][2][4][2], const Unit& u, int wr, int wc, int fr, int fq) const {
        const int row0 = u.pm * BM + wr * 64 + fr; const int col0 = u.pn * HALF + wc * 32 + 8 * fq;
        const float* bp = bias + (size_t)u.e * 2048 + col0;
        f32x4 bg[2], bu[2];
#pragma unroll
        for (int n = 0; n < 2; ++n) { bg[n] = *(const f32x4*)(bp + 4 * n); bu[n] = *(const f32x4*)(bp + 1024 + 4 * n); }
#pragma unroll
        for (int ai = 0; ai < 2; ++ai)
#pragma unroll
            for (int m = 0; m < 4; ++m) { unsigned char* rowp = O + (size_t)(row0 + ai * HALF + m * 16) * 1024 + col0;
                float r[8];
#pragma unroll
                for (int n = 0; n < 2; ++n) { const f32x4 gt = acc[ai][0][m][n] * ascale + bg[n], up = acc[ai][1][m][n] * ascale + bu[n];
#pragma unroll
                    for (int i = 0; i < 4; ++i) { const float g = fminf(gt[i], 7.0f), uu = fminf(fmaxf(up[i], -7.0f), 7.0f);
                        const float sg = __builtin_amdgcn_rcpf(1.0f + __builtin_amdgcn_exp2f(-1.702f * 1.4426950408889634f * g));
                        r[4 * n + i] = (uu + 1.0f) * (g * sg); } }
                *(unsigned long long*)rowp = (unsigned long long)pk4_fp8(r[0], r[1], r[2], r[3]) | ((unsigned long long)pk4_fp8(r[4], r[5], r[6], r[7]) << 32); }
    }
};
struct EpiBiasBf16 {
    static constexpr bool PERM = true, AFTER_DRAIN = false;
    bf16_t* O; const float* bias; float ascale;
    __device__ __forceinline__ void operator()(const f32x4 (&acc)[2][2][4][2], const Unit& u, int wr, int wc, int fr, int fq) const {
        const int row0 = u.pm * BM + wr * 64 + fr; const int col0 = u.pn * BM + wc * 32 + 8 * fq;
        const float* bp = bias + (size_t)u.e * 1024 + col0;
        f32x4 bv[2][2];
#pragma unroll
        for (int bj = 0; bj < 2; ++bj)
#pragma unroll
            for (int n = 0; n < 2; ++n) bv[bj][n] = *(const f32x4*)(bp + bj * HALF + 4 * n);
#pragma unroll
        for (int ai = 0; ai < 2; ++ai)
#pragma unroll
            for (int m = 0; m < 4; ++m) { bf16_t* rowp = O + (size_t)(row0 + ai * HALF + m * 16) * 1024 + col0;
#pragma unroll
                for (int bj = 0; bj < 2; ++bj) { const f32x4 v0 = acc[ai][bj][m][0] * ascale + bv[bj][0], v1 = acc[ai][bj][m][1] * ascale + bv[bj][1];
                    u32x4 w; w.x = cvt_pk_bf16(v0[0], v0[1]); w.y = cvt_pk_bf16(v0[2], v0[3]); w.z = cvt_pk_bf16(v1[0], v1[1]); w.w = cvt_pk_bf16(v1[2], v1[3]);
                    *(u32x4*)(rowp + bj * HALF) = w; } }
    }
};

template <class Epi, class Sched, bool ALIGN_EPI = false, bool SP2 = false, bool GATHER = false, bool F8 = false>
__device__ __forceinline__ void gemm_phase(PG8_LAS unsigned char* lds, const Gemm g, const Sched& S, const Epi& E, int tid_in) {
    int tid_l = tid_in; asm volatile("" : "+v"(tid_l));
    const int tid = tid_l, wid = __builtin_amdgcn_readfirstlane(tid >> 6), lane = tid & 63, wr = wid >> 2, wc = wid & 3, fr = lane & 15, fq = lane >> 4;
    const int K = g.K, nt = K / BK;
    unsigned voffA[2], voffB[2];
#pragma unroll
    for (int i = 0; i < 2; ++i) { int R, C; stage_rc(tid * 16 + i * 8192, R, C); const int Rb = Epi::PERM ? ((R & ~31) + perm32(R & 31)) : R;
        voffA[i] = (unsigned)(R * K + C) * 2u; voffB[i] = (unsigned)(Rb * K + C) * 2u; }
    const size_t kstep = (size_t)(BK * 2);
    static_assert(!GATHER || SP2, "GATHER is wired into the SP2 loop only");
    unsigned vAc0[2], vAc1[2], vAn0[2], vAn1[2]; int gR[2]; unsigned gC[2];
#pragma unroll
    for (int i = 0; i < 2; ++i) { int R, C; stage_rc(tid * 16 + i * 8192, R, C); gR[i] = R; gC[i] = (unsigned)C * 2u; vAc0[i] = voffA[i]; vAc1[i] = voffA[i]; vAn0[i] = voffA[i]; vAn1[i] = voffA[i]; }
#define PG8_GFETCH(d0, d1, ord) do { if constexpr (GATHER) { _Pragma("unroll") for (int _i = 0; _i < 2; ++_i) { \
        d0[_i] = (unsigned)g.rowtab[(ord) * 256 + gR[_i]] * (unsigned)(K * 2) + gC[_i]; d1[_i] = (unsigned)g.rowtab[(ord) * 256 + 128 + gR[_i]] * (unsigned)(K * 2) + gC[_i]; } } } while (0)
    const size_t hstep = (size_t)HALF * K * 2;
    const size_t hstepA = GATHER ? 0 : hstep;
    const size_t tstep = 2 * hstep;
    const unsigned ldsw = (unsigned)wid * 1024u;
    const int aoff = lds_byte(wr * 64 + fr, fq * 8), boff = lds_byte(wc * 32 + fr, fq * 8);
    typedef int v8i_t __attribute__((ext_vector_type(8))); typedef short v16s_a16 __attribute__((ext_vector_type(16), aligned(16)));
    const int f8c = 32 * (fq >> 1) + 16 * (fq & 1);
    const int aoff8a = lds_byte(wr * 64 + fr, f8c), boff8a = lds_byte(wc * 32 + fr, f8c);
    v8i_t At8[4], Au8[4], B08[2], B18[2]; int f8scale = 127; asm volatile("" : "+v"(f8scale));
#define PG8_SA(b, h) (((b) * 2 + (h)) * HTB)
#define PG8_SB(b, h) ((4 + (b) * 2 + (h)) * HTB)
#define PG8_STAGE(bufoff, gbase, voff) do { _Pragma("unroll") for (int _i = 0; _i < 2; ++_i) \
        __builtin_amdgcn_global_load_lds((const unsigned*)((const char*)(gbase) + (voff)[_i]), (PG8_LAS unsigned*)(lds + (bufoff) + ldsw + _i * 8192), 16, 0, 0); } while (0)
#define PG8_LDA(dst, b, h) do { if constexpr (F8) { _Pragma("unroll") for (int m = 0; m < 4; ++m) { const bf16x8 lo_ = *(const PG8_LAS bf16x8*)(lds + PG8_SA(b, h) + aoff8a + m * 2048), hi_ = *(const PG8_LAS bf16x8*)(lds + PG8_SA(b, h) + aoff8a + m * 2048 + 16); dst##8[m] = __builtin_bit_cast(v8i_t, __builtin_shufflevector(lo_, hi_, 0, 1, 2, 3, 4, 5, 6, 7, 8, 9, 10, 11, 12, 13, 14, 15)); } } \
        else { _Pragma("unroll") for (int m = 0; m < 4; ++m) _Pragma("unroll") for (int k = 0; k < 2; ++k) dst[m][k] = *(const PG8_LAS bf16x8*)(lds + PG8_SA(b, h) + aoff + m * 2048 + k * 1024); } } while (0)
#define PG8_LDB(dst, b, h) do { if constexpr (F8) { _Pragma("unroll") for (int n = 0; n < 2; ++n) { const bf16x8 lo_ = *(const PG8_LAS bf16x8*)(lds + PG8_SB(b, h) + boff8a + n * 2048), hi_ = *(const PG8_LAS bf16x8*)(lds + PG8_SB(b, h) + boff8a + n * 2048 + 16); dst##8[n] = __builtin_bit_cast(v8i_t, __builtin_shufflevector(lo_, hi_, 0, 1, 2, 3, 4, 5, 6, 7, 8, 9, 10, 11, 12, 13, 14, 15)); } } \
        else { _Pragma("unroll") for (int n = 0; n < 2; ++n) _Pragma("unroll") for (int k = 0; k < 2; ++k) dst[n][k] = *(const PG8_LAS bf16x8*)(lds + PG8_SB(b, h) + boff + n * 2048 + k * 1024); } } while (0)
#define PG8_MMA(ai, bj, At, Bt) do { __builtin_amdgcn_s_setprio(1); if constexpr (F8) { _Pragma("unroll") for (int m = 0; m < 4; ++m) _Pragma("unroll") for (int n = 0; n < 2; ++n) \
            asm volatile("v_mfma_scale_f32_16x16x128_f8f6f4 %0, %1, %2, %0, %3, %3 op_sel_hi:[0,0,0]" : "+v"(acc[ai][bj][m][n]) : "v"(Bt##8[n]), "v"(At##8[m]), "v"(f8scale)); } \
        else { _Pragma("unroll") for (int m = 0; m < 4; ++m) _Pragma("unroll") for (int n = 0; n < 2; ++n) _Pragma("unroll") for (int k = 0; k < 2; ++k) \
        acc[ai][bj][m][n] = __builtin_amdgcn_mfma_f32_16x16x32_bf16(Bt[n][k], At[m][k], acc[ai][bj][m][n], 0, 0, 0); } __builtin_amdgcn_s_setprio(0); } while (0)
#define PG8_WAIT_V(n) asm volatile("s_waitcnt vmcnt(" #n ")" ::: "memory")
#define PG8_WAIT_L(n) asm volatile("s_waitcnt lgkmcnt(" #n ")" ::: "memory")
#define PG8_BAR __builtin_amdgcn_s_barrier()
#define PG8_SCHED __builtin_amdgcn_sched_barrier(0)
    Unit cur, nxt; int ui = 0;
    if (!S.next(0, cur)) return;
    f32x4 acc[2][2][4][2];
#pragma unroll
    for (int a = 0; a < 2; ++a)
#pragma unroll
        for (int b = 0; b < 2; ++b)
#pragma unroll
            for (int m = 0; m < 4; ++m)
#pragma unroll
                for (int n = 0; n < 2; ++n) acc[a][b][m][n] = (f32x4){0.f, 0.f, 0.f, 0.f};
    bf16x8 At[4][2], Au[4][2], B0[2][2], B1[2][2];
    const char* cA = (const char*)g.A + (GATHER ? (size_t)0 : (size_t)cur.pm * tstep); PG8_GFETCH(vAc0, vAc1, 0); const char* cB = (const char*)g.Bt + (size_t)cur.e * g.bstride + (size_t)cur.pn * tstep;
    S.a_ready(cur);
    if constexpr (SP2) {
        PG8_STAGE(PG8_SB(0, 0), cB, voffB); PG8_STAGE(PG8_SB(0, 1), cB + hstep, voffB); PG8_STAGE(PG8_SA(0, 0), cA, vAc0); PG8_STAGE(PG8_SA(0, 1), cA + hstepA, vAc1);
        if (wr == 1) PG8_BAR;
        PG8_WAIT_V(2); PG8_BAR;
        PG8_STAGE(PG8_SB(1, 0), cB + kstep, voffB); PG8_STAGE(PG8_SA(1, 0), cA + kstep, vAc0); PG8_STAGE(PG8_SB(1, 1), cB + hstep + kstep, voffB);
        PG8_WAIT_V(6); PG8_BAR;
    } else {
        PG8_STAGE(PG8_SB(0, 0), cB, voffB); PG8_STAGE(PG8_SA(0, 0), cA, voffA); PG8_STAGE(PG8_SB(0, 1), cB + hstep, voffB); PG8_STAGE(PG8_SA(0, 1), cA + hstep, voffA);
        if (wr == 1) PG8_BAR;
        PG8_WAIT_V(4); PG8_BAR;
        PG8_STAGE(PG8_SB(1, 0), cB + kstep, voffB); PG8_STAGE(PG8_SA(1, 0), cA + kstep, voffA); PG8_STAGE(PG8_SB(1, 1), cB + hstep + kstep, voffB);
        PG8_WAIT_V(6); PG8_BAR;
    }
    for (;;) {
        const bool has_next = S.next(ui + 1, nxt);
        const char* nA = (has_next && !GATHER) ? (const char*)g.A + (size_t)nxt.pm * tstep : cA;
        if constexpr (GATHER) { if (has_next) PG8_GFETCH(vAn0, vAn1, ui + 1); else { vAn0[0] = vAc0[0]; vAn0[1] = vAc0[1]; vAn1[0] = vAc1[0]; vAn1[1] = vAc1[1]; } }
        const char* nB = has_next ? (const char*)g.Bt + (size_t)nxt.e * g.bstride + (size_t)nxt.pn * tstep : cB;
#pragma unroll 1
        for (int t = 0; t < nt; t += 2) {
            const bool last = (t == nt - 2);
            const char* a1 = cA + (size_t)(t + 1) * kstep;
            const char* a2 = last ? nA : cA + (size_t)(t + 2) * kstep; const char* b2 = last ? nB : cB + (size_t)(t + 2) * kstep;
            const char* a3 = a2 + kstep; const char* b3 = b2 + kstep;
            if (last && has_next) S.a_ready(nxt);
            unsigned vS0[2], vS1[2];
            vS0[0] = last ? vAn0[0] : vAc0[0]; vS0[1] = last ? vAn0[1] : vAc0[1]; vS1[0] = last ? vAn1[0] : vAc1[0]; vS1[1] = last ? vAn1[1] : vAc1[1];
            if constexpr (SP2) {
            PG8_LDB(B0, 0, 0); PG8_LDB(B1, 0, 1); PG8_SCHED; PG8_LDA(At, 0, 0); PG8_STAGE(PG8_SA(1, 1), a1 + hstepA, vAc1);
            PG8_WAIT_V(8); PG8_WAIT_L(0); PG8_BAR; PG8_MMA(0, 0, At, B0); PG8_MMA(0, 1, At, B1); PG8_BAR; PG8_SCHED;
            if constexpr (F8) { PG8_LDA(Au, 0, 1); } else { PG8_LDA(At, 0, 1); } PG8_STAGE(PG8_SB(0, 0), b2, voffB); PG8_STAGE(PG8_SB(0, 1), b2 + hstep, voffB); PG8_STAGE(PG8_SA(0, 0), a2, vS0);
            PG8_WAIT_V(8); PG8_WAIT_L(0); PG8_BAR; if constexpr (F8) { PG8_MMA(1, 0, Au, B0); PG8_MMA(1, 1, Au, B1); } else { PG8_MMA(1, 0, At, B0); PG8_MMA(1, 1, At, B1); } PG8_BAR; PG8_SCHED;
            PG8_LDB(B0, 1, 0); PG8_LDB(B1, 1, 1); PG8_SCHED; PG8_LDA(At, 1, 0); PG8_STAGE(PG8_SA(0, 1), a2 + hstepA, vS1);
            PG8_WAIT_V(8); PG8_WAIT_L(0); PG8_BAR; PG8_MMA(0, 0, At, B0); PG8_MMA(0, 1, At, B1); PG8_BAR; PG8_SCHED;
            if constexpr (F8) { PG8_LDA(Au, 1, 1); } else { PG8_LDA(At, 1, 1); } PG8_STAGE(PG8_SB(1, 0), b3, voffB); PG8_STAGE(PG8_SB(1, 1), b3 + hstep, voffB); PG8_STAGE(PG8_SA(1, 0), a3, vS0);
            PG8_WAIT_V(8); PG8_WAIT_L(0); PG8_BAR; if constexpr (F8) { PG8_MMA(1, 0, Au, B0); PG8_MMA(1, 1, Au, B1); } else { PG8_MMA(1, 0, At, B0); PG8_MMA(1, 1, At, B1); } PG8_BAR; PG8_SCHED;
            } else {
            PG8_LDB(B0, 0, 0); PG8_SCHED; PG8_LDA(At, 0, 0); PG8_STAGE(PG8_SA(1, 1), a1 + hstep, voffA);
            PG8_WAIT_L(8); PG8_BAR; PG8_WAIT_L(0); PG8_MMA(0, 0, At, B0); PG8_BAR; PG8_SCHED;
            PG8_LDB(B1, 0, 1); PG8_STAGE(PG8_SB(0, 0), b2, voffB);
            PG8_BAR; PG8_WAIT_L(0); PG8_MMA(0, 1, At, B1); PG8_BAR;
            PG8_LDA(At, 0, 1); PG8_STAGE(PG8_SA(0, 0), a2, voffA);
            PG8_BAR; PG8_WAIT_L(0); PG8_MMA(1, 0, At, B0); PG8_BAR; PG8_SCHED;
            PG8_STAGE(PG8_SB(0, 1), b2 + hstep, voffB);
            PG8_WAIT_V(6); PG8_BAR; PG8_MMA(1, 1, At, B1); PG8_BAR;
            PG8_LDB(B0, 1, 0); PG8_SCHED; PG8_LDA(At, 1, 0); PG8_STAGE(PG8_SA(0, 1), a2 + hstep, voffA);
            PG8_WAIT_L(8); PG8_BAR; PG8_WAIT_L(0); PG8_MMA(0, 0, At, B0); PG8_BAR; PG8_SCHED;
            PG8_LDB(B1, 1, 1); PG8_STAGE(PG8_SB(1, 0), b3, voffB);
            PG8_BAR; PG8_WAIT_L(0); PG8_MMA(0, 1, At, B1); PG8_BAR;
            PG8_LDA(At, 1, 1); PG8_STAGE(PG8_SA(1, 0), a3, voffA);
            PG8_BAR; PG8_WAIT_L(0); PG8_MMA(1, 0, At, B0); PG8_BAR; PG8_SCHED;
            PG8_STAGE(PG8_SB(1, 1), b3 + hstep, voffB);
            PG8_WAIT_V(6); PG8_BAR; PG8_MMA(1, 1, At, B1); PG8_BAR;
            }
        }
        if constexpr (ALIGN_EPI) { if (wr == 0) PG8_BAR; }
        if constexpr (F8) asm volatile("s_nop 15\n\ts_nop 15" ::: "memory");
        if constexpr (!Epi::AFTER_DRAIN) { E(acc, cur, wr, wc, fr, fq); S.done(cur); }
        if (!has_next) break;
#pragma unroll
        for (int a = 0; a < 2; ++a)
#pragma unroll
            for (int b = 0; b < 2; ++b)
#pragma unroll
                for (int m = 0; m < 4; ++m)
#pragma unroll
                    for (int n = 0; n < 2; ++n) acc[a][b][m][n] = (f32x4){0.f, 0.f, 0.f, 0.f};
        cur = nxt; cA = nA; cB = nB; ++ui;
        if constexpr (GATHER) { vAc0[0] = vAn0[0]; vAc0[1] = vAn0[1]; vAc1[0] = vAn1[0]; vAc1[1] = vAn1[1]; }
        if constexpr (ALIGN_EPI) { if (wr == 1) PG8_BAR; }
    }
    PG8_WAIT_V(0);
    if constexpr (!ALIGN_EPI) { if (wr == 0) PG8_BAR; }
    PG8_BAR;
    if constexpr (Epi::AFTER_DRAIN) { E.fused(acc, cur, wr, wc, fr, fq, lds, wid, lane); S.done(cur); }
#undef PG8_SA
#undef PG8_SB
#undef PG8_STAGE
#undef PG8_LDA
#undef PG8_LDB
#undef PG8_MMA
#undef PG8_WAIT_V
#undef PG8_WAIT_L
#undef PG8_BAR
#undef PG8_SCHED
#undef PG8_GFETCH
}
}
#include <hip/hip_bf16.h>
#include <cmath>
namespace attn_body {
using bf16=__hip_bfloat16;
using bf16x8=__attribute__((ext_vector_type(8)))short;
using s16x4=__attribute__((ext_vector_type(4)))short;
using f32x16=__attribute__((ext_vector_type(16)))float;
using u32x4=__attribute__((ext_vector_type(4)))unsigned;
constexpr int D=64,DM=1024,KVP=256;
constexpr int NW=8,QBLK=32,QB=QBLK*NW,KVBLK=64;
__device__ __forceinline__ int crow(int r,int hi){return (r&3)+8*(r>>2)+4*hi;}
#define SBAR() __builtin_amdgcn_sched_barrier(0)
__device__ __forceinline__ void cmask(f32x16&p0,f32x16&p1,int jb,int qrel,int hi){
  const float NEG=-INFINITY; int kb=64*jb+4*hi;
  #pragma unroll
  for(int r=0;r<16;++r){int kv=kb+(r&3)+8*(r>>2); if(kv>qrel)p0[r]=NEG; if(kv+32>qrel)p1[r]=NEG;}
}

constexpr int NSLOT=3, SLOTB=8192;
constexpr int LDS_K=0, LDS_V=NSLOT*SLOTB, LDS_WS=2*NSLOT*SLOTB, LDS_OST=LDS_WS+NW*64*4, LDS_BYTES=LDS_OST+NW*4096;
constexpr float C2=0.125f*1.4426950408889634f;
__device__ __forceinline__ void glds16(const void*gsrc,unsigned lds_dst){unsigned keep;
  asm volatile("s_mov_b32 %0, m0\n\ts_mov_b32 m0, %2\n\ts_nop 0\n\tglobal_load_lds_dwordx4 %1, off\n\ts_mov_b32 m0, %0":"=&s"(keep):"v"(gsrc),"s"(lds_dst):"memory");}
__device__ __forceinline__ float max3f(float a,float b,float c){float r;asm("v_max3_f32 %0, %1, %2, %3":"=v"(r):"v"(a),"v"(b),"v"(c));return r;}
__device__ __forceinline__ float max2f(float a,float b){float r;asm("v_max_f32_e32 %0, %1, %2":"=v"(r):"v"(a),"v"(b));return r;}
__device__ __forceinline__ float fadd_s(float a,float b){float r;asm("v_add_f32_e32 %0, %1, %2":"=v"(r):"v"(a),"v"(b));return r;}
__device__ __forceinline__ float fsub_s(float a,float b){float r;asm("v_sub_f32_e32 %0, %1, %2":"=v"(r):"v"(a),"v"(b));return r;}
typedef float f32x2_t __attribute__((ext_vector_type(2))); typedef __bf16 bf16x2_t __attribute__((ext_vector_type(2)));
__device__ __forceinline__ unsigned cvtpk_s(float lo,float hi){f32x2_t v={lo,hi};bf16x2_t b=__builtin_convertvector(v,bf16x2_t);return __builtin_bit_cast(unsigned,b);}
#define WAIT_BAR(N) asm volatile("s_waitcnt vmcnt(" #N ") lgkmcnt(0)\n\ts_barrier":::"memory")

__device__ __forceinline__ void qkt(f32x16&p0,f32x16&p1,const char*Kslot,const bf16x8*qr,const f32x16&negm,int r32,int hi){
  const char*kb=Kslot+hi*1024+r32*16;
  #pragma unroll
  for(int d0=0;d0<4;++d0){
    const bf16x8 b0=*reinterpret_cast<const bf16x8*>(kb+d0*2048);
    const bf16x8 b1=*reinterpret_cast<const bf16x8*>(kb+d0*2048+512);
    if(d0==0){p0=__builtin_amdgcn_mfma_f32_32x32x16_bf16(b0,qr[0],negm,0,0,0);p1=__builtin_amdgcn_mfma_f32_32x32x16_bf16(b1,qr[0],negm,0,0,0);}
    else{p0=__builtin_amdgcn_mfma_f32_32x32x16_bf16(b0,qr[d0],p0,0,0,0);p1=__builtin_amdgcn_mfma_f32_32x32x16_bf16(b1,qr[d0],p1,0,0,0);}}
}
typedef __attribute__((address_space(3))) const char* lds_cptr;
typedef short v4i16_t __attribute__((ext_vector_type(4)));
__device__ __forceinline__ void kload8(bf16x8*kf,lds_cptr kp){
  kf[0]=*(const __attribute__((address_space(3))) bf16x8*)(kp);      kf[1]=*(const __attribute__((address_space(3))) bf16x8*)(kp+512);
  kf[2]=*(const __attribute__((address_space(3))) bf16x8*)(kp+2048); kf[3]=*(const __attribute__((address_space(3))) bf16x8*)(kp+2560);
  kf[4]=*(const __attribute__((address_space(3))) bf16x8*)(kp+4096); kf[5]=*(const __attribute__((address_space(3))) bf16x8*)(kp+4608);
  kf[6]=*(const __attribute__((address_space(3))) bf16x8*)(kp+6144); kf[7]=*(const __attribute__((address_space(3))) bf16x8*)(kp+6656);
}
__device__ __forceinline__ void kload2(bf16x8*kf,lds_cptr kp,int j){ kf[2*j]=*(const __attribute__((address_space(3))) bf16x8*)(kp+j*2048); kf[2*j+1]=*(const __attribute__((address_space(3))) bf16x8*)(kp+j*2048+512); }
__device__ __forceinline__ s16x4 vtr(lds_cptr p){ return __builtin_bit_cast(s16x4,__builtin_amdgcn_ds_read_tr16_b64_v4i16((__attribute__((address_space(3))) v4i16_t*)p)); }
__device__ __forceinline__ float rowmax(const f32x16&p0,const f32x16&p1){
  float a=max3f(p0[0],p0[1],p1[0]),b=max3f(p0[2],p0[3],p1[1]);a=max3f(a,p1[2],p1[3]);
  #pragma unroll
  for(int r=4;r<16;r+=4){a=max3f(a,p0[r],p0[r+1]);b=max3f(b,p0[r+2],p0[r+3]);a=max3f(a,p1[r],p1[r+1]);b=max3f(b,p1[r+2],p1[r+3]);}
  const float m=max2f(a,b);
  auto rr=__builtin_amdgcn_permlane32_swap(__float_as_uint(m),__float_as_uint(m),false,false);
  return max2f(__uint_as_float(rr[0]),__uint_as_float(rr[1]));
}
__device__ __forceinline__ void pv(f32x16*o,int vb,bf16x8 pa0,bf16x8 pa1,bf16x8 pa2,bf16x8 pa3){
  #pragma unroll
  for(int d0=0;d0<2;++d0){s16x4 lo[4],hi[4];
    #pragma unroll
    for(int ks=0;ks<4;++ks){
      asm volatile("ds_read_b64_tr_b16 %0,%1 offset:%c2":"=&v"(lo[ks]):"v"(vb),"i"(d0*4096+ks*1024):"memory");
      asm volatile("ds_read_b64_tr_b16 %0,%1 offset:%c2":"=&v"(hi[ks]):"v"(vb),"i"(d0*4096+ks*1024+512):"memory");}
    asm volatile("s_waitcnt lgkmcnt(0)":::"memory");SBAR();
    #define PK(k) (bf16x8){lo[k][0],lo[k][1],lo[k][2],lo[k][3],hi[k][0],hi[k][1],hi[k][2],hi[k][3]}
    o[d0]=__builtin_amdgcn_mfma_f32_32x32x16_bf16(pa0,PK(0),o[d0],0,0,0);
    o[d0]=__builtin_amdgcn_mfma_f32_32x32x16_bf16(pa1,PK(1),o[d0],0,0,0);
    o[d0]=__builtin_amdgcn_mfma_f32_32x32x16_bf16(pa2,PK(2),o[d0],0,0,0);
    o[d0]=__builtin_amdgcn_mfma_f32_32x32x16_bf16(pa3,PK(3),o[d0],0,0,0);
    #undef PK
  }
}

#ifndef ATTN_STORE16
#define ATTN_STORE16(p,v) (*(u32x4*)(p)=(v))
#endif
template<int THRL> __device__ __forceinline__ void attn_unit(long qrow0,long kvrow0,int NT,int h,const bf16*Q,const bf16*__restrict__ K,const bf16*__restrict__ V,bf16*O,char*shm,int tid_in){
  int tid_l=tid_in; asm volatile("":"+v"(tid_l)); const int tid=tid_l,lane=tid&63,r32=lane&31,hi=lane>>5; const int wid=__builtin_amdgcn_readfirstlane(tid>>6);
  const bf16*Qw=Q+(qrow0+wid*QBLK)*DM+h*D;
  const bf16*Kh=K+kvrow0*KVP+(h>>2)*D,*Vh=V+kvrow0*KVP+(h>>2)*D;
  const unsigned lds0=(unsigned)(uintptr_t)shm;
  float*wsf=(float*)(shm+LDS_WS)+wid*64;
  const bf16*ksrc=Kh+(long)lane*KVP+wid*8;
  const bf16*vsrc=Vh+(long)(16*(wid&3)+(lane>>2))*KVP+(wid>>2)*32+(lane&3)*8;
  const unsigned kdst=lds0+LDS_K+wid*1024, vdst=lds0+LDS_V+wid*1024;
  #define DMA_K(t,slot) glds16(ksrc+(long)(t)*KVBLK*KVP,(unsigned)__builtin_amdgcn_readfirstlane(kdst+(slot)))
  #define DMA_V(t,slot) glds16(vsrc+(long)(t)*KVBLK*KVP,(unsigned)__builtin_amdgcn_readfirstlane(vdst+(slot)))
  const int vb0=(int)(lds0+LDS_V)+((lane>>4)&1)*32+(lane&3)*8+(4*hi+((lane&15)>>2))*64;
  const char*Kbase=shm+LDS_K; bf16x8 kf[8];
  const lds_cptr shm3=(lds_cptr)shm; const lds_cptr kp0=shm3+LDS_K+hi*1024+r32*16; const lds_cptr vp0=shm3+LDS_V+((lane>>4)&1)*32+(lane&3)*8+(4*hi+((lane&15)>>2))*64;
  DMA_K(0,0);DMA_V(0,0);DMA_K(1,SLOTB);
  bf16x8 qr[4];
  #pragma unroll
  for(int d0=0;d0<4;++d0)qr[d0]=*reinterpret_cast<const bf16x8*>(&Qw[(long)r32*DM+d0*16+hi*8]);
  float mhat=0.f,l_reg=0.f;f32x16 o[2];o[0]=f32x16{};o[1]=f32x16{};f32x16 negm=f32x16{};asm volatile("":"+v"(negm));
  #define CMASK(P0,P1,t) do{}while(0)
  bool resc=false;
  #define START(P0,P1) do{ const float rm=rowmax(P0,P1); resc=false; \
    { const float dl=rm; mhat=fadd_s(mhat,dl); \
      _Pragma("unroll") for(int r=0;r<16;++r){P0[r]=fsub_s(P0[r],dl);P1[r]=fsub_s(P1[r],dl);} \
      _Pragma("unroll") for(int r=0;r<16;++r)negm[r]=-mhat; asm volatile("":"+v"(negm)); } \
    _Pragma("unroll") for(int r=0;r<16;++r)P0[r]=__builtin_amdgcn_exp2f(P0[r]); }while(0)
  #define RESC() do{ if(resc){ asm volatile("s_waitcnt lgkmcnt(0)":::"memory"); \
      _Pragma("unroll") for(int d_=0;d_<2;++d_) _Pragma("unroll") for(int r=0;r<16;++r)o[d_][r]*=wsf[crow(r,hi)]; } }while(0)
  f32x16 pA0,pA1,pB0,pB1;
  int sl_prev=0,sl_cur=0,sl_next=SLOTB;
  #define ROT() do{sl_prev=sl_cur;sl_cur=sl_next;sl_next=(sl_next==(NSLOT-1)*SLOTB)?0:sl_next+SLOTB;}while(0)
  DMA_K(2,2*SLOTB);
  WAIT_BAR(3);
  qkt(pA0,pA1,Kbase,qr,negm,r32,hi);asm volatile("s_nop 15\n\ts_nop 7":"+v"(pA0),"+v"(pA1));CMASK(pA0,pA1,0);
  START(pA0,pA1);
  _Pragma("unroll") for(int r=0;r<16;++r)pA1[r]=__builtin_amdgcn_exp2f(pA1[r]);
  WAIT_BAR(0);
  DMA_K(3,0);DMA_V(1,SLOTB);
  ROT();
  kload8(kf,kp0+sl_cur);
  WAIT_BAR(2);
  s16x4 vlo[8],vhi[8]; u32x4 pw0,pw1,pw2,pw3;
  #define PKW(P,B) cvtpk_s(P[B],P[B+1])
  #define PAF(k) __builtin_bit_cast(bf16x8,pw##k)
  #define VFR(i) (bf16x8){vlo[i][0],vlo[i][1],vlo[i][2],vlo[i][3],vhi[i][0],vhi[i][1],vhi[i][2],vhi[i][3]}
  #define PIN(x) asm volatile("":"+v"(x))
  #define MX3(a,b,c) __builtin_fmaxf(__builtin_fmaxf((a),(b)),(c))
  #define GAPA(MF,A0,A1,A2,A3,W0,W1,PW) do{ MF; sacc+=A0; sacc+=A1; sacc+=A2; sacc+=A3; PIN(sacc); W0; W1; PIN(PW); SBAR(); }while(0)
  #define EX(v) __builtin_amdgcn_exp2f(v)
  #define GAPB(MF,X,B) do{ MF; X[B]=EX(X[B]); X[B+1]=EX(X[B+1]); X[B+2]=EX(X[B+2]); X[B+3]=EX(X[B+3]); PIN(X); SBAR(); }while(0)
  #define VRD(i) do{ vlo[i]=vtr(vp_+(((i)>>2)*4096+((i)&3)*1024)); vhi[i]=vtr(vp_+(((i)>>2)*4096+((i)&3)*1024+512)); }while(0)
  #define KRD(G,j) do{ if(G){ kload2(kf,kp0+sl_next,j); SBAR(); } }while(0)
  #define STEP(C0,C1,P0,P1,t,GK,GV,GL) do{ SBAR(); \
    const lds_cptr vp_=vp0+sl_prev; \
    VRD(0); SBAR(); float sacc=(P0[0]+P0[1]); \
    GAPA(C0=__builtin_amdgcn_mfma_f32_32x32x16_bf16(kf[0],qr[0],negm,0,0,0), P0[2],P0[3],P0[4],P0[5],     pw0[0]=PKW(P0,0), pw0[1]=PKW(P0,2), pw0); \
    VRD(4); SBAR(); GAPA(C1=__builtin_amdgcn_mfma_f32_32x32x16_bf16(kf[1],qr[0],negm,0,0,0), P0[6],P0[7],P0[8],P0[9],     pw0[2]=PKW(P0,4), pw0[3]=PKW(P0,6), pw0); \
    VRD(1); SBAR(); GAPA(C0=__builtin_amdgcn_mfma_f32_32x32x16_bf16(kf[2],qr[1],C0,0,0,0),   P0[10],P0[11],P0[12],P0[13], pw1[0]=PKW(P0,8), pw1[1]=PKW(P0,10), pw1); \
    VRD(5); SBAR(); GAPA(C1=__builtin_amdgcn_mfma_f32_32x32x16_bf16(kf[3],qr[1],C1,0,0,0),   P0[14],P0[15],P1[0],P1[1],   pw1[2]=PKW(P0,12),pw1[3]=PKW(P0,14), pw1); \
    VRD(2); SBAR(); GAPA(C0=__builtin_amdgcn_mfma_f32_32x32x16_bf16(kf[4],qr[2],C0,0,0,0),   P1[2],P1[3],P1[4],P1[5],     pw2[0]=PKW(P1,0), pw2[1]=PKW(P1,2), pw2); \
    VRD(6); SBAR(); GAPA(C1=__builtin_amdgcn_mfma_f32_32x32x16_bf16(kf[5],qr[2],C1,0,0,0),   P1[6],P1[7],P1[8],P1[9],     pw2[2]=PKW(P1,4), pw2[3]=PKW(P1,6), pw2); \
    VRD(3); SBAR(); GAPA(C0=__builtin_amdgcn_mfma_f32_32x32x16_bf16(kf[6],qr[3],C0,0,0,0),   P1[10],P1[11],P1[12],P1[13], pw3[0]=PKW(P1,8), pw3[1]=PKW(P1,10), pw3); \
    VRD(7); SBAR(); GAPA(C1=__builtin_amdgcn_mfma_f32_32x32x16_bf16(kf[7],qr[3],C1,0,0,0),   P1[14],P1[15],0.f,0.f,       pw3[2]=PKW(P1,12),pw3[3]=PKW(P1,14), pw3); \
    l_reg+=sacc; \
    if(GK){DMA_K((t)+3,sl_cur);} if(GV){DMA_V((t)+1,sl_next);} \
    CMASK(C0,C1,t); \
    { float a=MX3(C0[0],C0[1],C1[0]),b=MX3(C0[2],C0[3],C1[1]); a=MX3(a,C1[2],C1[3]); \
      _Pragma("unroll") for(int r=4;r<16;r+=4){a=MX3(a,C0[r],C0[r+1]);b=MX3(b,C0[r+2],C0[r+3]);a=MX3(a,C1[r],C1[r+1]);b=MX3(b,C1[r+2],C1[r+3]);} \
      float rm=__builtin_fmaxf(a,b); { auto rr=__builtin_amdgcn_permlane32_swap(__float_as_uint(rm),__float_as_uint(rm),false,false); rm=__builtin_fmaxf(__uint_as_float(rr[0]),__uint_as_float(rr[1])); } \
      resc=false; \
      if(__builtin_expect(__any(rm>(float)THRL),0)){ const float dl=__builtin_fmaxf(rm,0.f); mhat+=dl; \
        _Pragma("unroll") for(int r=0;r<16;++r){C0[r]-=dl;C1[r]-=dl;} \
        _Pragma("unroll") for(int r=0;r<16;++r)negm[r]=-mhat; asm volatile("":"+v"(negm)); \
        const float f=__builtin_amdgcn_exp2f(-dl); l_reg*=f; if(hi==0)wsf[r32]=f; resc=true; } } \
    SBAR(); \
    GAPB(o[0]=__builtin_amdgcn_mfma_f32_32x32x16_bf16(PAF(0),VFR(0),o[0],0,0,0), C0,0); \
    GAPB(o[1]=__builtin_amdgcn_mfma_f32_32x32x16_bf16(PAF(0),VFR(4),o[1],0,0,0), C0,4); \
    KRD(GL,0); GAPB(o[0]=__builtin_amdgcn_mfma_f32_32x32x16_bf16(PAF(1),VFR(1),o[0],0,0,0), C0,8); \
    KRD(GL,1); GAPB(o[1]=__builtin_amdgcn_mfma_f32_32x32x16_bf16(PAF(1),VFR(5),o[1],0,0,0), C0,12); \
    KRD(GL,2); GAPB(o[0]=__builtin_amdgcn_mfma_f32_32x32x16_bf16(PAF(2),VFR(2),o[0],0,0,0), C1,0); \
    KRD(GL,3); GAPB(o[1]=__builtin_amdgcn_mfma_f32_32x32x16_bf16(PAF(2),VFR(6),o[1],0,0,0), C1,4); \
    GAPB(o[0]=__builtin_amdgcn_mfma_f32_32x32x16_bf16(PAF(3),VFR(3),o[0],0,0,0), C1,8); \
    GAPB(o[1]=__builtin_amdgcn_mfma_f32_32x32x16_bf16(PAF(3),VFR(7),o[1],0,0,0), C1,12); \
    }while(0)
  int t=1;
  #undef CMASK
  #define CMASK(P0,P1,t) do{}while(0)
  for(;t+5<NT;t+=2){
    STEP(pB0,pB1,pA0,pA1,t,true,true,true);     WAIT_BAR(2); RESC(); ROT();
    STEP(pA0,pA1,pB0,pB1,t+1,true,true,true);   WAIT_BAR(2); RESC(); ROT();
  }
  #undef CMASK
  #define CMASK(P0,P1,t) do{}while(0)
  #define ENDW(tt) do{ if((tt)+3<NT){WAIT_BAR(2);} else if((tt)+2<NT){WAIT_BAR(1);} else {WAIT_BAR(0);} }while(0)
  for(;t+1<NT;t+=2){
    STEP(pB0,pB1,pA0,pA1,t,(t+3<NT),(t+1<NT),(t+1<NT));       ENDW(t);   RESC(); ROT();
    STEP(pA0,pA1,pB0,pB1,t+1,(t+4<NT),(t+2<NT),(t+2<NT));     ENDW(t+1); RESC(); ROT();
  }
  STEP(pB0,pB1,pA0,pA1,NT-1,false,false,false); RESC();
  { float sacc=pB0[0]+pB0[1]; _Pragma("unroll") for(int r=2;r<16;++r)sacc+=pB0[r]; _Pragma("unroll") for(int r=0;r<16;++r)sacc+=pB1[r]; l_reg+=sacc;
    pw0=(u32x4){PKW(pB0,0),PKW(pB0,2),PKW(pB0,4),PKW(pB0,6)};pw1=(u32x4){PKW(pB0,8),PKW(pB0,10),PKW(pB0,12),PKW(pB0,14)};pw2=(u32x4){PKW(pB1,0),PKW(pB1,2),PKW(pB1,4),PKW(pB1,6)};pw3=(u32x4){PKW(pB1,8),PKW(pB1,10),PKW(pB1,12),PKW(pB1,14)};
    SBAR(); pv(o,vb0+sl_cur,PAF(0),PAF(1),PAF(2),PAF(3)); }
  #undef PKW
  #undef PAF
  #undef VFR
  #undef PIN
  #undef MX3
  #undef GAPA
  #undef GAPB
  #undef EX
  #undef VRD
  #undef KRD
  #undef STEP
  #undef ENDW
  {auto rr=__builtin_amdgcn_permlane32_swap(__float_as_uint(l_reg),__float_as_uint(l_reg),false,false);l_reg=__uint_as_float(rr[0])+__uint_as_float(rr[1]);}
  if(hi==0)wsf[32+r32]=l_reg;asm volatile("s_waitcnt lgkmcnt(0)":::"memory");
  float rli[16];
  #pragma unroll
  for(int r=0;r<16;++r)rli[r]=__builtin_amdgcn_rcpf(wsf[32+crow(r,hi)]);
  bf16*Ow=O+(qrow0+wid*QBLK)*DM+h*D;
  { bf16*stg=(bf16*)(shm+LDS_OST)+wid*2048;
    #pragma unroll
    for(int r=0;r<16;++r){const int orow=crow(r,hi);
      #pragma unroll
      for(int d0=0;d0<2;++d0)stg[orow*64+d0*32+r32]=__float2bfloat16(o[d0][r]*rli[r]);}
    asm volatile("s_waitcnt lgkmcnt(0)":::"memory");
    #pragma unroll
    for(int i=0;i<4;++i){const int row=i*8+(lane>>3),ch=lane&7; const u32x4 v=*(const u32x4*)(stg+row*64+ch*8); ATTN_STORE16(Ow+(long)row*DM+ch*8,v);} }
  asm volatile("s_waitcnt lgkmcnt(0)\n\ts_barrier":::"memory");
  #undef DMA_K
  #undef DMA_V
  #undef CMASK
  #undef START
  #undef RESC
  #undef ROT
}
constexpr int ATTN_LDS_BYTES=LDS_BYTES;
#undef SBAR
#undef WAIT_BAR
}

constexpr int NWAVES = 8;
constexpr int NB = 8, SEQ = 4096, CTXL = 256, TB = SEQ + CTXL  , MT = NB * TB  , DMODEL = 1024;
constexpr int NMODC = 6 * DMODEL, MODROWS = 9;
constexpr int QKVN = 1536, WINN = 3104, WINP = 3328;
constexpr int NEXP = 32, TOPK = 4, MPAD = MT * TOPK + NEXP * 256;
constexpr int NLAYER = 4;
constexpr float RMS_EPS = 1e-6f;
constexpr float ATT_C2 = 0.125f * 1.4426950408889634f;

constexpr size_t MiB = 1u << 20;
constexpr size_t WS_CTL = 0, CTL_ZERO_BYTES = 1 * MiB;
constexpr size_t WS_MOD = 1 * MiB, WS_ROPE = 2 * MiB, WS_MODP = 3 * MiB;
constexpr size_t WS_SLOT = 17 * MiB, WS_GATEW = 18 * MiB, WS_SLOTPOS = 19 * MiB;
constexpr size_t WS_WQKV = 20 * MiB, WS_WOA = 26 * MiB, WS_WIN = 30 * MiB, WS_WOG = 43 * MiB, WS_WGU = 48 * MiB, WS_WDN = 560 * MiB;
constexpr size_t WS_X = 816 * MiB, WS_XN = 952 * MiB, WS_Q = 1020 * MiB, WS_K = 1088 * MiB, WS_V = 1105 * MiB, WS_G = 1122 * MiB;
constexpr size_t WS_OF = 1343 * MiB, WS_OB = 1479 * MiB, WS_XG = 1615 * MiB, WS_ACT = 1903 * MiB, WS_Y = 2191 * MiB, WS_XN8 = WS_ACT + 150 * MiB  , WS_PAR = 2479 * MiB, WS_LIST = 2483 * MiB  , WS_END = 2488 * MiB;
static_assert(WS_MODP + (size_t)16 * NLAYER * MODROWS * NMODC * 4 <= WS_SLOT && WS_WIN + (size_t)2 * WINP * 1024 * 2 <= WS_WOG && WS_G + (size_t)MT * WINP * 2 <= WS_OF && WS_XG + (size_t)MPAD * 1024 * 2 <= WS_ACT, "ws map");
constexpr int CW_TMO = 0, CW_BAR = 4096, CW_CNT = 16384;

constexpr int RING_OFF = 0, RING_BYTES = 131072;
constexpr int WR_STRIDE = 1028;
constexpr int LDS_AUX = 133120;
constexpr int AUX_LCNT = LDS_AUX, AUX_GB = LDS_AUX + 128, AUX_T2E = LDS_AUX + 256  , AUX_BASE = AUX_T2E + 2560  , AUX_NT = AUX_BASE + 128, AUX_CNT = AUX_NT + 64  , AUX_ENT = AUX_CNT + 128  , AUX_RS = AUX_ENT + 4352  , AUX_ROWTAB = AUX_RS + 576, ROWTAB_UNITS = 18  ;
constexpr int MISC_OFF = 154624;
constexpr int LDS_BYTES = 155648;
static_assert(AUX_ROWTAB + ROWTAB_UNITS * 512 <= MISC_OFF, "LDS map");

#define GAS __attribute__((address_space(1)))
#define LAS __attribute__((address_space(3)))
typedef unsigned short bf16;
typedef unsigned v4u __attribute__((ext_vector_type(4)));
typedef float f32x4 __attribute__((ext_vector_type(4)));
typedef short bf16x8 __attribute__((ext_vector_type(8)));
typedef GAS unsigned gu32;
typedef GAS unsigned long long gu64;
#define RLX_AGENT __ATOMIC_RELAXED, __HIP_MEMORY_SCOPE_AGENT
#define LDS_WAIT() asm volatile("s_waitcnt lgkmcnt(0)" ::: "memory")
#define VM_WAIT() asm volatile("s_waitcnt vmcnt(0)" ::: "memory")
__device__ __forceinline__ unsigned long long rt() { return __builtin_amdgcn_s_memrealtime(); }
__device__ __forceinline__ unsigned f2bf(float f) { unsigned u = __builtin_bit_cast(unsigned, f); return (u + 0x7fffu + ((u >> 16) & 1u)) >> 16; }
__device__ __forceinline__ unsigned pk2(float lo, float hi) { return f2bf(lo) | (f2bf(hi) << 16); }

#define XB_TMO      128
#define XB_XCNT(j)  (256  + 64 * (j))
#define XB_XSUB(j)  (1280 + 64 * (j))
#define XB_XGEN(j)  (2304 + 64 * (j))
#define XB_TOP      3328
#define XB_TOPGEN   3392
#define XCD_BAR_WORDS 3456
#define XB_SPIN_CAP (1u << 18)

__device__ __forceinline__ unsigned xb_ld(unsigned* p)              { return __hip_atomic_load(p, __ATOMIC_RELAXED, __HIP_MEMORY_SCOPE_AGENT); }
__device__ __forceinline__ unsigned xb_add(unsigned* p, unsigned v) { return __hip_atomic_fetch_add(p, v, __ATOMIC_RELAXED, __HIP_MEMORY_SCOPE_AGENT); }
__device__ __forceinline__ unsigned xb_xcc_id() { return (unsigned)__builtin_amdgcn_s_getreg((3 << 11) | 20) & 0xFu; }
#define XB_SPIN(cond, bar) do { unsigned _sp = 0; while (cond) { __builtin_amdgcn_s_sleep(1); \
    if ((++_sp & 255u) == 0u) { if (xb_ld(&(bar)[XB_TMO])) break; if (_sp > XB_SPIN_CAP) { atomicAdd(&(bar)[XB_TMO], 1u); break; } } } } while (0)

struct XcdBarrier {
    unsigned* bar; unsigned x;
    volatile LAS unsigned* st;
};

__device__ __forceinline__ XcdBarrier xcd_barrier_post(unsigned* bar, volatile LAS unsigned* st, bool xb_t0  ) {
    XcdBarrier b; b.bar = bar; b.x = xb_xcc_id(); b.st = st;
    if (xb_t0) (void)xb_add(&bar[XB_XCNT(b.x)], 1u);
    return b;
}
__device__ __forceinline__ void xcd_barrier_complete(unsigned* bar, unsigned x, unsigned& nloc, unsigned& nx) {
    const unsigned G = gridDim.x * gridDim.y * gridDim.z;
    unsigned sum, cnt, mine, sp = 0u;
    for (;;) {
        sum = 0u; cnt = 0u; mine = 0u;
#pragma unroll
        for (unsigned j = 0; j < 16; ++j) { const unsigned c = xb_ld(&bar[XB_XCNT(j)]); sum += c; cnt += (c > 0u) ? 1u : 0u; mine = (j == x) ? c : mine; }
        if (sum == G) break;
        __builtin_amdgcn_s_sleep(1);
        if ((++sp & 255u) == 0u) { if (xb_ld(&bar[XB_TMO])) break; if (sp > XB_SPIN_CAP) { atomicAdd(&bar[XB_TMO], 1u); break; } }
    }
    nloc = mine > 0u ? mine : 1u; nx = cnt > 0u ? cnt : 1u;
}

__device__ __forceinline__ void xcd_barrier(const XcdBarrier& b, bool xb_t0  ) {
    asm volatile("s_waitcnt vmcnt(0)" ::: "memory");
    __syncthreads();
    if (xb_t0) {
        unsigned* bar = b.bar;
        __builtin_amdgcn_s_waitcnt(0);
        unsigned nloc = b.st[0], nx = b.st[1];
        if (nloc == 0u) { xcd_barrier_complete(bar, b.x, nloc, nx); b.st[0] = nloc; b.st[1] = nx; }
        const unsigned old = xb_add(&bar[XB_XSUB(b.x)], 1u);
        const unsigned gen = old / nloc;
        if (old + 1u == (gen + 1u) * nloc) {
            __builtin_amdgcn_fence(__ATOMIC_RELEASE, "agent");
            asm volatile("s_waitcnt vmcnt(0)" ::: "memory");
            const unsigned og = xb_add(&bar[XB_TOP], 1u);
            const unsigned tg = og / nx;
            if (og + 1u == (tg + 1u) * nx) xb_add(&bar[XB_TOPGEN], 1u);
            else XB_SPIN(xb_ld(&bar[XB_TOPGEN]) == tg, bar);
            __builtin_amdgcn_fence(__ATOMIC_ACQUIRE, "agent");
            xb_add(&bar[XB_XGEN(b.x)], 1u);
            asm volatile("s_waitcnt vmcnt(0)" ::: "memory");
        } else {
            XB_SPIN(xb_ld(&bar[XB_XGEN(b.x)]) == gen, bar);
            __builtin_amdgcn_fence(__ATOMIC_ACQUIRE, "agent");
            asm volatile("s_waitcnt vmcnt(0)" ::: "memory");
        }
    }
    __syncthreads();
}

typedef float f32x2 __attribute__((ext_vector_type(2)));
using pg8::lane_now; using pg8::shx;
__device__ __forceinline__ float wave_sum(float v) {
    const int ln = lane_now();
#pragma unroll
    for (int o = 1; o < 64; o <<= 1) v += shx(v, o, ln);
    return v;
}
__device__ __forceinline__ float wave_max(float v) {
    const int ln = lane_now();
#pragma unroll
    for (int o = 1; o < 64; o <<= 1) v = fmaxf(v, shx(v, o, ln));
    return v;
}
__device__ __forceinline__ float bf2f(unsigned short h) { return __uint_as_float((unsigned)h << 16); }
__device__ __forceinline__ float silu_f(float x) { return x / (1.0f + __expf(-x)); }
__device__ __forceinline__ f32x4 bf4_to_f32(unsigned long long v) { return (f32x4){__uint_as_float((unsigned)(v & 0xffffu) << 16), __uint_as_float((unsigned)(v >> 16) << 16), __uint_as_float((unsigned)((v >> 32) & 0xffffu) << 16), __uint_as_float((unsigned)(v >> 48) << 16)}; }
__device__ __forceinline__ unsigned long long f32_to_bf4(f32x4 y) { return (unsigned long long)pk2(y.x, y.y) | ((unsigned long long)pk2(y.z, y.w) << 32); }
__device__ __forceinline__ int mod_row(int m) { const int b = m / TB; return (m - b * TB < CTXL) ? 8 : b; }

__device__ __forceinline__ void titem_load(const float* W, int N, int k0, int n0, int lane, f32x4 (&v)[16]) {
    const GAS f32x4* p = (const GAS f32x4*)(W + (size_t)(k0 + 16 * (lane >> 3)) * N + n0 + 4 * (lane & 7));
#pragma unroll
    for (int j = 0; j < 16; ++j) v[j] = p[(size_t)j * (N >> 2)];
}
__device__ __forceinline__ void titem_store8(const f32x4 (&v)[16], unsigned char* WT8, int K, int k0, int dst_row0, int lane) {
    unsigned char* o = WT8 + (size_t)(dst_row0 + 4 * (lane & 7)) * K + k0 + 16 * (lane >> 3);
#pragma unroll
    for (int i = 0; i < 4; ++i) { v4u q;
        q.x = pg8::pk4_fp8(v[0][i] * 32.f, v[1][i] * 32.f, v[2][i] * 32.f, v[3][i] * 32.f); q.y = pg8::pk4_fp8(v[4][i] * 32.f, v[5][i] * 32.f, v[6][i] * 32.f, v[7][i] * 32.f);
        q.z = pg8::pk4_fp8(v[8][i] * 32.f, v[9][i] * 32.f, v[10][i] * 32.f, v[11][i] * 32.f); q.w = pg8::pk4_fp8(v[12][i] * 32.f, v[13][i] * 32.f, v[14][i] * 32.f, v[15][i] * 32.f);
        *(GAS v4u*)(o + (size_t)i * K) = q; }
}
__device__ __forceinline__ void titem_store16(const f32x4 (&v)[16], bf16* WT, int K, int k0, int dst_row0, int lane) {
    bf16* o = WT + (size_t)(dst_row0 + 4 * (lane & 7)) * K + k0 + 16 * (lane >> 3);
#pragma unroll
    for (int i = 0; i < 4; ++i) { v4u q0, q1;
        q0.x = pk2(v[0][i], v[1][i]); q0.y = pk2(v[2][i], v[3][i]); q0.z = pk2(v[4][i], v[5][i]); q0.w = pk2(v[6][i], v[7][i]);
        q1.x = pk2(v[8][i], v[9][i]); q1.y = pk2(v[10][i], v[11][i]); q1.z = pk2(v[12][i], v[13][i]); q1.w = pk2(v[14][i], v[15][i]);
        *(GAS v4u*)(o + (size_t)i * K) = q0; *(GAS v4u*)(o + (size_t)i * K + 8) = q1; }
}

struct Args { const float* in[25]; float* out; unsigned char* ws; int ph_lo, ph_hi; };
constexpr int P_N1G = 0, P_N2G = 4096, P_QG = 8192, P_KG = 8320, P_GKF = 8448, P_GKB = 24832, P_BGF = 41216, P_BGB = 42240, P_OG = 43264, P_WR = 43776, P_BR = 174848, P_BGU = 174976, P_BDN = 437120, P_END = 568192;
#define LAUNDER_S(p) asm volatile("" : "+s"(p))
#define LAUNDER_V(p) asm volatile("" : "+v"(p))
#define PARF(ws) ((const float*)((ws) + WS_PAR))

constexpr int I8_GU = 128 * 8 * 64, I8_DN = 128 * 8 * 32, NI8 = I8_GU + I8_DN;
struct T8 { const float* W; unsigned char* O; int N, k0, n0, dst; };
__device__ __forceinline__ T8 dec8(const Args& A, unsigned char* ws, int it) { T8 t;
    const bool gu = it < I8_GU; const int r = gu ? it : it - I8_GU, sh = gu ? 6 : 5, mat = r >> (3 + sh), q = r & ((8 << sh) - 1), kb = q >> sh, n0 = (q & ((1 << sh) - 1)) * 32;
    t.N = gu ? 2048 : 1024; t.W = (gu ? A.in[21] : A.in[23]) + (size_t)mat * 1024 * t.N; t.O = ws + (gu ? WS_WGU : WS_WDN) + (size_t)mat * 1024 * t.N; t.k0 = kb * 128; t.n0 = n0;
    t.dst = gu ? ((n0 & 1023) >> 7) * 256 + (n0 >> 10) * 128 + (n0 & 127) : n0;
    return t; }
__device__ __forceinline__ void p0_prologue(const Args& A, LAS unsigned char* lds, int gw, int NGW, int wave, int lane) {
    unsigned char* ws = A.ws;
    { f32x4 va[16], vb[16]; int it = gw;
      if (it < NI8) { const T8 t = dec8(A, ws, it); titem_load(t.W, t.N, t.k0, t.n0, lane, va); }
      while (it + 2 * NGW < NI8) {
          { const T8 t = dec8(A, ws, it + NGW); titem_load(t.W, t.N, t.k0, t.n0, lane, vb); }
          { const T8 t = dec8(A, ws, it); titem_store8(va, t.O, 1024, t.k0, t.dst, lane); }
          { const T8 t = dec8(A, ws, it + 2 * NGW); titem_load(t.W, t.N, t.k0, t.n0, lane, va); }
          { const T8 t = dec8(A, ws, it + NGW); titem_store8(vb, t.O, 1024, t.k0, t.dst, lane); }
          it += 2 * NGW; }
      if (it < NI8) { const bool hb = it + NGW < NI8;
          if (hb) { const T8 t = dec8(A, ws, it + NGW); titem_load(t.W, t.N, t.k0, t.n0, lane, vb); }
          { const T8 t = dec8(A, ws, it); titem_store8(va, t.O, 1024, t.k0, t.dst, lane); }
          if (hb) { const T8 t = dec8(A, ws, it + NGW); titem_store8(vb, t.O, 1024, t.k0, t.dst, lane); } } }
    constexpr int J_QKV = 2 * 8 * (QKVN / 32), J_WO = 2 * 8 * 32, J_WIN = 2 * 8 * (WINN / 32), NJ = J_QKV + J_WO + J_WIN + J_WO;
    for (int it = gw; it < NJ; it += NGW) { int r = it; const float* W; bf16* O; int N, kb, n0, dst;
        if (r < J_QKV) { const int per = 8 * (QKVN / 32), mat = r / per, q = r - mat * per; kb = q / (QKVN / 32); n0 = (q - kb * (QKVN / 32)) * 32;
            dst = (n0 & ~255) + ((n0 >> 5) & 1) * 128 + ((n0 >> 6) & 3) * 32;
            W = A.in[8] + (size_t)mat * 1024 * QKVN; N = QKVN; O = (bf16*)(ws + WS_WQKV) + (size_t)mat * QKVN * 1024; }
        else if ((r -= J_QKV) < J_WO) { const int mat = r >> 8, q = r & 255; kb = q >> 5; n0 = (q & 31) * 32; dst = n0;
            W = A.in[11] + (size_t)mat * 1024 * 1024; N = 1024; O = (bf16*)(ws + WS_WOA) + (size_t)mat * 1024 * 1024; }
        else if ((r -= J_WO) < J_WIN) { const int per = 8 * (WINN / 32), mat = r / per, q = r - mat * per; kb = q / (WINN / 32); n0 = (q - kb * (WINN / 32)) * 32; dst = n0;
            W = A.in[12] + (size_t)mat * 1024 * WINN; N = WINN; O = (bf16*)(ws + WS_WIN) + (size_t)mat * WINP * 1024; }
        else { r -= J_WIN; const int mat = r >> 8, q = r & 255; kb = q >> 5; n0 = (q & 31) * 32; dst = n0;
            W = A.in[18] + (size_t)mat * 1024 * 1024; N = 1024; O = (bf16*)(ws + WS_WOG) + (size_t)mat * 1024 * 1024; }
        f32x4 v[16]; titem_load(W, N, kb * 128, n0, lane, v); titem_store16(v, O, 1024, kb * 128, dst, lane); }
    for (int it = gw; it < 2 * (WINP - WINN); it += NGW) { const int mat = it / (WINP - WINN), rr = WINN + it - mat * (WINP - WINN);
        GAS v4u* p = (GAS v4u*)((bf16*)(ws + WS_WIN) + ((size_t)mat * WINP + rr) * 1024) + lane; p[0] = (v4u){0u, 0u, 0u, 0u}; p[64] = (v4u){0u, 0u, 0u, 0u}; }
    for (int it = NGW - 1 - gw; it < NLAYER * 24 * 16; it += NGW) {
        const int l = it / (24 * 16), q = it - l * (24 * 16), cg = q / 16, kc = q - cg * 16;
        float s[MODROWS];
#pragma unroll
        for (int r = 0; r < MODROWS; ++r) { const float cv = (r < 8) ? A.in[1][r * 1024 + kc * 64 + lane] : A.in[3][kc * 64 + lane]; s[r] = silu_f(cv); }
        f32x4 acc[MODROWS];
#pragma unroll
        for (int r = 0; r < MODROWS; ++r) acc[r] = (f32x4){0.f, 0.f, 0.f, 0.f};
        const float* wp = A.in[4] + ((size_t)l * 1024 + kc * 64) * NMODC + cg * 256 + 4 * lane;
#pragma unroll 8
        for (int kk = 0; kk < 64; ++kk) { const f32x4 w = *(const f32x4*)(wp + (size_t)kk * NMODC);
#pragma unroll
            for (int r = 0; r < MODROWS; ++r) { const float sv = __shfl(s[r], kk); acc[r] = acc[r] + w * sv; } }
        float* op = (float*)(ws + WS_MODP) + (size_t)kc * (NLAYER * MODROWS * NMODC) + (size_t)l * MODROWS * NMODC + cg * 256 + 4 * lane;
#pragma unroll
        for (int r = 0; r < MODROWS; ++r) *(f32x4*)(op + (size_t)r * NMODC) = acc[r];
    }
    for (int m0 = gw; m0 < MT; m0 += 4 * NGW) { f32x4 x[4][4];
#pragma unroll
        for (int r = 0; r < 4; ++r) { const int m = m0 + r * NGW; if (m < MT) { const int b = m / TB, w = m - b * TB;
            const float* src = (w < CTXL) ? A.in[2] + ((size_t)b * CTXL + w) * 1024 : A.in[0] + ((size_t)b * SEQ + (w - CTXL)) * 1024; const GAS f32x4* sp = (const GAS f32x4*)src + lane;
#pragma unroll
            for (int j = 0; j < 4; ++j) x[r][j] = sp[64 * j]; } }
#pragma unroll
        for (int r = 0; r < 4; ++r) { const int m = m0 + r * NGW; if (m < MT) { GAS unsigned long long* dp = (GAS unsigned long long*)((bf16*)(ws + WS_X) + (size_t)m * 1024) + lane;
#pragma unroll
            for (int j = 0; j < 4; ++j) dp[64 * j] = f32_to_bf4(x[r][j]); } } }
    { float* par = (float*)(ws + WS_PAR); const int gt = gw * 64 + lane, NGT = NGW * 64;
#define CPL(k, src, n) float c##k##a = 0.f, c##k##b = 0.f; if (gt < (n)) c##k##a = A.in[src][gt]; if (gt + NGT < (n)) c##k##b = A.in[src][gt + NGT];
#define CPS(k, src, n, off) if (gt < (n)) par[(off) + gt] = c##k##a; if (gt + NGT < (n)) par[(off) + gt + NGT] = c##k##b; for (int i = gt + 2 * NGT; i < (n); i += NGT) par[(off) + i] = A.in[src][i];
      CPL(0, 6, 4096) CPL(1, 7, 4096) CPL(2, 9, 128) CPL(3, 10, 128) CPL(4, 13, 16384) CPL(5, 15, 16384) CPL(6, 14, 1024) CPL(7, 16, 1024) CPL(8, 17, 512) CPL(9, 19, 131072) CPL(10, 20, 128) CPL(11, 22, 262144) CPL(12, 24, 131072)
      CPS(0, 6, 4096, P_N1G) CPS(1, 7, 4096, P_N2G) CPS(2, 9, 128, P_QG) CPS(3, 10, 128, P_KG) CPS(4, 13, 16384, P_GKF) CPS(5, 15, 16384, P_GKB) CPS(6, 14, 1024, P_BGF) CPS(7, 16, 1024, P_BGB)
      CPS(8, 17, 512, P_OG) CPS(9, 19, 131072, P_WR) CPS(10, 20, 128, P_BR) CPS(11, 22, 262144, P_BGU) CPS(12, 24, 131072, P_BDN)
#undef CPL
#undef CPS
    }
    for (int idx = gw * 64 + lane; idx < SEQ * 32; idx += NGW * 64) { const int s = idx >> 5, i = idx & 31;
        const float invf = 1.0f / powf(10000.0f, (float)(i & 15) * (1.0f / 16.0f));
        const float ang = (float)((i < 16) ? (s >> 6) : (s & 63)) * invf;
        ((float*)(ws + WS_ROPE))[idx] = cosf(ang); ((float*)(ws + WS_ROPE))[SEQ * 32 + idx] = sinf(ang); }
}
__device__ __forceinline__ void p1_mod_reduce(const Args& A, int gtid, int NGT) {
    const float* P = (const float*)(A.ws + WS_MODP); float* Mo = (float*)(A.ws + WS_MOD);
    constexpr int N = NLAYER * MODROWS * NMODC;
    for (int i = gtid; i < N; i += NGT) { const int l = i / (MODROWS * NMODC), c = i % NMODC; float s = A.in[5][l * NMODC + c];
#pragma unroll
        for (int k = 0; k < 16; ++k) s += P[(size_t)k * N + i];
        Mo[i] = s; }
}
__device__ __forceinline__ void modulate_row(const bf16* xrow, const float* ng, const float* shp, const float* scp, bf16* orow, int lane, f32x4 (&y)[4], float& rs_out) {
    const GAS unsigned long long* xr = (const GAS unsigned long long*)xrow + lane;
    float ss = 0.f;
#pragma unroll
    for (int j = 0; j < 4; ++j) { y[j] = bf4_to_f32(xr[64 * j]); ss += (y[j].x * y[j].x + y[j].y * y[j].y) + (y[j].z * y[j].z + y[j].w * y[j].w); }
    const float rs = 1.0f / sqrtf(wave_sum(ss) * (1.0f / 1024.0f) + RMS_EPS); rs_out = rs;
    GAS unsigned long long* o8 = (GAS unsigned long long*)orow + lane;
#pragma unroll
    for (int j = 0; j < 4; ++j) { const f32x4 g = ((const GAS f32x4*)ng)[64 * j + lane], sh = ((const GAS f32x4*)shp)[64 * j + lane], sc = ((const GAS f32x4*)scp)[64 * j + lane];
        y[j] = (y[j] * rs) * g * (sc + 1.0f) + sh;
        o8[64 * j] = (unsigned long long)pk2(y[j].x, y[j].y) | ((unsigned long long)pk2(y[j].z, y[j].w) << 32); }
}
__device__ __forceinline__ void modulate_row2(const bf16* xa, const bf16* xb, const float* ng, const float* sha, const float* sca, const float* shb, const float* scb, unsigned char* oa, unsigned char* ob, int lane, float& rsa, float& rsb) {
    const GAS unsigned long long* pa = (const GAS unsigned long long*)xa + lane; const GAS unsigned long long* pb = (const GAS unsigned long long*)xb + lane;
    unsigned long long ra[4], rb[4];
#pragma unroll
    for (int j = 0; j < 4; ++j) { ra[j] = pa[64 * j]; rb[j] = pb[64 * j]; }
    f32x4 ya[4], yb[4]; float sa = 0.f, sb = 0.f;
#pragma unroll
    for (int j = 0; j < 4; ++j) { ya[j] = bf4_to_f32(ra[j]); yb[j] = bf4_to_f32(rb[j]); sa += (ya[j].x * ya[j].x + ya[j].y * ya[j].y) + (ya[j].z * ya[j].z + ya[j].w * ya[j].w); sb += (yb[j].x * yb[j].x + yb[j].y * yb[j].y) + (yb[j].z * yb[j].z + yb[j].w * yb[j].w); }
    const int ln = lane_now();
#pragma unroll
    for (int o = 1; o < 64; o <<= 1) { sa += shx(sa, o, ln); sb += shx(sb, o, ln); }
    rsa = 1.0f / sqrtf(sa * (1.0f / 1024.0f) + RMS_EPS); rsb = 1.0f / sqrtf(sb * (1.0f / 1024.0f) + RMS_EPS);
    GAS unsigned* qa = (GAS unsigned*)oa + lane; GAS unsigned* qb = (GAS unsigned*)ob + lane;
#pragma unroll
    for (int j = 0; j < 4; ++j) { const f32x4 g = ((const GAS f32x4*)ng)[64 * j + lane];
        const f32x4 ha = ((const GAS f32x4*)sha)[64 * j + lane], ca = ((const GAS f32x4*)sca)[64 * j + lane], hb = ((const GAS f32x4*)shb)[64 * j + lane], cb = ((const GAS f32x4*)scb)[64 * j + lane];
        const f32x4 va = (ya[j] * rsa) * g * (ca + 1.0f) + ha, vb = (yb[j] * rsb) * g * (cb + 1.0f) + hb;
        qa[64 * j] = pg8::pk4_fp8(va.x, va.y, va.z, va.w); qb[64 * j] = pg8::pk4_fp8(vb.x, vb.y, vb.z, vb.w); }
}
__device__ __forceinline__ void phase_modulate1(unsigned char* ws, int layer, int gw, int NGW, int lane) {
    const bf16* X = (const bf16*)(ws + WS_X); bf16* XN = (bf16*)(ws + WS_XN);
    const float* ng = PARF(ws) + P_N1G + layer * 1024; const float* Mo = (const float*)(ws + WS_MOD) + (size_t)layer * MODROWS * NMODC;
    for (int m = gw; m < MT; m += NGW) { const int mr = mod_row(m); f32x4 y[4]; float rs;
        modulate_row(X + (size_t)m * 1024, ng, Mo + (size_t)mr * NMODC + 0 * 1024, Mo + (size_t)mr * NMODC + 1 * 1024, XN + (size_t)m * 1024, lane, y, rs); }
}
__device__ __forceinline__ void phase_qknorm_rope(unsigned char* ws, int la, int gw, int NGW, int lane) {
    bf16* Qb = (bf16*)(ws + WS_Q); bf16* Kb = (bf16*)(ws + WS_K);
    const float* qg = PARF(ws) + P_QG + la * 64; const float* kg = PARF(ws) + P_KG + la * 64; const float* ropec = (const float*)(ws + WS_ROPE); const float* ropes = ropec + SEQ * 32;
    const int i = lane & 31, hs = lane >> 5;
    for (int m = gw; m < MT; m += NGW) { const int b = m / TB, w = m - b * TB; const bool lat = w >= CTXL;
        float cs = 1.f, sn = 0.f; if (lat) { cs = ropec[(w - CTXL) * 32 + i]; sn = ropes[(w - CTXL) * 32 + i]; }
#pragma unroll 2
        for (int hh = 0; hh < 20; hh += 2) { const int hd = hh + hs;
            unsigned* p = (hd < 16) ? (unsigned*)(Qb + (size_t)m * 1024 + hd * 64) + i : (unsigned*)(Kb + (size_t)m * 256 + (hd - 16) * 64) + i;
            const float* gp = (hd < 16) ? qg : kg; const float scl = (hd < 16) ? ATT_C2 : 1.0f;
            const unsigned v = *p; const float x1 = __uint_as_float(v << 16), x2 = __uint_as_float(v & 0xffff0000u);
            float ss = x1 * x1 + x2 * x2;
#pragma unroll
            for (int o = 1; o < 32; o <<= 1) ss += shx(ss, o, lane);
            const float rs = 1.0f / sqrtf(ss * (1.0f / 64.0f) + RMS_EPS);
            const float y1 = x1 * rs * gp[2 * i], y2 = x2 * rs * gp[2 * i + 1];
            const float r1 = (y1 * cs - y2 * sn) * scl, r2 = (y1 * sn + y2 * cs) * scl;
            *p = pk2(r1, r2); }
    }
}
__device__ __forceinline__ void phase_gla_recurrent(unsigned char* ws, int lg, LAS unsigned char* lds, int tid) {
    const int unit = blockIdx.x; if (unit >= 128) return;
    const int half = unit & 1, dir = (unit >> 1) & 1, h = (unit >> 2) & 3, b = unit >> 4;
    const bf16* G = (const bf16*)(ws + WS_G);
    float* Oo = (float*)(ws + (dir ? WS_OB : WS_OF));
    const float* wg = PARF(ws) + (dir ? P_GKB : P_GKF) + (size_t)lg * 16 * 512; const float* bg = PARF(ws) + (dir ? P_BGB : P_BGF) + lg * 512;
    LAS float* qq = (LAS float*)(lds + RING_OFF); LAS float* kk = qq + 64 * 128; LAS float* dd = kk + 64 * 128; LAS float* vv = dd + 64 * 128;
    const int sd = tid & 127, st0 = tid >> 7;
    float wcol[16];
#pragma unroll
    for (int r = 0; r < 16; ++r) wcol[r] = wg[r * 512 + h * 128 + sd];
    const float bcol = bg[h * 128 + sd];
    const int c = tid >> 2, dq = tid & 3;
    float s[32];
#pragma unroll
    for (int j = 0; j < 32; ++j) s[j] = 0.f;
    const float qscale = 0.08838834764831845f;
    for (int ch = 0; ch < TB / 64; ++ch) {
        __syncthreads();
#pragma unroll 4
        for (int i = 0; i < 16; ++i) { const int tt = st0 + 4 * i, n = 64 * ch + tt;
            const int w = dir ? (n < CTXL ? (CTXL - 1 - n) : (TB + CTXL - 1 - n)) : n;
            const bf16* gr = G + ((size_t)b * TB + w) * WINP;
            const float qv = bf2f(gr[h * 128 + sd]) * qscale, kv = bf2f(gr[512 + h * 128 + sd]);
            const bf16* lp = gr + 3072 + dir * 16; float z = bcol;
#pragma unroll
            for (int r = 0; r < 16; ++r) z += bf2f(lp[r]) * wcol[r];
            const float ls = fminf(z, 0.f) - log1pf(__expf(-fabsf(z)));
            qq[tt * 128 + sd] = qv; kk[tt * 128 + sd] = kv; dd[tt * 128 + sd] = __expf(ls * (1.0f / 16.0f));
            vv[tt * 128 + sd] = bf2f(gr[1024 + h * 256 + half * 128 + sd]); }
        __syncthreads();
        for (int tt = 0; tt < 64; ++tt) { const int n = 64 * ch + tt; const int w = dir ? (n < CTXL ? (CTXL - 1 - n) : (TB + CTXL - 1 - n)) : n;
            const float v = vv[tt * 128 + c]; float acc = 0.f;
            const LAS f32x4* q4 = (const LAS f32x4*)(qq + tt * 128 + dq * 32); const LAS f32x4* k4 = (const LAS f32x4*)(kk + tt * 128 + dq * 32); const LAS f32x4* d4 = (const LAS f32x4*)(dd + tt * 128 + dq * 32);
#pragma unroll
            for (int j = 0; j < 8; ++j) { const f32x4 qv = q4[j], kv = k4[j], dv = d4[j];
                s[4 * j + 0] = s[4 * j + 0] * dv.x + kv.x * v; acc += qv.x * s[4 * j + 0];
                s[4 * j + 1] = s[4 * j + 1] * dv.y + kv.y * v; acc += qv.y * s[4 * j + 1];
                s[4 * j + 2] = s[4 * j + 2] * dv.z + kv.z * v; acc += qv.z * s[4 * j + 2];
                s[4 * j + 3] = s[4 * j + 3] * dv.w + kv.w * v; acc += qv.w * s[4 * j + 3]; }
            acc += shx(acc, 1, tid & 63); acc += shx(acc, 2, tid & 63);
            if (dq == 0) Oo[((size_t)b * TB + w) * 1024 + h * 256 + half * 128 + c] = acc; }
    }
}
__device__ __forceinline__ void phase_gla_readout(unsigned char* ws, int lg, int gw, int NGW, int lane) {
    const float* OF = (const float*)(ws + WS_OF); const float* OB = (const float*)(ws + WS_OB); const bf16* G = (const bf16*)(ws + WS_G); bf16* OG = (bf16*)(ws + WS_Q);
    const f32x4 og = ((const GAS f32x4*)(PARF(ws) + P_OG + lg * 256))[lane];
    for (int m = gw; m < MT; m += NGW) {
#pragma unroll
        for (int hh = 0; hh < 4; ++hh) { const size_t off = (size_t)m * 1024 + hh * 256 + 4 * lane;
            f32x4 o = *(const GAS f32x4*)(OF + off) + *(const GAS f32x4*)(OB + off);
            const float ss = wave_sum((o.x * o.x + o.y * o.y) + (o.z * o.z + o.w * o.w));
            const float rs = 1.0f / sqrtf(ss * (1.0f / 256.0f) + RMS_EPS);
            const unsigned long long rv = *(const GAS unsigned long long*)(G + (size_t)m * WINP + 2048 + hh * 256 + 4 * lane);
            const float r0 = __uint_as_float((unsigned)(rv & 0xffffu) << 16), r1 = __uint_as_float((unsigned)(rv >> 16) << 16), r2 = __uint_as_float((unsigned)((rv >> 32) & 0xffffu) << 16), r3 = __uint_as_float((unsigned)(rv >> 48) << 16);
            o = o * rs * og;
            o.x *= silu_f(r0); o.y *= silu_f(r1); o.z *= silu_f(r2); o.w *= silu_f(r3);
            *(GAS unsigned long long*)(OG + off) = (unsigned long long)pk2(o.x, o.y) | ((unsigned long long)pk2(o.z, o.w) << 32); }
    }
}
constexpr size_t WS_GQ = WS_XG, WS_GKH = WS_XG + 68 * MiB, WS_GKT = WS_XG + 136 * MiB, WS_GVT = WS_XG + 204 * MiB, WS_GDL = WS_ACT, WS_SX = WS_OF;
static_assert((size_t)2176 * 2 * 16384 <= 68 * MiB && (size_t)2176 * 256 * 64 * 2 <= 68 * MiB && (size_t)64 * 68 * 65536 <= 272 * MiB, "gla buffers");
typedef float f32x16 __attribute__((ext_vector_type(16)));
__device__ __forceinline__ float log_sigmoid_fast(float z) { return fminf(z, 0.f) - __logf(1.0f + __expf(-fabsf(z))); }

struct G0Raw { unsigned qk[8][2]; v4u lfb; };
__device__ __forceinline__ void g0_load(G0Raw& R, unsigned char* ws, int cn, int tid) {
    const bf16* G = (const bf16*)(ws + WS_G);
    const int d2 = tid & 63, tb = tid >> 6, n = cn % 68, bh = cn / 68, h = bh & 3, b = bh >> 2;
    const size_t r0 = (size_t)b * TB + 64 * n;
#pragma unroll
    for (int j = 0; j < 8; ++j) { const bf16* gr = G + (r0 + 8 * tb + j) * WINP; R.qk[j][0] = *(const GAS unsigned*)(gr + h * 128 + 2 * d2); R.qk[j][1] = *(const GAS unsigned*)(gr + 512 + h * 128 + 2 * d2); }
    R.lfb = *(const GAS v4u*)(G + (r0 + ((tid & 255) >> 2)) * WINP + 3072 + 8 * (tid & 3));
}
__device__ __forceinline__ void g0_vload(unsigned (&raw)[32], const unsigned char* ws, int idx, int h, int dv, int th) {
    const int b = idx / 68, n = idx - b * 68; const bf16* vp = (const bf16*)(ws + WS_G) + ((size_t)b * TB + 64 * n + 32 * th) * WINP + 1024 + h * 256 + dv;
#pragma unroll
    for (int j = 0; j < 32; ++j) raw[j] = (unsigned)((const GAS bf16*)vp)[(size_t)j * WINP];
}
__device__ __forceinline__ void g0_vstore(const unsigned (&raw)[32], unsigned char* ws, int idx, int h, int dv, int th) {
    const int b = idx / 68, n = idx - b * 68, cn = (b * 4 + h) * 68 + n;
    unsigned char* vo = ws + WS_GVT + (size_t)cn * 32768 + (size_t)(((2 * th) * 8 + (dv >> 5)) * 64 + (dv & 31)) * 16;
    unsigned wv[16];
#pragma unroll
    for (int j = 0; j < 16; ++j) wv[j] = raw[2 * j] | (raw[2 * j + 1] << 16);
#pragma unroll
    for (int ql = 0; ql < 2; ++ql)
#pragma unroll
        for (int hq = 0; hq < 2; ++hq) *(GAS v4u*)(vo + ql * 8192 + hq * 512) = (v4u){wv[8 * ql + 2 * hq], wv[8 * ql + 2 * hq + 1], wv[8 * ql + 2 * hq + 4], wv[8 * ql + 2 * hq + 5]};
}
__device__ __forceinline__ void phase_gla_g0v(unsigned char* ws, int tid, int Gp, int bxp) {
    const int G4 = Gp >> 2, h = bxp & 3, wq = bxp >> 2;
    if (wq >= G4) return;
    const int dv = tid & 255, th = tid >> 8; unsigned ra[32], rb[32]; int idx = wq;
    if (idx < 544) g0_vload(ra, ws, idx, h, dv, th);
    while (idx + 2 * G4 < 544) { g0_vload(rb, ws, idx + G4, h, dv, th); g0_vstore(ra, ws, idx, h, dv, th); g0_vload(ra, ws, idx + 2 * G4, h, dv, th); g0_vstore(rb, ws, idx + G4, h, dv, th); idx += 2 * G4; }
    if (idx < 544) { const bool hb = idx + G4 < 544; if (hb) g0_vload(rb, ws, idx + G4, h, dv, th); g0_vstore(ra, ws, idx, h, dv, th); if (hb) g0_vstore(rb, ws, idx + G4, h, dv, th); }
}
__device__ __forceinline__ void phase_gla_g0(unsigned char* ws, int lg, LAS unsigned char* lds, int tid, int Gp, int bxp) {
    LAS float* tot = (LAS float*)(lds + RING_OFF);
    LAS unsigned char* lfl = lds + RING_OFF + 8192;
    const int d2 = tid & 63, tb = tid >> 6;
    const int G4 = Gp >> 2, h = bxp & 3, wq = bxp >> 2;
    if (wq >= G4 || wq >= 544) return;
    G0Raw R; g0_load(R, ws, ((wq / 68) * 4 + h) * 68 + wq % 68, tid);
    for (int idx = wq; idx < 544; idx += G4) {
        const int b = idx / 68, n = idx - b * 68, cn = (b * 4 + h) * 68 + n;
        float wf0[16], wf1[16], wb0[16], wb1[16];
        unsigned zi_ = 0u; LAUNDER_S(zi_); const unsigned char* wsi = ws + zi_;
        { const float* wgf = PARF(wsi) + P_GKF + (size_t)lg * 16 * 512 + h * 128 + 2 * d2; const float* wgb = PARF(wsi) + P_GKB + (size_t)lg * 16 * 512 + h * 128 + 2 * d2;
#pragma unroll
          for (int r = 0; r < 16; ++r) { const f32x2 a = *(const GAS f32x2*)(wgf + r * 512), c = *(const GAS f32x2*)(wgb + r * 512); wf0[r] = a.x; wf1[r] = a.y; wb0[r] = c.x; wb1[r] = c.y; } }
        const f32x2 bf_ = *(const GAS f32x2*)(PARF(wsi) + P_BGF + lg * 512 + h * 128 + 2 * d2), bb_ = *(const GAS f32x2*)(PARF(wsi) + P_BGB + lg * 512 + h * 128 + 2 * d2);
        __syncthreads();
        if (tid < 256) *(LAS v4u*)(lfl + tid * 16) = R.lfb;
        unsigned qk[8][2];
#pragma unroll
        for (int j = 0; j < 8; ++j) { qk[j][0] = R.qk[j][0]; qk[j][1] = R.qk[j][1]; }
        __syncthreads();
        if (idx + G4 < 544) { const int i2 = idx + G4, b2 = i2 / 68; g0_load(R, ws, (b2 * 4 + h) * 68 + (i2 - b2 * 68), tid); }
        float gf0[8], gf1[8], gb0[8], gb1[8];
#pragma unroll
        for (int j = 0; j < 8; ++j) { const LAS v4u* lp = (const LAS v4u*)(lfl + (8 * tb + j) * 64);
            const v4u l0 = lp[0], l1 = lp[1], l2 = lp[2], l3 = lp[3];
            float lf[16], lb[16];
            lf[0] = __uint_as_float(l0.x << 16); lf[1] = __uint_as_float(l0.x & 0xffff0000u); lf[2] = __uint_as_float(l0.y << 16); lf[3] = __uint_as_float(l0.y & 0xffff0000u);
            lf[4] = __uint_as_float(l0.z << 16); lf[5] = __uint_as_float(l0.z & 0xffff0000u); lf[6] = __uint_as_float(l0.w << 16); lf[7] = __uint_as_float(l0.w & 0xffff0000u);
            lf[8] = __uint_as_float(l1.x << 16); lf[9] = __uint_as_float(l1.x & 0xffff0000u); lf[10] = __uint_as_float(l1.y << 16); lf[11] = __uint_as_float(l1.y & 0xffff0000u);
            lf[12] = __uint_as_float(l1.z << 16); lf[13] = __uint_as_float(l1.z & 0xffff0000u); lf[14] = __uint_as_float(l1.w << 16); lf[15] = __uint_as_float(l1.w & 0xffff0000u);
            lb[0] = __uint_as_float(l2.x << 16); lb[1] = __uint_as_float(l2.x & 0xffff0000u); lb[2] = __uint_as_float(l2.y << 16); lb[3] = __uint_as_float(l2.y & 0xffff0000u);
            lb[4] = __uint_as_float(l2.z << 16); lb[5] = __uint_as_float(l2.z & 0xffff0000u); lb[6] = __uint_as_float(l2.w << 16); lb[7] = __uint_as_float(l2.w & 0xffff0000u);
            lb[8] = __uint_as_float(l3.x << 16); lb[9] = __uint_as_float(l3.x & 0xffff0000u); lb[10] = __uint_as_float(l3.y << 16); lb[11] = __uint_as_float(l3.y & 0xffff0000u);
            lb[12] = __uint_as_float(l3.z << 16); lb[13] = __uint_as_float(l3.z & 0xffff0000u); lb[14] = __uint_as_float(l3.w << 16); lb[15] = __uint_as_float(l3.w & 0xffff0000u);
            float zf0 = bf_.x, zf1 = bf_.y, zb0 = bb_.x, zb1 = bb_.y;
#pragma unroll
            for (int r = 0; r < 16; ++r) { zf0 += lf[r] * wf0[r]; zf1 += lf[r] * wf1[r]; zb0 += lb[r] * wb0[r]; zb1 += lb[r] * wb1[r]; }
            gf0[j] = log_sigmoid_fast(zf0) * 0.0625f; gf1[j] = log_sigmoid_fast(zf1) * 0.0625f; gb0[j] = log_sigmoid_fast(zb0) * 0.0625f; gb1[j] = log_sigmoid_fast(zb1) * 0.0625f; }
#pragma unroll
        for (int j = 1; j < 8; ++j) { gf0[j] += gf0[j - 1]; gf1[j] += gf1[j - 1]; gb0[7 - j] += gb0[8 - j]; gb1[7 - j] += gb1[8 - j]; }
        *(LAS f32x2*)(tot + (0 * 8 + tb) * 128 + 2 * d2) = (f32x2){gf0[7], gf1[7]}; *(LAS f32x2*)(tot + (1 * 8 + tb) * 128 + 2 * d2) = (f32x2){gb0[0], gb1[0]};
        __syncthreads();
        float pf0 = 0.f, pf1 = 0.f, pb0 = 0.f, pb1 = 0.f, lf0 = 0.f, lf1 = 0.f, lb0 = 0.f, lb1 = 0.f;
#pragma unroll
        for (int q = 0; q < 8; ++q) { const f32x2 a = *(const LAS f32x2*)(tot + (0 * 8 + q) * 128 + 2 * d2), c = *(const LAS f32x2*)(tot + (1 * 8 + q) * 128 + 2 * d2);
            lf0 += a.x; lf1 += a.y; lb0 += c.x; lb1 += c.y;
            if (q < tb) { pf0 += a.x; pf1 += a.y; } if (q > tb) { pb0 += c.x; pb1 += c.y; } }
        const size_t itf = (size_t)cn * 2, itb = itf + 1;
        bf16* Qf = (bf16*)(ws + WS_GQ) + itf * 8192; bf16* Qb = Qf + 8192; bf16* Kf = (bf16*)(ws + WS_GKH) + itf * 8192; bf16* Kb = Kf + 8192;
        const float elf0 = __expf(lf0), elf1 = __expf(lf1), elb0 = __expf(lb0), elb1 = __expf(lb1);
        float ktf0[8], ktf1[8], ktb0[8], ktb1[8];
#pragma unroll
        for (int j = 0; j < 8; ++j) { const int t = 8 * tb + j;
            const float q0 = __uint_as_float(qk[j][0] << 16) * 0.08838834764831845f, q1 = __uint_as_float(qk[j][0] & 0xffff0000u) * 0.08838834764831845f;
            const float k0 = __uint_as_float(qk[j][1] << 16), k1 = __uint_as_float(qk[j][1] & 0xffff0000u);
            const float ef0 = __expf(pf0 + gf0[j]), ef1 = __expf(pf1 + gf1[j]), eb0 = __expf(pb0 + gb0[j]), eb1 = __expf(pb1 + gb1[j]);
            const float rf0 = __builtin_amdgcn_rcpf(ef0), rf1 = __builtin_amdgcn_rcpf(ef1), rb0 = __builtin_amdgcn_rcpf(eb0), rb1 = __builtin_amdgcn_rcpf(eb1);
            *(GAS unsigned*)(Qf + t * 128 + 2 * d2) = pk2(q0 * ef0, q1 * ef1); *(GAS unsigned*)(Qb + t * 128 + 2 * d2) = pk2(q0 * eb0, q1 * eb1);
            *(GAS unsigned*)(Kf + t * 128 + 2 * d2) = pk2(k0 * rf0, k1 * rf1); *(GAS unsigned*)(Kb + t * 128 + 2 * d2) = pk2(k0 * rb0, k1 * rb1);
            ktf0[j] = k0 * rf0 * elf0; ktf1[j] = k1 * rf1 * elf1; ktb0[j] = k0 * rb0 * elb0; ktb1[j] = k1 * rb1 * elb1; }
        {
          unsigned char* Tf = ws + WS_GKT + itf * 16384 + (size_t)((((tb >> 1) * 4 + (d2 >> 4)) * 64 + ((2 * d2) & 31)) * 16 + 8 * (tb & 1)); unsigned char* Tb = Tf + 16384;
          *(GAS unsigned long long*)(Tf) = (unsigned long long)pk2(ktf0[0], ktf0[1]) | ((unsigned long long)pk2(ktf0[2], ktf0[3]) << 32);
          *(GAS unsigned long long*)(Tf + 512) = (unsigned long long)pk2(ktf0[4], ktf0[5]) | ((unsigned long long)pk2(ktf0[6], ktf0[7]) << 32);
          *(GAS unsigned long long*)(Tf + 16) = (unsigned long long)pk2(ktf1[0], ktf1[1]) | ((unsigned long long)pk2(ktf1[2], ktf1[3]) << 32);
          *(GAS unsigned long long*)(Tf + 528) = (unsigned long long)pk2(ktf1[4], ktf1[5]) | ((unsigned long long)pk2(ktf1[6], ktf1[7]) << 32);
          *(GAS unsigned long long*)(Tb) = (unsigned long long)pk2(ktb0[0], ktb0[1]) | ((unsigned long long)pk2(ktb0[2], ktb0[3]) << 32);
          *(GAS unsigned long long*)(Tb + 512) = (unsigned long long)pk2(ktb0[4], ktb0[5]) | ((unsigned long long)pk2(ktb0[6], ktb0[7]) << 32);
          *(GAS unsigned long long*)(Tb + 16) = (unsigned long long)pk2(ktb1[0], ktb1[1]) | ((unsigned long long)pk2(ktb1[2], ktb1[3]) << 32);
          *(GAS unsigned long long*)(Tb + 528) = (unsigned long long)pk2(ktb1[4], ktb1[5]) | ((unsigned long long)pk2(ktb1[6], ktb1[7]) << 32); }
        if (tb == 0) { float* DLp = (float*)(ws + WS_GDL) + itf * 128 + 2 * d2; *(GAS f32x2*)DLp = (f32x2){elf0, elf1}; *(GAS f32x2*)(DLp + 128) = (f32x2){elb0, elb1}; }
    }
}
struct G12Ops { bf16x8 a[4], b[4]; f32x4 d[4]; };
__device__ __forceinline__ void g12_load(G12Ops& o, unsigned char* ws, int bh, int dir, int m, int kb, int vb, int r, int hh) {
    const int n = dir ? (m < 4 ? 3 - m : 71 - m) : m; const size_t cn = (size_t)bh * 68 + n, item = cn * 2 + dir;
    const GAS bf16x8* ap = (const GAS bf16x8*)(ws + WS_GKT + item * 16384) + kb * 64 + (hh * 32 + r);
    const GAS bf16x8* bp = (const GAS bf16x8*)(ws + WS_GVT + cn * 32768) + vb * 64 + (hh * 32 + r);
    const float* dp = (const float*)(ws + WS_GDL) + item * 128 + 32 * kb + 4 * hh;
#pragma unroll
    for (int ks = 0; ks < 4; ++ks) { o.a[ks] = ap[ks * 256]; o.b[ks] = bp[ks * 512]; o.d[ks] = *(const GAS f32x4*)(dp + 8 * ks); }
}
__device__ __forceinline__ void phase_gla_g12(unsigned char* ws, LAS unsigned char* lds, int gwv, int wave, int lane) {
    if (gwv >= 2048) return;
    const int chain = gwv >> 5, blk = gwv & 31, kb = blk & 3, vb = blk >> 2, dir = chain & 1, bh = chain >> 1;
    const int r = lane & 31, hh = lane >> 5;
    LAS unsigned char* wl = lds + RING_OFF + wave * 2048;
    f32x16 acc;
#pragma unroll
    for (int g = 0; g < 16; ++g) acc[g] = 0.f;
    G12Ops o0, o1, o2;
    g12_load(o0, ws, bh, dir, 0, kb, vb, r, hh); g12_load(o1, ws, bh, dir, 1, kb, vb, r, hh);
#define G12_STEP(CUR, m_) do { const int mm_ = (m_); const int n = dir ? (mm_ < 4 ? 3 - mm_ : 71 - mm_) : mm_; \
        _Pragma("unroll") for (int gg = 0; gg < 4; ++gg) *(LAS unsigned long long*)(wl + (((gg >> 1) * 64 + (gg & 1) * 32 + r) * 16 + 8 * hh)) = (unsigned long long)pk2(acc[4 * gg], acc[4 * gg + 1]) | ((unsigned long long)pk2(acc[4 * gg + 2], acc[4 * gg + 3]) << 32); \
        LDS_WAIT(); const v4u s0 = *(const LAS v4u*)(wl + lane * 16), s1 = *(const LAS v4u*)(wl + 1024 + lane * 16); LDS_WAIT(); \
        { bf16* sp = (bf16*)(ws + WS_SX) + ((size_t)(bh * 2 + dir) * 68 + n) * 32768 + (size_t)(kb * 8 + vb) * 1024; ((GAS v4u*)sp)[lane] = s0; ((GAS v4u*)sp)[64 + lane] = s1; } \
        _Pragma("unroll") for (int gg = 0; gg < 4; ++gg) { acc[4 * gg] *= CUR.d[gg].x; acc[4 * gg + 1] *= CUR.d[gg].y; acc[4 * gg + 2] *= CUR.d[gg].z; acc[4 * gg + 3] *= CUR.d[gg].w; } \
        _Pragma("unroll") for (int ks = 0; ks < 4; ++ks) acc = __builtin_amdgcn_mfma_f32_32x32x16_bf16(CUR.a[ks], CUR.b[ks], acc, 0, 0, 0); } while (0)
    for (int m = 0; m < 66; m += 3) {
        g12_load(o2, ws, bh, dir, m + 2, kb, vb, r, hh); G12_STEP(o0, m);
        g12_load(o0, ws, bh, dir, m + 3, kb, vb, r, hh); G12_STEP(o1, m + 1);
        g12_load(o1, ws, bh, dir, (m + 4 < 68) ? m + 4 : 67, kb, vb, r, hh); G12_STEP(o2, m + 2);
    }
    G12_STEP(o0, 66); G12_STEP(o1, 67);
#undef G12_STEP
}
constexpr int G3_RS = 272, G3_TILE = 64 * G3_RS, G3_OL = 4 * G3_TILE  , G3_LD = 260;
static_assert(G3_OL + 64 * G3_LD * 4 <= MISC_OFF, "G3 LDS");
__device__ __forceinline__ void phase_gla_g3(unsigned char* ws, int lg, LAS unsigned char* lds, int tid) {
    const int lane = tid & 63, wave = __builtin_amdgcn_readfirstlane(tid >> 6), r = lane & 31, hh = lane >> 5, vb = wave;
    LAS unsigned char* TL = lds + RING_OFF; LAS float* OL = (LAS float*)(lds + RING_OFF + G3_OL);
    const bf16* G = (const bf16*)(ws + WS_G); bf16* OG = (bf16*)(ws + WS_Q);
    for (int cn = blockIdx.x; cn < 2176; cn += gridDim.x) {
        const int n = cn % 68, bh = cn / 68, h = bh & 3, b = bh >> 2;
        v4u st[4][2];
#pragma unroll
        for (int tl = 0; tl < 4; ++tl) { const bf16* src = (const bf16*)(ws + ((tl & 1) ? WS_GKH : WS_GQ)) + ((size_t)cn * 2 + (tl >> 1)) * 8192;
#pragma unroll
            for (int j = 0; j < 2; ++j) st[tl][j] = ((const GAS v4u*)src)[tid + 512 * j]; }
        __syncthreads();
#pragma unroll
        for (int tl = 0; tl < 4; ++tl)
#pragma unroll
            for (int j = 0; j < 2; ++j) { const int q = tid + 512 * j, row = q >> 4, ch = q & 15; *(LAS v4u*)(TL + tl * G3_TILE + row * G3_RS + ch * 16) = st[tl][j]; }
        __syncthreads();
        f32x16 P00, P01, P10, P11, O0, O1;
#pragma unroll
        for (int g = 0; g < 16; ++g) { P00[g] = 0.f; P01[g] = 0.f; P10[g] = 0.f; P11[g] = 0.f; O0[g] = 0.f; O1[g] = 0.f; }
#pragma unroll
        for (int dir = 0; dir < 2; ++dir) {
            const LAS unsigned char* Qt = TL + (2 * dir) * G3_TILE + r * G3_RS + 16 * hh; const LAS unsigned char* Kh = TL + (2 * dir + 1) * G3_TILE + r * G3_RS + 16 * hh;
            const GAS bf16x8* Sx = (const GAS bf16x8*)((const bf16*)(ws + WS_SX) + ((size_t)(bh * 2 + dir) * 68 + n) * 32768 + (size_t)vb * 1024) + lane;
            f32x16 X00, X11, Xoff;
#pragma unroll
            for (int g = 0; g < 16; ++g) { X00[g] = 0.f; X11[g] = 0.f; Xoff[g] = 0.f; }
#pragma unroll
            for (int s = 0; s < 8; ++s) {
                const bf16x8 q0 = *(const LAS bf16x8*)(Qt + 32 * s), q1 = *(const LAS bf16x8*)(Qt + 32 * G3_RS + 32 * s);
                const bf16x8 k0 = *(const LAS bf16x8*)(Kh + 32 * s), k1 = *(const LAS bf16x8*)(Kh + 32 * G3_RS + 32 * s);
                const bf16x8 sx = Sx[(s >> 1) * 1024 + (s & 1) * 64];
                X00 = __builtin_amdgcn_mfma_f32_32x32x16_bf16(k0, q0, X00, 0, 0, 0);
                X11 = __builtin_amdgcn_mfma_f32_32x32x16_bf16(k1, q1, X11, 0, 0, 0);
                if (dir == 0) Xoff = __builtin_amdgcn_mfma_f32_32x32x16_bf16(k0, q1, Xoff, 0, 0, 0); else Xoff = __builtin_amdgcn_mfma_f32_32x32x16_bf16(k1, q0, Xoff, 0, 0, 0);
                O0 = __builtin_amdgcn_mfma_f32_32x32x16_bf16(q0, sx, O0, 0, 0, 0); O1 = __builtin_amdgcn_mfma_f32_32x32x16_bf16(q1, sx, O1, 0, 0, 0); }
#pragma unroll
            for (int g = 0; g < 16; ++g) { const int tj = (g & 3) + 8 * (g >> 2) + 4 * hh; const bool keep = dir ? (tj >= r) : (tj <= r);
                P00[g] += keep ? X00[g] : 0.f; P11[g] += keep ? X11[g] : 0.f;
                if (dir == 0) P01[g] += Xoff[g]; else P10[g] += Xoff[g]; }
        }
        { const GAS bf16x8* Vt = (const GAS bf16x8*)(ws + WS_GVT + (size_t)cn * 32768) + vb * 64 + lane;
#pragma unroll
          for (int jb = 0; jb < 2; ++jb)
#pragma unroll
            for (int s2 = 0; s2 < 2; ++s2) { const bf16x8 bfv = Vt[(2 * jb + s2) * 512];
                const f32x16& Pa = jb ? P10 : P00; const f32x16& Pb = jb ? P11 : P01;
                const bf16x8 a0 = __builtin_bit_cast(bf16x8, ((v4u){pk2(Pa[8 * s2 + 0], Pa[8 * s2 + 1]), pk2(Pa[8 * s2 + 2], Pa[8 * s2 + 3]), pk2(Pa[8 * s2 + 4], Pa[8 * s2 + 5]), pk2(Pa[8 * s2 + 6], Pa[8 * s2 + 7])}));
                const bf16x8 a1 = __builtin_bit_cast(bf16x8, ((v4u){pk2(Pb[8 * s2 + 0], Pb[8 * s2 + 1]), pk2(Pb[8 * s2 + 2], Pb[8 * s2 + 3]), pk2(Pb[8 * s2 + 4], Pb[8 * s2 + 5]), pk2(Pb[8 * s2 + 6], Pb[8 * s2 + 7])}));
                O0 = __builtin_amdgcn_mfma_f32_32x32x16_bf16(a0, bfv, O0, 0, 0, 0); O1 = __builtin_amdgcn_mfma_f32_32x32x16_bf16(a1, bfv, O1, 0, 0, 0); } }
#pragma unroll
        for (int g = 0; g < 16; ++g) { const int t = (g & 3) + 8 * (g >> 2) + 4 * hh; OL[t * G3_LD + 32 * vb + r] = O0[g]; OL[(32 + t) * G3_LD + 32 * vb + r] = O1[g]; }
        __syncthreads();
        { const int t = tid >> 3, cc = tid & 7; const LAS f32x4* op = (const LAS f32x4*)(OL + t * G3_LD + 32 * cc);
          f32x4 o[8]; float ss = 0.f;
#pragma unroll
          for (int j = 0; j < 8; ++j) { o[j] = op[j]; ss += (o[j].x * o[j].x + o[j].y * o[j].y) + (o[j].z * o[j].z + o[j].w * o[j].w); }
          ss += __shfl_xor(ss, 1); ss += __shfl_xor(ss, 2); ss += __shfl_xor(ss, 4);
          const float rs = 1.0f / sqrtf(ss * (1.0f / 256.0f) + RMS_EPS);
          const size_t row = (size_t)b * TB + 64 * n + t;
          const GAS v4u* rp = (const GAS v4u*)(G + row * WINP + 2048 + h * 256 + 32 * cc); const GAS f32x4* gp = (const GAS f32x4*)(PARF(ws) + P_OG + lg * 256 + 32 * cc);
          GAS v4u* dst = (GAS v4u*)(OG + row * 1024 + h * 256 + 32 * cc);
#pragma unroll
          for (int j = 0; j < 4; ++j) { const v4u rv = rp[j]; const f32x4 g0 = gp[2 * j], g1 = gp[2 * j + 1]; const f32x4 a = o[2 * j] * rs * g0, c2 = o[2 * j + 1] * rs * g1;
              v4u w;
              w.x = pk2(a.x * silu_f(__uint_as_float(rv.x << 16)), a.y * silu_f(__uint_as_float(rv.x & 0xffff0000u)));
              w.y = pk2(a.z * silu_f(__uint_as_float(rv.y << 16)), a.w * silu_f(__uint_as_float(rv.y & 0xffff0000u)));
              w.z = pk2(c2.x * silu_f(__uint_as_float(rv.z << 16)), c2.y * silu_f(__uint_as_float(rv.z & 0xffff0000u)));
              w.w = pk2(c2.z * silu_f(__uint_as_float(rv.w << 16)), c2.w * silu_f(__uint_as_float(rv.w & 0xffff0000u)));
              dst[j] = w; } }
    }
}
constexpr int WIMG_RS = 2064;
static_assert(2 * 32 * WIMG_RS <= LDS_AUX, "router images below the aux tables");
__device__ __forceinline__ void phase_modulate2_route(unsigned char* ws, int layer, LAS unsigned char* lds, int vcu, int wave, int lane, int tid, bool dummy = false) {
    const bf16* X = (const bf16*)(ws + WS_X); bf16* XN = (bf16*)(ws + WS_XN);
    const float* ng = PARF(ws) + P_N2G + layer * 1024; const float* Mo = (const float*)(ws + WS_MOD) + (size_t)layer * MODROWS * NMODC;
    LAS unsigned char* WHI = lds + RING_OFF; LAS unsigned char* WLO = WHI + 32 * WIMG_RS;
    LAS unsigned* lcnt = (LAS unsigned*)(lds + AUX_LCNT); LAS unsigned* gb = (LAS unsigned*)(lds + AUX_GB); LAS unsigned* ent = (LAS unsigned*)(lds + AUX_ENT); LAS float* rsl = (LAS float*)(lds + AUX_RS);
    { const float* wsrc = PARF(ws) + P_WR + (size_t)layer * 1024 * 32;
      for (int idx = tid; idx < 1024 * 32; idx += NWAVES * 64) { const int k = idx >> 5, e = idx & 31; const float w = wsrc[idx]; const unsigned hi = f2bf(w), lo = f2bf(w - __uint_as_float(hi << 16));
          *(LAS unsigned short*)(WHI + e * WIMG_RS + 2 * k) = (unsigned short)hi; *(LAS unsigned short*)(WLO + e * WIMG_RS + 2 * k) = (unsigned short)lo; }
      if (tid < 32) lcnt[tid] = 0u; }
    gu32* cnt = (gu32*)(ws + WS_CTL) + CW_CNT + (layer + (dummy ? 4 : 0)) * 32 * 16;
    unsigned char* sbase = dummy ? ws + WS_XG : ws;
    const bool lastl = (layer == NLAYER - 1);
  for (int grp = vcu; grp < MT / 136; grp += (int)gridDim.x) {
    const int rbase = grp * 136;
    if (grp != vcu) { __syncthreads(); if (tid < 32) lcnt[tid] = 0u; }
    for (int rl = wave; rl < 136; rl += 2 * NWAVES) {
        const int rl2 = (rl + NWAVES < 136) ? rl + NWAVES : rl; const int m = rbase + rl, m2 = rbase + rl2, mr = mod_row(m), mr2 = mod_row(m2);
        float rs, rs2;
        modulate_row2(X + (size_t)m * 1024, X + (size_t)m2 * 1024, ng, Mo + (size_t)mr * NMODC + 3 * 1024, Mo + (size_t)mr * NMODC + 4 * 1024, Mo + (size_t)mr2 * NMODC + 3 * 1024, Mo + (size_t)mr2 * NMODC + 4 * 1024,
                      ws + WS_XN8 + (size_t)m * 1024, ws + WS_XN8 + (size_t)m2 * 1024, lane, rs, rs2);
        if (lane == 0) { rsl[rl] = rs; rsl[rl2] = rs2; } }
    __syncthreads();
    if (wave < 5) {
        const int r = lane & 31, hh = lane >> 5; const int rl = (32 * wave + r < 136) ? 32 * wave + r : 135; const int m = rbase + rl, mr = mod_row(m);
        const float rsr = rsl[rl];
        const bf16* xp = X + (size_t)m * 1024 + 8 * hh; const float* gp = ng + 8 * hh; const float* scp = Mo + (size_t)mr * NMODC + 4 * 1024 + 8 * hh; const float* shp = Mo + (size_t)mr * NMODC + 3 * 1024 + 8 * hh;
        const LAS unsigned char* wh = WHI + r * WIMG_RS + 16 * hh; const LAS unsigned char* wl = WLO + r * WIMG_RS + 16 * hh;
        f32x16 acc;
#pragma unroll
        for (int g = 0; g < 16; ++g) acc[g] = 0.f;
#pragma unroll 2
        for (int s = 0; s < 64; ++s) {
            const v4u xr8 = *(const GAS v4u*)(xp + 16 * s); const f32x4 x0 = (f32x4){__uint_as_float(xr8.x << 16), __uint_as_float(xr8.x & 0xffff0000u), __uint_as_float(xr8.y << 16), __uint_as_float(xr8.y & 0xffff0000u)}, x1 = (f32x4){__uint_as_float(xr8.z << 16), __uint_as_float(xr8.z & 0xffff0000u), __uint_as_float(xr8.w << 16), __uint_as_float(xr8.w & 0xffff0000u)}; const f32x4 g0 = *(const GAS f32x4*)(gp + 16 * s), g1 = *(const GAS f32x4*)(gp + 16 * s + 4);
            const f32x4 c0 = *(const GAS f32x4*)(scp + 16 * s), c1 = *(const GAS f32x4*)(scp + 16 * s + 4), h0 = *(const GAS f32x4*)(shp + 16 * s), h1 = *(const GAS f32x4*)(shp + 16 * s + 4);
            const f32x4 y0 = (x0 * rsr) * g0 * (c0 + 1.0f) + h0, y1 = (x1 * rsr) * g1 * (c1 + 1.0f) + h1;
            v4u ph, pl;
            ph.x = pg8::cvt_pk_bf16(y0.x, y0.y); ph.y = pg8::cvt_pk_bf16(y0.z, y0.w); ph.z = pg8::cvt_pk_bf16(y1.x, y1.y); ph.w = pg8::cvt_pk_bf16(y1.z, y1.w);
            pl.x = pg8::cvt_pk_bf16(y0.x - __uint_as_float(ph.x << 16), y0.y - __uint_as_float(ph.x & 0xffff0000u)); pl.y = pg8::cvt_pk_bf16(y0.z - __uint_as_float(ph.y << 16), y0.w - __uint_as_float(ph.y & 0xffff0000u));
            pl.z = pg8::cvt_pk_bf16(y1.x - __uint_as_float(ph.z << 16), y1.y - __uint_as_float(ph.z & 0xffff0000u)); pl.w = pg8::cvt_pk_bf16(y1.z - __uint_as_float(ph.w << 16), y1.w - __uint_as_float(ph.w & 0xffff0000u));
            const bf16x8 ahi = __builtin_bit_cast(bf16x8, ph), alo = __builtin_bit_cast(bf16x8, pl);
            const bf16x8 bhi = *(const LAS bf16x8*)(wh + 32 * s), blo = *(const LAS bf16x8*)(wl + 32 * s);
            acc = __builtin_amdgcn_mfma_f32_32x32x16_bf16(ahi, bhi, acc, 0, 0, 0); acc = __builtin_amdgcn_mfma_f32_32x32x16_bf16(alo, bhi, acc, 0, 0, 0); acc = __builtin_amdgcn_mfma_f32_32x32x16_bf16(ahi, blo, acc, 0, 0, 0); }
        const float brt = (PARF(ws) + P_BR)[layer * 32 + r];
#pragma unroll
        for (int g = 0; g < 16; ++g) { const int rowl = 32 * wave + (g & 3) + 8 * (g >> 2) + 4 * hh;
            float v = acc[g] + brt; float tv[4]; int te[4];
#pragma unroll
            for (int k = 0; k < 4; ++k) { float mx = v;
#pragma unroll
                for (int o = 1; o < 32; o <<= 1) mx = fmaxf(mx, shx(mx, o, lane));
                const unsigned long long bm = __ballot(v == mx); const unsigned hm = hh ? (unsigned)(bm >> 32) : (unsigned)bm; const int first = __ffs((int)hm) - 1;
                te[k] = first; tv[k] = mx; if (r == first) v = -INFINITY; }
            const bool valid = rowl < 136 && !(lastl && mod_row(rbase + (rowl < 136 ? rowl : 135)) == 8);
            if (r == 0 && rowl < 136) {
                if (valid) { const float e1 = __expf(tv[1] - tv[0]), e2 = __expf(tv[2] - tv[0]), e3 = __expf(tv[3] - tv[0]); const float inv = 1.0f / (1.0f + e1 + e2 + e3);
                    const float wk[4] = {inv, e1 * inv, e2 * inv, e3 * inv};
#pragma unroll
                    for (int k = 0; k < 4; ++k) { const unsigned lp = atomicAdd((unsigned*)&lcnt[te[k]], 1u); ent[(rowl * 4 + k) * 2 + 0] = ((unsigned)te[k] << 24) | lp; ent[(rowl * 4 + k) * 2 + 1] = __float_as_uint(wk[k]); } }
                else {
#pragma unroll
                    for (int k = 0; k < 4; ++k) ent[(rowl * 4 + k) * 2 + 0] = 0xffffffffu; } } }
    }
    __syncthreads();
    if (tid < 32) gb[tid] = __hip_atomic_fetch_add(cnt + tid * 16, lcnt[tid], __ATOMIC_RELAXED, __HIP_MEMORY_SCOPE_AGENT);
    __syncthreads();
    for (int q = tid; q < 136 * 4; q += NWAVES * 64) { const unsigned pe = ent[q * 2 + 0];
        if (pe != 0xffffffffu) { const unsigned e = pe >> 24, lp = pe & 0xffffffu; const int m = rbase + (q >> 2);
            ((unsigned*)(sbase + WS_SLOT))[m * 4 + (q & 3)] = (e << 24) | (gb[e] + lp); ((unsigned*)(sbase + WS_GATEW))[m * 4 + (q & 3)] = ent[q * 2 + 1];
            if (!dummy) ((int*)(ws + WS_LIST))[(size_t)e * MT + gb[e] + lp] = m; } }
  }
}
__device__ __forceinline__ void build_expert_tables(unsigned char* ws, int layer, LAS unsigned char* lds, int tid) {
    LAS int* t2e = (LAS int*)(lds + AUX_T2E); LAS int* base = (LAS int*)(lds + AUX_BASE); LAS int* ntp = (LAS int*)(lds + AUX_NT); LAS int* cntl = (LAS int*)(lds + AUX_CNT);
    gu32* cnt = (gu32*)(ws + WS_CTL) + CW_CNT + layer * 32 * 16;
    __syncthreads();
    if (tid < 64) { const unsigned cval = (tid < 32) ? __hip_atomic_load(cnt + tid * 16, RLX_AGENT) : 0u; const int tiles = (int)((cval + 255u) >> 8);
        int pre = tiles;
#pragma unroll
        for (int o = 1; o < 32; o <<= 1) { const int ln = tid & 63; const int t = __builtin_amdgcn_ds_bpermute(((ln >= o) ? ln - o : ln) << 2, pre); if (ln >= o) pre += t; }
        const int start = pre - tiles;
        if (tid < 32) { base[tid] = start * 256; cntl[tid] = (int)cval; for (int t = 0; t < tiles; ++t) t2e[start + t] = tid; if (tid == 31) ntp[0] = pre; } }
    __syncthreads();
}
__device__ __forceinline__ void phase_moe_gather(unsigned char* ws, int layer, LAS unsigned char* lds, int gw, int NGW, int lane, int tid) {
    build_expert_tables(ws, layer, lds, tid);
    const LAS int* base = (const LAS int*)(lds + AUX_BASE);
    const bf16* XN = (const bf16*)(ws + WS_XN); bf16* XG = (bf16*)(ws + WS_XG);
    const unsigned* slot = (const unsigned*)(ws + WS_SLOT); unsigned* spos = (unsigned*)(ws + WS_SLOTPOS);
    for (int m = gw; m < MT; m += NGW) {
        if (layer == NLAYER - 1 && mod_row(m) == 8) continue;
        const GAS v4u* src = (const GAS v4u*)(XN + (size_t)m * 1024) + lane; const v4u a = src[0], b = src[64];
#pragma unroll
        for (int k = 0; k < 4; ++k) { const unsigned pe = slot[m * 4 + k]; const int dst = base[pe >> 24] + (int)(pe & 0xffffffu);
            GAS v4u* dp = (GAS v4u*)(XG + (size_t)dst * 1024) + lane; dp[0] = a; dp[64] = b;
            if (lane == 0) spos[m * 4 + k] = (unsigned)dst; }
    }
}
__device__ __forceinline__ void phase_moe_combine(unsigned char* ws, float* out, int layer, LAS unsigned char* lds, int gw, int NGW, int lane, int tid, bool dummy = false) {
    build_expert_tables(ws, layer, lds, tid);
    const LAS int* base = (const LAS int*)(lds + AUX_BASE);
    bf16* X = (bf16*)(ws + WS_X); const unsigned char* Y = ws + WS_Y;
    const float* Mo = (const float*)(ws + WS_MOD) + (size_t)layer * MODROWS * NMODC;
    const unsigned* slot = (const unsigned*)(ws + WS_SLOT); const float* gw4 = (const float*)(ws + WS_GATEW);
    for (int m0 = gw; m0 < MT; m0 += 2 * NGW) {
        int mm[2], bb[2], ww[2], mrr[2]; bool ok[2];
#pragma unroll
        for (int p = 0; p < 2; ++p) { const int m = m0 + p * NGW; ok[p] = m < MT; mm[p] = ok[p] ? m : m0; bb[p] = mm[p] / TB; ww[p] = mm[p] - bb[p] * TB; mrr[p] = (ww[p] < CTXL) ? 8 : bb[p];
            if (layer == NLAYER - 1 && ww[p] < CTXL) ok[p] = false; }
        if (!ok[0] && !ok[1]) continue;
        unsigned pe[2][4]; float wk[2][4];
#pragma unroll
        for (int p = 0; p < 2; ++p)
#pragma unroll
            for (int k = 0; k < 4; ++k) { pe[p][k] = slot[mm[p] * 4 + k]; wk[p][k] = gw4[mm[p] * 4 + k]; }
        unsigned long long xv[2][4];
#pragma unroll
        for (int p = 0; p < 2; ++p) { const GAS unsigned long long* xp = (const GAS unsigned long long*)(X + (size_t)mm[p] * 1024) + lane;
#pragma unroll
            for (int j = 0; j < 4; ++j) xv[p][j] = xp[64 * j]; }
        unsigned yv[2][4][4];
#pragma unroll
        for (int p = 0; p < 2; ++p)
#pragma unroll
            for (int k = 0; k < 4; ++k) { unsigned e = pe[p][k] >> 24; if (!ok[p] || e > 31u) e = 0u;
                const unsigned sp = ok[p] ? (unsigned)base[e] + (pe[p][k] & 0xffffffu) : 0u;
                const GAS unsigned* yp = (const GAS unsigned*)(Y + (size_t)sp * 1024) + lane;
#pragma unroll
                for (int j = 0; j < 4; ++j) yv[p][k][j] = yp[64 * j]; }
        f32x4 f[2][4]; float ss[2];
#pragma unroll
        for (int p = 0; p < 2; ++p) { const GAS f32x4* gp = (const GAS f32x4*)(Mo + (size_t)mrr[p] * NMODC + 5 * 1024) + lane;
            ss[p] = 0.f;
#pragma unroll
            for (int j = 0; j < 4; ++j) { f32x4 a = (f32x4){0.f, 0.f, 0.f, 0.f};
#pragma unroll
                for (int k = 0; k < 4; ++k) { const unsigned w8 = yv[p][k][j]; const f32x2 lo2 = __builtin_amdgcn_cvt_pk_f32_fp8((int)w8, false), hi2 = __builtin_amdgcn_cvt_pk_f32_fp8((int)w8, true); a = a + (f32x4){lo2.x, lo2.y, hi2.x, hi2.y} * wk[p][k]; }
                f[p][j] = bf4_to_f32(xv[p][j]) + gp[64 * j] * a; } }
        asm volatile("" ::: "memory");
        const bool fuse = (layer < NLAYER - 1) && !dummy;
#pragma unroll
        for (int p = 0; p < 2; ++p) { if (!ok[p]) continue;
            GAS unsigned long long* xp = (GAS unsigned long long*)(X + (size_t)mm[p] * 1024) + lane;
            GAS f32x4* op = (GAS f32x4*)(out + ((size_t)bb[p] * SEQ + (ww[p] - CTXL)) * 1024) + lane;
#pragma unroll
            for (int j = 0; j < 4; ++j) { if (dummy) ((GAS f32x4*)((float*)(ws + WS_XG) + (size_t)mm[p] * 1024) + lane)[64 * j] = f[p][j]; else if (layer == NLAYER - 1) op[64 * j] = f[p][j]; else { const unsigned long long pk = f32_to_bf4(f[p][j]); xp[64 * j] = pk; f[p][j] = bf4_to_f32(pk); }
                ss[p] += (f[p][j].x * f[p][j].x + f[p][j].y * f[p][j].y) + (f[p][j].z * f[p][j].z + f[p][j].w * f[p][j].w); }
            if (fuse) { const float rs = 1.0f / sqrtf(wave_sum(ss[p]) * (1.0f / 1024.0f) + RMS_EPS);
                const float* ng = PARF(ws) + P_N1G + (layer + 1) * 1024; const float* Mn = (const float*)(ws + WS_MOD) + (size_t)(layer + 1) * MODROWS * NMODC + (size_t)mrr[p] * NMODC;
                GAS unsigned long long* o8 = (GAS unsigned long long*)((bf16*)(ws + WS_XN) + (size_t)mm[p] * 1024) + lane;
#pragma unroll
                for (int j = 0; j < 4; ++j) { const f32x4 g = ((const GAS f32x4*)ng)[64 * j + lane], sh = ((const GAS f32x4*)Mn)[64 * j + lane], sc = ((const GAS f32x4*)(Mn + 1024))[64 * j + lane];
                    o8[64 * j] = f32_to_bf4((f[p][j] * rs) * g * (sc + 1.0f) + sh); } } }
    }
}

constexpr int NPH_L = 11, NPHASE = 2 + NPH_L * NLAYER;
#ifndef PHMASK
#define PHMASK 0x7fff
#endif
#define EN(b) ((PHMASK >> (b)) & 1)
#ifndef DUPMASK
#define DUPMASK 0
#endif
#define DUP(b) for (int rep_ = 0; rep_ < (((DUPMASK >> (b)) & 1) ? 2 : 1); ++rep_)
__global__ void __launch_bounds__(NWAVES * 64, 2) dit_fwd(Args args) {
    extern __shared__ __attribute__((aligned(16))) unsigned char lds_raw[];
    LAS unsigned char* lds = (LAS unsigned char*)lds_raw;
    volatile LAS unsigned* MISC = (volatile LAS unsigned*)(lds + MISC_OFF);
    const int G = gridDim.x, bx = blockIdx.x;
    const int vcu = (G % 8 == 0) ? (bx % 8) * (G / 8) + bx / 8 : bx;
    const int wave0 = __builtin_amdgcn_readfirstlane((int)threadIdx.x >> 6);
#define LANE_ID(z) ((int)__builtin_amdgcn_mbcnt_hi(~0u, __builtin_amdgcn_mbcnt_lo(~0u, (z))))
    { const int t0 = (wave0 << 6) | LANE_ID(0u); for (int u = t0; u < (LDS_BYTES - MISC_OFF) / 4; u += NWAVES * 64) ((LAS unsigned*)(lds + MISC_OFF))[u] = 0u; }
    __syncthreads();
    const int lo = args.ph_lo, hi = args.ph_hi;
    XcdBarrier bar; bar.bar = (unsigned*)(args.ws + WS_CTL) + CW_BAR; bar.x = 0; bar.st = nullptr;
    if (hi - lo > 1) bar = xcd_barrier_post((unsigned*)(args.ws + WS_CTL) + CW_BAR, MISC + 8, wave0 == 0 && LANE_ID(0u) == 0);
#define IN(k) (lo <= (k) && (k) < hi)
#define SEAM(k) do { if (IN(k) && IN((k) + 1)) { XcdBarrier b_ = bar; unsigned zb_ = 0u; LAUNDER_S(zb_); b_.bar = bar.bar + zb_; xcd_barrier(b_, wave0 == 0 && LANE_ID(zb_) == 0); } } while (0)
#define PHASE_IDS() unsigned zoff_ = 0u; LAUNDER_S(zoff_); int tid = (wave0 << 6) | LANE_ID(zoff_); LAUNDER_V(tid); const int lane = tid & 63, wave = __builtin_amdgcn_readfirstlane(tid >> 6); const int gw = vcu * NWAVES + wave, NGW = G * NWAVES; \
    unsigned char* ws = args.ws + zoff_; const int Gp = G + (int)zoff_, bxp = bx + (int)zoff_; (void)lane; (void)gw; (void)NGW; (void)Gp; (void)bxp;

    if (EN(0) && IN(0)) DUP(0) { PHASE_IDS(); p0_prologue(args, lds, gw, NGW, wave, lane); } SEAM(0);
    if (EN(1) && IN(1)) { PHASE_IDS(); p1_mod_reduce(args, gw * 64 + lane, NGW * 64); } SEAM(1);

    for (int layer = 0; layer < NLAYER; ++layer) {
        const int pb = 2 + NPH_L * layer, lh = layer >> 1;
        if (layer == 0) { if (EN(2) && IN(pb + 0)) DUP(2) { PHASE_IDS(); phase_modulate1(ws, layer, gw, NGW, lane); } SEAM(pb + 0); }
        if ((layer & 1) == 0) {
            if (EN(3) && IN(pb + 1)) DUP(3) {
                PHASE_IDS();
                pg8::Gemm g{(const pg8::bf16_t*)(ws + WS_XN), (const pg8::bf16_t*)(ws + WS_WQKV) + (size_t)lh * QKVN * 1024, MT, QKVN, 1024, 0};
                pg8::StaticOrder S; S.init(MT, QKVN, Gp, bxp);
                LAS float* gl = (LAS float*)(lds + AUX_RS);
                if (tid < 128) gl[tid] = (PARF(ws) + (tid < 64 ? P_QG : P_KG - 64) + lh * 64)[tid];
                __syncthreads();
                pg8::EpiQKV E{ws, WS_Q, WS_K - WS_Q, WS_V - WS_K, gl, (const float*)(ws + WS_ROPE), ATT_C2};
                pg8::gemm_phase<pg8::EpiQKV, pg8::StaticOrder, true, true>(lds + RING_OFF, g, S, E, tid);
            } SEAM(pb + 1);
            if (EN(5) && IN(pb + 3)) DUP(5) {
                PHASE_IDS();
                const attn_body::bf16* Qp = (const attn_body::bf16*)(ws + WS_Q); const attn_body::bf16* Kp = (const attn_body::bf16*)(ws + WS_K); const attn_body::bf16* Vp = (const attn_body::bf16*)(ws + WS_V);
                attn_body::bf16* Op = (attn_body::bf16*)(ws + WS_XN);
                if (G == 256) {
                    for (int i = 0; i < 9; ++i) {
                        long qrow0, kvrow0; int NT, h;
                        if (i < 8) { const int x = vcu >> 5, j = vcu & 31, pair = 4 * x + (i >> 1), wi = (i & 1) * 32 + j, hq = wi >> 4, qb = wi & 15, b = pair >> 2, hk = pair & 3;
                            h = hk * 4 + hq; qrow0 = (long)b * TB + CTXL + qb * 256; kvrow0 = (long)b * TB; NT = TB / 64; }
                        else { if (vcu >= 128) break; const int b = vcu >> 4; h = vcu & 15; qrow0 = (long)b * TB; kvrow0 = qrow0; NT = CTXL / 64; }
                        attn_body::attn_unit<8>(qrow0, kvrow0, NT, h, Qp, Kp, Vp, Op, (char*)lds_raw + RING_OFF, tid);
                    }
                } else {
                    for (int U = bx; U < 2048 + 128; U += G) {
                        long qrow0, kvrow0; int NT, h;
                        if (U < 2048) { const int pair = U >> 6, wi = U & 63, hq = wi >> 4, qb = wi & 15, b = pair >> 2, hk = pair & 3; h = hk * 4 + hq; qrow0 = (long)b * TB + CTXL + qb * 256; kvrow0 = (long)b * TB; NT = TB / 64; }
                        else { const int v = U - 2048, b = v >> 4; h = v & 15; qrow0 = (long)b * TB; kvrow0 = qrow0; NT = CTXL / 64; }
                        attn_body::attn_unit<8>(qrow0, kvrow0, NT, h, Qp, Kp, Vp, Op, (char*)lds_raw + RING_OFF, tid);
                    }
                }
            } SEAM(pb + 3);
        } else {
            if (EN(6) && IN(pb + 1)) DUP(6) {
                PHASE_IDS();
                pg8::Gemm g{(const pg8::bf16_t*)(ws + WS_XN), (const pg8::bf16_t*)(ws + WS_WIN) + (size_t)lh * WINP * 1024, MT, WINP, 1024, 0};
                pg8::StaticOrder S; S.init(MT, WINP, Gp, bxp);
                pg8::EpiBf16 E{(pg8::bf16_t*)(ws + WS_G), WINP};
                pg8::gemm_phase<pg8::EpiBf16, pg8::StaticOrder, true, true>(lds + RING_OFF, g, S, E, tid);
            } SEAM(pb + 1);
            if (EN(7) && IN(pb + 2)) DUP(7) { { PHASE_IDS(); phase_gla_g0v(ws, tid, Gp, bxp); } { PHASE_IDS(); phase_gla_g0(ws, lh, lds, tid, Gp, bxp); } } SEAM(pb + 2);
            if (EN(8) && IN(pb + 3)) DUP(8) { PHASE_IDS(); phase_gla_g12(ws, lds, gw, wave, lane); } SEAM(pb + 3);
            if (EN(8) && IN(pb + 4)) DUP(9) { PHASE_IDS(); phase_gla_g3(ws, lh, lds, tid); } SEAM(pb + 4);
        }
        if (EN(9) && IN(pb + 5)) {
            PHASE_IDS();
            const pg8::bf16_t* Wt = (layer & 1) ? (const pg8::bf16_t*)(ws + WS_WOG) + (size_t)lh * 1024 * 1024 : (const pg8::bf16_t*)(ws + WS_WOA) + (size_t)lh * 1024 * 1024;
            pg8::Gemm g{(const pg8::bf16_t*)(ws + ((layer & 1) ? WS_Q : WS_XN)), Wt, MT, 1024, 1024, 0};
            pg8::StaticOrder S; if (layer == NLAYER - 1) S.init(NB * SEQ, 1024, Gp, bxp, true); else S.init(MT, 1024, Gp, bxp);
            pg8::EpiResGate E{(pg8::bf16_t*)(ws + WS_X), (const float*)(ws + WS_MOD) + (size_t)layer * MODROWS * NMODC + 2 * 1024};
            pg8::gemm_phase<pg8::EpiResGate, pg8::StaticOrder, true, true>(lds + RING_OFF, g, S, E, tid);
        } SEAM(pb + 5);
        if (EN(10) && IN(pb + 6)) { if ((DUPMASK >> 10) & 1) { PHASE_IDS(); phase_modulate2_route(ws, layer, lds, vcu, wave, lane, tid, true); __syncthreads(); } PHASE_IDS(); phase_modulate2_route(ws, layer, lds, vcu, wave, lane, tid); } SEAM(pb + 6);
        if (EN(12) && IN(pb + 8)) DUP(12) {
            PHASE_IDS();
            build_expert_tables(ws, layer, lds, tid);
            const int nT = __builtin_amdgcn_readfirstlane(((const LAS int*)(lds + AUX_NT))[0]);
            pg8::MoeOrder S{nT, 8, Gp, bxp, (const LAS int*)(lds + AUX_T2E)};
            LAS unsigned short* rowtab = (LAS unsigned short*)(lds + AUX_ROWTAB);
            { const LAS int* base = (const LAS int*)(lds + AUX_BASE); const LAS int* cntl = (const LAS int*)(lds + AUX_CNT); const int* LIST = (const int*)(ws + WS_LIST);
              pg8::Unit u;
              for (int i = 0; i < ROWTAB_UNITS && S.next(i, u); ++i) if (tid < 256) { const int pos = (u.pm - (base[u.e] >> 8)) * 256 + tid; rowtab[i * 256 + tid] = (unsigned short)((pos < cntl[u.e]) ? LIST[(size_t)u.e * MT + pos] : 0); }
              __syncthreads(); }
            pg8::Gemm g{(const pg8::bf16_t*)(ws + WS_XN8), (const pg8::bf16_t*)(ws + WS_WGU + (size_t)layer * 32 * 2048 * 1024), MPAD, 2048, 512, (size_t)2048 * 1024, rowtab};
            pg8::EpiSwiGLU8 E{ws + WS_ACT, PARF(ws) + P_BGU + (size_t)layer * 32 * 2048, 1.0f / 32.0f};
            pg8::gemm_phase<pg8::EpiSwiGLU8, pg8::MoeOrder, true, true, true, true>(lds + RING_OFF, g, S, E, tid);
        } SEAM(pb + 8);
        if (EN(13) && IN(pb + 9)) DUP(13) {
            PHASE_IDS();
            build_expert_tables(ws, layer, lds, tid);
            const int nT = __builtin_amdgcn_readfirstlane(((const LAS int*)(lds + AUX_NT))[0]);
            pg8::Gemm g{(const pg8::bf16_t*)(ws + WS_ACT), (const pg8::bf16_t*)(ws + WS_WDN + (size_t)layer * 32 * 1024 * 1024), MPAD, 1024, 512, (size_t)1024 * 1024};
            pg8::MoeOrder S{nT, 4, Gp, bxp, (const LAS int*)(lds + AUX_T2E)};
            pg8::EpiBiasF8 E{ws + WS_Y, PARF(ws) + P_BDN + (size_t)layer * 32 * 1024, 1.0f / 32.0f};
            pg8::gemm_phase<pg8::EpiBiasF8, pg8::MoeOrder, true, true, false, true>(lds + RING_OFF, g, S, E, tid);
        } SEAM(pb + 9);
        if (EN(14) && IN(pb + 10)) { if ((DUPMASK >> 14) & 1) { PHASE_IDS(); phase_moe_combine(ws, args.out, layer, lds, gw, NGW, lane, tid, true); } PHASE_IDS(); phase_moe_combine(ws, args.out, layer, lds, gw, NGW, lane, tid); } SEAM(pb + 10);
    }
#undef IN
#undef EN
#undef DUP
#undef SEAM
#undef PHASE_IDS
#undef LANE_ID
}

extern "C" void kernel_launch(void* const* d_in, const int* in_sizes, int n_in, void* d_out, int out_size, void* d_ws, size_t ws_size, hipStream_t stream) {
    static int grid = 0;
    if (grid == 0) {
        if (n_in != 25 || out_size != NB * SEQ * DMODEL || ws_size < WS_END) { fprintf(stderr, "kernel_launch: unexpected shapes: n_in %d out %d ws %zu (need >= %zu)\n", n_in, out_size, ws_size, (size_t)WS_END); grid = -1; return; }
        int dev = 0, cus = 0, per_cu = 0;
        if (hipGetDevice(&dev) != hipSuccess || hipDeviceGetAttribute(&cus, hipDeviceAttributeMultiprocessorCount, dev) != hipSuccess) { grid = -1; return; }
        if (hipFuncSetAttribute((const void*)dit_fwd, hipFuncAttributeMaxDynamicSharedMemorySize, LDS_BYTES) != hipSuccess) { fprintf(stderr, "kernel_launch: hipFuncSetAttribute failed\n"); grid = -1; return; }
        if (hipOccupancyMaxActiveBlocksPerMultiprocessor(&per_cu, (const void*)dit_fwd, NWAVES * 64, LDS_BYTES) != hipSuccess || per_cu < 1) fprintf(stderr, "kernel_launch: occupancy query reports %d\n", per_cu);
        (void)hipGetLastError();
        grid = cus;
    }
    if (grid < 0) return;
    if (hipMemsetAsync((char*)d_ws + WS_CTL, 0, CTL_ZERO_BYTES, stream) != hipSuccess) { fprintf(stderr, "kernel_launch: memset failed\n"); return; }
    Args a{};
    for (int i = 0; i < 25; ++i) a.in[i] = (const float*)d_in[i];
    a.out = (float*)d_out; a.ws = (unsigned char*)d_ws;
#if MK_ONE_LAUNCH
    a.ph_lo = 0; a.ph_hi = NPHASE;
    hipLaunchKernelGGL(dit_fwd, dim3(grid), dim3(NWAVES * 64), LDS_BYTES, stream, a);
#else
    for (int p = 0; p < NPHASE; ++p) { a.ph_lo = p; a.ph_hi = p + 1; hipLaunchKernelGGL(dit_fwd, dim3(grid), dim3(NWAVES * 64), LDS_BYTES, stream, a); }
#endif
    const hipError_t le = hipPeekAtLastError();
    if (le != hipSuccess) fprintf(stderr, "kernel_launch: launch failed: %s\n", hipGetErrorName(le));
}
```

```cpp
#include <hip/hip_runtime.h>
#include <hip/hip_bf16.h>
#include <cstdio>
#include <cstdint>
#include <cmath>

#ifndef MK_ONE_LAUNCH
#define MK_ONE_LAUNCH 1
#endif

namespace pg8 {
#define PG8_LAS __attribute__((address_space(3)))
typedef unsigned short bf16_t;
typedef short bf16x8 __attribute__((ext_vector_type(8)));
typedef float f32x4 __attribute__((ext_vector_type(4)));
typedef unsigned u32x4 __attribute__((ext_vector_type(4)));
constexpr int BM = 256, BK = 64, HALF = 128, HTB = HALF * BK * 2  , STAGE_BYTES = 8 * HTB, NXCD = 8, WGM = 8;

__host__ __device__ __forceinline__ int lds_byte(int r, int c) { const int st = (r >> 4) * 2 + (c >> 5), rr = r & 15, cc = c & 31, ob = rr * 64 + cc * 2; return st * 1024 + (ob ^ (((ob >> 9) & 1) << 5)); }
__host__ __device__ __forceinline__ void stage_rc(int b, int& R, int& C) { const int st = b / 1024, sb = b % 1024, swz = sb ^ (((sb >> 9) & 1) << 5); R = (st >> 1) * 16 + swz / 64; C = (st & 1) * 32 + (swz % 64) / 2; }
__host__ __device__ __forceinline__ int perm32(int rho) { const int n = rho >> 4, i = rho & 15; return 8 * (i >> 2) + 4 * n + (i & 3); }

struct Unit { int pm, pn, e; };
struct Gemm { const bf16_t* A; const bf16_t* Bt; int M, N, K; size_t bstride; const PG8_LAS unsigned short* rowtab; };

struct StaticOrder {
    int nM, nN, nwg, G, c; bool latent_only;
    __host__ __device__ __forceinline__ void init(int M, int N, int G_, int c_, bool lat_ = false) { nM = M / BM; nN = N / BM; nwg = nM * nN; G = G_; c = c_; latent_only = lat_; }
    __host__ __device__ __forceinline__ bool next(int i, Unit& u) const {
        const long L = (long)i * G + c; if (L >= nwg) return false;
        int wgid = (int)L; { const int q = nwg / NXCD, r = nwg % NXCD, xcd = wgid % NXCD, off = wgid / NXCD; wgid = (xcd < r ? xcd * (q + 1) : r * (q + 1) + (xcd - r) * q) + off; }
        const int nig = WGM * nN, gid = wgid / nig, fm = gid * WGM, gsz = (nM - fm) < WGM ? (nM - fm) : WGM;
        u.pm = fm + ((wgid % nig) % gsz); u.pn = (wgid % nig) / gsz; u.e = 0;
        if (latent_only) u.pm = (u.pm >> 4) * 17 + 1 + (u.pm & 15);
        return true;
    }
    __device__ __forceinline__ void a_ready(const Unit&) const {}
    __device__ __forceinline__ void done(const Unit&) const {}
};
struct MoeOrder {
    int nT, nN, G, c; const PG8_LAS int* t2e;
    __device__ __forceinline__ bool next(int i, Unit& u) const {
        const int x = c & 7, j = c >> 3, per = 32 / nN, mt = (i * (G >> 5) + x) * per + j / nN; if (mt >= nT) return false;
        u.pm = mt; u.pn = j % nN; u.e = __builtin_amdgcn_readfirstlane(t2e[mt]); return true;
    }
    __device__ __forceinline__ void a_ready(const Unit&) const {}
    __device__ __forceinline__ void done(const Unit&) const {}
};

__device__ __forceinline__ int lane_now() { unsigned z; asm volatile("s_mov_b32 %0, 0" : "=s"(z)); return (int)__builtin_amdgcn_mbcnt_hi(~0u, __builtin_amdgcn_mbcnt_lo(~0u, z)); }
__device__ __forceinline__ float shx(float v, int m, int ln) { return __int_as_float(__builtin_amdgcn_ds_bpermute((ln ^ m) << 2, __float_as_int(v))); }
__device__ __forceinline__ unsigned pk4_fp8(float a, float b, float c, float d) { int w = 0; w = __builtin_amdgcn_cvt_pk_fp8_f32(a, b, w, false); w = __builtin_amdgcn_cvt_pk_fp8_f32(c, d, w, true); return (unsigned)w; }
__device__ __forceinline__ unsigned cvt_pk_bf16(float lo, float hi) { unsigned r; asm volatile("v_cvt_pk_bf16_f32 %0, %1, %2" : "=v"(r) : "v"(lo), "v"(hi)); return r; }

struct EpiBf16 {
    static constexpr bool PERM = true, AFTER_DRAIN = false;
    bf16_t* O; int ldc;
    __device__ __forceinline__ void operator()(const f32x4 (&acc)[2][2][4][2], const Unit& u, int wr, int wc, int fr, int fq) const {
        const int row0 = u.pm * BM + wr * 64 + fr; const int col0 = u.pn * BM + wc * 32 + 8 * fq;
#pragma unroll
        for (int ai = 0; ai < 2; ++ai)
#pragma unroll
            for (int m = 0; m < 4; ++m) { bf16_t* rowp = O + (size_t)(row0 + ai * HALF + m * 16) * ldc + col0;
#pragma unroll
                for (int bj = 0; bj < 2; ++bj) { const f32x4 v0 = acc[ai][bj][m][0], v1 = acc[ai][bj][m][1];
                    u32x4 w; w.x = cvt_pk_bf16(v0[0], v0[1]); w.y = cvt_pk_bf16(v0[2], v0[3]); w.z = cvt_pk_bf16(v1[0], v1[1]); w.w = cvt_pk_bf16(v1[2], v1[3]);
                    *(u32x4*)(rowp + bj * HALF) = w; } }
    }
};
struct EpiQKV {
    static constexpr bool PERM = true, AFTER_DRAIN = false;
    unsigned char* wsb; size_t offQ, dK, dV;
    const PG8_LAS float* gl; const float* ropec; float c2;
    __device__ __forceinline__ void operator()(const f32x4 (&acc)[2][2][4][2], const Unit& u, int wr, int wc, int fr, int fq) const {
        const int isk = (u.pn >= 4) ? 1 : 0, isv = (u.pn >= 5) ? 1 : 0;
        bf16_t* base = (bf16_t*)(wsb + offQ + (size_t)isk * dK + (size_t)isv * dV); const int ldc = isk ? 256 : 1024;
        const int hcol = (isk ? wc : (u.pn * 4 + wc)) * 64 + 8 * fq;
        const int pmb = u.pm / 17, pml = u.pm - pmb * 17; const bool lat = pml != 0;
        const PG8_LAS float* gp = gl + (isk ? 64 : 0) + 8 * fq; const float scl = isk ? 1.0f : c2;
#pragma unroll
        for (int ai = 0; ai < 2; ++ai)
#pragma unroll
            for (int m = 0; m < 4; ++m) { const int rl = ai * HALF + wr * 64 + m * 16 + fr; const size_t row = (size_t)u.pm * BM + rl;
                f32x4 v[2][2]; float ss = 0.f;
#pragma unroll
                for (int bj = 0; bj < 2; ++bj)
#pragma unroll
                    for (int n = 0; n < 2; ++n) { v[bj][n] = acc[ai][bj][m][n]; ss += (v[bj][n][0] * v[bj][n][0] + v[bj][n][1] * v[bj][n][1]) + (v[bj][n][2] * v[bj][n][2] + v[bj][n][3] * v[bj][n][3]); }
                if (!isv) { const int ln = lane_now(); ss += shx(ss, 16, ln); ss += shx(ss, 32, ln);
                    const float rs = 1.0f / sqrtf(ss * (1.0f / 64.0f) + 1e-6f);
                    const int spos = (pml - 1) * 256 + rl;
#pragma unroll
                    for (int bj = 0; bj < 2; ++bj) { f32x4 cs = (f32x4){1.f, 1.f, 1.f, 1.f}, sn = (f32x4){0.f, 0.f, 0.f, 0.f};
                        if (lat) { const float* cp = ropec + (size_t)spos * 32 + 16 * bj + 4 * fq; cs = *(const f32x4*)cp; sn = *(const f32x4*)(cp + 4096 * 32); }
#pragma unroll
                        for (int n = 0; n < 2; ++n) { const f32x4 y = v[bj][n] * rs * *(const PG8_LAS f32x4*)(gp + 32 * bj + 4 * n);
                            const float c0 = cs[2 * n], s0 = sn[2 * n], c1 = cs[2 * n + 1], s1 = sn[2 * n + 1];
                            v[bj][n] = (f32x4){(y[0] * c0 - y[1] * s0) * scl, (y[0] * s0 + y[1] * c0) * scl, (y[2] * c1 - y[3] * s1) * scl, (y[2] * s1 + y[3] * c1) * scl}; } } }
                bf16_t* rowp = base + row * ldc + hcol;
#pragma unroll
                for (int bj = 0; bj < 2; ++bj) { u32x4 w; w.x = cvt_pk_bf16(v[bj][0][0], v[bj][0][1]); w.y = cvt_pk_bf16(v[bj][0][2], v[bj][0][3]); w.z = cvt_pk_bf16(v[bj][1][0], v[bj][1][1]); w.w = cvt_pk_bf16(v[bj][1][2], v[bj][1][3]);
                    *(u32x4*)(rowp + 32 * bj) = w; } }
    }
};
struct EpiBiasF8 {
    static constexpr bool PERM = true, AFTER_DRAIN = false;
    unsigned char* O; const float* bias; float ascale;
    __device__ __forceinline__ void operator()(const f32x4 (&acc)[2][2][4][2], const Unit& u, int wr, int wc, int fr, int fq) const {
        const int row0 = u.pm * BM + wr * 64 + fr; const int col0 = u.pn * BM + wc * 32 + 8 * fq;
        const float* bp = bias + (size_t)u.e * 1024 + col0;
        f32x4 bv[2][2];
#pragma unroll
        for (int bj = 0; bj < 2; ++bj)
#pragma unroll
            for (int n = 0; n < 2; ++n) bv[bj][n] = *(const f32x4*)(bp + bj * HALF + 4 * n);
#pragma unroll
        for (int ai = 0; ai < 2; ++ai)
#pragma unroll
            for (int m = 0; m < 4; ++m) { unsigned char* rowp = O + (size_t)(row0 + ai * HALF + m * 16) * 1024 + col0;
#pragma unroll
                for (int bj = 0; bj < 2; ++bj) { const f32x4 v0 = acc[ai][bj][m][0] * ascale + bv[bj][0], v1 = acc[ai][bj][m][1] * ascale + bv[bj][1];
                    *(unsigned long long*)(rowp + bj * HALF) = (unsigned long long)pk4_fp8(v0[0], v0[1], v0[2], v0[3]) | ((unsigned long long)pk4_fp8(v1[0], v1[1], v1[2], v1[3]) << 32); } }
    }
};
struct EpiResGate {
    static constexpr bool PERM = false, AFTER_DRAIN = false;
    bf16_t* X; const float* gate;
    __device__ __forceinline__ void operator()(const f32x4 (&acc)[2][2][4][2], const Unit& u, int wr, int wc, int fr, int fq) const {
        const int row0 = u.pm * BM + wr * 64 + fr; const int col0 = u.pn * BM + wc * 32 + 4 * fq;
        const int bb = u.pm / 17, mr = (u.pm - bb * 17 == 0) ? 8 : bb;
        const float* gp = gate + (size_t)mr * 6144 + col0;
        f32x4 gv[2][2];
#pragma unroll
        for (int bj = 0; bj < 2; ++bj)
#pragma unroll
            for (int n = 0; n < 2; ++n) gv[bj][n] = *(const f32x4*)(gp + bj * HALF + n * 16);
#pragma unroll
        for (int ai = 0; ai < 2; ++ai)
#pragma unroll
            for (int m = 0; m < 4; ++m) { bf16_t* rowp = X + (size_t)(row0 + ai * HALF + m * 16) * 1024 + col0;
#pragma unroll
                for (int bj = 0; bj < 2; ++bj)
#pragma unroll
                    for (int n = 0; n < 2; ++n) { unsigned long long* p = (unsigned long long*)(rowp + bj * HALF + n * 16); const unsigned long long v = *p;
                        f32x4 x = (f32x4){__uint_as_float((unsigned)(v & 0xffffu) << 16), __uint_as_float((unsigned)(v >> 16) << 16), __uint_as_float((unsigned)((v >> 32) & 0xffffu) << 16), __uint_as_float((unsigned)(v >> 48) << 16)};
                        x = x + gv[bj][n] * acc[ai][bj][m][n];
                        *p = (unsigned long long)cvt_pk_bf16(x[0], x[1]) | ((unsigned long long)cvt_pk_bf16(x[2], x[3]) << 32); } }
    }
};
struct EpiSwiGLU {
    static constexpr bool PERM = true, AFTER_DRAIN = false;
    bf16_t* O; const float* bias;
    __device__ __forceinline__ void operator()(const f32x4 (&acc)[2][2][4][2], const Unit& u, int wr, int wc, int fr, int fq) const {
        const int row0 = u.pm * BM + wr * 64 + fr; const int col0 = u.pn * HALF + wc * 32 + 8 * fq;
        const float* bp = bias + (size_t)u.e * 2048 + col0;
        f32x4 bg[2], bu[2];
#pragma unroll
        for (int n = 0; n < 2; ++n) { bg[n] = *(const f32x4*)(bp + 4 * n); bu[n] = *(const f32x4*)(bp + 1024 + 4 * n); }
#pragma unroll
        for (int ai = 0; ai < 2; ++ai)
#pragma unroll
            for (int m = 0; m < 4; ++m) { bf16_t* rowp = O + (size_t)(row0 + ai * HALF + m * 16) * 1024 + col0;
                float r[8];
#pragma unroll
                for (int n = 0; n < 2; ++n) { const f32x4 gt = acc[ai][0][m][n] + bg[n], up = acc[ai][1][m][n] + bu[n];
#pragma unroll
                    for (int i = 0; i < 4; ++i) { const float g = fminf(gt[i], 7.0f), uu = fminf(fmaxf(up[i], -7.0f), 7.0f);
                        const float sg = __builtin_amdgcn_rcpf(1.0f + __builtin_amdgcn_exp2f(-1.702f * 1.4426950408889634f * g));
                        r[4 * n + i] = (uu + 1.0f) * (g * sg); } }
                u32x4 w; w.x = cvt_pk_bf16(r[0], r[1]); w.y = cvt_pk_bf16(r[2], r[3]); w.z = cvt_pk_bf16(r[4], r[5]); w.w = cvt_pk_bf16(r[6], r[7]);
                *(u32x4*)rowp = w; }
    }
};
struct EpiSwiGLU8 {
    static constexpr bool PERM = true, AFTER_DRAIN = false;
    unsigned char* O; const float* bias; float ascale;
    __device__ __forceinline__ void operator()(const f32x4 (&acc)[2][2][4][2], const Unit& u, int wr, int wc, int fr, int fq) const {
        const int row0 = u.pm * BM + wr * 64 + fr; const int col0 = u.pn * HALF + wc * 32 + 8 * fq;
        const float* bp = bias + (size_t)u.e * 2048 + col0;
        f32x4 bg[2], bu[2];
#pragma unroll
        for (int n = 0; n < 2; ++n) { bg[n] = *(const f32x4*)(bp + 4 * n); bu[n] = *(const f32x4*)(bp + 1024 + 4 * n); }
#pragma unroll
        for (int ai = 0; ai < 2; ++ai)
#pragma unroll
            for (int m = 0; m < 4; ++m) { unsigned char* rowp = O + (size_t)(row0 + ai * HALF + m * 16) * 1024 + col0;
                float r[8];
#pragma unroll
                for (int n = 0; n < 2; ++n) { const f32x4 gt = acc[ai][0][m][n] * ascale + bg[n], up = acc[ai][1][m][n] * ascale + bu[n];
#pragma unroll
                    for (int i = 0; i < 4; ++i) { const float g = fminf(gt[i], 7.0f), uu = fminf(fmaxf(up[i], -7.0f), 7.0f);
                        const float sg = __builtin_amdgcn_rcpf(1.0f + __builtin_amdgcn_exp2f(-1.702f * 1.4426950408889634f * g));
                        r[4 * n + i] = (uu + 1.0f) * (g * sg); } }
                *(unsigned long long*)rowp = (unsigned long long)pk4_fp8(r[0], r[1], r[2], r[3]) | ((unsigned long long)pk4_fp8(r[4], r[5], r[6], r[7]) << 32); }
    }
};
struct EpiBiasBf16 {
    static constexpr bool PERM = true, AFTER_DRAIN = false;
    bf16_t* O; const float* bias; float ascale;
    __device__ __forceinline__ void operator()(const f32x4 (&acc)[2][2][4][2], const Unit& u, int wr, int wc, int fr, int fq) const {
        const int row0 = u.pm * BM + wr * 64 + fr; const int col0 = u.pn * BM + wc * 32 + 8 * fq;
        const float* bp = bias + (size_t)u.e * 1024 + col0;
        f32x4 bv[2][2];
#pragma unroll
        for (int bj = 0; bj < 2; ++bj)
#pragma unroll
            for (int n = 0; n < 2; ++n) bv[bj][n] = *(const f32x4*)(bp + bj * HALF + 4 * n);
#pragma unroll
        for (int ai = 0; ai < 2; ++ai)
#pragma unroll
            for (int m = 0; m < 4; ++m) { bf16_t* rowp = O + (size_t)(row0 + ai * HALF + m * 16) * 1024 + col0;
#pragma unroll
                for (int bj = 0; bj < 2; ++bj) { const f32x4 v0 = acc[ai][bj][m][0] * ascale + bv[bj][0], v1 = acc[ai][bj][m][1] * ascale + bv[bj][1];
                    u32x4 w; w.x = cvt_pk_bf16(v0[0], v0[1]); w.y = cvt_pk_bf16(v0[2], v0[3]); w.z = cvt_pk_bf16(v1[0], v1[1]); w.w = cvt_pk_bf16(v1[2], v1[3]);
                    *(u32x4*)(rowp + bj * HALF) = w; } }
    }
};

template <class Epi, class Sched, bool ALIGN_EPI = false, bool SP2 = false, bool GATHER = false, bool F8 = false>
__device__ __forceinline__ void gemm_phase(PG8_LAS unsigned char* lds, const Gemm g, const Sched& S, const Epi& E, int tid_in) {
    int tid_l = tid_in; asm volatile("" : "+v"(tid_l));
    const int tid = tid_l, wid = __builtin_amdgcn_readfirstlane(tid >> 6), lane = tid & 63, wr = wid >> 2, wc = wid & 3, fr = lane & 15, fq = lane >> 4;
    const int K = g.K, nt = K / BK;
    unsigned voffA[2], voffB[2];
#pragma unroll
    for (int i = 0; i < 2; ++i) { int R, C; stage_rc(tid * 16 + i * 8192, R, C); const int Rb = Epi::PERM ? ((R & ~31) + perm32(R & 31)) : R;
        voffA[i] = (unsigned)(R * K + C) * 2u; voffB[i] = (unsigned)(Rb * K + C) * 2u; }
    const size_t kstep = (size_t)(BK * 2);
    static_assert(!GATHER || SP2, "GATHER is wired into the SP2 loop only");
    unsigned vAc0[2], vAc1[2], vAn0[2], vAn1[2]; int gR[2]; unsigned gC[2];
#pragma unroll
    for (int i = 0; i < 2; ++i) { int R, C; stage_rc(tid * 16 + i * 8192, R, C); gR[i] = R; gC[i] = (unsigned)C * 2u; vAc0[i] = voffA[i]; vAc1[i] = voffA[i]; vAn0[i] = voffA[i]; vAn1[i] = voffA[i]; }
#define PG8_GFETCH(d0, d1, ord) do { if constexpr (GATHER) { _Pragma("unroll") for (int _i = 0; _i < 2; ++_i) { \
        d0[_i] = (unsigned)g.rowtab[(ord) * 256 + gR[_i]] * (unsigned)(K * 2) + gC[_i]; d1[_i] = (unsigned)g.rowtab[(ord) * 256 + 128 + gR[_i]] * (unsigned)(K * 2) + gC[_i]; } } } while (0)
    const size_t hstep = (size_t)HALF * K * 2;
    const size_t hstepA = GATHER ? 0 : hstep;
    const size_t tstep = 2 * hstep;
    const unsigned ldsw = (unsigned)wid * 1024u;
    const int aoff = lds_byte(wr * 64 + fr, fq * 8), boff = lds_byte(wc * 32 + fr, fq * 8);
    typedef int v8i_t __attribute__((ext_vector_type(8))); typedef short v16s_a16 __attribute__((ext_vector_type(16), aligned(16)));
    const int f8c = 32 * (fq >> 1) + 16 * (fq & 1);
    const int aoff8a = lds_byte(wr * 64 + fr, f8c), boff8a = lds_byte(wc * 32 + fr, f8c);
    v8i_t At8[4], Au8[4], B08[2], B18[2]; int f8scale = 127; asm volatile("" : "+v"(f8scale));
#define PG8_SA(b, h) (((b) * 2 + (h)) * HTB)
#define PG8_SB(b, h) ((4 + (b) * 2 + (h)) * HTB)
#define PG8_STAGE(bufoff, gbase, voff) do { _Pragma("unroll") for (int _i = 0; _i < 2; ++_i) \
        __builtin_amdgcn_global_load_lds((const unsigned*)((const char*)(gbase) + (voff)[_i]), (PG8_LAS unsigned*)(lds + (bufoff) + ldsw + _i * 8192), 16, 0, 0); } while (0)
#define PG8_LDA(dst, b, h) do { if constexpr (F8) { _Pragma("unroll") for (int m = 0; m < 4; ++m) { const bf16x8 lo_ = *(const PG8_LAS bf16x8*)(lds + PG8_SA(b, h) + aoff8a + m * 2048), hi_ = *(const PG8_LAS bf16x8*)(lds + PG8_SA(b, h) + aoff8a + m * 2048 + 16); dst##8[m] = __builtin_bit_cast(v8i_t, __builtin_shufflevector(lo_, hi_, 0, 1, 2, 3, 4, 5, 6, 7, 8, 9, 10, 11, 12, 13, 14, 15)); } } \
        else { _Pragma("unroll") for (int m = 0; m < 4; ++m) _Pragma("unroll") for (int k = 0; k < 2; ++k) dst[m][k] = *(const PG8_LAS bf16x8*)(lds + PG8_SA(b, h) + aoff + m * 2048 + k * 1024); } } while (0)
#define PG8_LDB(dst, b, h) do { if constexpr (F8) { _Pragma("unroll") for (int n = 0; n < 2; ++n) { const bf16x8 lo_ = *(const PG8_LAS bf16x8*)(lds + PG8_SB(b, h) + boff8a + n * 2048), hi_ = *(const PG8_LAS bf16x8*)(lds + PG8_SB(b, h) + boff8a + n * 2048 + 16); dst##8[n] = __builtin_bit_cast(v8i_t, __builtin_shufflevector(lo_, hi_, 0, 1, 2, 3, 4, 5, 6, 7, 8, 9, 10, 11, 12, 13, 14, 15)); } } \
        else { _Pragma("unroll") for (int n = 0; n < 2; ++n) _Pragma("unroll") for (int k = 0; k < 2; ++k) dst[n][k] = *(const PG8_LAS bf16x8*)(lds + PG8_SB(b, h) + boff + n * 2048 + k * 1024); } } while (0)
#define PG8_MMA(ai, bj, At, Bt) do { __builtin_amdgcn_s_setprio(1); if constexpr (F8) { _Pragma("unroll") for (int m = 0; m < 4; ++m) _Pragma("unroll") for (int n = 0; n < 2; ++n) \
            asm volatile("v_mfma_scale_f32_16x16x128_f8f6f4 %0, %1, %2, %0, %3, %3 op_sel_hi:[0,0,0]" : "+v"(acc[ai][bj][m][n]) : "v"(Bt##8[n]), "v"(At##8[m]), "v"(f8scale)); } \
        else { _Pragma("unroll") for (int m = 0; m < 4; ++m) _Pragma("unroll") for (int n = 0; n < 2; ++n) _Pragma("unroll") for (int k = 0; k < 2; ++k) \
        acc[ai][bj][m][n] = __builtin_amdgcn_mfma_f32_16x16x32_bf16(Bt[n][k], At[m][k], acc[ai][bj][m][n], 0, 0, 0); } __builtin_amdgcn_s_setprio(0); } while (0)
#define PG8_WAIT_V(n) asm volatile("s_waitcnt vmcnt(" #n ")" ::: "memory")
#define PG8_WAIT_L(n) asm volatile("s_waitcnt lgkmcnt(" #n ")" ::: "memory")
#define PG8_BAR __builtin_amdgcn_s_barrier()
#define PG8_SCHED __builtin_amdgcn_sched_barrier(0)
    Unit cur, nxt; int ui = 0;
    if (!S.next(0, cur)) return;
    f32x4 acc[2][2][4][2];
#pragma unroll
    for (int a = 0; a < 2; ++a)
#pragma unroll
        for (int b = 0; b < 2; ++b)
#pragma unroll
            for (int m = 0; m < 4; ++m)
#pragma unroll
                for (int n = 0; n < 2; ++n) acc[a][b][m][n] = (f32x4){0.f, 0.f, 0.f, 0.f};
    bf16x8 At[4][2], Au[4][2], B0[2][2], B1[2][2];
    const char* cA = (const char*)g.A + (GATHER ? (size_t)0 : (size_t)cur.pm * tstep); PG8_GFETCH(vAc0, vAc1, 0); const char* cB = (const char*)g.Bt + (size_t)cur.e * g.bstride + (size_t)cur.pn * tstep;
    S.a_ready(cur);
    if constexpr (SP2) {
        PG8_STAGE(PG8_SB(0, 0), cB, voffB); PG8_STAGE(PG8_SB(0, 1), cB + hstep, voffB); PG8_STAGE(PG8_SA(0, 0), cA, vAc0); PG8_STAGE(PG8_SA(0, 1), cA + hstepA, vAc1);
        if (wr == 1) PG8_BAR;
        PG8_WAIT_V(2); PG8_BAR;
        PG8_STAGE(PG8_SB(1, 0), cB + kstep, voffB); PG8_STAGE(PG8_SA(1, 0), cA + kstep, vAc0); PG8_STAGE(PG8_SB(1, 1), cB + hstep + kstep, voffB);
        PG8_WAIT_V(6); PG8_BAR;
    } else {
        PG8_STAGE(PG8_SB(0, 0), cB, voffB); PG8_STAGE(PG8_SA(0, 0), cA, voffA); PG8_STAGE(PG8_SB(0, 1), cB + hstep, voffB); PG8_STAGE(PG8_SA(0, 1), cA + hstep, voffA);
        if (wr == 1) PG8_BAR;
        PG8_WAIT_V(4); PG8_BAR;
        PG8_STAGE(PG8_SB(1, 0), cB + kstep, voffB); PG8_STAGE(PG8_SA(1, 0), cA + kstep, voffA); PG8_STAGE(PG8_SB(1, 1), cB + hstep + kstep, voffB);
        PG8_WAIT_V(6); PG8_BAR;
    }
    for (;;) {
        const bool has_next = S.next(ui + 1, nxt);
        const char* nA = (has_next && !GATHER) ? (const char*)g.A + (size_t)nxt.pm * tstep : cA;
        if constexpr (GATHER) { if (has_next) PG8_GFETCH(vAn0, vAn1, ui + 1); else { vAn0[0] = vAc0[0]; vAn0[1] = vAc0[1]; vAn1[0] = vAc1[0]; vAn1[1] = vAc1[1]; } }
        const char* nB = has_next ? (const char*)g.Bt + (size_t)nxt.e * g.bstride + (size_t)nxt.pn * tstep : cB;
#pragma unroll 1
        for (int t = 0; t < nt; t += 2) {
            const bool last = (t == nt - 2);
            const char* a1 = cA + (size_t)(t + 1) * kstep;
            const char* a2 = last ? nA : cA + (size_t)(t + 2) * kstep; const char* b2 = last ? nB : cB + (size_t)(t + 2) * kstep;
            const char* a3 = a2 + kstep; const char* b3 = b2 + kstep;
            if (last && has_next) S.a_ready(nxt);
            unsigned vS0[2], vS1[2];
            vS0[0] = last ? vAn0[0] : vAc0[0]; vS0[1] = last ? vAn0[1] : vAc0[1]; vS1[0] = last ? vAn1[0] : vAc1[0]; vS1[1] = last ? vAn1[1] : vAc1[1];
            if constexpr (SP2) {
            PG8_LDB(B0, 0, 0); PG8_LDB(B1, 0, 1); PG8_SCHED; PG8_LDA(At, 0, 0); PG8_STAGE(PG8_SA(1, 1), a1 + hstepA, vAc1);
            PG8_WAIT_V(8); PG8_WAIT_L(0); PG8_BAR; PG8_MMA(0, 0, At, B0); PG8_MMA(0, 1, At, B1); PG8_BAR; PG8_SCHED;
            if constexpr (F8) { PG8_LDA(Au, 0, 1); } else { PG8_LDA(At, 0, 1); } PG8_STAGE(PG8_SB(0, 0), b2, voffB); PG8_STAGE(PG8_SB(0, 1), b2 + hstep, voffB); PG8_STAGE(PG8_SA(0, 0), a2, vS0);
            PG8_WAIT_V(8); PG8_WAIT_L(0); PG8_BAR; if constexpr (F8) { PG8_MMA(1, 0, Au, B0); PG8_MMA(1, 1, Au, B1); } else { PG8_MMA(1, 0, At, B0); PG8_MMA(1, 1, At, B1); } PG8_BAR; PG8_SCHED;
            PG8_LDB(B0, 1, 0); PG8_LDB(B1, 1, 1); PG8_SCHED; PG8_LDA(At, 1, 0); PG8_STAGE(PG8_SA(0, 1), a2 + hstepA, vS1);
            PG8_WAIT_V(8); PG8_WAIT_L(0); PG8_BAR; PG8_MMA(0, 0, At, B0); PG8_MMA(0, 1, At, B1); PG8_BAR; PG8_SCHED;
            if constexpr (F8) { PG8_LDA(Au, 1, 1); } else { PG8_LDA(At, 1, 1); } PG8_STAGE(PG8_SB(1, 0), b3, voffB); PG8_STAGE(PG8_SB(1, 1), b3 + hstep, voffB); PG8_STAGE(PG8_SA(1, 0), a3, vS0);
            PG8_WAIT_V(8); PG8_WAIT_L(0); PG8_BAR; if constexpr (F8) { PG8_MMA(1, 0, Au, B0); PG8_MMA(1, 1, Au, B1); } else { PG8_MMA(1, 0, At, B0); PG8_MMA(1, 1, At, B1); } PG8_BAR; PG8_SCHED;
            } else {
            PG8_LDB(B0, 0, 0); PG8_SCHED; PG8_LDA(At, 0, 0); PG8_STAGE(PG8_SA(1, 1), a1 + hstep, voffA);
            PG8_WAIT_L(8); PG8_BAR; PG8_WAIT_L(0); PG8_MMA(0, 0, At, B0); PG8_BAR; PG8_SCHED;
            PG8_LDB(B1, 0, 1); PG8_STAGE(PG8_SB(0, 0), b2, voffB);
            PG8_BAR; PG8_WAIT_L(0); PG8_MMA(0, 1, At, B1); PG8_BAR;
            PG8_LDA(At, 0, 1); PG8_STAGE(PG8_SA(0, 0), a2, voffA);
            PG8_BAR; PG8_WAIT_L(0); PG8_MMA(1, 0, At, B0); PG8_BAR; PG8_SCHED;
            PG8_STAGE(PG8_SB(0, 1), b2 + hstep, voffB);
            PG8_WAIT_V(6); PG8_BAR; PG8_MMA(1, 1, At, B1); PG8_BAR;
            PG8_LDB(B0, 1, 0); PG8_SCHED; PG8_LDA(At, 1, 0); PG8_STAGE(PG8_SA(0, 1), a2 + hstep, voffA);
            PG8_WAIT_L(8); PG8_BAR; PG8_WAIT_L(0); PG8_MMA(0, 0, At, B0); PG8_BAR; PG8_SCHED;
            PG8_LDB(B1, 1, 1); PG8_STAGE(PG8_SB(1, 0), b3, voffB);
            PG8_BAR; PG8_WAIT_L(0); PG8_MMA(0, 1, At, B1); PG8_BAR;
            PG8_LDA(At, 1, 1); PG8_STAGE(PG8_SA(1, 0), a3, voffA);
            PG8_BAR; PG8_WAIT_L(0); PG8_MMA(1, 0, At, B0); PG8_BAR; PG8_SCHED;
            PG8_STAGE(PG8_SB(1, 1), b3 + hstep, voffB);
            PG8_WAIT_V(6); PG8_BAR; PG8_MMA(1, 1, At, B1); PG8_BAR;
            }
        }
        if constexpr (ALIGN_EPI) { if (wr == 0) PG8_BAR; }
        if constexpr (F8) asm volatile("s_nop 15\n\ts_nop 15" ::: "memory");
        if constexpr (!Epi::AFTER_DRAIN) { E(acc, cur, wr, wc, fr, fq); S.done(cur); }
        if (!has_next) break;
#pragma unroll
        for (int a = 0; a < 2; ++a)
#pragma unroll
            for (int b = 0; b < 2; ++b)
#pragma unroll
                for (int m = 0; m < 4; ++m)
#pragma unroll
                    for (int n = 0; n < 2; ++n) acc[a][b][m][n] = (f32x4){0.f, 0.f, 0.f, 0.f};
        cur = nxt; cA = nA; cB = nB; ++ui;
        if constexpr (GATHER) { vAc0[0] = vAn0[0]; vAc0[1] = vAn0[1]; vAc1[0] = vAn1[0]; vAc1[1] = vAn1[1]; }
        if constexpr (ALIGN_EPI) { if (wr == 1) PG8_BAR; }
    }
    PG8_WAIT_V(0);
    if constexpr (!ALIGN_EPI) { if (wr == 0) PG8_BAR; }
    PG8_BAR;
    if constexpr (Epi::AFTER_DRAIN) { E.fused(acc, cur, wr, wc, fr, fq, lds, wid, lane); S.done(cur); }
#undef PG8_SA
#undef PG8_SB
#undef PG8_STAGE
#undef PG8_LDA
#undef PG8_LDB
#undef PG8_MMA
#undef PG8_WAIT_V
#undef PG8_WAIT_L
#undef PG8_BAR
#undef PG8_SCHED
#undef PG8_GFETCH
}
}
#include <hip/hip_bf16.h>
#include <cmath>
namespace attn_body {
using bf16=__hip_bfloat16;
using bf16x8=__attribute__((ext_vector_type(8)))short;
using s16x4=__attribute__((ext_vector_type(4)))short;
using f32x16=__attribute__((ext_vector_type(16)))float;
using u32x4=__attribute__((ext_vector_type(4)))unsigned;
constexpr int D=64,DM=1024,KVP=256;
constexpr int NW=8,QBLK=32,QB=QBLK*NW,KVBLK=64;
__device__ __forceinline__ int crow(int r,int hi){return (r&3)+8*(r>>2)+4*hi;}
#define SBAR() __builtin_amdgcn_sched_barrier(0)
__device__ __forceinline__ void cmask(f32x16&p0,f32x16&p1,int jb,int qrel,int hi){
  const float NEG=-INFINITY; int kb=64*jb+4*hi;
  #pragma unroll
  for(int r=0;r<16;++r){int kv=kb+(r&3)+8*(r>>2); if(kv>qrel)p0[r]=NEG; if(kv+32>qrel)p1[r]=NEG;}
}

constexpr int NSLOT=3, SLOTB=8192;
constexpr int LDS_K=0, LDS_V=NSLOT*SLOTB, LDS_WS=2*NSLOT*SLOTB, LDS_OST=LDS_WS+NW*64*4, LDS_BYTES=LDS_OST+NW*4096;
constexpr float C2=0.125f*1.4426950408889634f;
__device__ __forceinline__ void glds16(const void*gsrc,unsigned lds_dst){unsigned keep;
  asm volatile("s_mov_b32 %0, m0\n\ts_mov_b32 m0, %2\n\ts_nop 0\n\tglobal_load_lds_dwordx4 %1, off\n\ts_mov_b32 m0, %0":"=&s"(keep):"v"(gsrc),"s"(lds_dst):"memory");}
__device__ __forceinline__ float max3f(float a,float b,float c){float r;asm("v_max3_f32 %0, %1, %2, %3":"=v"(r):"v"(a),"v"(b),"v"(c));return r;}
__device__ __forceinline__ float max2f(float a,float b){float r;asm("v_max_f32_e32 %0, %1, %2":"=v"(r):"v"(a),"v"(b));return r;}
__device__ __forceinline__ float fadd_s(float a,float b){float r;asm("v_add_f32_e32 %0, %1, %2":"=v"(r):"v"(a),"v"(b));return r;}
__device__ __forceinline__ float fsub_s(float a,float b){float r;asm("v_sub_f32_e32 %0, %1, %2":"=v"(r):"v"(a),"v"(b));return r;}
typedef float f32x2_t __attribute__((ext_vector_type(2))); typedef __bf16 bf16x2_t __attribute__((ext_vector_type(2)));
__device__ __forceinline__ unsigned cvtpk_s(float lo,float hi){f32x2_t v={lo,hi};bf16x2_t b=__builtin_convertvector(v,bf16x2_t);return __builtin_bit_cast(unsigned,b);}
#define WAIT_BAR(N) asm volatile("s_waitcnt vmcnt(" #N ") lgkmcnt(0)\n\ts_barrier":::"memory")

__device__ __forceinline__ void qkt(f32x16&p0,f32x16&p1,const char*Kslot,const bf16x8*qr,const f32x16&negm,int r32,int hi){
  const char*kb=Kslot+hi*1024+r32*16;
  #pragma unroll
  for(int d0=0;d0<4;++d0){
    const bf16x8 b0=*reinterpret_cast<const bf16x8*>(kb+d0*2048);
    const bf16x8 b1=*reinterpret_cast<const bf16x8*>(kb+d0*2048+512);
    if(d0==0){p0=__builtin_amdgcn_mfma_f32_32x32x16_bf16(b0,qr[0],negm,0,0,0);p1=__builtin_amdgcn_mfma_f32_32x32x16_bf16(b1,qr[0],negm,0,0,0);}
    else{p0=__builtin_amdgcn_mfma_f32_32x32x16_bf16(b0,qr[d0],p0,0,0,0);p1=__builtin_amdgcn_mfma_f32_32x32x16_bf16(b1,qr[d0],p1,0,0,0);}}
}
typedef __attribute__((address_space(3))) const char* lds_cptr;
typedef short v4i16_t __attribute__((ext_vector_type(4)));
__device__ __forceinline__ void kload8(bf16x8*kf,lds_cptr kp){
  kf[0]=*(const __attribute__((address_space(3))) bf16x8*)(kp);      kf[1]=*(const __attribute__((address_space(3))) bf16x8*)(kp+512);
  kf[2]=*(const __attribute__((address_space(3))) bf16x8*)(kp+2048); kf[3]=*(const __attribute__((address_space(3))) bf16x8*)(kp+2560);
  kf[4]=*(const __attribute__((address_space(3))) bf16x8*)(kp+4096); kf[5]=*(const __attribute__((address_space(3))) bf16x8*)(kp+4608);
  kf[6]=*(const __attribute__((address_space(3))) bf16x8*)(kp+6144); kf[7]=*(const __attribute__((address_space(3))) bf16x8*)(kp+6656);
}
__device__ __forceinline__ void kload2(bf16x8*kf,lds_cptr kp,int j){ kf[2*j]=*(const __attribute__((address_space(3))) bf16x8*)(kp+j*2048); kf[2*j+1]=*(const __attribute__((address_space(3))) bf16x8*)(kp+j*2048+512); }
__device__ __forceinline__ s16x4 vtr(lds_cptr p){ return __builtin_bit_cast(s16x4,__builtin_amdgcn_ds_read_tr16_b64_v4i16((__attribute__((address_space(3))) v4i16_t*)p)); }
__device__ __forceinline__ float rowmax(const f32x16&p0,const f32x16&p1){
  float a=max3f(p0[0],p0[1],p1[0]),b=max3f(p0[2],p0[3],p1[1]);a=max3f(a,p1[2],p1[3]);
  #pragma unroll
  for(int r=4;r<16;r+=4){a=max3f(a,p0[r],p0[r+1]);b=max3f(b,p0[r+2],p0[r+3]);a=max3f(a,p1[r],p1[r+1]);b=max3f(b,p1[r+2],p1[r+3]);}
  const float m=max2f(a,b);
  auto rr=__builtin_amdgcn_permlane32_swap(__float_as_uint(m),__float_as_uint(m),false,false);
  return max2f(__uint_as_float(rr[0]),__uint_as_float(rr[1]));
}
__device__ __forceinline__ void pv(f32x16*o,int vb,bf16x8 pa0,bf16x8 pa1,bf16x8 pa2,bf16x8 pa3){
  #pragma unroll
  for(int d0=0;d0<2;++d0){s16x4 lo[4],hi[4];
    #pragma unroll
    for(int ks=0;ks<4;++ks){
      asm volatile("ds_read_b64_tr_b16 %0,%1 offset:%c2":"=&v"(lo[ks]):"v"(vb),"i"(d0*4096+ks*1024):"memory");
      asm volatile("ds_read_b64_tr_b16 %0,%1 offset:%c2":"=&v"(hi[ks]):"v"(vb),"i"(d0*4096+ks*1024+512):"memory");}
    asm volatile("s_waitcnt lgkmcnt(0)":::"memory");SBAR();
    #define PK(k) (bf16x8){lo[k][0],lo[k][1],lo[k][2],lo[k][3],hi[k][0],hi[k][1],hi[k][2],hi[k][3]}
    o[d0]=__builtin_amdgcn_mfma_f32_32x32x16_bf16(pa0,PK(0),o[d0],0,0,0);
    o[d0]=__builtin_amdgcn_mfma_f32_32x32x16_bf16(pa1,PK(1),o[d0],0,0,0);
    o[d0]=__builtin_amdgcn_mfma_f32_32x32x16_bf16(pa2,PK(2),o[d0],0,0,0);
    o[d0]=__builtin_amdgcn_mfma_f32_32x32x16_bf16(pa3,PK(3),o[d0],0,0,0);
    #undef PK
  }
}

#ifndef ATTN_STORE16
#define ATTN_STORE16(p,v) (*(u32x4*)(p)=(v))
#endif
template<int THRL> __device__ __forceinline__ void attn_unit(long qrow0,long kvrow0,int NT,int h,const bf16*Q,const bf16*__restrict__ K,const bf16*__restrict__ V,bf16*O,char*shm,int tid_in){
  int tid_l=tid_in; asm volatile("":"+v"(tid_l)); const int tid=tid_l,lane=tid&63,r32=lane&31,hi=lane>>5; const int wid=__builtin_amdgcn_readfirstlane(tid>>6);
  const bf16*Qw=Q+(qrow0+wid*QBLK)*DM+h*D;
  const bf16*Kh=K+kvrow0*KVP+(h>>2)*D,*Vh=V+kvrow0*KVP+(h>>2)*D;
  const unsigned lds0=(unsigned)(uintptr_t)shm;
  float*wsf=(float*)(shm+LDS_WS)+wid*64;
  const bf16*ksrc=Kh+(long)lane*KVP+wid*8;
  const bf16*vsrc=Vh+(long)(16*(wid&3)+(lane>>2))*KVP+(wid>>2)*32+(lane&3)*8;
  const unsigned kdst=lds0+LDS_K+wid*1024, vdst=lds0+LDS_V+wid*1024;
  #define DMA_K(t,slot) glds16(ksrc+(long)(t)*KVBLK*KVP,(unsigned)__builtin_amdgcn_readfirstlane(kdst+(slot)))
  #define DMA_V(t,slot) glds16(vsrc+(long)(t)*KVBLK*KVP,(unsigned)__builtin_amdgcn_readfirstlane(vdst+(slot)))
  const int vb0=(int)(lds0+LDS_V)+((lane>>4)&1)*32+(lane&3)*8+(4*hi+((lane&15)>>2))*64;
  const char*Kbase=shm+LDS_K; bf16x8 kf[8];
  const lds_cptr shm3=(lds_cptr)shm; const lds_cptr kp0=shm3+LDS_K+hi*1024+r32*16; const lds_cptr vp0=shm3+LDS_V+((lane>>4)&1)*32+(lane&3)*8+(4*hi+((lane&15)>>2))*64;
  DMA_K(0,0);DMA_V(0,0);DMA_K(1,SLOTB);
  bf16x8 qr[4];
  #pragma unroll
  for(int d0=0;d0<4;++d0)qr[d0]=*reinterpret_cast<const bf16x8*>(&Qw[(long)r32*DM+d0*16+hi*8]);
  float mhat=0.f,l_reg=0.f;f32x16 o[2];o[0]=f32x16{};o[1]=f32x16{};f32x16 negm=f32x16{};asm volatile("":"+v"(negm));
  #define CMASK(P0,P1,t) do{}while(0)
  bool resc=false;
  #define START(P0,P1) do{ const float rm=rowmax(P0,P1); resc=false; \
    { const float dl=rm; mhat=fadd_s(mhat,dl); \
      _Pragma("unroll") for(int r=0;r<16;++r){P0[r]=fsub_s(P0[r],dl);P1[r]=fsub_s(P1[r],dl);} \
      _Pragma("unroll") for(int r=0;r<16;++r)negm[r]=-mhat; asm volatile("":"+v"(negm)); } \
    _Pragma("unroll") for(int r=0;r<16;++r)P0[r]=__builtin_amdgcn_exp2f(P0[r]); }while(0)
  #define RESC() do{ if(resc){ asm volatile("s_waitcnt lgkmcnt(0)":::"memory"); \
      _Pragma("unroll") for(int d_=0;d_<2;++d_) _Pragma("unroll") for(int r=0;r<16;++r)o[d_][r]*=wsf[crow(r,hi)]; } }while(0)
  f32x16 pA0,pA1,pB0,pB1;
  int sl_prev=0,sl_cur=0,sl_next=SLOTB;
  #define ROT() do{sl_prev=sl_cur;sl_cur=sl_next;sl_next=(sl_next==(NSLOT-1)*SLOTB)?0:sl_next+SLOTB;}while(0)
  DMA_K(2,2*SLOTB);
  WAIT_BAR(3);
  qkt(pA0,pA1,Kbase,qr,negm,r32,hi);asm volatile("s_nop 15\n\ts_nop 7":"+v"(pA0),"+v"(pA1));CMASK(pA0,pA1,0);
  START(pA0,pA1);
  _Pragma("unroll") for(int r=0;r<16;++r)pA1[r]=__builtin_amdgcn_exp2f(pA1[r]);
  WAIT_BAR(0);
  DMA_K(3,0);DMA_V(1,SLOTB);
  ROT();
  kload8(kf,kp0+sl_cur);
  WAIT_BAR(2);
  s16x4 vlo[8],vhi[8]; u32x4 pw0,pw1,pw2,pw3;
  #define PKW(P,B) cvtpk_s(P[B],P[B+1])
  #define PAF(k) __builtin_bit_cast(bf16x8,pw##k)
  #define VFR(i) (bf16x8){vlo[i][0],vlo[i][1],vlo[i][2],vlo[i][3],vhi[i][0],vhi[i][1],vhi[i][2],vhi[i][3]}
  #define PIN(x) asm volatile("":"+v"(x))
  #define MX3(a,b,c) __builtin_fmaxf(__builtin_fmaxf((a),(b)),(c))
  #define GAPA(MF,A0,A1,A2,A3,W0,W1,PW) do{ MF; sacc+=A0; sacc+=A1; sacc+=A2; sacc+=A3; PIN(sacc); W0; W1; PIN(PW); SBAR(); }while(0)
  #define EX(v) __builtin_amdgcn_exp2f(v)
  #define GAPB(MF,X,B) do{ MF; X[B]=EX(X[B]); X[B+1]=EX(X[B+1]); X[B+2]=EX(X[B+2]); X[B+3]=EX(X[B+3]); PIN(X); SBAR(); }while(0)
  #define VRD(i) do{ vlo[i]=vtr(vp_+(((i)>>2)*4096+((i)&3)*1024)); vhi[i]=vtr(vp_+(((i)>>2)*4096+((i)&3)*1024+512)); }while(0)
  #define KRD(G,j) do{ if(G){ kload2(kf,kp0+sl_next,j); SBAR(); } }while(0)
  #define STEP(C0,C1,P0,P1,t,GK,GV,GL) do{ SBAR(); \
    const lds_cptr vp_=vp0+sl_prev; \
    VRD(0); SBAR(); float sacc=(P0[0]+P0[1]); \
    GAPA(C0=__builtin_amdgcn_mfma_f32_32x32x16_bf16(kf[0],qr[0],negm,0,0,0), P0[2],P0[3],P0[4],P0[5],     pw0[0]=PKW(P0,0), pw0[1]=PKW(P0,2), pw0); \
    VRD(4); SBAR(); GAPA(C1=__builtin_amdgcn_mfma_f32_32x32x16_bf16(kf[1],qr[0],negm,0,0,0), P0[6],P0[7],P0[8],P0[9],     pw0[2]=PKW(P0,4), pw0[3]=PKW(P0,6), pw0); \
    VRD(1); SBAR(); GAPA(C0=__builtin_amdgcn_mfma_f32_32x32x16_bf16(kf[2],qr[1],C0,0,0,0),   P0[10],P0[11],P0[12],P0[13], pw1[0]=PKW(P0,8), pw1[1]=PKW(P0,10), pw1); \
    VRD(5); SBAR(); GAPA(C1=__builtin_amdgcn_mfma_f32_32x32x16_bf16(kf[3],qr[1],C1,0,0,0),   P0[14],P0[15],P1[0],P1[1],   pw1[2]=PKW(P0,12),pw1[3]=PKW(P0,14), pw1); \
    VRD(2); SBAR(); GAPA(C0=__builtin_amdgcn_mfma_f32_32x32x16_bf16(kf[4],qr[2],C0,0,0,0),   P1[2],P1[3],P1[4],P1[5],     pw2[0]=PKW(P1,0), pw2[1]=PKW(P1,2), pw2); \
    VRD(6); SBAR(); GAPA(C1=__builtin_amdgcn_mfma_f32_32x32x16_bf16(kf[5],qr[2],C1,0,0,0),   P1[6],P1[7],P1[8],P1[9],     pw2[2]=PKW(P1,4), pw2[3]=PKW(P1,6), pw2); \
    VRD(3); SBAR(); GAPA(C0=__builtin_amdgcn_mfma_f32_32x32x16_bf16(kf[6],qr[3],C0,0,0,0),   P1[10],P1[11],P1[12],P1[13], pw3[0]=PKW(P1,8), pw3[1]=PKW(P1,10), pw3); \
    VRD(7); SBAR(); GAPA(C1=__builtin_amdgcn_mfma_f32_32x32x16_bf16(kf[7],qr[3],C1,0,0,0),   P1[14],P1[15],0.f,0.f,       pw3[2]=PKW(P1,12),pw3[3]=PKW(P1,14), pw3); \
    l_reg+=sacc; \
    if(GK){DMA_K((t)+3,sl_cur);} if(GV){DMA_V((t)+1,sl_next);} \
    CMASK(C0,C1,t); \
    { float a=MX3(C0[0],C0[1],C1[0]),b=MX3(C0[2],C0[3],C1[1]); a=MX3(a,C1[2],C1[3]); \
      _Pragma("unroll") for(int r=4;r<16;r+=4){a=MX3(a,C0[r],C0[r+1]);b=MX3(b,C0[r+2],C0[r+3]);a=MX3(a,C1[r],C1[r+1]);b=MX3(b,C1[r+2],C1[r+3]);} \
      float rm=__builtin_fmaxf(a,b); { auto rr=__builtin_amdgcn_permlane32_swap(__float_as_uint(rm),__float_as_uint(rm),false,false); rm=__builtin_fmaxf(__uint_as_float(rr[0]),__uint_as_float(rr[1])); } \
      resc=false; \
      if(__builtin_expect(__any(rm>(float)THRL),0)){ const float dl=__builtin_fmaxf(rm,0.f); mhat+=dl; \
        _Pragma("unroll") for(int r=0;r<16;++r){C0[r]-=dl;C1[r]-=dl;} \
        _Pragma("unroll") for(int r=0;r<16;++r)negm[r]=-mhat; asm volatile("":"+v"(negm)); \
        const float f=__builtin_amdgcn_exp2f(-dl); l_reg*=f; if(hi==0)wsf[r32]=f; resc=true; } } \
    SBAR(); \
    GAPB(o[0]=__builtin_amdgcn_mfma_f32_32x32x16_bf16(PAF(0),VFR(0),o[0],0,0,0), C0,0); \
    GAPB(o[1]=__builtin_amdgcn_mfma_f32_32x32x16_bf16(PAF(0),VFR(4),o[1],0,0,0), C0,4); \
    KRD(GL,0); GAPB(o[0]=__builtin_amdgcn_mfma_f32_32x32x16_bf16(PAF(1),VFR(1),o[0],0,0,0), C0,8); \
    KRD(GL,1); GAPB(o[1]=__builtin_amdgcn_mfma_f32_32x32x16_bf16(PAF(1),VFR(5),o[1],0,0,0), C0,12); \
    KRD(GL,2); GAPB(o[0]=__builtin_amdgcn_mfma_f32_32x32x16_bf16(PAF(2),VFR(2),o[0],0,0,0), C1,0); \
    KRD(GL,3); GAPB(o[1]=__builtin_amdgcn_mfma_f32_32x32x16_bf16(PAF(2),VFR(6),o[1],0,0,0), C1,4); \
    GAPB(o[0]=__builtin_amdgcn_mfma_f32_32x32x16_bf16(PAF(3),VFR(3),o[0],0,0,0), C1,8); \
    GAPB(o[1]=__builtin_amdgcn_mfma_f32_32x32x16_bf16(PAF(3),VFR(7),o[1],0,0,0), C1,12); \
    }while(0)
  int t=1;
  #undef CMASK
  #define CMASK(P0,P1,t) do{}while(0)
  for(;t+5<NT;t+=2){
    STEP(pB0,pB1,pA0,pA1,t,true,true,true);     WAIT_BAR(2); RESC(); ROT();
    STEP(pA0,pA1,pB0,pB1,t+1,true,true,true);   WAIT_BAR(2); RESC(); ROT();
  }
  #undef CMASK
  #define CMASK(P0,P1,t) do{}while(0)
  #define ENDW(tt) do{ if((tt)+3<NT){WAIT_BAR(2);} else if((tt)+2<NT){WAIT_BAR(1);} else {WAIT_BAR(0);} }while(0)
  for(;t+1<NT;t+=2){
    STEP(pB0,pB1,pA0,pA1,t,(t+3<NT),(t+1<NT),(t+1<NT));       ENDW(t);   RESC(); ROT();
    STEP(pA0,pA1,pB0,pB1,t+1,(t+4<NT),(t+2<NT),(t+2<NT));     ENDW(t+1); RESC(); ROT();
  }
  STEP(pB0,pB1,pA0,pA1,NT-1,false,false,false); RESC();
  { float sacc=pB0[0]+pB0[1]; _Pragma("unroll") for(int r=2;r<16;++r)sacc+=pB0[r]; _Pragma("unroll") for(int r=0;r<16;++r)sacc+=pB1[r]; l_reg+=sacc;
    pw0=(u32x4){PKW(pB0,0),PKW(pB0,2),PKW(pB0,4),PKW(pB0,6)};pw1=(u32x4){PKW(pB0,8),PKW(pB0,10),PKW(pB0,12),PKW(pB0,14)};pw2=(u32x4){PKW(pB1,0),PKW(pB1,2),PKW(pB1,4),PKW(pB1,6)};pw3=(u32x4){PKW(pB1,8),PKW(pB1,10),PKW(pB1,12),PKW(pB1,14)};
    SBAR(); pv(o,vb0+sl_cur,PAF(0),PAF(1),PAF(2),PAF(3)); }
  #undef PKW
  #undef PAF
  #undef VFR
  #undef PIN
  #undef MX3
  #undef GAPA
  #undef GAPB
  #undef EX
  #undef VRD
  #undef KRD
  #undef STEP
  #undef ENDW
  {auto rr=__builtin_amdgcn_permlane32_swap(__float_as_uint(l_reg),__float_as_uint(l_reg),false,false);l_reg=__uint_as_float(rr[0])+__uint_as_float(rr[1]);}
  if(hi==0)wsf[32+r32]=l_reg;asm volatile("s_waitcnt lgkmcnt(0)":::"memory");
  float rli[16];
  #pragma unroll
  for(int r=0;r<16;++r)rli[r]=__builtin_amdgcn_rcpf(wsf[32+crow(r,hi)]);
  bf16*Ow=O+(qrow0+wid*QBLK)*DM+h*D;
  { bf16*stg=(bf16*)(shm+LDS_OST)+wid*2048;
    #pragma unroll
    for(int r=0;r<16;++r){const int orow=crow(r,hi);
      #pragma unroll
      for(int d0=0;d0<2;++d0)stg[orow*64+d0*32+r32]=__float2bfloat16(o[d0][r]*rli[r]);}
    asm volatile("s_waitcnt lgkmcnt(0)":::"memory");
    #pragma unroll
    for(int i=0;i<4;++i){const int row=i*8+(lane>>3),ch=lane&7; const u32x4 v=*(const u32x4*)(stg+row*64+ch*8); ATTN_STORE16(Ow+(long)row*DM+ch*8,v);} }
  asm volatile("s_waitcnt lgkmcnt(0)\n\ts_barrier":::"memory");
  #undef DMA_K
  #undef DMA_V
  #undef CMASK
  #undef START
  #undef RESC
  #undef ROT
}
constexpr int ATTN_LDS_BYTES=LDS_BYTES;
#undef SBAR
#undef WAIT_BAR
}

constexpr int NWAVES = 8;
constexpr int NB = 8, SEQ = 4096, CTXL = 256, TB = SEQ + CTXL  , MT = NB * TB  , DMODEL = 1024;
constexpr int NMODC = 6 * DMODEL, MODROWS = 9;
constexpr int QKVN = 1536, WINN = 3104, WINP = 3328;
constexpr int NEXP = 32, TOPK = 4, MPAD = MT * TOPK + NEXP * 256;
constexpr int NLAYER = 4;
constexpr float RMS_EPS = 1e-6f;
constexpr float ATT_C2 = 0.125f * 1.4426950408889634f;

constexpr size_t MiB = 1u << 20;
constexpr size_t WS_CTL = 0, CTL_ZERO_BYTES = 1 * MiB;
constexpr size_t WS_MOD = 1 * MiB, WS_ROPE = 2 * MiB, WS_MODP = 3 * MiB;
constexpr size_t WS_SLOT = 17 * MiB, WS_GATEW = 18 * MiB, WS_SLOTPOS = 19 * MiB;
constexpr size_t WS_WQKV = 20 * MiB, WS_WOA = 26 * MiB, WS_WIN = 30 * MiB, WS_WOG = 43 * MiB, WS_WGU = 48 * MiB, WS_WDN = 560 * MiB;
constexpr size_t WS_X = 816 * MiB, WS_XN = 952 * MiB, WS_Q = 1020 * MiB, WS_K = 1088 * MiB, WS_V = 1105 * MiB, WS_G = 1122 * MiB;
constexpr size_t WS_OF = 1343 * MiB, WS_OB = 1479 * MiB, WS_XG = 1615 * MiB, WS_ACT = 1903 * MiB, WS_Y = 2191 * MiB, WS_XN8 = WS_ACT + 150 * MiB  , WS_PAR = 2479 * MiB, WS_LIST = 2483 * MiB  , WS_END = 2488 * MiB;
static_assert(WS_MODP + (size_t)16 * NLAYER * MODROWS * NMODC * 4 <= WS_SLOT && WS_WIN + (size_t)2 * WINP * 1024 * 2 <= WS_WOG && WS_G + (size_t)MT * WINP * 2 <= WS_OF && WS_XG + (size_t)MPAD * 1024 * 2 <= WS_ACT, "ws map");
constexpr int CW_TMO = 0, CW_BAR = 4096, CW_CNT = 16384;

constexpr int RING_OFF = 0, RING_BYTES = 131072;
constexpr int WR_STRIDE = 1028;
constexpr int LDS_AUX = 133120;
constexpr int AUX_LCNT = LDS_AUX, AUX_GB = LDS_AUX + 128, AUX_T2E = LDS_AUX + 256  , AUX_BASE = AUX_T2E + 2560  , AUX_NT = AUX_BASE + 128, AUX_CNT = AUX_NT + 64  , AUX_ENT = AUX_CNT + 128  , AUX_RS = AUX_ENT + 4352  , AUX_ROWTAB = AUX_RS + 576, ROWTAB_UNITS = 18  ;
constexpr int MISC_OFF = 154624;
constexpr int LDS_BYTES = 155648;
static_assert(AUX_ROWTAB + ROWTAB_UNITS * 512 <= MISC_OFF, "LDS map");

#define GAS __attribute__((address_space(1)))
#define LAS __attribute__((address_space(3)))
typedef unsigned short bf16;
typedef unsigned v4u __attribute__((ext_vector_type(4)));
typedef float f32x4 __attribute__((ext_vector_type(4)));
typedef short bf16x8 __attribute__((ext_vector_type(8)));
typedef GAS unsigned gu32;
typedef GAS unsigned long long gu64;
#define RLX_AGENT __ATOMIC_RELAXED, __HIP_MEMORY_SCOPE_AGENT
#define LDS_WAIT() asm volatile("s_waitcnt lgkmcnt(0)" ::: "memory")
#define VM_WAIT() asm volatile("s_waitcnt vmcnt(0)" ::: "memory")
__device__ __forceinline__ unsigned long long rt() { return __builtin_amdgcn_s_memrealtime(); }
__device__ __forceinline__ unsigned f2bf(float f) { unsigned u = __builtin_bit_cast(unsigned, f); return (u + 0x7fffu + ((u >> 16) & 1u)) >> 16; }
__device__ __forceinline__ unsigned pk2(float lo, float hi) { return f2bf(lo) | (f2bf(hi) << 16); }

#define XB_TMO      128
#define XB_XCNT(j)  (256  + 64 * (j))
#define XB_XSUB(j)  (1280 + 64 * (j))
#define XB_XGEN(j)  (2304 + 64 * (j))
#define XB_TOP      3328
#define XB_TOPGEN   3392
#define XCD_BAR_WORDS 3456
#define XB_SPIN_CAP (1u << 18)

__device__ __forceinline__ unsigned xb_ld(unsigned* p)              { return __hip_atomic_load(p, __ATOMIC_RELAXED, __HIP_MEMORY_SCOPE_AGENT); }
__device__ __forceinline__ unsigned xb_add(unsigned* p, unsigned v) { return __hip_atomic_fetch_add(p, v, __ATOMIC_RELAXED, __HIP_MEMORY_SCOPE_AGENT); }
__device__ __forceinline__ unsigned xb_xcc_id() { return (unsigned)__builtin_amdgcn_s_getreg((3 << 11) | 20) & 0xFu; }
#define XB_SPIN(cond, bar) do { unsigned _sp = 0; while (cond) { __builtin_amdgcn_s_sleep(1); \
    if ((++_sp & 255u) == 0u) { if (xb_ld(&(bar)[XB_TMO])) break; if (_sp > XB_SPIN_CAP) { atomicAdd(&(bar)[XB_TMO], 1u); break; } } } } while (0)

struct XcdBarrier {
    unsigned* bar; unsigned x;
    volatile LAS unsigned* st;
};

__device__ __forceinline__ XcdBarrier xcd_barrier_post(unsigned* bar, volatile LAS unsigned* st, bool xb_t0  ) {
    XcdBarrier b; b.bar = bar; b.x = xb_xcc_id(); b.st = st;
    if (xb_t0) (void)xb_add(&bar[XB_XCNT(b.x)], 1u);
    return b;
}
__device__ __forceinline__ void xcd_barrier_complete(unsigned* bar, unsigned x, unsigned& nloc, unsigned& nx) {
    const unsigned G = gridDim.x * gridDim.y * gridDim.z;
    unsigned sum, cnt, mine, sp = 0u;
    for (;;) {
        sum = 0u; cnt = 0u; mine = 0u;
#pragma unroll
        for (unsigned j = 0; j < 16; ++j) { const unsigned c = xb_ld(&bar[XB_XCNT(j)]); sum += c; cnt += (c > 0u) ? 1u : 0u; mine = (j == x) ? c : mine; }
        if (sum == G) break;
        __builtin_amdgcn_s_sleep(1);
        if ((++sp & 255u) == 0u) { if (xb_ld(&bar[XB_TMO])) break; if (sp > XB_SPIN_CAP) { atomicAdd(&bar[XB_TMO], 1u); break; } }
    }
    nloc = mine > 0u ? mine : 1u; nx = cnt > 0u ? cnt : 1u;
}

__device__ __forceinline__ void xcd_barrier(const XcdBarrier& b, bool xb_t0  ) {
    asm volatile("s_waitcnt vmcnt(0)" ::: "memory");
    __syncthreads();
    if (xb_t0) {
        unsigned* bar = b.bar;
        __builtin_amdgcn_s_waitcnt(0);
        unsigned nloc = b.st[0], nx = b.st[1];
        if (nloc == 0u) { xcd_barrier_complete(bar, b.x, nloc, nx); b.st[0] = nloc; b.st[1] = nx; }
        const unsigned old = xb_add(&bar[XB_XSUB(b.x)], 1u);
        const unsigned gen = old / nloc;
        if (old + 1u == (gen + 1u) * nloc) {
            __builtin_amdgcn_fence(__ATOMIC_RELEASE, "agent");
            asm volatile("s_waitcnt vmcnt(0)" ::: "memory");
            const unsigned og = xb_add(&bar[XB_TOP], 1u);
            const unsigned tg = og / nx;
            if (og + 1u == (tg + 1u) * nx) xb_add(&bar[XB_TOPGEN], 1u);
            else XB_SPIN(xb_ld(&bar[XB_TOPGEN]) == tg, bar);
            __builtin_amdgcn_fence(__ATOMIC_ACQUIRE, "agent");
            xb_add(&bar[XB_XGEN(b.x)], 1u);
            asm volatile("s_waitcnt vmcnt(0)" ::: "memory");
        } else {
            XB_SPIN(xb_ld(&bar[XB_XGEN(b.x)]) == gen, bar);
            __builtin_amdgcn_fence(__ATOMIC_ACQUIRE, "agent");
            asm volatile("s_waitcnt vmcnt(0)" ::: "memory");
        }
    }
    __syncthreads();
}

typedef float f32x2 __attribute__((ext_vector_type(2)));
using pg8::lane_now; using pg8::shx;
__device__ __forceinline__ float wave_sum(float v) {
    const int ln = lane_now();
#pragma unroll
    for (int o = 1; o < 64; o <<= 1) v += shx(v, o, ln);
    return v;
}
__device__ __forceinline__ float wave_max(float v) {
    const int ln = lane_now();
#pragma unroll
    for (int o = 1; o < 64; o <<= 1) v = fmaxf(v, shx(v, o, ln));
    return v;
}
__device__ __forceinline__ float bf2f(unsigned short h) { return __uint_as_float((unsigned)h << 16); }
__device__ __forceinline__ float silu_f(float x) { return x / (1.0f + __expf(-x)); }
__device__ __forceinline__ f32x4 bf4_to_f32(unsigned long long v) { return (f32x4){__uint_as_float((unsigned)(v & 0xffffu) << 16), __uint_as_float((unsigned)(v >> 16) << 16), __uint_as_float((unsigned)((v >> 32) & 0xffffu) << 16), __uint_as_float((unsigned)(v >> 48) << 16)}; }
__device__ __forceinline__ unsigned long long f32_to_bf4(f32x4 y) { return (unsigned long long)pk2(y.x, y.y) | ((unsigned long long)pk2(y.z, y.w) << 32); }
__device__ __forceinline__ int mod_row(int m) { const int b = m / TB; return (m - b * TB < CTXL) ? 8 : b; }

__device__ __forceinline__ void titem_load(const float* W, int N, int k0, int n0, int lane, f32x4 (&v)[16]) {
    const GAS f32x4* p = (const GAS f32x4*)(W + (size_t)(k0 + 16 * (lane >> 3)) * N + n0 + 4 * (lane & 7));
#pragma unroll
    for (int j = 0; j < 16; ++j) v[j] = p[(size_t)j * (N >> 2)];
}
__device__ __forceinline__ void titem_store8(const f32x4 (&v)[16], unsigned char* WT8, int K, int k0, int dst_row0, int lane) {
    unsigned char* o = WT8 + (size_t)(dst_row0 + 4 * (lane & 7)) * K + k0 + 16 * (lane >> 3);
#pragma unroll
    for (int i = 0; i < 4; ++i) { v4u q;
        q.x = pg8::pk4_fp8(v[0][i] * 32.f, v[1][i] * 32.f, v[2][i] * 32.f, v[3][i] * 32.f); q.y = pg8::pk4_fp8(v[4][i] * 32.f, v[5][i] * 32.f, v[6][i] * 32.f, v[7][i] * 32.f);
        q.z = pg8::pk4_fp8(v[8][i] * 32.f, v[9][i] * 32.f, v[10][i] * 32.f, v[11][i] * 32.f); q.w = pg8::pk4_fp8(v[12][i] * 32.f, v[13][i] * 32.f, v[14][i] * 32.f, v[15][i] * 32.f);
        *(GAS v4u*)(o + (size_t)i * K) = q; }
}
__device__ __forceinline__ void titem_store16(const f32x4 (&v)[16], bf16* WT, int K, int k0, int dst_row0, int lane) {
    bf16* o = WT + (size_t)(dst_row0 + 4 * (lane & 7)) * K + k0 + 16 * (lane >> 3);
#pragma unroll
    for (int i = 0; i < 4; ++i) { v4u q0, q1;
        q0.x = pk2(v[0][i], v[1][i]); q0.y = pk2(v[2][i], v[3][i]); q0.z = pk2(v[4][i], v[5][i]); q0.w = pk2(v[6][i], v[7][i]);
        q1.x = pk2(v[8][i], v[9][i]); q1.y = pk2(v[10][i], v[11][i]); q1.z = pk2(v[12][i], v[13][i]); q1.w = pk2(v[14][i], v[15][i]);
        *(GAS v4u*)(o + (size_t)i * K) = q0; *(GAS v4u*)(o + (size_t)i * K + 8) = q1; }
}

struct Args { const float* in[25]; float* out; unsigned char* ws; int ph_lo, ph_hi; };
constexpr int P_N1G = 0, P_N2G = 4096, P_QG = 8192, P_KG = 8320, P_GKF = 8448, P_GKB = 24832, P_BGF = 41216, P_BGB = 42240, P_OG = 43264, P_WR = 43776, P_BR = 174848, P_BGU = 174976, P_BDN = 437120, P_END = 568192;
#define LAUNDER_S(p) asm volatile("" : "+s"(p))
#define LAUNDER_V(p) asm volatile("" : "+v"(p))
#define PARF(ws) ((const float*)((ws) + WS_PAR))

constexpr int I8_GU = 128 * 8 * 64, I8_DN = 128 * 8 * 32, NI8 = I8_GU + I8_DN;
struct T8 { const float* W; unsigned char* O; int N, k0, n0, dst; };
__device__ __forceinline__ T8 dec8(const Args& A, unsigned char* ws, int it) { T8 t;
    const bool gu = it < I8_GU; const int r = gu ? it : it - I8_GU, sh = gu ? 6 : 5, mat = r >> (3 + sh), q = r & ((8 << sh) - 1), kb = q >> sh, n0 = (q & ((1 << sh) - 1)) * 32;
    t.N = gu ? 2048 : 1024; t.W = (gu ? A.in[21] : A.in[23]) + (size_t)mat * 1024 * t.N; t.O = ws + (gu ? WS_WGU : WS_WDN) + (size_t)mat * 1024 * t.N; t.k0 = kb * 128; t.n0 = n0;
    t.dst = gu ? ((n0 & 1023) >> 7) * 256 + (n0 >> 10) * 128 + (n0 & 127) : n0;
    return t; }
__device__ __forceinline__ void p0_prologue(const Args& A, LAS unsigned char* lds, int gw, int NGW, int wave, int lane) {
    unsigned char* ws = A.ws;
    { f32x4 va[16], vb[16]; int it = gw;
      if (it < NI8) { const T8 t = dec8(A, ws, it); titem_load(t.W, t.N, t.k0, t.n0, lane, va); }
      while (it + 2 * NGW < NI8) {
          { const T8 t = dec8(A, ws, it + NGW); titem_load(t.W, t.N, t.k0, t.n0, lane, vb); }
          { const T8 t = dec8(A, ws, it); titem_store8(va, t.O, 1024, t.k0, t.dst, lane); }
          { const T8 t = dec8(A, ws, it + 2 * NGW); titem_load(t.W, t.N, t.k0, t.n0, lane, va); }
          { const T8 t = dec8(A, ws, it + NGW); titem_store8(vb, t.O, 1024, t.k0, t.dst, lane); }
          it += 2 * NGW; }
      if (it < NI8) { const bool hb = it + NGW < NI8;
          if (hb) { const T8 t = dec8(A, ws, it + NGW); titem_load(t.W, t.N, t.k0, t.n0, lane, vb); }
          { const T8 t = dec8(A, ws, it); titem_store8(va, t.O, 1024, t.k0, t.dst, lane); }
          if (hb) { const T8 t = dec8(A, ws, it + NGW); titem_store8(vb, t.O, 1024, t.k0, t.dst, lane); } } }
    constexpr int J_QKV = 2 * 8 * (QKVN / 32), J_WO = 2 * 8 * 32, J_WIN = 2 * 8 * (WINN / 32), NJ = J_QKV + J_WO + J_WIN + J_WO;
    for (int it = gw; it < NJ; it += NGW) { int r = it; const float* W; bf16* O; int N, kb, n0, dst;
        if (r < J_QKV) { const int per = 8 * (QKVN / 32), mat = r / per, q = r - mat * per; kb = q / (QKVN / 32); n0 = (q - kb * (QKVN / 32)) * 32;
            dst = (n0 & ~255) + ((n0 >> 5) & 1) * 128 + ((n0 >> 6) & 3) * 32;
            W = A.in[8] + (size_t)mat * 1024 * QKVN; N = QKVN; O = (bf16*)(ws + WS_WQKV) + (size_t)mat * QKVN * 1024; }
        else if ((r -= J_QKV) < J_WO) { const int mat = r >> 8, q = r & 255; kb = q >> 5; n0 = (q & 31) * 32; dst = n0;
            W = A.in[11] + (size_t)mat * 1024 * 1024; N = 1024; O = (bf16*)(ws + WS_WOA) + (size_t)mat * 1024 * 1024; }
        else if ((r -= J_WO) < J_WIN) { const int per = 8 * (WINN / 32), mat = r / per, q = r - mat * per; kb = q / (WINN / 32); n0 = (q - kb * (WINN / 32)) * 32; dst = n0;
            W = A.in[12] + (size_t)mat * 1024 * WINN; N = WINN; O = (bf16*)(ws + WS_WIN) + (size_t)mat * WINP * 1024; }
        else { r -= J_WIN; const int mat = r >> 8, q = r & 255; kb = q >> 5; n0 = (q & 31) * 32; dst = n0;
            W = A.in[18] + (size_t)mat * 1024 * 1024; N = 1024; O = (bf16*)(ws + WS_WOG) + (size_t)mat * 1024 * 1024; }
        f32x4 v[16]; titem_load(W, N, kb * 128, n0, lane, v); titem_store16(v, O, 1024, kb * 128, dst, lane); }
    for (int it = gw; it < 2 * (WINP - WINN); it += NGW) { const int mat = it / (WINP - WINN), rr = WINN + it - mat * (WINP - WINN);
        GAS v4u* p = (GAS v4u*)((bf16*)(ws + WS_WIN) + ((size_t)mat * WINP + rr) * 1024) + lane; p[0] = (v4u){0u, 0u, 0u, 0u}; p[64] = (v4u){0u, 0u, 0u, 0u}; }
    for (int it = NGW - 1 - gw; it < NLAYER * 24 * 16; it += NGW) {
        const int l = it / (24 * 16), q = it - l * (24 * 16), cg = q / 16, kc = q - cg * 16;
        float s[MODROWS];
#pragma unroll
        for (int r = 0; r < MODROWS; ++r) { const float cv = (r < 8) ? A.in[1][r * 1024 + kc * 64 + lane] : A.in[3][kc * 64 + lane]; s[r] = silu_f(cv); }
        f32x4 acc[MODROWS];
#pragma unroll
        for (int r = 0; r < MODROWS; ++r) acc[r] = (f32x4){0.f, 0.f, 0.f, 0.f};
        const float* wp = A.in[4] + ((size_t)l * 1024 + kc * 64) * NMODC + cg * 256 + 4 * lane;
#pragma unroll 8
        for (int kk = 0; kk < 64; ++kk) { const f32x4 w = *(const f32x4*)(wp + (size_t)kk * NMODC);
#pragma unroll
            for (int r = 0; r < MODROWS; ++r) { const float sv = __shfl(s[r], kk); acc[r] = acc[r] + w * sv; } }
        float* op = (float*)(ws + WS_MODP) + (size_t)kc * (NLAYER * MODROWS * NMODC) + (size_t)l * MODROWS * NMODC + cg * 256 + 4 * lane;
#pragma unroll
        for (int r = 0; r < MODROWS; ++r) *(f32x4*)(op + (size_t)r * NMODC) = acc[r];
    }
    for (int m0 = gw; m0 < MT; m0 += 4 * NGW) { f32x4 x[4][4];
#pragma unroll
        for (int r = 0; r < 4; ++r) { const int m = m0 + r * NGW; if (m < MT) { const int b = m / TB, w = m - b * TB;
            const float* src = (w < CTXL) ? A.in[2] + ((size_t)b * CTXL + w) * 1024 : A.in[0] + ((size_t)b * SEQ + (w - CTXL)) * 1024; const GAS f32x4* sp = (const GAS f32x4*)src + lane;
#pragma unroll
            for (int j = 0; j < 4; ++j) x[r][j] = sp[64 * j]; } }
#pragma unroll
        for (int r = 0; r < 4; ++r) { const int m = m0 + r * NGW; if (m < MT) { GAS unsigned long long* dp = (GAS unsigned long long*)((bf16*)(ws + WS_X) + (size_t)m * 1024) + lane;
#pragma unroll
            for (int j = 0; j < 4; ++j) dp[64 * j] = f32_to_bf4(x[r][j]); } } }
    { float* par = (float*)(ws + WS_PAR); const int gt = gw * 64 + lane, NGT = NGW * 64;
#define CPL(k, src, n) float c##k##a = 0.f, c##k##b = 0.f; if (gt < (n)) c##k##a = A.in[src][gt]; if (gt + NGT < (n)) c##k##b = A.in[src][gt + NGT];
#define CPS(k, src, n, off) if (gt < (n)) par[(off) + gt] = c##k##a; if (gt + NGT < (n)) par[(off) + gt + NGT] = c##k##b; for (int i = gt + 2 * NGT; i < (n); i += NGT) par[(off) + i] = A.in[src][i];
      CPL(0, 6, 4096) CPL(1, 7, 4096) CPL(2, 9, 128) CPL(3, 10, 128) CPL(4, 13, 16384) CPL(5, 15, 16384) CPL(6, 14, 1024) CPL(7, 16, 1024) CPL(8, 17, 512) CPL(9, 19, 131072) CPL(10, 20, 128) CPL(11, 22, 262144) CPL(12, 24, 131072)
      CPS(0, 6, 4096, P_N1G) CPS(1, 7, 4096, P_N2G) CPS(2, 9, 128, P_QG) CPS(3, 10, 128, P_KG) CPS(4, 13, 16384, P_GKF) CPS(5, 15, 16384, P_GKB) CPS(6, 14, 1024, P_BGF) CPS(7, 16, 1024, P_BGB)
      CPS(8, 17, 512, P_OG) CPS(9, 19, 131072, P_WR) CPS(10, 20, 128, P_BR) CPS(11, 22, 262144, P_BGU) CPS(12, 24, 131072, P_BDN)
#undef CPL
#undef CPS
    }
    for (int idx = gw * 64 + lane; idx < SEQ * 32; idx += NGW * 64) { const int s = idx >> 5, i = idx & 31;
        const float invf = 1.0f / powf(10000.0f, (float)(i & 15) * (1.0f / 16.0f));
        const float ang = (float)((i < 16) ? (s >> 6) : (s & 63)) * invf;
        ((float*)(ws + WS_ROPE))[idx] = cosf(ang); ((float*)(ws + WS_ROPE))[SEQ * 32 + idx] = sinf(ang); }
}
__device__ __forceinline__ void p1_mod_reduce(const Args& A, int gtid, int NGT) {
    const float* P = (const float*)(A.ws + WS_MODP); float* Mo = (float*)(A.ws + WS_MOD);
    constexpr int N = NLAYER * MODROWS * NMODC;
    for (int i = gtid; i < N; i += NGT) { const int l = i / (MODROWS * NMODC), c = i % NMODC; float s = A.in[5][l * NMODC + c];
#pragma unroll
        for (int k = 0; k < 16; ++k) s += P[(size_t)k * N + i];
        Mo[i] = s; }
}
__device__ __forceinline__ void modulate_row(const bf16* xrow, const float* ng, const float* shp, const float* scp, bf16* orow, int lane, f32x4 (&y)[4], float& rs_out) {
    const GAS unsigned long long* xr = (const GAS unsigned long long*)xrow + lane;
    float ss = 0.f;
#pragma unroll
    for (int j = 0; j < 4; ++j) { y[j] = bf4_to_f32(xr[64 * j]); ss += (y[j].x * y[j].x + y[j].y * y[j].y) + (y[j].z * y[j].z + y[j].w * y[j].w); }
    const float rs = 1.0f / sqrtf(wave_sum(ss) * (1.0f / 1024.0f) + RMS_EPS); rs_out = rs;
    GAS unsigned long long* o8 = (GAS unsigned long long*)orow + lane;
#pragma unroll
    for (int j = 0; j < 4; ++j) { const f32x4 g = ((const GAS f32x4*)ng)[64 * j + lane], sh = ((const GAS f32x4*)shp)[64 * j + lane], sc = ((const GAS f32x4*)scp)[64 * j + lane];
        y[j] = (y[j] * rs) * g * (sc + 1.0f) + sh;
        o8[64 * j] = (unsigned long long)pk2(y[j].x, y[j].y) | ((unsigned long long)pk2(y[j].z, y[j].w) << 32); }
}
__device__ __forceinline__ void modulate_row2(const bf16* xa, const bf16* xb, const float* ng, const float* sha, const float* sca, const float* shb, const float* scb, unsigned char* oa, unsigned char* ob, int lane, float& rsa, float& rsb) {
    const GAS unsigned long long* pa = (const GAS unsigned long long*)xa + lane; const GAS unsigned long long* pb = (const GAS unsigned long long*)xb + lane;
    unsigned long long ra[4], rb[4];
#pragma unroll
    for (int j = 0; j < 4; ++j) { ra[j] = pa[64 * j]; rb[j] = pb[64 * j]; }
    f32x4 ya[4], yb[4]; float sa = 0.f, sb = 0.f;
#pragma unroll
    for (int j = 0; j < 4; ++j) { ya[j] = bf4_to_f32(ra[j]); yb[j] = bf4_to_f32(rb[j]); sa += (ya[j].x * ya[j].x + ya[j].y * ya[j].y) + (ya[j].z * ya[j].z + ya[j].w * ya[j].w); sb += (yb[j].x * yb[j].x + yb[j].y * yb[j].y) + (yb[j].z * yb[j].z + yb[j].w * yb[j].w); }
    const int ln = lane_now();
#pragma unroll
    for (int o = 1; o < 64; o <<= 1) { sa += shx(sa, o, ln); sb += shx(sb, o, ln); }
    rsa = 1.0f / sqrtf(sa * (1.0f / 1024.0f) + RMS_EPS); rsb = 1.0f / sqrtf(sb * (1.0f / 1024.0f) + RMS_EPS);
    GAS unsigned* qa = (GAS unsigned*)oa + lane; GAS unsigned* qb = (GAS unsigned*)ob + lane;
#pragma unroll
    for (int j = 0; j < 4; ++j) { const f32x4 g = ((const GAS f32x4*)ng)[64 * j + lane];
        const f32x4 ha = ((const GAS f32x4*)sha)[64 * j + lane], ca = ((const GAS f32x4*)sca)[64 * j + lane], hb = ((const GAS f32x4*)shb)[64 * j + lane], cb = ((const GAS f32x4*)scb)[64 * j + lane];
        const f32x4 va = (ya[j] * rsa) * g * (ca + 1.0f) + ha, vb = (yb[j] * rsb) * g * (cb + 1.0f) + hb;
        qa[64 * j] = pg8::pk4_fp8(va.x, va.y, va.z, va.w); qb[64 * j] = pg8::pk4_fp8(vb.x, vb.y, vb.z, vb.w); }
}
__device__ __forceinline__ void phase_modulate1(unsigned char* ws, int layer, int gw, int NGW, int lane) {
    const bf16* X = (const bf16*)(ws + WS_X); bf16* XN = (bf16*)(ws + WS_XN);
    const float* ng = PARF(ws) + P_N1G + layer * 1024; const float* Mo = (const float*)(ws + WS_MOD) + (size_t)layer * MODROWS * NMODC;
    for (int m = gw; m < MT; m += NGW) { const int mr = mod_row(m); f32x4 y[4]; float rs;
        modulate_row(X + (size_t)m * 1024, ng, Mo + (size_t)mr * NMODC + 0 * 1024, Mo + (size_t)mr * NMODC + 1 * 1024, XN + (size_t)m * 1024, lane, y, rs); }
}
__device__ __forceinline__ void phase_qknorm_rope(unsigned char* ws, int la, int gw, int NGW, int lane) {
    bf16* Qb = (bf16*)(ws + WS_Q); bf16* Kb = (bf16*)(ws + WS_K);
    const float* qg = PARF(ws) + P_QG + la * 64; const float* kg = PARF(ws) + P_KG + la * 64; const float* ropec = (const float*)(ws + WS_ROPE); const float* ropes = ropec + SEQ * 32;
    const int i = lane & 31, hs = lane >> 5;
    for (int m = gw; m < MT; m += NGW) { const int b = m / TB, w = m - b * TB; const bool lat = w >= CTXL;
        float cs = 1.f, sn = 0.f; if (lat) { cs = ropec[(w - CTXL) * 32 + i]; sn = ropes[(w - CTXL) * 32 + i]; }
#pragma unroll 2
        for (int hh = 0; hh < 20; hh += 2) { const int hd = hh + hs;
            unsigned* p = (hd < 16) ? (unsigned*)(Qb + (size_t)m * 1024 + hd * 64) + i : (unsigned*)(Kb + (size_t)m * 256 + (hd - 16) * 64) + i;
            const float* gp = (hd < 16) ? qg : kg; const float scl = (hd < 16) ? ATT_C2 : 1.0f;
            const unsigned v = *p; const float x1 = __uint_as_float(v << 16), x2 = __uint_as_float(v & 0xffff0000u);
            float ss = x1 * x1 + x2 * x2;
#pragma unroll
            for (int o = 1; o < 32; o <<= 1) ss += shx(ss, o, lane);
            const float rs = 1.0f / sqrtf(ss * (1.0f / 64.0f) + RMS_EPS);
            const float y1 = x1 * rs * gp[2 * i], y2 = x2 * rs * gp[2 * i + 1];
            const float r1 = (y1 * cs - y2 * sn) * scl, r2 = (y1 * sn + y2 * cs) * scl;
            *p = pk2(r1, r2); }
    }
}
__device__ __forceinline__ void phase_gla_recurrent(unsigned char* ws, int lg, LAS unsigned char* lds, int tid) {
    const int unit = blockIdx.x; if (unit >= 128) return;
    const int half = unit & 1, dir = (unit >> 1) & 1, h = (unit >> 2) & 3, b = unit >> 4;
    const bf16* G = (const bf16*)(ws + WS_G);
    float* Oo = (float*)(ws + (dir ? WS_OB : WS_OF));
    const float* wg = PARF(ws) + (dir ? P_GKB : P_GKF) + (size_t)lg * 16 * 512; const float* bg = PARF(ws) + (dir ? P_BGB : P_BGF) + lg * 512;
    LAS float* qq = (LAS float*)(lds + RING_OFF); LAS float* kk = qq + 64 * 128; LAS float* dd = kk + 64 * 128; LAS float* vv = dd + 64 * 128;
    const int sd = tid & 127, st0 = tid >> 7;
    float wcol[16];
#pragma unroll
    for (int r = 0; r < 16; ++r) wcol[r] = wg[r * 512 + h * 128 + sd];
    const float bcol = bg[h * 128 + sd];
    const int c = tid >> 2, dq = tid & 3;
    float s[32];
#pragma unroll
    for (int j = 0; j < 32; ++j) s[j] = 0.f;
    const float qscale = 0.08838834764831845f;
    for (int ch = 0; ch < TB / 64; ++ch) {
        __syncthreads();
#pragma unroll 4
        for (int i = 0; i < 16; ++i) { const int tt = st0 + 4 * i, n = 64 * ch + tt;
            const int w = dir ? (n < CTXL ? (CTXL - 1 - n) : (TB + CTXL - 1 - n)) : n;
            const bf16* gr = G + ((size_t)b * TB + w) * WINP;
            const float qv = bf2f(gr[h * 128 + sd]) * qscale, kv = bf2f(gr[512 + h * 128 + sd]);
            const bf16* lp = gr + 3072 + dir * 16; float z = bcol;
#pragma unroll
            for (int r = 0; r < 16; ++r) z += bf2f(lp[r]) * wcol[r];
            const float ls = fminf(z, 0.f) - log1pf(__expf(-fabsf(z)));
            qq[tt * 128 + sd] = qv; kk[tt * 128 + sd] = kv; dd[tt * 128 + sd] = __expf(ls * (1.0f / 16.0f));
            vv[tt * 128 + sd] = bf2f(gr[1024 + h * 256 + half * 128 + sd]); }
        __syncthreads();
        for (int tt = 0; tt < 64; ++tt) { const int n = 64 * ch + tt; const int w = dir ? (n < CTXL ? (CTXL - 1 - n) : (TB + CTXL - 1 - n)) : n;
            const float v = vv[tt * 128 + c]; float acc = 0.f;
            const LAS f32x4* q4 = (const LAS f32x4*)(qq + tt * 128 + dq * 32); const LAS f32x4* k4 = (const LAS f32x4*)(kk + tt * 128 + dq * 32); const LAS f32x4* d4 = (const LAS f32x4*)(dd + tt * 128 + dq * 32);
#pragma unroll
            for (int j = 0; j < 8; ++j) { const f32x4 qv = q4[j], kv = k4[j], dv = d4[j];
                s[4 * j + 0] = s[4 * j + 0] * dv.x + kv.x * v; acc += qv.x * s[4 * j + 0];
                s[4 * j + 1] = s[4 * j + 1] * dv.y + kv.y * v; acc += qv.y * s[4 * j + 1];
                s[4 * j + 2] = s[4 * j + 2] * dv.z + kv.z * v; acc += qv.z * s[4 * j + 2];
                s[4 * j + 3] = s[4 * j + 3] * dv.w + kv.w * v; acc += qv.w * s[4 * j + 3]; }
            acc += shx(acc, 1, tid & 63); acc += shx(acc, 2, tid & 63);
            if (dq == 0) Oo[((size_t)b * TB + w) * 1024 + h * 256 + half * 128 + c] = acc; }
    }
}
__device__ __forceinline__ void phase_gla_readout(unsigned char* ws, int lg, int gw, int NGW, int lane) {
    const float* OF = (const float*)(ws + WS_OF); const float* OB = (const float*)(ws + WS_OB); const bf16* G = (const bf16*)(ws + WS_G); bf16* OG = (bf16*)(ws + WS_Q);
    const f32x4 og = ((const GAS f32x4*)(PARF(ws) + P_OG + lg * 256))[lane];
    for (int m = gw; m < MT; m += NGW) {
#pragma unroll
        for (int hh = 0; hh < 4; ++hh) { const size_t off = (size_t)m * 1024 + hh * 256 + 4 * lane;
            f32x4 o = *(const GAS f32x4*)(OF + off) + *(const GAS f32x4*)(OB + off);
            const float ss = wave_sum((o.x * o.x + o.y * o.y) + (o.z * o.z + o.w * o.w));
            const float rs = 1.0f / sqrtf(ss * (1.0f / 256.0f) + RMS_EPS);
            const unsigned long long rv = *(const GAS unsigned long long*)(G + (size_t)m * WINP + 2048 + hh * 256 + 4 * lane);
            const float r0 = __uint_as_float((unsigned)(rv & 0xffffu) << 16), r1 = __uint_as_float((unsigned)(rv >> 16) << 16), r2 = __uint_as_float((unsigned)((rv >> 32) & 0xffffu) << 16), r3 = __uint_as_float((unsigned)(rv >> 48) << 16);
            o = o * rs * og;
            o.x *= silu_f(r0); o.y *= silu_f(r1); o.z *= silu_f(r2); o.w *= silu_f(r3);
            *(GAS unsigned long long*)(OG + off) = (unsigned long long)pk2(o.x, o.y) | ((unsigned long long)pk2(o.z, o.w) << 32); }
    }
}
constexpr size_t WS_GQ = WS_XG, WS_GKH = WS_XG + 68 * MiB, WS_GKT = WS_XG + 136 * MiB, WS_GVT = WS_XG + 204 * MiB, WS_GDL = WS_ACT, WS_SX = WS_OF;
static_assert((size_t)2176 * 2 * 16384 <= 68 * MiB && (size_t)2176 * 256 * 64 * 2 <= 68 * MiB && (size_t)64 * 68 * 65536 <= 272 * MiB, "gla buffers");
typedef float f32x16 __attribute__((ext_vector_type(16)));
__device__ __forceinline__ float log_sigmoid_fast(float z) { return fminf(z, 0.f) - __logf(1.0f + __expf(-fabsf(z))); }

struct G0Raw { unsigned qk[8][2]; v4u lfb; };
__device__ __forceinline__ void g0_load(G0Raw& R, unsigned char* ws, int cn, int tid) {
    const bf16* G = (const bf16*)(ws + WS_G);
    const int d2 = tid & 63, tb = tid >> 6, n = cn % 68, bh = cn / 68, h = bh & 3, b = bh >> 2;
    const size_t r0 = (size_t)b * TB + 64 * n;
#pragma unroll
    for (int j = 0; j < 8; ++j) { const bf16* gr = G + (r0 + 8 * tb + j) * WINP; R.qk[j][0] = *(const GAS unsigned*)(gr + h * 128 + 2 * d2); R.qk[j][1] = *(const GAS unsigned*)(gr + 512 + h * 128 + 2 * d2); }
    R.lfb = *(const GAS v4u*)(G + (r0 + ((tid & 255) >> 2)) * WINP + 3072 + 8 * (tid & 3));
}
__device__ __forceinline__ void g0_vload(unsigned (&raw)[32], const unsigned char* ws, int idx, int h, int dv, int th) {
    const int b = idx / 68, n = idx - b * 68; const bf16* vp = (const bf16*)(ws + WS_G) + ((size_t)b * TB + 64 * n + 32 * th) * WINP + 1024 + h * 256 + dv;
#pragma unroll
    for (int j = 0; j < 32; ++j) raw[j] = (unsigned)((const GAS bf16*)vp)[(size_t)j * WINP];
}
__device__ __forceinline__ void g0_vstore(const unsigned (&raw)[32], unsigned char* ws, int idx, int h, int dv, int th) {
    const int b = idx / 68, n = idx - b * 68, cn = (b * 4 + h) * 68 + n;
    unsigned char* vo = ws + WS_GVT + (size_t)cn * 32768 + (size_t)(((2 * th) * 8 + (dv >> 5)) * 64 + (dv & 31)) * 16;
    unsigned wv[16];
#pragma unroll
    for (int j = 0; j < 16; ++j) wv[j] = raw[2 * j] | (raw[2 * j + 1] << 16);
#pragma unroll
    for (int ql = 0; ql < 2; ++ql)
#pragma unroll
        for (int hq = 0; hq < 2; ++hq) *(GAS v4u*)(vo + ql * 8192 + hq * 512) = (v4u){wv[8 * ql + 2 * hq], wv[8 * ql + 2 * hq + 1], wv[8 * ql + 2 * hq + 4], wv[8 * ql + 2 * hq + 5]};
}
__device__ __forceinline__ void phase_gla_g0v(unsigned char* ws, int tid, int Gp, int bxp) {
    const int G4 = Gp >> 2, h = bxp & 3, wq = bxp >> 2;
    if (wq >= G4) return;
    const int dv = tid & 255, th = tid >> 8; unsigned ra[32], rb[32]; int idx = wq;
    if (idx < 544) g0_vload(ra, ws, idx, h, dv, th);
    while (idx + 2 * G4 < 544) { g0_vload(rb, ws, idx + G4, h, dv, th); g0_vstore(ra, ws, idx, h, dv, th); g0_vload(ra, ws, idx + 2 * G4, h, dv, th); g0_vstore(rb, ws, idx + G4, h, dv, th); idx += 2 * G4; }
    if (idx < 544) { const bool hb = idx + G4 < 544; if (hb) g0_vload(rb, ws, idx + G4, h, dv, th); g0_vstore(ra, ws, idx, h, dv, th); if (hb) g0_vstore(rb, ws, idx + G4, h, dv, th); }
}
__device__ __forceinline__ void phase_gla_g0(unsigned char* ws, int lg, LAS unsigned char* lds, int tid, int Gp, int bxp) {
    LAS float* tot = (LAS float*)(lds + RING_OFF);
    LAS unsigned char* lfl = lds + RING_OFF + 8192;
    const int d2 = tid & 63, tb = tid >> 6;
    const int G4 = Gp >> 2, h = bxp & 3, wq = bxp >> 2;
    if (wq >= G4 || wq >= 544) return;
        float wf0[16], wf1[16], wb0[16], wb1[16];
        { const float* wgf = PARF(ws) + P_GKF + (size_t)lg * 16 * 512 + h * 128 + 2 * d2; const float* wgb = PARF(ws) + P_GKB + (size_t)lg * 16 * 512 + h * 128 + 2 * d2;
#pragma unroll
          for (int r = 0; r < 16; ++r) { const f32x2 a = *(const GAS f32x2*)(wgf + r * 512), c = *(const GAS f32x2*)(wgb + r * 512); wf0[r] = a.x; wf1[r] = a.y; wb0[r] = c.x; wb1[r] = c.y; } }
        const f32x2 bf_ = *(const GAS f32x2*)(PARF(ws) + P_BGF + lg * 512 + h * 128 + 2 * d2), bb_ = *(const GAS f32x2*)(PARF(ws) + P_BGB + lg * 512 + h * 128 + 2 * d2);
    G0Raw R; g0_load(R, ws, ((wq / 68) * 4 + h) * 68 + wq % 68, tid);
    for (int idx = wq; idx < 544; idx += G4) {
        const int b = idx / 68, n = idx - b * 68, cn = (b * 4 + h) * 68 + n;
        __syncthreads();
        if (tid < 256) *(LAS v4u*)(lfl + tid * 16) = R.lfb;
        unsigned qk[8][2];
#pragma unroll
        for (int j = 0; j < 8; ++j) { qk[j][0] = R.qk[j][0]; qk[j][1] = R.qk[j][1]; }
        __syncthreads();
        if (idx + G4 < 544) { const int i2 = idx + G4, b2 = i2 / 68; g0_load(R, ws, (b2 * 4 + h) * 68 + (i2 - b2 * 68), tid); }
        float gf0[8], gf1[8], gb0[8], gb1[8];
#pragma unroll
        for (int j = 0; j < 8; ++j) { const LAS v4u* lp = (const LAS v4u*)(lfl + (8 * tb + j) * 64);
            const v4u l0 = lp[0], l1 = lp[1], l2 = lp[2], l3 = lp[3];
            float lf[16], lb[16];
            lf[0] = __uint_as_float(l0.x << 16); lf[1] = __uint_as_float(l0.x & 0xffff0000u); lf[2] = __uint_as_float(l0.y << 16); lf[3] = __uint_as_float(l0.y & 0xffff0000u);
            lf[4] = __uint_as_float(l0.z << 16); lf[5] = __uint_as_float(l0.z & 0xffff0000u); lf[6] = __uint_as_float(l0.w << 16); lf[7] = __uint_as_float(l0.w & 0xffff0000u);
            lf[8] = __uint_as_float(l1.x << 16); lf[9] = __uint_as_float(l1.x & 0xffff0000u); lf[10] = __uint_as_float(l1.y << 16); lf[11] = __uint_as_float(l1.y & 0xffff0000u);
            lf[12] = __uint_as_float(l1.z << 16); lf[13] = __uint_as_float(l1.z & 0xffff0000u); lf[14] = __uint_as_float(l1.w << 16); lf[15] = __uint_as_float(l1.w & 0xffff0000u);
            lb[0] = __uint_as_float(l2.x << 16); lb[1] = __uint_as_float(l2.x & 0xffff0000u); lb[2] = __uint_as_float(l2.y << 16); lb[3] = __uint_as_float(l2.y & 0xffff0000u);
            lb[4] = __uint_as_float(l2.z << 16); lb[5] = __uint_as_float(l2.z & 0xffff0000u); lb[6] = __uint_as_float(l2.w << 16); lb[7] = __uint_as_float(l2.w & 0xffff0000u);
            lb[8] = __uint_as_float(l3.x << 16); lb[9] = __uint_as_float(l3.x & 0xffff0000u); lb[10] = __uint_as_float(l3.y << 16); lb[11] = __uint_as_float(l3.y & 0xffff0000u);
            lb[12] = __uint_as_float(l3.z << 16); lb[13] = __uint_as_float(l3.z & 0xffff0000u); lb[14] = __uint_as_float(l3.w << 16); lb[15] = __uint_as_float(l3.w & 0xffff0000u);
            float zf0 = bf_.x, zf1 = bf_.y, zb0 = bb_.x, zb1 = bb_.y;
#pragma unroll
            for (int r = 0; r < 16; ++r) { zf0 += lf[r] * wf0[r]; zf1 += lf[r] * wf1[r]; zb0 += lb[r] * wb0[r]; zb1 += lb[r] * wb1[r]; }
            gf0[j] = log_sigmoid_fast(zf0) * 0.0625f; gf1[j] = log_sigmoid_fast(zf1) * 0.0625f; gb0[j] = log_sigmoid_fast(zb0) * 0.0625f; gb1[j] = log_sigmoid_fast(zb1) * 0.0625f; }
#pragma unroll
        for (int j = 1; j < 8; ++j) { gf0[j] += gf0[j - 1]; gf1[j] += gf1[j - 1]; gb0[7 - j] += gb0[8 - j]; gb1[7 - j] += gb1[8 - j]; }
        *(LAS f32x2*)(tot + (0 * 8 + tb) * 128 + 2 * d2) = (f32x2){gf0[7], gf1[7]}; *(LAS f32x2*)(tot + (1 * 8 + tb) * 128 + 2 * d2) = (f32x2){gb0[0], gb1[0]};
        __syncthreads();
        float pf0 = 0.f, pf1 = 0.f, pb0 = 0.f, pb1 = 0.f, lf0 = 0.f, lf1 = 0.f, lb0 = 0.f, lb1 = 0.f;
#pragma unroll
        for (int q = 0; q < 8; ++q) { const f32x2 a = *(const LAS f32x2*)(tot + (0 * 8 + q) * 128 + 2 * d2), c = *(const LAS f32x2*)(tot + (1 * 8 + q) * 128 + 2 * d2);
            lf0 += a.x; lf1 += a.y; lb0 += c.x; lb1 += c.y;
            if (q < tb) { pf0 += a.x; pf1 += a.y; } if (q > tb) { pb0 += c.x; pb1 += c.y; } }
        const size_t itf = (size_t)cn * 2, itb = itf + 1;
        bf16* Qf = (bf16*)(ws + WS_GQ) + itf * 8192; bf16* Qb = Qf + 8192; bf16* Kf = (bf16*)(ws + WS_GKH) + itf * 8192; bf16* Kb = Kf + 8192;
        const float elf0 = __expf(lf0), elf1 = __expf(lf1), elb0 = __expf(lb0), elb1 = __expf(lb1);
        float ktf0[8], ktf1[8], ktb0[8], ktb1[8];
#pragma unroll
        for (int j = 0; j < 8; ++j) { const int t = 8 * tb + j;
            const float q0 = __uint_as_float(qk[j][0] << 16) * 0.08838834764831845f, q1 = __uint_as_float(qk[j][0] & 0xffff0000u) * 0.08838834764831845f;
            const float k0 = __uint_as_float(qk[j][1] << 16), k1 = __uint_as_float(qk[j][1] & 0xffff0000u);
            const float ef0 = __expf(pf0 + gf0[j]), ef1 = __expf(pf1 + gf1[j]), eb0 = __expf(pb0 + gb0[j]), eb1 = __expf(pb1 + gb1[j]);
            const float rf0 = __builtin_amdgcn_rcpf(ef0), rf1 = __builtin_amdgcn_rcpf(ef1), rb0 = __builtin_amdgcn_rcpf(eb0), rb1 = __builtin_amdgcn_rcpf(eb1);
            *(GAS unsigned*)(Qf + t * 128 + 2 * d2) = pk2(q0 * ef0, q1 * ef1); *(GAS unsigned*)(Qb + t * 128 + 2 * d2) = pk2(q0 * eb0, q1 * eb1);
            *(GAS unsigned*)(Kf + t * 128 + 2 * d2) = pk2(k0 * rf0, k1 * rf1); *(GAS unsigned*)(Kb + t * 128 + 2 * d2) = pk2(k0 * rb0, k1 * rb1);
            ktf0[j] = k0 * rf0 * elf0; ktf1[j] = k1 * rf1 * elf1; ktb0[j] = k0 * rb0 * elb0; ktb1[j] = k1 * rb1 * elb1; }
        {
          unsigned char* Tf = ws + WS_GKT + itf * 16384 + (size_t)((((tb >> 1) * 4 + (d2 >> 4)) * 64 + ((2 * d2) & 31)) * 16 + 8 * (tb & 1)); unsigned char* Tb = Tf + 16384;
          *(GAS unsigned long long*)(Tf) = (unsigned long long)pk2(ktf0[0], ktf0[1]) | ((unsigned long long)pk2(ktf0[2], ktf0[3]) << 32);
          *(GAS unsigned long long*)(Tf + 512) = (unsigned long long)pk2(ktf0[4], ktf0[5]) | ((unsigned long long)pk2(ktf0[6], ktf0[7]) << 32);
          *(GAS unsigned long long*)(Tf + 16) = (unsigned long long)pk2(ktf1[0], ktf1[1]) | ((unsigned long long)pk2(ktf1[2], ktf1[3]) << 32);
          *(GAS unsigned long long*)(Tf + 528) = (unsigned long long)pk2(ktf1[4], ktf1[5]) | ((unsigned long long)pk2(ktf1[6], ktf1[7]) << 32);
          *(GAS unsigned long long*)(Tb) = (unsigned long long)pk2(ktb0[0], ktb0[1]) | ((unsigned long long)pk2(ktb0[2], ktb0[3]) << 32);
          *(GAS unsigned long long*)(Tb + 512) = (unsigned long long)pk2(ktb0[4], ktb0[5]) | ((unsigned long long)pk2(ktb0[6], ktb0[7]) << 32);
          *(GAS unsigned long long*)(Tb + 16) = (unsigned long long)pk2(ktb1[0], ktb1[1]) | ((unsigned long long)pk2(ktb1[2], ktb1[3]) << 32);
          *(GAS unsigned long long*)(Tb + 528) = (unsigned long long)pk2(ktb1[4], ktb1[5]) | ((unsigned long long)pk2(ktb1[6], ktb1[7]) << 32); }
        if (tb == 0) { float* DLp = (float*)(ws + WS_GDL) + itf * 128 + 2 * d2; *(GAS f32x2*)DLp = (f32x2){elf0, elf1}; *(GAS f32x2*)(DLp + 128) = (f32x2){elb0, elb1}; }
    }
}
struct G12Ops { bf16x8 a[4], b[4]; f32x4 d[4]; };
__device__ __forceinline__ void g12_load(G12Ops& o, unsigned char* ws, int bh, int dir, int m, int kb, int vb, int r, int hh) {
    const int n = dir ? (m < 4 ? 3 - m : 71 - m) : m; const size_t cn = (size_t)bh * 68 + n, item = cn * 2 + dir;
    const GAS bf16x8* ap = (const GAS bf16x8*)(ws + WS_GKT + item * 16384) + kb * 64 + (hh * 32 + r);
    const GAS bf16x8* bp = (const GAS bf16x8*)(ws + WS_GVT + cn * 32768) + vb * 64 + (hh * 32 + r);
    const float* dp = (const float*)(ws + WS_GDL) + item * 128 + 32 * kb + 4 * hh;
#pragma unroll
    for (int ks = 0; ks < 4; ++ks) { o.a[ks] = ap[ks * 256]; o.b[ks] = bp[ks * 512]; o.d[ks] = *(const GAS f32x4*)(dp + 8 * ks); }
}
__device__ __forceinline__ void phase_gla_g12(unsigned char* ws, LAS unsigned char* lds, int gwv, int wave, int lane) {
    if (gwv >= 2048) return;
    const int chain = gwv >> 5, blk = gwv & 31, kb = blk & 3, vb = blk >> 2, dir = chain & 1, bh = chain >> 1;
    const int r = lane & 31, hh = lane >> 5;
    LAS unsigned char* wl = lds + RING_OFF + wave * 2048;
    f32x16 acc;
#pragma unroll
    for (int g = 0; g < 16; ++g) acc[g] = 0.f;
    G12Ops o0, o1, o2;
    g12_load(o0, ws, bh, dir, 0, kb, vb, r, hh); g12_load(o1, ws, bh, dir, 1, kb, vb, r, hh);
#define G12_STEP(CUR, m_) do { const int mm_ = (m_); const int n = dir ? (mm_ < 4 ? 3 - mm_ : 71 - mm_) : mm_; \
        _Pragma("unroll") for (int gg = 0; gg < 4; ++gg) *(LAS unsigned long long*)(wl + (((gg >> 1) * 64 + (gg & 1) * 32 + r) * 16 + 8 * hh)) = (unsigned long long)pk2(acc[4 * gg], acc[4 * gg + 1]) | ((unsigned long long)pk2(acc[4 * gg + 2], acc[4 * gg + 3]) << 32); \
        LDS_WAIT(); const v4u s0 = *(const LAS v4u*)(wl + lane * 16), s1 = *(const LAS v4u*)(wl + 1024 + lane * 16); LDS_WAIT(); \
        { bf16* sp = (bf16*)(ws + WS_SX) + ((size_t)(bh * 2 + dir) * 68 + n) * 32768 + (size_t)(kb * 8 + vb) * 1024; ((GAS v4u*)sp)[lane] = s0; ((GAS v4u*)sp)[64 + lane] = s1; } \
        _Pragma("unroll") for (int gg = 0; gg < 4; ++gg) { acc[4 * gg] *= CUR.d[gg].x; acc[4 * gg + 1] *= CUR.d[gg].y; acc[4 * gg + 2] *= CUR.d[gg].z; acc[4 * gg + 3] *= CUR.d[gg].w; } \
        _Pragma("unroll") for (int ks = 0; ks < 4; ++ks) acc = __builtin_amdgcn_mfma_f32_32x32x16_bf16(CUR.a[ks], CUR.b[ks], acc, 0, 0, 0); } while (0)
    for (int m = 0; m < 66; m += 3) {
        g12_load(o2, ws, bh, dir, m + 2, kb, vb, r, hh); G12_STEP(o0, m);
        g12_load(o0, ws, bh, dir, m + 3, kb, vb, r, hh); G12_STEP(o1, m + 1);
        g12_load(o1, ws, bh, dir, (m + 4 < 68) ? m + 4 : 67, kb, vb, r, hh); G12_STEP(o2, m + 2);
    }
    G12_STEP(o0, 66); G12_STEP(o1, 67);
#undef G12_STEP
}
constexpr int G3_RS = 272, G3_TILE = 64 * G3_RS, G3_OL = 4 * G3_TILE  , G3_LD = 260;
static_assert(G3_OL + 64 * G3_LD * 4 <= MISC_OFF, "G3 LDS");
__device__ __forceinline__ void phase_gla_g3(unsigned char* ws, int lg, LAS unsigned char* lds, int tid) {
    const int lane = tid & 63, wave = __builtin_amdgcn_readfirstlane(tid >> 6), r = lane & 31, hh = lane >> 5, vb = wave;
    LAS unsigned char* TL = lds + RING_OFF; LAS float* OL = (LAS float*)(lds + RING_OFF + G3_OL);
    const bf16* G = (const bf16*)(ws + WS_G); bf16* OG = (bf16*)(ws + WS_Q);
    for (int cn = blockIdx.x; cn < 2176; cn += gridDim.x) {
        const int n = cn % 68, bh = cn / 68, h = bh & 3, b = bh >> 2;
        v4u st[4][2];
#pragma unroll
        for (int tl = 0; tl < 4; ++tl) { const bf16* src = (const bf16*)(ws + ((tl & 1) ? WS_GKH : WS_GQ)) + ((size_t)cn * 2 + (tl >> 1)) * 8192;
#pragma unroll
            for (int j = 0; j < 2; ++j) st[tl][j] = ((const GAS v4u*)src)[tid + 512 * j]; }
        __syncthreads();
#pragma unroll
        for (int tl = 0; tl < 4; ++tl)
#pragma unroll
            for (int j = 0; j < 2; ++j) { const int q = tid + 512 * j, row = q >> 4, ch = q & 15; *(LAS v4u*)(TL + tl * G3_TILE + row * G3_RS + ch * 16) = st[tl][j]; }
        __syncthreads();
        f32x16 P00, P01, P10, P11, O0, O1;
#pragma unroll
        for (int g = 0; g < 16; ++g) { P00[g] = 0.f; P01[g] = 0.f; P10[g] = 0.f; P11[g] = 0.f; O0[g] = 0.f; O1[g] = 0.f; }
#pragma unroll
        for (int dir = 0; dir < 2; ++dir) {
            const LAS unsigned char* Qt = TL + (2 * dir) * G3_TILE + r * G3_RS + 16 * hh; const LAS unsigned char* Kh = TL + (2 * dir + 1) * G3_TILE + r * G3_RS + 16 * hh;
            const GAS bf16x8* Sx = (const GAS bf16x8*)((const bf16*)(ws + WS_SX) + ((size_t)(bh * 2 + dir) * 68 + n) * 32768 + (size_t)vb * 1024) + lane;
            f32x16 X00, X11, Xoff;
#pragma unroll
            for (int g = 0; g < 16; ++g) { X00[g] = 0.f; X11[g] = 0.f; Xoff[g] = 0.f; }
#pragma unroll
            for (int s = 0; s < 8; ++s) {
                const bf16x8 q0 = *(const LAS bf16x8*)(Qt + 32 * s), q1 = *(const LAS bf16x8*)(Qt + 32 * G3_RS + 32 * s);
                const bf16x8 k0 = *(const LAS bf16x8*)(Kh + 32 * s), k1 = *(const LAS bf16x8*)(Kh + 32 * G3_RS + 32 * s);
                const bf16x8 sx = Sx[(s >> 1) * 1024 + (s & 1) * 64];
                X00 = __builtin_amdgcn_mfma_f32_32x32x16_bf16(k0, q0, X00, 0, 0, 0);
                X11 = __builtin_amdgcn_mfma_f32_32x32x16_bf16(k1, q1, X11, 0, 0, 0);
                if (dir == 0) Xoff = __builtin_amdgcn_mfma_f32_32x32x16_bf16(k0, q1, Xoff, 0, 0, 0); else Xoff = __builtin_amdgcn_mfma_f32_32x32x16_bf16(k1, q0, Xoff, 0, 0, 0);
                O0 = __builtin_amdgcn_mfma_f32_32x32x16_bf16(q0, sx, O0, 0, 0, 0); O1 = __builtin_amdgcn_mfma_f32_32x32x16_bf16(q1, sx, O1, 0, 0, 0); }
#pragma unroll
            for (int g = 0; g < 16; ++g) { const int tj = (g & 3) + 8 * (g >> 2) + 4 * hh; const bool keep = dir ? (tj >= r) : (tj <= r);
                P00[g] += keep ? X00[g] : 0.f; P11[g] += keep ? X11[g] : 0.f;
                if (dir == 0) P01[g] += Xoff[g]; else P10[g] += Xoff[g]; }
        }
        { const GAS bf16x8* Vt = (const GAS bf16x8*)(ws + WS_GVT + (size_t)cn * 32768) + vb * 64 + lane;
#pragma unroll
          for (int jb = 0; jb < 2; ++jb)
#pragma unroll
            for (int s2 = 0; s2 < 2; ++s2) { const bf16x8 bfv = Vt[(2 * jb + s2) * 512];
                const f32x16& Pa = jb ? P10 : P00; const f32x16& Pb = jb ? P11 : P01;
                const bf16x8 a0 = __builtin_bit_cast(bf16x8, ((v4u){pk2(Pa[8 * s2 + 0], Pa[8 * s2 + 1]), pk2(Pa[8 * s2 + 2], Pa[8 * s2 + 3]), pk2(Pa[8 * s2 + 4], Pa[8 * s2 + 5]), pk2(Pa[8 * s2 + 6], Pa[8 * s2 + 7])}));
                const bf16x8 a1 = __builtin_bit_cast(bf16x8, ((v4u){pk2(Pb[8 * s2 + 0], Pb[8 * s2 + 1]), pk2(Pb[8 * s2 + 2], Pb[8 * s2 + 3]), pk2(Pb[8 * s2 + 4], Pb[8 * s2 + 5]), pk2(Pb[8 * s2 + 6], Pb[8 * s2 + 7])}));
                O0 = __builtin_amdgcn_mfma_f32_32x32x16_bf16(a0, bfv, O0, 0, 0, 0); O1 = __builtin_amdgcn_mfma_f32_32x32x16_bf16(a1, bfv, O1, 0, 0, 0); } }
#pragma unroll
        for (int g = 0; g < 16; ++g) { const int t = (g & 3) + 8 * (g >> 2) + 4 * hh; OL[t * G3_LD + 32 * vb + r] = O0[g]; OL[(32 + t) * G3_LD + 32 * vb + r] = O1[g]; }
        __syncthreads();
        { const int t = tid >> 3, cc = tid & 7; const LAS f32x4* op = (const LAS f32x4*)(OL + t * G3_LD + 32 * cc);
          f32x4 o[8]; float ss = 0.f;
#pragma unroll
          for (int j = 0; j < 8; ++j) { o[j] = op[j]; ss += (o[j].x * o[j].x + o[j].y * o[j].y) + (o[j].z * o[j].z + o[j].w * o[j].w); }
          ss += __shfl_xor(ss, 1); ss += __shfl_xor(ss, 2); ss += __shfl_xor(ss, 4);
          const float rs = 1.0f / sqrtf(ss * (1.0f / 256.0f) + RMS_EPS);
          const size_t row = (size_t)b * TB + 64 * n + t;
          const GAS v4u* rp = (const GAS v4u*)(G + row * WINP + 2048 + h * 256 + 32 * cc); const GAS f32x4* gp = (const GAS f32x4*)(PARF(ws) + P_OG + lg * 256 + 32 * cc);
          GAS v4u* dst = (GAS v4u*)(OG + row * 1024 + h * 256 + 32 * cc);
#pragma unroll
          for (int j = 0; j < 4; ++j) { const v4u rv = rp[j]; const f32x4 g0 = gp[2 * j], g1 = gp[2 * j + 1]; const f32x4 a = o[2 * j] * rs * g0, c2 = o[2 * j + 1] * rs * g1;
              v4u w;
              w.x = pk2(a.x * silu_f(__uint_as_float(rv.x << 16)), a.y * silu_f(__uint_as_float(rv.x & 0xffff0000u)));
              w.y = pk2(a.z * silu_f(__uint_as_float(rv.y << 16)), a.w * silu_f(__uint_as_float(rv.y & 0xffff0000u)));
              w.z = pk2(c2.x * silu_f(__uint_as_float(rv.z << 16)), c2.y * silu_f(__uint_as_float(rv.z & 0xffff0000u)));
              w.w = pk2(c2.z * silu_f(__uint_as_float(rv.w << 16)), c2.w * silu_f(__uint_as_float(rv.w & 0xffff0000u)));
              dst[j] = w; } }
    }
}
constexpr int WIMG_RS = 2064;
static_assert(2 * 32 * WIMG_RS <= LDS_AUX, "router images below the aux tables");
__device__ __forceinline__ void phase_modulate2_route(unsigned char* ws, int layer, LAS unsigned char* lds, int vcu, int wave, int lane, int tid, bool dummy = false) {
    const bf16* X = (const bf16*)(ws + WS_X); bf16* XN = (bf16*)(ws + WS_XN);
    const float* ng = PARF(ws) + P_N2G + layer * 1024; const float* Mo = (const float*)(ws + WS_MOD) + (size_t)layer * MODROWS * NMODC;
    LAS unsigned char* WHI = lds + RING_OFF; LAS unsigned char* WLO = WHI + 32 * WIMG_RS;
    LAS unsigned* lcnt = (LAS unsigned*)(lds + AUX_LCNT); LAS unsigned* gb = (LAS unsigned*)(lds + AUX_GB); LAS unsigned* ent = (LAS unsigned*)(lds + AUX_ENT); LAS float* rsl = (LAS float*)(lds + AUX_RS);
    { const float* wsrc = PARF(ws) + P_WR + (size_t)layer * 1024 * 32;
      for (int idx = tid; idx < 1024 * 32; idx += NWAVES * 64) { const int k = idx >> 5, e = idx & 31; const float w = wsrc[idx]; const unsigned hi = f2bf(w), lo = f2bf(w - __uint_as_float(hi << 16));
          *(LAS unsigned short*)(WHI + e * WIMG_RS + 2 * k) = (unsigned short)hi; *(LAS unsigned short*)(WLO + e * WIMG_RS + 2 * k) = (unsigned short)lo; }
      if (tid < 32) lcnt[tid] = 0u; }
    gu32* cnt = (gu32*)(ws + WS_CTL) + CW_CNT + (layer + (dummy ? 4 : 0)) * 32 * 16;
    unsigned char* sbase = dummy ? ws + WS_XG : ws;
    const bool lastl = (layer == NLAYER - 1);
  for (int grp = vcu; grp < MT / 136; grp += (int)gridDim.x) {
    const int rbase = grp * 136;
    if (grp != vcu) { __syncthreads(); if (tid < 32) lcnt[tid] = 0u; }
    for (int rl = wave; rl < 136; rl += 2 * NWAVES) {
        const int rl2 = (rl + NWAVES < 136) ? rl + NWAVES : rl; const int m = rbase + rl, m2 = rbase + rl2, mr = mod_row(m), mr2 = mod_row(m2);
        float rs, rs2;
        modulate_row2(X + (size_t)m * 1024, X + (size_t)m2 * 1024, ng, Mo + (size_t)mr * NMODC + 3 * 1024, Mo + (size_t)mr * NMODC + 4 * 1024, Mo + (size_t)mr2 * NMODC + 3 * 1024, Mo + (size_t)mr2 * NMODC + 4 * 1024,
                      ws + WS_XN8 + (size_t)m * 1024, ws + WS_XN8 + (size_t)m2 * 1024, lane, rs, rs2);
        if (lane == 0) { rsl[rl] = rs; rsl[rl2] = rs2; } }
    __syncthreads();
    if (wave < 5) {
        const int r = lane & 31, hh = lane >> 5; const int rl = (32 * wave + r < 136) ? 32 * wave + r : 135; const int m = rbase + rl, mr = mod_row(m);
        const float rsr = rsl[rl];
        const bf16* xp = X + (size_t)m * 1024 + 8 * hh; const float* gp = ng + 8 * hh; const float* scp = Mo + (size_t)mr * NMODC + 4 * 1024 + 8 * hh; const float* shp = Mo + (size_t)mr * NMODC + 3 * 1024 + 8 * hh;
        const LAS unsigned char* wh = WHI + r * WIMG_RS + 16 * hh; const LAS unsigned char* wl = WLO + r * WIMG_RS + 16 * hh;
        f32x16 acc;
#pragma unroll
        for (int g = 0; g < 16; ++g) acc[g] = 0.f;
#pragma unroll 2
        for (int s = 0; s < 64; ++s) {
            const v4u xr8 = *(const GAS v4u*)(xp + 16 * s); const f32x4 x0 = (f32x4){__uint_as_float(xr8.x << 16), __uint_as_float(xr8.x & 0xffff0000u), __uint_as_float(xr8.y << 16), __uint_as_float(xr8.y & 0xffff0000u)}, x1 = (f32x4){__uint_as_float(xr8.z << 16), __uint_as_float(xr8.z & 0xffff0000u), __uint_as_float(xr8.w << 16), __uint_as_float(xr8.w & 0xffff0000u)}; const f32x4 g0 = *(const GAS f32x4*)(gp + 16 * s), g1 = *(const GAS f32x4*)(gp + 16 * s + 4);
            const f32x4 c0 = *(const GAS f32x4*)(scp + 16 * s), c1 = *(const GAS f32x4*)(scp + 16 * s + 4), h0 = *(const GAS f32x4*)(shp + 16 * s), h1 = *(const GAS f32x4*)(shp + 16 * s + 4);
            const f32x4 y0 = (x0 * rsr) * g0 * (c0 + 1.0f) + h0, y1 = (x1 * rsr) * g1 * (c1 + 1.0f) + h1;
            v4u ph, pl;
            ph.x = pg8::cvt_pk_bf16(y0.x, y0.y); ph.y = pg8::cvt_pk_bf16(y0.z, y0.w); ph.z = pg8::cvt_pk_bf16(y1.x, y1.y); ph.w = pg8::cvt_pk_bf16(y1.z, y1.w);
            pl.x = pg8::cvt_pk_bf16(y0.x - __uint_as_float(ph.x << 16), y0.y - __uint_as_float(ph.x & 0xffff0000u)); pl.y = pg8::cvt_pk_bf16(y0.z - __uint_as_float(ph.y << 16), y0.w - __uint_as_float(ph.y & 0xffff0000u));
            pl.z = pg8::cvt_pk_bf16(y1.x - __uint_as_float(ph.z << 16), y1.y - __uint_as_float(ph.z & 0xffff0000u)); pl.w = pg8::cvt_pk_bf16(y1.z - __uint_as_float(ph.w << 16), y1.w - __uint_as_float(ph.w & 0xffff0000u));
            const bf16x8 ahi = __builtin_bit_cast(bf16x8, ph), alo = __builtin_bit_cast(bf16x8, pl);
            const bf16x8 bhi = *(const LAS bf16x8*)(wh + 32 * s), blo = *(const LAS bf16x8*)(wl + 32 * s);
            acc = __builtin_amdgcn_mfma_f32_32x32x16_bf16(ahi, bhi, acc, 0, 0, 0); acc = __builtin_amdgcn_mfma_f32_32x32x16_bf16(alo, bhi, acc, 0, 0, 0); acc = __builtin_amdgcn_mfma_f32_32x32x16_bf16(ahi, blo, acc, 0, 0, 0); }
        const float brt = (PARF(ws) + P_BR)[layer * 32 + r];
#pragma unroll
        for (int g = 0; g < 16; ++g) { const int rowl = 32 * wave + (g & 3) + 8 * (g >> 2) + 4 * hh;
            float v = acc[g] + brt; float tv[4]; int te[4];
#pragma unroll
            for (int k = 0; k < 4; ++k) { float mx = v;
#pragma unroll
                for (int o = 1; o < 32; o <<= 1) mx = fmaxf(mx, shx(mx, o, lane));
                const unsigned long long bm = __ballot(v == mx); const unsigned hm = hh ? (unsigned)(bm >> 32) : (unsigned)bm; const int first = __ffs((int)hm) - 1;
                te[k] = first; tv[k] = mx; if (r == first) v = -INFINITY; }
            const bool valid = rowl < 136 && !(lastl && mod_row(rbase + (rowl < 136 ? rowl : 135)) == 8);
            if (r == 0 && rowl < 136) {
                if (valid) { const float e1 = __expf(tv[1] - tv[0]), e2 = __expf(tv[2] - tv[0]), e3 = __expf(tv[3] - tv[0]); const float inv = 1.0f / (1.0f + e1 + e2 + e3);
                    const float wk[4] = {inv, e1 * inv, e2 * inv, e3 * inv};
#pragma unroll
                    for (int k = 0; k < 4; ++k) { const unsigned lp = atomicAdd((unsigned*)&lcnt[te[k]], 1u); ent[(rowl * 4 + k) * 2 + 0] = ((unsigned)te[k] << 24) | lp; ent[(rowl * 4 + k) * 2 + 1] = __float_as_uint(wk[k]); } }
                else {
#pragma unroll
                    for (int k = 0; k < 4; ++k) ent[(rowl * 4 + k) * 2 + 0] = 0xffffffffu; } } }
    }
    __syncthreads();
    if (tid < 32) gb[tid] = __hip_atomic_fetch_add(cnt + tid * 16, lcnt[tid], __ATOMIC_RELAXED, __HIP_MEMORY_SCOPE_AGENT);
    __syncthreads();
    for (int q = tid; q < 136 * 4; q += NWAVES * 64) { const unsigned pe = ent[q * 2 + 0];
        if (pe != 0xffffffffu) { const unsigned e = pe >> 24, lp = pe & 0xffffffu; const int m = rbase + (q >> 2);
            ((unsigned*)(sbase + WS_SLOT))[m * 4 + (q & 3)] = (e << 24) | (gb[e] + lp); ((unsigned*)(sbase + WS_GATEW))[m * 4 + (q & 3)] = ent[q * 2 + 1];
            if (!dummy) ((int*)(ws + WS_LIST))[(size_t)e * MT + gb[e] + lp] = m; } }
  }
}
__device__ __forceinline__ void build_expert_tables(unsigned char* ws, int layer, LAS unsigned char* lds, int tid) {
    LAS int* t2e = (LAS int*)(lds + AUX_T2E); LAS int* base = (LAS int*)(lds + AUX_BASE); LAS int* ntp = (LAS int*)(lds + AUX_NT); LAS int* cntl = (LAS int*)(lds + AUX_CNT);
    gu32* cnt = (gu32*)(ws + WS_CTL) + CW_CNT + layer * 32 * 16;
    __syncthreads();
    if (tid < 64) { const unsigned cval = (tid < 32) ? __hip_atomic_load(cnt + tid * 16, RLX_AGENT) : 0u; const int tiles = (int)((cval + 255u) >> 8);
        int pre = tiles;
#pragma unroll
        for (int o = 1; o < 32; o <<= 1) { const int ln = tid & 63; const int t = __builtin_amdgcn_ds_bpermute(((ln >= o) ? ln - o : ln) << 2, pre); if (ln >= o) pre += t; }
        const int start = pre - tiles;
        if (tid < 32) { base[tid] = start * 256; cntl[tid] = (int)cval; for (int t = 0; t < tiles; ++t) t2e[start + t] = tid; if (tid == 31) ntp[0] = pre; } }
    __syncthreads();
}
__device__ __forceinline__ void phase_moe_gather(unsigned char* ws, int layer, LAS unsigned char* lds, int gw, int NGW, int lane, int tid) {
    build_expert_tables(ws, layer, lds, tid);
    const LAS int* base = (const LAS int*)(lds + AUX_BASE);
    const bf16* XN = (const bf16*)(ws + WS_XN); bf16* XG = (bf16*)(ws + WS_XG);
    const unsigned* slot = (const unsigned*)(ws + WS_SLOT); unsigned* spos = (unsigned*)(ws + WS_SLOTPOS);
    for (int m = gw; m < MT; m += NGW) {
        if (layer == NLAYER - 1 && mod_row(m) == 8) continue;
        const GAS v4u* src = (const GAS v4u*)(XN + (size_t)m * 1024) + lane; const v4u a = src[0], b = src[64];
#pragma unroll
        for (int k = 0; k < 4; ++k) { const unsigned pe = slot[m * 4 + k]; const int dst = base[pe >> 24] + (int)(pe & 0xffffffu);
            GAS v4u* dp = (GAS v4u*)(XG + (size_t)dst * 1024) + lane; dp[0] = a; dp[64] = b;
            if (lane == 0) spos[m * 4 + k] = (unsigned)dst; }
    }
}
__device__ __forceinline__ void phase_moe_combine(unsigned char* ws, float* out, int layer, LAS unsigned char* lds, int gw, int NGW, int lane, int tid, bool dummy = false) {
    build_expert_tables(ws, layer, lds, tid);
    const LAS int* base = (const LAS int*)(lds + AUX_BASE);
    bf16* X = (bf16*)(ws + WS_X); const unsigned char* Y = ws + WS_Y;
    const float* Mo = (const float*)(ws + WS_MOD) + (size_t)layer * MODROWS * NMODC;
    const unsigned* slot = (const unsigned*)(ws + WS_SLOT); const float* gw4 = (const float*)(ws + WS_GATEW);
    for (int m0 = gw; m0 < MT; m0 += 2 * NGW) {
        int mm[2], bb[2], ww[2], mrr[2]; bool ok[2];
#pragma unroll
        for (int p = 0; p < 2; ++p) { const int m = m0 + p * NGW; ok[p] = m < MT; mm[p] = ok[p] ? m : m0; bb[p] = mm[p] / TB; ww[p] = mm[p] - bb[p] * TB; mrr[p] = (ww[p] < CTXL) ? 8 : bb[p];
            if (layer == NLAYER - 1 && ww[p] < CTXL) ok[p] = false; }
        if (!ok[0] && !ok[1]) continue;
        unsigned pe[2][4]; float wk[2][4];
#pragma unroll
        for (int p = 0; p < 2; ++p)
#pragma unroll
            for (int k = 0; k < 4; ++k) { pe[p][k] = slot[mm[p] * 4 + k]; wk[p][k] = gw4[mm[p] * 4 + k]; }
        unsigned long long xv[2][4];
#pragma unroll
        for (int p = 0; p < 2; ++p) { const GAS unsigned long long* xp = (const GAS unsigned long long*)(X + (size_t)mm[p] * 1024) + lane;
#pragma unroll
            for (int j = 0; j < 4; ++j) xv[p][j] = xp[64 * j]; }
        unsigned yv[2][4][4];
#pragma unroll
        for (int p = 0; p < 2; ++p)
#pragma unroll
            for (int k = 0; k < 4; ++k) { unsigned e = pe[p][k] >> 24; if (!ok[p] || e > 31u) e = 0u;
                const unsigned sp = ok[p] ? (unsigned)base[e] + (pe[p][k] & 0xffffffu) : 0u;
                const GAS unsigned* yp = (const GAS unsigned*)(Y + (size_t)sp * 1024) + lane;
#pragma unroll
                for (int j = 0; j < 4; ++j) yv[p][k][j] = yp[64 * j]; }
        f32x4 f[2][4]; float ss[2];
#pragma unroll
        for (int p = 0; p < 2; ++p) { const GAS f32x4* gp = (const GAS f32x4*)(Mo + (size_t)mrr[p] * NMODC + 5 * 1024) + lane;
            ss[p] = 0.f;
#pragma unroll
            for (int j = 0; j < 4; ++j) { f32x4 a = (f32x4){0.f, 0.f, 0.f, 0.f};
#pragma unroll
                for (int k = 0; k < 4; ++k) { const unsigned w8 = yv[p][k][j]; const f32x2 lo2 = __builtin_amdgcn_cvt_pk_f32_fp8((int)w8, false), hi2 = __builtin_amdgcn_cvt_pk_f32_fp8((int)w8, true); a = a + (f32x4){lo2.x, lo2.y, hi2.x, hi2.y} * wk[p][k]; }
                f[p][j] = bf4_to_f32(xv[p][j]) + gp[64 * j] * a; } }
        asm volatile("" ::: "memory");
        const bool fuse = (layer < NLAYER - 1) && !dummy;
#pragma unroll
        for (int p = 0; p < 2; ++p) { if (!ok[p]) continue;
            GAS unsigned long long* xp = (GAS unsigned long long*)(X + (size_t)mm[p] * 1024) + lane;
            GAS f32x4* op = (GAS f32x4*)(out + ((size_t)bb[p] * SEQ + (ww[p] - CTXL)) * 1024) + lane;
#pragma unroll
            for (int j = 0; j < 4; ++j) { if (dummy) ((GAS f32x4*)((float*)(ws + WS_XG) + (size_t)mm[p] * 1024) + lane)[64 * j] = f[p][j]; else if (layer == NLAYER - 1) op[64 * j] = f[p][j]; else { const unsigned long long pk = f32_to_bf4(f[p][j]); xp[64 * j] = pk; f[p][j] = bf4_to_f32(pk); }
                ss[p] += (f[p][j].x * f[p][j].x + f[p][j].y * f[p][j].y) + (f[p][j].z * f[p][j].z + f[p][j].w * f[p][j].w); }
            if (fuse) { const float rs = 1.0f / sqrtf(wave_sum(ss[p]) * (1.0f / 1024.0f) + RMS_EPS);
                const float* ng = PARF(ws) + P_N1G + (layer + 1) * 1024; const float* Mn = (const float*)(ws + WS_MOD) + (size_t)(layer + 1) * MODROWS * NMODC + (size_t)mrr[p] * NMODC;
                GAS unsigned long long* o8 = (GAS unsigned long long*)((bf16*)(ws + WS_XN) + (size_t)mm[p] * 1024) + lane;
#pragma unroll
                for (int j = 0; j < 4; ++j) { const f32x4 g = ((const GAS f32x4*)ng)[64 * j + lane], sh = ((const GAS f32x4*)Mn)[64 * j + lane], sc = ((const GAS f32x4*)(Mn + 1024))[64 * j + lane];
                    o8[64 * j] = f32_to_bf4((f[p][j] * rs) * g * (sc + 1.0f) + sh); } } }
    }
}

constexpr int NPH_L = 11, NPHASE = 2 + NPH_L * NLAYER;
#ifndef PHMASK
#define PHMASK 0x7fff
#endif
#define EN(b) ((PHMASK >> (b)) & 1)
#ifndef DUPMASK
#define DUPMASK 0
#endif
#define DUP(b) for (int rep_ = 0; rep_ < (((DUPMASK >> (b)) & 1) ? 2 : 1); ++rep_)
__global__ void __launch_bounds__(NWAVES * 64, 2) dit_fwd(Args args) {
    extern __shared__ __attribute__((aligned(16))) unsigned char lds_raw[];
    LAS unsigned char* lds = (LAS unsigned char*)lds_raw;
    volatile LAS unsigned* MISC = (volatile LAS unsigned*)(lds + MISC_OFF);
    const int G = gridDim.x, bx = blockIdx.x;
    const int vcu = (G % 8 == 0) ? (bx % 8) * (G / 8) + bx / 8 : bx;
    const int wave0 = __builtin_amdgcn_readfirstlane((int)threadIdx.x >> 6);
#define LANE_ID(z) ((int)__builtin_amdgcn_mbcnt_hi(~0u, __builtin_amdgcn_mbcnt_lo(~0u, (z))))
    { const int t0 = (wave0 << 6) | LANE_ID(0u); for (int u = t0; u < (LDS_BYTES - MISC_OFF) / 4; u += NWAVES * 64) ((LAS unsigned*)(lds + MISC_OFF))[u] = 0u; }
    __syncthreads();
    const int lo = args.ph_lo, hi = args.ph_hi;
    XcdBarrier bar; bar.bar = (unsigned*)(args.ws + WS_CTL) + CW_BAR; bar.x = 0; bar.st = nullptr;
    if (hi - lo > 1) bar = xcd_barrier_post((unsigned*)(args.ws + WS_CTL) + CW_BAR, MISC + 8, wave0 == 0 && LANE_ID(0u) == 0);
#define IN(k) (lo <= (k) && (k) < hi)
#define SEAM(k) do { if (IN(k) && IN((k) + 1)) { XcdBarrier b_ = bar; unsigned zb_ = 0u; LAUNDER_S(zb_); b_.bar = bar.bar + zb_; xcd_barrier(b_, wave0 == 0 && LANE_ID(zb_) == 0); } } while (0)
#define PHASE_IDS() unsigned zoff_ = 0u; LAUNDER_S(zoff_); int tid = (wave0 << 6) | LANE_ID(zoff_); LAUNDER_V(tid); const int lane = tid & 63, wave = __builtin_amdgcn_readfirstlane(tid >> 6); const int gw = vcu * NWAVES + wave, NGW = G * NWAVES; \
    unsigned char* ws = args.ws + zoff_; const int Gp = G + (int)zoff_, bxp = bx + (int)zoff_; (void)lane; (void)gw; (void)NGW; (void)Gp; (void)bxp;

    if (EN(0) && IN(0)) DUP(0) { PHASE_IDS(); p0_prologue(args, lds, gw, NGW, wave, lane); } SEAM(0);
    if (EN(1) && IN(1)) { PHASE_IDS(); p1_mod_reduce(args, gw * 64 + lane, NGW * 64); } SEAM(1);

    for (int layer = 0; layer < NLAYER; ++layer) {
        const int pb = 2 + NPH_L * layer, lh = layer >> 1;
        if (layer == 0) { if (EN(2) && IN(pb + 0)) DUP(2) { PHASE_IDS(); phase_modulate1(ws, layer, gw, NGW, lane); } SEAM(pb + 0); }
        if ((layer & 1) == 0) {
            if (EN(3) && IN(pb + 1)) DUP(3) {
                PHASE_IDS();
                pg8::Gemm g{(const pg8::bf16_t*)(ws + WS_XN), (const pg8::bf16_t*)(ws + WS_WQKV) + (size_t)lh * QKVN * 1024, MT, QKVN, 1024, 0};
                pg8::StaticOrder S; S.init(MT, QKVN, Gp, bxp);
                LAS float* gl = (LAS float*)(lds + AUX_RS);
                if (tid < 128) gl[tid] = (PARF(ws) + (tid < 64 ? P_QG : P_KG - 64) + lh * 64)[tid];
                __syncthreads();
                pg8::EpiQKV E{ws, WS_Q, WS_K - WS_Q, WS_V - WS_K, gl, (const float*)(ws + WS_ROPE), ATT_C2};
                pg8::gemm_phase<pg8::EpiQKV, pg8::StaticOrder, true, true>(lds + RING_OFF, g, S, E, tid);
            } SEAM(pb + 1);
            if (EN(5) && IN(pb + 3)) DUP(5) {
                PHASE_IDS();
                const attn_body::bf16* Qp = (const attn_body::bf16*)(ws + WS_Q); const attn_body::bf16* Kp = (const attn_body::bf16*)(ws + WS_K); const attn_body::bf16* Vp = (const attn_body::bf16*)(ws + WS_V);
                attn_body::bf16* Op = (attn_body::bf16*)(ws + WS_XN);
                if (G == 256) {
                    for (int i = 0; i < 9; ++i) {
                        long qrow0, kvrow0; int NT, h;
                        if (i < 8) { const int x = vcu >> 5, j = vcu & 31, pair = 4 * x + (i >> 1), wi = (i & 1) * 32 + j, hq = wi >> 4, qb = wi & 15, b = pair >> 2, hk = pair & 3;
                            h = hk * 4 + hq; qrow0 = (long)b * TB + CTXL + qb * 256; kvrow0 = (long)b * TB; NT = TB / 64; }
                        else { if (vcu >= 128) break; const int b = vcu >> 4; h = vcu & 15; qrow0 = (long)b * TB; kvrow0 = qrow0; NT = CTXL / 64; }
                        attn_body::attn_unit<8>(qrow0, kvrow0, NT, h, Qp, Kp, Vp, Op, (char*)lds_raw + RING_OFF, tid);
                    }
                } else {
                    for (int U = bx; U < 2048 + 128; U += G) {
                        long qrow0, kvrow0; int NT, h;
                        if (U < 2048) { const int pair = U >> 6, wi = U & 63, hq = wi >> 4, qb = wi & 15, b = pair >> 2, hk = pair & 3; h = hk * 4 + hq; qrow0 = (long)b * TB + CTXL + qb * 256; kvrow0 = (long)b * TB; NT = TB / 64; }
                        else { const int v = U - 2048, b = v >> 4; h = v & 15; qrow0 = (long)b * TB; kvrow0 = qrow0; NT = CTXL / 64; }
                        attn_body::attn_unit<8>(qrow0, kvrow0, NT, h, Qp, Kp, Vp, Op, (char*)lds_raw + RING_OFF, tid);
                    }
                }
            } SEAM(pb + 3);
        } else {
            if (EN(6) && IN(pb + 1)) DUP(6) {
                PHASE_IDS();
                pg8::Gemm g{(const pg8::bf16_t*)(ws + WS_XN), (const pg8::bf16_t*)(ws + WS_WIN) + (size_t)lh * WINP * 1024, MT, WINP, 1024, 0};
                pg8::StaticOrder S; S.init(MT, WINP, Gp, bxp);
                pg8::EpiBf16 E{(pg8::bf16_t*)(ws + WS_G), WINP};
                pg8::gemm_phase<pg8::EpiBf16, pg8::StaticOrder, true, true>(lds + RING_OFF, g, S, E, tid);
            } SEAM(pb + 1);
            if (EN(7) && IN(pb + 2)) DUP(7) { { PHASE_IDS(); phase_gla_g0v(ws, tid, Gp, bxp); } { PHASE_IDS(); phase_gla_g0(ws, lh, lds, tid, Gp, bxp); } } SEAM(pb + 2);
            if (EN(8) && IN(pb + 3)) DUP(8) { PHASE_IDS(); phase_gla_g12(ws, lds, gw, wave, lane); } SEAM(pb + 3);
            if (EN(8) && IN(pb + 4)) DUP(9) { PHASE_IDS(); phase_gla_g3(ws, lh, lds, tid); } SEAM(pb + 4);
        }
        if (EN(9) && IN(pb + 5)) {
            PHASE_IDS();
            const pg8::bf16_t* Wt = (layer & 1) ? (const pg8::bf16_t*)(ws + WS_WOG) + (size_t)lh * 1024 * 1024 : (const pg8::bf16_t*)(ws + WS_WOA) + (size_t)lh * 1024 * 1024;
            pg8::Gemm g{(const pg8::bf16_t*)(ws + ((layer & 1) ? WS_Q : WS_XN)), Wt, MT, 1024, 1024, 0};
            pg8::StaticOrder S; if (layer == NLAYER - 1) S.init(NB * SEQ, 1024, Gp, bxp, true); else S.init(MT, 1024, Gp, bxp);
            pg8::EpiResGate E{(pg8::bf16_t*)(ws + WS_X), (const float*)(ws + WS_MOD) + (size_t)layer * MODROWS * NMODC + 2 * 1024};
            pg8::gemm_phase<pg8::EpiResGate, pg8::StaticOrder, true, true>(lds + RING_OFF, g, S, E, tid);
        } SEAM(pb + 5);
        if (EN(10) && IN(pb + 6)) { if ((DUPMASK >> 10) & 1) { PHASE_IDS(); phase_modulate2_route(ws, layer, lds, vcu, wave, lane, tid, true); __syncthreads(); } PHASE_IDS(); phase_modulate2_route(ws, layer, lds, vcu, wave, lane, tid); } SEAM(pb + 6);
        if (EN(12) && IN(pb + 8)) DUP(12) {
            PHASE_IDS();
            build_expert_tables(ws, layer, lds, tid);
            const int nT = __builtin_amdgcn_readfirstlane(((const LAS int*)(lds + AUX_NT))[0]);
            pg8::MoeOrder S{nT, 8, Gp, bxp, (const LAS int*)(lds + AUX_T2E)};
            LAS unsigned short* rowtab = (LAS unsigned short*)(lds + AUX_ROWTAB);
            { const LAS int* base = (const LAS int*)(lds + AUX_BASE); const LAS int* cntl = (const LAS int*)(lds + AUX_CNT); const int* LIST = (const int*)(ws + WS_LIST);
              pg8::Unit u;
              for (int i = 0; i < ROWTAB_UNITS && S.next(i, u); ++i) if (tid < 256) { const int pos = (u.pm - (base[u.e] >> 8)) * 256 + tid; rowtab[i * 256 + tid] = (unsigned short)((pos < cntl[u.e]) ? LIST[(size_t)u.e * MT + pos] : 0); }
              __syncthreads(); }
            pg8::Gemm g{(const pg8::bf16_t*)(ws + WS_XN8), (const pg8::bf16_t*)(ws + WS_WGU + (size_t)layer * 32 * 2048 * 1024), MPAD, 2048, 512, (size_t)2048 * 1024, rowtab};
            pg8::EpiSwiGLU8 E{ws + WS_ACT, PARF(ws) + P_BGU + (size_t)layer * 32 * 2048, 1.0f / 32.0f};
            pg8::gemm_phase<pg8::EpiSwiGLU8, pg8::MoeOrder, true, true, true, true>(lds + RING_OFF, g, S, E, tid);
        } SEAM(pb + 8);
        if (EN(13) && IN(pb + 9)) DUP(13) {
            PHASE_IDS();
            build_expert_tables(ws, layer, lds, tid);
            const int nT = __builtin_amdgcn_readfirstlane(((const LAS int*)(lds + AUX_NT))[0]);
            pg8::Gemm g{(const pg8::bf16_t*)(ws + WS_ACT), (const pg8::bf16_t*)(ws + WS_WDN + (size_t)layer * 32 * 1024 * 1024), MPAD, 1024, 512, (size_t)1024 * 1024};
            pg8::MoeOrder S{nT, 4, Gp, bxp, (const LAS int*)(lds + AUX_T2E)};
            pg8::EpiBiasF8 E{ws + WS_Y, PARF(ws) + P_BDN + (size_t)layer * 32 * 1024, 1.0f / 32.0f};
            pg8::gemm_phase<pg8::EpiBiasF8, pg8::MoeOrder, true, true, false, true>(lds + RING_OFF, g, S, E, tid);
        } SEAM(pb + 9);
        if (EN(14) && IN(pb + 10)) { if ((DUPMASK >> 14) & 1) { PHASE_IDS(); phase_moe_combine(ws, args.out, layer, lds, gw, NGW, lane, tid, true); } PHASE_IDS(); phase_moe_combine(ws, args.out, layer, lds, gw, NGW, lane, tid); } SEAM(pb + 10);
    }
#undef IN
#undef EN
#undef DUP
#undef SEAM
#undef PHASE_IDS
#undef LANE_ID
}

extern "C" void kernel_launch(void* const* d_in, const int* in_sizes, int n_in, void* d_out, int out_size, void* d_ws, size_t ws_size, hipStream_t stream) {
    static int grid = 0;
    if (grid == 0) {
        if (n_in != 25 || out_size != NB * SEQ * DMODEL || ws_size < WS_END) { fprintf(stderr, "kernel_launch: unexpected shapes: n_in %d out %d ws %zu (need >= %zu)\n", n_in, out_size, ws_size, (size_t)WS_END); grid = -1; return; }
        int dev = 0, cus = 0, per_cu = 0;
        if (hipGetDevice(&dev) != hipSuccess || hipDeviceGetAttribute(&cus, hipDeviceAttributeMultiprocessorCount, dev) != hipSuccess) { grid = -1; return; }
        if (hipFuncSetAttribute((const void*)dit_fwd, hipFuncAttributeMaxDynamicSharedMemorySize, LDS_BYTES) != hipSuccess) { fprintf(stderr, "kernel_launch: hipFuncSetAttribute failed\n"); grid = -1; return; }
        if (hipOccupancyMaxActiveBlocksPerMultiprocessor(&per_cu, (const void*)dit_fwd, NWAVES * 64, LDS_BYTES) != hipSuccess || per_cu < 1) fprintf(stderr, "kernel_launch: occupancy query reports %d\n", per_cu);
        (void)hipGetLastError();
        grid = cus;
    }
    if (grid < 0) return;
    if (hipMemsetAsync((char*)d_ws + WS_CTL, 0, CTL_ZERO_BYTES, stream) != hipSuccess) { fprintf(stderr, "kernel_launch: memset failed\n"); return; }
    Args a{};
    for (int i = 0; i < 25; ++i) a.in[i] = (const float*)d_in[i];
    a.out = (float*)d_out; a.ws = (unsigned char*)d_ws;
#if MK_ONE_LAUNCH
    a.ph_lo = 0; a.ph_hi = NPHASE;
    hipLaunchKernelGGL(dit_fwd, dim3(grid), dim3(NWAVES * 64), LDS_BYTES, stream, a);
#else
    for (int p = 0; p < NPHASE; ++p) { a.ph_lo = p; a.ph_hi = p + 1; hipLaunchKernelGGL(dit_fwd, dim3(grid), dim3(NWAVES * 64), LDS_BYTES, stream, a); }
#endif
    const hipError_t le = hipPeekAtLastError();
    if (le != hipSuccess) fprintf(stderr, "kernel_launch: launch failed: %s\n", hipGetErrorName(le));
}
```

```cpp
#include <hip/hip_runtime.h>
#include <hip/hip_bf16.h>
#include <cstdio>
#include <cstdint>
#include <cmath>

#ifndef MK_ONE_LAUNCH
#define MK_ONE_LAUNCH 1
#endif

namespace pg8 {
#define PG8_LAS __attribute__((address_space(3)))
typedef unsigned short bf16_t;
typedef short bf16x8 __attribute__((ext_vector_type(8)));
typedef float f32x4 __attribute__((ext_vector_type(4)));
typedef unsigned u32x4 __attribute__((ext_vector_type(4)));
constexpr int BM = 256, BK = 64, HALF = 128, HTB = HALF * BK * 2  , STAGE_BYTES = 8 * HTB, NXCD = 8, WGM = 8;

__host__ __device__ __forceinline__ int lds_byte(int r, int c) { const int st = (r >> 4) * 2 + (c >> 5), rr = r & 15, cc = c & 31, ob = rr * 64 + cc * 2; return st * 1024 + (ob ^ (((ob >> 9) & 1) << 5)); }
__host__ __device__ __forceinline__ void stage_rc(int b, int& R, int& C) { const int st = b / 1024, sb = b % 1024, swz = sb ^ (((sb >> 9) & 1) << 5); R = (st >> 1) * 16 + swz / 64; C = (st & 1) * 32 + (swz % 64) / 2; }
__host__ __device__ __forceinline__ int perm32(int rho) { const int n = rho >> 4, i = rho & 15; return 8 * (i >> 2) + 4 * n + (i & 3); }

struct Unit { int pm, pn, e; };
struct Gemm { const bf16_t* A; const bf16_t* Bt; int M, N, K; size_t bstride; const PG8_LAS unsigned short* rowtab; };

struct StaticOrder {
    int nM, nN, nwg, G, c; bool latent_only;
    __host__ __device__ __forceinline__ void init(int M, int N, int G_, int c_, bool lat_ = false) { nM = M / BM; nN = N / BM; nwg = nM * nN; G = G_; c = c_; latent_only = lat_; }
    __host__ __device__ __forceinline__ bool next(int i, Unit& u) const {
        const long L = (long)i * G + c; if (L >= nwg) return false;
        int wgid = (int)L; { const int q = nwg / NXCD, r = nwg % NXCD, xcd = wgid % NXCD, off = wgid / NXCD; wgid = (xcd < r ? xcd * (q + 1) : r * (q + 1) + (xcd - r) * q) + off; }
        const int nig = WGM * nN, gid = wgid / nig, fm = gid * WGM, gsz = (nM - fm) < WGM ? (nM - fm) : WGM;
        u.pm = fm + ((wgid % nig) % gsz); u.pn = (wgid % nig) / gsz; u.e = 0;
        if (latent_only) u.pm = (u.pm >> 4) * 17 + 1 + (u.pm & 15);
        return true;
    }
    __device__ __forceinline__ void a_ready(const Unit&) const {}
    __device__ __forceinline__ void done(const Unit&) const {}
};
struct MoeOrder {
    int nT, nN, G, c; const PG8_LAS int* t2e;
    __device__ __forceinline__ bool next(int i, Unit& u) const {
        const int x = c & 7, j = c >> 3, per = 32 / nN, mt = (i * (G >> 5) + x) * per + j / nN; if (mt >= nT) return false;
        u.pm = mt; u.pn = j % nN; u.e = __builtin_amdgcn_readfirstlane(t2e[mt]); return true;
    }
    __device__ __forceinline__ void a_ready(const Unit&) const {}
    __device__ __forceinline__ void done(const Unit&) const {}
};

__device__ __forceinline__ int lane_now() { unsigned z; asm volatile("s_mov_b32 %0, 0" : "=s"(z)); return (int)__builtin_amdgcn_mbcnt_hi(~0u, __builtin_amdgcn_mbcnt_lo(~0u, z)); }
__device__ __forceinline__ float shx(float v, int m, int ln) { return __int_as_float(__builtin_amdgcn_ds_bpermute((ln ^ m) << 2, __float_as_int(v))); }
__device__ __forceinline__ unsigned pk4_fp8(float a, float b, float c, float d) { int w = 0; w = __builtin_amdgcn_cvt_pk_fp8_f32(a, b, w, false); w = __builtin_amdgcn_cvt_pk_fp8_f32(c, d, w, true); return (unsigned)w; }
__device__ __forceinline__ unsigned cvt_pk_bf16(float lo, float hi) { unsigned r; asm volatile("v_cvt_pk_bf16_f32 %0, %1, %2" : "=v"(r) : "v"(lo), "v"(hi)); return r; }

struct EpiBf16 {
    static constexpr bool PERM = true, AFTER_DRAIN = false;
    bf16_t* O; int ldc;
    __device__ __forceinline__ void operator()(const f32x4 (&acc)[2][2][4][2], const Unit& u, int wr, int wc, int fr, int fq) const {
        const int row0 = u.pm * BM + wr * 64 + fr; const int col0 = u.pn * BM + wc * 32 + 8 * fq;
#pragma unroll
        for (int ai = 0; ai < 2; ++ai)
#pragma unroll
            for (int m = 0; m < 4; ++m) { bf16_t* rowp = O + (size_t)(row0 + ai * HALF + m * 16) * ldc + col0;
#pragma unroll
                for (int bj = 0; bj < 2; ++bj) { const f32x4 v0 = acc[ai][bj][m][0], v1 = acc[ai][bj][m][1];
                    u32x4 w; w.x = cvt_pk_bf16(v0[0], v0[1]); w.y = cvt_pk_bf16(v0[2], v0[3]); w.z = cvt_pk_bf16(v1[0], v1[1]); w.w = cvt_pk_bf16(v1[2], v1[3]);
                    *(u32x4*)(rowp + bj * HALF) = w; } }
    }
};
struct EpiQKV {
    static constexpr bool PERM = true, AFTER_DRAIN = false;
    unsigned char* wsb; size_t offQ, dK, dV;
    const PG8_LAS float* gl; const float* ropec; float c2;
    __device__ __forceinline__ void operator()(const f32x4 (&acc)[2][2][4][2], const Unit& u, int wr, int wc, int fr, int fq) const {
        const int isk = (u.pn >= 4) ? 1 : 0, isv = (u.pn >= 5) ? 1 : 0;
        bf16_t* base = (bf16_t*)(wsb + offQ + (size_t)isk * dK + (size_t)isv * dV); const int ldc = isk ? 256 : 1024;
        const int hcol = (isk ? wc : (u.pn * 4 + wc)) * 64 + 8 * fq;
        const int pmb = u.pm / 17, pml = u.pm - pmb * 17; const bool lat = pml != 0;
        const PG8_LAS float* gp = gl + (isk ? 64 : 0) + 8 * fq; const float scl = isk ? 1.0f : c2;
#pragma unroll
        for (int ai = 0; ai < 2; ++ai)
#pragma unroll
            for (int m = 0; m < 4; ++m) { const int rl = ai * HALF + wr * 64 + m * 16 + fr; const size_t row = (size_t)u.pm * BM + rl;
                f32x4 v[2][2]; float ss = 0.f;
#pragma unroll
                for (int bj = 0; bj < 2; ++bj)
#pragma unroll
                    for (int n = 0; n < 2; ++n) { v[bj][n] = acc[ai][bj][m][n]; ss += (v[bj][n][0] * v[bj][n][0] + v[bj][n][1] * v[bj][n][1]) + (v[bj][n][2] * v[bj][n][2] + v[bj][n][3] * v[bj][n][3]); }
                if (!isv) { const int ln = lane_now(); ss += shx(ss, 16, ln); ss += shx(ss, 32, ln);
                    const float rs = 1.0f / sqrtf(ss * (1.0f / 64.0f) + 1e-6f);
                    const int spos = (pml - 1) * 256 + rl;
#pragma unroll
                    for (int bj = 0; bj < 2; ++bj) { f32x4 cs = (f32x4){1.f, 1.f, 1.f, 1.f}, sn = (f32x4){0.f, 0.f, 0.f, 0.f};
                        if (lat) { const float* cp = ropec + (size_t)spos * 32 + 16 * bj + 4 * fq; cs = *(const f32x4*)cp; sn = *(const f32x4*)(cp + 4096 * 32); }
#pragma unroll
                        for (int n = 0; n < 2; ++n) { const f32x4 y = v[bj][n] * rs * *(const PG8_LAS f32x4*)(gp + 32 * bj + 4 * n);
                            const float c0 = cs[2 * n], s0 = sn[2 * n], c1 = cs[2 * n + 1], s1 = sn[2 * n + 1];
                            v[bj][n] = (f32x4){(y[0] * c0 - y[1] * s0) * scl, (y[0] * s0 + y[1] * c0) * scl, (y[2] * c1 - y[3] * s1) * scl, (y[2] * s1 + y[3] * c1) * scl}; } } }
                bf16_t* rowp = base + row * ldc + hcol;
#pragma unroll
                for (int bj = 0; bj < 2; ++bj) { u32x4 w; w.x = cvt_pk_bf16(v[bj][0][0], v[bj][0][1]); w.y = cvt_pk_bf16(v[bj][0][2], v[bj][0][3]); w.z = cvt_pk_bf16(v[bj][1][0], v[bj][1][1]); w.w = cvt_pk_bf16(v[bj][1][2], v[bj][1][3]);
                    *(u32x4*)(rowp + 32 * bj) = w; } }
    }
};
struct EpiBiasF8 {
    static constexpr bool PERM = true, AFTER_DRAIN = false;
    unsigned char* O; const float* bias; float ascale;
    __device__ __forceinline__ void operator()(const f32x4 (&acc)[2][2][4][2], const Unit& u, int wr, int wc, int fr, int fq) const {
        const int row0 = u.pm * BM + wr * 64 + fr; const int col0 = u.pn * BM + wc * 32 + 8 * fq;
        const float* bp = bias + (size_t)u.e * 1024 + col0;
        f32x4 bv[2][2];
#pragma unroll
        for (int bj = 0; bj < 2; ++bj)
#pragma unroll
            for (int n = 0; n < 2; ++n) bv[bj][n] = *(const f32x4*)(bp + bj * HALF + 4 * n);
#pragma unroll
        for (int ai = 0; ai < 2; ++ai)
#pragma unroll
            for (int m = 0; m < 4; ++m) { unsigned char* rowp = O + (size_t)(row0 + ai * HALF + m * 16) * 1024 + col0;
#pragma unroll
                for (int bj = 0; bj < 2; ++bj) { const f32x4 v0 = acc[ai][bj][m][0] * ascale + bv[bj][0], v1 = acc[ai][bj][m][1] * ascale + bv[bj][1];
                    *(unsigned long long*)(rowp + bj * HALF) = (unsigned long long)pk4_fp8(v0[0], v0[1], v0[2], v0[3]) | ((unsigned long long)pk4_fp8(v1[0], v1[1], v1[2], v1[3]) << 32); } }
    }
};
struct EpiResGate {
    static constexpr bool PERM = false, AFTER_DRAIN = false;
    bf16_t* X; const float* gate;
    __device__ __forceinline__ void operator()(const f32x4 (&acc)[2][2][4][2], const Unit& u, int wr, int wc, int fr, int fq) const {
        const int row0 = u.pm * BM + wr * 64 + fr; const int col0 = u.pn * BM + wc * 32 + 4 * fq;
        const int bb = u.pm / 17, mr = (u.pm - bb * 17 == 0) ? 8 : bb;
        const float* gp = gate + (size_t)mr * 6144 + col0;
        f32x4 gv[2][2];
#pragma unroll
        for (int bj = 0; bj < 2; ++bj)
#pragma unroll
            for (int n = 0; n < 2; ++n) gv[bj][n] = *(const f32x4*)(gp + bj * HALF + n * 16);
#pragma unroll
        for (int ai = 0; ai < 2; ++ai)
#pragma unroll
            for (int m = 0; m < 4; ++m) { bf16_t* rowp = X + (size_t)(row0 + ai * HALF + m * 16) * 1024 + col0;
#pragma unroll
                for (int bj = 0; bj < 2; ++bj)
#pragma unroll
                    for (int n = 0; n < 2; ++n) { unsigned long long* p = (unsigned long long*)(rowp + bj * HALF + n * 16); const unsigned long long v = *p;
                        f32x4 x = (f32x4){__uint_as_float((unsigned)(v & 0xffffu) << 16), __uint_as_float((unsigned)(v >> 16) << 16), __uint_as_float((unsigned)((v >> 32) & 0xffffu) << 16), __uint_as_float((unsigned)(v >> 48) << 16)};
                        x = x + gv[bj][n] * acc[ai][bj][m][n];
                        *p = (unsigned long long)cvt_pk_bf16(x[0], x[1]) | ((unsigned long long)cvt_pk_bf16(x[2], x[3]) << 32); } }
    }
};
struct EpiSwiGLU {
    static constexpr bool PERM = true, AFTER_DRAIN = false;
    bf16_t* O; const float* bias;
    __device__ __forceinline__ void operator()(const f32x4 (&acc)[2][2][4][2], const Unit& u, int wr, int wc, int fr, int fq) const {
        const int row0 = u.pm * BM + wr * 64 + fr; const int col0 = u.pn * HALF + wc * 32 + 8 * fq;
        const float* bp = bias + (size_t)u.e * 2048 + col0;
        f32x4 bg[2], bu[2];
#pragma unroll
        for (int n = 0; n < 2; ++n) { bg[n] = *(const f32x4*)(bp + 4 * n); bu[n] = *(const f32x4*)(bp + 1024 + 4 * n); }
#pragma unroll
        for (int ai = 0; ai < 2; ++ai)
#pragma unroll
            for (int m = 0; m < 4; ++m) { bf16_t* rowp = O + (size_t)(row0 + ai * HALF + m * 16) * 1024 + col0;
                float r[8];
#pragma unroll
                for (int n = 0; n < 2; ++n) { const f32x4 gt = acc[ai][0][m][n] + bg[n], up = acc[ai][1][m][n] + bu[n];
#pragma unroll
                    for (int i = 0; i < 4; ++i) { const float g = fminf(gt[i], 7.0f), uu = fminf(fmaxf(up[i], -7.0f), 7.0f);
                        const float sg = __builtin_amdgcn_rcpf(1.0f + __builtin_amdgcn_exp2f(-1.702f * 1.4426950408889634f * g));
                        r[4 * n + i] = (uu + 1.0f) * (g * sg); } }
                u32x4 w; w.x = cvt_pk_bf16(r[0], r[1]); w.y = cvt_pk_bf16(r[2], r[3]); w.z = cvt_pk_bf16(r[4], r[5]); w.w = cvt_pk_bf16(r[6], r[7]);
                *(u32x4*)rowp = w; }
    }
};
struct EpiSwiGLU8 {
    static constexpr bool PERM = true, AFTER_DRAIN = false;
    unsigned char* O; const float* bias; float ascale;
    __device__ __forceinline__ void operator()(const f32x4 (&acc)[2][2][4][2], const Unit& u, int wr, int wc, int fr, int fq) const {
        const int row0 = u.pm * BM + wr * 64 + fr; const int col0 = u.pn * HALF + wc * 32 + 8 * fq;
        const float* bp = bias + (size_t)u.e * 2048 + col0;
        f32x4 bg[2], bu[2];
#pragma unroll
        for (int n = 0; n < 2; ++n) { bg[n] = *(const f32x4*)(bp + 4 * n); bu[n] = *(const f32x4*)(bp + 1024 + 4 * n); }
#pragma unroll
        for (int ai = 0; ai < 2; ++ai)
#pragma unroll
            for (int m = 0; m < 4; ++m) { unsigned char* rowp = O + (size_t)(row0 + ai * HALF + m * 16) * 1024 + col0;
                float r[8];
#pragma unroll
                for (int n = 0; n < 2; ++n) { const f32x4 gt = acc[ai][0][m][n] * ascale + bg[n], up = acc[ai][1][m][n] * ascale + bu[n];
#pragma unroll
                    for (int i = 0; i < 4; ++i) { const float g = fminf(gt[i], 7.0f), uu = fminf(fmaxf(up[i], -7.0f), 7.0f);
                        const float sg = __builtin_amdgcn_rcpf(1.0f + __builtin_amdgcn_exp2f(-1.702f * 1.4426950408889634f * g));
                        r[4 * n + i] = (uu + 1.0f) * (g * sg); } }
                *(unsigned long long*)rowp = (unsigned long long)pk4_fp8(r[0], r[1], r[2], r[3]) | ((unsigned long long)pk4_fp8(r[4], r[5], r[6], r[7]) << 32); }
    }
};
struct EpiBiasBf16 {
    static constexpr bool PERM = true, AFTER_DRAIN = false;
    bf16_t* O; const float* bias; float ascale;
    __device__ __forceinline__ void operator()(const f32x4 (&acc)[2][2][4][2], const Unit& u, int wr, int wc, int fr, int fq) const {
        const int row0 = u.pm * BM + wr * 64 + fr; const int col0 = u.pn * BM + wc * 32 + 8 * fq;
        const float* bp = bias + (size_t)u.e * 1024 + col0;
        f32x4 bv[2][2];
#pragma unroll
        for (int bj = 0; bj < 2; ++bj)
#pragma unroll
            for (int n = 0; n < 2; ++n) bv[bj][n] = *(const f32x4*)(bp + bj * HALF + 4 * n);
#pragma unroll
        for (int ai = 0; ai < 2; ++ai)
#pragma unroll
            for (int m = 0; m < 4; ++m) { bf16_t* rowp = O + (size_t)(row0 + ai * HALF + m * 16) * 1024 + col0;
#pragma unroll
                for (int bj = 0; bj < 2; ++bj) { const f32x4 v0 = acc[ai][bj][m][0] * ascale + bv[bj][0], v1 = acc[ai][bj][m][1] * ascale + bv[bj][1];
                    u32x4 w; w.x = cvt_pk_bf16(v0[0], v0[1]); w.y = cvt_pk_bf16(v0[2], v0[3]); w.z = cvt_pk_bf16(v1[0], v1[1]); w.w = cvt_pk_bf16(v1[2], v1[3]);
                    *(u32x4*)(rowp + bj * HALF) = w; } }
    }
};

template <class Epi, class Sched, bool ALIGN_EPI = false, bool SP2 = false, bool GATHER = false, bool F8 = false>
__device__ __forceinline__ void gemm_phase(PG8_LAS unsigned char* lds, const Gemm g, const Sched& S, const Epi& E, int tid_in) {
    int tid_l = tid_in; asm volatile("" : "+v"(tid_l));
    const int tid = tid_l, wid = __builtin_amdgcn_readfirstlane(tid >> 6), lane = tid & 63, wr = wid >> 2, wc = wid & 3, fr = lane & 15, fq = lane >> 4;
    const int K = g.K, nt = K / BK;
    unsigned voffA[2], voffB[2];
#pragma unroll
    for (int i = 0; i < 2; ++i) { int R, C; stage_rc(tid * 16 + i * 8192, R, C); const int Rb = Epi::PERM ? ((R & ~31) + perm32(R & 31)) : R;
        voffA[i] = (unsigned)(R * K + C) * 2u; voffB[i] = (unsigned)(Rb * K + C) * 2u; }
    const size_t kstep = (size_t)(BK * 2);
    static_assert(!GATHER || SP2, "GATHER is wired into the SP2 loop only");
    unsigned vAc0[2], vAc1[2], vAn0[2], vAn1[2]; int gR[2]; unsigned gC[2];
#pragma unroll
    for (int i = 0; i < 2; ++i) { int R, C; stage_rc(tid * 16 + i * 8192, R, C); gR[i] = R; gC[i] = (unsigned)C * 2u; vAc0[i] = voffA[i]; vAc1[i] = voffA[i]; vAn0[i] = voffA[i]; vAn1[i] = voffA[i]; }
#define PG8_GFETCH(d0, d1, ord) do { if constexpr (GATHER) { _Pragma("unroll") for (int _i = 0; _i < 2; ++_i) { \
        d0[_i] = (unsigned)g.rowtab[(ord) * 256 + gR[_i]] * (unsigned)(K * 2) + gC[_i]; d1[_i] = (unsigned)g.rowtab[(ord) * 256 + 128 + gR[_i]] * (unsigned)(K * 2) + gC[_i]; } } } while (0)
    const size_t hstep = (size_t)HALF * K * 2;
    const size_t hstepA = GATHER ? 0 : hstep;
    const size_t tstep = 2 * hstep;
    const unsigned ldsw = (unsigned)wid * 1024u;
    const int aoff = lds_byte(wr * 64 + fr, fq * 8), boff = lds_byte(wc * 32 + fr, fq * 8);
    typedef int v8i_t __attribute__((ext_vector_type(8))); typedef short v16s_a16 __attribute__((ext_vector_type(16), aligned(16)));
    const int f8c = 32 * (fq >> 1) + 16 * (fq & 1);
    const int aoff8a = lds_byte(wr * 64 + fr, f8c), boff8a = lds_byte(wc * 32 + fr, f8c);
    v8i_t At8[4], Au8[4], B08[2], B18[2]; int f8scale = 127; asm volatile("" : "+v"(f8scale));
#define PG8_SA(b, h) (((b) * 2 + (h)) * HTB)
#define PG8_SB(b, h) ((4 + (b) * 2 + (h)) * HTB)
#define PG8_STAGE(bufoff, gbase, voff) do { _Pragma("unroll") for (int _i = 0; _i < 2; ++_i) \
        __builtin_amdgcn_global_load_lds((const unsigned*)((const char*)(gbase) + (voff)[_i]), (PG8_LAS unsigned*)(lds + (bufoff) + ldsw + _i * 8192), 16, 0, 0); } while (0)
#define PG8_LDA(dst, b, h) do { if constexpr (F8) { _Pragma("unroll") for (int m = 0; m < 4; ++m) { const bf16x8 lo_ = *(const PG8_LAS bf16x8*)(lds + PG8_SA(b, h) + aoff8a + m * 2048), hi_ = *(const PG8_LAS bf16x8*)(lds + PG8_SA(b, h) + aoff8a + m * 2048 + 16); dst##8[m] = __builtin_bit_cast(v8i_t, __builtin_shufflevector(lo_, hi_, 0, 1, 2, 3, 4, 5, 6, 7, 8, 9, 10, 11, 12, 13, 14, 15)); } } \
        else { _Pragma("unroll") for (int m = 0; m < 4; ++m) _Pragma("unroll") for (int k = 0; k < 2; ++k) dst[m][k] = *(const PG8_LAS bf16x8*)(lds + PG8_SA(b, h) + aoff + m * 2048 + k * 1024); } } while (0)
#define PG8_LDB(dst, b, h) do { if constexpr (F8) { _Pragma("unroll") for (int n = 0; n < 2; ++n) { const bf16x8 lo_ = *(const PG8_LAS bf16x8*)(lds + PG8_SB(b, h) + boff8a + n * 2048), hi_ = *(const PG8_LAS bf16x8*)(lds + PG8_SB(b, h) + boff8a + n * 2048 + 16); dst##8[n] = __builtin_bit_cast(v8i_t, __builtin_shufflevector(lo_, hi_, 0, 1, 2, 3, 4, 5, 6, 7, 8, 9, 10, 11, 12, 13, 14, 15)); } } \
        else { _Pragma("unroll") for (int n = 0; n < 2; ++n) _Pragma("unroll") for (int k = 0; k < 2; ++k) dst[n][k] = *(const PG8_LAS bf16x8*)(lds + PG8_SB(b, h) + boff + n * 2048 + k * 1024); } } while (0)
#define PG8_MMA(ai, bj, At, Bt) do { __builtin_amdgcn_s_setprio(1); if constexpr (F8) { _Pragma("unroll") for (int m = 0; m < 4; ++m) _Pragma("unroll") for (int n = 0; n < 2; ++n) \
            asm volatile("v_mfma_scale_f32_16x16x128_f8f6f4 %0, %1, %2, %0, %3, %3 op_sel_hi:[0,0,0]" : "+v"(acc[ai][bj][m][n]) : "v"(Bt##8[n]), "v"(At##8[m]), "v"(f8scale)); } \
        else { _Pragma("unroll") for (int m = 0; m < 4; ++m) _Pragma("unroll") for (int n = 0; n < 2; ++n) _Pragma("unroll") for (int k = 0; k < 2; ++k) \
        acc[ai][bj][m][n] = __builtin_amdgcn_mfma_f32_16x16x32_bf16(Bt[n][k], At[m][k], acc[ai][bj][m][n], 0, 0, 0); } __builtin_amdgcn_s_setprio(0); } while (0)
#define PG8_WAIT_V(n) asm volatile("s_waitcnt vmcnt(" #n ")" ::: "memory")
#define PG8_WAIT_L(n) asm volatile("s_waitcnt lgkmcnt(" #n ")" ::: "memory")
#define PG8_BAR __builtin_amdgcn_s_barrier()
#define PG8_SCHED __builtin_amdgcn_sched_barrier(0)
    Unit cur, nxt; int ui = 0;
    if (!S.next(0, cur)) return;
    f32x4 acc[2][2][4][2];
#pragma unroll
    for (int a = 0; a < 2; ++a)
#pragma unroll
        for (int b = 0; b < 2; ++b)
#pragma unroll
            for (int m = 0; m < 4; ++m)
#pragma unroll
                for (int n = 0; n < 2; ++n) acc[a][b][m][n] = (f32x4){0.f, 0.f, 0.f, 0.f};
    bf16x8 At[4][2], Au[4][2], B0[2][2], B1[2][2];
    const char* cA = (const char*)g.A + (GATHER ? (size_t)0 : (size_t)cur.pm * tstep); PG8_GFETCH(vAc0, vAc1, 0); const char* cB = (const char*)g.Bt + (size_t)cur.e * g.bstride + (size_t)cur.pn * tstep;
    S.a_ready(cur);
    if constexpr (SP2) {
        PG8_STAGE(PG8_SB(0, 0), cB, voffB); PG8_STAGE(PG8_SB(0, 1), cB + hstep, voffB); PG8_STAGE(PG8_SA(0, 0), cA, vAc0); PG8_STAGE(PG8_SA(0, 1), cA + hstepA, vAc1);
        if (wr == 1) PG8_BAR;
        PG8_WAIT_V(2); PG8_BAR;
        PG8_STAGE(PG8_SB(1, 0), cB + kstep, voffB); PG8_STAGE(PG8_SA(1, 0), cA + kstep, vAc0); PG8_STAGE(PG8_SB(1, 1), cB + hstep + kstep, voffB);
        PG8_WAIT_V(6); PG8_BAR;
    } else {
        PG8_STAGE(PG8_SB(0, 0), cB, voffB); PG8_STAGE(PG8_SA(0, 0), cA, voffA); PG8_STAGE(PG8_SB(0, 1), cB + hstep, voffB); PG8_STAGE(PG8_SA(0, 1), cA + hstep, voffA);
        if (wr == 1) PG8_BAR;
        PG8_WAIT_V(4); PG8_BAR;
        PG8_STAGE(PG8_SB(1, 0), cB + kstep, voffB); PG8_STAGE(PG8_SA(1, 0), cA + kstep, voffA); PG8_STAGE(PG8_SB(1, 1), cB + hstep + kstep, voffB);
        PG8_WAIT_V(6); PG8_BAR;
    }
    for (;;) {
        const bool has_next = S.next(ui + 1, nxt);
        const char* nA = (has_next && !GATHER) ? (const char*)g.A + (size_t)nxt.pm * tstep : cA;
        if constexpr (GATHER) { if (has_next) PG8_GFETCH(vAn0, vAn1, ui + 1); else { vAn0[0] = vAc0[0]; vAn0[1] = vAc0[1]; vAn1[0] = vAc1[0]; vAn1[1] = vAc1[1]; } }
        const char* nB = has_next ? (const char*)g.Bt + (size_t)nxt.e * g.bstride + (size_t)nxt.pn * tstep : cB;
#pragma unroll 1
        for (int t = 0; t < nt; t += 2) {
            const bool last = (t == nt - 2);
            const char* a1 = cA + (size_t)(t + 1) * kstep;
            const char* a2 = last ? nA : cA + (size_t)(t + 2) * kstep; const char* b2 = last ? nB : cB + (size_t)(t + 2) * kstep;
            const char* a3 = a2 + kstep; const char* b3 = b2 + kstep;
            if (last && has_next) S.a_ready(nxt);
            unsigned vS0[2], vS1[2];
            vS0[0] = last ? vAn0[0] : vAc0[0]; vS0[1] = last ? vAn0[1] : vAc0[1]; vS1[0] = last ? vAn1[0] : vAc1[0]; vS1[1] = last ? vAn1[1] : vAc1[1];
            if constexpr (SP2) {
            PG8_LDB(B0, 0, 0); PG8_LDB(B1, 0, 1); PG8_SCHED; PG8_LDA(At, 0, 0); PG8_STAGE(PG8_SA(1, 1), a1 + hstepA, vAc1);
            PG8_WAIT_V(8); PG8_WAIT_L(0); PG8_BAR; PG8_MMA(0, 0, At, B0); PG8_MMA(0, 1, At, B1); PG8_BAR; PG8_SCHED;
            if constexpr (F8) { PG8_LDA(Au, 0, 1); } else { PG8_LDA(At, 0, 1); } PG8_STAGE(PG8_SB(0, 0), b2, voffB); PG8_STAGE(PG8_SB(0, 1), b2 + hstep, voffB); PG8_STAGE(PG8_SA(0, 0), a2, vS0);
            PG8_WAIT_V(8); PG8_WAIT_L(0); PG8_BAR; if constexpr (F8) { PG8_MMA(1, 0, Au, B0); PG8_MMA(1, 1, Au, B1); } else { PG8_MMA(1, 0, At, B0); PG8_MMA(1, 1, At, B1); } PG8_BAR; PG8_SCHED;
            PG8_LDB(B0, 1, 0); PG8_LDB(B1, 1, 1); PG8_SCHED; PG8_LDA(At, 1, 0); PG8_STAGE(PG8_SA(0, 1), a2 + hstepA, vS1);
            PG8_WAIT_V(8); PG8_WAIT_L(0); PG8_BAR; PG8_MMA(0, 0, At, B0); PG8_MMA(0, 1, At, B1); PG8_BAR; PG8_SCHED;
            if constexpr (F8) { PG8_LDA(Au, 1, 1); } else { PG8_LDA(At, 1, 1); } PG8_STAGE(PG8_SB(1, 0), b3, voffB); PG8_STAGE(PG8_SB(1, 1), b3 + hstep, voffB); PG8_STAGE(PG8_SA(1, 0), a3, vS0);
            PG8_WAIT_V(8); PG8_WAIT_L(0); PG8_BAR; if constexpr (F8) { PG8_MMA(1, 0, Au, B0); PG8_MMA(1, 1, Au, B1); } else { PG8_MMA(1, 0, At, B0); PG8_MMA(1, 1, At, B1); } PG8_BAR; PG8_SCHED;
            } else {
            PG8_LDB(B0, 0, 0); PG8_SCHED; PG8_LDA(At, 0, 0); PG8_STAGE(PG8_SA(1, 1), a1 + hstep, voffA);
            PG8_WAIT_L(8); PG8_BAR; PG8_WAIT_L(0); PG8_MMA(0, 0, At, B0); PG8_BAR; PG8_SCHED;
            PG8_LDB(B1, 0, 1); PG8_STAGE(PG8_SB(0, 0), b2, voffB);
            PG8_BAR; PG8_WAIT_L(0); PG8_MMA(0, 1, At, B1); PG8_BAR;
            PG8_LDA(At, 0, 1); PG8_STAGE(PG8_SA(0, 0), a2, voffA);
            PG8_BAR; PG8_WAIT_L(0); PG8_MMA(1, 0, At, B0); PG8_BAR; PG8_SCHED;
            PG8_STAGE(PG8_SB(0, 1), b2 + hstep, voffB);
            PG8_WAIT_V(6); PG8_BAR; PG8_MMA(1, 1, At, B1); PG8_BAR;
            PG8_LDB(B0, 1, 0); PG8_SCHED; PG8_LDA(At, 1, 0); PG8_STAGE(PG8_SA(0, 1), a2 + hstep, voffA);
            PG8_WAIT_L(8); PG8_BAR; PG8_WAIT_L(0); PG8_MMA(0, 0, At, B0); PG8_BAR; PG8_SCHED;
            PG8_LDB(B1, 1, 1); PG8_STAGE(PG8_SB(1, 0), b3, voffB);
            PG8_BAR; PG8_WAIT_L(0); PG8_MMA(0, 1, At, B1); PG8_BAR;
            PG8_LDA(At, 1, 1); PG8_STAGE(PG8_SA(1, 0), a3, voffA);
            PG8_BAR; PG8_WAIT_L(0); PG8_MMA(1, 0, At, B0); PG8_BAR; PG8_SCHED;
            PG8_STAGE(PG8_SB(1, 1), b3 + hstep, voffB);
            PG8_WAIT_V(6); PG8_BAR; PG8_MMA(1, 1, At, B1); PG8_BAR;
            }
        }
        if constexpr (ALIGN_EPI) { if (wr == 0) PG8_BAR; }
        if constexpr (F8) asm volatile("s_nop 15\n\ts_nop 15" ::: "memory");
        if constexpr (!Epi::AFTER_DRAIN) { E(acc, cur, wr, wc, fr, fq); S.done(cur); }
        if (!has_next) break;
#pragma unroll
        for (int a = 0; a < 2; ++a)
#pragma unroll
            for (int b = 0; b < 2; ++b)
#pragma unroll
                for (int m = 0; m < 4; ++m)
#pragma unroll
                    for (int n = 0; n < 2; ++n) acc[a][b][m][n] = (f32x4){0.f, 0.f, 0.f, 0.f};
        cur = nxt; cA = nA; cB = nB; ++ui;
        if constexpr (GATHER) { vAc0[0] = vAn0[0]; vAc0[1] = vAn0[1]; vAc1[0] = vAn1[0]; vAc1[1] = vAn1[1]; }
        if constexpr (ALIGN_EPI) { if (wr == 1) PG8_BAR; }
    }
    PG8_WAIT_V(0);
    if constexpr (!ALIGN_EPI) { if (wr == 0) PG8_BAR; }
    PG8_BAR;
    if constexpr (Epi::AFTER_DRAIN) { E.fused(acc, cur, wr, wc, fr, fq, lds, wid, lane); S.done(cur); }
#undef PG8_SA
#undef PG8_SB
#undef PG8_STAGE
#undef PG8_LDA
#undef PG8_LDB
#undef PG8_MMA
#undef PG8_WAIT_V
#undef PG8_WAIT_L
#undef PG8_BAR
#undef PG8_SCHED
#undef PG8_GFETCH
}
}
#include <hip/hip_bf16.h>
#include <cmath>
namespace attn_body {
using bf16=__hip_bfloat16;
using bf16x8=__attribute__((ext_vector_type(8)))short;
using s16x4=__attribute__((ext_vector_type(4)))short;
using f32x16=__attribute__((ext_vector_type(16)))float;
using u32x4=__attribute__((ext_vector_type(4)))unsigned;
constexpr int D=64,DM=1024,KVP=256;
constexpr int NW=8,QBLK=32,QB=QBLK*NW,KVBLK=64;
__device__ __forceinline__ int crow(int r,int hi){return (r&3)+8*(r>>2)+4*hi;}
#define SBAR() __builtin_amdgcn_sched_barrier(0)
__device__ __forceinline__ void cmask(f32x16&p0,f32x16&p1,int jb,int qrel,int hi){
  const float NEG=-INFINITY; int kb=64*jb+4*hi;
  #pragma unroll
  for(int r=0;r<16;++r){int kv=kb+(r&3)+8*(r>>2); if(kv>qrel)p0[r]=NEG; if(kv+32>qrel)p1[r]=NEG;}
}

constexpr int NSLOT=3, SLOTB=8192;
constexpr int LDS_K=0, LDS_V=NSLOT*SLOTB, LDS_WS=2*NSLOT*SLOTB, LDS_OST=LDS_WS+NW*64*4, LDS_BYTES=LDS_OST+NW*4096;
constexpr float C2=0.125f*1.4426950408889634f;
__device__ __forceinline__ void glds16(const void*gsrc,unsigned lds_dst){unsigned keep;
  asm volatile("s_mov_b32 %0, m0\n\ts_mov_b32 m0, %2\n\ts_nop 0\n\tglobal_load_lds_dwordx4 %1, off\n\ts_mov_b32 m0, %0":"=&s"(keep):"v"(gsrc),"s"(lds_dst):"memory");}
__device__ __forceinline__ float max3f(float a,float b,float c){float r;asm("v_max3_f32 %0, %1, %2, %3":"=v"(r):"v"(a),"v"(b),"v"(c));return r;}
__device__ __forceinline__ float max2f(float a,float b){float r;asm("v_max_f32_e32 %0, %1, %2":"=v"(r):"v"(a),"v"(b));return r;}
__device__ __forceinline__ float fadd_s(float a,float b){float r;asm("v_add_f32_e32 %0, %1, %2":"=v"(r):"v"(a),"v"(b));return r;}
__device__ __forceinline__ float fsub_s(float a,float b){float r;asm("v_sub_f32_e32 %0, %1, %2":"=v"(r):"v"(a),"v"(b));return r;}
typedef float f32x2_t __attribute__((ext_vector_type(2))); typedef __bf16 bf16x2_t __attribute__((ext_vector_type(2)));
__device__ __forceinline__ unsigned cvtpk_s(float lo,float hi){f32x2_t v={lo,hi};bf16x2_t b=__builtin_convertvector(v,bf16x2_t);return __builtin_bit_cast(unsigned,b);}
#define WAIT_BAR(N) asm volatile("s_waitcnt vmcnt(" #N ") lgkmcnt(0)\n\ts_barrier":::"memory")

__device__ __forceinline__ void qkt(f32x16&p0,f32x16&p1,const char*Kslot,const bf16x8*qr,const f32x16&negm,int r32,int hi){
  const char*kb=Kslot+hi*1024+r32*16;
  #pragma unroll
  for(int d0=0;d0<4;++d0){
    const bf16x8 b0=*reinterpret_cast<const bf16x8*>(kb+d0*2048);
    const bf16x8 b1=*reinterpret_cast<const bf16x8*>(kb+d0*2048+512);
    if(d0==0){p0=__builtin_amdgcn_mfma_f32_32x32x16_bf16(b0,qr[0],negm,0,0,0);p1=__builtin_amdgcn_mfma_f32_32x32x16_bf16(b1,qr[0],negm,0,0,0);}
    else{p0=__builtin_amdgcn_mfma_f32_32x32x16_bf16(b0,qr[d0],p0,0,0,0);p1=__builtin_amdgcn_mfma_f32_32x32x16_bf16(b1,qr[d0],p1,0,0,0);}}
}
typedef __attribute__((address_space(3))) const char* lds_cptr;
typedef short v4i16_t __attribute__((ext_vector_type(4)));
__device__ __forceinline__ void kload8(bf16x8*kf,lds_cptr kp){
  kf[0]=*(const __attribute__((address_space(3))) bf16x8*)(kp);      kf[1]=*(const __attribute__((address_space(3))) bf16x8*)(kp+512);
  kf[2]=*(const __attribute__((address_space(3))) bf16x8*)(kp+2048); kf[3]=*(const __attribute__((address_space(3))) bf16x8*)(kp+2560);
  kf[4]=*(const __attribute__((address_space(3))) bf16x8*)(kp+4096); kf[5]=*(const __attribute__((address_space(3))) bf16x8*)(kp+4608);
  kf[6]=*(const __attribute__((address_space(3))) bf16x8*)(kp+6144); kf[7]=*(const __attribute__((address_space(3))) bf16x8*)(kp+6656);
}
__device__ __forceinline__ void kload2(bf16x8*kf,lds_cptr kp,int j){ kf[2*j]=*(const __attribute__((address_space(3))) bf16x8*)(kp+j*2048); kf[2*j+1]=*(const __attribute__((address_space(3))) bf16x8*)(kp+j*2048+512); }
__device__ __forceinline__ s16x4 vtr(lds_cptr p){ return __builtin_bit_cast(s16x4,__builtin_amdgcn_ds_read_tr16_b64_v4i16((__attribute__((address_space(3))) v4i16_t*)p)); }
__device__ __forceinline__ float rowmax(const f32x16&p0,const f32x16&p1){
  float a=max3f(p0[0],p0[1],p1[0]),b=max3f(p0[2],p0[3],p1[1]);a=max3f(a,p1[2],p1[3]);
  #pragma unroll
  for(int r=4;r<16;r+=4){a=max3f(a,p0[r],p0[r+1]);b=max3f(b,p0[r+2],p0[r+3]);a=max3f(a,p1[r],p1[r+1]);b=max3f(b,p1[r+2],p1[r+3]);}
  const float m=max2f(a,b);
  auto rr=__builtin_amdgcn_permlane32_swap(__float_as_uint(m),__float_as_uint(m),false,false);
  return max2f(__uint_as_float(rr[0]),__uint_as_float(rr[1]));
}
__device__ __forceinline__ void pv(f32x16*o,int vb,bf16x8 pa0,bf16x8 pa1,bf16x8 pa2,bf16x8 pa3){
  #pragma unroll
  for(int d0=0;d0<2;++d0){s16x4 lo[4],hi[4];
    #pragma unroll
    for(int ks=0;ks<4;++ks){
      asm volatile("ds_read_b64_tr_b16 %0,%1 offset:%c2":"=&v"(lo[ks]):"v"(vb),"i"(d0*4096+ks*1024):"memory");
      asm volatile("ds_read_b64_tr_b16 %0,%1 offset:%c2":"=&v"(hi[ks]):"v"(vb),"i"(d0*4096+ks*1024+512):"memory");}
    asm volatile("s_waitcnt lgkmcnt(0)":::"memory");SBAR();
    #define PK(k) (bf16x8){lo[k][0],lo[k][1],lo[k][2],lo[k][3],hi[k][0],hi[k][1],hi[k][2],hi[k][3]}
    o[d0]=__builtin_amdgcn_mfma_f32_32x32x16_bf16(pa0,PK(0),o[d0],0,0,0);
    o[d0]=__builtin_amdgcn_mfma_f32_32x32x16_bf16(pa1,PK(1),o[d0],0,0,0);
    o[d0]=__builtin_amdgcn_mfma_f32_32x32x16_bf16(pa2,PK(2),o[d0],0,0,0);
    o[d0]=__builtin_amdgcn_mfma_f32_32x32x16_bf16(pa3,PK(3),o[d0],0,0,0);
    #undef PK
  }
}

#ifndef ATTN_STORE16
#define ATTN_STORE16(p,v) (*(u32x4*)(p)=(v))
#endif
template<int THRL> __device__ __forceinline__ void attn_unit(long qrow0,long kvrow0,int NT,int h,const bf16*Q,const bf16*__restrict__ K,const bf16*__restrict__ V,bf16*O,char*shm,int tid_in){
  int tid_l=tid_in; asm volatile("":"+v"(tid_l)); const int tid=tid_l,lane=tid&63,r32=lane&31,hi=lane>>5; const int wid=__builtin_amdgcn_readfirstlane(tid>>6);
  const bf16*Qw=Q+(qrow0+wid*QBLK)*DM+h*D;
  const bf16*Kh=K+kvrow0*KVP+(h>>2)*D,*Vh=V+kvrow0*KVP+(h>>2)*D;
  const unsigned lds0=(unsigned)(uintptr_t)shm;
  float*wsf=(float*)(shm+LDS_WS)+wid*64;
  const bf16*ksrc=Kh+(long)lane*KVP+wid*8;
  const bf16*vsrc=Vh+(long)(16*(wid&3)+(lane>>2))*KVP+(wid>>2)*32+(lane&3)*8;
  const unsigned kdst=lds0+LDS_K+wid*1024, vdst=lds0+LDS_V+wid*1024;
  #define DMA_K(t,slot) glds16(ksrc+(long)(t)*KVBLK*KVP,(unsigned)__builtin_amdgcn_readfirstlane(kdst+(slot)))
  #define DMA_V(t,slot) glds16(vsrc+(long)(t)*KVBLK*KVP,(unsigned)__builtin_amdgcn_readfirstlane(vdst+(slot)))
  const int vb0=(int)(lds0+LDS_V)+((lane>>4)&1)*32+(lane&3)*8+(4*hi+((lane&15)>>2))*64;
  const char*Kbase=shm+LDS_K; bf16x8 kf[8];
  const lds_cptr shm3=(lds_cptr)shm; const lds_cptr kp0=shm3+LDS_K+hi*1024+r32*16; const lds_cptr vp0=shm3+LDS_V+((lane>>4)&1)*32+(lane&3)*8+(4*hi+((lane&15)>>2))*64;
  DMA_K(0,0);DMA_V(0,0);DMA_K(1,SLOTB);
  bf16x8 qr[4];
  #pragma unroll
  for(int d0=0;d0<4;++d0)qr[d0]=*reinterpret_cast<const bf16x8*>(&Qw[(long)r32*DM+d0*16+hi*8]);
  float mhat=0.f,l_reg=0.f;f32x16 o[2];o[0]=f32x16{};o[1]=f32x16{};f32x16 negm=f32x16{};asm volatile("":"+v"(negm));
  #define CMASK(P0,P1,t) do{}while(0)
  bool resc=false;
  #define START(P0,P1) do{ const float rm=rowmax(P0,P1); resc=false; \
    { const float dl=rm; mhat=fadd_s(mhat,dl); \
      _Pragma("unroll") for(int r=0;r<16;++r){P0[r]=fsub_s(P0[r],dl);P1[r]=fsub_s(P1[r],dl);} \
      _Pragma("unroll") for(int r=0;r<16;++r)negm[r]=-mhat; asm volatile("":"+v"(negm)); } \
    _Pragma("unroll") for(int r=0;r<16;++r)P0[r]=__builtin_amdgcn_exp2f(P0[r]); }while(0)
  #define RESC() do{ if(resc){ asm volatile("s_waitcnt lgkmcnt(0)":::"memory"); \
      _Pragma("unroll") for(int d_=0;d_<2;++d_) _Pragma("unroll") for(int r=0;r<16;++r)o[d_][r]*=wsf[crow(r,hi)]; } }while(0)
  f32x16 pA0,pA1,pB0,pB1;
  int sl_prev=0,sl_cur=0,sl_next=SLOTB;
  #define ROT() do{sl_prev=sl_cur;sl_cur=sl_next;sl_next=(sl_next==(NSLOT-1)*SLOTB)?0:sl_next+SLOTB;}while(0)
  DMA_K(2,2*SLOTB);
  WAIT_BAR(3);
  qkt(pA0,pA1,Kbase,qr,negm,r32,hi);asm volatile("s_nop 15\n\ts_nop 7":"+v"(pA0),"+v"(pA1));CMASK(pA0,pA1,0);
  START(pA0,pA1);
  _Pragma("unroll") for(int r=0;r<16;++r)pA1[r]=__builtin_amdgcn_exp2f(pA1[r]);
  WAIT_BAR(0);
  DMA_K(3,0);DMA_V(1,SLOTB);
  ROT();
  kload8(kf,kp0+sl_cur);
  WAIT_BAR(2);
  s16x4 vlo[8],vhi[8]; u32x4 pw0,pw1,pw2,pw3;
  #define PKW(P,B) cvtpk_s(P[B],P[B+1])
  #define PAF(k) __builtin_bit_cast(bf16x8,pw##k)
  #define VFR(i) (bf16x8){vlo[i][0],vlo[i][1],vlo[i][2],vlo[i][3],vhi[i][0],vhi[i][1],vhi[i][2],vhi[i][3]}
  #define PIN(x) asm volatile("":"+v"(x))
  #define MX3(a,b,c) __builtin_fmaxf(__builtin_fmaxf((a),(b)),(c))
  #define GAPA(MF,A0,A1,A2,A3,W0,W1,PW) do{ MF; sacc+=A0; sacc+=A1; sacc+=A2; sacc+=A3; PIN(sacc); W0; W1; PIN(PW); SBAR(); }while(0)
  #define EX(v) __builtin_amdgcn_exp2f(v)
  #define GAPB(MF,X,B) do{ MF; X[B]=EX(X[B]); X[B+1]=EX(X[B+1]); X[B+2]=EX(X[B+2]); X[B+3]=EX(X[B+3]); PIN(X); SBAR(); }while(0)
  #define VRD(i) do{ vlo[i]=vtr(vp_+(((i)>>2)*4096+((i)&3)*1024)); vhi[i]=vtr(vp_+(((i)>>2)*4096+((i)&3)*1024+512)); }while(0)
  #define KRD(G,j) do{ if(G){ kload2(kf,kp0+sl_next,j); SBAR(); } }while(0)
  #define STEP(C0,C1,P0,P1,t,GK,GV,GL) do{ SBAR(); \
    const lds_cptr vp_=vp0+sl_prev; \
    VRD(0); SBAR(); float sacc=(P0[0]+P0[1]); \
    GAPA(C0=__builtin_amdgcn_mfma_f32_32x32x16_bf16(kf[0],qr[0],negm,0,0,0), P0[2],P0[3],P0[4],P0[5],     pw0[0]=PKW(P0,0), pw0[1]=PKW(P0,2), pw0); \
    VRD(4); SBAR(); GAPA(C1=__builtin_amdgcn_mfma_f32_32x32x16_bf16(kf[1],qr[0],negm,0,0,0), P0[6],P0[7],P0[8],P0[9],     pw0[2]=PKW(P0,4), pw0[3]=PKW(P0,6), pw0); \
    VRD(1); SBAR(); GAPA(C0=__builtin_amdgcn_mfma_f32_32x32x16_bf16(kf[2],qr[1],C0,0,0,0),   P0[10],P0[11],P0[12],P0[13], pw1[0]=PKW(P0,8), pw1[1]=PKW(P0,10), pw1); \
    VRD(5); SBAR(); GAPA(C1=__builtin_amdgcn_mfma_f32_32x32x16_bf16(kf[3],qr[1],C1,0,0,0),   P0[14],P0[15],P1[0],P1[1],   pw1[2]=PKW(P0,12),pw1[3]=PKW(P0,14), pw1); \
    VRD(2); SBAR(); GAPA(C0=__builtin_amdgcn_mfma_f32_32x32x16_bf16(kf[4],qr[2],C0,0,0,0),   P1[2],P1[3],P1[4],P1[5],     pw2[0]=PKW(P1,0), pw2[1]=PKW(P1,2), pw2); \
    VRD(6); SBAR(); GAPA(C1=__builtin_amdgcn_mfma_f32_32x32x16_bf16(kf[5],qr[2],C1,0,0,0),   P1[6],P1[7],P1[8],P1[9],     pw2[2]=PKW(P1,4), pw2[3]=PKW(P1,6), pw2); \
    VRD(3); SBAR(); GAPA(C0=__builtin_amdgcn_mfma_f32_32x32x16_bf16(kf[6],qr[3],C0,0,0,0),   P1[10],P1[11],P1[12],P1[13], pw3[0]=PKW(P1,8), pw3[1]=PKW(P1,10), pw3); \
    VRD(7); SBAR(); GAPA(C1=__builtin_amdgcn_mfma_f32_32x32x16_bf16(kf[7],qr[3],C1,0,0,0),   P1[14],P1[15],0.f,0.f,       pw3[2]=PKW(P1,12),pw3[3]=PKW(P1,14), pw3); \
    l_reg+=sacc; \
    if(GK){DMA_K((t)+3,sl_cur);} if(GV){DMA_V((t)+1,sl_next);} \
    CMASK(C0,C1,t); \
    { float a=MX3(C0[0],C0[1],C1[0]),b=MX3(C0[2],C0[3],C1[1]); a=MX3(a,C1[2],C1[3]); \
      _Pragma("unroll") for(int r=4;r<16;r+=4){a=MX3(a,C0[r],C0[r+1]);b=MX3(b,C0[r+2],C0[r+3]);a=MX3(a,C1[r],C1[r+1]);b=MX3(b,C1[r+2],C1[r+3]);} \
      float rm=__builtin_fmaxf(a,b); { auto rr=__builtin_amdgcn_permlane32_swap(__float_as_uint(rm),__float_as_uint(rm),false,false); rm=__builtin_fmaxf(__uint_as_float(rr[0]),__uint_as_float(rr[1])); } \
      resc=false; \
      if(__builtin_expect(__any(rm>(float)THRL),0)){ const float dl=__builtin_fmaxf(rm,0.f); mhat+=dl; \
        _Pragma("unroll") for(int r=0;r<16;++r){C0[r]-=dl;C1[r]-=dl;} \
        _Pragma("unroll") for(int r=0;r<16;++r)negm[r]=-mhat; asm volatile("":"+v"(negm)); \
        const float f=__builtin_amdgcn_exp2f(-dl); l_reg*=f; if(hi==0)wsf[r32]=f; resc=true; } } \
    SBAR(); \
    GAPB(o[0]=__builtin_amdgcn_mfma_f32_32x32x16_bf16(PAF(0),VFR(0),o[0],0,0,0), C0,0); \
    GAPB(o[1]=__builtin_amdgcn_mfma_f32_32x32x16_bf16(PAF(0),VFR(4),o[1],0,0,0), C0,4); \
    KRD(GL,0); GAPB(o[0]=__builtin_amdgcn_mfma_f32_32x32x16_bf16(PAF(1),VFR(1),o[0],0,0,0), C0,8); \
    KRD(GL,1); GAPB(o[1]=__builtin_amdgcn_mfma_f32_32x32x16_bf16(PAF(1),VFR(5),o[1],0,0,0), C0,12); \
    KRD(GL,2); GAPB(o[0]=__builtin_amdgcn_mfma_f32_32x32x16_bf16(PAF(2),VFR(2),o[0],0,0,0), C1,0); \
    KRD(GL,3); GAPB(o[1]=__builtin_amdgcn_mfma_f32_32x32x16_bf16(PAF(2),VFR(6),o[1],0,0,0), C1,4); \
    GAPB(o[0]=__builtin_amdgcn_mfma_f32_32x32x16_bf16(PAF(3),VFR(3),o[0],0,0,0), C1,8); \
    GAPB(o[1]=__builtin_amdgcn_mfma_f32_32x32x16_bf16(PAF(3),VFR(7),o[1],0,0,0), C1,12); \
    }while(0)
  int t=1;
  #undef CMASK
  #define CMASK(P0,P1,t) do{}while(0)
  for(;t+5<NT;t+=2){
    STEP(pB0,pB1,pA0,pA1,t,true,true,true);     WAIT_BAR(2); RESC(); ROT();
    STEP(pA0,pA1,pB0,pB1,t+1,true,true,true);   WAIT_BAR(2); RESC(); ROT();
  }
  #undef CMASK
  #define CMASK(P0,P1,t) do{}while(0)
  #define ENDW(tt) do{ if((tt)+3<NT){WAIT_BAR(2);} else if((tt)+2<NT){WAIT_BAR(1);} else {WAIT_BAR(0);} }while(0)
  for(;t+1<NT;t+=2){
    STEP(pB0,pB1,pA0,pA1,t,(t+3<NT),(t+1<NT),(t+1<NT));       ENDW(t);   RESC(); ROT();
    STEP(pA0,pA1,pB0,pB1,t+1,(t+4<NT),(t+2<NT),(t+2<NT));     ENDW(t+1); RESC(); ROT();
  }
  STEP(pB0,pB1,pA0,pA1,NT-1,false,false,false); RESC();
  { float sacc=pB0[0]+pB0[1]; _Pragma("unroll") for(int r=2;r<16;++r)sacc+=pB0[r]; _Pragma("unroll") for(int r=0;r<16;++r)sacc+=pB1[r]; l_reg+=sacc;
    pw0=(u32x4){PKW(pB0,0),PKW(pB0,2),PKW(pB0,4),PKW(pB0,6)};pw1=(u32x4){PKW(pB0,8),PKW(pB0,10),PKW(pB0,12),PKW(pB0,14)};pw2=(u32x4){PKW(pB1,0),PKW(pB1,2),PKW(pB1,4),PKW(pB1,6)};pw3=(u32x4){PKW(pB1,8),PKW(pB1,10),PKW(pB1,12),PKW(pB1,14)};
    SBAR(); pv(o,vb0+sl_cur,PAF(0),PAF(1),PAF(2),PAF(3)); }
  #undef PKW
  #undef PAF
  #undef VFR
  #undef PIN
  #undef MX3
  #undef GAPA
  #undef GAPB
  #undef EX
  #undef VRD
  #undef KRD
  #undef STEP
  #undef ENDW
  {auto rr=__builtin_amdgcn_permlane32_swap(__float_as_uint(l_reg),__float_as_uint(l_reg),false,false);l_reg=__uint_as_float(rr[0])+__uint_as_float(rr[1]);}
  if(hi==0)wsf[32+r32]=l_reg;asm volatile("s_waitcnt lgkmcnt(0)":::"memory");
  float rli[16];
  #pragma unroll
  for(int r=0;r<16;++r)rli[r]=__builtin_amdgcn_rcpf(wsf[32+crow(r,hi)]);
  bf16*Ow=O+(qrow0+wid*QBLK)*DM+h*D;
  { bf16*stg=(bf16*)(shm+LDS_OST)+wid*2048;
    #pragma unroll
    for(int r=0;r<16;++r){const int orow=crow(r,hi);
      #pragma unroll
      for(int d0=0;d0<2;++d0)stg[orow*64+d0*32+r32]=__float2bfloat16(o[d0][r]*rli[r]);}
    asm volatile("s_waitcnt lgkmcnt(0)":::"memory");
    #pragma unroll
    for(int i=0;i<4;++i){const int row=i*8+(lane>>3),ch=lane&7; const u32x4 v=*(const u32x4*)(stg+row*64+ch*8); ATTN_STORE16(Ow+(long)row*DM+ch*8,v);} }
  asm volatile("s_waitcnt lgkmcnt(0)\n\ts_barrier":::"memory");
  #undef DMA_K
  #undef DMA_V
  #undef CMASK
  #undef START
  #undef RESC
  #undef ROT
}
constexpr int ATTN_LDS_BYTES=LDS_BYTES;
#undef SBAR
#undef WAIT_BAR
}

constexpr int NWAVES = 8;
constexpr int NB = 8, SEQ = 4096, CTXL = 256, TB = SEQ + CTXL  , MT = NB * TB  , DMODEL = 1024;
constexpr int NMODC = 6 * DMODEL, MODROWS = 9;
constexpr int QKVN = 1536, WINN = 3104, WINP = 3328;
constexpr int NEXP = 32, TOPK = 4, MPAD = MT * TOPK + NEXP * 256;
constexpr int NLAYER = 4;
constexpr float RMS_EPS = 1e-6f;
constexpr float ATT_C2 = 0.125f * 1.4426950408889634f;

constexpr size_t MiB = 1u << 20;
constexpr size_t WS_CTL = 0, CTL_ZERO_BYTES = 1 * MiB;
constexpr size_t WS_MOD = 1 * MiB, WS_ROPE = 2 * MiB, WS_MODP = 3 * MiB;
constexpr size_t WS_SLOT = 17 * MiB, WS_GATEW = 18 * MiB, WS_SLOTPOS = 19 * MiB;
constexpr size_t WS_WQKV = 20 * MiB, WS_WOA = 26 * MiB, WS_WIN = 30 * MiB, WS_WOG = 43 * MiB, WS_WGU = 48 * MiB, WS_WDN = 560 * MiB;
constexpr size_t WS_X = 816 * MiB, WS_XN = 952 * MiB, WS_Q = 1020 * MiB, WS_K = 1088 * MiB, WS_V = 1105 * MiB, WS_G = 1122 * MiB;
constexpr size_t WS_OF = 1343 * MiB, WS_OB = 1479 * MiB, WS_XG = 1615 * MiB, WS_ACT = 1903 * MiB, WS_Y = 2191 * MiB, WS_XN8 = WS_ACT + 150 * MiB  , WS_PAR = 2479 * MiB, WS_LIST = 2483 * MiB  , WS_END = 2488 * MiB;
static_assert(WS_MODP + (size_t)16 * NLAYER * MODROWS * NMODC * 4 <= WS_SLOT && WS_WIN + (size_t)2 * WINP * 1024 * 2 <= WS_WOG && WS_G + (size_t)MT * WINP * 2 <= WS_OF && WS_XG + (size_t)MPAD * 1024 * 2 <= WS_ACT, "ws map");
constexpr int CW_TMO = 0, CW_BAR = 4096, CW_CNT = 16384;

constexpr int RING_OFF = 0, RING_BYTES = 131072;
constexpr int WR_STRIDE = 1028;
constexpr int LDS_AUX = 133120;
constexpr int AUX_LCNT = LDS_AUX, AUX_GB = LDS_AUX + 128, AUX_T2E = LDS_AUX + 256  , AUX_BASE = AUX_T2E + 2560  , AUX_NT = AUX_BASE + 128, AUX_CNT = AUX_NT + 64  , AUX_ENT = AUX_CNT + 128  , AUX_RS = AUX_ENT + 4352  , AUX_ROWTAB = AUX_RS + 576, ROWTAB_UNITS = 18  ;
constexpr int MISC_OFF = 154624;
constexpr int LDS_BYTES = 155648;
static_assert(AUX_ROWTAB + ROWTAB_UNITS * 512 <= MISC_OFF, "LDS map");

#define GAS __attribute__((address_space(1)))
#define LAS __attribute__((address_space(3)))
typedef unsigned short bf16;
typedef unsigned v4u __attribute__((ext_vector_type(4)));
typedef float f32x4 __attribute__((ext_vector_type(4)));
typedef short bf16x8 __attribute__((ext_vector_type(8)));
typedef GAS unsigned gu32;
typedef GAS unsigned long long gu64;
#define RLX_AGENT __ATOMIC_RELAXED, __HIP_MEMORY_SCOPE_AGENT
#define LDS_WAIT() asm volatile("s_waitcnt lgkmcnt(0)" ::: "memory")
#define VM_WAIT() asm volatile("s_waitcnt vmcnt(0)" ::: "memory")
__device__ __forceinline__ unsigned long long rt() { return __builtin_amdgcn_s_memrealtime(); }
__device__ __forceinline__ unsigned f2bf(float f) { unsigned u = __builtin_bit_cast(unsigned, f); return (u + 0x7fffu + ((u >> 16) & 1u)) >> 16; }
__device__ __forceinline__ unsigned pk2(float lo, float hi) { return f2bf(lo) | (f2bf(hi) << 16); }

#define XB_TMO      128
#define XB_XCNT(j)  (256  + 64 * (j))
#define XB_XSUB(j)  (1280 + 64 * (j))
#define XB_XGEN(j)  (2304 + 64 * (j))
#define XB_TOP      3328
#define XB_TOPGEN   3392
#define XCD_BAR_WORDS 3456
#define XB_SPIN_CAP (1u << 18)

__device__ __forceinline__ unsigned xb_ld(unsigned* p)              { return __hip_atomic_load(p, __ATOMIC_RELAXED, __HIP_MEMORY_SCOPE_AGENT); }
__device__ __forceinline__ unsigned xb_add(unsigned* p, unsigned v) { return __hip_atomic_fetch_add(p, v, __ATOMIC_RELAXED, __HIP_MEMORY_SCOPE_AGENT); }
__device__ __forceinline__ unsigned xb_xcc_id() { return (unsigned)__builtin_amdgcn_s_getreg((3 << 11) | 20) & 0xFu; }
#define XB_SPIN(cond, bar) do { unsigned _sp = 0; while (cond) { __builtin_amdgcn_s_sleep(1); \
    if ((++_sp & 255u) == 0u) { if (xb_ld(&(bar)[XB_TMO])) break; if (_sp > XB_SPIN_CAP) { atomicAdd(&(bar)[XB_TMO], 1u); break; } } } } while (0)

struct XcdBarrier {
    unsigned* bar; unsigned x;
    volatile LAS unsigned* st;
};

__device__ __forceinline__ XcdBarrier xcd_barrier_post(unsigned* bar, volatile LAS unsigned* st, bool xb_t0  ) {
    XcdBarrier b; b.bar = bar; b.x = xb_xcc_id(); b.st = st;
    if (xb_t0) (void)xb_add(&bar[XB_XCNT(b.x)], 1u);
    return b;
}
__device__ __forceinline__ void xcd_barrier_complete(unsigned* bar, unsigned x, unsigned& nloc, unsigned& nx) {
    const unsigned G = gridDim.x * gridDim.y * gridDim.z;
    unsigned sum, cnt, mine, sp = 0u;
    for (;;) {
        sum = 0u; cnt = 0u; mine = 0u;
#pragma unroll
        for (unsigned j = 0; j < 16; ++j) { const unsigned c = xb_ld(&bar[XB_XCNT(j)]); sum += c; cnt += (c > 0u) ? 1u : 0u; mine = (j == x) ? c : mine; }
        if (sum == G) break;
        __builtin_amdgcn_s_sleep(1);
        if ((++sp & 255u) == 0u) { if (xb_ld(&bar[XB_TMO])) break; if (sp > XB_SPIN_CAP) { atomicAdd(&bar[XB_TMO], 1u); break; } }
    }
    nloc = mine > 0u ? mine : 1u; nx = cnt > 0u ? cnt : 1u;
}

__device__ __forceinline__ void xcd_barrier(const XcdBarrier& b, bool xb_t0  ) {
    asm volatile("s_waitcnt vmcnt(0)" ::: "memory");
    __syncthreads();
    if (xb_t0) {
        unsigned* bar = b.bar;
        __builtin_amdgcn_s_waitcnt(0);
        unsigned nloc = b.st[0], nx = b.st[1];
        if (nloc == 0u) { xcd_barrier_complete(bar, b.x, nloc, nx); b.st[0] = nloc; b.st[1] = nx; }
        const unsigned old = xb_add(&bar[XB_XSUB(b.x)], 1u);
        const unsigned gen = old / nloc;
        if (old + 1u == (gen + 1u) * nloc) {
            __builtin_amdgcn_fence(__ATOMIC_RELEASE, "agent");
            asm volatile("s_waitcnt vmcnt(0)" ::: "memory");
            const unsigned og = xb_add(&bar[XB_TOP], 1u);
            const unsigned tg = og / nx;
            if (og + 1u == (tg + 1u) * nx) xb_add(&bar[XB_TOPGEN], 1u);
            else XB_SPIN(xb_ld(&bar[XB_TOPGEN]) == tg, bar);
            __builtin_amdgcn_fence(__ATOMIC_ACQUIRE, "agent");
            xb_add(&bar[XB_XGEN(b.x)], 1u);
            asm volatile("s_waitcnt vmcnt(0)" ::: "memory");
        } else {
            XB_SPIN(xb_ld(&bar[XB_XGEN(b.x)]) == gen, bar);
            __builtin_amdgcn_fence(__ATOMIC_ACQUIRE, "agent");
            asm volatile("s_waitcnt vmcnt(0)" ::: "memory");
        }
    }
    __syncthreads();
}

typedef float f32x2 __attribute__((ext_vector_type(2)));
using pg8::lane_now; using pg8::shx;
__device__ __forceinline__ float wave_sum(float v) {
    const int ln = lane_now();
#pragma unroll
    for (int o = 1; o < 64; o <<= 1) v += shx(v, o, ln);
    return v;
}
__device__ __forceinline__ float wave_max(float v) {
    const int ln = lane_now();
#pragma unroll
    for (int o = 1; o < 64; o <<= 1) v = fmaxf(v, shx(v, o, ln));
    return v;
}
__device__ __forceinline__ float bf2f(unsigned short h) { return __uint_as_float((unsigned)h << 16); }
__device__ __forceinline__ float silu_f(float x) { return x / (1.0f + __expf(-x)); }
__device__ __forceinline__ f32x4 bf4_to_f32(unsigned long long v) { return (f32x4){__uint_as_float((unsigned)(v & 0xffffu) << 16), __uint_as_float((unsigned)(v >> 16) << 16), __uint_as_float((unsigned)((v >> 32) & 0xffffu) << 16), __uint_as_float((unsigned)(v >> 48) << 16)}; }
__device__ __forceinline__ unsigned long long f32_to_bf4(f32x4 y) { return (unsigned long long)pk2(y.x, y.y) | ((unsigned long long)pk2(y.z, y.w) << 32); }
__device__ __forceinline__ int mod_row(int m) { const int b = m / TB; return (m - b * TB < CTXL) ? 8 : b; }

__device__ __forceinline__ void titem_load(const float* W, int N, int k0, int n0, int lane, f32x4 (&v)[16]) {
    const GAS f32x4* p = (const GAS f32x4*)(W + (size_t)(k0 + 16 * (lane >> 3)) * N + n0 + 4 * (lane & 7));
#pragma unroll
    for (int j = 0; j < 16; ++j) v[j] = p[(size_t)j * (N >> 2)];
}
__device__ __forceinline__ void titem_store8(const f32x4 (&v)[16], unsigned char* WT8, int K, int k0, int dst_row0, int lane) {
    unsigned char* o = WT8 + (size_t)(dst_row0 + 4 * (lane & 7)) * K + k0 + 16 * (lane >> 3);
#pragma unroll
    for (int i = 0; i < 4; ++i) { v4u q;
        q.x = pg8::pk4_fp8(v[0][i] * 32.f, v[1][i] * 32.f, v[2][i] * 32.f, v[3][i] * 32.f); q.y = pg8::pk4_fp8(v[4][i] * 32.f, v[5][i] * 32.f, v[6][i] * 32.f, v[7][i] * 32.f);
        q.z = pg8::pk4_fp8(v[8][i] * 32.f, v[9][i] * 32.f, v[10][i] * 32.f, v[11][i] * 32.f); q.w = pg8::pk4_fp8(v[12][i] * 32.f, v[13][i] * 32.f, v[14][i] * 32.f, v[15][i] * 32.f);
        *(GAS v4u*)(o + (size_t)i * K) = q; }
}
__device__ __forceinline__ void titem_store16(const f32x4 (&v)[16], bf16* WT, int K, int k0, int dst_row0, int lane) {
    bf16* o = WT + (size_t)(dst_row0 + 4 * (lane & 7)) * K + k0 + 16 * (lane >> 3);
#pragma unroll
    for (int i = 0; i < 4; ++i) { v4u q0, q1;
        q0.x = pk2(v[0][i], v[1][i]); q0.y = pk2(v[2][i], v[3][i]); q0.z = pk2(v[4][i], v[5][i]); q0.w = pk2(v[6][i], v[7][i]);
        q1.x = pk2(v[8][i], v[9][i]); q1.y = pk2(v[10][i], v[11][i]); q1.z = pk2(v[12][i], v[13][i]); q1.w = pk2(v[14][i], v[15][i]);
        *(GAS v4u*)(o + (size_t)i * K) = q0; *(GAS v4u*)(o + (size_t)i * K + 8) = q1; }
}

struct Args { const float* in[25]; float* out; unsigned char* ws; int ph_lo, ph_hi; };
constexpr int P_N1G = 0, P_N2G = 4096, P_QG = 8192, P_KG = 8320, P_GKF = 8448, P_GKB = 24832, P_BGF = 41216, P_BGB = 42240, P_OG = 43264, P_WR = 43776, P_BR = 174848, P_BGU = 174976, P_BDN = 437120, P_END = 568192;
#define LAUNDER_S(p) asm volatile("" : "+s"(p))
#define LAUNDER_V(p) asm volatile("" : "+v"(p))
#define PARF(ws) ((const float*)((ws) + WS_PAR))

constexpr int I8_GU = 128 * 8 * 64, I8_DN = 128 * 8 * 32, NI8 = I8_GU + I8_DN;
struct T8 { const float* W; unsigned char* O; int N, k0, n0, dst; };
__device__ __forceinline__ T8 dec8(const Args& A, unsigned char* ws, int it) { T8 t;
    const bool gu = it < I8_GU; const int r = gu ? it : it - I8_GU, sh = gu ? 6 : 5, mat = r >> (3 + sh), q = r & ((8 << sh) - 1), kb = q >> sh, n0 = (q & ((1 << sh) - 1)) * 32;
    t.N = gu ? 2048 : 1024; t.W = (gu ? A.in[21] : A.in[23]) + (size_t)mat * 1024 * t.N; t.O = ws + (gu ? WS_WGU : WS_WDN) + (size_t)mat * 1024 * t.N; t.k0 = kb * 128; t.n0 = n0;
    t.dst = gu ? ((n0 & 1023) >> 7) * 256 + (n0 >> 10) * 128 + (n0 & 127) : n0;
    return t; }
__device__ __forceinline__ void p0_prologue(const Args& A, LAS unsigned char* lds, int gw, int NGW, int wave, int lane) {
    unsigned char* ws = A.ws;
    { f32x4 va[16], vb[16]; int it = gw;
      if (it < NI8) { const T8 t = dec8(A, ws, it); titem_load(t.W, t.N, t.k0, t.n0, lane, va); }
      while (it + 2 * NGW < NI8) {
          { const T8 t = dec8(A, ws, it + NGW); titem_load(t.W, t.N, t.k0, t.n0, lane, vb); }
          { const T8 t = dec8(A, ws, it); titem_store8(va, t.O, 1024, t.k0, t.dst, lane); }
          { const T8 t = dec8(A, ws, it + 2 * NGW); titem_load(t.W, t.N, t.k0, t.n0, lane, va); }
          { const T8 t = dec8(A, ws, it + NGW); titem_store8(vb, t.O, 1024, t.k0, t.dst, lane); }
          it += 2 * NGW; }
      if (it < NI8) { const bool hb = it + NGW < NI8;
          if (hb) { const T8 t = dec8(A, ws, it + NGW); titem_load(t.W, t.N, t.k0, t.n0, lane, vb); }
          { const T8 t = dec8(A, ws, it); titem_store8(va, t.O, 1024, t.k0, t.dst, lane); }
          if (hb) { const T8 t = dec8(A, ws, it + NGW); titem_store8(vb, t.O, 1024, t.k0, t.dst, lane); } } }
    constexpr int J_QKV = 2 * 8 * (QKVN / 32), J_WO = 2 * 8 * 32, J_WIN = 2 * 8 * (WINN / 32), NJ = J_QKV + J_WO + J_WIN + J_WO;
    for (int it = gw; it < NJ; it += NGW) { int r = it; const float* W; bf16* O; int N, kb, n0, dst;
        if (r < J_QKV) { const int per = 8 * (QKVN / 32), mat = r / per, q = r - mat * per; kb = q / (QKVN / 32); n0 = (q - kb * (QKVN / 32)) * 32;
            dst = (n0 & ~255) + ((n0 >> 5) & 1) * 128 + ((n0 >> 6) & 3) * 32;
            W = A.in[8] + (size_t)mat * 1024 * QKVN; N = QKVN; O = (bf16*)(ws + WS_WQKV) + (size_t)mat * QKVN * 1024; }
        else if ((r -= J_QKV) < J_WO) { const int mat = r >> 8, q = r & 255; kb = q >> 5; n0 = (q & 31) * 32; dst = n0;
            W = A.in[11] + (size_t)mat * 1024 * 1024; N = 1024; O = (bf16*)(ws + WS_WOA) + (size_t)mat * 1024 * 1024; }
        else if ((r -= J_WO) < J_WIN) { const int per = 8 * (WINN / 32), mat = r / per, q = r - mat * per; kb = q / (WINN / 32); n0 = (q - kb * (WINN / 32)) * 32; dst = n0;
            W = A.in[12] + (size_t)mat * 1024 * WINN; N = WINN; O = (bf16*)(ws + WS_WIN) + (size_t)mat * WINP * 1024; }
        else { r -= J_WIN; const int mat = r >> 8, q = r & 255; kb = q >> 5; n0 = (q & 31) * 32; dst = n0;
            W = A.in[18] + (size_t)mat * 1024 * 1024; N = 1024; O = (bf16*)(ws + WS_WOG) + (size_t)mat * 1024 * 1024; }
        f32x4 v[16]; titem_load(W, N, kb * 128, n0, lane, v); titem_store16(v, O, 1024, kb * 128, dst, lane); }
    for (int it = gw; it < 2 * (WINP - WINN); it += NGW) { const int mat = it / (WINP - WINN), rr = WINN + it - mat * (WINP - WINN);
        GAS v4u* p = (GAS v4u*)((bf16*)(ws + WS_WIN) + ((size_t)mat * WINP + rr) * 1024) + lane; p[0] = (v4u){0u, 0u, 0u, 0u}; p[64] = (v4u){0u, 0u, 0u, 0u}; }
    for (int it = NGW - 1 - gw; it < NLAYER * 24 * 16; it += NGW) {
        const int l = it / (24 * 16), q = it - l * (24 * 16), cg = q / 16, kc = q - cg * 16;
        float s[MODROWS];
#pragma unroll
        for (int r = 0; r < MODROWS; ++r) { const float cv = (r < 8) ? A.in[1][r * 1024 + kc * 64 + lane] : A.in[3][kc * 64 + lane]; s[r] = silu_f(cv); }
        f32x4 acc[MODROWS];
#pragma unroll
        for (int r = 0; r < MODROWS; ++r) acc[r] = (f32x4){0.f, 0.f, 0.f, 0.f};
        const float* wp = A.in[4] + ((size_t)l * 1024 + kc * 64) * NMODC + cg * 256 + 4 * lane;
#pragma unroll 8
        for (int kk = 0; kk < 64; ++kk) { const f32x4 w = *(const f32x4*)(wp + (size_t)kk * NMODC);
#pragma unroll
            for (int r = 0; r < MODROWS; ++r) { const float sv = __shfl(s[r], kk); acc[r] = acc[r] + w * sv; } }
        float* op = (float*)(ws + WS_MODP) + (size_t)kc * (NLAYER * MODROWS * NMODC) + (size_t)l * MODROWS * NMODC + cg * 256 + 4 * lane;
#pragma unroll
        for (int r = 0; r < MODROWS; ++r) *(f32x4*)(op + (size_t)r * NMODC) = acc[r];
    }
    for (int m0 = gw; m0 < MT; m0 += 4 * NGW) { f32x4 x[4][4];
#pragma unroll
        for (int r = 0; r < 4; ++r) { const int m = m0 + r * NGW; if (m < MT) { const int b = m / TB, w = m - b * TB;
            const float* src = (w < CTXL) ? A.in[2] + ((size_t)b * CTXL + w) * 1024 : A.in[0] + ((size_t)b * SEQ + (w - CTXL)) * 1024; const GAS f32x4* sp = (const GAS f32x4*)src + lane;
#pragma unroll
            for (int j = 0; j < 4; ++j) x[r][j] = sp[64 * j]; } }
#pragma unroll
        for (int r = 0; r < 4; ++r) { const int m = m0 + r * NGW; if (m < MT) { GAS unsigned long long* dp = (GAS unsigned long long*)((bf16*)(ws + WS_X) + (size_t)m * 1024) + lane;
#pragma unroll
            for (int j = 0; j < 4; ++j) dp[64 * j] = f32_to_bf4(x[r][j]); } } }
    { float* par = (float*)(ws + WS_PAR); const int gt = gw * 64 + lane, NGT = NGW * 64;
#define CPL(k, src, n) float c##k##a = 0.f, c##k##b = 0.f; if (gt < (n)) c##k##a = A.in[src][gt]; if (gt + NGT < (n)) c##k##b = A.in[src][gt + NGT];
#define CPS(k, src, n, off) if (gt < (n)) par[(off) + gt] = c##k##a; if (gt + NGT < (n)) par[(off) + gt + NGT] = c##k##b; for (int i = gt + 2 * NGT; i < (n); i += NGT) par[(off) + i] = A.in[src][i];
      CPL(0, 6, 4096) CPL(1, 7, 4096) CPL(2, 9, 128) CPL(3, 10, 128) CPL(4, 13, 16384) CPL(5, 15, 16384) CPL(6, 14, 1024) CPL(7, 16, 1024) CPL(8, 17, 512) CPL(9, 19, 131072) CPL(10, 20, 128) CPL(11, 22, 262144) CPL(12, 24, 131072)
      CPS(0, 6, 4096, P_N1G) CPS(1, 7, 4096, P_N2G) CPS(2, 9, 128, P_QG) CPS(3, 10, 128, P_KG) CPS(4, 13, 16384, P_GKF) CPS(5, 15, 16384, P_GKB) CPS(6, 14, 1024, P_BGF) CPS(7, 16, 1024, P_BGB)
      CPS(8, 17, 512, P_OG) CPS(9, 19, 131072, P_WR) CPS(10, 20, 128, P_BR) CPS(11, 22, 262144, P_BGU) CPS(12, 24, 131072, P_BDN)
#undef CPL
#undef CPS
    }
    for (int idx = gw * 64 + lane; idx < SEQ * 32; idx += NGW * 64) { const int s = idx >> 5, i = idx & 31;
        const float invf = 1.0f / powf(10000.0f, (float)(i & 15) * (1.0f / 16.0f));
        const float ang = (float)((i < 16) ? (s >> 6) : (s & 63)) * invf;
        ((float*)(ws + WS_ROPE))[idx] = cosf(ang); ((float*)(ws + WS_ROPE))[SEQ * 32 + idx] = sinf(ang); }
}
__device__ __forceinline__ void p1_mod_reduce(const Args& A, int gtid, int NGT) {
    const float* P = (const float*)(A.ws + WS_MODP); float* Mo = (float*)(A.ws + WS_MOD);
    constexpr int N = NLAYER * MODROWS * NMODC;
    for (int i = gtid; i < N; i += NGT) { const int l = i / (MODROWS * NMODC), c = i % NMODC; float s = A.in[5][l * NMODC + c];
#pragma unroll
        for (int k = 0; k < 16; ++k) s += P[(size_t)k * N + i];
        Mo[i] = s; }
}
__device__ __forceinline__ void modulate_row(const bf16* xrow, const float* ng, const float* shp, const float* scp, bf16* orow, int lane, f32x4 (&y)[4], float& rs_out) {
    const GAS unsigned long long* xr = (const GAS unsigned long long*)xrow + lane;
    float ss = 0.f;
#pragma unroll
    for (int j = 0; j < 4; ++j) { y[j] = bf4_to_f32(xr[64 * j]); ss += (y[j].x * y[j].x + y[j].y * y[j].y) + (y[j].z * y[j].z + y[j].w * y[j].w); }
    const float rs = 1.0f / sqrtf(wave_sum(ss) * (1.0f / 1024.0f) + RMS_EPS); rs_out = rs;
    GAS unsigned long long* o8 = (GAS unsigned long long*)orow + lane;
#pragma unroll
    for (int j = 0; j < 4; ++j) { const f32x4 g = ((const GAS f32x4*)ng)[64 * j + lane], sh = ((const GAS f32x4*)shp)[64 * j + lane], sc = ((const GAS f32x4*)scp)[64 * j + lane];
        y[j] = (y[j] * rs) * g * (sc + 1.0f) + sh;
        o8[64 * j] = (unsigned long long)pk2(y[j].x, y[j].y) | ((unsigned long long)pk2(y[j].z, y[j].w) << 32); }
}
__device__ __forceinline__ void modulate_row2(const bf16* xa, const bf16* xb, const float* ng, const float* sha, const float* sca, const float* shb, const float* scb, unsigned char* oa, unsigned char* ob, int lane, float& rsa, float& rsb) {
    const GAS unsigned long long* pa = (const GAS unsigned long long*)xa + lane; const GAS unsigned long long* pb = (const GAS unsigned long long*)xb + lane;
    unsigned long long ra[4], rb[4];
#pragma unroll
    for (int j = 0; j < 4; ++j) { ra[j] = pa[64 * j]; rb[j] = pb[64 * j]; }
    f32x4 ya[4], yb[4]; float sa = 0.f, sb = 0.f;
#pragma unroll
    for (int j = 0; j < 4; ++j) { ya[j] = bf4_to_f32(ra[j]); yb[j] = bf4_to_f32(rb[j]); sa += (ya[j].x * ya[j].x + ya[j].y * ya[j].y) + (ya[j].z * ya[j].z + ya[j].w * ya[j].w); sb += (yb[j].x * yb[j].x + yb[j].y * yb[j].y) + (yb[j].z * yb[j].z + yb[j].w * yb[j].w); }
    const int ln = lane_now();
#pragma unroll
    for (int o = 1; o < 64; o <<= 1) { sa += shx(sa, o, ln); sb += shx(sb, o, ln); }
    rsa = 1.0f / sqrtf(sa * (1.0f / 1024.0f) + RMS_EPS); rsb = 1.0f / sqrtf(sb * (1.0f / 1024.0f) + RMS_EPS);
    GAS unsigned* qa = (GAS unsigned*)oa + lane; GAS unsigned* qb = (GAS unsigned*)ob + lane;
#pragma unroll
    for (int j = 0; j < 4; ++j) { const f32x4 g = ((const GAS f32x4*)ng)[64 * j + lane];
        const f32x4 ha = ((const GAS f32x4*)sha)[64 * j + lane], ca = ((const GAS f32x4*)sca)[64 * j + lane], hb = ((const GAS f32x4*)shb)[64 * j + lane], cb = ((const GAS f32x4*)scb)[64 * j + lane];
        const f32x4 va = (ya[j] * rsa) * g * (ca + 1.0f) + ha, vb = (yb[j] * rsb) * g * (cb + 1.0f) + hb;
        qa[64 * j] = pg8::pk4_fp8(va.x, va.y, va.z, va.w); qb[64 * j] = pg8::pk4_fp8(vb.x, vb.y, vb.z, vb.w); }
}
__device__ __forceinline__ void phase_modulate1(unsigned char* ws, int layer, int gw, int NGW, int lane) {
    const bf16* X = (const bf16*)(ws + WS_X); bf16* XN = (bf16*)(ws + WS_XN);
    const float* ng = PARF(ws) + P_N1G + layer * 1024; const float* Mo = (const float*)(ws + WS_MOD) + (size_t)layer * MODROWS * NMODC;
    for (int m = gw; m < MT; m += NGW) { const int mr = mod_row(m); f32x4 y[4]; float rs;
        modulate_row(X + (size_t)m * 1024, ng, Mo + (size_t)mr * NMODC + 0 * 1024, Mo + (size_t)mr * NMODC + 1 * 1024, XN + (size_t)m * 1024, lane, y, rs); }
}
__device__ __forceinline__ void phase_qknorm_rope(unsigned char* ws, int la, int gw, int NGW, int lane) {
    bf16* Qb = (bf16*)(ws + WS_Q); bf16* Kb = (bf16*)(ws + WS_K);
    const float* qg = PARF(ws) + P_QG + la * 64; const float* kg = PARF(ws) + P_KG + la * 64; const float* ropec = (const float*)(ws + WS_ROPE); const float* ropes = ropec + SEQ * 32;
    const int i = lane & 31, hs = lane >> 5;
    for (int m = gw; m < MT; m += NGW) { const int b = m / TB, w = m - b * TB; const bool lat = w >= CTXL;
        float cs = 1.f, sn = 0.f; if (lat) { cs = ropec[(w - CTXL) * 32 + i]; sn = ropes[(w - CTXL) * 32 + i]; }
#pragma unroll 2
        for (int hh = 0; hh < 20; hh += 2) { const int hd = hh + hs;
            unsigned* p = (hd < 16) ? (unsigned*)(Qb + (size_t)m * 1024 + hd * 64) + i : (unsigned*)(Kb + (size_t)m * 256 + (hd - 16) * 64) + i;
            const float* gp = (hd < 16) ? qg : kg; const float scl = (hd < 16) ? ATT_C2 : 1.0f;
            const unsigned v = *p; const float x1 = __uint_as_float(v << 16), x2 = __uint_as_float(v & 0xffff0000u);
            float ss = x1 * x1 + x2 * x2;
#pragma unroll
            for (int o = 1; o < 32; o <<= 1) ss += shx(ss, o, lane);
            const float rs = 1.0f / sqrtf(ss * (1.0f / 64.0f) + RMS_EPS);
            const float y1 = x1 * rs * gp[2 * i], y2 = x2 * rs * gp[2 * i + 1];
            const float r1 = (y1 * cs - y2 * sn) * scl, r2 = (y1 * sn + y2 * cs) * scl;
            *p = pk2(r1, r2); }
    }
}
__device__ __forceinline__ void phase_gla_recurrent(unsigned char* ws, int lg, LAS unsigned char* lds, int tid) {
    const int unit = blockIdx.x; if (unit >= 128) return;
    const int half = unit & 1, dir = (unit >> 1) & 1, h = (unit >> 2) & 3, b = unit >> 4;
    const bf16* G = (const bf16*)(ws + WS_G);
    float* Oo = (float*)(ws + (dir ? WS_OB : WS_OF));
    const float* wg = PARF(ws) + (dir ? P_GKB : P_GKF) + (size_t)lg * 16 * 512; const float* bg = PARF(ws) + (dir ? P_BGB : P_BGF) + lg * 512;
    LAS float* qq = (LAS float*)(lds + RING_OFF); LAS float* kk = qq + 64 * 128; LAS float* dd = kk + 64 * 128; LAS float* vv = dd + 64 * 128;
    const int sd = tid & 127, st0 = tid >> 7;
    float wcol[16];
#pragma unroll
    for (int r = 0; r < 16; ++r) wcol[r] = wg[r * 512 + h * 128 + sd];
    const float bcol = bg[h * 128 + sd];
    const int c = tid >> 2, dq = tid & 3;
    float s[32];
#pragma unroll
    for (int j = 0; j < 32; ++j) s[j] = 0.f;
    const float qscale = 0.08838834764831845f;
    for (int ch = 0; ch < TB / 64; ++ch) {
        __syncthreads();
#pragma unroll 4
        for (int i = 0; i < 16; ++i) { const int tt = st0 + 4 * i, n = 64 * ch + tt;
            const int w = dir ? (n < CTXL ? (CTXL - 1 - n) : (TB + CTXL - 1 - n)) : n;
            const bf16* gr = G + ((size_t)b * TB + w) * WINP;
            const float qv = bf2f(gr[h * 128 + sd]) * qscale, kv = bf2f(gr[512 + h * 128 + sd]);
            const bf16* lp = gr + 3072 + dir * 16; float z = bcol;
#pragma unroll
            for (int r = 0; r < 16; ++r) z += bf2f(lp[r]) * wcol[r];
            const float ls = fminf(z, 0.f) - log1pf(__expf(-fabsf(z)));
            qq[tt * 128 + sd] = qv; kk[tt * 128 + sd] = kv; dd[tt * 128 + sd] = __expf(ls * (1.0f / 16.0f));
            vv[tt * 128 + sd] = bf2f(gr[1024 + h * 256 + half * 128 + sd]); }
        __syncthreads();
        for (int tt = 0; tt < 64; ++tt) { const int n = 64 * ch + tt; const int w = dir ? (n < CTXL ? (CTXL - 1 - n) : (TB + CTXL - 1 - n)) : n;
            const float v = vv[tt * 128 + c]; float acc = 0.f;
            const LAS f32x4* q4 = (const LAS f32x4*)(qq + tt * 128 + dq * 32); const LAS f32x4* k4 = (const LAS f32x4*)(kk + tt * 128 + dq * 32); const LAS f32x4* d4 = (const LAS f32x4*)(dd + tt * 128 + dq * 32);
#pragma unroll
            for (int j = 0; j < 8; ++j) { const f32x4 qv = q4[j], kv = k4[j], dv = d4[j];
                s[4 * j + 0] = s[4 * j + 0] * dv.x + kv.x * v; acc += qv.x * s[4 * j + 0];
                s[4 * j + 1] = s[4 * j + 1] * dv.y + kv.y * v; acc += qv.y * s[4 * j + 1];
                s[4 * j + 2] = s[4 * j + 2] * dv.z + kv.z * v; acc += qv.z * s[4 * j + 2];
                s[4 * j + 3] = s[4 * j + 3] * dv.w + kv.w * v; acc += qv.w * s[4 * j + 3]; }
            acc += shx(acc, 1, tid & 63); acc += shx(acc, 2, tid & 63);
            if (dq == 0) Oo[((size_t)b * TB + w) * 1024 + h * 256 + half * 128 + c] = acc; }
    }
}
__device__ __forceinline__ void phase_gla_readout(unsigned char* ws, int lg, int gw, int NGW, int lane) {
    const float* OF = (const float*)(ws + WS_OF); const float* OB = (const float*)(ws + WS_OB); const bf16* G = (const bf16*)(ws + WS_G); bf16* OG = (bf16*)(ws + WS_Q);
    const f32x4 og = ((const GAS f32x4*)(PARF(ws) + P_OG + lg * 256))[lane];
    for (int m = gw; m < MT; m += NGW) {
#pragma unroll
        for (int hh = 0; hh < 4; ++hh) { const size_t off = (size_t)m * 1024 + hh * 256 + 4 * lane;
            f32x4 o = *(const GAS f32x4*)(OF + off) + *(const GAS f32x4*)(OB + off);
            const float ss = wave_sum((o.x * o.x + o.y * o.y) + (o.z * o.z + o.w * o.w));
            const float rs = 1.0f / sqrtf(ss * (1.0f / 256.0f) + RMS_EPS);
            const unsigned long long rv = *(const GAS unsigned long long*)(G + (size_t)m * WINP + 2048 + hh * 256 + 4 * lane);
            const float r0 = __uint_as_float((unsigned)(rv & 0xffffu) << 16), r1 = __uint_as_float((unsigned)(rv >> 16) << 16), r2 = __uint_as_float((unsigned)((rv >> 32) & 0xffffu) << 16), r3 = __uint_as_float((unsigned)(rv >> 48) << 16);
            o = o * rs * og;
            o.x *= silu_f(r0); o.y *= silu_f(r1); o.z *= silu_f(r2); o.w *= silu_f(r3);
            *(GAS unsigned long long*)(OG + off) = (unsigned long long)pk2(o.x, o.y) | ((unsigned long long)pk2(o.z, o.w) << 32); }
    }
}
constexpr size_t WS_GQ = WS_XG, WS_GKH = WS_XG + 68 * MiB, WS_GKT = WS_XG + 136 * MiB, WS_GVT = WS_XG + 204 * MiB, WS_GDL = WS_ACT, WS_SX = WS_OF;
static_assert((size_t)2176 * 2 * 16384 <= 68 * MiB && (size_t)2176 * 256 * 64 * 2 <= 68 * MiB && (size_t)64 * 68 * 65536 <= 272 * MiB, "gla buffers");
typedef float f32x16 __attribute__((ext_vector_type(16)));
__device__ __forceinline__ float log_sigmoid_fast(float z) { return fminf(z, 0.f) - __logf(1.0f + __expf(-fabsf(z))); }

struct G0Raw { unsigned qk[8][2]; v4u lfb; };
__device__ __forceinline__ void g0_load(G0Raw& R, unsigned char* ws, int cn, int tid) {
    const bf16* G = (const bf16*)(ws + WS_G);
    const int d2 = tid & 63, tb = tid >> 6, n = cn % 68, bh = cn / 68, h = bh & 3, b = bh >> 2;
    const size_t r0 = (size_t)b * TB + 64 * n;
#pragma unroll
    for (int j = 0; j < 8; ++j) { const bf16* gr = G + (r0 + 8 * tb + j) * WINP; R.qk[j][0] = *(const GAS unsigned*)(gr + h * 128 + 2 * d2); R.qk[j][1] = *(const GAS unsigned*)(gr + 512 + h * 128 + 2 * d2); }
    R.lfb = *(const GAS v4u*)(G + (r0 + ((tid & 255) >> 2)) * WINP + 3072 + 8 * (tid & 3));
}
__device__ __forceinline__ void g0_vload(unsigned (&raw)[32], const unsigned char* ws, int idx, int h, int dv, int th) {
    const int b = idx / 68, n = idx - b * 68; const bf16* vp = (const bf16*)(ws + WS_G) + ((size_t)b * TB + 64 * n + 32 * th) * WINP + 1024 + h * 256 + dv;
#pragma unroll
    for (int j = 0; j < 32; ++j) raw[j] = (unsigned)((const GAS bf16*)vp)[(size_t)j * WINP];
}
__device__ __forceinline__ void g0_vstore(const unsigned (&raw)[32], unsigned char* ws, int idx, int h, int dv, int th) {
    const int b = idx / 68, n = idx - b * 68, cn = (b * 4 + h) * 68 + n;
    unsigned char* vo = ws + WS_GVT + (size_t)cn * 32768 + (size_t)(((2 * th) * 8 + (dv >> 5)) * 64 + (dv & 31)) * 16;
    unsigned wv[16];
#pragma unroll
    for (int j = 0; j < 16; ++j) wv[j] = raw[2 * j] | (raw[2 * j + 1] << 16);
#pragma unroll
    for (int ql = 0; ql < 2; ++ql)
#pragma unroll
        for (int hq = 0; hq < 2; ++hq) *(GAS v4u*)(vo + ql * 8192 + hq * 512) = (v4u){wv[8 * ql + 2 * hq], wv[8 * ql + 2 * hq + 1], wv[8 * ql + 2 * hq + 4], wv[8 * ql + 2 * hq + 5]};
}
__device__ __forceinline__ void phase_gla_g0v(unsigned char* ws, int tid, int Gp, int bxp) {
    const int G4 = Gp >> 2, h = bxp & 3, wq = bxp >> 2;
    if (wq >= G4) return;
    const int dv = tid & 255, th = tid >> 8; unsigned ra[32], rb[32]; int idx = wq;
    if (idx < 544) g0_vload(ra, ws, idx, h, dv, th);
    while (idx + 2 * G4 < 544) { g0_vload(rb, ws, idx + G4, h, dv, th); g0_vstore(ra, ws, idx, h, dv, th); g0_vload(ra, ws, idx + 2 * G4, h, dv, th); g0_vstore(rb, ws, idx + G4, h, dv, th); idx += 2 * G4; }
    if (idx < 544) { const bool hb = idx + G4 < 544; if (hb) g0_vload(rb, ws, idx + G4, h, dv, th); g0_vstore(ra, ws, idx, h, dv, th); if (hb) g0_vstore(rb, ws, idx + G4, h, dv, th); }
}
__device__ __forceinline__ void phase_gla_g0(unsigned char* ws, int lg, LAS unsigned char* lds, int tid, int Gp, int bxp) {
    LAS float* tot = (LAS float*)(lds + RING_OFF);
    LAS unsigned char* lfl = lds + RING_OFF + 8192;
    const int d2 = tid & 63, tb = tid >> 6;
    const int G4 = Gp >> 2, h = bxp & 3, wq = bxp >> 2;
    if (wq >= G4 || wq >= 544) return;
        float wf0[16], wf1[16], wb0[16], wb1[16];
        { const float* wgf = PARF(ws) + P_GKF + (size_t)lg * 16 * 512 + h * 128 + 2 * d2; const float* wgb = PARF(ws) + P_GKB + (size_t)lg * 16 * 512 + h * 128 + 2 * d2;
#pragma unroll
          for (int r = 0; r < 16; ++r) { const f32x2 a = *(const GAS f32x2*)(wgf + r * 512), c = *(const GAS f32x2*)(wgb + r * 512); wf0[r] = a.x; wf1[r] = a.y; wb0[r] = c.x; wb1[r] = c.y; } }
        const f32x2 bf_ = *(const GAS f32x2*)(PARF(ws) + P_BGF + lg * 512 + h * 128 + 2 * d2), bb_ = *(const GAS f32x2*)(PARF(ws) + P_BGB + lg * 512 + h * 128 + 2 * d2);
    G0Raw R; g0_load(R, ws, ((wq / 68) * 4 + h) * 68 + wq % 68, tid);
    for (int idx = wq; idx < 544; idx += G4) {
        const int b = idx / 68, n = idx - b * 68, cn = (b * 4 + h) * 68 + n;
        __syncthreads();
        if (tid < 256) *(LAS v4u*)(lfl + tid * 16) = R.lfb;
        unsigned qk[8][2];
#pragma unroll
        for (int j = 0; j < 8; ++j) { qk[j][0] = R.qk[j][0]; qk[j][1] = R.qk[j][1]; }
        __syncthreads();
        if (idx + G4 < 544) { const int i2 = idx + G4, b2 = i2 / 68; g0_load(R, ws, (b2 * 4 + h) * 68 + (i2 - b2 * 68), tid); }
        float gf0[8], gf1[8], gb0[8], gb1[8];
#pragma unroll
        for (int j = 0; j < 8; ++j) { const LAS v4u* lp = (const LAS v4u*)(lfl + (8 * tb + j) * 64);
            const v4u l0 = lp[0], l1 = lp[1], l2 = lp[2], l3 = lp[3];
            float lf[16], lb[16];
            lf[0] = __uint_as_float(l0.x << 16); lf[1] = __uint_as_float(l0.x & 0xffff0000u); lf[2] = __uint_as_float(l0.y << 16); lf[3] = __uint_as_float(l0.y & 0xffff0000u);
            lf[4] = __uint_as_float(l0.z << 16); lf[5] = __uint_as_float(l0.z & 0xffff0000u); lf[6] = __uint_as_float(l0.w << 16); lf[7] = __uint_as_float(l0.w & 0xffff0000u);
            lf[8] = __uint_as_float(l1.x << 16); lf[9] = __uint_as_float(l1.x & 0xffff0000u); lf[10] = __uint_as_float(l1.y << 16); lf[11] = __uint_as_float(l1.y & 0xffff0000u);
            lf[12] = __uint_as_float(l1.z << 16); lf[13] = __uint_as_float(l1.z & 0xffff0000u); lf[14] = __uint_as_float(l1.w << 16); lf[15] = __uint_as_float(l1.w & 0xffff0000u);
            lb[0] = __uint_as_float(l2.x << 16); lb[1] = __uint_as_float(l2.x & 0xffff0000u); lb[2] = __uint_as_float(l2.y << 16); lb[3] = __uint_as_float(l2.y & 0xffff0000u);
            lb[4] = __uint_as_float(l2.z << 16); lb[5] = __uint_as_float(l2.z & 0xffff0000u); lb[6] = __uint_as_float(l2.w << 16); lb[7] = __uint_as_float(l2.w & 0xffff0000u);
            lb[8] = __uint_as_float(l3.x << 16); lb[9] = __uint_as_float(l3.x & 0xffff0000u); lb[10] = __uint_as_float(l3.y << 16); lb[11] = __uint_as_float(l3.y & 0xffff0000u);
            lb[12] = __uint_as_float(l3.z << 16); lb[13] = __uint_as_float(l3.z & 0xffff0000u); lb[14] = __uint_as_float(l3.w << 16); lb[15] = __uint_as_float(l3.w & 0xffff0000u);
            float zf0 = bf_.x, zf1 = bf_.y, zb0 = bb_.x, zb1 = bb_.y;
#pragma unroll
            for (int r = 0; r < 16; ++r) { zf0 += lf[r] * wf0[r]; zf1 += lf[r] * wf1[r]; zb0 += lb[r] * wb0[r]; zb1 += lb[r] * wb1[r]; }
            gf0[j] = log_sigmoid_fast(zf0) * 0.0625f; gf1[j] = log_sigmoid_fast(zf1) * 0.0625f; gb0[j] = log_sigmoid_fast(zb0) * 0.0625f; gb1[j] = log_sigmoid_fast(zb1) * 0.0625f; }
#pragma unroll
        for (int j = 1; j < 8; ++j) { gf0[j] += gf0[j - 1]; gf1[j] += gf1[j - 1]; gb0[7 - j] += gb0[8 - j]; gb1[7 - j] += gb1[8 - j]; }
        *(LAS f32x2*)(tot + (0 * 8 + tb) * 128 + 2 * d2) = (f32x2){gf0[7], gf1[7]}; *(LAS f32x2*)(tot + (1 * 8 + tb) * 128 + 2 * d2) = (f32x2){gb0[0], gb1[0]};
        __syncthreads();
        float pf0 = 0.f, pf1 = 0.f, pb0 = 0.f, pb1 = 0.f, lf0 = 0.f, lf1 = 0.f, lb0 = 0.f, lb1 = 0.f;
#pragma unroll
        for (int q = 0; q < 8; ++q) { const f32x2 a = *(const LAS f32x2*)(tot + (0 * 8 + q) * 128 + 2 * d2), c = *(const LAS f32x2*)(tot + (1 * 8 + q) * 128 + 2 * d2);
            lf0 += a.x; lf1 += a.y; lb0 += c.x; lb1 += c.y;
            if (q < tb) { pf0 += a.x; pf1 += a.y; } if (q > tb) { pb0 += c.x; pb1 += c.y; } }
        const size_t itf = (size_t)cn * 2, itb = itf + 1;
        bf16* Qf = (bf16*)(ws + WS_GQ) + itf * 8192; bf16* Qb = Qf + 8192; bf16* Kf = (bf16*)(ws + WS_GKH) + itf * 8192; bf16* Kb = Kf + 8192;
        const float elf0 = __expf(lf0), elf1 = __expf(lf1), elb0 = __expf(lb0), elb1 = __expf(lb1);
        float ktf0[8], ktf1[8], ktb0[8], ktb1[8];
#pragma unroll
        for (int j = 0; j < 8; ++j) { const int t = 8 * tb + j;
            const float q0 = __uint_as_float(qk[j][0] << 16) * 0.08838834764831845f, q1 = __uint_as_float(qk[j][0] & 0xffff0000u) * 0.08838834764831845f;
            const float k0 = __uint_as_float(qk[j][1] << 16), k1 = __uint_as_float(qk[j][1] & 0xffff0000u);
            const float ef0 = __expf(pf0 + gf0[j]), ef1 = __expf(pf1 + gf1[j]), eb0 = __expf(pb0 + gb0[j]), eb1 = __expf(pb1 + gb1[j]);
            const float rf0 = __builtin_amdgcn_rcpf(ef0), rf1 = __builtin_amdgcn_rcpf(ef1), rb0 = __builtin_amdgcn_rcpf(eb0), rb1 = __builtin_amdgcn_rcpf(eb1);
            *(GAS unsigned*)(Qf + t * 128 + 2 * d2) = pk2(q0 * ef0, q1 * ef1); *(GAS unsigned*)(Qb + t * 128 + 2 * d2) = pk2(q0 * eb0, q1 * eb1);
            *(GAS unsigned*)(Kf + t * 128 + 2 * d2) = pk2(k0 * rf0, k1 * rf1); *(GAS unsigned*)(Kb + t * 128 + 2 * d2) = pk2(k0 * rb0, k1 * rb1);
            ktf0[j] = k0 * rf0 * elf0; ktf1[j] = k1 * rf1 * elf1; ktb0[j] = k0 * rb0 * elb0; ktb1[j] = k1 * rb1 * elb1; }
        {
          unsigned char* Tf = ws + WS_GKT + itf * 16384 + (size_t)((((tb >> 1) * 4 + (d2 >> 4)) * 64 + ((2 * d2) & 31)) * 16 + 8 * (tb & 1)); unsigned char* Tb = Tf + 16384;
          *(GAS unsigned long long*)(Tf) = (unsigned long long)pk2(ktf0[0], ktf0[1]) | ((unsigned long long)pk2(ktf0[2], ktf0[3]) << 32);
          *(GAS unsigned long long*)(Tf + 512) = (unsigned long long)pk2(ktf0[4], ktf0[5]) | ((unsigned long long)pk2(ktf0[6], ktf0[7]) << 32);
          *(GAS unsigned long long*)(Tf + 16) = (unsigned long long)pk2(ktf1[0], ktf1[1]) | ((unsigned long long)pk2(ktf1[2], ktf1[3]) << 32);
          *(GAS unsigned long long*)(Tf + 528) = (unsigned long long)pk2(ktf1[4], ktf1[5]) | ((unsigned long long)pk2(ktf1[6], ktf1[7]) << 32);
          *(GAS unsigned long long*)(Tb) = (unsigned long long)pk2(ktb0[0], ktb0[1]) | ((unsigned long long)pk2(ktb0[2], ktb0[3]) << 32);
          *(GAS unsigned long long*)(Tb + 512) = (unsigned long long)pk2(ktb0[4], ktb0[5]) | ((unsigned long long)pk2(ktb0[6], ktb0[7]) << 32);
          *(GAS unsigned long long*)(Tb + 16) = (unsigned long long)pk2(ktb1[0], ktb1[1]) | ((unsigned long long)pk2(ktb1[2], ktb1[3]) << 32);
          *(GAS unsigned long long*)(Tb + 528) = (unsigned long long)pk2(ktb1[4], ktb1[5]) | ((unsigned long long)pk2(ktb1[6], ktb1[7]) << 32); }
        if (tb == 0) { float* DLp = (float*)(ws + WS_GDL) + itf * 128 + 2 * d2; *(GAS f32x2*)DLp = (f32x2){elf0, elf1}; *(GAS f32x2*)(DLp + 128) = (f32x2){elb0, elb1}; }
    }
}
struct G12Ops { bf16x8 a[4], b[4]; f32x4 d[4]; };
__device__ __forceinline__ void g12_load(G12Ops& o, unsigned char* ws, int bh, int dir, int m, int kb, int vb, int r, int hh) {
    const int n = dir ? (m < 4 ? 3 - m : 71 - m) : m; const size_t cn = (size_t)bh * 68 + n, item = cn * 2 + dir;
    const GAS bf16x8* ap = (const GAS bf16x8*)(ws + WS_GKT + item * 16384) + kb * 64 + (hh * 32 + r);
    const GAS bf16x8* bp = (const GAS bf16x8*)(ws + WS_GVT + cn * 32768) + vb * 64 + (hh * 32 + r);
    const float* dp = (const float*)(ws + WS_GDL) + item * 128 + 32 * kb + 4 * hh;
#pragma unroll
    for (int ks = 0; ks < 4; ++ks) { o.a[ks] = ap[ks * 256]; o.b[ks] = bp[ks * 512]; o.d[ks] = *(const GAS f32x4*)(dp + 8 * ks); }
}
__device__ __forceinline__ void phase_gla_g12(unsigned char* ws, LAS unsigned char* lds, int gwv, int wave, int lane) {
    if (gwv >= 2048) return;
    const int chain = gwv >> 5, blk = gwv & 31, kb = blk & 3, vb = blk >> 2, dir = chain & 1, bh = chain >> 1;
    const int r = lane & 31, hh = lane >> 5;
    LAS unsigned char* wl = lds + RING_OFF + wave * 2048;
    f32x16 acc;
#pragma unroll
    for (int g = 0; g < 16; ++g) acc[g] = 0.f;
    G12Ops o0, o1, o2;
    g12_load(o0, ws, bh, dir, 0, kb, vb, r, hh); g12_load(o1, ws, bh, dir, 1, kb, vb, r, hh);
#define G12_STEP(CUR, m_) do { const int mm_ = (m_); const int n = dir ? (mm_ < 4 ? 3 - mm_ : 71 - mm_) : mm_; \
        _Pragma("unroll") for (int gg = 0; gg < 4; ++gg) *(LAS unsigned long long*)(wl + (((gg >> 1) * 64 + (gg & 1) * 32 + r) * 16 + 8 * hh)) = (unsigned long long)pk2(acc[4 * gg], acc[4 * gg + 1]) | ((unsigned long long)pk2(acc[4 * gg + 2], acc[4 * gg + 3]) << 32); \
        LDS_WAIT(); const v4u s0 = *(const LAS v4u*)(wl + lane * 16), s1 = *(const LAS v4u*)(wl + 1024 + lane * 16); LDS_WAIT(); \
        { bf16* sp = (bf16*)(ws + WS_SX) + ((size_t)(bh * 2 + dir) * 68 + n) * 32768 + (size_t)(kb * 8 + vb) * 1024; ((GAS v4u*)sp)[lane] = s0; ((GAS v4u*)sp)[64 + lane] = s1; } \
        _Pragma("unroll") for (int gg = 0; gg < 4; ++gg) { acc[4 * gg] *= CUR.d[gg].x; acc[4 * gg + 1] *= CUR.d[gg].y; acc[4 * gg + 2] *= CUR.d[gg].z; acc[4 * gg + 3] *= CUR.d[gg].w; } \
        _Pragma("unroll") for (int ks = 0; ks < 4; ++ks) acc = __builtin_amdgcn_mfma_f32_32x32x16_bf16(CUR.a[ks], CUR.b[ks], acc, 0, 0, 0); } while (0)
    for (int m = 0; m < 66; m += 3) {
        g12_load(o2, ws, bh, dir, m + 2, kb, vb, r, hh); G12_STEP(o0, m);
        g12_load(o0, ws, bh, dir, m + 3, kb, vb, r, hh); G12_STEP(o1, m + 1);
        g12_load(o1, ws, bh, dir, (m + 4 < 68) ? m + 4 : 67, kb, vb, r, hh); G12_STEP(o2, m + 2);
    }
    G12_STEP(o0, 66); G12_STEP(o1, 67);
#undef G12_STEP
}
constexpr int G3_RS = 272, G3_TILE = 64 * G3_RS, G3_OL = 4 * G3_TILE  , G3_LD = 260;
static_assert(G3_OL + 64 * G3_LD * 4 <= MISC_OFF, "G3 LDS");
__device__ __forceinline__ void phase_gla_g3(unsigned char* ws, int lg, LAS unsigned char* lds, int tid) {
    const int lane = tid & 63, wave = __builtin_amdgcn_readfirstlane(tid >> 6), r = lane & 31, hh = lane >> 5, vb = wave;
    LAS unsigned char* TL = lds + RING_OFF; LAS float* OL = (LAS float*)(lds + RING_OFF + G3_OL);
    const bf16* G = (const bf16*)(ws + WS_G); bf16* OG = (bf16*)(ws + WS_Q);
    for (int cn = blockIdx.x; cn < 2176; cn += gridDim.x) {
        const int n = cn % 68, bh = cn / 68, h = bh & 3, b = bh >> 2;
        const GAS bf16x8* SxA = (const GAS bf16x8*)((const bf16*)(ws + WS_SX) + ((size_t)(bh * 2 + 0) * 68 + n) * 32768 + (size_t)vb * 1024) + lane;
        const GAS bf16x8* SxB = SxA + 68 * 4096;
        const GAS bf16x8* Vt = (const GAS bf16x8*)(ws + WS_GVT + (size_t)cn * 32768) + vb * 64 + lane;
        bf16x8 sA[8], sB[8], vf[4];
#pragma unroll
        for (int s = 0; s < 8; ++s) sA[s] = SxA[(s >> 1) * 1024 + (s & 1) * 64];
        v4u st[4][2];
#pragma unroll
        for (int tl = 0; tl < 4; ++tl) { const bf16* src = (const bf16*)(ws + ((tl & 1) ? WS_GKH : WS_GQ)) + ((size_t)cn * 2 + (tl >> 1)) * 8192;
#pragma unroll
            for (int j = 0; j < 2; ++j) st[tl][j] = ((const GAS v4u*)src)[tid + 512 * j]; }
        __syncthreads();
#pragma unroll
        for (int tl = 0; tl < 4; ++tl)
#pragma unroll
            for (int j = 0; j < 2; ++j) { const int q = tid + 512 * j, row = q >> 4, ch = q & 15; *(LAS v4u*)(TL + tl * G3_TILE + row * G3_RS + ch * 16) = st[tl][j]; }
        __syncthreads();
        f32x16 P00, P01, P10, P11, O0, O1;
#pragma unroll
        for (int g = 0; g < 16; ++g) { P00[g] = 0.f; P01[g] = 0.f; P10[g] = 0.f; P11[g] = 0.f; O0[g] = 0.f; O1[g] = 0.f; }
#pragma unroll
        for (int dir = 0; dir < 2; ++dir) {
            const LAS unsigned char* Qt = TL + (2 * dir) * G3_TILE + r * G3_RS + 16 * hh; const LAS unsigned char* Kh = TL + (2 * dir + 1) * G3_TILE + r * G3_RS + 16 * hh;
            if (dir == 0) {
#pragma unroll
                for (int s = 0; s < 8; ++s) sB[s] = SxB[(s >> 1) * 1024 + (s & 1) * 64];
            } else {
#pragma unroll
                for (int q = 0; q < 4; ++q) vf[q] = Vt[q * 512];
            }
            __builtin_amdgcn_sched_barrier(0);
            f32x16 X00, X11, Xoff;
#pragma unroll
            for (int g = 0; g < 16; ++g) { X00[g] = 0.f; X11[g] = 0.f; Xoff[g] = 0.f; }
#pragma unroll
            for (int s = 0; s < 8; ++s) {
                const bf16x8 q0 = *(const LAS bf16x8*)(Qt + 32 * s), q1 = *(const LAS bf16x8*)(Qt + 32 * G3_RS + 32 * s);
                const bf16x8 k0 = *(const LAS bf16x8*)(Kh + 32 * s), k1 = *(const LAS bf16x8*)(Kh + 32 * G3_RS + 32 * s);
                const bf16x8 sx = dir ? sB[s] : sA[s];
                X00 = __builtin_amdgcn_mfma_f32_32x32x16_bf16(k0, q0, X00, 0, 0, 0);
                X11 = __builtin_amdgcn_mfma_f32_32x32x16_bf16(k1, q1, X11, 0, 0, 0);
                if (dir == 0) Xoff = __builtin_amdgcn_mfma_f32_32x32x16_bf16(k0, q1, Xoff, 0, 0, 0); else Xoff = __builtin_amdgcn_mfma_f32_32x32x16_bf16(k1, q0, Xoff, 0, 0, 0);
                O0 = __builtin_amdgcn_mfma_f32_32x32x16_bf16(q0, sx, O0, 0, 0, 0); O1 = __builtin_amdgcn_mfma_f32_32x32x16_bf16(q1, sx, O1, 0, 0, 0); }
#pragma unroll
            for (int g = 0; g < 16; ++g) { const int tj = (g & 3) + 8 * (g >> 2) + 4 * hh; const bool keep = dir ? (tj >= r) : (tj <= r);
                P00[g] += keep ? X00[g] : 0.f; P11[g] += keep ? X11[g] : 0.f;
                if (dir == 0) P01[g] += Xoff[g]; else P10[g] += Xoff[g]; }
        }
        {
#pragma unroll
          for (int jb = 0; jb < 2; ++jb)
#pragma unroll
            for (int s2 = 0; s2 < 2; ++s2) { const bf16x8 bfv = vf[2 * jb + s2];
                const f32x16& Pa = jb ? P10 : P00; const f32x16& Pb = jb ? P11 : P01;
                const bf16x8 a0 = __builtin_bit_cast(bf16x8, ((v4u){pk2(Pa[8 * s2 + 0], Pa[8 * s2 + 1]), pk2(Pa[8 * s2 + 2], Pa[8 * s2 + 3]), pk2(Pa[8 * s2 + 4], Pa[8 * s2 + 5]), pk2(Pa[8 * s2 + 6], Pa[8 * s2 + 7])}));
                const bf16x8 a1 = __builtin_bit_cast(bf16x8, ((v4u){pk2(Pb[8 * s2 + 0], Pb[8 * s2 + 1]), pk2(Pb[8 * s2 + 2], Pb[8 * s2 + 3]), pk2(Pb[8 * s2 + 4], Pb[8 * s2 + 5]), pk2(Pb[8 * s2 + 6], Pb[8 * s2 + 7])}));
                O0 = __builtin_amdgcn_mfma_f32_32x32x16_bf16(a0, bfv, O0, 0, 0, 0); O1 = __builtin_amdgcn_mfma_f32_32x32x16_bf16(a1, bfv, O1, 0, 0, 0); } }
#pragma unroll
        for (int g = 0; g < 16; ++g) { const int t = (g & 3) + 8 * (g >> 2) + 4 * hh; OL[t * G3_LD + 32 * vb + r] = O0[g]; OL[(32 + t) * G3_LD + 32 * vb + r] = O1[g]; }
        __syncthreads();
        { const int t = tid >> 3, cc = tid & 7; const LAS f32x4* op = (const LAS f32x4*)(OL + t * G3_LD + 32 * cc);
          f32x4 o[8]; float ss = 0.f;
#pragma unroll
          for (int j = 0; j < 8; ++j) { o[j] = op[j]; ss += (o[j].x * o[j].x + o[j].y * o[j].y) + (o[j].z * o[j].z + o[j].w * o[j].w); }
          ss += __shfl_xor(ss, 1); ss += __shfl_xor(ss, 2); ss += __shfl_xor(ss, 4);
          const float rs = 1.0f / sqrtf(ss * (1.0f / 256.0f) + RMS_EPS);
          const size_t row = (size_t)b * TB + 64 * n + t;
          const GAS v4u* rp = (const GAS v4u*)(G + row * WINP + 2048 + h * 256 + 32 * cc); const GAS f32x4* gp = (const GAS f32x4*)(PARF(ws) + P_OG + lg * 256 + 32 * cc);
          GAS v4u* dst = (GAS v4u*)(OG + row * 1024 + h * 256 + 32 * cc);
#pragma unroll
          for (int j = 0; j < 4; ++j) { const v4u rv = rp[j]; const f32x4 g0 = gp[2 * j], g1 = gp[2 * j + 1]; const f32x4 a = o[2 * j] * rs * g0, c2 = o[2 * j + 1] * rs * g1;
              v4u w;
              w.x = pk2(a.x * silu_f(__uint_as_float(rv.x << 16)), a.y * silu_f(__uint_as_float(rv.x & 0xffff0000u)));
              w.y = pk2(a.z * silu_f(__uint_as_float(rv.y << 16)), a.w * silu_f(__uint_as_float(rv.y & 0xffff0000u)));
              w.z = pk2(c2.x * silu_f(__uint_as_float(rv.z << 16)), c2.y * silu_f(__uint_as_float(rv.z & 0xffff0000u)));
              w.w = pk2(c2.z * silu_f(__uint_as_float(rv.w << 16)), c2.w * silu_f(__uint_as_float(rv.w & 0xffff0000u)));
              dst[j] = w; } }
    }
}
constexpr int WIMG_RS = 2064;
static_assert(2 * 32 * WIMG_RS <= LDS_AUX, "router images below the aux tables");
__device__ __forceinline__ void phase_modulate2_route(unsigned char* ws, int layer, LAS unsigned char* lds, int vcu, int wave, int lane, int tid, bool dummy = false) {
    const bf16* X = (const bf16*)(ws + WS_X); bf16* XN = (bf16*)(ws + WS_XN);
    const float* ng = PARF(ws) + P_N2G + layer * 1024; const float* Mo = (const float*)(ws + WS_MOD) + (size_t)layer * MODROWS * NMODC;
    LAS unsigned char* WHI = lds + RING_OFF; LAS unsigned char* WLO = WHI + 32 * WIMG_RS;
    LAS unsigned* lcnt = (LAS unsigned*)(lds + AUX_LCNT); LAS unsigned* gb = (LAS unsigned*)(lds + AUX_GB); LAS unsigned* ent = (LAS unsigned*)(lds + AUX_ENT); LAS float* rsl = (LAS float*)(lds + AUX_RS);
    { const float* wsrc = PARF(ws) + P_WR + (size_t)layer * 1024 * 32;
      for (int idx = tid; idx < 1024 * 32; idx += NWAVES * 64) { const int k = idx >> 5, e = idx & 31; const float w = wsrc[idx]; const unsigned hi = f2bf(w), lo = f2bf(w - __uint_as_float(hi << 16));
          *(LAS unsigned short*)(WHI + e * WIMG_RS + 2 * k) = (unsigned short)hi; *(LAS unsigned short*)(WLO + e * WIMG_RS + 2 * k) = (unsigned short)lo; }
      if (tid < 32) lcnt[tid] = 0u; }
    gu32* cnt = (gu32*)(ws + WS_CTL) + CW_CNT + (layer + (dummy ? 4 : 0)) * 32 * 16;
    unsigned char* sbase = dummy ? ws + WS_XG : ws;
    const bool lastl = (layer == NLAYER - 1);
  for (int grp = vcu; grp < MT / 136; grp += (int)gridDim.x) {
    const int rbase = grp * 136;
    if (grp != vcu) { __syncthreads(); if (tid < 32) lcnt[tid] = 0u; }
    for (int rl = wave; rl < 136; rl += 2 * NWAVES) {
        const int rl2 = (rl + NWAVES < 136) ? rl + NWAVES : rl; const int m = rbase + rl, m2 = rbase + rl2, mr = mod_row(m), mr2 = mod_row(m2);
        float rs, rs2;
        modulate_row2(X + (size_t)m * 1024, X + (size_t)m2 * 1024, ng, Mo + (size_t)mr * NMODC + 3 * 1024, Mo + (size_t)mr * NMODC + 4 * 1024, Mo + (size_t)mr2 * NMODC + 3 * 1024, Mo + (size_t)mr2 * NMODC + 4 * 1024,
                      ws + WS_XN8 + (size_t)m * 1024, ws + WS_XN8 + (size_t)m2 * 1024, lane, rs, rs2);
        if (lane == 0) { rsl[rl] = rs; rsl[rl2] = rs2; } }
    __syncthreads();
    if (wave < 5) {
        const int r = lane & 31, hh = lane >> 5; const int rl = (32 * wave + r < 136) ? 32 * wave + r : 135; const int m = rbase + rl, mr = mod_row(m);
        const float rsr = rsl[rl];
        const bf16* xp = X + (size_t)m * 1024 + 8 * hh; const float* gp = ng + 8 * hh; const float* scp = Mo + (size_t)mr * NMODC + 4 * 1024 + 8 * hh; const float* shp = Mo + (size_t)mr * NMODC + 3 * 1024 + 8 * hh;
        const LAS unsigned char* wh = WHI + r * WIMG_RS + 16 * hh; const LAS unsigned char* wl = WLO + r * WIMG_RS + 16 * hh;
        f32x16 acc;
#pragma unroll
        for (int g = 0; g < 16; ++g) acc[g] = 0.f;
#pragma unroll 2
        for (int s = 0; s < 64; ++s) {
            const v4u xr8 = *(const GAS v4u*)(xp + 16 * s); const f32x4 x0 = (f32x4){__uint_as_float(xr8.x << 16), __uint_as_float(xr8.x & 0xffff0000u), __uint_as_float(xr8.y << 16), __uint_as_float(xr8.y & 0xffff0000u)}, x1 = (f32x4){__uint_as_float(xr8.z << 16), __uint_as_float(xr8.z & 0xffff0000u), __uint_as_float(xr8.w << 16), __uint_as_float(xr8.w & 0xffff0000u)}; const f32x4 g0 = *(const GAS f32x4*)(gp + 16 * s), g1 = *(const GAS f32x4*)(gp + 16 * s + 4);
            const f32x4 c0 = *(const GAS f32x4*)(scp + 16 * s), c1 = *(const GAS f32x4*)(scp + 16 * s + 4), h0 = *(const GAS f32x4*)(shp + 16 * s), h1 = *(const GAS f32x4*)(shp + 16 * s + 4);
            const f32x4 y0 = (x0 * rsr) * g0 * (c0 + 1.0f) + h0, y1 = (x1 * rsr) * g1 * (c1 + 1.0f) + h1;
            v4u ph, pl;
            ph.x = pg8::cvt_pk_bf16(y0.x, y0.y); ph.y = pg8::cvt_pk_bf16(y0.z, y0.w); ph.z = pg8::cvt_pk_bf16(y1.x, y1.y); ph.w = pg8::cvt_pk_bf16(y1.z, y1.w);
            pl.x = pg8::cvt_pk_bf16(y0.x - __uint_as_float(ph.x << 16), y0.y - __uint_as_float(ph.x & 0xffff0000u)); pl.y = pg8::cvt_pk_bf16(y0.z - __uint_as_float(ph.y << 16), y0.w - __uint_as_float(ph.y & 0xffff0000u));
            pl.z = pg8::cvt_pk_bf16(y1.x - __uint_as_float(ph.z << 16), y1.y - __uint_as_float(ph.z & 0xffff0000u)); pl.w = pg8::cvt_pk_bf16(y1.z - __uint_as_float(ph.w << 16), y1.w - __uint_as_float(ph.w & 0xffff0000u));
            const bf16x8 ahi = __builtin_bit_cast(bf16x8, ph), alo = __builtin_bit_cast(bf16x8, pl);
            const bf16x8 bhi = *(const LAS bf16x8*)(wh + 32 * s), blo = *(const LAS bf16x8*)(wl + 32 * s);
            acc = __builtin_amdgcn_mfma_f32_32x32x16_bf16(ahi, bhi, acc, 0, 0, 0); acc = __builtin_amdgcn_mfma_f32_32x32x16_bf16(alo, bhi, acc, 0, 0, 0); acc = __builtin_amdgcn_mfma_f32_32x32x16_bf16(ahi, blo, acc, 0, 0, 0); }
        const float brt = (PARF(ws) + P_BR)[layer * 32 + r];
#pragma unroll
        for (int g = 0; g < 16; ++g) { const int rowl = 32 * wave + (g & 3) + 8 * (g >> 2) + 4 * hh;
            float v = acc[g] + brt; float tv[4]; int te[4];
#pragma unroll
            for (int k = 0; k < 4; ++k) { float mx = v;
#pragma unroll
                for (int o = 1; o < 32; o <<= 1) mx = fmaxf(mx, shx(mx, o, lane));
                const unsigned long long bm = __ballot(v == mx); const unsigned hm = hh ? (unsigned)(bm >> 32) : (unsigned)bm; const int first = __ffs((int)hm) - 1;
                te[k] = first; tv[k] = mx; if (r == first) v = -INFINITY; }
            const bool valid = rowl < 136 && !(lastl && mod_row(rbase + (rowl < 136 ? rowl : 135)) == 8);
            if (r == 0 && rowl < 136) {
                if (valid) { const float e1 = __expf(tv[1] - tv[0]), e2 = __expf(tv[2] - tv[0]), e3 = __expf(tv[3] - tv[0]); const float inv = 1.0f / (1.0f + e1 + e2 + e3);
                    const float wk[4] = {inv, e1 * inv, e2 * inv, e3 * inv};
#pragma unroll
                    for (int k = 0; k < 4; ++k) { const unsigned lp = atomicAdd((unsigned*)&lcnt[te[k]], 1u); ent[(rowl * 4 + k) * 2 + 0] = ((unsigned)te[k] << 24) | lp; ent[(rowl * 4 + k) * 2 + 1] = __float_as_uint(wk[k]); } }
                else {
#pragma unroll
                    for (int k = 0; k < 4; ++k) ent[(rowl * 4 + k) * 2 + 0] = 0xffffffffu; } } }
    }
    __syncthreads();
    if (tid < 32) gb[tid] = __hip_atomic_fetch_add(cnt + tid * 16, lcnt[tid], __ATOMIC_RELAXED, __HIP_MEMORY_SCOPE_AGENT);
    __syncthreads();
    for (int q = tid; q < 136 * 4; q += NWAVES * 64) { const unsigned pe = ent[q * 2 + 0];
        if (pe != 0xffffffffu) { const unsigned e = pe >> 24, lp = pe & 0xffffffu; const int m = rbase + (q >> 2);
            ((unsigned*)(sbase + WS_SLOT))[m * 4 + (q & 3)] = (e << 24) | (gb[e] + lp); ((unsigned*)(sbase + WS_GATEW))[m * 4 + (q & 3)] = ent[q * 2 + 1];
            if (!dummy) ((int*)(ws + WS_LIST))[(size_t)e * MT + gb[e] + lp] = m; } }
  }
}
__device__ __forceinline__ void build_expert_tables(unsigned char* ws, int layer, LAS unsigned char* lds, int tid) {
    LAS int* t2e = (LAS int*)(lds + AUX_T2E); LAS int* base = (LAS int*)(lds + AUX_BASE); LAS int* ntp = (LAS int*)(lds + AUX_NT); LAS int* cntl = (LAS int*)(lds + AUX_CNT);
    gu32* cnt = (gu32*)(ws + WS_CTL) + CW_CNT + layer * 32 * 16;
    __syncthreads();
    if (tid < 64) { const unsigned cval = (tid < 32) ? __hip_atomic_load(cnt + tid * 16, RLX_AGENT) : 0u; const int tiles = (int)((cval + 255u) >> 8);
        int pre = tiles;
#pragma unroll
        for (int o = 1; o < 32; o <<= 1) { const int ln = tid & 63; const int t = __builtin_amdgcn_ds_bpermute(((ln >= o) ? ln - o : ln) << 2, pre); if (ln >= o) pre += t; }
        const int start = pre - tiles;
        if (tid < 32) { base[tid] = start * 256; cntl[tid] = (int)cval; for (int t = 0; t < tiles; ++t) t2e[start + t] = tid; if (tid == 31) ntp[0] = pre; } }
    __syncthreads();
}
__device__ __forceinline__ void phase_moe_gather(unsigned char* ws, int layer, LAS unsigned char* lds, int gw, int NGW, int lane, int tid) {
    build_expert_tables(ws, layer, lds, tid);
    const LAS int* base = (const LAS int*)(lds + AUX_BASE);
    const bf16* XN = (const bf16*)(ws + WS_XN); bf16* XG = (bf16*)(ws + WS_XG);
    const unsigned* slot = (const unsigned*)(ws + WS_SLOT); unsigned* spos = (unsigned*)(ws + WS_SLOTPOS);
    for (int m = gw; m < MT; m += NGW) {
        if (layer == NLAYER - 1 && mod_row(m) == 8) continue;
        const GAS v4u* src = (const GAS v4u*)(XN + (size_t)m * 1024) + lane; const v4u a = src[0], b = src[64];
#pragma unroll
        for (int k = 0; k < 4; ++k) { const unsigned pe = slot[m * 4 + k]; const int dst = base[pe >> 24] + (int)(pe & 0xffffffu);
            GAS v4u* dp = (GAS v4u*)(XG + (size_t)dst * 1024) + lane; dp[0] = a; dp[64] = b;
            if (lane == 0) spos[m * 4 + k] = (unsigned)dst; }
    }
}
__device__ __forceinline__ void phase_moe_combine(unsigned char* ws, float* out, int layer, LAS unsigned char* lds, int gw, int NGW, int lane, int tid, bool dummy = false) {
    build_expert_tables(ws, layer, lds, tid);
    const LAS int* base = (const LAS int*)(lds + AUX_BASE);
    bf16* X = (bf16*)(ws + WS_X); const unsigned char* Y = ws + WS_Y;
    const float* Mo = (const float*)(ws + WS_MOD) + (size_t)layer * MODROWS * NMODC;
    const unsigned* slot = (const unsigned*)(ws + WS_SLOT); const float* gw4 = (const float*)(ws + WS_GATEW);
    for (int m0 = gw; m0 < MT; m0 += 2 * NGW) {
        int mm[2], bb[2], ww[2], mrr[2]; bool ok[2];
#pragma unroll
        for (int p = 0; p < 2; ++p) { const int m = m0 + p * NGW; ok[p] = m < MT; mm[p] = ok[p] ? m : m0; bb[p] = mm[p] / TB; ww[p] = mm[p] - bb[p] * TB; mrr[p] = (ww[p] < CTXL) ? 8 : bb[p];
            if (layer == NLAYER - 1 && ww[p] < CTXL) ok[p] = false; }
        if (!ok[0] && !ok[1]) continue;
        unsigned pe[2][4]; float wk[2][4];
#pragma unroll
        for (int p = 0; p < 2; ++p)
#pragma unroll
            for (int k = 0; k < 4; ++k) { pe[p][k] = slot[mm[p] * 4 + k]; wk[p][k] = gw4[mm[p] * 4 + k]; }
        unsigned long long xv[2][4];
#pragma unroll
        for (int p = 0; p < 2; ++p) { const GAS unsigned long long* xp = (const GAS unsigned long long*)(X + (size_t)mm[p] * 1024) + lane;
#pragma unroll
            for (int j = 0; j < 4; ++j) xv[p][j] = xp[64 * j]; }
        unsigned yv[2][4][4];
#pragma unroll
        for (int p = 0; p < 2; ++p)
#pragma unroll
            for (int k = 0; k < 4; ++k) { unsigned e = pe[p][k] >> 24; if (!ok[p] || e > 31u) e = 0u;
                const unsigned sp = ok[p] ? (unsigned)base[e] + (pe[p][k] & 0xffffffu) : 0u;
                const GAS unsigned* yp = (const GAS unsigned*)(Y + (size_t)sp * 1024) + lane;
#pragma unroll
                for (int j = 0; j < 4; ++j) yv[p][k][j] = yp[64 * j]; }
        f32x4 f[2][4]; float ss[2];
#pragma unroll
        for (int p = 0; p < 2; ++p) { const GAS f32x4* gp = (const GAS f32x4*)(Mo + (size_t)mrr[p] * NMODC + 5 * 1024) + lane;
            ss[p] = 0.f;
#pragma unroll
            for (int j = 0; j < 4; ++j) { f32x4 a = (f32x4){0.f, 0.f, 0.f, 0.f};
#pragma unroll
                for (int k = 0; k < 4; ++k) { const unsigned w8 = yv[p][k][j]; const f32x2 lo2 = __builtin_amdgcn_cvt_pk_f32_fp8((int)w8, false), hi2 = __builtin_amdgcn_cvt_pk_f32_fp8((int)w8, true); a = a + (f32x4){lo2.x, lo2.y, hi2.x, hi2.y} * wk[p][k]; }
                f[p][j] = bf4_to_f32(xv[p][j]) + gp[64 * j] * a; } }
        asm volatile("" ::: "memory");
        const bool fuse = (layer < NLAYER - 1) && !dummy;
#pragma unroll
        for (int p = 0; p < 2; ++p) { if (!ok[p]) continue;
            GAS unsigned long long* xp = (GAS unsigned long long*)(X + (size_t)mm[p] * 1024) + lane;
            GAS f32x4* op = (GAS f32x4*)(out + ((size_t)bb[p] * SEQ + (ww[p] - CTXL)) * 1024) + lane;
#pragma unroll
            for (int j = 0; j < 4; ++j) { if (dummy) ((GAS f32x4*)((float*)(ws + WS_XG) + (size_t)mm[p] * 1024) + lane)[64 * j] = f[p][j]; else if (layer == NLAYER - 1) op[64 * j] = f[p][j]; else { const unsigned long long pk = f32_to_bf4(f[p][j]); xp[64 * j] = pk; f[p][j] = bf4_to_f32(pk); }
                ss[p] += (f[p][j].x * f[p][j].x + f[p][j].y * f[p][j].y) + (f[p][j].z * f[p][j].z + f[p][j].w * f[p][j].w); }
            if (fuse) { const float rs = 1.0f / sqrtf(wave_sum(ss[p]) * (1.0f / 1024.0f) + RMS_EPS);
                const float* ng = PARF(ws) + P_N1G + (layer + 1) * 1024; const float* Mn = (const float*)(ws + WS_MOD) + (size_t)(layer + 1) * MODROWS * NMODC + (size_t)mrr[p] * NMODC;
                GAS unsigned long long* o8 = (GAS unsigned long long*)((bf16*)(ws + WS_XN) + (size_t)mm[p] * 1024) + lane;
#pragma unroll
                for (int j = 0; j < 4; ++j) { const f32x4 g = ((const GAS f32x4*)ng)[64 * j + lane], sh = ((const GAS f32x4*)Mn)[64 * j + lane], sc = ((const GAS f32x4*)(Mn + 1024))[64 * j + lane];
                    o8[64 * j] = f32_to_bf4((f[p][j] * rs) * g * (sc + 1.0f) + sh); } } }
    }
}

constexpr int NPH_L = 11, NPHASE = 2 + NPH_L * NLAYER;
#ifndef PHMASK
#define PHMASK 0x7fff
#endif
#define EN(b) ((PHMASK >> (b)) & 1)
#ifndef DUPMASK
#define DUPMASK 0
#endif
#define DUP(b) for (int rep_ = 0; rep_ < (((DUPMASK >> (b)) & 1) ? 2 : 1); ++rep_)
__global__ void __launch_bounds__(NWAVES * 64, 2) dit_fwd(Args args) {
    extern __shared__ __attribute__((aligned(16))) unsigned char lds_raw[];
    LAS unsigned char* lds = (LAS unsigned char*)lds_raw;
    volatile LAS unsigned* MISC = (volatile LAS unsigned*)(lds + MISC_OFF);
    const int G = gridDim.x, bx = blockIdx.x;
    const int vcu = (G % 8 == 0) ? (bx % 8) * (G / 8) + bx / 8 : bx;
    const int wave0 = __builtin_amdgcn_readfirstlane((int)threadIdx.x >> 6);
#define LANE_ID(z) ((int)__builtin_amdgcn_mbcnt_hi(~0u, __builtin_amdgcn_mbcnt_lo(~0u, (z))))
    { const int t0 = (wave0 << 6) | LANE_ID(0u); for (int u = t0; u < (LDS_BYTES - MISC_OFF) / 4; u += NWAVES * 64) ((LAS unsigned*)(lds + MISC_OFF))[u] = 0u; }
    __syncthreads();
    const int lo = args.ph_lo, hi = args.ph_hi;
    XcdBarrier bar; bar.bar = (unsigned*)(args.ws + WS_CTL) + CW_BAR; bar.x = 0; bar.st = nullptr;
    if (hi - lo > 1) bar = xcd_barrier_post((unsigned*)(args.ws + WS_CTL) + CW_BAR, MISC + 8, wave0 == 0 && LANE_ID(0u) == 0);
#define IN(k) (lo <= (k) && (k) < hi)
#define SEAM(k) do { if (IN(k) && IN((k) + 1)) { XcdBarrier b_ = bar; unsigned zb_ = 0u; LAUNDER_S(zb_); b_.bar = bar.bar + zb_; xcd_barrier(b_, wave0 == 0 && LANE_ID(zb_) == 0); } } while (0)
#define PHASE_IDS() unsigned zoff_ = 0u; LAUNDER_S(zoff_); int tid = (wave0 << 6) | LANE_ID(zoff_); LAUNDER_V(tid); const int lane = tid & 63, wave = __builtin_amdgcn_readfirstlane(tid >> 6); const int gw = vcu * NWAVES + wave, NGW = G * NWAVES; \
    unsigned char* ws = args.ws + zoff_; const int Gp = G + (int)zoff_, bxp = bx + (int)zoff_; (void)lane; (void)gw; (void)NGW; (void)Gp; (void)bxp;

    if (EN(0) && IN(0)) DUP(0) { PHASE_IDS(); p0_prologue(args, lds, gw, NGW, wave, lane); } SEAM(0);
    if (EN(1) && IN(1)) { PHASE_IDS(); p1_mod_reduce(args, gw * 64 + lane, NGW * 64); } SEAM(1);

    for (int layer = 0; layer < NLAYER; ++layer) {
        const int pb = 2 + NPH_L * layer, lh = layer >> 1;
        if (layer == 0) { if (EN(2) && IN(pb + 0)) DUP(2) { PHASE_IDS(); phase_modulate1(ws, layer, gw, NGW, lane); } SEAM(pb + 0); }
        if ((layer & 1) == 0) {
            if (EN(3) && IN(pb + 1)) DUP(3) {
                PHASE_IDS();
                pg8::Gemm g{(const pg8::bf16_t*)(ws + WS_XN), (const pg8::bf16_t*)(ws + WS_WQKV) + (size_t)lh * QKVN * 1024, MT, QKVN, 1024, 0};
                pg8::StaticOrder S; S.init(MT, QKVN, Gp, bxp);
                LAS float* gl = (LAS float*)(lds + AUX_RS);
                if (tid < 128) gl[tid] = (PARF(ws) + (tid < 64 ? P_QG : P_KG - 64) + lh * 64)[tid];
                __syncthreads();
                pg8::EpiQKV E{ws, WS_Q, WS_K - WS_Q, WS_V - WS_K, gl, (const float*)(ws + WS_ROPE), ATT_C2};
                pg8::gemm_phase<pg8::EpiQKV, pg8::StaticOrder, true, true>(lds + RING_OFF, g, S, E, tid);
            } SEAM(pb + 1);
            if (EN(5) && IN(pb + 3)) DUP(5) {
                PHASE_IDS();
                const attn_body::bf16* Qp = (const attn_body::bf16*)(ws + WS_Q); const attn_body::bf16* Kp = (const attn_body::bf16*)(ws + WS_K); const attn_body::bf16* Vp = (const attn_body::bf16*)(ws + WS_V);
                attn_body::bf16* Op = (attn_body::bf16*)(ws + WS_XN);
                if (G == 256) {
                    for (int i = 0; i < 9; ++i) {
                        long qrow0, kvrow0; int NT, h;
                        if (i < 8) { const int x = vcu >> 5, j = vcu & 31, pair = 4 * x + (i >> 1), wi = (i & 1) * 32 + j, hq = wi >> 4, qb = wi & 15, b = pair >> 2, hk = pair & 3;
                            h = hk * 4 + hq; qrow0 = (long)b * TB + CTXL + qb * 256; kvrow0 = (long)b * TB; NT = TB / 64; }
                        else { if (vcu >= 128) break; const int b = vcu >> 4; h = vcu & 15; qrow0 = (long)b * TB; kvrow0 = qrow0; NT = CTXL / 64; }
                        attn_body::attn_unit<8>(qrow0, kvrow0, NT, h, Qp, Kp, Vp, Op, (char*)lds_raw + RING_OFF, tid);
                    }
                } else {
                    for (int U = bx; U < 2048 + 128; U += G) {
                        long qrow0, kvrow0; int NT, h;
                        if (U < 2048) { const int pair = U >> 6, wi = U & 63, hq = wi >> 4, qb = wi & 15, b = pair >> 2, hk = pair & 3; h = hk * 4 + hq; qrow0 = (long)b * TB + CTXL + qb * 256; kvrow0 = (long)b * TB; NT = TB / 64; }
                        else { const int v = U - 2048, b = v >> 4; h = v & 15; qrow0 = (long)b * TB; kvrow0 = qrow0; NT = CTXL / 64; }
                        attn_body::attn_unit<8>(qrow0, kvrow0, NT, h, Qp, Kp, Vp, Op, (char*)lds_raw + RING_OFF, tid);
                    }
                }
            } SEAM(pb + 3);
        } else {
            if (EN(6) && IN(pb + 1)) DUP(6) {
                PHASE_IDS();
                pg8::Gemm g{(const pg8::bf16_t*)(ws + WS_XN), (const pg8::bf16_t*)(ws + WS_WIN) + (size_t)lh * WINP * 1024, MT, WINP, 1024, 0};
                pg8::StaticOrder S; S.init(MT, WINP, Gp, bxp);
                pg8::EpiBf16 E{(pg8::bf16_t*)(ws + WS_G), WINP};
                pg8::gemm_phase<pg8::EpiBf16, pg8::StaticOrder, true, true>(lds + RING_OFF, g, S, E, tid);
            } SEAM(pb + 1);
            if (EN(7) && IN(pb + 2)) DUP(7) { { PHASE_IDS(); phase_gla_g0v(ws, tid, Gp, bxp); } { PHASE_IDS(); phase_gla_g0(ws, lh, lds, tid, Gp, bxp); } } SEAM(pb + 2);
            if (EN(8) && IN(pb + 3)) DUP(8) { PHASE_IDS(); phase_gla_g12(ws, lds, gw, wave, lane); } SEAM(pb + 3);
            if (EN(8) && IN(pb + 4)) DUP(9) { PHASE_IDS(); phase_gla_g3(ws, lh, lds, tid); } SEAM(pb + 4);
        }
        if (EN(9) && IN(pb + 5)) {
            PHASE_IDS();
            const pg8::bf16_t* Wt = (layer & 1) ? (const pg8::bf16_t*)(ws + WS_WOG) + (size_t)lh * 1024 * 1024 : (const pg8::bf16_t*)(ws + WS_WOA) + (size_t)lh * 1024 * 1024;
            pg8::Gemm g{(const pg8::bf16_t*)(ws + ((layer & 1) ? WS_Q : WS_XN)), Wt, MT, 1024, 1024, 0};
            pg8::StaticOrder S; if (layer == NLAYER - 1) S.init(NB * SEQ, 1024, Gp, bxp, true); else S.init(MT, 1024, Gp, bxp);
            pg8::EpiResGate E{(pg8::bf16_t*)(ws + WS_X), (const float*)(ws + WS_MOD) + (size_t)layer * MODROWS * NMODC + 2 * 1024};
            pg8::gemm_phase<pg8::EpiResGate, pg8::StaticOrder, true, true>(lds + RING_OFF, g, S, E, tid);
        } SEAM(pb + 5);
        if (EN(10) && IN(pb + 6)) { if ((DUPMASK >> 10) & 1) { PHASE_IDS(); phase_modulate2_route(ws, layer, lds, vcu, wave, lane, tid, true); __syncthreads(); } PHASE_IDS(); phase_modulate2_route(ws, layer, lds, vcu, wave, lane, tid); } SEAM(pb + 6);
        if (EN(12) && IN(pb + 8)) DUP(12) {
            PHASE_IDS();
            build_expert_tables(ws, layer, lds, tid);
            const int nT = __builtin_amdgcn_readfirstlane(((const LAS int*)(lds + AUX_NT))[0]);
            pg8::MoeOrder S{nT, 8, Gp, bxp, (const LAS int*)(lds + AUX_T2E)};
            LAS unsigned short* rowtab = (LAS unsigned short*)(lds + AUX_ROWTAB);
            { const LAS int* base = (const LAS int*)(lds + AUX_BASE); const LAS int* cntl = (const LAS int*)(lds + AUX_CNT); const int* LIST = (const int*)(ws + WS_LIST);
              pg8::Unit u;
              int rv[ROWTAB_UNITS];
#pragma unroll
              for (int i = 0; i < ROWTAB_UNITS; ++i) { const bool ok = S.next(i, u); const int e = ok ? u.e : 0, pos = ok ? (u.pm - (base[e] >> 8)) * 256 + (tid & 255) : 0;
                  rv[i] = (ok && pos < cntl[e]) ? LIST[(size_t)e * MT + pos] : 0; }
#pragma unroll
              for (int i = 0; i < ROWTAB_UNITS; ++i) if (tid < 256) rowtab[i * 256 + tid] = (unsigned short)rv[i];
              __syncthreads(); }
            pg8::Gemm g{(const pg8::bf16_t*)(ws + WS_XN8), (const pg8::bf16_t*)(ws + WS_WGU + (size_t)layer * 32 * 2048 * 1024), MPAD, 2048, 512, (size_t)2048 * 1024, rowtab};
            pg8::EpiSwiGLU8 E{ws + WS_ACT, PARF(ws) + P_BGU + (size_t)layer * 32 * 2048, 1.0f / 32.0f};
            pg8::gemm_phase<pg8::EpiSwiGLU8, pg8::MoeOrder, true, true, true, true>(lds + RING_OFF, g, S, E, tid);
        } SEAM(pb + 8);
        if (EN(13) && IN(pb + 9)) DUP(13) {
            PHASE_IDS();
            build_expert_tables(ws, layer, lds, tid);
            const int nT = __builtin_amdgcn_readfirstlane(((const LAS int*)(lds + AUX_NT))[0]);
            pg8::Gemm g{(const pg8::bf16_t*)(ws + WS_ACT), (const pg8::bf16_t*)(ws + WS_WDN + (size_t)layer * 32 * 1024 * 1024), MPAD, 1024, 512, (size_t)1024 * 1024};
            pg8::MoeOrder S{nT, 4, Gp, bxp, (const LAS int*)(lds + AUX_T2E)};
            pg8::EpiBiasF8 E{ws + WS_Y, PARF(ws) + P_BDN + (size_t)layer * 32 * 1024, 1.0f / 32.0f};
            pg8::gemm_phase<pg8::EpiBiasF8, pg8::MoeOrder, true, true, false, true>(lds + RING_OFF, g, S, E, tid);
        } SEAM(pb + 9);
        if (EN(14) && IN(pb + 10)) { if ((DUPMASK >> 14) & 1) { PHASE_IDS(); phase_moe_combine(ws, args.out, layer, lds, gw, NGW, lane, tid, true); } PHASE_IDS(); phase_moe_combine(ws, args.out, layer, lds, gw, NGW, lane, tid); } SEAM(pb + 10);
    }
#undef IN
#undef EN
#undef DUP
#undef SEAM
#undef PHASE_IDS
#undef LANE_ID
}

extern "C" void kernel_launch(void* const* d_in, const int* in_sizes, int n_in, void* d_out, int out_size, void* d_ws, size_t ws_size, hipStream_t stream) {
    static int grid = 0;
    if (grid == 0) {
        if (n_in != 25 || out_size != NB * SEQ * DMODEL || ws_size < WS_END) { fprintf(stderr, "kernel_launch: unexpected shapes: n_in %d out %d ws %zu (need >= %zu)\n", n_in, out_size, ws_size, (size_t)WS_END); grid = -1; return; }
        int dev = 0, cus = 0, per_cu = 0;
        if (hipGetDevice(&dev) != hipSuccess || hipDeviceGetAttribute(&cus, hipDeviceAttributeMultiprocessorCount, dev) != hipSuccess) { grid = -1; return; }
        if (hipFuncSetAttribute((const void*)dit_fwd, hipFuncAttributeMaxDynamicSharedMemorySize, LDS_BYTES) != hipSuccess) { fprintf(stderr, "kernel_launch: hipFuncSetAttribute failed\n"); grid = -1; return; }
        if (hipOccupancyMaxActiveBlocksPerMultiprocessor(&per_cu, (const void*)dit_fwd, NWAVES * 64, LDS_BYTES) != hipSuccess || per_cu < 1) fprintf(stderr, "kernel_launch: occupancy query reports %d\n", per_cu);
        (void)hipGetLastError();
        grid = cus;
    }
    if (grid < 0) return;
    if (hipMemsetAsync((char*)d_ws + WS_CTL, 0, CTL_ZERO_BYTES, stream) != hipSuccess) { fprintf(stderr, "kernel_launch: memset failed\n"); return; }
    Args a{};
    for (int i = 0; i < 25; ++i) a.in[i] = (const float*)d_in[i];
    a.out = (float*)d_out; a.ws = (unsigned char*)d_ws;
#if MK_ONE_LAUNCH
    a.ph_lo = 0; a.ph_hi = NPHASE;
    hipLaunchKernelGGL(dit_fwd, dim3(grid), dim3(NWAVES * 64), LDS_BYTES, stream, a);
#else
    for (int p = 0; p < NPHASE; ++p) { a.ph_lo = p; a.ph_hi = p + 1; hipLaunchKernelGGL(dit_fwd, dim3(grid), dim3(NWAVES * 64), LDS_BYTES, stream, a); }
#endif
    const hipError_t le = hipPeekAtLastError();
    if (le != hipSuccess) fprintf(stderr, "kernel_launch: launch failed: %s\n", hipGetErrorName(le));
}
```

```cpp
#include <hip/hip_runtime.h>
#include <hip/hip_bf16.h>
#include <cstdio>
#include <cstdint>
#include <cmath>

#ifndef MK_ONE_LAUNCH
#define MK_ONE_LAUNCH 1
#endif

namespace pg8 {
#define PG8_LAS __attribute__((address_space(3)))
typedef unsigned short bf16_t;
typedef short bf16x8 __attribute__((ext_vector_type(8)));
typedef float f32x4 __attribute__((ext_vector_type(4)));
typedef unsigned u32x4 __attribute__((ext_vector_type(4)));
constexpr int BM = 256, BK = 64, HALF = 128, HTB = HALF * BK * 2  , STAGE_BYTES = 8 * HTB, NXCD = 8, WGM = 8;

__host__ __device__ __forceinline__ int lds_byte(int r, int c) { const int st = (r >> 4) * 2 + (c >> 5), rr = r & 15, cc = c & 31, ob = rr * 64 + cc * 2; return st * 1024 + (ob ^ (((ob >> 9) & 1) << 5)); }
__host__ __device__ __forceinline__ void stage_rc(int b, int& R, int& C) { const int st = b / 1024, sb = b % 1024, swz = sb ^ (((sb >> 9) & 1) << 5); R = (st >> 1) * 16 + swz / 64; C = (st & 1) * 32 + (swz % 64) / 2; }
__host__ __device__ __forceinline__ int perm32(int rho) { const int n = rho >> 4, i = rho & 15; return 8 * (i >> 2) + 4 * n + (i & 3); }

struct Unit { int pm, pn, e; };
struct Gemm { const bf16_t* A; const bf16_t* Bt; int M, N, K; size_t bstride; const PG8_LAS unsigned short* rowtab; };

struct StaticOrder {
    int nM, nN, nwg, G, c; bool latent_only;
    __host__ __device__ __forceinline__ void init(int M, int N, int G_, int c_, bool lat_ = false) { nM = M / BM; nN = N / BM; nwg = nM * nN; G = G_; c = c_; latent_only = lat_; }
    __host__ __device__ __forceinline__ bool next(int i, Unit& u) const {
        const long L = (long)i * G + c; if (L >= nwg) return false;
        int wgid = (int)L; { const int q = nwg / NXCD, r = nwg % NXCD, xcd = wgid % NXCD, off = wgid / NXCD; wgid = (xcd < r ? xcd * (q + 1) : r * (q + 1) + (xcd - r) * q) + off; }
        const int nig = WGM * nN, gid = wgid / nig, fm = gid * WGM, gsz = (nM - fm) < WGM ? (nM - fm) : WGM;
        u.pm = fm + ((wgid % nig) % gsz); u.pn = (wgid % nig) / gsz; u.e = 0;
        if (latent_only) u.pm = (u.pm >> 4) * 17 + 1 + (u.pm & 15);
        return true;
    }
    __device__ __forceinline__ void a_ready(const Unit&) const {}
    __device__ __forceinline__ void done(const Unit&) const {}
};
struct MoeOrder {
    int nT, nN, G, c; const PG8_LAS int* t2e;
    __device__ __forceinline__ bool next(int i, Unit& u) const {
        const int x = c & 7, j = c >> 3, per = 32 / nN, mt = (i * (G >> 5) + x) * per + j / nN; if (mt >= nT) return false;
        u.pm = mt; u.pn = j % nN; u.e = __builtin_amdgcn_readfirstlane(t2e[mt]); return true;
    }
    __device__ __forceinline__ void a_ready(const Unit&) const {}
    __device__ __forceinline__ void done(const Unit&) const {}
};

__device__ __forceinline__ int lane_now() { unsigned z; asm volatile("s_mov_b32 %0, 0" : "=s"(z)); return (int)__builtin_amdgcn_mbcnt_hi(~0u, __builtin_amdgcn_mbcnt_lo(~0u, z)); }
__device__ __forceinline__ float shx(float v, int m, int ln) { return __int_as_float(__builtin_amdgcn_ds_bpermute((ln ^ m) << 2, __float_as_int(v))); }
__device__ __forceinline__ unsigned pk4_fp8(float a, float b, float c, float d) { int w = 0; w = __builtin_amdgcn_cvt_pk_fp8_f32(a, b, w, false); w = __builtin_amdgcn_cvt_pk_fp8_f32(c, d, w, true); return (unsigned)w; }
__device__ __forceinline__ unsigned cvt_pk_bf16(float lo, float hi) { unsigned r; asm volatile("v_cvt_pk_bf16_f32 %0, %1, %2" : "=v"(r) : "v"(lo), "v"(hi)); return r; }

struct EpiBf16 {
    static constexpr bool PERM = true, AFTER_DRAIN = false;
    bf16_t* O; int ldc;
    __device__ __forceinline__ void operator()(const f32x4 (&acc)[2][2][4][2], const Unit& u, int wr, int wc, int fr, int fq) const {
        const int row0 = u.pm * BM + wr * 64 + fr; const int col0 = u.pn * BM + wc * 32 + 8 * fq;
#pragma unroll
        for (int ai = 0; ai < 2; ++ai)
#pragma unroll
            for (int m = 0; m < 4; ++m) { bf16_t* rowp = O + (size_t)(row0 + ai * HALF + m * 16) * ldc + col0;
#pragma unroll
                for (int bj = 0; bj < 2; ++bj) { const f32x4 v0 = acc[ai][bj][m][0], v1 = acc[ai][bj][m][1];
                    u32x4 w; w.x = cvt_pk_bf16(v0[0], v0[1]); w.y = cvt_pk_bf16(v0[2], v0[3]); w.z = cvt_pk_bf16(v1[0], v1[1]); w.w = cvt_pk_bf16(v1[2], v1[3]);
                    *(u32x4*)(rowp + bj * HALF) = w; } }
    }
};
struct EpiQKV {
    static constexpr bool PERM = true, AFTER_DRAIN = false;
    unsigned char* wsb; size_t offQ, dK, dV;
    const PG8_LAS float* gl; const float* ropec; float c2;
    __device__ __forceinline__ void operator()(const f32x4 (&acc)[2][2][4][2], const Unit& u, int wr, int wc, int fr, int fq) const {
        const int isk = (u.pn >= 4) ? 1 : 0, isv = (u.pn >= 5) ? 1 : 0;
        bf16_t* base = (bf16_t*)(wsb + offQ + (size_t)isk * dK + (size_t)isv * dV); const int ldc = isk ? 256 : 1024;
        const int hcol = (isk ? wc : (u.pn * 4 + wc)) * 64 + 8 * fq;
        const int pmb = u.pm / 17, pml = u.pm - pmb * 17; const bool lat = pml != 0;
        const PG8_LAS float* gp = gl + (isk ? 64 : 0) + 8 * fq; const float scl = isk ? 1.0f : c2;
#pragma unroll
        for (int ai = 0; ai < 2; ++ai)
#pragma unroll
            for (int m = 0; m < 4; ++m) { const int rl = ai * HALF + wr * 64 + m * 16 + fr; const size_t row = (size_t)u.pm * BM + rl;
                f32x4 v[2][2]; float ss = 0.f;
#pragma unroll
                for (int bj = 0; bj < 2; ++bj)
#pragma unroll
                    for (int n = 0; n < 2; ++n) { v[bj][n] = acc[ai][bj][m][n]; ss += (v[bj][n][0] * v[bj][n][0] + v[bj][n][1] * v[bj][n][1]) + (v[bj][n][2] * v[bj][n][2] + v[bj][n][3] * v[bj][n][3]); }
                if (!isv) { const int ln = lane_now(); ss += shx(ss, 16, ln); ss += shx(ss, 32, ln);
                    const float rs = 1.0f / sqrtf(ss * (1.0f / 64.0f) + 1e-6f);
                    const int spos = (pml - 1) * 256 + rl;
#pragma unroll
                    for (int bj = 0; bj < 2; ++bj) { f32x4 cs = (f32x4){1.f, 1.f, 1.f, 1.f}, sn = (f32x4){0.f, 0.f, 0.f, 0.f};
                        if (lat) { const float* cp = ropec + (size_t)spos * 32 + 16 * bj + 4 * fq; cs = *(const f32x4*)cp; sn = *(const f32x4*)(cp + 4096 * 32); }
#pragma unroll
                        for (int n = 0; n < 2; ++n) { const f32x4 y = v[bj][n] * rs * *(const PG8_LAS f32x4*)(gp + 32 * bj + 4 * n);
                            const float c0 = cs[2 * n], s0 = sn[2 * n], c1 = cs[2 * n + 1], s1 = sn[2 * n + 1];
                            v[bj][n] = (f32x4){(y[0] * c0 - y[1] * s0) * scl, (y[0] * s0 + y[1] * c0) * scl, (y[2] * c1 - y[3] * s1) * scl, (y[2] * s1 + y[3] * c1) * scl}; } } }
                bf16_t* rowp = base + row * ldc + hcol;
#pragma unroll
                for (int bj = 0; bj < 2; ++bj) { u32x4 w; w.x = cvt_pk_bf16(v[bj][0][0], v[bj][0][1]); w.y = cvt_pk_bf16(v[bj][0][2], v[bj][0][3]); w.z = cvt_pk_bf16(v[bj][1][0], v[bj][1][1]); w.w = cvt_pk_bf16(v[bj][1][2], v[bj][1][3]);
                    *(u32x4*)(rowp + 32 * bj) = w; } }
    }
};
struct EpiBiasF8 {
    static constexpr bool PERM = true, AFTER_DRAIN = false;
    unsigned char* O; const float* bias; float ascale;
    __device__ __forceinline__ void operator()(const f32x4 (&acc)[2][2][4][2], const Unit& u, int wr, int wc, int fr, int fq) const {
        const int row0 = u.pm * BM + wr * 64 + fr; const int col0 = u.pn * BM + wc * 32 + 8 * fq;
        const float* bp = bias + (size_t)u.e * 1024 + col0;
        f32x4 bv[2][2];
#pragma unroll
        for (int bj = 0; bj < 2; ++bj)
#pragma unroll
            for (int n = 0; n < 2; ++n) bv[bj][n] = *(const f32x4*)(bp + bj * HALF + 4 * n);
#pragma unroll
        for (int ai = 0; ai < 2; ++ai)
#pragma unroll
            for (int m = 0; m < 4; ++m) { unsigned char* rowp = O + (size_t)(row0 + ai * HALF + m * 16) * 1024 + col0;
#pragma unroll
                for (int bj = 0; bj < 2; ++bj) { const f32x4 v0 = acc[ai][bj][m][0] * ascale + bv[bj][0], v1 = acc[ai][bj][m][1] * ascale + bv[bj][1];
                    *(unsigned long long*)(rowp + bj * HALF) = (unsigned long long)pk4_fp8(v0[0], v0[1], v0[2], v0[3]) | ((unsigned long long)pk4_fp8(v1[0], v1[1], v1[2], v1[3]) << 32); } }
    }
};
struct EpiResGate {
    static constexpr bool PERM = false, AFTER_DRAIN = false;
    bf16_t* X; const float* gate;
    __device__ __forceinline__ void operator()(const f32x4 (&acc)[2][2][4][2], const Unit& u, int wr, int wc, int fr, int fq) const {
        const int row0 = u.pm * BM + wr * 64 + fr; const int col0 = u.pn * BM + wc * 32 + 4 * fq;
        const int bb = u.pm / 17, mr = (u.pm - bb * 17 == 0) ? 8 : bb;
        const float* gp = gate + (size_t)mr * 6144 + col0;
        f32x4 gv[2][2];
#pragma unroll
        for (int bj = 0; bj < 2; ++bj)
#pragma unroll
            for (int n = 0; n < 2; ++n) gv[bj][n] = *(const f32x4*)(gp + bj * HALF + n * 16);
#pragma unroll
        for (int ai = 0; ai < 2; ++ai)
#pragma unroll
            for (int m = 0; m < 4; ++m) { bf16_t* rowp = X + (size_t)(row0 + ai * HALF + m * 16) * 1024 + col0;
#pragma unroll
                for (int bj = 0; bj < 2; ++bj)
#pragma unroll
                    for (int n = 0; n < 2; ++n) { unsigned long long* p = (unsigned long long*)(rowp + bj * HALF + n * 16); const unsigned long long v = *p;
                        f32x4 x = (f32x4){__uint_as_float((unsigned)(v & 0xffffu) << 16), __uint_as_float((unsigned)(v >> 16) << 16), __uint_as_float((unsigned)((v >> 32) & 0xffffu) << 16), __uint_as_float((unsigned)(v >> 48) << 16)};
                        x = x + gv[bj][n] * acc[ai][bj][m][n];
                        *p = (unsigned long long)cvt_pk_bf16(x[0], x[1]) | ((unsigned long long)cvt_pk_bf16(x[2], x[3]) << 32); } }
    }
};
struct EpiSwiGLU {
    static constexpr bool PERM = true, AFTER_DRAIN = false;
    bf16_t* O; const float* bias;
    __device__ __forceinline__ void operator()(const f32x4 (&acc)[2][2][4][2], const Unit& u, int wr, int wc, int fr, int fq) const {
        const int row0 = u.pm * BM + wr * 64 + fr; const int col0 = u.pn * HALF + wc * 32 + 8 * fq;
        const float* bp = bias + (size_t)u.e * 2048 + col0;
        f32x4 bg[2], bu[2];
#pragma unroll
        for (int n = 0; n < 2; ++n) { bg[n] = *(const f32x4*)(bp + 4 * n); bu[n] = *(const f32x4*)(bp + 1024 + 4 * n); }
#pragma unroll
        for (int ai = 0; ai < 2; ++ai)
#pragma unroll
            for (int m = 0; m < 4; ++m) { bf16_t* rowp = O + (size_t)(row0 + ai * HALF + m * 16) * 1024 + col0;
                float r[8];
#pragma unroll
                for (int n = 0; n < 2; ++n) { const f32x4 gt = acc[ai][0][m][n] + bg[n], up = acc[ai][1][m][n] + bu[n];
#pragma unroll
                    for (int i = 0; i < 4; ++i) { const float g = fminf(gt[i], 7.0f), uu = fminf(fmaxf(up[i], -7.0f), 7.0f);
                        const float sg = __builtin_amdgcn_rcpf(1.0f + __builtin_amdgcn_exp2f(-1.702f * 1.4426950408889634f * g));
                        r[4 * n + i] = (uu + 1.0f) * (g * sg); } }
                u32x4 w; w.x = cvt_pk_bf16(r[0], r[1]); w.y = cvt_pk_bf16(r[2], r[3]); w.z = cvt_pk_bf16(r[4], r[5]); w.w = cvt_pk_bf16(r[6], r[7]);
                *(u32x4*)rowp = w; }
    }
};
struct EpiSwiGLU8 {
    static constexpr bool PERM = true, AFTER_DRAIN = false;
    unsigned char* O; const float* bias; float ascale;
    __device__ __forceinline__ void operator()(const f32x4 (&acc)[2][2][4][2], const Unit& u, int wr, int wc, int fr, int fq) const {
        const int row0 = u.pm * BM + wr * 64 + fr; const int col0 = u.pn * HALF + wc * 32 + 8 * fq;
        const float* bp = bias + (size_t)u.e * 2048 + col0;
        f32x4 bg[2], bu[2];
#pragma unroll
        for (int n = 0; n < 2; ++n) { bg[n] = *(const f32x4*)(bp + 4 * n); bu[n] = *(const f32x4*)(bp + 1024 + 4 * n); }
#pragma unroll
        for (int ai = 0; ai < 2; ++ai)
#pragma unroll
            for (int m = 0; m < 4; ++m) { unsigned char* rowp = O + (size_t)(row0 + ai * HALF + m * 16) * 1024 + col0;
                float r[8];
#pragma unroll
                for (int n = 0; n < 2; ++n) { const f32x4 gt = acc[ai][0][m][n] * ascale + bg[n], up = acc[ai][1][m][n] * ascale + bu[n];
#pragma unroll
                    for (int i = 0; i < 4; ++i) { const float g = fminf(gt[i], 7.0f), uu = fminf(fmaxf(up[i], -7.0f), 7.0f);
                        const float sg = __builtin_amdgcn_rcpf(1.0f + __builtin_amdgcn_exp2f(-1.702f * 1.4426950408889634f * g));
                        r[4 * n + i] = (uu + 1.0f) * (g * sg); } }
                *(unsigned long long*)rowp = (unsigned long long)pk4_fp8(r[0], r[1], r[2], r[3]) | ((unsigned long long)pk4_fp8(r[4], r[5], r[6], r[7]) << 32); }
    }
};
struct EpiBiasBf16 {
    static constexpr bool PERM = true, AFTER_DRAIN = false;
    bf16_t* O; const float* bias; float ascale;
    __device__ __forceinline__ void operator()(const f32x4 (&acc)[2][2][4][2], const Unit& u, int wr, int wc, int fr, int fq) const {
        const int row0 = u.pm * BM + wr * 64 + fr; const int col0 = u.pn * BM + wc * 32 + 8 * fq;
        const float* bp = bias + (size_t)u.e * 1024 + col0;
        f32x4 bv[2][2];
#pragma unroll
        for (int bj = 0; bj < 2; ++bj)
#pragma unroll
            for (int n = 0; n < 2; ++n) bv[bj][n] = *(const f32x4*)(bp + bj * HALF + 4 * n);
#pragma unroll
        for (int ai = 0; ai < 2; ++ai)
#pragma unroll
            for (int m = 0; m < 4; ++m) { bf16_t* rowp = O + (size_t)(row0 + ai * HALF + m * 16) * 1024 + col0;
#pragma unroll
                for (int bj = 0; bj < 2; ++bj) { const f32x4 v0 = acc[ai][bj][m][0] * ascale + bv[bj][0], v1 = acc[ai][bj][m][1] * ascale + bv[bj][1];
                    u32x4 w; w.x = cvt_pk_bf16(v0[0], v0[1]); w.y = cvt_pk_bf16(v0[2], v0[3]); w.z = cvt_pk_bf16(v1[0], v1[1]); w.w = cvt_pk_bf16(v1[2], v1[3]);
                    *(u32x4*)(rowp + bj * HALF) = w; } }
    }
};

template <class Epi, class Sched, bool ALIGN_EPI = false, bool SP2 = false, bool GATHER = false, bool F8 = false>
__device__ __forceinline__ void gemm_phase(PG8_LAS unsigned char* lds, const Gemm g, const Sched& S, const Epi& E, int tid_in) {
    int tid_l = tid_in; asm volatile("" : "+v"(tid_l));
    const int tid = tid_l, wid = __builtin_amdgcn_readfirstlane(tid >> 6), lane = tid & 63, wr = wid >> 2, wc = wid & 3, fr = lane & 15, fq = lane >> 4;
    const int K = g.K, nt = K / BK;
    unsigned voffA[2], voffB[2];
#pragma unroll
    for (int i = 0; i < 2; ++i) { int R, C; stage_rc(tid * 16 + i * 8192, R, C); const int Rb = Epi::PERM ? ((R & ~31) + perm32(R & 31)) : R;
        voffA[i] = (unsigned)(R * K + C) * 2u; voffB[i] = (unsigned)(Rb * K + C) * 2u; }
    const size_t kstep = (size_t)(BK * 2);
    static_assert(!GATHER || SP2, "GATHER is wired into the SP2 loop only");
    unsigned vAc0[2], vAc1[2], vAn0[2], vAn1[2]; int gR[2]; unsigned gC[2];
#pragma unroll
    for (int i = 0; i < 2; ++i) { int R, C; stage_rc(tid * 16 + i * 8192, R, C); gR[i] = R; gC[i] = (unsigned)C * 2u; vAc0[i] = voffA[i]; vAc1[i] = voffA[i]; vAn0[i] = voffA[i]; vAn1[i] = voffA[i]; }
#define PG8_GFETCH(d0, d1, ord) do { if constexpr (GATHER) { _Pragma("unroll") for (int _i = 0; _i < 2; ++_i) { \
        d0[_i] = (unsigned)g.rowtab[(ord) * 256 + gR[_i]] * (unsigned)(K * 2) + gC[_i]; d1[_i] = (unsigned)g.rowtab[(ord) * 256 + 128 + gR[_i]] * (unsigned)(K * 2) + gC[_i]; } } } while (0)
    const size_t hstep = (size_t)HALF * K * 2;
    const size_t hstepA = GATHER ? 0 : hstep;
    const size_t tstep = 2 * hstep;
    const unsigned ldsw = (unsigned)wid * 1024u;
    const int aoff = lds_byte(wr * 64 + fr, fq * 8), boff = lds_byte(wc * 32 + fr, fq * 8);
    typedef int v8i_t __attribute__((ext_vector_type(8))); typedef short v16s_a16 __attribute__((ext_vector_type(16), aligned(16)));
    const int f8c = 32 * (fq >> 1) + 16 * (fq & 1);
    const int aoff8a = lds_byte(wr * 64 + fr, f8c), boff8a = lds_byte(wc * 32 + fr, f8c);
    v8i_t At8[4], Au8[4], B08[2], B18[2]; int f8scale = 127; asm volatile("" : "+v"(f8scale));
#define PG8_SA(b, h) (((b) * 2 + (h)) * HTB)
#define PG8_SB(b, h) ((4 + (b) * 2 + (h)) * HTB)
#define PG8_STAGE(bufoff, gbase, voff) do { _Pragma("unroll") for (int _i = 0; _i < 2; ++_i) \
        __builtin_amdgcn_global_load_lds((const unsigned*)((const char*)(gbase) + (voff)[_i]), (PG8_LAS unsigned*)(lds + (bufoff) + ldsw + _i * 8192), 16, 0, 0); } while (0)
#define PG8_LDA(dst, b, h) do { if constexpr (F8) { _Pragma("unroll") for (int m = 0; m < 4; ++m) { const bf16x8 lo_ = *(const PG8_LAS bf16x8*)(lds + PG8_SA(b, h) + aoff8a + m * 2048), hi_ = *(const PG8_LAS bf16x8*)(lds + PG8_SA(b, h) + aoff8a + m * 2048 + 16); dst##8[m] = __builtin_bit_cast(v8i_t, __builtin_shufflevector(lo_, hi_, 0, 1, 2, 3, 4, 5, 6, 7, 8, 9, 10, 11, 12, 13, 14, 15)); } } \
        else { _Pragma("unroll") for (int m = 0; m < 4; ++m) _Pragma("unroll") for (int k = 0; k < 2; ++k) dst[m][k] = *(const PG8_LAS bf16x8*)(lds + PG8_SA(b, h) + aoff + m * 2048 + k * 1024); } } while (0)
#define PG8_LDB(dst, b, h) do { if constexpr (F8) { _Pragma("unroll") for (int n = 0; n < 2; ++n) { const bf16x8 lo_ = *(const PG8_LAS bf16x8*)(lds + PG8_SB(b, h) + boff8a + n * 2048), hi_ = *(const PG8_LAS bf16x8*)(lds + PG8_SB(b, h) + boff8a + n * 2048 + 16); dst##8[n] = __builtin_bit_cast(v8i_t, __builtin_shufflevector(lo_, hi_, 0, 1, 2, 3, 4, 5, 6, 7, 8, 9, 10, 11, 12, 13, 14, 15)); } } \
        else { _Pragma("unroll") for (int n = 0; n < 2; ++n) _Pragma("unroll") for (int k = 0; k < 2; ++k) dst[n][k] = *(const PG8_LAS bf16x8*)(lds + PG8_SB(b, h) + boff + n * 2048 + k * 1024); } } while (0)
#define PG8_MMA(ai, bj, At, Bt) do { __builtin_amdgcn_s_setprio(1); if constexpr (F8) { _Pragma("unroll") for (int m = 0; m < 4; ++m) _Pragma("unroll") for (int n = 0; n < 2; ++n) \
            asm volatile("v_mfma_scale_f32_16x16x128_f8f6f4 %0, %1, %2, %0, %3, %3 op_sel_hi:[0,0,0]" : "+v"(acc[ai][bj][m][n]) : "v"(Bt##8[n]), "v"(At##8[m]), "v"(f8scale)); } \
        else { _Pragma("unroll") for (int m = 0; m < 4; ++m) _Pragma("unroll") for (int n = 0; n < 2; ++n) _Pragma("unroll") for (int k = 0; k < 2; ++k) \
        acc[ai][bj][m][n] = __builtin_amdgcn_mfma_f32_16x16x32_bf16(Bt[n][k], At[m][k], acc[ai][bj][m][n], 0, 0, 0); } __builtin_amdgcn_s_setprio(0); } while (0)
#define PG8_WAIT_V(n) asm volatile("s_waitcnt vmcnt(" #n ")" ::: "memory")
#define PG8_WAIT_L(n) asm volatile("s_waitcnt lgkmcnt(" #n ")" ::: "memory")
#define PG8_BAR __builtin_amdgcn_s_barrier()
#define PG8_SCHED __builtin_amdgcn_sched_barrier(0)
    Unit cur, nxt; int ui = 0;
    if (!S.next(0, cur)) return;
    f32x4 acc[2][2][4][2];
#pragma unroll
    for (int a = 0; a < 2; ++a)
#pragma unroll
        for (int b = 0; b < 2; ++b)
#pragma unroll
            for (int m = 0; m < 4; ++m)
#pragma unroll
                for (int n = 0; n < 2; ++n) acc[a][b][m][n] = (f32x4){0.f, 0.f, 0.f, 0.f};
    bf16x8 At[4][2], Au[4][2], B0[2][2], B1[2][2];
    const char* cA = (const char*)g.A + (GATHER ? (size_t)0 : (size_t)cur.pm * tstep); PG8_GFETCH(vAc0, vAc1, 0); const char* cB = (const char*)g.Bt + (size_t)cur.e * g.bstride + (size_t)cur.pn * tstep;
    S.a_ready(cur);
    if constexpr (SP2) {
        PG8_STAGE(PG8_SB(0, 0), cB, voffB); PG8_STAGE(PG8_SB(0, 1), cB + hstep, voffB); PG8_STAGE(PG8_SA(0, 0), cA, vAc0); PG8_STAGE(PG8_SA(0, 1), cA + hstepA, vAc1);
        if (wr == 1) PG8_BAR;
        PG8_WAIT_V(2); PG8_BAR;
        PG8_STAGE(PG8_SB(1, 0), cB + kstep, voffB); PG8_STAGE(PG8_SA(1, 0), cA + kstep, vAc0); PG8_STAGE(PG8_SB(1, 1), cB + hstep + kstep, voffB);
        PG8_WAIT_V(6); PG8_BAR;
    } else {
        PG8_STAGE(PG8_SB(0, 0), cB, voffB); PG8_STAGE(PG8_SA(0, 0), cA, voffA); PG8_STAGE(PG8_SB(0, 1), cB + hstep, voffB); PG8_STAGE(PG8_SA(0, 1), cA + hstep, voffA);
        if (wr == 1) PG8_BAR;
        PG8_WAIT_V(4); PG8_BAR;
        PG8_STAGE(PG8_SB(1, 0), cB + kstep, voffB); PG8_STAGE(PG8_SA(1, 0), cA + kstep, voffA); PG8_STAGE(PG8_SB(1, 1), cB + hstep + kstep, voffB);
        PG8_WAIT_V(6); PG8_BAR;
    }
    for (;;) {
        const bool has_next = S.next(ui + 1, nxt);
        const char* nA = (has_next && !GATHER) ? (const char*)g.A + (size_t)nxt.pm * tstep : cA;
        if constexpr (GATHER) { if (has_next) PG8_GFETCH(vAn0, vAn1, ui + 1); else { vAn0[0] = vAc0[0]; vAn0[1] = vAc0[1]; vAn1[0] = vAc1[0]; vAn1[1] = vAc1[1]; } }
        const char* nB = has_next ? (const char*)g.Bt + (size_t)nxt.e * g.bstride + (size_t)nxt.pn * tstep : cB;
#pragma unroll 1
        for (int t = 0; t < nt; t += 2) {
            const bool last = (t == nt - 2);
            const char* a1 = cA + (size_t)(t + 1) * kstep;
            const char* a2 = last ? nA : cA + (size_t)(t + 2) * kstep; const char* b2 = last ? nB : cB + (size_t)(t + 2) * kstep;
            const char* a3 = a2 + kstep; const char* b3 = b2 + kstep;
            if (last && has_next) S.a_ready(nxt);
            unsigned vS0[2], vS1[2];
            vS0[0] = last ? vAn0[0] : vAc0[0]; vS0[1] = last ? vAn0[1] : vAc0[1]; vS1[0] = last ? vAn1[0] : vAc1[0]; vS1[1] = last ? vAn1[1] : vAc1[1];
            if constexpr (SP2) {
            PG8_LDB(B0, 0, 0); PG8_LDB(B1, 0, 1); PG8_SCHED; PG8_LDA(At, 0, 0); PG8_STAGE(PG8_SA(1, 1), a1 + hstepA, vAc1);
            PG8_WAIT_V(8); PG8_WAIT_L(0); PG8_BAR; PG8_MMA(0, 0, At, B0); PG8_MMA(0, 1, At, B1); PG8_BAR; PG8_SCHED;
            if constexpr (F8) { PG8_LDA(Au, 0, 1); } else { PG8_LDA(At, 0, 1); } PG8_STAGE(PG8_SB(0, 0), b2, voffB); PG8_STAGE(PG8_SB(0, 1), b2 + hstep, voffB); PG8_STAGE(PG8_SA(0, 0), a2, vS0);
            PG8_WAIT_V(8); PG8_WAIT_L(0); PG8_BAR; if constexpr (F8) { PG8_MMA(1, 0, Au, B0); PG8_MMA(1, 1, Au, B1); } else { PG8_MMA(1, 0, At, B0); PG8_MMA(1, 1, At, B1); } PG8_BAR; PG8_SCHED;
            PG8_LDB(B0, 1, 0); PG8_LDB(B1, 1, 1); PG8_SCHED; PG8_LDA(At, 1, 0); PG8_STAGE(PG8_SA(0, 1), a2 + hstepA, vS1);
            PG8_WAIT_V(8); PG8_WAIT_L(0); PG8_BAR; PG8_MMA(0, 0, At, B0); PG8_MMA(0, 1, At, B1); PG8_BAR; PG8_SCHED;
            if constexpr (F8) { PG8_LDA(Au, 1, 1); } else { PG8_LDA(At, 1, 1); } PG8_STAGE(PG8_SB(1, 0), b3, voffB); PG8_STAGE(PG8_SB(1, 1), b3 + hstep, voffB); PG8_STAGE(PG8_SA(1, 0), a3, vS0);
            PG8_WAIT_V(8); PG8_WAIT_L(0); PG8_BAR; if constexpr (F8) { PG8_MMA(1, 0, Au, B0); PG8_MMA(1, 1, Au, B1); } else { PG8_MMA(1, 0, At, B0); PG8_MMA(1, 1, At, B1); } PG8_BAR; PG8_SCHED;
            } else {
            PG8_LDB(B0, 0, 0); PG8_SCHED; PG8_LDA(At, 0, 0); PG8_STAGE(PG8_SA(1, 1), a1 + hstep, voffA);
            PG8_WAIT_L(8); PG8_BAR; PG8_WAIT_L(0); PG8_MMA(0, 0, At, B0); PG8_BAR; PG8_SCHED;
            PG8_LDB(B1, 0, 1); PG8_STAGE(PG8_SB(0, 0), b2, voffB);
            PG8_BAR; PG8_WAIT_L(0); PG8_MMA(0, 1, At, B1); PG8_BAR;
            PG8_LDA(At, 0, 1); PG8_STAGE(PG8_SA(0, 0), a2, voffA);
            PG8_BAR; PG8_WAIT_L(0); PG8_MMA(1, 0, At, B0); PG8_BAR; PG8_SCHED;
            PG8_STAGE(PG8_SB(0, 1), b2 + hstep, voffB);
            PG8_WAIT_V(6); PG8_BAR; PG8_MMA(1, 1, At, B1); PG8_BAR;
            PG8_LDB(B0, 1, 0); PG8_SCHED; PG8_LDA(At, 1, 0); PG8_STAGE(PG8_SA(0, 1), a2 + hstep, voffA);
            PG8_WAIT_L(8); PG8_BAR; PG8_WAIT_L(0); PG8_MMA(0, 0, At, B0); PG8_BAR; PG8_SCHED;
            PG8_LDB(B1, 1, 1); PG8_STAGE(PG8_SB(1, 0), b3, voffB);
            PG8_BAR; PG8_WAIT_L(0); PG8_MMA(0, 1, At, B1); PG8_BAR;
            PG8_LDA(At, 1, 1); PG8_STAGE(PG8_SA(1, 0), a3, voffA);
            PG8_BAR; PG8_WAIT_L(0); PG8_MMA(1, 0, At, B0); PG8_BAR; PG8_SCHED;
            PG8_STAGE(PG8_SB(1, 1), b3 + hstep, voffB);
            PG8_WAIT_V(6); PG8_BAR; PG8_MMA(1, 1, At, B1); PG8_BAR;
            }
        }
        if constexpr (ALIGN_EPI) { if (wr == 0) PG8_BAR; }
        if constexpr (F8) asm volatile("s_nop 15\n\ts_nop 15" ::: "memory");
        if constexpr (!Epi::AFTER_DRAIN) { E(acc, cur, wr, wc, fr, fq); S.done(cur); }
        if (!has_next) break;
#pragma unroll
        for (int a = 0; a < 2; ++a)
#pragma unroll
            for (int b = 0; b < 2; ++b)
#pragma unroll
                for (int m = 0; m < 4; ++m)
#pragma unroll
                    for (int n = 0; n < 2; ++n) acc[a][b][m][n] = (f32x4){0.f, 0.f, 0.f, 0.f};
        cur = nxt; cA = nA; cB = nB; ++ui;
        if constexpr (GATHER) { vAc0[0] = vAn0[0]; vAc0[1] = vAn0[1]; vAc1[0] = vAn1[0]; vAc1[1] = vAn1[1]; }
        if constexpr (ALIGN_EPI) { if (wr == 1) PG8_BAR; }
    }
    PG8_WAIT_V(0);
    if constexpr (!ALIGN_EPI) { if (wr == 0) PG8_BAR; }
    PG8_BAR;
    if constexpr (Epi::AFTER_DRAIN) { E.fused(acc, cur, wr, wc, fr, fq, lds, wid, lane); S.done(cur); }
#undef PG8_SA
#undef PG8_SB
#undef PG8_STAGE
#undef PG8_LDA
#undef PG8_LDB
#undef PG8_MMA
#undef PG8_WAIT_V
#undef PG8_WAIT_L
#undef PG8_BAR
#undef PG8_SCHED
#undef PG8_GFETCH
}
}
#include <hip/hip_bf16.h>
#include <cmath>
namespace attn_body {
using bf16=__hip_bfloat16;
using bf16x8=__attribute__((ext_vector_type(8)))short;
using s16x4=__attribute__((ext_vector_type(4)))short;
using f32x16=__attribute__((ext_vector_type(16)))float;
using u32x4=__attribute__((ext_vector_type(4)))unsigned;
constexpr int D=64,DM=1024,KVP=256;
constexpr int NW=8,QBLK=32,QB=QBLK*NW,KVBLK=64;
__device__ __forceinline__ int crow(int r,int hi){return (r&3)+8*(r>>2)+4*hi;}
#define SBAR() __builtin_amdgcn_sched_barrier(0)
__device__ __forceinline__ void cmask(f32x16&p0,f32x16&p1,int jb,int qrel,int hi){
  const float NEG=-INFINITY; int kb=64*jb+4*hi;
  #pragma unroll
  for(int r=0;r<16;++r){int kv=kb+(r&3)+8*(r>>2); if(kv>qrel)p0[r]=NEG; if(kv+32>qrel)p1[r]=NEG;}
}

constexpr int NSLOT=3, SLOTB=8192;
constexpr int LDS_K=0, LDS_V=NSLOT*SLOTB, LDS_WS=2*NSLOT*SLOTB, LDS_OST=LDS_WS+NW*64*4, LDS_BYTES=LDS_OST+NW*4096;
constexpr float C2=0.125f*1.4426950408889634f;
__device__ __forceinline__ void glds16(const void*gsrc,unsigned lds_dst){unsigned keep;
  asm volatile("s_mov_b32 %0, m0\n\ts_mov_b32 m0, %2\n\ts_nop 0\n\tglobal_load_lds_dwordx4 %1, off\n\ts_mov_b32 m0, %0":"=&s"(keep):"v"(gsrc),"s"(lds_dst):"memory");}
__device__ __forceinline__ float max3f(float a,float b,float c){float r;asm("v_max3_f32 %0, %1, %2, %3":"=v"(r):"v"(a),"v"(b),"v"(c));return r;}
__device__ __forceinline__ float max2f(float a,float b){float r;asm("v_max_f32_e32 %0, %1, %2":"=v"(r):"v"(a),"v"(b));return r;}
__device__ __forceinline__ float fadd_s(float a,float b){float r;asm("v_add_f32_e32 %0, %1, %2":"=v"(r):"v"(a),"v"(b));return r;}
__device__ __forceinline__ float fsub_s(float a,float b){float r;asm("v_sub_f32_e32 %0, %1, %2":"=v"(r):"v"(a),"v"(b));return r;}
typedef float f32x2_t __attribute__((ext_vector_type(2))); typedef __bf16 bf16x2_t __attribute__((ext_vector_type(2)));
__device__ __forceinline__ unsigned cvtpk_s(float lo,float hi){f32x2_t v={lo,hi};bf16x2_t b=__builtin_convertvector(v,bf16x2_t);return __builtin_bit_cast(unsigned,b);}
#define WAIT_BAR(N) asm volatile("s_waitcnt vmcnt(" #N ") lgkmcnt(0)\n\ts_barrier":::"memory")

__device__ __forceinline__ void qkt(f32x16&p0,f32x16&p1,const char*Kslot,const bf16x8*qr,const f32x16&negm,int r32,int hi){
  const char*kb=Kslot+hi*1024+r32*16;
  #pragma unroll
  for(int d0=0;d0<4;++d0){
    const bf16x8 b0=*reinterpret_cast<const bf16x8*>(kb+d0*2048);
    const bf16x8 b1=*reinterpret_cast<const bf16x8*>(kb+d0*2048+512);
    if(d0==0){p0=__builtin_amdgcn_mfma_f32_32x32x16_bf16(b0,qr[0],negm,0,0,0);p1=__builtin_amdgcn_mfma_f32_32x32x16_bf16(b1,qr[0],negm,0,0,0);}
    else{p0=__builtin_amdgcn_mfma_f32_32x32x16_bf16(b0,qr[d0],p0,0,0,0);p1=__builtin_amdgcn_mfma_f32_32x32x16_bf16(b1,qr[d0],p1,0,0,0);}}
}
typedef __attribute__((address_space(3))) const char* lds_cptr;
typedef short v4i16_t __attribute__((ext_vector_type(4)));
__device__ __forceinline__ void kload8(bf16x8*kf,lds_cptr kp){
  kf[0]=*(const __attribute__((address_space(3))) bf16x8*)(kp);      kf[1]=*(const __attribute__((address_space(3))) bf16x8*)(kp+512);
  kf[2]=*(const __attribute__((address_space(3))) bf16x8*)(kp+2048); kf[3]=*(const __attribute__((address_space(3))) bf16x8*)(kp+2560);
  kf[4]=*(const __attribute__((address_space(3))) bf16x8*)(kp+4096); kf[5]=*(const __attribute__((address_space(3))) bf16x8*)(kp+4608);
  kf[6]=*(const __attribute__((address_space(3))) bf16x8*)(kp+6144); kf[7]=*(const __attribute__((address_space(3))) bf16x8*)(kp+6656);
}
__device__ __forceinline__ void kload2(bf16x8*kf,lds_cptr kp,int j){ kf[2*j]=*(const __attribute__((address_space(3))) bf16x8*)(kp+j*2048); kf[2*j+1]=*(const __attribute__((address_space(3))) bf16x8*)(kp+j*2048+512); }
__device__ __forceinline__ s16x4 vtr(lds_cptr p){ return __builtin_bit_cast(s16x4,__builtin_amdgcn_ds_read_tr16_b64_v4i16((__attribute__((address_space(3))) v4i16_t*)p)); }
__device__ __forceinline__ float rowmax(const f32x16&p0,const f32x16&p1){
  float a=max3f(p0[0],p0[1],p1[0]),b=max3f(p0[2],p0[3],p1[1]);a=max3f(a,p1[2],p1[3]);
  #pragma unroll
  for(int r=4;r<16;r+=4){a=max3f(a,p0[r],p0[r+1]);b=max3f(b,p0[r+2],p0[r+3]);a=max3f(a,p1[r],p1[r+1]);b=max3f(b,p1[r+2],p1[r+3]);}
  const float m=max2f(a,b);
  auto rr=__builtin_amdgcn_permlane32_swap(__float_as_uint(m),__float_as_uint(m),false,false);
  return max2f(__uint_as_float(rr[0]),__uint_as_float(rr[1]));
}
__device__ __forceinline__ void pv(f32x16*o,int vb,bf16x8 pa0,bf16x8 pa1,bf16x8 pa2,bf16x8 pa3){
  #pragma unroll
  for(int d0=0;d0<2;++d0){s16x4 lo[4],hi[4];
    #pragma unroll
    for(int ks=0;ks<4;++ks){
      asm volatile("ds_read_b64_tr_b16 %0,%1 offset:%c2":"=&v"(lo[ks]):"v"(vb),"i"(d0*4096+ks*1024):"memory");
      asm volatile("ds_read_b64_tr_b16 %0,%1 offset:%c2":"=&v"(hi[ks]):"v"(vb),"i"(d0*4096+ks*1024+512):"memory");}
    asm volatile("s_waitcnt lgkmcnt(0)":::"memory");SBAR();
    #define PK(k) (bf16x8){lo[k][0],lo[k][1],lo[k][2],lo[k][3],hi[k][0],hi[k][1],hi[k][2],hi[k][3]}
    o[d0]=__builtin_amdgcn_mfma_f32_32x32x16_bf16(pa0,PK(0),o[d0],0,0,0);
    o[d0]=__builtin_amdgcn_mfma_f32_32x32x16_bf16(pa1,PK(1),o[d0],0,0,0);
    o[d0]=__builtin_amdgcn_mfma_f32_32x32x16_bf16(pa2,PK(2),o[d0],0,0,0);
    o[d0]=__builtin_amdgcn_mfma_f32_32x32x16_bf16(pa3,PK(3),o[d0],0,0,0);
    #undef PK
  }
}

#ifndef ATTN_STORE16
#define ATTN_STORE16(p,v) (*(u32x4*)(p)=(v))
#endif
template<int THRL> __device__ __forceinline__ void attn_unit(long qrow0,long kvrow0,int NT,int h,const bf16*Q,const bf16*__restrict__ K,const bf16*__restrict__ V,bf16*O,char*shm,int tid_in){
  int tid_l=tid_in; asm volatile("":"+v"(tid_l)); const int tid=tid_l,lane=tid&63,r32=lane&31,hi=lane>>5; const int wid=__builtin_amdgcn_readfirstlane(tid>>6);
  const bf16*Qw=Q+(qrow0+wid*QBLK)*DM+h*D;
  const bf16*Kh=K+kvrow0*KVP+(h>>2)*D,*Vh=V+kvrow0*KVP+(h>>2)*D;
  const unsigned lds0=(unsigned)(uintptr_t)shm;
  float*wsf=(float*)(shm+LDS_WS)+wid*64;
  const bf16*ksrc=Kh+(long)lane*KVP+wid*8;
  const bf16*vsrc=Vh+(long)(16*(wid&3)+(lane>>2))*KVP+(wid>>2)*32+(lane&3)*8;
  const unsigned kdst=lds0+LDS_K+wid*1024, vdst=lds0+LDS_V+wid*1024;
  #define DMA_K(t,slot) glds16(ksrc+(long)(t)*KVBLK*KVP,(unsigned)__builtin_amdgcn_readfirstlane(kdst+(slot)))
  #define DMA_V(t,slot) glds16(vsrc+(long)(t)*KVBLK*KVP,(unsigned)__builtin_amdgcn_readfirstlane(vdst+(slot)))
  const int vb0=(int)(lds0+LDS_V)+((lane>>4)&1)*32+(lane&3)*8+(4*hi+((lane&15)>>2))*64;
  const char*Kbase=shm+LDS_K; bf16x8 kf[8];
  const lds_cptr shm3=(lds_cptr)shm; const lds_cptr kp0=shm3+LDS_K+hi*1024+r32*16; const lds_cptr vp0=shm3+LDS_V+((lane>>4)&1)*32+(lane&3)*8+(4*hi+((lane&15)>>2))*64;
  DMA_K(0,0);DMA_V(0,0);DMA_K(1,SLOTB);
  bf16x8 qr[4];
  #pragma unroll
  for(int d0=0;d0<4;++d0)qr[d0]=*reinterpret_cast<const bf16x8*>(&Qw[(long)r32*DM+d0*16+hi*8]);
  float mhat=0.f,l_reg=0.f;f32x16 o[2];o[0]=f32x16{};o[1]=f32x16{};f32x16 negm=f32x16{};asm volatile("":"+v"(negm));
  #define CMASK(P0,P1,t) do{}while(0)
  bool resc=false;
  #define START(P0,P1) do{ const float rm=rowmax(P0,P1); resc=false; \
    { const float dl=rm; mhat=fadd_s(mhat,dl); \
      _Pragma("unroll") for(int r=0;r<16;++r){P0[r]=fsub_s(P0[r],dl);P1[r]=fsub_s(P1[r],dl);} \
      _Pragma("unroll") for(int r=0;r<16;++r)negm[r]=-mhat; asm volatile("":"+v"(negm)); } \
    _Pragma("unroll") for(int r=0;r<16;++r)P0[r]=__builtin_amdgcn_exp2f(P0[r]); }while(0)
  #define RESC() do{ if(resc){ asm volatile("s_waitcnt lgkmcnt(0)":::"memory"); \
      _Pragma("unroll") for(int d_=0;d_<2;++d_) _Pragma("unroll") for(int r=0;r<16;++r)o[d_][r]*=wsf[crow(r,hi)]; } }while(0)
  f32x16 pA0,pA1,pB0,pB1;
  int sl_prev=0,sl_cur=0,sl_next=SLOTB;
  #define ROT() do{sl_prev=sl_cur;sl_cur=sl_next;sl_next=(sl_next==(NSLOT-1)*SLOTB)?0:sl_next+SLOTB;}while(0)
  DMA_K(2,2*SLOTB);
  WAIT_BAR(3);
  qkt(pA0,pA1,Kbase,qr,negm,r32,hi);asm volatile("s_nop 15\n\ts_nop 7":"+v"(pA0),"+v"(pA1));CMASK(pA0,pA1,0);
  START(pA0,pA1);
  _Pragma("unroll") for(int r=0;r<16;++r)pA1[r]=__builtin_amdgcn_exp2f(pA1[r]);
  WAIT_BAR(0);
  DMA_K(3,0);DMA_V(1,SLOTB);
  ROT();
  kload8(kf,kp0+sl_cur);
  WAIT_BAR(2);
  s16x4 vlo[8],vhi[8]; u32x4 pw0,pw1,pw2,pw3;
  #define PKW(P,B) cvtpk_s(P[B],P[B+1])
  #define PAF(k) __builtin_bit_cast(bf16x8,pw##k)
  #define VFR(i) (bf16x8){vlo[i][0],vlo[i][1],vlo[i][2],vlo[i][3],vhi[i][0],vhi[i][1],vhi[i][2],vhi[i][3]}
  #define PIN(x) asm volatile("":"+v"(x))
  #define MX3(a,b,c) __builtin_fmaxf(__builtin_fmaxf((a),(b)),(c))
  #define GAPA(MF,A0,A1,A2,A3,W0,W1,PW) do{ MF; sacc+=A0; sacc+=A1; sacc+=A2; sacc+=A3; PIN(sacc); W0; W1; PIN(PW); SBAR(); }while(0)
  #define EX(v) __builtin_amdgcn_exp2f(v)
  #define GAPB(MF,X,B) do{ MF; X[B]=EX(X[B]); X[B+1]=EX(X[B+1]); X[B+2]=EX(X[B+2]); X[B+3]=EX(X[B+3]); PIN(X); SBAR(); }while(0)
  #define VRD(i) do{ vlo[i]=vtr(vp_+(((i)>>2)*4096+((i)&3)*1024)); vhi[i]=vtr(vp_+(((i)>>2)*4096+((i)&3)*1024+512)); }while(0)
  #define KRD(G,j) do{ if(G){ kload2(kf,kp0+sl_next,j); SBAR(); } }while(0)
  #define STEP(C0,C1,P0,P1,t,GK,GV,GL) do{ SBAR(); \
    const lds_cptr vp_=vp0+sl_prev; \
    VRD(0); SBAR(); float sacc=(P0[0]+P0[1]); \
    GAPA(C0=__builtin_amdgcn_mfma_f32_32x32x16_bf16(kf[0],qr[0],negm,0,0,0), P0[2],P0[3],P0[4],P0[5],     pw0[0]=PKW(P0,0), pw0[1]=PKW(P0,2), pw0); \
    VRD(4); SBAR(); GAPA(C1=__builtin_amdgcn_mfma_f32_32x32x16_bf16(kf[1],qr[0],negm,0,0,0), P0[6],P0[7],P0[8],P0[9],     pw0[2]=PKW(P0,4), pw0[3]=PKW(P0,6), pw0); \
    VRD(1); SBAR(); GAPA(C0=__builtin_amdgcn_mfma_f32_32x32x16_bf16(kf[2],qr[1],C0,0,0,0),   P0[10],P0[11],P0[12],P0[13], pw1[0]=PKW(P0,8), pw1[1]=PKW(P0,10), pw1); \
    VRD(5); SBAR(); GAPA(C1=__builtin_amdgcn_mfma_f32_32x32x16_bf16(kf[3],qr[1],C1,0,0,0),   P0[14],P0[15],P1[0],P1[1],   pw1[2]=PKW(P0,12),pw1[3]=PKW(P0,14), pw1); \
    VRD(2); SBAR(); GAPA(C0=__builtin_amdgcn_mfma_f32_32x32x16_bf16(kf[4],qr[2],C0,0,0,0),   P1[2],P1[3],P1[4],P1[5],     pw2[0]=PKW(P1,0), pw2[1]=PKW(P1,2), pw2); \
    VRD(6); SBAR(); GAPA(C1=__builtin_amdgcn_mfma_f32_32x32x16_bf16(kf[5],qr[2],C1,0,0,0),   P1[6],P1[7],P1[8],P1[9],     pw2[2]=PKW(P1,4), pw2[3]=PKW(P1,6), pw2); \
    VRD(3); SBAR(); GAPA(C0=__builtin_amdgcn_mfma_f32_32x32x16_bf16(kf[6],qr[3],C0,0,0,0),   P1[10],P1[11],P1[12],P1[13], pw3[0]=PKW(P1,8), pw3[1]=PKW(P1,10), pw3); \
    VRD(7); SBAR(); GAPA(C1=__builtin_amdgcn_mfma_f32_32x32x16_bf16(kf[7],qr[3],C1,0,0,0),   P1[14],P1[15],0.f,0.f,       pw3[2]=PKW(P1,12),pw3[3]=PKW(P1,14), pw3); \
    l_reg+=sacc; \
    if(GK){DMA_K((t)+3,sl_cur);} if(GV){DMA_V((t)+1,sl_next);} \
    CMASK(C0,C1,t); \
    { float a=MX3(C0[0],C0[1],C1[0]),b=MX3(C0[2],C0[3],C1[1]); a=MX3(a,C1[2],C1[3]); \
      _Pragma("unroll") for(int r=4;r<16;r+=4){a=MX3(a,C0[r],C0[r+1]);b=MX3(b,C0[r+2],C0[r+3]);a=MX3(a,C1[r],C1[r+1]);b=MX3(b,C1[r+2],C1[r+3]);} \
      float rm=__builtin_fmaxf(a,b); { auto rr=__builtin_amdgcn_permlane32_swap(__float_as_uint(rm),__float_as_uint(rm),false,false); rm=__builtin_fmaxf(__uint_as_float(rr[0]),__uint_as_float(rr[1])); } \
      resc=false; \
      if(__builtin_expect(__any(rm>(float)THRL),0)){ const float dl=__builtin_fmaxf(rm,0.f); mhat+=dl; \
        _Pragma("unroll") for(int r=0;r<16;++r){C0[r]-=dl;C1[r]-=dl;} \
        _Pragma("unroll") for(int r=0;r<16;++r)negm[r]=-mhat; asm volatile("":"+v"(negm)); \
        const float f=__builtin_amdgcn_exp2f(-dl); l_reg*=f; if(hi==0)wsf[r32]=f; resc=true; } } \
    SBAR(); \
    GAPB(o[0]=__builtin_amdgcn_mfma_f32_32x32x16_bf16(PAF(0),VFR(0),o[0],0,0,0), C0,0); \
    GAPB(o[1]=__builtin_amdgcn_mfma_f32_32x32x16_bf16(PAF(0),VFR(4),o[1],0,0,0), C0,4); \
    KRD(GL,0); GAPB(o[0]=__builtin_amdgcn_mfma_f32_32x32x16_bf16(PAF(1),VFR(1),o[0],0,0,0), C0,8); \
    KRD(GL,1); GAPB(o[1]=__builtin_amdgcn_mfma_f32_32x32x16_bf16(PAF(1),VFR(5),o[1],0,0,0), C0,12); \
    KRD(GL,2); GAPB(o[0]=__builtin_amdgcn_mfma_f32_32x32x16_bf16(PAF(2),VFR(2),o[0],0,0,0), C1,0); \
    KRD(GL,3); GAPB(o[1]=__builtin_amdgcn_mfma_f32_32x32x16_bf16(PAF(2),VFR(6),o[1],0,0,0), C1,4); \
    GAPB(o[0]=__builtin_amdgcn_mfma_f32_32x32x16_bf16(PAF(3),VFR(3),o[0],0,0,0), C1,8); \
    GAPB(o[1]=__builtin_amdgcn_mfma_f32_32x32x16_bf16(PAF(3),VFR(7),o[1],0,0,0), C1,12); \
    }while(0)
  int t=1;
  #undef CMASK
  #define CMASK(P0,P1,t) do{}while(0)
  for(;t+5<NT;t+=2){
    STEP(pB0,pB1,pA0,pA1,t,true,true,true);     WAIT_BAR(2); RESC(); ROT();
    STEP(pA0,pA1,pB0,pB1,t+1,true,true,true);   WAIT_BAR(2); RESC(); ROT();
  }
  #undef CMASK
  #define CMASK(P0,P1,t) do{}while(0)
  #define ENDW(tt) do{ if((tt)+3<NT){WAIT_BAR(2);} else if((tt)+2<NT){WAIT_BAR(1);} else {WAIT_BAR(0);} }while(0)
  for(;t+1<NT;t+=2){
    STEP(pB0,pB1,pA0,pA1,t,(t+3<NT),(t+1<NT),(t+1<NT));       ENDW(t);   RESC(); ROT();
    STEP(pA0,pA1,pB0,pB1,t+1,(t+4<NT),(t+2<NT),(t+2<NT));     ENDW(t+1); RESC(); ROT();
  }
  STEP(pB0,pB1,pA0,pA1,NT-1,false,false,false); RESC();
  { float sacc=pB0[0]+pB0[1]; _Pragma("unroll") for(int r=2;r<16;++r)sacc+=pB0[r]; _Pragma("unroll") for(int r=0;r<16;++r)sacc+=pB1[r]; l_reg+=sacc;
    pw0=(u32x4){PKW(pB0,0),PKW(pB0,2),PKW(pB0,4),PKW(pB0,6)};pw1=(u32x4){PKW(pB0,8),PKW(pB0,10),PKW(pB0,12),PKW(pB0,14)};pw2=(u32x4){PKW(pB1,0),PKW(pB1,2),PKW(pB1,4),PKW(pB1,6)};pw3=(u32x4){PKW(pB1,8),PKW(pB1,10),PKW(pB1,12),PKW(pB1,14)};
    SBAR(); pv(o,vb0+sl_cur,PAF(0),PAF(1),PAF(2),PAF(3)); }
  #undef PKW
  #undef PAF
  #undef VFR
  #undef PIN
  #undef MX3
  #undef GAPA
  #undef GAPB
  #undef EX
  #undef VRD
  #undef KRD
  #undef STEP
  #undef ENDW
  {auto rr=__builtin_amdgcn_permlane32_swap(__float_as_uint(l_reg),__float_as_uint(l_reg),false,false);l_reg=__uint_as_float(rr[0])+__uint_as_float(rr[1]);}
  if(hi==0)wsf[32+r32]=l_reg;asm volatile("s_waitcnt lgkmcnt(0)":::"memory");
  float rli[16];
  #pragma unroll
  for(int r=0;r<16;++r)rli[r]=__builtin_amdgcn_rcpf(wsf[32+crow(r,hi)]);
  bf16*Ow=O+(qrow0+wid*QBLK)*DM+h*D;
  { bf16*stg=(bf16*)(shm+LDS_OST)+wid*2048;
    #pragma unroll
    for(int r=0;r<16;++r){const int orow=crow(r,hi);
      #pragma unroll
      for(int d0=0;d0<2;++d0)stg[orow*64+d0*32+r32]=__float2bfloat16(o[d0][r]*rli[r]);}
    asm volatile("s_waitcnt lgkmcnt(0)":::"memory");
    #pragma unroll
    for(int i=0;i<4;++i){const int row=i*8+(lane>>3),ch=lane&7; const u32x4 v=*(const u32x4*)(stg+row*64+ch*8); ATTN_STORE16(Ow+(long)row*DM+ch*8,v);} }
  asm volatile("s_waitcnt lgkmcnt(0)\n\ts_barrier":::"memory");
  #undef DMA_K
  #undef DMA_V
  #undef CMASK
  #undef START
  #undef RESC
  #undef ROT
}
constexpr int ATTN_LDS_BYTES=LDS_BYTES;
#undef SBAR
#undef WAIT_BAR
}

constexpr int NWAVES = 8;
constexpr int NB = 8, SEQ = 4096, CTXL = 256, TB = SEQ + CTXL  , MT = NB * TB  , DMODEL = 1024;
constexpr int NMODC = 6 * DMODEL, MODROWS = 9;
constexpr int QKVN = 1536, WINN = 3104, WINP = 3328;
constexpr int NEXP = 32, TOPK = 4, MPAD = MT * TOPK + NEXP * 256;
constexpr int NLAYER = 4;
constexpr float RMS_EPS = 1e-6f;
constexpr float ATT_C2 = 0.125f * 1.4426950408889634f;

constexpr size_t MiB = 1u << 20;
constexpr size_t WS_CTL = 0, CTL_ZERO_BYTES = 1 * MiB;
constexpr size_t WS_MOD = 1 * MiB, WS_ROPE = 2 * MiB, WS_MODP = 3 * MiB;
constexpr size_t WS_SLOT = 17 * MiB, WS_GATEW = 18 * MiB, WS_SLOTPOS = 19 * MiB;
constexpr size_t WS_WQKV = 20 * MiB, WS_WOA = 26 * MiB, WS_WIN = 30 * MiB, WS_WOG = 43 * MiB, WS_WGU = 48 * MiB, WS_WDN = 560 * MiB;
constexpr size_t WS_X = 816 * MiB, WS_XN = 952 * MiB, WS_Q = 1020 * MiB, WS_K = 1088 * MiB, WS_V = 1105 * MiB, WS_G = 1122 * MiB;
constexpr size_t WS_OF = 1343 * MiB, WS_OB = 1479 * MiB, WS_XG = 1615 * MiB, WS_ACT = 1903 * MiB, WS_Y = 2191 * MiB, WS_XN8 = WS_ACT + 150 * MiB  , WS_PAR = 2479 * MiB, WS_LIST = 2483 * MiB  , WS_END = 2488 * MiB;
static_assert(WS_MODP + (size_t)16 * NLAYER * MODROWS * NMODC * 4 <= WS_SLOT && WS_WIN + (size_t)2 * WINP * 1024 * 2 <= WS_WOG && WS_G + (size_t)MT * WINP * 2 <= WS_OF && WS_XG + (size_t)MPAD * 1024 * 2 <= WS_ACT, "ws map");
constexpr int CW_TMO = 0, CW_BAR = 4096, CW_CNT = 16384;

constexpr int RING_OFF = 0, RING_BYTES = 131072;
constexpr int WR_STRIDE = 1028;
constexpr int LDS_AUX = 133120;
constexpr int AUX_LCNT = LDS_AUX, AUX_GB = LDS_AUX + 128, AUX_T2E = LDS_AUX + 256  , AUX_BASE = AUX_T2E + 2560  , AUX_NT = AUX_BASE + 128, AUX_CNT = AUX_NT + 64  , AUX_ENT = AUX_CNT + 128  , AUX_RS = AUX_ENT + 4352  , AUX_ROWTAB = AUX_RS + 576, ROWTAB_UNITS = 18  ;
constexpr int MISC_OFF = 154624;
constexpr int LDS_BYTES = 155648;
static_assert(AUX_ROWTAB + ROWTAB_UNITS * 512 <= MISC_OFF, "LDS map");

#define GAS __attribute__((address_space(1)))
#define LAS __attribute__((address_space(3)))
typedef unsigned short bf16;
typedef unsigned v4u __attribute__((ext_vector_type(4)));
typedef float f32x4 __attribute__((ext_vector_type(4)));
typedef short bf16x8 __attribute__((ext_vector_type(8)));
typedef GAS unsigned gu32;
typedef GAS unsigned long long gu64;
#define RLX_AGENT __ATOMIC_RELAXED, __HIP_MEMORY_SCOPE_AGENT
#define LDS_WAIT() asm volatile("s_waitcnt lgkmcnt(0)" ::: "memory")
#define VM_WAIT() asm volatile("s_waitcnt vmcnt(0)" ::: "memory")
__device__ __forceinline__ unsigned long long rt() { return __builtin_amdgcn_s_memrealtime(); }
__device__ __forceinline__ unsigned f2bf(float f) { unsigned u = __builtin_bit_cast(unsigned, f); return (u + 0x7fffu + ((u >> 16) & 1u)) >> 16; }
__device__ __forceinline__ unsigned pk2(float lo, float hi) { return f2bf(lo) | (f2bf(hi) << 16); }

#define XB_TMO      128
#define XB_XCNT(j)  (256  + 64 * (j))
#define XB_XSUB(j)  (1280 + 64 * (j))
#define XB_XGEN(j)  (2304 + 64 * (j))
#define XB_TOP      3328
#define XB_TOPGEN   3392
#define XCD_BAR_WORDS 3456
#define XB_SPIN_CAP (1u << 18)

__device__ __forceinline__ unsigned xb_ld(unsigned* p)              { return __hip_atomic_load(p, __ATOMIC_RELAXED, __HIP_MEMORY_SCOPE_AGENT); }
__device__ __forceinline__ unsigned xb_add(unsigned* p, unsigned v) { return __hip_atomic_fetch_add(p, v, __ATOMIC_RELAXED, __HIP_MEMORY_SCOPE_AGENT); }
__device__ __forceinline__ unsigned xb_xcc_id() { return (unsigned)__builtin_amdgcn_s_getreg((3 << 11) | 20) & 0xFu; }
#define XB_SPIN(cond, bar) do { unsigned _sp = 0; while (cond) { __builtin_amdgcn_s_sleep(1); \
    if ((++_sp & 255u) == 0u) { if (xb_ld(&(bar)[XB_TMO])) break; if (_sp > XB_SPIN_CAP) { atomicAdd(&(bar)[XB_TMO], 1u); break; } } } } while (0)

struct XcdBarrier {
    unsigned* bar; unsigned x;
    volatile LAS unsigned* st;
};

__device__ __forceinline__ XcdBarrier xcd_barrier_post(unsigned* bar, volatile LAS unsigned* st, bool xb_t0  ) {
    XcdBarrier b; b.bar = bar; b.x = xb_xcc_id(); b.st = st;
    if (xb_t0) (void)xb_add(&bar[XB_XCNT(b.x)], 1u);
    return b;
}
__device__ __forceinline__ void xcd_barrier_complete(unsigned* bar, unsigned x, unsigned& nloc, unsigned& nx) {
    const unsigned G = gridDim.x * gridDim.y * gridDim.z;
    unsigned sum, cnt, mine, sp = 0u;
    for (;;) {
        sum = 0u; cnt = 0u; mine = 0u;
#pragma unroll
        for (unsigned j = 0; j < 16; ++j) { const unsigned c = xb_ld(&bar[XB_XCNT(j)]); sum += c; cnt += (c > 0u) ? 1u : 0u; mine = (j == x) ? c : mine; }
        if (sum == G) break;
        __builtin_amdgcn_s_sleep(1);
        if ((++sp & 255u) == 0u) { if (xb_ld(&bar[XB_TMO])) break; if (sp > XB_SPIN_CAP) { atomicAdd(&bar[XB_TMO], 1u); break; } }
    }
    nloc = mine > 0u ? mine : 1u; nx = cnt > 0u ? cnt : 1u;
}

__device__ __forceinline__ void xcd_barrier(const XcdBarrier& b, bool xb_t0  ) {
    asm volatile("s_waitcnt vmcnt(0)" ::: "memory");
    __syncthreads();
    if (xb_t0) {
        unsigned* bar = b.bar;
        __builtin_amdgcn_s_waitcnt(0);
        unsigned nloc = b.st[0], nx = b.st[1];
        if (nloc == 0u) { xcd_barrier_complete(bar, b.x, nloc, nx); b.st[0] = nloc; b.st[1] = nx; }
        const unsigned old = xb_add(&bar[XB_XSUB(b.x)], 1u);
        const unsigned gen = old / nloc;
        if (old + 1u == (gen + 1u) * nloc) {
            __builtin_amdgcn_fence(__ATOMIC_RELEASE, "agent");
            asm volatile("s_waitcnt vmcnt(0)" ::: "memory");
            const unsigned og = xb_add(&bar[XB_TOP], 1u);
            const unsigned tg = og / nx;
            if (og + 1u == (tg + 1u) * nx) xb_add(&bar[XB_TOPGEN], 1u);
            else XB_SPIN(xb_ld(&bar[XB_TOPGEN]) == tg, bar);
            __builtin_amdgcn_fence(__ATOMIC_ACQUIRE, "agent");
            xb_add(&bar[XB_XGEN(b.x)], 1u);
            asm volatile("s_waitcnt vmcnt(0)" ::: "memory");
        } else {
            XB_SPIN(xb_ld(&bar[XB_XGEN(b.x)]) == gen, bar);
            __builtin_amdgcn_fence(__ATOMIC_ACQUIRE, "agent");
            asm volatile("s_waitcnt vmcnt(0)" ::: "memory");
        }
    }
    __syncthreads();
}

typedef float f32x2 __attribute__((ext_vector_type(2)));
using pg8::lane_now; using pg8::shx;
__device__ __forceinline__ float wave_sum(float v) {
    const int ln = lane_now();
#pragma unroll
    for (int o = 1; o < 64; o <<= 1) v += shx(v, o, ln);
    return v;
}
__device__ __forceinline__ float wave_max(float v) {
    const int ln = lane_now();
#pragma unroll
    for (int o = 1; o < 64; o <<= 1) v = fmaxf(v, shx(v, o, ln));
    return v;
}
__device__ __forceinline__ float bf2f(unsigned short h) { return __uint_as_float((unsigned)h << 16); }
__device__ __forceinline__ float silu_f(float x) { return x / (1.0f + __expf(-x)); }
__device__ __forceinline__ f32x4 bf4_to_f32(unsigned long long v) { return (f32x4){__uint_as_float((unsigned)(v & 0xffffu) << 16), __uint_as_float((unsigned)(v >> 16) << 16), __uint_as_float((unsigned)((v >> 32) & 0xffffu) << 16), __uint_as_float((unsigned)(v >> 48) << 16)}; }
__device__ __forceinline__ unsigned long long f32_to_bf4(f32x4 y) { return (unsigned long long)pk2(y.x, y.y) | ((unsigned long long)pk2(y.z, y.w) << 32); }
__device__ __forceinline__ int mod_row(int m) { const int b = m / TB; return (m - b * TB < CTXL) ? 8 : b; }

__device__ __forceinline__ void titem_load(const float* W, int N, int k0, int n0, int lane, f32x4 (&v)[16]) {
    const GAS f32x4* p = (const GAS f32x4*)(W + (size_t)(k0 + 16 * (lane >> 3)) * N + n0 + 4 * (lane & 7));
#pragma unroll
    for (int j = 0; j < 16; ++j) v[j] = p[(size_t)j * (N >> 2)];
}
__device__ __forceinline__ void titem_store8(const f32x4 (&v)[16], unsigned char* WT8, int K, int k0, int dst_row0, int lane) {
    unsigned char* o = WT8 + (size_t)(dst_row0 + 4 * (lane & 7)) * K + k0 + 16 * (lane >> 3);
#pragma unroll
    for (int i = 0; i < 4; ++i) { v4u q;
        q.x = pg8::pk4_fp8(v[0][i] * 32.f, v[1][i] * 32.f, v[2][i] * 32.f, v[3][i] * 32.f); q.y = pg8::pk4_fp8(v[4][i] * 32.f, v[5][i] * 32.f, v[6][i] * 32.f, v[7][i] * 32.f);
        q.z = pg8::pk4_fp8(v[8][i] * 32.f, v[9][i] * 32.f, v[10][i] * 32.f, v[11][i] * 32.f); q.w = pg8::pk4_fp8(v[12][i] * 32.f, v[13][i] * 32.f, v[14][i] * 32.f, v[15][i] * 32.f);
        *(GAS v4u*)(o + (size_t)i * K) = q; }
}
__device__ __forceinline__ void titem_store16(const f32x4 (&v)[16], bf16* WT, int K, int k0, int dst_row0, int lane) {
    bf16* o = WT + (size_t)(dst_row0 + 4 * (lane & 7)) * K + k0 + 16 * (lane >> 3);
#pragma unroll
    for (int i = 0; i < 4; ++i) { v4u q0, q1;
        q0.x = pk2(v[0][i], v[1][i]); q0.y = pk2(v[2][i], v[3][i]); q0.z = pk2(v[4][i], v[5][i]); q0.w = pk2(v[6][i], v[7][i]);
        q1.x = pk2(v[8][i], v[9][i]); q1.y = pk2(v[10][i], v[11][i]); q1.z = pk2(v[12][i], v[13][i]); q1.w = pk2(v[14][i], v[15][i]);
        *(GAS v4u*)(o + (size_t)i * K) = q0; *(GAS v4u*)(o + (size_t)i * K + 8) = q1; }
}

struct Args { const float* in[25]; float* out; unsigned char* ws; int ph_lo, ph_hi; };
constexpr int P_N1G = 0, P_N2G = 4096, P_QG = 8192, P_KG = 8320, P_GKF = 8448, P_GKB = 24832, P_BGF = 41216, P_BGB = 42240, P_OG = 43264, P_WR = 43776, P_BR = 174848, P_BGU = 174976, P_BDN = 437120, P_END = 568192;
#define LAUNDER_S(p) asm volatile("" : "+s"(p))
#define LAUNDER_V(p) asm volatile("" : "+v"(p))
#define PARF(ws) ((const float*)((ws) + WS_PAR))

constexpr int I8_GU = 128 * 8 * 64, I8_DN = 128 * 8 * 32, NI8 = I8_GU + I8_DN;
struct T8 { const float* W; unsigned char* O; int N, k0, n0, dst; };
__device__ __forceinline__ T8 dec8(const Args& A, unsigned char* ws, int it) { T8 t;
    const bool gu = it < I8_GU; const int r = gu ? it : it - I8_GU, sh = gu ? 6 : 5, mat = r >> (3 + sh), q = r & ((8 << sh) - 1), kb = q >> sh, n0 = (q & ((1 << sh) - 1)) * 32;
    t.N = gu ? 2048 : 1024; t.W = (gu ? A.in[21] : A.in[23]) + (size_t)mat * 1024 * t.N; t.O = ws + (gu ? WS_WGU : WS_WDN) + (size_t)mat * 1024 * t.N; t.k0 = kb * 128; t.n0 = n0;
    t.dst = gu ? ((n0 & 1023) >> 7) * 256 + (n0 >> 10) * 128 + (n0 & 127) : n0;
    return t; }
__device__ __forceinline__ void p0_prologue(const Args& A, LAS unsigned char* lds, int gw, int NGW, int wave, int lane) {
    unsigned char* ws = A.ws;
    { f32x4 va[16], vb[16]; int it = gw;
      if (it < NI8) { const T8 t = dec8(A, ws, it); titem_load(t.W, t.N, t.k0, t.n0, lane, va); }
      while (it + 2 * NGW < NI8) {
          { const T8 t = dec8(A, ws, it + NGW); titem_load(t.W, t.N, t.k0, t.n0, lane, vb); }
          { const T8 t = dec8(A, ws, it); titem_store8(va, t.O, 1024, t.k0, t.dst, lane); }
          { const T8 t = dec8(A, ws, it + 2 * NGW); titem_load(t.W, t.N, t.k0, t.n0, lane, va); }
          { const T8 t = dec8(A, ws, it + NGW); titem_store8(vb, t.O, 1024, t.k0, t.dst, lane); }
          it += 2 * NGW; }
      if (it < NI8) { const bool hb = it + NGW < NI8;
          if (hb) { const T8 t = dec8(A, ws, it + NGW); titem_load(t.W, t.N, t.k0, t.n0, lane, vb); }
          { const T8 t = dec8(A, ws, it); titem_store8(va, t.O, 1024, t.k0, t.dst, lane); }
          if (hb) { const T8 t = dec8(A, ws, it + NGW); titem_store8(vb, t.O, 1024, t.k0, t.dst, lane); } } }
    constexpr int J_QKV = 2 * 8 * (QKVN / 32), J_WO = 2 * 8 * 32, J_WIN = 2 * 8 * (WINN / 32), NJ = J_QKV + J_WO + J_WIN + J_WO;
    for (int it = gw; it < NJ; it += NGW) { int r = it; const float* W; bf16* O; int N, kb, n0, dst;
        if (r < J_QKV) { const int per = 8 * (QKVN / 32), mat = r / per, q = r - mat * per; kb = q / (QKVN / 32); n0 = (q - kb * (QKVN / 32)) * 32;
            dst = (n0 & ~255) + ((n0 >> 5) & 1) * 128 + ((n0 >> 6) & 3) * 32;
            W = A.in[8] + (size_t)mat * 1024 * QKVN; N = QKVN; O = (bf16*)(ws + WS_WQKV) + (size_t)mat * QKVN * 1024; }
        else if ((r -= J_QKV) < J_WO) { const int mat = r >> 8, q = r & 255; kb = q >> 5; n0 = (q & 31) * 32; dst = n0;
            W = A.in[11] + (size_t)mat * 1024 * 1024; N = 1024; O = (bf16*)(ws + WS_WOA) + (size_t)mat * 1024 * 1024; }
        else if ((r -= J_WO) < J_WIN) { const int per = 8 * (WINN / 32), mat = r / per, q = r - mat * per; kb = q / (WINN / 32); n0 = (q - kb * (WINN / 32)) * 32; dst = n0;
            W = A.in[12] + (size_t)mat * 1024 * WINN; N = WINN; O = (bf16*)(ws + WS_WIN) + (size_t)mat * WINP * 1024; }
        else { r -= J_WIN; const int mat = r >> 8, q = r & 255; kb = q >> 5; n0 = (q & 31) * 32; dst = n0;
            W = A.in[18] + (size_t)mat * 1024 * 1024; N = 1024; O = (bf16*)(ws + WS_WOG) + (size_t)mat * 1024 * 1024; }
        f32x4 v[16]; titem_load(W, N, kb * 128, n0, lane, v); titem_store16(v, O, 1024, kb * 128, dst, lane); }
    for (int it = gw; it < 2 * (WINP - WINN); it += NGW) { const int mat = it / (WINP - WINN), rr = WINN + it - mat * (WINP - WINN);
        GAS v4u* p = (GAS v4u*)((bf16*)(ws + WS_WIN) + ((size_t)mat * WINP + rr) * 1024) + lane; p[0] = (v4u){0u, 0u, 0u, 0u}; p[64] = (v4u){0u, 0u, 0u, 0u}; }
    for (int it = NGW - 1 - gw; it < NLAYER * 24 * 16; it += NGW) {
        const int l = it / (24 * 16), q = it - l * (24 * 16), cg = q / 16, kc = q - cg * 16;
        float s[MODROWS];
#pragma unroll
        for (int r = 0; r < MODROWS; ++r) { const float cv = (r < 8) ? A.in[1][r * 1024 + kc * 64 + lane] : A.in[3][kc * 64 + lane]; s[r] = silu_f(cv); }
        f32x4 acc[MODROWS];
#pragma unroll
        for (int r = 0; r < MODROWS; ++r) acc[r] = (f32x4){0.f, 0.f, 0.f, 0.f};
        const float* wp = A.in[4] + ((size_t)l * 1024 + kc * 64) * NMODC + cg * 256 + 4 * lane;
#pragma unroll 8
        for (int kk = 0; kk < 64; ++kk) { const f32x4 w = *(const f32x4*)(wp + (size_t)kk * NMODC);
#pragma unroll
            for (int r = 0; r < MODROWS; ++r) { const float sv = __shfl(s[r], kk); acc[r] = acc[r] + w * sv; } }
        float* op = (float*)(ws + WS_MODP) + (size_t)kc * (NLAYER * MODROWS * NMODC) + (size_t)l * MODROWS * NMODC + cg * 256 + 4 * lane;
#pragma unroll
        for (int r = 0; r < MODROWS; ++r) *(f32x4*)(op + (size_t)r * NMODC) = acc[r];
    }
    for (int m0 = gw; m0 < MT; m0 += 4 * NGW) { f32x4 x[4][4];
#pragma unroll
        for (int r = 0; r < 4; ++r) { const int m = m0 + r * NGW; if (m < MT) { const int b = m / TB, w = m - b * TB;
            const float* src = (w < CTXL) ? A.in[2] + ((size_t)b * CTXL + w) * 1024 : A.in[0] + ((size_t)b * SEQ + (w - CTXL)) * 1024; const GAS f32x4* sp = (const GAS f32x4*)src + lane;
#pragma unroll
            for (int j = 0; j < 4; ++j) x[r][j] = sp[64 * j]; } }
#pragma unroll
        for (int r = 0; r < 4; ++r) { const int m = m0 + r * NGW; if (m < MT) { GAS unsigned long long* dp = (GAS unsigned long long*)((bf16*)(ws + WS_X) + (size_t)m * 1024) + lane;
#pragma unroll
            for (int j = 0; j < 4; ++j) dp[64 * j] = f32_to_bf4(x[r][j]); } } }
    { float* par = (float*)(ws + WS_PAR); const int gt = gw * 64 + lane, NGT = NGW * 64;
#define CPL(k, src, n) float c##k##a = 0.f, c##k##b = 0.f; if (gt < (n)) c##k##a = A.in[src][gt]; if (gt + NGT < (n)) c##k##b = A.in[src][gt + NGT];
#define CPS(k, src, n, off) if (gt < (n)) par[(off) + gt] = c##k##a; if (gt + NGT < (n)) par[(off) + gt + NGT] = c##k##b; for (int i = gt + 2 * NGT; i < (n); i += NGT) par[(off) + i] = A.in[src][i];
      CPL(0, 6, 4096) CPL(1, 7, 4096) CPL(2, 9, 128) CPL(3, 10, 128) CPL(4, 13, 16384) CPL(5, 15, 16384) CPL(6, 14, 1024) CPL(7, 16, 1024) CPL(8, 17, 512) CPL(9, 19, 131072) CPL(10, 20, 128) CPL(11, 22, 262144) CPL(12, 24, 131072)
      CPS(0, 6, 4096, P_N1G) CPS(1, 7, 4096, P_N2G) CPS(2, 9, 128, P_QG) CPS(3, 10, 128, P_KG) CPS(4, 13, 16384, P_GKF) CPS(5, 15, 16384, P_GKB) CPS(6, 14, 1024, P_BGF) CPS(7, 16, 1024, P_BGB)
      CPS(8, 17, 512, P_OG) CPS(9, 19, 131072, P_WR) CPS(10, 20, 128, P_BR) CPS(11, 22, 262144, P_BGU) CPS(12, 24, 131072, P_BDN)
#undef CPL
#undef CPS
    }
    for (int idx = gw * 64 + lane; idx < SEQ * 32; idx += NGW * 64) { const int s = idx >> 5, i = idx & 31;
        const float invf = 1.0f / powf(10000.0f, (float)(i & 15) * (1.0f / 16.0f));
        const float ang = (float)((i < 16) ? (s >> 6) : (s & 63)) * invf;
        ((float*)(ws + WS_ROPE))[idx] = cosf(ang); ((float*)(ws + WS_ROPE))[SEQ * 32 + idx] = sinf(ang); }
}
__device__ __forceinline__ void p1_mod_reduce(const Args& A, int gtid, int NGT) {
    const float* P = (const float*)(A.ws + WS_MODP); float* Mo = (float*)(A.ws + WS_MOD);
    constexpr int N = NLAYER * MODROWS * NMODC;
    for (int i = gtid; i < N; i += NGT) { const int l = i / (MODROWS * NMODC), c = i % NMODC; float s = A.in[5][l * NMODC + c];
#pragma unroll
        for (int k = 0; k < 16; ++k) s += P[(size_t)k * N + i];
        Mo[i] = s; }
}
__device__ __forceinline__ void modulate_row(const bf16* xrow, const float* ng, const float* shp, const float* scp, bf16* orow, int lane, f32x4 (&y)[4], float& rs_out) {
    const GAS unsigned long long* xr = (const GAS unsigned long long*)xrow + lane;
    float ss = 0.f;
#pragma unroll
    for (int j = 0; j < 4; ++j) { y[j] = bf4_to_f32(xr[64 * j]); ss += (y[j].x * y[j].x + y[j].y * y[j].y) + (y[j].z * y[j].z + y[j].w * y[j].w); }
    const float rs = 1.0f / sqrtf(wave_sum(ss) * (1.0f / 1024.0f) + RMS_EPS); rs_out = rs;
    GAS unsigned long long* o8 = (GAS unsigned long long*)orow + lane;
#pragma unroll
    for (int j = 0; j < 4; ++j) { const f32x4 g = ((const GAS f32x4*)ng)[64 * j + lane], sh = ((const GAS f32x4*)shp)[64 * j + lane], sc = ((const GAS f32x4*)scp)[64 * j + lane];
        y[j] = (y[j] * rs) * g * (sc + 1.0f) + sh;
        o8[64 * j] = (unsigned long long)pk2(y[j].x, y[j].y) | ((unsigned long long)pk2(y[j].z, y[j].w) << 32); }
}
template <bool F8>
__device__ __forceinline__ void modulate_row2(const bf16* xa, const bf16* xb, const float* ng, const float* sha, const float* sca, const float* shb, const float* scb, unsigned char* oa, unsigned char* ob, int lane, float& rsa, float& rsb) {
    const GAS unsigned long long* pa = (const GAS unsigned long long*)xa + lane; const GAS unsigned long long* pb = (const GAS unsigned long long*)xb + lane;
    unsigned long long ra[4], rb[4]; f32x4 g[4], ha[4], ca[4], hb[4], cb[4];
#pragma unroll
    for (int j = 0; j < 4; ++j) { ra[j] = pa[64 * j]; rb[j] = pb[64 * j]; }
#pragma unroll
    for (int j = 0; j < 4; ++j) { g[j] = ((const GAS f32x4*)ng)[64 * j + lane]; ha[j] = ((const GAS f32x4*)sha)[64 * j + lane]; ca[j] = ((const GAS f32x4*)sca)[64 * j + lane]; hb[j] = ((const GAS f32x4*)shb)[64 * j + lane]; cb[j] = ((const GAS f32x4*)scb)[64 * j + lane]; }
    f32x4 ya[4], yb[4]; float sa = 0.f, sb = 0.f;
#pragma unroll
    for (int j = 0; j < 4; ++j) { ya[j] = bf4_to_f32(ra[j]); yb[j] = bf4_to_f32(rb[j]); sa += (ya[j].x * ya[j].x + ya[j].y * ya[j].y) + (ya[j].z * ya[j].z + ya[j].w * ya[j].w); sb += (yb[j].x * yb[j].x + yb[j].y * yb[j].y) + (yb[j].z * yb[j].z + yb[j].w * yb[j].w); }
    const int ln = lane_now();
#pragma unroll
    for (int o = 1; o < 64; o <<= 1) { sa += shx(sa, o, ln); sb += shx(sb, o, ln); }
    rsa = 1.0f / sqrtf(sa * (1.0f / 1024.0f) + RMS_EPS); rsb = 1.0f / sqrtf(sb * (1.0f / 1024.0f) + RMS_EPS);
#pragma unroll
    for (int j = 0; j < 4; ++j) {
        const f32x4 va = (ya[j] * rsa) * g[j] * (ca[j] + 1.0f) + ha[j], vb = (yb[j] * rsb) * g[j] * (cb[j] + 1.0f) + hb[j];
        if constexpr (F8) { ((GAS unsigned*)oa + lane)[64 * j] = pg8::pk4_fp8(va.x, va.y, va.z, va.w); ((GAS unsigned*)ob + lane)[64 * j] = pg8::pk4_fp8(vb.x, vb.y, vb.z, vb.w); }
        else { ((GAS unsigned long long*)oa + lane)[64 * j] = f32_to_bf4(va); ((GAS unsigned long long*)ob + lane)[64 * j] = f32_to_bf4(vb); } }
}
__device__ __forceinline__ void phase_modulate1(unsigned char* ws, int layer, int gw, int NGW, int lane) {
    const bf16* X = (const bf16*)(ws + WS_X); bf16* XN = (bf16*)(ws + WS_XN);
    const float* ng = PARF(ws) + P_N1G + layer * 1024; const float* Mo = (const float*)(ws + WS_MOD) + (size_t)layer * MODROWS * NMODC;
    for (int m = gw; m < MT; m += 2 * NGW) { const int m2 = (m + NGW < MT) ? m + NGW : m; const int mr = mod_row(m), mr2 = mod_row(m2); float rs, rs2;
        modulate_row2<false>(X + (size_t)m * 1024, X + (size_t)m2 * 1024, ng, Mo + (size_t)mr * NMODC + 0 * 1024, Mo + (size_t)mr * NMODC + 1 * 1024, Mo + (size_t)mr2 * NMODC + 0 * 1024, Mo + (size_t)mr2 * NMODC + 1 * 1024,
                             (unsigned char*)(XN + (size_t)m * 1024), (unsigned char*)(XN + (size_t)m2 * 1024), lane, rs, rs2); }
}
__device__ __forceinline__ void phase_qknorm_rope(unsigned char* ws, int la, int gw, int NGW, int lane) {
    bf16* Qb = (bf16*)(ws + WS_Q); bf16* Kb = (bf16*)(ws + WS_K);
    const float* qg = PARF(ws) + P_QG + la * 64; const float* kg = PARF(ws) + P_KG + la * 64; const float* ropec = (const float*)(ws + WS_ROPE); const float* ropes = ropec + SEQ * 32;
    const int i = lane & 31, hs = lane >> 5;
    for (int m = gw; m < MT; m += NGW) { const int b = m / TB, w = m - b * TB; const bool lat = w >= CTXL;
        float cs = 1.f, sn = 0.f; if (lat) { cs = ropec[(w - CTXL) * 32 + i]; sn = ropes[(w - CTXL) * 32 + i]; }
#pragma unroll 2
        for (int hh = 0; hh < 20; hh += 2) { const int hd = hh + hs;
            unsigned* p = (hd < 16) ? (unsigned*)(Qb + (size_t)m * 1024 + hd * 64) + i : (unsigned*)(Kb + (size_t)m * 256 + (hd - 16) * 64) + i;
            const float* gp = (hd < 16) ? qg : kg; const float scl = (hd < 16) ? ATT_C2 : 1.0f;
            const unsigned v = *p; const float x1 = __uint_as_float(v << 16), x2 = __uint_as_float(v & 0xffff0000u);
            float ss = x1 * x1 + x2 * x2;
#pragma unroll
            for (int o = 1; o < 32; o <<= 1) ss += shx(ss, o, lane);
            const float rs = 1.0f / sqrtf(ss * (1.0f / 64.0f) + RMS_EPS);
            const float y1 = x1 * rs * gp[2 * i], y2 = x2 * rs * gp[2 * i + 1];
            const float r1 = (y1 * cs - y2 * sn) * scl, r2 = (y1 * sn + y2 * cs) * scl;
            *p = pk2(r1, r2); }
    }
}
__device__ __forceinline__ void phase_gla_recurrent(unsigned char* ws, int lg, LAS unsigned char* lds, int tid) {
    const int unit = blockIdx.x; if (unit >= 128) return;
    const int half = unit & 1, dir = (unit >> 1) & 1, h = (unit >> 2) & 3, b = unit >> 4;
    const bf16* G = (const bf16*)(ws + WS_G);
    float* Oo = (float*)(ws + (dir ? WS_OB : WS_OF));
    const float* wg = PARF(ws) + (dir ? P_GKB : P_GKF) + (size_t)lg * 16 * 512; const float* bg = PARF(ws) + (dir ? P_BGB : P_BGF) + lg * 512;
    LAS float* qq = (LAS float*)(lds + RING_OFF); LAS float* kk = qq + 64 * 128; LAS float* dd = kk + 64 * 128; LAS float* vv = dd + 64 * 128;
    const int sd = tid & 127, st0 = tid >> 7;
    float wcol[16];
#pragma unroll
    for (int r = 0; r < 16; ++r) wcol[r] = wg[r * 512 + h * 128 + sd];
    const float bcol = bg[h * 128 + sd];
    const int c = tid >> 2, dq = tid & 3;
    float s[32];
#pragma unroll
    for (int j = 0; j < 32; ++j) s[j] = 0.f;
    const float qscale = 0.08838834764831845f;
    for (int ch = 0; ch < TB / 64; ++ch) {
        __syncthreads();
#pragma unroll 4
        for (int i = 0; i < 16; ++i) { const int tt = st0 + 4 * i, n = 64 * ch + tt;
            const int w = dir ? (n < CTXL ? (CTXL - 1 - n) : (TB + CTXL - 1 - n)) : n;
            const bf16* gr = G + ((size_t)b * TB + w) * WINP;
            const float qv = bf2f(gr[h * 128 + sd]) * qscale, kv = bf2f(gr[512 + h * 128 + sd]);
            const bf16* lp = gr + 3072 + dir * 16; float z = bcol;
#pragma unroll
            for (int r = 0; r < 16; ++r) z += bf2f(lp[r]) * wcol[r];
            const float ls = fminf(z, 0.f) - log1pf(__expf(-fabsf(z)));
            qq[tt * 128 + sd] = qv; kk[tt * 128 + sd] = kv; dd[tt * 128 + sd] = __expf(ls * (1.0f / 16.0f));
            vv[tt * 128 + sd] = bf2f(gr[1024 + h * 256 + half * 128 + sd]); }
        __syncthreads();
        for (int tt = 0; tt < 64; ++tt) { const int n = 64 * ch + tt; const int w = dir ? (n < CTXL ? (CTXL - 1 - n) : (TB + CTXL - 1 - n)) : n;
            const float v = vv[tt * 128 + c]; float acc = 0.f;
            const LAS f32x4* q4 = (const LAS f32x4*)(qq + tt * 128 + dq * 32); const LAS f32x4* k4 = (const LAS f32x4*)(kk + tt * 128 + dq * 32); const LAS f32x4* d4 = (const LAS f32x4*)(dd + tt * 128 + dq * 32);
#pragma unroll
            for (int j = 0; j < 8; ++j) { const f32x4 qv = q4[j], kv = k4[j], dv = d4[j];
                s[4 * j + 0] = s[4 * j + 0] * dv.x + kv.x * v; acc += qv.x * s[4 * j + 0];
                s[4 * j + 1] = s[4 * j + 1] * dv.y + kv.y * v; acc += qv.y * s[4 * j + 1];
                s[4 * j + 2] = s[4 * j + 2] * dv.z + kv.z * v; acc += qv.z * s[4 * j + 2];
                s[4 * j + 3] = s[4 * j + 3] * dv.w + kv.w * v; acc += qv.w * s[4 * j + 3]; }
            acc += shx(acc, 1, tid & 63); acc += shx(acc, 2, tid & 63);
            if (dq == 0) Oo[((size_t)b * TB + w) * 1024 + h * 256 + half * 128 + c] = acc; }
    }
}
__device__ __forceinline__ void phase_gla_readout(unsigned char* ws, int lg, int gw, int NGW, int lane) {
    const float* OF = (const float*)(ws + WS_OF); const float* OB = (const float*)(ws + WS_OB); const bf16* G = (const bf16*)(ws + WS_G); bf16* OG = (bf16*)(ws + WS_Q);
    const f32x4 og = ((const GAS f32x4*)(PARF(ws) + P_OG + lg * 256))[lane];
    for (int m = gw; m < MT; m += NGW) {
#pragma unroll
        for (int hh = 0; hh < 4; ++hh) { const size_t off = (size_t)m * 1024 + hh * 256 + 4 * lane;
            f32x4 o = *(const GAS f32x4*)(OF + off) + *(const GAS f32x4*)(OB + off);
            const float ss = wave_sum((o.x * o.x + o.y * o.y) + (o.z * o.z + o.w * o.w));
            const float rs = 1.0f / sqrtf(ss * (1.0f / 256.0f) + RMS_EPS);
            const unsigned long long rv = *(const GAS unsigned long long*)(G + (size_t)m * WINP + 2048 + hh * 256 + 4 * lane);
            const float r0 = __uint_as_float((unsigned)(rv & 0xffffu) << 16), r1 = __uint_as_float((unsigned)(rv >> 16) << 16), r2 = __uint_as_float((unsigned)((rv >> 32) & 0xffffu) << 16), r3 = __uint_as_float((unsigned)(rv >> 48) << 16);
            o = o * rs * og;
            o.x *= silu_f(r0); o.y *= silu_f(r1); o.z *= silu_f(r2); o.w *= silu_f(r3);
            *(GAS unsigned long long*)(OG + off) = (unsigned long long)pk2(o.x, o.y) | ((unsigned long long)pk2(o.z, o.w) << 32); }
    }
}
constexpr size_t WS_GQ = WS_XG, WS_GKH = WS_XG + 68 * MiB, WS_GKT = WS_XG + 136 * MiB, WS_GVT = WS_XG + 204 * MiB, WS_GDL = WS_ACT, WS_SX = WS_OF;
static_assert((size_t)2176 * 2 * 16384 <= 68 * MiB && (size_t)2176 * 256 * 64 * 2 <= 68 * MiB && (size_t)64 * 68 * 65536 <= 272 * MiB, "gla buffers");
typedef float f32x16 __attribute__((ext_vector_type(16)));
__device__ __forceinline__ float log_sigmoid_fast(float z) { return fminf(z, 0.f) - __logf(1.0f + __expf(-fabsf(z))); }

struct G0Raw { unsigned qk[8][2]; v4u lfb; };
__device__ __forceinline__ void g0_load(G0Raw& R, unsigned char* ws, int cn, int tid) {
    const bf16* G = (const bf16*)(ws + WS_G);
    const int d2 = tid & 63, tb = tid >> 6, n = cn % 68, bh = cn / 68, h = bh & 3, b = bh >> 2;
    const size_t r0 = (size_t)b * TB + 64 * n;
#pragma unroll
    for (int j = 0; j < 8; ++j) { const bf16* gr = G + (r0 + 8 * tb + j) * WINP; R.qk[j][0] = *(const GAS unsigned*)(gr + h * 128 + 2 * d2); R.qk[j][1] = *(const GAS unsigned*)(gr + 512 + h * 128 + 2 * d2); }
    R.lfb = *(const GAS v4u*)(G + (r0 + ((tid & 255) >> 2)) * WINP + 3072 + 8 * (tid & 3));
}
__device__ __forceinline__ void g0_vload(unsigned (&raw)[32], const unsigned char* ws, int idx, int h, int dv, int th) {
    const int b = idx / 68, n = idx - b * 68; const bf16* vp = (const bf16*)(ws + WS_G) + ((size_t)b * TB + 64 * n + 32 * th) * WINP + 1024 + h * 256 + dv;
#pragma unroll
    for (int j = 0; j < 32; ++j) raw[j] = (unsigned)((const GAS bf16*)vp)[(size_t)j * WINP];
}
__device__ __forceinline__ void g0_vstore(const unsigned (&raw)[32], unsigned char* ws, int idx, int h, int dv, int th) {
    const int b = idx / 68, n = idx - b * 68, cn = (b * 4 + h) * 68 + n;
    unsigned char* vo = ws + WS_GVT + (size_t)cn * 32768 + (size_t)(((2 * th) * 8 + (dv >> 5)) * 64 + (dv & 31)) * 16;
    unsigned wv[16];
#pragma unroll
    for (int j = 0; j < 16; ++j) wv[j] = raw[2 * j] | (raw[2 * j + 1] << 16);
#pragma unroll
    for (int ql = 0; ql < 2; ++ql)
#pragma unroll
        for (int hq = 0; hq < 2; ++hq) *(GAS v4u*)(vo + ql * 8192 + hq * 512) = (v4u){wv[8 * ql + 2 * hq], wv[8 * ql + 2 * hq + 1], wv[8 * ql + 2 * hq + 4], wv[8 * ql + 2 * hq + 5]};
}
__device__ __forceinline__ void phase_gla_g0v(unsigned char* ws, int tid, int Gp, int bxp) {
    const int G4 = Gp >> 2, h = bxp & 3, wq = bxp >> 2;
    if (wq >= G4) return;
    const int dv = tid & 255, th = tid >> 8; unsigned ra[32], rb[32]; int idx = wq;
    if (idx < 544) g0_vload(ra, ws, idx, h, dv, th);
    while (idx + 2 * G4 < 544) { g0_vload(rb, ws, idx + G4, h, dv, th); g0_vstore(ra, ws, idx, h, dv, th); g0_vload(ra, ws, idx + 2 * G4, h, dv, th); g0_vstore(rb, ws, idx + G4, h, dv, th); idx += 2 * G4; }
    if (idx < 544) { const bool hb = idx + G4 < 544; if (hb) g0_vload(rb, ws, idx + G4, h, dv, th); g0_vstore(ra, ws, idx, h, dv, th); if (hb) g0_vstore(rb, ws, idx + G4, h, dv, th); }
}
__device__ __forceinline__ void phase_gla_g0(unsigned char* ws, int lg, LAS unsigned char* lds, int tid, int Gp, int bxp) {
    LAS float* tot = (LAS float*)(lds + RING_OFF);
    LAS unsigned char* lfl = lds + RING_OFF + 8192;
    const int d2 = tid & 63, tb = tid >> 6;
    const int G4 = Gp >> 2, h = bxp & 3, wq = bxp >> 2;
    if (wq >= G4 || wq >= 544) return;
        float wf0[16], wf1[16], wb0[16], wb1[16];
        { const float* wgf = PARF(ws) + P_GKF + (size_t)lg * 16 * 512 + h * 128 + 2 * d2; const float* wgb = PARF(ws) + P_GKB + (size_t)lg * 16 * 512 + h * 128 + 2 * d2;
#pragma unroll
          for (int r = 0; r < 16; ++r) { const f32x2 a = *(const GAS f32x2*)(wgf + r * 512), c = *(const GAS f32x2*)(wgb + r * 512); wf0[r] = a.x; wf1[r] = a.y; wb0[r] = c.x; wb1[r] = c.y; } }
        const f32x2 bf_ = *(const GAS f32x2*)(PARF(ws) + P_BGF + lg * 512 + h * 128 + 2 * d2), bb_ = *(const GAS f32x2*)(PARF(ws) + P_BGB + lg * 512 + h * 128 + 2 * d2);
    G0Raw R; g0_load(R, ws, ((wq / 68) * 4 + h) * 68 + wq % 68, tid);
    for (int idx = wq; idx < 544; idx += G4) {
        const int b = idx / 68, n = idx - b * 68, cn = (b * 4 + h) * 68 + n;
        __syncthreads();
        if (tid < 256) *(LAS v4u*)(lfl + tid * 16) = R.lfb;
        unsigned qk[8][2];
#pragma unroll
        for (int j = 0; j < 8; ++j) { qk[j][0] = R.qk[j][0]; qk[j][1] = R.qk[j][1]; }
        __syncthreads();
        if (idx + G4 < 544) { const int i2 = idx + G4, b2 = i2 / 68; g0_load(R, ws, (b2 * 4 + h) * 68 + (i2 - b2 * 68), tid); }
        float gf0[8], gf1[8], gb0[8], gb1[8];
#pragma unroll
        for (int j = 0; j < 8; ++j) { const LAS v4u* lp = (const LAS v4u*)(lfl + (8 * tb + j) * 64);
            const v4u l0 = lp[0], l1 = lp[1], l2 = lp[2], l3 = lp[3];
            float lf[16], lb[16];
            lf[0] = __uint_as_float(l0.x << 16); lf[1] = __uint_as_float(l0.x & 0xffff0000u); lf[2] = __uint_as_float(l0.y << 16); lf[3] = __uint_as_float(l0.y & 0xffff0000u);
            lf[4] = __uint_as_float(l0.z << 16); lf[5] = __uint_as_float(l0.z & 0xffff0000u); lf[6] = __uint_as_float(l0.w << 16); lf[7] = __uint_as_float(l0.w & 0xffff0000u);
            lf[8] = __uint_as_float(l1.x << 16); lf[9] = __uint_as_float(l1.x & 0xffff0000u); lf[10] = __uint_as_float(l1.y << 16); lf[11] = __uint_as_float(l1.y & 0xffff0000u);
            lf[12] = __uint_as_float(l1.z << 16); lf[13] = __uint_as_float(l1.z & 0xffff0000u); lf[14] = __uint_as_float(l1.w << 16); lf[15] = __uint_as_float(l1.w & 0xffff0000u);
            lb[0] = __uint_as_float(l2.x << 16); lb[1] = __uint_as_float(l2.x & 0xffff0000u); lb[2] = __uint_as_float(l2.y << 16); lb[3] = __uint_as_float(l2.y & 0xffff0000u);
            lb[4] = __uint_as_float(l2.z << 16); lb[5] = __uint_as_float(l2.z & 0xffff0000u); lb[6] = __uint_as_float(l2.w << 16); lb[7] = __uint_as_float(l2.w & 0xffff0000u);
            lb[8] = __uint_as_float(l3.x << 16); lb[9] = __uint_as_float(l3.x & 0xffff0000u); lb[10] = __uint_as_float(l3.y << 16); lb[11] = __uint_as_float(l3.y & 0xffff0000u);
            lb[12] = __uint_as_float(l3.z << 16); lb[13] = __uint_as_float(l3.z & 0xffff0000u); lb[14] = __uint_as_float(l3.w << 16); lb[15] = __uint_as_float(l3.w & 0xffff0000u);
            float zf0 = bf_.x, zf1 = bf_.y, zb0 = bb_.x, zb1 = bb_.y;
#pragma unroll
            for (int r = 0; r < 16; ++r) { zf0 += lf[r] * wf0[r]; zf1 += lf[r] * wf1[r]; zb0 += lb[r] * wb0[r]; zb1 += lb[r] * wb1[r]; }
            gf0[j] = log_sigmoid_fast(zf0) * 0.0625f; gf1[j] = log_sigmoid_fast(zf1) * 0.0625f; gb0[j] = log_sigmoid_fast(zb0) * 0.0625f; gb1[j] = log_sigmoid_fast(zb1) * 0.0625f; }
#pragma unroll
        for (int j = 1; j < 8; ++j) { gf0[j] += gf0[j - 1]; gf1[j] += gf1[j - 1]; gb0[7 - j] += gb0[8 - j]; gb1[7 - j] += gb1[8 - j]; }
        *(LAS f32x2*)(tot + (0 * 8 + tb) * 128 + 2 * d2) = (f32x2){gf0[7], gf1[7]}; *(LAS f32x2*)(tot + (1 * 8 + tb) * 128 + 2 * d2) = (f32x2){gb0[0], gb1[0]};
        __syncthreads();
        float pf0 = 0.f, pf1 = 0.f, pb0 = 0.f, pb1 = 0.f, lf0 = 0.f, lf1 = 0.f, lb0 = 0.f, lb1 = 0.f;
#pragma unroll
        for (int q = 0; q < 8; ++q) { const f32x2 a = *(const LAS f32x2*)(tot + (0 * 8 + q) * 128 + 2 * d2), c = *(const LAS f32x2*)(tot + (1 * 8 + q) * 128 + 2 * d2);
            lf0 += a.x; lf1 += a.y; lb0 += c.x; lb1 += c.y;
            if (q < tb) { pf0 += a.x; pf1 += a.y; } if (q > tb) { pb0 += c.x; pb1 += c.y; } }
        const size_t itf = (size_t)cn * 2, itb = itf + 1;
        bf16* Qf = (bf16*)(ws + WS_GQ) + itf * 8192; bf16* Qb = Qf + 8192; bf16* Kf = (bf16*)(ws + WS_GKH) + itf * 8192; bf16* Kb = Kf + 8192;
        const float elf0 = __expf(lf0), elf1 = __expf(lf1), elb0 = __expf(lb0), elb1 = __expf(lb1);
        float ktf0[8], ktf1[8], ktb0[8], ktb1[8];
#pragma unroll
        for (int j = 0; j < 8; ++j) { const int t = 8 * tb + j;
            const float q0 = __uint_as_float(qk[j][0] << 16) * 0.08838834764831845f, q1 = __uint_as_float(qk[j][0] & 0xffff0000u) * 0.08838834764831845f;
            const float k0 = __uint_as_float(qk[j][1] << 16), k1 = __uint_as_float(qk[j][1] & 0xffff0000u);
            const float ef0 = __expf(pf0 + gf0[j]), ef1 = __expf(pf1 + gf1[j]), eb0 = __expf(pb0 + gb0[j]), eb1 = __expf(pb1 + gb1[j]);
            const float rf0 = __builtin_amdgcn_rcpf(ef0), rf1 = __builtin_amdgcn_rcpf(ef1), rb0 = __builtin_amdgcn_rcpf(eb0), rb1 = __builtin_amdgcn_rcpf(eb1);
            *(GAS unsigned*)(Qf + t * 128 + 2 * d2) = pk2(q0 * ef0, q1 * ef1); *(GAS unsigned*)(Qb + t * 128 + 2 * d2) = pk2(q0 * eb0, q1 * eb1);
            *(GAS unsigned*)(Kf + t * 128 + 2 * d2) = pk2(k0 * rf0, k1 * rf1); *(GAS unsigned*)(Kb + t * 128 + 2 * d2) = pk2(k0 * rb0, k1 * rb1);
            ktf0[j] = k0 * rf0 * elf0; ktf1[j] = k1 * rf1 * elf1; ktb0[j] = k0 * rb0 * elb0; ktb1[j] = k1 * rb1 * elb1; }
        {
          unsigned char* Tf = ws + WS_GKT + itf * 16384 + (size_t)((((tb >> 1) * 4 + (d2 >> 4)) * 64 + ((2 * d2) & 31)) * 16 + 8 * (tb & 1)); unsigned char* Tb = Tf + 16384;
          *(GAS unsigned long long*)(Tf) = (unsigned long long)pk2(ktf0[0], ktf0[1]) | ((unsigned long long)pk2(ktf0[2], ktf0[3]) << 32);
          *(GAS unsigned long long*)(Tf + 512) = (unsigned long long)pk2(ktf0[4], ktf0[5]) | ((unsigned long long)pk2(ktf0[6], ktf0[7]) << 32);
          *(GAS unsigned long long*)(Tf + 16) = (unsigned long long)pk2(ktf1[0], ktf1[1]) | ((unsigned long long)pk2(ktf1[2], ktf1[3]) << 32);
          *(GAS unsigned long long*)(Tf + 528) = (unsigned long long)pk2(ktf1[4], ktf1[5]) | ((unsigned long long)pk2(ktf1[6], ktf1[7]) << 32);
          *(GAS unsigned long long*)(Tb) = (unsigned long long)pk2(ktb0[0], ktb0[1]) | ((unsigned long long)pk2(ktb0[2], ktb0[3]) << 32);
          *(GAS unsigned long long*)(Tb + 512) = (unsigned long long)pk2(ktb0[4], ktb0[5]) | ((unsigned long long)pk2(ktb0[6], ktb0[7]) << 32);
          *(GAS unsigned long long*)(Tb + 16) = (unsigned long long)pk2(ktb1[0], ktb1[1]) | ((unsigned long long)pk2(ktb1[2], ktb1[3]) << 32);
          *(GAS unsigned long long*)(Tb + 528) = (unsigned long long)pk2(ktb1[4], ktb1[5]) | ((unsigned long long)pk2(ktb1[6], ktb1[7]) << 32); }
        if (tb == 0) { float* DLp = (float*)(ws + WS_GDL) + itf * 128 + 2 * d2; *(GAS f32x2*)DLp = (f32x2){elf0, elf1}; *(GAS f32x2*)(DLp + 128) = (f32x2){elb0, elb1}; }
    }
}
struct G12Ops { bf16x8 a[4], b[4]; f32x4 d[4]; };
__device__ __forceinline__ void g12_load(G12Ops& o, unsigned char* ws, int bh, int dir, int m, int kb, int vb, int r, int hh) {
    const int n = dir ? (m < 4 ? 3 - m : 71 - m) : m; const size_t cn = (size_t)bh * 68 + n, item = cn * 2 + dir;
    const GAS bf16x8* ap = (const GAS bf16x8*)(ws + WS_GKT + item * 16384) + kb * 64 + (hh * 32 + r);
    const GAS bf16x8* bp = (const GAS bf16x8*)(ws + WS_GVT + cn * 32768) + vb * 64 + (hh * 32 + r);
    const float* dp = (const float*)(ws + WS_GDL) + item * 128 + 32 * kb + 4 * hh;
#pragma unroll
    for (int ks = 0; ks < 4; ++ks) { o.a[ks] = ap[ks * 256]; o.b[ks] = bp[ks * 512]; o.d[ks] = *(const GAS f32x4*)(dp + 8 * ks); }
}
__device__ __forceinline__ void phase_gla_g12(unsigned char* ws, LAS unsigned char* lds, int gwv, int wave, int lane) {
    if (gwv >= 2048) return;
    const int chain = gwv >> 5, blk = gwv & 31, kb = blk & 3, vb = blk >> 2, dir = chain & 1, bh = chain >> 1;
    const int r = lane & 31, hh = lane >> 5;
    LAS unsigned char* wl = lds + RING_OFF + wave * 2048;
    f32x16 acc;
#pragma unroll
    for (int g = 0; g < 16; ++g) acc[g] = 0.f;
    G12Ops o0, o1, o2;
    g12_load(o0, ws, bh, dir, 0, kb, vb, r, hh); g12_load(o1, ws, bh, dir, 1, kb, vb, r, hh);
#define G12_STEP(CUR, m_) do { const int mm_ = (m_); const int n = dir ? (mm_ < 4 ? 3 - mm_ : 71 - mm_) : mm_; \
        _Pragma("unroll") for (int gg = 0; gg < 4; ++gg) *(LAS unsigned long long*)(wl + (((gg >> 1) * 64 + (gg & 1) * 32 + r) * 16 + 8 * hh)) = (unsigned long long)pk2(acc[4 * gg], acc[4 * gg + 1]) | ((unsigned long long)pk2(acc[4 * gg + 2], acc[4 * gg + 3]) << 32); \
        LDS_WAIT(); const v4u s0 = *(const LAS v4u*)(wl + lane * 16), s1 = *(const LAS v4u*)(wl + 1024 + lane * 16); LDS_WAIT(); \
        { bf16* sp = (bf16*)(ws + WS_SX) + ((size_t)(bh * 2 + dir) * 68 + n) * 32768 + (size_t)(kb * 8 + vb) * 1024; ((GAS v4u*)sp)[lane] = s0; ((GAS v4u*)sp)[64 + lane] = s1; } \
        _Pragma("unroll") for (int gg = 0; gg < 4; ++gg) { acc[4 * gg] *= CUR.d[gg].x; acc[4 * gg + 1] *= CUR.d[gg].y; acc[4 * gg + 2] *= CUR.d[gg].z; acc[4 * gg + 3] *= CUR.d[gg].w; } \
        _Pragma("unroll") for (int ks = 0; ks < 4; ++ks) acc = __builtin_amdgcn_mfma_f32_32x32x16_bf16(CUR.a[ks], CUR.b[ks], acc, 0, 0, 0); } while (0)
    for (int m = 0; m < 66; m += 3) {
        g12_load(o2, ws, bh, dir, m + 2, kb, vb, r, hh); G12_STEP(o0, m);
        g12_load(o0, ws, bh, dir, m + 3, kb, vb, r, hh); G12_STEP(o1, m + 1);
        g12_load(o1, ws, bh, dir, (m + 4 < 68) ? m + 4 : 67, kb, vb, r, hh); G12_STEP(o2, m + 2);
    }
    G12_STEP(o0, 66); G12_STEP(o1, 67);
#undef G12_STEP
}
constexpr int G3_RS = 272, G3_TILE = 64 * G3_RS, G3_OL = 4 * G3_TILE  , G3_LD = 260;
static_assert(G3_OL + 64 * G3_LD * 4 <= MISC_OFF, "G3 LDS");
__device__ __forceinline__ void phase_gla_g3(unsigned char* ws, int lg, LAS unsigned char* lds, int tid) {
    const int lane = tid & 63, wave = __builtin_amdgcn_readfirstlane(tid >> 6), r = lane & 31, hh = lane >> 5, vb = wave;
    LAS unsigned char* TL = lds + RING_OFF; LAS float* OL = (LAS float*)(lds + RING_OFF + G3_OL);
    const bf16* G = (const bf16*)(ws + WS_G); bf16* OG = (bf16*)(ws + WS_Q);
    for (int cn = blockIdx.x; cn < 2176; cn += gridDim.x) {
        const int n = cn % 68, bh = cn / 68, h = bh & 3, b = bh >> 2;
        const GAS bf16x8* SxA = (const GAS bf16x8*)((const bf16*)(ws + WS_SX) + ((size_t)(bh * 2 + 0) * 68 + n) * 32768 + (size_t)vb * 1024) + lane;
        const GAS bf16x8* SxB = SxA + 68 * 4096;
        const GAS bf16x8* Vt = (const GAS bf16x8*)(ws + WS_GVT + (size_t)cn * 32768) + vb * 64 + lane;
        bf16x8 sA[8], sB[8], vf[4];
#pragma unroll
        for (int s = 0; s < 8; ++s) sA[s] = SxA[(s >> 1) * 1024 + (s & 1) * 64];
        v4u st[4][2];
#pragma unroll
        for (int tl = 0; tl < 4; ++tl) { const bf16* src = (const bf16*)(ws + ((tl & 1) ? WS_GKH : WS_GQ)) + ((size_t)cn * 2 + (tl >> 1)) * 8192;
#pragma unroll
            for (int j = 0; j < 2; ++j) st[tl][j] = ((const GAS v4u*)src)[tid + 512 * j]; }
        __syncthreads();
#pragma unroll
        for (int tl = 0; tl < 4; ++tl)
#pragma unroll
            for (int j = 0; j < 2; ++j) { const int q = tid + 512 * j, row = q >> 4, ch = q & 15; *(LAS v4u*)(TL + tl * G3_TILE + row * G3_RS + ch * 16) = st[tl][j]; }
        __syncthreads();
        f32x16 P00, P01, P10, P11, O0, O1;
#pragma unroll
        for (int g = 0; g < 16; ++g) { P00[g] = 0.f; P01[g] = 0.f; P10[g] = 0.f; P11[g] = 0.f; O0[g] = 0.f; O1[g] = 0.f; }
#pragma unroll
        for (int dir = 0; dir < 2; ++dir) {
            const LAS unsigned char* Qt = TL + (2 * dir) * G3_TILE + r * G3_RS + 16 * hh; const LAS unsigned char* Kh = TL + (2 * dir + 1) * G3_TILE + r * G3_RS + 16 * hh;
            if (dir == 0) {
#pragma unroll
                for (int s = 0; s < 8; ++s) sB[s] = SxB[(s >> 1) * 1024 + (s & 1) * 64];
            } else {
#pragma unroll
                for (int q = 0; q < 4; ++q) vf[q] = Vt[q * 512];
            }
            __builtin_amdgcn_sched_barrier(0);
            f32x16 X00, X11, Xoff;
#pragma unroll
            for (int g = 0; g < 16; ++g) { X00[g] = 0.f; X11[g] = 0.f; Xoff[g] = 0.f; }
#pragma unroll
            for (int s = 0; s < 8; ++s) {
                const bf16x8 q0 = *(const LAS bf16x8*)(Qt + 32 * s), q1 = *(const LAS bf16x8*)(Qt + 32 * G3_RS + 32 * s);
                const bf16x8 k0 = *(const LAS bf16x8*)(Kh + 32 * s), k1 = *(const LAS bf16x8*)(Kh + 32 * G3_RS + 32 * s);
                const bf16x8 sx = dir ? sB[s] : sA[s];
                X00 = __builtin_amdgcn_mfma_f32_32x32x16_bf16(k0, q0, X00, 0, 0, 0);
                X11 = __builtin_amdgcn_mfma_f32_32x32x16_bf16(k1, q1, X11, 0, 0, 0);
                if (dir == 0) Xoff = __builtin_amdgcn_mfma_f32_32x32x16_bf16(k0, q1, Xoff, 0, 0, 0); else Xoff = __builtin_amdgcn_mfma_f32_32x32x16_bf16(k1, q0, Xoff, 0, 0, 0);
                O0 = __builtin_amdgcn_mfma_f32_32x32x16_bf16(q0, sx, O0, 0, 0, 0); O1 = __builtin_amdgcn_mfma_f32_32x32x16_bf16(q1, sx, O1, 0, 0, 0); }
#pragma unroll
            for (int g = 0; g < 16; ++g) { const int tj = (g & 3) + 8 * (g >> 2) + 4 * hh; const bool keep = dir ? (tj >= r) : (tj <= r);
                P00[g] += keep ? X00[g] : 0.f; P11[g] += keep ? X11[g] : 0.f;
                if (dir == 0) P01[g] += Xoff[g]; else P10[g] += Xoff[g]; }
        }
        {
#pragma unroll
          for (int jb = 0; jb < 2; ++jb)
#pragma unroll
            for (int s2 = 0; s2 < 2; ++s2) { const bf16x8 bfv = vf[2 * jb + s2];
                const f32x16& Pa = jb ? P10 : P00; const f32x16& Pb = jb ? P11 : P01;
                const bf16x8 a0 = __builtin_bit_cast(bf16x8, ((v4u){pk2(Pa[8 * s2 + 0], Pa[8 * s2 + 1]), pk2(Pa[8 * s2 + 2], Pa[8 * s2 + 3]), pk2(Pa[8 * s2 + 4], Pa[8 * s2 + 5]), pk2(Pa[8 * s2 + 6], Pa[8 * s2 + 7])}));
                const bf16x8 a1 = __builtin_bit_cast(bf16x8, ((v4u){pk2(Pb[8 * s2 + 0], Pb[8 * s2 + 1]), pk2(Pb[8 * s2 + 2], Pb[8 * s2 + 3]), pk2(Pb[8 * s2 + 4], Pb[8 * s2 + 5]), pk2(Pb[8 * s2 + 6], Pb[8 * s2 + 7])}));
                O0 = __builtin_amdgcn_mfma_f32_32x32x16_bf16(a0, bfv, O0, 0, 0, 0); O1 = __builtin_amdgcn_mfma_f32_32x32x16_bf16(a1, bfv, O1, 0, 0, 0); } }
#pragma unroll
        for (int g = 0; g < 16; ++g) { const int t = (g & 3) + 8 * (g >> 2) + 4 * hh; OL[t * G3_LD + 32 * vb + r] = O0[g]; OL[(32 + t) * G3_LD + 32 * vb + r] = O1[g]; }
        __syncthreads();
        { const int t = tid >> 3, cc = tid & 7; const LAS f32x4* op = (const LAS f32x4*)(OL + t * G3_LD + 32 * cc);
          f32x4 o[8]; float ss = 0.f;
#pragma unroll
          for (int j = 0; j < 8; ++j) { o[j] = op[j]; ss += (o[j].x * o[j].x + o[j].y * o[j].y) + (o[j].z * o[j].z + o[j].w * o[j].w); }
          ss += __shfl_xor(ss, 1); ss += __shfl_xor(ss, 2); ss += __shfl_xor(ss, 4);
          const float rs = 1.0f / sqrtf(ss * (1.0f / 256.0f) + RMS_EPS);
          const size_t row = (size_t)b * TB + 64 * n + t;
          const GAS v4u* rp = (const GAS v4u*)(G + row * WINP + 2048 + h * 256 + 32 * cc); const GAS f32x4* gp = (const GAS f32x4*)(PARF(ws) + P_OG + lg * 256 + 32 * cc);
          GAS v4u* dst = (GAS v4u*)(OG + row * 1024 + h * 256 + 32 * cc);
#pragma unroll
          for (int j = 0; j < 4; ++j) { const v4u rv = rp[j]; const f32x4 g0 = gp[2 * j], g1 = gp[2 * j + 1]; const f32x4 a = o[2 * j] * rs * g0, c2 = o[2 * j + 1] * rs * g1;
              v4u w;
              w.x = pk2(a.x * silu_f(__uint_as_float(rv.x << 16)), a.y * silu_f(__uint_as_float(rv.x & 0xffff0000u)));
              w.y = pk2(a.z * silu_f(__uint_as_float(rv.y << 16)), a.w * silu_f(__uint_as_float(rv.y & 0xffff0000u)));
              w.z = pk2(c2.x * silu_f(__uint_as_float(rv.z << 16)), c2.y * silu_f(__uint_as_float(rv.z & 0xffff0000u)));
              w.w = pk2(c2.z * silu_f(__uint_as_float(rv.w << 16)), c2.w * silu_f(__uint_as_float(rv.w & 0xffff0000u)));
              dst[j] = w; } }
    }
}
constexpr int WIMG_RS = 2064;
static_assert(2 * 32 * WIMG_RS <= LDS_AUX, "router images below the aux tables");
__device__ __forceinline__ void phase_modulate2_route(unsigned char* ws, int layer, LAS unsigned char* lds, int vcu, int wave, int lane, int tid, bool dummy = false) {
    const bf16* X = (const bf16*)(ws + WS_X); bf16* XN = (bf16*)(ws + WS_XN);
    const float* ng = PARF(ws) + P_N2G + layer * 1024; const float* Mo = (const float*)(ws + WS_MOD) + (size_t)layer * MODROWS * NMODC;
    LAS unsigned char* WHI = lds + RING_OFF; LAS unsigned char* WLO = WHI + 32 * WIMG_RS;
    LAS unsigned* lcnt = (LAS unsigned*)(lds + AUX_LCNT); LAS unsigned* gb = (LAS unsigned*)(lds + AUX_GB); LAS unsigned* ent = (LAS unsigned*)(lds + AUX_ENT); LAS float* rsl = (LAS float*)(lds + AUX_RS);
    { const float* wsrc = PARF(ws) + P_WR + (size_t)layer * 1024 * 32;
      for (int idx = tid; idx < 1024 * 32; idx += NWAVES * 64) { const int k = idx >> 5, e = idx & 31; const float w = wsrc[idx]; const unsigned hi = f2bf(w), lo = f2bf(w - __uint_as_float(hi << 16));
          *(LAS unsigned short*)(WHI + e * WIMG_RS + 2 * k) = (unsigned short)hi; *(LAS unsigned short*)(WLO + e * WIMG_RS + 2 * k) = (unsigned short)lo; }
      if (tid < 32) lcnt[tid] = 0u; }
    gu32* cnt = (gu32*)(ws + WS_CTL) + CW_CNT + (layer + (dummy ? 4 : 0)) * 32 * 16;
    unsigned char* sbase = dummy ? ws + WS_XG : ws;
    const bool lastl = (layer == NLAYER - 1);
  for (int grp = vcu; grp < MT / 136; grp += (int)gridDim.x) {
    const int rbase = grp * 136;
    if (grp != vcu) { __syncthreads(); if (tid < 32) lcnt[tid] = 0u; }
    for (int rl = wave; rl < 136; rl += 2 * NWAVES) {
        const int rl2 = (rl + NWAVES < 136) ? rl + NWAVES : rl; const int m = rbase + rl, m2 = rbase + rl2, mr = mod_row(m), mr2 = mod_row(m2);
        float rs, rs2;
        modulate_row2<true>(X + (size_t)m * 1024, X + (size_t)m2 * 1024, ng, Mo + (size_t)mr * NMODC + 3 * 1024, Mo + (size_t)mr * NMODC + 4 * 1024, Mo + (size_t)mr2 * NMODC + 3 * 1024, Mo + (size_t)mr2 * NMODC + 4 * 1024,
                      ws + WS_XN8 + (size_t)m * 1024, ws + WS_XN8 + (size_t)m2 * 1024, lane, rs, rs2);
        if (lane == 0) { rsl[rl] = rs; rsl[rl2] = rs2; } }
    __syncthreads();
    if (wave < 5) {
        const int r = lane & 31, hh = lane >> 5; const int rl = (32 * wave + r < 136) ? 32 * wave + r : 135; const int m = rbase + rl, mr = mod_row(m);
        const float rsr = rsl[rl];
        const bf16* xp = X + (size_t)m * 1024 + 8 * hh; const float* gp = ng + 8 * hh; const float* scp = Mo + (size_t)mr * NMODC + 4 * 1024 + 8 * hh; const float* shp = Mo + (size_t)mr * NMODC + 3 * 1024 + 8 * hh;
        const LAS unsigned char* wh = WHI + r * WIMG_RS + 16 * hh; const LAS unsigned char* wl = WLO + r * WIMG_RS + 16 * hh;
        f32x16 acc;
#pragma unroll
        for (int g = 0; g < 16; ++g) acc[g] = 0.f;
#pragma unroll 2
        for (int s = 0; s < 64; ++s) {
            const v4u xr8 = *(const GAS v4u*)(xp + 16 * s); const f32x4 x0 = (f32x4){__uint_as_float(xr8.x << 16), __uint_as_float(xr8.x & 0xffff0000u), __uint_as_float(xr8.y << 16), __uint_as_float(xr8.y & 0xffff0000u)}, x1 = (f32x4){__uint_as_float(xr8.z << 16), __uint_as_float(xr8.z & 0xffff0000u), __uint_as_float(xr8.w << 16), __uint_as_float(xr8.w & 0xffff0000u)}; const f32x4 g0 = *(const GAS f32x4*)(gp + 16 * s), g1 = *(const GAS f32x4*)(gp + 16 * s + 4);
            const f32x4 c0 = *(const GAS f32x4*)(scp + 16 * s), c1 = *(const GAS f32x4*)(scp + 16 * s + 4), h0 = *(const GAS f32x4*)(shp + 16 * s), h1 = *(const GAS f32x4*)(shp + 16 * s + 4);
            const f32x4 y0 = (x0 * rsr) * g0 * (c0 + 1.0f) + h0, y1 = (x1 * rsr) * g1 * (c1 + 1.0f) + h1;
            v4u ph, pl;
            ph.x = pg8::cvt_pk_bf16(y0.x, y0.y); ph.y = pg8::cvt_pk_bf16(y0.z, y0.w); ph.z = pg8::cvt_pk_bf16(y1.x, y1.y); ph.w = pg8::cvt_pk_bf16(y1.z, y1.w);
            pl.x = pg8::cvt_pk_bf16(y0.x - __uint_as_float(ph.x << 16), y0.y - __uint_as_float(ph.x & 0xffff0000u)); pl.y = pg8::cvt_pk_bf16(y0.z - __uint_as_float(ph.y << 16), y0.w - __uint_as_float(ph.y & 0xffff0000u));
            pl.z = pg8::cvt_pk_bf16(y1.x - __uint_as_float(ph.z << 16), y1.y - __uint_as_float(ph.z & 0xffff0000u)); pl.w = pg8::cvt_pk_bf16(y1.z - __uint_as_float(ph.w << 16), y1.w - __uint_as_float(ph.w & 0xffff0000u));
            const bf16x8 ahi = __builtin_bit_cast(bf16x8, ph), alo = __builtin_bit_cast(bf16x8, pl);
            const bf16x8 bhi = *(const LAS bf16x8*)(wh + 32 * s), blo = *(const LAS bf16x8*)(wl + 32 * s);
            acc = __builtin_amdgcn_mfma_f32_32x32x16_bf16(ahi, bhi, acc, 0, 0, 0); acc = __builtin_amdgcn_mfma_f32_32x32x16_bf16(alo, bhi, acc, 0, 0, 0); acc = __builtin_amdgcn_mfma_f32_32x32x16_bf16(ahi, blo, acc, 0, 0, 0); }
        const float brt = (PARF(ws) + P_BR)[layer * 32 + r];
#pragma unroll
        for (int g = 0; g < 16; ++g) { const int rowl = 32 * wave + (g & 3) + 8 * (g >> 2) + 4 * hh;
            float v = acc[g] + brt; float tv[4]; int te[4];
#pragma unroll
            for (int k = 0; k < 4; ++k) { float mx = v;
#pragma unroll
                for (int o = 1; o < 32; o <<= 1) mx = fmaxf(mx, shx(mx, o, lane));
                const unsigned long long bm = __ballot(v == mx); const unsigned hm = hh ? (unsigned)(bm >> 32) : (unsigned)bm; const int first = __ffs((int)hm) - 1;
                te[k] = first; tv[k] = mx; if (r == first) v = -INFINITY; }
            const bool valid = rowl < 136 && !(lastl && mod_row(rbase + (rowl < 136 ? rowl : 135)) == 8);
            if (r == 0 && rowl < 136) {
                if (valid) { const float e1 = __expf(tv[1] - tv[0]), e2 = __expf(tv[2] - tv[0]), e3 = __expf(tv[3] - tv[0]); const float inv = 1.0f / (1.0f + e1 + e2 + e3);
                    const float wk[4] = {inv, e1 * inv, e2 * inv, e3 * inv};
#pragma unroll
                    for (int k = 0; k < 4; ++k) { const unsigned lp = atomicAdd((unsigned*)&lcnt[te[k]], 1u); ent[(rowl * 4 + k) * 2 + 0] = ((unsigned)te[k] << 24) | lp; ent[(rowl * 4 + k) * 2 + 1] = __float_as_uint(wk[k]); } }
                else {
#pragma unroll
                    for (int k = 0; k < 4; ++k) ent[(rowl * 4 + k) * 2 + 0] = 0xffffffffu; } } }
    }
    __syncthreads();
    if (tid < 32) gb[tid] = __hip_atomic_fetch_add(cnt + tid * 16, lcnt[tid], __ATOMIC_RELAXED, __HIP_MEMORY_SCOPE_AGENT);
    __syncthreads();
    for (int q = tid; q < 136 * 4; q += NWAVES * 64) { const unsigned pe = ent[q * 2 + 0];
        if (pe != 0xffffffffu) { const unsigned e = pe >> 24, lp = pe & 0xffffffu; const int m = rbase + (q >> 2);
            ((unsigned*)(sbase + WS_SLOT))[m * 4 + (q & 3)] = (e << 24) | (gb[e] + lp); ((unsigned*)(sbase + WS_GATEW))[m * 4 + (q & 3)] = ent[q * 2 + 1];
            if (!dummy) ((int*)(ws + WS_LIST))[(size_t)e * MT + gb[e] + lp] = m; } }
  }
}
__device__ __forceinline__ void build_expert_tables(unsigned char* ws, int layer, LAS unsigned char* lds, int tid) {
    LAS int* t2e = (LAS int*)(lds + AUX_T2E); LAS int* base = (LAS int*)(lds + AUX_BASE); LAS int* ntp = (LAS int*)(lds + AUX_NT); LAS int* cntl = (LAS int*)(lds + AUX_CNT);
    gu32* cnt = (gu32*)(ws + WS_CTL) + CW_CNT + layer * 32 * 16;
    __syncthreads();
    if (tid < 64) { const unsigned cval = (tid < 32) ? __hip_atomic_load(cnt + tid * 16, RLX_AGENT) : 0u; const int tiles = (int)((cval + 255u) >> 8);
        int pre = tiles;
#pragma unroll
        for (int o = 1; o < 32; o <<= 1) { const int ln = tid & 63; const int t = __builtin_amdgcn_ds_bpermute(((ln >= o) ? ln - o : ln) << 2, pre); if (ln >= o) pre += t; }
        const int start = pre - tiles;
        if (tid < 32) { base[tid] = start * 256; cntl[tid] = (int)cval; for (int t = 0; t < tiles; ++t) t2e[start + t] = tid; if (tid == 31) ntp[0] = pre; } }
    __syncthreads();
}
__device__ __forceinline__ void phase_moe_gather(unsigned char* ws, int layer, LAS unsigned char* lds, int gw, int NGW, int lane, int tid) {
    build_expert_tables(ws, layer, lds, tid);
    const LAS int* base = (const LAS int*)(lds + AUX_BASE);
    const bf16* XN = (const bf16*)(ws + WS_XN); bf16* XG = (bf16*)(ws + WS_XG);
    const unsigned* slot = (const unsigned*)(ws + WS_SLOT); unsigned* spos = (unsigned*)(ws + WS_SLOTPOS);
    for (int m = gw; m < MT; m += NGW) {
        if (layer == NLAYER - 1 && mod_row(m) == 8) continue;
        const GAS v4u* src = (const GAS v4u*)(XN + (size_t)m * 1024) + lane; const v4u a = src[0], b = src[64];
#pragma unroll
        for (int k = 0; k < 4; ++k) { const unsigned pe = slot[m * 4 + k]; const int dst = base[pe >> 24] + (int)(pe & 0xffffffu);
            GAS v4u* dp = (GAS v4u*)(XG + (size_t)dst * 1024) + lane; dp[0] = a; dp[64] = b;
            if (lane == 0) spos[m * 4 + k] = (unsigned)dst; }
    }
}
__device__ __forceinline__ void phase_moe_combine(unsigned char* ws, float* out, int layer, LAS unsigned char* lds, int gw, int NGW, int lane, int tid, bool dummy = false) {
    build_expert_tables(ws, layer, lds, tid);
    const LAS int* base = (const LAS int*)(lds + AUX_BASE);
    bf16* X = (bf16*)(ws + WS_X); const unsigned char* Y = ws + WS_Y;
    const float* Mo = (const float*)(ws + WS_MOD) + (size_t)layer * MODROWS * NMODC;
    const unsigned* slot = (const unsigned*)(ws + WS_SLOT); const float* gw4 = (const float*)(ws + WS_GATEW);
    for (int m0 = gw; m0 < MT; m0 += 2 * NGW) {
        int mm[2], bb[2], ww[2], mrr[2]; bool ok[2];
#pragma unroll
        for (int p = 0; p < 2; ++p) { const int m = m0 + p * NGW; ok[p] = m < MT; mm[p] = ok[p] ? m : m0; bb[p] = mm[p] / TB; ww[p] = mm[p] - bb[p] * TB; mrr[p] = (ww[p] < CTXL) ? 8 : bb[p];
            if (layer == NLAYER - 1 && ww[p] < CTXL) ok[p] = false; }
        if (!ok[0] && !ok[1]) continue;
        unsigned pe[2][4]; float wk[2][4];
#pragma unroll
        for (int p = 0; p < 2; ++p)
#pragma unroll
            for (int k = 0; k < 4; ++k) { pe[p][k] = slot[mm[p] * 4 + k]; wk[p][k] = gw4[mm[p] * 4 + k]; }
        unsigned long long xv[2][4];
#pragma unroll
        for (int p = 0; p < 2; ++p) { const GAS unsigned long long* xp = (const GAS unsigned long long*)(X + (size_t)mm[p] * 1024) + lane;
#pragma unroll
            for (int j = 0; j < 4; ++j) xv[p][j] = xp[64 * j]; }
        unsigned yv[2][4][4];
#pragma unroll
        for (int p = 0; p < 2; ++p)
#pragma unroll
            for (int k = 0; k < 4; ++k) { unsigned e = pe[p][k] >> 24; if (!ok[p] || e > 31u) e = 0u;
                const unsigned sp = ok[p] ? (unsigned)base[e] + (pe[p][k] & 0xffffffu) : 0u;
                const GAS unsigned* yp = (const GAS unsigned*)(Y + (size_t)sp * 1024) + lane;
#pragma unroll
                for (int j = 0; j < 4; ++j) yv[p][k][j] = yp[64 * j]; }
        f32x4 f[2][4]; float ss[2];
#pragma unroll
        for (int p = 0; p < 2; ++p) { const GAS f32x4* gp = (const GAS f32x4*)(Mo + (size_t)mrr[p] * NMODC + 5 * 1024) + lane;
            ss[p] = 0.f;
#pragma unroll
            for (int j = 0; j < 4; ++j) { f32x4 a = (f32x4){0.f, 0.f, 0.f, 0.f};
#pragma unroll
                for (int k = 0; k < 4; ++k) { const unsigned w8 = yv[p][k][j]; const f32x2 lo2 = __builtin_amdgcn_cvt_pk_f32_fp8((int)w8, false), hi2 = __builtin_amdgcn_cvt_pk_f32_fp8((int)w8, true); a = a + (f32x4){lo2.x, lo2.y, hi2.x, hi2.y} * wk[p][k]; }
                f[p][j] = bf4_to_f32(xv[p][j]) + gp[64 * j] * a; } }
        asm volatile("" ::: "memory");
        const bool fuse = (layer < NLAYER - 1) && !dummy;
        f32x4 pg[4], psh[2][4], psc[2][4];
        if (fuse) { const float* ng = PARF(ws) + P_N1G + (layer + 1) * 1024;
#pragma unroll
            for (int j = 0; j < 4; ++j) pg[j] = ((const GAS f32x4*)ng)[64 * j + lane];
#pragma unroll
            for (int p = 0; p < 2; ++p) { const float* Mn = (const float*)(ws + WS_MOD) + (size_t)(layer + 1) * MODROWS * NMODC + (size_t)mrr[p] * NMODC;
#pragma unroll
                for (int j = 0; j < 4; ++j) { psh[p][j] = ((const GAS f32x4*)Mn)[64 * j + lane]; psc[p][j] = ((const GAS f32x4*)(Mn + 1024))[64 * j + lane]; } } }
#pragma unroll
        for (int p = 0; p < 2; ++p) { if (!ok[p]) continue;
            GAS unsigned long long* xp = (GAS unsigned long long*)(X + (size_t)mm[p] * 1024) + lane;
            GAS f32x4* op = (GAS f32x4*)(out + ((size_t)bb[p] * SEQ + (ww[p] - CTXL)) * 1024) + lane;
#pragma unroll
            for (int j = 0; j < 4; ++j) { if (dummy) ((GAS f32x4*)((float*)(ws + WS_XG) + (size_t)mm[p] * 1024) + lane)[64 * j] = f[p][j]; else if (layer == NLAYER - 1) op[64 * j] = f[p][j]; else { const unsigned long long pk = f32_to_bf4(f[p][j]); xp[64 * j] = pk; f[p][j] = bf4_to_f32(pk); }
                ss[p] += (f[p][j].x * f[p][j].x + f[p][j].y * f[p][j].y) + (f[p][j].z * f[p][j].z + f[p][j].w * f[p][j].w); } }
        if (fuse) { float s0 = ss[0], s1 = ss[1]; const int ln = lane_now();
#pragma unroll
            for (int o = 1; o < 64; o <<= 1) { s0 += shx(s0, o, ln); s1 += shx(s1, o, ln); }
            const float rsv[2] = {1.0f / sqrtf(s0 * (1.0f / 1024.0f) + RMS_EPS), 1.0f / sqrtf(s1 * (1.0f / 1024.0f) + RMS_EPS)};
#pragma unroll
            for (int p = 0; p < 2; ++p) { if (!ok[p]) continue;
                GAS unsigned long long* o8 = (GAS unsigned long long*)((bf16*)(ws + WS_XN) + (size_t)mm[p] * 1024) + lane;
#pragma unroll
                for (int j = 0; j < 4; ++j) o8[64 * j] = f32_to_bf4((f[p][j] * rsv[p]) * pg[j] * (psc[p][j] + 1.0f) + psh[p][j]); } }
    }
}

constexpr int NPH_L = 11, NPHASE = 2 + NPH_L * NLAYER;
#ifndef PHMASK
#define PHMASK 0x7fff
#endif
#define EN(b) ((PHMASK >> (b)) & 1)
#ifndef DUPMASK
#define DUPMASK 0
#endif
#define DUP(b) for (int rep_ = 0; rep_ < (((DUPMASK >> (b)) & 1) ? 2 : 1); ++rep_)
__global__ void __launch_bounds__(NWAVES * 64, 2) dit_fwd(Args args) {
    extern __shared__ __attribute__((aligned(16))) unsigned char lds_raw[];
    LAS unsigned char* lds = (LAS unsigned char*)lds_raw;
    volatile LAS unsigned* MISC = (volatile LAS unsigned*)(lds + MISC_OFF);
    const int G = gridDim.x, bx = blockIdx.x;
    const int vcu = (G % 8 == 0) ? (bx % 8) * (G / 8) + bx / 8 : bx;
    const int wave0 = __builtin_amdgcn_readfirstlane((int)threadIdx.x >> 6);
#define LANE_ID(z) ((int)__builtin_amdgcn_mbcnt_hi(~0u, __builtin_amdgcn_mbcnt_lo(~0u, (z))))
    { const int t0 = (wave0 << 6) | LANE_ID(0u); for (int u = t0; u < (LDS_BYTES - MISC_OFF) / 4; u += NWAVES * 64) ((LAS unsigned*)(lds + MISC_OFF))[u] = 0u; }
    __syncthreads();
    const int lo = args.ph_lo, hi = args.ph_hi;
    XcdBarrier bar; bar.bar = (unsigned*)(args.ws + WS_CTL) + CW_BAR; bar.x = 0; bar.st = nullptr;
    if (hi - lo > 1) bar = xcd_barrier_post((unsigned*)(args.ws + WS_CTL) + CW_BAR, MISC + 8, wave0 == 0 && LANE_ID(0u) == 0);
#define IN(k) (lo <= (k) && (k) < hi)
#define SEAM(k) do { if (IN(k) && IN((k) + 1)) { XcdBarrier b_ = bar; unsigned zb_ = 0u; LAUNDER_S(zb_); b_.bar = bar.bar + zb_; xcd_barrier(b_, wave0 == 0 && LANE_ID(zb_) == 0); } } while (0)
#define PHASE_IDS() unsigned zoff_ = 0u; LAUNDER_S(zoff_); int tid = (wave0 << 6) | LANE_ID(zoff_); LAUNDER_V(tid); const int lane = tid & 63, wave = __builtin_amdgcn_readfirstlane(tid >> 6); const int gw = vcu * NWAVES + wave, NGW = G * NWAVES; \
    unsigned char* ws = args.ws + zoff_; const int Gp = G + (int)zoff_, bxp = bx + (int)zoff_; (void)lane; (void)gw; (void)NGW; (void)Gp; (void)bxp;

    if (EN(0) && IN(0)) DUP(0) { PHASE_IDS(); p0_prologue(args, lds, gw, NGW, wave, lane); } SEAM(0);
    if (EN(1) && IN(1)) { PHASE_IDS(); p1_mod_reduce(args, gw * 64 + lane, NGW * 64); } SEAM(1);

    for (int layer = 0; layer < NLAYER; ++layer) {
        const int pb = 2 + NPH_L * layer, lh = layer >> 1;
        if (layer == 0) { if (EN(2) && IN(pb + 0)) DUP(2) { PHASE_IDS(); phase_modulate1(ws, layer, gw, NGW, lane); } SEAM(pb + 0); }
        if ((layer & 1) == 0) {
            if (EN(3) && IN(pb + 1)) DUP(3) {
                PHASE_IDS();
                pg8::Gemm g{(const pg8::bf16_t*)(ws + WS_XN), (const pg8::bf16_t*)(ws + WS_WQKV) + (size_t)lh * QKVN * 1024, MT, QKVN, 1024, 0};
                pg8::StaticOrder S; S.init(MT, QKVN, Gp, bxp);
                LAS float* gl = (LAS float*)(lds + AUX_RS);
                if (tid < 128) gl[tid] = (PARF(ws) + (tid < 64 ? P_QG : P_KG - 64) + lh * 64)[tid];
                __syncthreads();
                pg8::EpiQKV E{ws, WS_Q, WS_K - WS_Q, WS_V - WS_K, gl, (const float*)(ws + WS_ROPE), ATT_C2};
                pg8::gemm_phase<pg8::EpiQKV, pg8::StaticOrder, true, true>(lds + RING_OFF, g, S, E, tid);
            } SEAM(pb + 1);
            if (EN(5) && IN(pb + 3)) DUP(5) {
                PHASE_IDS();
                const attn_body::bf16* Qp = (const attn_body::bf16*)(ws + WS_Q); const attn_body::bf16* Kp = (const attn_body::bf16*)(ws + WS_K); const attn_body::bf16* Vp = (const attn_body::bf16*)(ws + WS_V);
                attn_body::bf16* Op = (attn_body::bf16*)(ws + WS_XN);
                if (G == 256) {
                    for (int i = 0; i < 9; ++i) {
                        long qrow0, kvrow0; int NT, h;
                        if (i < 8) { const int x = vcu >> 5, j = vcu & 31, pair = 4 * x + (i >> 1), wi = (i & 1) * 32 + j, hq = wi >> 4, qb = wi & 15, b = pair >> 2, hk = pair & 3;
                            h = hk * 4 + hq; qrow0 = (long)b * TB + CTXL + qb * 256; kvrow0 = (long)b * TB; NT = TB / 64; }
                        else { if (vcu >= 128) break; const int b = vcu >> 4; h = vcu & 15; qrow0 = (long)b * TB; kvrow0 = qrow0; NT = CTXL / 64; }
                        attn_body::attn_unit<8>(qrow0, kvrow0, NT, h, Qp, Kp, Vp, Op, (char*)lds_raw + RING_OFF, tid);
                    }
                } else {
                    for (int U = bx; U < 2048 + 128; U += G) {
                        long qrow0, kvrow0; int NT, h;
                        if (U < 2048) { const int pair = U >> 6, wi = U & 63, hq = wi >> 4, qb = wi & 15, b = pair >> 2, hk = pair & 3; h = hk * 4 + hq; qrow0 = (long)b * TB + CTXL + qb * 256; kvrow0 = (long)b * TB; NT = TB / 64; }
                        else { const int v = U - 2048, b = v >> 4; h = v & 15; qrow0 = (long)b * TB; kvrow0 = qrow0; NT = CTXL / 64; }
                        attn_body::attn_unit<8>(qrow0, kvrow0, NT, h, Qp, Kp, Vp, Op, (char*)lds_raw + RING_OFF, tid);
                    }
                }
            } SEAM(pb + 3);
        } else {
            if (EN(6) && IN(pb + 1)) DUP(6) {
                PHASE_IDS();
                pg8::Gemm g{(const pg8::bf16_t*)(ws + WS_XN), (const pg8::bf16_t*)(ws + WS_WIN) + (size_t)lh * WINP * 1024, MT, WINP, 1024, 0};
                pg8::StaticOrder S; S.init(MT, WINP, Gp, bxp);
                pg8::EpiBf16 E{(pg8::bf16_t*)(ws + WS_G), WINP};
                pg8::gemm_phase<pg8::EpiBf16, pg8::StaticOrder, true, true>(lds + RING_OFF, g, S, E, tid);
            } SEAM(pb + 1);
            if (EN(7) && IN(pb + 2)) DUP(7) { { PHASE_IDS(); phase_gla_g0v(ws, tid, Gp, bxp); } { PHASE_IDS(); phase_gla_g0(ws, lh, lds, tid, Gp, bxp); } } SEAM(pb + 2);
            if (EN(8) && IN(pb + 3)) DUP(8) { PHASE_IDS(); phase_gla_g12(ws, lds, gw, wave, lane); } SEAM(pb + 3);
            if (EN(8) && IN(pb + 4)) DUP(9) { PHASE_IDS(); phase_gla_g3(ws, lh, lds, tid); } SEAM(pb + 4);
        }
        if (EN(9) && IN(pb + 5)) {
            PHASE_IDS();
            const pg8::bf16_t* Wt = (layer & 1) ? (const pg8::bf16_t*)(ws + WS_WOG) + (size_t)lh * 1024 * 1024 : (const pg8::bf16_t*)(ws + WS_WOA) + (size_t)lh * 1024 * 1024;
            pg8::Gemm g{(const pg8::bf16_t*)(ws + ((layer & 1) ? WS_Q : WS_XN)), Wt, MT, 1024, 1024, 0};
            pg8::StaticOrder S; if (layer == NLAYER - 1) S.init(NB * SEQ, 1024, Gp, bxp, true); else S.init(MT, 1024, Gp, bxp);
            pg8::EpiResGate E{(pg8::bf16_t*)(ws + WS_X), (const float*)(ws + WS_MOD) + (size_t)layer * MODROWS * NMODC + 2 * 1024};
            pg8::gemm_phase<pg8::EpiResGate, pg8::StaticOrder, true, true>(lds + RING_OFF, g, S, E, tid);
        } SEAM(pb + 5);
        if (EN(10) && IN(pb + 6)) { if ((DUPMASK >> 10) & 1) { PHASE_IDS(); phase_modulate2_route(ws, layer, lds, vcu, wave, lane, tid, true); __syncthreads(); } PHASE_IDS(); phase_modulate2_route(ws, layer, lds, vcu, wave, lane, tid); } SEAM(pb + 6);
        if (EN(12) && IN(pb + 8)) DUP(12) {
            PHASE_IDS();
            build_expert_tables(ws, layer, lds, tid);
            const int nT = __builtin_amdgcn_readfirstlane(((const LAS int*)(lds + AUX_NT))[0]);
            pg8::MoeOrder S{nT, 8, Gp, bxp, (const LAS int*)(lds + AUX_T2E)};
            LAS unsigned short* rowtab = (LAS unsigned short*)(lds + AUX_ROWTAB);
            { const LAS int* base = (const LAS int*)(lds + AUX_BASE); const LAS int* cntl = (const LAS int*)(lds + AUX_CNT); const int* LIST = (const int*)(ws + WS_LIST);
              pg8::Unit u;
              int rv[ROWTAB_UNITS];
#pragma unroll
              for (int i = 0; i < ROWTAB_UNITS; ++i) { const bool ok = S.next(i, u); const int e = ok ? u.e : 0, pos = ok ? (u.pm - (base[e] >> 8)) * 256 + (tid & 255) : 0;
                  rv[i] = (ok && pos < cntl[e]) ? LIST[(size_t)e * MT + pos] : 0; }
#pragma unroll
              for (int i = 0; i < ROWTAB_UNITS; ++i) if (tid < 256) rowtab[i * 256 + tid] = (unsigned short)rv[i];
              __syncthreads(); }
            pg8::Gemm g{(const pg8::bf16_t*)(ws + WS_XN8), (const pg8::bf16_t*)(ws + WS_WGU + (size_t)layer * 32 * 2048 * 1024), MPAD, 2048, 512, (size_t)2048 * 1024, rowtab};
            pg8::EpiSwiGLU8 E{ws + WS_ACT, PARF(ws) + P_BGU + (size_t)layer * 32 * 2048, 1.0f / 32.0f};
            pg8::gemm_phase<pg8::EpiSwiGLU8, pg8::MoeOrder, true, true, true, true>(lds + RING_OFF, g, S, E, tid);
        } SEAM(pb + 8);
        if (EN(13) && IN(pb + 9)) DUP(13) {
            PHASE_IDS();
            build_expert_tables(ws, layer, lds, tid);
            const int nT = __builtin_amdgcn_readfirstlane(((const LAS int*)(lds + AUX_NT))[0]);
            pg8::Gemm g{(const pg8::bf16_t*)(ws + WS_ACT), (const pg8::bf16_t*)(ws + WS_WDN + (size_t)layer * 32 * 1024 * 1024), MPAD, 1024, 512, (size_t)1024 * 1024};
            pg8::MoeOrder S{nT, 4, Gp, bxp, (const LAS int*)(lds + AUX_T2E)};
            pg8::EpiBiasF8 E{ws + WS_Y, PARF(ws) + P_BDN + (size_t)layer * 32 * 1024, 1.0f / 32.0f};
            pg8::gemm_phase<pg8::EpiBiasF8, pg8::MoeOrder, true, true, false, true>(lds + RING_OFF, g, S, E, tid);
        } SEAM(pb + 9);
        if (EN(14) && IN(pb + 10)) { if ((DUPMASK >> 14) & 1) { PHASE_IDS(); phase_moe_combine(ws, args.out, layer, lds, gw, NGW, lane, tid, true); } PHASE_IDS(); phase_moe_combine(ws, args.out, layer, lds, gw, NGW, lane, tid); } SEAM(pb + 10);
    }
#undef IN
#undef EN
#undef DUP
#undef SEAM
#undef PHASE_IDS
#undef LANE_ID
}

extern "C" void kernel_launch(void* const* d_in, const int* in_sizes, int n_in, void* d_out, int out_size, void* d_ws, size_t ws_size, hipStream_t stream) {
    static int grid = 0;
    if (grid == 0) {
        if (n_in != 25 || out_size != NB * SEQ * DMODEL || ws_size < WS_END) { fprintf(stderr, "kernel_launch: unexpected shapes: n_in %d out %d ws %zu (need >= %zu)\n", n_in, out_size, ws_size, (size_t)WS_END); grid = -1; return; }
        int dev = 0, cus = 0, per_cu = 0;
        if (hipGetDevice(&dev) != hipSuccess || hipDeviceGetAttribute(&cus, hipDeviceAttributeMultiprocessorCount, dev) != hipSuccess) { grid = -1; return; }
        if (hipFuncSetAttribute((const void*)dit_fwd, hipFuncAttributeMaxDynamicSharedMemorySize, LDS_BYTES) != hipSuccess) { fprintf(stderr, "kernel_launch: hipFuncSetAttribute failed\n"); grid = -1; return; }
        if (hipOccupancyMaxActiveBlocksPerMultiprocessor(&per_cu, (const void*)dit_fwd, NWAVES * 64, LDS_BYTES) != hipSuccess || per_cu < 1) fprintf(stderr, "kernel_launch: occupancy query reports %d\n", per_cu);
        (void)hipGetLastError();
        grid = cus;
    }
    if (grid < 0) return;
    if (hipMemsetAsync((char*)d_ws + WS_CTL, 0, CTL_ZERO_BYTES, stream) != hipSuccess) { fprintf(stderr, "kernel_launch: memset failed\n"); return; }
    Args a{};
    for (int i = 0; i < 25; ++i) a.in[i] = (const float*)d_in[i];
    a.out = (float*)d_out; a.ws = (unsigned char*)d_ws;
#if MK_ONE_LAUNCH
    a.ph_lo = 0; a.ph_hi = NPHASE;
    hipLaunchKernelGGL(dit_fwd, dim3(grid), dim3(NWAVES * 64), LDS_BYTES, stream, a);
#else
    for (int p = 0; p < NPHASE; ++p) { a.ph_lo = p; a.ph_hi = p + 1; hipLaunchKernelGGL(dit_fwd, dim3(grid), dim3(NWAVES * 64), LDS_BYTES, stream, a); }
#endif
    const hipError_t le = hipPeekAtLastError();
    if (le != hipSuccess) fprintf(stderr, "kernel_launch: launch failed: %s\n", hipGetErrorName(le));
}
```

```cpp
#include <hip/hip_runtime.h>
#include <hip/hip_bf16.h>
#include <cstdio>
#include <cstdint>
#include <cmath>

#ifndef MK_ONE_LAUNCH
#define MK_ONE_LAUNCH 1
#endif

namespace pg8 {
#define PG8_LAS __attribute__((address_space(3)))
typedef unsigned short bf16_t;
typedef short bf16x8 __attribute__((ext_vector_type(8)));
typedef float f32x4 __attribute__((ext_vector_type(4)));
typedef unsigned u32x4 __attribute__((ext_vector_type(4)));
constexpr int BM = 256, BK = 64, HALF = 128, HTB = HALF * BK * 2  , STAGE_BYTES = 8 * HTB, NXCD = 8, WGM = 8;

__host__ __device__ __forceinline__ int lds_byte(int r, int c) { const int st = (r >> 4) * 2 + (c >> 5), rr = r & 15, cc = c & 31, ob = rr * 64 + cc * 2; return st * 1024 + (ob ^ (((ob >> 9) & 1) << 5)); }
__host__ __device__ __forceinline__ void stage_rc(int b, int& R, int& C) { const int st = b / 1024, sb = b % 1024, swz = sb ^ (((sb >> 9) & 1) << 5); R = (st >> 1) * 16 + swz / 64; C = (st & 1) * 32 + (swz % 64) / 2; }
__host__ __device__ __forceinline__ int perm32(int rho) { const int n = rho >> 4, i = rho & 15; return 8 * (i >> 2) + 4 * n + (i & 3); }

struct Unit { int pm, pn, e; };
struct Gemm { const bf16_t* A; const bf16_t* Bt; int M, N, K; size_t bstride; const PG8_LAS unsigned short* rowtab; };

struct StaticOrder {
    int nM, nN, nwg, G, c; bool latent_only;
    __host__ __device__ __forceinline__ void init(int M, int N, int G_, int c_, bool lat_ = false) { nM = M / BM; nN = N / BM; nwg = nM * nN; G = G_; c = c_; latent_only = lat_; }
    __host__ __device__ __forceinline__ bool next(int i, Unit& u) const {
        const long L = (long)i * G + c; if (L >= nwg) return false;
        int wgid = (int)L; { const int q = nwg / NXCD, r = nwg % NXCD, xcd = wgid % NXCD, off = wgid / NXCD; wgid = (xcd < r ? xcd * (q + 1) : r * (q + 1) + (xcd - r) * q) + off; }
        const int nig = WGM * nN, gid = wgid / nig, fm = gid * WGM, gsz = (nM - fm) < WGM ? (nM - fm) : WGM;
        u.pm = fm + ((wgid % nig) % gsz); u.pn = (wgid % nig) / gsz; u.e = 0;
        if (latent_only) u.pm = (u.pm >> 4) * 17 + 1 + (u.pm & 15);
        return true;
    }
    __device__ __forceinline__ void a_ready(const Unit&) const {}
    __device__ __forceinline__ void done(const Unit&) const {}
};
struct MoeOrder {
    int nT, nN, G, c; const PG8_LAS int* t2e;
    __device__ __forceinline__ bool next(int i, Unit& u) const {
        const int x = c & 7, j = c >> 3, per = 32 / nN, mt = (i * (G >> 5) + x) * per + j / nN; if (mt >= nT) return false;
        u.pm = mt; u.pn = j % nN; u.e = __builtin_amdgcn_readfirstlane(t2e[mt]); return true;
    }
    __device__ __forceinline__ void a_ready(const Unit&) const {}
    __device__ __forceinline__ void done(const Unit&) const {}
};

__device__ __forceinline__ int lane_now() { unsigned z; asm volatile("s_mov_b32 %0, 0" : "=s"(z)); return (int)__builtin_amdgcn_mbcnt_hi(~0u, __builtin_amdgcn_mbcnt_lo(~0u, z)); }
__device__ __forceinline__ float shx(float v, int m, int ln) { return __int_as_float(__builtin_amdgcn_ds_bpermute((ln ^ m) << 2, __float_as_int(v))); }
__device__ __forceinline__ unsigned pk4_fp8(float a, float b, float c, float d) { int w = 0; w = __builtin_amdgcn_cvt_pk_fp8_f32(a, b, w, false); w = __builtin_amdgcn_cvt_pk_fp8_f32(c, d, w, true); return (unsigned)w; }
__device__ __forceinline__ unsigned cvt_pk_bf16(float lo, float hi) { unsigned r; asm volatile("v_cvt_pk_bf16_f32 %0, %1, %2" : "=v"(r) : "v"(lo), "v"(hi)); return r; }

struct EpiBf16 {
    static constexpr bool PERM = true, AFTER_DRAIN = false;
    bf16_t* O; int ldc;
    __device__ __forceinline__ void operator()(const f32x4 (&acc)[2][2][4][2], const Unit& u, int wr, int wc, int fr, int fq) const {
        const int row0 = u.pm * BM + wr * 64 + fr; const int col0 = u.pn * BM + wc * 32 + 8 * fq;
#pragma unroll
        for (int ai = 0; ai < 2; ++ai)
#pragma unroll
            for (int m = 0; m < 4; ++m) { bf16_t* rowp = O + (size_t)(row0 + ai * HALF + m * 16) * ldc + col0;
#pragma unroll
                for (int bj = 0; bj < 2; ++bj) { const f32x4 v0 = acc[ai][bj][m][0], v1 = acc[ai][bj][m][1];
                    u32x4 w; w.x = cvt_pk_bf16(v0[0], v0[1]); w.y = cvt_pk_bf16(v0[2], v0[3]); w.z = cvt_pk_bf16(v1[0], v1[1]); w.w = cvt_pk_bf16(v1[2], v1[3]);
                    *(u32x4*)(rowp + bj * HALF) = w; } }
    }
};
struct EpiQKV {
    static constexpr bool PERM = true, AFTER_DRAIN = false;
    unsigned char* wsb; size_t offQ, dK, dV;
    const PG8_LAS float* gl; const float* ropec; float c2;
    __device__ __forceinline__ void operator()(const f32x4 (&acc)[2][2][4][2], const Unit& u, int wr, int wc, int fr, int fq) const {
        const int isk = (u.pn >= 4) ? 1 : 0, isv = (u.pn >= 5) ? 1 : 0;
        bf16_t* base = (bf16_t*)(wsb + offQ + (size_t)isk * dK + (size_t)isv * dV); const int ldc = isk ? 256 : 1024;
        const int hcol = (isk ? wc : (u.pn * 4 + wc)) * 64 + 8 * fq;
        const int pmb = u.pm / 17, pml = u.pm - pmb * 17; const bool lat = pml != 0;
        const PG8_LAS float* gp = gl + (isk ? 64 : 0) + 8 * fq; const float scl = isk ? 1.0f : c2;
#pragma unroll
        for (int ai = 0; ai < 2; ++ai)
#pragma unroll
            for (int m = 0; m < 4; ++m) { const int rl = ai * HALF + wr * 64 + m * 16 + fr; const size_t row = (size_t)u.pm * BM + rl;
                f32x4 v[2][2]; float ss = 0.f;
#pragma unroll
                for (int bj = 0; bj < 2; ++bj)
#pragma unroll
                    for (int n = 0; n < 2; ++n) { v[bj][n] = acc[ai][bj][m][n]; ss += (v[bj][n][0] * v[bj][n][0] + v[bj][n][1] * v[bj][n][1]) + (v[bj][n][2] * v[bj][n][2] + v[bj][n][3] * v[bj][n][3]); }
                if (!isv) { const int ln = lane_now(); ss += shx(ss, 16, ln); ss += shx(ss, 32, ln);
                    const float rs = 1.0f / sqrtf(ss * (1.0f / 64.0f) + 1e-6f);
                    const int spos = (pml - 1) * 256 + rl;
#pragma unroll
                    for (int bj = 0; bj < 2; ++bj) { f32x4 cs = (f32x4){1.f, 1.f, 1.f, 1.f}, sn = (f32x4){0.f, 0.f, 0.f, 0.f};
                        if (lat) { const float* cp = ropec + (size_t)spos * 32 + 16 * bj + 4 * fq; cs = *(const f32x4*)cp; sn = *(const f32x4*)(cp + 4096 * 32); }
#pragma unroll
                        for (int n = 0; n < 2; ++n) { const f32x4 y = v[bj][n] * rs * *(const PG8_LAS f32x4*)(gp + 32 * bj + 4 * n);
                            const float c0 = cs[2 * n], s0 = sn[2 * n], c1 = cs[2 * n + 1], s1 = sn[2 * n + 1];
                            v[bj][n] = (f32x4){(y[0] * c0 - y[1] * s0) * scl, (y[0] * s0 + y[1] * c0) * scl, (y[2] * c1 - y[3] * s1) * scl, (y[2] * s1 + y[3] * c1) * scl}; } } }
                bf16_t* rowp = base + row * ldc + hcol;
#pragma unroll
                for (int bj = 0; bj < 2; ++bj) { u32x4 w; w.x = cvt_pk_bf16(v[bj][0][0], v[bj][0][1]); w.y = cvt_pk_bf16(v[bj][0][2], v[bj][0][3]); w.z = cvt_pk_bf16(v[bj][1][0], v[bj][1][1]); w.w = cvt_pk_bf16(v[bj][1][2], v[bj][1][3]);
                    *(u32x4*)(rowp + 32 * bj) = w; } }
    }
};
struct EpiBiasF8 {
    static constexpr bool PERM = true, AFTER_DRAIN = false;
    unsigned char* O; const float* bias; float ascale;
    __device__ __forceinline__ void operator()(const f32x4 (&acc)[2][2][4][2], const Unit& u, int wr, int wc, int fr, int fq) const {
        const int row0 = u.pm * BM + wr * 64 + fr; const int col0 = u.pn * BM + wc * 32 + 8 * fq;
        const float* bp = bias + (size_t)u.e * 1024 + col0;
        f32x4 bv[2][2];
#pragma unroll
        for (int bj = 0; bj < 2; ++bj)
#pragma unroll
            for (int n = 0; n < 2; ++n) bv[bj][n] = *(const f32x4*)(bp + bj * HALF + 4 * n);
#pragma unroll
        for (int ai = 0; ai < 2; ++ai)
#pragma unroll
            for (int m = 0; m < 4; ++m) { unsigned char* rowp = O + (size_t)(row0 + ai * HALF + m * 16) * 1024 + col0;
#pragma unroll
                for (int bj = 0; bj < 2; ++bj) { const f32x4 v0 = acc[ai][bj][m][0] * ascale + bv[bj][0], v1 = acc[ai][bj][m][1] * ascale + bv[bj][1];
                    *(unsigned long long*)(rowp + bj * HALF) = (unsigned long long)pk4_fp8(v0[0], v0[1], v0[2], v0[3]) | ((unsigned long long)pk4_fp8(v1[0], v1[1], v1[2], v1[3]) << 32); } }
    }
};
struct EpiResGate {
    static constexpr bool PERM = false, AFTER_DRAIN = false;
    bf16_t* X; const float* gate;
    __device__ __forceinline__ void operator()(const f32x4 (&acc)[2][2][4][2], const Unit& u, int wr, int wc, int fr, int fq) const {
        const int row0 = u.pm * BM + wr * 64 + fr; const int col0 = u.pn * BM + wc * 32 + 4 * fq;
        const int bb = u.pm / 17, mr = (u.pm - bb * 17 == 0) ? 8 : bb;
        const float* gp = gate + (size_t)mr * 6144 + col0;
        f32x4 gv[2][2];
#pragma unroll
        for (int bj = 0; bj < 2; ++bj)
#pragma unroll
            for (int n = 0; n < 2; ++n) gv[bj][n] = *(const f32x4*)(gp + bj * HALF + n * 16);
#pragma unroll
        for (int ai = 0; ai < 2; ++ai)
#pragma unroll
            for (int m = 0; m < 4; ++m) { bf16_t* rowp = X + (size_t)(row0 + ai * HALF + m * 16) * 1024 + col0;
#pragma unroll
                for (int bj = 0; bj < 2; ++bj)
#pragma unroll
                    for (int n = 0; n < 2; ++n) { unsigned long long* p = (unsigned long long*)(rowp + bj * HALF + n * 16); const unsigned long long v = *p;
                        f32x4 x = (f32x4){__uint_as_float((unsigned)(v & 0xffffu) << 16), __uint_as_float((unsigned)(v >> 16) << 16), __uint_as_float((unsigned)((v >> 32) & 0xffffu) << 16), __uint_as_float((unsigned)(v >> 48) << 16)};
                        x = x + gv[bj][n] * acc[ai][bj][m][n];
                        *p = (unsigned long long)cvt_pk_bf16(x[0], x[1]) | ((unsigned long long)cvt_pk_bf16(x[2], x[3]) << 32); } }
    }
};
struct EpiSwiGLU {
    static constexpr bool PERM = true, AFTER_DRAIN = false;
    bf16_t* O; const float* bias;
    __device__ __forceinline__ void operator()(const f32x4 (&acc)[2][2][4][2], const Unit& u, int wr, int wc, int fr, int fq) const {
        const int row0 = u.pm * BM + wr * 64 + fr; const int col0 = u.pn * HALF + wc * 32 + 8 * fq;
        const float* bp = bias + (size_t)u.e * 2048 + col0;
        f32x4 bg[2], bu[2];
#pragma unroll
        for (int n = 0; n < 2; ++n) { bg[n] = *(const f32x4*)(bp + 4 * n); bu[n] = *(const f32x4*)(bp + 1024 + 4 * n); }
#pragma unroll
        for (int ai = 0; ai < 2; ++ai)
#pragma unroll
            for (int m = 0; m < 4; ++m) { bf16_t* rowp = O + (size_t)(row0 + ai * HALF + m * 16) * 1024 + col0;
                float r[8];
#pragma unroll
                for (int n = 0; n < 2; ++n) { const f32x4 gt = acc[ai][0][m][n] + bg[n], up = acc[ai][1][m][n] + bu[n];
#pragma unroll
                    for (int i = 0; i < 4; ++i) { const float g = fminf(gt[i], 7.0f), uu = fminf(fmaxf(up[i], -7.0f), 7.0f);
                        const float sg = __builtin_amdgcn_rcpf(1.0f + __builtin_amdgcn_exp2f(-1.702f * 1.4426950408889634f * g));
                        r[4 * n + i] = (uu + 1.0f) * (g * sg); } }
                u32x4 w; w.x = cvt_pk_bf16(r[0], r[1]); w.y = cvt_pk_bf16(r[2], r[3]); w.z = cvt_pk_bf16(r[4], r[5]); w.w = cvt_pk_bf16(r[6], r[7]);
                *(u32x4*)rowp = w; }
    }
};
struct EpiSwiGLU8 {
    static constexpr bool PERM = true, AFTER_DRAIN = false;
    unsigned char* O; const float* bias; float ascale;
    __device__ __forceinline__ void operator()(const f32x4 (&acc)[2][2][4][2], const Unit& u, int wr, int wc, int fr, int fq) const {
        const int row0 = u.pm * BM + wr * 64 + fr; const int col0 = u.pn * HALF + wc * 32 + 8 * fq;
        const float* bp = bias + (size_t)u.e * 2048 + col0;
        f32x4 bg[2], bu[2];
#pragma unroll
        for (int n = 0; n < 2; ++n) { bg[n] = *(const f32x4*)(bp + 4 * n); bu[n] = *(const f32x4*)(bp + 1024 + 4 * n); }
#pragma unroll
        for (int ai = 0; ai < 2; ++ai)
#pragma unroll
            for (int m = 0; m < 4; ++m) { unsigned char* rowp = O + (size_t)(row0 + ai * HALF + m * 16) * 1024 + col0;
                float r[8];
#pragma unroll
                for (int n = 0; n < 2; ++n) { const f32x4 gt = acc[ai][0][m][n] * ascale + bg[n], up = acc[ai][1][m][n] * ascale + bu[n];
#pragma unroll
                    for (int i = 0; i < 4; ++i) { const float g = fminf(gt[i], 7.0f), uu = fminf(fmaxf(up[i], -7.0f), 7.0f);
                        const float sg = __builtin_amdgcn_rcpf(1.0f + __builtin_amdgcn_exp2f(-1.702f * 1.4426950408889634f * g));
                        r[4 * n + i] = (uu + 1.0f) * (g * sg); } }
                *(unsigned long long*)rowp = (unsigned long long)pk4_fp8(r[0], r[1], r[2], r[3]) | ((unsigned long long)pk4_fp8(r[4], r[5], r[6], r[7]) << 32); }
    }
};
struct EpiBiasBf16 {
    static constexpr bool PERM = true, AFTER_DRAIN = false;
    bf16_t* O; const float* bias; float ascale;
    __device__ __forceinline__ void operator()(const f32x4 (&acc)[2][2][4][2], const Unit& u, int wr, int wc, int fr, int fq) const {
        const int row0 = u.pm * BM + wr * 64 + fr; const int col0 = u.pn * BM + wc * 32 + 8 * fq;
        const float* bp = bias + (size_t)u.e * 1024 + col0;
        f32x4 bv[2][2];
#pragma unroll
        for (int bj = 0; bj < 2; ++bj)
#pragma unroll
            for (int n = 0; n < 2; ++n) bv[bj][n] = *(const f32x4*)(bp + bj * HALF + 4 * n);
#pragma unroll
        for (int ai = 0; ai < 2; ++ai)
#pragma unroll
            for (int m = 0; m < 4; ++m) { bf16_t* rowp = O + (size_t)(row0 + ai * HALF + m * 16) * 1024 + col0;
#pragma unroll
                for (int bj = 0; bj < 2; ++bj) { const f32x4 v0 = acc[ai][bj][m][0] * ascale + bv[bj][0], v1 = acc[ai][bj][m][1] * ascale + bv[bj][1];
                    u32x4 w; w.x = cvt_pk_bf16(v0[0], v0[1]); w.y = cvt_pk_bf16(v0[2], v0[3]); w.z = cvt_pk_bf16(v1[0], v1[1]); w.w = cvt_pk_bf16(v1[2], v1[3]);
                    *(u32x4*)(rowp + bj * HALF) = w; } }
    }
};

template <class Epi, class Sched, bool ALIGN_EPI = false, bool SP2 = false, bool GATHER = false, bool F8 = false>
__device__ __forceinline__ void gemm_phase(PG8_LAS unsigned char* lds, const Gemm g, const Sched& S, const Epi& E, int tid_in) {
    int tid_l = tid_in; asm volatile("" : "+v"(tid_l));
    const int tid = tid_l, wid = __builtin_amdgcn_readfirstlane(tid >> 6), lane = tid & 63, wr = wid >> 2, wc = wid & 3, fr = lane & 15, fq = lane >> 4;
    const int K = g.K, nt = K / BK;
    unsigned voffA[2], voffB[2];
#pragma unroll
    for (int i = 0; i < 2; ++i) { int R, C; stage_rc(tid * 16 + i * 8192, R, C); const int Rb = Epi::PERM ? ((R & ~31) + perm32(R & 31)) : R;
        voffA[i] = (unsigned)(R * K + C) * 2u; voffB[i] = (unsigned)(Rb * K + C) * 2u; }
    const size_t kstep = (size_t)(BK * 2);
    static_assert(!GATHER || SP2, "GATHER is wired into the SP2 loop only");
    unsigned vAc0[2], vAc1[2], vAn0[2], vAn1[2]; int gR[2]; unsigned gC[2];
#pragma unroll
    for (int i = 0; i < 2; ++i) { int R, C; stage_rc(tid * 16 + i * 8192, R, C); gR[i] = R; gC[i] = (unsigned)C * 2u; vAc0[i] = voffA[i]; vAc1[i] = voffA[i]; vAn0[i] = voffA[i]; vAn1[i] = voffA[i]; }
#define PG8_GFETCH(d0, d1, ord) do { if constexpr (GATHER) { _Pragma("unroll") for (int _i = 0; _i < 2; ++_i) { \
        d0[_i] = (unsigned)g.rowtab[(ord) * 256 + gR[_i]] * (unsigned)(K * 2) + gC[_i]; d1[_i] = (unsigned)g.rowtab[(ord) * 256 + 128 + gR[_i]] * (unsigned)(K * 2) + gC[_i]; } } } while (0)
    const size_t hstep = (size_t)HALF * K * 2;
    const size_t hstepA = GATHER ? 0 : hstep;
    const size_t tstep = 2 * hstep;
    const unsigned ldsw = (unsigned)wid * 1024u;
    const int aoff = lds_byte(wr * 64 + fr, fq * 8), boff = lds_byte(wc * 32 + fr, fq * 8);
    typedef int v8i_t __attribute__((ext_vector_type(8))); typedef short v16s_a16 __attribute__((ext_vector_type(16), aligned(16)));
    const int f8c = 32 * (fq >> 1) + 16 * (fq & 1);
    const int aoff8a = lds_byte(wr * 64 + fr, f8c), boff8a = lds_byte(wc * 32 + fr, f8c);
    v8i_t At8[4], Au8[4], B08[2], B18[2]; int f8scale = 127; asm volatile("" : "+v"(f8scale));
#define PG8_SA(b, h) (((b) * 2 + (h)) * HTB)
#define PG8_SB(b, h) ((4 + (b) * 2 + (h)) * HTB)
#define PG8_STAGE(bufoff, gbase, voff) do { _Pragma("unroll") for (int _i = 0; _i < 2; ++_i) \
        __builtin_amdgcn_global_load_lds((const unsigned*)((const char*)(gbase) + (voff)[_i]), (PG8_LAS unsigned*)(lds + (bufoff) + ldsw + _i * 8192), 16, 0, 0); } while (0)
#define PG8_LDA(dst, b, h) do { if constexpr (F8) { _Pragma("unroll") for (int m = 0; m < 4; ++m) { const bf16x8 lo_ = *(const PG8_LAS bf16x8*)(lds + PG8_SA(b, h) + aoff8a + m * 2048), hi_ = *(const PG8_LAS bf16x8*)(lds + PG8_SA(b, h) + aoff8a + m * 2048 + 16); dst##8[m] = __builtin_bit_cast(v8i_t, __builtin_shufflevector(lo_, hi_, 0, 1, 2, 3, 4, 5, 6, 7, 8, 9, 10, 11, 12, 13, 14, 15)); } } \
        else { _Pragma("unroll") for (int m = 0; m < 4; ++m) _Pragma("unroll") for (int k = 0; k < 2; ++k) dst[m][k] = *(const PG8_LAS bf16x8*)(lds + PG8_SA(b, h) + aoff + m * 2048 + k * 1024); } } while (0)
#define PG8_LDB(dst, b, h) do { if constexpr (F8) { _Pragma("unroll") for (int n = 0; n < 2; ++n) { const bf16x8 lo_ = *(const PG8_LAS bf16x8*)(lds + PG8_SB(b, h) + boff8a + n * 2048), hi_ = *(const PG8_LAS bf16x8*)(lds + PG8_SB(b, h) + boff8a + n * 2048 + 16); dst##8[n] = __builtin_bit_cast(v8i_t, __builtin_shufflevector(lo_, hi_, 0, 1, 2, 3, 4, 5, 6, 7, 8, 9, 10, 11, 12, 13, 14, 15)); } } \
        else { _Pragma("unroll") for (int n = 0; n < 2; ++n) _Pragma("unroll") for (int k = 0; k < 2; ++k) dst[n][k] = *(const PG8_LAS bf16x8*)(lds + PG8_SB(b, h) + boff + n * 2048 + k * 1024); } } while (0)
#define PG8_MMA(ai, bj, At, Bt) do { __builtin_amdgcn_s_setprio(1); if constexpr (F8) { _Pragma("unroll") for (int m = 0; m < 4; ++m) _Pragma("unroll") for (int n = 0; n < 2; ++n) \
            asm volatile("v_mfma_scale_f32_16x16x128_f8f6f4 %0, %1, %2, %0, %3, %3 op_sel_hi:[0,0,0]" : "+v"(acc[ai][bj][m][n]) : "v"(Bt##8[n]), "v"(At##8[m]), "v"(f8scale)); } \
        else { _Pragma("unroll") for (int m = 0; m < 4; ++m) _Pragma("unroll") for (int n = 0; n < 2; ++n) _Pragma("unroll") for (int k = 0; k < 2; ++k) \
        acc[ai][bj][m][n] = __builtin_amdgcn_mfma_f32_16x16x32_bf16(Bt[n][k], At[m][k], acc[ai][bj][m][n], 0, 0, 0); } __builtin_amdgcn_s_setprio(0); } while (0)
#define PG8_WAIT_V(n) asm volatile("s_waitcnt vmcnt(" #n ")" ::: "memory")
#define PG8_WAIT_L(n) asm volatile("s_waitcnt lgkmcnt(" #n ")" ::: "memory")
#define PG8_BAR __builtin_amdgcn_s_barrier()
#define PG8_SCHED __builtin_amdgcn_sched_barrier(0)
    Unit cur, nxt; int ui = 0;
    if (!S.next(0, cur)) return;
    f32x4 acc[2][2][4][2];
#pragma unroll
    for (int a = 0; a < 2; ++a)
#pragma unroll
        for (int b = 0; b < 2; ++b)
#pragma unroll
            for (int m = 0; m < 4; ++m)
#pragma unroll
                for (int n = 0; n < 2; ++n) acc[a][b][m][n] = (f32x4){0.f, 0.f, 0.f, 0.f};
    bf16x8 At[4][2], Au[4][2], B0[2][2], B1[2][2];
    const char* cA = (const char*)g.A + (GATHER ? (size_t)0 : (size_t)cur.pm * tstep); PG8_GFETCH(vAc0, vAc1, 0); const char* cB = (const char*)g.Bt + (size_t)cur.e * g.bstride + (size_t)cur.pn * tstep;
    S.a_ready(cur);
    if constexpr (SP2) {
        PG8_STAGE(PG8_SB(0, 0), cB, voffB); PG8_STAGE(PG8_SB(0, 1), cB + hstep, voffB); PG8_STAGE(PG8_SA(0, 0), cA, vAc0); PG8_STAGE(PG8_SA(0, 1), cA + hstepA, vAc1);
        if (wr == 1) PG8_BAR;
        PG8_WAIT_V(2); PG8_BAR;
        PG8_STAGE(PG8_SB(1, 0), cB + kstep, voffB); PG8_STAGE(PG8_SA(1, 0), cA + kstep, vAc0); PG8_STAGE(PG8_SB(1, 1), cB + hstep + kstep, voffB);
        PG8_WAIT_V(6); PG8_BAR;
    } else {
        PG8_STAGE(PG8_SB(0, 0), cB, voffB); PG8_STAGE(PG8_SA(0, 0), cA, voffA); PG8_STAGE(PG8_SB(0, 1), cB + hstep, voffB); PG8_STAGE(PG8_SA(0, 1), cA + hstep, voffA);
        if (wr == 1) PG8_BAR;
        PG8_WAIT_V(4); PG8_BAR;
        PG8_STAGE(PG8_SB(1, 0), cB + kstep, voffB); PG8_STAGE(PG8_SA(1, 0), cA + kstep, voffA); PG8_STAGE(PG8_SB(1, 1), cB + hstep + kstep, voffB);
        PG8_WAIT_V(6); PG8_BAR;
    }
    for (;;) {
        const bool has_next = S.next(ui + 1, nxt);
        const char* nA = (has_next && !GATHER) ? (const char*)g.A + (size_t)nxt.pm * tstep : cA;
        if constexpr (GATHER) { if (has_next) PG8_GFETCH(vAn0, vAn1, ui + 1); else { vAn0[0] = vAc0[0]; vAn0[1] = vAc0[1]; vAn1[0] = vAc1[0]; vAn1[1] = vAc1[1]; } }
        const char* nB = has_next ? (const char*)g.Bt + (size_t)nxt.e * g.bstride + (size_t)nxt.pn * tstep : cB;
#pragma unroll 1
        for (int t = 0; t < nt; t += 2) {
            const bool last = (t == nt - 2);
            const char* a1 = cA + (size_t)(t + 1) * kstep;
            const char* a2 = last ? nA : cA + (size_t)(t + 2) * kstep; const char* b2 = last ? nB : cB + (size_t)(t + 2) * kstep;
            const char* a3 = a2 + kstep; const char* b3 = b2 + kstep;
            if (last && has_next) S.a_ready(nxt);
            unsigned vS0[2], vS1[2];
            vS0[0] = last ? vAn0[0] : vAc0[0]; vS0[1] = last ? vAn0[1] : vAc0[1]; vS1[0] = last ? vAn1[0] : vAc1[0]; vS1[1] = last ? vAn1[1] : vAc1[1];
            if constexpr (SP2) {
            PG8_LDB(B0, 0, 0); PG8_LDB(B1, 0, 1); PG8_SCHED; PG8_LDA(At, 0, 0); PG8_STAGE(PG8_SA(1, 1), a1 + hstepA, vAc1);
            PG8_WAIT_V(8); PG8_WAIT_L(0); PG8_BAR; PG8_MMA(0, 0, At, B0); PG8_MMA(0, 1, At, B1); PG8_BAR; PG8_SCHED;
            if constexpr (F8) { PG8_LDA(Au, 0, 1); } else { PG8_LDA(At, 0, 1); } PG8_STAGE(PG8_SB(0, 0), b2, voffB); PG8_STAGE(PG8_SB(0, 1), b2 + hstep, voffB); PG8_STAGE(PG8_SA(0, 0), a2, vS0);
            PG8_WAIT_V(8); PG8_WAIT_L(0); PG8_BAR; if constexpr (F8) { PG8_MMA(1, 0, Au, B0); PG8_MMA(1, 1, Au, B1); } else { PG8_MMA(1, 0, At, B0); PG8_MMA(1, 1, At, B1); } PG8_BAR; PG8_SCHED;
            PG8_LDB(B0, 1, 0); PG8_LDB(B1, 1, 1); PG8_SCHED; PG8_LDA(At, 1, 0); PG8_STAGE(PG8_SA(0, 1), a2 + hstepA, vS1);
            PG8_WAIT_V(8); PG8_WAIT_L(0); PG8_BAR; PG8_MMA(0, 0, At, B0); PG8_MMA(0, 1, At, B1); PG8_BAR; PG8_SCHED;
            if constexpr (F8) { PG8_LDA(Au, 1, 1); } else { PG8_LDA(At, 1, 1); } PG8_STAGE(PG8_SB(1, 0), b3, voffB); PG8_STAGE(PG8_SB(1, 1), b3 + hstep, voffB); PG8_STAGE(PG8_SA(1, 0), a3, vS0);
            PG8_WAIT_V(8); PG8_WAIT_L(0); PG8_BAR; if constexpr (F8) { PG8_MMA(1, 0, Au, B0); PG8_MMA(1, 1, Au, B1); } else { PG8_MMA(1, 0, At, B0); PG8_MMA(1, 1, At, B1); } PG8_BAR; PG8_SCHED;
            } else {
            PG8_LDB(B0, 0, 0); PG8_SCHED; PG8_LDA(At, 0, 0); PG8_STAGE(PG8_SA(1, 1), a1 + hstep, voffA);
            PG8_WAIT_L(8); PG8_BAR; PG8_WAIT_L(0); PG8_MMA(0, 0, At, B0); PG8_BAR; PG8_SCHED;
            PG8_LDB(B1, 0, 1); PG8_STAGE(PG8_SB(0, 0), b2, voffB);
            PG8_BAR; PG8_WAIT_L(0); PG8_MMA(0, 1, At, B1); PG8_BAR;
            PG8_LDA(At, 0, 1); PG8_STAGE(PG8_SA(0, 0), a2, voffA);
            PG8_BAR; PG8_WAIT_L(0); PG8_MMA(1, 0, At, B0); PG8_BAR; PG8_SCHED;
            PG8_STAGE(PG8_SB(0, 1), b2 + hstep, voffB);
            PG8_WAIT_V(6); PG8_BAR; PG8_MMA(1, 1, At, B1); PG8_BAR;
            PG8_LDB(B0, 1, 0); PG8_SCHED; PG8_LDA(At, 1, 0); PG8_STAGE(PG8_SA(0, 1), a2 + hstep, voffA);
            PG8_WAIT_L(8); PG8_BAR; PG8_WAIT_L(0); PG8_MMA(0, 0, At, B0); PG8_BAR; PG8_SCHED;
            PG8_LDB(B1, 1, 1); PG8_STAGE(PG8_SB(1, 0), b3, voffB);
            PG8_BAR; PG8_WAIT_L(0); PG8_MMA(0, 1, At, B1); PG8_BAR;
            PG8_LDA(At, 1, 1); PG8_STAGE(PG8_SA(1, 0), a3, voffA);
            PG8_BAR; PG8_WAIT_L(0); PG8_MMA(1, 0, At, B0); PG8_BAR; PG8_SCHED;
            PG8_STAGE(PG8_SB(1, 1), b3 + hstep, voffB);
            PG8_WAIT_V(6); PG8_BAR; PG8_MMA(1, 1, At, B1); PG8_BAR;
            }
        }
        if constexpr (ALIGN_EPI) { if (wr == 0) PG8_BAR; }
        if constexpr (F8) asm volatile("s_nop 15\n\ts_nop 15" ::: "memory");
        if constexpr (!Epi::AFTER_DRAIN) { E(acc, cur, wr, wc, fr, fq); S.done(cur); }
        if (!has_next) break;
#pragma unroll
        for (int a = 0; a < 2; ++a)
#pragma unroll
            for (int b = 0; b < 2; ++b)
#pragma unroll
                for (int m = 0; m < 4; ++m)
#pragma unroll
                    for (int n = 0; n < 2; ++n) acc[a][b][m][n] = (f32x4){0.f, 0.f, 0.f, 0.f};
        cur = nxt; cA = nA; cB = nB; ++ui;
        if constexpr (GATHER) { vAc0[0] = vAn0[0]; vAc0[1] = vAn0[1]; vAc1[0] = vAn1[0]; vAc1[1] = vAn1[1]; }
        if constexpr (ALIGN_EPI) { if (wr == 1) PG8_BAR; }
    }
    PG8_WAIT_V(0);
    if constexpr (!ALIGN_EPI) { if (wr == 0) PG8_BAR; }
    PG8_BAR;
    if constexpr (Epi::AFTER_DRAIN) { E.fused(acc, cur, wr, wc, fr, fq, lds, wid, lane); S.done(cur); }
#undef PG8_SA
#undef PG8_SB
#undef PG8_STAGE
#undef PG8_LDA
#undef PG8_LDB
#undef PG8_MMA
#undef PG8_WAIT_V
#undef PG8_WAIT_L
#undef PG8_BAR
#undef PG8_SCHED
#undef PG8_GFETCH
}
}
#include <hip/hip_bf16.h>
#include <cmath>
namespace attn_body {
using bf16=__hip_bfloat16;
using bf16x8=__attribute__((ext_vector_type(8)))short;
using s16x4=__attribute__((ext_vector_type(4)))short;
using f32x16=__attribute__((ext_vector_type(16)))float;
using u32x4=__attribute__((ext_vector_type(4)))unsigned;
constexpr int D=64,DM=1024,KVP=256;
constexpr int NW=8,QBLK=32,QB=QBLK*NW,KVBLK=64;
__device__ __forceinline__ int crow(int r,int hi){return (r&3)+8*(r>>2)+4*hi;}
#define SBAR() __builtin_amdgcn_sched_barrier(0)
__device__ __forceinline__ void cmask(f32x16&p0,f32x16&p1,int jb,int qrel,int hi){
  const float NEG=-INFINITY; int kb=64*jb+4*hi;
  #pragma unroll
  for(int r=0;r<16;++r){int kv=kb+(r&3)+8*(r>>2); if(kv>qrel)p0[r]=NEG; if(kv+32>qrel)p1[r]=NEG;}
}

constexpr int NSLOT=3, SLOTB=8192;
constexpr int LDS_K=0, LDS_V=NSLOT*SLOTB, LDS_WS=2*NSLOT*SLOTB, LDS_OST=LDS_WS+NW*64*4, LDS_BYTES=LDS_OST+NW*4096;
constexpr float C2=0.125f*1.4426950408889634f;
__device__ __forceinline__ void glds16(const void*gsrc,unsigned lds_dst){unsigned keep;
  asm volatile("s_mov_b32 %0, m0\n\ts_mov_b32 m0, %2\n\ts_nop 0\n\tglobal_load_lds_dwordx4 %1, off\n\ts_mov_b32 m0, %0":"=&s"(keep):"v"(gsrc),"s"(lds_dst):"memory");}
__device__ __forceinline__ float max3f(float a,float b,float c){float r;asm("v_max3_f32 %0, %1, %2, %3":"=v"(r):"v"(a),"v"(b),"v"(c));return r;}
__device__ __forceinline__ float max2f(float a,float b){float r;asm("v_max_f32_e32 %0, %1, %2":"=v"(r):"v"(a),"v"(b));return r;}
__device__ __forceinline__ float fadd_s(float a,float b){float r;asm("v_add_f32_e32 %0, %1, %2":"=v"(r):"v"(a),"v"(b));return r;}
__device__ __forceinline__ float fsub_s(float a,float b){float r;asm("v_sub_f32_e32 %0, %1, %2":"=v"(r):"v"(a),"v"(b));return r;}
typedef float f32x2_t __attribute__((ext_vector_type(2))); typedef __bf16 bf16x2_t __attribute__((ext_vector_type(2)));
__device__ __forceinline__ unsigned cvtpk_s(float lo,float hi){f32x2_t v={lo,hi};bf16x2_t b=__builtin_convertvector(v,bf16x2_t);return __builtin_bit_cast(unsigned,b);}
#define WAIT_BAR(N) asm volatile("s_waitcnt vmcnt(" #N ") lgkmcnt(0)\n\ts_barrier":::"memory")

__device__ __forceinline__ void qkt(f32x16&p0,f32x16&p1,const char*Kslot,const bf16x8*qr,const f32x16&negm,int r32,int hi){
  const char*kb=Kslot+hi*1024+r32*16;
  #pragma unroll
  for(int d0=0;d0<4;++d0){
    const bf16x8 b0=*reinterpret_cast<const bf16x8*>(kb+d0*2048);
    const bf16x8 b1=*reinterpret_cast<const bf16x8*>(kb+d0*2048+512);
    if(d0==0){p0=__builtin_amdgcn_mfma_f32_32x32x16_bf16(b0,qr[0],negm,0,0,0);p1=__builtin_amdgcn_mfma_f32_32x32x16_bf16(b1,qr[0],negm,0,0,0);}
    else{p0=__builtin_amdgcn_mfma_f32_32x32x16_bf16(b0,qr[d0],p0,0,0,0);p1=__builtin_amdgcn_mfma_f32_32x32x16_bf16(b1,qr[d0],p1,0,0,0);}}
}
typedef __attribute__((address_space(3))) const char* lds_cptr;
typedef short v4i16_t __attribute__((ext_vector_type(4)));
__device__ __forceinline__ void kload8(bf16x8*kf,lds_cptr kp){
  kf[0]=*(const __attribute__((address_space(3))) bf16x8*)(kp);      kf[1]=*(const __attribute__((address_space(3))) bf16x8*)(kp+512);
  kf[2]=*(const __attribute__((address_space(3))) bf16x8*)(kp+2048); kf[3]=*(const __attribute__((address_space(3))) bf16x8*)(kp+2560);
  kf[4]=*(const __attribute__((address_space(3))) bf16x8*)(kp+4096); kf[5]=*(const __attribute__((address_space(3))) bf16x8*)(kp+4608);
  kf[6]=*(const __attribute__((address_space(3))) bf16x8*)(kp+6144); kf[7]=*(const __attribute__((address_space(3))) bf16x8*)(kp+6656);
}
__device__ __forceinline__ void kload2(bf16x8*kf,lds_cptr kp,int j){ kf[2*j]=*(const __attribute__((address_space(3))) bf16x8*)(kp+j*2048); kf[2*j+1]=*(const __attribute__((address_space(3))) bf16x8*)(kp+j*2048+512); }
__device__ __forceinline__ s16x4 vtr(lds_cptr p){ return __builtin_bit_cast(s16x4,__builtin_amdgcn_ds_read_tr16_b64_v4i16((__attribute__((address_space(3))) v4i16_t*)p)); }
__device__ __forceinline__ float rowmax(const f32x16&p0,const f32x16&p1){
  float a=max3f(p0[0],p0[1],p1[0]),b=max3f(p0[2],p0[3],p1[1]);a=max3f(a,p1[2],p1[3]);
  #pragma unroll
  for(int r=4;r<16;r+=4){a=max3f(a,p0[r],p0[r+1]);b=max3f(b,p0[r+2],p0[r+3]);a=max3f(a,p1[r],p1[r+1]);b=max3f(b,p1[r+2],p1[r+3]);}
  const float m=max2f(a,b);
  auto rr=__builtin_amdgcn_permlane32_swap(__float_as_uint(m),__float_as_uint(m),false,false);
  return max2f(__uint_as_float(rr[0]),__uint_as_float(rr[1]));
}
__device__ __forceinline__ void pv(f32x16*o,int vb,bf16x8 pa0,bf16x8 pa1,bf16x8 pa2,bf16x8 pa3){
  #pragma unroll
  for(int d0=0;d0<2;++d0){s16x4 lo[4],hi[4];
    #pragma unroll
    for(int ks=0;ks<4;++ks){
      asm volatile("ds_read_b64_tr_b16 %0,%1 offset:%c2":"=&v"(lo[ks]):"v"(vb),"i"(d0*4096+ks*1024):"memory");
      asm volatile("ds_read_b64_tr_b16 %0,%1 offset:%c2":"=&v"(hi[ks]):"v"(vb),"i"(d0*4096+ks*1024+512):"memory");}
    asm volatile("s_waitcnt lgkmcnt(0)":::"memory");SBAR();
    #define PK(k) (bf16x8){lo[k][0],lo[k][1],lo[k][2],lo[k][3],hi[k][0],hi[k][1],hi[k][2],hi[k][3]}
    o[d0]=__builtin_amdgcn_mfma_f32_32x32x16_bf16(pa0,PK(0),o[d0],0,0,0);
    o[d0]=__builtin_amdgcn_mfma_f32_32x32x16_bf16(pa1,PK(1),o[d0],0,0,0);
    o[d0]=__builtin_amdgcn_mfma_f32_32x32x16_bf16(pa2,PK(2),o[d0],0,0,0);
    o[d0]=__builtin_amdgcn_mfma_f32_32x32x16_bf16(pa3,PK(3),o[d0],0,0,0);
    #undef PK
  }
}

#ifndef ATTN_STORE16
#define ATTN_STORE16(p,v) (*(u32x4*)(p)=(v))
#endif
template<int THRL> __device__ __forceinline__ void attn_unit(long qrow0,long kvrow0,int NT,int h,const bf16*Q,const bf16*__restrict__ K,const bf16*__restrict__ V,bf16*O,char*shm,int tid_in){
  int tid_l=tid_in; asm volatile("":"+v"(tid_l)); const int tid=tid_l,lane=tid&63,r32=lane&31,hi=lane>>5; const int wid=__builtin_amdgcn_readfirstlane(tid>>6);
  const bf16*Qw=Q+(qrow0+wid*QBLK)*DM+h*D;
  const bf16*Kh=K+kvrow0*KVP+(h>>2)*D,*Vh=V+kvrow0*KVP+(h>>2)*D;
  const unsigned lds0=(unsigned)(uintptr_t)shm;
  float*wsf=(float*)(shm+LDS_WS)+wid*64;
  const bf16*ksrc=Kh+(long)lane*KVP+wid*8;
  const bf16*vsrc=Vh+(long)(16*(wid&3)+(lane>>2))*KVP+(wid>>2)*32+(lane&3)*8;
  const unsigned kdst=lds0+LDS_K+wid*1024, vdst=lds0+LDS_V+wid*1024;
  #define DMA_K(t,slot) glds16(ksrc+(long)(t)*KVBLK*KVP,(unsigned)__builtin_amdgcn_readfirstlane(kdst+(slot)))
  #define DMA_V(t,slot) glds16(vsrc+(long)(t)*KVBLK*KVP,(unsigned)__builtin_amdgcn_readfirstlane(vdst+(slot)))
  const int vb0=(int)(lds0+LDS_V)+((lane>>4)&1)*32+(lane&3)*8+(4*hi+((lane&15)>>2))*64;
  const char*Kbase=shm+LDS_K; bf16x8 kf[8];
  const lds_cptr shm3=(lds_cptr)shm; const lds_cptr kp0=shm3+LDS_K+hi*1024+r32*16; const lds_cptr vp0=shm3+LDS_V+((lane>>4)&1)*32+(lane&3)*8+(4*hi+((lane&15)>>2))*64;
  DMA_K(0,0);DMA_V(0,0);DMA_K(1,SLOTB);
  bf16x8 qr[4];
  #pragma unroll
  for(int d0=0;d0<4;++d0)qr[d0]=*reinterpret_cast<const bf16x8*>(&Qw[(long)r32*DM+d0*16+hi*8]);
  float mhat=0.f,l_reg=0.f;f32x16 o[2];o[0]=f32x16{};o[1]=f32x16{};f32x16 negm=f32x16{};asm volatile("":"+v"(negm));
  #define CMASK(P0,P1,t) do{}while(0)
  bool resc=false;
  #define START(P0,P1) do{ const float rm=rowmax(P0,P1); resc=false; \
    { const float dl=rm; mhat=fadd_s(mhat,dl); \
      _Pragma("unroll") for(int r=0;r<16;++r){P0[r]=fsub_s(P0[r],dl);P1[r]=fsub_s(P1[r],dl);} \
      _Pragma("unroll") for(int r=0;r<16;++r)negm[r]=-mhat; asm volatile("":"+v"(negm)); } \
    _Pragma("unroll") for(int r=0;r<16;++r)P0[r]=__builtin_amdgcn_exp2f(P0[r]); }while(0)
  #define RESC() do{ if(resc){ asm volatile("s_waitcnt lgkmcnt(0)":::"memory"); \
      _Pragma("unroll") for(int d_=0;d_<2;++d_) _Pragma("unroll") for(int r=0;r<16;++r)o[d_][r]*=wsf[crow(r,hi)]; } }while(0)
  f32x16 pA0,pA1,pB0,pB1;
  int sl_prev=0,sl_cur=0,sl_next=SLOTB;
  #define ROT() do{sl_prev=sl_cur;sl_cur=sl_next;sl_next=(sl_next==(NSLOT-1)*SLOTB)?0:sl_next+SLOTB;}while(0)
  DMA_K(2,2*SLOTB);
  WAIT_BAR(3);
  qkt(pA0,pA1,Kbase,qr,negm,r32,hi);asm volatile("s_nop 15\n\ts_nop 7":"+v"(pA0),"+v"(pA1));CMASK(pA0,pA1,0);
  START(pA0,pA1);
  _Pragma("unroll") for(int r=0;r<16;++r)pA1[r]=__builtin_amdgcn_exp2f(pA1[r]);
  WAIT_BAR(0);
  DMA_K(3,0);DMA_V(1,SLOTB);
  ROT();
  kload8(kf,kp0+sl_cur);
  WAIT_BAR(2);
  s16x4 vlo[8],vhi[8]; u32x4 pw0,pw1,pw2,pw3;
  #define PKW(P,B) cvtpk_s(P[B],P[B+1])
  #define PAF(k) __builtin_bit_cast(bf16x8,pw##k)
  #define VFR(i) (bf16x8){vlo[i][0],vlo[i][1],vlo[i][2],vlo[i][3],vhi[i][0],vhi[i][1],vhi[i][2],vhi[i][3]}
  #define PIN(x) asm volatile("":"+v"(x))
  #define MX3(a,b,c) __builtin_fmaxf(__builtin_fmaxf((a),(b)),(c))
  #define GAPA(MF,A0,A1,A2,A3,W0,W1,PW) do{ MF; sacc+=A0; sacc+=A1; sacc+=A2; sacc+=A3; PIN(sacc); W0; W1; PIN(PW); SBAR(); }while(0)
  #define EX(v) __builtin_amdgcn_exp2f(v)
  #define GAPB(MF,X,B) do{ MF; X[B]=EX(X[B]); X[B+1]=EX(X[B+1]); X[B+2]=EX(X[B+2]); X[B+3]=EX(X[B+3]); PIN(X); SBAR(); }while(0)
  #define VRD(i) do{ vlo[i]=vtr(vp_+(((i)>>2)*4096+((i)&3)*1024)); vhi[i]=vtr(vp_+(((i)>>2)*4096+((i)&3)*1024+512)); }while(0)
  #define KRD(G,j) do{ if(G){ kload2(kf,kp0+sl_next,j); SBAR(); } }while(0)
  #define STEP(C0,C1,P0,P1,t,GK,GV,GL) do{ SBAR(); \
    const lds_cptr vp_=vp0+sl_prev; \
    VRD(0); SBAR(); float sacc=(P0[0]+P0[1]); \
    GAPA(C0=__builtin_amdgcn_mfma_f32_32x32x16_bf16(kf[0],qr[0],negm,0,0,0), P0[2],P0[3],P0[4],P0[5],     pw0[0]=PKW(P0,0), pw0[1]=PKW(P0,2), pw0); \
    VRD(4); SBAR(); GAPA(C1=__builtin_amdgcn_mfma_f32_32x32x16_bf16(kf[1],qr[0],negm,0,0,0), P0[6],P0[7],P0[8],P0[9],     pw0[2]=PKW(P0,4), pw0[3]=PKW(P0,6), pw0); \
    VRD(1); SBAR(); GAPA(C0=__builtin_amdgcn_mfma_f32_32x32x16_bf16(kf[2],qr[1],C0,0,0,0),   P0[10],P0[11],P0[12],P0[13], pw1[0]=PKW(P0,8), pw1[1]=PKW(P0,10), pw1); \
    VRD(5); SBAR(); GAPA(C1=__builtin_amdgcn_mfma_f32_32x32x16_bf16(kf[3],qr[1],C1,0,0,0),   P0[14],P0[15],P1[0],P1[1],   pw1[2]=PKW(P0,12),pw1[3]=PKW(P0,14), pw1); \
    VRD(2); SBAR(); GAPA(C0=__builtin_amdgcn_mfma_f32_32x32x16_bf16(kf[4],qr[2],C0,0,0,0),   P1[2],P1[3],P1[4],P1[5],     pw2[0]=PKW(P1,0), pw2[1]=PKW(P1,2), pw2); \
    VRD(6); SBAR(); GAPA(C1=__builtin_amdgcn_mfma_f32_32x32x16_bf16(kf[5],qr[2],C1,0,0,0),   P1[6],P1[7],P1[8],P1[9],     pw2[2]=PKW(P1,4), pw2[3]=PKW(P1,6), pw2); \
    VRD(3); SBAR(); GAPA(C0=__builtin_amdgcn_mfma_f32_32x32x16_bf16(kf[6],qr[3],C0,0,0,0),   P1[10],P1[11],P1[12],P1[13], pw3[0]=PKW(P1,8), pw3[1]=PKW(P1,10), pw3); \
    VRD(7); SBAR(); GAPA(C1=__builtin_amdgcn_mfma_f32_32x32x16_bf16(kf[7],qr[3],C1,0,0,0),   P1[14],P1[15],0.f,0.f,       pw3[2]=PKW(P1,12),pw3[3]=PKW(P1,14), pw3); \
    l_reg+=sacc; \
    if(GK){DMA_K((t)+3,sl_cur);} if(GV){DMA_V((t)+1,sl_next);} \
    CMASK(C0,C1,t); \
    { float a=MX3(C0[0],C0[1],C1[0]),b=MX3(C0[2],C0[3],C1[1]); a=MX3(a,C1[2],C1[3]); \
      _Pragma("unroll") for(int r=4;r<16;r+=4){a=MX3(a,C0[r],C0[r+1]);b=MX3(b,C0[r+2],C0[r+3]);a=MX3(a,C1[r],C1[r+1]);b=MX3(b,C1[r+2],C1[r+3]);} \
      float rm=__builtin_fmaxf(a,b); { auto rr=__builtin_amdgcn_permlane32_swap(__float_as_uint(rm),__float_as_uint(rm),false,false); rm=__builtin_fmaxf(__uint_as_float(rr[0]),__uint_as_float(rr[1])); } \
      resc=false; \
      if(__builtin_expect(__any(rm>(float)THRL),0)){ const float dl=__builtin_fmaxf(rm,0.f); mhat+=dl; \
        _Pragma("unroll") for(int r=0;r<16;++r){C0[r]-=dl;C1[r]-=dl;} \
        _Pragma("unroll") for(int r=0;r<16;++r)negm[r]=-mhat; asm volatile("":"+v"(negm)); \
        const float f=__builtin_amdgcn_exp2f(-dl); l_reg*=f; if(hi==0)wsf[r32]=f; resc=true; } } \
    SBAR(); \
    GAPB(o[0]=__builtin_amdgcn_mfma_f32_32x32x16_bf16(PAF(0),VFR(0),o[0],0,0,0), C0,0); \
    GAPB(o[1]=__builtin_amdgcn_mfma_f32_32x32x16_bf16(PAF(0),VFR(4),o[1],0,0,0), C0,4); \
    KRD(GL,0); GAPB(o[0]=__builtin_amdgcn_mfma_f32_32x32x16_bf16(PAF(1),VFR(1),o[0],0,0,0), C0,8); \
    KRD(GL,1); GAPB(o[1]=__builtin_amdgcn_mfma_f32_32x32x16_bf16(PAF(1),VFR(5),o[1],0,0,0), C0,12); \
    KRD(GL,2); GAPB(o[0]=__builtin_amdgcn_mfma_f32_32x32x16_bf16(PAF(2),VFR(2),o[0],0,0,0), C1,0); \
    KRD(GL,3); GAPB(o[1]=__builtin_amdgcn_mfma_f32_32x32x16_bf16(PAF(2),VFR(6),o[1],0,0,0), C1,4); \
    GAPB(o[0]=__builtin_amdgcn_mfma_f32_32x32x16_bf16(PAF(3),VFR(3),o[0],0,0,0), C1,8); \
    GAPB(o[1]=__builtin_amdgcn_mfma_f32_32x32x16_bf16(PAF(3),VFR(7),o[1],0,0,0), C1,12); \
    }while(0)
  int t=1;
  #undef CMASK
  #define CMASK(P0,P1,t) do{}while(0)
  for(;t+5<NT;t+=2){
    STEP(pB0,pB1,pA0,pA1,t,true,true,true);     WAIT_BAR(2); RESC(); ROT();
    STEP(pA0,pA1,pB0,pB1,t+1,true,true,true);   WAIT_BAR(2); RESC(); ROT();
  }
  #undef CMASK
  #define CMASK(P0,P1,t) do{}while(0)
  #define ENDW(tt) do{ if((tt)+3<NT){WAIT_BAR(2);} else if((tt)+2<NT){WAIT_BAR(1);} else {WAIT_BAR(0);} }while(0)
  for(;t+1<NT;t+=2){
    STEP(pB0,pB1,pA0,pA1,t,(t+3<NT),(t+1<NT),(t+1<NT));       ENDW(t);   RESC(); ROT();
    STEP(pA0,pA1,pB0,pB1,t+1,(t+4<NT),(t+2<NT),(t+2<NT));     ENDW(t+1); RESC(); ROT();
  }
  STEP(pB0,pB1,pA0,pA1,NT-1,false,false,false); RESC();
  { float sacc=pB0[0]+pB0[1]; _Pragma("unroll") for(int r=2;r<16;++r)sacc+=pB0[r]; _Pragma("unroll") for(int r=0;r<16;++r)sacc+=pB1[r]; l_reg+=sacc;
    pw0=(u32x4){PKW(pB0,0),PKW(pB0,2),PKW(pB0,4),PKW(pB0,6)};pw1=(u32x4){PKW(pB0,8),PKW(pB0,10),PKW(pB0,12),PKW(pB0,14)};pw2=(u32x4){PKW(pB1,0),PKW(pB1,2),PKW(pB1,4),PKW(pB1,6)};pw3=(u32x4){PKW(pB1,8),PKW(pB1,10),PKW(pB1,12),PKW(pB1,14)};
    SBAR(); pv(o,vb0+sl_cur,PAF(0),PAF(1),PAF(2),PAF(3)); }
  #undef PKW
  #undef PAF
  #undef VFR
  #undef PIN
  #undef MX3
  #undef GAPA
  #undef GAPB
  #undef EX
  #undef VRD
  #undef KRD
  #undef STEP
  #undef ENDW
  {auto rr=__builtin_amdgcn_permlane32_swap(__float_as_uint(l_reg),__float_as_uint(l_reg),false,false);l_reg=__uint_as_float(rr[0])+__uint_as_float(rr[1]);}
  if(hi==0)wsf[32+r32]=l_reg;asm volatile("s_waitcnt lgkmcnt(0)":::"memory");
  float rli[16];
  #pragma unroll
  for(int r=0;r<16;++r)rli[r]=__builtin_amdgcn_rcpf(wsf[32+crow(r,hi)]);
  bf16*Ow=O+(qrow0+wid*QBLK)*DM+h*D;
  { bf16*stg=(bf16*)(shm+LDS_OST)+wid*2048;
    #pragma unroll
    for(int r=0;r<16;++r){const int orow=crow(r,hi);
      #pragma unroll
      for(int d0=0;d0<2;++d0)stg[orow*64+d0*32+r32]=__float2bfloat16(o[d0][r]*rli[r]);}
    asm volatile("s_waitcnt lgkmcnt(0)":::"memory");
    #pragma unroll
    for(int i=0;i<4;++i){const int row=i*8+(lane>>3),ch=lane&7; const u32x4 v=*(const u32x4*)(stg+row*64+ch*8); ATTN_STORE16(Ow+(long)row*DM+ch*8,v);} }
  asm volatile("s_waitcnt lgkmcnt(0)\n\ts_barrier":::"memory");
  #undef DMA_K
  #undef DMA_V
  #undef CMASK
  #undef START
  #undef RESC
  #undef ROT
}
constexpr int ATTN_LDS_BYTES=LDS_BYTES;
#undef SBAR
#undef WAIT_BAR
}

constexpr int NWAVES = 8;
constexpr int NB = 8, SEQ = 4096, CTXL = 256, TB = SEQ + CTXL  , MT = NB * TB  , DMODEL = 1024;
constexpr int NMODC = 6 * DMODEL, MODROWS = 9;
constexpr int QKVN = 1536, WINN = 3104, WINP = 3328;
constexpr int NEXP = 32, TOPK = 4, MPAD = MT * TOPK + NEXP * 256;
constexpr int NLAYER = 4;
constexpr float RMS_EPS = 1e-6f;
constexpr float ATT_C2 = 0.125f * 1.4426950408889634f;

constexpr size_t MiB = 1u << 20;
constexpr size_t WS_CTL = 0, CTL_ZERO_BYTES = 1 * MiB;
constexpr size_t WS_MOD = 1 * MiB, WS_ROPE = 2 * MiB, WS_MODP = 3 * MiB;
constexpr size_t WS_SLOT = 17 * MiB, WS_GATEW = 18 * MiB, WS_SLOTPOS = 19 * MiB;
constexpr size_t WS_WQKV = 20 * MiB, WS_WOA = 26 * MiB, WS_WIN = 30 * MiB, WS_WOG = 43 * MiB, WS_WGU = 48 * MiB, WS_WDN = 560 * MiB;
constexpr size_t WS_X = 816 * MiB, WS_XN = 952 * MiB, WS_Q = 1020 * MiB, WS_K = 1088 * MiB, WS_V = 1105 * MiB, WS_G = 1122 * MiB;
constexpr size_t WS_OF = 1343 * MiB, WS_OB = 1479 * MiB, WS_XG = 1615 * MiB, WS_ACT = 1903 * MiB, WS_Y = 2191 * MiB, WS_XN8 = WS_ACT + 150 * MiB  , WS_PAR = 2479 * MiB, WS_LIST = 2483 * MiB  , WS_END = 2488 * MiB;
static_assert(WS_MODP + (size_t)16 * NLAYER * MODROWS * NMODC * 4 <= WS_SLOT && WS_WIN + (size_t)2 * WINP * 1024 * 2 <= WS_WOG && WS_G + (size_t)MT * WINP * 2 <= WS_OF && WS_XG + (size_t)MPAD * 1024 * 2 <= WS_ACT, "ws map");
constexpr int CW_TMO = 0, CW_BAR = 4096, CW_CNT = 16384;

constexpr int RING_OFF = 0, RING_BYTES = 131072;
constexpr int WR_STRIDE = 1028;
constexpr int LDS_AUX = 133120;
constexpr int AUX_LCNT = LDS_AUX, AUX_GB = LDS_AUX + 128, AUX_T2E = LDS_AUX + 256  , AUX_BASE = AUX_T2E + 2560  , AUX_NT = AUX_BASE + 128, AUX_CNT = AUX_NT + 64  , AUX_ENT = AUX_CNT + 128  , AUX_RS = AUX_ENT + 4352  , AUX_ROWTAB = AUX_RS + 576, ROWTAB_UNITS = 18  ;
constexpr int MISC_OFF = 154624;
constexpr int LDS_BYTES = 155648;
static_assert(AUX_ROWTAB + ROWTAB_UNITS * 512 <= MISC_OFF, "LDS map");

#define GAS __attribute__((address_space(1)))
#define LAS __attribute__((address_space(3)))
typedef unsigned short bf16;
typedef unsigned v4u __attribute__((ext_vector_type(4)));
typedef float f32x4 __attribute__((ext_vector_type(4)));
typedef short bf16x8 __attribute__((ext_vector_type(8)));
typedef GAS unsigned gu32;
typedef GAS unsigned long long gu64;
#define RLX_AGENT __ATOMIC_RELAXED, __HIP_MEMORY_SCOPE_AGENT
#define LDS_WAIT() asm volatile("s_waitcnt lgkmcnt(0)" ::: "memory")
#define VM_WAIT() asm volatile("s_waitcnt vmcnt(0)" ::: "memory")
__device__ __forceinline__ unsigned long long rt() { return __builtin_amdgcn_s_memrealtime(); }
__device__ __forceinline__ unsigned f2bf(float f) { unsigned u = __builtin_bit_cast(unsigned, f); return (u + 0x7fffu + ((u >> 16) & 1u)) >> 16; }
__device__ __forceinline__ unsigned pk2(float lo, float hi) { return f2bf(lo) | (f2bf(hi) << 16); }

#define XB_TMO      128
#define XB_XCNT(j)  (256  + 64 * (j))
#define XB_XSUB(j)  (1280 + 64 * (j))
#define XB_XGEN(j)  (2304 + 64 * (j))
#define XB_TOP      3328
#define XB_TOPGEN   3392
#define XCD_BAR_WORDS 3456
#define XB_SPIN_CAP (1u << 18)

__device__ __forceinline__ unsigned xb_ld(unsigned* p)              { return __hip_atomic_load(p, __ATOMIC_RELAXED, __HIP_MEMORY_SCOPE_AGENT); }
__device__ __forceinline__ unsigned xb_add(unsigned* p, unsigned v) { return __hip_atomic_fetch_add(p, v, __ATOMIC_RELAXED, __HIP_MEMORY_SCOPE_AGENT); }
__device__ __forceinline__ unsigned xb_xcc_id() { return (unsigned)__builtin_amdgcn_s_getreg((3 << 11) | 20) & 0xFu; }
#define XB_SPIN(cond, bar) do { unsigned _sp = 0; while (cond) { __builtin_amdgcn_s_sleep(1); \
    if ((++_sp & 255u) == 0u) { if (xb_ld(&(bar)[XB_TMO])) break; if (_sp > XB_SPIN_CAP) { atomicAdd(&(bar)[XB_TMO], 1u); break; } } } } while (0)

struct XcdBarrier {
    unsigned* bar; unsigned x;
    volatile LAS unsigned* st;
};

__device__ __forceinline__ XcdBarrier xcd_barrier_post(unsigned* bar, volatile LAS unsigned* st, bool xb_t0  ) {
    XcdBarrier b; b.bar = bar; b.x = xb_xcc_id(); b.st = st;
    if (xb_t0) (void)xb_add(&bar[XB_XCNT(b.x)], 1u);
    return b;
}
__device__ __forceinline__ void xcd_barrier_complete(unsigned* bar, unsigned x, unsigned& nloc, unsigned& nx) {
    const unsigned G = gridDim.x * gridDim.y * gridDim.z;
    unsigned sum, cnt, mine, sp = 0u;
    for (;;) {
        sum = 0u; cnt = 0u; mine = 0u;
#pragma unroll
        for (unsigned j = 0; j < 16; ++j) { const unsigned c = xb_ld(&bar[XB_XCNT(j)]); sum += c; cnt += (c > 0u) ? 1u : 0u; mine = (j == x) ? c : mine; }
        if (sum == G) break;
        __builtin_amdgcn_s_sleep(1);
        if ((++sp & 255u) == 0u) { if (xb_ld(&bar[XB_TMO])) break; if (sp > XB_SPIN_CAP) { atomicAdd(&bar[XB_TMO], 1u); break; } }
    }
    nloc = mine > 0u ? mine : 1u; nx = cnt > 0u ? cnt : 1u;
}

__device__ __forceinline__ void xcd_barrier(const XcdBarrier& b, bool xb_t0  ) {
    asm volatile("s_waitcnt vmcnt(0)" ::: "memory");
    __syncthreads();
    if (xb_t0) {
        unsigned* bar = b.bar;
        __builtin_amdgcn_s_waitcnt(0);
        unsigned nloc = b.st[0], nx = b.st[1];
        if (nloc == 0u) { xcd_barrier_complete(bar, b.x, nloc, nx); b.st[0] = nloc; b.st[1] = nx; }
        const unsigned old = xb_add(&bar[XB_XSUB(b.x)], 1u);
        const unsigned gen = old / nloc;
        if (old + 1u == (gen + 1u) * nloc) {
            __builtin_amdgcn_fence(__ATOMIC_RELEASE, "agent");
            asm volatile("s_waitcnt vmcnt(0)" ::: "memory");
            const unsigned og = xb_add(&bar[XB_TOP], 1u);
            const unsigned tg = og / nx;
            if (og + 1u == (tg + 1u) * nx) xb_add(&bar[XB_TOPGEN], 1u);
            else XB_SPIN(xb_ld(&bar[XB_TOPGEN]) == tg, bar);
            __builtin_amdgcn_fence(__ATOMIC_ACQUIRE, "agent");
            xb_add(&bar[XB_XGEN(b.x)], 1u);
            asm volatile("s_waitcnt vmcnt(0)" ::: "memory");
        } else {
            XB_SPIN(xb_ld(&bar[XB_XGEN(b.x)]) == gen, bar);
            __builtin_amdgcn_fence(__ATOMIC_ACQUIRE, "agent");
            asm volatile("s_waitcnt vmcnt(0)" ::: "memory");
        }
    }
    __syncthreads();
}

typedef float f32x2 __attribute__((ext_vector_type(2)));
using pg8::lane_now; using pg8::shx;
__device__ __forceinline__ float wave_sum(float v) {
    const int ln = lane_now();
#pragma unroll
    for (int o = 1; o < 64; o <<= 1) v += shx(v, o, ln);
    return v;
}
__device__ __forceinline__ float wave_max(float v) {
    const int ln = lane_now();
#pragma unroll
    for (int o = 1; o < 64; o <<= 1) v = fmaxf(v, shx(v, o, ln));
    return v;
}
__device__ __forceinline__ float bf2f(unsigned short h) { return __uint_as_float((unsigned)h << 16); }
__device__ __forceinline__ float silu_f(float x) { return x / (1.0f + __expf(-x)); }
__device__ __forceinline__ f32x4 bf4_to_f32(unsigned long long v) { return (f32x4){__uint_as_float((unsigned)(v & 0xffffu) << 16), __uint_as_float((unsigned)(v >> 16) << 16), __uint_as_float((unsigned)((v >> 32) & 0xffffu) << 16), __uint_as_float((unsigned)(v >> 48) << 16)}; }
__device__ __forceinline__ unsigned long long f32_to_bf4(f32x4 y) { return (unsigned long long)pk2(y.x, y.y) | ((unsigned long long)pk2(y.z, y.w) << 32); }
__device__ __forceinline__ int mod_row(int m) { const int b = m / TB; return (m - b * TB < CTXL) ? 8 : b; }

__device__ __forceinline__ void titem_load(const float* W, int N, int k0, int n0, int lane, f32x4 (&v)[16]) {
    const GAS f32x4* p = (const GAS f32x4*)(W + (size_t)(k0 + 16 * (lane >> 3)) * N + n0 + 4 * (lane & 7));
#pragma unroll
    for (int j = 0; j < 16; ++j) v[j] = p[(size_t)j * (N >> 2)];
}
__device__ __forceinline__ void titem_store8(const f32x4 (&v)[16], unsigned char* WT8, int K, int k0, int dst_row0, int lane) {
    unsigned char* o = WT8 + (size_t)(dst_row0 + 4 * (lane & 7)) * K + k0 + 16 * (lane >> 3);
#pragma unroll
    for (int i = 0; i < 4; ++i) { v4u q;
        q.x = pg8::pk4_fp8(v[0][i] * 32.f, v[1][i] * 32.f, v[2][i] * 32.f, v[3][i] * 32.f); q.y = pg8::pk4_fp8(v[4][i] * 32.f, v[5][i] * 32.f, v[6][i] * 32.f, v[7][i] * 32.f);
        q.z = pg8::pk4_fp8(v[8][i] * 32.f, v[9][i] * 32.f, v[10][i] * 32.f, v[11][i] * 32.f); q.w = pg8::pk4_fp8(v[12][i] * 32.f, v[13][i] * 32.f, v[14][i] * 32.f, v[15][i] * 32.f);
        *(GAS v4u*)(o + (size_t)i * K) = q; }
}
__device__ __forceinline__ void titem_store16(const f32x4 (&v)[16], bf16* WT, int K, int k0, int dst_row0, int lane) {
    bf16* o = WT + (size_t)(dst_row0 + 4 * (lane & 7)) * K + k0 + 16 * (lane >> 3);
#pragma unroll
    for (int i = 0; i < 4; ++i) { v4u q0, q1;
        q0.x = pk2(v[0][i], v[1][i]); q0.y = pk2(v[2][i], v[3][i]); q0.z = pk2(v[4][i], v[5][i]); q0.w = pk2(v[6][i], v[7][i]);
        q1.x = pk2(v[8][i], v[9][i]); q1.y = pk2(v[10][i], v[11][i]); q1.z = pk2(v[12][i], v[13][i]); q1.w = pk2(v[14][i], v[15][i]);
        *(GAS v4u*)(o + (size_t)i * K) = q0; *(GAS v4u*)(o + (size_t)i * K + 8) = q1; }
}

struct Args { const float* in[25]; float* out; unsigned char* ws; int ph_lo, ph_hi; };
constexpr int P_N1G = 0, P_N2G = 4096, P_QG = 8192, P_KG = 8320, P_GKF = 8448, P_GKB = 24832, P_BGF = 41216, P_BGB = 42240, P_OG = 43264, P_WR = 43776, P_BR = 174848, P_BGU = 174976, P_BDN = 437120, P_END = 568192;
#define LAUNDER_S(p) asm volatile("" : "+s"(p))
#define LAUNDER_V(p) asm volatile("" : "+v"(p))
#define PARF(ws) ((const float*)((ws) + WS_PAR))

constexpr int I8_GU = 128 * 8 * 64, I8_DN = 128 * 8 * 32, NI8 = I8_GU + I8_DN;
struct T8 { const float* W; unsigned char* O; int N, k0, n0, dst; };
__device__ __forceinline__ T8 dec8(const Args& A, unsigned char* ws, int it) { T8 t;
    const bool gu = it < I8_GU; const int r = gu ? it : it - I8_GU, sh = gu ? 6 : 5, mat = r >> (3 + sh), q = r & ((8 << sh) - 1), kb = q >> sh, n0 = (q & ((1 << sh) - 1)) * 32;
    t.N = gu ? 2048 : 1024; t.W = (gu ? A.in[21] : A.in[23]) + (size_t)mat * 1024 * t.N; t.O = ws + (gu ? WS_WGU : WS_WDN) + (size_t)mat * 1024 * t.N; t.k0 = kb * 128; t.n0 = n0;
    t.dst = gu ? ((n0 & 1023) >> 7) * 256 + (n0 >> 10) * 128 + (n0 & 127) : n0;
    return t; }
__device__ __forceinline__ void p0_prologue(const Args& A, LAS unsigned char* lds, int gw, int NGW, int wave, int lane) {
    unsigned char* ws = A.ws;
    { f32x4 va[16], vb[16]; int it = gw;
      if (it < NI8) { const T8 t = dec8(A, ws, it); titem_load(t.W, t.N, t.k0, t.n0, lane, va); }
      while (it + 2 * NGW < NI8) {
          { const T8 t = dec8(A, ws, it + NGW); titem_load(t.W, t.N, t.k0, t.n0, lane, vb); }
          { const T8 t = dec8(A, ws, it); titem_store8(va, t.O, 1024, t.k0, t.dst, lane); }
          { const T8 t = dec8(A, ws, it + 2 * NGW); titem_load(t.W, t.N, t.k0, t.n0, lane, va); }
          { const T8 t = dec8(A, ws, it + NGW); titem_store8(vb, t.O, 1024, t.k0, t.dst, lane); }
          it += 2 * NGW; }
      if (it < NI8) { const bool hb = it + NGW < NI8;
          if (hb) { const T8 t = dec8(A, ws, it + NGW); titem_load(t.W, t.N, t.k0, t.n0, lane, vb); }
          { const T8 t = dec8(A, ws, it); titem_store8(va, t.O, 1024, t.k0, t.dst, lane); }
          if (hb) { const T8 t = dec8(A, ws, it + NGW); titem_store8(vb, t.O, 1024, t.k0, t.dst, lane); } } }
    constexpr int J_QKV = 2 * 8 * (QKVN / 32), J_WO = 2 * 8 * 32, J_WIN = 2 * 8 * (WINN / 32), NJ = J_QKV + J_WO + J_WIN + J_WO;
    for (int it = gw; it < NJ; it += NGW) { int r = it; const float* W; bf16* O; int N, kb, n0, dst;
        if (r < J_QKV) { const int per = 8 * (QKVN / 32), mat = r / per, q = r - mat * per; kb = q / (QKVN / 32); n0 = (q - kb * (QKVN / 32)) * 32;
            dst = (n0 & ~255) + ((n0 >> 5) & 1) * 128 + ((n0 >> 6) & 3) * 32;
            W = A.in[8] + (size_t)mat * 1024 * QKVN; N = QKVN; O = (bf16*)(ws + WS_WQKV) + (size_t)mat * QKVN * 1024; }
        else if ((r -= J_QKV) < J_WO) { const int mat = r >> 8, q = r & 255; kb = q >> 5; n0 = (q & 31) * 32; dst = n0;
            W = A.in[11] + (size_t)mat * 1024 * 1024; N = 1024; O = (bf16*)(ws + WS_WOA) + (size_t)mat * 1024 * 1024; }
        else if ((r -= J_WO) < J_WIN) { const int per = 8 * (WINN / 32), mat = r / per, q = r - mat * per; kb = q / (WINN / 32); n0 = (q - kb * (WINN / 32)) * 32; dst = n0;
            W = A.in[12] + (size_t)mat * 1024 * WINN; N = WINN; O = (bf16*)(ws + WS_WIN) + (size_t)mat * WINP * 1024; }
        else { r -= J_WIN; const int mat = r >> 8, q = r & 255; kb = q >> 5; n0 = (q & 31) * 32; dst = n0;
            W = A.in[18] + (size_t)mat * 1024 * 1024; N = 1024; O = (bf16*)(ws + WS_WOG) + (size_t)mat * 1024 * 1024; }
        f32x4 v[16]; titem_load(W, N, kb * 128, n0, lane, v); titem_store16(v, O, 1024, kb * 128, dst, lane); }
    for (int it = gw; it < 2 * (WINP - WINN); it += NGW) { const int mat = it / (WINP - WINN), rr = WINN + it - mat * (WINP - WINN);
        GAS v4u* p = (GAS v4u*)((bf16*)(ws + WS_WIN) + ((size_t)mat * WINP + rr) * 1024) + lane; p[0] = (v4u){0u, 0u, 0u, 0u}; p[64] = (v4u){0u, 0u, 0u, 0u}; }
    for (int it = NGW - 1 - gw; it < NLAYER * 24 * 16; it += NGW) {
        const int l = it / (24 * 16), q = it - l * (24 * 16), cg = q / 16, kc = q - cg * 16;
        float s[MODROWS];
#pragma unroll
        for (int r = 0; r < MODROWS; ++r) { const float cv = (r < 8) ? A.in[1][r * 1024 + kc * 64 + lane] : A.in[3][kc * 64 + lane]; s[r] = silu_f(cv); }
        f32x4 acc[MODROWS];
#pragma unroll
        for (int r = 0; r < MODROWS; ++r) acc[r] = (f32x4){0.f, 0.f, 0.f, 0.f};
        const float* wp = A.in[4] + ((size_t)l * 1024 + kc * 64) * NMODC + cg * 256 + 4 * lane;
#pragma unroll 8
        for (int kk = 0; kk < 64; ++kk) { const f32x4 w = *(const f32x4*)(wp + (size_t)kk * NMODC);
#pragma unroll
            for (int r = 0; r < MODROWS; ++r) { const float sv = __shfl(s[r], kk); acc[r] = acc[r] + w * sv; } }
        float* op = (float*)(ws + WS_MODP) + (size_t)kc * (NLAYER * MODROWS * NMODC) + (size_t)l * MODROWS * NMODC + cg * 256 + 4 * lane;
#pragma unroll
        for (int r = 0; r < MODROWS; ++r) *(f32x4*)(op + (size_t)r * NMODC) = acc[r];
    }
    for (int m0 = gw; m0 < MT; m0 += 4 * NGW) { f32x4 x[4][4];
#pragma unroll
        for (int r = 0; r < 4; ++r) { const int m = m0 + r * NGW; if (m < MT) { const int b = m / TB, w = m - b * TB;
            const float* src = (w < CTXL) ? A.in[2] + ((size_t)b * CTXL + w) * 1024 : A.in[0] + ((size_t)b * SEQ + (w - CTXL)) * 1024; const GAS f32x4* sp = (const GAS f32x4*)src + lane;
#pragma unroll
            for (int j = 0; j < 4; ++j) x[r][j] = sp[64 * j]; } }
#pragma unroll
        for (int r = 0; r < 4; ++r) { const int m = m0 + r * NGW; if (m < MT) { GAS unsigned long long* dp = (GAS unsigned long long*)((bf16*)(ws + WS_X) + (size_t)m * 1024) + lane;
#pragma unroll
            for (int j = 0; j < 4; ++j) dp[64 * j] = f32_to_bf4(x[r][j]); } } }
    { float* par = (float*)(ws + WS_PAR); const int gt = gw * 64 + lane, NGT = NGW * 64;
#define CPL(k, src, n) float c##k##a = 0.f, c##k##b = 0.f; if (gt < (n)) c##k##a = A.in[src][gt]; if (gt + NGT < (n)) c##k##b = A.in[src][gt + NGT];
#define CPS(k, src, n, off) if (gt < (n)) par[(off) + gt] = c##k##a; if (gt + NGT < (n)) par[(off) + gt + NGT] = c##k##b; for (int i = gt + 2 * NGT; i < (n); i += NGT) par[(off) + i] = A.in[src][i];
      CPL(0, 6, 4096) CPL(1, 7, 4096) CPL(2, 9, 128) CPL(3, 10, 128) CPL(4, 13, 16384) CPL(5, 15, 16384) CPL(6, 14, 1024) CPL(7, 16, 1024) CPL(8, 17, 512) CPL(9, 19, 131072) CPL(10, 20, 128) CPL(11, 22, 262144) CPL(12, 24, 131072)
      CPS(0, 6, 4096, P_N1G) CPS(1, 7, 4096, P_N2G) CPS(2, 9, 128, P_QG) CPS(3, 10, 128, P_KG) CPS(4, 13, 16384, P_GKF) CPS(5, 15, 16384, P_GKB) CPS(6, 14, 1024, P_BGF) CPS(7, 16, 1024, P_BGB)
      CPS(8, 17, 512, P_OG) CPS(9, 19, 131072, P_WR) CPS(10, 20, 128, P_BR) CPS(11, 22, 262144, P_BGU) CPS(12, 24, 131072, P_BDN)
#undef CPL
#undef CPS
    }
    for (int idx = gw * 64 + lane; idx < SEQ * 32; idx += NGW * 64) { const int s = idx >> 5, i = idx & 31;
        const float invf = 1.0f / powf(10000.0f, (float)(i & 15) * (1.0f / 16.0f));
        const float ang = (float)((i < 16) ? (s >> 6) : (s & 63)) * invf;
        ((float*)(ws + WS_ROPE))[idx] = cosf(ang); ((float*)(ws + WS_ROPE))[SEQ * 32 + idx] = sinf(ang); }
}
__device__ __forceinline__ void p1_mod_reduce(const Args& A, int gtid, int NGT) {
    const float* P = (const float*)(A.ws + WS_MODP); float* Mo = (float*)(A.ws + WS_MOD);
    constexpr int N = NLAYER * MODROWS * NMODC;
    for (int i = gtid; i < N; i += NGT) { const int l = i / (MODROWS * NMODC), c = i % NMODC; float s = A.in[5][l * NMODC + c];
#pragma unroll
        for (int k = 0; k < 16; ++k) s += P[(size_t)k * N + i];
        Mo[i] = s; }
}
__device__ __forceinline__ void modulate_row(const bf16* xrow, const float* ng, const float* shp, const float* scp, bf16* orow, int lane, f32x4 (&y)[4], float& rs_out) {
    const GAS unsigned long long* xr = (const GAS unsigned long long*)xrow + lane;
    float ss = 0.f;
#pragma unroll
    for (int j = 0; j < 4; ++j) { y[j] = bf4_to_f32(xr[64 * j]); ss += (y[j].x * y[j].x + y[j].y * y[j].y) + (y[j].z * y[j].z + y[j].w * y[j].w); }
    const float rs = 1.0f / sqrtf(wave_sum(ss) * (1.0f / 1024.0f) + RMS_EPS); rs_out = rs;
    GAS unsigned long long* o8 = (GAS unsigned long long*)orow + lane;
#pragma unroll
    for (int j = 0; j < 4; ++j) { const f32x4 g = ((const GAS f32x4*)ng)[64 * j + lane], sh = ((const GAS f32x4*)shp)[64 * j + lane], sc = ((const GAS f32x4*)scp)[64 * j + lane];
        y[j] = (y[j] * rs) * g * (sc + 1.0f) + sh;
        o8[64 * j] = (unsigned long long)pk2(y[j].x, y[j].y) | ((unsigned long long)pk2(y[j].z, y[j].w) << 32); }
}
template <bool F8>
__device__ __forceinline__ void modulate_row2(const bf16* xa, const bf16* xb, const float* ng, const float* sha, const float* sca, const float* shb, const float* scb, unsigned char* oa, unsigned char* ob, int lane, float& rsa, float& rsb) {
    const GAS unsigned long long* pa = (const GAS unsigned long long*)xa + lane; const GAS unsigned long long* pb = (const GAS unsigned long long*)xb + lane;
    unsigned long long ra[4], rb[4]; f32x4 g[4], ha[4], ca[4], hb[4], cb[4];
#pragma unroll
    for (int j = 0; j < 4; ++j) { ra[j] = pa[64 * j]; rb[j] = pb[64 * j]; }
#pragma unroll
    for (int j = 0; j < 4; ++j) { g[j] = ((const GAS f32x4*)ng)[64 * j + lane]; ha[j] = ((const GAS f32x4*)sha)[64 * j + lane]; ca[j] = ((const GAS f32x4*)sca)[64 * j + lane]; hb[j] = ((const GAS f32x4*)shb)[64 * j + lane]; cb[j] = ((const GAS f32x4*)scb)[64 * j + lane]; }
    f32x4 ya[4], yb[4]; float sa = 0.f, sb = 0.f;
#pragma unroll
    for (int j = 0; j < 4; ++j) { ya[j] = bf4_to_f32(ra[j]); yb[j] = bf4_to_f32(rb[j]); sa += (ya[j].x * ya[j].x + ya[j].y * ya[j].y) + (ya[j].z * ya[j].z + ya[j].w * ya[j].w); sb += (yb[j].x * yb[j].x + yb[j].y * yb[j].y) + (yb[j].z * yb[j].z + yb[j].w * yb[j].w); }
    const int ln = lane_now();
#pragma unroll
    for (int o = 1; o < 64; o <<= 1) { sa += shx(sa, o, ln); sb += shx(sb, o, ln); }
    rsa = 1.0f / sqrtf(sa * (1.0f / 1024.0f) + RMS_EPS); rsb = 1.0f / sqrtf(sb * (1.0f / 1024.0f) + RMS_EPS);
#pragma unroll
    for (int j = 0; j < 4; ++j) {
        const f32x4 va = (ya[j] * rsa) * g[j] * (ca[j] + 1.0f) + ha[j], vb = (yb[j] * rsb) * g[j] * (cb[j] + 1.0f) + hb[j];
        if constexpr (F8) { ((GAS unsigned*)oa + lane)[64 * j] = pg8::pk4_fp8(va.x, va.y, va.z, va.w); ((GAS unsigned*)ob + lane)[64 * j] = pg8::pk4_fp8(vb.x, vb.y, vb.z, vb.w); }
        else { ((GAS unsigned long long*)oa + lane)[64 * j] = f32_to_bf4(va); ((GAS unsigned long long*)ob + lane)[64 * j] = f32_to_bf4(vb); } }
}
__device__ __forceinline__ void phase_modulate1(unsigned char* ws, int layer, int gw, int NGW, int lane) {
    const bf16* X = (const bf16*)(ws + WS_X); bf16* XN = (bf16*)(ws + WS_XN);
    const float* ng = PARF(ws) + P_N1G + layer * 1024; const float* Mo = (const float*)(ws + WS_MOD) + (size_t)layer * MODROWS * NMODC;
    for (int m = gw; m < MT; m += 2 * NGW) { const int m2 = (m + NGW < MT) ? m + NGW : m; const int mr = mod_row(m), mr2 = mod_row(m2); float rs, rs2;
        modulate_row2<false>(X + (size_t)m * 1024, X + (size_t)m2 * 1024, ng, Mo + (size_t)mr * NMODC + 0 * 1024, Mo + (size_t)mr * NMODC + 1 * 1024, Mo + (size_t)mr2 * NMODC + 0 * 1024, Mo + (size_t)mr2 * NMODC + 1 * 1024,
                             (unsigned char*)(XN + (size_t)m * 1024), (unsigned char*)(XN + (size_t)m2 * 1024), lane, rs, rs2); }
}
__device__ __forceinline__ void phase_qknorm_rope(unsigned char* ws, int la, int gw, int NGW, int lane) {
    bf16* Qb = (bf16*)(ws + WS_Q); bf16* Kb = (bf16*)(ws + WS_K);
    const float* qg = PARF(ws) + P_QG + la * 64; const float* kg = PARF(ws) + P_KG + la * 64; const float* ropec = (const float*)(ws + WS_ROPE); const float* ropes = ropec + SEQ * 32;
    const int i = lane & 31, hs = lane >> 5;
    for (int m = gw; m < MT; m += NGW) { const int b = m / TB, w = m - b * TB; const bool lat = w >= CTXL;
        float cs = 1.f, sn = 0.f; if (lat) { cs = ropec[(w - CTXL) * 32 + i]; sn = ropes[(w - CTXL) * 32 + i]; }
#pragma unroll 2
        for (int hh = 0; hh < 20; hh += 2) { const int hd = hh + hs;
            unsigned* p = (hd < 16) ? (unsigned*)(Qb + (size_t)m * 1024 + hd * 64) + i : (unsigned*)(Kb + (size_t)m * 256 + (hd - 16) * 64) + i;
            const float* gp = (hd < 16) ? qg : kg; const float scl = (hd < 16) ? ATT_C2 : 1.0f;
            const unsigned v = *p; const float x1 = __uint_as_float(v << 16), x2 = __uint_as_float(v & 0xffff0000u);
            float ss = x1 * x1 + x2 * x2;
#pragma unroll
            for (int o = 1; o < 32; o <<= 1) ss += shx(ss, o, lane);
            const float rs = 1.0f / sqrtf(ss * (1.0f / 64.0f) + RMS_EPS);
            const float y1 = x1 * rs * gp[2 * i], y2 = x2 * rs * gp[2 * i + 1];
            const float r1 = (y1 * cs - y2 * sn) * scl, r2 = (y1 * sn + y2 * cs) * scl;
            *p = pk2(r1, r2); }
    }
}
__device__ __forceinline__ void phase_gla_recurrent(unsigned char* ws, int lg, LAS unsigned char* lds, int tid) {
    const int unit = blockIdx.x; if (unit >= 128) return;
    const int half = unit & 1, dir = (unit >> 1) & 1, h = (unit >> 2) & 3, b = unit >> 4;
    const bf16* G = (const bf16*)(ws + WS_G);
    float* Oo = (float*)(ws + (dir ? WS_OB : WS_OF));
    const float* wg = PARF(ws) + (dir ? P_GKB : P_GKF) + (size_t)lg * 16 * 512; const float* bg = PARF(ws) + (dir ? P_BGB : P_BGF) + lg * 512;
    LAS float* qq = (LAS float*)(lds + RING_OFF); LAS float* kk = qq + 64 * 128; LAS float* dd = kk + 64 * 128; LAS float* vv = dd + 64 * 128;
    const int sd = tid & 127, st0 = tid >> 7;
    float wcol[16];
#pragma unroll
    for (int r = 0; r < 16; ++r) wcol[r] = wg[r * 512 + h * 128 + sd];
    const float bcol = bg[h * 128 + sd];
    const int c = tid >> 2, dq = tid & 3;
    float s[32];
#pragma unroll
    for (int j = 0; j < 32; ++j) s[j] = 0.f;
    const float qscale = 0.08838834764831845f;
    for (int ch = 0; ch < TB / 64; ++ch) {
        __syncthreads();
#pragma unroll 4
        for (int i = 0; i < 16; ++i) { const int tt = st0 + 4 * i, n = 64 * ch + tt;
            const int w = dir ? (n < CTXL ? (CTXL - 1 - n) : (TB + CTXL - 1 - n)) : n;
            const bf16* gr = G + ((size_t)b * TB + w) * WINP;
            const float qv = bf2f(gr[h * 128 + sd]) * qscale, kv = bf2f(gr[512 + h * 128 + sd]);
            const bf16* lp = gr + 3072 + dir * 16; float z = bcol;
#pragma unroll
            for (int r = 0; r < 16; ++r) z += bf2f(lp[r]) * wcol[r];
            const float ls = fminf(z, 0.f) - log1pf(__expf(-fabsf(z)));
            qq[tt * 128 + sd] = qv; kk[tt * 128 + sd] = kv; dd[tt * 128 + sd] = __expf(ls * (1.0f / 16.0f));
            vv[tt * 128 + sd] = bf2f(gr[1024 + h * 256 + half * 128 + sd]); }
        __syncthreads();
        for (int tt = 0; tt < 64; ++tt) { const int n = 64 * ch + tt; const int w = dir ? (n < CTXL ? (CTXL - 1 - n) : (TB + CTXL - 1 - n)) : n;
            const float v = vv[tt * 128 + c]; float acc = 0.f;
            const LAS f32x4* q4 = (const LAS f32x4*)(qq + tt * 128 + dq * 32); const LAS f32x4* k4 = (const LAS f32x4*)(kk + tt * 128 + dq * 32); const LAS f32x4* d4 = (const LAS f32x4*)(dd + tt * 128 + dq * 32);
#pragma unroll
            for (int j = 0; j < 8; ++j) { const f32x4 qv = q4[j], kv = k4[j], dv = d4[j];
                s[4 * j + 0] = s[4 * j + 0] * dv.x + kv.x * v; acc += qv.x * s[4 * j + 0];
                s[4 * j + 1] = s[4 * j + 1] * dv.y + kv.y * v; acc += qv.y * s[4 * j + 1];
                s[4 * j + 2] = s[4 * j + 2] * dv.z + kv.z * v; acc += qv.z * s[4 * j + 2];
                s[4 * j + 3] = s[4 * j + 3] * dv.w + kv.w * v; acc += qv.w * s[4 * j + 3]; }
            acc += shx(acc, 1, tid & 63); acc += shx(acc, 2, tid & 63);
            if (dq == 0) Oo[((size_t)b * TB + w) * 1024 + h * 256 + half * 128 + c] = acc; }
    }
}
__device__ __forceinline__ void phase_gla_readout(unsigned char* ws, int lg, int gw, int NGW, int lane) {
    const float* OF = (const float*)(ws + WS_OF); const float* OB = (const float*)(ws + WS_OB); const bf16* G = (const bf16*)(ws + WS_G); bf16* OG = (bf16*)(ws + WS_Q);
    const f32x4 og = ((const GAS f32x4*)(PARF(ws) + P_OG + lg * 256))[lane];
    for (int m = gw; m < MT; m += NGW) {
#pragma unroll
        for (int hh = 0; hh < 4; ++hh) { const size_t off = (size_t)m * 1024 + hh * 256 + 4 * lane;
            f32x4 o = *(const GAS f32x4*)(OF + off) + *(const GAS f32x4*)(OB + off);
            const float ss = wave_sum((o.x * o.x + o.y * o.y) + (o.z * o.z + o.w * o.w));
            const float rs = 1.0f / sqrtf(ss * (1.0f / 256.0f) + RMS_EPS);
            const unsigned long long rv = *(const GAS unsigned long long*)(G + (size_t)m * WINP + 2048 + hh * 256 + 4 * lane);
            const float r0 = __uint_as_float((unsigned)(rv & 0xffffu) << 16), r1 = __uint_as_float((unsigned)(rv >> 16) << 16), r2 = __uint_as_float((unsigned)((rv >> 32) & 0xffffu) << 16), r3 = __uint_as_float((unsigned)(rv >> 48) << 16);
            o = o * rs * og;
            o.x *= silu_f(r0); o.y *= silu_f(r1); o.z *= silu_f(r2); o.w *= silu_f(r3);
            *(GAS unsigned long long*)(OG + off) = (unsigned long long)pk2(o.x, o.y) | ((unsigned long long)pk2(o.z, o.w) << 32); }
    }
}
constexpr size_t WS_GQ = WS_XG, WS_GKH = WS_XG + 68 * MiB, WS_GKT = WS_XG + 136 * MiB, WS_GVT = WS_XG + 204 * MiB, WS_GDL = WS_ACT, WS_SX = WS_OF;
static_assert((size_t)2176 * 2 * 16384 <= 68 * MiB && (size_t)2176 * 256 * 64 * 2 <= 68 * MiB && (size_t)64 * 68 * 65536 <= 272 * MiB, "gla buffers");
typedef float f32x16 __attribute__((ext_vector_type(16)));
__device__ __forceinline__ float log_sigmoid_fast(float z) { return fminf(z, 0.f) - __logf(1.0f + __expf(-fabsf(z))); }

struct G0Raw { unsigned qk[8][2]; v4u lfb; };
__device__ __forceinline__ void g0_load(G0Raw& R, unsigned char* ws, int cn, int tid) {
    const bf16* G = (const bf16*)(ws + WS_G);
    const int d2 = tid & 63, tb = tid >> 6, n = cn % 68, bh = cn / 68, h = bh & 3, b = bh >> 2;
    const size_t r0 = (size_t)b * TB + 64 * n;
#pragma unroll
    for (int j = 0; j < 8; ++j) { const bf16* gr = G + (r0 + 8 * tb + j) * WINP; R.qk[j][0] = *(const GAS unsigned*)(gr + h * 128 + 2 * d2); R.qk[j][1] = *(const GAS unsigned*)(gr + 512 + h * 128 + 2 * d2); }
    R.lfb = *(const GAS v4u*)(G + (r0 + ((tid & 255) >> 2)) * WINP + 3072 + 8 * (tid & 3));
}
__device__ __forceinline__ void g0_vload(unsigned (&raw)[32], const unsigned char* ws, int idx, int h, int dv, int th) {
    const int b = idx / 68, n = idx - b * 68; const bf16* vp = (const bf16*)(ws + WS_G) + ((size_t)b * TB + 64 * n + 32 * th) * WINP + 1024 + h * 256 + dv;
#pragma unroll
    for (int j = 0; j < 32; ++j) raw[j] = (unsigned)((const GAS bf16*)vp)[(size_t)j * WINP];
}
__device__ __forceinline__ void g0_vstore(const unsigned (&raw)[32], unsigned char* ws, int idx, int h, int dv, int th) {
    const int b = idx / 68, n = idx - b * 68, cn = (b * 4 + h) * 68 + n;
    unsigned char* vo = ws + WS_GVT + (size_t)cn * 32768 + (size_t)(((2 * th) * 8 + (dv >> 5)) * 64 + (dv & 31)) * 16;
    unsigned wv[16];
#pragma unroll
    for (int j = 0; j < 16; ++j) wv[j] = raw[2 * j] | (raw[2 * j + 1] << 16);
#pragma unroll
    for (int ql = 0; ql < 2; ++ql)
#pragma unroll
        for (int hq = 0; hq < 2; ++hq) *(GAS v4u*)(vo + ql * 8192 + hq * 512) = (v4u){wv[8 * ql + 2 * hq], wv[8 * ql + 2 * hq + 1], wv[8 * ql + 2 * hq + 4], wv[8 * ql + 2 * hq + 5]};
}
__device__ __forceinline__ void phase_gla_g0v(unsigned char* ws, int tid, int Gp, int bxp) {
    const int G4 = Gp >> 2, h = bxp & 3, wq = bxp >> 2;
    if (wq >= G4) return;
    const int dv = tid & 255, th = tid >> 8; unsigned ra[32], rb[32]; int idx = wq;
    if (idx < 544) g0_vload(ra, ws, idx, h, dv, th);
    while (idx + 2 * G4 < 544) { g0_vload(rb, ws, idx + G4, h, dv, th); g0_vstore(ra, ws, idx, h, dv, th); g0_vload(ra, ws, idx + 2 * G4, h, dv, th); g0_vstore(rb, ws, idx + G4, h, dv, th); idx += 2 * G4; }
    if (idx < 544) { const bool hb = idx + G4 < 544; if (hb) g0_vload(rb, ws, idx + G4, h, dv, th); g0_vstore(ra, ws, idx, h, dv, th); if (hb) g0_vstore(rb, ws, idx + G4, h, dv, th); }
}
__device__ __forceinline__ void phase_gla_g0(unsigned char* ws, int lg, LAS unsigned char* lds, int tid, int Gp, int bxp) {
    LAS float* tot = (LAS float*)(lds + RING_OFF);
    LAS unsigned char* lfl = lds + RING_OFF + 8192;
    const int d2 = tid & 63, tb = tid >> 6;
    const int G4 = Gp >> 2, h = bxp & 3, wq = bxp >> 2;
    if (wq >= G4 || wq >= 544) return;
        float wf0[16], wf1[16], wb0[16], wb1[16];
        { const float* wgf = PARF(ws) + P_GKF + (size_t)lg * 16 * 512 + h * 128 + 2 * d2; const float* wgb = PARF(ws) + P_GKB + (size_t)lg * 16 * 512 + h * 128 + 2 * d2;
#pragma unroll
          for (int r = 0; r < 16; ++r) { const f32x2 a = *(const GAS f32x2*)(wgf + r * 512), c = *(const GAS f32x2*)(wgb + r * 512); wf0[r] = a.x; wf1[r] = a.y; wb0[r] = c.x; wb1[r] = c.y; } }
        const f32x2 bf_ = *(const GAS f32x2*)(PARF(ws) + P_BGF + lg * 512 + h * 128 + 2 * d2), bb_ = *(const GAS f32x2*)(PARF(ws) + P_BGB + lg * 512 + h * 128 + 2 * d2);
    G0Raw R; g0_load(R, ws, ((wq / 68) * 4 + h) * 68 + wq % 68, tid);
    for (int idx = wq; idx < 544; idx += G4) {
        const int b = idx / 68, n = idx - b * 68, cn = (b * 4 + h) * 68 + n;
        __syncthreads();
        if (tid < 256) *(LAS v4u*)(lfl + tid * 16) = R.lfb;
        unsigned qk[8][2];
#pragma unroll
        for (int j = 0; j < 8; ++j) { qk[j][0] = R.qk[j][0]; qk[j][1] = R.qk[j][1]; }
        __syncthreads();
        if (idx + G4 < 544) { const int i2 = idx + G4, b2 = i2 / 68; g0_load(R, ws, (b2 * 4 + h) * 68 + (i2 - b2 * 68), tid); }
        float gf0[8], gf1[8], gb0[8], gb1[8];
#pragma unroll
        for (int j = 0; j < 8; ++j) { const LAS v4u* lp = (const LAS v4u*)(lfl + (8 * tb + j) * 64);
            const v4u l0 = lp[0], l1 = lp[1], l2 = lp[2], l3 = lp[3];
            float lf[16], lb[16];
            lf[0] = __uint_as_float(l0.x << 16); lf[1] = __uint_as_float(l0.x & 0xffff0000u); lf[2] = __uint_as_float(l0.y << 16); lf[3] = __uint_as_float(l0.y & 0xffff0000u);
            lf[4] = __uint_as_float(l0.z << 16); lf[5] = __uint_as_float(l0.z & 0xffff0000u); lf[6] = __uint_as_float(l0.w << 16); lf[7] = __uint_as_float(l0.w & 0xffff0000u);
            lf[8] = __uint_as_float(l1.x << 16); lf[9] = __uint_as_float(l1.x & 0xffff0000u); lf[10] = __uint_as_float(l1.y << 16); lf[11] = __uint_as_float(l1.y & 0xffff0000u);
            lf[12] = __uint_as_float(l1.z << 16); lf[13] = __uint_as_float(l1.z & 0xffff0000u); lf[14] = __uint_as_float(l1.w << 16); lf[15] = __uint_as_float(l1.w & 0xffff0000u);
            lb[0] = __uint_as_float(l2.x << 16); lb[1] = __uint_as_float(l2.x & 0xffff0000u); lb[2] = __uint_as_float(l2.y << 16); lb[3] = __uint_as_float(l2.y & 0xffff0000u);
            lb[4] = __uint_as_float(l2.z << 16); lb[5] = __uint_as_float(l2.z & 0xffff0000u); lb[6] = __uint_as_float(l2.w << 16); lb[7] = __uint_as_float(l2.w & 0xffff0000u);
            lb[8] = __uint_as_float(l3.x << 16); lb[9] = __uint_as_float(l3.x & 0xffff0000u); lb[10] = __uint_as_float(l3.y << 16); lb[11] = __uint_as_float(l3.y & 0xffff0000u);
            lb[12] = __uint_as_float(l3.z << 16); lb[13] = __uint_as_float(l3.z & 0xffff0000u); lb[14] = __uint_as_float(l3.w << 16); lb[15] = __uint_as_float(l3.w & 0xffff0000u);
            float zf0 = bf_.x, zf1 = bf_.y, zb0 = bb_.x, zb1 = bb_.y;
#pragma unroll
            for (int r = 0; r < 16; ++r) { zf0 += lf[r] * wf0[r]; zf1 += lf[r] * wf1[r]; zb0 += lb[r] * wb0[r]; zb1 += lb[r] * wb1[r]; }
            gf0[j] = log_sigmoid_fast(zf0) * 0.0625f; gf1[j] = log_sigmoid_fast(zf1) * 0.0625f; gb0[j] = log_sigmoid_fast(zb0) * 0.0625f; gb1[j] = log_sigmoid_fast(zb1) * 0.0625f; }
#pragma unroll
        for (int j = 1; j < 8; ++j) { gf0[j] += gf0[j - 1]; gf1[j] += gf1[j - 1]; gb0[7 - j] += gb0[8 - j]; gb1[7 - j] += gb1[8 - j]; }
        *(LAS f32x2*)(tot + (0 * 8 + tb) * 128 + 2 * d2) = (f32x2){gf0[7], gf1[7]}; *(LAS f32x2*)(tot + (1 * 8 + tb) * 128 + 2 * d2) = (f32x2){gb0[0], gb1[0]};
        __syncthreads();
        float pf0 = 0.f, pf1 = 0.f, pb0 = 0.f, pb1 = 0.f, lf0 = 0.f, lf1 = 0.f, lb0 = 0.f, lb1 = 0.f;
#pragma unroll
        for (int q = 0; q < 8; ++q) { const f32x2 a = *(const LAS f32x2*)(tot + (0 * 8 + q) * 128 + 2 * d2), c = *(const LAS f32x2*)(tot + (1 * 8 + q) * 128 + 2 * d2);
            lf0 += a.x; lf1 += a.y; lb0 += c.x; lb1 += c.y;
            if (q < tb) { pf0 += a.x; pf1 += a.y; } if (q > tb) { pb0 += c.x; pb1 += c.y; } }
        const size_t itf = (size_t)cn * 2, itb = itf + 1;
        bf16* Qf = (bf16*)(ws + WS_GQ) + itf * 8192; bf16* Qb = Qf + 8192; bf16* Kf = (bf16*)(ws + WS_GKH) + itf * 8192; bf16* Kb = Kf + 8192;
        const float elf0 = __expf(lf0), elf1 = __expf(lf1), elb0 = __expf(lb0), elb1 = __expf(lb1);
        float ktf0[8], ktf1[8], ktb0[8], ktb1[8];
#pragma unroll
        for (int j = 0; j < 8; ++j) { const int t = 8 * tb + j;
            const float q0 = __uint_as_float(qk[j][0] << 16) * 0.08838834764831845f, q1 = __uint_as_float(qk[j][0] & 0xffff0000u) * 0.08838834764831845f;
            const float k0 = __uint_as_float(qk[j][1] << 16), k1 = __uint_as_float(qk[j][1] & 0xffff0000u);
            const float ef0 = __expf(pf0 + gf0[j]), ef1 = __expf(pf1 + gf1[j]), eb0 = __expf(pb0 + gb0[j]), eb1 = __expf(pb1 + gb1[j]);
            const float rf0 = __builtin_amdgcn_rcpf(ef0), rf1 = __builtin_amdgcn_rcpf(ef1), rb0 = __builtin_amdgcn_rcpf(eb0), rb1 = __builtin_amdgcn_rcpf(eb1);
            *(GAS unsigned*)(Qf + t * 128 + 2 * d2) = pk2(q0 * ef0, q1 * ef1); *(GAS unsigned*)(Qb + t * 128 + 2 * d2) = pk2(q0 * eb0, q1 * eb1);
            *(GAS unsigned*)(Kf + t * 128 + 2 * d2) = pk2(k0 * rf0, k1 * rf1); *(GAS unsigned*)(Kb + t * 128 + 2 * d2) = pk2(k0 * rb0, k1 * rb1);
            ktf0[j] = k0 * rf0 * elf0; ktf1[j] = k1 * rf1 * elf1; ktb0[j] = k0 * rb0 * elb0; ktb1[j] = k1 * rb1 * elb1; }
        {
          unsigned char* Tf = ws + WS_GKT + itf * 16384 + (size_t)((((tb >> 1) * 4 + (d2 >> 4)) * 64 + ((2 * d2) & 31)) * 16 + 8 * (tb & 1)); unsigned char* Tb = Tf + 16384;
          *(GAS unsigned long long*)(Tf) = (unsigned long long)pk2(ktf0[0], ktf0[1]) | ((unsigned long long)pk2(ktf0[2], ktf0[3]) << 32);
          *(GAS unsigned long long*)(Tf + 512) = (unsigned long long)pk2(ktf0[4], ktf0[5]) | ((unsigned long long)pk2(ktf0[6], ktf0[7]) << 32);
          *(GAS unsigned long long*)(Tf + 16) = (unsigned long long)pk2(ktf1[0], ktf1[1]) | ((unsigned long long)pk2(ktf1[2], ktf1[3]) << 32);
          *(GAS unsigned long long*)(Tf + 528) = (unsigned long long)pk2(ktf1[4], ktf1[5]) | ((unsigned long long)pk2(ktf1[6], ktf1[7]) << 32);
          *(GAS unsigned long long*)(Tb) = (unsigned long long)pk2(ktb0[0], ktb0[1]) | ((unsigned long long)pk2(ktb0[2], ktb0[3]) << 32);
          *(GAS unsigned long long*)(Tb + 512) = (unsigned long long)pk2(ktb0[4], ktb0[5]) | ((unsigned long long)pk2(ktb0[6], ktb0[7]) << 32);
          *(GAS unsigned long long*)(Tb + 16) = (unsigned long long)pk2(ktb1[0], ktb1[1]) | ((unsigned long long)pk2(ktb1[2], ktb1[3]) << 32);
          *(GAS unsigned long long*)(Tb + 528) = (unsigned long long)pk2(ktb1[4], ktb1[5]) | ((unsigned long long)pk2(ktb1[6], ktb1[7]) << 32); }
        if (tb == 0) { float* DLp = (float*)(ws + WS_GDL) + itf * 128 + 2 * d2; *(GAS f32x2*)DLp = (f32x2){elf0, elf1}; *(GAS f32x2*)(DLp + 128) = (f32x2){elb0, elb1}; }
    }
}
struct G12Ops { bf16x8 a[4], b[4]; f32x4 d[4]; };
__device__ __forceinline__ void g12_load(G12Ops& o, unsigned char* ws, int bh, int dir, int m, int kb, int vb, int r, int hh) {
    const int n = dir ? (m < 4 ? 3 - m : 71 - m) : m; const size_t cn = (size_t)bh * 68 + n, item = cn * 2 + dir;
    const GAS bf16x8* ap = (const GAS bf16x8*)(ws + WS_GKT + item * 16384) + kb * 64 + (hh * 32 + r);
    const GAS bf16x8* bp = (const GAS bf16x8*)(ws + WS_GVT + cn * 32768) + vb * 64 + (hh * 32 + r);
    const float* dp = (const float*)(ws + WS_GDL) + item * 128 + 32 * kb + 4 * hh;
#pragma unroll
    for (int ks = 0; ks < 4; ++ks) { o.a[ks] = ap[ks * 256]; o.b[ks] = bp[ks * 512]; o.d[ks] = *(const GAS f32x4*)(dp + 8 * ks); }
}
__device__ __forceinline__ void phase_gla_g12(unsigned char* ws, LAS unsigned char* lds, int gwv, int wave, int lane) {
    if (gwv >= 2048) return;
    const int chain = gwv >> 5, blk = gwv & 31, kb = blk & 3, vb = blk >> 2, dir = chain & 1, bh = chain >> 1;
    const int r = lane & 31, hh = lane >> 5;
    LAS unsigned char* wl = lds + RING_OFF + wave * 2048;
    f32x16 acc;
#pragma unroll
    for (int g = 0; g < 16; ++g) acc[g] = 0.f;
    G12Ops o0, o1, o2;
    g12_load(o0, ws, bh, dir, 0, kb, vb, r, hh); g12_load(o1, ws, bh, dir, 1, kb, vb, r, hh);
#define G12_STEP(CUR, m_) do { const int mm_ = (m_); const int n = dir ? (mm_ < 4 ? 3 - mm_ : 71 - mm_) : mm_; \
        _Pragma("unroll") for (int gg = 0; gg < 4; ++gg) *(LAS unsigned long long*)(wl + (((gg >> 1) * 64 + (gg & 1) * 32 + r) * 16 + 8 * hh)) = (unsigned long long)pk2(acc[4 * gg], acc[4 * gg + 1]) | ((unsigned long long)pk2(acc[4 * gg + 2], acc[4 * gg + 3]) << 32); \
        LDS_WAIT(); const v4u s0 = *(const LAS v4u*)(wl + lane * 16), s1 = *(const LAS v4u*)(wl + 1024 + lane * 16); LDS_WAIT(); \
        { bf16* sp = (bf16*)(ws + WS_SX) + ((size_t)(bh * 2 + dir) * 68 + n) * 32768 + (size_t)(kb * 8 + vb) * 1024; ((GAS v4u*)sp)[lane] = s0; ((GAS v4u*)sp)[64 + lane] = s1; } \
        _Pragma("unroll") for (int gg = 0; gg < 4; ++gg) { acc[4 * gg] *= CUR.d[gg].x; acc[4 * gg + 1] *= CUR.d[gg].y; acc[4 * gg + 2] *= CUR.d[gg].z; acc[4 * gg + 3] *= CUR.d[gg].w; } \
        _Pragma("unroll") for (int ks = 0; ks < 4; ++ks) acc = __builtin_amdgcn_mfma_f32_32x32x16_bf16(CUR.a[ks], CUR.b[ks], acc, 0, 0, 0); } while (0)
    for (int m = 0; m < 66; m += 3) {
        g12_load(o2, ws, bh, dir, m + 2, kb, vb, r, hh); G12_STEP(o0, m);
        g12_load(o0, ws, bh, dir, m + 3, kb, vb, r, hh); G12_STEP(o1, m + 1);
        g12_load(o1, ws, bh, dir, (m + 4 < 68) ? m + 4 : 67, kb, vb, r, hh); G12_STEP(o2, m + 2);
    }
    G12_STEP(o0, 66); G12_STEP(o1, 67);
#undef G12_STEP
}
constexpr int G3_RS = 272, G3_TILE = 64 * G3_RS, G3_OL = 4 * G3_TILE  , G3_LD = 260;
static_assert(G3_OL + 64 * G3_LD * 4 <= MISC_OFF, "G3 LDS");
__device__ __forceinline__ void phase_gla_g3(unsigned char* ws, int lg, LAS unsigned char* lds, int tid) {
    const int lane = tid & 63, wave = __builtin_amdgcn_readfirstlane(tid >> 6), r = lane & 31, hh = lane >> 5, vb = wave;
    LAS unsigned char* TL = lds + RING_OFF; LAS float* OL = (LAS float*)(lds + RING_OFF + G3_OL);
    const bf16* G = (const bf16*)(ws + WS_G); bf16* OG = (bf16*)(ws + WS_Q);
    v4u st[4][2]; bf16x8 sA[8];
#define G3_REQUEST(cn_) do { \
        _Pragma("unroll") for (int tl_ = 0; tl_ < 4; ++tl_) { const bf16* src_ = (const bf16*)(ws + ((tl_ & 1) ? WS_GKH : WS_GQ)) + ((size_t)(cn_) * 2 + (tl_ >> 1)) * 8192; \
            _Pragma("unroll") for (int j_ = 0; j_ < 2; ++j_) st[tl_][j_] = ((const GAS v4u*)src_)[tid + 512 * j_]; } } while (0)
    if ((int)blockIdx.x < 2176) G3_REQUEST((int)blockIdx.x);
    for (int cn = blockIdx.x; cn < 2176; cn += gridDim.x) {
        const int n = cn % 68, bh = cn / 68, h = bh & 3, b = bh >> 2;
        const GAS bf16x8* SxB = (const GAS bf16x8*)((const bf16*)(ws + WS_SX) + ((size_t)(bh * 2 + 1) * 68 + n) * 32768 + (size_t)vb * 1024) + lane;
        const GAS bf16x8* Vt = (const GAS bf16x8*)(ws + WS_GVT + (size_t)cn * 32768) + vb * 64 + lane;
        bf16x8 sB[8], vf[4];
        { const GAS bf16x8* SxA = SxB - 68 * 4096;
#pragma unroll
          for (int s = 0; s < 8; ++s) sA[s] = SxA[(s >> 1) * 1024 + (s & 1) * 64]; }
        __syncthreads();
#pragma unroll
        for (int tl = 0; tl < 4; ++tl)
#pragma unroll
            for (int j = 0; j < 2; ++j) { const int q = tid + 512 * j, row = q >> 4, ch = q & 15; *(LAS v4u*)(TL + tl * G3_TILE + row * G3_RS + ch * 16) = st[tl][j]; }
        __syncthreads();
        f32x16 P00, P01, P10, P11, O0, O1;
#pragma unroll
        for (int g = 0; g < 16; ++g) { P00[g] = 0.f; P01[g] = 0.f; P10[g] = 0.f; P11[g] = 0.f; O0[g] = 0.f; O1[g] = 0.f; }
#pragma unroll
        for (int dir = 0; dir < 2; ++dir) {
            const LAS unsigned char* Qt = TL + (2 * dir) * G3_TILE + r * G3_RS + 16 * hh; const LAS unsigned char* Kh = TL + (2 * dir + 1) * G3_TILE + r * G3_RS + 16 * hh;
            if (dir == 0) {
#pragma unroll
                for (int s = 0; s < 8; ++s) sB[s] = SxB[(s >> 1) * 1024 + (s & 1) * 64];
            } else {
#pragma unroll
                for (int q = 0; q < 4; ++q) vf[q] = Vt[q * 512];
            }
            __builtin_amdgcn_sched_barrier(0);
            f32x16 X00, X11, Xoff;
#pragma unroll
            for (int g = 0; g < 16; ++g) { X00[g] = 0.f; X11[g] = 0.f; Xoff[g] = 0.f; }
#pragma unroll
            for (int s = 0; s < 8; ++s) {
                const bf16x8 q0 = *(const LAS bf16x8*)(Qt + 32 * s), q1 = *(const LAS bf16x8*)(Qt + 32 * G3_RS + 32 * s);
                const bf16x8 k0 = *(const LAS bf16x8*)(Kh + 32 * s), k1 = *(const LAS bf16x8*)(Kh + 32 * G3_RS + 32 * s);
                const bf16x8 sx = dir ? sB[s] : sA[s];
                X00 = __builtin_amdgcn_mfma_f32_32x32x16_bf16(k0, q0, X00, 0, 0, 0);
                X11 = __builtin_amdgcn_mfma_f32_32x32x16_bf16(k1, q1, X11, 0, 0, 0);
                if (dir == 0) Xoff = __builtin_amdgcn_mfma_f32_32x32x16_bf16(k0, q1, Xoff, 0, 0, 0); else Xoff = __builtin_amdgcn_mfma_f32_32x32x16_bf16(k1, q0, Xoff, 0, 0, 0);
                O0 = __builtin_amdgcn_mfma_f32_32x32x16_bf16(q0, sx, O0, 0, 0, 0); O1 = __builtin_amdgcn_mfma_f32_32x32x16_bf16(q1, sx, O1, 0, 0, 0); }
#pragma unroll
            for (int g = 0; g < 16; ++g) { const int tj = (g & 3) + 8 * (g >> 2) + 4 * hh; const bool keep = dir ? (tj >= r) : (tj <= r);
                P00[g] += keep ? X00[g] : 0.f; P11[g] += keep ? X11[g] : 0.f;
                if (dir == 0) P01[g] += Xoff[g]; else P10[g] += Xoff[g]; }
        }
        {
#pragma unroll
          for (int jb = 0; jb < 2; ++jb)
#pragma unroll
            for (int s2 = 0; s2 < 2; ++s2) { const bf16x8 bfv = vf[2 * jb + s2];
                const f32x16& Pa = jb ? P10 : P00; const f32x16& Pb = jb ? P11 : P01;
                const bf16x8 a0 = __builtin_bit_cast(bf16x8, ((v4u){pk2(Pa[8 * s2 + 0], Pa[8 * s2 + 1]), pk2(Pa[8 * s2 + 2], Pa[8 * s2 + 3]), pk2(Pa[8 * s2 + 4], Pa[8 * s2 + 5]), pk2(Pa[8 * s2 + 6], Pa[8 * s2 + 7])}));
                const bf16x8 a1 = __builtin_bit_cast(bf16x8, ((v4u){pk2(Pb[8 * s2 + 0], Pb[8 * s2 + 1]), pk2(Pb[8 * s2 + 2], Pb[8 * s2 + 3]), pk2(Pb[8 * s2 + 4], Pb[8 * s2 + 5]), pk2(Pb[8 * s2 + 6], Pb[8 * s2 + 7])}));
                O0 = __builtin_amdgcn_mfma_f32_32x32x16_bf16(a0, bfv, O0, 0, 0, 0); O1 = __builtin_amdgcn_mfma_f32_32x32x16_bf16(a1, bfv, O1, 0, 0, 0); } }
        const int rt_ = tid >> 3, rcc_ = tid & 7; const size_t rrow_ = (size_t)b * TB + 64 * n + rt_;
        v4u rvv[4]; f32x4 ogv[8];
        { const GAS v4u* rp = (const GAS v4u*)(G + rrow_ * WINP + 2048 + h * 256 + 32 * rcc_); const GAS f32x4* gp = (const GAS f32x4*)(PARF(ws) + P_OG + lg * 256 + 32 * rcc_);
#pragma unroll
          for (int j = 0; j < 4; ++j) { rvv[j] = rp[j]; ogv[2 * j] = gp[2 * j]; ogv[2 * j + 1] = gp[2 * j + 1]; } }
        __builtin_amdgcn_sched_barrier(0);
        if (cn + (int)gridDim.x < 2176) G3_REQUEST(cn + (int)gridDim.x);
        __builtin_amdgcn_sched_barrier(0);
#pragma unroll
        for (int g = 0; g < 16; ++g) { const int t = (g & 3) + 8 * (g >> 2) + 4 * hh; OL[t * G3_LD + 32 * vb + r] = O0[g]; OL[(32 + t) * G3_LD + 32 * vb + r] = O1[g]; }
        __syncthreads();
        { const int t = tid >> 3, cc = tid & 7; const LAS f32x4* op = (const LAS f32x4*)(OL + t * G3_LD + 32 * cc);
          f32x4 o[8]; float ss = 0.f;
#pragma unroll
          for (int j = 0; j < 8; ++j) { o[j] = op[j]; ss += (o[j].x * o[j].x + o[j].y * o[j].y) + (o[j].z * o[j].z + o[j].w * o[j].w); }
          ss += __shfl_xor(ss, 1); ss += __shfl_xor(ss, 2); ss += __shfl_xor(ss, 4);
          const float rs = 1.0f / sqrtf(ss * (1.0f / 256.0f) + RMS_EPS);
          GAS v4u* dst = (GAS v4u*)(OG + rrow_ * 1024 + h * 256 + 32 * cc);
#pragma unroll
          for (int j = 0; j < 4; ++j) { const v4u rv = rvv[j]; const f32x4 g0 = ogv[2 * j], g1 = ogv[2 * j + 1]; const f32x4 a = o[2 * j] * rs * g0, c2 = o[2 * j + 1] * rs * g1;
              v4u w;
              w.x = pk2(a.x * silu_f(__uint_as_float(rv.x << 16)), a.y * silu_f(__uint_as_float(rv.x & 0xffff0000u)));
              w.y = pk2(a.z * silu_f(__uint_as_float(rv.y << 16)), a.w * silu_f(__uint_as_float(rv.y & 0xffff0000u)));
              w.z = pk2(c2.x * silu_f(__uint_as_float(rv.z << 16)), c2.y * silu_f(__uint_as_float(rv.z & 0xffff0000u)));
              w.w = pk2(c2.z * silu_f(__uint_as_float(rv.w << 16)), c2.w * silu_f(__uint_as_float(rv.w & 0xffff0000u)));
              dst[j] = w; } }
    }
#undef G3_REQUEST
}
constexpr int WIMG_RS = 2064;
static_assert(2 * 32 * WIMG_RS <= LDS_AUX, "router images below the aux tables");
__device__ __forceinline__ void phase_modulate2_route(unsigned char* ws, int layer, LAS unsigned char* lds, int vcu, int wave, int lane, int tid, bool dummy = false) {
    const bf16* X = (const bf16*)(ws + WS_X); bf16* XN = (bf16*)(ws + WS_XN);
    const float* ng = PARF(ws) + P_N2G + layer * 1024; const float* Mo = (const float*)(ws + WS_MOD) + (size_t)layer * MODROWS * NMODC;
    LAS unsigned char* WHI = lds + RING_OFF; LAS unsigned char* WLO = WHI + 32 * WIMG_RS;
    LAS unsigned* lcnt = (LAS unsigned*)(lds + AUX_LCNT); LAS unsigned* gb = (LAS unsigned*)(lds + AUX_GB); LAS unsigned* ent = (LAS unsigned*)(lds + AUX_ENT); LAS float* rsl = (LAS float*)(lds + AUX_RS);
    { const float* wsrc = PARF(ws) + P_WR + (size_t)layer * 1024 * 32;
      for (int idx = tid; idx < 1024 * 32; idx += NWAVES * 64) { const int k = idx >> 5, e = idx & 31; const float w = wsrc[idx]; const unsigned hi = f2bf(w), lo = f2bf(w - __uint_as_float(hi << 16));
          *(LAS unsigned short*)(WHI + e * WIMG_RS + 2 * k) = (unsigned short)hi; *(LAS unsigned short*)(WLO + e * WIMG_RS + 2 * k) = (unsigned short)lo; }
      if (tid < 32) lcnt[tid] = 0u; }
    gu32* cnt = (gu32*)(ws + WS_CTL) + CW_CNT + (layer + (dummy ? 4 : 0)) * 32 * 16;
    unsigned char* sbase = dummy ? ws + WS_XG : ws;
    const bool lastl = (layer == NLAYER - 1);
  for (int grp = vcu; grp < MT / 136; grp += (int)gridDim.x) {
    const int rbase = grp * 136;
    if (grp != vcu) { __syncthreads(); if (tid < 32) lcnt[tid] = 0u; }
    for (int rl = wave; rl < 136; rl += 2 * NWAVES) {
        const int rl2 = (rl + NWAVES < 136) ? rl + NWAVES : rl; const int m = rbase + rl, m2 = rbase + rl2, mr = mod_row(m), mr2 = mod_row(m2);
        float rs, rs2;
        modulate_row2<true>(X + (size_t)m * 1024, X + (size_t)m2 * 1024, ng, Mo + (size_t)mr * NMODC + 3 * 1024, Mo + (size_t)mr * NMODC + 4 * 1024, Mo + (size_t)mr2 * NMODC + 3 * 1024, Mo + (size_t)mr2 * NMODC + 4 * 1024,
                      ws + WS_XN8 + (size_t)m * 1024, ws + WS_XN8 + (size_t)m2 * 1024, lane, rs, rs2);
        if (lane == 0) { rsl[rl] = rs; rsl[rl2] = rs2; } }
    __syncthreads();
    if (wave < 5) {
        const int r = lane & 31, hh = lane >> 5; const int rl = (32 * wave + r < 136) ? 32 * wave + r : 135; const int m = rbase + rl, mr = mod_row(m);
        const float rsr = rsl[rl];
        const bf16* xp = X + (size_t)m * 1024 + 8 * hh; const float* gp = ng + 8 * hh; const float* scp = Mo + (size_t)mr * NMODC + 4 * 1024 + 8 * hh; const float* shp = Mo + (size_t)mr * NMODC + 3 * 1024 + 8 * hh;
        const LAS unsigned char* wh = WHI + r * WIMG_RS + 16 * hh; const LAS unsigned char* wl = WLO + r * WIMG_RS + 16 * hh;
        f32x16 acc;
#pragma unroll
        for (int g = 0; g < 16; ++g) acc[g] = 0.f;
#pragma unroll 2
        for (int s = 0; s < 64; ++s) {
            const v4u xr8 = *(const GAS v4u*)(xp + 16 * s); const f32x4 x0 = (f32x4){__uint_as_float(xr8.x << 16), __uint_as_float(xr8.x & 0xffff0000u), __uint_as_float(xr8.y << 16), __uint_as_float(xr8.y & 0xffff0000u)}, x1 = (f32x4){__uint_as_float(xr8.z << 16), __uint_as_float(xr8.z & 0xffff0000u), __uint_as_float(xr8.w << 16), __uint_as_float(xr8.w & 0xffff0000u)}; const f32x4 g0 = *(const GAS f32x4*)(gp + 16 * s), g1 = *(const GAS f32x4*)(gp + 16 * s + 4);
            const f32x4 c0 = *(const GAS f32x4*)(scp + 16 * s), c1 = *(const GAS f32x4*)(scp + 16 * s + 4), h0 = *(const GAS f32x4*)(shp + 16 * s), h1 = *(const GAS f32x4*)(shp + 16 * s + 4);
            const f32x4 y0 = (x0 * rsr) * g0 * (c0 + 1.0f) + h0, y1 = (x1 * rsr) * g1 * (c1 + 1.0f) + h1;
            v4u ph, pl;
            ph.x = pg8::cvt_pk_bf16(y0.x, y0.y); ph.y = pg8::cvt_pk_bf16(y0.z, y0.w); ph.z = pg8::cvt_pk_bf16(y1.x, y1.y); ph.w = pg8::cvt_pk_bf16(y1.z, y1.w);
            pl.x = pg8::cvt_pk_bf16(y0.x - __uint_as_float(ph.x << 16), y0.y - __uint_as_float(ph.x & 0xffff0000u)); pl.y = pg8::cvt_pk_bf16(y0.z - __uint_as_float(ph.y << 16), y0.w - __uint_as_float(ph.y & 0xffff0000u));
            pl.z = pg8::cvt_pk_bf16(y1.x - __uint_as_float(ph.z << 16), y1.y - __uint_as_float(ph.z & 0xffff0000u)); pl.w = pg8::cvt_pk_bf16(y1.z - __uint_as_float(ph.w << 16), y1.w - __uint_as_float(ph.w & 0xffff0000u));
            const bf16x8 ahi = __builtin_bit_cast(bf16x8, ph), alo = __builtin_bit_cast(bf16x8, pl);
            const bf16x8 bhi = *(const LAS bf16x8*)(wh + 32 * s), blo = *(const LAS bf16x8*)(wl + 32 * s);
            acc = __builtin_amdgcn_mfma_f32_32x32x16_bf16(ahi, bhi, acc, 0, 0, 0); acc = __builtin_amdgcn_mfma_f32_32x32x16_bf16(alo, bhi, acc, 0, 0, 0); acc = __builtin_amdgcn_mfma_f32_32x32x16_bf16(ahi, blo, acc, 0, 0, 0); }
        const float brt = (PARF(ws) + P_BR)[layer * 32 + r];
#pragma unroll
        for (int g = 0; g < 16; ++g) { const int rowl = 32 * wave + (g & 3) + 8 * (g >> 2) + 4 * hh;
            float v = acc[g] + brt; float tv[4]; int te[4];
#pragma unroll
            for (int k = 0; k < 4; ++k) { float mx = v;
#pragma unroll
                for (int o = 1; o < 32; o <<= 1) mx = fmaxf(mx, shx(mx, o, lane));
                const unsigned long long bm = __ballot(v == mx); const unsigned hm = hh ? (unsigned)(bm >> 32) : (unsigned)bm; const int first = __ffs((int)hm) - 1;
                te[k] = first; tv[k] = mx; if (r == first) v = -INFINITY; }
            const bool valid = rowl < 136 && !(lastl && mod_row(rbase + (rowl < 136 ? rowl : 135)) == 8);
            if (r == 0 && rowl < 136) {
                if (valid) { const float e1 = __expf(tv[1] - tv[0]), e2 = __expf(tv[2] - tv[0]), e3 = __expf(tv[3] - tv[0]); const float inv = 1.0f / (1.0f + e1 + e2 + e3);
                    const float wk[4] = {inv, e1 * inv, e2 * inv, e3 * inv};
#pragma unroll
                    for (int k = 0; k < 4; ++k) { const unsigned lp = atomicAdd((unsigned*)&lcnt[te[k]], 1u); ent[(rowl * 4 + k) * 2 + 0] = ((unsigned)te[k] << 24) | lp; ent[(rowl * 4 + k) * 2 + 1] = __float_as_uint(wk[k]); } }
                else {
#pragma unroll
                    for (int k = 0; k < 4; ++k) ent[(rowl * 4 + k) * 2 + 0] = 0xffffffffu; } } }
    }
    __syncthreads();
    if (tid < 32) gb[tid] = __hip_atomic_fetch_add(cnt + tid * 16, lcnt[tid], __ATOMIC_RELAXED, __HIP_MEMORY_SCOPE_AGENT);
    __syncthreads();
    for (int q = tid; q < 136 * 4; q += NWAVES * 64) { const unsigned pe = ent[q * 2 + 0];
        if (pe != 0xffffffffu) { const unsigned e = pe >> 24, lp = pe & 0xffffffu; const int m = rbase + (q >> 2);
            ((unsigned*)(sbase + WS_SLOT))[m * 4 + (q & 3)] = (e << 24) | (gb[e] + lp); ((unsigned*)(sbase + WS_GATEW))[m * 4 + (q & 3)] = ent[q * 2 + 1];
            if (!dummy) ((int*)(ws + WS_LIST))[(size_t)e * MT + gb[e] + lp] = m; } }
  }
}
__device__ __forceinline__ void build_expert_tables(unsigned char* ws, int layer, LAS unsigned char* lds, int tid) {
    LAS int* t2e = (LAS int*)(lds + AUX_T2E); LAS int* base = (LAS int*)(lds + AUX_BASE); LAS int* ntp = (LAS int*)(lds + AUX_NT); LAS int* cntl = (LAS int*)(lds + AUX_CNT);
    gu32* cnt = (gu32*)(ws + WS_CTL) + CW_CNT + layer * 32 * 16;
    __syncthreads();
    if (tid < 64) { const unsigned cval = (tid < 32) ? __hip_atomic_load(cnt + tid * 16, RLX_AGENT) : 0u; const int tiles = (int)((cval + 255u) >> 8);
        int pre = tiles;
#pragma unroll
        for (int o = 1; o < 32; o <<= 1) { const int ln = tid & 63; const int t = __builtin_amdgcn_ds_bpermute(((ln >= o) ? ln - o : ln) << 2, pre); if (ln >= o) pre += t; }
        const int start = pre - tiles;
        if (tid < 32) { base[tid] = start * 256; cntl[tid] = (int)cval; for (int t = 0; t < tiles; ++t) t2e[start + t] = tid; if (tid == 31) ntp[0] = pre; } }
    __syncthreads();
}
__device__ __forceinline__ void phase_moe_gather(unsigned char* ws, int layer, LAS unsigned char* lds, int gw, int NGW, int lane, int tid) {
    build_expert_tables(ws, layer, lds, tid);
    const LAS int* base = (const LAS int*)(lds + AUX_BASE);
    const bf16* XN = (const bf16*)(ws + WS_XN); bf16* XG = (bf16*)(ws + WS_XG);
    const unsigned* slot = (const unsigned*)(ws + WS_SLOT); unsigned* spos = (unsigned*)(ws + WS_SLOTPOS);
    for (int m = gw; m < MT; m += NGW) {
        if (layer == NLAYER - 1 && mod_row(m) == 8) continue;
        const GAS v4u* src = (const GAS v4u*)(XN + (size_t)m * 1024) + lane; const v4u a = src[0], b = src[64];
#pragma unroll
        for (int k = 0; k < 4; ++k) { const unsigned pe = slot[m * 4 + k]; const int dst = base[pe >> 24] + (int)(pe & 0xffffffu);
            GAS v4u* dp = (GAS v4u*)(XG + (size_t)dst * 1024) + lane; dp[0] = a; dp[64] = b;
            if (lane == 0) spos[m * 4 + k] = (unsigned)dst; }
    }
}
__device__ __forceinline__ void phase_moe_combine(unsigned char* ws, float* out, int layer, LAS unsigned char* lds, int gw, int NGW, int lane, int tid, bool dummy = false) {
    build_expert_tables(ws, layer, lds, tid);
    const LAS int* base = (const LAS int*)(lds + AUX_BASE);
    bf16* X = (bf16*)(ws + WS_X); const unsigned char* Y = ws + WS_Y;
    const float* Mo = (const float*)(ws + WS_MOD) + (size_t)layer * MODROWS * NMODC;
    const unsigned* slot = (const unsigned*)(ws + WS_SLOT); const float* gw4 = (const float*)(ws + WS_GATEW);
    for (int m0 = gw; m0 < MT; m0 += 2 * NGW) {
        int mm[2], bb[2], ww[2], mrr[2]; bool ok[2];
#pragma unroll
        for (int p = 0; p < 2; ++p) { const int m = m0 + p * NGW; ok[p] = m < MT; mm[p] = ok[p] ? m : m0; bb[p] = mm[p] / TB; ww[p] = mm[p] - bb[p] * TB; mrr[p] = (ww[p] < CTXL) ? 8 : bb[p];
            if (layer == NLAYER - 1 && ww[p] < CTXL) ok[p] = false; }
        if (!ok[0] && !ok[1]) continue;
        unsigned pe[2][4]; float wk[2][4];
#pragma unroll
        for (int p = 0; p < 2; ++p)
#pragma unroll
            for (int k = 0; k < 4; ++k) { pe[p][k] = slot[mm[p] * 4 + k]; wk[p][k] = gw4[mm[p] * 4 + k]; }
        unsigned long long xv[2][4];
#pragma unroll
        for (int p = 0; p < 2; ++p) { const GAS unsigned long long* xp = (const GAS unsigned long long*)(X + (size_t)mm[p] * 1024) + lane;
#pragma unroll
            for (int j = 0; j < 4; ++j) xv[p][j] = xp[64 * j]; }
        unsigned yv[2][4][4];
#pragma unroll
        for (int p = 0; p < 2; ++p)
#pragma unroll
            for (int k = 0; k < 4; ++k) { unsigned e = pe[p][k] >> 24; if (!ok[p] || e > 31u) e = 0u;
                const unsigned sp = ok[p] ? (unsigned)base[e] + (pe[p][k] & 0xffffffu) : 0u;
                const GAS unsigned* yp = (const GAS unsigned*)(Y + (size_t)sp * 1024) + lane;
#pragma unroll
                for (int j = 0; j < 4; ++j) yv[p][k][j] = yp[64 * j]; }
        f32x4 f[2][4]; float ss[2];
#pragma unroll
        for (int p = 0; p < 2; ++p) { const GAS f32x4* gp = (const GAS f32x4*)(Mo + (size_t)mrr[p] * NMODC + 5 * 1024) + lane;
            ss[p] = 0.f;
#pragma unroll
            for (int j = 0; j < 4; ++j) { f32x4 a = (f32x4){0.f, 0.f, 0.f, 0.f};
#pragma unroll
                for (int k = 0; k < 4; ++k) { const unsigned w8 = yv[p][k][j]; const f32x2 lo2 = __builtin_amdgcn_cvt_pk_f32_fp8((int)w8, false), hi2 = __builtin_amdgcn_cvt_pk_f32_fp8((int)w8, true); a = a + (f32x4){lo2.x, lo2.y, hi2.x, hi2.y} * wk[p][k]; }
                f[p][j] = bf4_to_f32(xv[p][j]) + gp[64 * j] * a; } }
        asm volatile("" ::: "memory");
        const bool fuse = (layer < NLAYER - 1) && !dummy;
        f32x4 pg[4], psh[2][4], psc[2][4];
        if (fuse) { const float* ng = PARF(ws) + P_N1G + (layer + 1) * 1024;
#pragma unroll
            for (int j = 0; j < 4; ++j) pg[j] = ((const GAS f32x4*)ng)[64 * j + lane];
#pragma unroll
            for (int p = 0; p < 2; ++p) { const float* Mn = (const float*)(ws + WS_MOD) + (size_t)(layer + 1) * MODROWS * NMODC + (size_t)mrr[p] * NMODC;
#pragma unroll
                for (int j = 0; j < 4; ++j) { psh[p][j] = ((const GAS f32x4*)Mn)[64 * j + lane]; psc[p][j] = ((const GAS f32x4*)(Mn + 1024))[64 * j + lane]; } } }
#pragma unroll
        for (int p = 0; p < 2; ++p) { if (!ok[p]) continue;
            GAS unsigned long long* xp = (GAS unsigned long long*)(X + (size_t)mm[p] * 1024) + lane;
            GAS f32x4* op = (GAS f32x4*)(out + ((size_t)bb[p] * SEQ + (ww[p] - CTXL)) * 1024) + lane;
#pragma unroll
            for (int j = 0; j < 4; ++j) { if (dummy) ((GAS f32x4*)((float*)(ws + WS_XG) + (size_t)mm[p] * 1024) + lane)[64 * j] = f[p][j]; else if (layer == NLAYER - 1) op[64 * j] = f[p][j]; else { const unsigned long long pk = f32_to_bf4(f[p][j]); xp[64 * j] = pk; f[p][j] = bf4_to_f32(pk); }
                ss[p] += (f[p][j].x * f[p][j].x + f[p][j].y * f[p][j].y) + (f[p][j].z * f[p][j].z + f[p][j].w * f[p][j].w); } }
        if (fuse) { float s0 = ss[0], s1 = ss[1]; const int ln = lane_now();
#pragma unroll
            for (int o = 1; o < 64; o <<= 1) { s0 += shx(s0, o, ln); s1 += shx(s1, o, ln); }
            const float rsv[2] = {1.0f / sqrtf(s0 * (1.0f / 1024.0f) + RMS_EPS), 1.0f / sqrtf(s1 * (1.0f / 1024.0f) + RMS_EPS)};
#pragma unroll
            for (int p = 0; p < 2; ++p) { if (!ok[p]) continue;
                GAS unsigned long long* o8 = (GAS unsigned long long*)((bf16*)(ws + WS_XN) + (size_t)mm[p] * 1024) + lane;
#pragma unroll
                for (int j = 0; j < 4; ++j) o8[64 * j] = f32_to_bf4((f[p][j] * rsv[p]) * pg[j] * (psc[p][j] + 1.0f) + psh[p][j]); } }
    }
}

constexpr int NPH_L = 11, NPHASE = 2 + NPH_L * NLAYER;
#ifndef PHMASK
#define PHMASK 0x7fff
#endif
#define EN(b) ((PHMASK >> (b)) & 1)
#ifndef DUPMASK
#define DUPMASK 0
#endif
#define DUP(b) for (int rep_ = 0; rep_ < (((DUPMASK >> (b)) & 1) ? 2 : 1); ++rep_)
__global__ void __launch_bounds__(NWAVES * 64, 2) dit_fwd(Args args) {
    extern __shared__ __attribute__((aligned(16))) unsigned char lds_raw[];
    LAS unsigned char* lds = (LAS unsigned char*)lds_raw;
    volatile LAS unsigned* MISC = (volatile LAS unsigned*)(lds + MISC_OFF);
    const int G = gridDim.x, bx = blockIdx.x;
    const int vcu = (G % 8 == 0) ? (bx % 8) * (G / 8) + bx / 8 : bx;
    const int wave0 = __builtin_amdgcn_readfirstlane((int)threadIdx.x >> 6);
#define LANE_ID(z) ((int)__builtin_amdgcn_mbcnt_hi(~0u, __builtin_amdgcn_mbcnt_lo(~0u, (z))))
    { const int t0 = (wave0 << 6) | LANE_ID(0u); for (int u = t0; u < (LDS_BYTES - MISC_OFF) / 4; u += NWAVES * 64) ((LAS unsigned*)(lds + MISC_OFF))[u] = 0u; }
    __syncthreads();
    const int lo = args.ph_lo, hi = args.ph_hi;
    XcdBarrier bar; bar.bar = (unsigned*)(args.ws + WS_CTL) + CW_BAR; bar.x = 0; bar.st = nullptr;
    if (hi - lo > 1) bar = xcd_barrier_post((unsigned*)(args.ws + WS_CTL) + CW_BAR, MISC + 8, wave0 == 0 && LANE_ID(0u) == 0);
#define IN(k) (lo <= (k) && (k) < hi)
#define SEAM(k) do { if (IN(k) && IN((k) + 1)) { XcdBarrier b_ = bar; unsigned zb_ = 0u; LAUNDER_S(zb_); b_.bar = bar.bar + zb_; xcd_barrier(b_, wave0 == 0 && LANE_ID(zb_) == 0); } } while (0)
#define PHASE_IDS() unsigned zoff_ = 0u; LAUNDER_S(zoff_); int tid = (wave0 << 6) | LANE_ID(zoff_); LAUNDER_V(tid); const int lane = tid & 63, wave = __builtin_amdgcn_readfirstlane(tid >> 6); const int gw = vcu * NWAVES + wave, NGW = G * NWAVES; \
    unsigned char* ws = args.ws + zoff_; const int Gp = G + (int)zoff_, bxp = bx + (int)zoff_; (void)lane; (void)gw; (void)NGW; (void)Gp; (void)bxp;

    if (EN(0) && IN(0)) DUP(0) { PHASE_IDS(); p0_prologue(args, lds, gw, NGW, wave, lane); } SEAM(0);
    if (EN(1) && IN(1)) { PHASE_IDS(); p1_mod_reduce(args, gw * 64 + lane, NGW * 64); } SEAM(1);

    for (int layer = 0; layer < NLAYER; ++layer) {
        const int pb = 2 + NPH_L * layer, lh = layer >> 1;
        if (layer == 0) { if (EN(2) && IN(pb + 0)) DUP(2) { PHASE_IDS(); phase_modulate1(ws, layer, gw, NGW, lane); } SEAM(pb + 0); }
        if ((layer & 1) == 0) {
            if (EN(3) && IN(pb + 1)) DUP(3) {
                PHASE_IDS();
                pg8::Gemm g{(const pg8::bf16_t*)(ws + WS_XN), (const pg8::bf16_t*)(ws + WS_WQKV) + (size_t)lh * QKVN * 1024, MT, QKVN, 1024, 0};
                pg8::StaticOrder S; S.init(MT, QKVN, Gp, bxp);
                LAS float* gl = (LAS float*)(lds + AUX_RS);
                if (tid < 128) gl[tid] = (PARF(ws) + (tid < 64 ? P_QG : P_KG - 64) + lh * 64)[tid];
                __syncthreads();
                pg8::EpiQKV E{ws, WS_Q, WS_K - WS_Q, WS_V - WS_K, gl, (const float*)(ws + WS_ROPE), ATT_C2};
                pg8::gemm_phase<pg8::EpiQKV, pg8::StaticOrder, true, true>(lds + RING_OFF, g, S, E, tid);
            } SEAM(pb + 1);
            if (EN(5) && IN(pb + 3)) DUP(5) {
                PHASE_IDS();
                const attn_body::bf16* Qp = (const attn_body::bf16*)(ws + WS_Q); const attn_body::bf16* Kp = (const attn_body::bf16*)(ws + WS_K); const attn_body::bf16* Vp = (const attn_body::bf16*)(ws + WS_V);
                attn_body::bf16* Op = (attn_body::bf16*)(ws + WS_XN);
                if (G == 256) {
                    for (int i = 0; i < 9; ++i) {
                        long qrow0, kvrow0; int NT, h;
                        if (i < 8) { const int x = vcu >> 5, j = vcu & 31, pair = 4 * x + (i >> 1), wi = (i & 1) * 32 + j, hq = wi >> 4, qb = wi & 15, b = pair >> 2, hk = pair & 3;
                            h = hk * 4 + hq; qrow0 = (long)b * TB + CTXL + qb * 256; kvrow0 = (long)b * TB; NT = TB / 64; }
                        else { if (vcu >= 128) break; const int b = vcu >> 4; h = vcu & 15; qrow0 = (long)b * TB; kvrow0 = qrow0; NT = CTXL / 64; }
                        attn_body::attn_unit<8>(qrow0, kvrow0, NT, h, Qp, Kp, Vp, Op, (char*)lds_raw + RING_OFF, tid);
                    }
                } else {
                    for (int U = bx; U < 2048 + 128; U += G) {
                        long qrow0, kvrow0; int NT, h;
                        if (U < 2048) { const int pair = U >> 6, wi = U & 63, hq = wi >> 4, qb = wi & 15, b = pair >> 2, hk = pair & 3; h = hk * 4 + hq; qrow0 = (long)b * TB + CTXL + qb * 256; kvrow0 = (long)b * TB; NT = TB / 64; }
                        else { const int v = U - 2048, b = v >> 4; h = v & 15; qrow0 = (long)b * TB; kvrow0 = qrow0; NT = CTXL / 64; }
                        attn_body::attn_unit<8>(qrow0, kvrow0, NT, h, Qp, Kp, Vp, Op, (char*)lds_raw + RING_OFF, tid);
                    }
                }
            } SEAM(pb + 3);
        } else {
            if (EN(6) && IN(pb + 1)) DUP(6) {
                PHASE_IDS();
                pg8::Gemm g{(const pg8::bf16_t*)(ws + WS_XN), (const pg8::bf16_t*)(ws + WS_WIN) + (size_t)lh * WINP * 1024, MT, WINP, 1024, 0};
                pg8::StaticOrder S; S.init(MT, WINP, Gp, bxp);
                pg8::EpiBf16 E{(pg8::bf16_t*)(ws + WS_G), WINP};
                pg8::gemm_phase<pg8::EpiBf16, pg8::StaticOrder, true, true>(lds + RING_OFF, g, S, E, tid);
            } SEAM(pb + 1);
            if (EN(7) && IN(pb + 2)) DUP(7) { { PHASE_IDS(); phase_gla_g0v(ws, tid, Gp, bxp); } { PHASE_IDS(); phase_gla_g0(ws, lh, lds, tid, Gp, bxp); } } SEAM(pb + 2);
            if (EN(8) && IN(pb + 3)) DUP(8) { PHASE_IDS(); phase_gla_g12(ws, lds, gw, wave, lane); } SEAM(pb + 3);
            if (EN(8) && IN(pb + 4)) DUP(9) { PHASE_IDS(); phase_gla_g3(ws, lh, lds, tid); } SEAM(pb + 4);
        }
        if (EN(9) && IN(pb + 5)) {
            PHASE_IDS();
            const pg8::bf16_t* Wt = (layer & 1) ? (const pg8::bf16_t*)(ws + WS_WOG) + (size_t)lh * 1024 * 1024 : (const pg8::bf16_t*)(ws + WS_WOA) + (size_t)lh * 1024 * 1024;
            pg8::Gemm g{(const pg8::bf16_t*)(ws + ((layer & 1) ? WS_Q : WS_XN)), Wt, MT, 1024, 1024, 0};
            pg8::StaticOrder S; if (layer == NLAYER - 1) S.init(NB * SEQ, 1024, Gp, bxp, true); else S.init(MT, 1024, Gp, bxp);
            pg8::EpiResGate E{(pg8::bf16_t*)(ws + WS_X), (const float*)(ws + WS_MOD) + (size_t)layer * MODROWS * NMODC + 2 * 1024};
            pg8::gemm_phase<pg8::EpiResGate, pg8::StaticOrder, true, true>(lds + RING_OFF, g, S, E, tid);
        } SEAM(pb + 5);
        if (EN(10) && IN(pb + 6)) { if ((DUPMASK >> 10) & 1) { PHASE_IDS(); phase_modulate2_route(ws, layer, lds, vcu, wave, lane, tid, true); __syncthreads(); } PHASE_IDS(); phase_modulate2_route(ws, layer, lds, vcu, wave, lane, tid); } SEAM(pb + 6);
        if (EN(12) && IN(pb + 8)) DUP(12) {
            PHASE_IDS();
            build_expert_tables(ws, layer, lds, tid);
            const int nT = __builtin_amdgcn_readfirstlane(((const LAS int*)(lds + AUX_NT))[0]);
            pg8::MoeOrder S{nT, 8, Gp, bxp, (const LAS int*)(lds + AUX_T2E)};
            LAS unsigned short* rowtab = (LAS unsigned short*)(lds + AUX_ROWTAB);
            { const LAS int* base = (const LAS int*)(lds + AUX_BASE); const LAS int* cntl = (const LAS int*)(lds + AUX_CNT); const int* LIST = (const int*)(ws + WS_LIST);
              pg8::Unit u;
              int rv[ROWTAB_UNITS];
#pragma unroll
              for (int i = 0; i < ROWTAB_UNITS; ++i) { const bool ok = S.next(i, u); const int e = ok ? u.e : 0, pos = ok ? (u.pm - (base[e] >> 8)) * 256 + (tid & 255) : 0;
                  rv[i] = (ok && pos < cntl[e]) ? LIST[(size_t)e * MT + pos] : 0; }
#pragma unroll
              for (int i = 0; i < ROWTAB_UNITS; ++i) if (tid < 256) rowtab[i * 256 + tid] = (unsigned short)rv[i];
              __syncthreads(); }
            pg8::Gemm g{(const pg8::bf16_t*)(ws + WS_XN8), (const pg8::bf16_t*)(ws + WS_WGU + (size_t)layer * 32 * 2048 * 1024), MPAD, 2048, 512, (size_t)2048 * 1024, rowtab};
            pg8::EpiSwiGLU8 E{ws + WS_ACT, PARF(ws) + P_BGU + (size_t)layer * 32 * 2048, 1.0f / 32.0f};
            pg8::gemm_phase<pg8::EpiSwiGLU8, pg8::MoeOrder, true, true, true, true>(lds + RING_OFF, g, S, E, tid);
        } SEAM(pb + 8);
        if (EN(13) && IN(pb + 9)) DUP(13) {
            PHASE_IDS();
            build_expert_tables(ws, layer, lds, tid);
            const int nT = __builtin_amdgcn_readfirstlane(((const LAS int*)(lds + AUX_NT))[0]);
            pg8::Gemm g{(const pg8::bf16_t*)(ws + WS_ACT), (const pg8::bf16_t*)(ws + WS_WDN + (size_t)layer * 32 * 1024 * 1024), MPAD, 1024, 512, (size_t)1024 * 1024};
            pg8::MoeOrder S{nT, 4, Gp, bxp, (const LAS int*)(lds + AUX_T2E)};
            pg8::EpiBiasF8 E{ws + WS_Y, PARF(ws) + P_BDN + (size_t)layer * 32 * 1024, 1.0f / 32.0f};
            pg8::gemm_phase<pg8::EpiBiasF8, pg8::MoeOrder, true, true, false, true>(lds + RING_OFF, g, S, E, tid);
        } SEAM(pb + 9);
        if (EN(14) && IN(pb + 10)) { if ((DUPMASK >> 14) & 1) { PHASE_IDS(); phase_moe_combine(ws, args.out, layer, lds, gw, NGW, lane, tid, true); } PHASE_IDS(); phase_moe_combine(ws, args.out, layer, lds, gw, NGW, lane, tid); } SEAM(pb + 10);
    }
#undef IN
#undef EN
#undef DUP
#undef SEAM
#undef PHASE_IDS
#undef LANE_ID
}

extern "C" void kernel_launch(void* const* d_in, const int* in_sizes, int n_in, void* d_out, int out_size, void* d_ws, size_t ws_size, hipStream_t stream) {
    static int grid = 0;
    if (grid == 0) {
        if (n_in != 25 || out_size != NB * SEQ * DMODEL || ws_size < WS_END) { fprintf(stderr, "kernel_launch: unexpected shapes: n_in %d out %d ws %zu (need >= %zu)\n", n_in, out_size, ws_size, (size_t)WS_END); grid = -1; return; }
        int dev = 0, cus = 0, per_cu = 0;
        if (hipGetDevice(&dev) != hipSuccess || hipDeviceGetAttribute(&cus, hipDeviceAttributeMultiprocessorCount, dev) != hipSuccess) { grid = -1; return; }
        if (hipFuncSetAttribute((const void*)dit_fwd, hipFuncAttributeMaxDynamicSharedMemorySize, LDS_BYTES) != hipSuccess) { fprintf(stderr, "kernel_launch: hipFuncSetAttribute failed\n"); grid = -1; return; }
        if (hipOccupancyMaxActiveBlocksPerMultiprocessor(&per_cu, (const void*)dit_fwd, NWAVES * 64, LDS_BYTES) != hipSuccess || per_cu < 1) fprintf(stderr, "kernel_launch: occupancy query reports %d\n", per_cu);
        (void)hipGetLastError();
        grid = cus;
    }
    if (grid < 0) return;
    if (hipMemsetAsync((char*)d_ws + WS_CTL, 0, CTL_ZERO_BYTES, stream) != hipSuccess) { fprintf(stderr, "kernel_launch: memset failed\n"); return; }
    Args a{};
    for (int i = 0; i < 25; ++i) a.in[i] = (const float*)d_in[i];
    a.out = (float*)d_out; a.ws = (unsigned char*)d_ws;
#if MK_ONE_LAUNCH
    a.ph_lo = 0; a.ph_hi = NPHASE;
    hipLaunchKernelGGL(dit_fwd, dim3(grid), dim3(NWAVES * 64), LDS_BYTES, stream, a);
#else
    for (int p = 0; p < NPHASE; ++p) { a.ph_lo = p; a.ph_hi = p + 1; hipLaunchKernelGGL(dit_fwd, dim3(grid), dim3(NWAVES * 64), LDS_BYTES, stream, a); }
#endif
    const hipError_t le = hipPeekAtLastError();
    if (le != hipSuccess) fprintf(stderr, "kernel_launch: launch failed: %s\n", hipGetErrorName(le));
}
```

```cpp
#include <hip/hip_runtime.h>
#include <hip/hip_bf16.h>
#include <cstdio>
#include <cstdint>
#include <cmath>

#ifndef MK_ONE_LAUNCH
#define MK_ONE_LAUNCH 1
#endif

namespace pg8 {
#define PG8_LAS __attribute__((address_space(3)))
typedef unsigned short bf16_t;
typedef short bf16x8 __attribute__((ext_vector_type(8)));
typedef float f32x4 __attribute__((ext_vector_type(4)));
typedef unsigned u32x4 __attribute__((ext_vector_type(4)));
constexpr int BM = 256, BK = 64, HALF = 128, HTB = HALF * BK * 2  , STAGE_BYTES = 8 * HTB, NXCD = 8, WGM = 8;

__host__ __device__ __forceinline__ int lds_byte(int r, int c) { const int st = (r >> 4) * 2 + (c >> 5), rr = r & 15, cc = c & 31, ob = rr * 64 + cc * 2; return st * 1024 + (ob ^ (((ob >> 9) & 1) << 5)); }
__host__ __device__ __forceinline__ void stage_rc(int b, int& R, int& C) { const int st = b / 1024, sb = b % 1024, swz = sb ^ (((sb >> 9) & 1) << 5); R = (st >> 1) * 16 + swz / 64; C = (st & 1) * 32 + (swz % 64) / 2; }
__host__ __device__ __forceinline__ int perm32(int rho) { const int n = rho >> 4, i = rho & 15; return 8 * (i >> 2) + 4 * n + (i & 3); }

struct Unit { int pm, pn, e; };
struct Gemm { const bf16_t* A; const bf16_t* Bt; int M, N, K; size_t bstride; const PG8_LAS unsigned short* rowtab; };

struct StaticOrder {
    int nM, nN, nwg, G, c; bool latent_only;
    __host__ __device__ __forceinline__ void init(int M, int N, int G_, int c_, bool lat_ = false) { nM = M / BM; nN = N / BM; nwg = nM * nN; G = G_; c = c_; latent_only = lat_; }
    __host__ __device__ __forceinline__ bool next(int i, Unit& u) const {
        const long L = (long)i * G + c; if (L >= nwg) return false;
        int wgid = (int)L; { const int q = nwg / NXCD, r = nwg % NXCD, xcd = wgid % NXCD, off = wgid / NXCD; wgid = (xcd < r ? xcd * (q + 1) : r * (q + 1) + (xcd - r) * q) + off; }
        const int nig = WGM * nN, gid = wgid / nig, fm = gid * WGM, gsz = (nM - fm) < WGM ? (nM - fm) : WGM;
        u.pm = fm + ((wgid % nig) % gsz); u.pn = (wgid % nig) / gsz; u.e = 0;
        if (latent_only) u.pm = (u.pm >> 4) * 17 + 1 + (u.pm & 15);
        return true;
    }
    __device__ __forceinline__ void a_ready(const Unit&) const {}
    __device__ __forceinline__ void done(const Unit&) const {}
};
struct MoeOrder {
    int nT, nN, G, c; const PG8_LAS int* t2e; bool rev = false;
    __device__ __forceinline__ bool next(int i, Unit& u) const {
        const int x = c & 7, j = c >> 3, per = 32 / nN, stride = (G >> 5) * per, first = x * per + j / nN;
        if (rev) { const int nw = (nT - first + stride - 1) / stride; if (i >= nw) return false; i = nw - 1 - i; }
        const int mt = i * stride + first; if (mt >= nT) return false;
        u.pm = mt; u.pn = j % nN; u.e = __builtin_amdgcn_readfirstlane(t2e[mt]); return true;
    }
    __device__ __forceinline__ void a_ready(const Unit&) const {}
    __device__ __forceinline__ void done(const Unit&) const {}
};

__device__ __forceinline__ int lane_now() { unsigned z; asm volatile("s_mov_b32 %0, 0" : "=s"(z)); return (int)__builtin_amdgcn_mbcnt_hi(~0u, __builtin_amdgcn_mbcnt_lo(~0u, z)); }
__device__ __forceinline__ float shx(float v, int m, int ln) { return __int_as_float(__builtin_amdgcn_ds_bpermute((ln ^ m) << 2, __float_as_int(v))); }
__device__ __forceinline__ unsigned pk4_fp8(float a, float b, float c, float d) { int w = 0; w = __builtin_amdgcn_cvt_pk_fp8_f32(a, b, w, false); w = __builtin_amdgcn_cvt_pk_fp8_f32(c, d, w, true); return (unsigned)w; }
__device__ __forceinline__ unsigned pk4_fp8_sat(float a, float b, float c, float d) {
    return pk4_fp8(__builtin_amdgcn_fmed3f(a, -448.0f, 448.0f), __builtin_amdgcn_fmed3f(b, -448.0f, 448.0f), __builtin_amdgcn_fmed3f(c, -448.0f, 448.0f), __builtin_amdgcn_fmed3f(d, -448.0f, 448.0f)); }
__device__ __forceinline__ unsigned cvt_pk_bf16(float lo, float hi) { unsigned r; asm volatile("v_cvt_pk_bf16_f32 %0, %1, %2" : "=v"(r) : "v"(lo), "v"(hi)); return r; }

struct EpiBf16 {
    static constexpr bool PERM = true, AFTER_DRAIN = false;
    bf16_t* O; int ldc; float asc;
    __device__ __forceinline__ void operator()(const f32x4 (&acc)[2][2][4][2], const Unit& u, int wr, int wc, int fr, int fq) const {
        const int row0 = u.pm * BM + wr * 64 + fr; const int col0 = u.pn * BM + wc * 32 + 8 * fq;
#pragma unroll
        for (int ai = 0; ai < 2; ++ai)
#pragma unroll
            for (int m = 0; m < 4; ++m) { bf16_t* rowp = O + (size_t)(row0 + ai * HALF + m * 16) * ldc + col0;
#pragma unroll
                for (int bj = 0; bj < 2; ++bj) { const f32x4 v0 = acc[ai][bj][m][0] * asc, v1 = acc[ai][bj][m][1] * asc;
                    u32x4 w; w.x = cvt_pk_bf16(v0[0], v0[1]); w.y = cvt_pk_bf16(v0[2], v0[3]); w.z = cvt_pk_bf16(v1[0], v1[1]); w.w = cvt_pk_bf16(v1[2], v1[3]);
                    *(u32x4*)(rowp + bj * HALF) = w; } }
    }
};
struct EpiQKV {
    static constexpr bool PERM = true, AFTER_DRAIN = false;
    unsigned char* wsb; size_t offQ, dK, dV;
    const PG8_LAS float* gl; const PG8_LAS float* rt; float c2, asc;
    __device__ __forceinline__ void operator()(const f32x4 (&acc)[2][2][4][2], const Unit& u, int wr, int wc, int fr, int fq) const {
        const int isk = (u.pn >= 4) ? 1 : 0, isv = (u.pn >= 5) ? 1 : 0;
        bf16_t* base = (bf16_t*)(wsb + offQ + (size_t)isk * dK + (size_t)isv * dV); const int ldc = isk ? 256 : 1024;
        const int hcol = (isk ? wc : (u.pn * 4 + wc)) * 64 + 8 * fq;
        const int pmb = u.pm / 17, pml = u.pm - pmb * 17; const bool lat = pml != 0;
        const PG8_LAS float* gp = gl + (isk ? 64 : 0) + 8 * fq; const float scl = isk ? 1.0f : c2;
#pragma unroll
        for (int ai = 0; ai < 2; ++ai)
#pragma unroll
            for (int m = 0; m < 4; ++m) { const int rl = ai * HALF + wr * 64 + m * 16 + fr; const size_t row = (size_t)u.pm * BM + rl;
                f32x4 v[2][2]; float ss = 0.f;
#pragma unroll
                for (int bj = 0; bj < 2; ++bj)
#pragma unroll
                    for (int n = 0; n < 2; ++n) { v[bj][n] = acc[ai][bj][m][n] * asc; ss += (v[bj][n][0] * v[bj][n][0] + v[bj][n][1] * v[bj][n][1]) + (v[bj][n][2] * v[bj][n][2] + v[bj][n][3] * v[bj][n][3]); }
                if (!isv) { const int ln = lane_now(); ss += shx(ss, 16, ln); ss += shx(ss, 32, ln);
                    const float rs = 1.0f / sqrtf(ss * (1.0f / 64.0f) + 1e-6f);
                    const int spos = (pml - 1) * 256 + rl;
#pragma unroll
                    for (int bj = 0; bj < 2; ++bj) { f32x4 cs = (f32x4){1.f, 1.f, 1.f, 1.f}, sn = (f32x4){0.f, 0.f, 0.f, 0.f};
                        if (lat) { const PG8_LAS float* cp = rt + (bj ? (spos & 63) : (spos >> 6)) * 16 + 4 * fq; cs = *(const PG8_LAS f32x4*)cp; sn = *(const PG8_LAS f32x4*)(cp + 1024); }
#pragma unroll
                        for (int n = 0; n < 2; ++n) { const f32x4 y = v[bj][n] * rs * *(const PG8_LAS f32x4*)(gp + 32 * bj + 4 * n);
                            const float c0 = cs[2 * n], s0 = sn[2 * n], c1 = cs[2 * n + 1], s1 = sn[2 * n + 1];
                            v[bj][n] = (f32x4){(y[0] * c0 - y[1] * s0) * scl, (y[0] * s0 + y[1] * c0) * scl, (y[2] * c1 - y[3] * s1) * scl, (y[2] * s1 + y[3] * c1) * scl}; } } }
                bf16_t* rowp = base + row * ldc + hcol;
#pragma unroll
                for (int bj = 0; bj < 2; ++bj) { u32x4 w; w.x = cvt_pk_bf16(v[bj][0][0], v[bj][0][1]); w.y = cvt_pk_bf16(v[bj][0][2], v[bj][0][3]); w.z = cvt_pk_bf16(v[bj][1][0], v[bj][1][1]); w.w = cvt_pk_bf16(v[bj][1][2], v[bj][1][3]);
                    *(u32x4*)(rowp + 32 * bj) = w; } }
    }
};
struct EpiBiasF8 {
    static constexpr bool PERM = true, AFTER_DRAIN = false;
    unsigned char* O; const float* bias; float ascale;
    __device__ __forceinline__ void operator()(const f32x4 (&acc)[2][2][4][2], const Unit& u, int wr, int wc, int fr, int fq) const {
        const int row0 = u.pm * BM + wr * 64 + fr; const int col0 = u.pn * BM + wc * 32 + 8 * fq;
        const float* bp = bias + (size_t)u.e * 1024 + col0;
        f32x4 bv[2][2];
#pragma unroll
        for (int bj = 0; bj < 2; ++bj)
#pragma unroll
            for (int n = 0; n < 2; ++n) bv[bj][n] = *(const f32x4*)(bp + bj * HALF + 4 * n);
#pragma unroll
        for (int ai = 0; ai < 2; ++ai)
#pragma unroll
            for (int m = 0; m < 4; ++m) { unsigned char* rowp = O + (size_t)(row0 + ai * HALF + m * 16) * 1024 + col0;
#pragma unroll
                for (int bj = 0; bj < 2; ++bj) { const f32x4 v0 = acc[ai][bj][m][0] * ascale + bv[bj][0], v1 = acc[ai][bj][m][1] * ascale + bv[bj][1];
                    *(unsigned long long*)(rowp + bj * HALF) = (unsigned long long)pk4_fp8_sat(v0[0], v0[1], v0[2], v0[3]) | ((unsigned long long)pk4_fp8_sat(v1[0], v1[1], v1[2], v1[3]) << 32); } }
    }
};
struct EpiResGate {
    static constexpr bool PERM = false, AFTER_DRAIN = false;
    bf16_t* X; const float* gate; float asc;
    __device__ __forceinline__ void operator()(const f32x4 (&acc)[2][2][4][2], const Unit& u, int wr, int wc, int fr, int fq) const {
        const int row0 = u.pm * BM + wr * 64 + fr; const int col0 = u.pn * BM + wc * 32 + 4 * fq;
        const int bb = u.pm / 17, mr = (u.pm - bb * 17 == 0) ? 8 : bb;
        const float* gp = gate + (size_t)mr * 6144 + col0;
        f32x4 gv[2][2];
#pragma unroll
        for (int bj = 0; bj < 2; ++bj)
#pragma unroll
            for (int n = 0; n < 2; ++n) gv[bj][n] = *(const f32x4*)(gp + bj * HALF + n * 16) * asc;
#pragma unroll
        for (int ai = 0; ai < 2; ++ai) { unsigned long long xv[4][2][2];
#pragma unroll
            for (int m = 0; m < 4; ++m) { const bf16_t* rowp = X + (size_t)(row0 + ai * HALF + m * 16) * 1024 + col0;
#pragma unroll
                for (int bj = 0; bj < 2; ++bj)
#pragma unroll
                    for (int n = 0; n < 2; ++n) xv[m][bj][n] = *(const unsigned long long*)(rowp + bj * HALF + n * 16); }
#pragma unroll
            for (int m = 0; m < 4; ++m) { bf16_t* rowp = X + (size_t)(row0 + ai * HALF + m * 16) * 1024 + col0;
#pragma unroll
                for (int bj = 0; bj < 2; ++bj)
#pragma unroll
                    for (int n = 0; n < 2; ++n) { const unsigned long long v = xv[m][bj][n];
                        f32x4 x = (f32x4){__uint_as_float((unsigned)(v & 0xffffu) << 16), __uint_as_float((unsigned)(v >> 16) << 16), __uint_as_float((unsigned)((v >> 32) & 0xffffu) << 16), __uint_as_float((unsigned)(v >> 48) << 16)};
                        x = x + gv[bj][n] * acc[ai][bj][m][n];
                        *(unsigned long long*)(rowp + bj * HALF + n * 16) = (unsigned long long)cvt_pk_bf16(x[0], x[1]) | ((unsigned long long)cvt_pk_bf16(x[2], x[3]) << 32); } } }
    }
};
struct EpiSwiGLU {
    static constexpr bool PERM = true, AFTER_DRAIN = false;
    bf16_t* O; const float* bias;
    __device__ __forceinline__ void operator()(const f32x4 (&acc)[2][2][4][2], const Unit& u, int wr, int wc, int fr, int fq) const {
        const int row0 = u.pm * BM + wr * 64 + fr; const int col0 = u.pn * HALF + wc * 32 + 8 * fq;
        const float* bp = bias + (size_t)u.e * 2048 + col0;
        f32x4 bg[2], bu[2];
#pragma unroll
        for (int n = 0; n < 2; ++n) { bg[n] = *(const f32x4*)(bp + 4 * n); bu[n] = *(const f32x4*)(bp + 1024 + 4 * n); }
#pragma unroll
        for (int ai = 0; ai < 2; ++ai)
#pragma unroll
            for (int m = 0; m < 4; ++m) { bf16_t* rowp = O + (size_t)(row0 + ai * HALF + m * 16) * 1024 + col0;
                float r[8];
#pragma unroll
                for (int n = 0; n < 2; ++n) { const f32x4 gt = acc[ai][0][m][n] + bg[n], up = acc[ai][1][m][n] + bu[n];
#pragma unroll
                    for (int i = 0; i < 4; ++i) { const float g = fminf(gt[i], 7.0f), uu = fminf(fmaxf(up[i], -7.0f), 7.0f);
                        const float sg = __builtin_amdgcn_rcpf(1.0f + __builtin_amdgcn_exp2f(-1.702f * 1.4426950408889634f * g));
                        r[4 * n + i] = (uu + 1.0f) * (g * sg); } }
                u32x4 w; w.x = cvt_pk_bf16(r[0], r[1]); w.y = cvt_pk_bf16(r[2], r[3]); w.z = cvt_pk_bf16(r[4], r[5]); w.w = cvt_pk_bf16(r[6], r[7]);
                *(u32x4*)rowp = w; }
    }
};
struct EpiNull8 {
    static constexpr bool PERM = true, AFTER_DRAIN = false;
    __device__ __forceinline__ void operator()(const f32x4 (&acc)[2][2][4][2], const Unit& u, int wr, int wc, int fr, int fq) const { asm volatile("" :: "v"(acc[0][0][0][0]), "v"(acc[1][1][3][1])); }
};
struct EpiSwiGLU8 {
    static constexpr bool PERM = true, AFTER_DRAIN = false;
    unsigned char* O; const float* bias; float ascale;
    __device__ __forceinline__ void operator()(const f32x4 (&acc)[2][2][4][2], const Unit& u, int wr, int wc, int fr, int fq) const {
        const int row0 = u.pm * BM + wr * 64 + fr; const int col0 = u.pn * HALF + wc * 32 + 8 * fq;
        const float* bp = bias + (size_t)u.e * 2048 + col0;
        f32x4 bg[2], bu[2];
#pragma unroll
        for (int n = 0; n < 2; ++n) { bg[n] = *(const f32x4*)(bp + 4 * n); bu[n] = *(const f32x4*)(bp + 1024 + 4 * n); }
        float as_ = ascale, nc_ = -1.702f * 1.4426950408889634f; asm volatile("" : "+v"(as_), "+v"(nc_));
        const f32x4 asv = (f32x4){as_, as_, as_, as_}, nc = (f32x4){nc_, nc_, nc_, nc_};
#pragma unroll
        for (int ai = 0; ai < 2; ++ai)
#pragma unroll
            for (int m = 0; m < 4; ++m) { unsigned char* rowp = O + (size_t)(row0 + ai * HALF + m * 16) * 1024 + col0;
                f32x4 rr[2];
#pragma unroll
                for (int n = 0; n < 2; ++n) { const f32x4 gt = acc[ai][0][m][n] * asv + bg[n], up = acc[ai][1][m][n] * asv + bu[n];
                    f32x4 g, uu;
#pragma unroll
                    for (int i = 0; i < 4; ++i) { g[i] = fminf(gt[i], 7.0f); uu[i] = __builtin_amdgcn_fmed3f(up[i], -7.0f, 7.0f); }
                    const f32x4 za = g * nc; f32x4 ex;
#pragma unroll
                    for (int i = 0; i < 4; ++i) ex[i] = __builtin_amdgcn_exp2f(za[i]);
                    const f32x4 dn = ex + 1.0f; f32x4 sg;
#pragma unroll
                    for (int i = 0; i < 4; ++i) sg[i] = __builtin_amdgcn_rcpf(dn[i]);
                    rr[n] = (uu + 1.0f) * (g * sg); }
                float r[8] = {rr[0][0], rr[0][1], rr[0][2], rr[0][3], rr[1][0], rr[1][1], rr[1][2], rr[1][3]};
                *(unsigned long long*)rowp = (unsigned long long)pk4_fp8(r[0], r[1], r[2], r[3]) | ((unsigned long long)pk4_fp8(r[4], r[5], r[6], r[7]) << 32); }
    }
};
struct EpiBiasBf16 {
    static constexpr bool PERM = true, AFTER_DRAIN = false;
    bf16_t* O; const float* bias; float ascale;
    __device__ __forceinline__ void operator()(const f32x4 (&acc)[2][2][4][2], const Unit& u, int wr, int wc, int fr, int fq) const {
        const int row0 = u.pm * BM + wr * 64 + fr; const int col0 = u.pn * BM + wc * 32 + 8 * fq;
        const float* bp = bias + (size_t)u.e * 1024 + col0;
        f32x4 bv[2][2];
#pragma unroll
        for (int bj = 0; bj < 2; ++bj)
#pragma unroll
            for (int n = 0; n < 2; ++n) bv[bj][n] = *(const f32x4*)(bp + bj * HALF + 4 * n);
#pragma unroll
        for (int ai = 0; ai < 2; ++ai)
#pragma unroll
            for (int m = 0; m < 4; ++m) { bf16_t* rowp = O + (size_t)(row0 + ai * HALF + m * 16) * 1024 + col0;
#pragma unroll
                for (int bj = 0; bj < 2; ++bj) { const f32x4 v0 = acc[ai][bj][m][0] * ascale + bv[bj][0], v1 = acc[ai][bj][m][1] * ascale + bv[bj][1];
                    u32x4 w; w.x = cvt_pk_bf16(v0[0], v0[1]); w.y = cvt_pk_bf16(v0[2], v0[3]); w.z = cvt_pk_bf16(v1[0], v1[1]); w.w = cvt_pk_bf16(v1[2], v1[3]);
                    *(u32x4*)(rowp + bj * HALF) = w; } }
    }
};

template <class Epi, class Sched, bool ALIGN_EPI = false, bool SP2 = false, bool GATHER = false, bool F8 = false>
__device__ __forceinline__ void gemm_phase(PG8_LAS unsigned char* lds, const Gemm g, const Sched& S, const Epi& E, int tid_in) {
    int tid_l = tid_in; asm volatile("" : "+v"(tid_l));
    const int tid = tid_l, wid = __builtin_amdgcn_readfirstlane(tid >> 6), lane = tid & 63, wr = wid >> 2, wc = wid & 3, fr = lane & 15, fq = lane >> 4;
    const int K = g.K, nt = K / BK;
    unsigned voffA[2], voffB[2];
#pragma unroll
    for (int i = 0; i < 2; ++i) { int R, C; stage_rc(tid * 16 + i * 8192, R, C); const int Rb = Epi::PERM ? ((R & ~31) + perm32(R & 31)) : R;
        voffA[i] = (unsigned)(R * K + C) * 2u; voffB[i] = (unsigned)(Rb * K + C) * 2u; }
    const size_t kstep = (size_t)(BK * 2);
    static_assert(!GATHER || SP2, "GATHER is wired into the SP2 loop only");
    unsigned vAc0[2], vAc1[2], vAn0[2], vAn1[2]; int gR[2]; unsigned gC[2];
#pragma unroll
    for (int i = 0; i < 2; ++i) { int R, C; stage_rc(tid * 16 + i * 8192, R, C); gR[i] = R; gC[i] = (unsigned)C * 2u; vAc0[i] = voffA[i]; vAc1[i] = voffA[i]; vAn0[i] = voffA[i]; vAn1[i] = voffA[i]; }
#define PG8_GFETCH(d0, d1, ord) do { if constexpr (GATHER) { _Pragma("unroll") for (int _i = 0; _i < 2; ++_i) { \
        d0[_i] = (unsigned)g.rowtab[(ord) * 256 + gR[_i]] * (unsigned)(K * 2) + gC[_i]; d1[_i] = (unsigned)g.rowtab[(ord) * 256 + 128 + gR[_i]] * (unsigned)(K * 2) + gC[_i]; } } } while (0)
    const size_t hstep = (size_t)HALF * K * 2;
    const size_t hstepA = GATHER ? 0 : hstep;
    const size_t tstep = 2 * hstep;
    const unsigned ldsw = (unsigned)wid * 1024u;
    const int aoff = lds_byte(wr * 64 + fr, fq * 8), boff = lds_byte(wc * 32 + fr, fq * 8);
    typedef int v8i_t __attribute__((ext_vector_type(8))); typedef short v16s_a16 __attribute__((ext_vector_type(16), aligned(16)));
    const int f8c = 32 * (fq >> 1) + 16 * (fq & 1);
    const int aoff8a = lds_byte(wr * 64 + fr, f8c), boff8a = lds_byte(wc * 32 + fr, f8c);
    v8i_t At8[4], Au8[4], B08[2], B18[2]; int f8scale = 127; asm volatile("" : "+v"(f8scale));
#define PG8_SA(b, h) (((b) * 2 + (h)) * HTB)
#define PG8_SB(b, h) ((4 + (b) * 2 + (h)) * HTB)
#define PG8_STAGE(bufoff, gbase, voff) do { _Pragma("unroll") for (int _i = 0; _i < 2; ++_i) \
        __builtin_amdgcn_global_load_lds((const unsigned*)((const char*)(gbase) + (voff)[_i]), (PG8_LAS unsigned*)(lds + (bufoff) + ldsw + _i * 8192), 16, 0, 0); } while (0)
#define PG8_LDA(dst, b, h) do { if constexpr (F8) { _Pragma("unroll") for (int m = 0; m < 4; ++m) { const bf16x8 lo_ = *(const PG8_LAS bf16x8*)(lds + PG8_SA(b, h) + aoff8a + m * 2048), hi_ = *(const PG8_LAS bf16x8*)(lds + PG8_SA(b, h) + aoff8a + m * 2048 + 16); dst##8[m] = __builtin_bit_cast(v8i_t, __builtin_shufflevector(lo_, hi_, 0, 1, 2, 3, 4, 5, 6, 7, 8, 9, 10, 11, 12, 13, 14, 15)); } } \
        else { _Pragma("unroll") for (int m = 0; m < 4; ++m) _Pragma("unroll") for (int k = 0; k < 2; ++k) dst[m][k] = *(const PG8_LAS bf16x8*)(lds + PG8_SA(b, h) + aoff + m * 2048 + k * 1024); } } while (0)
#define PG8_LDB(dst, b, h) do { if constexpr (F8) { _Pragma("unroll") for (int n = 0; n < 2; ++n) { const bf16x8 lo_ = *(const PG8_LAS bf16x8*)(lds + PG8_SB(b, h) + boff8a + n * 2048), hi_ = *(const PG8_LAS bf16x8*)(lds + PG8_SB(b, h) + boff8a + n * 2048 + 16); dst##8[n] = __builtin_bit_cast(v8i_t, __builtin_shufflevector(lo_, hi_, 0, 1, 2, 3, 4, 5, 6, 7, 8, 9, 10, 11, 12, 13, 14, 15)); } } \
        else { _Pragma("unroll") for (int n = 0; n < 2; ++n) _Pragma("unroll") for (int k = 0; k < 2; ++k) dst[n][k] = *(const PG8_LAS bf16x8*)(lds + PG8_SB(b, h) + boff + n * 2048 + k * 1024); } } while (0)
#define PG8_MMA(ai, bj, At, Bt) do { __builtin_amdgcn_s_setprio(1); if constexpr (F8) { _Pragma("unroll") for (int m = 0; m < 4; ++m) _Pragma("unroll") for (int n = 0; n < 2; ++n) \
            asm volatile("v_mfma_scale_f32_16x16x128_f8f6f4 %0, %1, %2, %0, %3, %3 op_sel_hi:[0,0,0]" : "+v"(acc[ai][bj][m][n]) : "v"(Bt##8[n]), "v"(At##8[m]), "v"(f8scale)); } \
        else { _Pragma("unroll") for (int m = 0; m < 4; ++m) _Pragma("unroll") for (int n = 0; n < 2; ++n) _Pragma("unroll") for (int k = 0; k < 2; ++k) \
        acc[ai][bj][m][n] = __builtin_amdgcn_mfma_f32_16x16x32_bf16(Bt[n][k], At[m][k], acc[ai][bj][m][n], 0, 0, 0); } __builtin_amdgcn_s_setprio(0); } while (0)
#define PG8_WAIT_V(n) asm volatile("s_waitcnt vmcnt(" #n ")" ::: "memory")
#define PG8_WAIT_L(n) asm volatile("s_waitcnt lgkmcnt(" #n ")" ::: "memory")
#define PG8_BAR __builtin_amdgcn_s_barrier()
#define PG8_SCHED __builtin_amdgcn_sched_barrier(0)
    Unit cur, nxt; int ui = 0;
    if (!S.next(0, cur)) return;
    f32x4 acc[2][2][4][2];
#pragma unroll
    for (int a = 0; a < 2; ++a)
#pragma unroll
        for (int b = 0; b < 2; ++b)
#pragma unroll
            for (int m = 0; m < 4; ++m)
#pragma unroll
                for (int n = 0; n < 2; ++n) acc[a][b][m][n] = (f32x4){0.f, 0.f, 0.f, 0.f};
    bf16x8 At[4][2], Au[4][2], B0[2][2], B1[2][2];
    const char* cA = (const char*)g.A + (GATHER ? (size_t)0 : (size_t)cur.pm * tstep); PG8_GFETCH(vAc0, vAc1, 0); const char* cB = (const char*)g.Bt + (size_t)cur.e * g.bstride + (size_t)cur.pn * tstep;
    S.a_ready(cur);
    if constexpr (SP2) {
        PG8_STAGE(PG8_SB(0, 0), cB, voffB); PG8_STAGE(PG8_SB(0, 1), cB + hstep, voffB); PG8_STAGE(PG8_SA(0, 0), cA, vAc0); PG8_STAGE(PG8_SA(0, 1), cA + hstepA, vAc1);
        if (wr == 1) PG8_BAR;
        PG8_WAIT_V(2); PG8_BAR;
        PG8_STAGE(PG8_SB(1, 0), cB + kstep, voffB); PG8_STAGE(PG8_SA(1, 0), cA + kstep, vAc0); PG8_STAGE(PG8_SB(1, 1), cB + hstep + kstep, voffB);
        PG8_WAIT_V(6); PG8_BAR;
    } else {
        PG8_STAGE(PG8_SB(0, 0), cB, voffB); PG8_STAGE(PG8_SA(0, 0), cA, voffA); PG8_STAGE(PG8_SB(0, 1), cB + hstep, voffB); PG8_STAGE(PG8_SA(0, 1), cA + hstep, voffA);
        if (wr == 1) PG8_BAR;
        PG8_WAIT_V(4); PG8_BAR;
        PG8_STAGE(PG8_SB(1, 0), cB + kstep, voffB); PG8_STAGE(PG8_SA(1, 0), cA + kstep, voffA); PG8_STAGE(PG8_SB(1, 1), cB + hstep + kstep, voffB);
        PG8_WAIT_V(6); PG8_BAR;
    }
    for (;;) {
        const bool has_next = S.next(ui + 1, nxt);
        const char* nA = (has_next && !GATHER) ? (const char*)g.A + (size_t)nxt.pm * tstep : cA;
        if constexpr (GATHER) { if (has_next) PG8_GFETCH(vAn0, vAn1, ui + 1); else { vAn0[0] = vAc0[0]; vAn0[1] = vAc0[1]; vAn1[0] = vAc1[0]; vAn1[1] = vAc1[1]; } }
        const char* nB = has_next ? (const char*)g.Bt + (size_t)nxt.e * g.bstride + (size_t)nxt.pn * tstep : cB;
#pragma unroll 1
        for (int t = 0; t < nt; t += 2) {
            const bool last = (t == nt - 2);
            const char* a1 = cA + (size_t)(t + 1) * kstep;
            const char* a2 = last ? nA : cA + (size_t)(t + 2) * kstep; const char* b2 = last ? nB : cB + (size_t)(t + 2) * kstep;
            const char* a3 = a2 + kstep; const char* b3 = b2 + kstep;
            if (last && has_next) S.a_ready(nxt);
            unsigned vS0[2], vS1[2];
            vS0[0] = last ? vAn0[0] : vAc0[0]; vS0[1] = last ? vAn0[1] : vAc0[1]; vS1[0] = last ? vAn1[0] : vAc1[0]; vS1[1] = last ? vAn1[1] : vAc1[1];
            if constexpr (SP2) {
            PG8_LDB(B0, 0, 0); PG8_LDB(B1, 0, 1); PG8_SCHED; PG8_LDA(At, 0, 0); PG8_STAGE(PG8_SA(1, 1), a1 + hstepA, vAc1);
            PG8_WAIT_V(8); PG8_WAIT_L(0); PG8_BAR; PG8_MMA(0, 0, At, B0); PG8_MMA(0, 1, At, B1); PG8_BAR; PG8_SCHED;
            if constexpr (F8) { PG8_LDA(Au, 0, 1); } else { PG8_LDA(At, 0, 1); } PG8_STAGE(PG8_SB(0, 0), b2, voffB); PG8_STAGE(PG8_SB(0, 1), b2 + hstep, voffB); PG8_STAGE(PG8_SA(0, 0), a2, vS0);
            PG8_WAIT_V(8); PG8_WAIT_L(0); PG8_BAR; if constexpr (F8) { PG8_MMA(1, 0, Au, B0); PG8_MMA(1, 1, Au, B1); } else { PG8_MMA(1, 0, At, B0); PG8_MMA(1, 1, At, B1); } PG8_BAR; PG8_SCHED;
            PG8_LDB(B0, 1, 0); PG8_LDB(B1, 1, 1); PG8_SCHED; PG8_LDA(At, 1, 0); PG8_STAGE(PG8_SA(0, 1), a2 + hstepA, vS1);
            PG8_WAIT_V(8); PG8_WAIT_L(0); PG8_BAR; PG8_MMA(0, 0, At, B0); PG8_MMA(0, 1, At, B1); PG8_BAR; PG8_SCHED;
            if constexpr (F8) { PG8_LDA(Au, 1, 1); } else { PG8_LDA(At, 1, 1); } PG8_STAGE(PG8_SB(1, 0), b3, voffB); PG8_STAGE(PG8_SB(1, 1), b3 + hstep, voffB); PG8_STAGE(PG8_SA(1, 0), a3, vS0);
            PG8_WAIT_V(8); PG8_WAIT_L(0); PG8_BAR; if constexpr (F8) { PG8_MMA(1, 0, Au, B0); PG8_MMA(1, 1, Au, B1); } else { PG8_MMA(1, 0, At, B0); PG8_MMA(1, 1, At, B1); } PG8_BAR; PG8_SCHED;
            } else {
            PG8_LDB(B0, 0, 0); PG8_SCHED; PG8_LDA(At, 0, 0); PG8_STAGE(PG8_SA(1, 1), a1 + hstep, voffA);
            PG8_WAIT_L(8); PG8_BAR; PG8_WAIT_L(0); PG8_MMA(0, 0, At, B0); PG8_BAR; PG8_SCHED;
            PG8_LDB(B1, 0, 1); PG8_STAGE(PG8_SB(0, 0), b2, voffB);
            PG8_BAR; PG8_WAIT_L(0); PG8_MMA(0, 1, At, B1); PG8_BAR;
            PG8_LDA(At, 0, 1); PG8_STAGE(PG8_SA(0, 0), a2, voffA);
            PG8_BAR; PG8_WAIT_L(0); PG8_MMA(1, 0, At, B0); PG8_BAR; PG8_SCHED;
            PG8_STAGE(PG8_SB(0, 1), b2 + hstep, voffB);
            PG8_WAIT_V(6); PG8_BAR; PG8_MMA(1, 1, At, B1); PG8_BAR;
            PG8_LDB(B0, 1, 0); PG8_SCHED; PG8_LDA(At, 1, 0); PG8_STAGE(PG8_SA(0, 1), a2 + hstep, voffA);
            PG8_WAIT_L(8); PG8_BAR; PG8_WAIT_L(0); PG8_MMA(0, 0, At, B0); PG8_BAR; PG8_SCHED;
            PG8_LDB(B1, 1, 1); PG8_STAGE(PG8_SB(1, 0), b3, voffB);
            PG8_BAR; PG8_WAIT_L(0); PG8_MMA(0, 1, At, B1); PG8_BAR;
            PG8_LDA(At, 1, 1); PG8_STAGE(PG8_SA(1, 0), a3, voffA);
            PG8_BAR; PG8_WAIT_L(0); PG8_MMA(1, 0, At, B0); PG8_BAR; PG8_SCHED;
            PG8_STAGE(PG8_SB(1, 1), b3 + hstep, voffB);
            PG8_WAIT_V(6); PG8_BAR; PG8_MMA(1, 1, At, B1); PG8_BAR;
            }
        }
        if constexpr (ALIGN_EPI) { if (wr == 0) PG8_BAR; }
        if constexpr (F8) asm volatile("s_nop 15\n\ts_nop 15" ::: "memory");
        if constexpr (!Epi::AFTER_DRAIN) { E(acc, cur, wr, wc, fr, fq); S.done(cur); }
        if (!has_next) break;
#pragma unroll
        for (int a = 0; a < 2; ++a)
#pragma unroll
            for (int b = 0; b < 2; ++b)
#pragma unroll
                for (int m = 0; m < 4; ++m)
#pragma unroll
                    for (int n = 0; n < 2; ++n) acc[a][b][m][n] = (f32x4){0.f, 0.f, 0.f, 0.f};
        cur = nxt; cA = nA; cB = nB; ++ui;
        if constexpr (GATHER) { vAc0[0] = vAn0[0]; vAc0[1] = vAn0[1]; vAc1[0] = vAn1[0]; vAc1[1] = vAn1[1]; }
        if constexpr (ALIGN_EPI) { if (wr == 1) PG8_BAR; }
    }
    PG8_WAIT_V(0);
    if constexpr (!ALIGN_EPI) { if (wr == 0) PG8_BAR; }
    PG8_BAR;
    if constexpr (Epi::AFTER_DRAIN) { E.fused(acc, cur, wr, wc, fr, fq, lds, wid, lane); S.done(cur); }
#undef PG8_SA
#undef PG8_SB
#undef PG8_STAGE
#undef PG8_LDA
#undef PG8_LDB
#undef PG8_MMA
#undef PG8_WAIT_V
#undef PG8_WAIT_L
#undef PG8_BAR
#undef PG8_SCHED
#undef PG8_GFETCH
}
}
#include <hip/hip_bf16.h>
#include <cmath>
namespace attn_body {
using bf16=__hip_bfloat16;
using bf16x8=__attribute__((ext_vector_type(8)))short;
using s16x4=__attribute__((ext_vector_type(4)))short;
using f32x16=__attribute__((ext_vector_type(16)))float;
using u32x4=__attribute__((ext_vector_type(4)))unsigned;
constexpr int D=64,DM=1024,KVP=256;
constexpr int NW=8,QBLK=32,QB=QBLK*NW,KVBLK=64;
__device__ __forceinline__ int crow(int r,int hi){return (r&3)+8*(r>>2)+4*hi;}
#define SBAR() __builtin_amdgcn_sched_barrier(0)
__device__ __forceinline__ void cmask(f32x16&p0,f32x16&p1,int jb,int qrel,int hi){
  const float NEG=-INFINITY; int kb=64*jb+4*hi;
  #pragma unroll
  for(int r=0;r<16;++r){int kv=kb+(r&3)+8*(r>>2); if(kv>qrel)p0[r]=NEG; if(kv+32>qrel)p1[r]=NEG;}
}

constexpr int NSLOT=3, SLOTB=8192;
constexpr int LDS_K=0, LDS_V=NSLOT*SLOTB, LDS_WS=2*NSLOT*SLOTB, LDS_OST=LDS_WS+NW*64*4, LDS_BYTES=LDS_OST+NW*4096;
constexpr float C2=0.125f*1.4426950408889634f;
__device__ __forceinline__ void glds16(const void*gsrc,unsigned lds_dst){unsigned keep;
  asm volatile("s_mov_b32 %0, m0\n\ts_mov_b32 m0, %2\n\ts_nop 0\n\tglobal_load_lds_dwordx4 %1, off\n\ts_mov_b32 m0, %0":"=&s"(keep):"v"(gsrc),"s"(lds_dst):"memory");}
__device__ __forceinline__ float max3f(float a,float b,float c){float r;asm("v_max3_f32 %0, %1, %2, %3":"=v"(r):"v"(a),"v"(b),"v"(c));return r;}
__device__ __forceinline__ float max2f(float a,float b){float r;asm("v_max_f32_e32 %0, %1, %2":"=v"(r):"v"(a),"v"(b));return r;}
__device__ __forceinline__ float fadd_s(float a,float b){float r;asm("v_add_f32_e32 %0, %1, %2":"=v"(r):"v"(a),"v"(b));return r;}
__device__ __forceinline__ float fsub_s(float a,float b){float r;asm("v_sub_f32_e32 %0, %1, %2":"=v"(r):"v"(a),"v"(b));return r;}
typedef float f32x2_t __attribute__((ext_vector_type(2))); typedef __bf16 bf16x2_t __attribute__((ext_vector_type(2)));
__device__ __forceinline__ unsigned cvtpk_s(float lo,float hi){f32x2_t v={lo,hi};bf16x2_t b=__builtin_convertvector(v,bf16x2_t);return __builtin_bit_cast(unsigned,b);}
#define WAIT_BAR(N) asm volatile("s_waitcnt vmcnt(" #N ") lgkmcnt(0)\n\ts_barrier":::"memory")

__device__ __forceinline__ void qkt(f32x16&p0,f32x16&p1,const char*Kslot,const bf16x8*qr,const f32x16&negm,int r32,int hi){
  const char*kb=Kslot+hi*1024+r32*16;
  #pragma unroll
  for(int d0=0;d0<4;++d0){
    const bf16x8 b0=*reinterpret_cast<const bf16x8*>(kb+d0*2048);
    const bf16x8 b1=*reinterpret_cast<const bf16x8*>(kb+d0*2048+512);
    if(d0==0){p0=__builtin_amdgcn_mfma_f32_32x32x16_bf16(b0,qr[0],negm,0,0,0);p1=__builtin_amdgcn_mfma_f32_32x32x16_bf16(b1,qr[0],negm,0,0,0);}
    else{p0=__builtin_amdgcn_mfma_f32_32x32x16_bf16(b0,qr[d0],p0,0,0,0);p1=__builtin_amdgcn_mfma_f32_32x32x16_bf16(b1,qr[d0],p1,0,0,0);}}
}
typedef __attribute__((address_space(3))) const char* lds_cptr;
typedef short v4i16_t __attribute__((ext_vector_type(4)));
__device__ __forceinline__ void kload8(bf16x8*kf,lds_cptr kp){
  kf[0]=*(const __attribute__((address_space(3))) bf16x8*)(kp);      kf[1]=*(const __attribute__((address_space(3))) bf16x8*)(kp+512);
  kf[2]=*(const __attribute__((address_space(3))) bf16x8*)(kp+2048); kf[3]=*(const __attribute__((address_space(3))) bf16x8*)(kp+2560);
  kf[4]=*(const __attribute__((address_space(3))) bf16x8*)(kp+4096); kf[5]=*(const __attribute__((address_space(3))) bf16x8*)(kp+4608);
  kf[6]=*(const __attribute__((address_space(3))) bf16x8*)(kp+6144); kf[7]=*(const __attribute__((address_space(3))) bf16x8*)(kp+6656);
}
__device__ __forceinline__ void kload2(bf16x8*kf,lds_cptr kp,int j){ kf[2*j]=*(const __attribute__((address_space(3))) bf16x8*)(kp+j*2048); kf[2*j+1]=*(const __attribute__((address_space(3))) bf16x8*)(kp+j*2048+512); }
__device__ __forceinline__ s16x4 vtr(lds_cptr p){ return __builtin_bit_cast(s16x4,__builtin_amdgcn_ds_read_tr16_b64_v4i16((__attribute__((address_space(3))) v4i16_t*)p)); }
__device__ __forceinline__ float rowmax(const f32x16&p0,const f32x16&p1){
  float a=max3f(p0[0],p0[1],p1[0]),b=max3f(p0[2],p0[3],p1[1]);a=max3f(a,p1[2],p1[3]);
  #pragma unroll
  for(int r=4;r<16;r+=4){a=max3f(a,p0[r],p0[r+1]);b=max3f(b,p0[r+2],p0[r+3]);a=max3f(a,p1[r],p1[r+1]);b=max3f(b,p1[r+2],p1[r+3]);}
  const float m=max2f(a,b);
  auto rr=__builtin_amdgcn_permlane32_swap(__float_as_uint(m),__float_as_uint(m),false,false);
  return max2f(__uint_as_float(rr[0]),__uint_as_float(rr[1]));
}
__device__ __forceinline__ void pv(f32x16*o,int vb,bf16x8 pa0,bf16x8 pa1,bf16x8 pa2,bf16x8 pa3){
  #pragma unroll
  for(int d0=0;d0<2;++d0){s16x4 lo[4],hi[4];
    #pragma unroll
    for(int ks=0;ks<4;++ks){
      asm volatile("ds_read_b64_tr_b16 %0,%1 offset:%c2":"=&v"(lo[ks]):"v"(vb),"i"(d0*4096+ks*1024):"memory");
      asm volatile("ds_read_b64_tr_b16 %0,%1 offset:%c2":"=&v"(hi[ks]):"v"(vb),"i"(d0*4096+ks*1024+512):"memory");}
    asm volatile("s_waitcnt lgkmcnt(0)":::"memory");SBAR();
    #define PK(k) (bf16x8){lo[k][0],lo[k][1],lo[k][2],lo[k][3],hi[k][0],hi[k][1],hi[k][2],hi[k][3]}
    o[d0]=__builtin_amdgcn_mfma_f32_32x32x16_bf16(pa0,PK(0),o[d0],0,0,0);
    o[d0]=__builtin_amdgcn_mfma_f32_32x32x16_bf16(pa1,PK(1),o[d0],0,0,0);
    o[d0]=__builtin_amdgcn_mfma_f32_32x32x16_bf16(pa2,PK(2),o[d0],0,0,0);
    o[d0]=__builtin_amdgcn_mfma_f32_32x32x16_bf16(pa3,PK(3),o[d0],0,0,0);
    #undef PK
  }
}

#ifndef ATTN_STORE16
#define ATTN_STORE16(p,v) (*(u32x4*)(p)=(v))
#endif
template<int THRL> __device__ __forceinline__ void attn_unit(long qrow0,long kvrow0,int NT,int h,const bf16*Q,const bf16*__restrict__ K,const bf16*__restrict__ V,bf16*O,char*shm,int tid_in){
  int tid_l=tid_in; asm volatile("":"+v"(tid_l)); const int tid=tid_l,lane=tid&63,r32=lane&31,hi=lane>>5; const int wid=__builtin_amdgcn_readfirstlane(tid>>6);
  const bf16*Qw=Q+(qrow0+wid*QBLK)*DM+h*D;
  const bf16*Kh=K+kvrow0*KVP+(h>>2)*D,*Vh=V+kvrow0*KVP+(h>>2)*D;
  const unsigned lds0=(unsigned)(uintptr_t)shm;
  float*wsf=(float*)(shm+LDS_WS)+wid*64;
  const bf16*ksrc=Kh+(long)lane*KVP+wid*8;
  const bf16*vsrc=Vh+(long)(16*(wid&3)+(lane>>2))*KVP+(wid>>2)*32+(lane&3)*8;
  const unsigned kdst=lds0+LDS_K+wid*1024, vdst=lds0+LDS_V+wid*1024;
  #define DMA_K(t,slot) glds16(ksrc+(long)(t)*KVBLK*KVP,(unsigned)__builtin_amdgcn_readfirstlane(kdst+(slot)))
  #define DMA_V(t,slot) glds16(vsrc+(long)(t)*KVBLK*KVP,(unsigned)__builtin_amdgcn_readfirstlane(vdst+(slot)))
  const int vb0=(int)(lds0+LDS_V)+((lane>>4)&1)*32+(lane&3)*8+(4*hi+((lane&15)>>2))*64;
  const char*Kbase=shm+LDS_K; bf16x8 kf[8];
  const lds_cptr shm3=(lds_cptr)shm; const lds_cptr kp0=shm3+LDS_K+hi*1024+r32*16; const lds_cptr vp0=shm3+LDS_V+((lane>>4)&1)*32+(lane&3)*8+(4*hi+((lane&15)>>2))*64;
  DMA_K(0,0);DMA_V(0,0);DMA_K(1,SLOTB);
  bf16x8 qr[4];
  #pragma unroll
  for(int d0=0;d0<4;++d0)qr[d0]=*reinterpret_cast<const bf16x8*>(&Qw[(long)r32*DM+d0*16+hi*8]);
  float mhat=0.f,l_reg=0.f;f32x16 o[2];o[0]=f32x16{};o[1]=f32x16{};f32x16 negm=f32x16{};asm volatile("":"+v"(negm));
  #define CMASK(P0,P1,t) do{}while(0)
  bool resc=false;
  #define START(P0,P1) do{ const float rm=rowmax(P0,P1); resc=false; \
    { const float dl=rm; mhat=fadd_s(mhat,dl); \
      _Pragma("unroll") for(int r=0;r<16;++r){P0[r]=fsub_s(P0[r],dl);P1[r]=fsub_s(P1[r],dl);} \
      _Pragma("unroll") for(int r=0;r<16;++r)negm[r]=-mhat; asm volatile("":"+v"(negm)); } \
    _Pragma("unroll") for(int r=0;r<16;++r)P0[r]=__builtin_amdgcn_exp2f(P0[r]); }while(0)
  #define RESC() do{ if(resc){ asm volatile("s_waitcnt lgkmcnt(0)":::"memory"); \
      _Pragma("unroll") for(int d_=0;d_<2;++d_) _Pragma("unroll") for(int r=0;r<16;++r)o[d_][r]*=wsf[crow(r,hi)]; } }while(0)
  f32x16 pA0,pA1,pB0,pB1;
  int sl_prev=0,sl_cur=0,sl_next=SLOTB;
  #define ROT() do{sl_prev=sl_cur;sl_cur=sl_next;sl_next=(sl_next==(NSLOT-1)*SLOTB)?0:sl_next+SLOTB;}while(0)
  DMA_K(2,2*SLOTB);
  WAIT_BAR(3);
  qkt(pA0,pA1,Kbase,qr,negm,r32,hi);asm volatile("s_nop 15\n\ts_nop 7":"+v"(pA0),"+v"(pA1));CMASK(pA0,pA1,0);
  START(pA0,pA1);
  _Pragma("unroll") for(int r=0;r<16;++r)pA1[r]=__builtin_amdgcn_exp2f(pA1[r]);
  WAIT_BAR(0);
  DMA_K(3,0);DMA_V(1,SLOTB);
  ROT();
  kload8(kf,kp0+sl_cur);
  WAIT_BAR(2);
  s16x4 vlo[8],vhi[8]; u32x4 pw0,pw1,pw2,pw3;
  #define PKW(P,B) cvtpk_s(P[B],P[B+1])
  #define PAF(k) __builtin_bit_cast(bf16x8,pw##k)
  #define VFR(i) (bf16x8){vlo[i][0],vlo[i][1],vlo[i][2],vlo[i][3],vhi[i][0],vhi[i][1],vhi[i][2],vhi[i][3]}
  #define PIN(x) asm volatile("":"+v"(x))
  #define MX3(a,b,c) __builtin_fmaxf(__builtin_fmaxf((a),(b)),(c))
  #define GAPA(MF,A0,A1,A2,A3,W0,W1,PW) do{ MF; sacc+=A0; sacc+=A1; sacc+=A2; sacc+=A3; PIN(sacc); W0; W1; PIN(PW); SBAR(); }while(0)
  #define EX(v) __builtin_amdgcn_exp2f(v)
  #define GAPB(MF,X,B) do{ MF; X[B]=EX(X[B]); X[B+1]=EX(X[B+1]); X[B+2]=EX(X[B+2]); X[B+3]=EX(X[B+3]); PIN(X); SBAR(); }while(0)
  #define VRD(i) do{ vlo[i]=vtr(vp_+(((i)>>2)*4096+((i)&3)*1024)); vhi[i]=vtr(vp_+(((i)>>2)*4096+((i)&3)*1024+512)); }while(0)
  #define KRD(G,j) do{ if(G){ kload2(kf,kp0+sl_next,j); SBAR(); } }while(0)
  #define STEP(C0,C1,P0,P1,t,GK,GV,GL) do{ SBAR(); \
    const lds_cptr vp_=vp0+sl_prev; \
    VRD(0); SBAR(); float sacc=(P0[0]+P0[1]); \
    GAPA(C0=__builtin_amdgcn_mfma_f32_32x32x16_bf16(kf[0],qr[0],negm,0,0,0), P0[2],P0[3],P0[4],P0[5],     pw0[0]=PKW(P0,0), pw0[1]=PKW(P0,2), pw0); \
    VRD(4); SBAR(); GAPA(C1=__builtin_amdgcn_mfma_f32_32x32x16_bf16(kf[1],qr[0],negm,0,0,0), P0[6],P0[7],P0[8],P0[9],     pw0[2]=PKW(P0,4), pw0[3]=PKW(P0,6), pw0); \
    VRD(1); SBAR(); GAPA(C0=__builtin_amdgcn_mfma_f32_32x32x16_bf16(kf[2],qr[1],C0,0,0,0),   P0[10],P0[11],P0[12],P0[13], pw1[0]=PKW(P0,8), pw1[1]=PKW(P0,10), pw1); \
    VRD(5); SBAR(); GAPA(C1=__builtin_amdgcn_mfma_f32_32x32x16_bf16(kf[3],qr[1],C1,0,0,0),   P0[14],P0[15],P1[0],P1[1],   pw1[2]=PKW(P0,12),pw1[3]=PKW(P0,14), pw1); \
    VRD(2); SBAR(); GAPA(C0=__builtin_amdgcn_mfma_f32_32x32x16_bf16(kf[4],qr[2],C0,0,0,0),   P1[2],P1[3],P1[4],P1[5],     pw2[0]=PKW(P1,0), pw2[1]=PKW(P1,2), pw2); \
    VRD(6); SBAR(); GAPA(C1=__builtin_amdgcn_mfma_f32_32x32x16_bf16(kf[5],qr[2],C1,0,0,0),   P1[6],P1[7],P1[8],P1[9],     pw2[2]=PKW(P1,4), pw2[3]=PKW(P1,6), pw2); \
    VRD(3); SBAR(); GAPA(C0=__builtin_amdgcn_mfma_f32_32x32x16_bf16(kf[6],qr[3],C0,0,0,0),   P1[10],P1[11],P1[12],P1[13], pw3[0]=PKW(P1,8), pw3[1]=PKW(P1,10), pw3); \
    VRD(7); SBAR(); GAPA(C1=__builtin_amdgcn_mfma_f32_32x32x16_bf16(kf[7],qr[3],C1,0,0,0),   P1[14],P1[15],0.f,0.f,       pw3[2]=PKW(P1,12),pw3[3]=PKW(P1,14), pw3); \
    l_reg+=sacc; \
    if(GK){DMA_K((t)+3,sl_cur);} if(GV){DMA_V((t)+1,sl_next);} \
    CMASK(C0,C1,t); \
    { float a=MX3(C0[0],C0[1],C1[0]),b=MX3(C0[2],C0[3],C1[1]); a=MX3(a,C1[2],C1[3]); \
      _Pragma("unroll") for(int r=4;r<16;r+=4){a=MX3(a,C0[r],C0[r+1]);b=MX3(b,C0[r+2],C0[r+3]);a=MX3(a,C1[r],C1[r+1]);b=MX3(b,C1[r+2],C1[r+3]);} \
      float rm=__builtin_fmaxf(a,b); { auto rr=__builtin_amdgcn_permlane32_swap(__float_as_uint(rm),__float_as_uint(rm),false,false); rm=__builtin_fmaxf(__uint_as_float(rr[0]),__uint_as_float(rr[1])); } \
      resc=false; \
      if(__builtin_expect(__any(rm>(float)THRL),0)){ const float dl=__builtin_fmaxf(rm,0.f); mhat+=dl; \
        _Pragma("unroll") for(int r=0;r<16;++r){C0[r]-=dl;C1[r]-=dl;} \
        _Pragma("unroll") for(int r=0;r<16;++r)negm[r]=-mhat; asm volatile("":"+v"(negm)); \
        const float f=__builtin_amdgcn_exp2f(-dl); l_reg*=f; if(hi==0)wsf[r32]=f; resc=true; } } \
    SBAR(); \
    GAPB(o[0]=__builtin_amdgcn_mfma_f32_32x32x16_bf16(PAF(0),VFR(0),o[0],0,0,0), C0,0); \
    GAPB(o[1]=__builtin_amdgcn_mfma_f32_32x32x16_bf16(PAF(0),VFR(4),o[1],0,0,0), C0,4); \
    KRD(GL,0); GAPB(o[0]=__builtin_amdgcn_mfma_f32_32x32x16_bf16(PAF(1),VFR(1),o[0],0,0,0), C0,8); \
    KRD(GL,1); GAPB(o[1]=__builtin_amdgcn_mfma_f32_32x32x16_bf16(PAF(1),VFR(5),o[1],0,0,0), C0,12); \
    KRD(GL,2); GAPB(o[0]=__builtin_amdgcn_mfma_f32_32x32x16_bf16(PAF(2),VFR(2),o[0],0,0,0), C1,0); \
    KRD(GL,3); GAPB(o[1]=__builtin_amdgcn_mfma_f32_32x32x16_bf16(PAF(2),VFR(6),o[1],0,0,0), C1,4); \
    GAPB(o[0]=__builtin_amdgcn_mfma_f32_32x32x16_bf16(PAF(3),VFR(3),o[0],0,0,0), C1,8); \
    GAPB(o[1]=__builtin_amdgcn_mfma_f32_32x32x16_bf16(PAF(3),VFR(7),o[1],0,0,0), C1,12); \
    }while(0)
  int t=1;
  #undef CMASK
  #define CMASK(P0,P1,t) do{}while(0)
  for(;t+5<NT;t+=2){
    STEP(pB0,pB1,pA0,pA1,t,true,true,true);     WAIT_BAR(2); RESC(); ROT();
    STEP(pA0,pA1,pB0,pB1,t+1,true,true,true);   WAIT_BAR(2); RESC(); ROT();
  }
  #undef CMASK
  #define CMASK(P0,P1,t) do{}while(0)
  #define ENDW(tt) do{ if((tt)+3<NT){WAIT_BAR(2);} else if((tt)+2<NT){WAIT_BAR(1);} else {WAIT_BAR(0);} }while(0)
  for(;t+1<NT;t+=2){
    STEP(pB0,pB1,pA0,pA1,t,(t+3<NT),(t+1<NT),(t+1<NT));       ENDW(t);   RESC(); ROT();
    STEP(pA0,pA1,pB0,pB1,t+1,(t+4<NT),(t+2<NT),(t+2<NT));     ENDW(t+1); RESC(); ROT();
  }
  STEP(pB0,pB1,pA0,pA1,NT-1,false,false,false); RESC();
  { float sacc=pB0[0]+pB0[1]; _Pragma("unroll") for(int r=2;r<16;++r)sacc+=pB0[r]; _Pragma("unroll") for(int r=0;r<16;++r)sacc+=pB1[r]; l_reg+=sacc;
    pw0=(u32x4){PKW(pB0,0),PKW(pB0,2),PKW(pB0,4),PKW(pB0,6)};pw1=(u32x4){PKW(pB0,8),PKW(pB0,10),PKW(pB0,12),PKW(pB0,14)};pw2=(u32x4){PKW(pB1,0),PKW(pB1,2),PKW(pB1,4),PKW(pB1,6)};pw3=(u32x4){PKW(pB1,8),PKW(pB1,10),PKW(pB1,12),PKW(pB1,14)};
    SBAR(); pv(o,vb0+sl_cur,PAF(0),PAF(1),PAF(2),PAF(3)); }
  #undef PKW
  #undef PAF
  #undef VFR
  #undef PIN
  #undef MX3
  #undef GAPA
  #undef GAPB
  #undef EX
  #undef VRD
  #undef KRD
  #undef STEP
  #undef ENDW
  {auto rr=__builtin_amdgcn_permlane32_swap(__float_as_uint(l_reg),__float_as_uint(l_reg),false,false);l_reg=__uint_as_float(rr[0])+__uint_as_float(rr[1]);}
  if(hi==0)wsf[32+r32]=l_reg;asm volatile("s_waitcnt lgkmcnt(0)":::"memory");
  float rli[16];
  #pragma unroll
  for(int r=0;r<16;++r)rli[r]=__builtin_amdgcn_rcpf(wsf[32+crow(r,hi)]);
  bf16*Ow=O+(qrow0+wid*QBLK)*DM+h*D;
  { bf16*stg=(bf16*)(shm+LDS_OST)+wid*2048;
    #pragma unroll
    for(int r=0;r<16;++r){const int orow=crow(r,hi);
      #pragma unroll
      for(int d0=0;d0<2;++d0)stg[orow*64+d0*32+r32]=__float2bfloat16(o[d0][r]*rli[r]);}
    asm volatile("s_waitcnt lgkmcnt(0)":::"memory");
    #pragma unroll
    for(int i=0;i<4;++i){const int row=i*8+(lane>>3),ch=lane&7; const u32x4 v=*(const u32x4*)(stg+row*64+ch*8);
      #define O8C(x_) __builtin_amdgcn_fmed3f((x_)*32.f,-448.f,448.f)
      int w0=0,w1=0; w0=__builtin_amdgcn_cvt_pk_fp8_f32(O8C(__uint_as_float(v[0]<<16)),O8C(__uint_as_float(v[0]&0xffff0000u)),w0,false); w0=__builtin_amdgcn_cvt_pk_fp8_f32(O8C(__uint_as_float(v[1]<<16)),O8C(__uint_as_float(v[1]&0xffff0000u)),w0,true);
      w1=__builtin_amdgcn_cvt_pk_fp8_f32(O8C(__uint_as_float(v[2]<<16)),O8C(__uint_as_float(v[2]&0xffff0000u)),w1,false); w1=__builtin_amdgcn_cvt_pk_fp8_f32(O8C(__uint_as_float(v[3]<<16)),O8C(__uint_as_float(v[3]&0xffff0000u)),w1,true);
      #undef O8C
      *(unsigned long long*)((unsigned char*)O+((long)(qrow0+wid*QBLK+row))*DM+h*D+ch*8)=(unsigned long long)(unsigned)w0|((unsigned long long)(unsigned)w1<<32);} }
  asm volatile("s_waitcnt lgkmcnt(0)\n\ts_barrier":::"memory");
  #undef DMA_K
  #undef DMA_V
  #undef CMASK
  #undef START
  #undef RESC
  #undef ROT
}
constexpr int ATTN_LDS_BYTES=LDS_BYTES;
#undef SBAR
#undef WAIT_BAR
}

constexpr int NWAVES = 8;
constexpr int NB = 8, SEQ = 4096, CTXL = 256, TB = SEQ + CTXL  , MT = NB * TB  , DMODEL = 1024;
constexpr int NMODC = 6 * DMODEL, MODROWS = 9;
constexpr int QKVN = 1536, WINN = 3104, WINP = 3328;
constexpr int NEXP = 32, TOPK = 4, MPAD = MT * TOPK + NEXP * 256;
constexpr int NLAYER = 4;
constexpr float RMS_EPS = 1e-6f;
constexpr float ATT_C2 = 0.125f * 1.4426950408889634f;

constexpr size_t MiB = 1u << 20;
constexpr size_t WS_CTL = 0, CTL_ZERO_BYTES = 1 * MiB;
constexpr size_t WS_MOD = 1 * MiB, WS_ROPE = 2 * MiB, WS_MODP = 3 * MiB;
constexpr size_t WS_SLOT = 17 * MiB, WS_GATEW = 18 * MiB, WS_SLOTPOS = 19 * MiB;
constexpr size_t WS_WQKV = 20 * MiB, WS_WOA = 26 * MiB, WS_WIN = 30 * MiB, WS_WOG = 43 * MiB, WS_WGU = 48 * MiB, WS_WDN = 560 * MiB;
constexpr size_t WS_X = 816 * MiB, WS_XN = 952 * MiB, WS_Q = 1020 * MiB, WS_K = 1088 * MiB, WS_V = 1105 * MiB, WS_G = 1122 * MiB;
constexpr size_t WS_OF = 1343 * MiB, WS_OB = 1479 * MiB, WS_XG = 1615 * MiB, WS_ACT = 1903 * MiB, WS_Y = 2191 * MiB, WS_XN8 = WS_ACT + 150 * MiB  , WS_PAR = 2479 * MiB, WS_LIST = 2483 * MiB  , WS_END = 2488 * MiB;
static_assert(WS_MODP + (size_t)16 * NLAYER * MODROWS * NMODC * 4 <= WS_SLOT && WS_WIN + (size_t)2 * WINP * 1024 * 2 <= WS_WOG && WS_G + (size_t)MT * WINP * 2 <= WS_OF && WS_XG + (size_t)MPAD * 1024 * 2 <= WS_ACT, "ws map");
constexpr int CW_TMO = 0, CW_BAR = 4096, CW_CNT = 16384;

constexpr int RING_OFF = 0, RING_BYTES = 131072;
constexpr int WR_STRIDE = 1028;
constexpr int LDS_AUX = 133120;
constexpr int AUX_LCNT = LDS_AUX, AUX_GB = LDS_AUX + 128, AUX_T2E = LDS_AUX + 256  , AUX_BASE = AUX_T2E + 2560  , AUX_NT = AUX_BASE + 128, AUX_CNT = AUX_NT + 64  , AUX_ENT = AUX_CNT + 128  , AUX_RS = AUX_ENT + 4352  , AUX_ROWTAB = AUX_RS + 576, ROWTAB_UNITS = 18  ;
constexpr int MISC_OFF = 154624;
constexpr int LDS_BYTES = 155648;
static_assert(AUX_ROWTAB + ROWTAB_UNITS * 512 <= MISC_OFF, "LDS map");

#define GAS __attribute__((address_space(1)))
#define LAS __attribute__((address_space(3)))
typedef unsigned short bf16;
typedef unsigned v4u __attribute__((ext_vector_type(4)));
typedef float f32x4 __attribute__((ext_vector_type(4)));
typedef short bf16x8 __attribute__((ext_vector_type(8)));
typedef GAS unsigned gu32;
typedef GAS unsigned long long gu64;
#define RLX_AGENT __ATOMIC_RELAXED, __HIP_MEMORY_SCOPE_AGENT
#define LDS_WAIT() asm volatile("s_waitcnt lgkmcnt(0)" ::: "memory")
#define VM_WAIT() asm volatile("s_waitcnt vmcnt(0)" ::: "memory")
__device__ __forceinline__ unsigned long long rt() { return __builtin_amdgcn_s_memrealtime(); }
__device__ __forceinline__ unsigned f2bf(float f) { unsigned u = __builtin_bit_cast(unsigned, f); return (u + 0x7fffu + ((u >> 16) & 1u)) >> 16; }
typedef float pk2_f32x2 __attribute__((ext_vector_type(2))); typedef __bf16 pk2_bf16x2 __attribute__((ext_vector_type(2)));
__device__ __forceinline__ unsigned pk2(float lo, float hi) { return __builtin_bit_cast(unsigned, __builtin_convertvector((pk2_f32x2){lo, hi}, pk2_bf16x2)); }

#define XB_TMO      128
#define XB_XCNT(j)  (256  + 64 * (j))
#define XB_XSUB(j)  (1280 + 64 * (j))
#define XB_XGEN(j)  (2304 + 64 * (j))
#define XB_TOP      3328
#define XB_TOPGEN   3392
#define XCD_BAR_WORDS 3456
#define XB_SPIN_CAP (1u << 18)

__device__ __forceinline__ unsigned xb_ld(unsigned* p)              { return __hip_atomic_load(p, __ATOMIC_RELAXED, __HIP_MEMORY_SCOPE_AGENT); }
__device__ __forceinline__ unsigned xb_add(unsigned* p, unsigned v) { return __hip_atomic_fetch_add(p, v, __ATOMIC_RELAXED, __HIP_MEMORY_SCOPE_AGENT); }
__device__ __forceinline__ unsigned xb_xcc_id() { return (unsigned)__builtin_amdgcn_s_getreg((3 << 11) | 20) & 0xFu; }
#define XB_SPIN(cond, bar) do { unsigned _sp = 0; while (cond) { __builtin_amdgcn_s_sleep(1); \
    if ((++_sp & 255u) == 0u) { if (xb_ld(&(bar)[XB_TMO])) break; if (_sp > XB_SPIN_CAP) { atomicAdd(&(bar)[XB_TMO], 1u); break; } } } } while (0)

struct XcdBarrier {
    unsigned* bar; unsigned x;
    volatile LAS unsigned* st;
};

__device__ __forceinline__ XcdBarrier xcd_barrier_post(unsigned* bar, volatile LAS unsigned* st, bool xb_t0  ) {
    XcdBarrier b; b.bar = bar; b.x = xb_xcc_id(); b.st = st;
    if (xb_t0) (void)xb_add(&bar[XB_XCNT(b.x)], 1u);
    return b;
}
__device__ __forceinline__ void xcd_barrier_complete(unsigned* bar, unsigned x, unsigned& nloc, unsigned& nx) {
    const unsigned G = gridDim.x * gridDim.y * gridDim.z;
    unsigned sum, cnt, mine, sp = 0u;
    for (;;) {
        sum = 0u; cnt = 0u; mine = 0u;
#pragma unroll
        for (unsigned j = 0; j < 16; ++j) { const unsigned c = xb_ld(&bar[XB_XCNT(j)]); sum += c; cnt += (c > 0u) ? 1u : 0u; mine = (j == x) ? c : mine; }
        if (sum == G) break;
        __builtin_amdgcn_s_sleep(1);
        if ((++sp & 255u) == 0u) { if (xb_ld(&bar[XB_TMO])) break; if (sp > XB_SPIN_CAP) { atomicAdd(&bar[XB_TMO], 1u); break; } }
    }
    nloc = mine > 0u ? mine : 1u; nx = cnt > 0u ? cnt : 1u;
}

__device__ __forceinline__ void xcd_barrier(const XcdBarrier& b, bool xb_t0  ) {
    asm volatile("s_waitcnt vmcnt(0)" ::: "memory");
    __syncthreads();
    if (xb_t0) {
        unsigned* bar = b.bar;
        __builtin_amdgcn_s_waitcnt(0);
        unsigned nloc = b.st[0], nx = b.st[1];
        if (nloc == 0u) { xcd_barrier_complete(bar, b.x, nloc, nx); b.st[0] = nloc; b.st[1] = nx; }
        const unsigned old = xb_add(&bar[XB_XSUB(b.x)], 1u);
        const unsigned gen = old / nloc;
        if (old + 1u == (gen + 1u) * nloc) {
            __builtin_amdgcn_fence(__ATOMIC_RELEASE, "agent");
            asm volatile("s_waitcnt vmcnt(0)" ::: "memory");
            const unsigned og = xb_add(&bar[XB_TOP], 1u);
            const unsigned tg = og / nx;
            if (og + 1u == (tg + 1u) * nx) xb_add(&bar[XB_TOPGEN], 1u);
            else XB_SPIN(xb_ld(&bar[XB_TOPGEN]) == tg, bar);
            __builtin_amdgcn_fence(__ATOMIC_ACQUIRE, "agent");
            xb_add(&bar[XB_XGEN(b.x)], 1u);
            asm volatile("s_waitcnt vmcnt(0)" ::: "memory");
        } else {
            XB_SPIN(xb_ld(&bar[XB_XGEN(b.x)]) == gen, bar);
            __builtin_amdgcn_fence(__ATOMIC_ACQUIRE, "agent");
            asm volatile("s_waitcnt vmcnt(0)" ::: "memory");
        }
    }
    __syncthreads();
}

typedef float f32x2 __attribute__((ext_vector_type(2)));
using pg8::lane_now; using pg8::shx;
__device__ __forceinline__ float wave_sum(float v) {
    const int ln = lane_now();
#pragma unroll
    for (int o = 1; o < 64; o <<= 1) v += shx(v, o, ln);
    return v;
}
__device__ __forceinline__ float wave_max(float v) {
    const int ln = lane_now();
#pragma unroll
    for (int o = 1; o < 64; o <<= 1) v = fmaxf(v, shx(v, o, ln));
    return v;
}
__device__ __forceinline__ float bf2f(unsigned short h) { return __uint_as_float((unsigned)h << 16); }
__device__ __forceinline__ float silu_f(float x) { return x / (1.0f + __expf(-x)); }
__device__ __forceinline__ f32x4 bf4_to_f32(unsigned long long v) { return (f32x4){__uint_as_float((unsigned)(v & 0xffffu) << 16), __uint_as_float((unsigned)(v >> 16) << 16), __uint_as_float((unsigned)((v >> 32) & 0xffffu) << 16), __uint_as_float((unsigned)(v >> 48) << 16)}; }
__device__ __forceinline__ unsigned long long f32_to_bf4(f32x4 y) { return (unsigned long long)pk2(y.x, y.y) | ((unsigned long long)pk2(y.z, y.w) << 32); }
__device__ __forceinline__ int mod_row(int m) { const int b = m / TB; return (m - b * TB < CTXL) ? 8 : b; }

__device__ __forceinline__ void titem_load(const float* W, int N, int k0, int n0, int lane, f32x4 (&v)[16]) {
    const GAS f32x4* p = (const GAS f32x4*)(W + (size_t)(k0 + 16 * (lane >> 3)) * N + n0 + 4 * (lane & 7));
#pragma unroll
    for (int j = 0; j < 16; ++j) v[j] = p[(size_t)j * (N >> 2)];
}
__device__ __forceinline__ void titem_store8(const f32x4 (&v)[16], unsigned char* WT8, int K, int k0, int dst_row0, int lane) {
    unsigned char* o = WT8 + (size_t)(dst_row0 + 4 * (lane & 7)) * K + k0 + 16 * (lane >> 3);
#pragma unroll
    for (int i = 0; i < 4; ++i) { v4u q;
        q.x = pg8::pk4_fp8(v[0][i] * 32.f, v[1][i] * 32.f, v[2][i] * 32.f, v[3][i] * 32.f); q.y = pg8::pk4_fp8(v[4][i] * 32.f, v[5][i] * 32.f, v[6][i] * 32.f, v[7][i] * 32.f);
        q.z = pg8::pk4_fp8(v[8][i] * 32.f, v[9][i] * 32.f, v[10][i] * 32.f, v[11][i] * 32.f); q.w = pg8::pk4_fp8(v[12][i] * 32.f, v[13][i] * 32.f, v[14][i] * 32.f, v[15][i] * 32.f);
        *(GAS v4u*)(o + (size_t)i * K) = q; }
}
__device__ __forceinline__ void titem_store16(const f32x4 (&v)[16], bf16* WT, int K, int k0, int dst_row0, int lane) {
    bf16* o = WT + (size_t)(dst_row0 + 4 * (lane & 7)) * K + k0 + 16 * (lane >> 3);
#pragma unroll
    for (int i = 0; i < 4; ++i) { v4u q0, q1;
        q0.x = pk2(v[0][i], v[1][i]); q0.y = pk2(v[2][i], v[3][i]); q0.z = pk2(v[4][i], v[5][i]); q0.w = pk2(v[6][i], v[7][i]);
        q1.x = pk2(v[8][i], v[9][i]); q1.y = pk2(v[10][i], v[11][i]); q1.z = pk2(v[12][i], v[13][i]); q1.w = pk2(v[14][i], v[15][i]);
        *(GAS v4u*)(o + (size_t)i * K) = q0; *(GAS v4u*)(o + (size_t)i * K + 8) = q1; }
}

struct Args { const float* in[25]; float* out; unsigned char* ws; int ph_lo, ph_hi; };
constexpr int P_N1G = 0, P_N2G = 4096, P_QG = 8192, P_KG = 8320, P_GKF = 8448, P_GKB = 24832, P_BGF = 41216, P_BGB = 42240, P_OG = 43264, P_WR = 43776, P_BR = 174848, P_BGU = 174976, P_BDN = 437120, P_END = 568192;
#define LAUNDER_S(p) asm volatile("" : "+s"(p))
#define LAUNDER_V(p) asm volatile("" : "+v"(p))
#define PARF(ws) ((const float*)((ws) + WS_PAR))

constexpr int I8_GU = 128 * 8 * 64, I8_DN = 128 * 8 * 32, NI8 = I8_GU + I8_DN;
struct T8 { const float* W; unsigned char* O; int N, k0, n0, dst; };
__device__ __forceinline__ T8 dec8(const Args& A, unsigned char* ws, int it) { T8 t;
    const bool gu = it < I8_GU; const int r = gu ? it : it - I8_GU, sh = gu ? 6 : 5, mat = r >> (3 + sh), q = r & ((8 << sh) - 1), kb = q >> sh, n0 = (q & ((1 << sh) - 1)) * 32;
    t.N = gu ? 2048 : 1024; t.W = (gu ? A.in[21] : A.in[23]) + (size_t)mat * 1024 * t.N; t.O = ws + (gu ? WS_WGU : WS_WDN) + (size_t)mat * 1024 * t.N; t.k0 = kb * 128; t.n0 = n0;
    t.dst = gu ? ((n0 & 1023) >> 7) * 256 + (n0 >> 10) * 128 + (n0 & 127) : n0;
    return t; }
__device__ __forceinline__ void p0_prologue(const Args& A, LAS unsigned char* lds, int gw, int NGW, int wave, int lane) {
    unsigned char* ws = A.ws;
    { f32x4 va[16], vb[16]; int it = gw;
      if (it < NI8) { const T8 t = dec8(A, ws, it); titem_load(t.W, t.N, t.k0, t.n0, lane, va); }
      while (it + 2 * NGW < NI8) {
          { const T8 t = dec8(A, ws, it + NGW); titem_load(t.W, t.N, t.k0, t.n0, lane, vb); }
          { const T8 t = dec8(A, ws, it); titem_store8(va, t.O, 1024, t.k0, t.dst, lane); }
          { const T8 t = dec8(A, ws, it + 2 * NGW); titem_load(t.W, t.N, t.k0, t.n0, lane, va); }
          { const T8 t = dec8(A, ws, it + NGW); titem_store8(vb, t.O, 1024, t.k0, t.dst, lane); }
          it += 2 * NGW; }
      if (it < NI8) { const bool hb = it + NGW < NI8;
          if (hb) { const T8 t = dec8(A, ws, it + NGW); titem_load(t.W, t.N, t.k0, t.n0, lane, vb); }
          { const T8 t = dec8(A, ws, it); titem_store8(va, t.O, 1024, t.k0, t.dst, lane); }
          if (hb) { const T8 t = dec8(A, ws, it + NGW); titem_store8(vb, t.O, 1024, t.k0, t.dst, lane); } } }
    constexpr int J_QKV = 2 * 8 * (QKVN / 32), J_WO = 2 * 8 * 32, J_WIN = 2 * 8 * (WINN / 32), NJ = J_QKV + J_WO + J_WIN + J_WO;
    for (int it = gw; it < NJ; it += NGW) { int r = it; const float* W; bf16* O; int N, kb, n0, dst; bool is8 = r < J_QKV;
        if (r < J_QKV) { const int per = 8 * (QKVN / 32), mat = r / per, q = r - mat * per; kb = q / (QKVN / 32); n0 = (q - kb * (QKVN / 32)) * 32;
            dst = (n0 & ~255) + ((n0 >> 5) & 1) * 128 + ((n0 >> 6) & 3) * 32;
            W = A.in[8] + (size_t)mat * 1024 * QKVN; N = QKVN; O = (bf16*)(ws + WS_WQKV + (size_t)mat * QKVN * 1024); }
        else if ((r -= J_QKV) < J_WO) { const int mat = r >> 8, q = r & 255; kb = q >> 5; n0 = (q & 31) * 32; dst = n0;
            W = A.in[11] + (size_t)mat * 1024 * 1024; N = 1024; O = (bf16*)(ws + WS_WOA + (size_t)mat * 1024 * 1024); is8 = true; }
        else if ((r -= J_WO) < J_WIN) { const int per = 8 * (WINN / 32), mat = r / per, q = r - mat * per; kb = q / (WINN / 32); n0 = (q - kb * (WINN / 32)) * 32; dst = n0;
            W = A.in[12] + (size_t)mat * 1024 * WINN; N = WINN;
            is8 = true; O = (bf16*)(ws + WS_WIN + (size_t)mat * WINP * 1024); }
        else { r -= J_WIN; const int mat = r >> 8, q = r & 255; kb = q >> 5; n0 = (q & 31) * 32; dst = n0;
            W = A.in[18] + (size_t)mat * 1024 * 1024; N = 1024; O = (bf16*)(ws + WS_WOG + (size_t)mat * 1024 * 1024); is8 = true; }
        f32x4 v[16]; titem_load(W, N, kb * 128, n0, lane, v); if (is8) titem_store8(v, (unsigned char*)O, 1024, kb * 128, dst, lane); else titem_store16(v, O, 1024, kb * 128, dst, lane); }
    for (int it = gw; it < 2 * (WINP - WINN); it += NGW) { const int mat = it / (WINP - WINN), rr = WINN + it - mat * (WINP - WINN);
        GAS v4u* p = (GAS v4u*)(ws + WS_WIN + ((size_t)mat * WINP + rr) * 1024) + lane; p[0] = (v4u){0u, 0u, 0u, 0u}; }
    for (int it = NGW - 1 - gw; it < NLAYER * 24 * 16; it += NGW) {
        const int l = it / (24 * 16), q = it - l * (24 * 16), cg = q / 16, kc = q - cg * 16;
        float s[MODROWS];
#pragma unroll
        for (int r = 0; r < MODROWS; ++r) { const float cv = (r < 8) ? A.in[1][r * 1024 + kc * 64 + lane] : A.in[3][kc * 64 + lane]; s[r] = silu_f(cv); }
        f32x4 acc[MODROWS];
#pragma unroll
        for (int r = 0; r < MODROWS; ++r) acc[r] = (f32x4){0.f, 0.f, 0.f, 0.f};
        const float* wp = A.in[4] + ((size_t)l * 1024 + kc * 64) * NMODC + cg * 256 + 4 * lane;
#pragma unroll 8
        for (int kk = 0; kk < 64; ++kk) { const f32x4 w = *(const f32x4*)(wp + (size_t)kk * NMODC);
#pragma unroll
            for (int r = 0; r < MODROWS; ++r) { const float sv = __shfl(s[r], kk); acc[r] = acc[r] + w * sv; } }
        float* op = (float*)(ws + WS_MODP) + (size_t)kc * (NLAYER * MODROWS * NMODC) + (size_t)l * MODROWS * NMODC + cg * 256 + 4 * lane;
#pragma unroll
        for (int r = 0; r < MODROWS; ++r) *(f32x4*)(op + (size_t)r * NMODC) = acc[r];
    }
    for (int m0 = gw; m0 < MT; m0 += 4 * NGW) { f32x4 x[4][4];
#pragma unroll
        for (int r = 0; r < 4; ++r) { const int m = m0 + r * NGW; if (m < MT) { const int b = m / TB, w = m - b * TB;
            const float* src = (w < CTXL) ? A.in[2] + ((size_t)b * CTXL + w) * 1024 : A.in[0] + ((size_t)b * SEQ + (w - CTXL)) * 1024; const GAS f32x4* sp = (const GAS f32x4*)src + lane;
#pragma unroll
            for (int j = 0; j < 4; ++j) x[r][j] = sp[64 * j]; } }
#pragma unroll
        for (int r = 0; r < 4; ++r) { const int m = m0 + r * NGW; if (m < MT) { GAS unsigned long long* dp = (GAS unsigned long long*)((bf16*)(ws + WS_X) + (size_t)m * 1024) + lane;
#pragma unroll
            for (int j = 0; j < 4; ++j) dp[64 * j] = f32_to_bf4(x[r][j]); } } }
    { float* par = (float*)(ws + WS_PAR); const int gt = gw * 64 + lane, NGT = NGW * 64;
#define CPL(k, src, n) float c##k##a = 0.f, c##k##b = 0.f; if (gt < (n)) c##k##a = A.in[src][gt]; if (gt + NGT < (n)) c##k##b = A.in[src][gt + NGT];
#define CPS(k, src, n, off) if (gt < (n)) par[(off) + gt] = c##k##a; if (gt + NGT < (n)) par[(off) + gt + NGT] = c##k##b; for (int i = gt + 2 * NGT; i < (n); i += NGT) par[(off) + i] = A.in[src][i];
      CPL(0, 6, 4096) CPL(1, 7, 4096) CPL(2, 9, 128) CPL(3, 10, 128) CPL(4, 13, 16384) CPL(5, 15, 16384) CPL(6, 14, 1024) CPL(7, 16, 1024) CPL(8, 17, 512) CPL(9, 19, 131072) CPL(10, 20, 128) CPL(11, 22, 262144) CPL(12, 24, 131072)
      CPS(0, 6, 4096, P_N1G) CPS(1, 7, 4096, P_N2G) CPS(2, 9, 128, P_QG) CPS(3, 10, 128, P_KG) CPS(4, 13, 16384, P_GKF) CPS(5, 15, 16384, P_GKB) CPS(6, 14, 1024, P_BGF) CPS(7, 16, 1024, P_BGB)
      CPS(8, 17, 512, P_OG) CPS(9, 19, 131072, P_WR) CPS(10, 20, 128, P_BR) CPS(11, 22, 262144, P_BGU) CPS(12, 24, 131072, P_BDN)
#undef CPL
#undef CPS
    }
    for (int idx = gw * 64 + lane; idx < SEQ * 32; idx += NGW * 64) { const int s = idx >> 5, i = idx & 31;
        const float invf = 1.0f / powf(10000.0f, (float)(i & 15) * (1.0f / 16.0f));
        const float ang = (float)((i < 16) ? (s >> 6) : (s & 63)) * invf;
        ((float*)(ws + WS_ROPE))[idx] = cosf(ang); ((float*)(ws + WS_ROPE))[SEQ * 32 + idx] = sinf(ang); }
}
__device__ __forceinline__ void p1_mod_reduce(const Args& A, int gtid, int NGT) {
    const float* P = (const float*)(A.ws + WS_MODP); float* Mo = (float*)(A.ws + WS_MOD);
    constexpr int N = NLAYER * MODROWS * NMODC;
    for (int i = gtid; i < N; i += NGT) { const int l = i / (MODROWS * NMODC), c = i % NMODC; float s = A.in[5][l * NMODC + c];
#pragma unroll
        for (int k = 0; k < 16; ++k) s += P[(size_t)k * N + i];
        Mo[i] = s; }
}
__device__ __forceinline__ void modulate_row(const bf16* xrow, const float* ng, const float* shp, const float* scp, bf16* orow, int lane, f32x4 (&y)[4], float& rs_out) {
    const GAS unsigned long long* xr = (const GAS unsigned long long*)xrow + lane;
    float ss = 0.f;
#pragma unroll
    for (int j = 0; j < 4; ++j) { y[j] = bf4_to_f32(xr[64 * j]); ss += (y[j].x * y[j].x + y[j].y * y[j].y) + (y[j].z * y[j].z + y[j].w * y[j].w); }
    const float rs = 1.0f / sqrtf(wave_sum(ss) * (1.0f / 1024.0f) + RMS_EPS); rs_out = rs;
    GAS unsigned long long* o8 = (GAS unsigned long long*)orow + lane;
#pragma unroll
    for (int j = 0; j < 4; ++j) { const f32x4 g = ((const GAS f32x4*)ng)[64 * j + lane], sh = ((const GAS f32x4*)shp)[64 * j + lane], sc = ((const GAS f32x4*)scp)[64 * j + lane];
        y[j] = (y[j] * rs) * g * (sc + 1.0f) + sh;
        o8[64 * j] = (unsigned long long)pk2(y[j].x, y[j].y) | ((unsigned long long)pk2(y[j].z, y[j].w) << 32); }
}
template <bool F8>
__device__ __forceinline__ void modulate_row2(const bf16* xa, const bf16* xb, const float* ng, const float* sha, const float* sca, const float* shb, const float* scb, unsigned char* oa, unsigned char* ob, int lane, float& rsa, float& rsb) {
    const GAS unsigned long long* pa = (const GAS unsigned long long*)xa + lane; const GAS unsigned long long* pb = (const GAS unsigned long long*)xb + lane;
    unsigned long long ra[4], rb[4]; f32x4 g[4], ha[4], ca[4], hb[4], cb[4];
#pragma unroll
    for (int j = 0; j < 4; ++j) { ra[j] = pa[64 * j]; rb[j] = pb[64 * j]; }
#pragma unroll
    for (int j = 0; j < 4; ++j) { g[j] = ((const GAS f32x4*)ng)[64 * j + lane]; ha[j] = ((const GAS f32x4*)sha)[64 * j + lane]; ca[j] = ((const GAS f32x4*)sca)[64 * j + lane]; hb[j] = ((const GAS f32x4*)shb)[64 * j + lane]; cb[j] = ((const GAS f32x4*)scb)[64 * j + lane]; }
    f32x4 ya[4], yb[4]; float sa = 0.f, sb = 0.f;
#pragma unroll
    for (int j = 0; j < 4; ++j) { ya[j] = bf4_to_f32(ra[j]); yb[j] = bf4_to_f32(rb[j]); sa += (ya[j].x * ya[j].x + ya[j].y * ya[j].y) + (ya[j].z * ya[j].z + ya[j].w * ya[j].w); sb += (yb[j].x * yb[j].x + yb[j].y * yb[j].y) + (yb[j].z * yb[j].z + yb[j].w * yb[j].w); }
    const int ln = lane_now();
#pragma unroll
    for (int o = 1; o < 64; o <<= 1) { sa += shx(sa, o, ln); sb += shx(sb, o, ln); }
    rsa = 1.0f / sqrtf(sa * (1.0f / 1024.0f) + RMS_EPS); rsb = 1.0f / sqrtf(sb * (1.0f / 1024.0f) + RMS_EPS);
#pragma unroll
    for (int j = 0; j < 4; ++j) {
        const f32x4 va = (ya[j] * rsa) * g[j] * (ca[j] + 1.0f) + ha[j], vb = (yb[j] * rsb) * g[j] * (cb[j] + 1.0f) + hb[j];
        if constexpr (F8) { ((GAS unsigned*)oa + lane)[64 * j] = pg8::pk4_fp8_sat(va.x, va.y, va.z, va.w); ((GAS unsigned*)ob + lane)[64 * j] = pg8::pk4_fp8_sat(vb.x, vb.y, vb.z, vb.w); }
        else { ((GAS unsigned long long*)oa + lane)[64 * j] = f32_to_bf4(va); ((GAS unsigned long long*)ob + lane)[64 * j] = f32_to_bf4(vb); } }
}
__device__ __forceinline__ void phase_modulate1(unsigned char* ws, int layer, int gw, int NGW, int lane) {
    const bf16* X = (const bf16*)(ws + WS_X); bf16* XN = (bf16*)(ws + WS_XN);
    const float* ng = PARF(ws) + P_N1G + layer * 1024; const float* Mo = (const float*)(ws + WS_MOD) + (size_t)layer * MODROWS * NMODC;
    for (int m = gw; m < MT; m += 2 * NGW) { const int m2 = (m + NGW < MT) ? m + NGW : m; const int mr = mod_row(m), mr2 = mod_row(m2); float rs, rs2;
        modulate_row2<true>(X + (size_t)m * 1024, X + (size_t)m2 * 1024, ng, Mo + (size_t)mr * NMODC + 0 * 1024, Mo + (size_t)mr * NMODC + 1 * 1024, Mo + (size_t)mr2 * NMODC + 0 * 1024, Mo + (size_t)mr2 * NMODC + 1 * 1024,
                             (unsigned char*)XN + (size_t)m * 1024, (unsigned char*)XN + (size_t)m2 * 1024, lane, rs, rs2); }
}
__device__ __forceinline__ void phase_qknorm_rope(unsigned char* ws, int la, int gw, int NGW, int lane) {
    bf16* Qb = (bf16*)(ws + WS_Q); bf16* Kb = (bf16*)(ws + WS_K);
    const float* qg = PARF(ws) + P_QG + la * 64; const float* kg = PARF(ws) + P_KG + la * 64; const float* ropec = (const float*)(ws + WS_ROPE); const float* ropes = ropec + SEQ * 32;
    const int i = lane & 31, hs = lane >> 5;
    for (int m = gw; m < MT; m += NGW) { const int b = m / TB, w = m - b * TB; const bool lat = w >= CTXL;
        float cs = 1.f, sn = 0.f; if (lat) { cs = ropec[(w - CTXL) * 32 + i]; sn = ropes[(w - CTXL) * 32 + i]; }
#pragma unroll 2
        for (int hh = 0; hh < 20; hh += 2) { const int hd = hh + hs;
            unsigned* p = (hd < 16) ? (unsigned*)(Qb + (size_t)m * 1024 + hd * 64) + i : (unsigned*)(Kb + (size_t)m * 256 + (hd - 16) * 64) + i;
            const float* gp = (hd < 16) ? qg : kg; const float scl = (hd < 16) ? ATT_C2 : 1.0f;
            const unsigned v = *p; const float x1 = __uint_as_float(v << 16), x2 = __uint_as_float(v & 0xffff0000u);
            float ss = x1 * x1 + x2 * x2;
#pragma unroll
            for (int o = 1; o < 32; o <<= 1) ss += shx(ss, o, lane);
            const float rs = 1.0f / sqrtf(ss * (1.0f / 64.0f) + RMS_EPS);
            const float y1 = x1 * rs * gp[2 * i], y2 = x2 * rs * gp[2 * i + 1];
            const float r1 = (y1 * cs - y2 * sn) * scl, r2 = (y1 * sn + y2 * cs) * scl;
            *p = pk2(r1, r2); }
    }
}
__device__ __forceinline__ void phase_gla_recurrent(unsigned char* ws, int lg, LAS unsigned char* lds, int tid) {
    const int unit = blockIdx.x; if (unit >= 128) return;
    const int half = unit & 1, dir = (unit >> 1) & 1, h = (unit >> 2) & 3, b = unit >> 4;
    const bf16* G = (const bf16*)(ws + WS_G);
    float* Oo = (float*)(ws + (dir ? WS_OB : WS_OF));
    const float* wg = PARF(ws) + (dir ? P_GKB : P_GKF) + (size_t)lg * 16 * 512; const float* bg = PARF(ws) + (dir ? P_BGB : P_BGF) + lg * 512;
    LAS float* qq = (LAS float*)(lds + RING_OFF); LAS float* kk = qq + 64 * 128; LAS float* dd = kk + 64 * 128; LAS float* vv = dd + 64 * 128;
    const int sd = tid & 127, st0 = tid >> 7;
    float wcol[16];
#pragma unroll
    for (int r = 0; r < 16; ++r) wcol[r] = wg[r * 512 + h * 128 + sd];
    const float bcol = bg[h * 128 + sd];
    const int c = tid >> 2, dq = tid & 3;
    float s[32];
#pragma unroll
    for (int j = 0; j < 32; ++j) s[j] = 0.f;
    const float qscale = 0.08838834764831845f;
    for (int ch = 0; ch < TB / 64; ++ch) {
        __syncthreads();
#pragma unroll 4
        for (int i = 0; i < 16; ++i) { const int tt = st0 + 4 * i, n = 64 * ch + tt;
            const int w = dir ? (n < CTXL ? (CTXL - 1 - n) : (TB + CTXL - 1 - n)) : n;
            const bf16* gr = G + ((size_t)b * TB + w) * WINP;
            const float qv = bf2f(gr[h * 128 + sd]) * qscale, kv = bf2f(gr[512 + h * 128 + sd]);
            const bf16* lp = gr + 3072 + dir * 16; float z = bcol;
#pragma unroll
            for (int r = 0; r < 16; ++r) z += bf2f(lp[r]) * wcol[r];
            const float ls = fminf(z, 0.f) - log1pf(__expf(-fabsf(z)));
            qq[tt * 128 + sd] = qv; kk[tt * 128 + sd] = kv; dd[tt * 128 + sd] = __expf(ls * (1.0f / 16.0f));
            vv[tt * 128 + sd] = bf2f(gr[1024 + h * 256 + half * 128 + sd]); }
        __syncthreads();
        for (int tt = 0; tt < 64; ++tt) { const int n = 64 * ch + tt; const int w = dir ? (n < CTXL ? (CTXL - 1 - n) : (TB + CTXL - 1 - n)) : n;
            const float v = vv[tt * 128 + c]; float acc = 0.f;
            const LAS f32x4* q4 = (const LAS f32x4*)(qq + tt * 128 + dq * 32); const LAS f32x4* k4 = (const LAS f32x4*)(kk + tt * 128 + dq * 32); const LAS f32x4* d4 = (const LAS f32x4*)(dd + tt * 128 + dq * 32);
#pragma unroll
            for (int j = 0; j < 8; ++j) { const f32x4 qv = q4[j], kv = k4[j], dv = d4[j];
                s[4 * j + 0] = s[4 * j + 0] * dv.x + kv.x * v; acc += qv.x * s[4 * j + 0];
                s[4 * j + 1] = s[4 * j + 1] * dv.y + kv.y * v; acc += qv.y * s[4 * j + 1];
                s[4 * j + 2] = s[4 * j + 2] * dv.z + kv.z * v; acc += qv.z * s[4 * j + 2];
                s[4 * j + 3] = s[4 * j + 3] * dv.w + kv.w * v; acc += qv.w * s[4 * j + 3]; }
            acc += shx(acc, 1, tid & 63); acc += shx(acc, 2, tid & 63);
            if (dq == 0) Oo[((size_t)b * TB + w) * 1024 + h * 256 + half * 128 + c] = acc; }
    }
}
__device__ __forceinline__ void phase_gla_readout(unsigned char* ws, int lg, int gw, int NGW, int lane) {
    const float* OF = (const float*)(ws + WS_OF); const float* OB = (const float*)(ws + WS_OB); const bf16* G = (const bf16*)(ws + WS_G); bf16* OG = (bf16*)(ws + WS_Q);
    const f32x4 og = ((const GAS f32x4*)(PARF(ws) + P_OG + lg * 256))[lane];
    for (int m = gw; m < MT; m += NGW) {
#pragma unroll
        for (int hh = 0; hh < 4; ++hh) { const size_t off = (size_t)m * 1024 + hh * 256 + 4 * lane;
            f32x4 o = *(const GAS f32x4*)(OF + off) + *(const GAS f32x4*)(OB + off);
            const float ss = wave_sum((o.x * o.x + o.y * o.y) + (o.z * o.z + o.w * o.w));
            const float rs = 1.0f / sqrtf(ss * (1.0f / 256.0f) + RMS_EPS);
            const unsigned long long rv = *(const GAS unsigned long long*)(G + (size_t)m * WINP + 2048 + hh * 256 + 4 * lane);
            const float r0 = __uint_as_float((unsigned)(rv & 0xffffu) << 16), r1 = __uint_as_float((unsigned)(rv >> 16) << 16), r2 = __uint_as_float((unsigned)((rv >> 32) & 0xffffu) << 16), r3 = __uint_as_float((unsigned)(rv >> 48) << 16);
            o = o * rs * og;
            o.x *= silu_f(r0); o.y *= silu_f(r1); o.z *= silu_f(r2); o.w *= silu_f(r3);
            *(GAS unsigned long long*)(OG + off) = (unsigned long long)pk2(o.x, o.y) | ((unsigned long long)pk2(o.z, o.w) << 32); }
    }
}
constexpr size_t WS_GQ = WS_XG, WS_GKH = WS_XG + 68 * MiB, WS_GKT = WS_XG + 136 * MiB, WS_GVT = WS_XG + 204 * MiB, WS_GDL = WS_ACT, WS_SX = WS_OF;
static_assert((size_t)2176 * 2 * 16384 <= 68 * MiB && (size_t)2176 * 256 * 64 * 2 <= 68 * MiB && (size_t)64 * 68 * 65536 <= 272 * MiB, "gla buffers");
typedef float f32x16 __attribute__((ext_vector_type(16)));
__device__ __forceinline__ float log_sigmoid_fast(float z) { return fminf(z, 0.f) - __logf(1.0f + __expf(-fabsf(z))); }

struct G0Raw { unsigned qk[8][2]; v4u lfb; };
__device__ __forceinline__ void g0_load(G0Raw& R, unsigned char* ws, int cn, int tid) {
    const bf16* G = (const bf16*)(ws + WS_G);
    const int d2 = tid & 63, tb = tid >> 6, n = cn % 68, bh = cn / 68, h = bh & 3, b = bh >> 2;
    const size_t r0 = (size_t)b * TB + 64 * n;
#pragma unroll
    for (int j = 0; j < 8; ++j) { const bf16* gr = G + (r0 + 8 * tb + j) * WINP; R.qk[j][0] = *(const GAS unsigned*)(gr + h * 128 + 2 * d2); R.qk[j][1] = *(const GAS unsigned*)(gr + 512 + h * 128 + 2 * d2); }
    R.lfb = *(const GAS v4u*)(G + (r0 + ((tid & 255) >> 2)) * WINP + 3072 + 8 * (tid & 3));
}
__device__ __forceinline__ void g0_vload(unsigned (&raw)[32], const unsigned char* ws, int idx, int h, int dv, int th) {
    const int b = idx / 68, n = idx - b * 68; const bf16* vp = (const bf16*)(ws + WS_G) + ((size_t)b * TB + 64 * n + 32 * th) * WINP + 1024 + h * 256 + dv;
#pragma unroll
    for (int j = 0; j < 32; ++j) raw[j] = (unsigned)((const GAS bf16*)vp)[(size_t)j * WINP];
}
__device__ __forceinline__ void g0_vstore(const unsigned (&raw)[32], unsigned char* ws, int idx, int h, int dv, int th) {
    const int b = idx / 68, n = idx - b * 68, cn = (b * 4 + h) * 68 + n;
    unsigned char* vo = ws + WS_GVT + (size_t)cn * 32768 + (size_t)(((2 * th) * 8 + (dv >> 5)) * 64 + (dv & 31)) * 16;
    unsigned wv[16];
#pragma unroll
    for (int j = 0; j < 16; ++j) wv[j] = raw[2 * j] | (raw[2 * j + 1] << 16);
#pragma unroll
    for (int ql = 0; ql < 2; ++ql)
#pragma unroll
        for (int hq = 0; hq < 2; ++hq) *(GAS v4u*)(vo + ql * 8192 + hq * 512) = (v4u){wv[8 * ql + 2 * hq], wv[8 * ql + 2 * hq + 1], wv[8 * ql + 2 * hq + 4], wv[8 * ql + 2 * hq + 5]};
}
__device__ __forceinline__ void phase_gla_g0v(unsigned char* ws, int tid, int Gp, int bxp) {
    const int G4 = Gp >> 2, h = bxp & 3, wq = bxp >> 2;
    if (wq >= G4) return;
    const int dv = tid & 255, th = tid >> 8; unsigned ra[32], rb[32]; int idx = wq;
    if (idx < 544) g0_vload(ra, ws, idx, h, dv, th);
    while (idx + 2 * G4 < 544) { g0_vload(rb, ws, idx + G4, h, dv, th); g0_vstore(ra, ws, idx, h, dv, th); g0_vload(ra, ws, idx + 2 * G4, h, dv, th); g0_vstore(rb, ws, idx + G4, h, dv, th); idx += 2 * G4; }
    if (idx < 544) { const bool hb = idx + G4 < 544; if (hb) g0_vload(rb, ws, idx + G4, h, dv, th); g0_vstore(ra, ws, idx, h, dv, th); if (hb) g0_vstore(rb, ws, idx + G4, h, dv, th); }
}
__device__ __forceinline__ void phase_gla_g0(unsigned char* ws, int lg, LAS unsigned char* lds, int tid, int Gp, int bxp) {
    LAS float* tot = (LAS float*)(lds + RING_OFF);
    LAS float* lfl = (LAS float*)(lds + RING_OFF + 8192);
    const int d2 = tid & 63, tb = tid >> 6;
    const int G4 = Gp >> 2, h = bxp & 3, wq = bxp >> 2;
    if (wq >= G4 || wq >= 544) return;
        f32x2 wf[16], wb[16];
        { const float* wgf = PARF(ws) + P_GKF + (size_t)lg * 16 * 512 + h * 128 + 2 * d2; const float* wgb = PARF(ws) + P_GKB + (size_t)lg * 16 * 512 + h * 128 + 2 * d2;
#pragma unroll
          for (int r = 0; r < 16; ++r) { wf[r] = *(const GAS f32x2*)(wgf + r * 512); wb[r] = *(const GAS f32x2*)(wgb + r * 512); } }
        const f32x2 bf_ = *(const GAS f32x2*)(PARF(ws) + P_BGF + lg * 512 + h * 128 + 2 * d2), bb_ = *(const GAS f32x2*)(PARF(ws) + P_BGB + lg * 512 + h * 128 + 2 * d2);
    G0Raw R; g0_load(R, ws, ((wq / 68) * 4 + h) * 68 + wq % 68, tid);
    for (int idx = wq; idx < 544; idx += G4) {
        const int b = idx / 68, n = idx - b * 68, cn = (b * 4 + h) * 68 + n;
        __syncthreads();
        if (tid < 256) { const v4u l = R.lfb; LAS f32x4* dp = (LAS f32x4*)(lfl + tid * 8);
            dp[0] = (f32x4){__uint_as_float(l.x << 16), __uint_as_float(l.x & 0xffff0000u), __uint_as_float(l.y << 16), __uint_as_float(l.y & 0xffff0000u)};
            dp[1] = (f32x4){__uint_as_float(l.z << 16), __uint_as_float(l.z & 0xffff0000u), __uint_as_float(l.w << 16), __uint_as_float(l.w & 0xffff0000u)}; }
        unsigned qk[8][2];
#pragma unroll
        for (int j = 0; j < 8; ++j) { qk[j][0] = R.qk[j][0]; qk[j][1] = R.qk[j][1]; }
        __syncthreads();
        if (idx + G4 < 544) { const int i2 = idx + G4, b2 = i2 / 68; g0_load(R, ws, (b2 * 4 + h) * 68 + (i2 - b2 * 68), tid); }
        float gf0[8], gf1[8], gb0[8], gb1[8];
#pragma unroll
        for (int j = 0; j < 8; ++j) { const LAS f32x4* lp = (const LAS f32x4*)(lfl + (8 * tb + j) * 32);
            f32x2 zf = bf_, zb = bb_;
#pragma unroll
            for (int q = 0; q < 4; ++q) { const f32x4 a = lp[q], c = lp[4 + q];
#pragma unroll
                for (int e = 0; e < 4; ++e) { zf += (f32x2){a[e], a[e]} * wf[4 * q + e]; zb += (f32x2){c[e], c[e]} * wb[4 * q + e]; } }
            gf0[j] = log_sigmoid_fast(zf.x) * 0.0625f; gf1[j] = log_sigmoid_fast(zf.y) * 0.0625f; gb0[j] = log_sigmoid_fast(zb.x) * 0.0625f; gb1[j] = log_sigmoid_fast(zb.y) * 0.0625f; }
#pragma unroll
        for (int j = 1; j < 8; ++j) { gf0[j] += gf0[j - 1]; gf1[j] += gf1[j - 1]; gb0[7 - j] += gb0[8 - j]; gb1[7 - j] += gb1[8 - j]; }
        *(LAS f32x2*)(tot + (0 * 8 + tb) * 128 + 2 * d2) = (f32x2){gf0[7], gf1[7]}; *(LAS f32x2*)(tot + (1 * 8 + tb) * 128 + 2 * d2) = (f32x2){gb0[0], gb1[0]};
        __syncthreads();
        float pf0 = 0.f, pf1 = 0.f, pb0 = 0.f, pb1 = 0.f, lf0 = 0.f, lf1 = 0.f, lb0 = 0.f, lb1 = 0.f;
#pragma unroll
        for (int q = 0; q < 8; ++q) { const f32x2 a = *(const LAS f32x2*)(tot + (0 * 8 + q) * 128 + 2 * d2), c = *(const LAS f32x2*)(tot + (1 * 8 + q) * 128 + 2 * d2);
            lf0 += a.x; lf1 += a.y; lb0 += c.x; lb1 += c.y;
            if (q < tb) { pf0 += a.x; pf1 += a.y; } if (q > tb) { pb0 += c.x; pb1 += c.y; } }
        const size_t itf = (size_t)cn * 2, itb = itf + 1;
        bf16* Qf = (bf16*)(ws + WS_GQ) + itf * 8192; bf16* Qb = Qf + 8192; bf16* Kf = (bf16*)(ws + WS_GKH) + itf * 8192; bf16* Kb = Kf + 8192;
        const float elf0 = __expf(lf0), elf1 = __expf(lf1), elb0 = __expf(lb0), elb1 = __expf(lb1);
        float ktf0[8], ktf1[8], ktb0[8], ktb1[8];
#pragma unroll
        for (int j = 0; j < 8; ++j) { const int t = 8 * tb + j;
            const float q0 = __uint_as_float(qk[j][0] << 16) * 0.08838834764831845f, q1 = __uint_as_float(qk[j][0] & 0xffff0000u) * 0.08838834764831845f;
            const float k0 = __uint_as_float(qk[j][1] << 16), k1 = __uint_as_float(qk[j][1] & 0xffff0000u);
            const float ef0 = __expf(pf0 + gf0[j]), ef1 = __expf(pf1 + gf1[j]), eb0 = __expf(pb0 + gb0[j]), eb1 = __expf(pb1 + gb1[j]);
            const float rf0 = __builtin_amdgcn_rcpf(ef0), rf1 = __builtin_amdgcn_rcpf(ef1), rb0 = __builtin_amdgcn_rcpf(eb0), rb1 = __builtin_amdgcn_rcpf(eb1);
            *(GAS unsigned*)(Qf + t * 128 + 2 * d2) = pk2(q0 * ef0, q1 * ef1); *(GAS unsigned*)(Qb + t * 128 + 2 * d2) = pk2(q0 * eb0, q1 * eb1);
            *(GAS unsigned*)(Kf + t * 128 + 2 * d2) = pk2(k0 * rf0, k1 * rf1); *(GAS unsigned*)(Kb + t * 128 + 2 * d2) = pk2(k0 * rb0, k1 * rb1);
            ktf0[j] = k0 * rf0 * elf0; ktf1[j] = k1 * rf1 * elf1; ktb0[j] = k0 * rb0 * elb0; ktb1[j] = k1 * rb1 * elb1; }
        {
          unsigned char* Tf = ws + WS_GKT + itf * 16384 + (size_t)((((tb >> 1) * 4 + (d2 >> 4)) * 64 + ((2 * d2) & 31)) * 16 + 8 * (tb & 1)); unsigned char* Tb = Tf + 16384;
          *(GAS unsigned long long*)(Tf) = (unsigned long long)pk2(ktf0[0], ktf0[1]) | ((unsigned long long)pk2(ktf0[2], ktf0[3]) << 32);
          *(GAS unsigned long long*)(Tf + 512) = (unsigned long long)pk2(ktf0[4], ktf0[5]) | ((unsigned long long)pk2(ktf0[6], ktf0[7]) << 32);
          *(GAS unsigned long long*)(Tf + 16) = (unsigned long long)pk2(ktf1[0], ktf1[1]) | ((unsigned long long)pk2(ktf1[2], ktf1[3]) << 32);
          *(GAS unsigned long long*)(Tf + 528) = (unsigned long long)pk2(ktf1[4], ktf1[5]) | ((unsigned long long)pk2(ktf1[6], ktf1[7]) << 32);
          *(GAS unsigned long long*)(Tb) = (unsigned long long)pk2(ktb0[0], ktb0[1]) | ((unsigned long long)pk2(ktb0[2], ktb0[3]) << 32);
          *(GAS unsigned long long*)(Tb + 512) = (unsigned long long)pk2(ktb0[4], ktb0[5]) | ((unsigned long long)pk2(ktb0[6], ktb0[7]) << 32);
          *(GAS unsigned long long*)(Tb + 16) = (unsigned long long)pk2(ktb1[0], ktb1[1]) | ((unsigned long long)pk2(ktb1[2], ktb1[3]) << 32);
          *(GAS unsigned long long*)(Tb + 528) = (unsigned long long)pk2(ktb1[4], ktb1[5]) | ((unsigned long long)pk2(ktb1[6], ktb1[7]) << 32); }
        if (tb == 0) { float* DLp = (float*)(ws + WS_GDL) + itf * 128 + 2 * d2; *(GAS f32x2*)DLp = (f32x2){elf0, elf1}; *(GAS f32x2*)(DLp + 128) = (f32x2){elb0, elb1}; }
    }
}
struct G12Ops { bf16x8 a[4], b[4]; f32x4 d[4]; };
__device__ __forceinline__ void g12_load(G12Ops& o, unsigned char* ws, int bh, int dir, int m, int kb, int vb, int r, int hh) {
    const int n = dir ? (m < 4 ? 3 - m : 71 - m) : m; const size_t cn = (size_t)bh * 68 + n, item = cn * 2 + dir;
    const GAS bf16x8* ap = (const GAS bf16x8*)(ws + WS_GKT + item * 16384) + kb * 64 + (hh * 32 + r);
    const GAS bf16x8* bp = (const GAS bf16x8*)(ws + WS_GVT + cn * 32768) + vb * 64 + (hh * 32 + r);
    const float* dp = (const float*)(ws + WS_GDL) + item * 128 + 32 * kb + 4 * hh;
#pragma unroll
    for (int ks = 0; ks < 4; ++ks) { o.a[ks] = ap[ks * 256]; o.b[ks] = bp[ks * 512]; o.d[ks] = *(const GAS f32x4*)(dp + 8 * ks); }
}
__device__ __forceinline__ void phase_gla_g12(unsigned char* ws, LAS unsigned char* lds, int gwv, int wave, int lane) {
    if (gwv >= 2048) return;
    const int chain = gwv >> 5, blk = gwv & 31, kb = blk & 3, vb = blk >> 2, dir = chain & 1, bh = chain >> 1;
    const int r = lane & 31, hh = lane >> 5;
    LAS unsigned char* wl = lds + RING_OFF + wave * 2048;
    f32x16 acc;
#pragma unroll
    for (int g = 0; g < 16; ++g) acc[g] = 0.f;
    G12Ops o0, o1, o2;
    g12_load(o0, ws, bh, dir, 0, kb, vb, r, hh); g12_load(o1, ws, bh, dir, 1, kb, vb, r, hh);
#define G12_STEP(CUR, m_) do { const int mm_ = (m_); const int n = dir ? (mm_ < 4 ? 3 - mm_ : 71 - mm_) : mm_; \
        _Pragma("unroll") for (int gg = 0; gg < 4; ++gg) *(LAS unsigned long long*)(wl + (((gg >> 1) * 64 + (gg & 1) * 32 + r) * 16 + 8 * hh)) = (unsigned long long)pk2(acc[4 * gg], acc[4 * gg + 1]) | ((unsigned long long)pk2(acc[4 * gg + 2], acc[4 * gg + 3]) << 32); \
        LDS_WAIT(); const v4u s0 = *(const LAS v4u*)(wl + lane * 16), s1 = *(const LAS v4u*)(wl + 1024 + lane * 16); LDS_WAIT(); \
        { bf16* sp = (bf16*)(ws + WS_SX) + ((size_t)(bh * 2 + dir) * 68 + n) * 32768 + (size_t)(kb * 8 + vb) * 1024; ((GAS v4u*)sp)[lane] = s0; ((GAS v4u*)sp)[64 + lane] = s1; } \
        _Pragma("unroll") for (int gg = 0; gg < 4; ++gg) { acc[4 * gg] *= CUR.d[gg].x; acc[4 * gg + 1] *= CUR.d[gg].y; acc[4 * gg + 2] *= CUR.d[gg].z; acc[4 * gg + 3] *= CUR.d[gg].w; } \
        _Pragma("unroll") for (int ks = 0; ks < 4; ++ks) acc = __builtin_amdgcn_mfma_f32_32x32x16_bf16(CUR.a[ks], CUR.b[ks], acc, 0, 0, 0); } while (0)
    for (int m = 0; m < 66; m += 3) {
        __syncthreads();
        g12_load(o2, ws, bh, dir, m + 2, kb, vb, r, hh); G12_STEP(o0, m);
        g12_load(o0, ws, bh, dir, m + 3, kb, vb, r, hh); G12_STEP(o1, m + 1);
        g12_load(o1, ws, bh, dir, (m + 4 < 68) ? m + 4 : 67, kb, vb, r, hh); G12_STEP(o2, m + 2);
    }
    G12_STEP(o0, 66); G12_STEP(o1, 67);
#undef G12_STEP
}
constexpr int G3_RS = 272, G3_TILE = 64 * G3_RS, G3_OL = 4 * G3_TILE  , G3_LD = 260;
static_assert(G3_OL + 64 * G3_LD * 4 <= MISC_OFF, "G3 LDS");
__device__ __forceinline__ void phase_gla_g3(unsigned char* ws, int lg, LAS unsigned char* lds, int tid) {
    const int lane = tid & 63, wave = __builtin_amdgcn_readfirstlane(tid >> 6), r = lane & 31, hh = lane >> 5, vb = wave;
    LAS unsigned char* TL = lds + RING_OFF; LAS float* OL = (LAS float*)(lds + RING_OFF + G3_OL);
    const bf16* G = (const bf16*)(ws + WS_G); bf16* OG = (bf16*)(ws + WS_Q);
    v4u st[4][2]; bf16x8 sA[8];
#define G3_REQUEST(cn_) do { \
        _Pragma("unroll") for (int tl_ = 0; tl_ < 4; ++tl_) { const bf16* src_ = (const bf16*)(ws + ((tl_ & 1) ? WS_GKH : WS_GQ)) + ((size_t)(cn_) * 2 + (tl_ >> 1)) * 8192; \
            _Pragma("unroll") for (int j_ = 0; j_ < 2; ++j_) st[tl_][j_] = ((const GAS v4u*)src_)[tid + 512 * j_]; } } while (0)
    if ((int)blockIdx.x < 2176) G3_REQUEST((int)blockIdx.x);
    for (int cn = blockIdx.x; cn < 2176; cn += gridDim.x) {
        const int n = cn % 68, bh = cn / 68, h = bh & 3, b = bh >> 2;
        const GAS bf16x8* SxB = (const GAS bf16x8*)((const bf16*)(ws + WS_SX) + ((size_t)(bh * 2 + 1) * 68 + n) * 32768 + (size_t)vb * 1024) + lane;
        const GAS bf16x8* Vt = (const GAS bf16x8*)(ws + WS_GVT + (size_t)cn * 32768) + vb * 64 + lane;
        bf16x8 sB[8], vf[4];
        { const GAS bf16x8* SxA = SxB - 68 * 4096;
#pragma unroll
          for (int s = 0; s < 8; ++s) sA[s] = SxA[(s >> 1) * 1024 + (s & 1) * 64]; }
        __syncthreads();
#pragma unroll
        for (int tl = 0; tl < 4; ++tl)
#pragma unroll
            for (int j = 0; j < 2; ++j) { const int q = tid + 512 * j, row = q >> 4, ch = q & 15; *(LAS v4u*)(TL + tl * G3_TILE + row * G3_RS + ch * 16) = st[tl][j]; }
        __syncthreads();
        f32x16 P00, P01, P10, P11, O0, O1;
#pragma unroll
        for (int g = 0; g < 16; ++g) { P00[g] = 0.f; P01[g] = 0.f; P10[g] = 0.f; P11[g] = 0.f; O0[g] = 0.f; O1[g] = 0.f; }
#pragma unroll
        for (int dir = 0; dir < 2; ++dir) {
            const LAS unsigned char* Qt = TL + (2 * dir) * G3_TILE + r * G3_RS + 16 * hh; const LAS unsigned char* Kh = TL + (2 * dir + 1) * G3_TILE + r * G3_RS + 16 * hh;
            if (dir == 0) {
#pragma unroll
                for (int s = 0; s < 8; ++s) sB[s] = SxB[(s >> 1) * 1024 + (s & 1) * 64];
            } else {
#pragma unroll
                for (int q = 0; q < 4; ++q) vf[q] = Vt[q * 512];
            }
            __builtin_amdgcn_sched_barrier(0);
            f32x16 X00, X11, Xoff;
#pragma unroll
            for (int g = 0; g < 16; ++g) { X00[g] = 0.f; X11[g] = 0.f; Xoff[g] = 0.f; }
#pragma unroll
            for (int s = 0; s < 8; ++s) {
                const bf16x8 q0 = *(const LAS bf16x8*)(Qt + 32 * s), q1 = *(const LAS bf16x8*)(Qt + 32 * G3_RS + 32 * s);
                const bf16x8 k0 = *(const LAS bf16x8*)(Kh + 32 * s), k1 = *(const LAS bf16x8*)(Kh + 32 * G3_RS + 32 * s);
                const bf16x8 sx = dir ? sB[s] : sA[s];
                X00 = __builtin_amdgcn_mfma_f32_32x32x16_bf16(k0, q0, X00, 0, 0, 0);
                X11 = __builtin_amdgcn_mfma_f32_32x32x16_bf16(k1, q1, X11, 0, 0, 0);
                if (dir == 0) Xoff = __builtin_amdgcn_mfma_f32_32x32x16_bf16(k0, q1, Xoff, 0, 0, 0); else Xoff = __builtin_amdgcn_mfma_f32_32x32x16_bf16(k1, q0, Xoff, 0, 0, 0);
                O0 = __builtin_amdgcn_mfma_f32_32x32x16_bf16(q0, sx, O0, 0, 0, 0); O1 = __builtin_amdgcn_mfma_f32_32x32x16_bf16(q1, sx, O1, 0, 0, 0); }
#pragma unroll
            for (int g = 0; g < 16; ++g) { const int tj = (g & 3) + 8 * (g >> 2) + 4 * hh; const bool keep = dir ? (tj >= r) : (tj <= r);
                P00[g] += keep ? X00[g] : 0.f; P11[g] += keep ? X11[g] : 0.f;
                if (dir == 0) P01[g] += Xoff[g]; else P10[g] += Xoff[g]; }
        }
        {
#pragma unroll
          for (int jb = 0; jb < 2; ++jb)
#pragma unroll
            for (int s2 = 0; s2 < 2; ++s2) { const bf16x8 bfv = vf[2 * jb + s2];
                const f32x16& Pa = jb ? P10 : P00; const f32x16& Pb = jb ? P11 : P01;
                const bf16x8 a0 = __builtin_bit_cast(bf16x8, ((v4u){pk2(Pa[8 * s2 + 0], Pa[8 * s2 + 1]), pk2(Pa[8 * s2 + 2], Pa[8 * s2 + 3]), pk2(Pa[8 * s2 + 4], Pa[8 * s2 + 5]), pk2(Pa[8 * s2 + 6], Pa[8 * s2 + 7])}));
                const bf16x8 a1 = __builtin_bit_cast(bf16x8, ((v4u){pk2(Pb[8 * s2 + 0], Pb[8 * s2 + 1]), pk2(Pb[8 * s2 + 2], Pb[8 * s2 + 3]), pk2(Pb[8 * s2 + 4], Pb[8 * s2 + 5]), pk2(Pb[8 * s2 + 6], Pb[8 * s2 + 7])}));
                O0 = __builtin_amdgcn_mfma_f32_32x32x16_bf16(a0, bfv, O0, 0, 0, 0); O1 = __builtin_amdgcn_mfma_f32_32x32x16_bf16(a1, bfv, O1, 0, 0, 0); } }
        const int rt_ = tid >> 3, rcc_ = tid & 7; const size_t rrow_ = (size_t)b * TB + 64 * n + rt_;
        v4u rvv[4]; f32x4 ogv[8];
        { const GAS v4u* rp = (const GAS v4u*)(G + rrow_ * WINP + 2048 + h * 256 + 32 * rcc_); const GAS f32x4* gp = (const GAS f32x4*)(PARF(ws) + P_OG + lg * 256 + 32 * rcc_);
#pragma unroll
          for (int j = 0; j < 4; ++j) { rvv[j] = rp[j]; ogv[2 * j] = gp[2 * j]; ogv[2 * j + 1] = gp[2 * j + 1]; } }
        __builtin_amdgcn_sched_barrier(0);
        if (cn + (int)gridDim.x < 2176) G3_REQUEST(cn + (int)gridDim.x);
        __builtin_amdgcn_sched_barrier(0);
#pragma unroll
        for (int g = 0; g < 16; ++g) { const int t = (g & 3) + 8 * (g >> 2) + 4 * hh; OL[t * G3_LD + 32 * vb + r] = O0[g]; OL[(32 + t) * G3_LD + 32 * vb + r] = O1[g]; }
        __syncthreads();
        { const int t = tid >> 3, cc = tid & 7; const LAS f32x4* op = (const LAS f32x4*)(OL + t * G3_LD + 32 * cc);
          f32x4 o[8]; float ss = 0.f;
#pragma unroll
          for (int j = 0; j < 8; ++j) { o[j] = op[j]; ss += (o[j].x * o[j].x + o[j].y * o[j].y) + (o[j].z * o[j].z + o[j].w * o[j].w); }
          ss += __shfl_xor(ss, 1); ss += __shfl_xor(ss, 2); ss += __shfl_xor(ss, 4);
          const float rs = 1.0f / sqrtf(ss * (1.0f / 256.0f) + RMS_EPS);
          GAS unsigned long long* dst = (GAS unsigned long long*)((unsigned char*)OG + rrow_ * 1024 + h * 256 + 32 * cc);
#pragma unroll
          for (int j = 0; j < 4; ++j) { const v4u rv = rvv[j]; const f32x4 g0 = ogv[2 * j], g1 = ogv[2 * j + 1]; const f32x4 a = o[2 * j] * rs * g0, c2 = o[2 * j + 1] * rs * g1;
              const unsigned w0 = pg8::pk4_fp8(a.x * silu_f(__uint_as_float(rv.x << 16)), a.y * silu_f(__uint_as_float(rv.x & 0xffff0000u)), a.z * silu_f(__uint_as_float(rv.y << 16)), a.w * silu_f(__uint_as_float(rv.y & 0xffff0000u)));
              const unsigned w1 = pg8::pk4_fp8(c2.x * silu_f(__uint_as_float(rv.z << 16)), c2.y * silu_f(__uint_as_float(rv.z & 0xffff0000u)), c2.z * silu_f(__uint_as_float(rv.w << 16)), c2.w * silu_f(__uint_as_float(rv.w & 0xffff0000u)));
              dst[j] = (unsigned long long)w0 | ((unsigned long long)w1 << 32); } }
    }
#undef G3_REQUEST
}
constexpr int WIMG_RS = 2064;
static_assert(2 * 32 * WIMG_RS <= LDS_AUX, "router images below the aux tables");
__device__ __forceinline__ void phase_modulate2_route(unsigned char* ws, int layer, LAS unsigned char* lds, int vcu, int wave, int lane, int tid, bool dummy = false) {
    const bf16* X = (const bf16*)(ws + WS_X); bf16* XN = (bf16*)(ws + WS_XN);
    const float* ng = PARF(ws) + P_N2G + layer * 1024; const float* Mo = (const float*)(ws + WS_MOD) + (size_t)layer * MODROWS * NMODC;
    LAS unsigned char* WHI = lds + RING_OFF; LAS unsigned char* WLO = WHI + 32 * WIMG_RS;
    LAS unsigned* lcnt = (LAS unsigned*)(lds + AUX_LCNT); LAS unsigned* gb = (LAS unsigned*)(lds + AUX_GB); LAS unsigned* ent = (LAS unsigned*)(lds + AUX_ENT); LAS float* rsl = (LAS float*)(lds + AUX_RS);
    { const float* wsrc = PARF(ws) + P_WR + (size_t)layer * 1024 * 32;
      for (int b0 = 0; b0 < 64; b0 += 16) { float wv[16];
#pragma unroll
          for (int j = 0; j < 16; ++j) wv[j] = ((const GAS float*)wsrc)[tid + (b0 + j) * (NWAVES * 64)];
#pragma unroll
          for (int j = 0; j < 16; ++j) { const int idx = tid + (b0 + j) * (NWAVES * 64), k = idx >> 5, e = idx & 31; const float w = wv[j]; const unsigned hi = f2bf(w), lo = f2bf(w - __uint_as_float(hi << 16));
              *(LAS unsigned short*)(WHI + e * WIMG_RS + 2 * k) = (unsigned short)hi; *(LAS unsigned short*)(WLO + e * WIMG_RS + 2 * k) = (unsigned short)lo; } }
      if (tid < 32) lcnt[tid] = 0u; }
    gu32* cnt = (gu32*)(ws + WS_CTL) + CW_CNT + (layer + (dummy ? 4 : 0)) * 32 * 16;
    unsigned char* sbase = dummy ? ws + WS_XG : ws;
    const bool lastl = (layer == NLAYER - 1);
  for (int grp = vcu; grp < MT / 136; grp += (int)gridDim.x) {
    const int rbase = grp * 136;
    if (grp != vcu) { __syncthreads(); if (tid < 32) lcnt[tid] = 0u; }
    for (int rl = wave; rl < 136; rl += 2 * NWAVES) {
        const int rl2 = (rl + NWAVES < 136) ? rl + NWAVES : rl; const int m = rbase + rl, m2 = rbase + rl2, mr = mod_row(m), mr2 = mod_row(m2);
        float rs, rs2;
        modulate_row2<true>(X + (size_t)m * 1024, X + (size_t)m2 * 1024, ng, Mo + (size_t)mr * NMODC + 3 * 1024, Mo + (size_t)mr * NMODC + 4 * 1024, Mo + (size_t)mr2 * NMODC + 3 * 1024, Mo + (size_t)mr2 * NMODC + 4 * 1024,
                      ws + WS_XN8 + (size_t)m * 1024, ws + WS_XN8 + (size_t)m2 * 1024, lane, rs, rs2);
        if (lane == 0) { rsl[rl] = rs; rsl[rl2] = rs2; } }
    __syncthreads();
    if (wave < 5) {
        const int r = lane & 31, hh = lane >> 5; const int rl = (32 * wave + r < 136) ? 32 * wave + r : 135; const int m = rbase + rl, mr = mod_row(m);
        const float rsr = rsl[rl];
        const bf16* xp = X + (size_t)m * 1024 + 8 * hh; const float* gp = ng + 8 * hh; const float* scp = Mo + (size_t)mr * NMODC + 4 * 1024 + 8 * hh; const float* shp = Mo + (size_t)mr * NMODC + 3 * 1024 + 8 * hh;
        const LAS unsigned char* wh = WHI + r * WIMG_RS + 16 * hh; const LAS unsigned char* wl = WLO + r * WIMG_RS + 16 * hh;
        f32x16 acc;
#pragma unroll
        for (int g = 0; g < 16; ++g) acc[g] = 0.f;
#define RT_LD(q, s_) do { const int ss_ = (s_) & 63; q##x = *(const GAS v4u*)(xp + 16 * ss_); q##g0 = *(const GAS f32x4*)(gp + 16 * ss_); q##g1 = *(const GAS f32x4*)(gp + 16 * ss_ + 4); \
            q##c0 = *(const GAS f32x4*)(scp + 16 * ss_); q##c1 = *(const GAS f32x4*)(scp + 16 * ss_ + 4); q##h0 = *(const GAS f32x4*)(shp + 16 * ss_); q##h1 = *(const GAS f32x4*)(shp + 16 * ss_ + 4); } while (0)
#define RT_STEP(q, s_) do { const v4u xr8 = q##x; const f32x4 x0 = (f32x4){__uint_as_float(xr8.x << 16), __uint_as_float(xr8.x & 0xffff0000u), __uint_as_float(xr8.y << 16), __uint_as_float(xr8.y & 0xffff0000u)}, x1 = (f32x4){__uint_as_float(xr8.z << 16), __uint_as_float(xr8.z & 0xffff0000u), __uint_as_float(xr8.w << 16), __uint_as_float(xr8.w & 0xffff0000u)}; \
            const f32x4 y0 = (x0 * rsr) * q##g0 * (q##c0 + 1.0f) + q##h0, y1 = (x1 * rsr) * q##g1 * (q##c1 + 1.0f) + q##h1;        \
            v4u ph, pl; \
            ph.x = pg8::cvt_pk_bf16(y0.x, y0.y); ph.y = pg8::cvt_pk_bf16(y0.z, y0.w); ph.z = pg8::cvt_pk_bf16(y1.x, y1.y); ph.w = pg8::cvt_pk_bf16(y1.z, y1.w); \
            pl.x = pg8::cvt_pk_bf16(y0.x - __uint_as_float(ph.x << 16), y0.y - __uint_as_float(ph.x & 0xffff0000u)); pl.y = pg8::cvt_pk_bf16(y0.z - __uint_as_float(ph.y << 16), y0.w - __uint_as_float(ph.y & 0xffff0000u)); \
            pl.z = pg8::cvt_pk_bf16(y1.x - __uint_as_float(ph.z << 16), y1.y - __uint_as_float(ph.z & 0xffff0000u)); pl.w = pg8::cvt_pk_bf16(y1.z - __uint_as_float(ph.w << 16), y1.w - __uint_as_float(ph.w & 0xffff0000u)); \
            const bf16x8 ahi = __builtin_bit_cast(bf16x8, ph), alo = __builtin_bit_cast(bf16x8, pl); \
            const bf16x8 bhi = *(const LAS bf16x8*)(wh + 32 * (s_)), blo = *(const LAS bf16x8*)(wl + 32 * (s_)); \
            acc = __builtin_amdgcn_mfma_f32_32x32x16_bf16(ahi, bhi, acc, 0, 0, 0); acc = __builtin_amdgcn_mfma_f32_32x32x16_bf16(alo, bhi, acc, 0, 0, 0); acc = __builtin_amdgcn_mfma_f32_32x32x16_bf16(ahi, blo, acc, 0, 0, 0); } while (0)
#define RT_DECL(q) v4u q##x; f32x4 q##g0, q##g1, q##c0, q##c1, q##h0, q##h1
        RT_DECL(pa); RT_DECL(pb); RT_DECL(pc); RT_DECL(pd);
        RT_LD(pa, 0); RT_LD(pb, 1);
#pragma unroll 1
        for (int s = 0; s < 64; s += 4) {
            RT_LD(pc, s + 2); RT_LD(pd, s + 3); __builtin_amdgcn_sched_barrier(0);
            RT_STEP(pa, s); RT_STEP(pb, s + 1); __builtin_amdgcn_sched_barrier(0);
            RT_LD(pa, s + 4); RT_LD(pb, s + 5); __builtin_amdgcn_sched_barrier(0);
            RT_STEP(pc, s + 2); RT_STEP(pd, s + 3); __builtin_amdgcn_sched_barrier(0); }
#undef RT_LD
#undef RT_STEP
#undef RT_DECL
        const float brt = (PARF(ws) + P_BR)[layer * 32 + r];
#pragma unroll
        for (int g = 0; g < 16; ++g) { const int rowl = 32 * wave + (g & 3) + 8 * (g >> 2) + 4 * hh;
            float v = acc[g] + brt; float tv[4]; int te[4];
#pragma unroll
            for (int k = 0; k < 4; ++k) { float mx = v;
#pragma unroll
                for (int o = 1; o < 32; o <<= 1) mx = fmaxf(mx, shx(mx, o, lane));
                const unsigned long long bm = __ballot(v == mx); const unsigned hm = hh ? (unsigned)(bm >> 32) : (unsigned)bm; const int first = __ffs((int)hm) - 1;
                te[k] = first; tv[k] = mx; if (r == first) v = -INFINITY; }
            const bool valid = rowl < 136 && !(lastl && mod_row(rbase + (rowl < 136 ? rowl : 135)) == 8);
            if (r == 0 && rowl < 136) {
                if (valid) { const float e1 = __expf(tv[1] - tv[0]), e2 = __expf(tv[2] - tv[0]), e3 = __expf(tv[3] - tv[0]); const float inv = 1.0f / (1.0f + e1 + e2 + e3);
                    const float wk[4] = {inv, e1 * inv, e2 * inv, e3 * inv};
#pragma unroll
                    for (int k = 0; k < 4; ++k) { const unsigned lp = atomicAdd((unsigned*)&lcnt[te[k]], 1u); ent[(rowl * 4 + k) * 2 + 0] = ((unsigned)te[k] << 24) | lp; ent[(rowl * 4 + k) * 2 + 1] = __float_as_uint(wk[k]); } }
                else {
#pragma unroll
                    for (int k = 0; k < 4; ++k) ent[(rowl * 4 + k) * 2 + 0] = 0xffffffffu; } } }
    }
    __syncthreads();
    if (tid < 32) gb[tid] = __hip_atomic_fetch_add(cnt + tid * 16, lcnt[tid], __ATOMIC_RELAXED, __HIP_MEMORY_SCOPE_AGENT);
    __syncthreads();
    for (int q = tid; q < 136 * 4; q += NWAVES * 64) { const unsigned pe = ent[q * 2 + 0];
        if (pe != 0xffffffffu) { const unsigned e = pe >> 24, lp = pe & 0xffffffu; const int m = rbase + (q >> 2);
            ((unsigned*)(sbase + WS_SLOT))[m * 4 + (q & 3)] = (e << 24) | (gb[e] + lp); ((unsigned*)(sbase + WS_GATEW))[m * 4 + (q & 3)] = ent[q * 2 + 1];
            if (!dummy) ((int*)(ws + WS_LIST))[(size_t)e * MT + gb[e] + lp] = m; } }
  }
}
__device__ __forceinline__ void build_expert_tables(unsigned char* ws, int layer, LAS unsigned char* lds, int tid) {
    LAS int* t2e = (LAS int*)(lds + AUX_T2E); LAS int* base = (LAS int*)(lds + AUX_BASE); LAS int* ntp = (LAS int*)(lds + AUX_NT); LAS int* cntl = (LAS int*)(lds + AUX_CNT);
    gu32* cnt = (gu32*)(ws + WS_CTL) + CW_CNT + layer * 32 * 16;
    __syncthreads();
    if (tid < 64) { const unsigned cval = (tid < 32) ? __hip_atomic_load(cnt + tid * 16, RLX_AGENT) : 0u; const int tiles = (int)((cval + 255u) >> 8);
        int pre = tiles;
#pragma unroll
        for (int o = 1; o < 32; o <<= 1) { const int ln = tid & 63; const int t = __builtin_amdgcn_ds_bpermute(((ln >= o) ? ln - o : ln) << 2, pre); if (ln >= o) pre += t; }
        const int start = pre - tiles;
        if (tid < 32) { base[tid] = start * 256; cntl[tid] = (int)cval; for (int t = 0; t < tiles; ++t) t2e[start + t] = tid; if (tid == 31) ntp[0] = pre; } }
    __syncthreads();
}
__device__ __forceinline__ void phase_moe_gather(unsigned char* ws, int layer, LAS unsigned char* lds, int gw, int NGW, int lane, int tid) {
    build_expert_tables(ws, layer, lds, tid);
    const LAS int* base = (const LAS int*)(lds + AUX_BASE);
    const bf16* XN = (const bf16*)(ws + WS_XN); bf16* XG = (bf16*)(ws + WS_XG);
    const unsigned* slot = (const unsigned*)(ws + WS_SLOT); unsigned* spos = (unsigned*)(ws + WS_SLOTPOS);
    for (int m = gw; m < MT; m += NGW) {
        if (layer == NLAYER - 1 && mod_row(m) == 8) continue;
        const GAS v4u* src = (const GAS v4u*)(XN + (size_t)m * 1024) + lane; const v4u a = src[0], b = src[64];
#pragma unroll
        for (int k = 0; k < 4; ++k) { const unsigned pe = slot[m * 4 + k]; const int dst = base[pe >> 24] + (int)(pe & 0xffffffu);
            GAS v4u* dp = (GAS v4u*)(XG + (size_t)dst * 1024) + lane; dp[0] = a; dp[64] = b;
            if (lane == 0) spos[m * 4 + k] = (unsigned)dst; }
    }
}
__device__ __forceinline__ void phase_moe_combine(unsigned char* ws, float* out, int layer, LAS unsigned char* lds, int gw, int NGW, int lane, int tid, bool dummy = false) {
    build_expert_tables(ws, layer, lds, tid);
    const LAS int* base = (const LAS int*)(lds + AUX_BASE);
    bf16* X = (bf16*)(ws + WS_X); const unsigned char* Y = ws + WS_Y;
    const float* Mo = (const float*)(ws + WS_MOD) + (size_t)layer * MODROWS * NMODC;
    const unsigned* slot = (const unsigned*)(ws + WS_SLOT); const float* gw4 = (const float*)(ws + WS_GATEW);
    for (int m0 = gw; m0 < MT; m0 += 2 * NGW) {
        int mm[2], bb[2], ww[2], mrr[2]; bool ok[2];
#pragma unroll
        for (int p = 0; p < 2; ++p) { const int m = m0 + p * NGW; ok[p] = m < MT; mm[p] = ok[p] ? m : m0; bb[p] = mm[p] / TB; ww[p] = mm[p] - bb[p] * TB; mrr[p] = (ww[p] < CTXL) ? 8 : bb[p];
            if (layer == NLAYER - 1 && ww[p] < CTXL) ok[p] = false; }
        if (!ok[0] && !ok[1]) continue;
        unsigned pe[2][4]; float wk[2][4];
#pragma unroll
        for (int p = 0; p < 2; ++p)
#pragma unroll
            for (int k = 0; k < 4; ++k) { pe[p][k] = slot[mm[p] * 4 + k]; wk[p][k] = gw4[mm[p] * 4 + k]; }
        unsigned long long xv[2][4];
#pragma unroll
        for (int p = 0; p < 2; ++p) { const GAS unsigned long long* xp = (const GAS unsigned long long*)(X + (size_t)mm[p] * 1024) + lane;
#pragma unroll
            for (int j = 0; j < 4; ++j) xv[p][j] = xp[64 * j]; }
        unsigned yv[2][4][4];
#pragma unroll
        for (int p = 0; p < 2; ++p)
#pragma unroll
            for (int k = 0; k < 4; ++k) { unsigned e = pe[p][k] >> 24; if (!ok[p] || e > 31u) e = 0u;
                const unsigned sp = ok[p] ? (unsigned)base[e] + (pe[p][k] & 0xffffffu) : 0u;
                const GAS unsigned* yp = (const GAS unsigned*)(Y + (size_t)sp * 1024) + lane;
#pragma unroll
                for (int j = 0; j < 4; ++j) yv[p][k][j] = yp[64 * j]; }
        f32x4 f[2][4]; float ss[2];
#pragma unroll
        for (int p = 0; p < 2; ++p) { const GAS f32x4* gp = (const GAS f32x4*)(Mo + (size_t)mrr[p] * NMODC + 5 * 1024) + lane;
            ss[p] = 0.f;
#pragma unroll
            for (int j = 0; j < 4; ++j) { f32x4 a = (f32x4){0.f, 0.f, 0.f, 0.f};
#pragma unroll
                for (int k = 0; k < 4; ++k) { const unsigned w8 = yv[p][k][j]; const f32x2 lo2 = __builtin_amdgcn_cvt_pk_f32_fp8((int)w8, false), hi2 = __builtin_amdgcn_cvt_pk_f32_fp8((int)w8, true); a = a + (f32x4){lo2.x, lo2.y, hi2.x, hi2.y} * wk[p][k]; }
                f[p][j] = bf4_to_f32(xv[p][j]) + gp[64 * j] * a; } }
        asm volatile("" ::: "memory");
        const bool fuse = (layer < NLAYER - 1) && !dummy;
        f32x4 pg[4], psh[2][4], psc[2][4];
        if (fuse) { const float* ng = PARF(ws) + P_N1G + (layer + 1) * 1024;
#pragma unroll
            for (int j = 0; j < 4; ++j) pg[j] = ((const GAS f32x4*)ng)[64 * j + lane];
#pragma unroll
            for (int p = 0; p < 2; ++p) { const float* Mn = (const float*)(ws + WS_MOD) + (size_t)(layer + 1) * MODROWS * NMODC + (size_t)mrr[p] * NMODC;
#pragma unroll
                for (int j = 0; j < 4; ++j) { psh[p][j] = ((const GAS f32x4*)Mn)[64 * j + lane]; psc[p][j] = ((const GAS f32x4*)(Mn + 1024))[64 * j + lane]; } } }
#pragma unroll
        for (int p = 0; p < 2; ++p) { if (!ok[p]) continue;
            GAS unsigned long long* xp = (GAS unsigned long long*)(X + (size_t)mm[p] * 1024) + lane;
            GAS f32x4* op = (GAS f32x4*)(out + ((size_t)bb[p] * SEQ + (ww[p] - CTXL)) * 1024) + lane;
#pragma unroll
            for (int j = 0; j < 4; ++j) { if (dummy) ((GAS f32x4*)((float*)(ws + WS_XG) + (size_t)mm[p] * 1024) + lane)[64 * j] = f[p][j]; else if (layer == NLAYER - 1) op[64 * j] = f[p][j]; else { const unsigned long long pk = f32_to_bf4(f[p][j]); xp[64 * j] = pk; f[p][j] = bf4_to_f32(pk); }
                ss[p] += (f[p][j].x * f[p][j].x + f[p][j].y * f[p][j].y) + (f[p][j].z * f[p][j].z + f[p][j].w * f[p][j].w); } }
        if (fuse) { float s0 = ss[0], s1 = ss[1]; const int ln = lane_now();
#pragma unroll
            for (int o = 1; o < 64; o <<= 1) { s0 += shx(s0, o, ln); s1 += shx(s1, o, ln); }
            const float rsv[2] = {1.0f / sqrtf(s0 * (1.0f / 1024.0f) + RMS_EPS), 1.0f / sqrtf(s1 * (1.0f / 1024.0f) + RMS_EPS)};
#pragma unroll
            for (int p = 0; p < 2; ++p) { if (!ok[p]) continue;
                { GAS unsigned* o4 = (GAS unsigned*)(ws + WS_XN + (size_t)mm[p] * 1024) + lane;
#pragma unroll
                  for (int j = 0; j < 4; ++j) { const f32x4 y = (f[p][j] * rsv[p]) * pg[j] * (psc[p][j] + 1.0f) + psh[p][j]; o4[64 * j] = pg8::pk4_fp8_sat(y.x, y.y, y.z, y.w); } } } }
    }
}

constexpr int NPH_L = 11, NPHASE = 2 + NPH_L * NLAYER;
#ifndef PHMASK
#define PHMASK 0x7fff
#endif
#define EN(b) ((PHMASK >> (b)) & 1)
#ifndef DUPMASK
#define DUPMASK 0
#endif
#define DUP(b) for (int rep_ = 0; rep_ < (((DUPMASK >> (b)) & 1) ? 2 : 1); ++rep_)
__global__ void __launch_bounds__(NWAVES * 64, 2) dit_fwd(Args args) {
    extern __shared__ __attribute__((aligned(16))) unsigned char lds_raw[];
    LAS unsigned char* lds = (LAS unsigned char*)lds_raw;
    volatile LAS unsigned* MISC = (volatile LAS unsigned*)(lds + MISC_OFF);
    const int G = gridDim.x, bx = blockIdx.x;
    const int vcu = (G % 8 == 0) ? (bx % 8) * (G / 8) + bx / 8 : bx;
    const int wave0 = __builtin_amdgcn_readfirstlane((int)threadIdx.x >> 6);
#define LANE_ID(z) ((int)__builtin_amdgcn_mbcnt_hi(~0u, __builtin_amdgcn_mbcnt_lo(~0u, (z))))
    { const int t0 = (wave0 << 6) | LANE_ID(0u); for (int u = t0; u < (LDS_BYTES - MISC_OFF) / 4; u += NWAVES * 64) ((LAS unsigned*)(lds + MISC_OFF))[u] = 0u; }
    __syncthreads();
    const int lo = args.ph_lo, hi = args.ph_hi;
    XcdBarrier bar; bar.bar = (unsigned*)(args.ws + WS_CTL) + CW_BAR; bar.x = 0; bar.st = nullptr;
    if (hi - lo > 1) bar = xcd_barrier_post((unsigned*)(args.ws + WS_CTL) + CW_BAR, MISC + 8, wave0 == 0 && LANE_ID(0u) == 0);
#define IN(k) (lo <= (k) && (k) < hi)
#define SEAM(k) do { if (IN(k) && IN((k) + 1)) { XcdBarrier b_ = bar; unsigned zb_ = 0u; LAUNDER_S(zb_); b_.bar = bar.bar + zb_; xcd_barrier(b_, wave0 == 0 && LANE_ID(zb_) == 0); } } while (0)
#define PHASE_IDS() unsigned zoff_ = 0u; LAUNDER_S(zoff_); int tid = (wave0 << 6) | LANE_ID(zoff_); LAUNDER_V(tid); const int lane = tid & 63, wave = __builtin_amdgcn_readfirstlane(tid >> 6); const int gw = vcu * NWAVES + wave, NGW = G * NWAVES; \
    unsigned char* ws = args.ws + zoff_; const int Gp = G + (int)zoff_, bxp = bx + (int)zoff_; (void)lane; (void)gw; (void)NGW; (void)Gp; (void)bxp;

    if (EN(0) && IN(0)) DUP(0) { PHASE_IDS(); p0_prologue(args, lds, gw, NGW, wave, lane); } SEAM(0);
    if (EN(1) && IN(1)) { PHASE_IDS(); p1_mod_reduce(args, gw * 64 + lane, NGW * 64); } SEAM(1);

    for (int layer = 0; layer < NLAYER; ++layer) {
        const int pb = 2 + NPH_L * layer, lh = layer >> 1;
        if (layer == 0) { if (EN(2) && IN(pb + 0)) DUP(2) { PHASE_IDS(); phase_modulate1(ws, layer, gw, NGW, lane); } SEAM(pb + 0); }
        if ((layer & 1) == 0) {
            if (EN(3) && IN(pb + 1)) DUP(3) {
                PHASE_IDS();
                pg8::Gemm g{(const pg8::bf16_t*)(ws + WS_XN), (const pg8::bf16_t*)(ws + WS_WQKV + (size_t)lh * QKVN * 1024), MT, QKVN, 512, 0};
                pg8::StaticOrder S; S.init(MT, QKVN, Gp, bxp);
                LAS float* gl = (LAS float*)(lds + AUX_RS);
                if (tid < 128) gl[tid] = (PARF(ws) + (tid < 64 ? P_QG : P_KG - 64) + lh * 64)[tid];
                LAS float* rtab = (LAS float*)(lds + AUX_ROWTAB);
                { const float* rc = (const float*)(ws + WS_ROPE);
#pragma unroll
                  for (int q = 0; q < 2; ++q) { const int idx = tid + 512 * q, vv = idx >> 4, ii = idx & 15; rtab[idx] = rc[vv * 32 + 16 + ii]; rtab[1024 + idx] = rc[SEQ * 32 + vv * 32 + 16 + ii]; } }
                __syncthreads();
                pg8::EpiQKV E{ws, WS_Q, WS_K - WS_Q, WS_V - WS_K, gl, rtab, ATT_C2, 1.0f / 32.0f};
                pg8::gemm_phase<pg8::EpiQKV, pg8::StaticOrder, true, true, false, true>(lds + RING_OFF, g, S, E, tid);
            } SEAM(pb + 1);
            if (EN(5) && IN(pb + 3)) DUP(5) {
                PHASE_IDS();
                const attn_body::bf16* Qp = (const attn_body::bf16*)(ws + WS_Q); const attn_body::bf16* Kp = (const attn_body::bf16*)(ws + WS_K); const attn_body::bf16* Vp = (const attn_body::bf16*)(ws + WS_V);
                attn_body::bf16* Op = (attn_body::bf16*)(ws + WS_XN);
                if (G == 256) {
                    for (int i = 0; i < 9; ++i) {
                        long qrow0, kvrow0; int NT, h;
                        if (i < 8) { const int x = vcu >> 5, j = vcu & 31, pair = 4 * x + (i >> 1), wi = (i & 1) * 32 + j, hq = wi >> 4, qb = wi & 15, b = pair >> 2, hk = pair & 3;
                            h = hk * 4 + hq; qrow0 = (long)b * TB + CTXL + qb * 256; kvrow0 = (long)b * TB; NT = TB / 64; }
                        else { if (vcu >= 128) break; const int b = vcu >> 4; h = vcu & 15; qrow0 = (long)b * TB; kvrow0 = qrow0; NT = CTXL / 64; }
                        attn_body::attn_unit<8>(qrow0, kvrow0, NT, h, Qp, Kp, Vp, Op, (char*)lds_raw + RING_OFF, tid);
                    }
                } else {
                    for (int U = bx; U < 2048 + 128; U += G) {
                        long qrow0, kvrow0; int NT, h;
                        if (U < 2048) { const int pair = U >> 6, wi = U & 63, hq = wi >> 4, qb = wi & 15, b = pair >> 2, hk = pair & 3; h = hk * 4 + hq; qrow0 = (long)b * TB + CTXL + qb * 256; kvrow0 = (long)b * TB; NT = TB / 64; }
                        else { const int v = U - 2048, b = v >> 4; h = v & 15; qrow0 = (long)b * TB; kvrow0 = qrow0; NT = CTXL / 64; }
                        attn_body::attn_unit<8>(qrow0, kvrow0, NT, h, Qp, Kp, Vp, Op, (char*)lds_raw + RING_OFF, tid);
                    }
                }
            } SEAM(pb + 3);
        } else {
            if (EN(6) && IN(pb + 1)) DUP(6) {
                PHASE_IDS();
                pg8::Gemm g{(const pg8::bf16_t*)(ws + WS_XN), (const pg8::bf16_t*)(ws + WS_WIN + (size_t)lh * WINP * 1024), MT, WINP, 512, 0};
                pg8::StaticOrder S; S.init(MT, WINP, Gp, bxp);
                pg8::EpiBf16 E{(pg8::bf16_t*)(ws + WS_G), WINP, 1.0f / 32.0f};
                pg8::gemm_phase<pg8::EpiBf16, pg8::StaticOrder, true, true, false, true>(lds + RING_OFF, g, S, E, tid);
            } SEAM(pb + 1);
            if (EN(7) && IN(pb + 2)) DUP(7) { { PHASE_IDS(); phase_gla_g0v(ws, tid, Gp, bxp); } { PHASE_IDS(); phase_gla_g0(ws, lh, lds, tid, Gp, bxp); } } SEAM(pb + 2);
            if (EN(8) && IN(pb + 3)) DUP(8) { PHASE_IDS(); phase_gla_g12(ws, lds, gw, wave, lane); } SEAM(pb + 3);
            if (EN(8) && IN(pb + 4)) DUP(9) { PHASE_IDS(); phase_gla_g3(ws, lh, lds, tid); } SEAM(pb + 4);
        }
        if (EN(9) && IN(pb + 5)) {
            PHASE_IDS();
            const pg8::bf16_t* Wt = (const pg8::bf16_t*)(ws + ((layer & 1) ? WS_WOG : WS_WOA) + (size_t)lh * 1024 * 1024);
            pg8::Gemm g{(const pg8::bf16_t*)(ws + ((layer & 1) ? WS_Q : WS_XN)), Wt, MT, 1024, 512, 0};
            pg8::StaticOrder S; if (layer == NLAYER - 1) S.init(NB * SEQ, 1024, Gp, bxp, true); else S.init(MT, 1024, Gp, bxp);
            pg8::EpiResGate E{(pg8::bf16_t*)(ws + WS_X), (const float*)(ws + WS_MOD) + (size_t)layer * MODROWS * NMODC + 2 * 1024, (layer & 1) ? 1.0f / 32.0f : 1.0f / 1024.0f};
            pg8::gemm_phase<pg8::EpiResGate, pg8::StaticOrder, true, true, false, true>(lds + RING_OFF, g, S, E, tid);
        } SEAM(pb + 5);
        if (EN(10) && IN(pb + 6)) { if ((DUPMASK >> 10) & 1) { PHASE_IDS(); phase_modulate2_route(ws, layer, lds, vcu, wave, lane, tid, true); __syncthreads(); } PHASE_IDS(); phase_modulate2_route(ws, layer, lds, vcu, wave, lane, tid); } SEAM(pb + 6);
        if (EN(12) && IN(pb + 8)) DUP(12) {
            PHASE_IDS();
            build_expert_tables(ws, layer, lds, tid);
            const int nT = __builtin_amdgcn_readfirstlane(((const LAS int*)(lds + AUX_NT))[0]);
            pg8::MoeOrder S{nT, 8, Gp, bxp, (const LAS int*)(lds + AUX_T2E)};
            LAS unsigned short* rowtab = (LAS unsigned short*)(lds + AUX_ROWTAB);
            { const LAS int* base = (const LAS int*)(lds + AUX_BASE); const LAS int* cntl = (const LAS int*)(lds + AUX_CNT); const int* LIST = (const int*)(ws + WS_LIST);
              pg8::Unit u;
              int rv[ROWTAB_UNITS];
#pragma unroll
              for (int i = 0; i < ROWTAB_UNITS; ++i) { const bool ok = S.next(i, u); const int e = ok ? u.e : 0, pos = ok ? (u.pm - (base[e] >> 8)) * 256 + (tid & 255) : 0;
                  rv[i] = (ok && pos < cntl[e]) ? LIST[(size_t)e * MT + pos] : 0; }
#pragma unroll
              for (int i = 0; i < ROWTAB_UNITS; ++i) if (tid < 256) rowtab[i * 256 + tid] = (unsigned short)rv[i];
              __syncthreads(); }
            pg8::Gemm g{(const pg8::bf16_t*)(ws + WS_XN8), (const pg8::bf16_t*)(ws + WS_WGU + (size_t)layer * 32 * 2048 * 1024), MPAD, 2048, 512, (size_t)2048 * 1024, rowtab};
            pg8::EpiSwiGLU8 E{ws + WS_ACT, PARF(ws) + P_BGU + (size_t)layer * 32 * 2048, 1.0f / 32.0f};
#if (DUPMASK >> 15) & 1
            { pg8::EpiNull8 E0; pg8::gemm_phase<pg8::EpiNull8, pg8::MoeOrder, true, true, true, true>(lds + RING_OFF, g, S, E0, tid); __syncthreads(); }
#endif
            pg8::gemm_phase<pg8::EpiSwiGLU8, pg8::MoeOrder, true, true, true, true>(lds + RING_OFF, g, S, E, tid);
        } SEAM(pb + 8);
        if (EN(13) && IN(pb + 9)) DUP(13) {
            PHASE_IDS();
            build_expert_tables(ws, layer, lds, tid);
            const int nT = __builtin_amdgcn_readfirstlane(((const LAS int*)(lds + AUX_NT))[0]);
            pg8::Gemm g{(const pg8::bf16_t*)(ws + WS_ACT), (const pg8::bf16_t*)(ws + WS_WDN + (size_t)layer * 32 * 1024 * 1024), MPAD, 1024, 512, (size_t)1024 * 1024};
            pg8::MoeOrder S{nT, 4, Gp, bxp, (const LAS int*)(lds + AUX_T2E), true};
            pg8::EpiBiasF8 E{ws + WS_Y, PARF(ws) + P_BDN + (size_t)layer * 32 * 1024, 1.0f / 32.0f};
            pg8::gemm_phase<pg8::EpiBiasF8, pg8::MoeOrder, true, true, false, true>(lds + RING_OFF, g, S, E, tid);
        } SEAM(pb + 9);
        if (EN(14) && IN(pb + 10)) { if ((DUPMASK >> 14) & 1) { PHASE_IDS(); phase_moe_combine(ws, args.out, layer, lds, gw, NGW, lane, tid, true); } PHASE_IDS(); phase_moe_combine(ws, args.out, layer, lds, gw, NGW, lane, tid); } SEAM(pb + 10);
    }
#undef IN
#undef EN
#undef DUP
#undef SEAM
#undef PHASE_IDS
#undef LANE_ID
}

extern "C" void kernel_launch(void* const* d_in, const int* in_sizes, int n_in, void* d_out, int out_size, void* d_ws, size_t ws_size, hipStream_t stream) {
    static int grid = 0;
    if (grid == 0) {
        if (n_in != 25 || out_size != NB * SEQ * DMODEL || ws_size < WS_END) { fprintf(stderr, "kernel_launch: unexpected shapes: n_in %d out %d ws %zu (need >= %zu)\n", n_in, out_size, ws_size, (size_t)WS_END); grid = -1; return; }
        int dev = 0, cus = 0, per_cu = 0;
        if (hipGetDevice(&dev) != hipSuccess || hipDeviceGetAttribute(&cus, hipDeviceAttributeMultiprocessorCount, dev) != hipSuccess) { grid = -1; return; }
        if (hipFuncSetAttribute((const void*)dit_fwd, hipFuncAttributeMaxDynamicSharedMemorySize, LDS_BYTES) != hipSuccess) { fprintf(stderr, "kernel_launch: hipFuncSetAttribute failed\n"); grid = -1; return; }
        if (hipOccupancyMaxActiveBlocksPerMultiprocessor(&per_cu, (const void*)dit_fwd, NWAVES * 64, LDS_BYTES) != hipSuccess || per_cu < 1) fprintf(stderr, "kernel_launch: occupancy query reports %d\n", per_cu);
        (void)hipGetLastError();
        grid = cus;
    }
    if (grid < 0) return;
    if (hipMemsetAsync((char*)d_ws + WS_CTL, 0, CTL_ZERO_BYTES, stream) != hipSuccess) { fprintf(stderr, "kernel_launch: memset failed\n"); return; }
    Args a{};
    for (int i = 0; i < 25; ++i) a.in[i] = (const float*)d_in[i];
    a.out = (float*)d_out; a.ws = (unsigned char*)d_ws;
#if MK_ONE_LAUNCH
    a.ph_lo = 0; a.ph_hi = NPHASE;
    hipLaunchKernelGGL(dit_fwd, dim3(grid), dim3(NWAVES * 64), LDS_BYTES, stream, a);
#else
    for (int p = 0; p < NPHASE; ++p) { a.ph_lo = p; a.ph_hi = p + 1; hipLaunchKernelGGL(dit_fwd, dim3(grid), dim3(NWAVES * 64), LDS_BYTES, stream, a); }
#endif
    const hipError_t le = hipPeekAtLastError();
    if (le != hipSuccess) fprintf(stderr, "kernel_launch: launch failed: %s\n", hipGetErrorName(le));
}
```

```cpp
#include <hip/hip_runtime.h>
#include <hip/hip_bf16.h>
#include <cstdio>
#include <cstdint>
#include <cmath>

#ifndef MK_ONE_LAUNCH
#define MK_ONE_LAUNCH 1
#endif

namespace pg8 {
#define PG8_LAS __attribute__((address_space(3)))
typedef unsigned short bf16_t;
typedef short bf16x8 __attribute__((ext_vector_type(8)));
typedef float f32x4 __attribute__((ext_vector_type(4)));
typedef unsigned u32x4 __attribute__((ext_vector_type(4)));
constexpr int BM = 256, BK = 64, HALF = 128, HTB = HALF * BK * 2  , STAGE_BYTES = 8 * HTB, NXCD = 8, WGM = 8;

__host__ __device__ __forceinline__ int lds_byte(int r, int c) { const int st = (r >> 4) * 2 + (c >> 5), rr = r & 15, cc = c & 31, ob = rr * 64 + cc * 2; return st * 1024 + (ob ^ (((ob >> 9) & 1) << 5)); }
__host__ __device__ __forceinline__ void stage_rc(int b, int& R, int& C) { const int st = b / 1024, sb = b % 1024, swz = sb ^ (((sb >> 9) & 1) << 5); R = (st >> 1) * 16 + swz / 64; C = (st & 1) * 32 + (swz % 64) / 2; }
__host__ __device__ __forceinline__ int perm32(int rho) { const int n = rho >> 4, i = rho & 15; return 8 * (i >> 2) + 4 * n + (i & 3); }

struct Unit { int pm, pn, e; };
struct Gemm { const bf16_t* A; const bf16_t* Bt; int M, N, K; size_t bstride; const PG8_LAS unsigned short* rowtab; };

struct StaticOrder {
    int nM, nN, nwg, G, c; bool latent_only;
    __host__ __device__ __forceinline__ void init(int M, int N, int G_, int c_, bool lat_ = false) { nM = M / BM; nN = N / BM; nwg = nM * nN; G = G_; c = c_; latent_only = lat_; }
    __host__ __device__ __forceinline__ bool next(int i, Unit& u) const {
        const long L = (long)i * G + c; if (L >= nwg) return false;
        int wgid = (int)L; { const int q = nwg / NXCD, r = nwg % NXCD, xcd = wgid % NXCD, off = wgid / NXCD; wgid = (xcd < r ? xcd * (q + 1) : r * (q + 1) + (xcd - r) * q) + off; }
        const int nig = WGM * nN, gid = wgid / nig, fm = gid * WGM, gsz = (nM - fm) < WGM ? (nM - fm) : WGM;
        u.pm = fm + ((wgid % nig) % gsz); u.pn = (wgid % nig) / gsz; u.e = 0;
        if (latent_only) u.pm = (u.pm >> 4) * 17 + 1 + (u.pm & 15);
        return true;
    }
    __device__ __forceinline__ void a_ready(const Unit&) const {}
    __device__ __forceinline__ void done(const Unit&) const {}
};
struct MoeOrder {
    int nT, nN, G, c; const PG8_LAS int* t2e; bool rev = false;
    __device__ __forceinline__ bool next(int i, Unit& u) const {
        const int x = c & 7, j = c >> 3, per = 32 / nN, stride = (G >> 5) * per, first = x * per + j / nN;
        if (rev) { const int nw = (nT - first + stride - 1) / stride; if (i >= nw) return false; i = nw - 1 - i; }
        const int mt = i * stride + first; if (mt >= nT) return false;
        u.pm = mt; u.pn = j % nN; u.e = __builtin_amdgcn_readfirstlane(t2e[mt]); return true;
    }
    __device__ __forceinline__ void a_ready(const Unit&) const {}
    __device__ __forceinline__ void done(const Unit&) const {}
};

__device__ __forceinline__ int lane_now() { unsigned z; asm volatile("s_mov_b32 %0, 0" : "=s"(z)); return (int)__builtin_amdgcn_mbcnt_hi(~0u, __builtin_amdgcn_mbcnt_lo(~0u, z)); }
__device__ __forceinline__ float shx(float v, int m, int ln) { return __int_as_float(__builtin_amdgcn_ds_bpermute((ln ^ m) << 2, __float_as_int(v))); }
__device__ __forceinline__ unsigned pk4_fp8(float a, float b, float c, float d) { int w = 0; w = __builtin_amdgcn_cvt_pk_fp8_f32(a, b, w, false); w = __builtin_amdgcn_cvt_pk_fp8_f32(c, d, w, true); return (unsigned)w; }
__device__ __forceinline__ unsigned pk4_fp8_sat(float a, float b, float c, float d) {
    return pk4_fp8(__builtin_amdgcn_fmed3f(a, -448.0f, 448.0f), __builtin_amdgcn_fmed3f(b, -448.0f, 448.0f), __builtin_amdgcn_fmed3f(c, -448.0f, 448.0f), __builtin_amdgcn_fmed3f(d, -448.0f, 448.0f)); }
__device__ __forceinline__ unsigned cvt_pk_bf16(float lo, float hi) { unsigned r; asm volatile("v_cvt_pk_bf16_f32 %0, %1, %2" : "=v"(r) : "v"(lo), "v"(hi)); return r; }

struct EpiBf16 {
    static constexpr bool PERM = true, AFTER_DRAIN = false;
    bf16_t* O; int ldc; float asc;
    unsigned char* O8; int p8lo, p8hi;
    __device__ __forceinline__ void operator()(const f32x4 (&acc)[2][2][4][2], const Unit& u, int wr, int wc, int fr, int fq) const {
        const int row0 = u.pm * BM + wr * 64 + fr; const int col0 = u.pn * BM + wc * 32 + 8 * fq;
        if (u.pn >= p8lo && u.pn < p8hi) { const int ld8 = (p8hi - p8lo) * BM, c8 = col0 - p8lo * BM;
#pragma unroll
            for (int ai = 0; ai < 2; ++ai)
#pragma unroll
                for (int m = 0; m < 4; ++m) { unsigned char* rowp = O8 + (size_t)(row0 + ai * HALF + m * 16) * ld8 + c8;
#pragma unroll
                    for (int bj = 0; bj < 2; ++bj) { const f32x4 v0 = acc[ai][bj][m][0] * asc, v1 = acc[ai][bj][m][1] * asc;
                        *(unsigned long long*)(rowp + bj * HALF) = (unsigned long long)pk4_fp8_sat(v0[0], v0[1], v0[2], v0[3]) | ((unsigned long long)pk4_fp8_sat(v1[0], v1[1], v1[2], v1[3]) << 32); } }
            return; }
#pragma unroll
        for (int ai = 0; ai < 2; ++ai)
#pragma unroll
            for (int m = 0; m < 4; ++m) { bf16_t* rowp = O + (size_t)(row0 + ai * HALF + m * 16) * ldc + col0;
#pragma unroll
                for (int bj = 0; bj < 2; ++bj) { const f32x4 v0 = acc[ai][bj][m][0] * asc, v1 = acc[ai][bj][m][1] * asc;
                    u32x4 w; w.x = cvt_pk_bf16(v0[0], v0[1]); w.y = cvt_pk_bf16(v0[2], v0[3]); w.z = cvt_pk_bf16(v1[0], v1[1]); w.w = cvt_pk_bf16(v1[2], v1[3]);
                    *(u32x4*)(rowp + bj * HALF) = w; } }
    }
};
struct EpiQKV {
    static constexpr bool PERM = true, AFTER_DRAIN = false;
    unsigned char* wsb; size_t offQ, dK, dV;
    const PG8_LAS float* gl; const PG8_LAS float* rt; float c2, asc;
    __device__ __forceinline__ void operator()(const f32x4 (&acc)[2][2][4][2], const Unit& u, int wr, int wc, int fr, int fq) const {
        const int isk = (u.pn >= 4) ? 1 : 0, isv = (u.pn >= 5) ? 1 : 0;
        bf16_t* base = (bf16_t*)(wsb + offQ + (size_t)isk * dK + (size_t)isv * dV); const int ldc = isk ? 256 : 1024;
        const int hcol = (isk ? wc : (u.pn * 4 + wc)) * 64 + 8 * fq;
        const int pmb = u.pm / 17, pml = u.pm - pmb * 17; const bool lat = pml != 0;
        const PG8_LAS float* gp = gl + (isk ? 64 : 0) + 8 * fq; const float scl = isk ? 1.0f : c2;
#pragma unroll
        for (int ai = 0; ai < 2; ++ai)
#pragma unroll
            for (int m = 0; m < 4; ++m) { const int rl = ai * HALF + wr * 64 + m * 16 + fr; const size_t row = (size_t)u.pm * BM + rl;
                f32x4 v[2][2]; float ss = 0.f;
#pragma unroll
                for (int bj = 0; bj < 2; ++bj)
#pragma unroll
                    for (int n = 0; n < 2; ++n) { v[bj][n] = acc[ai][bj][m][n] * asc; ss += (v[bj][n][0] * v[bj][n][0] + v[bj][n][1] * v[bj][n][1]) + (v[bj][n][2] * v[bj][n][2] + v[bj][n][3] * v[bj][n][3]); }
                if (!isv) { const int ln = lane_now(); ss += shx(ss, 16, ln); ss += shx(ss, 32, ln);
                    const float rs = 1.0f / sqrtf(ss * (1.0f / 64.0f) + 1e-6f);
                    const int spos = (pml - 1) * 256 + rl;
#pragma unroll
                    for (int bj = 0; bj < 2; ++bj) { f32x4 cs = (f32x4){1.f, 1.f, 1.f, 1.f}, sn = (f32x4){0.f, 0.f, 0.f, 0.f};
                        if (lat) { const PG8_LAS float* cp = rt + (bj ? (spos & 63) : (spos >> 6)) * 16 + 4 * fq; cs = *(const PG8_LAS f32x4*)cp; sn = *(const PG8_LAS f32x4*)(cp + 1024); }
#pragma unroll
                        for (int n = 0; n < 2; ++n) { const f32x4 y = v[bj][n] * rs * *(const PG8_LAS f32x4*)(gp + 32 * bj + 4 * n);
                            const float c0 = cs[2 * n], s0 = sn[2 * n], c1 = cs[2 * n + 1], s1 = sn[2 * n + 1];
                            v[bj][n] = (f32x4){(y[0] * c0 - y[1] * s0) * scl, (y[0] * s0 + y[1] * c0) * scl, (y[2] * c1 - y[3] * s1) * scl, (y[2] * s1 + y[3] * c1) * scl}; } } }
                bf16_t* rowp = base + row * ldc + hcol;
#pragma unroll
                for (int bj = 0; bj < 2; ++bj) { u32x4 w; w.x = cvt_pk_bf16(v[bj][0][0], v[bj][0][1]); w.y = cvt_pk_bf16(v[bj][0][2], v[bj][0][3]); w.z = cvt_pk_bf16(v[bj][1][0], v[bj][1][1]); w.w = cvt_pk_bf16(v[bj][1][2], v[bj][1][3]);
                    *(u32x4*)(rowp + 32 * bj) = w; } }
    }
};
struct EpiBiasF8 {
    static constexpr bool PERM = true, AFTER_DRAIN = false;
    unsigned char* O; const float* bias; float ascale;
    __device__ __forceinline__ void operator()(const f32x4 (&acc)[2][2][4][2], const Unit& u, int wr, int wc, int fr, int fq) const {
        const int row0 = u.pm * BM + wr * 64 + fr; const int col0 = u.pn * BM + wc * 32 + 8 * fq;
        const float* bp = bias + (size_t)u.e * 1024 + col0;
        f32x4 bv[2][2];
#pragma unroll
        for (int bj = 0; bj < 2; ++bj)
#pragma unroll
            for (int n = 0; n < 2; ++n) bv[bj][n] = *(const f32x4*)(bp + bj * HALF + 4 * n);
#pragma unroll
        for (int ai = 0; ai < 2; ++ai)
#pragma unroll
            for (int m = 0; m < 4; ++m) { unsigned char* rowp = O + (size_t)(row0 + ai * HALF + m * 16) * 1024 + col0;
#pragma unroll
                for (int bj = 0; bj < 2; ++bj) { const f32x4 v0 = acc[ai][bj][m][0] * ascale + bv[bj][0], v1 = acc[ai][bj][m][1] * ascale + bv[bj][1];
                    *(unsigned long long*)(rowp + bj * HALF) = (unsigned long long)pk4_fp8_sat(v0[0], v0[1], v0[2], v0[3]) | ((unsigned long long)pk4_fp8_sat(v1[0], v1[1], v1[2], v1[3]) << 32); } }
    }
};
struct EpiResGate {
    static constexpr bool PERM = false, AFTER_DRAIN = false;
    bf16_t* X; const float* gate; float asc;
    __device__ __forceinline__ void operator()(const f32x4 (&acc)[2][2][4][2], const Unit& u, int wr, int wc, int fr, int fq) const {
        const int row0 = u.pm * BM + wr * 64 + fr; const int col0 = u.pn * BM + wc * 32 + 4 * fq;
        const int bb = u.pm / 17, mr = (u.pm - bb * 17 == 0) ? 8 : bb;
        const float* gp = gate + (size_t)mr * 6144 + col0;
        f32x4 gv[2][2];
#pragma unroll
        for (int bj = 0; bj < 2; ++bj)
#pragma unroll
            for (int n = 0; n < 2; ++n) gv[bj][n] = *(const f32x4*)(gp + bj * HALF + n * 16) * asc;
#pragma unroll
        for (int ai = 0; ai < 2; ++ai) { unsigned long long xv[4][2][2];
#pragma unroll
            for (int m = 0; m < 4; ++m) { const bf16_t* rowp = X + (size_t)(row0 + ai * HALF + m * 16) * 1024 + col0;
#pragma unroll
                for (int bj = 0; bj < 2; ++bj)
#pragma unroll
                    for (int n = 0; n < 2; ++n) xv[m][bj][n] = *(const unsigned long long*)(rowp + bj * HALF + n * 16); }
#pragma unroll
            for (int m = 0; m < 4; ++m) { bf16_t* rowp = X + (size_t)(row0 + ai * HALF + m * 16) * 1024 + col0;
#pragma unroll
                for (int bj = 0; bj < 2; ++bj)
#pragma unroll
                    for (int n = 0; n < 2; ++n) { const unsigned long long v = xv[m][bj][n];
                        f32x4 x = (f32x4){__uint_as_float((unsigned)(v & 0xffffu) << 16), __uint_as_float((unsigned)(v >> 16) << 16), __uint_as_float((unsigned)((v >> 32) & 0xffffu) << 16), __uint_as_float((unsigned)(v >> 48) << 16)};
                        x = x + gv[bj][n] * acc[ai][bj][m][n];
                        *(unsigned long long*)(rowp + bj * HALF + n * 16) = (unsigned long long)cvt_pk_bf16(x[0], x[1]) | ((unsigned long long)cvt_pk_bf16(x[2], x[3]) << 32); } } }
    }
};
struct EpiSwiGLU {
    static constexpr bool PERM = true, AFTER_DRAIN = false;
    bf16_t* O; const float* bias;
    __device__ __forceinline__ void operator()(const f32x4 (&acc)[2][2][4][2], const Unit& u, int wr, int wc, int fr, int fq) const {
        const int row0 = u.pm * BM + wr * 64 + fr; const int col0 = u.pn * HALF + wc * 32 + 8 * fq;
        const float* bp = bias + (size_t)u.e * 2048 + col0;
        f32x4 bg[2], bu[2];
#pragma unroll
        for (int n = 0; n < 2; ++n) { bg[n] = *(const f32x4*)(bp + 4 * n); bu[n] = *(const f32x4*)(bp + 1024 + 4 * n); }
#pragma unroll
        for (int ai = 0; ai < 2; ++ai)
#pragma unroll
            for (int m = 0; m < 4; ++m) { bf16_t* rowp = O + (size_t)(row0 + ai * HALF + m * 16) * 1024 + col0;
                float r[8];
#pragma unroll
                for (int n = 0; n < 2; ++n) { const f32x4 gt = acc[ai][0][m][n] + bg[n], up = acc[ai][1][m][n] + bu[n];
#pragma unroll
                    for (int i = 0; i < 4; ++i) { const float g = fminf(gt[i], 7.0f), uu = fminf(fmaxf(up[i], -7.0f), 7.0f);
                        const float sg = __builtin_amdgcn_rcpf(1.0f + __builtin_amdgcn_exp2f(-1.702f * 1.4426950408889634f * g));
                        r[4 * n + i] = (uu + 1.0f) * (g * sg); } }
                u32x4 w; w.x = cvt_pk_bf16(r[0], r[1]); w.y = cvt_pk_bf16(r[2], r[3]); w.z = cvt_pk_bf16(r[4], r[5]); w.w = cvt_pk_bf16(r[6], r[7]);
                *(u32x4*)rowp = w; }
    }
};
struct EpiNull8 {
    static constexpr bool PERM = true, AFTER_DRAIN = false;
    __device__ __forceinline__ void operator()(const f32x4 (&acc)[2][2][4][2], const Unit& u, int wr, int wc, int fr, int fq) const { asm volatile("" :: "v"(acc[0][0][0][0]), "v"(acc[1][1][3][1])); }
};
struct EpiSwiGLU8 {
    static constexpr bool PERM = true, AFTER_DRAIN = false;
    unsigned char* O; const float* bias; float ascale;
    __device__ __forceinline__ void operator()(const f32x4 (&acc)[2][2][4][2], const Unit& u, int wr, int wc, int fr, int fq) const {
        const int row0 = u.pm * BM + wr * 64 + fr; const int col0 = u.pn * HALF + wc * 32 + 8 * fq;
        const float* bp = bias + (size_t)u.e * 2048 + col0;
        f32x4 bg[2], bu[2];
#pragma unroll
        for (int n = 0; n < 2; ++n) { bg[n] = *(const f32x4*)(bp + 4 * n); bu[n] = *(const f32x4*)(bp + 1024 + 4 * n); }
        float as_ = ascale, nc_ = -1.702f * 1.4426950408889634f; asm volatile("" : "+v"(as_), "+v"(nc_));
        const f32x4 asv = (f32x4){as_, as_, as_, as_}, nc = (f32x4){nc_, nc_, nc_, nc_};
#pragma unroll
        for (int ai = 0; ai < 2; ++ai)
#pragma unroll
            for (int m = 0; m < 4; ++m) { unsigned char* rowp = O + (size_t)(row0 + ai * HALF + m * 16) * 1024 + col0;
                f32x4 rr[2];
#pragma unroll
                for (int n = 0; n < 2; ++n) { const f32x4 gt = acc[ai][0][m][n] * asv + bg[n], up = acc[ai][1][m][n] * asv + bu[n];
                    f32x4 g, uu;
#pragma unroll
                    for (int i = 0; i < 4; ++i) { g[i] = fminf(gt[i], 7.0f); uu[i] = __builtin_amdgcn_fmed3f(up[i], -7.0f, 7.0f); }
                    const f32x4 za = g * nc; f32x4 ex;
#pragma unroll
                    for (int i = 0; i < 4; ++i) ex[i] = __builtin_amdgcn_exp2f(za[i]);
                    const f32x4 dn = ex + 1.0f; f32x4 sg;
#pragma unroll
                    for (int i = 0; i < 4; ++i) sg[i] = __builtin_amdgcn_rcpf(dn[i]);
                    rr[n] = (uu + 1.0f) * (g * sg); }
                float r[8] = {rr[0][0], rr[0][1], rr[0][2], rr[0][3], rr[1][0], rr[1][1], rr[1][2], rr[1][3]};
                *(unsigned long long*)rowp = (unsigned long long)pk4_fp8(r[0], r[1], r[2], r[3]) | ((unsigned long long)pk4_fp8(r[4], r[5], r[6], r[7]) << 32); }
    }
};
struct EpiBiasBf16 {
    static constexpr bool PERM = true, AFTER_DRAIN = false;
    bf16_t* O; const float* bias; float ascale;
    __device__ __forceinline__ void operator()(const f32x4 (&acc)[2][2][4][2], const Unit& u, int wr, int wc, int fr, int fq) const {
        const int row0 = u.pm * BM + wr * 64 + fr; const int col0 = u.pn * BM + wc * 32 + 8 * fq;
        const float* bp = bias + (size_t)u.e * 1024 + col0;
        f32x4 bv[2][2];
#pragma unroll
        for (int bj = 0; bj < 2; ++bj)
#pragma unroll
            for (int n = 0; n < 2; ++n) bv[bj][n] = *(const f32x4*)(bp + bj * HALF + 4 * n);
#pragma unroll
        for (int ai = 0; ai < 2; ++ai)
#pragma unroll
            for (int m = 0; m < 4; ++m) { bf16_t* rowp = O + (size_t)(row0 + ai * HALF + m * 16) * 1024 + col0;
#pragma unroll
                for (int bj = 0; bj < 2; ++bj) { const f32x4 v0 = acc[ai][bj][m][0] * ascale + bv[bj][0], v1 = acc[ai][bj][m][1] * ascale + bv[bj][1];
                    u32x4 w; w.x = cvt_pk_bf16(v0[0], v0[1]); w.y = cvt_pk_bf16(v0[2], v0[3]); w.z = cvt_pk_bf16(v1[0], v1[1]); w.w = cvt_pk_bf16(v1[2], v1[3]);
                    *(u32x4*)(rowp + bj * HALF) = w; } }
    }
};

template <class Epi, class Sched, bool ALIGN_EPI = false, bool SP2 = false, bool GATHER = false, bool F8 = false>
__device__ __forceinline__ void gemm_phase(PG8_LAS unsigned char* lds, const Gemm g, const Sched& S, const Epi& E, int tid_in) {
    int tid_l = tid_in; asm volatile("" : "+v"(tid_l));
    const int tid = tid_l, wid = __builtin_amdgcn_readfirstlane(tid >> 6), lane = tid & 63, wr = wid >> 2, wc = wid & 3, fr = lane & 15, fq = lane >> 4;
    const int K = g.K, nt = K / BK;
    unsigned voffA[2], voffB[2];
#pragma unroll
    for (int i = 0; i < 2; ++i) { int R, C; stage_rc(tid * 16 + i * 8192, R, C); const int Rb = Epi::PERM ? ((R & ~31) + perm32(R & 31)) : R;
        voffA[i] = (unsigned)(R * K + C) * 2u; voffB[i] = (unsigned)(Rb * K + C) * 2u; }
    const size_t kstep = (size_t)(BK * 2);
    static_assert(!GATHER || SP2, "GATHER is wired into the SP2 loop only");
    unsigned vAc0[2], vAc1[2], vAn0[2], vAn1[2]; int gR[2]; unsigned gC[2];
#pragma unroll
    for (int i = 0; i < 2; ++i) { int R, C; stage_rc(tid * 16 + i * 8192, R, C); gR[i] = R; gC[i] = (unsigned)C * 2u; vAc0[i] = voffA[i]; vAc1[i] = voffA[i]; vAn0[i] = voffA[i]; vAn1[i] = voffA[i]; }
#define PG8_GFETCH(d0, d1, ord) do { if constexpr (GATHER) { _Pragma("unroll") for (int _i = 0; _i < 2; ++_i) { \
        d0[_i] = (unsigned)g.rowtab[(ord) * 256 + gR[_i]] * (unsigned)(K * 2) + gC[_i]; d1[_i] = (unsigned)g.rowtab[(ord) * 256 + 128 + gR[_i]] * (unsigned)(K * 2) + gC[_i]; } } } while (0)
    const size_t hstep = (size_t)HALF * K * 2;
    const size_t hstepA = GATHER ? 0 : hstep;
    const size_t tstep = 2 * hstep;
    const unsigned ldsw = (unsigned)wid * 1024u;
    const int aoff = lds_byte(wr * 64 + fr, fq * 8), boff = lds_byte(wc * 32 + fr, fq * 8);
    typedef int v8i_t __attribute__((ext_vector_type(8))); typedef short v16s_a16 __attribute__((ext_vector_type(16), aligned(16)));
    const int f8c = 32 * (fq >> 1) + 16 * (fq & 1);
    const int aoff8a = lds_byte(wr * 64 + fr, f8c), boff8a = lds_byte(wc * 32 + fr, f8c);
    v8i_t At8[4], Au8[4], B08[2], B18[2]; int f8scale = 127; asm volatile("" : "+v"(f8scale));
#define PG8_SA(b, h) (((b) * 2 + (h)) * HTB)
#define PG8_SB(b, h) ((4 + (b) * 2 + (h)) * HTB)
#define PG8_STAGE(bufoff, gbase, voff) do { _Pragma("unroll") for (int _i = 0; _i < 2; ++_i) \
        __builtin_amdgcn_global_load_lds((const unsigned*)((const char*)(gbase) + (voff)[_i]), (PG8_LAS unsigned*)(lds + (bufoff) + ldsw + _i * 8192), 16, 0, 0); } while (0)
#define PG8_LDA(dst, b, h) do { if constexpr (F8) { _Pragma("unroll") for (int m = 0; m < 4; ++m) { const bf16x8 lo_ = *(const PG8_LAS bf16x8*)(lds + PG8_SA(b, h) + aoff8a + m * 2048), hi_ = *(const PG8_LAS bf16x8*)(lds + PG8_SA(b, h) + aoff8a + m * 2048 + 16); dst##8[m] = __builtin_bit_cast(v8i_t, __builtin_shufflevector(lo_, hi_, 0, 1, 2, 3, 4, 5, 6, 7, 8, 9, 10, 11, 12, 13, 14, 15)); } } \
        else { _Pragma("unroll") for (int m = 0; m < 4; ++m) _Pragma("unroll") for (int k = 0; k < 2; ++k) dst[m][k] = *(const PG8_LAS bf16x8*)(lds + PG8_SA(b, h) + aoff + m * 2048 + k * 1024); } } while (0)
#define PG8_LDB(dst, b, h) do { if constexpr (F8) { _Pragma("unroll") for (int n = 0; n < 2; ++n) { const bf16x8 lo_ = *(const PG8_LAS bf16x8*)(lds + PG8_SB(b, h) + boff8a + n * 2048), hi_ = *(const PG8_LAS bf16x8*)(lds + PG8_SB(b, h) + boff8a + n * 2048 + 16); dst##8[n] = __builtin_bit_cast(v8i_t, __builtin_shufflevector(lo_, hi_, 0, 1, 2, 3, 4, 5, 6, 7, 8, 9, 10, 11, 12, 13, 14, 15)); } } \
        else { _Pragma("unroll") for (int n = 0; n < 2; ++n) _Pragma("unroll") for (int k = 0; k < 2; ++k) dst[n][k] = *(const PG8_LAS bf16x8*)(lds + PG8_SB(b, h) + boff + n * 2048 + k * 1024); } } while (0)
#define PG8_MMA(ai, bj, At, Bt) do { __builtin_amdgcn_s_setprio(1); if constexpr (F8) { _Pragma("unroll") for (int m = 0; m < 4; ++m) _Pragma("unroll") for (int n = 0; n < 2; ++n) \
            asm volatile("v_mfma_scale_f32_16x16x128_f8f6f4 %0, %1, %2, %0, %3, %3 op_sel_hi:[0,0,0]" : "+v"(acc[ai][bj][m][n]) : "v"(Bt##8[n]), "v"(At##8[m]), "v"(f8scale)); } \
        else { _Pragma("unroll") for (int m = 0; m < 4; ++m) _Pragma("unroll") for (int n = 0; n < 2; ++n) _Pragma("unroll") for (int k = 0; k < 2; ++k) \
        acc[ai][bj][m][n] = __builtin_amdgcn_mfma_f32_16x16x32_bf16(Bt[n][k], At[m][k], acc[ai][bj][m][n], 0, 0, 0); } __builtin_amdgcn_s_setprio(0); } while (0)
#define PG8_WAIT_V(n) asm volatile("s_waitcnt vmcnt(" #n ")" ::: "memory")
#define PG8_WAIT_L(n) asm volatile("s_waitcnt lgkmcnt(" #n ")" ::: "memory")
#define PG8_BAR __builtin_amdgcn_s_barrier()
#define PG8_SCHED __builtin_amdgcn_sched_barrier(0)
    Unit cur, nxt; int ui = 0;
    if (!S.next(0, cur)) return;
    f32x4 acc[2][2][4][2];
#pragma unroll
    for (int a = 0; a < 2; ++a)
#pragma unroll
        for (int b = 0; b < 2; ++b)
#pragma unroll
            for (int m = 0; m < 4; ++m)
#pragma unroll
                for (int n = 0; n < 2; ++n) acc[a][b][m][n] = (f32x4){0.f, 0.f, 0.f, 0.f};
    bf16x8 At[4][2], Au[4][2], B0[2][2], B1[2][2];
    const char* cA = (const char*)g.A + (GATHER ? (size_t)0 : (size_t)cur.pm * tstep); PG8_GFETCH(vAc0, vAc1, 0); const char* cB = (const char*)g.Bt + (size_t)cur.e * g.bstride + (size_t)cur.pn * tstep;
    S.a_ready(cur);
    if constexpr (SP2) {
        PG8_STAGE(PG8_SB(0, 0), cB, voffB); PG8_STAGE(PG8_SB(0, 1), cB + hstep, voffB); PG8_STAGE(PG8_SA(0, 0), cA, vAc0); PG8_STAGE(PG8_SA(0, 1), cA + hstepA, vAc1);
        if (wr == 1) PG8_BAR;
        PG8_WAIT_V(2); PG8_BAR;
        PG8_STAGE(PG8_SB(1, 0), cB + kstep, voffB); PG8_STAGE(PG8_SA(1, 0), cA + kstep, vAc0); PG8_STAGE(PG8_SB(1, 1), cB + hstep + kstep, voffB);
        PG8_WAIT_V(6); PG8_BAR;
    } else {
        PG8_STAGE(PG8_SB(0, 0), cB, voffB); PG8_STAGE(PG8_SA(0, 0), cA, voffA); PG8_STAGE(PG8_SB(0, 1), cB + hstep, voffB); PG8_STAGE(PG8_SA(0, 1), cA + hstep, voffA);
        if (wr == 1) PG8_BAR;
        PG8_WAIT_V(4); PG8_BAR;
        PG8_STAGE(PG8_SB(1, 0), cB + kstep, voffB); PG8_STAGE(PG8_SA(1, 0), cA + kstep, voffA); PG8_STAGE(PG8_SB(1, 1), cB + hstep + kstep, voffB);
        PG8_WAIT_V(6); PG8_BAR;
    }
    for (;;) {
        const bool has_next = S.next(ui + 1, nxt);
        const char* nA = (has_next && !GATHER) ? (const char*)g.A + (size_t)nxt.pm * tstep : cA;
        if constexpr (GATHER) { if (has_next) PG8_GFETCH(vAn0, vAn1, ui + 1); else { vAn0[0] = vAc0[0]; vAn0[1] = vAc0[1]; vAn1[0] = vAc1[0]; vAn1[1] = vAc1[1]; } }
        const char* nB = has_next ? (const char*)g.Bt + (size_t)nxt.e * g.bstride + (size_t)nxt.pn * tstep : cB;
#pragma unroll 1
        for (int t = 0; t < nt; t += 2) {
            const bool last = (t == nt - 2);
            const char* a1 = cA + (size_t)(t + 1) * kstep;
            const char* a2 = last ? nA : cA + (size_t)(t + 2) * kstep; const char* b2 = last ? nB : cB + (size_t)(t + 2) * kstep;
            const char* a3 = a2 + kstep; const char* b3 = b2 + kstep;
            if (last && has_next) S.a_ready(nxt);
            unsigned vS0[2], vS1[2];
            vS0[0] = last ? vAn0[0] : vAc0[0]; vS0[1] = last ? vAn0[1] : vAc0[1]; vS1[0] = last ? vAn1[0] : vAc1[0]; vS1[1] = last ? vAn1[1] : vAc1[1];
            if constexpr (SP2) {
            PG8_LDB(B0, 0, 0); PG8_LDB(B1, 0, 1); PG8_SCHED; PG8_LDA(At, 0, 0); PG8_STAGE(PG8_SA(1, 1), a1 + hstepA, vAc1);
            PG8_WAIT_V(8); PG8_WAIT_L(0); PG8_BAR; PG8_MMA(0, 0, At, B0); PG8_MMA(0, 1, At, B1); PG8_BAR; PG8_SCHED;
            if constexpr (F8) { PG8_LDA(Au, 0, 1); } else { PG8_LDA(At, 0, 1); } PG8_STAGE(PG8_SB(0, 0), b2, voffB); PG8_STAGE(PG8_SB(0, 1), b2 + hstep, voffB); PG8_STAGE(PG8_SA(0, 0), a2, vS0);
            PG8_WAIT_V(8); PG8_WAIT_L(0); PG8_BAR; if constexpr (F8) { PG8_MMA(1, 0, Au, B0); PG8_MMA(1, 1, Au, B1); } else { PG8_MMA(1, 0, At, B0); PG8_MMA(1, 1, At, B1); } PG8_BAR; PG8_SCHED;
            PG8_LDB(B0, 1, 0); PG8_LDB(B1, 1, 1); PG8_SCHED; PG8_LDA(At, 1, 0); PG8_STAGE(PG8_SA(0, 1), a2 + hstepA, vS1);
            PG8_WAIT_V(8); PG8_WAIT_L(0); PG8_BAR; PG8_MMA(0, 0, At, B0); PG8_MMA(0, 1, At, B1); PG8_BAR; PG8_SCHED;
            if constexpr (F8) { PG8_LDA(Au, 1, 1); } else { PG8_LDA(At, 1, 1); } PG8_STAGE(PG8_SB(1, 0), b3, voffB); PG8_STAGE(PG8_SB(1, 1), b3 + hstep, voffB); PG8_STAGE(PG8_SA(1, 0), a3, vS0);
            PG8_WAIT_V(8); PG8_WAIT_L(0); PG8_BAR; if constexpr (F8) { PG8_MMA(1, 0, Au, B0); PG8_MMA(1, 1, Au, B1); } else { PG8_MMA(1, 0, At, B0); PG8_MMA(1, 1, At, B1); } PG8_BAR; PG8_SCHED;
            } else {
            PG8_LDB(B0, 0, 0); PG8_SCHED; PG8_LDA(At, 0, 0); PG8_STAGE(PG8_SA(1, 1), a1 + hstep, voffA);
            PG8_WAIT_L(8); PG8_BAR; PG8_WAIT_L(0); PG8_MMA(0, 0, At, B0); PG8_BAR; PG8_SCHED;
            PG8_LDB(B1, 0, 1); PG8_STAGE(PG8_SB(0, 0), b2, voffB);
            PG8_BAR; PG8_WAIT_L(0); PG8_MMA(0, 1, At, B1); PG8_BAR;
            PG8_LDA(At, 0, 1); PG8_STAGE(PG8_SA(0, 0), a2, voffA);
            PG8_BAR; PG8_WAIT_L(0); PG8_MMA(1, 0, At, B0); PG8_BAR; PG8_SCHED;
            PG8_STAGE(PG8_SB(0, 1), b2 + hstep, voffB);
            PG8_WAIT_V(6); PG8_BAR; PG8_MMA(1, 1, At, B1); PG8_BAR;
            PG8_LDB(B0, 1, 0); PG8_SCHED; PG8_LDA(At, 1, 0); PG8_STAGE(PG8_SA(0, 1), a2 + hstep, voffA);
            PG8_WAIT_L(8); PG8_BAR; PG8_WAIT_L(0); PG8_MMA(0, 0, At, B0); PG8_BAR; PG8_SCHED;
            PG8_LDB(B1, 1, 1); PG8_STAGE(PG8_SB(1, 0), b3, voffB);
            PG8_BAR; PG8_WAIT_L(0); PG8_MMA(0, 1, At, B1); PG8_BAR;
            PG8_LDA(At, 1, 1); PG8_STAGE(PG8_SA(1, 0), a3, voffA);
            PG8_BAR; PG8_WAIT_L(0); PG8_MMA(1, 0, At, B0); PG8_BAR; PG8_SCHED;
            PG8_STAGE(PG8_SB(1, 1), b3 + hstep, voffB);
            PG8_WAIT_V(6); PG8_BAR; PG8_MMA(1, 1, At, B1); PG8_BAR;
            }
        }
        if constexpr (ALIGN_EPI) { if (wr == 0) PG8_BAR; }
        if constexpr (F8) asm volatile("s_nop 15\n\ts_nop 15" ::: "memory");
        if constexpr (!Epi::AFTER_DRAIN) { E(acc, cur, wr, wc, fr, fq); S.done(cur); }
        if (!has_next) break;
#pragma unroll
        for (int a = 0; a < 2; ++a)
#pragma unroll
            for (int b = 0; b < 2; ++b)
#pragma unroll
                for (int m = 0; m < 4; ++m)
#pragma unroll
                    for (int n = 0; n < 2; ++n) acc[a][b][m][n] = (f32x4){0.f, 0.f, 0.f, 0.f};
        cur = nxt; cA = nA; cB = nB; ++ui;
        if constexpr (GATHER) { vAc0[0] = vAn0[0]; vAc0[1] = vAn0[1]; vAc1[0] = vAn1[0]; vAc1[1] = vAn1[1]; }
        if constexpr (ALIGN_EPI) { if (wr == 1) PG8_BAR; }
    }
    PG8_WAIT_V(0);
    if constexpr (!ALIGN_EPI) { if (wr == 0) PG8_BAR; }
    PG8_BAR;
    if constexpr (Epi::AFTER_DRAIN) { E.fused(acc, cur, wr, wc, fr, fq, lds, wid, lane); S.done(cur); }
#undef PG8_SA
#undef PG8_SB
#undef PG8_STAGE
#undef PG8_LDA
#undef PG8_LDB
#undef PG8_MMA
#undef PG8_WAIT_V
#undef PG8_WAIT_L
#undef PG8_BAR
#undef PG8_SCHED
#undef PG8_GFETCH
}
}
#include <hip/hip_bf16.h>
#include <cmath>
namespace attn_body {
using bf16=__hip_bfloat16;
using bf16x8=__attribute__((ext_vector_type(8)))short;
using s16x4=__attribute__((ext_vector_type(4)))short;
using f32x16=__attribute__((ext_vector_type(16)))float;
using u32x4=__attribute__((ext_vector_type(4)))unsigned;
constexpr int D=64,DM=1024,KVP=256;
constexpr int NW=8,QBLK=32,QB=QBLK*NW,KVBLK=64;
__device__ __forceinline__ int crow(int r,int hi){return (r&3)+8*(r>>2)+4*hi;}
#define SBAR() __builtin_amdgcn_sched_barrier(0)
__device__ __forceinline__ void cmask(f32x16&p0,f32x16&p1,int jb,int qrel,int hi){
  const float NEG=-INFINITY; int kb=64*jb+4*hi;
  #pragma unroll
  for(int r=0;r<16;++r){int kv=kb+(r&3)+8*(r>>2); if(kv>qrel)p0[r]=NEG; if(kv+32>qrel)p1[r]=NEG;}
}

constexpr int NSLOT=3, SLOTB=8192;
constexpr int LDS_K=0, LDS_V=NSLOT*SLOTB, LDS_WS=2*NSLOT*SLOTB, LDS_OST=LDS_WS+NW*64*4, LDS_BYTES=LDS_OST+NW*4096;
constexpr float C2=0.125f*1.4426950408889634f;
__device__ __forceinline__ void glds16(const void*gsrc,unsigned lds_dst){unsigned keep;
  asm volatile("s_mov_b32 %0, m0\n\ts_mov_b32 m0, %2\n\ts_nop 0\n\tglobal_load_lds_dwordx4 %1, off\n\ts_mov_b32 m0, %0":"=&s"(keep):"v"(gsrc),"s"(lds_dst):"memory");}
__device__ __forceinline__ float max3f(float a,float b,float c){float r;asm("v_max3_f32 %0, %1, %2, %3":"=v"(r):"v"(a),"v"(b),"v"(c));return r;}
__device__ __forceinline__ float max2f(float a,float b){float r;asm("v_max_f32_e32 %0, %1, %2":"=v"(r):"v"(a),"v"(b));return r;}
__device__ __forceinline__ float fadd_s(float a,float b){float r;asm("v_add_f32_e32 %0, %1, %2":"=v"(r):"v"(a),"v"(b));return r;}
__device__ __forceinline__ float fsub_s(float a,float b){float r;asm("v_sub_f32_e32 %0, %1, %2":"=v"(r):"v"(a),"v"(b));return r;}
typedef float f32x2_t __attribute__((ext_vector_type(2))); typedef __bf16 bf16x2_t __attribute__((ext_vector_type(2)));
__device__ __forceinline__ unsigned cvtpk_s(float lo,float hi){f32x2_t v={lo,hi};bf16x2_t b=__builtin_convertvector(v,bf16x2_t);return __builtin_bit_cast(unsigned,b);}
#define WAIT_BAR(N) asm volatile("s_waitcnt vmcnt(" #N ") lgkmcnt(0)\n\ts_barrier":::"memory")

__device__ __forceinline__ void qkt(f32x16&p0,f32x16&p1,const char*Kslot,const bf16x8*qr,const f32x16&negm,int r32,int hi){
  const char*kb=Kslot+hi*1024+r32*16;
  #pragma unroll
  for(int d0=0;d0<4;++d0){
    const bf16x8 b0=*reinterpret_cast<const bf16x8*>(kb+d0*2048);
    const bf16x8 b1=*reinterpret_cast<const bf16x8*>(kb+d0*2048+512);
    if(d0==0){p0=__builtin_amdgcn_mfma_f32_32x32x16_bf16(b0,qr[0],negm,0,0,0);p1=__builtin_amdgcn_mfma_f32_32x32x16_bf16(b1,qr[0],negm,0,0,0);}
    else{p0=__builtin_amdgcn_mfma_f32_32x32x16_bf16(b0,qr[d0],p0,0,0,0);p1=__builtin_amdgcn_mfma_f32_32x32x16_bf16(b1,qr[d0],p1,0,0,0);}}
}
typedef __attribute__((address_space(3))) const char* lds_cptr;
typedef short v4i16_t __attribute__((ext_vector_type(4)));
__device__ __forceinline__ void kload8(bf16x8*kf,lds_cptr kp){
  kf[0]=*(const __attribute__((address_space(3))) bf16x8*)(kp);      kf[1]=*(const __attribute__((address_space(3))) bf16x8*)(kp+512);
  kf[2]=*(const __attribute__((address_space(3))) bf16x8*)(kp+2048); kf[3]=*(const __attribute__((address_space(3))) bf16x8*)(kp+2560);
  kf[4]=*(const __attribute__((address_space(3))) bf16x8*)(kp+4096); kf[5]=*(const __attribute__((address_space(3))) bf16x8*)(kp+4608);
  kf[6]=*(const __attribute__((address_space(3))) bf16x8*)(kp+6144); kf[7]=*(const __attribute__((address_space(3))) bf16x8*)(kp+6656);
}
__device__ __forceinline__ void kload2(bf16x8*kf,lds_cptr kp,int j){ kf[2*j]=*(const __attribute__((address_space(3))) bf16x8*)(kp+j*2048); kf[2*j+1]=*(const __attribute__((address_space(3))) bf16x8*)(kp+j*2048+512); }
__device__ __forceinline__ s16x4 vtr(lds_cptr p){ return __builtin_bit_cast(s16x4,__builtin_amdgcn_ds_read_tr16_b64_v4i16((__attribute__((address_space(3))) v4i16_t*)p)); }
__device__ __forceinline__ float rowmax(const f32x16&p0,const f32x16&p1){
  float a=max3f(p0[0],p0[1],p1[0]),b=max3f(p0[2],p0[3],p1[1]);a=max3f(a,p1[2],p1[3]);
  #pragma unroll
  for(int r=4;r<16;r+=4){a=max3f(a,p0[r],p0[r+1]);b=max3f(b,p0[r+2],p0[r+3]);a=max3f(a,p1[r],p1[r+1]);b=max3f(b,p1[r+2],p1[r+3]);}
  const float m=max2f(a,b);
  auto rr=__builtin_amdgcn_permlane32_swap(__float_as_uint(m),__float_as_uint(m),false,false);
  return max2f(__uint_as_float(rr[0]),__uint_as_float(rr[1]));
}
__device__ __forceinline__ void pv(f32x16*o,int vb,bf16x8 pa0,bf16x8 pa1,bf16x8 pa2,bf16x8 pa3){
  #pragma unroll
  for(int d0=0;d0<2;++d0){s16x4 lo[4],hi[4];
    #pragma unroll
    for(int ks=0;ks<4;++ks){
      asm volatile("ds_read_b64_tr_b16 %0,%1 offset:%c2":"=&v"(lo[ks]):"v"(vb),"i"(d0*4096+ks*1024):"memory");
      asm volatile("ds_read_b64_tr_b16 %0,%1 offset:%c2":"=&v"(hi[ks]):"v"(vb),"i"(d0*4096+ks*1024+512):"memory");}
    asm volatile("s_waitcnt lgkmcnt(0)":::"memory");SBAR();
    #define PK(k) (bf16x8){lo[k][0],lo[k][1],lo[k][2],lo[k][3],hi[k][0],hi[k][1],hi[k][2],hi[k][3]}
    o[d0]=__builtin_amdgcn_mfma_f32_32x32x16_bf16(pa0,PK(0),o[d0],0,0,0);
    o[d0]=__builtin_amdgcn_mfma_f32_32x32x16_bf16(pa1,PK(1),o[d0],0,0,0);
    o[d0]=__builtin_amdgcn_mfma_f32_32x32x16_bf16(pa2,PK(2),o[d0],0,0,0);
    o[d0]=__builtin_amdgcn_mfma_f32_32x32x16_bf16(pa3,PK(3),o[d0],0,0,0);
    #undef PK
  }
}

#ifndef ATTN_STORE16
#define ATTN_STORE16(p,v) (*(u32x4*)(p)=(v))
#endif
template<int THRL> __device__ __forceinline__ void attn_unit(long qrow0,long kvrow0,int NT,int h,const bf16*Q,const bf16*__restrict__ K,const bf16*__restrict__ V,bf16*O,char*shm,int tid_in){
  int tid_l=tid_in; asm volatile("":"+v"(tid_l)); const int tid=tid_l,lane=tid&63,r32=lane&31,hi=lane>>5; const int wid=__builtin_amdgcn_readfirstlane(tid>>6);
  const bf16*Qw=Q+(qrow0+wid*QBLK)*DM+h*D;
  const bf16*Kh=K+kvrow0*KVP+(h>>2)*D,*Vh=V+kvrow0*KVP+(h>>2)*D;
  const unsigned lds0=(unsigned)(uintptr_t)shm;
  float*wsf=(float*)(shm+LDS_WS)+wid*64;
  const bf16*ksrc=Kh+(long)lane*KVP+wid*8;
  const bf16*vsrc=Vh+(long)(16*(wid&3)+(lane>>2))*KVP+(wid>>2)*32+(lane&3)*8;
  const unsigned kdst=lds0+LDS_K+wid*1024, vdst=lds0+LDS_V+wid*1024;
  #define DMA_K(t,slot) glds16(ksrc+(long)(t)*KVBLK*KVP,(unsigned)__builtin_amdgcn_readfirstlane(kdst+(slot)))
  #define DMA_V(t,slot) glds16(vsrc+(long)(t)*KVBLK*KVP,(unsigned)__builtin_amdgcn_readfirstlane(vdst+(slot)))
  const int vb0=(int)(lds0+LDS_V)+((lane>>4)&1)*32+(lane&3)*8+(4*hi+((lane&15)>>2))*64;
  const char*Kbase=shm+LDS_K; bf16x8 kf[8];
  const lds_cptr shm3=(lds_cptr)shm; const lds_cptr kp0=shm3+LDS_K+hi*1024+r32*16; const lds_cptr vp0=shm3+LDS_V+((lane>>4)&1)*32+(lane&3)*8+(4*hi+((lane&15)>>2))*64;
  DMA_K(0,0);DMA_V(0,0);DMA_K(1,SLOTB);
  bf16x8 qr[4];
  #pragma unroll
  for(int d0=0;d0<4;++d0)qr[d0]=*reinterpret_cast<const bf16x8*>(&Qw[(long)r32*DM+d0*16+hi*8]);
  float mhat=0.f,l_reg=0.f;f32x16 o[2];o[0]=f32x16{};o[1]=f32x16{};f32x16 negm=f32x16{};asm volatile("":"+v"(negm));
  #define CMASK(P0,P1,t) do{}while(0)
  bool resc=false;
  #define START(P0,P1) do{ const float rm=rowmax(P0,P1); resc=false; \
    { const float dl=rm; mhat=fadd_s(mhat,dl); \
      _Pragma("unroll") for(int r=0;r<16;++r){P0[r]=fsub_s(P0[r],dl);P1[r]=fsub_s(P1[r],dl);} \
      _Pragma("unroll") for(int r=0;r<16;++r)negm[r]=-mhat; asm volatile("":"+v"(negm)); } \
    _Pragma("unroll") for(int r=0;r<16;++r)P0[r]=__builtin_amdgcn_exp2f(P0[r]); }while(0)
  #define RESC() do{ if(resc){ asm volatile("s_waitcnt lgkmcnt(0)":::"memory"); \
      _Pragma("unroll") for(int d_=0;d_<2;++d_) _Pragma("unroll") for(int r=0;r<16;++r)o[d_][r]*=wsf[crow(r,hi)]; } }while(0)
  f32x16 pA0,pA1,pB0,pB1;
  int sl_prev=0,sl_cur=0,sl_next=SLOTB;
  #define ROT() do{sl_prev=sl_cur;sl_cur=sl_next;sl_next=(sl_next==(NSLOT-1)*SLOTB)?0:sl_next+SLOTB;}while(0)
  DMA_K(2,2*SLOTB);
  WAIT_BAR(3);
  qkt(pA0,pA1,Kbase,qr,negm,r32,hi);asm volatile("s_nop 15\n\ts_nop 7":"+v"(pA0),"+v"(pA1));CMASK(pA0,pA1,0);
  START(pA0,pA1);
  _Pragma("unroll") for(int r=0;r<16;++r)pA1[r]=__builtin_amdgcn_exp2f(pA1[r]);
  WAIT_BAR(0);
  DMA_K(3,0);DMA_V(1,SLOTB);
  ROT();
  kload8(kf,kp0+sl_cur);
  WAIT_BAR(2);
  s16x4 vlo[8],vhi[8]; u32x4 pw0,pw1,pw2,pw3;
  #define PKW(P,B) cvtpk_s(P[B],P[B+1])
  #define PAF(k) __builtin_bit_cast(bf16x8,pw##k)
  #define VFR(i) (bf16x8){vlo[i][0],vlo[i][1],vlo[i][2],vlo[i][3],vhi[i][0],vhi[i][1],vhi[i][2],vhi[i][3]}
  #define PIN(x) asm volatile("":"+v"(x))
  #define MX3(a,b,c) __builtin_fmaxf(__builtin_fmaxf((a),(b)),(c))
  #define GAPA(MF,A0,A1,A2,A3,W0,W1,PW) do{ MF; sacc+=A0; sacc+=A1; sacc+=A2; sacc+=A3; PIN(sacc); W0; W1; PIN(PW); SBAR(); }while(0)
  #define EX(v) __builtin_amdgcn_exp2f(v)
  #define GAPB(MF,X,B) do{ MF; X[B]=EX(X[B]); X[B+1]=EX(X[B+1]); X[B+2]=EX(X[B+2]); X[B+3]=EX(X[B+3]); PIN(X); SBAR(); }while(0)
  #define VRD(i) do{ vlo[i]=vtr(vp_+(((i)>>2)*4096+((i)&3)*1024)); vhi[i]=vtr(vp_+(((i)>>2)*4096+((i)&3)*1024+512)); }while(0)
  #define KRD(G,j) do{ if(G){ kload2(kf,kp0+sl_next,j); SBAR(); } }while(0)
  #define STEP(C0,C1,P0,P1,t,GK,GV,GL) do{ SBAR(); \
    const lds_cptr vp_=vp0+sl_prev; \
    VRD(0); SBAR(); float sacc=(P0[0]+P0[1]); \
    GAPA(C0=__builtin_amdgcn_mfma_f32_32x32x16_bf16(kf[0],qr[0],negm,0,0,0), P0[2],P0[3],P0[4],P0[5],     pw0[0]=PKW(P0,0), pw0[1]=PKW(P0,2), pw0); \
    VRD(4); SBAR(); GAPA(C1=__builtin_amdgcn_mfma_f32_32x32x16_bf16(kf[1],qr[0],negm,0,0,0), P0[6],P0[7],P0[8],P0[9],     pw0[2]=PKW(P0,4), pw0[3]=PKW(P0,6), pw0); \
    VRD(1); SBAR(); GAPA(C0=__builtin_amdgcn_mfma_f32_32x32x16_bf16(kf[2],qr[1],C0,0,0,0),   P0[10],P0[11],P0[12],P0[13], pw1[0]=PKW(P0,8), pw1[1]=PKW(P0,10), pw1); \
    VRD(5); SBAR(); GAPA(C1=__builtin_amdgcn_mfma_f32_32x32x16_bf16(kf[3],qr[1],C1,0,0,0),   P0[14],P0[15],P1[0],P1[1],   pw1[2]=PKW(P0,12),pw1[3]=PKW(P0,14), pw1); \
    VRD(2); SBAR(); GAPA(C0=__builtin_amdgcn_mfma_f32_32x32x16_bf16(kf[4],qr[2],C0,0,0,0),   P1[2],P1[3],P1[4],P1[5],     pw2[0]=PKW(P1,0), pw2[1]=PKW(P1,2), pw2); \
    VRD(6); SBAR(); GAPA(C1=__builtin_amdgcn_mfma_f32_32x32x16_bf16(kf[5],qr[2],C1,0,0,0),   P1[6],P1[7],P1[8],P1[9],     pw2[2]=PKW(P1,4), pw2[3]=PKW(P1,6), pw2); \
    VRD(3); SBAR(); GAPA(C0=__builtin_amdgcn_mfma_f32_32x32x16_bf16(kf[6],qr[3],C0,0,0,0),   P1[10],P1[11],P1[12],P1[13], pw3[0]=PKW(P1,8), pw3[1]=PKW(P1,10), pw3); \
    VRD(7); SBAR(); GAPA(C1=__builtin_amdgcn_mfma_f32_32x32x16_bf16(kf[7],qr[3],C1,0,0,0),   P1[14],P1[15],0.f,0.f,       pw3[2]=PKW(P1,12),pw3[3]=PKW(P1,14), pw3); \
    l_reg+=sacc; \
    if(GK){DMA_K((t)+3,sl_cur);} if(GV){DMA_V((t)+1,sl_next);} \
    CMASK(C0,C1,t); \
    { float a=MX3(C0[0],C0[1],C1[0]),b=MX3(C0[2],C0[3],C1[1]); a=MX3(a,C1[2],C1[3]); \
      _Pragma("unroll") for(int r=4;r<16;r+=4){a=MX3(a,C0[r],C0[r+1]);b=MX3(b,C0[r+2],C0[r+3]);a=MX3(a,C1[r],C1[r+1]);b=MX3(b,C1[r+2],C1[r+3]);} \
      float rm=__builtin_fmaxf(a,b); { auto rr=__builtin_amdgcn_permlane32_swap(__float_as_uint(rm),__float_as_uint(rm),false,false); rm=__builtin_fmaxf(__uint_as_float(rr[0]),__uint_as_float(rr[1])); } \
      resc=false; \
      if(__builtin_expect(__any(rm>(float)THRL),0)){ const float dl=__builtin_fmaxf(rm,0.f); mhat+=dl; \
        _Pragma("unroll") for(int r=0;r<16;++r){C0[r]-=dl;C1[r]-=dl;} \
        _Pragma("unroll") for(int r=0;r<16;++r)negm[r]=-mhat; asm volatile("":"+v"(negm)); \
        const float f=__builtin_amdgcn_exp2f(-dl); l_reg*=f; if(hi==0)wsf[r32]=f; resc=true; } } \
    SBAR(); \
    GAPB(o[0]=__builtin_amdgcn_mfma_f32_32x32x16_bf16(PAF(0),VFR(0),o[0],0,0,0), C0,0); \
    GAPB(o[1]=__builtin_amdgcn_mfma_f32_32x32x16_bf16(PAF(0),VFR(4),o[1],0,0,0), C0,4); \
    KRD(GL,0); GAPB(o[0]=__builtin_amdgcn_mfma_f32_32x32x16_bf16(PAF(1),VFR(1),o[0],0,0,0), C0,8); \
    KRD(GL,1); GAPB(o[1]=__builtin_amdgcn_mfma_f32_32x32x16_bf16(PAF(1),VFR(5),o[1],0,0,0), C0,12); \
    KRD(GL,2); GAPB(o[0]=__builtin_amdgcn_mfma_f32_32x32x16_bf16(PAF(2),VFR(2),o[0],0,0,0), C1,0); \
    KRD(GL,3); GAPB(o[1]=__builtin_amdgcn_mfma_f32_32x32x16_bf16(PAF(2),VFR(6),o[1],0,0,0), C1,4); \
    GAPB(o[0]=__builtin_amdgcn_mfma_f32_32x32x16_bf16(PAF(3),VFR(3),o[0],0,0,0), C1,8); \
    GAPB(o[1]=__builtin_amdgcn_mfma_f32_32x32x16_bf16(PAF(3),VFR(7),o[1],0,0,0), C1,12); \
    }while(0)
  int t=1;
  #undef CMASK
  #define CMASK(P0,P1,t) do{}while(0)
  for(;t+5<NT;t+=2){
    STEP(pB0,pB1,pA0,pA1,t,true,true,true);     WAIT_BAR(2); RESC(); ROT();
    STEP(pA0,pA1,pB0,pB1,t+1,true,true,true);   WAIT_BAR(2); RESC(); ROT();
  }
  #undef CMASK
  #define CMASK(P0,P1,t) do{}while(0)
  #define ENDW(tt) do{ if((tt)+3<NT){WAIT_BAR(2);} else if((tt)+2<NT){WAIT_BAR(1);} else {WAIT_BAR(0);} }while(0)
  for(;t+1<NT;t+=2){
    STEP(pB0,pB1,pA0,pA1,t,(t+3<NT),(t+1<NT),(t+1<NT));       ENDW(t);   RESC(); ROT();
    STEP(pA0,pA1,pB0,pB1,t+1,(t+4<NT),(t+2<NT),(t+2<NT));     ENDW(t+1); RESC(); ROT();
  }
  STEP(pB0,pB1,pA0,pA1,NT-1,false,false,false); RESC();
  { float sacc=pB0[0]+pB0[1]; _Pragma("unroll") for(int r=2;r<16;++r)sacc+=pB0[r]; _Pragma("unroll") for(int r=0;r<16;++r)sacc+=pB1[r]; l_reg+=sacc;
    pw0=(u32x4){PKW(pB0,0),PKW(pB0,2),PKW(pB0,4),PKW(pB0,6)};pw1=(u32x4){PKW(pB0,8),PKW(pB0,10),PKW(pB0,12),PKW(pB0,14)};pw2=(u32x4){PKW(pB1,0),PKW(pB1,2),PKW(pB1,4),PKW(pB1,6)};pw3=(u32x4){PKW(pB1,8),PKW(pB1,10),PKW(pB1,12),PKW(pB1,14)};
    SBAR(); pv(o,vb0+sl_cur,PAF(0),PAF(1),PAF(2),PAF(3)); }
  #undef PKW
  #undef PAF
  #undef VFR
  #undef PIN
  #undef MX3
  #undef GAPA
  #undef GAPB
  #undef EX
  #undef VRD
  #undef KRD
  #undef STEP
  #undef ENDW
  {auto rr=__builtin_amdgcn_permlane32_swap(__float_as_uint(l_reg),__float_as_uint(l_reg),false,false);l_reg=__uint_as_float(rr[0])+__uint_as_float(rr[1]);}
  if(hi==0)wsf[32+r32]=l_reg;asm volatile("s_waitcnt lgkmcnt(0)":::"memory");
  float rli[16];
  #pragma unroll
  for(int r=0;r<16;++r)rli[r]=__builtin_amdgcn_rcpf(wsf[32+crow(r,hi)]);
  bf16*Ow=O+(qrow0+wid*QBLK)*DM+h*D;
  { bf16*stg=(bf16*)(shm+LDS_OST)+wid*2048;
    #pragma unroll
    for(int r=0;r<16;++r){const int orow=crow(r,hi);
      #pragma unroll
      for(int d0=0;d0<2;++d0)stg[orow*64+d0*32+r32]=__float2bfloat16(o[d0][r]*rli[r]);}
    asm volatile("s_waitcnt lgkmcnt(0)":::"memory");
    #pragma unroll
    for(int i=0;i<4;++i){const int row=i*8+(lane>>3),ch=lane&7; const u32x4 v=*(const u32x4*)(stg+row*64+ch*8);
      #define O8C(x_) __builtin_amdgcn_fmed3f((x_)*32.f,-448.f,448.f)
      int w0=0,w1=0; w0=__builtin_amdgcn_cvt_pk_fp8_f32(O8C(__uint_as_float(v[0]<<16)),O8C(__uint_as_float(v[0]&0xffff0000u)),w0,false); w0=__builtin_amdgcn_cvt_pk_fp8_f32(O8C(__uint_as_float(v[1]<<16)),O8C(__uint_as_float(v[1]&0xffff0000u)),w0,true);
      w1=__builtin_amdgcn_cvt_pk_fp8_f32(O8C(__uint_as_float(v[2]<<16)),O8C(__uint_as_float(v[2]&0xffff0000u)),w1,false); w1=__builtin_amdgcn_cvt_pk_fp8_f32(O8C(__uint_as_float(v[3]<<16)),O8C(__uint_as_float(v[3]&0xffff0000u)),w1,true);
      #undef O8C
      *(unsigned long long*)((unsigned char*)O+((long)(qrow0+wid*QBLK+row))*DM+h*D+ch*8)=(unsigned long long)(unsigned)w0|((unsigned long long)(unsigned)w1<<32);} }
  asm volatile("s_waitcnt lgkmcnt(0)\n\ts_barrier":::"memory");
  #undef DMA_K
  #undef DMA_V
  #undef CMASK
  #undef START
  #undef RESC
  #undef ROT
}
constexpr int ATTN_LDS_BYTES=LDS_BYTES;
#undef SBAR
#undef WAIT_BAR
}

constexpr int NWAVES = 8;
constexpr int NB = 8, SEQ = 4096, CTXL = 256, TB = SEQ + CTXL  , MT = NB * TB  , DMODEL = 1024;
constexpr int NMODC = 6 * DMODEL, MODROWS = 9;
constexpr int QKVN = 1536, WINN = 3104, WINP = 3328;
constexpr int NEXP = 32, TOPK = 4, MPAD = MT * TOPK + NEXP * 256;
constexpr int NLAYER = 4;
constexpr float RMS_EPS = 1e-6f;
constexpr float ATT_C2 = 0.125f * 1.4426950408889634f;

constexpr size_t MiB = 1u << 20;
constexpr size_t WS_CTL = 0, CTL_ZERO_BYTES = 1 * MiB;
constexpr size_t WS_MOD = 1 * MiB, WS_ROPE = 2 * MiB, WS_MODP = 3 * MiB;
constexpr size_t WS_SLOT = 17 * MiB, WS_GATEW = 18 * MiB, WS_SLOTPOS = 19 * MiB;
constexpr size_t WS_WQKV = 20 * MiB, WS_WOA = 26 * MiB, WS_WIN = 30 * MiB, WS_WOG = 43 * MiB, WS_WGU = 48 * MiB, WS_WDN = 560 * MiB;
constexpr size_t WS_X = 816 * MiB, WS_XN = 952 * MiB, WS_Q = 1020 * MiB, WS_K = 1088 * MiB, WS_V = 1105 * MiB, WS_G = 1122 * MiB;
constexpr size_t WS_OF = 1343 * MiB, WS_OB = 1479 * MiB, WS_XG = 1615 * MiB, WS_ACT = 1903 * MiB, WS_Y = 2191 * MiB, WS_XN8 = WS_ACT + 150 * MiB  , WS_PAR = 2479 * MiB, WS_LIST = 2483 * MiB  , WS_END = 2488 * MiB;
static_assert(WS_MODP + (size_t)16 * NLAYER * MODROWS * NMODC * 4 <= WS_SLOT && WS_WIN + (size_t)2 * WINP * 1024 * 2 <= WS_WOG && WS_G + (size_t)MT * WINP * 2 <= WS_OF && WS_XG + (size_t)MPAD * 1024 * 2 <= WS_ACT, "ws map");
constexpr int CW_TMO = 0, CW_BAR = 4096, CW_CNT = 16384;

constexpr int RING_OFF = 0, RING_BYTES = 131072;
constexpr int WR_STRIDE = 1028;
constexpr int LDS_AUX = 133120;
constexpr int AUX_LCNT = LDS_AUX, AUX_GB = LDS_AUX + 128, AUX_T2E = LDS_AUX + 256  , AUX_BASE = AUX_T2E + 2560  , AUX_NT = AUX_BASE + 128, AUX_CNT = AUX_NT + 64  , AUX_ENT = AUX_CNT + 128  , AUX_RS = AUX_ENT + 4352  , AUX_ROWTAB = AUX_RS + 576, ROWTAB_UNITS = 18  ;
constexpr int MISC_OFF = 154624;
constexpr int LDS_BYTES = 155648;
static_assert(AUX_ROWTAB + ROWTAB_UNITS * 512 <= MISC_OFF, "LDS map");

#define GAS __attribute__((address_space(1)))
#define LAS __attribute__((address_space(3)))
typedef unsigned short bf16;
typedef unsigned v4u __attribute__((ext_vector_type(4)));
typedef float f32x4 __attribute__((ext_vector_type(4)));
typedef short bf16x8 __attribute__((ext_vector_type(8)));
typedef GAS unsigned gu32;
typedef GAS unsigned long long gu64;
#define RLX_AGENT __ATOMIC_RELAXED, __HIP_MEMORY_SCOPE_AGENT
#define LDS_WAIT() asm volatile("s_waitcnt lgkmcnt(0)" ::: "memory")
#define VM_WAIT() asm volatile("s_waitcnt vmcnt(0)" ::: "memory")
__device__ __forceinline__ unsigned long long rt() { return __builtin_amdgcn_s_memrealtime(); }
__device__ __forceinline__ unsigned f2bf(float f) { unsigned u = __builtin_bit_cast(unsigned, f); return (u + 0x7fffu + ((u >> 16) & 1u)) >> 16; }
typedef float pk2_f32x2 __attribute__((ext_vector_type(2))); typedef __bf16 pk2_bf16x2 __attribute__((ext_vector_type(2)));
__device__ __forceinline__ unsigned pk2(float lo, float hi) { return __builtin_bit_cast(unsigned, __builtin_convertvector((pk2_f32x2){lo, hi}, pk2_bf16x2)); }

#define XB_TMO      128
#define XB_XCNT(j)  (256  + 64 * (j))
#define XB_XSUB(j)  (1280 + 64 * (j))
#define XB_XGEN(j)  (2304 + 64 * (j))
#define XB_TOP      3328
#define XB_TOPGEN   3392
#define XCD_BAR_WORDS 3456
#define XB_SPIN_CAP (1u << 18)

__device__ __forceinline__ unsigned xb_ld(unsigned* p)              { return __hip_atomic_load(p, __ATOMIC_RELAXED, __HIP_MEMORY_SCOPE_AGENT); }
__device__ __forceinline__ unsigned xb_add(unsigned* p, unsigned v) { return __hip_atomic_fetch_add(p, v, __ATOMIC_RELAXED, __HIP_MEMORY_SCOPE_AGENT); }
__device__ __forceinline__ unsigned xb_xcc_id() { return (unsigned)__builtin_amdgcn_s_getreg((3 << 11) | 20) & 0xFu; }
#define XB_SPIN(cond, bar) do { unsigned _sp = 0; while (cond) { __builtin_amdgcn_s_sleep(1); \
    if ((++_sp & 255u) == 0u) { if (xb_ld(&(bar)[XB_TMO])) break; if (_sp > XB_SPIN_CAP) { atomicAdd(&(bar)[XB_TMO], 1u); break; } } } } while (0)

struct XcdBarrier {
    unsigned* bar; unsigned x;
    volatile LAS unsigned* st;
};

__device__ __forceinline__ XcdBarrier xcd_barrier_post(unsigned* bar, volatile LAS unsigned* st, bool xb_t0  ) {
    XcdBarrier b; b.bar = bar; b.x = xb_xcc_id(); b.st = st;
    if (xb_t0) (void)xb_add(&bar[XB_XCNT(b.x)], 1u);
    return b;
}
__device__ __forceinline__ void xcd_barrier_complete(unsigned* bar, unsigned x, unsigned& nloc, unsigned& nx) {
    const unsigned G = gridDim.x * gridDim.y * gridDim.z;
    unsigned sum, cnt, mine, sp = 0u;
    for (;;) {
        sum = 0u; cnt = 0u; mine = 0u;
#pragma unroll
        for (unsigned j = 0; j < 16; ++j) { const unsigned c = xb_ld(&bar[XB_XCNT(j)]); sum += c; cnt += (c > 0u) ? 1u : 0u; mine = (j == x) ? c : mine; }
        if (sum == G) break;
        __builtin_amdgcn_s_sleep(1);
        if ((++sp & 255u) == 0u) { if (xb_ld(&bar[XB_TMO])) break; if (sp > XB_SPIN_CAP) { atomicAdd(&bar[XB_TMO], 1u); break; } }
    }
    nloc = mine > 0u ? mine : 1u; nx = cnt > 0u ? cnt : 1u;
}

__device__ __forceinline__ void xcd_barrier(const XcdBarrier& b, bool xb_t0  ) {
    asm volatile("s_waitcnt vmcnt(0)" ::: "memory");
    __syncthreads();
    if (xb_t0) {
        unsigned* bar = b.bar;
        __builtin_amdgcn_s_waitcnt(0);
        unsigned nloc = b.st[0], nx = b.st[1];
        if (nloc == 0u) { xcd_barrier_complete(bar, b.x, nloc, nx); b.st[0] = nloc; b.st[1] = nx; }
        const unsigned old = xb_add(&bar[XB_XSUB(b.x)], 1u);
        const unsigned gen = old / nloc;
        if (old + 1u == (gen + 1u) * nloc) {
            __builtin_amdgcn_fence(__ATOMIC_RELEASE, "agent");
            asm volatile("s_waitcnt vmcnt(0)" ::: "memory");
            const unsigned og = xb_add(&bar[XB_TOP], 1u);
            const unsigned tg = og / nx;
            if (og + 1u == (tg + 1u) * nx) xb_add(&bar[XB_TOPGEN], 1u);
            else XB_SPIN(xb_ld(&bar[XB_TOPGEN]) == tg, bar);
            __builtin_amdgcn_fence(__ATOMIC_ACQUIRE, "agent");
            xb_add(&bar[XB_XGEN(b.x)], 1u);
            asm volatile("s_waitcnt vmcnt(0)" ::: "memory");
        } else {
            XB_SPIN(xb_ld(&bar[XB_XGEN(b.x)]) == gen, bar);
            __builtin_amdgcn_fence(__ATOMIC_ACQUIRE, "agent");
            asm volatile("s_waitcnt vmcnt(0)" ::: "memory");
        }
    }
    __syncthreads();
}

typedef float f32x2 __attribute__((ext_vector_type(2)));
using pg8::lane_now; using pg8::shx;
__device__ __forceinline__ float wave_sum(float v) {
    const int ln = lane_now();
#pragma unroll
    for (int o = 1; o < 64; o <<= 1) v += shx(v, o, ln);
    return v;
}
__device__ __forceinline__ float wave_max(float v) {
    const int ln = lane_now();
#pragma unroll
    for (int o = 1; o < 64; o <<= 1) v = fmaxf(v, shx(v, o, ln));
    return v;
}
__device__ __forceinline__ float bf2f(unsigned short h) { return __uint_as_float((unsigned)h << 16); }
__device__ __forceinline__ float silu_f(float x) { return x / (1.0f + __expf(-x)); }
__device__ __forceinline__ f32x4 bf4_to_f32(unsigned long long v) { return (f32x4){__uint_as_float((unsigned)(v & 0xffffu) << 16), __uint_as_float((unsigned)(v >> 16) << 16), __uint_as_float((unsigned)((v >> 32) & 0xffffu) << 16), __uint_as_float((unsigned)(v >> 48) << 16)}; }
__device__ __forceinline__ unsigned long long f32_to_bf4(f32x4 y) { return (unsigned long long)pk2(y.x, y.y) | ((unsigned long long)pk2(y.z, y.w) << 32); }
__device__ __forceinline__ int mod_row(int m) { const int b = m / TB; return (m - b * TB < CTXL) ? 8 : b; }

__device__ __forceinline__ void titem_load(const float* W, int N, int k0, int n0, int lane, f32x4 (&v)[16]) {
    const GAS f32x4* p = (const GAS f32x4*)(W + (size_t)(k0 + 16 * (lane >> 3)) * N + n0 + 4 * (lane & 7));
#pragma unroll
    for (int j = 0; j < 16; ++j) v[j] = p[(size_t)j * (N >> 2)];
}
__device__ __forceinline__ void titem_store8(const f32x4 (&v)[16], unsigned char* WT8, int K, int k0, int dst_row0, int lane) {
    unsigned char* o = WT8 + (size_t)(dst_row0 + 4 * (lane & 7)) * K + k0 + 16 * (lane >> 3);
#pragma unroll
    for (int i = 0; i < 4; ++i) { v4u q;
        q.x = pg8::pk4_fp8(v[0][i] * 32.f, v[1][i] * 32.f, v[2][i] * 32.f, v[3][i] * 32.f); q.y = pg8::pk4_fp8(v[4][i] * 32.f, v[5][i] * 32.f, v[6][i] * 32.f, v[7][i] * 32.f);
        q.z = pg8::pk4_fp8(v[8][i] * 32.f, v[9][i] * 32.f, v[10][i] * 32.f, v[11][i] * 32.f); q.w = pg8::pk4_fp8(v[12][i] * 32.f, v[13][i] * 32.f, v[14][i] * 32.f, v[15][i] * 32.f);
        *(GAS v4u*)(o + (size_t)i * K) = q; }
}
__device__ __forceinline__ void titem_store16(const f32x4 (&v)[16], bf16* WT, int K, int k0, int dst_row0, int lane) {
    bf16* o = WT + (size_t)(dst_row0 + 4 * (lane & 7)) * K + k0 + 16 * (lane >> 3);
#pragma unroll
    for (int i = 0; i < 4; ++i) { v4u q0, q1;
        q0.x = pk2(v[0][i], v[1][i]); q0.y = pk2(v[2][i], v[3][i]); q0.z = pk2(v[4][i], v[5][i]); q0.w = pk2(v[6][i], v[7][i]);
        q1.x = pk2(v[8][i], v[9][i]); q1.y = pk2(v[10][i], v[11][i]); q1.z = pk2(v[12][i], v[13][i]); q1.w = pk2(v[14][i], v[15][i]);
        *(GAS v4u*)(o + (size_t)i * K) = q0; *(GAS v4u*)(o + (size_t)i * K + 8) = q1; }
}

struct Args { const float* in[25]; float* out; unsigned char* ws; int ph_lo, ph_hi; };
constexpr int P_N1G = 0, P_N2G = 4096, P_QG = 8192, P_KG = 8320, P_GKF = 8448, P_GKB = 24832, P_BGF = 41216, P_BGB = 42240, P_OG = 43264, P_WR = 43776, P_BR = 174848, P_BGU = 174976, P_BDN = 437120, P_END = 568192;
#define LAUNDER_S(p) asm volatile("" : "+s"(p))
#define LAUNDER_V(p) asm volatile("" : "+v"(p))
#define PARF(ws) ((const float*)((ws) + WS_PAR))

constexpr int I8_GU = 128 * 8 * 64, I8_DN = 128 * 8 * 32, NI8 = I8_GU + I8_DN;
struct T8 { const float* W; unsigned char* O; int N, k0, n0, dst; };
__device__ __forceinline__ T8 dec8(const Args& A, unsigned char* ws, int it) { T8 t;
    const bool gu = it < I8_GU; const int r = gu ? it : it - I8_GU, sh = gu ? 6 : 5, mat = r >> (3 + sh), q = r & ((8 << sh) - 1), kb = q >> sh, n0 = (q & ((1 << sh) - 1)) * 32;
    t.N = gu ? 2048 : 1024; t.W = (gu ? A.in[21] : A.in[23]) + (size_t)mat * 1024 * t.N; t.O = ws + (gu ? WS_WGU : WS_WDN) + (size_t)mat * 1024 * t.N; t.k0 = kb * 128; t.n0 = n0;
    t.dst = gu ? ((n0 & 1023) >> 7) * 256 + (n0 >> 10) * 128 + (n0 & 127) : n0;
    return t; }
__device__ __forceinline__ void p0_prologue(const Args& A, LAS unsigned char* lds, int gw, int NGW, int wave, int lane) {
    unsigned char* ws = A.ws;
    { f32x4 va[16], vb[16]; int it = gw;
      if (it < NI8) { const T8 t = dec8(A, ws, it); titem_load(t.W, t.N, t.k0, t.n0, lane, va); }
      while (it + 2 * NGW < NI8) {
          { const T8 t = dec8(A, ws, it + NGW); titem_load(t.W, t.N, t.k0, t.n0, lane, vb); }
          { const T8 t = dec8(A, ws, it); titem_store8(va, t.O, 1024, t.k0, t.dst, lane); }
          { const T8 t = dec8(A, ws, it + 2 * NGW); titem_load(t.W, t.N, t.k0, t.n0, lane, va); }
          { const T8 t = dec8(A, ws, it + NGW); titem_store8(vb, t.O, 1024, t.k0, t.dst, lane); }
          it += 2 * NGW; }
      if (it < NI8) { const bool hb = it + NGW < NI8;
          if (hb) { const T8 t = dec8(A, ws, it + NGW); titem_load(t.W, t.N, t.k0, t.n0, lane, vb); }
          { const T8 t = dec8(A, ws, it); titem_store8(va, t.O, 1024, t.k0, t.dst, lane); }
          if (hb) { const T8 t = dec8(A, ws, it + NGW); titem_store8(vb, t.O, 1024, t.k0, t.dst, lane); } } }
    constexpr int J_QKV = 2 * 8 * (QKVN / 32), J_WO = 2 * 8 * 32, J_WIN = 2 * 8 * (WINN / 32), NJ = J_QKV + J_WO + J_WIN + J_WO;
    for (int it = gw; it < NJ; it += NGW) { int r = it; const float* W; bf16* O; int N, kb, n0, dst; bool is8 = r < J_QKV;
        if (r < J_QKV) { const int per = 8 * (QKVN / 32), mat = r / per, q = r - mat * per; kb = q / (QKVN / 32); n0 = (q - kb * (QKVN / 32)) * 32;
            dst = (n0 & ~255) + ((n0 >> 5) & 1) * 128 + ((n0 >> 6) & 3) * 32;
            W = A.in[8] + (size_t)mat * 1024 * QKVN; N = QKVN; O = (bf16*)(ws + WS_WQKV + (size_t)mat * QKVN * 1024); }
        else if ((r -= J_QKV) < J_WO) { const int mat = r >> 8, q = r & 255; kb = q >> 5; n0 = (q & 31) * 32; dst = n0;
            W = A.in[11] + (size_t)mat * 1024 * 1024; N = 1024; O = (bf16*)(ws + WS_WOA + (size_t)mat * 1024 * 1024); is8 = true; }
        else if ((r -= J_WO) < J_WIN) { const int per = 8 * (WINN / 32), mat = r / per, q = r - mat * per; kb = q / (WINN / 32); n0 = (q - kb * (WINN / 32)) * 32; dst = n0;
            W = A.in[12] + (size_t)mat * 1024 * WINN; N = WINN;
            is8 = true; O = (bf16*)(ws + WS_WIN + (size_t)mat * WINP * 1024); }
        else { r -= J_WIN; const int mat = r >> 8, q = r & 255; kb = q >> 5; n0 = (q & 31) * 32; dst = n0;
            W = A.in[18] + (size_t)mat * 1024 * 1024; N = 1024; O = (bf16*)(ws + WS_WOG + (size_t)mat * 1024 * 1024); is8 = true; }
        f32x4 v[16]; titem_load(W, N, kb * 128, n0, lane, v); if (is8) titem_store8(v, (unsigned char*)O, 1024, kb * 128, dst, lane); else titem_store16(v, O, 1024, kb * 128, dst, lane); }
    for (int it = gw; it < 2 * (WINP - WINN); it += NGW) { const int mat = it / (WINP - WINN), rr = WINN + it - mat * (WINP - WINN);
        GAS v4u* p = (GAS v4u*)(ws + WS_WIN + ((size_t)mat * WINP + rr) * 1024) + lane; p[0] = (v4u){0u, 0u, 0u, 0u}; }
    for (int it = NGW - 1 - gw; it < NLAYER * 24 * 16; it += NGW) {
        const int l = it / (24 * 16), q = it - l * (24 * 16), cg = q / 16, kc = q - cg * 16;
        float s[MODROWS];
#pragma unroll
        for (int r = 0; r < MODROWS; ++r) { const float cv = (r < 8) ? A.in[1][r * 1024 + kc * 64 + lane] : A.in[3][kc * 64 + lane]; s[r] = silu_f(cv); }
        f32x4 acc[MODROWS];
#pragma unroll
        for (int r = 0; r < MODROWS; ++r) acc[r] = (f32x4){0.f, 0.f, 0.f, 0.f};
        const float* wp = A.in[4] + ((size_t)l * 1024 + kc * 64) * NMODC + cg * 256 + 4 * lane;
#pragma unroll 8
        for (int kk = 0; kk < 64; ++kk) { const f32x4 w = *(const f32x4*)(wp + (size_t)kk * NMODC);
#pragma unroll
            for (int r = 0; r < MODROWS; ++r) { const float sv = __shfl(s[r], kk); acc[r] = acc[r] + w * sv; } }
        float* op = (float*)(ws + WS_MODP) + (size_t)kc * (NLAYER * MODROWS * NMODC) + (size_t)l * MODROWS * NMODC + cg * 256 + 4 * lane;
#pragma unroll
        for (int r = 0; r < MODROWS; ++r) *(f32x4*)(op + (size_t)r * NMODC) = acc[r];
    }
    for (int m0 = gw; m0 < MT; m0 += 4 * NGW) { f32x4 x[4][4];
#pragma unroll
        for (int r = 0; r < 4; ++r) { const int m = m0 + r * NGW; if (m < MT) { const int b = m / TB, w = m - b * TB;
            const float* src = (w < CTXL) ? A.in[2] + ((size_t)b * CTXL + w) * 1024 : A.in[0] + ((size_t)b * SEQ + (w - CTXL)) * 1024; const GAS f32x4* sp = (const GAS f32x4*)src + lane;
#pragma unroll
            for (int j = 0; j < 4; ++j) x[r][j] = sp[64 * j]; } }
#pragma unroll
        for (int r = 0; r < 4; ++r) { const int m = m0 + r * NGW; if (m < MT) { GAS unsigned long long* dp = (GAS unsigned long long*)((bf16*)(ws + WS_X) + (size_t)m * 1024) + lane;
#pragma unroll
            for (int j = 0; j < 4; ++j) dp[64 * j] = f32_to_bf4(x[r][j]); } } }
    { float* par = (float*)(ws + WS_PAR); const int gt = gw * 64 + lane, NGT = NGW * 64;
#define CPL(k, src, n) float c##k##a = 0.f, c##k##b = 0.f; if (gt < (n)) c##k##a = A.in[src][gt]; if (gt + NGT < (n)) c##k##b = A.in[src][gt + NGT];
#define CPS(k, src, n, off) if (gt < (n)) par[(off) + gt] = c##k##a; if (gt + NGT < (n)) par[(off) + gt + NGT] = c##k##b; for (int i = gt + 2 * NGT; i < (n); i += NGT) par[(off) + i] = A.in[src][i];
      CPL(0, 6, 4096) CPL(1, 7, 4096) CPL(2, 9, 128) CPL(3, 10, 128) CPL(4, 13, 16384) CPL(5, 15, 16384) CPL(6, 14, 1024) CPL(7, 16, 1024) CPL(8, 17, 512) CPL(9, 19, 131072) CPL(10, 20, 128) CPL(11, 22, 262144) CPL(12, 24, 131072)
      CPS(0, 6, 4096, P_N1G) CPS(1, 7, 4096, P_N2G) CPS(2, 9, 128, P_QG) CPS(3, 10, 128, P_KG) CPS(4, 13, 16384, P_GKF) CPS(5, 15, 16384, P_GKB) CPS(6, 14, 1024, P_BGF) CPS(7, 16, 1024, P_BGB)
      CPS(8, 17, 512, P_OG) CPS(9, 19, 131072, P_WR) CPS(10, 20, 128, P_BR) CPS(11, 22, 262144, P_BGU) CPS(12, 24, 131072, P_BDN)
#undef CPL
#undef CPS
    }
    for (int idx = gw * 64 + lane; idx < SEQ * 32; idx += NGW * 64) { const int s = idx >> 5, i = idx & 31;
        const float invf = 1.0f / powf(10000.0f, (float)(i & 15) * (1.0f / 16.0f));
        const float ang = (float)((i < 16) ? (s >> 6) : (s & 63)) * invf;
        ((float*)(ws + WS_ROPE))[idx] = cosf(ang); ((float*)(ws + WS_ROPE))[SEQ * 32 + idx] = sinf(ang); }
}
__device__ __forceinline__ void p1_mod_reduce(const Args& A, int gtid, int NGT) {
    const float* P = (const float*)(A.ws + WS_MODP); float* Mo = (float*)(A.ws + WS_MOD);
    constexpr int N = NLAYER * MODROWS * NMODC;
    for (int i = gtid; i < N; i += NGT) { const int l = i / (MODROWS * NMODC), c = i % NMODC; float s = A.in[5][l * NMODC + c];
#pragma unroll
        for (int k = 0; k < 16; ++k) s += P[(size_t)k * N + i];
        Mo[i] = s; }
}
__device__ __forceinline__ void modulate_row(const bf16* xrow, const float* ng, const float* shp, const float* scp, bf16* orow, int lane, f32x4 (&y)[4], float& rs_out) {
    const GAS unsigned long long* xr = (const GAS unsigned long long*)xrow + lane;
    float ss = 0.f;
#pragma unroll
    for (int j = 0; j < 4; ++j) { y[j] = bf4_to_f32(xr[64 * j]); ss += (y[j].x * y[j].x + y[j].y * y[j].y) + (y[j].z * y[j].z + y[j].w * y[j].w); }
    const float rs = 1.0f / sqrtf(wave_sum(ss) * (1.0f / 1024.0f) + RMS_EPS); rs_out = rs;
    GAS unsigned long long* o8 = (GAS unsigned long long*)orow + lane;
#pragma unroll
    for (int j = 0; j < 4; ++j) { const f32x4 g = ((const GAS f32x4*)ng)[64 * j + lane], sh = ((const GAS f32x4*)shp)[64 * j + lane], sc = ((const GAS f32x4*)scp)[64 * j + lane];
        y[j] = (y[j] * rs) * g * (sc + 1.0f) + sh;
        o8[64 * j] = (unsigned long long)pk2(y[j].x, y[j].y) | ((unsigned long long)pk2(y[j].z, y[j].w) << 32); }
}
template <bool F8>
__device__ __forceinline__ void modulate_row2(const bf16* xa, const bf16* xb, const float* ng, const float* sha, const float* sca, const float* shb, const float* scb, unsigned char* oa, unsigned char* ob, int lane, float& rsa, float& rsb) {
    const GAS unsigned long long* pa = (const GAS unsigned long long*)xa + lane; const GAS unsigned long long* pb = (const GAS unsigned long long*)xb + lane;
    unsigned long long ra[4], rb[4]; f32x4 g[4], ha[4], ca[4], hb[4], cb[4];
#pragma unroll
    for (int j = 0; j < 4; ++j) { ra[j] = pa[64 * j]; rb[j] = pb[64 * j]; }
#pragma unroll
    for (int j = 0; j < 4; ++j) { g[j] = ((const GAS f32x4*)ng)[64 * j + lane]; ha[j] = ((const GAS f32x4*)sha)[64 * j + lane]; ca[j] = ((const GAS f32x4*)sca)[64 * j + lane]; hb[j] = ((const GAS f32x4*)shb)[64 * j + lane]; cb[j] = ((const GAS f32x4*)scb)[64 * j + lane]; }
    f32x4 ya[4], yb[4]; float sa = 0.f, sb = 0.f;
#pragma unroll
    for (int j = 0; j < 4; ++j) { ya[j] = bf4_to_f32(ra[j]); yb[j] = bf4_to_f32(rb[j]); sa += (ya[j].x * ya[j].x + ya[j].y * ya[j].y) + (ya[j].z * ya[j].z + ya[j].w * ya[j].w); sb += (yb[j].x * yb[j].x + yb[j].y * yb[j].y) + (yb[j].z * yb[j].z + yb[j].w * yb[j].w); }
    const int ln = lane_now();
#pragma unroll
    for (int o = 1; o < 64; o <<= 1) { sa += shx(sa, o, ln); sb += shx(sb, o, ln); }
    rsa = 1.0f / sqrtf(sa * (1.0f / 1024.0f) + RMS_EPS); rsb = 1.0f / sqrtf(sb * (1.0f / 1024.0f) + RMS_EPS);
#pragma unroll
    for (int j = 0; j < 4; ++j) {
        const f32x4 va = (ya[j] * rsa) * g[j] * (ca[j] + 1.0f) + ha[j], vb = (yb[j] * rsb) * g[j] * (cb[j] + 1.0f) + hb[j];
        if constexpr (F8) { ((GAS unsigned*)oa + lane)[64 * j] = pg8::pk4_fp8_sat(va.x, va.y, va.z, va.w); ((GAS unsigned*)ob + lane)[64 * j] = pg8::pk4_fp8_sat(vb.x, vb.y, vb.z, vb.w); }
        else { ((GAS unsigned long long*)oa + lane)[64 * j] = f32_to_bf4(va); ((GAS unsigned long long*)ob + lane)[64 * j] = f32_to_bf4(vb); } }
}
__device__ __forceinline__ void phase_modulate1(unsigned char* ws, int layer, int gw, int NGW, int lane) {
    const bf16* X = (const bf16*)(ws + WS_X); bf16* XN = (bf16*)(ws + WS_XN);
    const float* ng = PARF(ws) + P_N1G + layer * 1024; const float* Mo = (const float*)(ws + WS_MOD) + (size_t)layer * MODROWS * NMODC;
    for (int m = gw; m < MT; m += 2 * NGW) { const int m2 = (m + NGW < MT) ? m + NGW : m; const int mr = mod_row(m), mr2 = mod_row(m2); float rs, rs2;
        modulate_row2<true>(X + (size_t)m * 1024, X + (size_t)m2 * 1024, ng, Mo + (size_t)mr * NMODC + 0 * 1024, Mo + (size_t)mr * NMODC + 1 * 1024, Mo + (size_t)mr2 * NMODC + 0 * 1024, Mo + (size_t)mr2 * NMODC + 1 * 1024,
                             (unsigned char*)XN + (size_t)m * 1024, (unsigned char*)XN + (size_t)m2 * 1024, lane, rs, rs2); }
}
__device__ __forceinline__ void phase_qknorm_rope(unsigned char* ws, int la, int gw, int NGW, int lane) {
    bf16* Qb = (bf16*)(ws + WS_Q); bf16* Kb = (bf16*)(ws + WS_K);
    const float* qg = PARF(ws) + P_QG + la * 64; const float* kg = PARF(ws) + P_KG + la * 64; const float* ropec = (const float*)(ws + WS_ROPE); const float* ropes = ropec + SEQ * 32;
    const int i = lane & 31, hs = lane >> 5;
    for (int m = gw; m < MT; m += NGW) { const int b = m / TB, w = m - b * TB; const bool lat = w >= CTXL;
        float cs = 1.f, sn = 0.f; if (lat) { cs = ropec[(w - CTXL) * 32 + i]; sn = ropes[(w - CTXL) * 32 + i]; }
#pragma unroll 2
        for (int hh = 0; hh < 20; hh += 2) { const int hd = hh + hs;
            unsigned* p = (hd < 16) ? (unsigned*)(Qb + (size_t)m * 1024 + hd * 64) + i : (unsigned*)(Kb + (size_t)m * 256 + (hd - 16) * 64) + i;
            const float* gp = (hd < 16) ? qg : kg; const float scl = (hd < 16) ? ATT_C2 : 1.0f;
            const unsigned v = *p; const float x1 = __uint_as_float(v << 16), x2 = __uint_as_float(v & 0xffff0000u);
            float ss = x1 * x1 + x2 * x2;
#pragma unroll
            for (int o = 1; o < 32; o <<= 1) ss += shx(ss, o, lane);
            const float rs = 1.0f / sqrtf(ss * (1.0f / 64.0f) + RMS_EPS);
            const float y1 = x1 * rs * gp[2 * i], y2 = x2 * rs * gp[2 * i + 1];
            const float r1 = (y1 * cs - y2 * sn) * scl, r2 = (y1 * sn + y2 * cs) * scl;
            *p = pk2(r1, r2); }
    }
}
__device__ __forceinline__ void phase_gla_recurrent(unsigned char* ws, int lg, LAS unsigned char* lds, int tid) {
    const int unit = blockIdx.x; if (unit >= 128) return;
    const int half = unit & 1, dir = (unit >> 1) & 1, h = (unit >> 2) & 3, b = unit >> 4;
    const bf16* G = (const bf16*)(ws + WS_G);
    float* Oo = (float*)(ws + (dir ? WS_OB : WS_OF));
    const float* wg = PARF(ws) + (dir ? P_GKB : P_GKF) + (size_t)lg * 16 * 512; const float* bg = PARF(ws) + (dir ? P_BGB : P_BGF) + lg * 512;
    LAS float* qq = (LAS float*)(lds + RING_OFF); LAS float* kk = qq + 64 * 128; LAS float* dd = kk + 64 * 128; LAS float* vv = dd + 64 * 128;
    const int sd = tid & 127, st0 = tid >> 7;
    float wcol[16];
#pragma unroll
    for (int r = 0; r < 16; ++r) wcol[r] = wg[r * 512 + h * 128 + sd];
    const float bcol = bg[h * 128 + sd];
    const int c = tid >> 2, dq = tid & 3;
    float s[32];
#pragma unroll
    for (int j = 0; j < 32; ++j) s[j] = 0.f;
    const float qscale = 0.08838834764831845f;
    for (int ch = 0; ch < TB / 64; ++ch) {
        __syncthreads();
#pragma unroll 4
        for (int i = 0; i < 16; ++i) { const int tt = st0 + 4 * i, n = 64 * ch + tt;
            const int w = dir ? (n < CTXL ? (CTXL - 1 - n) : (TB + CTXL - 1 - n)) : n;
            const bf16* gr = G + ((size_t)b * TB + w) * WINP;
            const float qv = bf2f(gr[h * 128 + sd]) * qscale, kv = bf2f(gr[512 + h * 128 + sd]);
            const bf16* lp = gr + 3072 + dir * 16; float z = bcol;
#pragma unroll
            for (int r = 0; r < 16; ++r) z += bf2f(lp[r]) * wcol[r];
            const float ls = fminf(z, 0.f) - log1pf(__expf(-fabsf(z)));
            qq[tt * 128 + sd] = qv; kk[tt * 128 + sd] = kv; dd[tt * 128 + sd] = __expf(ls * (1.0f / 16.0f));
            vv[tt * 128 + sd] = bf2f(gr[1024 + h * 256 + half * 128 + sd]); }
        __syncthreads();
        for (int tt = 0; tt < 64; ++tt) { const int n = 64 * ch + tt; const int w = dir ? (n < CTXL ? (CTXL - 1 - n) : (TB + CTXL - 1 - n)) : n;
            const float v = vv[tt * 128 + c]; float acc = 0.f;
            const LAS f32x4* q4 = (const LAS f32x4*)(qq + tt * 128 + dq * 32); const LAS f32x4* k4 = (const LAS f32x4*)(kk + tt * 128 + dq * 32); const LAS f32x4* d4 = (const LAS f32x4*)(dd + tt * 128 + dq * 32);
#pragma unroll
            for (int j = 0; j < 8; ++j) { const f32x4 qv = q4[j], kv = k4[j], dv = d4[j];
                s[4 * j + 0] = s[4 * j + 0] * dv.x + kv.x * v; acc += qv.x * s[4 * j + 0];
                s[4 * j + 1] = s[4 * j + 1] * dv.y + kv.y * v; acc += qv.y * s[4 * j + 1];
                s[4 * j + 2] = s[4 * j + 2] * dv.z + kv.z * v; acc += qv.z * s[4 * j + 2];
                s[4 * j + 3] = s[4 * j + 3] * dv.w + kv.w * v; acc += qv.w * s[4 * j + 3]; }
            acc += shx(acc, 1, tid & 63); acc += shx(acc, 2, tid & 63);
            if (dq == 0) Oo[((size_t)b * TB + w) * 1024 + h * 256 + half * 128 + c] = acc; }
    }
}
__device__ __forceinline__ void phase_gla_readout(unsigned char* ws, int lg, int gw, int NGW, int lane) {
    const float* OF = (const float*)(ws + WS_OF); const float* OB = (const float*)(ws + WS_OB); const bf16* G = (const bf16*)(ws + WS_G); bf16* OG = (bf16*)(ws + WS_Q);
    const f32x4 og = ((const GAS f32x4*)(PARF(ws) + P_OG + lg * 256))[lane];
    for (int m = gw; m < MT; m += NGW) {
#pragma unroll
        for (int hh = 0; hh < 4; ++hh) { const size_t off = (size_t)m * 1024 + hh * 256 + 4 * lane;
            f32x4 o = *(const GAS f32x4*)(OF + off) + *(const GAS f32x4*)(OB + off);
            const float ss = wave_sum((o.x * o.x + o.y * o.y) + (o.z * o.z + o.w * o.w));
            const float rs = 1.0f / sqrtf(ss * (1.0f / 256.0f) + RMS_EPS);
            const unsigned long long rv = *(const GAS unsigned long long*)(G + (size_t)m * WINP + 2048 + hh * 256 + 4 * lane);
            const float r0 = __uint_as_float((unsigned)(rv & 0xffffu) << 16), r1 = __uint_as_float((unsigned)(rv >> 16) << 16), r2 = __uint_as_float((unsigned)((rv >> 32) & 0xffffu) << 16), r3 = __uint_as_float((unsigned)(rv >> 48) << 16);
            o = o * rs * og;
            o.x *= silu_f(r0); o.y *= silu_f(r1); o.z *= silu_f(r2); o.w *= silu_f(r3);
            *(GAS unsigned long long*)(OG + off) = (unsigned long long)pk2(o.x, o.y) | ((unsigned long long)pk2(o.z, o.w) << 32); }
    }
}
constexpr size_t WS_GQ = WS_XG, WS_GKH = WS_XG + 68 * MiB, WS_GKT = WS_XG + 136 * MiB, WS_GVT = WS_XG + 204 * MiB, WS_GDL = WS_ACT, WS_SX = WS_OF;
static_assert((size_t)2176 * 2 * 16384 <= 68 * MiB && (size_t)2176 * 256 * 64 * 2 <= 68 * MiB && (size_t)64 * 68 * 65536 <= 272 * MiB, "gla buffers");
typedef float f32x16 __attribute__((ext_vector_type(16)));
__device__ __forceinline__ float log_sigmoid_fast(float z) { return fminf(z, 0.f) - __logf(1.0f + __expf(-fabsf(z))); }

struct G0Raw { unsigned qk[8][2]; v4u lfb; };
__device__ __forceinline__ void g0_load(G0Raw& R, unsigned char* ws, int cn, int tid) {
    const bf16* G = (const bf16*)(ws + WS_G);
    const int d2 = tid & 63, tb = tid >> 6, n = cn % 68, bh = cn / 68, h = bh & 3, b = bh >> 2;
    const size_t r0 = (size_t)b * TB + 64 * n;
#pragma unroll
    for (int j = 0; j < 8; ++j) { const bf16* gr = G + (r0 + 8 * tb + j) * WINP; R.qk[j][0] = *(const GAS unsigned*)(gr + h * 128 + 2 * d2); R.qk[j][1] = *(const GAS unsigned*)(gr + 512 + h * 128 + 2 * d2); }
    R.lfb = *(const GAS v4u*)(G + (r0 + ((tid & 255) >> 2)) * WINP + 3072 + 8 * (tid & 3));
}
__device__ __forceinline__ void g0_vload(unsigned (&raw)[32], const unsigned char* ws, int idx, int h, int dv, int th) {
    const int b = idx / 68, n = idx - b * 68; const bf16* vp = (const bf16*)(ws + WS_G) + ((size_t)b * TB + 64 * n + 32 * th) * WINP + 1024 + h * 256 + dv;
#pragma unroll
    for (int j = 0; j < 32; ++j) raw[j] = (unsigned)((const GAS bf16*)vp)[(size_t)j * WINP];
}
__device__ __forceinline__ void g0_vstore(const unsigned (&raw)[32], unsigned char* ws, int idx, int h, int dv, int th) {
    const int b = idx / 68, n = idx - b * 68, cn = (b * 4 + h) * 68 + n;
    unsigned char* vo = ws + WS_GVT + (size_t)cn * 16384 + (size_t)(((2 * th) * 8 + (dv >> 5)) * 64 + (dv & 31)) * 8;
#define G0_VF(i_) __uint_as_float(raw[i_] << 16)
#pragma unroll
    for (int ql = 0; ql < 2; ++ql)
#pragma unroll
        for (int hq = 0; hq < 2; ++hq) { const int t0 = 16 * ql + 4 * hq;
            *(GAS unsigned long long*)(vo + ql * 4096 + hq * 256) = (unsigned long long)pg8::pk4_fp8_sat(G0_VF(t0), G0_VF(t0 + 1), G0_VF(t0 + 2), G0_VF(t0 + 3)) | ((unsigned long long)pg8::pk4_fp8_sat(G0_VF(t0 + 8), G0_VF(t0 + 9), G0_VF(t0 + 10), G0_VF(t0 + 11)) << 32); }
#undef G0_VF
}
__device__ __forceinline__ void phase_gla_g0v(unsigned char* ws, int tid, int Gp, int bxp) {
    const int G4 = Gp >> 2, h = bxp & 3, wq = bxp >> 2;
    if (wq >= G4) return;
    const int dv = tid & 255, th = tid >> 8; unsigned ra[32], rb[32]; int idx = wq;
    if (idx < 544) g0_vload(ra, ws, idx, h, dv, th);
    while (idx + 2 * G4 < 544) { g0_vload(rb, ws, idx + G4, h, dv, th); g0_vstore(ra, ws, idx, h, dv, th); g0_vload(ra, ws, idx + 2 * G4, h, dv, th); g0_vstore(rb, ws, idx + G4, h, dv, th); idx += 2 * G4; }
    if (idx < 544) { const bool hb = idx + G4 < 544; if (hb) g0_vload(rb, ws, idx + G4, h, dv, th); g0_vstore(ra, ws, idx, h, dv, th); if (hb) g0_vstore(rb, ws, idx + G4, h, dv, th); }
}
__device__ __forceinline__ void phase_gla_g0(unsigned char* ws, int lg, LAS unsigned char* lds, int tid, int Gp, int bxp) {
    LAS float* tot = (LAS float*)(lds + RING_OFF);
    LAS float* lfl = (LAS float*)(lds + RING_OFF + 8192);
    const int d2 = tid & 63, tb = tid >> 6;
    const int G4 = Gp >> 2, h = bxp & 3, wq = bxp >> 2;
    if (wq >= G4 || wq >= 544) return;
        f32x2 wf[16], wb[16];
        { const float* wgf = PARF(ws) + P_GKF + (size_t)lg * 16 * 512 + h * 128 + 2 * d2; const float* wgb = PARF(ws) + P_GKB + (size_t)lg * 16 * 512 + h * 128 + 2 * d2;
#pragma unroll
          for (int r = 0; r < 16; ++r) { wf[r] = *(const GAS f32x2*)(wgf + r * 512); wb[r] = *(const GAS f32x2*)(wgb + r * 512); } }
        const f32x2 bf_ = *(const GAS f32x2*)(PARF(ws) + P_BGF + lg * 512 + h * 128 + 2 * d2), bb_ = *(const GAS f32x2*)(PARF(ws) + P_BGB + lg * 512 + h * 128 + 2 * d2);
    G0Raw R; g0_load(R, ws, ((wq / 68) * 4 + h) * 68 + wq % 68, tid);
    for (int idx = wq; idx < 544; idx += G4) {
        const int b = idx / 68, n = idx - b * 68, cn = (b * 4 + h) * 68 + n;
        __syncthreads();
        if (tid < 256) { const v4u l = R.lfb; LAS f32x4* dp = (LAS f32x4*)(lfl + tid * 8);
            dp[0] = (f32x4){__uint_as_float(l.x << 16), __uint_as_float(l.x & 0xffff0000u), __uint_as_float(l.y << 16), __uint_as_float(l.y & 0xffff0000u)};
            dp[1] = (f32x4){__uint_as_float(l.z << 16), __uint_as_float(l.z & 0xffff0000u), __uint_as_float(l.w << 16), __uint_as_float(l.w & 0xffff0000u)}; }
        unsigned qk[8][2];
#pragma unroll
        for (int j = 0; j < 8; ++j) { qk[j][0] = R.qk[j][0]; qk[j][1] = R.qk[j][1]; }
        __syncthreads();
        if (idx + G4 < 544) { const int i2 = idx + G4, b2 = i2 / 68; g0_load(R, ws, (b2 * 4 + h) * 68 + (i2 - b2 * 68), tid); }
        float gf0[8], gf1[8], gb0[8], gb1[8];
#pragma unroll
        for (int j = 0; j < 8; ++j) { const LAS f32x4* lp = (const LAS f32x4*)(lfl + (8 * tb + j) * 32);
            f32x2 zf = bf_, zb = bb_;
#pragma unroll
            for (int q = 0; q < 4; ++q) { const f32x4 a = lp[q], c = lp[4 + q];
#pragma unroll
                for (int e = 0; e < 4; ++e) { zf += (f32x2){a[e], a[e]} * wf[4 * q + e]; zb += (f32x2){c[e], c[e]} * wb[4 * q + e]; } }
            gf0[j] = log_sigmoid_fast(zf.x) * 0.0625f; gf1[j] = log_sigmoid_fast(zf.y) * 0.0625f; gb0[j] = log_sigmoid_fast(zb.x) * 0.0625f; gb1[j] = log_sigmoid_fast(zb.y) * 0.0625f; }
#pragma unroll
        for (int j = 1; j < 8; ++j) { gf0[j] += gf0[j - 1]; gf1[j] += gf1[j - 1]; gb0[7 - j] += gb0[8 - j]; gb1[7 - j] += gb1[8 - j]; }
        *(LAS f32x2*)(tot + (0 * 8 + tb) * 128 + 2 * d2) = (f32x2){gf0[7], gf1[7]}; *(LAS f32x2*)(tot + (1 * 8 + tb) * 128 + 2 * d2) = (f32x2){gb0[0], gb1[0]};
        __syncthreads();
        float pf0 = 0.f, pf1 = 0.f, pb0 = 0.f, pb1 = 0.f, lf0 = 0.f, lf1 = 0.f, lb0 = 0.f, lb1 = 0.f;
#pragma unroll
        for (int q = 0; q < 8; ++q) { const f32x2 a = *(const LAS f32x2*)(tot + (0 * 8 + q) * 128 + 2 * d2), c = *(const LAS f32x2*)(tot + (1 * 8 + q) * 128 + 2 * d2);
            lf0 += a.x; lf1 += a.y; lb0 += c.x; lb1 += c.y;
            if (q < tb) { pf0 += a.x; pf1 += a.y; } if (q > tb) { pb0 += c.x; pb1 += c.y; } }
        const size_t itf = (size_t)cn * 2, itb = itf + 1;
        bf16* Qf = (bf16*)(ws + WS_GQ) + itf * 8192; bf16* Qb = Qf + 8192; bf16* Kf = (bf16*)(ws + WS_GKH) + itf * 8192; bf16* Kb = Kf + 8192;
        const float elf0 = __expf(lf0), elf1 = __expf(lf1), elb0 = __expf(lb0), elb1 = __expf(lb1);
        float ktf0[8], ktf1[8], ktb0[8], ktb1[8];
#pragma unroll
        for (int j = 0; j < 8; ++j) { const int t = 8 * tb + j;
            const float q0 = __uint_as_float(qk[j][0] << 16) * 0.08838834764831845f, q1 = __uint_as_float(qk[j][0] & 0xffff0000u) * 0.08838834764831845f;
            const float k0 = __uint_as_float(qk[j][1] << 16), k1 = __uint_as_float(qk[j][1] & 0xffff0000u);
            const float ef0 = __expf(pf0 + gf0[j]), ef1 = __expf(pf1 + gf1[j]), eb0 = __expf(pb0 + gb0[j]), eb1 = __expf(pb1 + gb1[j]);
            const float rf0 = __builtin_amdgcn_rcpf(ef0), rf1 = __builtin_amdgcn_rcpf(ef1), rb0 = __builtin_amdgcn_rcpf(eb0), rb1 = __builtin_amdgcn_rcpf(eb1);
            *(GAS unsigned*)(Qf + t * 128 + 2 * d2) = pk2(q0 * ef0, q1 * ef1); *(GAS unsigned*)(Qb + t * 128 + 2 * d2) = pk2(q0 * eb0, q1 * eb1);
            *(GAS unsigned*)(Kf + t * 128 + 2 * d2) = pk2(k0 * rf0, k1 * rf1); *(GAS unsigned*)(Kb + t * 128 + 2 * d2) = pk2(k0 * rb0, k1 * rb1);
            ktf0[j] = k0 * rf0 * elf0; ktf1[j] = k1 * rf1 * elf1; ktb0[j] = k0 * rb0 * elb0; ktb1[j] = k1 * rb1 * elb1; }
        {
          unsigned char* Tf = ws + WS_GKT + itf * 8192 + (size_t)((((tb >> 1) * 4 + (d2 >> 4)) * 64 + ((2 * d2) & 31)) * 8 + 4 * (tb & 1)); unsigned char* Tb = Tf + 8192;
          *(GAS unsigned*)(Tf) = pg8::pk4_fp8_sat(ktf0[0], ktf0[1], ktf0[2], ktf0[3]);
          *(GAS unsigned*)(Tf + 256) = pg8::pk4_fp8_sat(ktf0[4], ktf0[5], ktf0[6], ktf0[7]);
          *(GAS unsigned*)(Tf + 8) = pg8::pk4_fp8_sat(ktf1[0], ktf1[1], ktf1[2], ktf1[3]);
          *(GAS unsigned*)(Tf + 264) = pg8::pk4_fp8_sat(ktf1[4], ktf1[5], ktf1[6], ktf1[7]);
          *(GAS unsigned*)(Tb) = pg8::pk4_fp8_sat(ktb0[0], ktb0[1], ktb0[2], ktb0[3]);
          *(GAS unsigned*)(Tb + 256) = pg8::pk4_fp8_sat(ktb0[4], ktb0[5], ktb0[6], ktb0[7]);
          *(GAS unsigned*)(Tb + 8) = pg8::pk4_fp8_sat(ktb1[0], ktb1[1], ktb1[2], ktb1[3]);
          *(GAS unsigned*)(Tb + 264) = pg8::pk4_fp8_sat(ktb1[4], ktb1[5], ktb1[6], ktb1[7]); }
        if (tb == 0) { float* DLp = (float*)(ws + WS_GDL) + itf * 128 + 2 * d2; *(GAS f32x2*)DLp = (f32x2){elf0, elf1}; *(GAS f32x2*)(DLp + 128) = (f32x2){elb0, elb1}; }
    }
}
struct G12Ops { long a[4], b[4]; f32x4 d[4]; };
__device__ __forceinline__ void g12_load(G12Ops& o, unsigned char* ws, int bh, int dir, int m, int kb, int vb, int r, int hh) {
    const int n = dir ? (m < 4 ? 3 - m : 71 - m) : m; const size_t cn = (size_t)bh * 68 + n, item = cn * 2 + dir;
    const unsigned char* ap = ws + WS_GKT + item * 8192 + (size_t)(kb * 64 + hh * 32 + r) * 8;
    const unsigned char* bp = ws + WS_GVT + cn * 16384 + (size_t)(vb * 64 + hh * 32 + r) * 8;
    const float* dp = (const float*)(ws + WS_GDL) + item * 128 + 32 * kb + 4 * hh;
#pragma unroll
    for (int ks = 0; ks < 4; ++ks) { o.a[ks] = *(const GAS long*)(ap + ks * 2048); o.b[ks] = *(const GAS long*)(bp + ks * 4096); o.d[ks] = *(const GAS f32x4*)(dp + 8 * ks); }
}
__device__ __forceinline__ void phase_gla_g12(unsigned char* ws, LAS unsigned char* lds, int gwv, int wave, int lane) {
    if (gwv >= 2048) return;
    const int chain = gwv >> 5, blk = gwv & 31, kb = blk & 3, vb = blk >> 2, dir = chain & 1, bh = chain >> 1;
    const int r = lane & 31, hh = lane >> 5;
    LAS unsigned char* wl = lds + RING_OFF + wave * 2048;
    f32x16 acc;
#pragma unroll
    for (int g = 0; g < 16; ++g) acc[g] = 0.f;
    G12Ops o0, o1, o2;
    g12_load(o0, ws, bh, dir, 0, kb, vb, r, hh); g12_load(o1, ws, bh, dir, 1, kb, vb, r, hh);
#define G12_STEP(CUR, m_) do { const int mm_ = (m_); const int n = dir ? (mm_ < 4 ? 3 - mm_ : 71 - mm_) : mm_; \
        _Pragma("unroll") for (int gg = 0; gg < 4; ++gg) *(LAS unsigned*)(wl + (((gg >> 1) * 64 + (gg & 1) * 32 + r) * 8 + 4 * hh)) = pg8::pk4_fp8_sat(acc[4 * gg], acc[4 * gg + 1], acc[4 * gg + 2], acc[4 * gg + 3]); \
        LDS_WAIT(); const v4u s0 = *(const LAS v4u*)(wl + lane * 16); LDS_WAIT(); \
        { unsigned char* sp = ws + WS_SX + ((size_t)(bh * 2 + dir) * 68 + n) * 32768 + (size_t)(kb * 8 + vb) * 1024; ((GAS v4u*)sp)[lane] = s0; }        \
        _Pragma("unroll") for (int gg = 0; gg < 4; ++gg) { acc[4 * gg] *= CUR.d[gg].x; acc[4 * gg + 1] *= CUR.d[gg].y; acc[4 * gg + 2] *= CUR.d[gg].z; acc[4 * gg + 3] *= CUR.d[gg].w; } \
        _Pragma("unroll") for (int ks = 0; ks < 4; ++ks) acc = __builtin_amdgcn_mfma_f32_32x32x16_fp8_fp8(CUR.a[ks], CUR.b[ks], acc, 0, 0, 0); } while (0)
    for (int m = 0; m < 66; m += 3) {
        __syncthreads();
        g12_load(o2, ws, bh, dir, m + 2, kb, vb, r, hh); G12_STEP(o0, m);
        g12_load(o0, ws, bh, dir, m + 3, kb, vb, r, hh); G12_STEP(o1, m + 1);
        g12_load(o1, ws, bh, dir, (m + 4 < 68) ? m + 4 : 67, kb, vb, r, hh); G12_STEP(o2, m + 2);
    }
    G12_STEP(o0, 66); G12_STEP(o1, 67);
#undef G12_STEP
}
constexpr int G3_RS = 272, G3_TILE = 64 * G3_RS, G3_OL = 4 * G3_TILE  , G3_LD = 260;
static_assert(G3_OL + 64 * G3_LD * 4 <= MISC_OFF, "G3 LDS");
__device__ __forceinline__ void phase_gla_g3(unsigned char* ws, int lg, LAS unsigned char* lds, int tid) {
    const int lane = tid & 63, wave = __builtin_amdgcn_readfirstlane(tid >> 6), r = lane & 31, hh = lane >> 5, vb = wave;
    LAS unsigned char* TL = lds + RING_OFF; LAS float* OL = (LAS float*)(lds + RING_OFF + G3_OL);
    const bf16* G = (const bf16*)(ws + WS_G); bf16* OG = (bf16*)(ws + WS_Q);
    v4u st[4][2]; unsigned long long sA[8];
#define G3_REQUEST(cn_) do { \
        _Pragma("unroll") for (int tl_ = 0; tl_ < 4; ++tl_) { const bf16* src_ = (const bf16*)(ws + ((tl_ & 1) ? WS_GKH : WS_GQ)) + ((size_t)(cn_) * 2 + (tl_ >> 1)) * 8192; \
            _Pragma("unroll") for (int j_ = 0; j_ < 2; ++j_) st[tl_][j_] = ((const GAS v4u*)src_)[tid + 512 * j_]; } } while (0)
    if ((int)blockIdx.x < 2176) G3_REQUEST((int)blockIdx.x);
    for (int cn = blockIdx.x; cn < 2176; cn += gridDim.x) {
        const int n = cn % 68, bh = cn / 68, h = bh & 3, b = bh >> 2;
        const unsigned char* SxB = ws + WS_SX + ((size_t)(bh * 2 + 1) * 68 + n) * 32768 + (size_t)vb * 1024 + lane * 8;
        const unsigned char* Vt = ws + WS_GVT + (size_t)cn * 16384 + (size_t)(vb * 64 + lane) * 8;
        unsigned long long sB[8], vf[4];
        { const unsigned char* SxA = SxB - (size_t)68 * 32768;
#pragma unroll
          for (int s = 0; s < 8; ++s) sA[s] = *(const GAS unsigned long long*)(SxA + (s >> 1) * 8192 + (s & 1) * 512); }
        __syncthreads();
#pragma unroll
        for (int tl = 0; tl < 4; ++tl)
#pragma unroll
            for (int j = 0; j < 2; ++j) { const int q = tid + 512 * j, row = q >> 4, ch = q & 15; *(LAS v4u*)(TL + tl * G3_TILE + row * G3_RS + ch * 16) = st[tl][j]; }
        __syncthreads();
        f32x16 P00, P01, P10, P11, O0, O1;
#pragma unroll
        for (int g = 0; g < 16; ++g) { P00[g] = 0.f; P01[g] = 0.f; P10[g] = 0.f; P11[g] = 0.f; O0[g] = 0.f; O1[g] = 0.f; }
#pragma unroll
        for (int dir = 0; dir < 2; ++dir) {
            const LAS unsigned char* Qt = TL + (2 * dir) * G3_TILE + r * G3_RS + 16 * hh; const LAS unsigned char* Kh = TL + (2 * dir + 1) * G3_TILE + r * G3_RS + 16 * hh;
            if (dir == 0) {
#pragma unroll
                for (int s = 0; s < 8; ++s) sB[s] = *(const GAS unsigned long long*)(SxB + (s >> 1) * 8192 + (s & 1) * 512);
            } else {
#pragma unroll
                for (int q = 0; q < 4; ++q) vf[q] = *(const GAS unsigned long long*)(Vt + q * 4096);
            }
            __builtin_amdgcn_sched_barrier(0);
            f32x16 X00, X11, Xoff;
#pragma unroll
            for (int g = 0; g < 16; ++g) { X00[g] = 0.f; X11[g] = 0.f; Xoff[g] = 0.f; }
#pragma unroll
            for (int s = 0; s < 8; ++s) {
                const bf16x8 q0 = *(const LAS bf16x8*)(Qt + 32 * s), q1 = *(const LAS bf16x8*)(Qt + 32 * G3_RS + 32 * s);
                const bf16x8 k0 = *(const LAS bf16x8*)(Kh + 32 * s), k1 = *(const LAS bf16x8*)(Kh + 32 * G3_RS + 32 * s);
                const unsigned long long s8 = dir ? sB[s] : sA[s]; const int d0_ = (int)(unsigned)s8, d1_ = (int)(unsigned)(s8 >> 32);
                const f32x2 e0 = __builtin_amdgcn_cvt_pk_f32_fp8(d0_, false), e1 = __builtin_amdgcn_cvt_pk_f32_fp8(d0_, true), e2 = __builtin_amdgcn_cvt_pk_f32_fp8(d1_, false), e3 = __builtin_amdgcn_cvt_pk_f32_fp8(d1_, true);
                const bf16x8 sx = __builtin_bit_cast(bf16x8, ((v4u){pk2(e0.x, e0.y), pk2(e1.x, e1.y), pk2(e2.x, e2.y), pk2(e3.x, e3.y)}));
                X00 = __builtin_amdgcn_mfma_f32_32x32x16_bf16(k0, q0, X00, 0, 0, 0);
                X11 = __builtin_amdgcn_mfma_f32_32x32x16_bf16(k1, q1, X11, 0, 0, 0);
                if (dir == 0) Xoff = __builtin_amdgcn_mfma_f32_32x32x16_bf16(k0, q1, Xoff, 0, 0, 0); else Xoff = __builtin_amdgcn_mfma_f32_32x32x16_bf16(k1, q0, Xoff, 0, 0, 0);
                O0 = __builtin_amdgcn_mfma_f32_32x32x16_bf16(q0, sx, O0, 0, 0, 0); O1 = __builtin_amdgcn_mfma_f32_32x32x16_bf16(q1, sx, O1, 0, 0, 0); }
#pragma unroll
            for (int g = 0; g < 16; ++g) { const int tj = (g & 3) + 8 * (g >> 2) + 4 * hh; const bool keep = dir ? (tj >= r) : (tj <= r);
                P00[g] += keep ? X00[g] : 0.f; P11[g] += keep ? X11[g] : 0.f;
                if (dir == 0) P01[g] += Xoff[g]; else P10[g] += Xoff[g]; }
        }
        {
#pragma unroll
          for (int jb = 0; jb < 2; ++jb)
#pragma unroll
            for (int s2 = 0; s2 < 2; ++s2) { const unsigned long long v8_ = vf[2 * jb + s2]; const int vd0_ = (int)(unsigned)v8_, vd1_ = (int)(unsigned)(v8_ >> 32);
                const f32x2 ve0 = __builtin_amdgcn_cvt_pk_f32_fp8(vd0_, false), ve1 = __builtin_amdgcn_cvt_pk_f32_fp8(vd0_, true), ve2 = __builtin_amdgcn_cvt_pk_f32_fp8(vd1_, false), ve3 = __builtin_amdgcn_cvt_pk_f32_fp8(vd1_, true);
                const bf16x8 bfv = __builtin_bit_cast(bf16x8, ((v4u){pk2(ve0.x, ve0.y), pk2(ve1.x, ve1.y), pk2(ve2.x, ve2.y), pk2(ve3.x, ve3.y)}));
                const f32x16& Pa = jb ? P10 : P00; const f32x16& Pb = jb ? P11 : P01;
                const bf16x8 a0 = __builtin_bit_cast(bf16x8, ((v4u){pk2(Pa[8 * s2 + 0], Pa[8 * s2 + 1]), pk2(Pa[8 * s2 + 2], Pa[8 * s2 + 3]), pk2(Pa[8 * s2 + 4], Pa[8 * s2 + 5]), pk2(Pa[8 * s2 + 6], Pa[8 * s2 + 7])}));
                const bf16x8 a1 = __builtin_bit_cast(bf16x8, ((v4u){pk2(Pb[8 * s2 + 0], Pb[8 * s2 + 1]), pk2(Pb[8 * s2 + 2], Pb[8 * s2 + 3]), pk2(Pb[8 * s2 + 4], Pb[8 * s2 + 5]), pk2(Pb[8 * s2 + 6], Pb[8 * s2 + 7])}));
                O0 = __builtin_amdgcn_mfma_f32_32x32x16_bf16(a0, bfv, O0, 0, 0, 0); O1 = __builtin_amdgcn_mfma_f32_32x32x16_bf16(a1, bfv, O1, 0, 0, 0); } }
        const int rt_ = tid >> 3, rcc_ = tid & 7; const size_t rrow_ = (size_t)b * TB + 64 * n + rt_;
        v4u rvv[2]; f32x4 ogv[8];
        { const GAS v4u* rp = (const GAS v4u*)(ws + WS_Y + rrow_ * 1024 + h * 256 + 32 * rcc_); const GAS f32x4* gp = (const GAS f32x4*)(PARF(ws) + P_OG + lg * 256 + 32 * rcc_);
          rvv[0] = rp[0]; rvv[1] = rp[1];
#pragma unroll
          for (int j = 0; j < 4; ++j) { ogv[2 * j] = gp[2 * j]; ogv[2 * j + 1] = gp[2 * j + 1]; } }
        __builtin_amdgcn_sched_barrier(0);
        if (cn + (int)gridDim.x < 2176) G3_REQUEST(cn + (int)gridDim.x);
        __builtin_amdgcn_sched_barrier(0);
#pragma unroll
        for (int g = 0; g < 16; ++g) { const int t = (g & 3) + 8 * (g >> 2) + 4 * hh; OL[t * G3_LD + 32 * vb + r] = O0[g]; OL[(32 + t) * G3_LD + 32 * vb + r] = O1[g]; }
        __syncthreads();
        { const int t = tid >> 3, cc = tid & 7; const LAS f32x4* op = (const LAS f32x4*)(OL + t * G3_LD + 32 * cc);
          f32x4 o[8]; float ss = 0.f;
#pragma unroll
          for (int j = 0; j < 8; ++j) { o[j] = op[j]; ss += (o[j].x * o[j].x + o[j].y * o[j].y) + (o[j].z * o[j].z + o[j].w * o[j].w); }
          ss += __shfl_xor(ss, 1); ss += __shfl_xor(ss, 2); ss += __shfl_xor(ss, 4);
          const float rs = 1.0f / sqrtf(ss * (1.0f / 256.0f) + RMS_EPS);
          GAS unsigned long long* dst = (GAS unsigned long long*)((unsigned char*)OG + rrow_ * 1024 + h * 256 + 32 * cc);
#pragma unroll
          for (int j = 0; j < 4; ++j) { const int rd0 = (int)rvv[j >> 1][2 * (j & 1)], rd1 = (int)rvv[j >> 1][2 * (j & 1) + 1];
              const f32x2 r01 = __builtin_amdgcn_cvt_pk_f32_fp8(rd0, false), r23 = __builtin_amdgcn_cvt_pk_f32_fp8(rd0, true), r45 = __builtin_amdgcn_cvt_pk_f32_fp8(rd1, false), r67 = __builtin_amdgcn_cvt_pk_f32_fp8(rd1, true);
              const f32x4 g0 = ogv[2 * j], g1 = ogv[2 * j + 1]; const f32x4 a = o[2 * j] * rs * g0, c2 = o[2 * j + 1] * rs * g1;
              const unsigned w0 = pg8::pk4_fp8(a.x * silu_f(r01.x), a.y * silu_f(r01.y), a.z * silu_f(r23.x), a.w * silu_f(r23.y));
              const unsigned w1 = pg8::pk4_fp8(c2.x * silu_f(r45.x), c2.y * silu_f(r45.y), c2.z * silu_f(r67.x), c2.w * silu_f(r67.y));
              dst[j] = (unsigned long long)w0 | ((unsigned long long)w1 << 32); } }
    }
#undef G3_REQUEST
}
constexpr int WIMG_RS = 2064;
static_assert(2 * 32 * WIMG_RS <= LDS_AUX, "router images below the aux tables");
__device__ __forceinline__ void phase_modulate2_route(unsigned char* ws, int layer, LAS unsigned char* lds, int vcu, int wave, int lane, int tid, bool dummy = false) {
    const bf16* X = (const bf16*)(ws + WS_X); bf16* XN = (bf16*)(ws + WS_XN);
    const float* ng = PARF(ws) + P_N2G + layer * 1024; const float* Mo = (const float*)(ws + WS_MOD) + (size_t)layer * MODROWS * NMODC;
    LAS unsigned char* WHI = lds + RING_OFF; LAS unsigned char* WLO = WHI + 32 * WIMG_RS;
    LAS unsigned* lcnt = (LAS unsigned*)(lds + AUX_LCNT); LAS unsigned* gb = (LAS unsigned*)(lds + AUX_GB); LAS unsigned* ent = (LAS unsigned*)(lds + AUX_ENT); LAS float* rsl = (LAS float*)(lds + AUX_RS);
    { const float* wsrc = PARF(ws) + P_WR + (size_t)layer * 1024 * 32;
      for (int b0 = 0; b0 < 64; b0 += 16) { float wv[16];
#pragma unroll
          for (int j = 0; j < 16; ++j) wv[j] = ((const GAS float*)wsrc)[tid + (b0 + j) * (NWAVES * 64)];
#pragma unroll
          for (int j = 0; j < 16; ++j) { const int idx = tid + (b0 + j) * (NWAVES * 64), k = idx >> 5, e = idx & 31; const float w = wv[j]; const unsigned hi = f2bf(w), lo = f2bf(w - __uint_as_float(hi << 16));
              *(LAS unsigned short*)(WHI + e * WIMG_RS + 2 * k) = (unsigned short)hi; *(LAS unsigned short*)(WLO + e * WIMG_RS + 2 * k) = (unsigned short)lo; } }
      if (tid < 32) lcnt[tid] = 0u; }
    gu32* cnt = (gu32*)(ws + WS_CTL) + CW_CNT + (layer + (dummy ? 4 : 0)) * 32 * 16;
    unsigned char* sbase = dummy ? ws + WS_XG : ws;
    const bool lastl = (layer == NLAYER - 1);
  for (int grp = vcu; grp < MT / 136; grp += (int)gridDim.x) {
    const int rbase = grp * 136;
    if (grp != vcu) { __syncthreads(); if (tid < 32) lcnt[tid] = 0u; }
    for (int rl = wave; rl < 136; rl += 2 * NWAVES) {
        const int rl2 = (rl + NWAVES < 136) ? rl + NWAVES : rl; const int m = rbase + rl, m2 = rbase + rl2, mr = mod_row(m), mr2 = mod_row(m2);
        float rs, rs2;
        modulate_row2<true>(X + (size_t)m * 1024, X + (size_t)m2 * 1024, ng, Mo + (size_t)mr * NMODC + 3 * 1024, Mo + (size_t)mr * NMODC + 4 * 1024, Mo + (size_t)mr2 * NMODC + 3 * 1024, Mo + (size_t)mr2 * NMODC + 4 * 1024,
                      ws + WS_XN8 + (size_t)m * 1024, ws + WS_XN8 + (size_t)m2 * 1024, lane, rs, rs2);
        if (lane == 0) { rsl[rl] = rs; rsl[rl2] = rs2; } }
    __syncthreads();
    if (wave < 5) {
        const int r = lane & 31, hh = lane >> 5; const int rl = (32 * wave + r < 136) ? 32 * wave + r : 135; const int m = rbase + rl, mr = mod_row(m);
        const float rsr = rsl[rl];
        const bf16* xp = X + (size_t)m * 1024 + 8 * hh; const float* gp = ng + 8 * hh; const float* scp = Mo + (size_t)mr * NMODC + 4 * 1024 + 8 * hh; const float* shp = Mo + (size_t)mr * NMODC + 3 * 1024 + 8 * hh;
        const LAS unsigned char* wh = WHI + r * WIMG_RS + 16 * hh; const LAS unsigned char* wl = WLO + r * WIMG_RS + 16 * hh;
        f32x16 acc;
#pragma unroll
        for (int g = 0; g < 16; ++g) acc[g] = 0.f;
#define RT_LD(q, s_) do { const int ss_ = (s_) & 63; q##x = *(const GAS v4u*)(xp + 16 * ss_); q##g0 = *(const GAS f32x4*)(gp + 16 * ss_); q##g1 = *(const GAS f32x4*)(gp + 16 * ss_ + 4); \
            q##c0 = *(const GAS f32x4*)(scp + 16 * ss_); q##c1 = *(const GAS f32x4*)(scp + 16 * ss_ + 4); q##h0 = *(const GAS f32x4*)(shp + 16 * ss_); q##h1 = *(const GAS f32x4*)(shp + 16 * ss_ + 4); } while (0)
#define RT_STEP(q, s_) do { const v4u xr8 = q##x; const f32x4 x0 = (f32x4){__uint_as_float(xr8.x << 16), __uint_as_float(xr8.x & 0xffff0000u), __uint_as_float(xr8.y << 16), __uint_as_float(xr8.y & 0xffff0000u)}, x1 = (f32x4){__uint_as_float(xr8.z << 16), __uint_as_float(xr8.z & 0xffff0000u), __uint_as_float(xr8.w << 16), __uint_as_float(xr8.w & 0xffff0000u)}; \
            const f32x4 y0 = (x0 * rsr) * q##g0 * (q##c0 + 1.0f) + q##h0, y1 = (x1 * rsr) * q##g1 * (q##c1 + 1.0f) + q##h1;        \
            v4u ph, pl; \
            ph.x = pg8::cvt_pk_bf16(y0.x, y0.y); ph.y = pg8::cvt_pk_bf16(y0.z, y0.w); ph.z = pg8::cvt_pk_bf16(y1.x, y1.y); ph.w = pg8::cvt_pk_bf16(y1.z, y1.w); \
            pl.x = pg8::cvt_pk_bf16(y0.x - __uint_as_float(ph.x << 16), y0.y - __uint_as_float(ph.x & 0xffff0000u)); pl.y = pg8::cvt_pk_bf16(y0.z - __uint_as_float(ph.y << 16), y0.w - __uint_as_float(ph.y & 0xffff0000u)); \
            pl.z = pg8::cvt_pk_bf16(y1.x - __uint_as_float(ph.z << 16), y1.y - __uint_as_float(ph.z & 0xffff0000u)); pl.w = pg8::cvt_pk_bf16(y1.z - __uint_as_float(ph.w << 16), y1.w - __uint_as_float(ph.w & 0xffff0000u)); \
            const bf16x8 ahi = __builtin_bit_cast(bf16x8, ph), alo = __builtin_bit_cast(bf16x8, pl); \
            const bf16x8 bhi = *(const LAS bf16x8*)(wh + 32 * (s_)), blo = *(const LAS bf16x8*)(wl + 32 * (s_)); \
            acc = __builtin_amdgcn_mfma_f32_32x32x16_bf16(ahi, bhi, acc, 0, 0, 0); acc = __builtin_amdgcn_mfma_f32_32x32x16_bf16(alo, bhi, acc, 0, 0, 0); acc = __builtin_amdgcn_mfma_f32_32x32x16_bf16(ahi, blo, acc, 0, 0, 0); } while (0)
#define RT_DECL(q) v4u q##x; f32x4 q##g0, q##g1, q##c0, q##c1, q##h0, q##h1
        RT_DECL(pa); RT_DECL(pb); RT_DECL(pc); RT_DECL(pd);
        RT_LD(pa, 0); RT_LD(pb, 1);
#pragma unroll 1
        for (int s = 0; s < 64; s += 4) {
            RT_LD(pc, s + 2); RT_LD(pd, s + 3); __builtin_amdgcn_sched_barrier(0);
            RT_STEP(pa, s); RT_STEP(pb, s + 1); __builtin_amdgcn_sched_barrier(0);
            RT_LD(pa, s + 4); RT_LD(pb, s + 5); __builtin_amdgcn_sched_barrier(0);
            RT_STEP(pc, s + 2); RT_STEP(pd, s + 3); __builtin_amdgcn_sched_barrier(0); }
#undef RT_LD
#undef RT_STEP
#undef RT_DECL
        const float brt = (PARF(ws) + P_BR)[layer * 32 + r];
#pragma unroll
        for (int g = 0; g < 16; ++g) { const int rowl = 32 * wave + (g & 3) + 8 * (g >> 2) + 4 * hh;
            float v = acc[g] + brt; float tv[4]; int te[4];
#pragma unroll
            for (int k = 0; k < 4; ++k) { float mx = v;
#pragma unroll
                for (int o = 1; o < 32; o <<= 1) mx = fmaxf(mx, shx(mx, o, lane));
                const unsigned long long bm = __ballot(v == mx); const unsigned hm = hh ? (unsigned)(bm >> 32) : (unsigned)bm; const int first = __ffs((int)hm) - 1;
                te[k] = first; tv[k] = mx; if (r == first) v = -INFINITY; }
            const bool valid = rowl < 136 && !(lastl && mod_row(rbase + (rowl < 136 ? rowl : 135)) == 8);
            if (r == 0 && rowl < 136) {
                if (valid) { const float e1 = __expf(tv[1] - tv[0]), e2 = __expf(tv[2] - tv[0]), e3 = __expf(tv[3] - tv[0]); const float inv = 1.0f / (1.0f + e1 + e2 + e3);
                    const float wk[4] = {inv, e1 * inv, e2 * inv, e3 * inv};
#pragma unroll
                    for (int k = 0; k < 4; ++k) { const unsigned lp = atomicAdd((unsigned*)&lcnt[te[k]], 1u); ent[(rowl * 4 + k) * 2 + 0] = ((unsigned)te[k] << 24) | lp; ent[(rowl * 4 + k) * 2 + 1] = __float_as_uint(wk[k]); } }
                else {
#pragma unroll
                    for (int k = 0; k < 4; ++k) ent[(rowl * 4 + k) * 2 + 0] = 0xffffffffu; } } }
    }
    __syncthreads();
    if (tid < 32) gb[tid] = __hip_atomic_fetch_add(cnt + tid * 16, lcnt[tid], __ATOMIC_RELAXED, __HIP_MEMORY_SCOPE_AGENT);
    __syncthreads();
    for (int q = tid; q < 136 * 4; q += NWAVES * 64) { const unsigned pe = ent[q * 2 + 0];
        if (pe != 0xffffffffu) { const unsigned e = pe >> 24, lp = pe & 0xffffffu; const int m = rbase + (q >> 2);
            ((unsigned*)(sbase + WS_SLOT))[m * 4 + (q & 3)] = (e << 24) | (gb[e] + lp); ((unsigned*)(sbase + WS_GATEW))[m * 4 + (q & 3)] = ent[q * 2 + 1];
            if (!dummy) ((int*)(ws + WS_LIST))[(size_t)e * MT + gb[e] + lp] = m; } }
  }
}
__device__ __forceinline__ void build_expert_tables(unsigned char* ws, int layer, LAS unsigned char* lds, int tid) {
    LAS int* t2e = (LAS int*)(lds + AUX_T2E); LAS int* base = (LAS int*)(lds + AUX_BASE); LAS int* ntp = (LAS int*)(lds + AUX_NT); LAS int* cntl = (LAS int*)(lds + AUX_CNT);
    gu32* cnt = (gu32*)(ws + WS_CTL) + CW_CNT + layer * 32 * 16;
    __syncthreads();
    if (tid < 64) { const unsigned cval = (tid < 32) ? __hip_atomic_load(cnt + tid * 16, RLX_AGENT) : 0u; const int tiles = (int)((cval + 255u) >> 8);
        int pre = tiles;
#pragma unroll
        for (int o = 1; o < 32; o <<= 1) { const int ln = tid & 63; const int t = __builtin_amdgcn_ds_bpermute(((ln >= o) ? ln - o : ln) << 2, pre); if (ln >= o) pre += t; }
        const int start = pre - tiles;
        if (tid < 32) { base[tid] = start * 256; cntl[tid] = (int)cval; for (int t = 0; t < tiles; ++t) t2e[start + t] = tid; if (tid == 31) ntp[0] = pre; } }
    __syncthreads();
}
__device__ __forceinline__ void phase_moe_gather(unsigned char* ws, int layer, LAS unsigned char* lds, int gw, int NGW, int lane, int tid) {
    build_expert_tables(ws, layer, lds, tid);
    const LAS int* base = (const LAS int*)(lds + AUX_BASE);
    const bf16* XN = (const bf16*)(ws + WS_XN); bf16* XG = (bf16*)(ws + WS_XG);
    const unsigned* slot = (const unsigned*)(ws + WS_SLOT); unsigned* spos = (unsigned*)(ws + WS_SLOTPOS);
    for (int m = gw; m < MT; m += NGW) {
        if (layer == NLAYER - 1 && mod_row(m) == 8) continue;
        const GAS v4u* src = (const GAS v4u*)(XN + (size_t)m * 1024) + lane; const v4u a = src[0], b = src[64];
#pragma unroll
        for (int k = 0; k < 4; ++k) { const unsigned pe = slot[m * 4 + k]; const int dst = base[pe >> 24] + (int)(pe & 0xffffffu);
            GAS v4u* dp = (GAS v4u*)(XG + (size_t)dst * 1024) + lane; dp[0] = a; dp[64] = b;
            if (lane == 0) spos[m * 4 + k] = (unsigned)dst; }
    }
}
__device__ __forceinline__ void phase_moe_combine(unsigned char* ws, float* out, int layer, LAS unsigned char* lds, int gw, int NGW, int lane, int tid, bool dummy = false) {
    build_expert_tables(ws, layer, lds, tid);
    const LAS int* base = (const LAS int*)(lds + AUX_BASE);
    bf16* X = (bf16*)(ws + WS_X); const unsigned char* Y = ws + WS_Y;
    const float* Mo = (const float*)(ws + WS_MOD) + (size_t)layer * MODROWS * NMODC;
    const unsigned* slot = (const unsigned*)(ws + WS_SLOT); const float* gw4 = (const float*)(ws + WS_GATEW);
    for (int m0 = gw; m0 < MT; m0 += 2 * NGW) {
        int mm[2], bb[2], ww[2], mrr[2]; bool ok[2];
#pragma unroll
        for (int p = 0; p < 2; ++p) { const int m = m0 + p * NGW; ok[p] = m < MT; mm[p] = ok[p] ? m : m0; bb[p] = mm[p] / TB; ww[p] = mm[p] - bb[p] * TB; mrr[p] = (ww[p] < CTXL) ? 8 : bb[p];
            if (layer == NLAYER - 1 && ww[p] < CTXL) ok[p] = false; }
        if (!ok[0] && !ok[1]) continue;
        unsigned pe[2][4]; float wk[2][4];
#pragma unroll
        for (int p = 0; p < 2; ++p)
#pragma unroll
            for (int k = 0; k < 4; ++k) { pe[p][k] = slot[mm[p] * 4 + k]; wk[p][k] = gw4[mm[p] * 4 + k]; }
        unsigned long long xv[2][4];
#pragma unroll
        for (int p = 0; p < 2; ++p) { const GAS unsigned long long* xp = (const GAS unsigned long long*)(X + (size_t)mm[p] * 1024) + lane;
#pragma unroll
            for (int j = 0; j < 4; ++j) xv[p][j] = xp[64 * j]; }
        unsigned yv[2][4][4];
#pragma unroll
        for (int p = 0; p < 2; ++p)
#pragma unroll
            for (int k = 0; k < 4; ++k) { unsigned e = pe[p][k] >> 24; if (!ok[p] || e > 31u) e = 0u;
                const unsigned sp = ok[p] ? (unsigned)base[e] + (pe[p][k] & 0xffffffu) : 0u;
                const GAS unsigned* yp = (const GAS unsigned*)(Y + (size_t)sp * 1024) + lane;
#pragma unroll
                for (int j = 0; j < 4; ++j) yv[p][k][j] = yp[64 * j]; }
        f32x4 f[2][4]; float ss[2];
#pragma unroll
        for (int p = 0; p < 2; ++p) { const GAS f32x4* gp = (const GAS f32x4*)(Mo + (size_t)mrr[p] * NMODC + 5 * 1024) + lane;
            ss[p] = 0.f;
#pragma unroll
            for (int j = 0; j < 4; ++j) { f32x4 a = (f32x4){0.f, 0.f, 0.f, 0.f};
#pragma unroll
                for (int k = 0; k < 4; ++k) { const unsigned w8 = yv[p][k][j]; const f32x2 lo2 = __builtin_amdgcn_cvt_pk_f32_fp8((int)w8, false), hi2 = __builtin_amdgcn_cvt_pk_f32_fp8((int)w8, true); a = a + (f32x4){lo2.x, lo2.y, hi2.x, hi2.y} * wk[p][k]; }
                f[p][j] = bf4_to_f32(xv[p][j]) + gp[64 * j] * a; } }
        asm volatile("" ::: "memory");
        const bool fuse = (layer < NLAYER - 1) && !dummy;
        f32x4 pg[4], psh[2][4], psc[2][4];
        if (fuse) { const float* ng = PARF(ws) + P_N1G + (layer + 1) * 1024;
#pragma unroll
            for (int j = 0; j < 4; ++j) pg[j] = ((const GAS f32x4*)ng)[64 * j + lane];
#pragma unroll
            for (int p = 0; p < 2; ++p) { const float* Mn = (const float*)(ws + WS_MOD) + (size_t)(layer + 1) * MODROWS * NMODC + (size_t)mrr[p] * NMODC;
#pragma unroll
                for (int j = 0; j < 4; ++j) { psh[p][j] = ((const GAS f32x4*)Mn)[64 * j + lane]; psc[p][j] = ((const GAS f32x4*)(Mn + 1024))[64 * j + lane]; } } }
#pragma unroll
        for (int p = 0; p < 2; ++p) { if (!ok[p]) continue;
            GAS unsigned long long* xp = (GAS unsigned long long*)(X + (size_t)mm[p] * 1024) + lane;
            GAS f32x4* op = (GAS f32x4*)(out + ((size_t)bb[p] * SEQ + (ww[p] - CTXL)) * 1024) + lane;
#pragma unroll
            for (int j = 0; j < 4; ++j) { if (dummy) ((GAS f32x4*)((float*)(ws + WS_XG) + (size_t)mm[p] * 1024) + lane)[64 * j] = f[p][j]; else if (layer == NLAYER - 1) op[64 * j] = f[p][j]; else { const unsigned long long pk = f32_to_bf4(f[p][j]); xp[64 * j] = pk; f[p][j] = bf4_to_f32(pk); }
                ss[p] += (f[p][j].x * f[p][j].x + f[p][j].y * f[p][j].y) + (f[p][j].z * f[p][j].z + f[p][j].w * f[p][j].w); } }
        if (fuse) { float s0 = ss[0], s1 = ss[1]; const int ln = lane_now();
#pragma unroll
            for (int o = 1; o < 64; o <<= 1) { s0 += shx(s0, o, ln); s1 += shx(s1, o, ln); }
            const float rsv[2] = {1.0f / sqrtf(s0 * (1.0f / 1024.0f) + RMS_EPS), 1.0f / sqrtf(s1 * (1.0f / 1024.0f) + RMS_EPS)};
#pragma unroll
            for (int p = 0; p < 2; ++p) { if (!ok[p]) continue;
                { GAS unsigned* o4 = (GAS unsigned*)(ws + WS_XN + (size_t)mm[p] * 1024) + lane;
#pragma unroll
                  for (int j = 0; j < 4; ++j) { const f32x4 y = (f[p][j] * rsv[p]) * pg[j] * (psc[p][j] + 1.0f) + psh[p][j]; o4[64 * j] = pg8::pk4_fp8_sat(y.x, y.y, y.z, y.w); } } } }
    }
}

constexpr int NPH_L = 11, NPHASE = 2 + NPH_L * NLAYER;
#ifndef PHMASK
#define PHMASK 0x7fff
#endif
#define EN(b) ((PHMASK >> (b)) & 1)
#ifndef DUPMASK
#define DUPMASK 0
#endif
#define DUP(b) for (int rep_ = 0; rep_ < (((DUPMASK >> (b)) & 1) ? 2 : 1); ++rep_)
__global__ void __launch_bounds__(NWAVES * 64, 2) dit_fwd(Args args) {
    extern __shared__ __attribute__((aligned(16))) unsigned char lds_raw[];
    LAS unsigned char* lds = (LAS unsigned char*)lds_raw;
    volatile LAS unsigned* MISC = (volatile LAS unsigned*)(lds + MISC_OFF);
    const int G = gridDim.x, bx = blockIdx.x;
    const int vcu = (G % 8 == 0) ? (bx % 8) * (G / 8) + bx / 8 : bx;
    const int wave0 = __builtin_amdgcn_readfirstlane((int)threadIdx.x >> 6);
#define LANE_ID(z) ((int)__builtin_amdgcn_mbcnt_hi(~0u, __builtin_amdgcn_mbcnt_lo(~0u, (z))))
    { const int t0 = (wave0 << 6) | LANE_ID(0u); for (int u = t0; u < (LDS_BYTES - MISC_OFF) / 4; u += NWAVES * 64) ((LAS unsigned*)(lds + MISC_OFF))[u] = 0u; }
    __syncthreads();
    const int lo = args.ph_lo, hi = args.ph_hi;
    XcdBarrier bar; bar.bar = (unsigned*)(args.ws + WS_CTL) + CW_BAR; bar.x = 0; bar.st = nullptr;
    if (hi - lo > 1) bar = xcd_barrier_post((unsigned*)(args.ws + WS_CTL) + CW_BAR, MISC + 8, wave0 == 0 && LANE_ID(0u) == 0);
#define IN(k) (lo <= (k) && (k) < hi)
#define SEAM(k) do { if (IN(k) && IN((k) + 1)) { XcdBarrier b_ = bar; unsigned zb_ = 0u; LAUNDER_S(zb_); b_.bar = bar.bar + zb_; xcd_barrier(b_, wave0 == 0 && LANE_ID(zb_) == 0); } } while (0)
#define PHASE_IDS() unsigned zoff_ = 0u; LAUNDER_S(zoff_); int tid = (wave0 << 6) | LANE_ID(zoff_); LAUNDER_V(tid); const int lane = tid & 63, wave = __builtin_amdgcn_readfirstlane(tid >> 6); const int gw = vcu * NWAVES + wave, NGW = G * NWAVES; \
    unsigned char* ws = args.ws + zoff_; const int Gp = G + (int)zoff_, bxp = bx + (int)zoff_; (void)lane; (void)gw; (void)NGW; (void)Gp; (void)bxp;

    if (EN(0) && IN(0)) DUP(0) { PHASE_IDS(); p0_prologue(args, lds, gw, NGW, wave, lane); } SEAM(0);
    if (EN(1) && IN(1)) { PHASE_IDS(); p1_mod_reduce(args, gw * 64 + lane, NGW * 64); } SEAM(1);

    for (int layer = 0; layer < NLAYER; ++layer) {
        const int pb = 2 + NPH_L * layer, lh = layer >> 1;
        if (layer == 0) { if (EN(2) && IN(pb + 0)) DUP(2) { PHASE_IDS(); phase_modulate1(ws, layer, gw, NGW, lane); } SEAM(pb + 0); }
        if ((layer & 1) == 0) {
            if (EN(3) && IN(pb + 1)) DUP(3) {
                PHASE_IDS();
                pg8::Gemm g{(const pg8::bf16_t*)(ws + WS_XN), (const pg8::bf16_t*)(ws + WS_WQKV + (size_t)lh * QKVN * 1024), MT, QKVN, 512, 0};
                pg8::StaticOrder S; S.init(MT, QKVN, Gp, bxp);
                LAS float* gl = (LAS float*)(lds + AUX_RS);
                if (tid < 128) gl[tid] = (PARF(ws) + (tid < 64 ? P_QG : P_KG - 64) + lh * 64)[tid];
                LAS float* rtab = (LAS float*)(lds + AUX_ROWTAB);
                { const float* rc = (const float*)(ws + WS_ROPE);
#pragma unroll
                  for (int q = 0; q < 2; ++q) { const int idx = tid + 512 * q, vv = idx >> 4, ii = idx & 15; rtab[idx] = rc[vv * 32 + 16 + ii]; rtab[1024 + idx] = rc[SEQ * 32 + vv * 32 + 16 + ii]; } }
                __syncthreads();
                pg8::EpiQKV E{ws, WS_Q, WS_K - WS_Q, WS_V - WS_K, gl, rtab, ATT_C2, 1.0f / 32.0f};
                pg8::gemm_phase<pg8::EpiQKV, pg8::StaticOrder, true, true, false, true>(lds + RING_OFF, g, S, E, tid);
            } SEAM(pb + 1);
            if (EN(5) && IN(pb + 3)) DUP(5) {
                PHASE_IDS();
                const attn_body::bf16* Qp = (const attn_body::bf16*)(ws + WS_Q); const attn_body::bf16* Kp = (const attn_body::bf16*)(ws + WS_K); const attn_body::bf16* Vp = (const attn_body::bf16*)(ws + WS_V);
                attn_body::bf16* Op = (attn_body::bf16*)(ws + WS_XN);
                if (G == 256) {
                    for (int i = 0; i < 9; ++i) {
                        long qrow0, kvrow0; int NT, h;
                        if (i < 8) { const int x = vcu >> 5, j = vcu & 31, pair = 4 * x + (i >> 1), wi = (i & 1) * 32 + j, hq = wi >> 4, qb = wi & 15, b = pair >> 2, hk = pair & 3;
                            h = hk * 4 + hq; qrow0 = (long)b * TB + CTXL + qb * 256; kvrow0 = (long)b * TB; NT = TB / 64; }
                        else { if (vcu >= 128) break; const int b = vcu >> 4; h = vcu & 15; qrow0 = (long)b * TB; kvrow0 = qrow0; NT = CTXL / 64; }
                        attn_body::attn_unit<8>(qrow0, kvrow0, NT, h, Qp, Kp, Vp, Op, (char*)lds_raw + RING_OFF, tid);
                    }
                } else {
                    for (int U = bx; U < 2048 + 128; U += G) {
                        long qrow0, kvrow0; int NT, h;
                        if (U < 2048) { const int pair = U >> 6, wi = U & 63, hq = wi >> 4, qb = wi & 15, b = pair >> 2, hk = pair & 3; h = hk * 4 + hq; qrow0 = (long)b * TB + CTXL + qb * 256; kvrow0 = (long)b * TB; NT = TB / 64; }
                        else { const int v = U - 2048, b = v >> 4; h = v & 15; qrow0 = (long)b * TB; kvrow0 = qrow0; NT = CTXL / 64; }
                        attn_body::attn_unit<8>(qrow0, kvrow0, NT, h, Qp, Kp, Vp, Op, (char*)lds_raw + RING_OFF, tid);
                    }
                }
            } SEAM(pb + 3);
        } else {
            if (EN(6) && IN(pb + 1)) DUP(6) {
                PHASE_IDS();
                pg8::Gemm g{(const pg8::bf16_t*)(ws + WS_XN), (const pg8::bf16_t*)(ws + WS_WIN + (size_t)lh * WINP * 1024), MT, WINP, 512, 0};
                pg8::StaticOrder S; S.init(MT, WINP, Gp, bxp);
                pg8::EpiBf16 E{(pg8::bf16_t*)(ws + WS_G), WINP, 1.0f / 32.0f, ws + WS_Y, 8, 12};
                pg8::gemm_phase<pg8::EpiBf16, pg8::StaticOrder, true, true, false, true>(lds + RING_OFF, g, S, E, tid);
            } SEAM(pb + 1);
            if (EN(7) && IN(pb + 2)) DUP(7) { { PHASE_IDS(); phase_gla_g0v(ws, tid, Gp, bxp); } { PHASE_IDS(); phase_gla_g0(ws, lh, lds, tid, Gp, bxp); } } SEAM(pb + 2);
            if (EN(8) && IN(pb + 3)) DUP(8) { PHASE_IDS(); phase_gla_g12(ws, lds, gw, wave, lane); } SEAM(pb + 3);
            if (EN(8) && IN(pb + 4)) DUP(9) { PHASE_IDS(); phase_gla_g3(ws, lh, lds, tid); } SEAM(pb + 4);
        }
        if (EN(9) && IN(pb + 5)) {
            PHASE_IDS();
            const pg8::bf16_t* Wt = (const pg8::bf16_t*)(ws + ((layer & 1) ? WS_WOG : WS_WOA) + (size_t)lh * 1024 * 1024);
            pg8::Gemm g{(const pg8::bf16_t*)(ws + ((layer & 1) ? WS_Q : WS_XN)), Wt, MT, 1024, 512, 0};
            pg8::StaticOrder S; if (layer == NLAYER - 1) S.init(NB * SEQ, 1024, Gp, bxp, true); else S.init(MT, 1024, Gp, bxp);
            pg8::EpiResGate E{(pg8::bf16_t*)(ws + WS_X), (const float*)(ws + WS_MOD) + (size_t)layer * MODROWS * NMODC + 2 * 1024, (layer & 1) ? 1.0f / 32.0f : 1.0f / 1024.0f};
            pg8::gemm_phase<pg8::EpiResGate, pg8::StaticOrder, true, true, false, true>(lds + RING_OFF, g, S, E, tid);
        } SEAM(pb + 5);
        if (EN(10) && IN(pb + 6)) { if ((DUPMASK >> 10) & 1) { PHASE_IDS(); phase_modulate2_route(ws, layer, lds, vcu, wave, lane, tid, true); __syncthreads(); } PHASE_IDS(); phase_modulate2_route(ws, layer, lds, vcu, wave, lane, tid); } SEAM(pb + 6);
        if (EN(12) && IN(pb + 8)) DUP(12) {
            PHASE_IDS();
            build_expert_tables(ws, layer, lds, tid);
            const int nT = __builtin_amdgcn_readfirstlane(((const LAS int*)(lds + AUX_NT))[0]);
            pg8::MoeOrder S{nT, 8, Gp, bxp, (const LAS int*)(lds + AUX_T2E)};
            LAS unsigned short* rowtab = (LAS unsigned short*)(lds + AUX_ROWTAB);
            { const LAS int* base = (const LAS int*)(lds + AUX_BASE); const LAS int* cntl = (const LAS int*)(lds + AUX_CNT); const int* LIST = (const int*)(ws + WS_LIST);
              pg8::Unit u;
              int rv[ROWTAB_UNITS];
#pragma unroll
              for (int i = 0; i < ROWTAB_UNITS; ++i) { const bool ok = S.next(i, u); const int e = ok ? u.e : 0, pos = ok ? (u.pm - (base[e] >> 8)) * 256 + (tid & 255) : 0;
                  rv[i] = (ok && pos < cntl[e]) ? LIST[(size_t)e * MT + pos] : 0; }
#pragma unroll
              for (int i = 0; i < ROWTAB_UNITS; ++i) if (tid < 256) rowtab[i * 256 + tid] = (unsigned short)rv[i];
              __syncthreads(); }
            pg8::Gemm g{(const pg8::bf16_t*)(ws + WS_XN8), (const pg8::bf16_t*)(ws + WS_WGU + (size_t)layer * 32 * 2048 * 1024), MPAD, 2048, 512, (size_t)2048 * 1024, rowtab};
            pg8::EpiSwiGLU8 E{ws + WS_ACT, PARF(ws) + P_BGU + (size_t)layer * 32 * 2048, 1.0f / 32.0f};
#if (DUPMASK >> 15) & 1
            { pg8::EpiNull8 E0; pg8::gemm_phase<pg8::EpiNull8, pg8::MoeOrder, true, true, true, true>(lds + RING_OFF, g, S, E0, tid); __syncthreads(); }
#endif
            pg8::gemm_phase<pg8::EpiSwiGLU8, pg8::MoeOrder, true, true, true, true>(lds + RING_OFF, g, S, E, tid);
        } SEAM(pb + 8);
        if (EN(13) && IN(pb + 9)) DUP(13) {
            PHASE_IDS();
            build_expert_tables(ws, layer, lds, tid);
            const int nT = __builtin_amdgcn_readfirstlane(((const LAS int*)(lds + AUX_NT))[0]);
            pg8::Gemm g{(const pg8::bf16_t*)(ws + WS_ACT), (const pg8::bf16_t*)(ws + WS_WDN + (size_t)layer * 32 * 1024 * 1024), MPAD, 1024, 512, (size_t)1024 * 1024};
            pg8::MoeOrder S{nT, 4, Gp, bxp, (const LAS int*)(lds + AUX_T2E), true};
            pg8::EpiBiasF8 E{ws + WS_Y, PARF(ws) + P_BDN + (size_t)layer * 32 * 1024, 1.0f / 32.0f};
            pg8::gemm_phase<pg8::EpiBiasF8, pg8::MoeOrder, true, true, false, true>(lds + RING_OFF, g, S, E, tid);
        } SEAM(pb + 9);
        if (EN(14) && IN(pb + 10)) { if ((DUPMASK >> 14) & 1) { PHASE_IDS(); phase_moe_combine(ws, args.out, layer, lds, gw, NGW, lane, tid, true); } PHASE_IDS(); phase_moe_combine(ws, args.out, layer, lds, gw, NGW, lane, tid); } SEAM(pb + 10);
    }
#undef IN
#undef EN
#undef DUP
#undef SEAM
#undef PHASE_IDS
#undef LANE_ID
}

extern "C" void kernel_launch(void* const* d_in, const int* in_sizes, int n_in, void* d_out, int out_size, void* d_ws, size_t ws_size, hipStream_t stream) {
    static int grid = 0;
    if (grid == 0) {
        if (n_in != 25 || out_size != NB * SEQ * DMODEL || ws_size < WS_END) { fprintf(stderr, "kernel_launch: unexpected shapes: n_in %d out %d ws %zu (need >= %zu)\n", n_in, out_size, ws_size, (size_t)WS_END); grid = -1; return; }
        int dev = 0, cus = 0, per_cu = 0;
        if (hipGetDevice(&dev) != hipSuccess || hipDeviceGetAttribute(&cus, hipDeviceAttributeMultiprocessorCount, dev) != hipSuccess) { grid = -1; return; }
        if (hipFuncSetAttribute((const void*)dit_fwd, hipFuncAttributeMaxDynamicSharedMemorySize, LDS_BYTES) != hipSuccess) { fprintf(stderr, "kernel_launch: hipFuncSetAttribute failed\n"); grid = -1; return; }
        if (hipOccupancyMaxActiveBlocksPerMultiprocessor(&per_cu, (const void*)dit_fwd, NWAVES * 64, LDS_BYTES) != hipSuccess || per_cu < 1) fprintf(stderr, "kernel_launch: occupancy query reports %d\n", per_cu);
        (void)hipGetLastError();
        grid = cus;
    }
    if (grid < 0) return;
    if (hipMemsetAsync((char*)d_ws + WS_CTL, 0, CTL_ZERO_BYTES, stream) != hipSuccess) { fprintf(stderr, "kernel_launch: memset failed\n"); return; }
    Args a{};
    for (int i = 0; i < 25; ++i) a.in[i] = (const float*)d_in[i];
    a.out = (float*)d_out; a.ws = (unsigned char*)d_ws;
#if MK_ONE_LAUNCH
    a.ph_lo = 0; a.ph_hi = NPHASE;
    hipLaunchKernelGGL(dit_fwd, dim3(grid), dim3(NWAVES * 64), LDS_BYTES, stream, a);
#else
    for (int p = 0; p < NPHASE; ++p) { a.ph_lo = p; a.ph_hi = p + 1; hipLaunchKernelGGL(dit_fwd, dim3(grid), dim3(NWAVES * 64), LDS_BYTES, stream, a); }
#endif
    const hipError_t le = hipPeekAtLastError();
    if (le != hipSuccess) fprintf(stderr, "kernel_launch: launch failed: %s\n", hipGetErrorName(le));
}
```
